# Optimizing an MI355X kernel written in HIP

```python
import jax
import jax.numpy as jnp
from jax import lax
import numpy as np

D_MODEL = 1024
BATCH = 8
SEQ = 8192
DEPTH = 2

HEAD_DIM = 64
A_HEADS = 8
A_KV_HEADS = 2
A_HALF_WINDOW = 128
B_HEADS_PER_GROUP = 4
B_CONFIGS = ((128, 1), (512, 4), (2048, 16))
C_HEADS = 8
GRID_W = 64
NA_KH = 8
NA_KW = 16
NUM_BUCKETS = 32
REL_MAX_DIST = 2048
N_GROUPS = 4
EXPERTS_PER_GROUP = 8
N_EXPERTS = N_GROUPS * EXPERTS_PER_GROUP
TOP_K = 2
D_EXPERT = 512
MOE_BLOCK = 256
BLK = 128
LN_EPS = 1e-5
NEG_INF = -1e30
DEEPNORM_ALPHA = (2 * DEPTH) ** 0.25
DEEPNORM_BETA = (8 * DEPTH) ** -0.25

A_Q = A_HEADS * HEAD_DIM
A_KV = A_KV_HEADS * HEAD_DIM
B_W = B_HEADS_PER_GROUP * HEAD_DIM
C_W = C_HEADS * HEAD_DIM
N_BRANCH = 3
IN_SIZES = (A_Q, A_KV, A_KV) + (B_W,) * (3 * len(B_CONFIGS)) + (C_W,) * 3 + (D_MODEL,) * N_BRANCH
W_IN_COLS = sum(IN_SIZES)
N_BIAS_HEADS = A_HEADS + B_HEADS_PER_GROUP * len(B_CONFIGS)

kernel_name = 'hybrid_gated_mixers_hmoe_encoder'


def layer_norm(x, g, b):
    xf = x.astype(jnp.float32)
    mu = xf.mean(-1, keepdims=True)
    var = jnp.square(xf - mu).mean(-1, keepdims=True)
    return ((xf - mu) * lax.rsqrt(var + LN_EPS) * g + b).astype(x.dtype)


def t5_bucket(rel):
    half = NUM_BUCKETS // 2
    max_exact = half // 2
    ret = np.where(rel > 0, half, 0)
    n = np.abs(rel)
    large = max_exact + (np.log(np.maximum(n, max_exact) / max_exact)
                         / np.log(REL_MAX_DIST / max_exact) * (half - max_exact)).astype(np.int32)
    large = np.minimum(large, half - 1)
    return (ret + np.where(n < max_exact, n, large)).astype(np.int32)


def banded_attention(q, k, v, half, dist_scale, bias_tab, sink, with_lse):
    N, L, Hk, G, Dh = q.shape
    nb = -(-L // BLK)
    Lp = nb * BLK
    KL = BLK + 2 * half
    qp = jnp.pad(q, ((0, 0), (0, Lp - L), (0, 0), (0, 0), (0, 0)))
    kv_pad = ((0, 0), (half, Lp - L + half), (0, 0), (0, 0))
    kp = jnp.pad(k, kv_pad)
    vp = jnp.pad(v, kv_pad)
    off = np.arange(KL)[None, :] - half - np.arange(BLK)[:, None]
    band = jnp.asarray(np.abs(off) <= half)
    bucket = jnp.asarray(t5_bucket(off * dist_scale))
    bias = bias_tab[bucket].astype(jnp.float32).reshape(BLK, KL, Hk, G).transpose(2, 3, 0, 1)
    scale = Dh ** -0.5

    def block(b):
        start = b * BLK
        qb = lax.dynamic_slice_in_dim(qp, start, BLK, axis=1)
        kb = lax.dynamic_slice_in_dim(kp, start, KL, axis=1)
        vb = lax.dynamic_slice_in_dim(vp, start, KL, axis=1)
        kpos = start - half + jnp.arange(KL)
        valid = band & ((kpos >= 0) & (kpos < L))[None, :]
        s = jnp.einsum('nqhgd,nkhd->nhgqk', qb, kb, preferred_element_type=jnp.float32) * scale + bias
        s = jnp.where(valid, s, NEG_INF)
        m = s.max(-1)
        if sink is not None:
            sk = sink.astype(jnp.float32)[None, :, :, None]
            m = jnp.maximum(m, sk)
        p = jnp.exp(s - m[..., None])
        denom = p.sum(-1)
        if sink is not None:
            denom = denom + jnp.exp(sk - m)
        o = jnp.einsum('nhgqk,nkhd->nqhgd', p, vb.astype(jnp.float32)) / denom.transpose(0, 3, 1, 2)[..., None]
        if with_lse:
            return o.astype(q.dtype), m + jnp.log(denom)
        return o.astype(q.dtype)

    res = lax.map(block, jnp.arange(nb))
    if with_lse:
        o, lse = res
        lse = lse.transpose(1, 0, 4, 2, 3).reshape(N, Lp, Hk, G)[:, :L]
    else:
        o = res
    o = jnp.moveaxis(o, 0, 1).reshape(N, Lp, Hk, G, Dh)[:, :L]
    if with_lse:
        return o, lse
    return o


def dilated_attention(q, k, v, window, dilation, bias_tab):
    Bn, L, H, Dh = q.shape
    Ls = L // dilation

    def to_sub(t):
        return t.reshape(Bn, Ls, dilation, H, Dh).transpose(0, 2, 1, 3, 4).reshape(Bn * dilation, Ls, H, Dh)

    o, lse = banded_attention(to_sub(q)[:, :, :, None], to_sub(k), to_sub(v),
                              window // (2 * dilation), dilation, bias_tab, None, True)
    o = o[:, :, :, 0].reshape(Bn, dilation, Ls, H, Dh).transpose(0, 2, 1, 3, 4).reshape(Bn, L, H, Dh)
    lse = lse[..., 0].reshape(Bn, dilation, Ls, H).transpose(0, 2, 1, 3).reshape(Bn, L, H)
    return o, lse


def neighborhood_attention(q, k, v, rpb):
    Bn, L, H, Dh = q.shape
    rows = L // GRID_W
    kh = min(NA_KH, rows)
    n_cb = GRID_W // NA_KW
    kcw = 2 * NA_KW
    qcol = np.arange(GRID_W).reshape(n_cb, NA_KW)
    cb_start = np.clip(np.arange(n_cb) * NA_KW - NA_KW // 2, 0, GRID_W - kcw)
    kcol = cb_start[:, None] + np.arange(kcw)
    qstart = np.clip(qcol - NA_KW // 2, 0, GRID_W - NA_KW)
    col_valid = (kcol[:, None, :] >= qstart[:, :, None]) & (kcol[:, None, :] < qstart[:, :, None] + NA_KW)
    cidx = np.clip(kcol[:, None, :] - qcol[:, :, None] + NA_KW - 1, 0, 2 * NA_KW - 2)
    mask = jnp.asarray(np.broadcast_to(col_valid[:, :, None, :], (n_cb, NA_KW, kh, kcw)).reshape(n_cb, NA_KW, kh * kcw))
    qg = q.reshape(Bn, rows, GRID_W, H, Dh)
    kg = k.reshape(Bn, rows, GRID_W, H, Dh)
    vg = v.reshape(Bn, rows, GRID_W, H, Dh)
    rpb32 = rpb.astype(jnp.float32)
    scale = Dh ** -0.5

    def row(i):
        rstart = jnp.clip(i - kh // 2, 0, rows - kh)
        qr = lax.dynamic_index_in_dim(qg, i, axis=1, keepdims=False).reshape(Bn, n_cb, NA_KW, H, Dh)
        kr = lax.dynamic_slice_in_dim(kg, rstart, kh, axis=1)[:, :, kcol]
        vr = lax.dynamic_slice_in_dim(vg, rstart, kh, axis=1)[:, :, kcol]
        kr = kr.transpose(0, 2, 1, 3, 4, 5).reshape(Bn, n_cb, kh * kcw, H, Dh)
        vr = vr.transpose(0, 2, 1, 3, 4, 5).reshape(Bn, n_cb, kh * kcw, H, Dh)
        ridx = rstart + jnp.arange(kh) - i + NA_KH - 1
        bias = rpb32[:, ridx[None, None, :, None], cidx[:, :, None, :]]
        bias = bias.reshape(H, n_cb, NA_KW, kh * kcw).transpose(1, 0, 2, 3)
        s = jnp.einsum('ncqhd,nckhd->nchqk', qr, kr, preferred_element_type=jnp.float32) * scale + bias
        s = jnp.where(mask[:, None], s, NEG_INF)
        p = jax.nn.softmax(s, axis=-1)
        o = jnp.einsum('nchqk,nckhd->ncqhd', p, vr.astype(jnp.float32))
        return o.reshape(Bn, GRID_W, H, Dh).astype(q.dtype)

    out = lax.map(row, jnp.arange(rows))
    return jnp.moveaxis(out, 0, 1).reshape(Bn, L, H, Dh)


def gated_mixer(h, rel_bias, w_in, b_gate, sink_a, rpb_c, w_br_a, w_br_b, w_br_c, w_out):
    Bn, L, _ = h.shape
    n_b = len(B_CONFIGS)
    proj = h @ w_in
    parts = jnp.split(proj, [int(c) for c in np.cumsum(IN_SIZES)[:-1]], axis=-1)
    qa = parts[0].reshape(Bn, L, A_KV_HEADS, A_HEADS // A_KV_HEADS, HEAD_DIM)
    ka = parts[1].reshape(Bn, L, A_KV_HEADS, HEAD_DIM)
    va = parts[2].reshape(Bn, L, A_KV_HEADS, HEAD_DIM)
    o_a = banded_attention(qa, ka, va, A_HALF_WINDOW, 1, rel_bias[:, :A_HEADS],
                           sink_a.reshape(A_KV_HEADS, A_HEADS // A_KV_HEADS), False).reshape(Bn, L, A_Q)
    outs, lses = [], []
    for g, (window, dilation) in enumerate(B_CONFIGS):
        qb, kb, vb = [t.reshape(Bn, L, B_HEADS_PER_GROUP, HEAD_DIM) for t in parts[3 + 3 * g: 6 + 3 * g]]
        c0 = A_HEADS + g * B_HEADS_PER_GROUP
        o, lse = dilated_attention(qb, kb, vb, window, dilation, rel_bias[:, c0:c0 + B_HEADS_PER_GROUP])
        outs.append(o)
        lses.append(lse)
    wts = jax.nn.softmax(jnp.stack(lses), axis=0)
    o_b = jnp.einsum('gblh,gblhd->blhd', wts, jnp.stack(outs).astype(jnp.float32)).astype(h.dtype).reshape(Bn, L, B_W)
    qc, kc, vc = [t.reshape(Bn, L, C_HEADS, HEAD_DIM) for t in parts[3 + 3 * n_b: 6 + 3 * n_b]]
    o_c = neighborhood_attention(qc, kc, vc, rpb_c).reshape(Bn, L, C_W)
    g_a, g_b, g_c = [jax.nn.sigmoid(parts[6 + 3 * n_b + i] + b_gate[i]) for i in range(N_BRANCH)]
    merged = g_a * (o_a @ w_br_a) + g_b * (o_b @ w_br_b) + g_c * (o_c @ w_br_c)
    return merged @ w_out


def hier_moe(h, w_rg, b_rg, w_re, b_re, w_eg, w_eu, w_ed):
    Bn, L, D = h.shape
    T = Bn * L
    xf = h.reshape(T, D)
    f32 = jnp.float32
    g_logits = jnp.dot(xf, w_rg, preferred_element_type=f32) + b_rg.astype(f32)
    g_prob = jax.nn.softmax(g_logits, axis=-1)
    g_idx = lax.top_k(g_logits, 1)[1][:, 0]
    g_w = jnp.take_along_axis(g_prob, g_idx[:, None], axis=-1)[:, 0]
    e_logits_all = jnp.einsum('td,gde->tge', xf, w_re, preferred_element_type=f32) + b_re.astype(f32)
    e_logits = jnp.take_along_axis(e_logits_all, g_idx[:, None, None], axis=1)[:, 0]
    e_top, e_idx = lax.top_k(e_logits, TOP_K)
    gate = g_w[:, None] * jax.nn.softmax(e_top, axis=-1)
    eid = g_idx[:, None] * EXPERTS_PER_GROUP + e_idx
    n_assign = T * TOP_K
    e_flat = eid.reshape(n_assign)
    w_flat = gate.reshape(n_assign)
    tok_flat = jnp.arange(n_assign) // TOP_K
    order = jnp.argsort(e_flat)
    e_sorted = e_flat[order]
    counts = jnp.bincount(e_flat, length=N_EXPERTS)
    offsets = jnp.cumsum(counts) - counts
    padded = (counts + MOE_BLOCK - 1) // MOE_BLOCK * MOE_BLOCK
    pad_end = jnp.cumsum(padded)
    pad_off = pad_end - padded
    dest = pad_off[e_sorted] + (jnp.arange(n_assign) - offsets[e_sorted])
    nblk = -(-n_assign // MOE_BLOCK) + N_EXPERTS
    P = nblk * MOE_BLOCK
    buf_tok = jnp.full((P,), T, jnp.int32).at[dest].set(tok_flat[order].astype(jnp.int32))
    buf_w = jnp.zeros((P,), f32).at[dest].set(w_flat[order])
    blk_e = jnp.minimum(jnp.searchsorted(pad_end, jnp.arange(nblk) * MOE_BLOCK, side='right'), N_EXPERTS - 1)
    x_pad = jnp.concatenate([xf, jnp.zeros((1, D), xf.dtype)], axis=0)

    def run(b):
        tok = lax.dynamic_slice_in_dim(buf_tok, b * MOE_BLOCK, MOE_BLOCK)
        wb = lax.dynamic_slice_in_dim(buf_w, b * MOE_BLOCK, MOE_BLOCK)
        e = blk_e[b]
        xb = x_pad[tok]
        hid = jax.nn.silu(xb @ w_eg[e]) * (xb @ w_eu[e])
        return ((hid @ w_ed[e]) * wb[:, None]).astype(h.dtype)

    yb = lax.map(run, jnp.arange(nblk))
    out = jnp.zeros((T + 1, D), h.dtype).at[buf_tok].add(yb.reshape(P, D))[:T]
    return out.reshape(Bn, L, D)


def setup_inputs(seed: int = 0) -> dict:
    key = jax.random.key(seed)
    ks = jax.random.split(key, 26)
    f32 = jnp.float32

    def nrm(k, shape, scale):
        return jax.random.normal(k, shape, f32) * scale

    return {
        'x': nrm(ks[0], (BATCH, SEQ, D_MODEL), 1.0),
        'ln0_g': 1.0 + nrm(ks[1], (D_MODEL,), 0.05),
        'ln0_b': nrm(ks[2], (D_MODEL,), 0.02),
        'rel_bias': nrm(ks[3], (NUM_BUCKETS, N_BIAS_HEADS), 0.1),
        'w_in': nrm(ks[4], (DEPTH, D_MODEL, W_IN_COLS), D_MODEL ** -0.5),
        'b_gate': nrm(ks[5], (DEPTH, N_BRANCH, D_MODEL), 0.02),
        'sink_a': nrm(ks[6], (DEPTH, A_HEADS), 0.5),
        'rpb_c': nrm(ks[7], (DEPTH, C_HEADS, 2 * NA_KH - 1, 2 * NA_KW - 1), 0.1),
        'w_br_a': nrm(ks[8], (DEPTH, A_Q, D_MODEL), A_Q ** -0.5),
        'w_br_b': nrm(ks[9], (DEPTH, B_W, D_MODEL), B_W ** -0.5),
        'w_br_c': nrm(ks[10], (DEPTH, C_W, D_MODEL), C_W ** -0.5),
        'w_out': nrm(ks[11], (DEPTH, D_MODEL, D_MODEL), D_MODEL ** -0.5 * DEEPNORM_BETA),
        'ln1_g': 1.0 + nrm(ks[12], (DEPTH, D_MODEL), 0.05),
        'ln1_b': nrm(ks[13], (DEPTH, D_MODEL), 0.02),
        'w_rg': nrm(ks[14], (DEPTH, D_MODEL, N_GROUPS), D_MODEL ** -0.5),
        'b_rg': nrm(ks[15], (DEPTH, N_GROUPS), 0.01),
        'w_re': nrm(ks[16], (DEPTH, N_GROUPS, D_MODEL, EXPERTS_PER_GROUP), D_MODEL ** -0.5),
        'b_re': nrm(ks[17], (DEPTH, N_GROUPS, EXPERTS_PER_GROUP), 0.01),
        'w_eg': nrm(ks[18], (DEPTH, N_EXPERTS, D_MODEL, D_EXPERT), D_MODEL ** -0.5),
        'w_eu': nrm(ks[19], (DEPTH, N_EXPERTS, D_MODEL, D_EXPERT), D_MODEL ** -0.5),
        'w_ed': nrm(ks[20], (DEPTH, N_EXPERTS, D_EXPERT, D_MODEL), D_EXPERT ** -0.5 * DEEPNORM_BETA),
        'ln2_g': 1.0 + nrm(ks[21], (DEPTH, D_MODEL), 0.05),
        'ln2_b': nrm(ks[22], (DEPTH, D_MODEL), 0.02),
    }


def reference(x, ln0_g, ln0_b, rel_bias, w_in, b_gate, sink_a, rpb_c, w_br_a, w_br_b, w_br_c, w_out,
              ln1_g, ln1_b, w_rg, b_rg, w_re, b_re, w_eg, w_eu, w_ed, ln2_g, ln2_b):
    h = layer_norm(x, ln0_g, ln0_b)
    for l in range(DEPTH):
        y = gated_mixer(h, rel_bias, w_in[l], b_gate[l], sink_a[l], rpb_c[l],
                        w_br_a[l], w_br_b[l], w_br_c[l], w_out[l])
        h = layer_norm(DEEPNORM_ALPHA * h + y, ln1_g[l], ln1_b[l])
        y = hier_moe(h, w_rg[l], b_rg[l], w_re[l], b_re[l], w_eg[l], w_eu[l], w_ed[l])
        h = layer_norm(DEEPNORM_ALPHA * h + y, ln2_g[l], ln2_b[l])
    return h
```

```cpp
#include <hip/hip_runtime.h>
#include <cstdio>
#include <cstdint>
#include <cmath>

typedef unsigned short bf16;
typedef short bf16x8 __attribute__((ext_vector_type(8)));
typedef float f32x16 __attribute__((ext_vector_type(16)));
typedef float f32x4 __attribute__((ext_vector_type(4)));

constexpr int D = 1024, L = 8192, NBATCH = 8, T = NBATCH * L, DEPTH = 2;
constexpr int NCOL = 7680, QKVW = 4608, GATEW = 3072;
constexpr int CH = 32768, NCHUNK = T / CH;
constexpr int OW = 1280;
constexpr int NE = 32, DE = 512;
constexpr int MAXRT = T * 2 / 256 + NE, PROWS = MAXRT * 256;
constexpr float LN_EPS = 1e-5f;
constexpr float ALPHA = 1.41421356237309515f;
constexpr int AQ = 0, AK = 512, AV = 640, BQ0 = 768, CQ = 3072, CK = 3584, CV = 4096;

constexpr size_t MiB = 1u << 20;
constexpr size_t WS_CTL = 0;
constexpr size_t WS_HB = 232 * MiB, WS_QKV = 360 * MiB, WS_GATES = 648 * MiB, WS_OABC = 840 * MiB, WS_OG = 920 * MiB, WS_LSE = 968 * MiB,
                 WS_REC = 970 * MiB, WS_ROWTOK = 972 * MiB, WS_ROWGATE = 973 * MiB, WS_END = 974 * MiB;
constexpr size_t WS_MERGED = WS_QKV, WS_HID = WS_QKV, WS_YB = WS_QKV + 136 * MiB;

__device__ __constant__ signed char BUCK_A[257] = {12,11,11,11,11,11,11,11,11,11,11,11,11,11,11,11,11,11,11,11,11,11,11,11,11,11,11,11,11,11,11,11,11,11,11,11,11,11,11,11,11,11,11,11,11,11,11,11,11,11,11,11,11,11,11,11,11,11,11,11,11,11,11,11,11,10,10,10,10,10,10,10,10,10,10,10,10,10,10,10,10,10,10,10,10,10,10,10,10,10,10,10,10,10,10,10,10,9,9,9,9,9,9,9,9,9,9,9,9,9,9,9,9,8,8,8,8,8,8,8,8,7,6,5,4,3,2,1,0,17,18,19,20,21,22,23,24,24,24,24,24,24,24,24,25,25,25,25,25,25,25,25,25,25,25,25,25,25,25,25,26,26,26,26,26,26,26,26,26,26,26,26,26,26,26,26,26,26,26,26,26,26,26,26,26,26,26,26,26,26,26,26,27,27,27,27,27,27,27,27,27,27,27,27,27,27,27,27,27,27,27,27,27,27,27,27,27,27,27,27,27,27,27,27,27,27,27,27,27,27,27,27,27,27,27,27,27,27,27,27,27,27,27,27,27,27,27,27,27,27,27,27,27,27,27,27,28};
__device__ __constant__ signed char BUCK_B[3][129] = {
 {11,10,10,10,10,10,10,10,10,10,10,10,10,10,10,10,10,10,10,10,10,10,10,10,10,10,10,10,10,10,10,10,10,9,9,9,9,9,9,9,9,9,9,9,9,9,9,9,9,8,8,8,8,8,8,8,8,7,6,5,4,3,2,1,0,17,18,19,20,21,22,23,24,24,24,24,24,24,24,24,25,25,25,25,25,25,25,25,25,25,25,25,25,25,25,25,26,26,26,26,26,26,26,26,26,26,26,26,26,26,26,26,26,26,26,26,26,26,26,26,26,26,26,26,26,26,26,26,27},
 {13,12,12,12,12,12,12,12,12,12,12,12,12,12,12,12,12,12,12,12,12,12,12,12,12,12,12,12,12,12,12,12,12,11,11,11,11,11,11,11,11,11,11,11,11,11,11,11,11,10,10,10,10,10,10,10,10,9,9,9,9,8,8,4,0,20,24,24,25,25,25,25,26,26,26,26,26,26,26,26,27,27,27,27,27,27,27,27,27,27,27,27,27,27,27,27,28,28,28,28,28,28,28,28,28,28,28,28,28,28,28,28,28,28,28,28,28,28,28,28,28,28,28,28,28,28,28,28,29},
 {15,14,14,14,14,14,14,14,14,14,14,14,14,14,14,14,14,14,14,14,14,14,14,14,14,14,14,14,14,14,14,14,14,13,13,13,13,13,13,13,13,13,13,13,13,13,13,13,13,12,12,12,12,12,12,12,12,11,11,11,11,10,10,9,0,25,26,26,27,27,27,27,28,28,28,28,28,28,28,28,29,29,29,29,29,29,29,29,29,29,29,29,29,29,29,29,30,30,30,30,30,30,30,30,30,30,30,30,30,30,30,30,30,30,30,30,30,30,30,30,30,30,30,30,30,30,30,30,31}};

__device__ __forceinline__ float bf2f(bf16 b) { return __uint_as_float(((unsigned)b) << 16); }
__device__ __forceinline__ bf16 f2bf(float f) { unsigned u = __float_as_uint(f); u += 0x7fffu + ((u >> 16) & 1u); return (bf16)(u >> 16); }
__device__ __forceinline__ float wave_sum(float v) {
#pragma unroll
    for (int o = 1; o < 64; o <<= 1) v += __shfl_xor(v, o);
    return v;
}

__global__ __launch_bounds__(256) void k_ln(int mode, const float* src, float* h, bf16* hb, const bf16* yb, const float* g, const float* bta, int row0, int nrows) {
    const int lane = threadIdx.x & 63, wv = blockIdx.x * 4 + (threadIdx.x >> 6), nw = gridDim.x * 4;
    for (int rr = wv; rr < nrows; rr += nw) {
        const size_t row = (size_t)row0 + rr;
        f32x4 v[4];
#pragma unroll
        for (int j = 0; j < 4; ++j) {
            const int c = lane * 4 + 256 * j;
            v[j] = *(const f32x4*)((mode == 0 ? src : h) + row * D + c);
            if (mode == 2) {
                const uint2 a = *(const uint2*)(yb + (row * 2) * D + c), b = *(const uint2*)(yb + (row * 2 + 1) * D + c);
                v[j].x = ALPHA * v[j].x + bf2f((bf16)(a.x & 0xffff)) + bf2f((bf16)(b.x & 0xffff));
                v[j].y = ALPHA * v[j].y + bf2f((bf16)(a.x >> 16)) + bf2f((bf16)(b.x >> 16));
                v[j].z = ALPHA * v[j].z + bf2f((bf16)(a.y & 0xffff)) + bf2f((bf16)(b.y & 0xffff));
                v[j].w = ALPHA * v[j].w + bf2f((bf16)(a.y >> 16)) + bf2f((bf16)(b.y >> 16));
            }
        }
        float s = 0.f;
#pragma unroll
        for (int j = 0; j < 4; ++j) s += (v[j].x + v[j].y) + (v[j].z + v[j].w);
        const float mean = wave_sum(s) * (1.f / D);
        float q = 0.f;
#pragma unroll
        for (int j = 0; j < 4; ++j) { v[j] = v[j] - mean; q += (v[j].x * v[j].x + v[j].y * v[j].y) + (v[j].z * v[j].z + v[j].w * v[j].w); }
        const float rstd = 1.0f / sqrtf(wave_sum(q) * (1.f / D) + LN_EPS);
#pragma unroll
        for (int j = 0; j < 4; ++j) {
            const int c = lane * 4 + 256 * j;
            const f32x4 gg = *(const f32x4*)(g + c), bb = *(const f32x4*)(bta + c);
            const f32x4 o = v[j] * rstd * gg + bb;
            *(f32x4*)(h + row * D + c) = o;
            if (hb) { uint2 w; w.x = (unsigned)f2bf(o.x) | ((unsigned)f2bf(o.y) << 16); w.y = (unsigned)f2bf(o.z) | ((unsigned)f2bf(o.w) << 16); *(uint2*)(hb + row * D + c) = w; }
        }
    }
}

__device__ __forceinline__ void wave_gemm32(const bf16* arow, const float* wcol, int ldw, int K, f32x16& acc) {
    for (int k0 = 0; k0 < K; k0 += 16) {
        const bf16x8 a = *(const bf16x8*)(arow + k0);
        bf16x8 b;
#pragma unroll
        for (int j = 0; j < 8; ++j) b[j] = (short)f2bf(wcol[(size_t)(k0 + j) * ldw]);
        acc = __builtin_amdgcn_mfma_f32_32x32x16_bf16(a, b, acc, 0, 0, 0);
    }
}
#define ACC_ROW(reg, h) (((reg) & 3) + 8 * ((reg) >> 2) + 4 * (h))

__global__ __launch_bounds__(256) void k_p1(const bf16* hbc, const float* w_in, const float* b_gate, bf16* qkv, bf16* gates) {
    const int lane = threadIdx.x & 63, r = lane & 31, hh = lane >> 5;
    const int wv = blockIdx.x * 4 + (threadIdx.x >> 6), nw = gridDim.x * 4;
    const int ntn = NCOL / 32, total = (CH / 32) * ntn;
    for (int tile = wv; tile < total; tile += nw) {
        const int tm = tile / ntn, tn = tile % ntn;
        f32x16 acc; for (int i = 0; i < 16; ++i) acc[i] = 0.f;
        wave_gemm32(hbc + (size_t)(tm * 32 + r) * D + 8 * hh, w_in + (size_t)(8 * hh) * NCOL + tn * 32 + r, NCOL, D, acc);
        const int col = tn * 32 + r;
#pragma unroll
        for (int i = 0; i < 16; ++i) {
            const int row = tm * 32 + ACC_ROW(i, hh);
            if (col < QKVW) qkv[(size_t)row * QKVW + col] = f2bf(acc[i]);
            else { const float z = acc[i] + b_gate[col - QKVW]; gates[(size_t)row * GATEW + (col - QKVW)] = f2bf(1.0f / (1.0f + __expf(-z))); }
        }
    }
}

__global__ __launch_bounds__(256) void k_attn_naive(const bf16* qkv, bf16* oabc, bf16* og, float* lse, const float* rel_bias, const float* sink_l, const float* rpb_l, float sc) {
    const long idx = (long)blockIdx.x * 256 + threadIdx.x;
    if (idx >= (long)28 * CH) return;
    const int ht = (int)(idx / CH), tl = (int)(idx % CH), b = tl / L, t = tl % L;
    const bf16* base = qkv + (size_t)(b * L) * QKVW;
    int qcol, kcol, vcol;
    if (ht < 8) { qcol = AQ + ht * 64; kcol = AK + (ht >> 2) * 64; vcol = AV + (ht >> 2) * 64; }
    else if (ht < 20) { const int g = (ht - 8) >> 2, h = (ht - 8) & 3; qcol = BQ0 + 768 * g + h * 64; kcol = qcol + 256; vcol = qcol + 512; }
    else { const int h = ht - 20; qcol = CQ + h * 64; kcol = CK + h * 64; vcol = CV + h * 64; }
    float q[64], o[64];
    {
        const uint4* qp = (const uint4*)(base + (size_t)t * QKVW + qcol);
#pragma unroll
        for (int c = 0; c < 8; ++c) { const uint4 u = qp[c]; const unsigned w[4] = {u.x, u.y, u.z, u.w};
#pragma unroll
            for (int i = 0; i < 4; ++i) { q[8 * c + 2 * i] = bf2f((bf16)(w[i] & 0xffff)); q[8 * c + 2 * i + 1] = bf2f((bf16)(w[i] >> 16)); } }
    }
#pragma unroll
    for (int i = 0; i < 64; ++i) o[i] = 0.f;
    float m = -1e30f, l = 0.f;
    if (ht < 8) { m = sink_l[ht]; l = 1.f; }
#define PROC_KEY(KT, BIAS) do { \
        const uint4* kp = (const uint4*)(base + (size_t)(KT) * QKVW + kcol); float s = 0.f; \
        _Pragma("unroll") for (int c = 0; c < 8; ++c) { const uint4 u = kp[c]; const unsigned w[4] = {u.x, u.y, u.z, u.w}; \
            _Pragma("unroll") for (int i = 0; i < 4; ++i) { s += q[8 * c + 2 * i] * bf2f((bf16)(w[i] & 0xffff)); s += q[8 * c + 2 * i + 1] * bf2f((bf16)(w[i] >> 16)); } } \
        s = s * sc + (BIAS); const float mn = fmaxf(m, s), corr = __expf(m - mn), p = __expf(s - mn); l = l * corr + p; m = mn; \
        const uint4* vp = (const uint4*)(base + (size_t)(KT) * QKVW + vcol); \
        _Pragma("unroll") for (int c = 0; c < 8; ++c) { const uint4 u = vp[c]; const unsigned w[4] = {u.x, u.y, u.z, u.w}; \
            _Pragma("unroll") for (int i = 0; i < 4; ++i) { o[8 * c + 2 * i] = o[8 * c + 2 * i] * corr + p * bf2f((bf16)(w[i] & 0xffff)); o[8 * c + 2 * i + 1] = o[8 * c + 2 * i + 1] * corr + p * bf2f((bf16)(w[i] >> 16)); } } \
    } while (0)
    if (ht < 8) {
        for (int rel = -128; rel <= 128; ++rel) { const int kt = t + rel; if (kt < 0 || kt >= L) continue;
            const float bias = rel_bias[BUCK_A[rel + 128] * 20 + ht]; PROC_KEY(kt, bias); }
    } else if (ht < 20) {
        const int g = (ht - 8) >> 2, h = (ht - 8) & 3, dil = (g == 0) ? 1 : (g == 1 ? 4 : 16);
        for (int off = -64; off <= 64; ++off) { const int kt = t + off * dil; if (kt < 0 || kt >= L) continue;
            const float bias = rel_bias[BUCK_B[g][off + 64] * 20 + 8 + 4 * g + h]; PROC_KEY(kt, bias); }
    } else {
        const int h = ht - 20, gi = t >> 6, gc = t & 63;
        int rs = gi - 4; rs = rs < 0 ? 0 : (rs > 120 ? 120 : rs);
        int cs = gc - 8; cs = cs < 0 ? 0 : (cs > 48 ? 48 : cs);
        for (int kr = rs; kr < rs + 8; ++kr)
            for (int kc = cs; kc < cs + 16; ++kc) { const float bias = rpb_l[(h * 15 + (kr - gi + 7)) * 31 + (kc - gc + 15)]; const int kt = kr * 64 + kc; PROC_KEY(kt, bias); }
    }
#undef PROC_KEY
    const float inv = 1.0f / l;
    bf16* dst;
    if (ht < 8) dst = oabc + (size_t)tl * OW + ht * 64;
    else if (ht < 20) { const int g = (ht - 8) >> 2, h = (ht - 8) & 3; dst = og + ((size_t)tl * 3 + g) * 256 + h * 64; lse[((size_t)tl * 3 + g) * 4 + h] = m + __logf(l); }
    else dst = oabc + (size_t)tl * OW + 768 + (ht - 20) * 64;
#pragma unroll
    for (int c = 0; c < 8; ++c) { uint4 u;
        u.x = (unsigned)f2bf(o[8 * c + 0] * inv) | ((unsigned)f2bf(o[8 * c + 1] * inv) << 16); u.y = (unsigned)f2bf(o[8 * c + 2] * inv) | ((unsigned)f2bf(o[8 * c + 3] * inv) << 16);
        u.z = (unsigned)f2bf(o[8 * c + 4] * inv) | ((unsigned)f2bf(o[8 * c + 5] * inv) << 16); u.w = (unsigned)f2bf(o[8 * c + 6] * inv) | ((unsigned)f2bf(o[8 * c + 7] * inv) << 16);
        ((uint4*)dst)[c] = u; }
}

__global__ __launch_bounds__(256) void k_combine(const bf16* og, const float* lse, bf16* oabc) {
    const long idx = (long)blockIdx.x * 256 + threadIdx.x;
    if (idx >= (long)CH * 32) return;
    const int tl = (int)(idx >> 5), hc = (int)(idx & 31), h = hc >> 3, c = hc & 7;
    const float l0 = lse[((size_t)tl * 3 + 0) * 4 + h], l1 = lse[((size_t)tl * 3 + 1) * 4 + h], l2 = lse[((size_t)tl * 3 + 2) * 4 + h];
    const float mx = fmaxf(l0, fmaxf(l1, l2)); float w0 = __expf(l0 - mx), w1 = __expf(l1 - mx), w2 = __expf(l2 - mx); const float inv = 1.0f / (w0 + w1 + w2); w0 *= inv; w1 *= inv; w2 *= inv;
    const uint4 a = *(const uint4*)(og + ((size_t)tl * 3 + 0) * 256 + h * 64 + c * 8), b = *(const uint4*)(og + ((size_t)tl * 3 + 1) * 256 + h * 64 + c * 8), d = *(const uint4*)(og + ((size_t)tl * 3 + 2) * 256 + h * 64 + c * 8);
    const unsigned aw[4] = {a.x, a.y, a.z, a.w}, bw[4] = {b.x, b.y, b.z, b.w}, dw[4] = {d.x, d.y, d.z, d.w}; unsigned ow[4];
#pragma unroll
    for (int i = 0; i < 4; ++i) {
        const float lo = w0 * bf2f((bf16)(aw[i] & 0xffff)) + w1 * bf2f((bf16)(bw[i] & 0xffff)) + w2 * bf2f((bf16)(dw[i] & 0xffff));
        const float hi = w0 * bf2f((bf16)(aw[i] >> 16)) + w1 * bf2f((bf16)(bw[i] >> 16)) + w2 * bf2f((bf16)(dw[i] >> 16));
        ow[i] = (unsigned)f2bf(lo) | ((unsigned)f2bf(hi) << 16);
    }
    *(uint4*)(oabc + (size_t)tl * OW + 512 + h * 64 + c * 8) = make_uint4(ow[0], ow[1], ow[2], ow[3]);
}

__global__ __launch_bounds__(256) void k_p3(const bf16* oabc, const bf16* gates, const float* wa, const float* wb, const float* wc, bf16* merged) {
    const int lane = threadIdx.x & 63, r = lane & 31, hh = lane >> 5;
    const int wv = blockIdx.x * 4 + (threadIdx.x >> 6), nw = gridDim.x * 4;
    const int ntn = D / 32, total = (CH / 32) * ntn;
    for (int tile = wv; tile < total; tile += nw) {
        const int tm = tile / ntn, tn = tile % ntn, col = tn * 32 + r;
        f32x16 mg; for (int i = 0; i < 16; ++i) mg[i] = 0.f;
#pragma unroll 1
        for (int br = 0; br < 3; ++br) {
            f32x16 acc; for (int i = 0; i < 16; ++i) acc[i] = 0.f;
            const int koff = br == 0 ? 0 : (br == 1 ? 512 : 768), K = br == 1 ? 256 : 512;
            const float* w = br == 0 ? wa : (br == 1 ? wb : wc);
            wave_gemm32(oabc + (size_t)(tm * 32 + r) * OW + koff + 8 * hh, w + (size_t)(8 * hh) * D + col, D, K, acc);
#pragma unroll
            for (int i = 0; i < 16; ++i) { const int row = tm * 32 + ACC_ROW(i, hh); mg[i] += bf2f(gates[(size_t)row * GATEW + br * 1024 + col]) * acc[i]; }
        }
#pragma unroll
        for (int i = 0; i < 16; ++i) { const int row = tm * 32 + ACC_ROW(i, hh); merged[(size_t)row * D + col] = f2bf(mg[i]); }
    }
}
__global__ __launch_bounds__(256) void k_p4(const bf16* merged, const float* wo, float* hchunk) {
    const int lane = threadIdx.x & 63, r = lane & 31, hh = lane >> 5;
    const int wv = blockIdx.x * 4 + (threadIdx.x >> 6), nw = gridDim.x * 4;
    const int ntn = D / 32, total = (CH / 32) * ntn;
    for (int tile = wv; tile < total; tile += nw) {
        const int tm = tile / ntn, tn = tile % ntn, col = tn * 32 + r;
        f32x16 acc; for (int i = 0; i < 16; ++i) acc[i] = 0.f;
        wave_gemm32(merged + (size_t)(tm * 32 + r) * D + 8 * hh, wo + (size_t)(8 * hh) * D + col, D, D, acc);
#pragma unroll
        for (int i = 0; i < 16; ++i) { const int row = tm * 32 + ACC_ROW(i, hh); float* p = hchunk + (size_t)row * D + col; *p = ALPHA * *p + acc[i]; }
    }
}

struct Rec { int e0, s0, e1, s1; float g0, g1; int pad0, pad1; };
__global__ __launch_bounds__(256) void k_router(const float* h, const float* w_rg, const float* b_rg, const float* w_re, const float* b_re, int* cnt, Rec* rec) {
    const int lane = threadIdx.x & 63, wv = blockIdx.x * 4 + (threadIdx.x >> 6), nw = gridDim.x * 4;
    for (int t = wv; t < T; t += nw) {
        float x[16];
#pragma unroll
        for (int j = 0; j < 4; ++j) { const f32x4 v = *(const f32x4*)(h + (size_t)t * D + lane * 4 + 256 * j); x[4 * j] = v.x; x[4 * j + 1] = v.y; x[4 * j + 2] = v.z; x[4 * j + 3] = v.w; }
        float gl[4] = {0.f, 0.f, 0.f, 0.f};
#pragma unroll
        for (int j = 0; j < 4; ++j)
#pragma unroll
            for (int i = 0; i < 4; ++i) { const f32x4 w = *(const f32x4*)(w_rg + (size_t)(lane * 4 + 256 * j + i) * 4); const float xv = x[4 * j + i]; gl[0] += xv * w.x; gl[1] += xv * w.y; gl[2] += xv * w.z; gl[3] += xv * w.w; }
#pragma unroll
        for (int g = 0; g < 4; ++g) gl[g] = wave_sum(gl[g]) + b_rg[g];
        int gi = 0; float gm = gl[0];
#pragma unroll
        for (int g = 1; g < 4; ++g) if (gl[g] > gm) { gm = gl[g]; gi = g; }
        float gs = 0.f;
#pragma unroll
        for (int g = 0; g < 4; ++g) gs += __expf(gl[g] - gm);
        const float gw = 1.0f / gs;
        float el[8];
#pragma unroll
        for (int e = 0; e < 8; ++e) el[e] = 0.f;
        const float* wre = w_re + (size_t)gi * D * 8;
#pragma unroll
        for (int j = 0; j < 4; ++j)
#pragma unroll
            for (int i = 0; i < 4; ++i) { const float* wp = wre + (size_t)(lane * 4 + 256 * j + i) * 8; const f32x4 w0 = *(const f32x4*)wp, w1 = *(const f32x4*)(wp + 4); const float xv = x[4 * j + i];
                el[0] += xv * w0.x; el[1] += xv * w0.y; el[2] += xv * w0.z; el[3] += xv * w0.w; el[4] += xv * w1.x; el[5] += xv * w1.y; el[6] += xv * w1.z; el[7] += xv * w1.w; }
#pragma unroll
        for (int e = 0; e < 8; ++e) el[e] = wave_sum(el[e]) + b_re[gi * 8 + e];
        int i0 = 0; float t0 = el[0];
#pragma unroll
        for (int e = 1; e < 8; ++e) if (el[e] > t0) { t0 = el[e]; i0 = e; }
        int i1 = -1; float t1 = -3.0e38f;
#pragma unroll
        for (int e = 0; e < 8; ++e) if (e != i0 && el[e] > t1) { t1 = el[e]; i1 = e; }
        const float ex = __expf(t1 - t0), p0 = 1.0f / (1.0f + ex), p1 = ex / (1.0f + ex);
        if (lane == 0) {
            Rec rc; rc.e0 = gi * 8 + i0; rc.e1 = gi * 8 + i1; rc.g0 = gw * p0; rc.g1 = gw * p1; rc.pad0 = 0; rc.pad1 = 0;
            rc.s0 = atomicAdd(cnt + rc.e0, 1); rc.s1 = atomicAdd(cnt + rc.e1, 1);
            rec[t] = rc;
        }
    }
}
__device__ __forceinline__ void pad_offsets(const int* cnt, int* po) { int acc = 0; for (int e = 0; e < NE; ++e) { po[e] = acc; acc += (cnt[e] + 255) / 256 * 256; } po[NE] = acc; }
__global__ __launch_bounds__(256) void k_dispatch(const int* cnt, const Rec* rec, int* rowtok, float* rowgate) {
    __shared__ int po[NE + 1];
    if (threadIdx.x == 0) pad_offsets(cnt, po);
    __syncthreads();
    for (int t = blockIdx.x * 256 + threadIdx.x; t < T; t += gridDim.x * 256) {
        const Rec rc = rec[t];
        const int d0 = po[rc.e0] + rc.s0, d1 = po[rc.e1] + rc.s1;
        rowtok[d0] = 2 * t; rowgate[d0] = rc.g0; rowtok[d1] = 2 * t + 1; rowgate[d1] = rc.g1;
    }
}
__global__ __launch_bounds__(256) void k_p7(const bf16* hb, const int* cnt, const int* rowtok, const float* w_eg, const float* w_eu, bf16* hid) {
    __shared__ int po[NE + 1];
    if (threadIdx.x == 0) pad_offsets(cnt, po);
    __syncthreads();
    const int lane = threadIdx.x & 63, r = lane & 31, hh = lane >> 5;
    const int wv = blockIdx.x * 4 + (threadIdx.x >> 6), nw = gridDim.x * 4;
    const int ntn = DE / 32, total = (po[NE] / 32) * ntn;
    for (int tile = wv; tile < total; tile += nw) {
        const int tm = tile / ntn, tn = tile % ntn, col = tn * 32 + r, row0 = tm * 32;
        int e = 0; while (e < NE - 1 && po[e + 1] <= row0) ++e;
        int tok = rowtok[row0 + r]; tok = tok < 0 ? 0 : (tok >> 1);
        f32x16 ag, au; for (int i = 0; i < 16; ++i) { ag[i] = 0.f; au[i] = 0.f; }
        wave_gemm32(hb + (size_t)tok * D + 8 * hh, w_eg + (size_t)e * D * DE + (size_t)(8 * hh) * DE + col, DE, D, ag);
        wave_gemm32(hb + (size_t)tok * D + 8 * hh, w_eu + (size_t)e * D * DE + (size_t)(8 * hh) * DE + col, DE, D, au);
#pragma unroll
        for (int i = 0; i < 16; ++i) { const int row = row0 + ACC_ROW(i, hh); const float gsl = ag[i] / (1.0f + __expf(-ag[i])); hid[(size_t)row * DE + col] = f2bf(gsl * au[i]); }
    }
}
__global__ __launch_bounds__(256) void k_p8(const bf16* hid, const int* cnt, const int* rowtok, const float* rowgate, const float* w_ed, bf16* yb) {
    __shared__ int po[NE + 1];
    if (threadIdx.x == 0) pad_offsets(cnt, po);
    __syncthreads();
    const int lane = threadIdx.x & 63, r = lane & 31, hh = lane >> 5;
    const int wv = blockIdx.x * 4 + (threadIdx.x >> 6), nw = gridDim.x * 4;
    const int ntn = D / 32, total = (po[NE] / 32) * ntn;
    for (int tile = wv; tile < total; tile += nw) {
        const int tm = tile / ntn, tn = tile % ntn, col = tn * 32 + r, row0 = tm * 32;
        int e = 0; while (e < NE - 1 && po[e + 1] <= row0) ++e;
        f32x16 acc; for (int i = 0; i < 16; ++i) acc[i] = 0.f;
        wave_gemm32(hid + (size_t)(row0 + r) * DE + 8 * hh, w_ed + (size_t)e * DE * D + (size_t)(8 * hh) * D + col, D, DE, acc);
#pragma unroll
        for (int i = 0; i < 16; ++i) { const int row = row0 + ACC_ROW(i, hh); const int rt = rowtok[row]; if (rt >= 0) yb[(size_t)rt * D + col] = f2bf(acc[i] * rowgate[row]); }
    }
}

extern "C" void kernel_launch(void* const* d_in, const int* in_sizes, int n_in, void* d_out, int out_size, void* d_ws, size_t ws_size, hipStream_t stream) {
    if (n_in != 23 || out_size != T * D || ws_size < WS_END) { fprintf(stderr, "kernel_launch: unexpected shapes (n_in %d out %d ws %zu)\n", n_in, out_size, ws_size); return; }
    const float* x = (const float*)d_in[0]; const float* ln0_g = (const float*)d_in[1]; const float* ln0_b = (const float*)d_in[2]; const float* rel_bias = (const float*)d_in[3];
    const float* w_in = (const float*)d_in[4]; const float* b_gate = (const float*)d_in[5]; const float* sink_a = (const float*)d_in[6]; const float* rpb_c = (const float*)d_in[7];
    const float* w_br_a = (const float*)d_in[8]; const float* w_br_b = (const float*)d_in[9]; const float* w_br_c = (const float*)d_in[10]; const float* w_out = (const float*)d_in[11];
    const float* ln1_g = (const float*)d_in[12]; const float* ln1_b = (const float*)d_in[13]; const float* w_rg = (const float*)d_in[14]; const float* b_rg = (const float*)d_in[15];
    const float* w_re = (const float*)d_in[16]; const float* b_re = (const float*)d_in[17]; const float* w_eg = (const float*)d_in[18]; const float* w_eu = (const float*)d_in[19];
    const float* w_ed = (const float*)d_in[20]; const float* ln2_g = (const float*)d_in[21]; const float* ln2_b = (const float*)d_in[22];
    unsigned char* ws = (unsigned char*)d_ws; float* h = (float*)d_out;
    bf16* hb = (bf16*)(ws + WS_HB); bf16* qkv = (bf16*)(ws + WS_QKV); bf16* gates = (bf16*)(ws + WS_GATES); bf16* oabc = (bf16*)(ws + WS_OABC); bf16* og = (bf16*)(ws + WS_OG);
    float* lse = (float*)(ws + WS_LSE); Rec* rec = (Rec*)(ws + WS_REC); int* rowtok = (int*)(ws + WS_ROWTOK); float* rowgate = (float*)(ws + WS_ROWGATE);
    bf16* merged = (bf16*)(ws + WS_MERGED); bf16* hid = (bf16*)(ws + WS_HID); bf16* yb = (bf16*)(ws + WS_YB); int* cnt = (int*)(ws + WS_CTL);
    (void)hipMemsetAsync(ws + WS_CTL, 0, 4096, stream);
    const int G = 2048;
    k_ln<<<G, 256, 0, stream>>>(0, x, h, hb, nullptr, ln0_g, ln0_b, 0, T);
    for (int l = 0; l < DEPTH; ++l) {
        for (int c = 0; c < NCHUNK; ++c) {
            const size_t r0 = (size_t)c * CH;
            k_p1<<<G, 256, 0, stream>>>(hb + r0 * D, w_in + (size_t)l * D * NCOL, b_gate + (size_t)l * GATEW, qkv, gates);
            k_attn_naive<<<(28 * CH + 255) / 256, 256, 0, stream>>>(qkv, oabc, og, lse, rel_bias, sink_a + l * 8, rpb_c + (size_t)l * 8 * 15 * 31, 0.125f);
            k_combine<<<(CH * 32 + 255) / 256, 256, 0, stream>>>(og, lse, oabc);
            k_p3<<<G, 256, 0, stream>>>(oabc, gates, w_br_a + (size_t)l * 512 * D, w_br_b + (size_t)l * 256 * D, w_br_c + (size_t)l * 512 * D, merged);
            k_p4<<<G, 256, 0, stream>>>(merged, w_out + (size_t)l * D * D, h + r0 * D);
            k_ln<<<G, 256, 0, stream>>>(1, nullptr, h, hb, nullptr, ln1_g + l * D, ln1_b + l * D, (int)r0, CH);
        }
        k_router<<<G, 256, 0, stream>>>(h, w_rg + (size_t)l * D * 4, b_rg + l * 4, w_re + (size_t)l * 4 * D * 8, b_re + l * 32, cnt + l * 32, rec);
        (void)hipMemsetAsync(rowtok, 0xFF, (size_t)PROWS * 4, stream);
        k_dispatch<<<256, 256, 0, stream>>>(cnt + l * 32, rec, rowtok, rowgate);
        k_p7<<<G, 256, 0, stream>>>(hb, cnt + l * 32, rowtok, w_eg + (size_t)l * NE * D * DE, w_eu + (size_t)l * NE * D * DE, hid);
        k_p8<<<G, 256, 0, stream>>>(hid, cnt + l * 32, rowtok, rowgate, w_ed + (size_t)l * NE * DE * D, yb);
        k_ln<<<G, 256, 0, stream>>>(2, nullptr, h, (l == DEPTH - 1) ? nullptr : hb, yb, ln2_g + l * D, ln2_b + l * D, 0, T);
    }
}
```

```cpp
#include <hip/hip_runtime.h>
#include <cstdio>
#include <cstdint>
#include <cmath>

typedef unsigned short bf16;
typedef short bf16x8 __attribute__((ext_vector_type(8)));
typedef float f32x16 __attribute__((ext_vector_type(16)));
typedef float f32x4 __attribute__((ext_vector_type(4)));

constexpr int D = 1024, L = 8192, NBATCH = 8, T = NBATCH * L, DEPTH = 2;
constexpr int NCOL = 7680, QKVW = 4608, GATEW = 3072;
constexpr int CH = 32768, NCHUNK = T / CH;
constexpr int OW = 1280;
constexpr int NE = 32, DE = 512;
constexpr int MAXRT = T * 2 / 256 + NE, PROWS = MAXRT * 256;
constexpr float LN_EPS = 1e-5f;
constexpr float ALPHA = 1.41421356237309515f;
constexpr int AQ = 0, AK = 512, AV = 640, BQ0 = 768, CQ = 3072, CK = 3584, CV = 4096;

constexpr size_t MiB = 1u << 20;
constexpr size_t WS_CTL = 0;
constexpr size_t WS_WIN = 1 * MiB, WS_WBRA = 31 * MiB, WS_WBRB = 33 * MiB, WS_WBRC = 34 * MiB, WS_WOUT = 36 * MiB, WS_WGU = 40 * MiB, WS_WD = 168 * MiB;
constexpr size_t WS_HB = 232 * MiB, WS_QKV = 360 * MiB, WS_GATES = 648 * MiB, WS_OABC = 840 * MiB, WS_OG = 920 * MiB, WS_LSE = 968 * MiB,
                 WS_REC = 970 * MiB, WS_ROWTOK = 972 * MiB, WS_ROWGATE = 973 * MiB, WS_END = 974 * MiB;
constexpr size_t WS_MERGED = WS_QKV, WS_HID = WS_QKV, WS_YB = WS_QKV + 136 * MiB;

__device__ __constant__ signed char BUCK_A[257] = {12,11,11,11,11,11,11,11,11,11,11,11,11,11,11,11,11,11,11,11,11,11,11,11,11,11,11,11,11,11,11,11,11,11,11,11,11,11,11,11,11,11,11,11,11,11,11,11,11,11,11,11,11,11,11,11,11,11,11,11,11,11,11,11,11,10,10,10,10,10,10,10,10,10,10,10,10,10,10,10,10,10,10,10,10,10,10,10,10,10,10,10,10,10,10,10,10,9,9,9,9,9,9,9,9,9,9,9,9,9,9,9,9,8,8,8,8,8,8,8,8,7,6,5,4,3,2,1,0,17,18,19,20,21,22,23,24,24,24,24,24,24,24,24,25,25,25,25,25,25,25,25,25,25,25,25,25,25,25,25,26,26,26,26,26,26,26,26,26,26,26,26,26,26,26,26,26,26,26,26,26,26,26,26,26,26,26,26,26,26,26,26,27,27,27,27,27,27,27,27,27,27,27,27,27,27,27,27,27,27,27,27,27,27,27,27,27,27,27,27,27,27,27,27,27,27,27,27,27,27,27,27,27,27,27,27,27,27,27,27,27,27,27,27,27,27,27,27,27,27,27,27,27,27,27,27,28};
__device__ __constant__ signed char BUCK_B[3][129] = {
 {11,10,10,10,10,10,10,10,10,10,10,10,10,10,10,10,10,10,10,10,10,10,10,10,10,10,10,10,10,10,10,10,10,9,9,9,9,9,9,9,9,9,9,9,9,9,9,9,9,8,8,8,8,8,8,8,8,7,6,5,4,3,2,1,0,17,18,19,20,21,22,23,24,24,24,24,24,24,24,24,25,25,25,25,25,25,25,25,25,25,25,25,25,25,25,25,26,26,26,26,26,26,26,26,26,26,26,26,26,26,26,26,26,26,26,26,26,26,26,26,26,26,26,26,26,26,26,26,27},
 {13,12,12,12,12,12,12,12,12,12,12,12,12,12,12,12,12,12,12,12,12,12,12,12,12,12,12,12,12,12,12,12,12,11,11,11,11,11,11,11,11,11,11,11,11,11,11,11,11,10,10,10,10,10,10,10,10,9,9,9,9,8,8,4,0,20,24,24,25,25,25,25,26,26,26,26,26,26,26,26,27,27,27,27,27,27,27,27,27,27,27,27,27,27,27,27,28,28,28,28,28,28,28,28,28,28,28,28,28,28,28,28,28,28,28,28,28,28,28,28,28,28,28,28,28,28,28,28,29},
 {15,14,14,14,14,14,14,14,14,14,14,14,14,14,14,14,14,14,14,14,14,14,14,14,14,14,14,14,14,14,14,14,14,13,13,13,13,13,13,13,13,13,13,13,13,13,13,13,13,12,12,12,12,12,12,12,12,11,11,11,11,10,10,9,0,25,26,26,27,27,27,27,28,28,28,28,28,28,28,28,29,29,29,29,29,29,29,29,29,29,29,29,29,29,29,29,30,30,30,30,30,30,30,30,30,30,30,30,30,30,30,30,30,30,30,30,30,30,30,30,30,30,30,30,30,30,30,30,31}};

__device__ __forceinline__ float bf2f(bf16 b) { return __uint_as_float(((unsigned)b) << 16); }
__device__ __forceinline__ bf16 f2bf(float f) { unsigned u = __float_as_uint(f); u += 0x7fffu + ((u >> 16) & 1u); return (bf16)(u >> 16); }
__device__ __forceinline__ float wave_sum(float v) {
#pragma unroll
    for (int o = 1; o < 64; o <<= 1) v += __shfl_xor(v, o);
    return v;
}

__global__ __launch_bounds__(256) void k_ln(int mode, const float* src, float* h, bf16* hb, const bf16* yb, const float* g, const float* bta, int row0, int nrows) {
    const int lane = threadIdx.x & 63, wv = blockIdx.x * 4 + (threadIdx.x >> 6), nw = gridDim.x * 4;
    for (int rr = wv; rr < nrows; rr += nw) {
        const size_t row = (size_t)row0 + rr;
        f32x4 v[4];
#pragma unroll
        for (int j = 0; j < 4; ++j) {
            const int c = lane * 4 + 256 * j;
            v[j] = *(const f32x4*)((mode == 0 ? src : h) + row * D + c);
            if (mode == 2) {
                const uint2 a = *(const uint2*)(yb + (row * 2) * D + c), b = *(const uint2*)(yb + (row * 2 + 1) * D + c);
                v[j].x = ALPHA * v[j].x + bf2f((bf16)(a.x & 0xffff)) + bf2f((bf16)(b.x & 0xffff));
                v[j].y = ALPHA * v[j].y + bf2f((bf16)(a.x >> 16)) + bf2f((bf16)(b.x >> 16));
                v[j].z = ALPHA * v[j].z + bf2f((bf16)(a.y & 0xffff)) + bf2f((bf16)(b.y & 0xffff));
                v[j].w = ALPHA * v[j].w + bf2f((bf16)(a.y >> 16)) + bf2f((bf16)(b.y >> 16));
            }
        }
        float s = 0.f;
#pragma unroll
        for (int j = 0; j < 4; ++j) s += (v[j].x + v[j].y) + (v[j].z + v[j].w);
        const float mean = wave_sum(s) * (1.f / D);
        float q = 0.f;
#pragma unroll
        for (int j = 0; j < 4; ++j) { v[j] = v[j] - mean; q += (v[j].x * v[j].x + v[j].y * v[j].y) + (v[j].z * v[j].z + v[j].w * v[j].w); }
        const float rstd = 1.0f / sqrtf(wave_sum(q) * (1.f / D) + LN_EPS);
#pragma unroll
        for (int j = 0; j < 4; ++j) {
            const int c = lane * 4 + 256 * j;
            const f32x4 gg = *(const f32x4*)(g + c), bb = *(const f32x4*)(bta + c);
            const f32x4 o = v[j] * rstd * gg + bb;
            *(f32x4*)(h + row * D + c) = o;
            if (hb) { uint2 w; w.x = (unsigned)f2bf(o.x) | ((unsigned)f2bf(o.y) << 16); w.y = (unsigned)f2bf(o.z) | ((unsigned)f2bf(o.w) << 16); *(uint2*)(hb + row * D + c) = w; }
        }
    }
}

__device__ __forceinline__ void wave_gemm32(const bf16* arow, const float* wcol, int ldw, int K, f32x16& acc) {
    for (int k0 = 0; k0 < K; k0 += 16) {
        const bf16x8 a = *(const bf16x8*)(arow + k0);
        bf16x8 b;
#pragma unroll
        for (int j = 0; j < 8; ++j) b[j] = (short)f2bf(wcol[(size_t)(k0 + j) * ldw]);
        acc = __builtin_amdgcn_mfma_f32_32x32x16_bf16(a, b, acc, 0, 0, 0);
    }
}
#define ACC_ROW(reg, h) (((reg) & 3) + 8 * ((reg) >> 2) + 4 * (h))

__global__ __launch_bounds__(256) void k_p1(const bf16* hbc, const float* w_in, const float* b_gate, bf16* qkv, bf16* gates) {
    const int lane = threadIdx.x & 63, r = lane & 31, hh = lane >> 5;
    const int wv = blockIdx.x * 4 + (threadIdx.x >> 6), nw = gridDim.x * 4;
    const int ntn = NCOL / 32, total = (CH / 32) * ntn;
    for (int tile = wv; tile < total; tile += nw) {
        const int tm = tile / ntn, tn = tile % ntn;
        f32x16 acc; for (int i = 0; i < 16; ++i) acc[i] = 0.f;
        wave_gemm32(hbc + (size_t)(tm * 32 + r) * D + 8 * hh, w_in + (size_t)(8 * hh) * NCOL + tn * 32 + r, NCOL, D, acc);
        const int col = tn * 32 + r;
#pragma unroll
        for (int i = 0; i < 16; ++i) {
            const int row = tm * 32 + ACC_ROW(i, hh);
            if (col < QKVW) qkv[(size_t)row * QKVW + col] = f2bf(acc[i]);
            else { const float z = acc[i] + b_gate[col - QKVW]; gates[(size_t)row * GATEW + (col - QKVW)] = f2bf(1.0f / (1.0f + __expf(-z))); }
        }
    }
}

__global__ __launch_bounds__(256) void k_attn_naive(const bf16* qkv, bf16* oabc, bf16* og, float* lse, const float* rel_bias, const float* sink_l, const float* rpb_l, float sc) {
    const long idx = (long)blockIdx.x * 256 + threadIdx.x;
    if (idx >= (long)28 * CH) return;
    const int ht = (int)(idx / CH), tl = (int)(idx % CH), b = tl / L, t = tl % L;
    const bf16* base = qkv + (size_t)(b * L) * QKVW;
    int qcol, kcol, vcol;
    if (ht < 8) { qcol = AQ + ht * 64; kcol = AK + (ht >> 2) * 64; vcol = AV + (ht >> 2) * 64; }
    else if (ht < 20) { const int g = (ht - 8) >> 2, h = (ht - 8) & 3; qcol = BQ0 + 768 * g + h * 64; kcol = qcol + 256; vcol = qcol + 512; }
    else { const int h = ht - 20; qcol = CQ + h * 64; kcol = CK + h * 64; vcol = CV + h * 64; }
    float q[64], o[64];
    {
        const uint4* qp = (const uint4*)(base + (size_t)t * QKVW + qcol);
#pragma unroll
        for (int c = 0; c < 8; ++c) { const uint4 u = qp[c]; const unsigned w[4] = {u.x, u.y, u.z, u.w};
#pragma unroll
            for (int i = 0; i < 4; ++i) { q[8 * c + 2 * i] = bf2f((bf16)(w[i] & 0xffff)); q[8 * c + 2 * i + 1] = bf2f((bf16)(w[i] >> 16)); } }
    }
#pragma unroll
    for (int i = 0; i < 64; ++i) o[i] = 0.f;
    float m = -1e30f, l = 0.f;
    if (ht < 8) { m = sink_l[ht]; l = 1.f; }
#define PROC_KEY(KT, BIAS) do { \
        const uint4* kp = (const uint4*)(base + (size_t)(KT) * QKVW + kcol); float s = 0.f; \
        _Pragma("unroll") for (int c = 0; c < 8; ++c) { const uint4 u = kp[c]; const unsigned w[4] = {u.x, u.y, u.z, u.w}; \
            _Pragma("unroll") for (int i = 0; i < 4; ++i) { s += q[8 * c + 2 * i] * bf2f((bf16)(w[i] & 0xffff)); s += q[8 * c + 2 * i + 1] * bf2f((bf16)(w[i] >> 16)); } } \
        s = s * sc + (BIAS); const float mn = fmaxf(m, s), corr = __expf(m - mn), p = __expf(s - mn); l = l * corr + p; m = mn; \
        const uint4* vp = (const uint4*)(base + (size_t)(KT) * QKVW + vcol); \
        _Pragma("unroll") for (int c = 0; c < 8; ++c) { const uint4 u = vp[c]; const unsigned w[4] = {u.x, u.y, u.z, u.w}; \
            _Pragma("unroll") for (int i = 0; i < 4; ++i) { o[8 * c + 2 * i] = o[8 * c + 2 * i] * corr + p * bf2f((bf16)(w[i] & 0xffff)); o[8 * c + 2 * i + 1] = o[8 * c + 2 * i + 1] * corr + p * bf2f((bf16)(w[i] >> 16)); } } \
    } while (0)
    if (ht < 8) {
        for (int rel = -128; rel <= 128; ++rel) { const int kt = t + rel; if (kt < 0 || kt >= L) continue;
            const float bias = rel_bias[BUCK_A[rel + 128] * 20 + ht]; PROC_KEY(kt, bias); }
    } else if (ht < 20) {
        const int g = (ht - 8) >> 2, h = (ht - 8) & 3, dil = (g == 0) ? 1 : (g == 1 ? 4 : 16);
        for (int off = -64; off <= 64; ++off) { const int kt = t + off * dil; if (kt < 0 || kt >= L) continue;
            const float bias = rel_bias[BUCK_B[g][off + 64] * 20 + 8 + 4 * g + h]; PROC_KEY(kt, bias); }
    } else {
        const int h = ht - 20, gi = t >> 6, gc = t & 63;
        int rs = gi - 4; rs = rs < 0 ? 0 : (rs > 120 ? 120 : rs);
        int cs = gc - 8; cs = cs < 0 ? 0 : (cs > 48 ? 48 : cs);
        for (int kr = rs; kr < rs + 8; ++kr)
            for (int kc = cs; kc < cs + 16; ++kc) { const float bias = rpb_l[(h * 15 + (kr - gi + 7)) * 31 + (kc - gc + 15)]; const int kt = kr * 64 + kc; PROC_KEY(kt, bias); }
    }
#undef PROC_KEY
    const float inv = 1.0f / l;
    bf16* dst;
    if (ht < 8) dst = oabc + (size_t)tl * OW + ht * 64;
    else if (ht < 20) { const int g = (ht - 8) >> 2, h = (ht - 8) & 3; dst = og + ((size_t)tl * 3 + g) * 256 + h * 64; lse[((size_t)tl * 3 + g) * 4 + h] = m + __logf(l); }
    else dst = oabc + (size_t)tl * OW + 768 + (ht - 20) * 64;
#pragma unroll
    for (int c = 0; c < 8; ++c) { uint4 u;
        u.x = (unsigned)f2bf(o[8 * c + 0] * inv) | ((unsigned)f2bf(o[8 * c + 1] * inv) << 16); u.y = (unsigned)f2bf(o[8 * c + 2] * inv) | ((unsigned)f2bf(o[8 * c + 3] * inv) << 16);
        u.z = (unsigned)f2bf(o[8 * c + 4] * inv) | ((unsigned)f2bf(o[8 * c + 5] * inv) << 16); u.w = (unsigned)f2bf(o[8 * c + 6] * inv) | ((unsigned)f2bf(o[8 * c + 7] * inv) << 16);
        ((uint4*)dst)[c] = u; }
}

__global__ __launch_bounds__(256) void k_combine(const bf16* og, const float* lse, bf16* oabc) {
    const long idx = (long)blockIdx.x * 256 + threadIdx.x;
    if (idx >= (long)CH * 32) return;
    const int tl = (int)(idx >> 5), hc = (int)(idx & 31), h = hc >> 3, c = hc & 7;
    const float l0 = lse[((size_t)tl * 3 + 0) * 4 + h], l1 = lse[((size_t)tl * 3 + 1) * 4 + h], l2 = lse[((size_t)tl * 3 + 2) * 4 + h];
    const float mx = fmaxf(l0, fmaxf(l1, l2)); float w0 = __expf(l0 - mx), w1 = __expf(l1 - mx), w2 = __expf(l2 - mx); const float inv = 1.0f / (w0 + w1 + w2); w0 *= inv; w1 *= inv; w2 *= inv;
    const uint4 a = *(const uint4*)(og + ((size_t)tl * 3 + 0) * 256 + h * 64 + c * 8), b = *(const uint4*)(og + ((size_t)tl * 3 + 1) * 256 + h * 64 + c * 8), d = *(const uint4*)(og + ((size_t)tl * 3 + 2) * 256 + h * 64 + c * 8);
    const unsigned aw[4] = {a.x, a.y, a.z, a.w}, bw[4] = {b.x, b.y, b.z, b.w}, dw[4] = {d.x, d.y, d.z, d.w}; unsigned ow[4];
#pragma unroll
    for (int i = 0; i < 4; ++i) {
        const float lo = w0 * bf2f((bf16)(aw[i] & 0xffff)) + w1 * bf2f((bf16)(bw[i] & 0xffff)) + w2 * bf2f((bf16)(dw[i] & 0xffff));
        const float hi = w0 * bf2f((bf16)(aw[i] >> 16)) + w1 * bf2f((bf16)(bw[i] >> 16)) + w2 * bf2f((bf16)(dw[i] >> 16));
        ow[i] = (unsigned)f2bf(lo) | ((unsigned)f2bf(hi) << 16);
    }
    *(uint4*)(oabc + (size_t)tl * OW + 512 + h * 64 + c * 8) = make_uint4(ow[0], ow[1], ow[2], ow[3]);
}

__global__ __launch_bounds__(256) void k_p3(const bf16* oabc, const bf16* gates, const float* wa, const float* wb, const float* wc, bf16* merged) {
    const int lane = threadIdx.x & 63, r = lane & 31, hh = lane >> 5;
    const int wv = blockIdx.x * 4 + (threadIdx.x >> 6), nw = gridDim.x * 4;
    const int ntn = D / 32, total = (CH / 32) * ntn;
    for (int tile = wv; tile < total; tile += nw) {
        const int tm = tile / ntn, tn = tile % ntn, col = tn * 32 + r;
        f32x16 mg; for (int i = 0; i < 16; ++i) mg[i] = 0.f;
#pragma unroll 1
        for (int br = 0; br < 3; ++br) {
            f32x16 acc; for (int i = 0; i < 16; ++i) acc[i] = 0.f;
            const int koff = br == 0 ? 0 : (br == 1 ? 512 : 768), K = br == 1 ? 256 : 512;
            const float* w = br == 0 ? wa : (br == 1 ? wb : wc);
            wave_gemm32(oabc + (size_t)(tm * 32 + r) * OW + koff + 8 * hh, w + (size_t)(8 * hh) * D + col, D, K, acc);
#pragma unroll
            for (int i = 0; i < 16; ++i) { const int row = tm * 32 + ACC_ROW(i, hh); mg[i] += bf2f(gates[(size_t)row * GATEW + br * 1024 + col]) * acc[i]; }
        }
#pragma unroll
        for (int i = 0; i < 16; ++i) { const int row = tm * 32 + ACC_ROW(i, hh); merged[(size_t)row * D + col] = f2bf(mg[i]); }
    }
}
__global__ __launch_bounds__(256) void k_p4(const bf16* merged, const float* wo, float* hchunk) {
    const int lane = threadIdx.x & 63, r = lane & 31, hh = lane >> 5;
    const int wv = blockIdx.x * 4 + (threadIdx.x >> 6), nw = gridDim.x * 4;
    const int ntn = D / 32, total = (CH / 32) * ntn;
    for (int tile = wv; tile < total; tile += nw) {
        const int tm = tile / ntn, tn = tile % ntn, col = tn * 32 + r;
        f32x16 acc; for (int i = 0; i < 16; ++i) acc[i] = 0.f;
        wave_gemm32(merged + (size_t)(tm * 32 + r) * D + 8 * hh, wo + (size_t)(8 * hh) * D + col, D, D, acc);
#pragma unroll
        for (int i = 0; i < 16; ++i) { const int row = tm * 32 + ACC_ROW(i, hh); float* p = hchunk + (size_t)row * D + col; *p = ALPHA * *p + acc[i]; }
    }
}

struct Rec { int e0, s0, e1, s1; float g0, g1; int pad0, pad1; };
__global__ __launch_bounds__(256) void k_router(const float* h, const float* w_rg, const float* b_rg, const float* w_re, const float* b_re, int* cnt, Rec* rec) {
    const int lane = threadIdx.x & 63, wv = blockIdx.x * 4 + (threadIdx.x >> 6), nw = gridDim.x * 4;
    for (int t = wv; t < T; t += nw) {
        float x[16];
#pragma unroll
        for (int j = 0; j < 4; ++j) { const f32x4 v = *(const f32x4*)(h + (size_t)t * D + lane * 4 + 256 * j); x[4 * j] = v.x; x[4 * j + 1] = v.y; x[4 * j + 2] = v.z; x[4 * j + 3] = v.w; }
        float gl[4] = {0.f, 0.f, 0.f, 0.f};
#pragma unroll
        for (int j = 0; j < 4; ++j)
#pragma unroll
            for (int i = 0; i < 4; ++i) { const f32x4 w = *(const f32x4*)(w_rg + (size_t)(lane * 4 + 256 * j + i) * 4); const float xv = x[4 * j + i]; gl[0] += xv * w.x; gl[1] += xv * w.y; gl[2] += xv * w.z; gl[3] += xv * w.w; }
#pragma unroll
        for (int g = 0; g < 4; ++g) gl[g] = wave_sum(gl[g]) + b_rg[g];
        int gi = 0; float gm = gl[0];
#pragma unroll
        for (int g = 1; g < 4; ++g) if (gl[g] > gm) { gm = gl[g]; gi = g; }
        float gs = 0.f;
#pragma unroll
        for (int g = 0; g < 4; ++g) gs += __expf(gl[g] - gm);
        const float gw = 1.0f / gs;
        float el[8];
#pragma unroll
        for (int e = 0; e < 8; ++e) el[e] = 0.f;
        const float* wre = w_re + (size_t)gi * D * 8;
#pragma unroll
        for (int j = 0; j < 4; ++j)
#pragma unroll
            for (int i = 0; i < 4; ++i) { const float* wp = wre + (size_t)(lane * 4 + 256 * j + i) * 8; const f32x4 w0 = *(const f32x4*)wp, w1 = *(const f32x4*)(wp + 4); const float xv = x[4 * j + i];
                el[0] += xv * w0.x; el[1] += xv * w0.y; el[2] += xv * w0.z; el[3] += xv * w0.w; el[4] += xv * w1.x; el[5] += xv * w1.y; el[6] += xv * w1.z; el[7] += xv * w1.w; }
#pragma unroll
        for (int e = 0; e < 8; ++e) el[e] = wave_sum(el[e]) + b_re[gi * 8 + e];
        int i0 = 0; float t0 = el[0];
#pragma unroll
        for (int e = 1; e < 8; ++e) if (el[e] > t0) { t0 = el[e]; i0 = e; }
        int i1 = -1; float t1 = -3.0e38f;
#pragma unroll
        for (int e = 0; e < 8; ++e) if (e != i0 && el[e] > t1) { t1 = el[e]; i1 = e; }
        const float ex = __expf(t1 - t0), p0 = 1.0f / (1.0f + ex), p1 = ex / (1.0f + ex);
        if (lane == 0) {
            Rec rc; rc.e0 = gi * 8 + i0; rc.e1 = gi * 8 + i1; rc.g0 = gw * p0; rc.g1 = gw * p1; rc.pad0 = 0; rc.pad1 = 0;
            rc.s0 = atomicAdd(cnt + rc.e0, 1); rc.s1 = atomicAdd(cnt + rc.e1, 1);
            rec[t] = rc;
        }
    }
}
__device__ __forceinline__ void pad_offsets(const int* cnt, int* po) { int acc = 0; for (int e = 0; e < NE; ++e) { po[e] = acc; acc += (cnt[e] + 255) / 256 * 256; } po[NE] = acc; }
__global__ __launch_bounds__(256) void k_dispatch(const int* cnt, const Rec* rec, int* rowtok, float* rowgate) {
    __shared__ int po[NE + 1];
    if (threadIdx.x == 0) pad_offsets(cnt, po);
    __syncthreads();
    for (int t = blockIdx.x * 256 + threadIdx.x; t < T; t += gridDim.x * 256) {
        const Rec rc = rec[t];
        const int d0 = po[rc.e0] + rc.s0, d1 = po[rc.e1] + rc.s1;
        rowtok[d0] = 2 * t; rowgate[d0] = rc.g0; rowtok[d1] = 2 * t + 1; rowgate[d1] = rc.g1;
    }
}
__global__ __launch_bounds__(256) void k_p7(const bf16* hb, const int* cnt, const int* rowtok, const float* w_eg, const float* w_eu, bf16* hid) {
    __shared__ int po[NE + 1];
    if (threadIdx.x == 0) pad_offsets(cnt, po);
    __syncthreads();
    const int lane = threadIdx.x & 63, r = lane & 31, hh = lane >> 5;
    const int wv = blockIdx.x * 4 + (threadIdx.x >> 6), nw = gridDim.x * 4;
    const int ntn = DE / 32, total = (po[NE] / 32) * ntn;
    for (int tile = wv; tile < total; tile += nw) {
        const int tm = tile / ntn, tn = tile % ntn, col = tn * 32 + r, row0 = tm * 32;
        int e = 0; while (e < NE - 1 && po[e + 1] <= row0) ++e;
        int tok = rowtok[row0 + r]; tok = tok < 0 ? 0 : (tok >> 1);
        f32x16 ag, au; for (int i = 0; i < 16; ++i) { ag[i] = 0.f; au[i] = 0.f; }
        wave_gemm32(hb + (size_t)tok * D + 8 * hh, w_eg + (size_t)e * D * DE + (size_t)(8 * hh) * DE + col, DE, D, ag);
        wave_gemm32(hb + (size_t)tok * D + 8 * hh, w_eu + (size_t)e * D * DE + (size_t)(8 * hh) * DE + col, DE, D, au);
#pragma unroll
        for (int i = 0; i < 16; ++i) { const int row = row0 + ACC_ROW(i, hh); const float gsl = ag[i] / (1.0f + __expf(-ag[i])); hid[(size_t)row * DE + col] = f2bf(gsl * au[i]); }
    }
}
__global__ __launch_bounds__(256) void k_p8(const bf16* hid, const int* cnt, const int* rowtok, const float* rowgate, const float* w_ed, bf16* yb) {
    __shared__ int po[NE + 1];
    if (threadIdx.x == 0) pad_offsets(cnt, po);
    __syncthreads();
    const int lane = threadIdx.x & 63, r = lane & 31, hh = lane >> 5;
    const int wv = blockIdx.x * 4 + (threadIdx.x >> 6), nw = gridDim.x * 4;
    const int ntn = D / 32, total = (po[NE] / 32) * ntn;
    for (int tile = wv; tile < total; tile += nw) {
        const int tm = tile / ntn, tn = tile % ntn, col = tn * 32 + r, row0 = tm * 32;
        int e = 0; while (e < NE - 1 && po[e + 1] <= row0) ++e;
        f32x16 acc; for (int i = 0; i < 16; ++i) acc[i] = 0.f;
        wave_gemm32(hid + (size_t)(row0 + r) * DE + 8 * hh, w_ed + (size_t)e * DE * D + (size_t)(8 * hh) * D + col, D, DE, acc);
#pragma unroll
        for (int i = 0; i < 16; ++i) { const int row = row0 + ACC_ROW(i, hh); const int rt = rowtok[row]; if (rt >= 0) yb[(size_t)rt * D + col] = f2bf(acc[i] * rowgate[row]); }
    }
}


namespace pg8 {
#define PG8_LAS __attribute__((address_space(3)))
typedef unsigned short bf16_t;
typedef unsigned u32x4 __attribute__((ext_vector_type(4)));
constexpr int BM = 256, BK = 64, HALF = 128, HTB = HALF * BK * 2  , STAGE_BYTES = 8 * HTB, NXCD = 8, WGM = 8;

__host__ __device__ __forceinline__ int lds_byte(int r, int c) { const int st = (r >> 4) * 2 + (c >> 5), rr = r & 15, cc = c & 31, ob = rr * 64 + cc * 2; return st * 1024 + (ob ^ (((ob >> 9) & 1) << 5)); }
__host__ __device__ __forceinline__ void stage_rc(int b, int& R, int& C) { const int st = b / 1024, sb = b % 1024, swz = sb ^ (((sb >> 9) & 1) << 5); R = (st >> 1) * 16 + swz / 64; C = (st & 1) * 32 + (swz % 64) / 2; }
__host__ __device__ __forceinline__ int perm32(int rho) { const int n = rho >> 4, i = rho & 15; return 8 * (i >> 2) + 4 * n + (i & 3); }

struct Unit { int pm, pn, e, ui; };

struct DenseOrder {
    int nM, nN, nwg, G, c; const char* A; const char* B; size_t tstepA, tstepB;
    __device__ void init(const void* A_, int lda, const void* B_, int ldb, int M, int N, int G_, int c_) { nM = M / BM; nN = N / BM; nwg = nM * nN; G = G_; c = c_; A = (const char*)A_; B = (const char*)B_; tstepA = (size_t)BM * lda * 2; tstepB = (size_t)BM * ldb * 2; }
    __device__ bool next(int i, Unit& u) const {
        const long Lx = (long)i * G + c; if (Lx >= nwg) return false;
        int wgid = (int)Lx; { const int q = nwg / NXCD, r = nwg % NXCD, xcd = wgid % NXCD, off = wgid / NXCD; wgid = (xcd < r ? xcd * (q + 1) : r * (q + 1) + (xcd - r) * q) + off; }
        const int nig = WGM * nN, gid = wgid / nig, fm = gid * WGM, gsz = (nM - fm) < WGM ? (nM - fm) : WGM;
        u.pm = fm + ((wgid % nig) % gsz); u.pn = (wgid % nig) / gsz; u.e = 0; u.ui = i; return true;
    }
    __device__ __forceinline__ const char* a_base(const Unit& u) const { return A + (size_t)u.pm * tstepA; }
    __device__ __forceinline__ const char* b_base(const Unit& u) const { return B + (size_t)u.pn * tstepB; }
    __device__ __forceinline__ int a_row(const Unit&, int) const { return 0; }
};

__device__ __forceinline__ unsigned cvt_pk_bf16(float lo, float hi) { unsigned r; asm volatile("v_cvt_pk_bf16_f32 %0, %1, %2" : "=v"(r) : "v"(lo), "v"(hi)); return r; }

template <class Epi, class Sched, bool GATHER>
__device__ __forceinline__ void gemm_phase(PG8_LAS unsigned char* lds, const Sched& S, const Epi& E, const int K, const int lda, const int ldb) {
    int tid = threadIdx.x; asm volatile("" : "+v"(tid));
    const int wid = __builtin_amdgcn_readfirstlane(tid >> 6), lane = tid & 63, wr = wid >> 2, wc = wid & 3, fr = lane & 15, fq = lane >> 4;
    const int nt = K / BK;
    int RA[2], CA[2]; unsigned voffB[2];
#pragma unroll
    for (int i = 0; i < 2; ++i) { int R, C; stage_rc(tid * 16 + i * 8192, R, C); const int Rb = Epi::PERM ? ((R & ~31) + perm32(R & 31)) : R; RA[i] = R; CA[i] = C; voffB[i] = (unsigned)(Rb * ldb + C) * 2u; }
    const size_t kstep = (size_t)(BK * 2);
    const size_t hstepB = (size_t)HALF * ldb * 2;
    const unsigned ldsw = (unsigned)wid * 1024u;
    const int aoff = lds_byte(wr * 64 + fr, fq * 8), boff = lds_byte(wc * 32 + fr, fq * 8);
#define PG8_SA(b, h) (((b) * 2 + (h)) * HTB)
#define PG8_SB(b, h) ((4 + (b) * 2 + (h)) * HTB)
#define PG8_STAGE2(bufoff, gbase, v0, v1) do { \
        __builtin_amdgcn_global_load_lds((const unsigned*)((const char*)(gbase) + (v0)), (PG8_LAS unsigned*)(lds + (bufoff) + ldsw), 16, 0, 0); \
        __builtin_amdgcn_global_load_lds((const unsigned*)((const char*)(gbase) + (v1)), (PG8_LAS unsigned*)(lds + (bufoff) + ldsw + 8192), 16, 0, 0); } while (0)
#define PG8_STAGEB(bufoff, gbase) PG8_STAGE2(bufoff, gbase, voffB[0], voffB[1])
#define PG8_LDA(dst, b, h) do { _Pragma("unroll") for (int m = 0; m < 4; ++m) _Pragma("unroll") for (int k = 0; k < 2; ++k) dst[m][k] = *(const PG8_LAS bf16x8*)(lds + PG8_SA(b, h) + aoff + m * 2048 + k * 1024); } while (0)
#define PG8_LDB(dst, b, h) do { _Pragma("unroll") for (int n = 0; n < 2; ++n) _Pragma("unroll") for (int k = 0; k < 2; ++k) dst[n][k] = *(const PG8_LAS bf16x8*)(lds + PG8_SB(b, h) + boff + n * 2048 + k * 1024); } while (0)
#define PG8_MMA(ai, bj, At, Bt) do { __builtin_amdgcn_s_setprio(1); _Pragma("unroll") for (int m = 0; m < 4; ++m) _Pragma("unroll") for (int n = 0; n < 2; ++n) _Pragma("unroll") for (int k = 0; k < 2; ++k) \
        acc[ai][bj][m][n] = __builtin_amdgcn_mfma_f32_16x16x32_bf16(Bt[n][k], At[m][k], acc[ai][bj][m][n], 0, 0, 0); __builtin_amdgcn_s_setprio(0); } while (0)
#define PG8_WAIT_V(n) asm volatile("s_waitcnt vmcnt(" #n ")" ::: "memory")
#define PG8_WAIT_L(n) asm volatile("s_waitcnt lgkmcnt(" #n ")" ::: "memory")
#define PG8_BAR __builtin_amdgcn_s_barrier()
#define PG8_SCHED __builtin_amdgcn_sched_barrier(0)
#define PG8_VOFFA(dst, u) do { _Pragma("unroll") for (int h_ = 0; h_ < 2; ++h_) _Pragma("unroll") for (int i_ = 0; i_ < 2; ++i_) { \
        const int row_ = GATHER ? S.a_row(u, h_ * HALF + RA[i_]) : (h_ * HALF + RA[i_]); dst[h_][i_] = (unsigned)(row_ * lda + CA[i_]) * 2u; } } while (0)
    Unit cur, nxt;
    if (!S.next(0, cur)) return;
    f32x4 acc[2][2][4][2];
#pragma unroll
    for (int a = 0; a < 2; ++a)
#pragma unroll
        for (int b = 0; b < 2; ++b)
#pragma unroll
            for (int m = 0; m < 4; ++m)
#pragma unroll
                for (int n = 0; n < 2; ++n) acc[a][b][m][n] = (f32x4){0.f, 0.f, 0.f, 0.f};
    bf16x8 At[4][2], B0[2][2], B1[2][2];
    unsigned vc[2][2], vn[2][2];
    PG8_VOFFA(vc, cur);
    const char* cA = S.a_base(cur); const char* cB = S.b_base(cur);
    PG8_STAGEB(PG8_SB(0, 0), cB); PG8_STAGEB(PG8_SB(0, 1), cB + hstepB); PG8_STAGE2(PG8_SA(0, 0), cA, vc[0][0], vc[0][1]); PG8_STAGE2(PG8_SA(0, 1), cA, vc[1][0], vc[1][1]);
    if (wr == 1) PG8_BAR;
    PG8_WAIT_V(2); PG8_BAR;
    PG8_STAGEB(PG8_SB(1, 0), cB + kstep); PG8_STAGE2(PG8_SA(1, 0), cA + kstep, vc[0][0], vc[0][1]); PG8_STAGEB(PG8_SB(1, 1), cB + hstepB + kstep);
    PG8_WAIT_V(6); PG8_BAR;
    int ui = 0;
    for (;;) {
        const bool has_next = S.next(ui + 1, nxt);
        const char* nA = has_next ? S.a_base(nxt) : cA; const char* nB = has_next ? S.b_base(nxt) : cB;
        if (GATHER) { if (has_next) { PG8_VOFFA(vn, nxt); } else {
#pragma unroll
            for (int h_ = 0; h_ < 2; ++h_) { vn[h_][0] = vc[h_][0]; vn[h_][1] = vc[h_][1]; } } }
        for (int t = 0; t < nt; t += 2) {
            const bool last = (t == nt - 2);
            const char* a1 = cA + (size_t)(t + 1) * kstep;
            const char* a2 = last ? nA : cA + (size_t)(t + 2) * kstep; const char* b2 = last ? nB : cB + (size_t)(t + 2) * kstep;
            const char* a3 = a2 + kstep; const char* b3 = b2 + kstep;
            unsigned w00, w01, w10, w11;
            if (GATHER) { w00 = last ? vn[0][0] : vc[0][0]; w01 = last ? vn[0][1] : vc[0][1]; w10 = last ? vn[1][0] : vc[1][0]; w11 = last ? vn[1][1] : vc[1][1]; }
            else { w00 = vc[0][0]; w01 = vc[0][1]; w10 = vc[1][0]; w11 = vc[1][1]; }
            PG8_LDB(B0, 0, 0); PG8_LDB(B1, 0, 1); PG8_SCHED; PG8_LDA(At, 0, 0); PG8_STAGE2(PG8_SA(1, 1), a1, vc[1][0], vc[1][1]);
            PG8_WAIT_V(8); PG8_WAIT_L(0); PG8_BAR; PG8_MMA(0, 0, At, B0); PG8_MMA(0, 1, At, B1); PG8_BAR; PG8_SCHED;
            PG8_LDA(At, 0, 1); PG8_STAGEB(PG8_SB(0, 0), b2); PG8_STAGEB(PG8_SB(0, 1), b2 + hstepB); PG8_STAGE2(PG8_SA(0, 0), a2, w00, w01);
            PG8_WAIT_V(8); PG8_WAIT_L(0); PG8_BAR; PG8_MMA(1, 0, At, B0); PG8_MMA(1, 1, At, B1); PG8_BAR; PG8_SCHED;
            PG8_LDB(B0, 1, 0); PG8_LDB(B1, 1, 1); PG8_SCHED; PG8_LDA(At, 1, 0); PG8_STAGE2(PG8_SA(0, 1), a2, w10, w11);
            PG8_WAIT_V(8); PG8_WAIT_L(0); PG8_BAR; PG8_MMA(0, 0, At, B0); PG8_MMA(0, 1, At, B1); PG8_BAR; PG8_SCHED;
            PG8_LDA(At, 1, 1); PG8_STAGEB(PG8_SB(1, 0), b3); PG8_STAGEB(PG8_SB(1, 1), b3 + hstepB); PG8_STAGE2(PG8_SA(1, 0), a3, w00, w01);
            PG8_WAIT_V(8); PG8_WAIT_L(0); PG8_BAR; PG8_MMA(1, 0, At, B0); PG8_MMA(1, 1, At, B1); PG8_BAR; PG8_SCHED;
        }
        if (wr == 0) PG8_BAR;
        E(acc, cur, wr, wc, fr, fq);
        if (!has_next) break;
#pragma unroll
        for (int a = 0; a < 2; ++a)
#pragma unroll
            for (int b = 0; b < 2; ++b)
#pragma unroll
                for (int m = 0; m < 4; ++m)
#pragma unroll
                    for (int n = 0; n < 2; ++n) acc[a][b][m][n] = (f32x4){0.f, 0.f, 0.f, 0.f};
        cur = nxt; cA = nA; cB = nB; ++ui;
        if (GATHER) {
#pragma unroll
            for (int h_ = 0; h_ < 2; ++h_) { vc[h_][0] = vn[h_][0]; vc[h_][1] = vn[h_][1]; } }
        if (wr == 1) PG8_BAR;
    }
    PG8_WAIT_V(0);
    PG8_BAR;
#undef PG8_SA
#undef PG8_SB
#undef PG8_STAGE2
#undef PG8_STAGEB
#undef PG8_LDA
#undef PG8_LDB
#undef PG8_MMA
#undef PG8_WAIT_V
#undef PG8_WAIT_L
#undef PG8_BAR
#undef PG8_SCHED
#undef PG8_VOFFA
}
}

constexpr int NWAVES = 8, NTHREADS = 512;
constexpr int RING_OFF = 0, RING_BYTES = 131072, ROWS_OFF = 131072, ROWS_BYTES = 12288, MISC_OFF = ROWS_OFF + ROWS_BYTES, LDS_BYTES = 147456;
static_assert(MISC_OFF + 128 <= LDS_BYTES, "LDS map");
constexpr int CW_CNT = 0;
constexpr int CW_BAR = 4096;
constexpr size_t CTL_ZERO_BYTES = 64 * 1024;
constexpr float LOG2E = 1.4426950408889634f, LN2 = 0.6931471805599453f;
constexpr float QSCALE = 0.125f * LOG2E;

#define GAS __attribute__((address_space(1)))
#define LAS __attribute__((address_space(3)))
typedef unsigned v4u __attribute__((ext_vector_type(4)));
typedef unsigned v2u __attribute__((ext_vector_type(2)));
#define LDS_WAIT() asm volatile("s_waitcnt lgkmcnt(0)" ::: "memory")
__device__ __forceinline__ unsigned pk2(float lo, float hi) { return (unsigned)f2bf(lo) | ((unsigned)f2bf(hi) << 16); }

#define XB_TMO      128
#define XB_XCNT(j)  (256  + 64 * (j))
#define XB_XSUB(j)  (1280 + 64 * (j))
#define XB_XGEN(j)  (2304 + 64 * (j))
#define XB_TOP      3328
#define XB_TOPGEN   3392
#define XCD_BAR_WORDS 3456
#define XB_SPIN_CAP (1u << 18)

__device__ __forceinline__ unsigned xb_ld(unsigned* p)              { return __hip_atomic_load(p, __ATOMIC_RELAXED, __HIP_MEMORY_SCOPE_AGENT); }
__device__ __forceinline__ unsigned xb_add(unsigned* p, unsigned v) { return __hip_atomic_fetch_add(p, v, __ATOMIC_RELAXED, __HIP_MEMORY_SCOPE_AGENT); }
__device__ __forceinline__ unsigned xb_xcc_id() { return (unsigned)__builtin_amdgcn_s_getreg((3 << 11) | 20) & 0xFu; }
#define XB_SPIN(cond, bar) do { unsigned _sp = 0; while (cond) { __builtin_amdgcn_s_sleep(1); \
    if ((++_sp & 255u) == 0u) { if (xb_ld(&(bar)[XB_TMO])) break; if (_sp > XB_SPIN_CAP) { atomicAdd(&(bar)[XB_TMO], 1u); break; } } } } while (0)

struct XcdBarrier {
    unsigned* bar; unsigned x;
    volatile LAS unsigned* st;
};

__device__ __forceinline__ XcdBarrier xcd_barrier_post(unsigned* bar, volatile LAS unsigned* st) {
    XcdBarrier b; b.bar = bar; b.x = xb_xcc_id(); b.st = st;
    if (threadIdx.x == 0) (void)xb_add(&bar[XB_XCNT(b.x)], 1u);
    return b;
}
__device__ __forceinline__ void xcd_barrier_complete(unsigned* bar, unsigned x, unsigned& nloc, unsigned& nx) {
    const unsigned G = gridDim.x * gridDim.y * gridDim.z;
    unsigned sum, cnt, mine, sp = 0u;
    for (;;) {
        sum = 0u; cnt = 0u; mine = 0u;
#pragma unroll
        for (unsigned j = 0; j < 16; ++j) { const unsigned c = xb_ld(&bar[XB_XCNT(j)]); sum += c; cnt += (c > 0u) ? 1u : 0u; mine = (j == x) ? c : mine; }
        if (sum == G) break;
        __builtin_amdgcn_s_sleep(1);
        if ((++sp & 255u) == 0u) { if (xb_ld(&bar[XB_TMO])) break; if (sp > XB_SPIN_CAP) { atomicAdd(&bar[XB_TMO], 1u); break; } }
    }
    nloc = mine > 0u ? mine : 1u; nx = cnt > 0u ? cnt : 1u;
}

__device__ __forceinline__ void xcd_barrier(const XcdBarrier& b) {
    asm volatile("s_waitcnt vmcnt(0)" ::: "memory");
    __syncthreads();
    if (threadIdx.x == 0) {
        unsigned* bar = b.bar;
        __builtin_amdgcn_s_waitcnt(0);
        unsigned nloc = b.st[0], nx = b.st[1];
        if (nloc == 0u) { xcd_barrier_complete(bar, b.x, nloc, nx); b.st[0] = nloc; b.st[1] = nx; }
        const unsigned old = xb_add(&bar[XB_XSUB(b.x)], 1u);
        const unsigned gen = old / nloc;
        if (old + 1u == (gen + 1u) * nloc) {
            __builtin_amdgcn_fence(__ATOMIC_RELEASE, "agent");
            asm volatile("s_waitcnt vmcnt(0)" ::: "memory");
            const unsigned og = xb_add(&bar[XB_TOP], 1u);
            const unsigned tg = og / nx;
            if (og + 1u == (tg + 1u) * nx) xb_add(&bar[XB_TOPGEN], 1u);
            else XB_SPIN(xb_ld(&bar[XB_TOPGEN]) == tg, bar);
            __builtin_amdgcn_fence(__ATOMIC_ACQUIRE, "agent");
            xb_add(&bar[XB_XGEN(b.x)], 1u);
            asm volatile("s_waitcnt vmcnt(0)" ::: "memory");
        } else {
            XB_SPIN(xb_ld(&bar[XB_XGEN(b.x)]) == gen, bar);
            __builtin_amdgcn_fence(__ATOMIC_ACQUIRE, "agent");
            asm volatile("s_waitcnt vmcnt(0)" ::: "memory");
        }
    }
    __syncthreads();
}


struct Args { const float* in[23]; float* out; unsigned char* ws; int s_lo, s_hi; };

struct Frame {
    LAS unsigned char* lds; int tid, lane, wave, vcu, G;
    const float* const* in; float* h; unsigned char* ws;
};

#define LAUNDER(F) do { asm volatile("" : "+v"((F).tid)); (F).lane = (F).tid & 63; } while (0)
__device__ __forceinline__ void p0_item(const float* W, int ldw, int k0, int n0, bf16* WT, int Kd, int drow0, float scale, LAS float* scr, int lane) {
#pragma unroll 8
    for (int i = 0; i < 32; ++i) { const int kk = 2 * i + (lane >> 5); scr[kk * 33 + (lane & 31)] = W[(size_t)(k0 + kk) * ldw + n0 + (lane & 31)] * scale; }
    LDS_WAIT(); asm volatile("" ::: "memory");
    const int c = lane & 7;
#pragma unroll
    for (int j = 0; j < 4; ++j) { const int n = (lane >> 3) + 8 * j; const LAS float* s = scr + (8 * c) * 33 + n;
        v4u o; o.x = pk2(s[0 * 33], s[1 * 33]); o.y = pk2(s[2 * 33], s[3 * 33]); o.z = pk2(s[4 * 33], s[5 * 33]); o.w = pk2(s[6 * 33], s[7 * 33]);
        *(v4u*)(WT + (size_t)(drow0 + n) * Kd + k0 + 8 * c) = o; }
    LDS_WAIT(); asm volatile("" ::: "memory");
}
__device__ __forceinline__ bool is_q_col(int n) { return n < 512 || (n >= 768 && n < 3072 && ((n - 768) % 768) < 256) || (n >= 3072 && n < 3584); }

__device__ __forceinline__ void ph_prologue(Frame& F) { LAUNDER(F);
    LAS float* scr = (LAS float*)(F.lds + RING_OFF + F.wave * 16384);
    const int gw = F.vcu * NWAVES + F.wave, NGW = F.G * NWAVES, lane = F.lane;
    const float* w_in = F.in[4]; const float* w_a = F.in[8]; const float* w_b = F.in[9]; const float* w_c = F.in[10]; const float* w_o = F.in[11];
    const float* w_eg = F.in[18]; const float* w_eu = F.in[19]; const float* w_ed = F.in[20];
    bf16* WIN = (bf16*)(F.ws + WS_WIN); bf16* WBRA = (bf16*)(F.ws + WS_WBRA); bf16* WBRB = (bf16*)(F.ws + WS_WBRB); bf16* WBRC = (bf16*)(F.ws + WS_WBRC); bf16* WOUT = (bf16*)(F.ws + WS_WOUT);
    bf16* WGU = (bf16*)(F.ws + WS_WGU); bf16* WD = (bf16*)(F.ws + WS_WD);
    constexpr int I_IN = 16 * (NCOL / 32), I_A = 8 * 32, I_B = 4 * 32, I_C = 8 * 32, I_O = 16 * 32, I_G = 16 * 16, I_D = 8 * 32;
    constexpr int I_LAYER = I_IN + I_A + I_B + I_C + I_O + NE * (2 * I_G + I_D);
    for (int it = gw; it < DEPTH * I_LAYER; it += NGW) {
        const int l = it / I_LAYER; int r = it % I_LAYER;
        if (r < I_IN) { const int nb = r % (NCOL / 32), kb = r / (NCOL / 32); p0_item(w_in + (size_t)l * D * NCOL, NCOL, 64 * kb, 32 * nb, WIN + (size_t)l * NCOL * D, D, 32 * nb, is_q_col(32 * nb) ? QSCALE : 1.0f, scr, lane); continue; } r -= I_IN;
        if (r < I_A) { const int nb = r % 32, kb = r / 32; p0_item(w_a + (size_t)l * 512 * D, D, 64 * kb, 32 * nb, WBRA + (size_t)l * D * 512, 512, 32 * nb, 1.0f, scr, lane); continue; } r -= I_A;
        if (r < I_B) { const int nb = r % 32, kb = r / 32; p0_item(w_b + (size_t)l * 256 * D, D, 64 * kb, 32 * nb, WBRB + (size_t)l * D * 256, 256, 32 * nb, 1.0f, scr, lane); continue; } r -= I_B;
        if (r < I_C) { const int nb = r % 32, kb = r / 32; p0_item(w_c + (size_t)l * 512 * D, D, 64 * kb, 32 * nb, WBRC + (size_t)l * D * 512, 512, 32 * nb, 1.0f, scr, lane); continue; } r -= I_C;
        if (r < I_O) { const int nb = r % 32, kb = r / 32; p0_item(w_o + (size_t)l * D * D, D, 64 * kb, 32 * nb, WOUT + (size_t)l * D * D, D, 32 * nb, 1.0f, scr, lane); continue; } r -= I_O;
        const int e = r / (2 * I_G + I_D); r %= (2 * I_G + I_D); const size_t le = (size_t)l * NE + e;
        if (r < 2 * I_G) { const int up = r / I_G; r %= I_G; const int nb = r % 16, kb = r / 16;
            p0_item((up ? w_eu : w_eg) + le * D * DE, DE, 64 * kb, 32 * nb, WGU + le * 1024 * 1024, D, (nb >> 2) * 256 + up * 128 + (nb & 3) * 32, 1.0f, scr, lane); continue; }
        r -= 2 * I_G; { const int nb = r % 32, kb = r / 32; p0_item(w_ed + le * DE * D, D, 64 * kb, 32 * nb, WD + le * D * DE, DE, 32 * nb, 1.0f, scr, lane); }
    }
}

template <int MODE> __device__ __forceinline__ void ln_row(const float* src, float* h, bf16* hb, const bf16* yb, const float* g, const float* bta, size_t row, int lane, f32x4 (&o)[4]) {
    f32x4 v[4];
#pragma unroll
    for (int j = 0; j < 4; ++j) {
        const int c = lane * 4 + 256 * j;
        v[j] = *(const f32x4*)((MODE == 0 ? src : h) + row * D + c);
        if (MODE == 2) {
            const uint2 a = *(const uint2*)(yb + (row * 2) * D + c), b = *(const uint2*)(yb + (row * 2 + 1) * D + c);
            v[j].x = ALPHA * v[j].x + bf2f((bf16)(a.x & 0xffff)) + bf2f((bf16)(b.x & 0xffff));
            v[j].y = ALPHA * v[j].y + bf2f((bf16)(a.x >> 16)) + bf2f((bf16)(b.x >> 16));
            v[j].z = ALPHA * v[j].z + bf2f((bf16)(a.y & 0xffff)) + bf2f((bf16)(b.y & 0xffff));
            v[j].w = ALPHA * v[j].w + bf2f((bf16)(a.y >> 16)) + bf2f((bf16)(b.y >> 16));
        }
    }
    float s = 0.f;
#pragma unroll
    for (int j = 0; j < 4; ++j) s += (v[j].x + v[j].y) + (v[j].z + v[j].w);
    const float mean = wave_sum(s) * (1.f / D);
    float q = 0.f;
#pragma unroll
    for (int j = 0; j < 4; ++j) { v[j] = v[j] - mean; q += (v[j].x * v[j].x + v[j].y * v[j].y) + (v[j].z * v[j].z + v[j].w * v[j].w); }
    const float rstd = 1.0f / sqrtf(wave_sum(q) * (1.f / D) + LN_EPS);
#pragma unroll
    for (int j = 0; j < 4; ++j) {
        const int c = lane * 4 + 256 * j;
        const f32x4 gg = *(const f32x4*)(g + c), bb = *(const f32x4*)(bta + c);
        o[j] = v[j] * rstd * gg + bb;
        *(f32x4*)(h + row * D + c) = o[j];
        if (hb) { uint2 w; w.x = pk2(o[j].x, o[j].y); w.y = pk2(o[j].z, o[j].w); *(uint2*)(hb + row * D + c) = w; }
    }
}

struct EpiP1 {
    static constexpr bool PERM = true;
    bf16* qkv; bf16* gates; const float* b_gate;
    __device__ __forceinline__ void operator()(const f32x4 (&acc)[2][2][4][2], const pg8::Unit& u, int wr, int wc, int fr, int fq) const {
        const int row0 = u.pm * 256 + wr * 64 + fr; const bool isg = u.pn >= 18;
        bf16* base = isg ? gates : qkv; const int ldc = isg ? GATEW : QKVW; const int col0 = (isg ? (u.pn - 18) : u.pn) * 256 + wc * 32 + 8 * fq;
        f32x4 bv[2][2];
#pragma unroll
        for (int bj = 0; bj < 2; ++bj)
#pragma unroll
            for (int n = 0; n < 2; ++n) bv[bj][n] = isg ? *(const f32x4*)(b_gate + col0 + bj * 128 + 4 * n) : (f32x4){0.f, 0.f, 0.f, 0.f};
#pragma unroll
        for (int ai = 0; ai < 2; ++ai)
#pragma unroll
            for (int m = 0; m < 4; ++m) { bf16* rowp = base + (size_t)(row0 + ai * 128 + m * 16) * ldc + col0;
#pragma unroll
                for (int bj = 0; bj < 2; ++bj) { f32x4 v0 = acc[ai][bj][m][0] + bv[bj][0], v1 = acc[ai][bj][m][1] + bv[bj][1];
                    if (isg) {
#pragma unroll
                        for (int j = 0; j < 4; ++j) { v0[j] = __builtin_amdgcn_rcpf(1.0f + __builtin_amdgcn_exp2f(-LOG2E * v0[j])); v1[j] = __builtin_amdgcn_rcpf(1.0f + __builtin_amdgcn_exp2f(-LOG2E * v1[j])); } }
                    v4u w; w.x = pg8::cvt_pk_bf16(v0[0], v0[1]); w.y = pg8::cvt_pk_bf16(v0[2], v0[3]); w.z = pg8::cvt_pk_bf16(v1[0], v1[1]); w.w = pg8::cvt_pk_bf16(v1[2], v1[3]);
                    *(v4u*)(rowp + bj * 128) = w; } }
    }
};
template <bool FIRST> struct EpiP3 {
    static constexpr bool PERM = true;
    bf16* merged; const bf16* gates; int br;
    __device__ __forceinline__ void operator()(const f32x4 (&acc)[2][2][4][2], const pg8::Unit& u, int wr, int wc, int fr, int fq) const {
        const int row0 = u.pm * 256 + wr * 64 + fr, col0 = u.pn * 256 + wc * 32 + 8 * fq;
#pragma unroll
        for (int ai = 0; ai < 2; ++ai)
#pragma unroll
            for (int m = 0; m < 4; ++m) { const size_t row = (size_t)(row0 + ai * 128 + m * 16);
#pragma unroll
                for (int bj = 0; bj < 2; ++bj) {
                    const v4u gw = *(const v4u*)(gates + row * GATEW + br * 1024 + col0 + bj * 128);
                    v4u ow = FIRST ? (v4u){0u, 0u, 0u, 0u} : *(const v4u*)(merged + row * D + col0 + bj * 128);
                    const f32x4 a0 = acc[ai][bj][m][0], a1 = acc[ai][bj][m][1];
                    float r[8];
#pragma unroll
                    for (int j = 0; j < 4; ++j) { const unsigned g2 = gw[j], o2 = ow[j]; const float av0 = j < 2 ? a0[2 * j] : a1[2 * j - 4], av1 = j < 2 ? a0[2 * j + 1] : a1[2 * j - 3];
                        r[2 * j] = __uint_as_float(g2 << 16) * av0 + (FIRST ? 0.f : __uint_as_float(o2 << 16)); r[2 * j + 1] = __uint_as_float(g2 & 0xffff0000u) * av1 + (FIRST ? 0.f : __uint_as_float(o2 & 0xffff0000u)); }
                    v4u w; w.x = pg8::cvt_pk_bf16(r[0], r[1]); w.y = pg8::cvt_pk_bf16(r[2], r[3]); w.z = pg8::cvt_pk_bf16(r[4], r[5]); w.w = pg8::cvt_pk_bf16(r[6], r[7]);
                    *(v4u*)(merged + row * D + col0 + bj * 128) = w; }
                asm volatile("" ::: "memory"); }
    }
};
struct EpiP4 {
    static constexpr bool PERM = false;
    float* hc;
    __device__ __forceinline__ void operator()(const f32x4 (&acc)[2][2][4][2], const pg8::Unit& u, int wr, int wc, int fr, int fq) const {
        const int row0 = u.pm * 256 + wr * 64 + fr, col0 = u.pn * 256 + wc * 32 + 4 * fq;
#pragma unroll
        for (int ai = 0; ai < 2; ++ai)
#pragma unroll
            for (int m = 0; m < 4; ++m) { float* rowp = hc + (size_t)(row0 + ai * 128 + m * 16) * D + col0;
#pragma unroll
                for (int bj = 0; bj < 2; ++bj)
#pragma unroll
                    for (int n = 0; n < 2; ++n) { f32x4* p = (f32x4*)(rowp + bj * 128 + n * 16); *p = *p * ALPHA + acc[ai][bj][m][n]; }
                asm volatile("" ::: "memory"); }
    }
};
struct EpiP7 {
    static constexpr bool PERM = true;
    bf16* hid;
    __device__ __forceinline__ void operator()(const f32x4 (&acc)[2][2][4][2], const pg8::Unit& u, int wr, int wc, int fr, int fq) const {
        const int row0 = u.pm * 256 + wr * 64 + fr, col0 = u.pn * 128 + wc * 32 + 8 * fq;
#pragma unroll
        for (int ai = 0; ai < 2; ++ai)
#pragma unroll
            for (int m = 0; m < 4; ++m) { float r[8];
#pragma unroll
                for (int n = 0; n < 2; ++n)
#pragma unroll
                    for (int j = 0; j < 4; ++j) { const float gv = acc[ai][0][m][n][j], uv = acc[ai][1][m][n][j]; r[4 * n + j] = gv * __builtin_amdgcn_rcpf(1.0f + __builtin_amdgcn_exp2f(-LOG2E * gv)) * uv; }
                v4u w; w.x = pg8::cvt_pk_bf16(r[0], r[1]); w.y = pg8::cvt_pk_bf16(r[2], r[3]); w.z = pg8::cvt_pk_bf16(r[4], r[5]); w.w = pg8::cvt_pk_bf16(r[6], r[7]);
                *(v4u*)(hid + (size_t)(row0 + ai * 128 + m * 16) * DE + col0) = w; }
    }
};
struct EpiP8 {
    static constexpr bool PERM = true;
    bf16* yb; const int* rowtok; const float* rowgate;
    __device__ __forceinline__ void operator()(const f32x4 (&acc)[2][2][4][2], const pg8::Unit& u, int wr, int wc, int fr, int fq) const {
        const int row0 = u.pm * 256 + wr * 64 + fr, col0 = u.pn * 256 + wc * 32 + 8 * fq;
#pragma unroll
        for (int ai = 0; ai < 2; ++ai)
#pragma unroll
            for (int m = 0; m < 4; ++m) { const int row = row0 + ai * 128 + m * 16; const int rt = rowtok[row]; const float gt = rowgate[row];
                if (rt >= 0) {
#pragma unroll
                    for (int bj = 0; bj < 2; ++bj) { const f32x4 v0 = acc[ai][bj][m][0] * gt, v1 = acc[ai][bj][m][1] * gt;
                        v4u w; w.x = pg8::cvt_pk_bf16(v0[0], v0[1]); w.y = pg8::cvt_pk_bf16(v0[2], v0[3]); w.z = pg8::cvt_pk_bf16(v1[0], v1[1]); w.w = pg8::cvt_pk_bf16(v1[2], v1[3]);
                        *(v4u*)(yb + (size_t)rt * D + col0 + bj * 128) = w; } } }
    }
};

__device__ __forceinline__ void router_row(const float (&x)[16], int t, int lane, const float* w_rg, const float* b_rg, const float* w_re, const float* b_re, int* cnt, Rec* rec) {
    float gl[4] = {0.f, 0.f, 0.f, 0.f};
#pragma unroll
    for (int j = 0; j < 4; ++j)
#pragma unroll
        for (int i = 0; i < 4; ++i) { const f32x4 w = *(const f32x4*)(w_rg + (size_t)(lane * 4 + 256 * j + i) * 4); const float xv = x[4 * j + i]; gl[0] += xv * w.x; gl[1] += xv * w.y; gl[2] += xv * w.z; gl[3] += xv * w.w; }
#pragma unroll
    for (int g = 0; g < 4; ++g) gl[g] = wave_sum(gl[g]) + b_rg[g];
    int gi = 0; float gm = gl[0];
#pragma unroll
    for (int g = 1; g < 4; ++g) if (gl[g] > gm) { gm = gl[g]; gi = g; }
    float gs = 0.f;
#pragma unroll
    for (int g = 0; g < 4; ++g) gs += __expf(gl[g] - gm);
    const float gw = 1.0f / gs;
    float el[8];
#pragma unroll
    for (int e = 0; e < 8; ++e) el[e] = 0.f;
    const float* wre = w_re + (size_t)gi * D * 8;
#pragma unroll
    for (int j = 0; j < 4; ++j)
#pragma unroll
        for (int i = 0; i < 4; ++i) { const float* wp = wre + (size_t)(lane * 4 + 256 * j + i) * 8; const f32x4 w0 = *(const f32x4*)wp, w1 = *(const f32x4*)(wp + 4); const float xv = x[4 * j + i];
            el[0] += xv * w0.x; el[1] += xv * w0.y; el[2] += xv * w0.z; el[3] += xv * w0.w; el[4] += xv * w1.x; el[5] += xv * w1.y; el[6] += xv * w1.z; el[7] += xv * w1.w; }
#pragma unroll
    for (int e = 0; e < 8; ++e) el[e] = wave_sum(el[e]) + b_re[gi * 8 + e];
    int i0 = 0; float t0 = el[0];
#pragma unroll
    for (int e = 1; e < 8; ++e) if (el[e] > t0) { t0 = el[e]; i0 = e; }
    int i1 = -1; float t1 = -3.0e38f;
#pragma unroll
    for (int e = 0; e < 8; ++e) if (e != i0 && el[e] > t1) { t1 = el[e]; i1 = e; }
    const float ex = __expf(t1 - t0), p0 = 1.0f / (1.0f + ex), p1 = ex / (1.0f + ex);
    if (lane == 0) {
        Rec rc; rc.e0 = gi * 8 + i0; rc.e1 = gi * 8 + i1; rc.g0 = gw * p0; rc.g1 = gw * p1; rc.pad0 = 0; rc.pad1 = 0;
        rc.s0 = atomicAdd(cnt + rc.e0, 1); rc.s1 = atomicAdd(cnt + rc.e1, 1);
        rec[t] = rc;
    }
}

__device__ __forceinline__ void ph_ln0(Frame& F) { LAUNDER(F);
    const int gw = F.vcu * NWAVES + F.wave, NGW = F.G * NWAVES;
    bf16* hb = (bf16*)(F.ws + WS_HB);
    for (int m = gw; m < T; m += NGW) { f32x4 o[4]; ln_row<0>(F.in[0], F.h, hb, nullptr, F.in[1], F.in[2], (size_t)m, F.lane, o); }
}
__device__ __forceinline__ void ph_p1(Frame& F, int l, int c) { LAUNDER(F);
    pg8::DenseOrder S; S.init((const bf16*)(F.ws + WS_HB) + (size_t)c * CH * D, D, (const bf16*)(F.ws + WS_WIN) + (size_t)l * NCOL * D, D, CH, NCOL, F.G, (int)blockIdx.x);
    EpiP1 E{(bf16*)(F.ws + WS_QKV), (bf16*)(F.ws + WS_GATES), F.in[5] + (size_t)l * GATEW};
    pg8::gemm_phase<EpiP1, pg8::DenseOrder, false>(F.lds + RING_OFF, S, E, D, D, D);
}
__device__ __forceinline__ void ph_cmb(Frame& F) { LAUNDER(F);
    const bf16* og = (const bf16*)(F.ws + WS_OG); const float* lse = (const float*)(F.ws + WS_LSE); bf16* oabc = (bf16*)(F.ws + WS_OABC);
    for (int idx = F.vcu * NTHREADS + F.tid; idx < CH * 32; idx += F.G * NTHREADS) {
        const int tl = idx >> 5, hc = idx & 31, h = hc >> 3, c = hc & 7;
        const float l0 = lse[((size_t)tl * 3 + 0) * 4 + h], l1 = lse[((size_t)tl * 3 + 1) * 4 + h], l2 = lse[((size_t)tl * 3 + 2) * 4 + h];
        const float mx = fmaxf(l0, fmaxf(l1, l2)); float w0 = __expf(l0 - mx), w1 = __expf(l1 - mx), w2 = __expf(l2 - mx); const float inv = 1.0f / (w0 + w1 + w2); w0 *= inv; w1 *= inv; w2 *= inv;
        const v4u a = *(const v4u*)(og + ((size_t)tl * 3 + 0) * 256 + h * 64 + c * 8), b = *(const v4u*)(og + ((size_t)tl * 3 + 1) * 256 + h * 64 + c * 8), d = *(const v4u*)(og + ((size_t)tl * 3 + 2) * 256 + h * 64 + c * 8);
        v4u ow;
#pragma unroll
        for (int i = 0; i < 4; ++i) {
            const float lo = w0 * __uint_as_float(a[i] << 16) + w1 * __uint_as_float(b[i] << 16) + w2 * __uint_as_float(d[i] << 16);
            const float hi = w0 * __uint_as_float(a[i] & 0xffff0000u) + w1 * __uint_as_float(b[i] & 0xffff0000u) + w2 * __uint_as_float(d[i] & 0xffff0000u);
            ow[i] = pk2(lo, hi);
        }
        *(v4u*)(oabc + (size_t)tl * OW + 512 + h * 64 + c * 8) = ow;
    }
}
__device__ __forceinline__ void ph_p3(Frame& F, int l) { LAUNDER(F);
    const bf16* oabc = (const bf16*)(F.ws + WS_OABC); bf16* merged = (bf16*)(F.ws + WS_MERGED); const bf16* gates = (const bf16*)(F.ws + WS_GATES);
    { pg8::DenseOrder S; S.init(oabc, OW, (const bf16*)(F.ws + WS_WBRA) + (size_t)l * D * 512, 512, CH, D, F.G, (int)blockIdx.x);
      EpiP3<true> E{merged, gates, 0}; pg8::gemm_phase<EpiP3<true>, pg8::DenseOrder, false>(F.lds + RING_OFF, S, E, 512, OW, 512); }
    { pg8::DenseOrder S; S.init(oabc + 512, OW, (const bf16*)(F.ws + WS_WBRB) + (size_t)l * D * 256, 256, CH, D, F.G, (int)blockIdx.x);
      EpiP3<false> E{merged, gates, 1}; pg8::gemm_phase<EpiP3<false>, pg8::DenseOrder, false>(F.lds + RING_OFF, S, E, 256, OW, 256); }
    { pg8::DenseOrder S; S.init(oabc + 768, OW, (const bf16*)(F.ws + WS_WBRC) + (size_t)l * D * 512, 512, CH, D, F.G, (int)blockIdx.x);
      EpiP3<false> E{merged, gates, 2}; pg8::gemm_phase<EpiP3<false>, pg8::DenseOrder, false>(F.lds + RING_OFF, S, E, 512, OW, 512); }
}
__device__ __forceinline__ void ph_p4(Frame& F, int l, int c) { LAUNDER(F);
    pg8::DenseOrder S; S.init((const bf16*)(F.ws + WS_MERGED), D, (const bf16*)(F.ws + WS_WOUT) + (size_t)l * D * D, D, CH, D, F.G, (int)blockIdx.x);
    EpiP4 E{F.h + (size_t)c * CH * D};
    pg8::gemm_phase<EpiP4, pg8::DenseOrder, false>(F.lds + RING_OFF, S, E, D, D, D);
}
__device__ __forceinline__ void ph_ln1(Frame& F, int l, int c) { LAUNDER(F);
    const int gw = F.vcu * NWAVES + F.wave, NGW = F.G * NWAVES;
    bf16* hb = (bf16*)(F.ws + WS_HB); int* cnt = (int*)(F.ws + WS_CTL) + CW_CNT + l * 32; Rec* rec = (Rec*)(F.ws + WS_REC);
    for (int m = gw; m < CH; m += NGW) {
        const size_t row = (size_t)c * CH + m; f32x4 o[4];
        ln_row<1>(nullptr, F.h, hb, nullptr, F.in[12] + l * D, F.in[13] + l * D, row, F.lane, o);
        float x[16];
#pragma unroll
        for (int j = 0; j < 4; ++j) { x[4 * j] = o[j].x; x[4 * j + 1] = o[j].y; x[4 * j + 2] = o[j].z; x[4 * j + 3] = o[j].w; }
        router_row(x, (int)row, F.lane, F.in[14] + (size_t)l * D * 4, F.in[15] + l * 4, F.in[16] + (size_t)l * 4 * D * 8, F.in[17] + l * 32, cnt, rec);
    }
}
__device__ __forceinline__ void ph_dsp(Frame& F, int l) { LAUNDER(F);
    LAS int* po = (LAS int*)(F.lds + ROWS_OFF);
    const int* cnt = (const int*)(F.ws + WS_CTL) + CW_CNT + l * 32; const Rec* rec = (const Rec*)(F.ws + WS_REC); int* rowtok = (int*)(F.ws + WS_ROWTOK); float* rowgate = (float*)(F.ws + WS_ROWGATE);
    if (F.tid == 0) { int acc = 0; for (int e = 0; e < NE; ++e) { po[e] = acc; acc += (cnt[e] + 255) / 256 * 256; } po[NE] = acc; }
    __syncthreads();
    const int gt = F.vcu * NTHREADS + F.tid, GT = F.G * NTHREADS;
    for (int t = gt; t < T; t += GT) {
        const Rec rc = rec[t];
        const int d0 = po[rc.e0] + rc.s0, d1 = po[rc.e1] + rc.s1;
        rowtok[d0] = 2 * t; rowgate[d0] = rc.g0; rowtok[d1] = 2 * t + 1; rowgate[d1] = rc.g1;
    }
    for (int e = 0; e < NE; ++e) for (int r = po[e] + cnt[e] + gt; r < po[e + 1]; r += GT) { rowtok[r] = -1; rowgate[r] = 0.f; }
    __syncthreads();
}
__device__ __forceinline__ int moe_setup(Frame& F, int l, bool gather) { LAUNDER(F);
    LAS int* rows = (LAS int*)(F.lds + ROWS_OFF); LAS int* ulist = rows + 11 * 256; LAS int* po = ulist + 16;
    const int* cnt = (const int*)(F.ws + WS_CTL) + CW_CNT + l * 32; const int* rowtok = (const int*)(F.ws + WS_ROWTOK);
    if (F.tid == 0) { int acc = 0; for (int e = 0; e < NE; ++e) { po[e] = acc; acc += (cnt[e] + 255) / 256 * 256; } po[NE] = acc; }
    __syncthreads();
    const int nu_all = (po[NE] / 256) * 4; int nun = (nu_all - F.vcu + F.G - 1) / F.G; nun = nun < 0 ? 0 : (nun > 11 ? 11 : nun);
    if (F.tid < nun) { const int Lx = F.tid * F.G + F.vcu, rt = Lx >> 2, pn = Lx & 3; int e = 0; while (e < NE - 1 && po[e + 1] <= rt * 256) ++e; ulist[F.tid] = (rt << 8) | (e << 2) | pn; }
    if (gather) for (int idx = F.tid; idx < nun * 256; idx += NTHREADS) { const int i = idx >> 8, r = idx & 255, Lx = i * F.G + F.vcu; rows[idx] = rowtok[(Lx >> 2) * 256 + r]; }
    __syncthreads();
    return nun;
}
struct MoeOrder {
    int nun; const LAS int* ulist; const LAS int* rows; const char* A; const char* B; size_t tstepA, estepB, tstepB;
    __device__ __forceinline__ bool next(int i, pg8::Unit& u) const {
        if (i >= nun) return false;
        const int w = __builtin_amdgcn_readfirstlane(ulist[i]); u.pm = w >> 8; u.e = (w >> 2) & 63; u.pn = w & 3; u.ui = i; return true;
    }
    __device__ __forceinline__ const char* a_base(const pg8::Unit& u) const { return A + (size_t)u.pm * tstepA; }
    __device__ __forceinline__ const char* b_base(const pg8::Unit& u) const { return B + (size_t)u.e * estepB + (size_t)u.pn * tstepB; }
    __device__ __forceinline__ int a_row(const pg8::Unit& u, int r) const { const int t = rows[u.ui * 256 + r]; return t < 0 ? 0 : (t >> 1); }
};
__device__ __forceinline__ void ph_p7(Frame& F, int l) { LAUNDER(F);
    const int nun = moe_setup(F, l, true);
    LAS int* rows = (LAS int*)(F.lds + ROWS_OFF);
    MoeOrder S{nun, rows + 11 * 256, rows, (const char*)(F.ws + WS_HB), (const char*)(F.ws + WS_WGU) + (size_t)l * NE * 1024 * 1024 * 2, 0, (size_t)1024 * 1024 * 2, (size_t)256 * 1024 * 2};
    EpiP7 E{(bf16*)(F.ws + WS_HID)};
    pg8::gemm_phase<EpiP7, MoeOrder, true>(F.lds + RING_OFF, S, E, D, D, D);
}
__device__ __forceinline__ void ph_p8(Frame& F, int l) { LAUNDER(F);
    const int nun = moe_setup(F, l, false);
    LAS int* rows = (LAS int*)(F.lds + ROWS_OFF);
    MoeOrder S{nun, rows + 11 * 256, rows, (const char*)(F.ws + WS_HID), (const char*)(F.ws + WS_WD) + (size_t)l * NE * 1024 * 512 * 2, (size_t)256 * DE * 2, (size_t)1024 * 512 * 2, (size_t)256 * 512 * 2};
    EpiP8 E{(bf16*)(F.ws + WS_YB), (const int*)(F.ws + WS_ROWTOK), (const float*)(F.ws + WS_ROWGATE)};
    pg8::gemm_phase<EpiP8, MoeOrder, false>(F.lds + RING_OFF, S, E, DE, DE, DE);
}
__device__ __forceinline__ void ph_ln2(Frame& F, int l) { LAUNDER(F);
    const int gw = F.vcu * NWAVES + F.wave, NGW = F.G * NWAVES;
    bf16* hb = (l == DEPTH - 1) ? nullptr : (bf16*)(F.ws + WS_HB);
    for (int m = gw; m < T; m += NGW) { f32x4 o[4]; ln_row<2>(nullptr, F.h, hb, (const bf16*)(F.ws + WS_YB), F.in[21] + l * D, F.in[22] + l * D, (size_t)m, F.lane, o); }
}

__device__ __forceinline__ void ph_att(Frame& F, int l) { (void)F; (void)l; }

constexpr int NSTEPS = 1 + DEPTH * 16;
__global__ void __launch_bounds__(NTHREADS, 2) mk_fwd(Args args) {
    extern __shared__ __attribute__((aligned(16))) unsigned char lds[];
    Frame F;
    F.lds = (LAS unsigned char*)lds; F.tid = threadIdx.x; F.lane = F.tid & 63; F.wave = __builtin_amdgcn_readfirstlane(F.tid >> 6);
    F.G = gridDim.x; { const int bx = blockIdx.x; F.vcu = (F.G % 8 == 0) ? (bx % 8) * (F.G / 8) + bx / 8 : bx; }
    F.in = args.in; F.h = args.out; F.ws = args.ws;
    volatile LAS unsigned* MISC = (volatile LAS unsigned*)(F.lds + MISC_OFF);
    if (F.tid < 32) MISC[F.tid] = 0u;
    __syncthreads();
    const int lo = args.s_lo, hi = args.s_hi;
    XcdBarrier bar; bar.bar = (unsigned*)(F.ws + WS_CTL) + CW_BAR; bar.x = 0; bar.st = nullptr;
    if (hi - lo > 1) bar = xcd_barrier_post((unsigned*)(F.ws + WS_CTL) + CW_BAR, MISC + 8);
#define RUN(s) (lo <= (s) && (s) < hi)
#define SEAM(s) do { if (RUN(s) && RUN((s) + 1)) xcd_barrier(bar); } while (0)
    if (RUN(0)) { ph_prologue(F); ph_ln0(F); }
    SEAM(0);
    for (int l = 0; l < DEPTH; ++l) {
        const int sb = 1 + l * 16;
        for (int c = 0; c < NCHUNK; ++c) {
            const int s = sb + c * 6;
            if (RUN(s)) ph_p1(F, l, c);
            SEAM(s);
            if (RUN(s + 1)) ph_att(F, l);
            SEAM(s + 1);
            if (RUN(s + 2)) ph_cmb(F);
            SEAM(s + 2);
            if (RUN(s + 3)) ph_p3(F, l);
            SEAM(s + 3);
            if (RUN(s + 4)) ph_p4(F, l, c);
            SEAM(s + 4);
            if (RUN(s + 5)) ph_ln1(F, l, c);
            SEAM(s + 5);
        }
        if (RUN(sb + 12)) ph_dsp(F, l);
        SEAM(sb + 12);
        if (RUN(sb + 13)) ph_p7(F, l);
        SEAM(sb + 13);
        if (RUN(sb + 14)) ph_p8(F, l);
        SEAM(sb + 14);
        if (RUN(sb + 15)) ph_ln2(F, l);
        SEAM(sb + 15);
    }
#undef RUN
#undef SEAM
}

#ifndef FAST_MASK
#define FAST_MASK 0x7FB
#endif
#ifndef ONE_LAUNCH
#define ONE_LAUNCH 0
#endif
extern "C" void kernel_launch(void* const* d_in, const int* in_sizes, int n_in, void* d_out, int out_size, void* d_ws, size_t ws_size, hipStream_t stream) {
    static int grid = 0;
    if (grid == 0) {
        if (n_in != 23 || out_size != T * D || ws_size < WS_END) { fprintf(stderr, "kernel_launch: unexpected shapes (n_in %d out %d ws %zu)\n", n_in, out_size, ws_size); grid = -1; return; }
        int dev = 0, cus = 0, per_cu = 0;
        if (hipGetDevice(&dev) != hipSuccess || hipDeviceGetAttribute(&cus, hipDeviceAttributeMultiprocessorCount, dev) != hipSuccess) { grid = -1; return; }
        if (hipFuncSetAttribute((const void*)mk_fwd, hipFuncAttributeMaxDynamicSharedMemorySize, LDS_BYTES) != hipSuccess) { fprintf(stderr, "kernel_launch: hipFuncSetAttribute failed\n"); grid = -1; return; }
        if (hipOccupancyMaxActiveBlocksPerMultiprocessor(&per_cu, (const void*)mk_fwd, NTHREADS, LDS_BYTES) != hipSuccess || per_cu < 1) fprintf(stderr, "kernel_launch: occupancy query reports %d\n", per_cu);
        (void)hipGetLastError();
        grid = cus;
    }
    if (grid < 0) return;
    const float* x = (const float*)d_in[0]; const float* ln0_g = (const float*)d_in[1]; const float* ln0_b = (const float*)d_in[2]; const float* rel_bias = (const float*)d_in[3];
    const float* w_in = (const float*)d_in[4]; const float* b_gate = (const float*)d_in[5]; const float* sink_a = (const float*)d_in[6]; const float* rpb_c = (const float*)d_in[7];
    const float* w_br_a = (const float*)d_in[8]; const float* w_br_b = (const float*)d_in[9]; const float* w_br_c = (const float*)d_in[10]; const float* w_out = (const float*)d_in[11];
    const float* ln1_g = (const float*)d_in[12]; const float* ln1_b = (const float*)d_in[13]; const float* w_rg = (const float*)d_in[14]; const float* b_rg = (const float*)d_in[15];
    const float* w_re = (const float*)d_in[16]; const float* b_re = (const float*)d_in[17]; const float* w_eg = (const float*)d_in[18]; const float* w_eu = (const float*)d_in[19];
    const float* w_ed = (const float*)d_in[20]; const float* ln2_g = (const float*)d_in[21]; const float* ln2_b = (const float*)d_in[22];
    unsigned char* ws = (unsigned char*)d_ws; float* h = (float*)d_out;
    bf16* hb = (bf16*)(ws + WS_HB); bf16* qkv = (bf16*)(ws + WS_QKV); bf16* gates = (bf16*)(ws + WS_GATES); bf16* oabc = (bf16*)(ws + WS_OABC); bf16* og = (bf16*)(ws + WS_OG);
    float* lse = (float*)(ws + WS_LSE); Rec* rec = (Rec*)(ws + WS_REC); int* rowtok = (int*)(ws + WS_ROWTOK); float* rowgate = (float*)(ws + WS_ROWGATE);
    bf16* merged = (bf16*)(ws + WS_MERGED); bf16* hid = (bf16*)(ws + WS_HID); bf16* yb = (bf16*)(ws + WS_YB); int* cnt = (int*)(ws + WS_CTL) + CW_CNT;
    (void)hipMemsetAsync(ws + WS_CTL, 0, CTL_ZERO_BYTES, stream);
    Args a{};
    for (int i = 0; i < 23; ++i) a.in[i] = (const float*)d_in[i];
    a.out = h; a.ws = ws;
    if (ONE_LAUNCH) { a.s_lo = 0; a.s_hi = NSTEPS; hipLaunchKernelGGL(mk_fwd, dim3(grid), dim3(NTHREADS), LDS_BYTES, stream, a); return; }
    const int G = 2048;
    const bool fastp1 = (FAST_MASK >> 1) & 1;
    for (int s = 0; s < NSTEPS; ++s) {
        int kind, l = 0, c = 0;
        if (s == 0) kind = 0; else { const int r = (s - 1) % 16; l = (s - 1) / 16; if (r < 12) { c = r / 6; kind = 1 + r % 6; } else kind = 7 + (r - 12); }
        if ((FAST_MASK >> kind) & 1) { a.s_lo = s; a.s_hi = s + 1; hipLaunchKernelGGL(mk_fwd, dim3(grid), dim3(NTHREADS), LDS_BYTES, stream, a); continue; }
        const size_t r0 = (size_t)c * CH;
        switch (kind) {
        case 0: k_ln<<<G, 256, 0, stream>>>(0, x, h, hb, nullptr, ln0_g, ln0_b, 0, T); break;
        case 1: k_p1<<<G, 256, 0, stream>>>(hb + r0 * D, w_in + (size_t)l * D * NCOL, b_gate + (size_t)l * GATEW, qkv, gates); break;
        case 2: k_attn_naive<<<(28 * CH + 255) / 256, 256, 0, stream>>>(qkv, oabc, og, lse, rel_bias, sink_a + l * 8, rpb_c + (size_t)l * 8 * 15 * 31, fastp1 ? LN2 : 0.125f); break;
        case 3: k_combine<<<(CH * 32 + 255) / 256, 256, 0, stream>>>(og, lse, oabc); break;
        case 4: k_p3<<<G, 256, 0, stream>>>(oabc, gates, w_br_a + (size_t)l * 512 * D, w_br_b + (size_t)l * 256 * D, w_br_c + (size_t)l * 512 * D, merged); break;
        case 5: k_p4<<<G, 256, 0, stream>>>(merged, w_out + (size_t)l * D * D, h + r0 * D); break;
        case 6: k_ln<<<G, 256, 0, stream>>>(1, nullptr, h, hb, nullptr, ln1_g + l * D, ln1_b + l * D, (int)r0, CH);
                if (c == NCHUNK - 1) k_router<<<G, 256, 0, stream>>>(h, w_rg + (size_t)l * D * 4, b_rg + l * 4, w_re + (size_t)l * 4 * D * 8, b_re + l * 32, cnt + l * 32, rec);
                break;
        case 7: (void)hipMemsetAsync(rowtok, 0xFF, (size_t)PROWS * 4, stream); k_dispatch<<<256, 256, 0, stream>>>(cnt + l * 32, rec, rowtok, rowgate); break;
        case 8: k_p7<<<G, 256, 0, stream>>>(hb, cnt + l * 32, rowtok, w_eg + (size_t)l * NE * D * DE, w_eu + (size_t)l * NE * D * DE, hid); break;
        case 9: k_p8<<<G, 256, 0, stream>>>(hid, cnt + l * 32, rowtok, rowgate, w_ed + (size_t)l * NE * DE * D, yb); break;
        case 10: k_ln<<<G, 256, 0, stream>>>(2, nullptr, h, (l == DEPTH - 1) ? nullptr : hb, yb, ln2_g + l * D, ln2_b + l * D, 0, T); break;
        }
    }
}
```

```cpp
#include <hip/hip_runtime.h>
#include <cstdio>
#include <cstdint>
#include <cmath>

typedef unsigned short bf16;
typedef short bf16x8 __attribute__((ext_vector_type(8)));
typedef float f32x16 __attribute__((ext_vector_type(16)));
typedef float f32x4 __attribute__((ext_vector_type(4)));

constexpr int D = 1024, L = 8192, NBATCH = 8, T = NBATCH * L, DEPTH = 2;
constexpr int NCOL = 7680, QKVW = 4608, GATEW = 3072;
constexpr int CH = 32768, NCHUNK = T / CH;
constexpr int OW = 1280;
constexpr int NE = 32, DE = 512;
constexpr int MAXRT = T * 2 / 256 + NE, PROWS = MAXRT * 256;
constexpr float LN_EPS = 1e-5f;
constexpr float ALPHA = 1.41421356237309515f;
constexpr int AQ = 0, AK = 512, AV = 640, BQ0 = 768, CQ = 3072, CK = 3584, CV = 4096;

constexpr size_t MiB = 1u << 20;
constexpr size_t WS_CTL = 0;
constexpr size_t WS_WIN = 1 * MiB, WS_WBRA = 31 * MiB, WS_WBRB = 33 * MiB, WS_WBRC = 34 * MiB, WS_WOUT = 36 * MiB, WS_WGU = 40 * MiB, WS_WD = 168 * MiB;
constexpr size_t WS_HB = 232 * MiB, WS_QKV = 360 * MiB, WS_GATES = 648 * MiB, WS_OABC = 840 * MiB, WS_OG = 920 * MiB, WS_LSE = 968 * MiB,
                 WS_REC = 970 * MiB, WS_ROWTOK = 972 * MiB, WS_ROWGATE = 973 * MiB, WS_TABA = 974 * MiB, WS_TABB = WS_TABA + 16384, WS_TABC = WS_TABA + 32768, WS_END = 975 * MiB;
constexpr size_t WS_MERGED = WS_QKV, WS_HID = WS_QKV, WS_YB = WS_QKV + 136 * MiB;

__device__ __constant__ signed char BUCK_A[257] = {12,11,11,11,11,11,11,11,11,11,11,11,11,11,11,11,11,11,11,11,11,11,11,11,11,11,11,11,11,11,11,11,11,11,11,11,11,11,11,11,11,11,11,11,11,11,11,11,11,11,11,11,11,11,11,11,11,11,11,11,11,11,11,11,11,10,10,10,10,10,10,10,10,10,10,10,10,10,10,10,10,10,10,10,10,10,10,10,10,10,10,10,10,10,10,10,10,9,9,9,9,9,9,9,9,9,9,9,9,9,9,9,9,8,8,8,8,8,8,8,8,7,6,5,4,3,2,1,0,17,18,19,20,21,22,23,24,24,24,24,24,24,24,24,25,25,25,25,25,25,25,25,25,25,25,25,25,25,25,25,26,26,26,26,26,26,26,26,26,26,26,26,26,26,26,26,26,26,26,26,26,26,26,26,26,26,26,26,26,26,26,26,27,27,27,27,27,27,27,27,27,27,27,27,27,27,27,27,27,27,27,27,27,27,27,27,27,27,27,27,27,27,27,27,27,27,27,27,27,27,27,27,27,27,27,27,27,27,27,27,27,27,27,27,27,27,27,27,27,27,27,27,27,27,27,27,28};
__device__ __constant__ signed char BUCK_B[3][129] = {
 {11,10,10,10,10,10,10,10,10,10,10,10,10,10,10,10,10,10,10,10,10,10,10,10,10,10,10,10,10,10,10,10,10,9,9,9,9,9,9,9,9,9,9,9,9,9,9,9,9,8,8,8,8,8,8,8,8,7,6,5,4,3,2,1,0,17,18,19,20,21,22,23,24,24,24,24,24,24,24,24,25,25,25,25,25,25,25,25,25,25,25,25,25,25,25,25,26,26,26,26,26,26,26,26,26,26,26,26,26,26,26,26,26,26,26,26,26,26,26,26,26,26,26,26,26,26,26,26,27},
 {13,12,12,12,12,12,12,12,12,12,12,12,12,12,12,12,12,12,12,12,12,12,12,12,12,12,12,12,12,12,12,12,12,11,11,11,11,11,11,11,11,11,11,11,11,11,11,11,11,10,10,10,10,10,10,10,10,9,9,9,9,8,8,4,0,20,24,24,25,25,25,25,26,26,26,26,26,26,26,26,27,27,27,27,27,27,27,27,27,27,27,27,27,27,27,27,28,28,28,28,28,28,28,28,28,28,28,28,28,28,28,28,28,28,28,28,28,28,28,28,28,28,28,28,28,28,28,28,29},
 {15,14,14,14,14,14,14,14,14,14,14,14,14,14,14,14,14,14,14,14,14,14,14,14,14,14,14,14,14,14,14,14,14,13,13,13,13,13,13,13,13,13,13,13,13,13,13,13,13,12,12,12,12,12,12,12,12,11,11,11,11,10,10,9,0,25,26,26,27,27,27,27,28,28,28,28,28,28,28,28,29,29,29,29,29,29,29,29,29,29,29,29,29,29,29,29,30,30,30,30,30,30,30,30,30,30,30,30,30,30,30,30,30,30,30,30,30,30,30,30,30,30,30,30,30,30,30,30,31}};

__device__ __forceinline__ float bf2f(bf16 b) { return __uint_as_float(((unsigned)b) << 16); }
__device__ __forceinline__ bf16 f2bf(float f) { unsigned u = __float_as_uint(f); u += 0x7fffu + ((u >> 16) & 1u); return (bf16)(u >> 16); }
__device__ __forceinline__ float wave_sum(float v) {
#pragma unroll
    for (int o = 1; o < 64; o <<= 1) v += __shfl_xor(v, o);
    return v;
}

__global__ __launch_bounds__(256) void k_ln(int mode, const float* src, float* h, bf16* hb, const bf16* yb, const float* g, const float* bta, int row0, int nrows) {
    const int lane = threadIdx.x & 63, wv = blockIdx.x * 4 + (threadIdx.x >> 6), nw = gridDim.x * 4;
    for (int rr = wv; rr < nrows; rr += nw) {
        const size_t row = (size_t)row0 + rr;
        f32x4 v[4];
#pragma unroll
        for (int j = 0; j < 4; ++j) {
            const int c = lane * 4 + 256 * j;
            v[j] = *(const f32x4*)((mode == 0 ? src : h) + row * D + c);
            if (mode == 2) {
                const uint2 a = *(const uint2*)(yb + (row * 2) * D + c), b = *(const uint2*)(yb + (row * 2 + 1) * D + c);
                v[j].x = ALPHA * v[j].x + bf2f((bf16)(a.x & 0xffff)) + bf2f((bf16)(b.x & 0xffff));
                v[j].y = ALPHA * v[j].y + bf2f((bf16)(a.x >> 16)) + bf2f((bf16)(b.x >> 16));
                v[j].z = ALPHA * v[j].z + bf2f((bf16)(a.y & 0xffff)) + bf2f((bf16)(b.y & 0xffff));
                v[j].w = ALPHA * v[j].w + bf2f((bf16)(a.y >> 16)) + bf2f((bf16)(b.y >> 16));
            }
        }
        float s = 0.f;
#pragma unroll
        for (int j = 0; j < 4; ++j) s += (v[j].x + v[j].y) + (v[j].z + v[j].w);
        const float mean = wave_sum(s) * (1.f / D);
        float q = 0.f;
#pragma unroll
        for (int j = 0; j < 4; ++j) { v[j] = v[j] - mean; q += (v[j].x * v[j].x + v[j].y * v[j].y) + (v[j].z * v[j].z + v[j].w * v[j].w); }
        const float rstd = 1.0f / sqrtf(wave_sum(q) * (1.f / D) + LN_EPS);
#pragma unroll
        for (int j = 0; j < 4; ++j) {
            const int c = lane * 4 + 256 * j;
            const f32x4 gg = *(const f32x4*)(g + c), bb = *(const f32x4*)(bta + c);
            const f32x4 o = v[j] * rstd * gg + bb;
            *(f32x4*)(h + row * D + c) = o;
            if (hb) { uint2 w; w.x = (unsigned)f2bf(o.x) | ((unsigned)f2bf(o.y) << 16); w.y = (unsigned)f2bf(o.z) | ((unsigned)f2bf(o.w) << 16); *(uint2*)(hb + row * D + c) = w; }
        }
    }
}

__device__ __forceinline__ void wave_gemm32(const bf16* arow, const float* wcol, int ldw, int K, f32x16& acc) {
    for (int k0 = 0; k0 < K; k0 += 16) {
        const bf16x8 a = *(const bf16x8*)(arow + k0);
        bf16x8 b;
#pragma unroll
        for (int j = 0; j < 8; ++j) b[j] = (short)f2bf(wcol[(size_t)(k0 + j) * ldw]);
        acc = __builtin_amdgcn_mfma_f32_32x32x16_bf16(a, b, acc, 0, 0, 0);
    }
}
#define ACC_ROW(reg, h) (((reg) & 3) + 8 * ((reg) >> 2) + 4 * (h))

__global__ __launch_bounds__(256) void k_p1(const bf16* hbc, const float* w_in, const float* b_gate, bf16* qkv, bf16* gates) {
    const int lane = threadIdx.x & 63, r = lane & 31, hh = lane >> 5;
    const int wv = blockIdx.x * 4 + (threadIdx.x >> 6), nw = gridDim.x * 4;
    const int ntn = NCOL / 32, total = (CH / 32) * ntn;
    for (int tile = wv; tile < total; tile += nw) {
        const int tm = tile / ntn, tn = tile % ntn;
        f32x16 acc; for (int i = 0; i < 16; ++i) acc[i] = 0.f;
        wave_gemm32(hbc + (size_t)(tm * 32 + r) * D + 8 * hh, w_in + (size_t)(8 * hh) * NCOL + tn * 32 + r, NCOL, D, acc);
        const int col = tn * 32 + r;
#pragma unroll
        for (int i = 0; i < 16; ++i) {
            const int row = tm * 32 + ACC_ROW(i, hh);
            if (col < QKVW) qkv[(size_t)row * QKVW + col] = f2bf(acc[i]);
            else { const float z = acc[i] + b_gate[col - QKVW]; gates[(size_t)row * GATEW + (col - QKVW)] = f2bf(1.0f / (1.0f + __expf(-z))); }
        }
    }
}

__global__ __launch_bounds__(256) void k_attn_naive(const bf16* qkv, bf16* oabc, bf16* og, float* lse, const float* rel_bias, const float* sink_l, const float* rpb_l, float sc) {
    const long idx = (long)blockIdx.x * 256 + threadIdx.x;
    if (idx >= (long)28 * CH) return;
    const int ht = (int)(idx / CH), tl = (int)(idx % CH), b = tl / L, t = tl % L;
    const bf16* base = qkv + (size_t)(b * L) * QKVW;
    int qcol, kcol, vcol;
    if (ht < 8) { qcol = AQ + ht * 64; kcol = AK + (ht >> 2) * 64; vcol = AV + (ht >> 2) * 64; }
    else if (ht < 20) { const int g = (ht - 8) >> 2, h = (ht - 8) & 3; qcol = BQ0 + 768 * g + h * 64; kcol = qcol + 256; vcol = qcol + 512; }
    else { const int h = ht - 20; qcol = CQ + h * 64; kcol = CK + h * 64; vcol = CV + h * 64; }
    float q[64], o[64];
    {
        const uint4* qp = (const uint4*)(base + (size_t)t * QKVW + qcol);
#pragma unroll
        for (int c = 0; c < 8; ++c) { const uint4 u = qp[c]; const unsigned w[4] = {u.x, u.y, u.z, u.w};
#pragma unroll
            for (int i = 0; i < 4; ++i) { q[8 * c + 2 * i] = bf2f((bf16)(w[i] & 0xffff)); q[8 * c + 2 * i + 1] = bf2f((bf16)(w[i] >> 16)); } }
    }
#pragma unroll
    for (int i = 0; i < 64; ++i) o[i] = 0.f;
    float m = -1e30f, l = 0.f;
    if (ht < 8) { m = sink_l[ht]; l = 1.f; }
#define PROC_KEY(KT, BIAS) do { \
        const uint4* kp = (const uint4*)(base + (size_t)(KT) * QKVW + kcol); float s = 0.f; \
        _Pragma("unroll") for (int c = 0; c < 8; ++c) { const uint4 u = kp[c]; const unsigned w[4] = {u.x, u.y, u.z, u.w}; \
            _Pragma("unroll") for (int i = 0; i < 4; ++i) { s += q[8 * c + 2 * i] * bf2f((bf16)(w[i] & 0xffff)); s += q[8 * c + 2 * i + 1] * bf2f((bf16)(w[i] >> 16)); } } \
        s = s * sc + (BIAS); const float mn = fmaxf(m, s), corr = __expf(m - mn), p = __expf(s - mn); l = l * corr + p; m = mn; \
        const uint4* vp = (const uint4*)(base + (size_t)(KT) * QKVW + vcol); \
        _Pragma("unroll") for (int c = 0; c < 8; ++c) { const uint4 u = vp[c]; const unsigned w[4] = {u.x, u.y, u.z, u.w}; \
            _Pragma("unroll") for (int i = 0; i < 4; ++i) { o[8 * c + 2 * i] = o[8 * c + 2 * i] * corr + p * bf2f((bf16)(w[i] & 0xffff)); o[8 * c + 2 * i + 1] = o[8 * c + 2 * i + 1] * corr + p * bf2f((bf16)(w[i] >> 16)); } } \
    } while (0)
    if (ht < 8) {
        for (int rel = -128; rel <= 128; ++rel) { const int kt = t + rel; if (kt < 0 || kt >= L) continue;
            const float bias = rel_bias[BUCK_A[rel + 128] * 20 + ht]; PROC_KEY(kt, bias); }
    } else if (ht < 20) {
        const int g = (ht - 8) >> 2, h = (ht - 8) & 3, dil = (g == 0) ? 1 : (g == 1 ? 4 : 16);
        for (int off = -64; off <= 64; ++off) { const int kt = t + off * dil; if (kt < 0 || kt >= L) continue;
            const float bias = rel_bias[BUCK_B[g][off + 64] * 20 + 8 + 4 * g + h]; PROC_KEY(kt, bias); }
    } else {
        const int h = ht - 20, gi = t >> 6, gc = t & 63;
        int rs = gi - 4; rs = rs < 0 ? 0 : (rs > 120 ? 120 : rs);
        int cs = gc - 8; cs = cs < 0 ? 0 : (cs > 48 ? 48 : cs);
        for (int kr = rs; kr < rs + 8; ++kr)
            for (int kc = cs; kc < cs + 16; ++kc) { const float bias = rpb_l[(h * 15 + (kr - gi + 7)) * 31 + (kc - gc + 15)]; const int kt = kr * 64 + kc; PROC_KEY(kt, bias); }
    }
#undef PROC_KEY
    const float inv = 1.0f / l;
    bf16* dst;
    if (ht < 8) dst = oabc + (size_t)tl * OW + ht * 64;
    else if (ht < 20) { const int g = (ht - 8) >> 2, h = (ht - 8) & 3; dst = og + ((size_t)tl * 3 + g) * 256 + h * 64; lse[((size_t)tl * 3 + g) * 4 + h] = m + __logf(l); }
    else dst = oabc + (size_t)tl * OW + 768 + (ht - 20) * 64;
#pragma unroll
    for (int c = 0; c < 8; ++c) { uint4 u;
        u.x = (unsigned)f2bf(o[8 * c + 0] * inv) | ((unsigned)f2bf(o[8 * c + 1] * inv) << 16); u.y = (unsigned)f2bf(o[8 * c + 2] * inv) | ((unsigned)f2bf(o[8 * c + 3] * inv) << 16);
        u.z = (unsigned)f2bf(o[8 * c + 4] * inv) | ((unsigned)f2bf(o[8 * c + 5] * inv) << 16); u.w = (unsigned)f2bf(o[8 * c + 6] * inv) | ((unsigned)f2bf(o[8 * c + 7] * inv) << 16);
        ((uint4*)dst)[c] = u; }
}

__global__ __launch_bounds__(256) void k_combine(const bf16* og, const float* lse, bf16* oabc) {
    const long idx = (long)blockIdx.x * 256 + threadIdx.x;
    if (idx >= (long)CH * 32) return;
    const int tl = (int)(idx >> 5), hc = (int)(idx & 31), h = hc >> 3, c = hc & 7;
    const float l0 = lse[((size_t)tl * 3 + 0) * 4 + h], l1 = lse[((size_t)tl * 3 + 1) * 4 + h], l2 = lse[((size_t)tl * 3 + 2) * 4 + h];
    const float mx = fmaxf(l0, fmaxf(l1, l2)); float w0 = __expf(l0 - mx), w1 = __expf(l1 - mx), w2 = __expf(l2 - mx); const float inv = 1.0f / (w0 + w1 + w2); w0 *= inv; w1 *= inv; w2 *= inv;
    const uint4 a = *(const uint4*)(og + ((size_t)tl * 3 + 0) * 256 + h * 64 + c * 8), b = *(const uint4*)(og + ((size_t)tl * 3 + 1) * 256 + h * 64 + c * 8), d = *(const uint4*)(og + ((size_t)tl * 3 + 2) * 256 + h * 64 + c * 8);
    const unsigned aw[4] = {a.x, a.y, a.z, a.w}, bw[4] = {b.x, b.y, b.z, b.w}, dw[4] = {d.x, d.y, d.z, d.w}; unsigned ow[4];
#pragma unroll
    for (int i = 0; i < 4; ++i) {
        const float lo = w0 * bf2f((bf16)(aw[i] & 0xffff)) + w1 * bf2f((bf16)(bw[i] & 0xffff)) + w2 * bf2f((bf16)(dw[i] & 0xffff));
        const float hi = w0 * bf2f((bf16)(aw[i] >> 16)) + w1 * bf2f((bf16)(bw[i] >> 16)) + w2 * bf2f((bf16)(dw[i] >> 16));
        ow[i] = (unsigned)f2bf(lo) | ((unsigned)f2bf(hi) << 16);
    }
    *(uint4*)(oabc + (size_t)tl * OW + 512 + h * 64 + c * 8) = make_uint4(ow[0], ow[1], ow[2], ow[3]);
}

__global__ __launch_bounds__(256) void k_p3(const bf16* oabc, const bf16* gates, const float* wa, const float* wb, const float* wc, bf16* merged) {
    const int lane = threadIdx.x & 63, r = lane & 31, hh = lane >> 5;
    const int wv = blockIdx.x * 4 + (threadIdx.x >> 6), nw = gridDim.x * 4;
    const int ntn = D / 32, total = (CH / 32) * ntn;
    for (int tile = wv; tile < total; tile += nw) {
        const int tm = tile / ntn, tn = tile % ntn, col = tn * 32 + r;
        f32x16 mg; for (int i = 0; i < 16; ++i) mg[i] = 0.f;
#pragma unroll 1
        for (int br = 0; br < 3; ++br) {
            f32x16 acc; for (int i = 0; i < 16; ++i) acc[i] = 0.f;
            const int koff = br == 0 ? 0 : (br == 1 ? 512 : 768), K = br == 1 ? 256 : 512;
            const float* w = br == 0 ? wa : (br == 1 ? wb : wc);
            wave_gemm32(oabc + (size_t)(tm * 32 + r) * OW + koff + 8 * hh, w + (size_t)(8 * hh) * D + col, D, K, acc);
#pragma unroll
            for (int i = 0; i < 16; ++i) { const int row = tm * 32 + ACC_ROW(i, hh); mg[i] += bf2f(gates[(size_t)row * GATEW + br * 1024 + col]) * acc[i]; }
        }
#pragma unroll
        for (int i = 0; i < 16; ++i) { const int row = tm * 32 + ACC_ROW(i, hh); merged[(size_t)row * D + col] = f2bf(mg[i]); }
    }
}
__global__ __launch_bounds__(256) void k_p4(const bf16* merged, const float* wo, float* hchunk) {
    const int lane = threadIdx.x & 63, r = lane & 31, hh = lane >> 5;
    const int wv = blockIdx.x * 4 + (threadIdx.x >> 6), nw = gridDim.x * 4;
    const int ntn = D / 32, total = (CH / 32) * ntn;
    for (int tile = wv; tile < total; tile += nw) {
        const int tm = tile / ntn, tn = tile % ntn, col = tn * 32 + r;
        f32x16 acc; for (int i = 0; i < 16; ++i) acc[i] = 0.f;
        wave_gemm32(merged + (size_t)(tm * 32 + r) * D + 8 * hh, wo + (size_t)(8 * hh) * D + col, D, D, acc);
#pragma unroll
        for (int i = 0; i < 16; ++i) { const int row = tm * 32 + ACC_ROW(i, hh); float* p = hchunk + (size_t)row * D + col; *p = ALPHA * *p + acc[i]; }
    }
}

struct Rec { int e0, s0, e1, s1; float g0, g1; int pad0, pad1; };
__global__ __launch_bounds__(256) void k_router(const float* h, const float* w_rg, const float* b_rg, const float* w_re, const float* b_re, int* cnt, Rec* rec) {
    const int lane = threadIdx.x & 63, wv = blockIdx.x * 4 + (threadIdx.x >> 6), nw = gridDim.x * 4;
    for (int t = wv; t < T; t += nw) {
        float x[16];
#pragma unroll
        for (int j = 0; j < 4; ++j) { const f32x4 v = *(const f32x4*)(h + (size_t)t * D + lane * 4 + 256 * j); x[4 * j] = v.x; x[4 * j + 1] = v.y; x[4 * j + 2] = v.z; x[4 * j + 3] = v.w; }
        float gl[4] = {0.f, 0.f, 0.f, 0.f};
#pragma unroll
        for (int j = 0; j < 4; ++j)
#pragma unroll
            for (int i = 0; i < 4; ++i) { const f32x4 w = *(const f32x4*)(w_rg + (size_t)(lane * 4 + 256 * j + i) * 4); const float xv = x[4 * j + i]; gl[0] += xv * w.x; gl[1] += xv * w.y; gl[2] += xv * w.z; gl[3] += xv * w.w; }
#pragma unroll
        for (int g = 0; g < 4; ++g) gl[g] = wave_sum(gl[g]) + b_rg[g];
        int gi = 0; float gm = gl[0];
#pragma unroll
        for (int g = 1; g < 4; ++g) if (gl[g] > gm) { gm = gl[g]; gi = g; }
        float gs = 0.f;
#pragma unroll
        for (int g = 0; g < 4; ++g) gs += __expf(gl[g] - gm);
        const float gw = 1.0f / gs;
        float el[8];
#pragma unroll
        for (int e = 0; e < 8; ++e) el[e] = 0.f;
        const float* wre = w_re + (size_t)gi * D * 8;
#pragma unroll
        for (int j = 0; j < 4; ++j)
#pragma unroll
            for (int i = 0; i < 4; ++i) { const float* wp = wre + (size_t)(lane * 4 + 256 * j + i) * 8; const f32x4 w0 = *(const f32x4*)wp, w1 = *(const f32x4*)(wp + 4); const float xv = x[4 * j + i];
                el[0] += xv * w0.x; el[1] += xv * w0.y; el[2] += xv * w0.z; el[3] += xv * w0.w; el[4] += xv * w1.x; el[5] += xv * w1.y; el[6] += xv * w1.z; el[7] += xv * w1.w; }
#pragma unroll
        for (int e = 0; e < 8; ++e) el[e] = wave_sum(el[e]) + b_re[gi * 8 + e];
        int i0 = 0; float t0 = el[0];
#pragma unroll
        for (int e = 1; e < 8; ++e) if (el[e] > t0) { t0 = el[e]; i0 = e; }
        int i1 = -1; float t1 = -3.0e38f;
#pragma unroll
        for (int e = 0; e < 8; ++e) if (e != i0 && el[e] > t1) { t1 = el[e]; i1 = e; }
        const float ex = __expf(t1 - t0), p0 = 1.0f / (1.0f + ex), p1 = ex / (1.0f + ex);
        if (lane == 0) {
            Rec rc; rc.e0 = gi * 8 + i0; rc.e1 = gi * 8 + i1; rc.g0 = gw * p0; rc.g1 = gw * p1; rc.pad0 = 0; rc.pad1 = 0;
            rc.s0 = atomicAdd(cnt + rc.e0, 1); rc.s1 = atomicAdd(cnt + rc.e1, 1);
            rec[t] = rc;
        }
    }
}
__device__ __forceinline__ void pad_offsets(const int* cnt, int* po) { int acc = 0; for (int e = 0; e < NE; ++e) { po[e] = acc; acc += (cnt[e] + 255) / 256 * 256; } po[NE] = acc; }
__global__ __launch_bounds__(256) void k_dispatch(const int* cnt, const Rec* rec, int* rowtok, float* rowgate) {
    __shared__ int po[NE + 1];
    if (threadIdx.x == 0) pad_offsets(cnt, po);
    __syncthreads();
    for (int t = blockIdx.x * 256 + threadIdx.x; t < T; t += gridDim.x * 256) {
        const Rec rc = rec[t];
        const int d0 = po[rc.e0] + rc.s0, d1 = po[rc.e1] + rc.s1;
        rowtok[d0] = 2 * t; rowgate[d0] = rc.g0; rowtok[d1] = 2 * t + 1; rowgate[d1] = rc.g1;
    }
}
__global__ __launch_bounds__(256) void k_p7(const bf16* hb, const int* cnt, const int* rowtok, const float* w_eg, const float* w_eu, bf16* hid) {
    __shared__ int po[NE + 1];
    if (threadIdx.x == 0) pad_offsets(cnt, po);
    __syncthreads();
    const int lane = threadIdx.x & 63, r = lane & 31, hh = lane >> 5;
    const int wv = blockIdx.x * 4 + (threadIdx.x >> 6), nw = gridDim.x * 4;
    const int ntn = DE / 32, total = (po[NE] / 32) * ntn;
    for (int tile = wv; tile < total; tile += nw) {
        const int tm = tile / ntn, tn = tile % ntn, col = tn * 32 + r, row0 = tm * 32;
        int e = 0; while (e < NE - 1 && po[e + 1] <= row0) ++e;
        int tok = rowtok[row0 + r]; tok = tok < 0 ? 0 : (tok >> 1);
        f32x16 ag, au; for (int i = 0; i < 16; ++i) { ag[i] = 0.f; au[i] = 0.f; }
        wave_gemm32(hb + (size_t)tok * D + 8 * hh, w_eg + (size_t)e * D * DE + (size_t)(8 * hh) * DE + col, DE, D, ag);
        wave_gemm32(hb + (size_t)tok * D + 8 * hh, w_eu + (size_t)e * D * DE + (size_t)(8 * hh) * DE + col, DE, D, au);
#pragma unroll
        for (int i = 0; i < 16; ++i) { const int row = row0 + ACC_ROW(i, hh); const float gsl = ag[i] / (1.0f + __expf(-ag[i])); hid[(size_t)row * DE + col] = f2bf(gsl * au[i]); }
    }
}
__global__ __launch_bounds__(256) void k_p8(const bf16* hid, const int* cnt, const int* rowtok, const float* rowgate, const float* w_ed, bf16* yb) {
    __shared__ int po[NE + 1];
    if (threadIdx.x == 0) pad_offsets(cnt, po);
    __syncthreads();
    const int lane = threadIdx.x & 63, r = lane & 31, hh = lane >> 5;
    const int wv = blockIdx.x * 4 + (threadIdx.x >> 6), nw = gridDim.x * 4;
    const int ntn = D / 32, total = (po[NE] / 32) * ntn;
    for (int tile = wv; tile < total; tile += nw) {
        const int tm = tile / ntn, tn = tile % ntn, col = tn * 32 + r, row0 = tm * 32;
        int e = 0; while (e < NE - 1 && po[e + 1] <= row0) ++e;
        f32x16 acc; for (int i = 0; i < 16; ++i) acc[i] = 0.f;
        wave_gemm32(hid + (size_t)(row0 + r) * DE + 8 * hh, w_ed + (size_t)e * DE * D + (size_t)(8 * hh) * D + col, D, DE, acc);
#pragma unroll
        for (int i = 0; i < 16; ++i) { const int row = row0 + ACC_ROW(i, hh); const int rt = rowtok[row]; if (rt >= 0) yb[(size_t)rt * D + col] = f2bf(acc[i] * rowgate[row]); }
    }
}


namespace pg8 {
#define PG8_LAS __attribute__((address_space(3)))
typedef unsigned short bf16_t;
typedef unsigned u32x4 __attribute__((ext_vector_type(4)));
constexpr int BM = 256, BK = 64, HALF = 128, HTB = HALF * BK * 2  , STAGE_BYTES = 8 * HTB, NXCD = 8, WGM = 8;

__host__ __device__ __forceinline__ int lds_byte(int r, int c) { const int st = (r >> 4) * 2 + (c >> 5), rr = r & 15, cc = c & 31, ob = rr * 64 + cc * 2; return st * 1024 + (ob ^ (((ob >> 9) & 1) << 5)); }
__host__ __device__ __forceinline__ void stage_rc(int b, int& R, int& C) { const int st = b / 1024, sb = b % 1024, swz = sb ^ (((sb >> 9) & 1) << 5); R = (st >> 1) * 16 + swz / 64; C = (st & 1) * 32 + (swz % 64) / 2; }
__host__ __device__ __forceinline__ int perm32(int rho) { const int n = rho >> 4, i = rho & 15; return 8 * (i >> 2) + 4 * n + (i & 3); }

struct Unit { int pm, pn, e, ui; };

struct DenseOrder {
    int nM, nN, nwg, G, c; const char* A; const char* B; size_t tstepA, tstepB;
    __device__ void init(const void* A_, int lda, const void* B_, int ldb, int M, int N, int G_, int c_) { nM = M / BM; nN = N / BM; nwg = nM * nN; G = G_; c = c_; A = (const char*)A_; B = (const char*)B_; tstepA = (size_t)BM * lda * 2; tstepB = (size_t)BM * ldb * 2; }
    __device__ bool next(int i, Unit& u) const {
        const long Lx = (long)i * G + c; if (Lx >= nwg) return false;
        int wgid = (int)Lx; { const int q = nwg / NXCD, r = nwg % NXCD, xcd = wgid % NXCD, off = wgid / NXCD; wgid = (xcd < r ? xcd * (q + 1) : r * (q + 1) + (xcd - r) * q) + off; }
        const int nig = WGM * nN, gid = wgid / nig, fm = gid * WGM, gsz = (nM - fm) < WGM ? (nM - fm) : WGM;
        u.pm = fm + ((wgid % nig) % gsz); u.pn = (wgid % nig) / gsz; u.e = 0; u.ui = i; return true;
    }
    __device__ __forceinline__ const char* a_base(const Unit& u) const { return A + (size_t)u.pm * tstepA; }
    __device__ __forceinline__ const char* b_base(const Unit& u) const { return B + (size_t)u.pn * tstepB; }
    __device__ __forceinline__ int a_row(const Unit&, int) const { return 0; }
};

__device__ __forceinline__ unsigned cvt_pk_bf16(float lo, float hi) { unsigned r; asm volatile("v_cvt_pk_bf16_f32 %0, %1, %2" : "=v"(r) : "v"(lo), "v"(hi)); return r; }

template <class Epi, class Sched, bool GATHER>
__device__ __forceinline__ void gemm_phase(PG8_LAS unsigned char* lds, const Sched& S, const Epi& E, const int K, const int lda, const int ldb) {
    int tid = threadIdx.x; asm volatile("" : "+v"(tid));
    const int wid = __builtin_amdgcn_readfirstlane(tid >> 6), lane = tid & 63, wr = wid >> 2, wc = wid & 3, fr = lane & 15, fq = lane >> 4;
    const int nt = K / BK;
    int RA[2], CA[2]; unsigned voffB[2];
#pragma unroll
    for (int i = 0; i < 2; ++i) { int R, C; stage_rc(tid * 16 + i * 8192, R, C); const int Rb = Epi::PERM ? ((R & ~31) + perm32(R & 31)) : R; RA[i] = R; CA[i] = C; voffB[i] = (unsigned)(Rb * ldb + C) * 2u; }
    const size_t kstep = (size_t)(BK * 2);
    const size_t hstepB = (size_t)HALF * ldb * 2;
    const unsigned ldsw = (unsigned)wid * 1024u;
    const int aoff = lds_byte(wr * 64 + fr, fq * 8), boff = lds_byte(wc * 32 + fr, fq * 8);
#define PG8_SA(b, h) (((b) * 2 + (h)) * HTB)
#define PG8_SB(b, h) ((4 + (b) * 2 + (h)) * HTB)
#define PG8_STAGE2(bufoff, gbase, v0, v1) do { \
        __builtin_amdgcn_global_load_lds((const unsigned*)((const char*)(gbase) + (v0)), (PG8_LAS unsigned*)(lds + (bufoff) + ldsw), 16, 0, 0); \
        __builtin_amdgcn_global_load_lds((const unsigned*)((const char*)(gbase) + (v1)), (PG8_LAS unsigned*)(lds + (bufoff) + ldsw + 8192), 16, 0, 0); } while (0)
#define PG8_STAGEB(bufoff, gbase) PG8_STAGE2(bufoff, gbase, voffB[0], voffB[1])
#define PG8_LDA(dst, b, h) do { _Pragma("unroll") for (int m = 0; m < 4; ++m) _Pragma("unroll") for (int k = 0; k < 2; ++k) dst[m][k] = *(const PG8_LAS bf16x8*)(lds + PG8_SA(b, h) + aoff + m * 2048 + k * 1024); } while (0)
#define PG8_LDB(dst, b, h) do { _Pragma("unroll") for (int n = 0; n < 2; ++n) _Pragma("unroll") for (int k = 0; k < 2; ++k) dst[n][k] = *(const PG8_LAS bf16x8*)(lds + PG8_SB(b, h) + boff + n * 2048 + k * 1024); } while (0)
#define PG8_MMA(ai, bj, At, Bt) do { __builtin_amdgcn_s_setprio(1); _Pragma("unroll") for (int m = 0; m < 4; ++m) _Pragma("unroll") for (int n = 0; n < 2; ++n) _Pragma("unroll") for (int k = 0; k < 2; ++k) \
        acc[ai][bj][m][n] = __builtin_amdgcn_mfma_f32_16x16x32_bf16(Bt[n][k], At[m][k], acc[ai][bj][m][n], 0, 0, 0); __builtin_amdgcn_s_setprio(0); } while (0)
#define PG8_WAIT_V(n) asm volatile("s_waitcnt vmcnt(" #n ")" ::: "memory")
#define PG8_WAIT_L(n) asm volatile("s_waitcnt lgkmcnt(" #n ")" ::: "memory")
#define PG8_BAR __builtin_amdgcn_s_barrier()
#define PG8_SCHED __builtin_amdgcn_sched_barrier(0)
#define PG8_VOFFA(dst, u) do { _Pragma("unroll") for (int h_ = 0; h_ < 2; ++h_) _Pragma("unroll") for (int i_ = 0; i_ < 2; ++i_) { \
        const int row_ = GATHER ? S.a_row(u, h_ * HALF + RA[i_]) : (h_ * HALF + RA[i_]); dst[h_][i_] = (unsigned)(row_ * lda + CA[i_]) * 2u; } } while (0)
    Unit cur, nxt;
    if (!S.next(0, cur)) return;
    f32x4 acc[2][2][4][2];
#pragma unroll
    for (int a = 0; a < 2; ++a)
#pragma unroll
        for (int b = 0; b < 2; ++b)
#pragma unroll
            for (int m = 0; m < 4; ++m)
#pragma unroll
                for (int n = 0; n < 2; ++n) acc[a][b][m][n] = (f32x4){0.f, 0.f, 0.f, 0.f};
    bf16x8 At[4][2], B0[2][2], B1[2][2];
    unsigned vc[2][2], vn[2][2];
    PG8_VOFFA(vc, cur);
    const char* cA = S.a_base(cur); const char* cB = S.b_base(cur);
    PG8_STAGEB(PG8_SB(0, 0), cB); PG8_STAGEB(PG8_SB(0, 1), cB + hstepB); PG8_STAGE2(PG8_SA(0, 0), cA, vc[0][0], vc[0][1]); PG8_STAGE2(PG8_SA(0, 1), cA, vc[1][0], vc[1][1]);
    if (wr == 1) PG8_BAR;
    PG8_WAIT_V(2); PG8_BAR;
    PG8_STAGEB(PG8_SB(1, 0), cB + kstep); PG8_STAGE2(PG8_SA(1, 0), cA + kstep, vc[0][0], vc[0][1]); PG8_STAGEB(PG8_SB(1, 1), cB + hstepB + kstep);
    PG8_WAIT_V(6); PG8_BAR;
    int ui = 0;
    for (;;) {
        const bool has_next = S.next(ui + 1, nxt);
        const char* nA = has_next ? S.a_base(nxt) : cA; const char* nB = has_next ? S.b_base(nxt) : cB;
        if (GATHER) { if (has_next) { PG8_VOFFA(vn, nxt); } else {
#pragma unroll
            for (int h_ = 0; h_ < 2; ++h_) { vn[h_][0] = vc[h_][0]; vn[h_][1] = vc[h_][1]; } } }
        for (int t = 0; t < nt; t += 2) {
            const bool last = (t == nt - 2);
            const char* a1 = cA + (size_t)(t + 1) * kstep;
            const char* a2 = last ? nA : cA + (size_t)(t + 2) * kstep; const char* b2 = last ? nB : cB + (size_t)(t + 2) * kstep;
            const char* a3 = a2 + kstep; const char* b3 = b2 + kstep;
            unsigned w00, w01, w10, w11;
            if (GATHER) { w00 = last ? vn[0][0] : vc[0][0]; w01 = last ? vn[0][1] : vc[0][1]; w10 = last ? vn[1][0] : vc[1][0]; w11 = last ? vn[1][1] : vc[1][1]; }
            else { w00 = vc[0][0]; w01 = vc[0][1]; w10 = vc[1][0]; w11 = vc[1][1]; }
            PG8_LDB(B0, 0, 0); PG8_LDB(B1, 0, 1); PG8_SCHED; PG8_LDA(At, 0, 0); PG8_STAGE2(PG8_SA(1, 1), a1, vc[1][0], vc[1][1]);
            PG8_WAIT_V(8); PG8_WAIT_L(0); PG8_BAR; PG8_MMA(0, 0, At, B0); PG8_MMA(0, 1, At, B1); PG8_BAR; PG8_SCHED;
            PG8_LDA(At, 0, 1); PG8_STAGEB(PG8_SB(0, 0), b2); PG8_STAGEB(PG8_SB(0, 1), b2 + hstepB); PG8_STAGE2(PG8_SA(0, 0), a2, w00, w01);
            PG8_WAIT_V(8); PG8_WAIT_L(0); PG8_BAR; PG8_MMA(1, 0, At, B0); PG8_MMA(1, 1, At, B1); PG8_BAR; PG8_SCHED;
            PG8_LDB(B0, 1, 0); PG8_LDB(B1, 1, 1); PG8_SCHED; PG8_LDA(At, 1, 0); PG8_STAGE2(PG8_SA(0, 1), a2, w10, w11);
            PG8_WAIT_V(8); PG8_WAIT_L(0); PG8_BAR; PG8_MMA(0, 0, At, B0); PG8_MMA(0, 1, At, B1); PG8_BAR; PG8_SCHED;
            PG8_LDA(At, 1, 1); PG8_STAGEB(PG8_SB(1, 0), b3); PG8_STAGEB(PG8_SB(1, 1), b3 + hstepB); PG8_STAGE2(PG8_SA(1, 0), a3, w00, w01);
            PG8_WAIT_V(8); PG8_WAIT_L(0); PG8_BAR; PG8_MMA(1, 0, At, B0); PG8_MMA(1, 1, At, B1); PG8_BAR; PG8_SCHED;
        }
        if (wr == 0) PG8_BAR;
        E(acc, cur, wr, wc, fr, fq);
        if (!has_next) break;
#pragma unroll
        for (int a = 0; a < 2; ++a)
#pragma unroll
            for (int b = 0; b < 2; ++b)
#pragma unroll
                for (int m = 0; m < 4; ++m)
#pragma unroll
                    for (int n = 0; n < 2; ++n) acc[a][b][m][n] = (f32x4){0.f, 0.f, 0.f, 0.f};
        cur = nxt; cA = nA; cB = nB; ++ui;
        if (GATHER) {
#pragma unroll
            for (int h_ = 0; h_ < 2; ++h_) { vc[h_][0] = vn[h_][0]; vc[h_][1] = vn[h_][1]; } }
        if (wr == 1) PG8_BAR;
    }
    PG8_WAIT_V(0);
    PG8_BAR;
#undef PG8_SA
#undef PG8_SB
#undef PG8_STAGE2
#undef PG8_STAGEB
#undef PG8_LDA
#undef PG8_LDB
#undef PG8_MMA
#undef PG8_WAIT_V
#undef PG8_WAIT_L
#undef PG8_BAR
#undef PG8_SCHED
#undef PG8_VOFFA
}
}

constexpr int NWAVES = 8, NTHREADS = 512;
constexpr int RING_OFF = 0, RING_BYTES = 131072, ROWS_OFF = 131072, ROWS_BYTES = 12288, MISC_OFF = ROWS_OFF + ROWS_BYTES, LDS_BYTES = 147456;
static_assert(MISC_OFF + 128 <= LDS_BYTES, "LDS map");
constexpr int CW_CNT = 0;
constexpr int CW_BAR = 4096;
constexpr size_t CTL_ZERO_BYTES = 64 * 1024;
constexpr float LOG2E = 1.4426950408889634f, LN2 = 0.6931471805599453f;
constexpr float QSCALE = 0.125f * LOG2E;

#define GAS __attribute__((address_space(1)))
#define LAS __attribute__((address_space(3)))
typedef unsigned v4u __attribute__((ext_vector_type(4)));
typedef unsigned v2u __attribute__((ext_vector_type(2)));
#define LDS_WAIT() asm volatile("s_waitcnt lgkmcnt(0)" ::: "memory")
__device__ __forceinline__ unsigned pk2(float lo, float hi) { return (unsigned)f2bf(lo) | ((unsigned)f2bf(hi) << 16); }

#define XB_TMO      128
#define XB_XCNT(j)  (256  + 64 * (j))
#define XB_XSUB(j)  (1280 + 64 * (j))
#define XB_XGEN(j)  (2304 + 64 * (j))
#define XB_TOP      3328
#define XB_TOPGEN   3392
#define XCD_BAR_WORDS 3456
#define XB_SPIN_CAP (1u << 18)

__device__ __forceinline__ unsigned xb_ld(unsigned* p)              { return __hip_atomic_load(p, __ATOMIC_RELAXED, __HIP_MEMORY_SCOPE_AGENT); }
__device__ __forceinline__ unsigned xb_add(unsigned* p, unsigned v) { return __hip_atomic_fetch_add(p, v, __ATOMIC_RELAXED, __HIP_MEMORY_SCOPE_AGENT); }
__device__ __forceinline__ unsigned xb_xcc_id() { return (unsigned)__builtin_amdgcn_s_getreg((3 << 11) | 20) & 0xFu; }
#define XB_SPIN(cond, bar) do { unsigned _sp = 0; while (cond) { __builtin_amdgcn_s_sleep(1); \
    if ((++_sp & 255u) == 0u) { if (xb_ld(&(bar)[XB_TMO])) break; if (_sp > XB_SPIN_CAP) { atomicAdd(&(bar)[XB_TMO], 1u); break; } } } } while (0)

struct XcdBarrier {
    unsigned* bar; unsigned x;
    volatile LAS unsigned* st;
};

__device__ __forceinline__ XcdBarrier xcd_barrier_post(unsigned* bar, volatile LAS unsigned* st) {
    XcdBarrier b; b.bar = bar; b.x = xb_xcc_id(); b.st = st;
    if (threadIdx.x == 0) (void)xb_add(&bar[XB_XCNT(b.x)], 1u);
    return b;
}
__device__ __forceinline__ void xcd_barrier_complete(unsigned* bar, unsigned x, unsigned& nloc, unsigned& nx) {
    const unsigned G = gridDim.x * gridDim.y * gridDim.z;
    unsigned sum, cnt, mine, sp = 0u;
    for (;;) {
        sum = 0u; cnt = 0u; mine = 0u;
#pragma unroll
        for (unsigned j = 0; j < 16; ++j) { const unsigned c = xb_ld(&bar[XB_XCNT(j)]); sum += c; cnt += (c > 0u) ? 1u : 0u; mine = (j == x) ? c : mine; }
        if (sum == G) break;
        __builtin_amdgcn_s_sleep(1);
        if ((++sp & 255u) == 0u) { if (xb_ld(&bar[XB_TMO])) break; if (sp > XB_SPIN_CAP) { atomicAdd(&bar[XB_TMO], 1u); break; } }
    }
    nloc = mine > 0u ? mine : 1u; nx = cnt > 0u ? cnt : 1u;
}

__device__ __forceinline__ void xcd_barrier(const XcdBarrier& b) {
    asm volatile("s_waitcnt vmcnt(0)" ::: "memory");
    __syncthreads();
    if (threadIdx.x == 0) {
        unsigned* bar = b.bar;
        __builtin_amdgcn_s_waitcnt(0);
        unsigned nloc = b.st[0], nx = b.st[1];
        if (nloc == 0u) { xcd_barrier_complete(bar, b.x, nloc, nx); b.st[0] = nloc; b.st[1] = nx; }
        const unsigned old = xb_add(&bar[XB_XSUB(b.x)], 1u);
        const unsigned gen = old / nloc;
        if (old + 1u == (gen + 1u) * nloc) {
            __builtin_amdgcn_fence(__ATOMIC_RELEASE, "agent");
            asm volatile("s_waitcnt vmcnt(0)" ::: "memory");
            const unsigned og = xb_add(&bar[XB_TOP], 1u);
            const unsigned tg = og / nx;
            if (og + 1u == (tg + 1u) * nx) xb_add(&bar[XB_TOPGEN], 1u);
            else XB_SPIN(xb_ld(&bar[XB_TOPGEN]) == tg, bar);
            __builtin_amdgcn_fence(__ATOMIC_ACQUIRE, "agent");
            xb_add(&bar[XB_XGEN(b.x)], 1u);
            asm volatile("s_waitcnt vmcnt(0)" ::: "memory");
        } else {
            XB_SPIN(xb_ld(&bar[XB_XGEN(b.x)]) == gen, bar);
            __builtin_amdgcn_fence(__ATOMIC_ACQUIRE, "agent");
            asm volatile("s_waitcnt vmcnt(0)" ::: "memory");
        }
    }
    __syncthreads();
}


struct Args { const float* in[23]; float* out; unsigned char* ws; int s_lo, s_hi; };

struct Frame {
    LAS unsigned char* lds; int tid, lane, wave, vcu, G;
    const float* const* in; float* h; unsigned char* ws;
};

#define LAUNDER(F) do { asm volatile("" : "+v"((F).tid)); (F).lane = (F).tid & 63; asm volatile("" : "+s"((F).G), "+s"((F).vcu)); } while (0)
__device__ __forceinline__ void p0_item(const float* W, int ldw, int k0, int n0, bf16* WT, int Kd, int drow0, float scale, LAS float* scr, int lane) {
#pragma unroll 8
    for (int i = 0; i < 32; ++i) { const int kk = 2 * i + (lane >> 5); scr[kk * 33 + (lane & 31)] = W[(size_t)(k0 + kk) * ldw + n0 + (lane & 31)] * scale; }
    LDS_WAIT(); asm volatile("" ::: "memory");
    const int c = lane & 7;
#pragma unroll
    for (int j = 0; j < 4; ++j) { const int n = (lane >> 3) + 8 * j; const LAS float* s = scr + (8 * c) * 33 + n;
        v4u o; o.x = pk2(s[0 * 33], s[1 * 33]); o.y = pk2(s[2 * 33], s[3 * 33]); o.z = pk2(s[4 * 33], s[5 * 33]); o.w = pk2(s[6 * 33], s[7 * 33]);
        *(v4u*)(WT + (size_t)(drow0 + n) * Kd + k0 + 8 * c) = o; }
    LDS_WAIT(); asm volatile("" ::: "memory");
}
__device__ __forceinline__ bool is_q_col(int n) { return n < 512 || (n >= 768 && n < 3072 && ((n - 768) % 768) < 256) || (n >= 3072 && n < 3584); }

__device__ __forceinline__ void ph_prologue(Frame& F) { LAUNDER(F);
    LAS float* scr = (LAS float*)(F.lds + RING_OFF + F.wave * 16384);
    const int gw = F.vcu * NWAVES + F.wave, NGW = F.G * NWAVES, lane = F.lane;
    const float* w_in = F.in[4]; const float* w_a = F.in[8]; const float* w_b = F.in[9]; const float* w_c = F.in[10]; const float* w_o = F.in[11];
    const float* w_eg = F.in[18]; const float* w_eu = F.in[19]; const float* w_ed = F.in[20];
    bf16* WIN = (bf16*)(F.ws + WS_WIN); bf16* WBRA = (bf16*)(F.ws + WS_WBRA); bf16* WBRB = (bf16*)(F.ws + WS_WBRB); bf16* WBRC = (bf16*)(F.ws + WS_WBRC); bf16* WOUT = (bf16*)(F.ws + WS_WOUT);
    bf16* WGU = (bf16*)(F.ws + WS_WGU); bf16* WD = (bf16*)(F.ws + WS_WD);
    constexpr int I_IN = 16 * (NCOL / 32), I_A = 8 * 32, I_B = 4 * 32, I_C = 8 * 32, I_O = 16 * 32, I_G = 16 * 16, I_D = 8 * 32;
    constexpr int I_LAYER = I_IN + I_A + I_B + I_C + I_O + NE * (2 * I_G + I_D);
    for (int it = gw; it < DEPTH * I_LAYER; it += NGW) {
        const int l = it / I_LAYER; int r = it % I_LAYER;
        if (r < I_IN) { const int nb = r % (NCOL / 32), kb = r / (NCOL / 32); p0_item(w_in + (size_t)l * D * NCOL, NCOL, 64 * kb, 32 * nb, WIN + (size_t)l * NCOL * D, D, 32 * nb, is_q_col(32 * nb) ? QSCALE : 1.0f, scr, lane); continue; } r -= I_IN;
        if (r < I_A) { const int nb = r % 32, kb = r / 32; p0_item(w_a + (size_t)l * 512 * D, D, 64 * kb, 32 * nb, WBRA + (size_t)l * D * 512, 512, 32 * nb, 1.0f, scr, lane); continue; } r -= I_A;
        if (r < I_B) { const int nb = r % 32, kb = r / 32; p0_item(w_b + (size_t)l * 256 * D, D, 64 * kb, 32 * nb, WBRB + (size_t)l * D * 256, 256, 32 * nb, 1.0f, scr, lane); continue; } r -= I_B;
        if (r < I_C) { const int nb = r % 32, kb = r / 32; p0_item(w_c + (size_t)l * 512 * D, D, 64 * kb, 32 * nb, WBRC + (size_t)l * D * 512, 512, 32 * nb, 1.0f, scr, lane); continue; } r -= I_C;
        if (r < I_O) { const int nb = r % 32, kb = r / 32; p0_item(w_o + (size_t)l * D * D, D, 64 * kb, 32 * nb, WOUT + (size_t)l * D * D, D, 32 * nb, 1.0f, scr, lane); continue; } r -= I_O;
        const int e = r / (2 * I_G + I_D); r %= (2 * I_G + I_D); const size_t le = (size_t)l * NE + e;
        if (r < 2 * I_G) { const int up = r / I_G; r %= I_G; const int nb = r % 16, kb = r / 16;
            p0_item((up ? w_eu : w_eg) + le * D * DE, DE, 64 * kb, 32 * nb, WGU + le * 1024 * 1024, D, (nb >> 2) * 256 + up * 128 + (nb & 3) * 32, 1.0f, scr, lane); continue; }
        r -= 2 * I_G; { const int nb = r % 32, kb = r / 32; p0_item(w_ed + le * DE * D, D, 64 * kb, 32 * nb, WD + le * D * DE, DE, 32 * nb, 1.0f, scr, lane); }
    }
}

template <int MODE> __device__ __forceinline__ void ln_row(const float* src, float* h, bf16* hb, const bf16* yb, const float* g, const float* bta, size_t row, int lane, f32x4 (&o)[4]) {
    f32x4 v[4];
#pragma unroll
    for (int j = 0; j < 4; ++j) {
        const int c = lane * 4 + 256 * j;
        v[j] = *(const f32x4*)((MODE == 0 ? src : h) + row * D + c);
        if (MODE == 2) {
            const uint2 a = *(const uint2*)(yb + (row * 2) * D + c), b = *(const uint2*)(yb + (row * 2 + 1) * D + c);
            v[j].x = ALPHA * v[j].x + bf2f((bf16)(a.x & 0xffff)) + bf2f((bf16)(b.x & 0xffff));
            v[j].y = ALPHA * v[j].y + bf2f((bf16)(a.x >> 16)) + bf2f((bf16)(b.x >> 16));
            v[j].z = ALPHA * v[j].z + bf2f((bf16)(a.y & 0xffff)) + bf2f((bf16)(b.y & 0xffff));
            v[j].w = ALPHA * v[j].w + bf2f((bf16)(a.y >> 16)) + bf2f((bf16)(b.y >> 16));
        }
    }
    float s = 0.f;
#pragma unroll
    for (int j = 0; j < 4; ++j) s += (v[j].x + v[j].y) + (v[j].z + v[j].w);
    const float mean = wave_sum(s) * (1.f / D);
    float q = 0.f;
#pragma unroll
    for (int j = 0; j < 4; ++j) { v[j] = v[j] - mean; q += (v[j].x * v[j].x + v[j].y * v[j].y) + (v[j].z * v[j].z + v[j].w * v[j].w); }
    const float rstd = 1.0f / sqrtf(wave_sum(q) * (1.f / D) + LN_EPS);
#pragma unroll
    for (int j = 0; j < 4; ++j) {
        const int c = lane * 4 + 256 * j;
        const f32x4 gg = *(const f32x4*)(g + c), bb = *(const f32x4*)(bta + c);
        o[j] = v[j] * rstd * gg + bb;
        *(f32x4*)(h + row * D + c) = o[j];
        if (hb) { uint2 w; w.x = pk2(o[j].x, o[j].y); w.y = pk2(o[j].z, o[j].w); *(uint2*)(hb + row * D + c) = w; }
    }
}

struct EpiP1 {
    static constexpr bool PERM = true;
    bf16* qkv; bf16* gates; const float* b_gate;
    __device__ __forceinline__ void operator()(const f32x4 (&acc)[2][2][4][2], const pg8::Unit& u, int wr, int wc, int fr, int fq) const {
        const int row0 = u.pm * 256 + wr * 64 + fr; const bool isg = u.pn >= 18;
        bf16* base = isg ? gates : qkv; const int ldc = isg ? GATEW : QKVW; const int col0 = (isg ? (u.pn - 18) : u.pn) * 256 + wc * 32 + 8 * fq;
        f32x4 bv[2][2];
#pragma unroll
        for (int bj = 0; bj < 2; ++bj)
#pragma unroll
            for (int n = 0; n < 2; ++n) bv[bj][n] = isg ? *(const f32x4*)(b_gate + col0 + bj * 128 + 4 * n) : (f32x4){0.f, 0.f, 0.f, 0.f};
#pragma unroll
        for (int ai = 0; ai < 2; ++ai)
#pragma unroll
            for (int m = 0; m < 4; ++m) { bf16* rowp = base + (size_t)(row0 + ai * 128 + m * 16) * ldc + col0;
#pragma unroll
                for (int bj = 0; bj < 2; ++bj) { f32x4 v0 = acc[ai][bj][m][0] + bv[bj][0], v1 = acc[ai][bj][m][1] + bv[bj][1];
                    if (isg) {
#pragma unroll
                        for (int j = 0; j < 4; ++j) { v0[j] = __builtin_amdgcn_rcpf(1.0f + __builtin_amdgcn_exp2f(-LOG2E * v0[j])); v1[j] = __builtin_amdgcn_rcpf(1.0f + __builtin_amdgcn_exp2f(-LOG2E * v1[j])); } }
                    v4u w; w.x = pg8::cvt_pk_bf16(v0[0], v0[1]); w.y = pg8::cvt_pk_bf16(v0[2], v0[3]); w.z = pg8::cvt_pk_bf16(v1[0], v1[1]); w.w = pg8::cvt_pk_bf16(v1[2], v1[3]);
                    *(v4u*)(rowp + bj * 128) = w; } }
    }
};
template <bool FIRST> struct EpiP3 {
    static constexpr bool PERM = true;
    bf16* merged; const bf16* gates; int br;
    __device__ __forceinline__ void operator()(const f32x4 (&acc)[2][2][4][2], const pg8::Unit& u, int wr, int wc, int fr, int fq) const {
        const int row0 = u.pm * 256 + wr * 64 + fr, col0 = u.pn * 256 + wc * 32 + 8 * fq;
#pragma unroll
        for (int ai = 0; ai < 2; ++ai)
#pragma unroll
            for (int m = 0; m < 4; ++m) { const size_t row = (size_t)(row0 + ai * 128 + m * 16);
#pragma unroll
                for (int bj = 0; bj < 2; ++bj) {
                    const v4u gw = *(const v4u*)(gates + row * GATEW + br * 1024 + col0 + bj * 128);
                    v4u ow = FIRST ? (v4u){0u, 0u, 0u, 0u} : *(const v4u*)(merged + row * D + col0 + bj * 128);
                    const f32x4 a0 = acc[ai][bj][m][0], a1 = acc[ai][bj][m][1];
                    float r[8];
#pragma unroll
                    for (int j = 0; j < 4; ++j) { const unsigned g2 = gw[j], o2 = ow[j]; const float av0 = j < 2 ? a0[2 * j] : a1[2 * j - 4], av1 = j < 2 ? a0[2 * j + 1] : a1[2 * j - 3];
                        r[2 * j] = __uint_as_float(g2 << 16) * av0 + (FIRST ? 0.f : __uint_as_float(o2 << 16)); r[2 * j + 1] = __uint_as_float(g2 & 0xffff0000u) * av1 + (FIRST ? 0.f : __uint_as_float(o2 & 0xffff0000u)); }
                    v4u w; w.x = pg8::cvt_pk_bf16(r[0], r[1]); w.y = pg8::cvt_pk_bf16(r[2], r[3]); w.z = pg8::cvt_pk_bf16(r[4], r[5]); w.w = pg8::cvt_pk_bf16(r[6], r[7]);
                    *(v4u*)(merged + row * D + col0 + bj * 128) = w; }
                asm volatile("" ::: "memory"); }
    }
};
struct EpiP4 {
    static constexpr bool PERM = false;
    float* hc;
    __device__ __forceinline__ void operator()(const f32x4 (&acc)[2][2][4][2], const pg8::Unit& u, int wr, int wc, int fr, int fq) const {
        const int row0 = u.pm * 256 + wr * 64 + fr, col0 = u.pn * 256 + wc * 32 + 4 * fq;
#pragma unroll
        for (int ai = 0; ai < 2; ++ai)
#pragma unroll
            for (int m = 0; m < 4; ++m) { float* rowp = hc + (size_t)(row0 + ai * 128 + m * 16) * D + col0;
#pragma unroll
                for (int bj = 0; bj < 2; ++bj)
#pragma unroll
                    for (int n = 0; n < 2; ++n) { f32x4* p = (f32x4*)(rowp + bj * 128 + n * 16); *p = *p * ALPHA + acc[ai][bj][m][n]; }
                asm volatile("" ::: "memory"); }
    }
};
struct EpiP7 {
    static constexpr bool PERM = true;
    bf16* hid;
    __device__ __forceinline__ void operator()(const f32x4 (&acc)[2][2][4][2], const pg8::Unit& u, int wr, int wc, int fr, int fq) const {
        const int row0 = u.pm * 256 + wr * 64 + fr, col0 = u.pn * 128 + wc * 32 + 8 * fq;
#pragma unroll
        for (int ai = 0; ai < 2; ++ai)
#pragma unroll
            for (int m = 0; m < 4; ++m) { float r[8];
#pragma unroll
                for (int n = 0; n < 2; ++n)
#pragma unroll
                    for (int j = 0; j < 4; ++j) { const float gv = acc[ai][0][m][n][j], uv = acc[ai][1][m][n][j]; r[4 * n + j] = gv * __builtin_amdgcn_rcpf(1.0f + __builtin_amdgcn_exp2f(-LOG2E * gv)) * uv; }
                v4u w; w.x = pg8::cvt_pk_bf16(r[0], r[1]); w.y = pg8::cvt_pk_bf16(r[2], r[3]); w.z = pg8::cvt_pk_bf16(r[4], r[5]); w.w = pg8::cvt_pk_bf16(r[6], r[7]);
                *(v4u*)(hid + (size_t)(row0 + ai * 128 + m * 16) * DE + col0) = w; }
    }
};
struct EpiP8 {
    static constexpr bool PERM = true;
    bf16* yb; const int* rowtok; const float* rowgate;
    __device__ __forceinline__ void operator()(const f32x4 (&acc)[2][2][4][2], const pg8::Unit& u, int wr, int wc, int fr, int fq) const {
        const int row0 = u.pm * 256 + wr * 64 + fr, col0 = u.pn * 256 + wc * 32 + 8 * fq;
#pragma unroll
        for (int ai = 0; ai < 2; ++ai)
#pragma unroll
            for (int m = 0; m < 4; ++m) { const int row = row0 + ai * 128 + m * 16; const int rt = rowtok[row]; const float gt = rowgate[row];
                if (rt >= 0) {
#pragma unroll
                    for (int bj = 0; bj < 2; ++bj) { const f32x4 v0 = acc[ai][bj][m][0] * gt, v1 = acc[ai][bj][m][1] * gt;
                        v4u w; w.x = pg8::cvt_pk_bf16(v0[0], v0[1]); w.y = pg8::cvt_pk_bf16(v0[2], v0[3]); w.z = pg8::cvt_pk_bf16(v1[0], v1[1]); w.w = pg8::cvt_pk_bf16(v1[2], v1[3]);
                        *(v4u*)(yb + (size_t)rt * D + col0 + bj * 128) = w; } } }
    }
};

__device__ __forceinline__ void router_row(const float (&x)[16], int t, int lane, const float* w_rg, const float* b_rg, const float* w_re, const float* b_re, int* cnt, Rec* rec) {
    float gl[4] = {0.f, 0.f, 0.f, 0.f};
#pragma unroll
    for (int j = 0; j < 4; ++j)
#pragma unroll
        for (int i = 0; i < 4; ++i) { const f32x4 w = *(const f32x4*)(w_rg + (size_t)(lane * 4 + 256 * j + i) * 4); const float xv = x[4 * j + i]; gl[0] += xv * w.x; gl[1] += xv * w.y; gl[2] += xv * w.z; gl[3] += xv * w.w; }
#pragma unroll
    for (int g = 0; g < 4; ++g) gl[g] = wave_sum(gl[g]) + b_rg[g];
    int gi = 0; float gm = gl[0];
#pragma unroll
    for (int g = 1; g < 4; ++g) if (gl[g] > gm) { gm = gl[g]; gi = g; }
    float gs = 0.f;
#pragma unroll
    for (int g = 0; g < 4; ++g) gs += __expf(gl[g] - gm);
    const float gw = 1.0f / gs;
    float el[8];
#pragma unroll
    for (int e = 0; e < 8; ++e) el[e] = 0.f;
    const float* wre = w_re + (size_t)gi * D * 8;
#pragma unroll
    for (int j = 0; j < 4; ++j)
#pragma unroll
        for (int i = 0; i < 4; ++i) { const float* wp = wre + (size_t)(lane * 4 + 256 * j + i) * 8; const f32x4 w0 = *(const f32x4*)wp, w1 = *(const f32x4*)(wp + 4); const float xv = x[4 * j + i];
            el[0] += xv * w0.x; el[1] += xv * w0.y; el[2] += xv * w0.z; el[3] += xv * w0.w; el[4] += xv * w1.x; el[5] += xv * w1.y; el[6] += xv * w1.z; el[7] += xv * w1.w; }
#pragma unroll
    for (int e = 0; e < 8; ++e) el[e] = wave_sum(el[e]) + b_re[gi * 8 + e];
    int i0 = 0; float t0 = el[0];
#pragma unroll
    for (int e = 1; e < 8; ++e) if (el[e] > t0) { t0 = el[e]; i0 = e; }
    int i1 = -1; float t1 = -3.0e38f;
#pragma unroll
    for (int e = 0; e < 8; ++e) if (e != i0 && el[e] > t1) { t1 = el[e]; i1 = e; }
    const float ex = __expf(t1 - t0), p0 = 1.0f / (1.0f + ex), p1 = ex / (1.0f + ex);
    if (lane == 0) {
        Rec rc; rc.e0 = gi * 8 + i0; rc.e1 = gi * 8 + i1; rc.g0 = gw * p0; rc.g1 = gw * p1; rc.pad0 = 0; rc.pad1 = 0;
        rc.s0 = atomicAdd(cnt + rc.e0, 1); rc.s1 = atomicAdd(cnt + rc.e1, 1);
        rec[t] = rc;
    }
}

__device__ __forceinline__ void ph_ln0(Frame& F) { LAUNDER(F);
    const int gw = F.vcu * NWAVES + F.wave, NGW = F.G * NWAVES;
    bf16* hb = (bf16*)(F.ws + WS_HB);
    for (int m = gw; m < T; m += NGW) { f32x4 o[4]; ln_row<0>(F.in[0], F.h, hb, nullptr, F.in[1], F.in[2], (size_t)m, F.lane, o); }
}
__device__ __forceinline__ void ph_p1(Frame& F, int l, int c) { LAUNDER(F);
    pg8::DenseOrder S; S.init((const bf16*)(F.ws + WS_HB) + (size_t)c * CH * D, D, (const bf16*)(F.ws + WS_WIN) + (size_t)l * NCOL * D, D, CH, NCOL, F.G, (int)blockIdx.x);
    EpiP1 E{(bf16*)(F.ws + WS_QKV), (bf16*)(F.ws + WS_GATES), F.in[5] + (size_t)l * GATEW};
    pg8::gemm_phase<EpiP1, pg8::DenseOrder, false>(F.lds + RING_OFF, S, E, D, D, D);
}
__device__ __forceinline__ void ph_cmb(Frame& F) { LAUNDER(F);
    const bf16* og = (const bf16*)(F.ws + WS_OG); const float* lse = (const float*)(F.ws + WS_LSE); bf16* oabc = (bf16*)(F.ws + WS_OABC);
    for (int idx = F.vcu * NTHREADS + F.tid; idx < CH * 32; idx += F.G * NTHREADS) {
        const int tl = idx >> 5, hc = idx & 31, h = hc >> 3, c = hc & 7;
        const float l0 = lse[((size_t)tl * 3 + 0) * 4 + h], l1 = lse[((size_t)tl * 3 + 1) * 4 + h], l2 = lse[((size_t)tl * 3 + 2) * 4 + h];
        const float mx = fmaxf(l0, fmaxf(l1, l2)); float w0 = __expf(l0 - mx), w1 = __expf(l1 - mx), w2 = __expf(l2 - mx); const float inv = 1.0f / (w0 + w1 + w2); w0 *= inv; w1 *= inv; w2 *= inv;
        const v4u a = *(const v4u*)(og + ((size_t)tl * 3 + 0) * 256 + h * 64 + c * 8), b = *(const v4u*)(og + ((size_t)tl * 3 + 1) * 256 + h * 64 + c * 8), d = *(const v4u*)(og + ((size_t)tl * 3 + 2) * 256 + h * 64 + c * 8);
        v4u ow;
#pragma unroll
        for (int i = 0; i < 4; ++i) {
            const float lo = w0 * __uint_as_float(a[i] << 16) + w1 * __uint_as_float(b[i] << 16) + w2 * __uint_as_float(d[i] << 16);
            const float hi = w0 * __uint_as_float(a[i] & 0xffff0000u) + w1 * __uint_as_float(b[i] & 0xffff0000u) + w2 * __uint_as_float(d[i] & 0xffff0000u);
            ow[i] = pk2(lo, hi);
        }
        *(v4u*)(oabc + (size_t)tl * OW + 512 + h * 64 + c * 8) = ow;
    }
}
__device__ __forceinline__ void ph_p3(Frame& F, int l) { LAUNDER(F);
    const bf16* oabc = (const bf16*)(F.ws + WS_OABC); bf16* merged = (bf16*)(F.ws + WS_MERGED); const bf16* gates = (const bf16*)(F.ws + WS_GATES);
    { pg8::DenseOrder S; S.init(oabc, OW, (const bf16*)(F.ws + WS_WBRA) + (size_t)l * D * 512, 512, CH, D, F.G, (int)blockIdx.x);
      EpiP3<true> E{merged, gates, 0}; pg8::gemm_phase<EpiP3<true>, pg8::DenseOrder, false>(F.lds + RING_OFF, S, E, 512, OW, 512); }
    { pg8::DenseOrder S; S.init(oabc + 512, OW, (const bf16*)(F.ws + WS_WBRB) + (size_t)l * D * 256, 256, CH, D, F.G, (int)blockIdx.x);
      EpiP3<false> E{merged, gates, 1}; pg8::gemm_phase<EpiP3<false>, pg8::DenseOrder, false>(F.lds + RING_OFF, S, E, 256, OW, 256); }
    { pg8::DenseOrder S; S.init(oabc + 768, OW, (const bf16*)(F.ws + WS_WBRC) + (size_t)l * D * 512, 512, CH, D, F.G, (int)blockIdx.x);
      EpiP3<false> E{merged, gates, 2}; pg8::gemm_phase<EpiP3<false>, pg8::DenseOrder, false>(F.lds + RING_OFF, S, E, 512, OW, 512); }
}
__device__ __forceinline__ void ph_p4(Frame& F, int l, int c) { LAUNDER(F);
    pg8::DenseOrder S; S.init((const bf16*)(F.ws + WS_MERGED), D, (const bf16*)(F.ws + WS_WOUT) + (size_t)l * D * D, D, CH, D, F.G, (int)blockIdx.x);
    EpiP4 E{F.h + (size_t)c * CH * D};
    pg8::gemm_phase<EpiP4, pg8::DenseOrder, false>(F.lds + RING_OFF, S, E, D, D, D);
}
__device__ __forceinline__ void ph_ln1(Frame& F, int l, int c) { LAUNDER(F);
    const int gw = F.vcu * NWAVES + F.wave, NGW = F.G * NWAVES;
    bf16* hb = (bf16*)(F.ws + WS_HB); int* cnt = (int*)(F.ws + WS_CTL) + CW_CNT + l * 32; Rec* rec = (Rec*)(F.ws + WS_REC);
    for (int m = gw; m < CH; m += NGW) {
        const size_t row = (size_t)c * CH + m; f32x4 o[4];
        ln_row<1>(nullptr, F.h, hb, nullptr, F.in[12] + l * D, F.in[13] + l * D, row, F.lane, o);
        float x[16];
#pragma unroll
        for (int j = 0; j < 4; ++j) { x[4 * j] = o[j].x; x[4 * j + 1] = o[j].y; x[4 * j + 2] = o[j].z; x[4 * j + 3] = o[j].w; }
        router_row(x, (int)row, F.lane, F.in[14] + (size_t)l * D * 4, F.in[15] + l * 4, F.in[16] + (size_t)l * 4 * D * 8, F.in[17] + l * 32, cnt, rec);
    }
}
__device__ __forceinline__ void ph_dsp(Frame& F, int l) { LAUNDER(F);
    LAS int* po = (LAS int*)(F.lds + ROWS_OFF);
    const int* cnt = (const int*)(F.ws + WS_CTL) + CW_CNT + l * 32; const Rec* rec = (const Rec*)(F.ws + WS_REC); int* rowtok = (int*)(F.ws + WS_ROWTOK); float* rowgate = (float*)(F.ws + WS_ROWGATE);
    if (F.tid == 0) { int acc = 0; for (int e = 0; e < NE; ++e) { po[e] = acc; acc += (cnt[e] + 255) / 256 * 256; } po[NE] = acc; }
    __syncthreads();
    const int gt = F.vcu * NTHREADS + F.tid, GT = F.G * NTHREADS;
    for (int t = gt; t < T; t += GT) {
        const Rec rc = rec[t];
        const int d0 = po[rc.e0] + rc.s0, d1 = po[rc.e1] + rc.s1;
        rowtok[d0] = 2 * t; rowgate[d0] = rc.g0; rowtok[d1] = 2 * t + 1; rowgate[d1] = rc.g1;
    }
    for (int e = 0; e < NE; ++e) for (int r = po[e] + cnt[e] + gt; r < po[e + 1]; r += GT) { rowtok[r] = -1; rowgate[r] = 0.f; }
    __syncthreads();
}
__device__ __forceinline__ int moe_setup(Frame& F, int l, bool gather) { LAUNDER(F);
    LAS int* rows = (LAS int*)(F.lds + ROWS_OFF); LAS int* ulist = rows + 11 * 256; LAS int* po = ulist + 16;
    const int* cnt = (const int*)(F.ws + WS_CTL) + CW_CNT + l * 32; const int* rowtok = (const int*)(F.ws + WS_ROWTOK);
    if (F.tid == 0) { int acc = 0; for (int e = 0; e < NE; ++e) { po[e] = acc; acc += (cnt[e] + 255) / 256 * 256; } po[NE] = acc; }
    __syncthreads();
    const int nu_all = (po[NE] / 256) * 4; int nun = (nu_all - F.vcu + F.G - 1) / F.G; nun = nun < 0 ? 0 : (nun > 11 ? 11 : nun);
    if (F.tid < nun) { const int Lx = F.tid * F.G + F.vcu, rt = Lx >> 2, pn = Lx & 3; int e = 0; while (e < NE - 1 && po[e + 1] <= rt * 256) ++e; ulist[F.tid] = (rt << 8) | (e << 2) | pn; }
    if (gather) for (int idx = F.tid; idx < nun * 256; idx += NTHREADS) { const int i = idx >> 8, r = idx & 255, Lx = i * F.G + F.vcu; rows[idx] = rowtok[(Lx >> 2) * 256 + r]; }
    __syncthreads();
    return nun;
}
struct MoeOrder {
    int nun; const LAS int* ulist; const LAS int* rows; const char* A; const char* B; size_t tstepA, estepB, tstepB;
    __device__ __forceinline__ bool next(int i, pg8::Unit& u) const {
        if (i >= nun) return false;
        const int w = __builtin_amdgcn_readfirstlane(ulist[i]); u.pm = w >> 8; u.e = (w >> 2) & 63; u.pn = w & 3; u.ui = i; return true;
    }
    __device__ __forceinline__ const char* a_base(const pg8::Unit& u) const { return A + (size_t)u.pm * tstepA; }
    __device__ __forceinline__ const char* b_base(const pg8::Unit& u) const { return B + (size_t)u.e * estepB + (size_t)u.pn * tstepB; }
    __device__ __forceinline__ int a_row(const pg8::Unit& u, int r) const { const int t = rows[u.ui * 256 + r]; return t < 0 ? 0 : (t >> 1); }
};
__device__ __forceinline__ void ph_p7(Frame& F, int l) { LAUNDER(F);
    const int nun = moe_setup(F, l, true);
    LAS int* rows = (LAS int*)(F.lds + ROWS_OFF);
    MoeOrder S{nun, rows + 11 * 256, rows, (const char*)(F.ws + WS_HB), (const char*)(F.ws + WS_WGU) + (size_t)l * NE * 1024 * 1024 * 2, 0, (size_t)1024 * 1024 * 2, (size_t)256 * 1024 * 2};
    EpiP7 E{(bf16*)(F.ws + WS_HID)};
    pg8::gemm_phase<EpiP7, MoeOrder, true>(F.lds + RING_OFF, S, E, D, D, D);
}
__device__ __forceinline__ void ph_p8(Frame& F, int l) { LAUNDER(F);
    const int nun = moe_setup(F, l, false);
    LAS int* rows = (LAS int*)(F.lds + ROWS_OFF);
    MoeOrder S{nun, rows + 11 * 256, rows, (const char*)(F.ws + WS_HID), (const char*)(F.ws + WS_WD) + (size_t)l * NE * 1024 * 512 * 2, (size_t)256 * DE * 2, (size_t)1024 * 512 * 2, (size_t)256 * 512 * 2};
    EpiP8 E{(bf16*)(F.ws + WS_YB), (const int*)(F.ws + WS_ROWTOK), (const float*)(F.ws + WS_ROWGATE)};
    pg8::gemm_phase<EpiP8, MoeOrder, false>(F.lds + RING_OFF, S, E, DE, DE, DE);
}
__device__ __forceinline__ void ph_ln2(Frame& F, int l) { LAUNDER(F);
    const int gw = F.vcu * NWAVES + F.wave, NGW = F.G * NWAVES;
    bf16* hb = (l == DEPTH - 1) ? nullptr : (bf16*)(F.ws + WS_HB);
    for (int m = gw; m < T; m += NGW) { f32x4 o[4]; ln_row<2>(nullptr, F.h, hb, (const bf16*)(F.ws + WS_YB), F.in[21] + l * D, F.in[22] + l * D, (size_t)m, F.lane, o); }
}

typedef short s16x4 __attribute__((ext_vector_type(4)));
constexpr int NT_A = (CH / 32) * 8, NT_B = (CH / L) * 3 * 256 * 4, NT_C = (CH / 32) * 8, NT_ALL = NT_A + NT_B + NT_C;
constexpr float NEGBIG = -1.0e30f, MINIT = -5.0e29f;
#define RC16(reg) (((reg) & 3) + 8 * ((reg) >> 2))

__device__ __forceinline__ void ph_tables(Frame& F) { LAUNDER(F);
    float* TA = (float*)(F.ws + WS_TABA); float* TB = (float*)(F.ws + WS_TABB); float* TC = (float*)(F.ws + WS_TABC);
    const float* rel_bias = F.in[3]; const float* rpb = F.in[7];
    const int gt = F.vcu * NTHREADS + F.tid, GT = F.G * NTHREADS;
    for (int i = gt; i < 8 * 320; i += GT) { const int h = i / 320, rel = i % 320 - 160; TA[i] = (rel >= -128 && rel <= 128) ? rel_bias[BUCK_A[rel + 128] * 20 + h] * LOG2E : NEGBIG; }
    for (int i = gt; i < 12 * 192; i += GT) { const int gh = i / 192, g = gh >> 2, rel = i % 192 - 96; TB[i] = (rel >= -64 && rel <= 64) ? rel_bias[BUCK_B[g][rel + 64] * 20 + 8 + gh] * LOG2E : NEGBIG; }
    for (int i = gt; i < DEPTH * 8 * 1024; i += GT) { const int lh = i >> 10, ri = (i >> 6) & 15, ci = (i & 63) - 16; TC[i] = (ri < 15 && ci >= 0 && ci <= 30) ? rpb[((size_t)lh * 15 + ri) * 31 + ci] * LOG2E : NEGBIG; }
}

template <int TYPE>
__device__ __forceinline__ void att_task(LAS unsigned char* wl, const int lane, const bf16* seq  , const float* tabsrc,
                                         const int qcol, const int kcol, const int vcol, const int TT0, const int TSTEP, const int kstride, const int tlo, const int thi,
                                         const int tq  , const int ci_i  , const int ci_c  , const int cbs,
                                         const float m_init, const float l_init, bf16* orow  , float* lse_out) {
    const int qi = lane & 31, hh = lane >> 5;
    LAS unsigned char* kt = wl; LAS unsigned char* vt = wl + 4096; LAS float* tb = (LAS float*)(wl + 8192);
    constexpr int TBN = TYPE == 0 ? 320 : (TYPE == 1 ? 192 : 1024);
#pragma unroll
    for (int i = 0; i < TBN / 64; ++i) tb[lane + 64 * i] = tabsrc[lane + 64 * i];
    bf16x8 Qf[4];
#pragma unroll
    for (int s = 0; s < 4; ++s) Qf[s] = *(const bf16x8*)(seq + (size_t)tq * QKVW + qcol + 16 * s + 8 * hh);
    f32x16 O0, O1;
#pragma unroll
    for (int i = 0; i < 16; ++i) { O0[i] = 0.f; O1[i] = 0.f; }
    float m = m_init, l = l_init;
    const int lkey = lane >> 3, lch = lane & 7;
    const bf16* gk = seq + (size_t)(lkey * kstride) * QKVW + 8 * lch;
    const size_t istep = (size_t)8 * kstride * QKVW;
    unsigned kwoff[4], vwoff[4];
#pragma unroll
    for (int i = 0; i < 4; ++i) { const int key = lkey + 8 * i; kwoff[i] = key * 128 + ((lch ^ (key & 7)) << 4); vwoff[i] = key * 128 + (((lch >> 2) ^ ((key >> 1) & 1)) << 6) + ((lch & 3) << 4); }
    unsigned kroff[4];
#pragma unroll
    for (int s = 0; s < 4; ++s) kroff[s] = qi * 128 + (((2 * s + hh) ^ (qi & 7)) << 4);
    const int q4 = (lane & 15) >> 2, p4 = lane & 3, g1 = (lane >> 4) & 1, sw = (q4 >> 1) & 1;
    const unsigned vr0 = (4 * hh + q4) * 128 + 32 * g1 + 8 * p4 + (sw << 6), vr1 = (4 * hh + q4) * 128 + 32 * g1 + 8 * p4 + ((sw ^ 1) << 6);
    const int bidx0 = (TYPE == 2) ? (cbs - ci_c + 31 + 4 * hh) : (32 - qi + 4 * hh);
    int cs = ci_c - 8; cs = cs < 0 ? 0 : (cs > 48 ? 48 : cs);
    const int xm = cbs - cs + 4 * hh;
    int rs_i = ci_i - 4; rs_i = rs_i < 0 ? 0 : (rs_i > 120 ? 120 : rs_i);
    v4u kreg[4], vreg[4];
    {
        const bf16* gt0 = gk + (size_t)(TT0 + tlo * TSTEP) * QKVW;
#pragma unroll
        for (int i = 0; i < 4; ++i) { kreg[i] = *(const v4u*)(gt0 + i * istep + kcol); vreg[i] = *(const v4u*)(gt0 + i * istep + vcol); }
    }
    for (int ti = tlo; ti <= thi; ++ti) {
#pragma unroll
        for (int i = 0; i < 4; ++i) { *(LAS v4u*)(kt + kwoff[i]) = kreg[i]; *(LAS v4u*)(vt + vwoff[i]) = vreg[i]; }
        if (ti < thi) {
            const bf16* gt0 = gk + (size_t)(TT0 + (ti + 1) * TSTEP) * QKVW;
#pragma unroll
            for (int i = 0; i < 4; ++i) { kreg[i] = *(const v4u*)(gt0 + i * istep + kcol); vreg[i] = *(const v4u*)(gt0 + i * istep + vcol); }
        }
        f32x16 S;
#pragma unroll
        for (int i = 0; i < 16; ++i) S[i] = 0.f;
#pragma unroll
        for (int s = 0; s < 4; ++s) { const bf16x8 Kf = *(const LAS bf16x8*)(kt + kroff[s]); S = __builtin_amdgcn_mfma_f32_32x32x16_bf16(Kf, Qf[s], S, 0, 0, 0); }
        int bidx;
        if (TYPE == 2) { const bool rv = (ti >= rs_i) && (ti < rs_i + 8); bidx = bidx0 + (rv ? (ti - ci_i + 7) : 15) * 64; }
        else bidx = bidx0 + 32 * ti;
        float tmax = NEGBIG;
#pragma unroll
        for (int r = 0; r < 16; ++r) { float v = S[r] + tb[bidx + RC16(r)]; if (TYPE == 2) v = ((unsigned)(xm + RC16(r)) < 16u) ? v : NEGBIG; S[r] = v; tmax = fmaxf(tmax, v); }
        tmax = fmaxf(tmax, __shfl_xor(tmax, 32));
        const float mn = fmaxf(m, tmax), corr = __builtin_amdgcn_exp2f(m - mn);
        float rsum = 0.f;
#pragma unroll
        for (int r = 0; r < 16; ++r) { const float p = __builtin_amdgcn_exp2f(S[r] - mn); S[r] = p; rsum += p; }
        rsum += __shfl_xor(rsum, 32);
        l = l * corr + rsum; m = mn;
#pragma unroll
        for (int i = 0; i < 16; ++i) { O0[i] *= corr; O1[i] *= corr; }
#pragma unroll
        for (int s2 = 0; s2 < 2; ++s2) {
            bf16x8 Pf; unsigned pw[4];
#pragma unroll
            for (int j = 0; j < 4; ++j) pw[j] = pg8::cvt_pk_bf16(S[8 * s2 + 2 * j], S[8 * s2 + 2 * j + 1]);
            Pf = __builtin_bit_cast(bf16x8, (v4u){pw[0], pw[1], pw[2], pw[3]});
            const s16x4 a00 = __builtin_amdgcn_ds_read_tr16_b64_v4i16((LAS s16x4*)(vt + vr0 + (16 * s2) * 128));
            const s16x4 a01 = __builtin_amdgcn_ds_read_tr16_b64_v4i16((LAS s16x4*)(vt + vr0 + (16 * s2 + 8) * 128));
            const s16x4 a10 = __builtin_amdgcn_ds_read_tr16_b64_v4i16((LAS s16x4*)(vt + vr1 + (16 * s2) * 128));
            const s16x4 a11 = __builtin_amdgcn_ds_read_tr16_b64_v4i16((LAS s16x4*)(vt + vr1 + (16 * s2 + 8) * 128));
            const bf16x8 V0 = (bf16x8){a00[0], a00[1], a00[2], a00[3], a01[0], a01[1], a01[2], a01[3]};
            const bf16x8 V1 = (bf16x8){a10[0], a10[1], a10[2], a10[3], a11[0], a11[1], a11[2], a11[3]};
            O0 = __builtin_amdgcn_mfma_f32_32x32x16_bf16(V0, Pf, O0, 0, 0, 0);
            O1 = __builtin_amdgcn_mfma_f32_32x32x16_bf16(V1, Pf, O1, 0, 0, 0);
        }
    }
    const float inv = 1.0f / l;
#pragma unroll
    for (int g = 0; g < 4; ++g) {
        v2u w0, w1;
        w0.x = pg8::cvt_pk_bf16(O0[4 * g] * inv, O0[4 * g + 1] * inv); w0.y = pg8::cvt_pk_bf16(O0[4 * g + 2] * inv, O0[4 * g + 3] * inv);
        w1.x = pg8::cvt_pk_bf16(O1[4 * g] * inv, O1[4 * g + 1] * inv); w1.y = pg8::cvt_pk_bf16(O1[4 * g + 2] * inv, O1[4 * g + 3] * inv);
        *(v2u*)(orow + 8 * g + 4 * hh) = w0; *(v2u*)(orow + 32 + 8 * g + 4 * hh) = w1;
    }
    if (TYPE == 1 && hh == 0) *lse_out = (m + __builtin_amdgcn_logf(l)) * LN2;
}

__device__ __forceinline__ void ph_att(Frame& F, int l) { LAUNDER(F);
    const int lane = F.lane, qi = lane & 31;
    LAS unsigned char* wl = F.lds + RING_OFF + F.wave * 16384;
    const bf16* qkv = (const bf16*)(F.ws + WS_QKV); bf16* oabc = (bf16*)(F.ws + WS_OABC); bf16* og = (bf16*)(F.ws + WS_OG); float* lse = (float*)(F.ws + WS_LSE);
    const float* TA = (const float*)(F.ws + WS_TABA); const float* TB = (const float*)(F.ws + WS_TABB); const float* TC = (const float*)(F.ws + WS_TABC) + (size_t)l * 8 * 1024;
    const float* sink = F.in[6] + l * 8;
    const int gw = F.vcu * NWAVES + F.wave, NGW = F.G * NWAVES;
    for (int task = gw; task < NT_ALL; task += NGW) {
        if (task < NT_A) {
            const int hq = task & 7, qb = (task >> 3) & 255, b = task >> 11, q0 = qb * 32;
            int tlo = 0, thi = 8; if (q0 - 128 < 0) tlo = (128 - q0) / 32; if (q0 + 128 + 31 >= L) thi = (L - 1 - (q0 - 128)) / 32;
            const int tq = q0 + qi;
            att_task<0>(wl, lane, qkv + (size_t)b * L * QKVW, TA + hq * 320, AQ + hq * 64, AK + (hq >> 2) * 64, AV + (hq >> 2) * 64, q0 - 128, 32, 1, tlo, thi, tq, 0, 0, 0,
                        sink[hq] * LOG2E, 1.0f, oabc + (size_t)(b * L + tq) * OW + hq * 64, nullptr);
        } else if (task < NT_A + NT_B) {
            const int j = task - NT_A, h = j & 3, sbi = (j >> 2) & 255, bg = j >> 10, g = bg % 3, b = bg / 3;
            const int dsh = 2 * g, d = 1 << dsh, nsb = 256 >> dsh, r = sbi / nsb, sb = sbi % nsb, q0 = sb * 32, Ls = L >> dsh;
            int tlo = 0, thi = 4; if (q0 - 64 < 0) tlo = (64 - q0) / 32; if (q0 + 64 + 31 >= Ls) thi = (Ls - 1 - (q0 - 64)) / 32;
            const int tq = (q0 + qi) * d + r, qc = BQ0 + 768 * g + h * 64;
            att_task<1>(wl, lane, qkv + (size_t)b * L * QKVW, TB + (g * 4 + h) * 192, qc, qc + 256, qc + 512, (q0 - 64) * d + r, 32 * d, d, tlo, thi, tq, 0, 0, 0,
                        MINIT, 0.0f, og + ((size_t)(b * L + tq) * 3 + g) * 256 + h * 64, lse + ((size_t)(b * L + tq) * 3 + g) * 4 + h);
        } else {
            const int j = task - NT_A - NT_B, h = j & 7, cbi = (j >> 3) & 255, b = j >> 11, ip = cbi >> 2, cb = cbi & 3;
            const int gi = 2 * ip + (qi >> 4), gc = 16 * cb + (qi & 15), tq = gi * 64 + gc;
            int cbs = 16 * cb - 8; cbs = cbs < 0 ? 0 : (cbs > 32 ? 32 : cbs);
            int rlo = 2 * ip - 4; rlo = rlo < 0 ? 0 : (rlo > 120 ? 120 : rlo);
            int rhi = 2 * ip + 1 - 4; rhi = rhi < 0 ? 0 : (rhi > 120 ? 120 : rhi); rhi += 7;
            att_task<2>(wl, lane, qkv + (size_t)b * L * QKVW, TC + h * 1024, CQ + h * 64, CK + h * 64, CV + h * 64, cbs, 64, 1, rlo, rhi, tq, gi, gc, cbs,
                        MINIT, 0.0f, oabc + (size_t)(b * L + tq) * OW + 768 + h * 64, nullptr);
        }
    }
}

constexpr int NSTEPS = 1 + DEPTH * 16;
__global__ void __launch_bounds__(NTHREADS, 2) mk_fwd(Args args) {
    extern __shared__ __attribute__((aligned(16))) unsigned char lds[];
    Frame F;
    F.lds = (LAS unsigned char*)lds; F.tid = threadIdx.x; F.lane = F.tid & 63; F.wave = __builtin_amdgcn_readfirstlane(F.tid >> 6);
    F.G = gridDim.x; { const int bx = blockIdx.x; F.vcu = (F.G % 8 == 0) ? (bx % 8) * (F.G / 8) + bx / 8 : bx; }
    F.in = args.in; F.h = args.out; F.ws = args.ws;
    volatile LAS unsigned* MISC = (volatile LAS unsigned*)(F.lds + MISC_OFF);
    if (F.tid < 32) MISC[F.tid] = 0u;
    __syncthreads();
    const int lo = args.s_lo, hi = args.s_hi;
    XcdBarrier bar; bar.bar = (unsigned*)(F.ws + WS_CTL) + CW_BAR; bar.x = 0; bar.st = nullptr;
    if (hi - lo > 1) bar = xcd_barrier_post((unsigned*)(F.ws + WS_CTL) + CW_BAR, MISC + 8);
#define RUN(s) (lo <= (s) && (s) < hi)
#define SEAM(s) do { if (RUN(s) && RUN((s) + 1)) xcd_barrier(bar); } while (0)
    if (RUN(0)) { ph_prologue(F); ph_tables(F); ph_ln0(F); }
    SEAM(0);
    for (int l = 0; l < DEPTH; ++l) {
        const int sb = 1 + l * 16;
        for (int c = 0; c < NCHUNK; ++c) {
            const int s = sb + c * 6;
            if (RUN(s)) ph_p1(F, l, c);
            SEAM(s);
            if (RUN(s + 1)) ph_att(F, l);
            SEAM(s + 1);
            if (RUN(s + 2)) ph_cmb(F);
            SEAM(s + 2);
            if (RUN(s + 3)) ph_p3(F, l);
            SEAM(s + 3);
            if (RUN(s + 4)) ph_p4(F, l, c);
            SEAM(s + 4);
            if (RUN(s + 5)) ph_ln1(F, l, c);
            SEAM(s + 5);
        }
        if (RUN(sb + 12)) ph_dsp(F, l);
        SEAM(sb + 12);
        if (RUN(sb + 13)) ph_p7(F, l);
        SEAM(sb + 13);
        if (RUN(sb + 14)) ph_p8(F, l);
        SEAM(sb + 14);
        if (RUN(sb + 15)) ph_ln2(F, l);
        SEAM(sb + 15);
    }
#undef RUN
#undef SEAM
}

#ifndef FAST_MASK
#define FAST_MASK 0x7FF
#endif
#ifndef ONE_LAUNCH
#define ONE_LAUNCH 0
#endif
extern "C" void kernel_launch(void* const* d_in, const int* in_sizes, int n_in, void* d_out, int out_size, void* d_ws, size_t ws_size, hipStream_t stream) {
    static int grid = 0;
    if (grid == 0) {
        if (n_in != 23 || out_size != T * D || ws_size < WS_END) { fprintf(stderr, "kernel_launch: unexpected shapes (n_in %d out %d ws %zu)\n", n_in, out_size, ws_size); grid = -1; return; }
        int dev = 0, cus = 0, per_cu = 0;
        if (hipGetDevice(&dev) != hipSuccess || hipDeviceGetAttribute(&cus, hipDeviceAttributeMultiprocessorCount, dev) != hipSuccess) { grid = -1; return; }
        if (hipFuncSetAttribute((const void*)mk_fwd, hipFuncAttributeMaxDynamicSharedMemorySize, LDS_BYTES) != hipSuccess) { fprintf(stderr, "kernel_launch: hipFuncSetAttribute failed\n"); grid = -1; return; }
        if (hipOccupancyMaxActiveBlocksPerMultiprocessor(&per_cu, (const void*)mk_fwd, NTHREADS, LDS_BYTES) != hipSuccess || per_cu < 1) fprintf(stderr, "kernel_launch: occupancy query reports %d\n", per_cu);
        (void)hipGetLastError();
        grid = cus;
    }
    if (grid < 0) return;
    const float* x = (const float*)d_in[0]; const float* ln0_g = (const float*)d_in[1]; const float* ln0_b = (const float*)d_in[2]; const float* rel_bias = (const float*)d_in[3];
    const float* w_in = (const float*)d_in[4]; const float* b_gate = (const float*)d_in[5]; const float* sink_a = (const float*)d_in[6]; const float* rpb_c = (const float*)d_in[7];
    const float* w_br_a = (const float*)d_in[8]; const float* w_br_b = (const float*)d_in[9]; const float* w_br_c = (const float*)d_in[10]; const float* w_out = (const float*)d_in[11];
    const float* ln1_g = (const float*)d_in[12]; const float* ln1_b = (const float*)d_in[13]; const float* w_rg = (const float*)d_in[14]; const float* b_rg = (const float*)d_in[15];
    const float* w_re = (const float*)d_in[16]; const float* b_re = (const float*)d_in[17]; const float* w_eg = (const float*)d_in[18]; const float* w_eu = (const float*)d_in[19];
    const float* w_ed = (const float*)d_in[20]; const float* ln2_g = (const float*)d_in[21]; const float* ln2_b = (const float*)d_in[22];
    unsigned char* ws = (unsigned char*)d_ws; float* h = (float*)d_out;
    bf16* hb = (bf16*)(ws + WS_HB); bf16* qkv = (bf16*)(ws + WS_QKV); bf16* gates = (bf16*)(ws + WS_GATES); bf16* oabc = (bf16*)(ws + WS_OABC); bf16* og = (bf16*)(ws + WS_OG);
    float* lse = (float*)(ws + WS_LSE); Rec* rec = (Rec*)(ws + WS_REC); int* rowtok = (int*)(ws + WS_ROWTOK); float* rowgate = (float*)(ws + WS_ROWGATE);
    bf16* merged = (bf16*)(ws + WS_MERGED); bf16* hid = (bf16*)(ws + WS_HID); bf16* yb = (bf16*)(ws + WS_YB); int* cnt = (int*)(ws + WS_CTL) + CW_CNT;
    (void)hipMemsetAsync(ws + WS_CTL, 0, CTL_ZERO_BYTES, stream);
    Args a{};
    for (int i = 0; i < 23; ++i) a.in[i] = (const float*)d_in[i];
    a.out = h; a.ws = ws;
    if (ONE_LAUNCH) { a.s_lo = 0; a.s_hi = NSTEPS; hipLaunchKernelGGL(mk_fwd, dim3(grid), dim3(NTHREADS), LDS_BYTES, stream, a); return; }
    const int G = 2048;
    const bool fastp1 = (FAST_MASK >> 1) & 1;
    for (int s = 0; s < NSTEPS; ++s) {
        int kind, l = 0, c = 0;
        if (s == 0) kind = 0; else { const int r = (s - 1) % 16; l = (s - 1) / 16; if (r < 12) { c = r / 6; kind = 1 + r % 6; } else kind = 7 + (r - 12); }
        if ((FAST_MASK >> kind) & 1) { a.s_lo = s; a.s_hi = s + 1; hipLaunchKernelGGL(mk_fwd, dim3(grid), dim3(NTHREADS), LDS_BYTES, stream, a); continue; }
        const size_t r0 = (size_t)c * CH;
        switch (kind) {
        case 0: k_ln<<<G, 256, 0, stream>>>(0, x, h, hb, nullptr, ln0_g, ln0_b, 0, T); break;
        case 1: k_p1<<<G, 256, 0, stream>>>(hb + r0 * D, w_in + (size_t)l * D * NCOL, b_gate + (size_t)l * GATEW, qkv, gates); break;
        case 2: k_attn_naive<<<(28 * CH + 255) / 256, 256, 0, stream>>>(qkv, oabc, og, lse, rel_bias, sink_a + l * 8, rpb_c + (size_t)l * 8 * 15 * 31, fastp1 ? LN2 : 0.125f); break;
        case 3: k_combine<<<(CH * 32 + 255) / 256, 256, 0, stream>>>(og, lse, oabc); break;
        case 4: k_p3<<<G, 256, 0, stream>>>(oabc, gates, w_br_a + (size_t)l * 512 * D, w_br_b + (size_t)l * 256 * D, w_br_c + (size_t)l * 512 * D, merged); break;
        case 5: k_p4<<<G, 256, 0, stream>>>(merged, w_out + (size_t)l * D * D, h + r0 * D); break;
        case 6: k_ln<<<G, 256, 0, stream>>>(1, nullptr, h, hb, nullptr, ln1_g + l * D, ln1_b + l * D, (int)r0, CH);
                if (c == NCHUNK - 1) k_router<<<G, 256, 0, stream>>>(h, w_rg + (size_t)l * D * 4, b_rg + l * 4, w_re + (size_t)l * 4 * D * 8, b_re + l * 32, cnt + l * 32, rec);
                break;
        case 7: (void)hipMemsetAsync(rowtok, 0xFF, (size_t)PROWS * 4, stream); k_dispatch<<<256, 256, 0, stream>>>(cnt + l * 32, rec, rowtok, rowgate); break;
        case 8: k_p7<<<G, 256, 0, stream>>>(hb, cnt + l * 32, rowtok, w_eg + (size_t)l * NE * D * DE, w_eu + (size_t)l * NE * D * DE, hid); break;
        case 9: k_p8<<<G, 256, 0, stream>>>(hid, cnt + l * 32, rowtok, rowgate, w_ed + (size_t)l * NE * DE * D, yb); break;
        case 10: k_ln<<<G, 256, 0, stream>>>(2, nullptr, h, (l == DEPTH - 1) ? nullptr : hb, yb, ln2_g + l * D, ln2_b + l * D, 0, T); break;
        }
    }
}
```

```cpp
#include <hip/hip_runtime.h>
#include <cstdio>
#include <cstdint>
#include <cmath>

typedef unsigned short bf16;
typedef short bf16x8 __attribute__((ext_vector_type(8)));
typedef float f32x16 __attribute__((ext_vector_type(16)));
typedef float f32x4 __attribute__((ext_vector_type(4)));

constexpr int D = 1024, L = 8192, NBATCH = 8, T = NBATCH * L, DEPTH = 2;
constexpr int NCOL = 7680, QKVW = 4608, GATEW = 3072;
constexpr int CH = 32768, NCHUNK = T / CH;
constexpr int OW = 1280;
constexpr int NE = 32, DE = 512;
constexpr int MAXRT = T * 2 / 256 + NE, PROWS = MAXRT * 256;
constexpr float LN_EPS = 1e-5f;
constexpr float ALPHA = 1.41421356237309515f;
constexpr int AQ = 0, AK = 512, AV = 640, BQ0 = 768, CQ = 3072, CK = 3584, CV = 4096;

constexpr size_t MiB = 1u << 20;
constexpr size_t WS_CTL = 0;
constexpr size_t WS_WIN = 1 * MiB, WS_WBRA = 31 * MiB, WS_WBRB = 33 * MiB, WS_WBRC = 34 * MiB, WS_WOUT = 36 * MiB, WS_WGU = 40 * MiB, WS_WD = 168 * MiB;
constexpr size_t WS_HB = 232 * MiB, WS_QKV = 360 * MiB, WS_GATES = 648 * MiB, WS_OABC = 840 * MiB, WS_OG = 920 * MiB, WS_LSE = 968 * MiB,
                 WS_REC = 970 * MiB, WS_ROWTOK = 972 * MiB, WS_ROWGATE = 973 * MiB, WS_TABA = 974 * MiB, WS_TABB = WS_TABA + 16384, WS_TABC = WS_TABA + 32768, WS_END = 975 * MiB;
constexpr size_t WS_MERGED = WS_QKV, WS_HID = WS_QKV, WS_YB = WS_QKV + 136 * MiB;

__device__ __constant__ signed char BUCK_A[257] = {12,11,11,11,11,11,11,11,11,11,11,11,11,11,11,11,11,11,11,11,11,11,11,11,11,11,11,11,11,11,11,11,11,11,11,11,11,11,11,11,11,11,11,11,11,11,11,11,11,11,11,11,11,11,11,11,11,11,11,11,11,11,11,11,11,10,10,10,10,10,10,10,10,10,10,10,10,10,10,10,10,10,10,10,10,10,10,10,10,10,10,10,10,10,10,10,10,9,9,9,9,9,9,9,9,9,9,9,9,9,9,9,9,8,8,8,8,8,8,8,8,7,6,5,4,3,2,1,0,17,18,19,20,21,22,23,24,24,24,24,24,24,24,24,25,25,25,25,25,25,25,25,25,25,25,25,25,25,25,25,26,26,26,26,26,26,26,26,26,26,26,26,26,26,26,26,26,26,26,26,26,26,26,26,26,26,26,26,26,26,26,26,27,27,27,27,27,27,27,27,27,27,27,27,27,27,27,27,27,27,27,27,27,27,27,27,27,27,27,27,27,27,27,27,27,27,27,27,27,27,27,27,27,27,27,27,27,27,27,27,27,27,27,27,27,27,27,27,27,27,27,27,27,27,27,27,28};
__device__ __constant__ signed char BUCK_B[3][129] = {
 {11,10,10,10,10,10,10,10,10,10,10,10,10,10,10,10,10,10,10,10,10,10,10,10,10,10,10,10,10,10,10,10,10,9,9,9,9,9,9,9,9,9,9,9,9,9,9,9,9,8,8,8,8,8,8,8,8,7,6,5,4,3,2,1,0,17,18,19,20,21,22,23,24,24,24,24,24,24,24,24,25,25,25,25,25,25,25,25,25,25,25,25,25,25,25,25,26,26,26,26,26,26,26,26,26,26,26,26,26,26,26,26,26,26,26,26,26,26,26,26,26,26,26,26,26,26,26,26,27},
 {13,12,12,12,12,12,12,12,12,12,12,12,12,12,12,12,12,12,12,12,12,12,12,12,12,12,12,12,12,12,12,12,12,11,11,11,11,11,11,11,11,11,11,11,11,11,11,11,11,10,10,10,10,10,10,10,10,9,9,9,9,8,8,4,0,20,24,24,25,25,25,25,26,26,26,26,26,26,26,26,27,27,27,27,27,27,27,27,27,27,27,27,27,27,27,27,28,28,28,28,28,28,28,28,28,28,28,28,28,28,28,28,28,28,28,28,28,28,28,28,28,28,28,28,28,28,28,28,29},
 {15,14,14,14,14,14,14,14,14,14,14,14,14,14,14,14,14,14,14,14,14,14,14,14,14,14,14,14,14,14,14,14,14,13,13,13,13,13,13,13,13,13,13,13,13,13,13,13,13,12,12,12,12,12,12,12,12,11,11,11,11,10,10,9,0,25,26,26,27,27,27,27,28,28,28,28,28,28,28,28,29,29,29,29,29,29,29,29,29,29,29,29,29,29,29,29,30,30,30,30,30,30,30,30,30,30,30,30,30,30,30,30,30,30,30,30,30,30,30,30,30,30,30,30,30,30,30,30,31}};

__device__ __forceinline__ float bf2f(bf16 b) { return __uint_as_float(((unsigned)b) << 16); }
__device__ __forceinline__ bf16 f2bf(float f) { unsigned u = __float_as_uint(f); u += 0x7fffu + ((u >> 16) & 1u); return (bf16)(u >> 16); }
__device__ __forceinline__ float wave_sum(float v) {
#pragma unroll
    for (int o = 1; o < 64; o <<= 1) v += __shfl_xor(v, o);
    return v;
}

__global__ __launch_bounds__(256) void k_ln(int mode, const float* src, float* h, bf16* hb, const bf16* yb, const float* g, const float* bta, int row0, int nrows) {
    const int lane = threadIdx.x & 63, wv = blockIdx.x * 4 + (threadIdx.x >> 6), nw = gridDim.x * 4;
    for (int rr = wv; rr < nrows; rr += nw) {
        const size_t row = (size_t)row0 + rr;
        f32x4 v[4];
#pragma unroll
        for (int j = 0; j < 4; ++j) {
            const int c = lane * 4 + 256 * j;
            v[j] = *(const f32x4*)((mode == 0 ? src : h) + row * D + c);
            if (mode == 2) {
                const uint2 a = *(const uint2*)(yb + (row * 2) * D + c), b = *(const uint2*)(yb + (row * 2 + 1) * D + c);
                v[j].x = ALPHA * v[j].x + bf2f((bf16)(a.x & 0xffff)) + bf2f((bf16)(b.x & 0xffff));
                v[j].y = ALPHA * v[j].y + bf2f((bf16)(a.x >> 16)) + bf2f((bf16)(b.x >> 16));
                v[j].z = ALPHA * v[j].z + bf2f((bf16)(a.y & 0xffff)) + bf2f((bf16)(b.y & 0xffff));
                v[j].w = ALPHA * v[j].w + bf2f((bf16)(a.y >> 16)) + bf2f((bf16)(b.y >> 16));
            }
        }
        float s = 0.f;
#pragma unroll
        for (int j = 0; j < 4; ++j) s += (v[j].x + v[j].y) + (v[j].z + v[j].w);
        const float mean = wave_sum(s) * (1.f / D);
        float q = 0.f;
#pragma unroll
        for (int j = 0; j < 4; ++j) { v[j] = v[j] - mean; q += (v[j].x * v[j].x + v[j].y * v[j].y) + (v[j].z * v[j].z + v[j].w * v[j].w); }
        const float rstd = 1.0f / sqrtf(wave_sum(q) * (1.f / D) + LN_EPS);
#pragma unroll
        for (int j = 0; j < 4; ++j) {
            const int c = lane * 4 + 256 * j;
            const f32x4 gg = *(const f32x4*)(g + c), bb = *(const f32x4*)(bta + c);
            const f32x4 o = v[j] * rstd * gg + bb;
            *(f32x4*)(h + row * D + c) = o;
            if (hb) { uint2 w; w.x = (unsigned)f2bf(o.x) | ((unsigned)f2bf(o.y) << 16); w.y = (unsigned)f2bf(o.z) | ((unsigned)f2bf(o.w) << 16); *(uint2*)(hb + row * D + c) = w; }
        }
    }
}

__device__ __forceinline__ void wave_gemm32(const bf16* arow, const float* wcol, int ldw, int K, f32x16& acc) {
    for (int k0 = 0; k0 < K; k0 += 16) {
        const bf16x8 a = *(const bf16x8*)(arow + k0);
        bf16x8 b;
#pragma unroll
        for (int j = 0; j < 8; ++j) b[j] = (short)f2bf(wcol[(size_t)(k0 + j) * ldw]);
        acc = __builtin_amdgcn_mfma_f32_32x32x16_bf16(a, b, acc, 0, 0, 0);
    }
}
#define ACC_ROW(reg, h) (((reg) & 3) + 8 * ((reg) >> 2) + 4 * (h))

__global__ __launch_bounds__(256) void k_p1(const bf16* hbc, const float* w_in, const float* b_gate, bf16* qkv, bf16* gates) {
    const int lane = threadIdx.x & 63, r = lane & 31, hh = lane >> 5;
    const int wv = blockIdx.x * 4 + (threadIdx.x >> 6), nw = gridDim.x * 4;
    const int ntn = NCOL / 32, total = (CH / 32) * ntn;
    for (int tile = wv; tile < total; tile += nw) {
        const int tm = tile / ntn, tn = tile % ntn;
        f32x16 acc; for (int i = 0; i < 16; ++i) acc[i] = 0.f;
        wave_gemm32(hbc + (size_t)(tm * 32 + r) * D + 8 * hh, w_in + (size_t)(8 * hh) * NCOL + tn * 32 + r, NCOL, D, acc);
        const int col = tn * 32 + r;
#pragma unroll
        for (int i = 0; i < 16; ++i) {
            const int row = tm * 32 + ACC_ROW(i, hh);
            if (col < QKVW) qkv[(size_t)row * QKVW + col] = f2bf(acc[i]);
            else { const float z = acc[i] + b_gate[col - QKVW]; gates[(size_t)row * GATEW + (col - QKVW)] = f2bf(1.0f / (1.0f + __expf(-z))); }
        }
    }
}

__global__ __launch_bounds__(256) void k_attn_naive(const bf16* qkv, bf16* oabc, bf16* og, float* lse, const float* rel_bias, const float* sink_l, const float* rpb_l, float sc) {
    const long idx = (long)blockIdx.x * 256 + threadIdx.x;
    if (idx >= (long)28 * CH) return;
    const int ht = (int)(idx / CH), tl = (int)(idx % CH), b = tl / L, t = tl % L;
    const bf16* base = qkv + (size_t)(b * L) * QKVW;
    int qcol, kcol, vcol;
    if (ht < 8) { qcol = AQ + ht * 64; kcol = AK + (ht >> 2) * 64; vcol = AV + (ht >> 2) * 64; }
    else if (ht < 20) { const int g = (ht - 8) >> 2, h = (ht - 8) & 3; qcol = BQ0 + 768 * g + h * 64; kcol = qcol + 256; vcol = qcol + 512; }
    else { const int h = ht - 20; qcol = CQ + h * 64; kcol = CK + h * 64; vcol = CV + h * 64; }
    float q[64], o[64];
    {
        const uint4* qp = (const uint4*)(base + (size_t)t * QKVW + qcol);
#pragma unroll
        for (int c = 0; c < 8; ++c) { const uint4 u = qp[c]; const unsigned w[4] = {u.x, u.y, u.z, u.w};
#pragma unroll
            for (int i = 0; i < 4; ++i) { q[8 * c + 2 * i] = bf2f((bf16)(w[i] & 0xffff)); q[8 * c + 2 * i + 1] = bf2f((bf16)(w[i] >> 16)); } }
    }
#pragma unroll
    for (int i = 0; i < 64; ++i) o[i] = 0.f;
    float m = -1e30f, l = 0.f;
    if (ht < 8) { m = sink_l[ht]; l = 1.f; }
#define PROC_KEY(KT, BIAS) do { \
        const uint4* kp = (const uint4*)(base + (size_t)(KT) * QKVW + kcol); float s = 0.f; \
        _Pragma("unroll") for (int c = 0; c < 8; ++c) { const uint4 u = kp[c]; const unsigned w[4] = {u.x, u.y, u.z, u.w}; \
            _Pragma("unroll") for (int i = 0; i < 4; ++i) { s += q[8 * c + 2 * i] * bf2f((bf16)(w[i] & 0xffff)); s += q[8 * c + 2 * i + 1] * bf2f((bf16)(w[i] >> 16)); } } \
        s = s * sc + (BIAS); const float mn = fmaxf(m, s), corr = __expf(m - mn), p = __expf(s - mn); l = l * corr + p; m = mn; \
        const uint4* vp = (const uint4*)(base + (size_t)(KT) * QKVW + vcol); \
        _Pragma("unroll") for (int c = 0; c < 8; ++c) { const uint4 u = vp[c]; const unsigned w[4] = {u.x, u.y, u.z, u.w}; \
            _Pragma("unroll") for (int i = 0; i < 4; ++i) { o[8 * c + 2 * i] = o[8 * c + 2 * i] * corr + p * bf2f((bf16)(w[i] & 0xffff)); o[8 * c + 2 * i + 1] = o[8 * c + 2 * i + 1] * corr + p * bf2f((bf16)(w[i] >> 16)); } } \
    } while (0)
    if (ht < 8) {
        for (int rel = -128; rel <= 128; ++rel) { const int kt = t + rel; if (kt < 0 || kt >= L) continue;
            const float bias = rel_bias[BUCK_A[rel + 128] * 20 + ht]; PROC_KEY(kt, bias); }
    } else if (ht < 20) {
        const int g = (ht - 8) >> 2, h = (ht - 8) & 3, dil = (g == 0) ? 1 : (g == 1 ? 4 : 16);
        for (int off = -64; off <= 64; ++off) { const int kt = t + off * dil; if (kt < 0 || kt >= L) continue;
            const float bias = rel_bias[BUCK_B[g][off + 64] * 20 + 8 + 4 * g + h]; PROC_KEY(kt, bias); }
    } else {
        const int h = ht - 20, gi = t >> 6, gc = t & 63;
        int rs = gi - 4; rs = rs < 0 ? 0 : (rs > 120 ? 120 : rs);
        int cs = gc - 8; cs = cs < 0 ? 0 : (cs > 48 ? 48 : cs);
        for (int kr = rs; kr < rs + 8; ++kr)
            for (int kc = cs; kc < cs + 16; ++kc) { const float bias = rpb_l[(h * 15 + (kr - gi + 7)) * 31 + (kc - gc + 15)]; const int kt = kr * 64 + kc; PROC_KEY(kt, bias); }
    }
#undef PROC_KEY
    const float inv = 1.0f / l;
    bf16* dst;
    if (ht < 8) dst = oabc + (size_t)tl * OW + ht * 64;
    else if (ht < 20) { const int g = (ht - 8) >> 2, h = (ht - 8) & 3; dst = og + ((size_t)tl * 3 + g) * 256 + h * 64; lse[((size_t)tl * 3 + g) * 4 + h] = m + __logf(l); }
    else dst = oabc + (size_t)tl * OW + 768 + (ht - 20) * 64;
#pragma unroll
    for (int c = 0; c < 8; ++c) { uint4 u;
        u.x = (unsigned)f2bf(o[8 * c + 0] * inv) | ((unsigned)f2bf(o[8 * c + 1] * inv) << 16); u.y = (unsigned)f2bf(o[8 * c + 2] * inv) | ((unsigned)f2bf(o[8 * c + 3] * inv) << 16);
        u.z = (unsigned)f2bf(o[8 * c + 4] * inv) | ((unsigned)f2bf(o[8 * c + 5] * inv) << 16); u.w = (unsigned)f2bf(o[8 * c + 6] * inv) | ((unsigned)f2bf(o[8 * c + 7] * inv) << 16);
        ((uint4*)dst)[c] = u; }
}

__global__ __launch_bounds__(256) void k_combine(const bf16* og, const float* lse, bf16* oabc) {
    const long idx = (long)blockIdx.x * 256 + threadIdx.x;
    if (idx >= (long)CH * 32) return;
    const int tl = (int)(idx >> 5), hc = (int)(idx & 31), h = hc >> 3, c = hc & 7;
    const float l0 = lse[((size_t)tl * 3 + 0) * 4 + h], l1 = lse[((size_t)tl * 3 + 1) * 4 + h], l2 = lse[((size_t)tl * 3 + 2) * 4 + h];
    const float mx = fmaxf(l0, fmaxf(l1, l2)); float w0 = __expf(l0 - mx), w1 = __expf(l1 - mx), w2 = __expf(l2 - mx); const float inv = 1.0f / (w0 + w1 + w2); w0 *= inv; w1 *= inv; w2 *= inv;
    const uint4 a = *(const uint4*)(og + ((size_t)tl * 3 + 0) * 256 + h * 64 + c * 8), b = *(const uint4*)(og + ((size_t)tl * 3 + 1) * 256 + h * 64 + c * 8), d = *(const uint4*)(og + ((size_t)tl * 3 + 2) * 256 + h * 64 + c * 8);
    const unsigned aw[4] = {a.x, a.y, a.z, a.w}, bw[4] = {b.x, b.y, b.z, b.w}, dw[4] = {d.x, d.y, d.z, d.w}; unsigned ow[4];
#pragma unroll
    for (int i = 0; i < 4; ++i) {
        const float lo = w0 * bf2f((bf16)(aw[i] & 0xffff)) + w1 * bf2f((bf16)(bw[i] & 0xffff)) + w2 * bf2f((bf16)(dw[i] & 0xffff));
        const float hi = w0 * bf2f((bf16)(aw[i] >> 16)) + w1 * bf2f((bf16)(bw[i] >> 16)) + w2 * bf2f((bf16)(dw[i] >> 16));
        ow[i] = (unsigned)f2bf(lo) | ((unsigned)f2bf(hi) << 16);
    }
    *(uint4*)(oabc + (size_t)tl * OW + 512 + h * 64 + c * 8) = make_uint4(ow[0], ow[1], ow[2], ow[3]);
}

__global__ __launch_bounds__(256) void k_p3(const bf16* oabc, const bf16* gates, const float* wa, const float* wb, const float* wc, bf16* merged) {
    const int lane = threadIdx.x & 63, r = lane & 31, hh = lane >> 5;
    const int wv = blockIdx.x * 4 + (threadIdx.x >> 6), nw = gridDim.x * 4;
    const int ntn = D / 32, total = (CH / 32) * ntn;
    for (int tile = wv; tile < total; tile += nw) {
        const int tm = tile / ntn, tn = tile % ntn, col = tn * 32 + r;
        f32x16 mg; for (int i = 0; i < 16; ++i) mg[i] = 0.f;
#pragma unroll 1
        for (int br = 0; br < 3; ++br) {
            f32x16 acc; for (int i = 0; i < 16; ++i) acc[i] = 0.f;
            const int koff = br == 0 ? 0 : (br == 1 ? 512 : 768), K = br == 1 ? 256 : 512;
            const float* w = br == 0 ? wa : (br == 1 ? wb : wc);
            wave_gemm32(oabc + (size_t)(tm * 32 + r) * OW + koff + 8 * hh, w + (size_t)(8 * hh) * D + col, D, K, acc);
#pragma unroll
            for (int i = 0; i < 16; ++i) { const int row = tm * 32 + ACC_ROW(i, hh); mg[i] += bf2f(gates[(size_t)row * GATEW + br * 1024 + col]) * acc[i]; }
        }
#pragma unroll
        for (int i = 0; i < 16; ++i) { const int row = tm * 32 + ACC_ROW(i, hh); merged[(size_t)row * D + col] = f2bf(mg[i]); }
    }
}
__global__ __launch_bounds__(256) void k_p4(const bf16* merged, const float* wo, float* hchunk) {
    const int lane = threadIdx.x & 63, r = lane & 31, hh = lane >> 5;
    const int wv = blockIdx.x * 4 + (threadIdx.x >> 6), nw = gridDim.x * 4;
    const int ntn = D / 32, total = (CH / 32) * ntn;
    for (int tile = wv; tile < total; tile += nw) {
        const int tm = tile / ntn, tn = tile % ntn, col = tn * 32 + r;
        f32x16 acc; for (int i = 0; i < 16; ++i) acc[i] = 0.f;
        wave_gemm32(merged + (size_t)(tm * 32 + r) * D + 8 * hh, wo + (size_t)(8 * hh) * D + col, D, D, acc);
#pragma unroll
        for (int i = 0; i < 16; ++i) { const int row = tm * 32 + ACC_ROW(i, hh); float* p = hchunk + (size_t)row * D + col; *p = ALPHA * *p + acc[i]; }
    }
}

struct Rec { int e0, s0, e1, s1; float g0, g1; int pad0, pad1; };
__global__ __launch_bounds__(256) void k_router(const float* h, const float* w_rg, const float* b_rg, const float* w_re, const float* b_re, int* cnt, Rec* rec) {
    const int lane = threadIdx.x & 63, wv = blockIdx.x * 4 + (threadIdx.x >> 6), nw = gridDim.x * 4;
    for (int t = wv; t < T; t += nw) {
        float x[16];
#pragma unroll
        for (int j = 0; j < 4; ++j) { const f32x4 v = *(const f32x4*)(h + (size_t)t * D + lane * 4 + 256 * j); x[4 * j] = v.x; x[4 * j + 1] = v.y; x[4 * j + 2] = v.z; x[4 * j + 3] = v.w; }
        float gl[4] = {0.f, 0.f, 0.f, 0.f};
#pragma unroll
        for (int j = 0; j < 4; ++j)
#pragma unroll
            for (int i = 0; i < 4; ++i) { const f32x4 w = *(const f32x4*)(w_rg + (size_t)(lane * 4 + 256 * j + i) * 4); const float xv = x[4 * j + i]; gl[0] += xv * w.x; gl[1] += xv * w.y; gl[2] += xv * w.z; gl[3] += xv * w.w; }
#pragma unroll
        for (int g = 0; g < 4; ++g) gl[g] = wave_sum(gl[g]) + b_rg[g];
        int gi = 0; float gm = gl[0];
#pragma unroll
        for (int g = 1; g < 4; ++g) if (gl[g] > gm) { gm = gl[g]; gi = g; }
        float gs = 0.f;
#pragma unroll
        for (int g = 0; g < 4; ++g) gs += __expf(gl[g] - gm);
        const float gw = 1.0f / gs;
        float el[8];
#pragma unroll
        for (int e = 0; e < 8; ++e) el[e] = 0.f;
        const float* wre = w_re + (size_t)gi * D * 8;
#pragma unroll
        for (int j = 0; j < 4; ++j)
#pragma unroll
            for (int i = 0; i < 4; ++i) { const float* wp = wre + (size_t)(lane * 4 + 256 * j + i) * 8; const f32x4 w0 = *(const f32x4*)wp, w1 = *(const f32x4*)(wp + 4); const float xv = x[4 * j + i];
                el[0] += xv * w0.x; el[1] += xv * w0.y; el[2] += xv * w0.z; el[3] += xv * w0.w; el[4] += xv * w1.x; el[5] += xv * w1.y; el[6] += xv * w1.z; el[7] += xv * w1.w; }
#pragma unroll
        for (int e = 0; e < 8; ++e) el[e] = wave_sum(el[e]) + b_re[gi * 8 + e];
        int i0 = 0; float t0 = el[0];
#pragma unroll
        for (int e = 1; e < 8; ++e) if (el[e] > t0) { t0 = el[e]; i0 = e; }
        int i1 = -1; float t1 = -3.0e38f;
#pragma unroll
        for (int e = 0; e < 8; ++e) if (e != i0 && el[e] > t1) { t1 = el[e]; i1 = e; }
        const float ex = __expf(t1 - t0), p0 = 1.0f / (1.0f + ex), p1 = ex / (1.0f + ex);
        if (lane == 0) {
            Rec rc; rc.e0 = gi * 8 + i0; rc.e1 = gi * 8 + i1; rc.g0 = gw * p0; rc.g1 = gw * p1; rc.pad0 = 0; rc.pad1 = 0;
            rc.s0 = atomicAdd(cnt + rc.e0, 1); rc.s1 = atomicAdd(cnt + rc.e1, 1);
            rec[t] = rc;
        }
    }
}
__device__ __forceinline__ void pad_offsets(const int* cnt, int* po) { int acc = 0; for (int e = 0; e < NE; ++e) { po[e] = acc; acc += (cnt[e] + 255) / 256 * 256; } po[NE] = acc; }
__global__ __launch_bounds__(256) void k_dispatch(const int* cnt, const Rec* rec, int* rowtok, float* rowgate) {
    __shared__ int po[NE + 1];
    if (threadIdx.x == 0) pad_offsets(cnt, po);
    __syncthreads();
    for (int t = blockIdx.x * 256 + threadIdx.x; t < T; t += gridDim.x * 256) {
        const Rec rc = rec[t];
        const int d0 = po[rc.e0] + rc.s0, d1 = po[rc.e1] + rc.s1;
        rowtok[d0] = 2 * t; rowgate[d0] = rc.g0; rowtok[d1] = 2 * t + 1; rowgate[d1] = rc.g1;
    }
}
__global__ __launch_bounds__(256) void k_p7(const bf16* hb, const int* cnt, const int* rowtok, const float* w_eg, const float* w_eu, bf16* hid) {
    __shared__ int po[NE + 1];
    if (threadIdx.x == 0) pad_offsets(cnt, po);
    __syncthreads();
    const int lane = threadIdx.x & 63, r = lane & 31, hh = lane >> 5;
    const int wv = blockIdx.x * 4 + (threadIdx.x >> 6), nw = gridDim.x * 4;
    const int ntn = DE / 32, total = (po[NE] / 32) * ntn;
    for (int tile = wv; tile < total; tile += nw) {
        const int tm = tile / ntn, tn = tile % ntn, col = tn * 32 + r, row0 = tm * 32;
        int e = 0; while (e < NE - 1 && po[e + 1] <= row0) ++e;
        int tok = rowtok[row0 + r]; tok = tok < 0 ? 0 : (tok >> 1);
        f32x16 ag, au; for (int i = 0; i < 16; ++i) { ag[i] = 0.f; au[i] = 0.f; }
        wave_gemm32(hb + (size_t)tok * D + 8 * hh, w_eg + (size_t)e * D * DE + (size_t)(8 * hh) * DE + col, DE, D, ag);
        wave_gemm32(hb + (size_t)tok * D + 8 * hh, w_eu + (size_t)e * D * DE + (size_t)(8 * hh) * DE + col, DE, D, au);
#pragma unroll
        for (int i = 0; i < 16; ++i) { const int row = row0 + ACC_ROW(i, hh); const float gsl = ag[i] / (1.0f + __expf(-ag[i])); hid[(size_t)row * DE + col] = f2bf(gsl * au[i]); }
    }
}
__global__ __launch_bounds__(256) void k_p8(const bf16* hid, const int* cnt, const int* rowtok, const float* rowgate, const float* w_ed, bf16* yb) {
    __shared__ int po[NE + 1];
    if (threadIdx.x == 0) pad_offsets(cnt, po);
    __syncthreads();
    const int lane = threadIdx.x & 63, r = lane & 31, hh = lane >> 5;
    const int wv = blockIdx.x * 4 + (threadIdx.x >> 6), nw = gridDim.x * 4;
    const int ntn = D / 32, total = (po[NE] / 32) * ntn;
    for (int tile = wv; tile < total; tile += nw) {
        const int tm = tile / ntn, tn = tile % ntn, col = tn * 32 + r, row0 = tm * 32;
        int e = 0; while (e < NE - 1 && po[e + 1] <= row0) ++e;
        f32x16 acc; for (int i = 0; i < 16; ++i) acc[i] = 0.f;
        wave_gemm32(hid + (size_t)(row0 + r) * DE + 8 * hh, w_ed + (size_t)e * DE * D + (size_t)(8 * hh) * D + col, D, DE, acc);
#pragma unroll
        for (int i = 0; i < 16; ++i) { const int row = row0 + ACC_ROW(i, hh); const int rt = rowtok[row]; if (rt >= 0) yb[(size_t)rt * D + col] = f2bf(acc[i] * rowgate[row]); }
    }
}


namespace pg8 {
#define PG8_LAS __attribute__((address_space(3)))
typedef unsigned short bf16_t;
typedef unsigned u32x4 __attribute__((ext_vector_type(4)));
constexpr int BM = 256, BK = 64, HALF = 128, HTB = HALF * BK * 2  , STAGE_BYTES = 8 * HTB, NXCD = 8, WGM = 8;

__host__ __device__ __forceinline__ int lds_byte(int r, int c) { const int st = (r >> 4) * 2 + (c >> 5), rr = r & 15, cc = c & 31, ob = rr * 64 + cc * 2; return st * 1024 + (ob ^ (((ob >> 9) & 1) << 5)); }
__host__ __device__ __forceinline__ void stage_rc(int b, int& R, int& C) { const int st = b / 1024, sb = b % 1024, swz = sb ^ (((sb >> 9) & 1) << 5); R = (st >> 1) * 16 + swz / 64; C = (st & 1) * 32 + (swz % 64) / 2; }
__host__ __device__ __forceinline__ int perm32(int rho) { const int n = rho >> 4, i = rho & 15; return 8 * (i >> 2) + 4 * n + (i & 3); }

struct Unit { int pm, pn, e, ui; };

struct DenseOrder {
    int nM, nN, nwg, G, c; const char* A; const char* B; size_t tstepA, tstepB;
    __device__ void init(const void* A_, int lda, const void* B_, int ldb, int M, int N, int G_, int c_) { nM = M / BM; nN = N / BM; nwg = nM * nN; G = G_; c = c_; A = (const char*)A_; B = (const char*)B_; tstepA = (size_t)BM * lda * 2; tstepB = (size_t)BM * ldb * 2; }
    __device__ bool next(int i, Unit& u) const {
        const long Lx = (long)i * G + c; if (Lx >= nwg) return false;
        int wgid = (int)Lx; { const int q = nwg / NXCD, r = nwg % NXCD, xcd = wgid % NXCD, off = wgid / NXCD; wgid = (xcd < r ? xcd * (q + 1) : r * (q + 1) + (xcd - r) * q) + off; }
        const int nig = WGM * nN, gid = wgid / nig, fm = gid * WGM, gsz = (nM - fm) < WGM ? (nM - fm) : WGM;
        u.pm = fm + ((wgid % nig) % gsz); u.pn = (wgid % nig) / gsz; u.e = 0; u.ui = i; return true;
    }
    __device__ __forceinline__ const char* a_base(const Unit& u) const { return A + (size_t)u.pm * tstepA; }
    __device__ __forceinline__ const char* b_base(const Unit& u) const { return B + (size_t)u.pn * tstepB; }
    __device__ __forceinline__ int a_row(const Unit&, int) const { return 0; }
};

__device__ __forceinline__ unsigned cvt_pk_bf16(float lo, float hi) { unsigned r; asm volatile("v_cvt_pk_bf16_f32 %0, %1, %2" : "=v"(r) : "v"(lo), "v"(hi)); return r; }

template <class Epi, class Sched, bool GATHER>
__device__ __forceinline__ void gemm_phase(PG8_LAS unsigned char* lds, const Sched& S, const Epi& E, const int K, const int lda, const int ldb) {
    int tid = threadIdx.x; asm volatile("" : "+v"(tid));
    const int wid = __builtin_amdgcn_readfirstlane(tid >> 6), lane = tid & 63, wr = wid >> 2, wc = wid & 3, fr = lane & 15, fq = lane >> 4;
    const int nt = K / BK;
    int RA[2], CA[2]; unsigned voffB[2];
#pragma unroll
    for (int i = 0; i < 2; ++i) { int R, C; stage_rc(tid * 16 + i * 8192, R, C); const int Rb = Epi::PERM ? ((R & ~31) + perm32(R & 31)) : R; RA[i] = R; CA[i] = C; voffB[i] = (unsigned)(Rb * ldb + C) * 2u; }
    const size_t kstep = (size_t)(BK * 2);
    const size_t hstepB = (size_t)HALF * ldb * 2;
    const unsigned ldsw = (unsigned)wid * 1024u;
    const int aoff = lds_byte(wr * 64 + fr, fq * 8), boff = lds_byte(wc * 32 + fr, fq * 8);
#define PG8_SA(b, h) (((b) * 2 + (h)) * HTB)
#define PG8_SB(b, h) ((4 + (b) * 2 + (h)) * HTB)
#define PG8_STAGE2(bufoff, gbase, v0, v1) do { \
        __builtin_amdgcn_global_load_lds((const unsigned*)((const char*)(gbase) + (v0)), (PG8_LAS unsigned*)(lds + (bufoff) + ldsw), 16, 0, 0); \
        __builtin_amdgcn_global_load_lds((const unsigned*)((const char*)(gbase) + (v1)), (PG8_LAS unsigned*)(lds + (bufoff) + ldsw + 8192), 16, 0, 0); } while (0)
#define PG8_STAGEB(bufoff, gbase) PG8_STAGE2(bufoff, gbase, voffB[0], voffB[1])
#define PG8_LDA(dst, b, h) do { _Pragma("unroll") for (int m = 0; m < 4; ++m) _Pragma("unroll") for (int k = 0; k < 2; ++k) dst[m][k] = *(const PG8_LAS bf16x8*)(lds + PG8_SA(b, h) + aoff + m * 2048 + k * 1024); } while (0)
#define PG8_LDB(dst, b, h) do { _Pragma("unroll") for (int n = 0; n < 2; ++n) _Pragma("unroll") for (int k = 0; k < 2; ++k) dst[n][k] = *(const PG8_LAS bf16x8*)(lds + PG8_SB(b, h) + boff + n * 2048 + k * 1024); } while (0)
#define PG8_MMA(ai, bj, At, Bt) do { __builtin_amdgcn_s_setprio(1); _Pragma("unroll") for (int m = 0; m < 4; ++m) _Pragma("unroll") for (int n = 0; n < 2; ++n) _Pragma("unroll") for (int k = 0; k < 2; ++k) \
        acc[ai][bj][m][n] = __builtin_amdgcn_mfma_f32_16x16x32_bf16(Bt[n][k], At[m][k], acc[ai][bj][m][n], 0, 0, 0); __builtin_amdgcn_s_setprio(0); } while (0)
#define PG8_WAIT_V(n) asm volatile("s_waitcnt vmcnt(" #n ")" ::: "memory")
#define PG8_WAIT_L(n) asm volatile("s_waitcnt lgkmcnt(" #n ")" ::: "memory")
#define PG8_BAR __builtin_amdgcn_s_barrier()
#define PG8_SCHED __builtin_amdgcn_sched_barrier(0)
#define PG8_VOFFA(dst, u) do { _Pragma("unroll") for (int h_ = 0; h_ < 2; ++h_) _Pragma("unroll") for (int i_ = 0; i_ < 2; ++i_) { \
        const int row_ = GATHER ? S.a_row(u, h_ * HALF + RA[i_]) : (h_ * HALF + RA[i_]); dst[h_][i_] = (unsigned)(row_ * lda + CA[i_]) * 2u; } } while (0)
    Unit cur, nxt;
    if (!S.next(0, cur)) return;
    f32x4 acc[2][2][4][2];
#pragma unroll
    for (int a = 0; a < 2; ++a)
#pragma unroll
        for (int b = 0; b < 2; ++b)
#pragma unroll
            for (int m = 0; m < 4; ++m)
#pragma unroll
                for (int n = 0; n < 2; ++n) acc[a][b][m][n] = (f32x4){0.f, 0.f, 0.f, 0.f};
    bf16x8 At[4][2], B0[2][2], B1[2][2];
    unsigned vc[2][2], vn[2][2];
    PG8_VOFFA(vc, cur);
    const char* cA = S.a_base(cur); const char* cB = S.b_base(cur);
    PG8_STAGEB(PG8_SB(0, 0), cB); PG8_STAGEB(PG8_SB(0, 1), cB + hstepB); PG8_STAGE2(PG8_SA(0, 0), cA, vc[0][0], vc[0][1]); PG8_STAGE2(PG8_SA(0, 1), cA, vc[1][0], vc[1][1]);
    if (wr == 1) PG8_BAR;
    PG8_WAIT_V(2); PG8_BAR;
    PG8_STAGEB(PG8_SB(1, 0), cB + kstep); PG8_STAGE2(PG8_SA(1, 0), cA + kstep, vc[0][0], vc[0][1]); PG8_STAGEB(PG8_SB(1, 1), cB + hstepB + kstep);
    PG8_WAIT_V(6); PG8_BAR;
    int ui = 0;
    for (;;) {
        const bool has_next = S.next(ui + 1, nxt);
        const char* nA = has_next ? S.a_base(nxt) : cA; const char* nB = has_next ? S.b_base(nxt) : cB;
        if (GATHER) { if (has_next) { PG8_VOFFA(vn, nxt); } else {
#pragma unroll
            for (int h_ = 0; h_ < 2; ++h_) { vn[h_][0] = vc[h_][0]; vn[h_][1] = vc[h_][1]; } } }
        for (int t = 0; t < nt; t += 2) {
            const bool last = (t == nt - 2);
            const char* a1 = cA + (size_t)(t + 1) * kstep;
            const char* a2 = last ? nA : cA + (size_t)(t + 2) * kstep; const char* b2 = last ? nB : cB + (size_t)(t + 2) * kstep;
            const char* a3 = a2 + kstep; const char* b3 = b2 + kstep;
            unsigned w00, w01, w10, w11;
            if (GATHER) { w00 = last ? vn[0][0] : vc[0][0]; w01 = last ? vn[0][1] : vc[0][1]; w10 = last ? vn[1][0] : vc[1][0]; w11 = last ? vn[1][1] : vc[1][1]; }
            else { w00 = vc[0][0]; w01 = vc[0][1]; w10 = vc[1][0]; w11 = vc[1][1]; }
            PG8_LDB(B0, 0, 0); PG8_LDB(B1, 0, 1); PG8_SCHED; PG8_LDA(At, 0, 0); PG8_STAGE2(PG8_SA(1, 1), a1, vc[1][0], vc[1][1]);
            PG8_WAIT_V(8); PG8_WAIT_L(0); PG8_BAR; PG8_MMA(0, 0, At, B0); PG8_MMA(0, 1, At, B1); PG8_BAR; PG8_SCHED;
            PG8_LDA(At, 0, 1); PG8_STAGEB(PG8_SB(0, 0), b2); PG8_STAGEB(PG8_SB(0, 1), b2 + hstepB); PG8_STAGE2(PG8_SA(0, 0), a2, w00, w01);
            PG8_WAIT_V(8); PG8_WAIT_L(0); PG8_BAR; PG8_MMA(1, 0, At, B0); PG8_MMA(1, 1, At, B1); PG8_BAR; PG8_SCHED;
            PG8_LDB(B0, 1, 0); PG8_LDB(B1, 1, 1); PG8_SCHED; PG8_LDA(At, 1, 0); PG8_STAGE2(PG8_SA(0, 1), a2, w10, w11);
            PG8_WAIT_V(8); PG8_WAIT_L(0); PG8_BAR; PG8_MMA(0, 0, At, B0); PG8_MMA(0, 1, At, B1); PG8_BAR; PG8_SCHED;
            PG8_LDA(At, 1, 1); PG8_STAGEB(PG8_SB(1, 0), b3); PG8_STAGEB(PG8_SB(1, 1), b3 + hstepB); PG8_STAGE2(PG8_SA(1, 0), a3, w00, w01);
            PG8_WAIT_V(8); PG8_WAIT_L(0); PG8_BAR; PG8_MMA(1, 0, At, B0); PG8_MMA(1, 1, At, B1); PG8_BAR; PG8_SCHED;
        }
        if (wr == 0) PG8_BAR;
        E(acc, cur, wr, wc, fr, fq);
        if (!has_next) break;
#pragma unroll
        for (int a = 0; a < 2; ++a)
#pragma unroll
            for (int b = 0; b < 2; ++b)
#pragma unroll
                for (int m = 0; m < 4; ++m)
#pragma unroll
                    for (int n = 0; n < 2; ++n) acc[a][b][m][n] = (f32x4){0.f, 0.f, 0.f, 0.f};
        cur = nxt; cA = nA; cB = nB; ++ui;
        if (GATHER) {
#pragma unroll
            for (int h_ = 0; h_ < 2; ++h_) { vc[h_][0] = vn[h_][0]; vc[h_][1] = vn[h_][1]; } }
        if (wr == 1) PG8_BAR;
    }
    PG8_WAIT_V(0);
    PG8_BAR;
#undef PG8_SA
#undef PG8_SB
#undef PG8_STAGE2
#undef PG8_STAGEB
#undef PG8_LDA
#undef PG8_LDB
#undef PG8_MMA
#undef PG8_WAIT_V
#undef PG8_WAIT_L
#undef PG8_BAR
#undef PG8_SCHED
#undef PG8_VOFFA
}
}

constexpr int NWAVES = 8, NTHREADS = 512;
constexpr int RING_OFF = 0, RING_BYTES = 131072, ROWS_OFF = 131072, ROWS_BYTES = 12288, MISC_OFF = ROWS_OFF + ROWS_BYTES, LDS_BYTES = 147456;
static_assert(MISC_OFF + 128 <= LDS_BYTES, "LDS map");
constexpr int CW_CNT = 0;
constexpr int CW_BAR = 4096;
constexpr size_t CTL_ZERO_BYTES = 64 * 1024;
constexpr float LOG2E = 1.4426950408889634f, LN2 = 0.6931471805599453f;
constexpr float QSCALE = 0.125f * LOG2E;

#define GAS __attribute__((address_space(1)))
#define LAS __attribute__((address_space(3)))
typedef unsigned v4u __attribute__((ext_vector_type(4)));
typedef unsigned v2u __attribute__((ext_vector_type(2)));
#define LDS_WAIT() asm volatile("s_waitcnt lgkmcnt(0)" ::: "memory")
__device__ __forceinline__ unsigned pk2(float lo, float hi) { return (unsigned)f2bf(lo) | ((unsigned)f2bf(hi) << 16); }

#define XB_TMO      128
#define XB_XCNT(j)  (256  + 64 * (j))
#define XB_XSUB(j)  (1280 + 64 * (j))
#define XB_XGEN(j)  (2304 + 64 * (j))
#define XB_TOP      3328
#define XB_TOPGEN   3392
#define XCD_BAR_WORDS 3456
#define XB_SPIN_CAP (1u << 18)

__device__ __forceinline__ unsigned xb_ld(unsigned* p)              { return __hip_atomic_load(p, __ATOMIC_RELAXED, __HIP_MEMORY_SCOPE_AGENT); }
__device__ __forceinline__ unsigned xb_add(unsigned* p, unsigned v) { return __hip_atomic_fetch_add(p, v, __ATOMIC_RELAXED, __HIP_MEMORY_SCOPE_AGENT); }
__device__ __forceinline__ unsigned xb_xcc_id() { return (unsigned)__builtin_amdgcn_s_getreg((3 << 11) | 20) & 0xFu; }
#define XB_SPIN(cond, bar) do { unsigned _sp = 0; while (cond) { __builtin_amdgcn_s_sleep(1); \
    if ((++_sp & 255u) == 0u) { if (xb_ld(&(bar)[XB_TMO])) break; if (_sp > XB_SPIN_CAP) { atomicAdd(&(bar)[XB_TMO], 1u); break; } } } } while (0)

struct XcdBarrier {
    unsigned* bar; unsigned x;
    volatile LAS unsigned* st;
};

__device__ __forceinline__ XcdBarrier xcd_barrier_post(unsigned* bar, volatile LAS unsigned* st) {
    XcdBarrier b; b.bar = bar; b.x = xb_xcc_id(); b.st = st;
    if (threadIdx.x == 0) (void)xb_add(&bar[XB_XCNT(b.x)], 1u);
    return b;
}
__device__ __forceinline__ void xcd_barrier_complete(unsigned* bar, unsigned x, unsigned& nloc, unsigned& nx) {
    const unsigned G = gridDim.x * gridDim.y * gridDim.z;
    unsigned sum, cnt, mine, sp = 0u;
    for (;;) {
        sum = 0u; cnt = 0u; mine = 0u;
#pragma unroll
        for (unsigned j = 0; j < 16; ++j) { const unsigned c = xb_ld(&bar[XB_XCNT(j)]); sum += c; cnt += (c > 0u) ? 1u : 0u; mine = (j == x) ? c : mine; }
        if (sum == G) break;
        __builtin_amdgcn_s_sleep(1);
        if ((++sp & 255u) == 0u) { if (xb_ld(&bar[XB_TMO])) break; if (sp > XB_SPIN_CAP) { atomicAdd(&bar[XB_TMO], 1u); break; } }
    }
    nloc = mine > 0u ? mine : 1u; nx = cnt > 0u ? cnt : 1u;
}

__device__ __forceinline__ void xcd_barrier(const XcdBarrier& b) {
    asm volatile("s_waitcnt vmcnt(0)" ::: "memory");
    __syncthreads();
    if (threadIdx.x == 0) {
        unsigned* bar = b.bar;
        __builtin_amdgcn_s_waitcnt(0);
        unsigned nloc = b.st[0], nx = b.st[1];
        if (nloc == 0u) { xcd_barrier_complete(bar, b.x, nloc, nx); b.st[0] = nloc; b.st[1] = nx; }
        const unsigned old = xb_add(&bar[XB_XSUB(b.x)], 1u);
        const unsigned gen = old / nloc;
        if (old + 1u == (gen + 1u) * nloc) {
            __builtin_amdgcn_fence(__ATOMIC_RELEASE, "agent");
            asm volatile("s_waitcnt vmcnt(0)" ::: "memory");
            const unsigned og = xb_add(&bar[XB_TOP], 1u);
            const unsigned tg = og / nx;
            if (og + 1u == (tg + 1u) * nx) xb_add(&bar[XB_TOPGEN], 1u);
            else XB_SPIN(xb_ld(&bar[XB_TOPGEN]) == tg, bar);
            __builtin_amdgcn_fence(__ATOMIC_ACQUIRE, "agent");
            xb_add(&bar[XB_XGEN(b.x)], 1u);
            asm volatile("s_waitcnt vmcnt(0)" ::: "memory");
        } else {
            XB_SPIN(xb_ld(&bar[XB_XGEN(b.x)]) == gen, bar);
            __builtin_amdgcn_fence(__ATOMIC_ACQUIRE, "agent");
            asm volatile("s_waitcnt vmcnt(0)" ::: "memory");
        }
    }
    __syncthreads();
}


struct Args { const float* in[23]; float* out; unsigned char* ws; int s_lo, s_hi; };

struct Frame {
    LAS unsigned char* lds; int tid, lane, wave, vcu, G;
    const float* const* in; float* h; unsigned char* ws;
};

#define LAUNDER(F) do { asm volatile("" : "+v"((F).tid)); (F).lane = (F).tid & 63; asm volatile("" : "+s"((F).G), "+s"((F).vcu)); } while (0)
__device__ __forceinline__ void p0_item(const float* W, int ldw, int k0, int n0, bf16* WT, int Kd, int drow0, float scale, LAS float* scr, int lane) {
#pragma unroll 8
    for (int i = 0; i < 32; ++i) { const int kk = 2 * i + (lane >> 5); scr[kk * 33 + (lane & 31)] = W[(size_t)(k0 + kk) * ldw + n0 + (lane & 31)] * scale; }
    LDS_WAIT(); asm volatile("" ::: "memory");
    const int c = lane & 7;
#pragma unroll
    for (int j = 0; j < 4; ++j) { const int n = (lane >> 3) + 8 * j; const LAS float* s = scr + (8 * c) * 33 + n;
        v4u o; o.x = pk2(s[0 * 33], s[1 * 33]); o.y = pk2(s[2 * 33], s[3 * 33]); o.z = pk2(s[4 * 33], s[5 * 33]); o.w = pk2(s[6 * 33], s[7 * 33]);
        *(v4u*)(WT + (size_t)(drow0 + n) * Kd + k0 + 8 * c) = o; }
    LDS_WAIT(); asm volatile("" ::: "memory");
}
__device__ __forceinline__ bool is_q_col(int n) { return n < 512 || (n >= 768 && n < 3072 && ((n - 768) % 768) < 256) || (n >= 3072 && n < 3584); }

__device__ __forceinline__ void ph_prologue(Frame& F) { LAUNDER(F);
    LAS float* scr = (LAS float*)(F.lds + RING_OFF + F.wave * 16384);
    const int gw = F.vcu * NWAVES + F.wave, NGW = F.G * NWAVES, lane = F.lane;
    const float* w_in = F.in[4]; const float* w_a = F.in[8]; const float* w_b = F.in[9]; const float* w_c = F.in[10]; const float* w_o = F.in[11];
    const float* w_eg = F.in[18]; const float* w_eu = F.in[19]; const float* w_ed = F.in[20];
    bf16* WIN = (bf16*)(F.ws + WS_WIN); bf16* WBRA = (bf16*)(F.ws + WS_WBRA); bf16* WBRB = (bf16*)(F.ws + WS_WBRB); bf16* WBRC = (bf16*)(F.ws + WS_WBRC); bf16* WOUT = (bf16*)(F.ws + WS_WOUT);
    bf16* WGU = (bf16*)(F.ws + WS_WGU); bf16* WD = (bf16*)(F.ws + WS_WD);
    constexpr int I_IN = 16 * (NCOL / 32), I_A = 8 * 32, I_B = 4 * 32, I_C = 8 * 32, I_O = 16 * 32, I_G = 16 * 16, I_D = 8 * 32;
    constexpr int I_LAYER = I_IN + I_A + I_B + I_C + I_O + NE * (2 * I_G + I_D);
    for (int it = gw; it < DEPTH * I_LAYER; it += NGW) {
        const int l = it / I_LAYER; int r = it % I_LAYER;
        if (r < I_IN) { const int nb = r % (NCOL / 32), kb = r / (NCOL / 32); p0_item(w_in + (size_t)l * D * NCOL, NCOL, 64 * kb, 32 * nb, WIN + (size_t)l * NCOL * D, D, 32 * nb, is_q_col(32 * nb) ? QSCALE : 1.0f, scr, lane); continue; } r -= I_IN;
        if (r < I_A) { const int nb = r % 32, kb = r / 32; p0_item(w_a + (size_t)l * 512 * D, D, 64 * kb, 32 * nb, WBRA + (size_t)l * D * 512, 512, 32 * nb, 1.0f, scr, lane); continue; } r -= I_A;
        if (r < I_B) { const int nb = r % 32, kb = r / 32; p0_item(w_b + (size_t)l * 256 * D, D, 64 * kb, 32 * nb, WBRB + (size_t)l * D * 256, 256, 32 * nb, 1.0f, scr, lane); continue; } r -= I_B;
        if (r < I_C) { const int nb = r % 32, kb = r / 32; p0_item(w_c + (size_t)l * 512 * D, D, 64 * kb, 32 * nb, WBRC + (size_t)l * D * 512, 512, 32 * nb, 1.0f, scr, lane); continue; } r -= I_C;
        if (r < I_O) { const int nb = r % 32, kb = r / 32; p0_item(w_o + (size_t)l * D * D, D, 64 * kb, 32 * nb, WOUT + (size_t)l * D * D, D, 32 * nb, 1.0f, scr, lane); continue; } r -= I_O;
        const int e = r / (2 * I_G + I_D); r %= (2 * I_G + I_D); const size_t le = (size_t)l * NE + e;
        if (r < 2 * I_G) { const int up = r / I_G; r %= I_G; const int nb = r % 16, kb = r / 16;
            p0_item((up ? w_eu : w_eg) + le * D * DE, DE, 64 * kb, 32 * nb, WGU + le * 1024 * 1024, D, (nb >> 2) * 256 + up * 128 + (nb & 3) * 32, 1.0f, scr, lane); continue; }
        r -= 2 * I_G; { const int nb = r % 32, kb = r / 32; p0_item(w_ed + le * DE * D, D, 64 * kb, 32 * nb, WD + le * D * DE, DE, 32 * nb, 1.0f, scr, lane); }
    }
}

template <int MODE> __device__ __forceinline__ void ln_row(const float* src, float* h, bf16* hb, const bf16* yb, const float* g, const float* bta, size_t row, int lane, f32x4 (&o)[4]) {
    f32x4 v[4];
#pragma unroll
    for (int j = 0; j < 4; ++j) {
        const int c = lane * 4 + 256 * j;
        v[j] = *(const f32x4*)((MODE == 0 ? src : h) + row * D + c);
        if (MODE == 2) {
            const uint2 a = *(const uint2*)(yb + (row * 2) * D + c), b = *(const uint2*)(yb + (row * 2 + 1) * D + c);
            v[j].x = ALPHA * v[j].x + bf2f((bf16)(a.x & 0xffff)) + bf2f((bf16)(b.x & 0xffff));
            v[j].y = ALPHA * v[j].y + bf2f((bf16)(a.x >> 16)) + bf2f((bf16)(b.x >> 16));
            v[j].z = ALPHA * v[j].z + bf2f((bf16)(a.y & 0xffff)) + bf2f((bf16)(b.y & 0xffff));
            v[j].w = ALPHA * v[j].w + bf2f((bf16)(a.y >> 16)) + bf2f((bf16)(b.y >> 16));
        }
    }
    float s = 0.f;
#pragma unroll
    for (int j = 0; j < 4; ++j) s += (v[j].x + v[j].y) + (v[j].z + v[j].w);
    const float mean = wave_sum(s) * (1.f / D);
    float q = 0.f;
#pragma unroll
    for (int j = 0; j < 4; ++j) { v[j] = v[j] - mean; q += (v[j].x * v[j].x + v[j].y * v[j].y) + (v[j].z * v[j].z + v[j].w * v[j].w); }
    const float rstd = 1.0f / sqrtf(wave_sum(q) * (1.f / D) + LN_EPS);
#pragma unroll
    for (int j = 0; j < 4; ++j) {
        const int c = lane * 4 + 256 * j;
        const f32x4 gg = *(const f32x4*)(g + c), bb = *(const f32x4*)(bta + c);
        o[j] = v[j] * rstd * gg + bb;
        *(f32x4*)(h + row * D + c) = o[j];
        if (hb) { uint2 w; w.x = pk2(o[j].x, o[j].y); w.y = pk2(o[j].z, o[j].w); *(uint2*)(hb + row * D + c) = w; }
    }
}

struct EpiP1 {
    static constexpr bool PERM = true;
    bf16* qkv; bf16* gates; const float* b_gate;
    __device__ __forceinline__ void operator()(const f32x4 (&acc)[2][2][4][2], const pg8::Unit& u, int wr, int wc, int fr, int fq) const {
        const int row0 = u.pm * 256 + wr * 64 + fr; const bool isg = u.pn >= 18;
        bf16* base = isg ? gates : qkv; const int ldc = isg ? GATEW : QKVW; const int col0 = (isg ? (u.pn - 18) : u.pn) * 256 + wc * 32 + 8 * fq;
        f32x4 bv[2][2];
#pragma unroll
        for (int bj = 0; bj < 2; ++bj)
#pragma unroll
            for (int n = 0; n < 2; ++n) bv[bj][n] = isg ? *(const f32x4*)(b_gate + col0 + bj * 128 + 4 * n) : (f32x4){0.f, 0.f, 0.f, 0.f};
#pragma unroll
        for (int ai = 0; ai < 2; ++ai)
#pragma unroll
            for (int m = 0; m < 4; ++m) { bf16* rowp = base + (size_t)(row0 + ai * 128 + m * 16) * ldc + col0;
#pragma unroll
                for (int bj = 0; bj < 2; ++bj) { f32x4 v0 = acc[ai][bj][m][0] + bv[bj][0], v1 = acc[ai][bj][m][1] + bv[bj][1];
                    if (isg) {
#pragma unroll
                        for (int j = 0; j < 4; ++j) { v0[j] = __builtin_amdgcn_rcpf(1.0f + __builtin_amdgcn_exp2f(-LOG2E * v0[j])); v1[j] = __builtin_amdgcn_rcpf(1.0f + __builtin_amdgcn_exp2f(-LOG2E * v1[j])); } }
                    v4u w; w.x = pg8::cvt_pk_bf16(v0[0], v0[1]); w.y = pg8::cvt_pk_bf16(v0[2], v0[3]); w.z = pg8::cvt_pk_bf16(v1[0], v1[1]); w.w = pg8::cvt_pk_bf16(v1[2], v1[3]);
                    *(v4u*)(rowp + bj * 128) = w; } }
    }
};
template <bool FIRST> struct EpiP3 {
    static constexpr bool PERM = true;
    bf16* merged; const bf16* gates; int br;
    __device__ __forceinline__ void operator()(const f32x4 (&acc)[2][2][4][2], const pg8::Unit& u, int wr, int wc, int fr, int fq) const {
        const int row0 = u.pm * 256 + wr * 64 + fr, col0 = u.pn * 256 + wc * 32 + 8 * fq;
#pragma unroll
        for (int ai = 0; ai < 2; ++ai)
#pragma unroll
            for (int m = 0; m < 4; ++m) { const size_t row = (size_t)(row0 + ai * 128 + m * 16);
#pragma unroll
                for (int bj = 0; bj < 2; ++bj) {
                    const v4u gw = *(const v4u*)(gates + row * GATEW + br * 1024 + col0 + bj * 128);
                    v4u ow = FIRST ? (v4u){0u, 0u, 0u, 0u} : *(const v4u*)(merged + row * D + col0 + bj * 128);
                    const f32x4 a0 = acc[ai][bj][m][0], a1 = acc[ai][bj][m][1];
                    float r[8];
#pragma unroll
                    for (int j = 0; j < 4; ++j) { const unsigned g2 = gw[j], o2 = ow[j]; const float av0 = j < 2 ? a0[2 * j] : a1[2 * j - 4], av1 = j < 2 ? a0[2 * j + 1] : a1[2 * j - 3];
                        r[2 * j] = __uint_as_float(g2 << 16) * av0 + (FIRST ? 0.f : __uint_as_float(o2 << 16)); r[2 * j + 1] = __uint_as_float(g2 & 0xffff0000u) * av1 + (FIRST ? 0.f : __uint_as_float(o2 & 0xffff0000u)); }
                    v4u w; w.x = pg8::cvt_pk_bf16(r[0], r[1]); w.y = pg8::cvt_pk_bf16(r[2], r[3]); w.z = pg8::cvt_pk_bf16(r[4], r[5]); w.w = pg8::cvt_pk_bf16(r[6], r[7]);
                    *(v4u*)(merged + row * D + col0 + bj * 128) = w; }
                asm volatile("" ::: "memory"); }
    }
};
struct EpiP4 {
    static constexpr bool PERM = false;
    float* hc;
    __device__ __forceinline__ void operator()(const f32x4 (&acc)[2][2][4][2], const pg8::Unit& u, int wr, int wc, int fr, int fq) const {
        const int row0 = u.pm * 256 + wr * 64 + fr, col0 = u.pn * 256 + wc * 32 + 4 * fq;
#pragma unroll
        for (int ai = 0; ai < 2; ++ai)
#pragma unroll
            for (int m = 0; m < 4; ++m) { float* rowp = hc + (size_t)(row0 + ai * 128 + m * 16) * D + col0;
#pragma unroll
                for (int bj = 0; bj < 2; ++bj)
#pragma unroll
                    for (int n = 0; n < 2; ++n) { f32x4* p = (f32x4*)(rowp + bj * 128 + n * 16); *p = *p * ALPHA + acc[ai][bj][m][n]; }
                asm volatile("" ::: "memory"); }
    }
};
struct EpiP7 {
    static constexpr bool PERM = true;
    bf16* hid;
    __device__ __forceinline__ void operator()(const f32x4 (&acc)[2][2][4][2], const pg8::Unit& u, int wr, int wc, int fr, int fq) const {
        const int row0 = u.pm * 256 + wr * 64 + fr, col0 = u.pn * 128 + wc * 32 + 8 * fq;
#pragma unroll
        for (int ai = 0; ai < 2; ++ai)
#pragma unroll
            for (int m = 0; m < 4; ++m) { float r[8];
#pragma unroll
                for (int n = 0; n < 2; ++n)
#pragma unroll
                    for (int j = 0; j < 4; ++j) { const float gv = acc[ai][0][m][n][j], uv = acc[ai][1][m][n][j]; r[4 * n + j] = gv * __builtin_amdgcn_rcpf(1.0f + __builtin_amdgcn_exp2f(-LOG2E * gv)) * uv; }
                v4u w; w.x = pg8::cvt_pk_bf16(r[0], r[1]); w.y = pg8::cvt_pk_bf16(r[2], r[3]); w.z = pg8::cvt_pk_bf16(r[4], r[5]); w.w = pg8::cvt_pk_bf16(r[6], r[7]);
                *(v4u*)(hid + (size_t)(row0 + ai * 128 + m * 16) * DE + col0) = w; }
    }
};
struct EpiP8 {
    static constexpr bool PERM = true;
    bf16* yb; const int* rowtok; const float* rowgate;
    __device__ __forceinline__ void operator()(const f32x4 (&acc)[2][2][4][2], const pg8::Unit& u, int wr, int wc, int fr, int fq) const {
        const int row0 = u.pm * 256 + wr * 64 + fr, col0 = u.pn * 256 + wc * 32 + 8 * fq;
#pragma unroll
        for (int ai = 0; ai < 2; ++ai)
#pragma unroll
            for (int m = 0; m < 4; ++m) { const int row = row0 + ai * 128 + m * 16; const int rt = rowtok[row]; const float gt = rowgate[row];
                if (rt >= 0) {
#pragma unroll
                    for (int bj = 0; bj < 2; ++bj) { const f32x4 v0 = acc[ai][bj][m][0] * gt, v1 = acc[ai][bj][m][1] * gt;
                        v4u w; w.x = pg8::cvt_pk_bf16(v0[0], v0[1]); w.y = pg8::cvt_pk_bf16(v0[2], v0[3]); w.z = pg8::cvt_pk_bf16(v1[0], v1[1]); w.w = pg8::cvt_pk_bf16(v1[2], v1[3]);
                        *(v4u*)(yb + (size_t)rt * D + col0 + bj * 128) = w; } } }
    }
};

__device__ __forceinline__ void router_row(const float (&x)[16], int t, int lane, const float* w_rg, const float* b_rg, const float* w_re, const float* b_re, int* cnt, Rec* rec) {
    float gl[4] = {0.f, 0.f, 0.f, 0.f};
#pragma unroll
    for (int j = 0; j < 4; ++j)
#pragma unroll
        for (int i = 0; i < 4; ++i) { const f32x4 w = *(const f32x4*)(w_rg + (size_t)(lane * 4 + 256 * j + i) * 4); const float xv = x[4 * j + i]; gl[0] += xv * w.x; gl[1] += xv * w.y; gl[2] += xv * w.z; gl[3] += xv * w.w; }
#pragma unroll
    for (int g = 0; g < 4; ++g) gl[g] = wave_sum(gl[g]) + b_rg[g];
    int gi = 0; float gm = gl[0];
#pragma unroll
    for (int g = 1; g < 4; ++g) if (gl[g] > gm) { gm = gl[g]; gi = g; }
    float gs = 0.f;
#pragma unroll
    for (int g = 0; g < 4; ++g) gs += __expf(gl[g] - gm);
    const float gw = 1.0f / gs;
    float el[8];
#pragma unroll
    for (int e = 0; e < 8; ++e) el[e] = 0.f;
    const float* wre = w_re + (size_t)gi * D * 8;
#pragma unroll
    for (int j = 0; j < 4; ++j)
#pragma unroll
        for (int i = 0; i < 4; ++i) { const float* wp = wre + (size_t)(lane * 4 + 256 * j + i) * 8; const f32x4 w0 = *(const f32x4*)wp, w1 = *(const f32x4*)(wp + 4); const float xv = x[4 * j + i];
            el[0] += xv * w0.x; el[1] += xv * w0.y; el[2] += xv * w0.z; el[3] += xv * w0.w; el[4] += xv * w1.x; el[5] += xv * w1.y; el[6] += xv * w1.z; el[7] += xv * w1.w; }
#pragma unroll
    for (int e = 0; e < 8; ++e) el[e] = wave_sum(el[e]) + b_re[gi * 8 + e];
    int i0 = 0; float t0 = el[0];
#pragma unroll
    for (int e = 1; e < 8; ++e) if (el[e] > t0) { t0 = el[e]; i0 = e; }
    int i1 = -1; float t1 = -3.0e38f;
#pragma unroll
    for (int e = 0; e < 8; ++e) if (e != i0 && el[e] > t1) { t1 = el[e]; i1 = e; }
    const float ex = __expf(t1 - t0), p0 = 1.0f / (1.0f + ex), p1 = ex / (1.0f + ex);
    if (lane == 0) {
        Rec rc; rc.e0 = gi * 8 + i0; rc.e1 = gi * 8 + i1; rc.g0 = gw * p0; rc.g1 = gw * p1; rc.pad0 = 0; rc.pad1 = 0;
        rc.s0 = atomicAdd(cnt + rc.e0, 1); rc.s1 = atomicAdd(cnt + rc.e1, 1);
        rec[t] = rc;
    }
}

__device__ __forceinline__ void ph_ln0(Frame& F) { LAUNDER(F);
    const int gw = F.vcu * NWAVES + F.wave, NGW = F.G * NWAVES;
    bf16* hb = (bf16*)(F.ws + WS_HB);
    for (int m = gw; m < T; m += NGW) { f32x4 o[4]; ln_row<0>(F.in[0], F.h, hb, nullptr, F.in[1], F.in[2], (size_t)m, F.lane, o); }
}
__device__ __forceinline__ void ph_p1(Frame& F, int l, int c) { LAUNDER(F);
    pg8::DenseOrder S; S.init((const bf16*)(F.ws + WS_HB) + (size_t)c * CH * D, D, (const bf16*)(F.ws + WS_WIN) + (size_t)l * NCOL * D, D, CH, NCOL, F.G, (int)blockIdx.x);
    EpiP1 E{(bf16*)(F.ws + WS_QKV), (bf16*)(F.ws + WS_GATES), F.in[5] + (size_t)l * GATEW};
    pg8::gemm_phase<EpiP1, pg8::DenseOrder, false>(F.lds + RING_OFF, S, E, D, D, D);
}
__device__ __forceinline__ void ph_cmb(Frame& F) { LAUNDER(F);
    const bf16* og = (const bf16*)(F.ws + WS_OG); const float* lse = (const float*)(F.ws + WS_LSE); bf16* oabc = (bf16*)(F.ws + WS_OABC);
    for (int idx = F.vcu * NTHREADS + F.tid; idx < CH * 32; idx += F.G * NTHREADS) {
        const int tl = idx >> 5, hc = idx & 31, h = hc >> 3, c = hc & 7;
        const float l0 = lse[((size_t)tl * 3 + 0) * 4 + h], l1 = lse[((size_t)tl * 3 + 1) * 4 + h], l2 = lse[((size_t)tl * 3 + 2) * 4 + h];
        const float mx = fmaxf(l0, fmaxf(l1, l2)); float w0 = __expf(l0 - mx), w1 = __expf(l1 - mx), w2 = __expf(l2 - mx); const float inv = 1.0f / (w0 + w1 + w2); w0 *= inv; w1 *= inv; w2 *= inv;
        const v4u a = *(const v4u*)(og + ((size_t)tl * 3 + 0) * 256 + h * 64 + c * 8), b = *(const v4u*)(og + ((size_t)tl * 3 + 1) * 256 + h * 64 + c * 8), d = *(const v4u*)(og + ((size_t)tl * 3 + 2) * 256 + h * 64 + c * 8);
        v4u ow;
#pragma unroll
        for (int i = 0; i < 4; ++i) {
            const float lo = w0 * __uint_as_float(a[i] << 16) + w1 * __uint_as_float(b[i] << 16) + w2 * __uint_as_float(d[i] << 16);
            const float hi = w0 * __uint_as_float(a[i] & 0xffff0000u) + w1 * __uint_as_float(b[i] & 0xffff0000u) + w2 * __uint_as_float(d[i] & 0xffff0000u);
            ow[i] = pk2(lo, hi);
        }
        *(v4u*)(oabc + (size_t)tl * OW + 512 + h * 64 + c * 8) = ow;
    }
}
__device__ __forceinline__ void ph_p3(Frame& F, int l) { LAUNDER(F);
    const bf16* oabc = (const bf16*)(F.ws + WS_OABC); bf16* merged = (bf16*)(F.ws + WS_MERGED); const bf16* gates = (const bf16*)(F.ws + WS_GATES);
    { pg8::DenseOrder S; S.init(oabc, OW, (const bf16*)(F.ws + WS_WBRA) + (size_t)l * D * 512, 512, CH, D, F.G, (int)blockIdx.x);
      EpiP3<true> E{merged, gates, 0}; pg8::gemm_phase<EpiP3<true>, pg8::DenseOrder, false>(F.lds + RING_OFF, S, E, 512, OW, 512); }
    { pg8::DenseOrder S; S.init(oabc + 512, OW, (const bf16*)(F.ws + WS_WBRB) + (size_t)l * D * 256, 256, CH, D, F.G, (int)blockIdx.x);
      EpiP3<false> E{merged, gates, 1}; pg8::gemm_phase<EpiP3<false>, pg8::DenseOrder, false>(F.lds + RING_OFF, S, E, 256, OW, 256); }
    { pg8::DenseOrder S; S.init(oabc + 768, OW, (const bf16*)(F.ws + WS_WBRC) + (size_t)l * D * 512, 512, CH, D, F.G, (int)blockIdx.x);
      EpiP3<false> E{merged, gates, 2}; pg8::gemm_phase<EpiP3<false>, pg8::DenseOrder, false>(F.lds + RING_OFF, S, E, 512, OW, 512); }
}
__device__ __forceinline__ void ph_p4(Frame& F, int l, int c) { LAUNDER(F);
    pg8::DenseOrder S; S.init((const bf16*)(F.ws + WS_MERGED), D, (const bf16*)(F.ws + WS_WOUT) + (size_t)l * D * D, D, CH, D, F.G, (int)blockIdx.x);
    EpiP4 E{F.h + (size_t)c * CH * D};
    pg8::gemm_phase<EpiP4, pg8::DenseOrder, false>(F.lds + RING_OFF, S, E, D, D, D);
}
__device__ __forceinline__ void ph_ln1(Frame& F, int l, int c) { LAUNDER(F);
    const int gw = F.vcu * NWAVES + F.wave, NGW = F.G * NWAVES;
    bf16* hb = (bf16*)(F.ws + WS_HB); int* cnt = (int*)(F.ws + WS_CTL) + CW_CNT + l * 32; Rec* rec = (Rec*)(F.ws + WS_REC);
    for (int m = gw; m < CH; m += NGW) {
        const size_t row = (size_t)c * CH + m; f32x4 o[4];
        ln_row<1>(nullptr, F.h, hb, nullptr, F.in[12] + l * D, F.in[13] + l * D, row, F.lane, o);
        float x[16];
#pragma unroll
        for (int j = 0; j < 4; ++j) { x[4 * j] = o[j].x; x[4 * j + 1] = o[j].y; x[4 * j + 2] = o[j].z; x[4 * j + 3] = o[j].w; }
        router_row(x, (int)row, F.lane, F.in[14] + (size_t)l * D * 4, F.in[15] + l * 4, F.in[16] + (size_t)l * 4 * D * 8, F.in[17] + l * 32, cnt, rec);
    }
}
__device__ __forceinline__ void ph_dsp(Frame& F, int l) { LAUNDER(F);
    LAS int* po = (LAS int*)(F.lds + ROWS_OFF);
    const int* cnt = (const int*)(F.ws + WS_CTL) + CW_CNT + l * 32; const Rec* rec = (const Rec*)(F.ws + WS_REC); int* rowtok = (int*)(F.ws + WS_ROWTOK); float* rowgate = (float*)(F.ws + WS_ROWGATE);
    if (F.tid == 0) { int acc = 0; for (int e = 0; e < NE; ++e) { po[e] = acc; acc += (cnt[e] + 255) / 256 * 256; } po[NE] = acc; }
    __syncthreads();
    const int gt = F.vcu * NTHREADS + F.tid, GT = F.G * NTHREADS;
    for (int t = gt; t < T; t += GT) {
        const Rec rc = rec[t];
        const int d0 = po[rc.e0] + rc.s0, d1 = po[rc.e1] + rc.s1;
        rowtok[d0] = 2 * t; rowgate[d0] = rc.g0; rowtok[d1] = 2 * t + 1; rowgate[d1] = rc.g1;
    }
    for (int e = 0; e < NE; ++e) for (int r = po[e] + cnt[e] + gt; r < po[e + 1]; r += GT) { rowtok[r] = -1; rowgate[r] = 0.f; }
    __syncthreads();
}
__device__ __forceinline__ int moe_setup(Frame& F, int l, bool gather) { LAUNDER(F);
    LAS int* rows = (LAS int*)(F.lds + ROWS_OFF); LAS int* ulist = rows + 11 * 256; LAS int* po = ulist + 16;
    const int* cnt = (const int*)(F.ws + WS_CTL) + CW_CNT + l * 32; const int* rowtok = (const int*)(F.ws + WS_ROWTOK);
    if (F.tid == 0) { int acc = 0; for (int e = 0; e < NE; ++e) { po[e] = acc; acc += (cnt[e] + 255) / 256 * 256; } po[NE] = acc; }
    __syncthreads();
    const int nu_all = (po[NE] / 256) * 4; int nun = (nu_all - F.vcu + F.G - 1) / F.G; nun = nun < 0 ? 0 : (nun > 11 ? 11 : nun);
    if (F.tid < nun) { const int Lx = F.tid * F.G + F.vcu, rt = Lx >> 2, pn = Lx & 3; int e = 0; while (e < NE - 1 && po[e + 1] <= rt * 256) ++e; ulist[F.tid] = (rt << 8) | (e << 2) | pn; }
    if (gather) for (int idx = F.tid; idx < nun * 256; idx += NTHREADS) { const int i = idx >> 8, r = idx & 255, Lx = i * F.G + F.vcu; rows[idx] = rowtok[(Lx >> 2) * 256 + r]; }
    __syncthreads();
    return nun;
}
struct MoeOrder {
    int nun; const LAS int* ulist; const LAS int* rows; const char* A; const char* B; size_t tstepA, estepB, tstepB;
    __device__ __forceinline__ bool next(int i, pg8::Unit& u) const {
        if (i >= nun) return false;
        const int w = __builtin_amdgcn_readfirstlane(ulist[i]); u.pm = w >> 8; u.e = (w >> 2) & 63; u.pn = w & 3; u.ui = i; return true;
    }
    __device__ __forceinline__ const char* a_base(const pg8::Unit& u) const { return A + (size_t)u.pm * tstepA; }
    __device__ __forceinline__ const char* b_base(const pg8::Unit& u) const { return B + (size_t)u.e * estepB + (size_t)u.pn * tstepB; }
    __device__ __forceinline__ int a_row(const pg8::Unit& u, int r) const { const int t = rows[u.ui * 256 + r]; return t < 0 ? 0 : (t >> 1); }
};
__device__ __forceinline__ void ph_p7(Frame& F, int l) { LAUNDER(F);
    const int nun = moe_setup(F, l, true);
    LAS int* rows = (LAS int*)(F.lds + ROWS_OFF);
    MoeOrder S{nun, rows + 11 * 256, rows, (const char*)(F.ws + WS_HB), (const char*)(F.ws + WS_WGU) + (size_t)l * NE * 1024 * 1024 * 2, 0, (size_t)1024 * 1024 * 2, (size_t)256 * 1024 * 2};
    EpiP7 E{(bf16*)(F.ws + WS_HID)};
    pg8::gemm_phase<EpiP7, MoeOrder, true>(F.lds + RING_OFF, S, E, D, D, D);
}
__device__ __forceinline__ void ph_p8(Frame& F, int l) { LAUNDER(F);
    const int nun = moe_setup(F, l, false);
    LAS int* rows = (LAS int*)(F.lds + ROWS_OFF);
    MoeOrder S{nun, rows + 11 * 256, rows, (const char*)(F.ws + WS_HID), (const char*)(F.ws + WS_WD) + (size_t)l * NE * 1024 * 512 * 2, (size_t)256 * DE * 2, (size_t)1024 * 512 * 2, (size_t)256 * 512 * 2};
    EpiP8 E{(bf16*)(F.ws + WS_YB), (const int*)(F.ws + WS_ROWTOK), (const float*)(F.ws + WS_ROWGATE)};
    pg8::gemm_phase<EpiP8, MoeOrder, false>(F.lds + RING_OFF, S, E, DE, DE, DE);
}
__device__ __forceinline__ void ph_ln2(Frame& F, int l) { LAUNDER(F);
    const int gw = F.vcu * NWAVES + F.wave, NGW = F.G * NWAVES;
    bf16* hb = (l == DEPTH - 1) ? nullptr : (bf16*)(F.ws + WS_HB);
    for (int m = gw; m < T; m += NGW) { f32x4 o[4]; ln_row<2>(nullptr, F.h, hb, (const bf16*)(F.ws + WS_YB), F.in[21] + l * D, F.in[22] + l * D, (size_t)m, F.lane, o); }
}

typedef short s16x4 __attribute__((ext_vector_type(4)));
constexpr int NT_A = (CH / 32) * 8, NT_B = (CH / L) * 3 * 256 * 4, NT_C = (CH / 32) * 8, NT_ALL = NT_A + NT_B + NT_C;
constexpr float NEGBIG = -1.0e30f, MINIT = -5.0e29f;
#define RC16(reg) (((reg) & 3) + 8 * ((reg) >> 2))

__device__ __forceinline__ void ph_tables(Frame& F) { LAUNDER(F);
    float* TA = (float*)(F.ws + WS_TABA); float* TB = (float*)(F.ws + WS_TABB); float* TC = (float*)(F.ws + WS_TABC);
    const float* rel_bias = F.in[3]; const float* rpb = F.in[7];
    const int gt = F.vcu * NTHREADS + F.tid, GT = F.G * NTHREADS;
    for (int i = gt; i < 8 * 320; i += GT) { const int h = i / 320, rel = i % 320 - 160; TA[i] = (rel >= -128 && rel <= 128) ? rel_bias[BUCK_A[rel + 128] * 20 + h] * LOG2E : NEGBIG; }
    for (int i = gt; i < 12 * 192; i += GT) { const int gh = i / 192, g = gh >> 2, rel = i % 192 - 96; TB[i] = (rel >= -64 && rel <= 64) ? rel_bias[BUCK_B[g][rel + 64] * 20 + 8 + gh] * LOG2E : NEGBIG; }
    for (int i = gt; i < DEPTH * 8 * 1024; i += GT) { const int lh = i >> 10, ri = (i >> 6) & 15, ci = (i & 63) - 16; TC[i] = (ri < 15 && ci >= 0 && ci <= 30) ? rpb[((size_t)lh * 15 + ri) * 31 + ci] * LOG2E : NEGBIG; }
}

template <int TYPE>
__device__ __forceinline__ void att_task(LAS unsigned char* wl, const int lane, const bf16* seq  , const float* tabsrc,
                                         const int qcol, const int kcol, const int vcol, const int TT0, const int TSTEP, const int kstride, const int tlo, const int thi,
                                         const int tq  , const int ci_i  , const int ci_c  , const int cbs,
                                         const float m_init, const float l_init, bf16* orow  , float* lse_out) {
    const int qi = lane & 31, hh = lane >> 5;
    LAS unsigned char* kt = wl; LAS unsigned char* vt = wl + 4096; LAS float* tb = (LAS float*)(wl + 8192);
    constexpr int TBN = TYPE == 0 ? 320 : (TYPE == 1 ? 192 : 1024);
#pragma unroll
    for (int i = 0; i < TBN / 64; ++i) tb[lane + 64 * i] = tabsrc[lane + 64 * i];
    bf16x8 Qf[4];
#pragma unroll
    for (int s = 0; s < 4; ++s) Qf[s] = *(const bf16x8*)(seq + (size_t)tq * QKVW + qcol + 16 * s + 8 * hh);
    f32x16 O0, O1;
#pragma unroll
    for (int i = 0; i < 16; ++i) { O0[i] = 0.f; O1[i] = 0.f; }
    float m = m_init, l = l_init;
    const int lkey = lane >> 3, lch = lane & 7;
    const bf16* gk = seq + (size_t)(lkey * kstride) * QKVW + 8 * lch;
    const size_t istep = (size_t)8 * kstride * QKVW;
    unsigned kwoff[4], vwoff[4];
#pragma unroll
    for (int i = 0; i < 4; ++i) { const int key = lkey + 8 * i; kwoff[i] = key * 128 + ((lch ^ (key & 7)) << 4); vwoff[i] = key * 128 + (((lch >> 2) ^ ((key >> 1) & 1)) << 6) + ((lch & 3) << 4); }
    unsigned kroff[4];
#pragma unroll
    for (int s = 0; s < 4; ++s) kroff[s] = qi * 128 + (((2 * s + hh) ^ (qi & 7)) << 4);
    const int q4 = (lane & 15) >> 2, p4 = lane & 3, g1 = (lane >> 4) & 1, sw = (q4 >> 1) & 1;
    const unsigned vr0 = (4 * hh + q4) * 128 + 32 * g1 + 8 * p4 + (sw << 6), vr1 = (4 * hh + q4) * 128 + 32 * g1 + 8 * p4 + ((sw ^ 1) << 6);
    const int bidx0 = (TYPE == 2) ? (cbs - ci_c + 31 + 4 * hh) : (32 - qi + 4 * hh);
    int cs = ci_c - 8; cs = cs < 0 ? 0 : (cs > 48 ? 48 : cs);
    const int xm = cbs - cs + 4 * hh;
    int rs_i = ci_i - 4; rs_i = rs_i < 0 ? 0 : (rs_i > 120 ? 120 : rs_i);
    v4u kreg[4], vreg[4];
    {
        const bf16* gt0 = gk + (size_t)(TT0 + tlo * TSTEP) * QKVW;
#pragma unroll
        for (int i = 0; i < 4; ++i) { kreg[i] = *(const v4u*)(gt0 + i * istep + kcol); vreg[i] = *(const v4u*)(gt0 + i * istep + vcol); }
    }
    for (int ti = tlo; ti <= thi; ++ti) {
#pragma unroll
        for (int i = 0; i < 4; ++i) { *(LAS v4u*)(kt + kwoff[i]) = kreg[i]; *(LAS v4u*)(vt + vwoff[i]) = vreg[i]; }
        if (ti < thi) {
            const bf16* gt0 = gk + (size_t)(TT0 + (ti + 1) * TSTEP) * QKVW;
#pragma unroll
            for (int i = 0; i < 4; ++i) { kreg[i] = *(const v4u*)(gt0 + i * istep + kcol); vreg[i] = *(const v4u*)(gt0 + i * istep + vcol); }
        }
        f32x16 S;
#pragma unroll
        for (int i = 0; i < 16; ++i) S[i] = 0.f;
#pragma unroll
        for (int s = 0; s < 4; ++s) { const bf16x8 Kf = *(const LAS bf16x8*)(kt + kroff[s]); S = __builtin_amdgcn_mfma_f32_32x32x16_bf16(Kf, Qf[s], S, 0, 0, 0); }
        int bidx;
        if (TYPE == 2) { const bool rv = (ti >= rs_i) && (ti < rs_i + 8); bidx = bidx0 + (rv ? (ti - ci_i + 7) : 15) * 64; }
        else bidx = bidx0 + 32 * ti;
        float tmax = NEGBIG;
#pragma unroll
        for (int r = 0; r < 16; ++r) { float v = S[r] + tb[bidx + RC16(r)]; if (TYPE == 2) v = ((unsigned)(xm + RC16(r)) < 16u) ? v : NEGBIG; S[r] = v; tmax = fmaxf(tmax, v); }
        tmax = fmaxf(tmax, __shfl_xor(tmax, 32));
        const float mn = fmaxf(m, tmax), corr = __builtin_amdgcn_exp2f(m - mn);
        float rsum = 0.f;
#pragma unroll
        for (int r = 0; r < 16; ++r) { const float p = __builtin_amdgcn_exp2f(S[r] - mn); S[r] = p; rsum += p; }
        rsum += __shfl_xor(rsum, 32);
        l = l * corr + rsum; m = mn;
#pragma unroll
        for (int i = 0; i < 16; ++i) { O0[i] *= corr; O1[i] *= corr; }
#pragma unroll
        for (int s2 = 0; s2 < 2; ++s2) {
            bf16x8 Pf; unsigned pw[4];
#pragma unroll
            for (int j = 0; j < 4; ++j) pw[j] = pg8::cvt_pk_bf16(S[8 * s2 + 2 * j], S[8 * s2 + 2 * j + 1]);
            Pf = __builtin_bit_cast(bf16x8, (v4u){pw[0], pw[1], pw[2], pw[3]});
            const s16x4 a00 = __builtin_amdgcn_ds_read_tr16_b64_v4i16((LAS s16x4*)(vt + vr0 + (16 * s2) * 128));
            const s16x4 a01 = __builtin_amdgcn_ds_read_tr16_b64_v4i16((LAS s16x4*)(vt + vr0 + (16 * s2 + 8) * 128));
            const s16x4 a10 = __builtin_amdgcn_ds_read_tr16_b64_v4i16((LAS s16x4*)(vt + vr1 + (16 * s2) * 128));
            const s16x4 a11 = __builtin_amdgcn_ds_read_tr16_b64_v4i16((LAS s16x4*)(vt + vr1 + (16 * s2 + 8) * 128));
            const bf16x8 V0 = (bf16x8){a00[0], a00[1], a00[2], a00[3], a01[0], a01[1], a01[2], a01[3]};
            const bf16x8 V1 = (bf16x8){a10[0], a10[1], a10[2], a10[3], a11[0], a11[1], a11[2], a11[3]};
            O0 = __builtin_amdgcn_mfma_f32_32x32x16_bf16(V0, Pf, O0, 0, 0, 0);
            O1 = __builtin_amdgcn_mfma_f32_32x32x16_bf16(V1, Pf, O1, 0, 0, 0);
        }
    }
    const float inv = 1.0f / l;
#pragma unroll
    for (int g = 0; g < 4; ++g) {
        v2u w0, w1;
        w0.x = pg8::cvt_pk_bf16(O0[4 * g] * inv, O0[4 * g + 1] * inv); w0.y = pg8::cvt_pk_bf16(O0[4 * g + 2] * inv, O0[4 * g + 3] * inv);
        w1.x = pg8::cvt_pk_bf16(O1[4 * g] * inv, O1[4 * g + 1] * inv); w1.y = pg8::cvt_pk_bf16(O1[4 * g + 2] * inv, O1[4 * g + 3] * inv);
        *(v2u*)(orow + 8 * g + 4 * hh) = w0; *(v2u*)(orow + 32 + 8 * g + 4 * hh) = w1;
    }
    if (TYPE == 1 && hh == 0) *lse_out = (m + __builtin_amdgcn_logf(l)) * LN2;
}

__device__ __forceinline__ void ph_att(Frame& F, int l) { LAUNDER(F);
    const int lane = F.lane, qi = lane & 31;
    LAS unsigned char* wl = F.lds + RING_OFF + F.wave * 16384;
    const bf16* qkv = (const bf16*)(F.ws + WS_QKV); bf16* oabc = (bf16*)(F.ws + WS_OABC); bf16* og = (bf16*)(F.ws + WS_OG); float* lse = (float*)(F.ws + WS_LSE);
    const float* TA = (const float*)(F.ws + WS_TABA); const float* TB = (const float*)(F.ws + WS_TABB); const float* TC = (const float*)(F.ws + WS_TABC) + (size_t)l * 8 * 1024;
    const float* sink = F.in[6] + l * 8;
    const int gw = F.vcu * NWAVES + F.wave, NGW = F.G * NWAVES;
    for (int task = gw; task < NT_ALL; task += NGW) {
        if (task < NT_A) {
            const int hq = task & 7, qb = (task >> 3) & 255, b = task >> 11, q0 = qb * 32;
            int tlo = 0, thi = 8; if (q0 - 128 < 0) tlo = (128 - q0) / 32; if (q0 + 128 + 31 >= L) thi = (L - 1 - (q0 - 128)) / 32;
            const int tq = q0 + qi;
            att_task<0>(wl, lane, qkv + (size_t)b * L * QKVW, TA + hq * 320, AQ + hq * 64, AK + (hq >> 2) * 64, AV + (hq >> 2) * 64, q0 - 128, 32, 1, tlo, thi, tq, 0, 0, 0,
                        sink[hq] * LOG2E, 1.0f, oabc + (size_t)(b * L + tq) * OW + hq * 64, nullptr);
        } else if (task < NT_A + NT_B) {
            const int j = task - NT_A, h = j & 3, sbi = (j >> 2) & 255, bg = j >> 10, g = bg % 3, b = bg / 3;
            const int dsh = 2 * g, d = 1 << dsh, nsb = 256 >> dsh, r = sbi / nsb, sb = sbi % nsb, q0 = sb * 32, Ls = L >> dsh;
            int tlo = 0, thi = 4; if (q0 - 64 < 0) tlo = (64 - q0) / 32; if (q0 + 64 + 31 >= Ls) thi = (Ls - 1 - (q0 - 64)) / 32;
            const int tq = (q0 + qi) * d + r, qc = BQ0 + 768 * g + h * 64;
            att_task<1>(wl, lane, qkv + (size_t)b * L * QKVW, TB + (g * 4 + h) * 192, qc, qc + 256, qc + 512, (q0 - 64) * d + r, 32 * d, d, tlo, thi, tq, 0, 0, 0,
                        MINIT, 0.0f, og + ((size_t)(b * L + tq) * 3 + g) * 256 + h * 64, lse + ((size_t)(b * L + tq) * 3 + g) * 4 + h);
        } else {
            const int j = task - NT_A - NT_B, h = j & 7, cbi = (j >> 3) & 255, b = j >> 11, ip = cbi >> 2, cb = cbi & 3;
            const int gi = 2 * ip + (qi >> 4), gc = 16 * cb + (qi & 15), tq = gi * 64 + gc;
            int cbs = 16 * cb - 8; cbs = cbs < 0 ? 0 : (cbs > 32 ? 32 : cbs);
            int rlo = 2 * ip - 4; rlo = rlo < 0 ? 0 : (rlo > 120 ? 120 : rlo);
            int rhi = 2 * ip + 1 - 4; rhi = rhi < 0 ? 0 : (rhi > 120 ? 120 : rhi); rhi += 7;
            att_task<2>(wl, lane, qkv + (size_t)b * L * QKVW, TC + h * 1024, CQ + h * 64, CK + h * 64, CV + h * 64, cbs, 64, 1, rlo, rhi, tq, gi, gc, cbs,
                        MINIT, 0.0f, oabc + (size_t)(b * L + tq) * OW + 768 + h * 64, nullptr);
        }
    }
}

constexpr int NSTEPS = 1 + DEPTH * 16;
__global__ void __launch_bounds__(NTHREADS, 2) mk_fwd(Args args) {
    extern __shared__ __attribute__((aligned(16))) unsigned char lds[];
    Frame F;
    F.lds = (LAS unsigned char*)lds; F.tid = threadIdx.x; F.lane = F.tid & 63; F.wave = __builtin_amdgcn_readfirstlane(F.tid >> 6);
    F.G = gridDim.x; { const int bx = blockIdx.x; F.vcu = (F.G % 8 == 0) ? (bx % 8) * (F.G / 8) + bx / 8 : bx; }
    F.in = args.in; F.h = args.out; F.ws = args.ws;
    volatile LAS unsigned* MISC = (volatile LAS unsigned*)(F.lds + MISC_OFF);
    if (F.tid < 32) MISC[F.tid] = 0u;
    __syncthreads();
    const int lo = args.s_lo, hi = args.s_hi;
    XcdBarrier bar; bar.bar = (unsigned*)(F.ws + WS_CTL) + CW_BAR; bar.x = 0; bar.st = nullptr;
    if (hi - lo > 1) bar = xcd_barrier_post((unsigned*)(F.ws + WS_CTL) + CW_BAR, MISC + 8);
#define RUN(s) (lo <= (s) && (s) < hi)
#define SEAM(s) do { if (RUN(s) && RUN((s) + 1)) xcd_barrier(bar); } while (0)
    if (RUN(0)) { ph_prologue(F); ph_tables(F); ph_ln0(F); }
    SEAM(0);
    for (int l = 0; l < DEPTH; ++l) {
        const int sb = 1 + l * 16;
        for (int c = 0; c < NCHUNK; ++c) {
            const int s = sb + c * 6;
            if (RUN(s)) ph_p1(F, l, c);
            SEAM(s);
            if (RUN(s + 1)) ph_att(F, l);
            SEAM(s + 1);
            if (RUN(s + 2)) ph_cmb(F);
            SEAM(s + 2);
            if (RUN(s + 3)) ph_p3(F, l);
            SEAM(s + 3);
            if (RUN(s + 4)) ph_p4(F, l, c);
            SEAM(s + 4);
            if (RUN(s + 5)) ph_ln1(F, l, c);
            SEAM(s + 5);
        }
        if (RUN(sb + 12)) ph_dsp(F, l);
        SEAM(sb + 12);
        if (RUN(sb + 13)) ph_p7(F, l);
        SEAM(sb + 13);
        if (RUN(sb + 14)) ph_p8(F, l);
        SEAM(sb + 14);
        if (RUN(sb + 15)) ph_ln2(F, l);
        SEAM(sb + 15);
    }
#undef RUN
#undef SEAM
}

#ifndef FAST_MASK
#define FAST_MASK 0x7FF
#endif
#ifndef ONE_LAUNCH
#define ONE_LAUNCH 1
#endif
extern "C" void kernel_launch(void* const* d_in, const int* in_sizes, int n_in, void* d_out, int out_size, void* d_ws, size_t ws_size, hipStream_t stream) {
    static int grid = 0;
    if (grid == 0) {
        if (n_in != 23 || out_size != T * D || ws_size < WS_END) { fprintf(stderr, "kernel_launch: unexpected shapes (n_in %d out %d ws %zu)\n", n_in, out_size, ws_size); grid = -1; return; }
        int dev = 0, cus = 0, per_cu = 0;
        if (hipGetDevice(&dev) != hipSuccess || hipDeviceGetAttribute(&cus, hipDeviceAttributeMultiprocessorCount, dev) != hipSuccess) { grid = -1; return; }
        if (hipFuncSetAttribute((const void*)mk_fwd, hipFuncAttributeMaxDynamicSharedMemorySize, LDS_BYTES) != hipSuccess) { fprintf(stderr, "kernel_launch: hipFuncSetAttribute failed\n"); grid = -1; return; }
        if (hipOccupancyMaxActiveBlocksPerMultiprocessor(&per_cu, (const void*)mk_fwd, NTHREADS, LDS_BYTES) != hipSuccess || per_cu < 1) fprintf(stderr, "kernel_launch: occupancy query reports %d\n", per_cu);
        (void)hipGetLastError();
        grid = cus;
    }
    if (grid < 0) return;
    const float* x = (const float*)d_in[0]; const float* ln0_g = (const float*)d_in[1]; const float* ln0_b = (const float*)d_in[2]; const float* rel_bias = (const float*)d_in[3];
    const float* w_in = (const float*)d_in[4]; const float* b_gate = (const float*)d_in[5]; const float* sink_a = (const float*)d_in[6]; const float* rpb_c = (const float*)d_in[7];
    const float* w_br_a = (const float*)d_in[8]; const float* w_br_b = (const float*)d_in[9]; const float* w_br_c = (const float*)d_in[10]; const float* w_out = (const float*)d_in[11];
    const float* ln1_g = (const float*)d_in[12]; const float* ln1_b = (const float*)d_in[13]; const float* w_rg = (const float*)d_in[14]; const float* b_rg = (const float*)d_in[15];
    const float* w_re = (const float*)d_in[16]; const float* b_re = (const float*)d_in[17]; const float* w_eg = (const float*)d_in[18]; const float* w_eu = (const float*)d_in[19];
    const float* w_ed = (const float*)d_in[20]; const float* ln2_g = (const float*)d_in[21]; const float* ln2_b = (const float*)d_in[22];
    unsigned char* ws = (unsigned char*)d_ws; float* h = (float*)d_out;
    bf16* hb = (bf16*)(ws + WS_HB); bf16* qkv = (bf16*)(ws + WS_QKV); bf16* gates = (bf16*)(ws + WS_GATES); bf16* oabc = (bf16*)(ws + WS_OABC); bf16* og = (bf16*)(ws + WS_OG);
    float* lse = (float*)(ws + WS_LSE); Rec* rec = (Rec*)(ws + WS_REC); int* rowtok = (int*)(ws + WS_ROWTOK); float* rowgate = (float*)(ws + WS_ROWGATE);
    bf16* merged = (bf16*)(ws + WS_MERGED); bf16* hid = (bf16*)(ws + WS_HID); bf16* yb = (bf16*)(ws + WS_YB); int* cnt = (int*)(ws + WS_CTL) + CW_CNT;
    (void)hipMemsetAsync(ws + WS_CTL, 0, CTL_ZERO_BYTES, stream);
    Args a{};
    for (int i = 0; i < 23; ++i) a.in[i] = (const float*)d_in[i];
    a.out = h; a.ws = ws;
    if (ONE_LAUNCH) { a.s_lo = 0; a.s_hi = NSTEPS; hipLaunchKernelGGL(mk_fwd, dim3(grid), dim3(NTHREADS), LDS_BYTES, stream, a); return; }
    const int G = 2048;
    const bool fastp1 = (FAST_MASK >> 1) & 1;
    for (int s = 0; s < NSTEPS; ++s) {
        int kind, l = 0, c = 0;
        if (s == 0) kind = 0; else { const int r = (s - 1) % 16; l = (s - 1) / 16; if (r < 12) { c = r / 6; kind = 1 + r % 6; } else kind = 7 + (r - 12); }
        if ((FAST_MASK >> kind) & 1) { a.s_lo = s; a.s_hi = s + 1; hipLaunchKernelGGL(mk_fwd, dim3(grid), dim3(NTHREADS), LDS_BYTES, stream, a); continue; }
        const size_t r0 = (size_t)c * CH;
        switch (kind) {
        case 0: k_ln<<<G, 256, 0, stream>>>(0, x, h, hb, nullptr, ln0_g, ln0_b, 0, T); break;
        case 1: k_p1<<<G, 256, 0, stream>>>(hb + r0 * D, w_in + (size_t)l * D * NCOL, b_gate + (size_t)l * GATEW, qkv, gates); break;
        case 2: k_attn_naive<<<(28 * CH + 255) / 256, 256, 0, stream>>>(qkv, oabc, og, lse, rel_bias, sink_a + l * 8, rpb_c + (size_t)l * 8 * 15 * 31, fastp1 ? LN2 : 0.125f); break;
        case 3: k_combine<<<(CH * 32 + 255) / 256, 256, 0, stream>>>(og, lse, oabc); break;
        case 4: k_p3<<<G, 256, 0, stream>>>(oabc, gates, w_br_a + (size_t)l * 512 * D, w_br_b + (size_t)l * 256 * D, w_br_c + (size_t)l * 512 * D, merged); break;
        case 5: k_p4<<<G, 256, 0, stream>>>(merged, w_out + (size_t)l * D * D, h + r0 * D); break;
        case 6: k_ln<<<G, 256, 0, stream>>>(1, nullptr, h, hb, nullptr, ln1_g + l * D, ln1_b + l * D, (int)r0, CH);
                if (c == NCHUNK - 1) k_router<<<G, 256, 0, stream>>>(h, w_rg + (size_t)l * D * 4, b_rg + l * 4, w_re + (size_t)l * 4 * D * 8, b_re + l * 32, cnt + l * 32, rec);
                break;
        case 7: (void)hipMemsetAsync(rowtok, 0xFF, (size_t)PROWS * 4, stream); k_dispatch<<<256, 256, 0, stream>>>(cnt + l * 32, rec, rowtok, rowgate); break;
        case 8: k_p7<<<G, 256, 0, stream>>>(hb, cnt + l * 32, rowtok, w_eg + (size_t)l * NE * D * DE, w_eu + (size_t)l * NE * D * DE, hid); break;
        case 9: k_p8<<<G, 256, 0, stream>>>(hid, cnt + l * 32, rowtok, rowgate, w_ed + (size_t)l * NE * DE * D, yb); break;
        case 10: k_ln<<<G, 256, 0, stream>>>(2, nullptr, h, (l == DEPTH - 1) ? nullptr : hb, yb, ln2_g + l * D, ln2_b + l * D, 0, T); break;
        }
    }
}
```

```cpp
#include <hip/hip_runtime.h>
#include <cstdio>
#include <cstdint>
#include <cmath>

typedef unsigned short bf16;
typedef short bf16x8 __attribute__((ext_vector_type(8)));
typedef float f32x16 __attribute__((ext_vector_type(16)));
typedef float f32x4 __attribute__((ext_vector_type(4)));

constexpr int D = 1024, L = 8192, NBATCH = 8, T = NBATCH * L, DEPTH = 2;
constexpr int NCOL = 7680, QKVW = 4608, GATEW = 3072;
constexpr int CH = 32768, NCHUNK = T / CH;
constexpr int OW = 1280;
constexpr int NE = 32, DE = 512;
constexpr int MAXRT = T * 2 / 256 + NE, PROWS = MAXRT * 256;
constexpr float LN_EPS = 1e-5f;
constexpr float ALPHA = 1.41421356237309515f;
constexpr int AQ = 0, AK = 512, AV = 640, BQ0 = 768, CQ = 3072, CK = 3584, CV = 4096;

constexpr size_t MiB = 1u << 20;
constexpr size_t WS_CTL = 0;
constexpr size_t WS_WIN = 1 * MiB, WS_WBRA = 31 * MiB, WS_WBRB = 33 * MiB, WS_WBRC = 34 * MiB, WS_WOUT = 36 * MiB, WS_WGU = 40 * MiB, WS_WD = 168 * MiB;
constexpr size_t WS_HB = 232 * MiB, WS_QKV = 360 * MiB, WS_GATES = 648 * MiB, WS_OABC = 840 * MiB, WS_OG = 920 * MiB, WS_LSE = 968 * MiB,
                 WS_REC = 970 * MiB, WS_ROWTOK = 972 * MiB, WS_ROWGATE = 973 * MiB, WS_TABA = 974 * MiB, WS_TABB = WS_TABA + 16384, WS_TABC = WS_TABA + 32768, WS_END = 975 * MiB;
constexpr size_t WS_MERGED = WS_QKV, WS_HID = WS_QKV, WS_YB = WS_QKV + 136 * MiB;
constexpr int CSTR = 32;

__device__ __constant__ signed char BUCK_A[257] = {12,11,11,11,11,11,11,11,11,11,11,11,11,11,11,11,11,11,11,11,11,11,11,11,11,11,11,11,11,11,11,11,11,11,11,11,11,11,11,11,11,11,11,11,11,11,11,11,11,11,11,11,11,11,11,11,11,11,11,11,11,11,11,11,11,10,10,10,10,10,10,10,10,10,10,10,10,10,10,10,10,10,10,10,10,10,10,10,10,10,10,10,10,10,10,10,10,9,9,9,9,9,9,9,9,9,9,9,9,9,9,9,9,8,8,8,8,8,8,8,8,7,6,5,4,3,2,1,0,17,18,19,20,21,22,23,24,24,24,24,24,24,24,24,25,25,25,25,25,25,25,25,25,25,25,25,25,25,25,25,26,26,26,26,26,26,26,26,26,26,26,26,26,26,26,26,26,26,26,26,26,26,26,26,26,26,26,26,26,26,26,26,27,27,27,27,27,27,27,27,27,27,27,27,27,27,27,27,27,27,27,27,27,27,27,27,27,27,27,27,27,27,27,27,27,27,27,27,27,27,27,27,27,27,27,27,27,27,27,27,27,27,27,27,27,27,27,27,27,27,27,27,27,27,27,27,28};
__device__ __constant__ signed char BUCK_B[3][129] = {
 {11,10,10,10,10,10,10,10,10,10,10,10,10,10,10,10,10,10,10,10,10,10,10,10,10,10,10,10,10,10,10,10,10,9,9,9,9,9,9,9,9,9,9,9,9,9,9,9,9,8,8,8,8,8,8,8,8,7,6,5,4,3,2,1,0,17,18,19,20,21,22,23,24,24,24,24,24,24,24,24,25,25,25,25,25,25,25,25,25,25,25,25,25,25,25,25,26,26,26,26,26,26,26,26,26,26,26,26,26,26,26,26,26,26,26,26,26,26,26,26,26,26,26,26,26,26,26,26,27},
 {13,12,12,12,12,12,12,12,12,12,12,12,12,12,12,12,12,12,12,12,12,12,12,12,12,12,12,12,12,12,12,12,12,11,11,11,11,11,11,11,11,11,11,11,11,11,11,11,11,10,10,10,10,10,10,10,10,9,9,9,9,8,8,4,0,20,24,24,25,25,25,25,26,26,26,26,26,26,26,26,27,27,27,27,27,27,27,27,27,27,27,27,27,27,27,27,28,28,28,28,28,28,28,28,28,28,28,28,28,28,28,28,28,28,28,28,28,28,28,28,28,28,28,28,28,28,28,28,29},
 {15,14,14,14,14,14,14,14,14,14,14,14,14,14,14,14,14,14,14,14,14,14,14,14,14,14,14,14,14,14,14,14,14,13,13,13,13,13,13,13,13,13,13,13,13,13,13,13,13,12,12,12,12,12,12,12,12,11,11,11,11,10,10,9,0,25,26,26,27,27,27,27,28,28,28,28,28,28,28,28,29,29,29,29,29,29,29,29,29,29,29,29,29,29,29,29,30,30,30,30,30,30,30,30,30,30,30,30,30,30,30,30,30,30,30,30,30,30,30,30,30,30,30,30,30,30,30,30,31}};

__device__ __forceinline__ float bf2f(bf16 b) { return __uint_as_float(((unsigned)b) << 16); }
__device__ __forceinline__ bf16 f2bf(float f) { unsigned u = __float_as_uint(f); u += 0x7fffu + ((u >> 16) & 1u); return (bf16)(u >> 16); }
__device__ __forceinline__ float wave_sum(float v) {
#pragma unroll
    for (int o = 1; o < 64; o <<= 1) v += __shfl_xor(v, o);
    return v;
}

__global__ __launch_bounds__(256) void k_ln(int mode, const float* src, float* h, bf16* hb, const bf16* yb, const float* g, const float* bta, int row0, int nrows) {
    const int lane = threadIdx.x & 63, wv = blockIdx.x * 4 + (threadIdx.x >> 6), nw = gridDim.x * 4;
    for (int rr = wv; rr < nrows; rr += nw) {
        const size_t row = (size_t)row0 + rr;
        f32x4 v[4];
#pragma unroll
        for (int j = 0; j < 4; ++j) {
            const int c = lane * 4 + 256 * j;
            v[j] = *(const f32x4*)((mode == 0 ? src : h) + row * D + c);
            if (mode == 2) {
                const uint2 a = *(const uint2*)(yb + (row * 2) * D + c), b = *(const uint2*)(yb + (row * 2 + 1) * D + c);
                v[j].x = ALPHA * v[j].x + bf2f((bf16)(a.x & 0xffff)) + bf2f((bf16)(b.x & 0xffff));
                v[j].y = ALPHA * v[j].y + bf2f((bf16)(a.x >> 16)) + bf2f((bf16)(b.x >> 16));
                v[j].z = ALPHA * v[j].z + bf2f((bf16)(a.y & 0xffff)) + bf2f((bf16)(b.y & 0xffff));
                v[j].w = ALPHA * v[j].w + bf2f((bf16)(a.y >> 16)) + bf2f((bf16)(b.y >> 16));
            }
        }
        float s = 0.f;
#pragma unroll
        for (int j = 0; j < 4; ++j) s += (v[j].x + v[j].y) + (v[j].z + v[j].w);
        const float mean = wave_sum(s) * (1.f / D);
        float q = 0.f;
#pragma unroll
        for (int j = 0; j < 4; ++j) { v[j] = v[j] - mean; q += (v[j].x * v[j].x + v[j].y * v[j].y) + (v[j].z * v[j].z + v[j].w * v[j].w); }
        const float rstd = 1.0f / sqrtf(wave_sum(q) * (1.f / D) + LN_EPS);
#pragma unroll
        for (int j = 0; j < 4; ++j) {
            const int c = lane * 4 + 256 * j;
            const f32x4 gg = *(const f32x4*)(g + c), bb = *(const f32x4*)(bta + c);
            const f32x4 o = v[j] * rstd * gg + bb;
            *(f32x4*)(h + row * D + c) = o;
            if (hb) { uint2 w; w.x = (unsigned)f2bf(o.x) | ((unsigned)f2bf(o.y) << 16); w.y = (unsigned)f2bf(o.z) | ((unsigned)f2bf(o.w) << 16); *(uint2*)(hb + row * D + c) = w; }
        }
    }
}

__device__ __forceinline__ void wave_gemm32(const bf16* arow, const float* wcol, int ldw, int K, f32x16& acc) {
    for (int k0 = 0; k0 < K; k0 += 16) {
        const bf16x8 a = *(const bf16x8*)(arow + k0);
        bf16x8 b;
#pragma unroll
        for (int j = 0; j < 8; ++j) b[j] = (short)f2bf(wcol[(size_t)(k0 + j) * ldw]);
        acc = __builtin_amdgcn_mfma_f32_32x32x16_bf16(a, b, acc, 0, 0, 0);
    }
}
#define ACC_ROW(reg, h) (((reg) & 3) + 8 * ((reg) >> 2) + 4 * (h))

__global__ __launch_bounds__(256) void k_p1(const bf16* hbc, const float* w_in, const float* b_gate, bf16* qkv, bf16* gates) {
    const int lane = threadIdx.x & 63, r = lane & 31, hh = lane >> 5;
    const int wv = blockIdx.x * 4 + (threadIdx.x >> 6), nw = gridDim.x * 4;
    const int ntn = NCOL / 32, total = (CH / 32) * ntn;
    for (int tile = wv; tile < total; tile += nw) {
        const int tm = tile / ntn, tn = tile % ntn;
        f32x16 acc; for (int i = 0; i < 16; ++i) acc[i] = 0.f;
        wave_gemm32(hbc + (size_t)(tm * 32 + r) * D + 8 * hh, w_in + (size_t)(8 * hh) * NCOL + tn * 32 + r, NCOL, D, acc);
        const int col = tn * 32 + r;
#pragma unroll
        for (int i = 0; i < 16; ++i) {
            const int row = tm * 32 + ACC_ROW(i, hh);
            if (col < QKVW) qkv[(size_t)row * QKVW + col] = f2bf(acc[i]);
            else { const float z = acc[i] + b_gate[col - QKVW]; gates[(size_t)row * GATEW + (col - QKVW)] = f2bf(1.0f / (1.0f + __expf(-z))); }
        }
    }
}

__global__ __launch_bounds__(256) void k_attn_naive(const bf16* qkv, bf16* oabc, bf16* og, float* lse, const float* rel_bias, const float* sink_l, const float* rpb_l, float sc) {
    const long idx = (long)blockIdx.x * 256 + threadIdx.x;
    if (idx >= (long)28 * CH) return;
    const int ht = (int)(idx / CH), tl = (int)(idx % CH), b = tl / L, t = tl % L;
    const bf16* base = qkv + (size_t)(b * L) * QKVW;
    int qcol, kcol, vcol;
    if (ht < 8) { qcol = AQ + ht * 64; kcol = AK + (ht >> 2) * 64; vcol = AV + (ht >> 2) * 64; }
    else if (ht < 20) { const int g = (ht - 8) >> 2, h = (ht - 8) & 3; qcol = BQ0 + 768 * g + h * 64; kcol = qcol + 256; vcol = qcol + 512; }
    else { const int h = ht - 20; qcol = CQ + h * 64; kcol = CK + h * 64; vcol = CV + h * 64; }
    float q[64], o[64];
    {
        const uint4* qp = (const uint4*)(base + (size_t)t * QKVW + qcol);
#pragma unroll
        for (int c = 0; c < 8; ++c) { const uint4 u = qp[c]; const unsigned w[4] = {u.x, u.y, u.z, u.w};
#pragma unroll
            for (int i = 0; i < 4; ++i) { q[8 * c + 2 * i] = bf2f((bf16)(w[i] & 0xffff)); q[8 * c + 2 * i + 1] = bf2f((bf16)(w[i] >> 16)); } }
    }
#pragma unroll
    for (int i = 0; i < 64; ++i) o[i] = 0.f;
    float m = -1e30f, l = 0.f;
    if (ht < 8) { m = sink_l[ht]; l = 1.f; }
#define PROC_KEY(KT, BIAS) do { \
        const uint4* kp = (const uint4*)(base + (size_t)(KT) * QKVW + kcol); float s = 0.f; \
        _Pragma("unroll") for (int c = 0; c < 8; ++c) { const uint4 u = kp[c]; const unsigned w[4] = {u.x, u.y, u.z, u.w}; \
            _Pragma("unroll") for (int i = 0; i < 4; ++i) { s += q[8 * c + 2 * i] * bf2f((bf16)(w[i] & 0xffff)); s += q[8 * c + 2 * i + 1] * bf2f((bf16)(w[i] >> 16)); } } \
        s = s * sc + (BIAS); const float mn = fmaxf(m, s), corr = __expf(m - mn), p = __expf(s - mn); l = l * corr + p; m = mn; \
        const uint4* vp = (const uint4*)(base + (size_t)(KT) * QKVW + vcol); \
        _Pragma("unroll") for (int c = 0; c < 8; ++c) { const uint4 u = vp[c]; const unsigned w[4] = {u.x, u.y, u.z, u.w}; \
            _Pragma("unroll") for (int i = 0; i < 4; ++i) { o[8 * c + 2 * i] = o[8 * c + 2 * i] * corr + p * bf2f((bf16)(w[i] & 0xffff)); o[8 * c + 2 * i + 1] = o[8 * c + 2 * i + 1] * corr + p * bf2f((bf16)(w[i] >> 16)); } } \
    } while (0)
    if (ht < 8) {
        for (int rel = -128; rel <= 128; ++rel) { const int kt = t + rel; if (kt < 0 || kt >= L) continue;
            const float bias = rel_bias[BUCK_A[rel + 128] * 20 + ht]; PROC_KEY(kt, bias); }
    } else if (ht < 20) {
        const int g = (ht - 8) >> 2, h = (ht - 8) & 3, dil = (g == 0) ? 1 : (g == 1 ? 4 : 16);
        for (int off = -64; off <= 64; ++off) { const int kt = t + off * dil; if (kt < 0 || kt >= L) continue;
            const float bias = rel_bias[BUCK_B[g][off + 64] * 20 + 8 + 4 * g + h]; PROC_KEY(kt, bias); }
    } else {
        const int h = ht - 20, gi = t >> 6, gc = t & 63;
        int rs = gi - 4; rs = rs < 0 ? 0 : (rs > 120 ? 120 : rs);
        int cs = gc - 8; cs = cs < 0 ? 0 : (cs > 48 ? 48 : cs);
        for (int kr = rs; kr < rs + 8; ++kr)
            for (int kc = cs; kc < cs + 16; ++kc) { const float bias = rpb_l[(h * 15 + (kr - gi + 7)) * 31 + (kc - gc + 15)]; const int kt = kr * 64 + kc; PROC_KEY(kt, bias); }
    }
#undef PROC_KEY
    const float inv = 1.0f / l;
    bf16* dst;
    if (ht < 8) dst = oabc + (size_t)tl * OW + ht * 64;
    else if (ht < 20) { const int g = (ht - 8) >> 2, h = (ht - 8) & 3; dst = og + ((size_t)tl * 3 + g) * 256 + h * 64; lse[((size_t)tl * 3 + g) * 4 + h] = m + __logf(l); }
    else dst = oabc + (size_t)tl * OW + 768 + (ht - 20) * 64;
#pragma unroll
    for (int c = 0; c < 8; ++c) { uint4 u;
        u.x = (unsigned)f2bf(o[8 * c + 0] * inv) | ((unsigned)f2bf(o[8 * c + 1] * inv) << 16); u.y = (unsigned)f2bf(o[8 * c + 2] * inv) | ((unsigned)f2bf(o[8 * c + 3] * inv) << 16);
        u.z = (unsigned)f2bf(o[8 * c + 4] * inv) | ((unsigned)f2bf(o[8 * c + 5] * inv) << 16); u.w = (unsigned)f2bf(o[8 * c + 6] * inv) | ((unsigned)f2bf(o[8 * c + 7] * inv) << 16);
        ((uint4*)dst)[c] = u; }
}

__global__ __launch_bounds__(256) void k_combine(const bf16* og, const float* lse, bf16* oabc) {
    const long idx = (long)blockIdx.x * 256 + threadIdx.x;
    if (idx >= (long)CH * 32) return;
    const int tl = (int)(idx >> 5), hc = (int)(idx & 31), h = hc >> 3, c = hc & 7;
    const float l0 = lse[((size_t)tl * 3 + 0) * 4 + h], l1 = lse[((size_t)tl * 3 + 1) * 4 + h], l2 = lse[((size_t)tl * 3 + 2) * 4 + h];
    const float mx = fmaxf(l0, fmaxf(l1, l2)); float w0 = __expf(l0 - mx), w1 = __expf(l1 - mx), w2 = __expf(l2 - mx); const float inv = 1.0f / (w0 + w1 + w2); w0 *= inv; w1 *= inv; w2 *= inv;
    const uint4 a = *(const uint4*)(og + ((size_t)tl * 3 + 0) * 256 + h * 64 + c * 8), b = *(const uint4*)(og + ((size_t)tl * 3 + 1) * 256 + h * 64 + c * 8), d = *(const uint4*)(og + ((size_t)tl * 3 + 2) * 256 + h * 64 + c * 8);
    const unsigned aw[4] = {a.x, a.y, a.z, a.w}, bw[4] = {b.x, b.y, b.z, b.w}, dw[4] = {d.x, d.y, d.z, d.w}; unsigned ow[4];
#pragma unroll
    for (int i = 0; i < 4; ++i) {
        const float lo = w0 * bf2f((bf16)(aw[i] & 0xffff)) + w1 * bf2f((bf16)(bw[i] & 0xffff)) + w2 * bf2f((bf16)(dw[i] & 0xffff));
        const float hi = w0 * bf2f((bf16)(aw[i] >> 16)) + w1 * bf2f((bf16)(bw[i] >> 16)) + w2 * bf2f((bf16)(dw[i] >> 16));
        ow[i] = (unsigned)f2bf(lo) | ((unsigned)f2bf(hi) << 16);
    }
    *(uint4*)(oabc + (size_t)tl * OW + 512 + h * 64 + c * 8) = make_uint4(ow[0], ow[1], ow[2], ow[3]);
}

__global__ __launch_bounds__(256) void k_p3(const bf16* oabc, const bf16* gates, const float* wa, const float* wb, const float* wc, bf16* merged) {
    const int lane = threadIdx.x & 63, r = lane & 31, hh = lane >> 5;
    const int wv = blockIdx.x * 4 + (threadIdx.x >> 6), nw = gridDim.x * 4;
    const int ntn = D / 32, total = (CH / 32) * ntn;
    for (int tile = wv; tile < total; tile += nw) {
        const int tm = tile / ntn, tn = tile % ntn, col = tn * 32 + r;
        f32x16 mg; for (int i = 0; i < 16; ++i) mg[i] = 0.f;
#pragma unroll 1
        for (int br = 0; br < 3; ++br) {
            f32x16 acc; for (int i = 0; i < 16; ++i) acc[i] = 0.f;
            const int koff = br == 0 ? 0 : (br == 1 ? 512 : 768), K = br == 1 ? 256 : 512;
            const float* w = br == 0 ? wa : (br == 1 ? wb : wc);
            wave_gemm32(oabc + (size_t)(tm * 32 + r) * OW + koff + 8 * hh, w + (size_t)(8 * hh) * D + col, D, K, acc);
#pragma unroll
            for (int i = 0; i < 16; ++i) { const int row = tm * 32 + ACC_ROW(i, hh); mg[i] += bf2f(gates[(size_t)row * GATEW + br * 1024 + col]) * acc[i]; }
        }
#pragma unroll
        for (int i = 0; i < 16; ++i) { const int row = tm * 32 + ACC_ROW(i, hh); merged[(size_t)row * D + col] = f2bf(mg[i]); }
    }
}
__global__ __launch_bounds__(256) void k_p4(const bf16* merged, const float* wo, float* hchunk) {
    const int lane = threadIdx.x & 63, r = lane & 31, hh = lane >> 5;
    const int wv = blockIdx.x * 4 + (threadIdx.x >> 6), nw = gridDim.x * 4;
    const int ntn = D / 32, total = (CH / 32) * ntn;
    for (int tile = wv; tile < total; tile += nw) {
        const int tm = tile / ntn, tn = tile % ntn, col = tn * 32 + r;
        f32x16 acc; for (int i = 0; i < 16; ++i) acc[i] = 0.f;
        wave_gemm32(merged + (size_t)(tm * 32 + r) * D + 8 * hh, wo + (size_t)(8 * hh) * D + col, D, D, acc);
#pragma unroll
        for (int i = 0; i < 16; ++i) { const int row = tm * 32 + ACC_ROW(i, hh); float* p = hchunk + (size_t)row * D + col; *p = ALPHA * *p + acc[i]; }
    }
}

struct Rec { int e0, s0, e1, s1; float g0, g1; int pad0, pad1; };
__global__ __launch_bounds__(256) void k_router(const float* h, const float* w_rg, const float* b_rg, const float* w_re, const float* b_re, int* cnt, Rec* rec) {
    const int lane = threadIdx.x & 63, wv = blockIdx.x * 4 + (threadIdx.x >> 6), nw = gridDim.x * 4;
    for (int t = wv; t < T; t += nw) {
        float x[16];
#pragma unroll
        for (int j = 0; j < 4; ++j) { const f32x4 v = *(const f32x4*)(h + (size_t)t * D + lane * 4 + 256 * j); x[4 * j] = v.x; x[4 * j + 1] = v.y; x[4 * j + 2] = v.z; x[4 * j + 3] = v.w; }
        float gl[4] = {0.f, 0.f, 0.f, 0.f};
#pragma unroll
        for (int j = 0; j < 4; ++j)
#pragma unroll
            for (int i = 0; i < 4; ++i) { const f32x4 w = *(const f32x4*)(w_rg + (size_t)(lane * 4 + 256 * j + i) * 4); const float xv = x[4 * j + i]; gl[0] += xv * w.x; gl[1] += xv * w.y; gl[2] += xv * w.z; gl[3] += xv * w.w; }
#pragma unroll
        for (int g = 0; g < 4; ++g) gl[g] = wave_sum(gl[g]) + b_rg[g];
        int gi = 0; float gm = gl[0];
#pragma unroll
        for (int g = 1; g < 4; ++g) if (gl[g] > gm) { gm = gl[g]; gi = g; }
        float gs = 0.f;
#pragma unroll
        for (int g = 0; g < 4; ++g) gs += __expf(gl[g] - gm);
        const float gw = 1.0f / gs;
        float el[8];
#pragma unroll
        for (int e = 0; e < 8; ++e) el[e] = 0.f;
        const float* wre = w_re + (size_t)gi * D * 8;
#pragma unroll
        for (int j = 0; j < 4; ++j)
#pragma unroll
            for (int i = 0; i < 4; ++i) { const float* wp = wre + (size_t)(lane * 4 + 256 * j + i) * 8; const f32x4 w0 = *(const f32x4*)wp, w1 = *(const f32x4*)(wp + 4); const float xv = x[4 * j + i];
                el[0] += xv * w0.x; el[1] += xv * w0.y; el[2] += xv * w0.z; el[3] += xv * w0.w; el[4] += xv * w1.x; el[5] += xv * w1.y; el[6] += xv * w1.z; el[7] += xv * w1.w; }
#pragma unroll
        for (int e = 0; e < 8; ++e) el[e] = wave_sum(el[e]) + b_re[gi * 8 + e];
        int i0 = 0; float t0 = el[0];
#pragma unroll
        for (int e = 1; e < 8; ++e) if (el[e] > t0) { t0 = el[e]; i0 = e; }
        int i1 = -1; float t1 = -3.0e38f;
#pragma unroll
        for (int e = 0; e < 8; ++e) if (e != i0 && el[e] > t1) { t1 = el[e]; i1 = e; }
        const float ex = __expf(t1 - t0), p0 = 1.0f / (1.0f + ex), p1 = ex / (1.0f + ex);
        if (lane == 0) {
            Rec rc; rc.e0 = gi * 8 + i0; rc.e1 = gi * 8 + i1; rc.g0 = gw * p0; rc.g1 = gw * p1; rc.pad0 = 0; rc.pad1 = 0;
            rc.s0 = atomicAdd(cnt + rc.e0 * CSTR, 1); rc.s1 = atomicAdd(cnt + rc.e1 * CSTR, 1);
            rec[t] = rc;
        }
    }
}
__device__ __forceinline__ void pad_offsets(const int* cnt, int* po) { int acc = 0; for (int e = 0; e < NE; ++e) { po[e] = acc; acc += (cnt[e * CSTR] + 255) / 256 * 256; } po[NE] = acc; }
__global__ __launch_bounds__(256) void k_dispatch(const int* cnt, const Rec* rec, int* rowtok, float* rowgate) {
    __shared__ int po[NE + 1];
    if (threadIdx.x == 0) pad_offsets(cnt, po);
    __syncthreads();
    for (int t = blockIdx.x * 256 + threadIdx.x; t < T; t += gridDim.x * 256) {
        const Rec rc = rec[t];
        const int d0 = po[rc.e0] + rc.s0, d1 = po[rc.e1] + rc.s1;
        rowtok[d0] = 2 * t; rowgate[d0] = rc.g0; rowtok[d1] = 2 * t + 1; rowgate[d1] = rc.g1;
    }
}
__global__ __launch_bounds__(256) void k_p7(const bf16* hb, const int* cnt, const int* rowtok, const float* w_eg, const float* w_eu, bf16* hid) {
    __shared__ int po[NE + 1];
    if (threadIdx.x == 0) pad_offsets(cnt, po);
    __syncthreads();
    const int lane = threadIdx.x & 63, r = lane & 31, hh = lane >> 5;
    const int wv = blockIdx.x * 4 + (threadIdx.x >> 6), nw = gridDim.x * 4;
    const int ntn = DE / 32, total = (po[NE] / 32) * ntn;
    for (int tile = wv; tile < total; tile += nw) {
        const int tm = tile / ntn, tn = tile % ntn, col = tn * 32 + r, row0 = tm * 32;
        int e = 0; while (e < NE - 1 && po[e + 1] <= row0) ++e;
        int tok = rowtok[row0 + r]; tok = tok < 0 ? 0 : (tok >> 1);
        f32x16 ag, au; for (int i = 0; i < 16; ++i) { ag[i] = 0.f; au[i] = 0.f; }
        wave_gemm32(hb + (size_t)tok * D + 8 * hh, w_eg + (size_t)e * D * DE + (size_t)(8 * hh) * DE + col, DE, D, ag);
        wave_gemm32(hb + (size_t)tok * D + 8 * hh, w_eu + (size_t)e * D * DE + (size_t)(8 * hh) * DE + col, DE, D, au);
#pragma unroll
        for (int i = 0; i < 16; ++i) { const int row = row0 + ACC_ROW(i, hh); const float gsl = ag[i] / (1.0f + __expf(-ag[i])); hid[(size_t)row * DE + col] = f2bf(gsl * au[i]); }
    }
}
__global__ __launch_bounds__(256) void k_p8(const bf16* hid, const int* cnt, const int* rowtok, const float* rowgate, const float* w_ed, bf16* yb) {
    __shared__ int po[NE + 1];
    if (threadIdx.x == 0) pad_offsets(cnt, po);
    __syncthreads();
    const int lane = threadIdx.x & 63, r = lane & 31, hh = lane >> 5;
    const int wv = blockIdx.x * 4 + (threadIdx.x >> 6), nw = gridDim.x * 4;
    const int ntn = D / 32, total = (po[NE] / 32) * ntn;
    for (int tile = wv; tile < total; tile += nw) {
        const int tm = tile / ntn, tn = tile % ntn, col = tn * 32 + r, row0 = tm * 32;
        int e = 0; while (e < NE - 1 && po[e + 1] <= row0) ++e;
        f32x16 acc; for (int i = 0; i < 16; ++i) acc[i] = 0.f;
        wave_gemm32(hid + (size_t)(row0 + r) * DE + 8 * hh, w_ed + (size_t)e * DE * D + (size_t)(8 * hh) * D + col, D, DE, acc);
#pragma unroll
        for (int i = 0; i < 16; ++i) { const int row = row0 + ACC_ROW(i, hh); const int rt = rowtok[row]; if (rt >= 0) yb[(size_t)rt * D + col] = f2bf(acc[i] * rowgate[row]); }
    }
}


namespace pg8 {
#define PG8_LAS __attribute__((address_space(3)))
typedef unsigned short bf16_t;
typedef unsigned u32x4 __attribute__((ext_vector_type(4)));
constexpr int BM = 256, BK = 64, HALF = 128, HTB = HALF * BK * 2  , STAGE_BYTES = 8 * HTB, NXCD = 8, WGM = 8;

__host__ __device__ __forceinline__ int lds_byte(int r, int c) { const int st = (r >> 4) * 2 + (c >> 5), rr = r & 15, cc = c & 31, ob = rr * 64 + cc * 2; return st * 1024 + (ob ^ (((ob >> 9) & 1) << 5)); }
__host__ __device__ __forceinline__ void stage_rc(int b, int& R, int& C) { const int st = b / 1024, sb = b % 1024, swz = sb ^ (((sb >> 9) & 1) << 5); R = (st >> 1) * 16 + swz / 64; C = (st & 1) * 32 + (swz % 64) / 2; }
__host__ __device__ __forceinline__ int perm32(int rho) { const int n = rho >> 4, i = rho & 15; return 8 * (i >> 2) + 4 * n + (i & 3); }

struct Unit { int pm, pn, e, ui; };

struct DenseOrder {
    int nM, nN, nwg, G, c; const char* A; const char* B; size_t tstepA, tstepB;
    __device__ void init(const void* A_, int lda, const void* B_, int ldb, int M, int N, int G_, int c_) { nM = M / BM; nN = N / BM; nwg = nM * nN; G = G_; c = c_; A = (const char*)A_; B = (const char*)B_; tstepA = (size_t)BM * lda * 2; tstepB = (size_t)BM * ldb * 2; }
    __device__ bool next(int i, Unit& u) const {
        const long Lx = (long)i * G + c; if (Lx >= nwg) return false;
        int wgid = (int)Lx; { const int q = nwg / NXCD, r = nwg % NXCD, xcd = wgid % NXCD, off = wgid / NXCD; wgid = (xcd < r ? xcd * (q + 1) : r * (q + 1) + (xcd - r) * q) + off; }
        const int nig = WGM * nN, gid = wgid / nig, fm = gid * WGM, gsz = (nM - fm) < WGM ? (nM - fm) : WGM;
        u.pm = fm + ((wgid % nig) % gsz); u.pn = (wgid % nig) / gsz; u.e = 0; u.ui = i; return true;
    }
    __device__ __forceinline__ const char* a_base(const Unit& u) const { return A + (size_t)u.pm * tstepA; }
    __device__ __forceinline__ const char* b_base(const Unit& u) const { return B + (size_t)u.pn * tstepB; }
    __device__ __forceinline__ int a_row(const Unit&, int) const { return 0; }
};

__device__ __forceinline__ unsigned cvt_pk_bf16(float lo, float hi) { unsigned r; asm volatile("v_cvt_pk_bf16_f32 %0, %1, %2" : "=v"(r) : "v"(lo), "v"(hi)); return r; }

template <class Epi, class Sched, bool GATHER>
__device__ __forceinline__ void gemm_phase(PG8_LAS unsigned char* lds, const Sched& S, const Epi& E, const int K, const int lda, const int ldb) {
    int tid = threadIdx.x; asm volatile("" : "+v"(tid));
    const int wid = __builtin_amdgcn_readfirstlane(tid >> 6), lane = tid & 63, wr = wid >> 2, wc = wid & 3, fr = lane & 15, fq = lane >> 4;
    const int nt = K / BK;
    int RA[2], CA[2]; unsigned voffB[2];
#pragma unroll
    for (int i = 0; i < 2; ++i) { int R, C; stage_rc(tid * 16 + i * 8192, R, C); const int Rb = Epi::PERM ? ((R & ~31) + perm32(R & 31)) : R; RA[i] = R; CA[i] = C; voffB[i] = (unsigned)(Rb * ldb + C) * 2u; }
    const size_t kstep = (size_t)(BK * 2);
    const size_t hstepB = (size_t)HALF * ldb * 2;
    const unsigned ldsw = (unsigned)wid * 1024u;
    const int aoff = lds_byte(wr * 64 + fr, fq * 8), boff = lds_byte(wc * 32 + fr, fq * 8);
#define PG8_SA(b, h) (((b) * 2 + (h)) * HTB)
#define PG8_SB(b, h) ((4 + (b) * 2 + (h)) * HTB)
#define PG8_STAGE2(bufoff, gbase, v0, v1) do { \
        __builtin_amdgcn_global_load_lds((const unsigned*)((const char*)(gbase) + (v0)), (PG8_LAS unsigned*)(lds + (bufoff) + ldsw), 16, 0, 0); \
        __builtin_amdgcn_global_load_lds((const unsigned*)((const char*)(gbase) + (v1)), (PG8_LAS unsigned*)(lds + (bufoff) + ldsw + 8192), 16, 0, 0); } while (0)
#define PG8_STAGEB(bufoff, gbase) PG8_STAGE2(bufoff, gbase, voffB[0], voffB[1])
#define PG8_LDA(dst, b, h) do { _Pragma("unroll") for (int m = 0; m < 4; ++m) _Pragma("unroll") for (int k = 0; k < 2; ++k) dst[m][k] = *(const PG8_LAS bf16x8*)(lds + PG8_SA(b, h) + aoff + m * 2048 + k * 1024); } while (0)
#define PG8_LDB(dst, b, h) do { _Pragma("unroll") for (int n = 0; n < 2; ++n) _Pragma("unroll") for (int k = 0; k < 2; ++k) dst[n][k] = *(const PG8_LAS bf16x8*)(lds + PG8_SB(b, h) + boff + n * 2048 + k * 1024); } while (0)
#define PG8_MMA(ai, bj, At, Bt) do { __builtin_amdgcn_s_setprio(1); _Pragma("unroll") for (int m = 0; m < 4; ++m) _Pragma("unroll") for (int n = 0; n < 2; ++n) _Pragma("unroll") for (int k = 0; k < 2; ++k) \
        acc[ai][bj][m][n] = __builtin_amdgcn_mfma_f32_16x16x32_bf16(Bt[n][k], At[m][k], acc[ai][bj][m][n], 0, 0, 0); __builtin_amdgcn_s_setprio(0); } while (0)
#define PG8_WAIT_V(n) asm volatile("s_waitcnt vmcnt(" #n ")" ::: "memory")
#define PG8_WAIT_L(n) asm volatile("s_waitcnt lgkmcnt(" #n ")" ::: "memory")
#define PG8_BAR __builtin_amdgcn_s_barrier()
#define PG8_SCHED __builtin_amdgcn_sched_barrier(0)
#define PG8_VOFFA(dst, u) do { _Pragma("unroll") for (int h_ = 0; h_ < 2; ++h_) _Pragma("unroll") for (int i_ = 0; i_ < 2; ++i_) { \
        const int row_ = GATHER ? S.a_row(u, h_ * HALF + RA[i_]) : (h_ * HALF + RA[i_]); dst[h_][i_] = (unsigned)(row_ * lda + CA[i_]) * 2u; } } while (0)
    Unit cur, nxt;
    if (!S.next(0, cur)) return;
    f32x4 acc[2][2][4][2];
#pragma unroll
    for (int a = 0; a < 2; ++a)
#pragma unroll
        for (int b = 0; b < 2; ++b)
#pragma unroll
            for (int m = 0; m < 4; ++m)
#pragma unroll
                for (int n = 0; n < 2; ++n) acc[a][b][m][n] = (f32x4){0.f, 0.f, 0.f, 0.f};
    bf16x8 At[4][2], B0[2][2], B1[2][2];
    unsigned vc[2][2], vn[2][2];
    PG8_VOFFA(vc, cur);
    const char* cA = S.a_base(cur); const char* cB = S.b_base(cur);
    PG8_STAGEB(PG8_SB(0, 0), cB); PG8_STAGEB(PG8_SB(0, 1), cB + hstepB); PG8_STAGE2(PG8_SA(0, 0), cA, vc[0][0], vc[0][1]); PG8_STAGE2(PG8_SA(0, 1), cA, vc[1][0], vc[1][1]);
    if (wr == 1) PG8_BAR;
    PG8_WAIT_V(2); PG8_BAR;
    PG8_STAGEB(PG8_SB(1, 0), cB + kstep); PG8_STAGE2(PG8_SA(1, 0), cA + kstep, vc[0][0], vc[0][1]); PG8_STAGEB(PG8_SB(1, 1), cB + hstepB + kstep);
    PG8_WAIT_V(6); PG8_BAR;
    int ui = 0;
    for (;;) {
        const bool has_next = S.next(ui + 1, nxt);
        const char* nA = has_next ? S.a_base(nxt) : cA; const char* nB = has_next ? S.b_base(nxt) : cB;
        if (GATHER) { if (has_next) { PG8_VOFFA(vn, nxt); } else {
#pragma unroll
            for (int h_ = 0; h_ < 2; ++h_) { vn[h_][0] = vc[h_][0]; vn[h_][1] = vc[h_][1]; } } }
        for (int t = 0; t < nt; t += 2) {
            const bool last = (t == nt - 2);
            const char* a1 = cA + (size_t)(t + 1) * kstep;
            const char* a2 = last ? nA : cA + (size_t)(t + 2) * kstep; const char* b2 = last ? nB : cB + (size_t)(t + 2) * kstep;
            const char* a3 = a2 + kstep; const char* b3 = b2 + kstep;
            unsigned w00, w01, w10, w11;
            if (GATHER) { w00 = last ? vn[0][0] : vc[0][0]; w01 = last ? vn[0][1] : vc[0][1]; w10 = last ? vn[1][0] : vc[1][0]; w11 = last ? vn[1][1] : vc[1][1]; }
            else { w00 = vc[0][0]; w01 = vc[0][1]; w10 = vc[1][0]; w11 = vc[1][1]; }
            PG8_LDB(B0, 0, 0); PG8_LDB(B1, 0, 1); PG8_SCHED; PG8_LDA(At, 0, 0); PG8_STAGE2(PG8_SA(1, 1), a1, vc[1][0], vc[1][1]);
            PG8_WAIT_V(8); PG8_WAIT_L(0); PG8_BAR; PG8_MMA(0, 0, At, B0); PG8_MMA(0, 1, At, B1); PG8_BAR; PG8_SCHED;
            PG8_LDA(At, 0, 1); PG8_STAGEB(PG8_SB(0, 0), b2); PG8_STAGEB(PG8_SB(0, 1), b2 + hstepB); PG8_STAGE2(PG8_SA(0, 0), a2, w00, w01);
            PG8_WAIT_V(8); PG8_WAIT_L(0); PG8_BAR; PG8_MMA(1, 0, At, B0); PG8_MMA(1, 1, At, B1); PG8_BAR; PG8_SCHED;
            PG8_LDB(B0, 1, 0); PG8_LDB(B1, 1, 1); PG8_SCHED; PG8_LDA(At, 1, 0); PG8_STAGE2(PG8_SA(0, 1), a2, w10, w11);
            PG8_WAIT_V(8); PG8_WAIT_L(0); PG8_BAR; PG8_MMA(0, 0, At, B0); PG8_MMA(0, 1, At, B1); PG8_BAR; PG8_SCHED;
            PG8_LDA(At, 1, 1); PG8_STAGEB(PG8_SB(1, 0), b3); PG8_STAGEB(PG8_SB(1, 1), b3 + hstepB); PG8_STAGE2(PG8_SA(1, 0), a3, w00, w01);
            PG8_WAIT_V(8); PG8_WAIT_L(0); PG8_BAR; PG8_MMA(1, 0, At, B0); PG8_MMA(1, 1, At, B1); PG8_BAR; PG8_SCHED;
        }
        if (wr == 0) PG8_BAR;
        E(acc, cur, wr, wc, fr, fq);
        if (!has_next) break;
#pragma unroll
        for (int a = 0; a < 2; ++a)
#pragma unroll
            for (int b = 0; b < 2; ++b)
#pragma unroll
                for (int m = 0; m < 4; ++m)
#pragma unroll
                    for (int n = 0; n < 2; ++n) acc[a][b][m][n] = (f32x4){0.f, 0.f, 0.f, 0.f};
        cur = nxt; cA = nA; cB = nB; ++ui;
        if (GATHER) {
#pragma unroll
            for (int h_ = 0; h_ < 2; ++h_) { vc[h_][0] = vn[h_][0]; vc[h_][1] = vn[h_][1]; } }
        if (wr == 1) PG8_BAR;
    }
    PG8_WAIT_V(0);
    PG8_BAR;
#undef PG8_SA
#undef PG8_SB
#undef PG8_STAGE2
#undef PG8_STAGEB
#undef PG8_LDA
#undef PG8_LDB
#undef PG8_MMA
#undef PG8_WAIT_V
#undef PG8_WAIT_L
#undef PG8_BAR
#undef PG8_SCHED
#undef PG8_VOFFA
}
}

constexpr int NWAVES = 8, NTHREADS = 512;
constexpr int RING_OFF = 0, RING_BYTES = 131072, ROWS_OFF = 131072, ROWS_BYTES = 12288, ROUTER_BYTES = 147456  , MISC_OFF = ROUTER_BYTES, LDS_BYTES = 148480;
static_assert(MISC_OFF + 128 <= LDS_BYTES, "LDS map");
constexpr int CW_CNT = 0;
constexpr int CW_BAR = 4096;
constexpr size_t CTL_ZERO_BYTES = 64 * 1024;
constexpr float LOG2E = 1.4426950408889634f, LN2 = 0.6931471805599453f;
constexpr float QSCALE = 0.125f * LOG2E;

#define GAS __attribute__((address_space(1)))
#define LAS __attribute__((address_space(3)))
typedef unsigned v4u __attribute__((ext_vector_type(4)));
typedef unsigned v2u __attribute__((ext_vector_type(2)));
#define LDS_WAIT() asm volatile("s_waitcnt lgkmcnt(0)" ::: "memory")
__device__ __forceinline__ unsigned pk2(float lo, float hi) { return (unsigned)f2bf(lo) | ((unsigned)f2bf(hi) << 16); }

#define XB_TMO      128
#define XB_XCNT(j)  (256  + 64 * (j))
#define XB_XSUB(j)  (1280 + 64 * (j))
#define XB_XGEN(j)  (2304 + 64 * (j))
#define XB_TOP      3328
#define XB_TOPGEN   3392
#define XCD_BAR_WORDS 3456
#define XB_SPIN_CAP (1u << 18)

__device__ __forceinline__ unsigned xb_ld(unsigned* p)              { return __hip_atomic_load(p, __ATOMIC_RELAXED, __HIP_MEMORY_SCOPE_AGENT); }
__device__ __forceinline__ unsigned xb_add(unsigned* p, unsigned v) { return __hip_atomic_fetch_add(p, v, __ATOMIC_RELAXED, __HIP_MEMORY_SCOPE_AGENT); }
__device__ __forceinline__ unsigned xb_xcc_id() { return (unsigned)__builtin_amdgcn_s_getreg((3 << 11) | 20) & 0xFu; }
#define XB_SPIN(cond, bar) do { unsigned _sp = 0; while (cond) { __builtin_amdgcn_s_sleep(1); \
    if ((++_sp & 255u) == 0u) { if (xb_ld(&(bar)[XB_TMO])) break; if (_sp > XB_SPIN_CAP) { atomicAdd(&(bar)[XB_TMO], 1u); break; } } } } while (0)

struct XcdBarrier {
    unsigned* bar; unsigned x;
    volatile LAS unsigned* st;
};

__device__ __forceinline__ XcdBarrier xcd_barrier_post(unsigned* bar, volatile LAS unsigned* st) {
    XcdBarrier b; b.bar = bar; b.x = xb_xcc_id(); b.st = st;
    if (threadIdx.x == 0) (void)xb_add(&bar[XB_XCNT(b.x)], 1u);
    return b;
}
__device__ __forceinline__ void xcd_barrier_complete(unsigned* bar, unsigned x, unsigned& nloc, unsigned& nx) {
    const unsigned G = gridDim.x * gridDim.y * gridDim.z;
    unsigned sum, cnt, mine, sp = 0u;
    for (;;) {
        sum = 0u; cnt = 0u; mine = 0u;
#pragma unroll
        for (unsigned j = 0; j < 16; ++j) { const unsigned c = xb_ld(&bar[XB_XCNT(j)]); sum += c; cnt += (c > 0u) ? 1u : 0u; mine = (j == x) ? c : mine; }
        if (sum == G) break;
        __builtin_amdgcn_s_sleep(1);
        if ((++sp & 255u) == 0u) { if (xb_ld(&bar[XB_TMO])) break; if (sp > XB_SPIN_CAP) { atomicAdd(&bar[XB_TMO], 1u); break; } }
    }
    nloc = mine > 0u ? mine : 1u; nx = cnt > 0u ? cnt : 1u;
}

__device__ __forceinline__ void xcd_barrier(const XcdBarrier& b) {
    asm volatile("s_waitcnt vmcnt(0)" ::: "memory");
    __syncthreads();
    if (threadIdx.x == 0) {
        unsigned* bar = b.bar;
        __builtin_amdgcn_s_waitcnt(0);
        unsigned nloc = b.st[0], nx = b.st[1];
        if (nloc == 0u) { xcd_barrier_complete(bar, b.x, nloc, nx); b.st[0] = nloc; b.st[1] = nx; }
        const unsigned old = xb_add(&bar[XB_XSUB(b.x)], 1u);
        const unsigned gen = old / nloc;
        if (old + 1u == (gen + 1u) * nloc) {
            __builtin_amdgcn_fence(__ATOMIC_RELEASE, "agent");
            asm volatile("s_waitcnt vmcnt(0)" ::: "memory");
            const unsigned og = xb_add(&bar[XB_TOP], 1u);
            const unsigned tg = og / nx;
            if (og + 1u == (tg + 1u) * nx) xb_add(&bar[XB_TOPGEN], 1u);
            else XB_SPIN(xb_ld(&bar[XB_TOPGEN]) == tg, bar);
            __builtin_amdgcn_fence(__ATOMIC_ACQUIRE, "agent");
            xb_add(&bar[XB_XGEN(b.x)], 1u);
            asm volatile("s_waitcnt vmcnt(0)" ::: "memory");
        } else {
            XB_SPIN(xb_ld(&bar[XB_XGEN(b.x)]) == gen, bar);
            __builtin_amdgcn_fence(__ATOMIC_ACQUIRE, "agent");
            asm volatile("s_waitcnt vmcnt(0)" ::: "memory");
        }
    }
    __syncthreads();
}


struct Args { const float* in[23]; float* out; unsigned char* ws; int s_lo, s_hi, probe, pad; };

struct Frame {
    LAS unsigned char* lds; int tid, lane, wave, vcu, G;
    const float* const* in; float* h; unsigned char* ws; int probe;
};

#define LAUNDER(F) do { asm volatile("" : "+v"((F).tid)); (F).lane = (F).tid & 63; asm volatile("" : "+s"((F).G), "+s"((F).vcu)); } while (0)
__device__ __forceinline__ void p0_item(const float* W, int ldw, int k0, int n0, bf16* WT, int Kd, int drow0, float scale, LAS float* scr, int lane) {
#pragma unroll 8
    for (int i = 0; i < 32; ++i) { const int kk = 2 * i + (lane >> 5); scr[kk * 33 + (lane & 31)] = W[(size_t)(k0 + kk) * ldw + n0 + (lane & 31)] * scale; }
    LDS_WAIT(); asm volatile("" ::: "memory");
    const int c = lane & 7;
#pragma unroll
    for (int j = 0; j < 4; ++j) { const int n = (lane >> 3) + 8 * j; const LAS float* s = scr + (8 * c) * 33 + n;
        v4u o; o.x = pk2(s[0 * 33], s[1 * 33]); o.y = pk2(s[2 * 33], s[3 * 33]); o.z = pk2(s[4 * 33], s[5 * 33]); o.w = pk2(s[6 * 33], s[7 * 33]);
        *(v4u*)(WT + (size_t)(drow0 + n) * Kd + k0 + 8 * c) = o; }
    LDS_WAIT(); asm volatile("" ::: "memory");
}
__device__ __forceinline__ bool is_q_col(int n) { return n < 512 || (n >= 768 && n < 3072 && ((n - 768) % 768) < 256) || (n >= 3072 && n < 3584); }

__device__ __forceinline__ void ph_prologue(Frame& F) { LAUNDER(F);
    LAS float* scr = (LAS float*)(F.lds + RING_OFF + F.wave * 16384);
    const int gw = F.vcu * NWAVES + F.wave, NGW = F.G * NWAVES, lane = F.lane;
    const float* w_in = F.in[4]; const float* w_a = F.in[8]; const float* w_b = F.in[9]; const float* w_c = F.in[10]; const float* w_o = F.in[11];
    const float* w_eg = F.in[18]; const float* w_eu = F.in[19]; const float* w_ed = F.in[20];
    bf16* WIN = (bf16*)(F.ws + WS_WIN); bf16* WBRA = (bf16*)(F.ws + WS_WBRA); bf16* WBRB = (bf16*)(F.ws + WS_WBRB); bf16* WBRC = (bf16*)(F.ws + WS_WBRC); bf16* WOUT = (bf16*)(F.ws + WS_WOUT);
    bf16* WGU = (bf16*)(F.ws + WS_WGU); bf16* WD = (bf16*)(F.ws + WS_WD);
    constexpr int I_IN = 16 * (NCOL / 32), I_A = 8 * 32, I_B = 4 * 32, I_C = 8 * 32, I_O = 16 * 32, I_G = 16 * 16, I_D = 8 * 32;
    constexpr int I_LAYER = I_IN + I_A + I_B + I_C + I_O + NE * (2 * I_G + I_D);
    for (int it = gw; it < DEPTH * I_LAYER; it += NGW) {
        const int l = it / I_LAYER; int r = it % I_LAYER;
        if (r < I_IN) { const int nb = r % (NCOL / 32), kb = r / (NCOL / 32); p0_item(w_in + (size_t)l * D * NCOL, NCOL, 64 * kb, 32 * nb, WIN + (size_t)l * NCOL * D, D, 32 * nb, is_q_col(32 * nb) ? QSCALE : 1.0f, scr, lane); continue; } r -= I_IN;
        if (r < I_A) { const int nb = r % 32, kb = r / 32; p0_item(w_a + (size_t)l * 512 * D, D, 64 * kb, 32 * nb, WBRA + (size_t)l * D * 512, 512, 32 * nb, 1.0f, scr, lane); continue; } r -= I_A;
        if (r < I_B) { const int nb = r % 32, kb = r / 32; p0_item(w_b + (size_t)l * 256 * D, D, 64 * kb, 32 * nb, WBRB + (size_t)l * D * 256, 256, 32 * nb, 1.0f, scr, lane); continue; } r -= I_B;
        if (r < I_C) { const int nb = r % 32, kb = r / 32; p0_item(w_c + (size_t)l * 512 * D, D, 64 * kb, 32 * nb, WBRC + (size_t)l * D * 512, 512, 32 * nb, 1.0f, scr, lane); continue; } r -= I_C;
        if (r < I_O) { const int nb = r % 32, kb = r / 32; p0_item(w_o + (size_t)l * D * D, D, 64 * kb, 32 * nb, WOUT + (size_t)l * D * D, D, 32 * nb, 1.0f, scr, lane); continue; } r -= I_O;
        const int e = r / (2 * I_G + I_D); r %= (2 * I_G + I_D); const size_t le = (size_t)l * NE + e;
        if (r < 2 * I_G) { const int up = r / I_G; r %= I_G; const int nb = r % 16, kb = r / 16;
            p0_item((up ? w_eu : w_eg) + le * D * DE, DE, 64 * kb, 32 * nb, WGU + le * 1024 * 1024, D, (nb >> 2) * 256 + up * 128 + (nb & 3) * 32, 1.0f, scr, lane); continue; }
        r -= 2 * I_G; { const int nb = r % 32, kb = r / 32; p0_item(w_ed + le * DE * D, D, 64 * kb, 32 * nb, WD + le * D * DE, DE, 32 * nb, 1.0f, scr, lane); }
    }
}

template <int MODE> __device__ __forceinline__ void ln_row(const float* src, const float* h, float* hout, bf16* hb, const bf16* yb, const float* g, const float* bta, size_t row, int lane, f32x4 (&o)[4]) {
    f32x4 v[4];
#pragma unroll
    for (int j = 0; j < 4; ++j) {
        const int c = lane * 4 + 256 * j;
        v[j] = *(const f32x4*)((MODE == 0 ? src : h) + row * D + c);
        if (MODE == 2) {
            const uint2 a = *(const uint2*)(yb + (row * 2) * D + c), b = *(const uint2*)(yb + (row * 2 + 1) * D + c);
            v[j].x = ALPHA * v[j].x + bf2f((bf16)(a.x & 0xffff)) + bf2f((bf16)(b.x & 0xffff));
            v[j].y = ALPHA * v[j].y + bf2f((bf16)(a.x >> 16)) + bf2f((bf16)(b.x >> 16));
            v[j].z = ALPHA * v[j].z + bf2f((bf16)(a.y & 0xffff)) + bf2f((bf16)(b.y & 0xffff));
            v[j].w = ALPHA * v[j].w + bf2f((bf16)(a.y >> 16)) + bf2f((bf16)(b.y >> 16));
        }
    }
    float s = 0.f;
#pragma unroll
    for (int j = 0; j < 4; ++j) s += (v[j].x + v[j].y) + (v[j].z + v[j].w);
    const float mean = wave_sum(s) * (1.f / D);
    float q = 0.f;
#pragma unroll
    for (int j = 0; j < 4; ++j) { v[j] = v[j] - mean; q += (v[j].x * v[j].x + v[j].y * v[j].y) + (v[j].z * v[j].z + v[j].w * v[j].w); }
    const float rstd = 1.0f / sqrtf(wave_sum(q) * (1.f / D) + LN_EPS);
#pragma unroll
    for (int j = 0; j < 4; ++j) {
        const int c = lane * 4 + 256 * j;
        const f32x4 gg = *(const f32x4*)(g + c), bb = *(const f32x4*)(bta + c);
        o[j] = v[j] * rstd * gg + bb;
        *(f32x4*)(hout + row * D + c) = o[j];
        if (hb) { uint2 w; w.x = pk2(o[j].x, o[j].y); w.y = pk2(o[j].z, o[j].w); *(uint2*)(hb + row * D + c) = w; }
    }
}

struct EpiP1 {
    static constexpr bool PERM = true;
    bf16* qkv; bf16* gates; const float* b_gate;
    __device__ __forceinline__ void operator()(const f32x4 (&acc)[2][2][4][2], const pg8::Unit& u, int wr, int wc, int fr, int fq) const {
        const int row0 = u.pm * 256 + wr * 64 + fr; const bool isg = u.pn >= 18;
        bf16* base = isg ? gates : qkv; const int ldc = isg ? GATEW : QKVW; const int col0 = (isg ? (u.pn - 18) : u.pn) * 256 + wc * 32 + 8 * fq;
        f32x4 bv[2][2];
#pragma unroll
        for (int bj = 0; bj < 2; ++bj)
#pragma unroll
            for (int n = 0; n < 2; ++n) bv[bj][n] = isg ? *(const f32x4*)(b_gate + col0 + bj * 128 + 4 * n) : (f32x4){0.f, 0.f, 0.f, 0.f};
#pragma unroll
        for (int ai = 0; ai < 2; ++ai)
#pragma unroll
            for (int m = 0; m < 4; ++m) { bf16* rowp = base + (size_t)(row0 + ai * 128 + m * 16) * ldc + col0;
#pragma unroll
                for (int bj = 0; bj < 2; ++bj) { f32x4 v0 = acc[ai][bj][m][0] + bv[bj][0], v1 = acc[ai][bj][m][1] + bv[bj][1];
                    if (isg) {
#pragma unroll
                        for (int j = 0; j < 4; ++j) { v0[j] = __builtin_amdgcn_rcpf(1.0f + __builtin_amdgcn_exp2f(-LOG2E * v0[j])); v1[j] = __builtin_amdgcn_rcpf(1.0f + __builtin_amdgcn_exp2f(-LOG2E * v1[j])); } }
                    v4u w; w.x = pg8::cvt_pk_bf16(v0[0], v0[1]); w.y = pg8::cvt_pk_bf16(v0[2], v0[3]); w.z = pg8::cvt_pk_bf16(v1[0], v1[1]); w.w = pg8::cvt_pk_bf16(v1[2], v1[3]);
                    *(v4u*)(rowp + bj * 128) = w; } }
    }
};
template <bool FIRST> struct EpiP3 {
    static constexpr bool PERM = true;
    bf16* merged; const bf16* gates; int br;
    __device__ __forceinline__ void operator()(const f32x4 (&acc)[2][2][4][2], const pg8::Unit& u, int wr, int wc, int fr, int fq) const {
        const int row0 = u.pm * 256 + wr * 64 + fr, col0 = u.pn * 256 + wc * 32 + 8 * fq;
#pragma unroll
        for (int ai = 0; ai < 2; ++ai)
#pragma unroll
            for (int m = 0; m < 4; ++m) { const size_t row = (size_t)(row0 + ai * 128 + m * 16);
#pragma unroll
                for (int bj = 0; bj < 2; ++bj) {
                    const v4u gw = *(const v4u*)(gates + row * GATEW + br * 1024 + col0 + bj * 128);
                    v4u ow = FIRST ? (v4u){0u, 0u, 0u, 0u} : *(const v4u*)(merged + row * D + col0 + bj * 128);
                    const f32x4 a0 = acc[ai][bj][m][0], a1 = acc[ai][bj][m][1];
                    float r[8];
#pragma unroll
                    for (int j = 0; j < 4; ++j) { const unsigned g2 = gw[j], o2 = ow[j]; const float av0 = j < 2 ? a0[2 * j] : a1[2 * j - 4], av1 = j < 2 ? a0[2 * j + 1] : a1[2 * j - 3];
                        r[2 * j] = __uint_as_float(g2 << 16) * av0 + (FIRST ? 0.f : __uint_as_float(o2 << 16)); r[2 * j + 1] = __uint_as_float(g2 & 0xffff0000u) * av1 + (FIRST ? 0.f : __uint_as_float(o2 & 0xffff0000u)); }
                    v4u w; w.x = pg8::cvt_pk_bf16(r[0], r[1]); w.y = pg8::cvt_pk_bf16(r[2], r[3]); w.z = pg8::cvt_pk_bf16(r[4], r[5]); w.w = pg8::cvt_pk_bf16(r[6], r[7]);
                    *(v4u*)(merged + row * D + col0 + bj * 128) = w; }
                asm volatile("" ::: "memory"); }
    }
};
struct EpiP4 {
    static constexpr bool PERM = false;
    const float* hc; float* ho;
    __device__ __forceinline__ void operator()(const f32x4 (&acc)[2][2][4][2], const pg8::Unit& u, int wr, int wc, int fr, int fq) const {
        const int row0 = u.pm * 256 + wr * 64 + fr, col0 = u.pn * 256 + wc * 32 + 4 * fq;
#pragma unroll
        for (int ai = 0; ai < 2; ++ai)
#pragma unroll
            for (int m = 0; m < 4; ++m) { const size_t ro = (size_t)(row0 + ai * 128 + m * 16) * D + col0;
#pragma unroll
                for (int bj = 0; bj < 2; ++bj)
#pragma unroll
                    for (int n = 0; n < 2; ++n) { const f32x4 hv = *(const f32x4*)(hc + ro + bj * 128 + n * 16); *(f32x4*)(ho + ro + bj * 128 + n * 16) = hv * ALPHA + acc[ai][bj][m][n]; }
                asm volatile("" ::: "memory"); }
    }
};
struct EpiP7 {
    static constexpr bool PERM = true;
    bf16* hid;
    __device__ __forceinline__ void operator()(const f32x4 (&acc)[2][2][4][2], const pg8::Unit& u, int wr, int wc, int fr, int fq) const {
        const int row0 = u.pm * 256 + wr * 64 + fr, col0 = u.pn * 128 + wc * 32 + 8 * fq;
#pragma unroll
        for (int ai = 0; ai < 2; ++ai)
#pragma unroll
            for (int m = 0; m < 4; ++m) { float r[8];
#pragma unroll
                for (int n = 0; n < 2; ++n)
#pragma unroll
                    for (int j = 0; j < 4; ++j) { const float gv = acc[ai][0][m][n][j], uv = acc[ai][1][m][n][j]; r[4 * n + j] = gv * __builtin_amdgcn_rcpf(1.0f + __builtin_amdgcn_exp2f(-LOG2E * gv)) * uv; }
                v4u w; w.x = pg8::cvt_pk_bf16(r[0], r[1]); w.y = pg8::cvt_pk_bf16(r[2], r[3]); w.z = pg8::cvt_pk_bf16(r[4], r[5]); w.w = pg8::cvt_pk_bf16(r[6], r[7]);
                *(v4u*)(hid + (size_t)(row0 + ai * 128 + m * 16) * DE + col0) = w; }
    }
};
struct EpiP8 {
    static constexpr bool PERM = true;
    bf16* yb; const int* rowtok; const float* rowgate;
    __device__ __forceinline__ void operator()(const f32x4 (&acc)[2][2][4][2], const pg8::Unit& u, int wr, int wc, int fr, int fq) const {
        const int row0 = u.pm * 256 + wr * 64 + fr, col0 = u.pn * 256 + wc * 32 + 8 * fq;
#pragma unroll
        for (int ai = 0; ai < 2; ++ai)
#pragma unroll
            for (int m = 0; m < 4; ++m) { const int row = row0 + ai * 128 + m * 16; const int rt = rowtok[row]; const float gt = rowgate[row];
                if (rt >= 0) {
#pragma unroll
                    for (int bj = 0; bj < 2; ++bj) { const f32x4 v0 = acc[ai][bj][m][0] * gt, v1 = acc[ai][bj][m][1] * gt;
                        v4u w; w.x = pg8::cvt_pk_bf16(v0[0], v0[1]); w.y = pg8::cvt_pk_bf16(v0[2], v0[3]); w.z = pg8::cvt_pk_bf16(v1[0], v1[1]); w.w = pg8::cvt_pk_bf16(v1[2], v1[3]);
                        *(v4u*)(yb + (size_t)rt * D + col0 + bj * 128) = w; } } }
    }
};

__device__ __forceinline__ void router_row(const float (&x)[16], int t, int lane, const LAS float* w_rg, const float* b_rg, const LAS float* w_re, const float* b_re, int* cnt, Rec* rec) {
    float gl[4] = {0.f, 0.f, 0.f, 0.f};
#pragma unroll
    for (int j = 0; j < 4; ++j)
#pragma unroll
        for (int i = 0; i < 4; ++i) { const f32x4 w = *(const LAS f32x4*)(w_rg + ((j * 4 + i) * 64 + lane) * 4); const float xv = x[4 * j + i]; gl[0] += xv * w.x; gl[1] += xv * w.y; gl[2] += xv * w.z; gl[3] += xv * w.w; }
#pragma unroll
    for (int g = 0; g < 4; ++g) gl[g] = wave_sum(gl[g]) + b_rg[g];
    int gi = 0; float gm = gl[0];
#pragma unroll
    for (int g = 1; g < 4; ++g) if (gl[g] > gm) { gm = gl[g]; gi = g; }
    float gs = 0.f;
#pragma unroll
    for (int g = 0; g < 4; ++g) gs += __expf(gl[g] - gm);
    const float gw = 1.0f / gs;
    float el[8];
#pragma unroll
    for (int e = 0; e < 8; ++e) el[e] = 0.f;
    const LAS float* wre = w_re + gi * (D * 8);
#pragma unroll
    for (int j = 0; j < 4; ++j)
#pragma unroll
        for (int i = 0; i < 4; ++i) { const LAS float* wp = wre + ((j * 4 + i) * 128 + lane) * 4; const f32x4 w0 = *(const LAS f32x4*)wp, w1 = *(const LAS f32x4*)(wp + 256); const float xv = x[4 * j + i];
            el[0] += xv * w0.x; el[1] += xv * w0.y; el[2] += xv * w0.z; el[3] += xv * w0.w; el[4] += xv * w1.x; el[5] += xv * w1.y; el[6] += xv * w1.z; el[7] += xv * w1.w; }
#pragma unroll
    for (int e = 0; e < 8; ++e) el[e] = wave_sum(el[e]) + b_re[gi * 8 + e];
    int i0 = 0; float t0 = el[0];
#pragma unroll
    for (int e = 1; e < 8; ++e) if (el[e] > t0) { t0 = el[e]; i0 = e; }
    int i1 = -1; float t1 = -3.0e38f;
#pragma unroll
    for (int e = 0; e < 8; ++e) if (e != i0 && el[e] > t1) { t1 = el[e]; i1 = e; }
    const float ex = __expf(t1 - t0), p0 = 1.0f / (1.0f + ex), p1 = ex / (1.0f + ex);
    if (lane == 0) {
        Rec rc; rc.e0 = gi * 8 + i0; rc.e1 = gi * 8 + i1; rc.g0 = gw * p0; rc.g1 = gw * p1; rc.pad0 = 0; rc.pad1 = 0;
        rc.s0 = atomicAdd(cnt + rc.e0 * CSTR, 1); rc.s1 = atomicAdd(cnt + rc.e1 * CSTR, 1);
        rec[t] = rc;
    }
}

__device__ __forceinline__ void ph_ln0(Frame& F) { LAUNDER(F);
    const int gw = F.vcu * NWAVES + F.wave, NGW = F.G * NWAVES;
    bf16* hb = (bf16*)(F.ws + WS_HB);
    for (int m = gw; m < T; m += NGW) { f32x4 o[4]; ln_row<0>(F.in[0], F.h, F.h, hb, nullptr, F.in[1], F.in[2], (size_t)m, F.lane, o); }
}
__device__ __forceinline__ void ph_p1(Frame& F, int l, int c) { LAUNDER(F);
    pg8::DenseOrder S; S.init((const bf16*)(F.ws + WS_HB) + (size_t)c * CH * D, D, (const bf16*)(F.ws + WS_WIN) + (size_t)l * NCOL * D, D, CH, NCOL, F.G, (int)blockIdx.x);
    EpiP1 E{(bf16*)(F.ws + WS_QKV), (bf16*)(F.ws + WS_GATES), F.in[5] + (size_t)l * GATEW};
    pg8::gemm_phase<EpiP1, pg8::DenseOrder, false>(F.lds + RING_OFF, S, E, D, D, D);
}
__device__ __forceinline__ void ph_cmb(Frame& F) { LAUNDER(F);
    const bf16* og = (const bf16*)(F.ws + WS_OG); const float* lse = (const float*)(F.ws + WS_LSE); bf16* oabc = (bf16*)(F.ws + WS_OABC);
    for (int idx = F.vcu * NTHREADS + F.tid; idx < CH * 32; idx += F.G * NTHREADS) {
        const int tl = idx >> 5, hc = idx & 31, h = hc >> 3, c = hc & 7;
        const float l0 = lse[((size_t)tl * 3 + 0) * 4 + h], l1 = lse[((size_t)tl * 3 + 1) * 4 + h], l2 = lse[((size_t)tl * 3 + 2) * 4 + h];
        const float mx = fmaxf(l0, fmaxf(l1, l2)); float w0 = __expf(l0 - mx), w1 = __expf(l1 - mx), w2 = __expf(l2 - mx); const float inv = 1.0f / (w0 + w1 + w2); w0 *= inv; w1 *= inv; w2 *= inv;
        const v4u a = *(const v4u*)(og + ((size_t)tl * 3 + 0) * 256 + h * 64 + c * 8), b = *(const v4u*)(og + ((size_t)tl * 3 + 1) * 256 + h * 64 + c * 8), d = *(const v4u*)(og + ((size_t)tl * 3 + 2) * 256 + h * 64 + c * 8);
        v4u ow;
#pragma unroll
        for (int i = 0; i < 4; ++i) {
            const float lo = w0 * __uint_as_float(a[i] << 16) + w1 * __uint_as_float(b[i] << 16) + w2 * __uint_as_float(d[i] << 16);
            const float hi = w0 * __uint_as_float(a[i] & 0xffff0000u) + w1 * __uint_as_float(b[i] & 0xffff0000u) + w2 * __uint_as_float(d[i] & 0xffff0000u);
            ow[i] = pk2(lo, hi);
        }
        *(v4u*)(oabc + (size_t)tl * OW + 512 + h * 64 + c * 8) = ow;
    }
}
__device__ __forceinline__ void ph_p3(Frame& F, int l) { LAUNDER(F);
    const bf16* oabc = (const bf16*)(F.ws + WS_OABC); bf16* merged = (bf16*)(F.ws + WS_MERGED); const bf16* gates = (const bf16*)(F.ws + WS_GATES);
    { pg8::DenseOrder S; S.init(oabc, OW, (const bf16*)(F.ws + WS_WBRA) + (size_t)l * D * 512, 512, CH, D, F.G, (int)blockIdx.x);
      EpiP3<true> E{merged, gates, 0}; pg8::gemm_phase<EpiP3<true>, pg8::DenseOrder, false>(F.lds + RING_OFF, S, E, 512, OW, 512); }
    { pg8::DenseOrder S; S.init(oabc + 512, OW, (const bf16*)(F.ws + WS_WBRB) + (size_t)l * D * 256, 256, CH, D, F.G, (int)blockIdx.x);
      EpiP3<false> E{merged, gates, 1}; pg8::gemm_phase<EpiP3<false>, pg8::DenseOrder, false>(F.lds + RING_OFF, S, E, 256, OW, 256); }
    { pg8::DenseOrder S; S.init(oabc + 768, OW, (const bf16*)(F.ws + WS_WBRC) + (size_t)l * D * 512, 512, CH, D, F.G, (int)blockIdx.x);
      EpiP3<false> E{merged, gates, 2}; pg8::gemm_phase<EpiP3<false>, pg8::DenseOrder, false>(F.lds + RING_OFF, S, E, 512, OW, 512); }
}
__device__ __forceinline__ void ph_p4(Frame& F, int l, int c) { LAUNDER(F);
    pg8::DenseOrder S; S.init((const bf16*)(F.ws + WS_MERGED), D, (const bf16*)(F.ws + WS_WOUT) + (size_t)l * D * D, D, CH, D, F.G, (int)blockIdx.x);
    EpiP4 E{F.h + (size_t)c * CH * D, F.probe ? (float*)(F.ws + WS_OABC) : F.h + (size_t)c * CH * D};
    pg8::gemm_phase<EpiP4, pg8::DenseOrder, false>(F.lds + RING_OFF, S, E, D, D, D);
}
__device__ __forceinline__ void ph_ln1(Frame& F, int l, int c) { LAUNDER(F);
    const int gw = F.vcu * NWAVES + F.wave, NGW = F.G * NWAVES;
    bf16* hb = (bf16*)(F.ws + WS_HB); int* cnt = (int*)(F.ws + WS_CTL) + CW_CNT + l * (32 * CSTR); Rec* rec = (Rec*)(F.ws + WS_REC);
    float* hout = F.h;
    if (F.probe) { hout = (float*)(F.ws + WS_OABC) - (size_t)c * CH * D; hb = (bf16*)(F.ws + WS_QKV) - (size_t)c * CH * D; cnt = (int*)(F.ws + WS_CTL) + 8192 + l * 1024; rec = (Rec*)(F.ws + WS_GATES); }
    LAS float* lrg = (LAS float*)(F.lds + RING_OFF); LAS float* lre = lrg + D * 4;
    { const float* w_rg = F.in[14] + (size_t)l * D * 4; const float* w_re = F.in[16] + (size_t)l * 4 * D * 8;
      for (int u = F.tid; u < D + 4 * D * 2; u += NTHREADS) {
          if (u < D) { const int e = u, ln = (e & 255) >> 2, i = e & 3, j = e >> 8; *(LAS f32x4*)(lrg + ((j * 4 + i) * 64 + ln) * 4) = *(const f32x4*)(w_rg + (size_t)e * 4); }
          else { const int v = u - D, half = v & 1, e = (v >> 1) & 1023, g = v >> 11, ln = (e & 255) >> 2, i = e & 3, j = e >> 8;
                 *(LAS f32x4*)(lre + g * (D * 8) + (((j * 4 + i) * 2 + half) * 64 + ln) * 4) = *(const f32x4*)(w_re + ((size_t)g * D + e) * 8 + half * 4); } }
      __syncthreads(); }
    for (int m = gw; m < CH; m += NGW) {
        const size_t row = (size_t)c * CH + m; f32x4 o[4];
        ln_row<1>(nullptr, F.h, hout, hb, nullptr, F.in[12] + l * D, F.in[13] + l * D, row, F.lane, o);
        float x[16];
#pragma unroll
        for (int j = 0; j < 4; ++j) { x[4 * j] = o[j].x; x[4 * j + 1] = o[j].y; x[4 * j + 2] = o[j].z; x[4 * j + 3] = o[j].w; }
        router_row(x, (int)row, F.lane, lrg, F.in[15] + l * 4, lre, F.in[17] + l * 32, cnt, rec);
    }
    __syncthreads();
}
__device__ __forceinline__ void ph_dsp(Frame& F, int l) { LAUNDER(F);
    LAS int* po = (LAS int*)(F.lds + ROWS_OFF);
    const int* cnt = (const int*)(F.ws + WS_CTL) + CW_CNT + l * (32 * CSTR); const Rec* rec = (const Rec*)(F.ws + WS_REC); int* rowtok = (int*)(F.ws + WS_ROWTOK); float* rowgate = (float*)(F.ws + WS_ROWGATE);
    if (F.tid == 0) { int acc = 0; for (int e = 0; e < NE; ++e) { po[e] = acc; acc += (cnt[e * CSTR] + 255) / 256 * 256; } po[NE] = acc; }
    __syncthreads();
    const int gt = F.vcu * NTHREADS + F.tid, GT = F.G * NTHREADS;
    for (int t = gt; t < T; t += GT) {
        const Rec rc = rec[t];
        const int d0 = po[rc.e0] + rc.s0, d1 = po[rc.e1] + rc.s1;
        rowtok[d0] = 2 * t; rowgate[d0] = rc.g0; rowtok[d1] = 2 * t + 1; rowgate[d1] = rc.g1;
    }
    for (int e = 0; e < NE; ++e) for (int r = po[e] + cnt[e * CSTR] + gt; r < po[e + 1]; r += GT) { rowtok[r] = -1; rowgate[r] = 0.f; }
    __syncthreads();
}
__device__ __forceinline__ int moe_setup(Frame& F, int l, bool gather) { LAUNDER(F);
    LAS int* rows = (LAS int*)(F.lds + ROWS_OFF); LAS int* ulist = rows + 11 * 256; LAS int* po = ulist + 16;
    const int* cnt = (const int*)(F.ws + WS_CTL) + CW_CNT + l * (32 * CSTR); const int* rowtok = (const int*)(F.ws + WS_ROWTOK);
    if (F.tid == 0) { int acc = 0; for (int e = 0; e < NE; ++e) { po[e] = acc; acc += (cnt[e * CSTR] + 255) / 256 * 256; } po[NE] = acc; }
    __syncthreads();
    const int nu_all = (po[NE] / 256) * 4; int nun = (nu_all - F.vcu + F.G - 1) / F.G; nun = nun < 0 ? 0 : (nun > 11 ? 11 : nun);
    if (F.tid < nun) { const int Lx = F.tid * F.G + F.vcu, rt = Lx >> 2, pn = Lx & 3; int e = 0; while (e < NE - 1 && po[e + 1] <= rt * 256) ++e; ulist[F.tid] = (rt << 8) | (e << 2) | pn; }
    if (gather) for (int idx = F.tid; idx < nun * 256; idx += NTHREADS) { const int i = idx >> 8, r = idx & 255, Lx = i * F.G + F.vcu; rows[idx] = rowtok[(Lx >> 2) * 256 + r]; }
    __syncthreads();
    return nun;
}
struct MoeOrder {
    int nun; const LAS int* ulist; const LAS int* rows; const char* A; const char* B; size_t tstepA, estepB, tstepB;
    __device__ __forceinline__ bool next(int i, pg8::Unit& u) const {
        if (i >= nun) return false;
        const int w = __builtin_amdgcn_readfirstlane(ulist[i]); u.pm = w >> 8; u.e = (w >> 2) & 63; u.pn = w & 3; u.ui = i; return true;
    }
    __device__ __forceinline__ const char* a_base(const pg8::Unit& u) const { return A + (size_t)u.pm * tstepA; }
    __device__ __forceinline__ const char* b_base(const pg8::Unit& u) const { return B + (size_t)u.e * estepB + (size_t)u.pn * tstepB; }
    __device__ __forceinline__ int a_row(const pg8::Unit& u, int r) const { const int t = rows[u.ui * 256 + r]; return t < 0 ? 0 : (t >> 1); }
};
__device__ __forceinline__ void ph_p7(Frame& F, int l) { LAUNDER(F);
    const int nun = moe_setup(F, l, true);
    LAS int* rows = (LAS int*)(F.lds + ROWS_OFF);
    MoeOrder S{nun, rows + 11 * 256, rows, (const char*)(F.ws + WS_HB), (const char*)(F.ws + WS_WGU) + (size_t)l * NE * 1024 * 1024 * 2, 0, (size_t)1024 * 1024 * 2, (size_t)256 * 1024 * 2};
    EpiP7 E{(bf16*)(F.ws + WS_HID)};
    pg8::gemm_phase<EpiP7, MoeOrder, true>(F.lds + RING_OFF, S, E, D, D, D);
}
__device__ __forceinline__ void ph_p8(Frame& F, int l) { LAUNDER(F);
    const int nun = moe_setup(F, l, false);
    LAS int* rows = (LAS int*)(F.lds + ROWS_OFF);
    MoeOrder S{nun, rows + 11 * 256, rows, (const char*)(F.ws + WS_HID), (const char*)(F.ws + WS_WD) + (size_t)l * NE * 1024 * 512 * 2, (size_t)256 * DE * 2, (size_t)1024 * 512 * 2, (size_t)256 * 512 * 2};
    EpiP8 E{(bf16*)(F.ws + WS_YB), (const int*)(F.ws + WS_ROWTOK), (const float*)(F.ws + WS_ROWGATE)};
    pg8::gemm_phase<EpiP8, MoeOrder, false>(F.lds + RING_OFF, S, E, DE, DE, DE);
}
__device__ __forceinline__ void ph_ln2(Frame& F, int l) { LAUNDER(F);
    const int gw = F.vcu * NWAVES + F.wave, NGW = F.G * NWAVES;
    bf16* hb = (l == DEPTH - 1) ? nullptr : (bf16*)(F.ws + WS_HB);
    if (F.probe) { for (int m = gw; m < T; m += NGW) { f32x4 o[4]; ln_row<2>(nullptr, F.h, (float*)(F.ws + WS_OABC) - (size_t)(m & ~32767) * D, nullptr, (const bf16*)(F.ws + WS_YB), F.in[21] + l * D, F.in[22] + l * D, (size_t)m, F.lane, o); } return; }
    for (int m = gw; m < T; m += NGW) { f32x4 o[4]; ln_row<2>(nullptr, F.h, F.h, hb, (const bf16*)(F.ws + WS_YB), F.in[21] + l * D, F.in[22] + l * D, (size_t)m, F.lane, o); }
}

typedef short s16x4 __attribute__((ext_vector_type(4)));
constexpr int NT_A = (CH / 32) * 8, NT_B = (CH / L) * 3 * 256 * 4, NT_C = (CH / 32) * 8, NT_ALL = NT_A + NT_B + NT_C;
constexpr float NEGBIG = -1.0e30f, MINIT = -5.0e29f;
#define RC16(reg) (((reg) & 3) + 8 * ((reg) >> 2))

__device__ __forceinline__ void ph_tables(Frame& F) { LAUNDER(F);
    float* TA = (float*)(F.ws + WS_TABA); float* TB = (float*)(F.ws + WS_TABB); float* TC = (float*)(F.ws + WS_TABC);
    const float* rel_bias = F.in[3]; const float* rpb = F.in[7];
    const int gt = F.vcu * NTHREADS + F.tid, GT = F.G * NTHREADS;
    for (int i = gt; i < 8 * 320; i += GT) { const int h = i / 320, rel = i % 320 - 160; TA[i] = (rel >= -128 && rel <= 128) ? rel_bias[BUCK_A[rel + 128] * 20 + h] * LOG2E : NEGBIG; }
    for (int i = gt; i < 12 * 192; i += GT) { const int gh = i / 192, g = gh >> 2, rel = i % 192 - 96; TB[i] = (rel >= -64 && rel <= 64) ? rel_bias[BUCK_B[g][rel + 64] * 20 + 8 + gh] * LOG2E : NEGBIG; }
    for (int i = gt; i < DEPTH * 8 * 1024; i += GT) { const int lh = i >> 10, ri = (i >> 6) & 15, ci = (i & 63) - 16; TC[i] = (ri < 15 && ci >= 0 && ci <= 30) ? rpb[((size_t)lh * 15 + ri) * 31 + ci] * LOG2E : NEGBIG; }
}

template <int TYPE>
__device__ __forceinline__ void att_task(LAS unsigned char* wl, const int lane, const bf16* seq  , const float* tabsrc,
                                         const int qcol, const int kcol, const int vcol, const int TT0, const int TSTEP, const int kstride, const int tlo, const int thi,
                                         const int tq  , const int ci_i  , const int ci_c  , const int cbs,
                                         const float m_init, const float l_init, bf16* orow  , float* lse_out) {
    const int qi = lane & 31, hh = lane >> 5;
    LAS unsigned char* kt = wl; LAS unsigned char* vt = wl + 4096; LAS float* tb = (LAS float*)(wl + 8192);
    constexpr int TBN = TYPE == 0 ? 320 : (TYPE == 1 ? 192 : 1024);
#pragma unroll
    for (int i = 0; i < TBN / 64; ++i) tb[lane + 64 * i] = tabsrc[lane + 64 * i];
    bf16x8 Qf[4];
#pragma unroll
    for (int s = 0; s < 4; ++s) Qf[s] = *(const bf16x8*)(seq + (size_t)tq * QKVW + qcol + 16 * s + 8 * hh);
    f32x16 O0, O1;
#pragma unroll
    for (int i = 0; i < 16; ++i) { O0[i] = 0.f; O1[i] = 0.f; }
    float m = m_init, l = l_init;
    const int lkey = lane >> 3, lch = lane & 7;
    const bf16* gk = seq + (size_t)(lkey * kstride) * QKVW + 8 * lch;
    const size_t istep = (size_t)8 * kstride * QKVW;
    unsigned kwoff[4], vwoff[4];
#pragma unroll
    for (int i = 0; i < 4; ++i) { const int key = lkey + 8 * i; kwoff[i] = key * 128 + ((lch ^ (key & 7)) << 4); vwoff[i] = key * 128 + (((lch >> 2) ^ ((key >> 1) & 1)) << 6) + ((lch & 3) << 4); }
    unsigned kroff[4];
#pragma unroll
    for (int s = 0; s < 4; ++s) kroff[s] = qi * 128 + (((2 * s + hh) ^ (qi & 7)) << 4);
    const int q4 = (lane & 15) >> 2, p4 = lane & 3, g1 = (lane >> 4) & 1, sw = (q4 >> 1) & 1;
    const unsigned vr0 = (4 * hh + q4) * 128 + 32 * g1 + 8 * p4 + (sw << 6), vr1 = (4 * hh + q4) * 128 + 32 * g1 + 8 * p4 + ((sw ^ 1) << 6);
    const int bidx0 = (TYPE == 2) ? (cbs - ci_c + 31 + 4 * hh) : (32 - qi + 4 * hh);
    int cs = ci_c - 8; cs = cs < 0 ? 0 : (cs > 48 ? 48 : cs);
    const int xm = cbs - cs + 4 * hh;
    int rs_i = ci_i - 4; rs_i = rs_i < 0 ? 0 : (rs_i > 120 ? 120 : rs_i);
    v4u kreg[4], vreg[4];
    {
        const bf16* gt0 = gk + (size_t)(TT0 + tlo * TSTEP) * QKVW;
#pragma unroll
        for (int i = 0; i < 4; ++i) { kreg[i] = *(const v4u*)(gt0 + i * istep + kcol); vreg[i] = *(const v4u*)(gt0 + i * istep + vcol); }
    }
    for (int ti = tlo; ti <= thi; ++ti) {
#pragma unroll
        for (int i = 0; i < 4; ++i) { *(LAS v4u*)(kt + kwoff[i]) = kreg[i]; *(LAS v4u*)(vt + vwoff[i]) = vreg[i]; }
        if (ti < thi) {
            const bf16* gt0 = gk + (size_t)(TT0 + (ti + 1) * TSTEP) * QKVW;
#pragma unroll
            for (int i = 0; i < 4; ++i) { kreg[i] = *(const v4u*)(gt0 + i * istep + kcol); vreg[i] = *(const v4u*)(gt0 + i * istep + vcol); }
        }
        f32x16 S;
#pragma unroll
        for (int i = 0; i < 16; ++i) S[i] = 0.f;
#pragma unroll
        for (int s = 0; s < 4; ++s) { const bf16x8 Kf = *(const LAS bf16x8*)(kt + kroff[s]); S = __builtin_amdgcn_mfma_f32_32x32x16_bf16(Kf, Qf[s], S, 0, 0, 0); }
        int bidx;
        if (TYPE == 2) { const bool rv = (ti >= rs_i) && (ti < rs_i + 8); bidx = bidx0 + (rv ? (ti - ci_i + 7) : 15) * 64; }
        else bidx = bidx0 + 32 * ti;
        float tmax = NEGBIG;
#pragma unroll
        for (int r = 0; r < 16; ++r) { float v = S[r] + tb[bidx + RC16(r)]; if (TYPE == 2) v = ((unsigned)(xm + RC16(r)) < 16u) ? v : NEGBIG; S[r] = v; tmax = fmaxf(tmax, v); }
        tmax = fmaxf(tmax, __shfl_xor(tmax, 32));
        const float mn = fmaxf(m, tmax), corr = __builtin_amdgcn_exp2f(m - mn);
        float rsum = 0.f;
#pragma unroll
        for (int r = 0; r < 16; ++r) { const float p = __builtin_amdgcn_exp2f(S[r] - mn); S[r] = p; rsum += p; }
        rsum += __shfl_xor(rsum, 32);
        l = l * corr + rsum; m = mn;
#pragma unroll
        for (int i = 0; i < 16; ++i) { O0[i] *= corr; O1[i] *= corr; }
#pragma unroll
        for (int s2 = 0; s2 < 2; ++s2) {
            bf16x8 Pf; unsigned pw[4];
#pragma unroll
            for (int j = 0; j < 4; ++j) pw[j] = pg8::cvt_pk_bf16(S[8 * s2 + 2 * j], S[8 * s2 + 2 * j + 1]);
            Pf = __builtin_bit_cast(bf16x8, (v4u){pw[0], pw[1], pw[2], pw[3]});
            const s16x4 a00 = __builtin_amdgcn_ds_read_tr16_b64_v4i16((LAS s16x4*)(vt + vr0 + (16 * s2) * 128));
            const s16x4 a01 = __builtin_amdgcn_ds_read_tr16_b64_v4i16((LAS s16x4*)(vt + vr0 + (16 * s2 + 8) * 128));
            const s16x4 a10 = __builtin_amdgcn_ds_read_tr16_b64_v4i16((LAS s16x4*)(vt + vr1 + (16 * s2) * 128));
            const s16x4 a11 = __builtin_amdgcn_ds_read_tr16_b64_v4i16((LAS s16x4*)(vt + vr1 + (16 * s2 + 8) * 128));
            const bf16x8 V0 = (bf16x8){a00[0], a00[1], a00[2], a00[3], a01[0], a01[1], a01[2], a01[3]};
            const bf16x8 V1 = (bf16x8){a10[0], a10[1], a10[2], a10[3], a11[0], a11[1], a11[2], a11[3]};
            O0 = __builtin_amdgcn_mfma_f32_32x32x16_bf16(V0, Pf, O0, 0, 0, 0);
            O1 = __builtin_amdgcn_mfma_f32_32x32x16_bf16(V1, Pf, O1, 0, 0, 0);
        }
    }
    const float inv = 1.0f / l;
#pragma unroll
    for (int g = 0; g < 4; ++g) {
        v2u w0, w1;
        w0.x = pg8::cvt_pk_bf16(O0[4 * g] * inv, O0[4 * g + 1] * inv); w0.y = pg8::cvt_pk_bf16(O0[4 * g + 2] * inv, O0[4 * g + 3] * inv);
        w1.x = pg8::cvt_pk_bf16(O1[4 * g] * inv, O1[4 * g + 1] * inv); w1.y = pg8::cvt_pk_bf16(O1[4 * g + 2] * inv, O1[4 * g + 3] * inv);
        *(v2u*)(orow + 8 * g + 4 * hh) = w0; *(v2u*)(orow + 32 + 8 * g + 4 * hh) = w1;
    }
    if (TYPE == 1 && hh == 0) *lse_out = (m + __builtin_amdgcn_logf(l)) * LN2;
}

__device__ __forceinline__ void ph_att(Frame& F, int l) { LAUNDER(F);
    const int lane = F.lane, qi = lane & 31;
    LAS unsigned char* wl = F.lds + RING_OFF + F.wave * 16384;
    const bf16* qkv = (const bf16*)(F.ws + WS_QKV); bf16* oabc = (bf16*)(F.ws + WS_OABC); bf16* og = (bf16*)(F.ws + WS_OG); float* lse = (float*)(F.ws + WS_LSE);
    const float* TA = (const float*)(F.ws + WS_TABA); const float* TB = (const float*)(F.ws + WS_TABB); const float* TC = (const float*)(F.ws + WS_TABC) + (size_t)l * 8 * 1024;
    const float* sink = F.in[6] + l * 8;
    const int gw = F.vcu * NWAVES + F.wave, NGW = F.G * NWAVES;
    for (int task = gw; task < NT_ALL; task += NGW) {
        if (task < NT_A) {
            const int hq = task & 7, qb = (task >> 3) & 255, b = task >> 11, q0 = qb * 32;
            int tlo = 0, thi = 8; if (q0 - 128 < 0) tlo = (128 - q0) / 32; if (q0 + 128 + 31 >= L) thi = (L - 1 - (q0 - 128)) / 32;
            const int tq = q0 + qi;
            att_task<0>(wl, lane, qkv + (size_t)b * L * QKVW, TA + hq * 320, AQ + hq * 64, AK + (hq >> 2) * 64, AV + (hq >> 2) * 64, q0 - 128, 32, 1, tlo, thi, tq, 0, 0, 0,
                        sink[hq] * LOG2E, 1.0f, oabc + (size_t)(b * L + tq) * OW + hq * 64, nullptr);
        } else if (task < NT_A + NT_B) {
            const int j = task - NT_A, h = j & 3, sbi = (j >> 2) & 255, bg = j >> 10, g = bg % 3, b = bg / 3;
            const int dsh = 2 * g, d = 1 << dsh, nsb = 256 >> dsh, r = sbi / nsb, sb = sbi % nsb, q0 = sb * 32, Ls = L >> dsh;
            int tlo = 0, thi = 4; if (q0 - 64 < 0) tlo = (64 - q0) / 32; if (q0 + 64 + 31 >= Ls) thi = (Ls - 1 - (q0 - 64)) / 32;
            const int tq = (q0 + qi) * d + r, qc = BQ0 + 768 * g + h * 64;
            att_task<1>(wl, lane, qkv + (size_t)b * L * QKVW, TB + (g * 4 + h) * 192, qc, qc + 256, qc + 512, (q0 - 64) * d + r, 32 * d, d, tlo, thi, tq, 0, 0, 0,
                        MINIT, 0.0f, og + ((size_t)(b * L + tq) * 3 + g) * 256 + h * 64, lse + ((size_t)(b * L + tq) * 3 + g) * 4 + h);
        } else {
            const int j = task - NT_A - NT_B, h = j & 7, cbi = (j >> 3) & 255, b = j >> 11, ip = cbi >> 2, cb = cbi & 3;
            const int gi = 2 * ip + (qi >> 4), gc = 16 * cb + (qi & 15), tq = gi * 64 + gc;
            int cbs = 16 * cb - 8; cbs = cbs < 0 ? 0 : (cbs > 32 ? 32 : cbs);
            int rlo = 2 * ip - 4; rlo = rlo < 0 ? 0 : (rlo > 120 ? 120 : rlo);
            int rhi = 2 * ip + 1 - 4; rhi = rhi < 0 ? 0 : (rhi > 120 ? 120 : rhi); rhi += 7;
            att_task<2>(wl, lane, qkv + (size_t)b * L * QKVW, TC + h * 1024, CQ + h * 64, CK + h * 64, CV + h * 64, cbs, 64, 1, rlo, rhi, tq, gi, gc, cbs,
                        MINIT, 0.0f, oabc + (size_t)(b * L + tq) * OW + 768 + h * 64, nullptr);
        }
    }
}

#define DUP_KIND 6
constexpr int NSTEPS = 1 + DEPTH * 16;
__global__ void __launch_bounds__(NTHREADS, 2) mk_fwd(Args args) {
    extern __shared__ __attribute__((aligned(16))) unsigned char lds[];
    Frame F;
    F.lds = (LAS unsigned char*)lds; F.tid = threadIdx.x; F.lane = F.tid & 63; F.wave = __builtin_amdgcn_readfirstlane(F.tid >> 6);
    F.G = gridDim.x; { const int bx = blockIdx.x; F.vcu = (F.G % 8 == 0) ? (bx % 8) * (F.G / 8) + bx / 8 : bx; }
    F.in = args.in; F.h = args.out; F.ws = args.ws; F.probe = args.probe;
    volatile LAS unsigned* MISC = (volatile LAS unsigned*)(F.lds + MISC_OFF);
    if (F.tid < 32) MISC[F.tid] = 0u;
    __syncthreads();
    const int lo = args.s_lo, hi = args.s_hi;
    XcdBarrier bar; bar.bar = (unsigned*)(F.ws + WS_CTL) + CW_BAR; bar.x = 0; bar.st = nullptr;
    if (hi - lo > 1) bar = xcd_barrier_post((unsigned*)(F.ws + WS_CTL) + CW_BAR, MISC + 8);
#define RUN(s) (lo <= (s) && (s) < hi)
#define SEAM(s) do { if (RUN(s) && RUN((s) + 1)) xcd_barrier(bar); } while (0)
    if (RUN(0)) { ph_prologue(F); ph_tables(F); ph_ln0(F); }
    SEAM(0);
    for (int l = 0; l < DEPTH; ++l) {
        const int sb = 1 + l * 16;
        for (int c = 0; c < NCHUNK; ++c) {
            const int s = sb + c * 6;
            if (RUN(s)) ph_p1(F, l, c);
            SEAM(s);
            if (RUN(s + 1)) ph_att(F, l);
            SEAM(s + 1);
            if (RUN(s + 2)) ph_cmb(F);
            SEAM(s + 2);
            if (RUN(s + 3)) ph_p3(F, l);
            SEAM(s + 3);
            if (RUN(s + 4)) ph_p4(F, l, c);
            SEAM(s + 4);
            if (RUN(s + 5)) ph_ln1(F, l, c);
            SEAM(s + 5);
        }
        if (RUN(sb + 12)) ph_dsp(F, l);
        SEAM(sb + 12);
        if (RUN(sb + 13)) ph_p7(F, l);
        SEAM(sb + 13);
        if (RUN(sb + 14)) ph_p8(F, l);
        SEAM(sb + 14);
        if (RUN(sb + 15)) ph_ln2(F, l);
        SEAM(sb + 15);
    }
#undef RUN
#undef SEAM
}

#ifndef FAST_MASK
#define FAST_MASK 0x7FF
#endif
#ifndef ONE_LAUNCH
#define ONE_LAUNCH 0
#endif
extern "C" void kernel_launch(void* const* d_in, const int* in_sizes, int n_in, void* d_out, int out_size, void* d_ws, size_t ws_size, hipStream_t stream) {
    static int grid = 0;
    if (grid == 0) {
        if (n_in != 23 || out_size != T * D || ws_size < WS_END) { fprintf(stderr, "kernel_launch: unexpected shapes (n_in %d out %d ws %zu)\n", n_in, out_size, ws_size); grid = -1; return; }
        int dev = 0, cus = 0, per_cu = 0;
        if (hipGetDevice(&dev) != hipSuccess || hipDeviceGetAttribute(&cus, hipDeviceAttributeMultiprocessorCount, dev) != hipSuccess) { grid = -1; return; }
        if (hipFuncSetAttribute((const void*)mk_fwd, hipFuncAttributeMaxDynamicSharedMemorySize, LDS_BYTES) != hipSuccess) { fprintf(stderr, "kernel_launch: hipFuncSetAttribute failed\n"); grid = -1; return; }
        if (hipOccupancyMaxActiveBlocksPerMultiprocessor(&per_cu, (const void*)mk_fwd, NTHREADS, LDS_BYTES) != hipSuccess || per_cu < 1) fprintf(stderr, "kernel_launch: occupancy query reports %d\n", per_cu);
        (void)hipGetLastError();
        grid = cus;
    }
    if (grid < 0) return;
    const float* x = (const float*)d_in[0]; const float* ln0_g = (const float*)d_in[1]; const float* ln0_b = (const float*)d_in[2]; const float* rel_bias = (const float*)d_in[3];
    const float* w_in = (const float*)d_in[4]; const float* b_gate = (const float*)d_in[5]; const float* sink_a = (const float*)d_in[6]; const float* rpb_c = (const float*)d_in[7];
    const float* w_br_a = (const float*)d_in[8]; const float* w_br_b = (const float*)d_in[9]; const float* w_br_c = (const float*)d_in[10]; const float* w_out = (const float*)d_in[11];
    const float* ln1_g = (const float*)d_in[12]; const float* ln1_b = (const float*)d_in[13]; const float* w_rg = (const float*)d_in[14]; const float* b_rg = (const float*)d_in[15];
    const float* w_re = (const float*)d_in[16]; const float* b_re = (const float*)d_in[17]; const float* w_eg = (const float*)d_in[18]; const float* w_eu = (const float*)d_in[19];
    const float* w_ed = (const float*)d_in[20]; const float* ln2_g = (const float*)d_in[21]; const float* ln2_b = (const float*)d_in[22];
    unsigned char* ws = (unsigned char*)d_ws; float* h = (float*)d_out;
    bf16* hb = (bf16*)(ws + WS_HB); bf16* qkv = (bf16*)(ws + WS_QKV); bf16* gates = (bf16*)(ws + WS_GATES); bf16* oabc = (bf16*)(ws + WS_OABC); bf16* og = (bf16*)(ws + WS_OG);
    float* lse = (float*)(ws + WS_LSE); Rec* rec = (Rec*)(ws + WS_REC); int* rowtok = (int*)(ws + WS_ROWTOK); float* rowgate = (float*)(ws + WS_ROWGATE);
    bf16* merged = (bf16*)(ws + WS_MERGED); bf16* hid = (bf16*)(ws + WS_HID); bf16* yb = (bf16*)(ws + WS_YB); int* cnt = (int*)(ws + WS_CTL) + CW_CNT;
    (void)hipMemsetAsync(ws + WS_CTL, 0, CTL_ZERO_BYTES, stream);
    Args a{};
    for (int i = 0; i < 23; ++i) a.in[i] = (const float*)d_in[i];
    a.out = h; a.ws = ws;
    if (ONE_LAUNCH) { a.s_lo = 0; a.s_hi = NSTEPS; hipLaunchKernelGGL(mk_fwd, dim3(grid), dim3(NTHREADS), LDS_BYTES, stream, a); return; }
    const int G = 2048;
    const bool fastp1 = (FAST_MASK >> 1) & 1;
    for (int s = 0; s < NSTEPS; ++s) {
        int kind, l = 0, c = 0;
        if (s == 0) kind = 0; else { const int r = (s - 1) % 16; l = (s - 1) / 16; if (r < 12) { c = r / 6; kind = 1 + r % 6; } else kind = 7 + (r - 12); }
        if ((FAST_MASK >> kind) & 1) { a.s_lo = s; a.s_hi = s + 1;
#ifdef DUP_KIND
            if (kind == DUP_KIND && (kind == 5 || kind == 6 || kind == 10)) { a.probe = 1; hipLaunchKernelGGL(mk_fwd, dim3(grid), dim3(NTHREADS), LDS_BYTES, stream, a); a.probe = 0; }
#endif
            hipLaunchKernelGGL(mk_fwd, dim3(grid), dim3(NTHREADS), LDS_BYTES, stream, a);
#ifdef DUP_KIND
            if (kind == DUP_KIND && !(kind == 5 || kind == 6 || kind == 10)) { hipLaunchKernelGGL(mk_fwd, dim3(grid), dim3(NTHREADS), LDS_BYTES, stream, a); }
#endif
            continue; }
        const size_t r0 = (size_t)c * CH;
        switch (kind) {
        case 0: k_ln<<<G, 256, 0, stream>>>(0, x, h, hb, nullptr, ln0_g, ln0_b, 0, T); break;
        case 1: k_p1<<<G, 256, 0, stream>>>(hb + r0 * D, w_in + (size_t)l * D * NCOL, b_gate + (size_t)l * GATEW, qkv, gates); break;
        case 2: k_attn_naive<<<(28 * CH + 255) / 256, 256, 0, stream>>>(qkv, oabc, og, lse, rel_bias, sink_a + l * 8, rpb_c + (size_t)l * 8 * 15 * 31, fastp1 ? LN2 : 0.125f); break;
        case 3: k_combine<<<(CH * 32 + 255) / 256, 256, 0, stream>>>(og, lse, oabc); break;
        case 4: k_p3<<<G, 256, 0, stream>>>(oabc, gates, w_br_a + (size_t)l * 512 * D, w_br_b + (size_t)l * 256 * D, w_br_c + (size_t)l * 512 * D, merged); break;
        case 5: k_p4<<<G, 256, 0, stream>>>(merged, w_out + (size_t)l * D * D, h + r0 * D); break;
        case 6: k_ln<<<G, 256, 0, stream>>>(1, nullptr, h, hb, nullptr, ln1_g + l * D, ln1_b + l * D, (int)r0, CH);
                if (c == NCHUNK - 1) k_router<<<G, 256, 0, stream>>>(h, w_rg + (size_t)l * D * 4, b_rg + l * 4, w_re + (size_t)l * 4 * D * 8, b_re + l * 32, cnt + l * (32 * CSTR), rec);
                break;
        case 7: (void)hipMemsetAsync(rowtok, 0xFF, (size_t)PROWS * 4, stream); k_dispatch<<<256, 256, 0, stream>>>(cnt + l * (32 * CSTR), rec, rowtok, rowgate); break;
        case 8: k_p7<<<G, 256, 0, stream>>>(hb, cnt + l * (32 * CSTR), rowtok, w_eg + (size_t)l * NE * D * DE, w_eu + (size_t)l * NE * D * DE, hid); break;
        case 9: k_p8<<<G, 256, 0, stream>>>(hid, cnt + l * (32 * CSTR), rowtok, rowgate, w_ed + (size_t)l * NE * DE * D, yb); break;
        case 10: k_ln<<<G, 256, 0, stream>>>(2, nullptr, h, (l == DEPTH - 1) ? nullptr : hb, yb, ln2_g + l * D, ln2_b + l * D, 0, T); break;
        }
    }
}
```

```cpp
#include <hip/hip_runtime.h>
#include <cstdio>
#include <cstdint>
#include <cmath>

typedef unsigned short bf16;
typedef short bf16x8 __attribute__((ext_vector_type(8)));
typedef float f32x16 __attribute__((ext_vector_type(16)));
typedef float f32x4 __attribute__((ext_vector_type(4)));

constexpr int D = 1024, L = 8192, NBATCH = 8, T = NBATCH * L, DEPTH = 2;
constexpr int NCOL = 7680, QKVW = 4608, GATEW = 3072;
constexpr int CH = 32768, NCHUNK = T / CH;
constexpr int OW = 1280;
constexpr int NE = 32, DE = 512;
constexpr int MAXRT = T * 2 / 256 + NE, PROWS = MAXRT * 256;
constexpr float LN_EPS = 1e-5f;
constexpr float ALPHA = 1.41421356237309515f;
constexpr int AQ = 0, AK = 512, AV = 640, BQ0 = 768, CQ = 3072, CK = 3584, CV = 4096;

constexpr size_t MiB = 1u << 20;
constexpr size_t WS_CTL = 0;
constexpr size_t WS_WIN = 1 * MiB, WS_WBRA = 31 * MiB, WS_WBRB = 33 * MiB, WS_WBRC = 34 * MiB, WS_WOUT = 36 * MiB, WS_WGU = 40 * MiB, WS_WD = 168 * MiB;
constexpr size_t WS_HB = 232 * MiB, WS_QKV = 360 * MiB, WS_GATES = 648 * MiB, WS_OABC = 840 * MiB, WS_OG = 920 * MiB, WS_LSE = 968 * MiB,
                 WS_REC = 970 * MiB, WS_ROWTOK = 972 * MiB, WS_ROWGATE = 973 * MiB, WS_TABA = 974 * MiB, WS_TABB = WS_TABA + 16384, WS_TABC = WS_TABA + 32768, WS_END = 975 * MiB;
constexpr size_t WS_MERGED = WS_QKV, WS_HID = WS_QKV, WS_YB = WS_QKV + 136 * MiB;
constexpr int CSTR = 32;

__device__ __constant__ signed char BUCK_A[257] = {12,11,11,11,11,11,11,11,11,11,11,11,11,11,11,11,11,11,11,11,11,11,11,11,11,11,11,11,11,11,11,11,11,11,11,11,11,11,11,11,11,11,11,11,11,11,11,11,11,11,11,11,11,11,11,11,11,11,11,11,11,11,11,11,11,10,10,10,10,10,10,10,10,10,10,10,10,10,10,10,10,10,10,10,10,10,10,10,10,10,10,10,10,10,10,10,10,9,9,9,9,9,9,9,9,9,9,9,9,9,9,9,9,8,8,8,8,8,8,8,8,7,6,5,4,3,2,1,0,17,18,19,20,21,22,23,24,24,24,24,24,24,24,24,25,25,25,25,25,25,25,25,25,25,25,25,25,25,25,25,26,26,26,26,26,26,26,26,26,26,26,26,26,26,26,26,26,26,26,26,26,26,26,26,26,26,26,26,26,26,26,26,27,27,27,27,27,27,27,27,27,27,27,27,27,27,27,27,27,27,27,27,27,27,27,27,27,27,27,27,27,27,27,27,27,27,27,27,27,27,27,27,27,27,27,27,27,27,27,27,27,27,27,27,27,27,27,27,27,27,27,27,27,27,27,27,28};
__device__ __constant__ signed char BUCK_B[3][129] = {
 {11,10,10,10,10,10,10,10,10,10,10,10,10,10,10,10,10,10,10,10,10,10,10,10,10,10,10,10,10,10,10,10,10,9,9,9,9,9,9,9,9,9,9,9,9,9,9,9,9,8,8,8,8,8,8,8,8,7,6,5,4,3,2,1,0,17,18,19,20,21,22,23,24,24,24,24,24,24,24,24,25,25,25,25,25,25,25,25,25,25,25,25,25,25,25,25,26,26,26,26,26,26,26,26,26,26,26,26,26,26,26,26,26,26,26,26,26,26,26,26,26,26,26,26,26,26,26,26,27},
 {13,12,12,12,12,12,12,12,12,12,12,12,12,12,12,12,12,12,12,12,12,12,12,12,12,12,12,12,12,12,12,12,12,11,11,11,11,11,11,11,11,11,11,11,11,11,11,11,11,10,10,10,10,10,10,10,10,9,9,9,9,8,8,4,0,20,24,24,25,25,25,25,26,26,26,26,26,26,26,26,27,27,27,27,27,27,27,27,27,27,27,27,27,27,27,27,28,28,28,28,28,28,28,28,28,28,28,28,28,28,28,28,28,28,28,28,28,28,28,28,28,28,28,28,28,28,28,28,29},
 {15,14,14,14,14,14,14,14,14,14,14,14,14,14,14,14,14,14,14,14,14,14,14,14,14,14,14,14,14,14,14,14,14,13,13,13,13,13,13,13,13,13,13,13,13,13,13,13,13,12,12,12,12,12,12,12,12,11,11,11,11,10,10,9,0,25,26,26,27,27,27,27,28,28,28,28,28,28,28,28,29,29,29,29,29,29,29,29,29,29,29,29,29,29,29,29,30,30,30,30,30,30,30,30,30,30,30,30,30,30,30,30,30,30,30,30,30,30,30,30,30,30,30,30,30,30,30,30,31}};

__device__ __forceinline__ float bf2f(bf16 b) { return __uint_as_float(((unsigned)b) << 16); }
__device__ __forceinline__ bf16 f2bf(float f) { unsigned u = __float_as_uint(f); u += 0x7fffu + ((u >> 16) & 1u); return (bf16)(u >> 16); }
__device__ __forceinline__ float wave_sum(float v) {
#pragma unroll
    for (int o = 1; o < 64; o <<= 1) v += __shfl_xor(v, o);
    return v;
}

__global__ __launch_bounds__(256) void k_ln(int mode, const float* src, float* h, bf16* hb, const bf16* yb, const float* g, const float* bta, int row0, int nrows) {
    const int lane = threadIdx.x & 63, wv = blockIdx.x * 4 + (threadIdx.x >> 6), nw = gridDim.x * 4;
    for (int rr = wv; rr < nrows; rr += nw) {
        const size_t row = (size_t)row0 + rr;
        f32x4 v[4];
#pragma unroll
        for (int j = 0; j < 4; ++j) {
            const int c = lane * 4 + 256 * j;
            v[j] = *(const f32x4*)((mode == 0 ? src : h) + row * D + c);
            if (mode == 2) {
                const uint2 a = *(const uint2*)(yb + (row * 2) * D + c), b = *(const uint2*)(yb + (row * 2 + 1) * D + c);
                v[j].x = ALPHA * v[j].x + bf2f((bf16)(a.x & 0xffff)) + bf2f((bf16)(b.x & 0xffff));
                v[j].y = ALPHA * v[j].y + bf2f((bf16)(a.x >> 16)) + bf2f((bf16)(b.x >> 16));
                v[j].z = ALPHA * v[j].z + bf2f((bf16)(a.y & 0xffff)) + bf2f((bf16)(b.y & 0xffff));
                v[j].w = ALPHA * v[j].w + bf2f((bf16)(a.y >> 16)) + bf2f((bf16)(b.y >> 16));
            }
        }
        float s = 0.f;
#pragma unroll
        for (int j = 0; j < 4; ++j) s += (v[j].x + v[j].y) + (v[j].z + v[j].w);
        const float mean = wave_sum(s) * (1.f / D);
        float q = 0.f;
#pragma unroll
        for (int j = 0; j < 4; ++j) { v[j] = v[j] - mean; q += (v[j].x * v[j].x + v[j].y * v[j].y) + (v[j].z * v[j].z + v[j].w * v[j].w); }
        const float rstd = 1.0f / sqrtf(wave_sum(q) * (1.f / D) + LN_EPS);
#pragma unroll
        for (int j = 0; j < 4; ++j) {
            const int c = lane * 4 + 256 * j;
            const f32x4 gg = *(const f32x4*)(g + c), bb = *(const f32x4*)(bta + c);
            const f32x4 o = v[j] * rstd * gg + bb;
            *(f32x4*)(h + row * D + c) = o;
            if (hb) { uint2 w; w.x = (unsigned)f2bf(o.x) | ((unsigned)f2bf(o.y) << 16); w.y = (unsigned)f2bf(o.z) | ((unsigned)f2bf(o.w) << 16); *(uint2*)(hb + row * D + c) = w; }
        }
    }
}

__device__ __forceinline__ void wave_gemm32(const bf16* arow, const float* wcol, int ldw, int K, f32x16& acc) {
    for (int k0 = 0; k0 < K; k0 += 16) {
        const bf16x8 a = *(const bf16x8*)(arow + k0);
        bf16x8 b;
#pragma unroll
        for (int j = 0; j < 8; ++j) b[j] = (short)f2bf(wcol[(size_t)(k0 + j) * ldw]);
        acc = __builtin_amdgcn_mfma_f32_32x32x16_bf16(a, b, acc, 0, 0, 0);
    }
}
#define ACC_ROW(reg, h) (((reg) & 3) + 8 * ((reg) >> 2) + 4 * (h))

__global__ __launch_bounds__(256) void k_p1(const bf16* hbc, const float* w_in, const float* b_gate, bf16* qkv, bf16* gates) {
    const int lane = threadIdx.x & 63, r = lane & 31, hh = lane >> 5;
    const int wv = blockIdx.x * 4 + (threadIdx.x >> 6), nw = gridDim.x * 4;
    const int ntn = NCOL / 32, total = (CH / 32) * ntn;
    for (int tile = wv; tile < total; tile += nw) {
        const int tm = tile / ntn, tn = tile % ntn;
        f32x16 acc; for (int i = 0; i < 16; ++i) acc[i] = 0.f;
        wave_gemm32(hbc + (size_t)(tm * 32 + r) * D + 8 * hh, w_in + (size_t)(8 * hh) * NCOL + tn * 32 + r, NCOL, D, acc);
        const int col = tn * 32 + r;
#pragma unroll
        for (int i = 0; i < 16; ++i) {
            const int row = tm * 32 + ACC_ROW(i, hh);
            if (col < QKVW) qkv[(size_t)row * QKVW + col] = f2bf(acc[i]);
            else { const float z = acc[i] + b_gate[col - QKVW]; gates[(size_t)row * GATEW + (col - QKVW)] = f2bf(1.0f / (1.0f + __expf(-z))); }
        }
    }
}

__global__ __launch_bounds__(256) void k_attn_naive(const bf16* qkv, bf16* oabc, bf16* og, float* lse, const float* rel_bias, const float* sink_l, const float* rpb_l, float sc) {
    const long idx = (long)blockIdx.x * 256 + threadIdx.x;
    if (idx >= (long)28 * CH) return;
    const int ht = (int)(idx / CH), tl = (int)(idx % CH), b = tl / L, t = tl % L;
    const bf16* base = qkv + (size_t)(b * L) * QKVW;
    int qcol, kcol, vcol;
    if (ht < 8) { qcol = AQ + ht * 64; kcol = AK + (ht >> 2) * 64; vcol = AV + (ht >> 2) * 64; }
    else if (ht < 20) { const int g = (ht - 8) >> 2, h = (ht - 8) & 3; qcol = BQ0 + 768 * g + h * 64; kcol = qcol + 256; vcol = qcol + 512; }
    else { const int h = ht - 20; qcol = CQ + h * 64; kcol = CK + h * 64; vcol = CV + h * 64; }
    float q[64], o[64];
    {
        const uint4* qp = (const uint4*)(base + (size_t)t * QKVW + qcol);
#pragma unroll
        for (int c = 0; c < 8; ++c) { const uint4 u = qp[c]; const unsigned w[4] = {u.x, u.y, u.z, u.w};
#pragma unroll
            for (int i = 0; i < 4; ++i) { q[8 * c + 2 * i] = bf2f((bf16)(w[i] & 0xffff)); q[8 * c + 2 * i + 1] = bf2f((bf16)(w[i] >> 16)); } }
    }
#pragma unroll
    for (int i = 0; i < 64; ++i) o[i] = 0.f;
    float m = -1e30f, l = 0.f;
    if (ht < 8) { m = sink_l[ht]; l = 1.f; }
#define PROC_KEY(KT, BIAS) do { \
        const uint4* kp = (const uint4*)(base + (size_t)(KT) * QKVW + kcol); float s = 0.f; \
        _Pragma("unroll") for (int c = 0; c < 8; ++c) { const uint4 u = kp[c]; const unsigned w[4] = {u.x, u.y, u.z, u.w}; \
            _Pragma("unroll") for (int i = 0; i < 4; ++i) { s += q[8 * c + 2 * i] * bf2f((bf16)(w[i] & 0xffff)); s += q[8 * c + 2 * i + 1] * bf2f((bf16)(w[i] >> 16)); } } \
        s = s * sc + (BIAS); const float mn = fmaxf(m, s), corr = __expf(m - mn), p = __expf(s - mn); l = l * corr + p; m = mn; \
        const uint4* vp = (const uint4*)(base + (size_t)(KT) * QKVW + vcol); \
        _Pragma("unroll") for (int c = 0; c < 8; ++c) { const uint4 u = vp[c]; const unsigned w[4] = {u.x, u.y, u.z, u.w}; \
            _Pragma("unroll") for (int i = 0; i < 4; ++i) { o[8 * c + 2 * i] = o[8 * c + 2 * i] * corr + p * bf2f((bf16)(w[i] & 0xffff)); o[8 * c + 2 * i + 1] = o[8 * c + 2 * i + 1] * corr + p * bf2f((bf16)(w[i] >> 16)); } } \
    } while (0)
    if (ht < 8) {
        for (int rel = -128; rel <= 128; ++rel) { const int kt = t + rel; if (kt < 0 || kt >= L) continue;
            const float bias = rel_bias[BUCK_A[rel + 128] * 20 + ht]; PROC_KEY(kt, bias); }
    } else if (ht < 20) {
        const int g = (ht - 8) >> 2, h = (ht - 8) & 3, dil = (g == 0) ? 1 : (g == 1 ? 4 : 16);
        for (int off = -64; off <= 64; ++off) { const int kt = t + off * dil; if (kt < 0 || kt >= L) continue;
            const float bias = rel_bias[BUCK_B[g][off + 64] * 20 + 8 + 4 * g + h]; PROC_KEY(kt, bias); }
    } else {
        const int h = ht - 20, gi = t >> 6, gc = t & 63;
        int rs = gi - 4; rs = rs < 0 ? 0 : (rs > 120 ? 120 : rs);
        int cs = gc - 8; cs = cs < 0 ? 0 : (cs > 48 ? 48 : cs);
        for (int kr = rs; kr < rs + 8; ++kr)
            for (int kc = cs; kc < cs + 16; ++kc) { const float bias = rpb_l[(h * 15 + (kr - gi + 7)) * 31 + (kc - gc + 15)]; const int kt = kr * 64 + kc; PROC_KEY(kt, bias); }
    }
#undef PROC_KEY
    const float inv = 1.0f / l;
    bf16* dst;
    if (ht < 8) dst = oabc + (size_t)tl * OW + ht * 64;
    else if (ht < 20) { const int g = (ht - 8) >> 2, h = (ht - 8) & 3; dst = og + ((size_t)tl * 3 + g) * 256 + h * 64; lse[((size_t)tl * 3 + g) * 4 + h] = m + __logf(l); }
    else dst = oabc + (size_t)tl * OW + 768 + (ht - 20) * 64;
#pragma unroll
    for (int c = 0; c < 8; ++c) { uint4 u;
        u.x = (unsigned)f2bf(o[8 * c + 0] * inv) | ((unsigned)f2bf(o[8 * c + 1] * inv) << 16); u.y = (unsigned)f2bf(o[8 * c + 2] * inv) | ((unsigned)f2bf(o[8 * c + 3] * inv) << 16);
        u.z = (unsigned)f2bf(o[8 * c + 4] * inv) | ((unsigned)f2bf(o[8 * c + 5] * inv) << 16); u.w = (unsigned)f2bf(o[8 * c + 6] * inv) | ((unsigned)f2bf(o[8 * c + 7] * inv) << 16);
        ((uint4*)dst)[c] = u; }
}

__global__ __launch_bounds__(256) void k_combine(const bf16* og, const float* lse, bf16* oabc) {
    const long idx = (long)blockIdx.x * 256 + threadIdx.x;
    if (idx >= (long)CH * 32) return;
    const int tl = (int)(idx >> 5), hc = (int)(idx & 31), h = hc >> 3, c = hc & 7;
    const float l0 = lse[((size_t)tl * 3 + 0) * 4 + h], l1 = lse[((size_t)tl * 3 + 1) * 4 + h], l2 = lse[((size_t)tl * 3 + 2) * 4 + h];
    const float mx = fmaxf(l0, fmaxf(l1, l2)); float w0 = __expf(l0 - mx), w1 = __expf(l1 - mx), w2 = __expf(l2 - mx); const float inv = 1.0f / (w0 + w1 + w2); w0 *= inv; w1 *= inv; w2 *= inv;
    const uint4 a = *(const uint4*)(og + ((size_t)tl * 3 + 0) * 256 + h * 64 + c * 8), b = *(const uint4*)(og + ((size_t)tl * 3 + 1) * 256 + h * 64 + c * 8), d = *(const uint4*)(og + ((size_t)tl * 3 + 2) * 256 + h * 64 + c * 8);
    const unsigned aw[4] = {a.x, a.y, a.z, a.w}, bw[4] = {b.x, b.y, b.z, b.w}, dw[4] = {d.x, d.y, d.z, d.w}; unsigned ow[4];
#pragma unroll
    for (int i = 0; i < 4; ++i) {
        const float lo = w0 * bf2f((bf16)(aw[i] & 0xffff)) + w1 * bf2f((bf16)(bw[i] & 0xffff)) + w2 * bf2f((bf16)(dw[i] & 0xffff));
        const float hi = w0 * bf2f((bf16)(aw[i] >> 16)) + w1 * bf2f((bf16)(bw[i] >> 16)) + w2 * bf2f((bf16)(dw[i] >> 16));
        ow[i] = (unsigned)f2bf(lo) | ((unsigned)f2bf(hi) << 16);
    }
    *(uint4*)(oabc + (size_t)tl * OW + 512 + h * 64 + c * 8) = make_uint4(ow[0], ow[1], ow[2], ow[3]);
}

__global__ __launch_bounds__(256) void k_p3(const bf16* oabc, const bf16* gates, const float* wa, const float* wb, const float* wc, bf16* merged) {
    const int lane = threadIdx.x & 63, r = lane & 31, hh = lane >> 5;
    const int wv = blockIdx.x * 4 + (threadIdx.x >> 6), nw = gridDim.x * 4;
    const int ntn = D / 32, total = (CH / 32) * ntn;
    for (int tile = wv; tile < total; tile += nw) {
        const int tm = tile / ntn, tn = tile % ntn, col = tn * 32 + r;
        f32x16 mg; for (int i = 0; i < 16; ++i) mg[i] = 0.f;
#pragma unroll 1
        for (int br = 0; br < 3; ++br) {
            f32x16 acc; for (int i = 0; i < 16; ++i) acc[i] = 0.f;
            const int koff = br == 0 ? 0 : (br == 1 ? 512 : 768), K = br == 1 ? 256 : 512;
            const float* w = br == 0 ? wa : (br == 1 ? wb : wc);
            wave_gemm32(oabc + (size_t)(tm * 32 + r) * OW + koff + 8 * hh, w + (size_t)(8 * hh) * D + col, D, K, acc);
#pragma unroll
            for (int i = 0; i < 16; ++i) { const int row = tm * 32 + ACC_ROW(i, hh); mg[i] += bf2f(gates[(size_t)row * GATEW + br * 1024 + col]) * acc[i]; }
        }
#pragma unroll
        for (int i = 0; i < 16; ++i) { const int row = tm * 32 + ACC_ROW(i, hh); merged[(size_t)row * D + col] = f2bf(mg[i]); }
    }
}
__global__ __launch_bounds__(256) void k_p4(const bf16* merged, const float* wo, float* hchunk) {
    const int lane = threadIdx.x & 63, r = lane & 31, hh = lane >> 5;
    const int wv = blockIdx.x * 4 + (threadIdx.x >> 6), nw = gridDim.x * 4;
    const int ntn = D / 32, total = (CH / 32) * ntn;
    for (int tile = wv; tile < total; tile += nw) {
        const int tm = tile / ntn, tn = tile % ntn, col = tn * 32 + r;
        f32x16 acc; for (int i = 0; i < 16; ++i) acc[i] = 0.f;
        wave_gemm32(merged + (size_t)(tm * 32 + r) * D + 8 * hh, wo + (size_t)(8 * hh) * D + col, D, D, acc);
#pragma unroll
        for (int i = 0; i < 16; ++i) { const int row = tm * 32 + ACC_ROW(i, hh); float* p = hchunk + (size_t)row * D + col; *p = ALPHA * *p + acc[i]; }
    }
}

struct Rec { int e0, s0, e1, s1; float g0, g1; int pad0, pad1; };
__global__ __launch_bounds__(256) void k_router(const float* h, const float* w_rg, const float* b_rg, const float* w_re, const float* b_re, int* cnt, Rec* rec) {
    const int lane = threadIdx.x & 63, wv = blockIdx.x * 4 + (threadIdx.x >> 6), nw = gridDim.x * 4;
    for (int t = wv; t < T; t += nw) {
        float x[16];
#pragma unroll
        for (int j = 0; j < 4; ++j) { const f32x4 v = *(const f32x4*)(h + (size_t)t * D + lane * 4 + 256 * j); x[4 * j] = v.x; x[4 * j + 1] = v.y; x[4 * j + 2] = v.z; x[4 * j + 3] = v.w; }
        float gl[4] = {0.f, 0.f, 0.f, 0.f};
#pragma unroll
        for (int j = 0; j < 4; ++j)
#pragma unroll
            for (int i = 0; i < 4; ++i) { const f32x4 w = *(const f32x4*)(w_rg + (size_t)(lane * 4 + 256 * j + i) * 4); const float xv = x[4 * j + i]; gl[0] += xv * w.x; gl[1] += xv * w.y; gl[2] += xv * w.z; gl[3] += xv * w.w; }
#pragma unroll
        for (int g = 0; g < 4; ++g) gl[g] = wave_sum(gl[g]) + b_rg[g];
        int gi = 0; float gm = gl[0];
#pragma unroll
        for (int g = 1; g < 4; ++g) if (gl[g] > gm) { gm = gl[g]; gi = g; }
        float gs = 0.f;
#pragma unroll
        for (int g = 0; g < 4; ++g) gs += __expf(gl[g] - gm);
        const float gw = 1.0f / gs;
        float el[8];
#pragma unroll
        for (int e = 0; e < 8; ++e) el[e] = 0.f;
        const float* wre = w_re + (size_t)gi * D * 8;
#pragma unroll
        for (int j = 0; j < 4; ++j)
#pragma unroll
            for (int i = 0; i < 4; ++i) { const float* wp = wre + (size_t)(lane * 4 + 256 * j + i) * 8; const f32x4 w0 = *(const f32x4*)wp, w1 = *(const f32x4*)(wp + 4); const float xv = x[4 * j + i];
                el[0] += xv * w0.x; el[1] += xv * w0.y; el[2] += xv * w0.z; el[3] += xv * w0.w; el[4] += xv * w1.x; el[5] += xv * w1.y; el[6] += xv * w1.z; el[7] += xv * w1.w; }
#pragma unroll
        for (int e = 0; e < 8; ++e) el[e] = wave_sum(el[e]) + b_re[gi * 8 + e];
        int i0 = 0; float t0 = el[0];
#pragma unroll
        for (int e = 1; e < 8; ++e) if (el[e] > t0) { t0 = el[e]; i0 = e; }
        int i1 = -1; float t1 = -3.0e38f;
#pragma unroll
        for (int e = 0; e < 8; ++e) if (e != i0 && el[e] > t1) { t1 = el[e]; i1 = e; }
        const float ex = __expf(t1 - t0), p0 = 1.0f / (1.0f + ex), p1 = ex / (1.0f + ex);
        if (lane == 0) {
            Rec rc; rc.e0 = gi * 8 + i0; rc.e1 = gi * 8 + i1; rc.g0 = gw * p0; rc.g1 = gw * p1; rc.pad0 = 0; rc.pad1 = 0;
            rc.s0 = atomicAdd(cnt + rc.e0 * CSTR, 1); rc.s1 = atomicAdd(cnt + rc.e1 * CSTR, 1);
            rec[t] = rc;
        }
    }
}
__device__ __forceinline__ void pad_offsets(const int* cnt, int* po) { int acc = 0; for (int e = 0; e < NE; ++e) { po[e] = acc; acc += (cnt[e * CSTR] + 255) / 256 * 256; } po[NE] = acc; }
__global__ __launch_bounds__(256) void k_dispatch(const int* cnt, const Rec* rec, int* rowtok, float* rowgate) {
    __shared__ int po[NE + 1];
    if (threadIdx.x == 0) pad_offsets(cnt, po);
    __syncthreads();
    for (int t = blockIdx.x * 256 + threadIdx.x; t < T; t += gridDim.x * 256) {
        const Rec rc = rec[t];
        const int d0 = po[rc.e0] + rc.s0, d1 = po[rc.e1] + rc.s1;
        rowtok[d0] = 2 * t; rowgate[d0] = rc.g0; rowtok[d1] = 2 * t + 1; rowgate[d1] = rc.g1;
    }
}
__global__ __launch_bounds__(256) void k_p7(const bf16* hb, const int* cnt, const int* rowtok, const float* w_eg, const float* w_eu, bf16* hid) {
    __shared__ int po[NE + 1];
    if (threadIdx.x == 0) pad_offsets(cnt, po);
    __syncthreads();
    const int lane = threadIdx.x & 63, r = lane & 31, hh = lane >> 5;
    const int wv = blockIdx.x * 4 + (threadIdx.x >> 6), nw = gridDim.x * 4;
    const int ntn = DE / 32, total = (po[NE] / 32) * ntn;
    for (int tile = wv; tile < total; tile += nw) {
        const int tm = tile / ntn, tn = tile % ntn, col = tn * 32 + r, row0 = tm * 32;
        int e = 0; while (e < NE - 1 && po[e + 1] <= row0) ++e;
        int tok = rowtok[row0 + r]; tok = tok < 0 ? 0 : (tok >> 1);
        f32x16 ag, au; for (int i = 0; i < 16; ++i) { ag[i] = 0.f; au[i] = 0.f; }
        wave_gemm32(hb + (size_t)tok * D + 8 * hh, w_eg + (size_t)e * D * DE + (size_t)(8 * hh) * DE + col, DE, D, ag);
        wave_gemm32(hb + (size_t)tok * D + 8 * hh, w_eu + (size_t)e * D * DE + (size_t)(8 * hh) * DE + col, DE, D, au);
#pragma unroll
        for (int i = 0; i < 16; ++i) { const int row = row0 + ACC_ROW(i, hh); const float gsl = ag[i] / (1.0f + __expf(-ag[i])); hid[(size_t)row * DE + col] = f2bf(gsl * au[i]); }
    }
}
__global__ __launch_bounds__(256) void k_p8(const bf16* hid, const int* cnt, const int* rowtok, const float* rowgate, const float* w_ed, bf16* yb) {
    __shared__ int po[NE + 1];
    if (threadIdx.x == 0) pad_offsets(cnt, po);
    __syncthreads();
    const int lane = threadIdx.x & 63, r = lane & 31, hh = lane >> 5;
    const int wv = blockIdx.x * 4 + (threadIdx.x >> 6), nw = gridDim.x * 4;
    const int ntn = D / 32, total = (po[NE] / 32) * ntn;
    for (int tile = wv; tile < total; tile += nw) {
        const int tm = tile / ntn, tn = tile % ntn, col = tn * 32 + r, row0 = tm * 32;
        int e = 0; while (e < NE - 1 && po[e + 1] <= row0) ++e;
        f32x16 acc; for (int i = 0; i < 16; ++i) acc[i] = 0.f;
        wave_gemm32(hid + (size_t)(row0 + r) * DE + 8 * hh, w_ed + (size_t)e * DE * D + (size_t)(8 * hh) * D + col, D, DE, acc);
#pragma unroll
        for (int i = 0; i < 16; ++i) { const int row = row0 + ACC_ROW(i, hh); const int rt = rowtok[row]; if (rt >= 0) yb[(size_t)rt * D + col] = f2bf(acc[i] * rowgate[row]); }
    }
}


namespace pg8 {
#define PG8_LAS __attribute__((address_space(3)))
typedef unsigned short bf16_t;
typedef unsigned u32x4 __attribute__((ext_vector_type(4)));
constexpr int BM = 256, BK = 64, HALF = 128, HTB = HALF * BK * 2  , STAGE_BYTES = 8 * HTB, NXCD = 8, WGM = 8;

__host__ __device__ __forceinline__ int lds_byte(int r, int c) { const int st = (r >> 4) * 2 + (c >> 5), rr = r & 15, cc = c & 31, ob = rr * 64 + cc * 2; return st * 1024 + (ob ^ (((ob >> 9) & 1) << 5)); }
__host__ __device__ __forceinline__ void stage_rc(int b, int& R, int& C) { const int st = b / 1024, sb = b % 1024, swz = sb ^ (((sb >> 9) & 1) << 5); R = (st >> 1) * 16 + swz / 64; C = (st & 1) * 32 + (swz % 64) / 2; }
__host__ __device__ __forceinline__ int perm32(int rho) { const int n = rho >> 4, i = rho & 15; return 8 * (i >> 2) + 4 * n + (i & 3); }

struct Unit { int pm, pn, e, ui; };

struct DenseOrder {
    int nM, nN, nwg, G, c; const char* A; const char* B; size_t tstepA, tstepB;
    __device__ void init(const void* A_, int lda, const void* B_, int ldb, int M, int N, int G_, int c_) { nM = M / BM; nN = N / BM; nwg = nM * nN; G = G_; c = c_; A = (const char*)A_; B = (const char*)B_; tstepA = (size_t)BM * lda * 2; tstepB = (size_t)BM * ldb * 2; }
    __device__ bool next(int i, Unit& u) const {
        const long Lx = (long)i * G + c; if (Lx >= nwg) return false;
        int wgid = (int)Lx; { const int q = nwg / NXCD, r = nwg % NXCD, xcd = wgid % NXCD, off = wgid / NXCD; wgid = (xcd < r ? xcd * (q + 1) : r * (q + 1) + (xcd - r) * q) + off; }
        const int nig = WGM * nN, gid = wgid / nig, fm = gid * WGM, gsz = (nM - fm) < WGM ? (nM - fm) : WGM;
        u.pm = fm + ((wgid % nig) % gsz); u.pn = (wgid % nig) / gsz; u.e = 0; u.ui = i; return true;
    }
    __device__ __forceinline__ const char* a_base(const Unit& u) const { return A + (size_t)u.pm * tstepA; }
    __device__ __forceinline__ const char* b_base(const Unit& u) const { return B + (size_t)u.pn * tstepB; }
    __device__ __forceinline__ int a_row(const Unit&, int) const { return 0; }
};

__device__ __forceinline__ unsigned cvt_pk_bf16(float lo, float hi) { unsigned r; asm volatile("v_cvt_pk_bf16_f32 %0, %1, %2" : "=v"(r) : "v"(lo), "v"(hi)); return r; }

template <class Epi, class Sched, bool GATHER>
__device__ __forceinline__ void gemm_phase(PG8_LAS unsigned char* lds, const Sched& S, const Epi& E, const int K, const int lda, const int ldb) {
    int tid = threadIdx.x; asm volatile("" : "+v"(tid));
    const int wid = __builtin_amdgcn_readfirstlane(tid >> 6), lane = tid & 63, wr = wid >> 2, wc = wid & 3, fr = lane & 15, fq = lane >> 4;
    const int nt = K / BK;
    int RA[2], CA[2]; unsigned voffB[2];
#pragma unroll
    for (int i = 0; i < 2; ++i) { int R, C; stage_rc(tid * 16 + i * 8192, R, C); const int Rb = Epi::PERM ? ((R & ~31) + perm32(R & 31)) : R; RA[i] = R; CA[i] = C; voffB[i] = (unsigned)(Rb * ldb + C) * 2u; }
    const size_t kstep = (size_t)(BK * 2);
    const size_t hstepB = (size_t)HALF * ldb * 2;
    const unsigned ldsw = (unsigned)wid * 1024u;
    const int aoff = lds_byte(wr * 64 + fr, fq * 8), boff = lds_byte(wc * 32 + fr, fq * 8);
#define PG8_SA(b, h) (((b) * 2 + (h)) * HTB)
#define PG8_SB(b, h) ((4 + (b) * 2 + (h)) * HTB)
#define PG8_STAGE2(bufoff, gbase, v0, v1) do { \
        __builtin_amdgcn_global_load_lds((const unsigned*)((const char*)(gbase) + (v0)), (PG8_LAS unsigned*)(lds + (bufoff) + ldsw), 16, 0, 0); \
        __builtin_amdgcn_global_load_lds((const unsigned*)((const char*)(gbase) + (v1)), (PG8_LAS unsigned*)(lds + (bufoff) + ldsw + 8192), 16, 0, 0); } while (0)
#define PG8_STAGEB(bufoff, gbase) PG8_STAGE2(bufoff, gbase, voffB[0], voffB[1])
#define PG8_LDA(dst, b, h) do { _Pragma("unroll") for (int m = 0; m < 4; ++m) _Pragma("unroll") for (int k = 0; k < 2; ++k) dst[m][k] = *(const PG8_LAS bf16x8*)(lds + PG8_SA(b, h) + aoff + m * 2048 + k * 1024); } while (0)
#define PG8_LDB(dst, b, h) do { _Pragma("unroll") for (int n = 0; n < 2; ++n) _Pragma("unroll") for (int k = 0; k < 2; ++k) dst[n][k] = *(const PG8_LAS bf16x8*)(lds + PG8_SB(b, h) + boff + n * 2048 + k * 1024); } while (0)
#define PG8_MMA(ai, bj, At, Bt) do { __builtin_amdgcn_s_setprio(1); _Pragma("unroll") for (int m = 0; m < 4; ++m) _Pragma("unroll") for (int n = 0; n < 2; ++n) _Pragma("unroll") for (int k = 0; k < 2; ++k) \
        acc[ai][bj][m][n] = __builtin_amdgcn_mfma_f32_16x16x32_bf16(Bt[n][k], At[m][k], acc[ai][bj][m][n], 0, 0, 0); __builtin_amdgcn_s_setprio(0); } while (0)
#define PG8_WAIT_V(n) asm volatile("s_waitcnt vmcnt(" #n ")" ::: "memory")
#define PG8_WAIT_L(n) asm volatile("s_waitcnt lgkmcnt(" #n ")" ::: "memory")
#define PG8_BAR __builtin_amdgcn_s_barrier()
#define PG8_SCHED __builtin_amdgcn_sched_barrier(0)
#define PG8_VOFFA(dst, u) do { _Pragma("unroll") for (int h_ = 0; h_ < 2; ++h_) _Pragma("unroll") for (int i_ = 0; i_ < 2; ++i_) { \
        const int row_ = GATHER ? S.a_row(u, h_ * HALF + RA[i_]) : (h_ * HALF + RA[i_]); dst[h_][i_] = (unsigned)(row_ * lda + CA[i_]) * 2u; } } while (0)
    Unit cur, nxt;
    if (!S.next(0, cur)) return;
    f32x4 acc[2][2][4][2];
#pragma unroll
    for (int a = 0; a < 2; ++a)
#pragma unroll
        for (int b = 0; b < 2; ++b)
#pragma unroll
            for (int m = 0; m < 4; ++m)
#pragma unroll
                for (int n = 0; n < 2; ++n) acc[a][b][m][n] = (f32x4){0.f, 0.f, 0.f, 0.f};
    bf16x8 At[4][2], B0[2][2], B1[2][2];
    unsigned vc[2][2], vn[2][2];
    PG8_VOFFA(vc, cur);
    const char* cA = S.a_base(cur); const char* cB = S.b_base(cur);
    PG8_STAGEB(PG8_SB(0, 0), cB); PG8_STAGEB(PG8_SB(0, 1), cB + hstepB); PG8_STAGE2(PG8_SA(0, 0), cA, vc[0][0], vc[0][1]); PG8_STAGE2(PG8_SA(0, 1), cA, vc[1][0], vc[1][1]);
    if (wr == 1) PG8_BAR;
    PG8_WAIT_V(2); PG8_BAR;
    PG8_STAGEB(PG8_SB(1, 0), cB + kstep); PG8_STAGE2(PG8_SA(1, 0), cA + kstep, vc[0][0], vc[0][1]); PG8_STAGEB(PG8_SB(1, 1), cB + hstepB + kstep);
    PG8_WAIT_V(6); PG8_BAR;
    int ui = 0;
    for (;;) {
        const bool has_next = S.next(ui + 1, nxt);
        const char* nA = has_next ? S.a_base(nxt) : cA; const char* nB = has_next ? S.b_base(nxt) : cB;
        if (GATHER) { if (has_next) { PG8_VOFFA(vn, nxt); } else {
#pragma unroll
            for (int h_ = 0; h_ < 2; ++h_) { vn[h_][0] = vc[h_][0]; vn[h_][1] = vc[h_][1]; } } }
        for (int t = 0; t < nt; t += 2) {
            const bool last = (t == nt - 2);
            const char* a1 = cA + (size_t)(t + 1) * kstep;
            const char* a2 = last ? nA : cA + (size_t)(t + 2) * kstep; const char* b2 = last ? nB : cB + (size_t)(t + 2) * kstep;
            const char* a3 = a2 + kstep; const char* b3 = b2 + kstep;
            unsigned w00, w01, w10, w11;
            if (GATHER) { w00 = last ? vn[0][0] : vc[0][0]; w01 = last ? vn[0][1] : vc[0][1]; w10 = last ? vn[1][0] : vc[1][0]; w11 = last ? vn[1][1] : vc[1][1]; }
            else { w00 = vc[0][0]; w01 = vc[0][1]; w10 = vc[1][0]; w11 = vc[1][1]; }
            PG8_LDB(B0, 0, 0); PG8_LDB(B1, 0, 1); PG8_SCHED; PG8_LDA(At, 0, 0); PG8_STAGE2(PG8_SA(1, 1), a1, vc[1][0], vc[1][1]);
            PG8_WAIT_V(8); PG8_WAIT_L(0); PG8_BAR; PG8_MMA(0, 0, At, B0); PG8_MMA(0, 1, At, B1); PG8_BAR; PG8_SCHED;
            PG8_LDA(At, 0, 1); PG8_STAGEB(PG8_SB(0, 0), b2); PG8_STAGEB(PG8_SB(0, 1), b2 + hstepB); PG8_STAGE2(PG8_SA(0, 0), a2, w00, w01);
            PG8_WAIT_V(8); PG8_WAIT_L(0); PG8_BAR; PG8_MMA(1, 0, At, B0); PG8_MMA(1, 1, At, B1); PG8_BAR; PG8_SCHED;
            PG8_LDB(B0, 1, 0); PG8_LDB(B1, 1, 1); PG8_SCHED; PG8_LDA(At, 1, 0); PG8_STAGE2(PG8_SA(0, 1), a2, w10, w11);
            PG8_WAIT_V(8); PG8_WAIT_L(0); PG8_BAR; PG8_MMA(0, 0, At, B0); PG8_MMA(0, 1, At, B1); PG8_BAR; PG8_SCHED;
            PG8_LDA(At, 1, 1); PG8_STAGEB(PG8_SB(1, 0), b3); PG8_STAGEB(PG8_SB(1, 1), b3 + hstepB); PG8_STAGE2(PG8_SA(1, 0), a3, w00, w01);
            PG8_WAIT_V(8); PG8_WAIT_L(0); PG8_BAR; PG8_MMA(1, 0, At, B0); PG8_MMA(1, 1, At, B1); PG8_BAR; PG8_SCHED;
        }
        if (wr == 0) PG8_BAR;
        E(acc, cur, wr, wc, fr, fq);
        if (!has_next) break;
#pragma unroll
        for (int a = 0; a < 2; ++a)
#pragma unroll
            for (int b = 0; b < 2; ++b)
#pragma unroll
                for (int m = 0; m < 4; ++m)
#pragma unroll
                    for (int n = 0; n < 2; ++n) acc[a][b][m][n] = (f32x4){0.f, 0.f, 0.f, 0.f};
        cur = nxt; cA = nA; cB = nB; ++ui;
        if (GATHER) {
#pragma unroll
            for (int h_ = 0; h_ < 2; ++h_) { vc[h_][0] = vn[h_][0]; vc[h_][1] = vn[h_][1]; } }
        if (wr == 1) PG8_BAR;
    }
    PG8_WAIT_V(0);
    PG8_BAR;
#undef PG8_SA
#undef PG8_SB
#undef PG8_STAGE2
#undef PG8_STAGEB
#undef PG8_LDA
#undef PG8_LDB
#undef PG8_MMA
#undef PG8_WAIT_V
#undef PG8_WAIT_L
#undef PG8_BAR
#undef PG8_SCHED
#undef PG8_VOFFA
}
}

constexpr int NWAVES = 8, NTHREADS = 512;
constexpr int RING_OFF = 0, RING_BYTES = 131072, ROWS_OFF = 131072, ROWS_BYTES = 12288, ROUTER_BYTES = 147456  , MISC_OFF = ROUTER_BYTES, LDS_BYTES = 148480;
static_assert(MISC_OFF + 128 <= LDS_BYTES, "LDS map");
constexpr int CW_CNT = 0;
constexpr int CW_BAR = 4096;
constexpr size_t CTL_ZERO_BYTES = 64 * 1024;
constexpr float LOG2E = 1.4426950408889634f, LN2 = 0.6931471805599453f;
constexpr float QSCALE = 0.125f * LOG2E;

#define GAS __attribute__((address_space(1)))
#define LAS __attribute__((address_space(3)))
typedef unsigned v4u __attribute__((ext_vector_type(4)));
typedef unsigned v2u __attribute__((ext_vector_type(2)));
#define LDS_WAIT() asm volatile("s_waitcnt lgkmcnt(0)" ::: "memory")
__device__ __forceinline__ unsigned pk2(float lo, float hi) { return (unsigned)f2bf(lo) | ((unsigned)f2bf(hi) << 16); }

#define XB_TMO      128
#define XB_XCNT(j)  (256  + 64 * (j))
#define XB_XSUB(j)  (1280 + 64 * (j))
#define XB_XGEN(j)  (2304 + 64 * (j))
#define XB_TOP      3328
#define XB_TOPGEN   3392
#define XCD_BAR_WORDS 3456
#define XB_SPIN_CAP (1u << 18)

__device__ __forceinline__ unsigned xb_ld(unsigned* p)              { return __hip_atomic_load(p, __ATOMIC_RELAXED, __HIP_MEMORY_SCOPE_AGENT); }
__device__ __forceinline__ unsigned xb_add(unsigned* p, unsigned v) { return __hip_atomic_fetch_add(p, v, __ATOMIC_RELAXED, __HIP_MEMORY_SCOPE_AGENT); }
__device__ __forceinline__ unsigned xb_xcc_id() { return (unsigned)__builtin_amdgcn_s_getreg((3 << 11) | 20) & 0xFu; }
#define XB_SPIN(cond, bar) do { unsigned _sp = 0; while (cond) { __builtin_amdgcn_s_sleep(1); \
    if ((++_sp & 255u) == 0u) { if (xb_ld(&(bar)[XB_TMO])) break; if (_sp > XB_SPIN_CAP) { atomicAdd(&(bar)[XB_TMO], 1u); break; } } } } while (0)

struct XcdBarrier {
    unsigned* bar; unsigned x;
    volatile LAS unsigned* st;
};

__device__ __forceinline__ XcdBarrier xcd_barrier_post(unsigned* bar, volatile LAS unsigned* st) {
    XcdBarrier b; b.bar = bar; b.x = xb_xcc_id(); b.st = st;
    if (threadIdx.x == 0) (void)xb_add(&bar[XB_XCNT(b.x)], 1u);
    return b;
}
__device__ __forceinline__ void xcd_barrier_complete(unsigned* bar, unsigned x, unsigned& nloc, unsigned& nx) {
    const unsigned G = gridDim.x * gridDim.y * gridDim.z;
    unsigned sum, cnt, mine, sp = 0u;
    for (;;) {
        sum = 0u; cnt = 0u; mine = 0u;
#pragma unroll
        for (unsigned j = 0; j < 16; ++j) { const unsigned c = xb_ld(&bar[XB_XCNT(j)]); sum += c; cnt += (c > 0u) ? 1u : 0u; mine = (j == x) ? c : mine; }
        if (sum == G) break;
        __builtin_amdgcn_s_sleep(1);
        if ((++sp & 255u) == 0u) { if (xb_ld(&bar[XB_TMO])) break; if (sp > XB_SPIN_CAP) { atomicAdd(&bar[XB_TMO], 1u); break; } }
    }
    nloc = mine > 0u ? mine : 1u; nx = cnt > 0u ? cnt : 1u;
}

__device__ __forceinline__ void xcd_barrier(const XcdBarrier& b) {
    asm volatile("s_waitcnt vmcnt(0)" ::: "memory");
    __syncthreads();
    if (threadIdx.x == 0) {
        unsigned* bar = b.bar;
        __builtin_amdgcn_s_waitcnt(0);
        unsigned nloc = b.st[0], nx = b.st[1];
        if (nloc == 0u) { xcd_barrier_complete(bar, b.x, nloc, nx); b.st[0] = nloc; b.st[1] = nx; }
        const unsigned old = xb_add(&bar[XB_XSUB(b.x)], 1u);
        const unsigned gen = old / nloc;
        if (old + 1u == (gen + 1u) * nloc) {
            __builtin_amdgcn_fence(__ATOMIC_RELEASE, "agent");
            asm volatile("s_waitcnt vmcnt(0)" ::: "memory");
            const unsigned og = xb_add(&bar[XB_TOP], 1u);
            const unsigned tg = og / nx;
            if (og + 1u == (tg + 1u) * nx) xb_add(&bar[XB_TOPGEN], 1u);
            else XB_SPIN(xb_ld(&bar[XB_TOPGEN]) == tg, bar);
            __builtin_amdgcn_fence(__ATOMIC_ACQUIRE, "agent");
            xb_add(&bar[XB_XGEN(b.x)], 1u);
            asm volatile("s_waitcnt vmcnt(0)" ::: "memory");
        } else {
            XB_SPIN(xb_ld(&bar[XB_XGEN(b.x)]) == gen, bar);
            __builtin_amdgcn_fence(__ATOMIC_ACQUIRE, "agent");
            asm volatile("s_waitcnt vmcnt(0)" ::: "memory");
        }
    }
    __syncthreads();
}


struct Args { const float* in[23]; float* out; unsigned char* ws; int s_lo, s_hi, probe, pad; };

struct Frame {
    LAS unsigned char* lds; int tid, lane, wave, vcu, G;
    const float* const* in; float* h; unsigned char* ws; int probe;
};

#define LAUNDER(F) do { asm volatile("" : "+v"((F).tid)); (F).lane = (F).tid & 63; asm volatile("" : "+s"((F).G), "+s"((F).vcu)); } while (0)
__device__ __forceinline__ void p0_item(const float* W, int ldw, int k0, int n0, bf16* WT, int Kd, int drow0, float scale, LAS float* scr, int lane) {
#pragma unroll 8
    for (int i = 0; i < 32; ++i) { const int kk = 2 * i + (lane >> 5); scr[kk * 33 + (lane & 31)] = W[(size_t)(k0 + kk) * ldw + n0 + (lane & 31)] * scale; }
    LDS_WAIT(); asm volatile("" ::: "memory");
    const int c = lane & 7;
#pragma unroll
    for (int j = 0; j < 4; ++j) { const int n = (lane >> 3) + 8 * j; const LAS float* s = scr + (8 * c) * 33 + n;
        v4u o; o.x = pk2(s[0 * 33], s[1 * 33]); o.y = pk2(s[2 * 33], s[3 * 33]); o.z = pk2(s[4 * 33], s[5 * 33]); o.w = pk2(s[6 * 33], s[7 * 33]);
        *(v4u*)(WT + (size_t)(drow0 + n) * Kd + k0 + 8 * c) = o; }
    LDS_WAIT(); asm volatile("" ::: "memory");
}
__device__ __forceinline__ bool is_q_col(int n) { return n < 512 || (n >= 768 && n < 3072 && ((n - 768) % 768) < 256) || (n >= 3072 && n < 3584); }

__device__ __forceinline__ void ph_prologue(Frame& F) { LAUNDER(F);
    LAS float* scr = (LAS float*)(F.lds + RING_OFF + F.wave * 16384);
    const int gw = F.vcu * NWAVES + F.wave, NGW = F.G * NWAVES, lane = F.lane;
    const float* w_in = F.in[4]; const float* w_a = F.in[8]; const float* w_b = F.in[9]; const float* w_c = F.in[10]; const float* w_o = F.in[11];
    const float* w_eg = F.in[18]; const float* w_eu = F.in[19]; const float* w_ed = F.in[20];
    bf16* WIN = (bf16*)(F.ws + WS_WIN); bf16* WBRA = (bf16*)(F.ws + WS_WBRA); bf16* WBRB = (bf16*)(F.ws + WS_WBRB); bf16* WBRC = (bf16*)(F.ws + WS_WBRC); bf16* WOUT = (bf16*)(F.ws + WS_WOUT);
    bf16* WGU = (bf16*)(F.ws + WS_WGU); bf16* WD = (bf16*)(F.ws + WS_WD);
    constexpr int I_IN = 16 * (NCOL / 32), I_A = 8 * 32, I_B = 4 * 32, I_C = 8 * 32, I_O = 16 * 32, I_G = 16 * 16, I_D = 8 * 32;
    constexpr int I_LAYER = I_IN + I_A + I_B + I_C + I_O + NE * (2 * I_G + I_D);
    for (int it = gw; it < DEPTH * I_LAYER; it += NGW) {
        const int l = it / I_LAYER; int r = it % I_LAYER;
        if (r < I_IN) { const int nb = r % (NCOL / 32), kb = r / (NCOL / 32); p0_item(w_in + (size_t)l * D * NCOL, NCOL, 64 * kb, 32 * nb, WIN + (size_t)l * NCOL * D, D, 32 * nb, is_q_col(32 * nb) ? QSCALE : 1.0f, scr, lane); continue; } r -= I_IN;
        if (r < I_A) { const int nb = r % 32, kb = r / 32; p0_item(w_a + (size_t)l * 512 * D, D, 64 * kb, 32 * nb, WBRA + (size_t)l * D * 512, 512, 32 * nb, 1.0f, scr, lane); continue; } r -= I_A;
        if (r < I_B) { const int nb = r % 32, kb = r / 32; p0_item(w_b + (size_t)l * 256 * D, D, 64 * kb, 32 * nb, WBRB + (size_t)l * D * 256, 256, 32 * nb, 1.0f, scr, lane); continue; } r -= I_B;
        if (r < I_C) { const int nb = r % 32, kb = r / 32; p0_item(w_c + (size_t)l * 512 * D, D, 64 * kb, 32 * nb, WBRC + (size_t)l * D * 512, 512, 32 * nb, 1.0f, scr, lane); continue; } r -= I_C;
        if (r < I_O) { const int nb = r % 32, kb = r / 32; p0_item(w_o + (size_t)l * D * D, D, 64 * kb, 32 * nb, WOUT + (size_t)l * D * D, D, 32 * nb, 1.0f, scr, lane); continue; } r -= I_O;
        const int e = r / (2 * I_G + I_D); r %= (2 * I_G + I_D); const size_t le = (size_t)l * NE + e;
        if (r < 2 * I_G) { const int up = r / I_G; r %= I_G; const int nb = r % 16, kb = r / 16;
            p0_item((up ? w_eu : w_eg) + le * D * DE, DE, 64 * kb, 32 * nb, WGU + le * 1024 * 1024, D, (nb >> 2) * 256 + up * 128 + (nb & 3) * 32, 1.0f, scr, lane); continue; }
        r -= 2 * I_G; { const int nb = r % 32, kb = r / 32; p0_item(w_ed + le * DE * D, D, 64 * kb, 32 * nb, WD + le * D * DE, DE, 32 * nb, 1.0f, scr, lane); }
    }
}

template <int MODE> __device__ __forceinline__ void ln_row(const float* src, const float* h, float* hout, bf16* hb, const bf16* yb, const float* g, const float* bta, size_t row, int lane, f32x4 (&o)[4]) {
    f32x4 v[4];
#pragma unroll
    for (int j = 0; j < 4; ++j) {
        const int c = lane * 4 + 256 * j;
        v[j] = *(const f32x4*)((MODE == 0 ? src : h) + row * D + c);
        if (MODE == 2) {
            const uint2 a = *(const uint2*)(yb + (row * 2) * D + c), b = *(const uint2*)(yb + (row * 2 + 1) * D + c);
            v[j].x = ALPHA * v[j].x + bf2f((bf16)(a.x & 0xffff)) + bf2f((bf16)(b.x & 0xffff));
            v[j].y = ALPHA * v[j].y + bf2f((bf16)(a.x >> 16)) + bf2f((bf16)(b.x >> 16));
            v[j].z = ALPHA * v[j].z + bf2f((bf16)(a.y & 0xffff)) + bf2f((bf16)(b.y & 0xffff));
            v[j].w = ALPHA * v[j].w + bf2f((bf16)(a.y >> 16)) + bf2f((bf16)(b.y >> 16));
        }
    }
    float s = 0.f;
#pragma unroll
    for (int j = 0; j < 4; ++j) s += (v[j].x + v[j].y) + (v[j].z + v[j].w);
    const float mean = wave_sum(s) * (1.f / D);
    float q = 0.f;
#pragma unroll
    for (int j = 0; j < 4; ++j) { v[j] = v[j] - mean; q += (v[j].x * v[j].x + v[j].y * v[j].y) + (v[j].z * v[j].z + v[j].w * v[j].w); }
    const float rstd = 1.0f / sqrtf(wave_sum(q) * (1.f / D) + LN_EPS);
#pragma unroll
    for (int j = 0; j < 4; ++j) {
        const int c = lane * 4 + 256 * j;
        const f32x4 gg = *(const f32x4*)(g + c), bb = *(const f32x4*)(bta + c);
        o[j] = v[j] * rstd * gg + bb;
        *(f32x4*)(hout + row * D + c) = o[j];
        if (hb) { uint2 w; w.x = pk2(o[j].x, o[j].y); w.y = pk2(o[j].z, o[j].w); *(uint2*)(hb + row * D + c) = w; }
    }
}

struct EpiP1 {
    static constexpr bool PERM = true;
    bf16* qkv; bf16* gates; const float* b_gate;
    __device__ __forceinline__ void operator()(const f32x4 (&acc)[2][2][4][2], const pg8::Unit& u, int wr, int wc, int fr, int fq) const {
        const int row0 = u.pm * 256 + wr * 64 + fr; const bool isg = u.pn >= 18;
        bf16* base = isg ? gates : qkv; const int ldc = isg ? GATEW : QKVW; const int col0 = (isg ? (u.pn - 18) : u.pn) * 256 + wc * 32 + 8 * fq;
        f32x4 bv[2][2];
#pragma unroll
        for (int bj = 0; bj < 2; ++bj)
#pragma unroll
            for (int n = 0; n < 2; ++n) bv[bj][n] = isg ? *(const f32x4*)(b_gate + col0 + bj * 128 + 4 * n) : (f32x4){0.f, 0.f, 0.f, 0.f};
#pragma unroll
        for (int ai = 0; ai < 2; ++ai)
#pragma unroll
            for (int m = 0; m < 4; ++m) { bf16* rowp = base + (size_t)(row0 + ai * 128 + m * 16) * ldc + col0;
#pragma unroll
                for (int bj = 0; bj < 2; ++bj) { f32x4 v0 = acc[ai][bj][m][0] + bv[bj][0], v1 = acc[ai][bj][m][1] + bv[bj][1];
                    if (isg) {
#pragma unroll
                        for (int j = 0; j < 4; ++j) { v0[j] = __builtin_amdgcn_rcpf(1.0f + __builtin_amdgcn_exp2f(-LOG2E * v0[j])); v1[j] = __builtin_amdgcn_rcpf(1.0f + __builtin_amdgcn_exp2f(-LOG2E * v1[j])); } }
                    v4u w; w.x = pg8::cvt_pk_bf16(v0[0], v0[1]); w.y = pg8::cvt_pk_bf16(v0[2], v0[3]); w.z = pg8::cvt_pk_bf16(v1[0], v1[1]); w.w = pg8::cvt_pk_bf16(v1[2], v1[3]);
                    *(v4u*)(rowp + bj * 128) = w; } }
    }
};
template <bool FIRST> struct EpiP3 {
    static constexpr bool PERM = true;
    bf16* merged; const bf16* gates; int br;
    __device__ __forceinline__ void operator()(const f32x4 (&acc)[2][2][4][2], const pg8::Unit& u, int wr, int wc, int fr, int fq) const {
        const int row0 = u.pm * 256 + wr * 64 + fr, col0 = u.pn * 256 + wc * 32 + 8 * fq;
#pragma unroll
        for (int ai = 0; ai < 2; ++ai) {
            v4u gw[4][2], ow[4][2];
#pragma unroll
            for (int m = 0; m < 4; ++m)
#pragma unroll
                for (int bj = 0; bj < 2; ++bj) { const size_t row = (size_t)(row0 + ai * 128 + m * 16);
                    gw[m][bj] = *(const v4u*)(gates + row * GATEW + br * 1024 + col0 + bj * 128);
                    ow[m][bj] = FIRST ? (v4u){0u, 0u, 0u, 0u} : *(const v4u*)(merged + row * D + col0 + bj * 128); }
#pragma unroll
            for (int m = 0; m < 4; ++m)
#pragma unroll
                for (int bj = 0; bj < 2; ++bj) { const size_t row = (size_t)(row0 + ai * 128 + m * 16);
                    const f32x4 a0 = acc[ai][bj][m][0], a1 = acc[ai][bj][m][1];
                    float r[8];
#pragma unroll
                    for (int j = 0; j < 4; ++j) { const unsigned g2 = gw[m][bj][j], o2 = ow[m][bj][j]; const float av0 = j < 2 ? a0[2 * j] : a1[2 * j - 4], av1 = j < 2 ? a0[2 * j + 1] : a1[2 * j - 3];
                        r[2 * j] = __uint_as_float(g2 << 16) * av0 + (FIRST ? 0.f : __uint_as_float(o2 << 16)); r[2 * j + 1] = __uint_as_float(g2 & 0xffff0000u) * av1 + (FIRST ? 0.f : __uint_as_float(o2 & 0xffff0000u)); }
                    v4u w; w.x = pg8::cvt_pk_bf16(r[0], r[1]); w.y = pg8::cvt_pk_bf16(r[2], r[3]); w.z = pg8::cvt_pk_bf16(r[4], r[5]); w.w = pg8::cvt_pk_bf16(r[6], r[7]);
                    *(v4u*)(merged + row * D + col0 + bj * 128) = w; }
            asm volatile("" ::: "memory"); }
    }
};
struct EpiP4 {
    static constexpr bool PERM = false;
    const float* hc; float* ho;
    __device__ __forceinline__ void operator()(const f32x4 (&acc)[2][2][4][2], const pg8::Unit& u, int wr, int wc, int fr, int fq) const {
        const int row0 = u.pm * 256 + wr * 64 + fr, col0 = u.pn * 256 + wc * 32 + 4 * fq;
#pragma unroll
        for (int ai = 0; ai < 2; ++ai)
#pragma unroll
            for (int mp = 0; mp < 2; ++mp) { f32x4 hv[2][2][2];
#pragma unroll
                for (int mm = 0; mm < 2; ++mm)
#pragma unroll
                    for (int bj = 0; bj < 2; ++bj)
#pragma unroll
                        for (int n = 0; n < 2; ++n) hv[mm][bj][n] = *(const f32x4*)(hc + (size_t)(row0 + ai * 128 + (2 * mp + mm) * 16) * D + col0 + bj * 128 + n * 16);
#pragma unroll
                for (int mm = 0; mm < 2; ++mm)
#pragma unroll
                    for (int bj = 0; bj < 2; ++bj)
#pragma unroll
                        for (int n = 0; n < 2; ++n) *(f32x4*)(ho + (size_t)(row0 + ai * 128 + (2 * mp + mm) * 16) * D + col0 + bj * 128 + n * 16) = hv[mm][bj][n] * ALPHA + acc[ai][bj][2 * mp + mm][n];
                asm volatile("" ::: "memory"); }
    }
};
struct EpiP7 {
    static constexpr bool PERM = true;
    bf16* hid;
    __device__ __forceinline__ void operator()(const f32x4 (&acc)[2][2][4][2], const pg8::Unit& u, int wr, int wc, int fr, int fq) const {
        const int row0 = u.pm * 256 + wr * 64 + fr, col0 = u.pn * 128 + wc * 32 + 8 * fq;
#pragma unroll
        for (int ai = 0; ai < 2; ++ai)
#pragma unroll
            for (int m = 0; m < 4; ++m) { float r[8];
#pragma unroll
                for (int n = 0; n < 2; ++n)
#pragma unroll
                    for (int j = 0; j < 4; ++j) { const float gv = acc[ai][0][m][n][j], uv = acc[ai][1][m][n][j]; r[4 * n + j] = gv * __builtin_amdgcn_rcpf(1.0f + __builtin_amdgcn_exp2f(-LOG2E * gv)) * uv; }
                v4u w; w.x = pg8::cvt_pk_bf16(r[0], r[1]); w.y = pg8::cvt_pk_bf16(r[2], r[3]); w.z = pg8::cvt_pk_bf16(r[4], r[5]); w.w = pg8::cvt_pk_bf16(r[6], r[7]);
                *(v4u*)(hid + (size_t)(row0 + ai * 128 + m * 16) * DE + col0) = w; }
    }
};
struct EpiP8 {
    static constexpr bool PERM = true;
    bf16* yb; const int* rowtok; const float* rowgate;
    __device__ __forceinline__ void operator()(const f32x4 (&acc)[2][2][4][2], const pg8::Unit& u, int wr, int wc, int fr, int fq) const {
        const int row0 = u.pm * 256 + wr * 64 + fr, col0 = u.pn * 256 + wc * 32 + 8 * fq;
        int rt[2][4]; float gt[2][4];
#pragma unroll
        for (int ai = 0; ai < 2; ++ai)
#pragma unroll
            for (int m = 0; m < 4; ++m) { const int row = row0 + ai * 128 + m * 16; rt[ai][m] = rowtok[row]; gt[ai][m] = rowgate[row]; }
#pragma unroll
        for (int ai = 0; ai < 2; ++ai)
#pragma unroll
            for (int m = 0; m < 4; ++m) {
                if (rt[ai][m] >= 0) {
#pragma unroll
                    for (int bj = 0; bj < 2; ++bj) { const f32x4 v0 = acc[ai][bj][m][0] * gt[ai][m], v1 = acc[ai][bj][m][1] * gt[ai][m];
                        v4u w; w.x = pg8::cvt_pk_bf16(v0[0], v0[1]); w.y = pg8::cvt_pk_bf16(v0[2], v0[3]); w.z = pg8::cvt_pk_bf16(v1[0], v1[1]); w.w = pg8::cvt_pk_bf16(v1[2], v1[3]);
                        *(v4u*)(yb + (size_t)rt[ai][m] * D + col0 + bj * 128) = w; } } }
    }
};

__device__ __forceinline__ void router_row(const float (&x)[16], int t, int lane, const LAS float* w_rg, const float* b_rg, const LAS float* w_re, const float* b_re, int* cnt, Rec* rec) {
    float gl[4] = {0.f, 0.f, 0.f, 0.f};
#pragma unroll
    for (int j = 0; j < 4; ++j)
#pragma unroll
        for (int i = 0; i < 4; ++i) { const f32x4 w = *(const LAS f32x4*)(w_rg + ((j * 4 + i) * 64 + lane) * 4); const float xv = x[4 * j + i]; gl[0] += xv * w.x; gl[1] += xv * w.y; gl[2] += xv * w.z; gl[3] += xv * w.w; }
#pragma unroll
    for (int g = 0; g < 4; ++g) gl[g] = wave_sum(gl[g]) + b_rg[g];
    int gi = 0; float gm = gl[0];
#pragma unroll
    for (int g = 1; g < 4; ++g) if (gl[g] > gm) { gm = gl[g]; gi = g; }
    float gs = 0.f;
#pragma unroll
    for (int g = 0; g < 4; ++g) gs += __expf(gl[g] - gm);
    const float gw = 1.0f / gs;
    float el[8];
#pragma unroll
    for (int e = 0; e < 8; ++e) el[e] = 0.f;
    const LAS float* wre = w_re + gi * (D * 8);
#pragma unroll
    for (int j = 0; j < 4; ++j)
#pragma unroll
        for (int i = 0; i < 4; ++i) { const LAS float* wp = wre + ((j * 4 + i) * 128 + lane) * 4; const f32x4 w0 = *(const LAS f32x4*)wp, w1 = *(const LAS f32x4*)(wp + 256); const float xv = x[4 * j + i];
            el[0] += xv * w0.x; el[1] += xv * w0.y; el[2] += xv * w0.z; el[3] += xv * w0.w; el[4] += xv * w1.x; el[5] += xv * w1.y; el[6] += xv * w1.z; el[7] += xv * w1.w; }
#pragma unroll
    for (int e = 0; e < 8; ++e) el[e] = wave_sum(el[e]) + b_re[gi * 8 + e];
    int i0 = 0; float t0 = el[0];
#pragma unroll
    for (int e = 1; e < 8; ++e) if (el[e] > t0) { t0 = el[e]; i0 = e; }
    int i1 = -1; float t1 = -3.0e38f;
#pragma unroll
    for (int e = 0; e < 8; ++e) if (e != i0 && el[e] > t1) { t1 = el[e]; i1 = e; }
    const float ex = __expf(t1 - t0), p0 = 1.0f / (1.0f + ex), p1 = ex / (1.0f + ex);
    if (lane == 0) {
        Rec rc; rc.e0 = gi * 8 + i0; rc.e1 = gi * 8 + i1; rc.g0 = gw * p0; rc.g1 = gw * p1; rc.pad0 = 0; rc.pad1 = 0;
        rc.s0 = atomicAdd(cnt + rc.e0 * CSTR, 1); rc.s1 = atomicAdd(cnt + rc.e1 * CSTR, 1);
        rec[t] = rc;
    }
}

__device__ __forceinline__ void ph_ln0(Frame& F) { LAUNDER(F);
    const int gw = F.vcu * NWAVES + F.wave, NGW = F.G * NWAVES;
    bf16* hb = (bf16*)(F.ws + WS_HB);
    for (int m = gw; m < T; m += NGW) { f32x4 o[4]; ln_row<0>(F.in[0], F.h, F.h, hb, nullptr, F.in[1], F.in[2], (size_t)m, F.lane, o); }
}
__device__ __forceinline__ void ph_p1(Frame& F, int l, int c) { LAUNDER(F);
    pg8::DenseOrder S; S.init((const bf16*)(F.ws + WS_HB) + (size_t)c * CH * D, D, (const bf16*)(F.ws + WS_WIN) + (size_t)l * NCOL * D, D, CH, NCOL, F.G, (int)blockIdx.x);
    EpiP1 E{(bf16*)(F.ws + WS_QKV), (bf16*)(F.ws + WS_GATES), F.in[5] + (size_t)l * GATEW};
    pg8::gemm_phase<EpiP1, pg8::DenseOrder, false>(F.lds + RING_OFF, S, E, D, D, D);
}
__device__ __forceinline__ void ph_cmb(Frame& F) { LAUNDER(F);
    const bf16* og = (const bf16*)(F.ws + WS_OG); const float* lse = (const float*)(F.ws + WS_LSE); bf16* oabc = (bf16*)(F.ws + WS_OABC);
    for (int idx = F.vcu * NTHREADS + F.tid; idx < CH * 32; idx += F.G * NTHREADS) {
        const int tl = idx >> 5, hc = idx & 31, h = hc >> 3, c = hc & 7;
        const float l0 = lse[((size_t)tl * 3 + 0) * 4 + h], l1 = lse[((size_t)tl * 3 + 1) * 4 + h], l2 = lse[((size_t)tl * 3 + 2) * 4 + h];
        const float mx = fmaxf(l0, fmaxf(l1, l2)); float w0 = __expf(l0 - mx), w1 = __expf(l1 - mx), w2 = __expf(l2 - mx); const float inv = 1.0f / (w0 + w1 + w2); w0 *= inv; w1 *= inv; w2 *= inv;
        const v4u a = *(const v4u*)(og + ((size_t)tl * 3 + 0) * 256 + h * 64 + c * 8), b = *(const v4u*)(og + ((size_t)tl * 3 + 1) * 256 + h * 64 + c * 8), d = *(const v4u*)(og + ((size_t)tl * 3 + 2) * 256 + h * 64 + c * 8);
        v4u ow;
#pragma unroll
        for (int i = 0; i < 4; ++i) {
            const float lo = w0 * __uint_as_float(a[i] << 16) + w1 * __uint_as_float(b[i] << 16) + w2 * __uint_as_float(d[i] << 16);
            const float hi = w0 * __uint_as_float(a[i] & 0xffff0000u) + w1 * __uint_as_float(b[i] & 0xffff0000u) + w2 * __uint_as_float(d[i] & 0xffff0000u);
            ow[i] = pk2(lo, hi);
        }
        *(v4u*)(oabc + (size_t)tl * OW + 512 + h * 64 + c * 8) = ow;
    }
}
__device__ __forceinline__ void ph_p3(Frame& F, int l) { LAUNDER(F);
    const bf16* oabc = (const bf16*)(F.ws + WS_OABC); bf16* merged = (bf16*)(F.ws + WS_MERGED); const bf16* gates = (const bf16*)(F.ws + WS_GATES);
    { pg8::DenseOrder S; S.init(oabc, OW, (const bf16*)(F.ws + WS_WBRA) + (size_t)l * D * 512, 512, CH, D, F.G, (int)blockIdx.x);
      EpiP3<true> E{merged, gates, 0}; pg8::gemm_phase<EpiP3<true>, pg8::DenseOrder, false>(F.lds + RING_OFF, S, E, 512, OW, 512); }
    { pg8::DenseOrder S; S.init(oabc + 512, OW, (const bf16*)(F.ws + WS_WBRB) + (size_t)l * D * 256, 256, CH, D, F.G, (int)blockIdx.x);
      EpiP3<false> E{merged, gates, 1}; pg8::gemm_phase<EpiP3<false>, pg8::DenseOrder, false>(F.lds + RING_OFF, S, E, 256, OW, 256); }
    { pg8::DenseOrder S; S.init(oabc + 768, OW, (const bf16*)(F.ws + WS_WBRC) + (size_t)l * D * 512, 512, CH, D, F.G, (int)blockIdx.x);
      EpiP3<false> E{merged, gates, 2}; pg8::gemm_phase<EpiP3<false>, pg8::DenseOrder, false>(F.lds + RING_OFF, S, E, 512, OW, 512); }
}
__device__ __forceinline__ void ph_p4(Frame& F, int l, int c) { LAUNDER(F);
    pg8::DenseOrder S; S.init((const bf16*)(F.ws + WS_MERGED), D, (const bf16*)(F.ws + WS_WOUT) + (size_t)l * D * D, D, CH, D, F.G, (int)blockIdx.x);
    EpiP4 E{F.h + (size_t)c * CH * D, F.probe ? (float*)(F.ws + WS_OABC) : F.h + (size_t)c * CH * D};
    pg8::gemm_phase<EpiP4, pg8::DenseOrder, false>(F.lds + RING_OFF, S, E, D, D, D);
}
__device__ __forceinline__ void ph_ln1(Frame& F, int l, int c) { LAUNDER(F);
    const int gw = F.vcu * NWAVES + F.wave, NGW = F.G * NWAVES;
    bf16* hb = (bf16*)(F.ws + WS_HB); int* cnt = (int*)(F.ws + WS_CTL) + CW_CNT + l * (32 * CSTR); Rec* rec = (Rec*)(F.ws + WS_REC);
    float* hout = F.h;
    if (F.probe) { hout = (float*)(F.ws + WS_OABC) - (size_t)c * CH * D; hb = (bf16*)(F.ws + WS_QKV) - (size_t)c * CH * D; cnt = (int*)(F.ws + WS_CTL) + 8192 + l * 1024; rec = (Rec*)(F.ws + WS_GATES); }
    LAS float* lrg = (LAS float*)(F.lds + RING_OFF); LAS float* lre = lrg + D * 4;
    { const float* w_rg = F.in[14] + (size_t)l * D * 4; const float* w_re = F.in[16] + (size_t)l * 4 * D * 8;
      for (int u = F.tid; u < D + 4 * D * 2; u += NTHREADS) {
          if (u < D) { const int e = u, ln = (e & 255) >> 2, i = e & 3, j = e >> 8; *(LAS f32x4*)(lrg + ((j * 4 + i) * 64 + ln) * 4) = *(const f32x4*)(w_rg + (size_t)e * 4); }
          else { const int v = u - D, half = v & 1, e = (v >> 1) & 1023, g = v >> 11, ln = (e & 255) >> 2, i = e & 3, j = e >> 8;
                 *(LAS f32x4*)(lre + g * (D * 8) + (((j * 4 + i) * 2 + half) * 64 + ln) * 4) = *(const f32x4*)(w_re + ((size_t)g * D + e) * 8 + half * 4); } }
      __syncthreads(); }
    for (int m = gw; m < CH; m += NGW) {
        const size_t row = (size_t)c * CH + m; f32x4 o[4];
        ln_row<1>(nullptr, F.h, hout, hb, nullptr, F.in[12] + l * D, F.in[13] + l * D, row, F.lane, o);
        float x[16];
#pragma unroll
        for (int j = 0; j < 4; ++j) { x[4 * j] = o[j].x; x[4 * j + 1] = o[j].y; x[4 * j + 2] = o[j].z; x[4 * j + 3] = o[j].w; }
        router_row(x, (int)row, F.lane, lrg, F.in[15] + l * 4, lre, F.in[17] + l * 32, cnt, rec);
    }
    __syncthreads();
}
__device__ __forceinline__ void ph_dsp(Frame& F, int l) { LAUNDER(F);
    LAS int* po = (LAS int*)(F.lds + ROWS_OFF);
    const int* cnt = (const int*)(F.ws + WS_CTL) + CW_CNT + l * (32 * CSTR); const Rec* rec = (const Rec*)(F.ws + WS_REC); int* rowtok = (int*)(F.ws + WS_ROWTOK); float* rowgate = (float*)(F.ws + WS_ROWGATE);
    if (F.tid == 0) { int acc = 0; for (int e = 0; e < NE; ++e) { po[e] = acc; acc += (cnt[e * CSTR] + 255) / 256 * 256; } po[NE] = acc; }
    __syncthreads();
    const int gt = F.vcu * NTHREADS + F.tid, GT = F.G * NTHREADS;
    for (int t = gt; t < T; t += GT) {
        const Rec rc = rec[t];
        const int d0 = po[rc.e0] + rc.s0, d1 = po[rc.e1] + rc.s1;
        rowtok[d0] = 2 * t; rowgate[d0] = rc.g0; rowtok[d1] = 2 * t + 1; rowgate[d1] = rc.g1;
    }
    for (int e = 0; e < NE; ++e) for (int r = po[e] + cnt[e * CSTR] + gt; r < po[e + 1]; r += GT) { rowtok[r] = -1; rowgate[r] = 0.f; }
    __syncthreads();
}
__device__ __forceinline__ int moe_setup(Frame& F, int l, bool gather) { LAUNDER(F);
    LAS int* rows = (LAS int*)(F.lds + ROWS_OFF); LAS int* ulist = rows + 11 * 256; LAS int* po = ulist + 16;
    const int* cnt = (const int*)(F.ws + WS_CTL) + CW_CNT + l * (32 * CSTR); const int* rowtok = (const int*)(F.ws + WS_ROWTOK);
    if (F.tid == 0) { int acc = 0; for (int e = 0; e < NE; ++e) { po[e] = acc; acc += (cnt[e * CSTR] + 255) / 256 * 256; } po[NE] = acc; }
    __syncthreads();
    const int nu_all = (po[NE] / 256) * 4; int nun = (nu_all - F.vcu + F.G - 1) / F.G; nun = nun < 0 ? 0 : (nun > 11 ? 11 : nun);
    if (F.tid < nun) { const int Lx = F.tid * F.G + F.vcu, rt = Lx >> 2, pn = Lx & 3; int e = 0; while (e < NE - 1 && po[e + 1] <= rt * 256) ++e; ulist[F.tid] = (rt << 8) | (e << 2) | pn; }
    if (gather) for (int idx = F.tid; idx < nun * 256; idx += NTHREADS) { const int i = idx >> 8, r = idx & 255, Lx = i * F.G + F.vcu; rows[idx] = rowtok[(Lx >> 2) * 256 + r]; }
    __syncthreads();
    return nun;
}
struct MoeOrder {
    int nun; const LAS int* ulist; const LAS int* rows; const char* A; const char* B; size_t tstepA, estepB, tstepB;
    __device__ __forceinline__ bool next(int i, pg8::Unit& u) const {
        if (i >= nun) return false;
        const int w = __builtin_amdgcn_readfirstlane(ulist[i]); u.pm = w >> 8; u.e = (w >> 2) & 63; u.pn = w & 3; u.ui = i; return true;
    }
    __device__ __forceinline__ const char* a_base(const pg8::Unit& u) const { return A + (size_t)u.pm * tstepA; }
    __device__ __forceinline__ const char* b_base(const pg8::Unit& u) const { return B + (size_t)u.e * estepB + (size_t)u.pn * tstepB; }
    __device__ __forceinline__ int a_row(const pg8::Unit& u, int r) const { const int t = rows[u.ui * 256 + r]; return t < 0 ? 0 : (t >> 1); }
};
__device__ __forceinline__ void ph_p7(Frame& F, int l) { LAUNDER(F);
    const int nun = moe_setup(F, l, true);
    LAS int* rows = (LAS int*)(F.lds + ROWS_OFF);
    MoeOrder S{nun, rows + 11 * 256, rows, (const char*)(F.ws + WS_HB), (const char*)(F.ws + WS_WGU) + (size_t)l * NE * 1024 * 1024 * 2, 0, (size_t)1024 * 1024 * 2, (size_t)256 * 1024 * 2};
    EpiP7 E{(bf16*)(F.ws + WS_HID)};
    pg8::gemm_phase<EpiP7, MoeOrder, true>(F.lds + RING_OFF, S, E, D, D, D);
}
__device__ __forceinline__ void ph_p8(Frame& F, int l) { LAUNDER(F);
    const int nun = moe_setup(F, l, false);
    LAS int* rows = (LAS int*)(F.lds + ROWS_OFF);
    MoeOrder S{nun, rows + 11 * 256, rows, (const char*)(F.ws + WS_HID), (const char*)(F.ws + WS_WD) + (size_t)l * NE * 1024 * 512 * 2, (size_t)256 * DE * 2, (size_t)1024 * 512 * 2, (size_t)256 * 512 * 2};
    EpiP8 E{(bf16*)(F.ws + WS_YB), (const int*)(F.ws + WS_ROWTOK), (const float*)(F.ws + WS_ROWGATE)};
    pg8::gemm_phase<EpiP8, MoeOrder, false>(F.lds + RING_OFF, S, E, DE, DE, DE);
}
__device__ __forceinline__ void ph_ln2(Frame& F, int l) { LAUNDER(F);
    const int gw = F.vcu * NWAVES + F.wave, NGW = F.G * NWAVES;
    bf16* hb = (l == DEPTH - 1) ? nullptr : (bf16*)(F.ws + WS_HB);
    if (F.probe) { for (int m = gw; m < T; m += NGW) { f32x4 o[4]; ln_row<2>(nullptr, F.h, (float*)(F.ws + WS_OABC) - (size_t)(m & ~32767) * D, nullptr, (const bf16*)(F.ws + WS_YB), F.in[21] + l * D, F.in[22] + l * D, (size_t)m, F.lane, o); } return; }
    for (int m = gw; m < T; m += NGW) { f32x4 o[4]; ln_row<2>(nullptr, F.h, F.h, hb, (const bf16*)(F.ws + WS_YB), F.in[21] + l * D, F.in[22] + l * D, (size_t)m, F.lane, o); }
}

typedef short s16x4 __attribute__((ext_vector_type(4)));
constexpr int NT_A = (CH / 32) * 8, NT_B = (CH / L) * 3 * 256 * 4, NT_C = (CH / 32) * 8, NT_ALL = NT_A + NT_B + NT_C;
constexpr float NEGBIG = -1.0e30f, MINIT = -5.0e29f;
#define RC16(reg) (((reg) & 3) + 8 * ((reg) >> 2))

__device__ __forceinline__ void ph_tables(Frame& F) { LAUNDER(F);
    float* TA = (float*)(F.ws + WS_TABA); float* TB = (float*)(F.ws + WS_TABB); float* TC = (float*)(F.ws + WS_TABC);
    const float* rel_bias = F.in[3]; const float* rpb = F.in[7];
    const int gt = F.vcu * NTHREADS + F.tid, GT = F.G * NTHREADS;
    for (int i = gt; i < 8 * 320; i += GT) { const int h = i / 320, rel = i % 320 - 160; TA[i] = (rel >= -128 && rel <= 128) ? rel_bias[BUCK_A[rel + 128] * 20 + h] * LOG2E : NEGBIG; }
    for (int i = gt; i < 12 * 192; i += GT) { const int gh = i / 192, g = gh >> 2, rel = i % 192 - 96; TB[i] = (rel >= -64 && rel <= 64) ? rel_bias[BUCK_B[g][rel + 64] * 20 + 8 + gh] * LOG2E : NEGBIG; }
    for (int i = gt; i < DEPTH * 8 * 1024; i += GT) { const int lh = i >> 10, ri = (i >> 6) & 15, ci = (i & 63) - 16; TC[i] = (ri < 15 && ci >= 0 && ci <= 30) ? rpb[((size_t)lh * 15 + ri) * 31 + ci] * LOG2E : NEGBIG; }
}

template <int TYPE>
__device__ __forceinline__ void att_task(LAS unsigned char* wl, const int lane, const bf16* seq  , const float* tabsrc,
                                         const int qcol, const int kcol, const int vcol, const int TT0, const int TSTEP, const int kstride, const int tlo, const int thi,
                                         const int tq  , const int ci_i  , const int ci_c  , const int cbs,
                                         const float m_init, const float l_init, bf16* orow  , float* lse_out) {
    const int qi = lane & 31, hh = lane >> 5;
    LAS unsigned char* kt = wl; LAS unsigned char* vt = wl + 4096; LAS float* tb = (LAS float*)(wl + 8192);
    constexpr int TBN = TYPE == 0 ? 320 : (TYPE == 1 ? 192 : 1024);
#pragma unroll
    for (int i = 0; i < TBN / 64; ++i) tb[lane + 64 * i] = tabsrc[lane + 64 * i];
    bf16x8 Qf[4];
#pragma unroll
    for (int s = 0; s < 4; ++s) Qf[s] = *(const bf16x8*)(seq + (size_t)tq * QKVW + qcol + 16 * s + 8 * hh);
    f32x16 O0, O1;
#pragma unroll
    for (int i = 0; i < 16; ++i) { O0[i] = 0.f; O1[i] = 0.f; }
    float m = m_init, l = l_init;
    const int lkey = lane >> 3, lch = lane & 7;
    const bf16* gk = seq + (size_t)(lkey * kstride) * QKVW + 8 * lch;
    const size_t istep = (size_t)8 * kstride * QKVW;
    unsigned kwoff[4], vwoff[4];
#pragma unroll
    for (int i = 0; i < 4; ++i) { const int key = lkey + 8 * i; kwoff[i] = key * 128 + ((lch ^ (key & 7)) << 4); vwoff[i] = key * 128 + (((lch >> 2) ^ ((key >> 1) & 1)) << 6) + ((lch & 3) << 4); }
    unsigned kroff[4];
#pragma unroll
    for (int s = 0; s < 4; ++s) kroff[s] = qi * 128 + (((2 * s + hh) ^ (qi & 7)) << 4);
    const int q4 = (lane & 15) >> 2, p4 = lane & 3, g1 = (lane >> 4) & 1, sw = (q4 >> 1) & 1;
    const unsigned vr0 = (4 * hh + q4) * 128 + 32 * g1 + 8 * p4 + (sw << 6), vr1 = (4 * hh + q4) * 128 + 32 * g1 + 8 * p4 + ((sw ^ 1) << 6);
    const int bidx0 = (TYPE == 2) ? (cbs - ci_c + 31 + 4 * hh) : (32 - qi + 4 * hh);
    int cs = ci_c - 8; cs = cs < 0 ? 0 : (cs > 48 ? 48 : cs);
    const int xm = cbs - cs + 4 * hh;
    int rs_i = ci_i - 4; rs_i = rs_i < 0 ? 0 : (rs_i > 120 ? 120 : rs_i);
    v4u kreg[4], vreg[4];
    {
        const bf16* gt0 = gk + (size_t)(TT0 + tlo * TSTEP) * QKVW;
#pragma unroll
        for (int i = 0; i < 4; ++i) { kreg[i] = *(const v4u*)(gt0 + i * istep + kcol); vreg[i] = *(const v4u*)(gt0 + i * istep + vcol); }
    }
    for (int ti = tlo; ti <= thi; ++ti) {
#pragma unroll
        for (int i = 0; i < 4; ++i) { *(LAS v4u*)(kt + kwoff[i]) = kreg[i]; *(LAS v4u*)(vt + vwoff[i]) = vreg[i]; }
        if (ti < thi) {
            const bf16* gt0 = gk + (size_t)(TT0 + (ti + 1) * TSTEP) * QKVW;
#pragma unroll
            for (int i = 0; i < 4; ++i) { kreg[i] = *(const v4u*)(gt0 + i * istep + kcol); vreg[i] = *(const v4u*)(gt0 + i * istep + vcol); }
        }
        f32x16 S;
#pragma unroll
        for (int i = 0; i < 16; ++i) S[i] = 0.f;
#pragma unroll
        for (int s = 0; s < 4; ++s) { const bf16x8 Kf = *(const LAS bf16x8*)(kt + kroff[s]); S = __builtin_amdgcn_mfma_f32_32x32x16_bf16(Kf, Qf[s], S, 0, 0, 0); }
        int bidx;
        if (TYPE == 2) { const bool rv = (ti >= rs_i) && (ti < rs_i + 8); bidx = bidx0 + (rv ? (ti - ci_i + 7) : 15) * 64; }
        else bidx = bidx0 + 32 * ti;
        float tmax = NEGBIG;
#pragma unroll
        for (int r = 0; r < 16; ++r) { float v = S[r] + tb[bidx + RC16(r)]; if (TYPE == 2) v = ((unsigned)(xm + RC16(r)) < 16u) ? v : NEGBIG; S[r] = v; tmax = fmaxf(tmax, v); }
        tmax = fmaxf(tmax, __shfl_xor(tmax, 32));
        const float mn = fmaxf(m, tmax), corr = __builtin_amdgcn_exp2f(m - mn);
        float rsum = 0.f;
#pragma unroll
        for (int r = 0; r < 16; ++r) { const float p = __builtin_amdgcn_exp2f(S[r] - mn); S[r] = p; rsum += p; }
        rsum += __shfl_xor(rsum, 32);
        l = l * corr + rsum; m = mn;
#pragma unroll
        for (int i = 0; i < 16; ++i) { O0[i] *= corr; O1[i] *= corr; }
#pragma unroll
        for (int s2 = 0; s2 < 2; ++s2) {
            bf16x8 Pf; unsigned pw[4];
#pragma unroll
            for (int j = 0; j < 4; ++j) pw[j] = pg8::cvt_pk_bf16(S[8 * s2 + 2 * j], S[8 * s2 + 2 * j + 1]);
            Pf = __builtin_bit_cast(bf16x8, (v4u){pw[0], pw[1], pw[2], pw[3]});
            const s16x4 a00 = __builtin_amdgcn_ds_read_tr16_b64_v4i16((LAS s16x4*)(vt + vr0 + (16 * s2) * 128));
            const s16x4 a01 = __builtin_amdgcn_ds_read_tr16_b64_v4i16((LAS s16x4*)(vt + vr0 + (16 * s2 + 8) * 128));
            const s16x4 a10 = __builtin_amdgcn_ds_read_tr16_b64_v4i16((LAS s16x4*)(vt + vr1 + (16 * s2) * 128));
            const s16x4 a11 = __builtin_amdgcn_ds_read_tr16_b64_v4i16((LAS s16x4*)(vt + vr1 + (16 * s2 + 8) * 128));
            const bf16x8 V0 = (bf16x8){a00[0], a00[1], a00[2], a00[3], a01[0], a01[1], a01[2], a01[3]};
            const bf16x8 V1 = (bf16x8){a10[0], a10[1], a10[2], a10[3], a11[0], a11[1], a11[2], a11[3]};
            O0 = __builtin_amdgcn_mfma_f32_32x32x16_bf16(V0, Pf, O0, 0, 0, 0);
            O1 = __builtin_amdgcn_mfma_f32_32x32x16_bf16(V1, Pf, O1, 0, 0, 0);
        }
    }
    const float inv = 1.0f / l;
#pragma unroll
    for (int g = 0; g < 4; ++g) {
        v2u w0, w1;
        w0.x = pg8::cvt_pk_bf16(O0[4 * g] * inv, O0[4 * g + 1] * inv); w0.y = pg8::cvt_pk_bf16(O0[4 * g + 2] * inv, O0[4 * g + 3] * inv);
        w1.x = pg8::cvt_pk_bf16(O1[4 * g] * inv, O1[4 * g + 1] * inv); w1.y = pg8::cvt_pk_bf16(O1[4 * g + 2] * inv, O1[4 * g + 3] * inv);
        *(v2u*)(orow + 8 * g + 4 * hh) = w0; *(v2u*)(orow + 32 + 8 * g + 4 * hh) = w1;
    }
    if (TYPE == 1 && hh == 0) *lse_out = (m + __builtin_amdgcn_logf(l)) * LN2;
}

__device__ __forceinline__ void ph_att(Frame& F, int l) { LAUNDER(F);
    const int lane = F.lane, qi = lane & 31;
    LAS unsigned char* wl = F.lds + RING_OFF + F.wave * 16384;
    const bf16* qkv = (const bf16*)(F.ws + WS_QKV); bf16* oabc = (bf16*)(F.ws + WS_OABC); bf16* og = (bf16*)(F.ws + WS_OG); float* lse = (float*)(F.ws + WS_LSE);
    const float* TA = (const float*)(F.ws + WS_TABA); const float* TB = (const float*)(F.ws + WS_TABB); const float* TC = (const float*)(F.ws + WS_TABC) + (size_t)l * 8 * 1024;
    const float* sink = F.in[6] + l * 8;
    const int gw = F.vcu * NWAVES + F.wave, NGW = F.G * NWAVES;
    for (int task = gw; task < NT_ALL; task += NGW) {
        if (task < NT_A) {
            const int hq = task & 7, qb = (task >> 3) & 255, b = task >> 11, q0 = qb * 32;
            int tlo = 0, thi = 8; if (q0 - 128 < 0) tlo = (128 - q0) / 32; if (q0 + 128 + 31 >= L) thi = (L - 1 - (q0 - 128)) / 32;
            const int tq = q0 + qi;
            att_task<0>(wl, lane, qkv + (size_t)b * L * QKVW, TA + hq * 320, AQ + hq * 64, AK + (hq >> 2) * 64, AV + (hq >> 2) * 64, q0 - 128, 32, 1, tlo, thi, tq, 0, 0, 0,
                        sink[hq] * LOG2E, 1.0f, oabc + (size_t)(b * L + tq) * OW + hq * 64, nullptr);
        } else if (task < NT_A + NT_B) {
            const int j = task - NT_A, h = j & 3, sbi = (j >> 2) & 255, bg = j >> 10, g = bg % 3, b = bg / 3;
            const int dsh = 2 * g, d = 1 << dsh, nsb = 256 >> dsh, r = sbi / nsb, sb = sbi % nsb, q0 = sb * 32, Ls = L >> dsh;
            int tlo = 0, thi = 4; if (q0 - 64 < 0) tlo = (64 - q0) / 32; if (q0 + 64 + 31 >= Ls) thi = (Ls - 1 - (q0 - 64)) / 32;
            const int tq = (q0 + qi) * d + r, qc = BQ0 + 768 * g + h * 64;
            att_task<1>(wl, lane, qkv + (size_t)b * L * QKVW, TB + (g * 4 + h) * 192, qc, qc + 256, qc + 512, (q0 - 64) * d + r, 32 * d, d, tlo, thi, tq, 0, 0, 0,
                        MINIT, 0.0f, og + ((size_t)(b * L + tq) * 3 + g) * 256 + h * 64, lse + ((size_t)(b * L + tq) * 3 + g) * 4 + h);
        } else {
            const int j = task - NT_A - NT_B, h = j & 7, cbi = (j >> 3) & 255, b = j >> 11, ip = cbi >> 2, cb = cbi & 3;
            const int gi = 2 * ip + (qi >> 4), gc = 16 * cb + (qi & 15), tq = gi * 64 + gc;
            int cbs = 16 * cb - 8; cbs = cbs < 0 ? 0 : (cbs > 32 ? 32 : cbs);
            int rlo = 2 * ip - 4; rlo = rlo < 0 ? 0 : (rlo > 120 ? 120 : rlo);
            int rhi = 2 * ip + 1 - 4; rhi = rhi < 0 ? 0 : (rhi > 120 ? 120 : rhi); rhi += 7;
            att_task<2>(wl, lane, qkv + (size_t)b * L * QKVW, TC + h * 1024, CQ + h * 64, CK + h * 64, CV + h * 64, cbs, 64, 1, rlo, rhi, tq, gi, gc, cbs,
                        MINIT, 0.0f, oabc + (size_t)(b * L + tq) * OW + 768 + h * 64, nullptr);
        }
    }
}

constexpr int NSTEPS = 1 + DEPTH * 16;
__global__ void __launch_bounds__(NTHREADS, 2) mk_fwd(Args args) {
    extern __shared__ __attribute__((aligned(16))) unsigned char lds[];
    Frame F;
    F.lds = (LAS unsigned char*)lds; F.tid = threadIdx.x; F.lane = F.tid & 63; F.wave = __builtin_amdgcn_readfirstlane(F.tid >> 6);
    F.G = gridDim.x; { const int bx = blockIdx.x; F.vcu = (F.G % 8 == 0) ? (bx % 8) * (F.G / 8) + bx / 8 : bx; }
    F.in = args.in; F.h = args.out; F.ws = args.ws; F.probe = args.probe;
    volatile LAS unsigned* MISC = (volatile LAS unsigned*)(F.lds + MISC_OFF);
    if (F.tid < 32) MISC[F.tid] = 0u;
    __syncthreads();
    const int lo = args.s_lo, hi = args.s_hi;
    XcdBarrier bar; bar.bar = (unsigned*)(F.ws + WS_CTL) + CW_BAR; bar.x = 0; bar.st = nullptr;
    if (hi - lo > 1) bar = xcd_barrier_post((unsigned*)(F.ws + WS_CTL) + CW_BAR, MISC + 8);
#define RUN(s) (lo <= (s) && (s) < hi)
#define SEAM(s) do { if (RUN(s) && RUN((s) + 1)) xcd_barrier(bar); } while (0)
    if (RUN(0)) { ph_prologue(F); ph_tables(F); ph_ln0(F); }
    SEAM(0);
    for (int l = 0; l < DEPTH; ++l) {
        const int sb = 1 + l * 16;
        for (int c = 0; c < NCHUNK; ++c) {
            const int s = sb + c * 6;
            if (RUN(s)) ph_p1(F, l, c);
            SEAM(s);
            if (RUN(s + 1)) ph_att(F, l);
            SEAM(s + 1);
            if (RUN(s + 2)) ph_cmb(F);
            SEAM(s + 2);
            if (RUN(s + 3)) ph_p3(F, l);
            SEAM(s + 3);
            if (RUN(s + 4)) ph_p4(F, l, c);
            SEAM(s + 4);
            if (RUN(s + 5)) ph_ln1(F, l, c);
            SEAM(s + 5);
        }
        if (RUN(sb + 12)) ph_dsp(F, l);
        SEAM(sb + 12);
        if (RUN(sb + 13)) ph_p7(F, l);
        SEAM(sb + 13);
        if (RUN(sb + 14)) ph_p8(F, l);
        SEAM(sb + 14);
        if (RUN(sb + 15)) ph_ln2(F, l);
        SEAM(sb + 15);
    }
#undef RUN
#undef SEAM
}

#ifndef FAST_MASK
#define FAST_MASK 0x7FF
#endif
#ifndef ONE_LAUNCH
#define ONE_LAUNCH 1
#endif
extern "C" void kernel_launch(void* const* d_in, const int* in_sizes, int n_in, void* d_out, int out_size, void* d_ws, size_t ws_size, hipStream_t stream) {
    static int grid = 0;
    if (grid == 0) {
        if (n_in != 23 || out_size != T * D || ws_size < WS_END) { fprintf(stderr, "kernel_launch: unexpected shapes (n_in %d out %d ws %zu)\n", n_in, out_size, ws_size); grid = -1; return; }
        int dev = 0, cus = 0, per_cu = 0;
        if (hipGetDevice(&dev) != hipSuccess || hipDeviceGetAttribute(&cus, hipDeviceAttributeMultiprocessorCount, dev) != hipSuccess) { grid = -1; return; }
        if (hipFuncSetAttribute((const void*)mk_fwd, hipFuncAttributeMaxDynamicSharedMemorySize, LDS_BYTES) != hipSuccess) { fprintf(stderr, "kernel_launch: hipFuncSetAttribute failed\n"); grid = -1; return; }
        if (hipOccupancyMaxActiveBlocksPerMultiprocessor(&per_cu, (const void*)mk_fwd, NTHREADS, LDS_BYTES) != hipSuccess || per_cu < 1) fprintf(stderr, "kernel_launch: occupancy query reports %d\n", per_cu);
        (void)hipGetLastError();
        grid = cus;
    }
    if (grid < 0) return;
    const float* x = (const float*)d_in[0]; const float* ln0_g = (const float*)d_in[1]; const float* ln0_b = (const float*)d_in[2]; const float* rel_bias = (const float*)d_in[3];
    const float* w_in = (const float*)d_in[4]; const float* b_gate = (const float*)d_in[5]; const float* sink_a = (const float*)d_in[6]; const float* rpb_c = (const float*)d_in[7];
    const float* w_br_a = (const float*)d_in[8]; const float* w_br_b = (const float*)d_in[9]; const float* w_br_c = (const float*)d_in[10]; const float* w_out = (const float*)d_in[11];
    const float* ln1_g = (const float*)d_in[12]; const float* ln1_b = (const float*)d_in[13]; const float* w_rg = (const float*)d_in[14]; const float* b_rg = (const float*)d_in[15];
    const float* w_re = (const float*)d_in[16]; const float* b_re = (const float*)d_in[17]; const float* w_eg = (const float*)d_in[18]; const float* w_eu = (const float*)d_in[19];
    const float* w_ed = (const float*)d_in[20]; const float* ln2_g = (const float*)d_in[21]; const float* ln2_b = (const float*)d_in[22];
    unsigned char* ws = (unsigned char*)d_ws; float* h = (float*)d_out;
    bf16* hb = (bf16*)(ws + WS_HB); bf16* qkv = (bf16*)(ws + WS_QKV); bf16* gates = (bf16*)(ws + WS_GATES); bf16* oabc = (bf16*)(ws + WS_OABC); bf16* og = (bf16*)(ws + WS_OG);
    float* lse = (float*)(ws + WS_LSE); Rec* rec = (Rec*)(ws + WS_REC); int* rowtok = (int*)(ws + WS_ROWTOK); float* rowgate = (float*)(ws + WS_ROWGATE);
    bf16* merged = (bf16*)(ws + WS_MERGED); bf16* hid = (bf16*)(ws + WS_HID); bf16* yb = (bf16*)(ws + WS_YB); int* cnt = (int*)(ws + WS_CTL) + CW_CNT;
    (void)hipMemsetAsync(ws + WS_CTL, 0, CTL_ZERO_BYTES, stream);
    Args a{};
    for (int i = 0; i < 23; ++i) a.in[i] = (const float*)d_in[i];
    a.out = h; a.ws = ws;
    if (ONE_LAUNCH) { a.s_lo = 0; a.s_hi = NSTEPS; hipLaunchKernelGGL(mk_fwd, dim3(grid), dim3(NTHREADS), LDS_BYTES, stream, a); return; }
    const int G = 2048;
    const bool fastp1 = (FAST_MASK >> 1) & 1;
    for (int s = 0; s < NSTEPS; ++s) {
        int kind, l = 0, c = 0;
        if (s == 0) kind = 0; else { const int r = (s - 1) % 16; l = (s - 1) / 16; if (r < 12) { c = r / 6; kind = 1 + r % 6; } else kind = 7 + (r - 12); }
        if ((FAST_MASK >> kind) & 1) { a.s_lo = s; a.s_hi = s + 1;
#ifdef DUP_KIND
            if (kind == DUP_KIND && (kind == 5 || kind == 6 || kind == 10)) { a.probe = 1; hipLaunchKernelGGL(mk_fwd, dim3(grid), dim3(NTHREADS), LDS_BYTES, stream, a); a.probe = 0; }
#endif
            hipLaunchKernelGGL(mk_fwd, dim3(grid), dim3(NTHREADS), LDS_BYTES, stream, a);
#ifdef DUP_KIND
            if (kind == DUP_KIND && !(kind == 5 || kind == 6 || kind == 10)) { hipLaunchKernelGGL(mk_fwd, dim3(grid), dim3(NTHREADS), LDS_BYTES, stream, a); }
#endif
            continue; }
        const size_t r0 = (size_t)c * CH;
        switch (kind) {
        case 0: k_ln<<<G, 256, 0, stream>>>(0, x, h, hb, nullptr, ln0_g, ln0_b, 0, T); break;
        case 1: k_p1<<<G, 256, 0, stream>>>(hb + r0 * D, w_in + (size_t)l * D * NCOL, b_gate + (size_t)l * GATEW, qkv, gates); break;
        case 2: k_attn_naive<<<(28 * CH + 255) / 256, 256, 0, stream>>>(qkv, oabc, og, lse, rel_bias, sink_a + l * 8, rpb_c + (size_t)l * 8 * 15 * 31, fastp1 ? LN2 : 0.125f); break;
        case 3: k_combine<<<(CH * 32 + 255) / 256, 256, 0, stream>>>(og, lse, oabc); break;
        case 4: k_p3<<<G, 256, 0, stream>>>(oabc, gates, w_br_a + (size_t)l * 512 * D, w_br_b + (size_t)l * 256 * D, w_br_c + (size_t)l * 512 * D, merged); break;
        case 5: k_p4<<<G, 256, 0, stream>>>(merged, w_out + (size_t)l * D * D, h + r0 * D); break;
        case 6: k_ln<<<G, 256, 0, stream>>>(1, nullptr, h, hb, nullptr, ln1_g + l * D, ln1_b + l * D, (int)r0, CH);
                if (c == NCHUNK - 1) k_router<<<G, 256, 0, stream>>>(h, w_rg + (size_t)l * D * 4, b_rg + l * 4, w_re + (size_t)l * 4 * D * 8, b_re + l * 32, cnt + l * (32 * CSTR), rec);
                break;
        case 7: (void)hipMemsetAsync(rowtok, 0xFF, (size_t)PROWS * 4, stream); k_dispatch<<<256, 256, 0, stream>>>(cnt + l * (32 * CSTR), rec, rowtok, rowgate); break;
        case 8: k_p7<<<G, 256, 0, stream>>>(hb, cnt + l * (32 * CSTR), rowtok, w_eg + (size_t)l * NE * D * DE, w_eu + (size_t)l * NE * D * DE, hid); break;
        case 9: k_p8<<<G, 256, 0, stream>>>(hid, cnt + l * (32 * CSTR), rowtok, rowgate, w_ed + (size_t)l * NE * DE * D, yb); break;
        case 10: k_ln<<<G, 256, 0, stream>>>(2, nullptr, h, (l == DEPTH - 1) ? nullptr : hb, yb, ln2_g + l * D, ln2_b + l * D, 0, T); break;
        }
    }
}
```

```cpp
#include <hip/hip_runtime.h>
#include <cstdio>
#include <cstdint>
#include <cmath>

typedef unsigned short bf16;
typedef short bf16x8 __attribute__((ext_vector_type(8)));
typedef float f32x16 __attribute__((ext_vector_type(16)));
typedef float f32x4 __attribute__((ext_vector_type(4)));

constexpr int D = 1024, L = 8192, NBATCH = 8, T = NBATCH * L, DEPTH = 2;
constexpr int NCOL = 7680, QKVW = 4608, GATEW = 3072;
constexpr int CH = 32768, NCHUNK = T / CH;
constexpr int OW = 1280;
constexpr int NE = 32, DE = 512;
constexpr int MAXRT = T * 2 / 256 + NE, PROWS = MAXRT * 256;
constexpr float LN_EPS = 1e-5f;
constexpr float ALPHA = 1.41421356237309515f;
constexpr int AQ = 0, AK = 512, AV = 640, BQ0 = 768, CQ = 3072, CK = 3584, CV = 4096;

constexpr size_t MiB = 1u << 20;
constexpr size_t WS_CTL = 0;
constexpr size_t WS_WIN = 1 * MiB, WS_WBRA = 31 * MiB, WS_WBRB = 33 * MiB, WS_WBRC = 34 * MiB, WS_WOUT = 36 * MiB, WS_WGU = 40 * MiB, WS_WD = 168 * MiB;
constexpr size_t WS_HB = 232 * MiB, WS_QKV = 360 * MiB, WS_GATES = 648 * MiB, WS_OABC = 840 * MiB, WS_OG = 920 * MiB, WS_LSE = 968 * MiB,
                 WS_REC = 970 * MiB, WS_ROWTOK = 972 * MiB, WS_ROWGATE = 973 * MiB, WS_TABA = 974 * MiB, WS_TABB = WS_TABA + 16384, WS_TABC = WS_TABA + 32768, WS_END = 975 * MiB;
constexpr size_t WS_MERGED = WS_QKV, WS_HID = WS_QKV, WS_YB = WS_QKV + 136 * MiB;
constexpr int CSTR = 32;

__device__ __constant__ signed char BUCK_A[257] = {12,11,11,11,11,11,11,11,11,11,11,11,11,11,11,11,11,11,11,11,11,11,11,11,11,11,11,11,11,11,11,11,11,11,11,11,11,11,11,11,11,11,11,11,11,11,11,11,11,11,11,11,11,11,11,11,11,11,11,11,11,11,11,11,11,10,10,10,10,10,10,10,10,10,10,10,10,10,10,10,10,10,10,10,10,10,10,10,10,10,10,10,10,10,10,10,10,9,9,9,9,9,9,9,9,9,9,9,9,9,9,9,9,8,8,8,8,8,8,8,8,7,6,5,4,3,2,1,0,17,18,19,20,21,22,23,24,24,24,24,24,24,24,24,25,25,25,25,25,25,25,25,25,25,25,25,25,25,25,25,26,26,26,26,26,26,26,26,26,26,26,26,26,26,26,26,26,26,26,26,26,26,26,26,26,26,26,26,26,26,26,26,27,27,27,27,27,27,27,27,27,27,27,27,27,27,27,27,27,27,27,27,27,27,27,27,27,27,27,27,27,27,27,27,27,27,27,27,27,27,27,27,27,27,27,27,27,27,27,27,27,27,27,27,27,27,27,27,27,27,27,27,27,27,27,27,28};
__device__ __constant__ signed char BUCK_B[3][129] = {
 {11,10,10,10,10,10,10,10,10,10,10,10,10,10,10,10,10,10,10,10,10,10,10,10,10,10,10,10,10,10,10,10,10,9,9,9,9,9,9,9,9,9,9,9,9,9,9,9,9,8,8,8,8,8,8,8,8,7,6,5,4,3,2,1,0,17,18,19,20,21,22,23,24,24,24,24,24,24,24,24,25,25,25,25,25,25,25,25,25,25,25,25,25,25,25,25,26,26,26,26,26,26,26,26,26,26,26,26,26,26,26,26,26,26,26,26,26,26,26,26,26,26,26,26,26,26,26,26,27},
 {13,12,12,12,12,12,12,12,12,12,12,12,12,12,12,12,12,12,12,12,12,12,12,12,12,12,12,12,12,12,12,12,12,11,11,11,11,11,11,11,11,11,11,11,11,11,11,11,11,10,10,10,10,10,10,10,10,9,9,9,9,8,8,4,0,20,24,24,25,25,25,25,26,26,26,26,26,26,26,26,27,27,27,27,27,27,27,27,27,27,27,27,27,27,27,27,28,28,28,28,28,28,28,28,28,28,28,28,28,28,28,28,28,28,28,28,28,28,28,28,28,28,28,28,28,28,28,28,29},
 {15,14,14,14,14,14,14,14,14,14,14,14,14,14,14,14,14,14,14,14,14,14,14,14,14,14,14,14,14,14,14,14,14,13,13,13,13,13,13,13,13,13,13,13,13,13,13,13,13,12,12,12,12,12,12,12,12,11,11,11,11,10,10,9,0,25,26,26,27,27,27,27,28,28,28,28,28,28,28,28,29,29,29,29,29,29,29,29,29,29,29,29,29,29,29,29,30,30,30,30,30,30,30,30,30,30,30,30,30,30,30,30,30,30,30,30,30,30,30,30,30,30,30,30,30,30,30,30,31}};

__device__ __forceinline__ float bf2f(bf16 b) { return __uint_as_float(((unsigned)b) << 16); }
__device__ __forceinline__ bf16 f2bf(float f) { unsigned u = __float_as_uint(f); u += 0x7fffu + ((u >> 16) & 1u); return (bf16)(u >> 16); }
__device__ __forceinline__ float wave_sum(float v) {
#pragma unroll
    for (int o = 1; o < 64; o <<= 1) v += __shfl_xor(v, o);
    return v;
}

__global__ __launch_bounds__(256) void k_ln(int mode, const float* src, float* h, bf16* hb, const bf16* yb, const float* g, const float* bta, int row0, int nrows) {
    const int lane = threadIdx.x & 63, wv = blockIdx.x * 4 + (threadIdx.x >> 6), nw = gridDim.x * 4;
    for (int rr = wv; rr < nrows; rr += nw) {
        const size_t row = (size_t)row0 + rr;
        f32x4 v[4];
#pragma unroll
        for (int j = 0; j < 4; ++j) {
            const int c = lane * 4 + 256 * j;
            v[j] = *(const f32x4*)((mode == 0 ? src : h) + row * D + c);
            if (mode == 2) {
                const uint2 a = *(const uint2*)(yb + (row * 2) * D + c), b = *(const uint2*)(yb + (row * 2 + 1) * D + c);
                v[j].x = ALPHA * v[j].x + bf2f((bf16)(a.x & 0xffff)) + bf2f((bf16)(b.x & 0xffff));
                v[j].y = ALPHA * v[j].y + bf2f((bf16)(a.x >> 16)) + bf2f((bf16)(b.x >> 16));
                v[j].z = ALPHA * v[j].z + bf2f((bf16)(a.y & 0xffff)) + bf2f((bf16)(b.y & 0xffff));
                v[j].w = ALPHA * v[j].w + bf2f((bf16)(a.y >> 16)) + bf2f((bf16)(b.y >> 16));
            }
        }
        float s = 0.f;
#pragma unroll
        for (int j = 0; j < 4; ++j) s += (v[j].x + v[j].y) + (v[j].z + v[j].w);
        const float mean = wave_sum(s) * (1.f / D);
        float q = 0.f;
#pragma unroll
        for (int j = 0; j < 4; ++j) { v[j] = v[j] - mean; q += (v[j].x * v[j].x + v[j].y * v[j].y) + (v[j].z * v[j].z + v[j].w * v[j].w); }
        const float rstd = 1.0f / sqrtf(wave_sum(q) * (1.f / D) + LN_EPS);
#pragma unroll
        for (int j = 0; j < 4; ++j) {
            const int c = lane * 4 + 256 * j;
            const f32x4 gg = *(const f32x4*)(g + c), bb = *(const f32x4*)(bta + c);
            const f32x4 o = v[j] * rstd * gg + bb;
            *(f32x4*)(h + row * D + c) = o;
            if (hb) { uint2 w; w.x = (unsigned)f2bf(o.x) | ((unsigned)f2bf(o.y) << 16); w.y = (unsigned)f2bf(o.z) | ((unsigned)f2bf(o.w) << 16); *(uint2*)(hb + row * D + c) = w; }
        }
    }
}

__device__ __forceinline__ void wave_gemm32(const bf16* arow, const float* wcol, int ldw, int K, f32x16& acc) {
    for (int k0 = 0; k0 < K; k0 += 16) {
        const bf16x8 a = *(const bf16x8*)(arow + k0);
        bf16x8 b;
#pragma unroll
        for (int j = 0; j < 8; ++j) b[j] = (short)f2bf(wcol[(size_t)(k0 + j) * ldw]);
        acc = __builtin_amdgcn_mfma_f32_32x32x16_bf16(a, b, acc, 0, 0, 0);
    }
}
#define ACC_ROW(reg, h) (((reg) & 3) + 8 * ((reg) >> 2) + 4 * (h))

__global__ __launch_bounds__(256) void k_p1(const bf16* hbc, const float* w_in, const float* b_gate, bf16* qkv, bf16* gates) {
    const int lane = threadIdx.x & 63, r = lane & 31, hh = lane >> 5;
    const int wv = blockIdx.x * 4 + (threadIdx.x >> 6), nw = gridDim.x * 4;
    const int ntn = NCOL / 32, total = (CH / 32) * ntn;
    for (int tile = wv; tile < total; tile += nw) {
        const int tm = tile / ntn, tn = tile % ntn;
        f32x16 acc; for (int i = 0; i < 16; ++i) acc[i] = 0.f;
        wave_gemm32(hbc + (size_t)(tm * 32 + r) * D + 8 * hh, w_in + (size_t)(8 * hh) * NCOL + tn * 32 + r, NCOL, D, acc);
        const int col = tn * 32 + r;
#pragma unroll
        for (int i = 0; i < 16; ++i) {
            const int row = tm * 32 + ACC_ROW(i, hh);
            if (col < QKVW) qkv[(size_t)row * QKVW + col] = f2bf(acc[i]);
            else { const float z = acc[i] + b_gate[col - QKVW]; gates[(size_t)row * GATEW + (col - QKVW)] = f2bf(1.0f / (1.0f + __expf(-z))); }
        }
    }
}

__global__ __launch_bounds__(256) void k_attn_naive(const bf16* qkv, bf16* oabc, bf16* og, float* lse, const float* rel_bias, const float* sink_l, const float* rpb_l, float sc) {
    const long idx = (long)blockIdx.x * 256 + threadIdx.x;
    if (idx >= (long)28 * CH) return;
    const int ht = (int)(idx / CH), tl = (int)(idx % CH), b = tl / L, t = tl % L;
    const bf16* base = qkv + (size_t)(b * L) * QKVW;
    int qcol, kcol, vcol;
    if (ht < 8) { qcol = AQ + ht * 64; kcol = AK + (ht >> 2) * 64; vcol = AV + (ht >> 2) * 64; }
    else if (ht < 20) { const int g = (ht - 8) >> 2, h = (ht - 8) & 3; qcol = BQ0 + 768 * g + h * 64; kcol = qcol + 256; vcol = qcol + 512; }
    else { const int h = ht - 20; qcol = CQ + h * 64; kcol = CK + h * 64; vcol = CV + h * 64; }
    float q[64], o[64];
    {
        const uint4* qp = (const uint4*)(base + (size_t)t * QKVW + qcol);
#pragma unroll
        for (int c = 0; c < 8; ++c) { const uint4 u = qp[c]; const unsigned w[4] = {u.x, u.y, u.z, u.w};
#pragma unroll
            for (int i = 0; i < 4; ++i) { q[8 * c + 2 * i] = bf2f((bf16)(w[i] & 0xffff)); q[8 * c + 2 * i + 1] = bf2f((bf16)(w[i] >> 16)); } }
    }
#pragma unroll
    for (int i = 0; i < 64; ++i) o[i] = 0.f;
    float m = -1e30f, l = 0.f;
    if (ht < 8) { m = sink_l[ht]; l = 1.f; }
#define PROC_KEY(KT, BIAS) do { \
        const uint4* kp = (const uint4*)(base + (size_t)(KT) * QKVW + kcol); float s = 0.f; \
        _Pragma("unroll") for (int c = 0; c < 8; ++c) { const uint4 u = kp[c]; const unsigned w[4] = {u.x, u.y, u.z, u.w}; \
            _Pragma("unroll") for (int i = 0; i < 4; ++i) { s += q[8 * c + 2 * i] * bf2f((bf16)(w[i] & 0xffff)); s += q[8 * c + 2 * i + 1] * bf2f((bf16)(w[i] >> 16)); } } \
        s = s * sc + (BIAS); const float mn = fmaxf(m, s), corr = __expf(m - mn), p = __expf(s - mn); l = l * corr + p; m = mn; \
        const uint4* vp = (const uint4*)(base + (size_t)(KT) * QKVW + vcol); \
        _Pragma("unroll") for (int c = 0; c < 8; ++c) { const uint4 u = vp[c]; const unsigned w[4] = {u.x, u.y, u.z, u.w}; \
            _Pragma("unroll") for (int i = 0; i < 4; ++i) { o[8 * c + 2 * i] = o[8 * c + 2 * i] * corr + p * bf2f((bf16)(w[i] & 0xffff)); o[8 * c + 2 * i + 1] = o[8 * c + 2 * i + 1] * corr + p * bf2f((bf16)(w[i] >> 16)); } } \
    } while (0)
    if (ht < 8) {
        for (int rel = -128; rel <= 128; ++rel) { const int kt = t + rel; if (kt < 0 || kt >= L) continue;
            const float bias = rel_bias[BUCK_A[rel + 128] * 20 + ht]; PROC_KEY(kt, bias); }
    } else if (ht < 20) {
        const int g = (ht - 8) >> 2, h = (ht - 8) & 3, dil = (g == 0) ? 1 : (g == 1 ? 4 : 16);
        for (int off = -64; off <= 64; ++off) { const int kt = t + off * dil; if (kt < 0 || kt >= L) continue;
            const float bias = rel_bias[BUCK_B[g][off + 64] * 20 + 8 + 4 * g + h]; PROC_KEY(kt, bias); }
    } else {
        const int h = ht - 20, gi = t >> 6, gc = t & 63;
        int rs = gi - 4; rs = rs < 0 ? 0 : (rs > 120 ? 120 : rs);
        int cs = gc - 8; cs = cs < 0 ? 0 : (cs > 48 ? 48 : cs);
        for (int kr = rs; kr < rs + 8; ++kr)
            for (int kc = cs; kc < cs + 16; ++kc) { const float bias = rpb_l[(h * 15 + (kr - gi + 7)) * 31 + (kc - gc + 15)]; const int kt = kr * 64 + kc; PROC_KEY(kt, bias); }
    }
#undef PROC_KEY
    const float inv = 1.0f / l;
    bf16* dst;
    if (ht < 8) dst = oabc + (size_t)tl * OW + ht * 64;
    else if (ht < 20) { const int g = (ht - 8) >> 2, h = (ht - 8) & 3; dst = og + ((size_t)tl * 3 + g) * 256 + h * 64; lse[((size_t)tl * 3 + g) * 4 + h] = m + __logf(l); }
    else dst = oabc + (size_t)tl * OW + 768 + (ht - 20) * 64;
#pragma unroll
    for (int c = 0; c < 8; ++c) { uint4 u;
        u.x = (unsigned)f2bf(o[8 * c + 0] * inv) | ((unsigned)f2bf(o[8 * c + 1] * inv) << 16); u.y = (unsigned)f2bf(o[8 * c + 2] * inv) | ((unsigned)f2bf(o[8 * c + 3] * inv) << 16);
        u.z = (unsigned)f2bf(o[8 * c + 4] * inv) | ((unsigned)f2bf(o[8 * c + 5] * inv) << 16); u.w = (unsigned)f2bf(o[8 * c + 6] * inv) | ((unsigned)f2bf(o[8 * c + 7] * inv) << 16);
        ((uint4*)dst)[c] = u; }
}

__global__ __launch_bounds__(256) void k_combine(const bf16* og, const float* lse, bf16* oabc) {
    const long idx = (long)blockIdx.x * 256 + threadIdx.x;
    if (idx >= (long)CH * 32) return;
    const int tl = (int)(idx >> 5), hc = (int)(idx & 31), h = hc >> 3, c = hc & 7;
    const float l0 = lse[((size_t)tl * 3 + 0) * 4 + h], l1 = lse[((size_t)tl * 3 + 1) * 4 + h], l2 = lse[((size_t)tl * 3 + 2) * 4 + h];
    const float mx = fmaxf(l0, fmaxf(l1, l2)); float w0 = __expf(l0 - mx), w1 = __expf(l1 - mx), w2 = __expf(l2 - mx); const float inv = 1.0f / (w0 + w1 + w2); w0 *= inv; w1 *= inv; w2 *= inv;
    const uint4 a = *(const uint4*)(og + ((size_t)tl * 3 + 0) * 256 + h * 64 + c * 8), b = *(const uint4*)(og + ((size_t)tl * 3 + 1) * 256 + h * 64 + c * 8), d = *(const uint4*)(og + ((size_t)tl * 3 + 2) * 256 + h * 64 + c * 8);
    const unsigned aw[4] = {a.x, a.y, a.z, a.w}, bw[4] = {b.x, b.y, b.z, b.w}, dw[4] = {d.x, d.y, d.z, d.w}; unsigned ow[4];
#pragma unroll
    for (int i = 0; i < 4; ++i) {
        const float lo = w0 * bf2f((bf16)(aw[i] & 0xffff)) + w1 * bf2f((bf16)(bw[i] & 0xffff)) + w2 * bf2f((bf16)(dw[i] & 0xffff));
        const float hi = w0 * bf2f((bf16)(aw[i] >> 16)) + w1 * bf2f((bf16)(bw[i] >> 16)) + w2 * bf2f((bf16)(dw[i] >> 16));
        ow[i] = (unsigned)f2bf(lo) | ((unsigned)f2bf(hi) << 16);
    }
    *(uint4*)(oabc + (size_t)tl * OW + 512 + h * 64 + c * 8) = make_uint4(ow[0], ow[1], ow[2], ow[3]);
}

__global__ __launch_bounds__(256) void k_p3(const bf16* oabc, const bf16* gates, const float* wa, const float* wb, const float* wc, bf16* merged) {
    const int lane = threadIdx.x & 63, r = lane & 31, hh = lane >> 5;
    const int wv = blockIdx.x * 4 + (threadIdx.x >> 6), nw = gridDim.x * 4;
    const int ntn = D / 32, total = (CH / 32) * ntn;
    for (int tile = wv; tile < total; tile += nw) {
        const int tm = tile / ntn, tn = tile % ntn, col = tn * 32 + r;
        f32x16 mg; for (int i = 0; i < 16; ++i) mg[i] = 0.f;
#pragma unroll 1
        for (int br = 0; br < 3; ++br) {
            f32x16 acc; for (int i = 0; i < 16; ++i) acc[i] = 0.f;
            const int koff = br == 0 ? 0 : (br == 1 ? 512 : 768), K = br == 1 ? 256 : 512;
            const float* w = br == 0 ? wa : (br == 1 ? wb : wc);
            wave_gemm32(oabc + (size_t)(tm * 32 + r) * OW + koff + 8 * hh, w + (size_t)(8 * hh) * D + col, D, K, acc);
#pragma unroll
            for (int i = 0; i < 16; ++i) { const int row = tm * 32 + ACC_ROW(i, hh); mg[i] += bf2f(gates[(size_t)row * GATEW + br * 1024 + col]) * acc[i]; }
        }
#pragma unroll
        for (int i = 0; i < 16; ++i) { const int row = tm * 32 + ACC_ROW(i, hh); merged[(size_t)row * D + col] = f2bf(mg[i]); }
    }
}
__global__ __launch_bounds__(256) void k_p4(const bf16* merged, const float* wo, float* hchunk) {
    const int lane = threadIdx.x & 63, r = lane & 31, hh = lane >> 5;
    const int wv = blockIdx.x * 4 + (threadIdx.x >> 6), nw = gridDim.x * 4;
    const int ntn = D / 32, total = (CH / 32) * ntn;
    for (int tile = wv; tile < total; tile += nw) {
        const int tm = tile / ntn, tn = tile % ntn, col = tn * 32 + r;
        f32x16 acc; for (int i = 0; i < 16; ++i) acc[i] = 0.f;
        wave_gemm32(merged + (size_t)(tm * 32 + r) * D + 8 * hh, wo + (size_t)(8 * hh) * D + col, D, D, acc);
#pragma unroll
        for (int i = 0; i < 16; ++i) { const int row = tm * 32 + ACC_ROW(i, hh); float* p = hchunk + (size_t)row * D + col; *p = ALPHA * *p + acc[i]; }
    }
}

struct Rec { int e0, s0, e1, s1; float g0, g1; int pad0, pad1; };
__global__ __launch_bounds__(256) void k_router(const float* h, const float* w_rg, const float* b_rg, const float* w_re, const float* b_re, int* cnt, Rec* rec) {
    const int lane = threadIdx.x & 63, wv = blockIdx.x * 4 + (threadIdx.x >> 6), nw = gridDim.x * 4;
    for (int t = wv; t < T; t += nw) {
        float x[16];
#pragma unroll
        for (int j = 0; j < 4; ++j) { const f32x4 v = *(const f32x4*)(h + (size_t)t * D + lane * 4 + 256 * j); x[4 * j] = v.x; x[4 * j + 1] = v.y; x[4 * j + 2] = v.z; x[4 * j + 3] = v.w; }
        float gl[4] = {0.f, 0.f, 0.f, 0.f};
#pragma unroll
        for (int j = 0; j < 4; ++j)
#pragma unroll
            for (int i = 0; i < 4; ++i) { const f32x4 w = *(const f32x4*)(w_rg + (size_t)(lane * 4 + 256 * j + i) * 4); const float xv = x[4 * j + i]; gl[0] += xv * w.x; gl[1] += xv * w.y; gl[2] += xv * w.z; gl[3] += xv * w.w; }
#pragma unroll
        for (int g = 0; g < 4; ++g) gl[g] = wave_sum(gl[g]) + b_rg[g];
        int gi = 0; float gm = gl[0];
#pragma unroll
        for (int g = 1; g < 4; ++g) if (gl[g] > gm) { gm = gl[g]; gi = g; }
        float gs = 0.f;
#pragma unroll
        for (int g = 0; g < 4; ++g) gs += __expf(gl[g] - gm);
        const float gw = 1.0f / gs;
        float el[8];
#pragma unroll
        for (int e = 0; e < 8; ++e) el[e] = 0.f;
        const float* wre = w_re + (size_t)gi * D * 8;
#pragma unroll
        for (int j = 0; j < 4; ++j)
#pragma unroll
            for (int i = 0; i < 4; ++i) { const float* wp = wre + (size_t)(lane * 4 + 256 * j + i) * 8; const f32x4 w0 = *(const f32x4*)wp, w1 = *(const f32x4*)(wp + 4); const float xv = x[4 * j + i];
                el[0] += xv * w0.x; el[1] += xv * w0.y; el[2] += xv * w0.z; el[3] += xv * w0.w; el[4] += xv * w1.x; el[5] += xv * w1.y; el[6] += xv * w1.z; el[7] += xv * w1.w; }
#pragma unroll
        for (int e = 0; e < 8; ++e) el[e] = wave_sum(el[e]) + b_re[gi * 8 + e];
        int i0 = 0; float t0 = el[0];
#pragma unroll
        for (int e = 1; e < 8; ++e) if (el[e] > t0) { t0 = el[e]; i0 = e; }
        int i1 = -1; float t1 = -3.0e38f;
#pragma unroll
        for (int e = 0; e < 8; ++e) if (e != i0 && el[e] > t1) { t1 = el[e]; i1 = e; }
        const float ex = __expf(t1 - t0), p0 = 1.0f / (1.0f + ex), p1 = ex / (1.0f + ex);
        if (lane == 0) {
            Rec rc; rc.e0 = gi * 8 + i0; rc.e1 = gi * 8 + i1; rc.g0 = gw * p0; rc.g1 = gw * p1; rc.pad0 = 0; rc.pad1 = 0;
            rc.s0 = atomicAdd(cnt + rc.e0 * CSTR, 1); rc.s1 = atomicAdd(cnt + rc.e1 * CSTR, 1);
            rec[t] = rc;
        }
    }
}
__device__ __forceinline__ void pad_offsets(const int* cnt, int* po) { int acc = 0; for (int e = 0; e < NE; ++e) { po[e] = acc; acc += (cnt[e * CSTR] + 255) / 256 * 256; } po[NE] = acc; }
__global__ __launch_bounds__(256) void k_dispatch(const int* cnt, const Rec* rec, int* rowtok, float* rowgate) {
    __shared__ int po[NE + 1];
    if (threadIdx.x == 0) pad_offsets(cnt, po);
    __syncthreads();
    for (int t = blockIdx.x * 256 + threadIdx.x; t < T; t += gridDim.x * 256) {
        const Rec rc = rec[t];
        const int d0 = po[rc.e0] + rc.s0, d1 = po[rc.e1] + rc.s1;
        rowtok[d0] = 2 * t; rowgate[d0] = rc.g0; rowtok[d1] = 2 * t + 1; rowgate[d1] = rc.g1;
    }
}
__global__ __launch_bounds__(256) void k_p7(const bf16* hb, const int* cnt, const int* rowtok, const float* w_eg, const float* w_eu, bf16* hid) {
    __shared__ int po[NE + 1];
    if (threadIdx.x == 0) pad_offsets(cnt, po);
    __syncthreads();
    const int lane = threadIdx.x & 63, r = lane & 31, hh = lane >> 5;
    const int wv = blockIdx.x * 4 + (threadIdx.x >> 6), nw = gridDim.x * 4;
    const int ntn = DE / 32, total = (po[NE] / 32) * ntn;
    for (int tile = wv; tile < total; tile += nw) {
        const int tm = tile / ntn, tn = tile % ntn, col = tn * 32 + r, row0 = tm * 32;
        int e = 0; while (e < NE - 1 && po[e + 1] <= row0) ++e;
        int tok = rowtok[row0 + r]; tok = tok < 0 ? 0 : (tok >> 1);
        f32x16 ag, au; for (int i = 0; i < 16; ++i) { ag[i] = 0.f; au[i] = 0.f; }
        wave_gemm32(hb + (size_t)tok * D + 8 * hh, w_eg + (size_t)e * D * DE + (size_t)(8 * hh) * DE + col, DE, D, ag);
        wave_gemm32(hb + (size_t)tok * D + 8 * hh, w_eu + (size_t)e * D * DE + (size_t)(8 * hh) * DE + col, DE, D, au);
#pragma unroll
        for (int i = 0; i < 16; ++i) { const int row = row0 + ACC_ROW(i, hh); const float gsl = ag[i] / (1.0f + __expf(-ag[i])); hid[(size_t)row * DE + col] = f2bf(gsl * au[i]); }
    }
}
__global__ __launch_bounds__(256) void k_p8(const bf16* hid, const int* cnt, const int* rowtok, const float* rowgate, const float* w_ed, bf16* yb) {
    __shared__ int po[NE + 1];
    if (threadIdx.x == 0) pad_offsets(cnt, po);
    __syncthreads();
    const int lane = threadIdx.x & 63, r = lane & 31, hh = lane >> 5;
    const int wv = blockIdx.x * 4 + (threadIdx.x >> 6), nw = gridDim.x * 4;
    const int ntn = D / 32, total = (po[NE] / 32) * ntn;
    for (int tile = wv; tile < total; tile += nw) {
        const int tm = tile / ntn, tn = tile % ntn, col = tn * 32 + r, row0 = tm * 32;
        int e = 0; while (e < NE - 1 && po[e + 1] <= row0) ++e;
        f32x16 acc; for (int i = 0; i < 16; ++i) acc[i] = 0.f;
        wave_gemm32(hid + (size_t)(row0 + r) * DE + 8 * hh, w_ed + (size_t)e * DE * D + (size_t)(8 * hh) * D + col, D, DE, acc);
#pragma unroll
        for (int i = 0; i < 16; ++i) { const int row = row0 + ACC_ROW(i, hh); const int rt = rowtok[row]; if (rt >= 0) yb[(size_t)rt * D + col] = f2bf(acc[i] * rowgate[row]); }
    }
}


namespace pg8 {
#define PG8_LAS __attribute__((address_space(3)))
typedef unsigned short bf16_t;
typedef unsigned u32x4 __attribute__((ext_vector_type(4)));
constexpr int BM = 256, BK = 64, HALF = 128, HTB = HALF * BK * 2  , STAGE_BYTES = 8 * HTB, NXCD = 8, WGM = 8;

__host__ __device__ __forceinline__ int lds_byte(int r, int c) { const int st = (r >> 4) * 2 + (c >> 5), rr = r & 15, cc = c & 31, ob = rr * 64 + cc * 2; return st * 1024 + (ob ^ (((ob >> 9) & 1) << 5)); }
__host__ __device__ __forceinline__ void stage_rc(int b, int& R, int& C) { const int st = b / 1024, sb = b % 1024, swz = sb ^ (((sb >> 9) & 1) << 5); R = (st >> 1) * 16 + swz / 64; C = (st & 1) * 32 + (swz % 64) / 2; }
__host__ __device__ __forceinline__ int perm32(int rho) { const int n = rho >> 4, i = rho & 15; return 8 * (i >> 2) + 4 * n + (i & 3); }

struct Unit { int pm, pn, e, ui; };

struct DenseOrder {
    int nM, nN, nwg, G, c; const char* A; const char* B; size_t tstepA, tstepB;
    __device__ void init(const void* A_, int lda, const void* B_, int ldb, int M, int N, int G_, int c_) { nM = M / BM; nN = N / BM; nwg = nM * nN; G = G_; c = c_; A = (const char*)A_; B = (const char*)B_; tstepA = (size_t)BM * lda * 2; tstepB = (size_t)BM * ldb * 2; }
    __device__ bool next(int i, Unit& u) const {
        const long Lx = (long)i * G + c; if (Lx >= nwg) return false;
        int wgid = (int)Lx; { const int q = nwg / NXCD, r = nwg % NXCD, xcd = wgid % NXCD, off = wgid / NXCD; wgid = (xcd < r ? xcd * (q + 1) : r * (q + 1) + (xcd - r) * q) + off; }
        const int nig = WGM * nN, gid = wgid / nig, fm = gid * WGM, gsz = (nM - fm) < WGM ? (nM - fm) : WGM;
        u.pm = fm + ((wgid % nig) % gsz); u.pn = (wgid % nig) / gsz; u.e = 0; u.ui = i; return true;
    }
    __device__ __forceinline__ const char* a_base(const Unit& u) const { return A + (size_t)u.pm * tstepA; }
    __device__ __forceinline__ const char* b_base(const Unit& u) const { return B + (size_t)u.pn * tstepB; }
    __device__ __forceinline__ int a_row(const Unit&, int) const { return 0; }
};

__device__ __forceinline__ unsigned cvt_pk_bf16(float lo, float hi) { unsigned r; asm volatile("v_cvt_pk_bf16_f32 %0, %1, %2" : "=v"(r) : "v"(lo), "v"(hi)); return r; }

template <class Epi, class Sched, bool GATHER>
__device__ __forceinline__ void gemm_phase(PG8_LAS unsigned char* lds, const Sched& S, const Epi& E, const int K, const int lda, const int ldb) {
    int tid = threadIdx.x; asm volatile("" : "+v"(tid));
    const int wid = __builtin_amdgcn_readfirstlane(tid >> 6), lane = tid & 63, wr = wid >> 2, wc = wid & 3, fr = lane & 15, fq = lane >> 4;
    const int nt = K / BK;
    int RA[2], CA[2]; unsigned voffB[2];
#pragma unroll
    for (int i = 0; i < 2; ++i) { int R, C; stage_rc(tid * 16 + i * 8192, R, C); const int Rb = Epi::PERM ? ((R & ~31) + perm32(R & 31)) : R; RA[i] = R; CA[i] = C; voffB[i] = (unsigned)(Rb * ldb + C) * 2u; }
    const size_t kstep = (size_t)(BK * 2);
    const size_t hstepB = (size_t)HALF * ldb * 2;
    const unsigned ldsw = (unsigned)wid * 1024u;
    const int aoff = lds_byte(wr * 64 + fr, fq * 8), boff = lds_byte(wc * 32 + fr, fq * 8);
#define PG8_SA(b, h) (((b) * 2 + (h)) * HTB)
#define PG8_SB(b, h) ((4 + (b) * 2 + (h)) * HTB)
#define PG8_STAGE2(bufoff, gbase, v0, v1) do { \
        __builtin_amdgcn_global_load_lds((const unsigned*)((const char*)(gbase) + (v0)), (PG8_LAS unsigned*)(lds + (bufoff) + ldsw), 16, 0, 0); \
        __builtin_amdgcn_global_load_lds((const unsigned*)((const char*)(gbase) + (v1)), (PG8_LAS unsigned*)(lds + (bufoff) + ldsw + 8192), 16, 0, 0); } while (0)
#define PG8_STAGEB(bufoff, gbase) PG8_STAGE2(bufoff, gbase, voffB[0], voffB[1])
#define PG8_LDA(dst, b, h) do { _Pragma("unroll") for (int m = 0; m < 4; ++m) _Pragma("unroll") for (int k = 0; k < 2; ++k) dst[m][k] = *(const PG8_LAS bf16x8*)(lds + PG8_SA(b, h) + aoff + m * 2048 + k * 1024); } while (0)
#define PG8_LDB(dst, b, h) do { _Pragma("unroll") for (int n = 0; n < 2; ++n) _Pragma("unroll") for (int k = 0; k < 2; ++k) dst[n][k] = *(const PG8_LAS bf16x8*)(lds + PG8_SB(b, h) + boff + n * 2048 + k * 1024); } while (0)
#define PG8_MMA(ai, bj, At, Bt) do { __builtin_amdgcn_s_setprio(1); _Pragma("unroll") for (int m = 0; m < 4; ++m) _Pragma("unroll") for (int n = 0; n < 2; ++n) _Pragma("unroll") for (int k = 0; k < 2; ++k) \
        acc[ai][bj][m][n] = __builtin_amdgcn_mfma_f32_16x16x32_bf16(Bt[n][k], At[m][k], acc[ai][bj][m][n], 0, 0, 0); __builtin_amdgcn_s_setprio(0); } while (0)
#define PG8_WAIT_V(n) asm volatile("s_waitcnt vmcnt(" #n ")" ::: "memory")
#define PG8_WAIT_L(n) asm volatile("s_waitcnt lgkmcnt(" #n ")" ::: "memory")
#define PG8_BAR __builtin_amdgcn_s_barrier()
#define PG8_SCHED __builtin_amdgcn_sched_barrier(0)
#define PG8_VOFFA(dst, u) do { _Pragma("unroll") for (int h_ = 0; h_ < 2; ++h_) _Pragma("unroll") for (int i_ = 0; i_ < 2; ++i_) { \
        const int row_ = GATHER ? S.a_row(u, h_ * HALF + RA[i_]) : (h_ * HALF + RA[i_]); dst[h_][i_] = (unsigned)(row_ * lda + CA[i_]) * 2u; } } while (0)
    Unit cur, nxt;
    if (!S.next(0, cur)) return;
    f32x4 acc[2][2][4][2];
#pragma unroll
    for (int a = 0; a < 2; ++a)
#pragma unroll
        for (int b = 0; b < 2; ++b)
#pragma unroll
            for (int m = 0; m < 4; ++m)
#pragma unroll
                for (int n = 0; n < 2; ++n) acc[a][b][m][n] = (f32x4){0.f, 0.f, 0.f, 0.f};
    bf16x8 At[4][2], B0[2][2], B1[2][2];
    unsigned vc[2][2], vn[2][2];
    PG8_VOFFA(vc, cur);
    const char* cA = S.a_base(cur); const char* cB = S.b_base(cur);
    PG8_STAGEB(PG8_SB(0, 0), cB); PG8_STAGEB(PG8_SB(0, 1), cB + hstepB); PG8_STAGE2(PG8_SA(0, 0), cA, vc[0][0], vc[0][1]); PG8_STAGE2(PG8_SA(0, 1), cA, vc[1][0], vc[1][1]);
    if (wr == 1) PG8_BAR;
    PG8_WAIT_V(2); PG8_BAR;
    PG8_STAGEB(PG8_SB(1, 0), cB + kstep); PG8_STAGE2(PG8_SA(1, 0), cA + kstep, vc[0][0], vc[0][1]); PG8_STAGEB(PG8_SB(1, 1), cB + hstepB + kstep);
    PG8_WAIT_V(6); PG8_BAR;
    int ui = 0;
    for (;;) {
        const bool has_next = S.next(ui + 1, nxt);
        const char* nA = has_next ? S.a_base(nxt) : cA; const char* nB = has_next ? S.b_base(nxt) : cB;
        if (GATHER) { if (has_next) { PG8_VOFFA(vn, nxt); } else {
#pragma unroll
            for (int h_ = 0; h_ < 2; ++h_) { vn[h_][0] = vc[h_][0]; vn[h_][1] = vc[h_][1]; } } }
        for (int t = 0; t < nt; t += 2) {
            const bool last = (t == nt - 2);
            const char* a1 = cA + (size_t)(t + 1) * kstep;
            const char* a2 = last ? nA : cA + (size_t)(t + 2) * kstep; const char* b2 = last ? nB : cB + (size_t)(t + 2) * kstep;
            const char* a3 = a2 + kstep; const char* b3 = b2 + kstep;
            unsigned w00, w01, w10, w11;
            if (GATHER) { w00 = last ? vn[0][0] : vc[0][0]; w01 = last ? vn[0][1] : vc[0][1]; w10 = last ? vn[1][0] : vc[1][0]; w11 = last ? vn[1][1] : vc[1][1]; }
            else { w00 = vc[0][0]; w01 = vc[0][1]; w10 = vc[1][0]; w11 = vc[1][1]; }
            PG8_LDB(B0, 0, 0); PG8_LDB(B1, 0, 1); PG8_SCHED; PG8_LDA(At, 0, 0); PG8_STAGE2(PG8_SA(1, 1), a1, vc[1][0], vc[1][1]);
            PG8_WAIT_V(8); PG8_WAIT_L(0); PG8_BAR; PG8_MMA(0, 0, At, B0); PG8_MMA(0, 1, At, B1); PG8_BAR; PG8_SCHED;
            PG8_LDA(At, 0, 1); PG8_STAGEB(PG8_SB(0, 0), b2); PG8_STAGEB(PG8_SB(0, 1), b2 + hstepB); PG8_STAGE2(PG8_SA(0, 0), a2, w00, w01);
            PG8_WAIT_V(8); PG8_WAIT_L(0); PG8_BAR; PG8_MMA(1, 0, At, B0); PG8_MMA(1, 1, At, B1); PG8_BAR; PG8_SCHED;
            PG8_LDB(B0, 1, 0); PG8_LDB(B1, 1, 1); PG8_SCHED; PG8_LDA(At, 1, 0); PG8_STAGE2(PG8_SA(0, 1), a2, w10, w11);
            PG8_WAIT_V(8); PG8_WAIT_L(0); PG8_BAR; PG8_MMA(0, 0, At, B0); PG8_MMA(0, 1, At, B1); PG8_BAR; PG8_SCHED;
            PG8_LDA(At, 1, 1); PG8_STAGEB(PG8_SB(1, 0), b3); PG8_STAGEB(PG8_SB(1, 1), b3 + hstepB); PG8_STAGE2(PG8_SA(1, 0), a3, w00, w01);
            PG8_WAIT_V(8); PG8_WAIT_L(0); PG8_BAR; PG8_MMA(1, 0, At, B0); PG8_MMA(1, 1, At, B1); PG8_BAR; PG8_SCHED;
        }
        if (wr == 0) PG8_BAR;
        E(acc, cur, wr, wc, fr, fq);
        if (!has_next) break;
#pragma unroll
        for (int a = 0; a < 2; ++a)
#pragma unroll
            for (int b = 0; b < 2; ++b)
#pragma unroll
                for (int m = 0; m < 4; ++m)
#pragma unroll
                    for (int n = 0; n < 2; ++n) acc[a][b][m][n] = (f32x4){0.f, 0.f, 0.f, 0.f};
        cur = nxt; cA = nA; cB = nB; ++ui;
        if (GATHER) {
#pragma unroll
            for (int h_ = 0; h_ < 2; ++h_) { vc[h_][0] = vn[h_][0]; vc[h_][1] = vn[h_][1]; } }
        if (wr == 1) PG8_BAR;
    }
    PG8_WAIT_V(0);
    PG8_BAR;
#undef PG8_SA
#undef PG8_SB
#undef PG8_STAGE2
#undef PG8_STAGEB
#undef PG8_LDA
#undef PG8_LDB
#undef PG8_MMA
#undef PG8_WAIT_V
#undef PG8_WAIT_L
#undef PG8_BAR
#undef PG8_SCHED
#undef PG8_VOFFA
}
}

constexpr int NWAVES = 8, NTHREADS = 512;
constexpr int RING_OFF = 0, RING_BYTES = 131072, ROWS_OFF = 131072, ROWS_BYTES = 12288, ROUTER_BYTES = 147456  , MISC_OFF = ROUTER_BYTES, LDS_BYTES = 148480;
static_assert(MISC_OFF + 128 <= LDS_BYTES, "LDS map");
constexpr int CW_CNT = 0;
constexpr int CW_BAR = 4096;
constexpr size_t CTL_ZERO_BYTES = 64 * 1024;
constexpr float LOG2E = 1.4426950408889634f, LN2 = 0.6931471805599453f;
constexpr float QSCALE = 0.125f * LOG2E;

#define GAS __attribute__((address_space(1)))
#define LAS __attribute__((address_space(3)))
typedef unsigned v4u __attribute__((ext_vector_type(4)));
typedef unsigned v2u __attribute__((ext_vector_type(2)));
#define LDS_WAIT() asm volatile("s_waitcnt lgkmcnt(0)" ::: "memory")
__device__ __forceinline__ unsigned pk2(float lo, float hi) { return (unsigned)f2bf(lo) | ((unsigned)f2bf(hi) << 16); }

#define XB_TMO      128
#define XB_XCNT(j)  (256  + 64 * (j))
#define XB_XSUB(j)  (1280 + 64 * (j))
#define XB_XGEN(j)  (2304 + 64 * (j))
#define XB_TOP      3328
#define XB_TOPGEN   3392
#define XCD_BAR_WORDS 3456
#define XB_SPIN_CAP (1u << 18)

__device__ __forceinline__ unsigned xb_ld(unsigned* p)              { return __hip_atomic_load(p, __ATOMIC_RELAXED, __HIP_MEMORY_SCOPE_AGENT); }
__device__ __forceinline__ unsigned xb_add(unsigned* p, unsigned v) { return __hip_atomic_fetch_add(p, v, __ATOMIC_RELAXED, __HIP_MEMORY_SCOPE_AGENT); }
__device__ __forceinline__ unsigned xb_xcc_id() { return (unsigned)__builtin_amdgcn_s_getreg((3 << 11) | 20) & 0xFu; }
#define XB_SPIN(cond, bar) do { unsigned _sp = 0; while (cond) { __builtin_amdgcn_s_sleep(1); \
    if ((++_sp & 255u) == 0u) { if (xb_ld(&(bar)[XB_TMO])) break; if (_sp > XB_SPIN_CAP) { atomicAdd(&(bar)[XB_TMO], 1u); break; } } } } while (0)

struct XcdBarrier {
    unsigned* bar; unsigned x;
    volatile LAS unsigned* st;
};

__device__ __forceinline__ XcdBarrier xcd_barrier_post(unsigned* bar, volatile LAS unsigned* st) {
    XcdBarrier b; b.bar = bar; b.x = xb_xcc_id(); b.st = st;
    if (threadIdx.x == 0) (void)xb_add(&bar[XB_XCNT(b.x)], 1u);
    return b;
}
__device__ __forceinline__ void xcd_barrier_complete(unsigned* bar, unsigned x, unsigned& nloc, unsigned& nx) {
    const unsigned G = gridDim.x * gridDim.y * gridDim.z;
    unsigned sum, cnt, mine, sp = 0u;
    for (;;) {
        sum = 0u; cnt = 0u; mine = 0u;
#pragma unroll
        for (unsigned j = 0; j < 16; ++j) { const unsigned c = xb_ld(&bar[XB_XCNT(j)]); sum += c; cnt += (c > 0u) ? 1u : 0u; mine = (j == x) ? c : mine; }
        if (sum == G) break;
        __builtin_amdgcn_s_sleep(1);
        if ((++sp & 255u) == 0u) { if (xb_ld(&bar[XB_TMO])) break; if (sp > XB_SPIN_CAP) { atomicAdd(&bar[XB_TMO], 1u); break; } }
    }
    nloc = mine > 0u ? mine : 1u; nx = cnt > 0u ? cnt : 1u;
}

__device__ __forceinline__ void xcd_barrier(const XcdBarrier& b) {
    asm volatile("s_waitcnt vmcnt(0)" ::: "memory");
    __syncthreads();
    if (threadIdx.x == 0) {
        unsigned* bar = b.bar;
        __builtin_amdgcn_s_waitcnt(0);
        unsigned nloc = b.st[0], nx = b.st[1];
        if (nloc == 0u) { xcd_barrier_complete(bar, b.x, nloc, nx); b.st[0] = nloc; b.st[1] = nx; }
        const unsigned old = xb_add(&bar[XB_XSUB(b.x)], 1u);
        const unsigned gen = old / nloc;
        if (old + 1u == (gen + 1u) * nloc) {
            __builtin_amdgcn_fence(__ATOMIC_RELEASE, "agent");
            asm volatile("s_waitcnt vmcnt(0)" ::: "memory");
            const unsigned og = xb_add(&bar[XB_TOP], 1u);
            const unsigned tg = og / nx;
            if (og + 1u == (tg + 1u) * nx) xb_add(&bar[XB_TOPGEN], 1u);
            else XB_SPIN(xb_ld(&bar[XB_TOPGEN]) == tg, bar);
            __builtin_amdgcn_fence(__ATOMIC_ACQUIRE, "agent");
            xb_add(&bar[XB_XGEN(b.x)], 1u);
            asm volatile("s_waitcnt vmcnt(0)" ::: "memory");
        } else {
            XB_SPIN(xb_ld(&bar[XB_XGEN(b.x)]) == gen, bar);
            __builtin_amdgcn_fence(__ATOMIC_ACQUIRE, "agent");
            asm volatile("s_waitcnt vmcnt(0)" ::: "memory");
        }
    }
    __syncthreads();
}


struct Args { const float* in[23]; float* out; unsigned char* ws; int s_lo, s_hi, probe, pad; };

struct Frame {
    LAS unsigned char* lds; int tid, lane, wave, vcu, G;
    const float* const* in; float* h; unsigned char* ws; int probe;
};

#define LAUNDER(F) do { asm volatile("" : "+v"((F).tid)); (F).lane = (F).tid & 63; asm volatile("" : "+s"((F).G), "+s"((F).vcu)); } while (0)
__device__ __forceinline__ void p0_item(const float* W, int ldw, int k0, int n0, bf16* WT, int Kd, int drow0, float scale, LAS float* scr, int lane) {
#pragma unroll 8
    for (int i = 0; i < 32; ++i) { const int kk = 2 * i + (lane >> 5); scr[kk * 33 + (lane & 31)] = W[(size_t)(k0 + kk) * ldw + n0 + (lane & 31)] * scale; }
    LDS_WAIT(); asm volatile("" ::: "memory");
    const int c = lane & 7;
#pragma unroll
    for (int j = 0; j < 4; ++j) { const int n = (lane >> 3) + 8 * j; const LAS float* s = scr + (8 * c) * 33 + n;
        v4u o; o.x = pk2(s[0 * 33], s[1 * 33]); o.y = pk2(s[2 * 33], s[3 * 33]); o.z = pk2(s[4 * 33], s[5 * 33]); o.w = pk2(s[6 * 33], s[7 * 33]);
        *(v4u*)(WT + (size_t)(drow0 + n) * Kd + k0 + 8 * c) = o; }
    LDS_WAIT(); asm volatile("" ::: "memory");
}
__device__ __forceinline__ bool is_q_col(int n) { return n < 512 || (n >= 768 && n < 3072 && ((n - 768) % 768) < 256) || (n >= 3072 && n < 3584); }

__device__ __forceinline__ void ph_prologue(Frame& F) { LAUNDER(F);
    LAS float* scr = (LAS float*)(F.lds + RING_OFF + F.wave * 16384);
    const int gw = F.vcu * NWAVES + F.wave, NGW = F.G * NWAVES, lane = F.lane;
    const float* w_in = F.in[4]; const float* w_a = F.in[8]; const float* w_b = F.in[9]; const float* w_c = F.in[10]; const float* w_o = F.in[11];
    const float* w_eg = F.in[18]; const float* w_eu = F.in[19]; const float* w_ed = F.in[20];
    bf16* WIN = (bf16*)(F.ws + WS_WIN); bf16* WBRA = (bf16*)(F.ws + WS_WBRA); bf16* WBRB = (bf16*)(F.ws + WS_WBRB); bf16* WBRC = (bf16*)(F.ws + WS_WBRC); bf16* WOUT = (bf16*)(F.ws + WS_WOUT);
    bf16* WGU = (bf16*)(F.ws + WS_WGU); bf16* WD = (bf16*)(F.ws + WS_WD);
    constexpr int I_IN = 16 * (NCOL / 32), I_A = 8 * 32, I_B = 4 * 32, I_C = 8 * 32, I_O = 16 * 32, I_G = 16 * 16, I_D = 8 * 32;
    constexpr int I_LAYER = I_IN + I_A + I_B + I_C + I_O + NE * (2 * I_G + I_D);
    for (int it = gw; it < DEPTH * I_LAYER; it += NGW) {
        const int l = it / I_LAYER; int r = it % I_LAYER;
        if (r < I_IN) { const int nb = r % (NCOL / 32), kb = r / (NCOL / 32); p0_item(w_in + (size_t)l * D * NCOL, NCOL, 64 * kb, 32 * nb, WIN + (size_t)l * NCOL * D, D, 32 * nb, is_q_col(32 * nb) ? QSCALE : 1.0f, scr, lane); continue; } r -= I_IN;
        if (r < I_A) { const int nb = r % 32, kb = r / 32; p0_item(w_a + (size_t)l * 512 * D, D, 64 * kb, 32 * nb, WBRA + (size_t)l * D * 512, 512, 32 * nb, 1.0f, scr, lane); continue; } r -= I_A;
        if (r < I_B) { const int nb = r % 32, kb = r / 32; p0_item(w_b + (size_t)l * 256 * D, D, 64 * kb, 32 * nb, WBRB + (size_t)l * D * 256, 256, 32 * nb, 1.0f, scr, lane); continue; } r -= I_B;
        if (r < I_C) { const int nb = r % 32, kb = r / 32; p0_item(w_c + (size_t)l * 512 * D, D, 64 * kb, 32 * nb, WBRC + (size_t)l * D * 512, 512, 32 * nb, 1.0f, scr, lane); continue; } r -= I_C;
        if (r < I_O) { const int nb = r % 32, kb = r / 32; p0_item(w_o + (size_t)l * D * D, D, 64 * kb, 32 * nb, WOUT + (size_t)l * D * D, D, 32 * nb, 1.0f, scr, lane); continue; } r -= I_O;
        const int e = r / (2 * I_G + I_D); r %= (2 * I_G + I_D); const size_t le = (size_t)l * NE + e;
        if (r < 2 * I_G) { const int up = r / I_G; r %= I_G; const int nb = r % 16, kb = r / 16;
            p0_item((up ? w_eu : w_eg) + le * D * DE, DE, 64 * kb, 32 * nb, WGU + le * 1024 * 1024, D, (nb >> 2) * 256 + up * 128 + (nb & 3) * 32, 1.0f, scr, lane); continue; }
        r -= 2 * I_G; { const int nb = r % 32, kb = r / 32; p0_item(w_ed + le * DE * D, D, 64 * kb, 32 * nb, WD + le * D * DE, DE, 32 * nb, 1.0f, scr, lane); }
    }
}

template <int MODE> __device__ __forceinline__ void ln_row(const float* src, const float* h, float* hout, bf16* hb, const bf16* yb, const float* g, const float* bta, size_t row, int lane, f32x4 (&o)[4]) {
    f32x4 v[4];
#pragma unroll
    for (int j = 0; j < 4; ++j) {
        const int c = lane * 4 + 256 * j;
        v[j] = *(const f32x4*)((MODE == 0 ? src : h) + row * D + c);
        if (MODE == 2) {
            const uint2 a = *(const uint2*)(yb + (row * 2) * D + c), b = *(const uint2*)(yb + (row * 2 + 1) * D + c);
            v[j].x = ALPHA * v[j].x + bf2f((bf16)(a.x & 0xffff)) + bf2f((bf16)(b.x & 0xffff));
            v[j].y = ALPHA * v[j].y + bf2f((bf16)(a.x >> 16)) + bf2f((bf16)(b.x >> 16));
            v[j].z = ALPHA * v[j].z + bf2f((bf16)(a.y & 0xffff)) + bf2f((bf16)(b.y & 0xffff));
            v[j].w = ALPHA * v[j].w + bf2f((bf16)(a.y >> 16)) + bf2f((bf16)(b.y >> 16));
        }
    }
    float s = 0.f;
#pragma unroll
    for (int j = 0; j < 4; ++j) s += (v[j].x + v[j].y) + (v[j].z + v[j].w);
    const float mean = wave_sum(s) * (1.f / D);
    float q = 0.f;
#pragma unroll
    for (int j = 0; j < 4; ++j) { v[j] = v[j] - mean; q += (v[j].x * v[j].x + v[j].y * v[j].y) + (v[j].z * v[j].z + v[j].w * v[j].w); }
    const float rstd = 1.0f / sqrtf(wave_sum(q) * (1.f / D) + LN_EPS);
#pragma unroll
    for (int j = 0; j < 4; ++j) {
        const int c = lane * 4 + 256 * j;
        const f32x4 gg = *(const f32x4*)(g + c), bb = *(const f32x4*)(bta + c);
        o[j] = v[j] * rstd * gg + bb;
        *(f32x4*)(hout + row * D + c) = o[j];
        if (hb) { uint2 w; w.x = pk2(o[j].x, o[j].y); w.y = pk2(o[j].z, o[j].w); *(uint2*)(hb + row * D + c) = w; }
    }
}

struct EpiP1 {
    static constexpr bool PERM = true;
    bf16* qkv; bf16* gates; const float* b_gate;
    __device__ __forceinline__ void operator()(const f32x4 (&acc)[2][2][4][2], const pg8::Unit& u, int wr, int wc, int fr, int fq) const {
        const int row0 = u.pm * 256 + wr * 64 + fr; const bool isg = u.pn >= 18;
        bf16* base = isg ? gates : qkv; const int ldc = isg ? GATEW : QKVW; const int col0 = (isg ? (u.pn - 18) : u.pn) * 256 + wc * 32 + 8 * fq;
        f32x4 bv[2][2];
#pragma unroll
        for (int bj = 0; bj < 2; ++bj)
#pragma unroll
            for (int n = 0; n < 2; ++n) bv[bj][n] = isg ? *(const f32x4*)(b_gate + col0 + bj * 128 + 4 * n) : (f32x4){0.f, 0.f, 0.f, 0.f};
#pragma unroll
        for (int ai = 0; ai < 2; ++ai)
#pragma unroll
            for (int m = 0; m < 4; ++m) { bf16* rowp = base + (size_t)(row0 + ai * 128 + m * 16) * ldc + col0;
#pragma unroll
                for (int bj = 0; bj < 2; ++bj) { f32x4 v0 = acc[ai][bj][m][0] + bv[bj][0], v1 = acc[ai][bj][m][1] + bv[bj][1];
                    if (isg) {
#pragma unroll
                        for (int j = 0; j < 4; ++j) { v0[j] = __builtin_amdgcn_rcpf(1.0f + __builtin_amdgcn_exp2f(-LOG2E * v0[j])); v1[j] = __builtin_amdgcn_rcpf(1.0f + __builtin_amdgcn_exp2f(-LOG2E * v1[j])); } }
                    v4u w; w.x = pg8::cvt_pk_bf16(v0[0], v0[1]); w.y = pg8::cvt_pk_bf16(v0[2], v0[3]); w.z = pg8::cvt_pk_bf16(v1[0], v1[1]); w.w = pg8::cvt_pk_bf16(v1[2], v1[3]);
                    *(v4u*)(rowp + bj * 128) = w; } }
    }
};
template <bool FIRST> struct EpiP3 {
    static constexpr bool PERM = true;
    bf16* merged; const bf16* gates; int br;
    __device__ __forceinline__ void operator()(const f32x4 (&acc)[2][2][4][2], const pg8::Unit& u, int wr, int wc, int fr, int fq) const {
        const int row0 = u.pm * 256 + wr * 64 + fr, col0 = u.pn * 256 + wc * 32 + 8 * fq;
#pragma unroll
        for (int ai = 0; ai < 2; ++ai) {
            v4u gw[4][2], ow[4][2];
#pragma unroll
            for (int m = 0; m < 4; ++m)
#pragma unroll
                for (int bj = 0; bj < 2; ++bj) { const size_t row = (size_t)(row0 + ai * 128 + m * 16);
                    gw[m][bj] = *(const v4u*)(gates + row * GATEW + br * 1024 + col0 + bj * 128);
                    ow[m][bj] = FIRST ? (v4u){0u, 0u, 0u, 0u} : *(const v4u*)(merged + row * D + col0 + bj * 128); }
#pragma unroll
            for (int m = 0; m < 4; ++m)
#pragma unroll
                for (int bj = 0; bj < 2; ++bj) { const size_t row = (size_t)(row0 + ai * 128 + m * 16);
                    const f32x4 a0 = acc[ai][bj][m][0], a1 = acc[ai][bj][m][1];
                    float r[8];
#pragma unroll
                    for (int j = 0; j < 4; ++j) { const unsigned g2 = gw[m][bj][j], o2 = ow[m][bj][j]; const float av0 = j < 2 ? a0[2 * j] : a1[2 * j - 4], av1 = j < 2 ? a0[2 * j + 1] : a1[2 * j - 3];
                        r[2 * j] = __uint_as_float(g2 << 16) * av0 + (FIRST ? 0.f : __uint_as_float(o2 << 16)); r[2 * j + 1] = __uint_as_float(g2 & 0xffff0000u) * av1 + (FIRST ? 0.f : __uint_as_float(o2 & 0xffff0000u)); }
                    v4u w; w.x = pg8::cvt_pk_bf16(r[0], r[1]); w.y = pg8::cvt_pk_bf16(r[2], r[3]); w.z = pg8::cvt_pk_bf16(r[4], r[5]); w.w = pg8::cvt_pk_bf16(r[6], r[7]);
                    *(v4u*)(merged + row * D + col0 + bj * 128) = w; }
            asm volatile("" ::: "memory"); }
    }
};
struct EpiP4 {
    static constexpr bool PERM = false;
    const float* hc; float* ho;
    __device__ __forceinline__ void operator()(const f32x4 (&acc)[2][2][4][2], const pg8::Unit& u, int wr, int wc, int fr, int fq) const {
        const int row0 = u.pm * 256 + wr * 64 + fr, col0 = u.pn * 256 + wc * 32 + 4 * fq;
#pragma unroll
        for (int ai = 0; ai < 2; ++ai)
#pragma unroll
            for (int mp = 0; mp < 2; ++mp) { f32x4 hv[2][2][2];
#pragma unroll
                for (int mm = 0; mm < 2; ++mm)
#pragma unroll
                    for (int bj = 0; bj < 2; ++bj)
#pragma unroll
                        for (int n = 0; n < 2; ++n) hv[mm][bj][n] = *(const f32x4*)(hc + (size_t)(row0 + ai * 128 + (2 * mp + mm) * 16) * D + col0 + bj * 128 + n * 16);
#pragma unroll
                for (int mm = 0; mm < 2; ++mm)
#pragma unroll
                    for (int bj = 0; bj < 2; ++bj)
#pragma unroll
                        for (int n = 0; n < 2; ++n) *(f32x4*)(ho + (size_t)(row0 + ai * 128 + (2 * mp + mm) * 16) * D + col0 + bj * 128 + n * 16) = hv[mm][bj][n] * ALPHA + acc[ai][bj][2 * mp + mm][n];
                asm volatile("" ::: "memory"); }
    }
};
struct EpiP7 {
    static constexpr bool PERM = true;
    bf16* hid;
    __device__ __forceinline__ void operator()(const f32x4 (&acc)[2][2][4][2], const pg8::Unit& u, int wr, int wc, int fr, int fq) const {
        const int row0 = u.pm * 256 + wr * 64 + fr, col0 = u.pn * 128 + wc * 32 + 8 * fq;
#pragma unroll
        for (int ai = 0; ai < 2; ++ai)
#pragma unroll
            for (int m = 0; m < 4; ++m) { float r[8];
#pragma unroll
                for (int n = 0; n < 2; ++n)
#pragma unroll
                    for (int j = 0; j < 4; ++j) { const float gv = acc[ai][0][m][n][j], uv = acc[ai][1][m][n][j]; r[4 * n + j] = gv * __builtin_amdgcn_rcpf(1.0f + __builtin_amdgcn_exp2f(-LOG2E * gv)) * uv; }
                v4u w; w.x = pg8::cvt_pk_bf16(r[0], r[1]); w.y = pg8::cvt_pk_bf16(r[2], r[3]); w.z = pg8::cvt_pk_bf16(r[4], r[5]); w.w = pg8::cvt_pk_bf16(r[6], r[7]);
                *(v4u*)(hid + (size_t)(row0 + ai * 128 + m * 16) * DE + col0) = w; }
    }
};
struct EpiP8 {
    static constexpr bool PERM = true;
    bf16* yb; const int* rowtok; const float* rowgate;
    __device__ __forceinline__ void operator()(const f32x4 (&acc)[2][2][4][2], const pg8::Unit& u, int wr, int wc, int fr, int fq) const {
        const int row0 = u.pm * 256 + wr * 64 + fr, col0 = u.pn * 256 + wc * 32 + 8 * fq;
        int rt[2][4]; float gt[2][4];
#pragma unroll
        for (int ai = 0; ai < 2; ++ai)
#pragma unroll
            for (int m = 0; m < 4; ++m) { const int row = row0 + ai * 128 + m * 16; rt[ai][m] = rowtok[row]; gt[ai][m] = rowgate[row]; }
#pragma unroll
        for (int ai = 0; ai < 2; ++ai)
#pragma unroll
            for (int m = 0; m < 4; ++m) {
                if (rt[ai][m] >= 0) {
#pragma unroll
                    for (int bj = 0; bj < 2; ++bj) { const f32x4 v0 = acc[ai][bj][m][0] * gt[ai][m], v1 = acc[ai][bj][m][1] * gt[ai][m];
                        v4u w; w.x = pg8::cvt_pk_bf16(v0[0], v0[1]); w.y = pg8::cvt_pk_bf16(v0[2], v0[3]); w.z = pg8::cvt_pk_bf16(v1[0], v1[1]); w.w = pg8::cvt_pk_bf16(v1[2], v1[3]);
                        *(v4u*)(yb + (size_t)rt[ai][m] * D + col0 + bj * 128) = w; } } }
    }
};

__device__ __forceinline__ void router_row(const float (&x)[16], int t, int lane, const LAS float* w_rg, const float* b_rg, const LAS float* w_re, const float* b_re, int* cnt, Rec* rec) {
    float gl[4] = {0.f, 0.f, 0.f, 0.f};
#pragma unroll
    for (int j = 0; j < 4; ++j)
#pragma unroll
        for (int i = 0; i < 4; ++i) { const f32x4 w = *(const LAS f32x4*)(w_rg + ((j * 4 + i) * 64 + lane) * 4); const float xv = x[4 * j + i]; gl[0] += xv * w.x; gl[1] += xv * w.y; gl[2] += xv * w.z; gl[3] += xv * w.w; }
#pragma unroll
    for (int g = 0; g < 4; ++g) gl[g] = wave_sum(gl[g]) + b_rg[g];
    int gi = 0; float gm = gl[0];
#pragma unroll
    for (int g = 1; g < 4; ++g) if (gl[g] > gm) { gm = gl[g]; gi = g; }
    float gs = 0.f;
#pragma unroll
    for (int g = 0; g < 4; ++g) gs += __expf(gl[g] - gm);
    const float gw = 1.0f / gs;
    float el[8];
#pragma unroll
    for (int e = 0; e < 8; ++e) el[e] = 0.f;
    const LAS float* wre = w_re + gi * (D * 8);
#pragma unroll
    for (int j = 0; j < 4; ++j)
#pragma unroll
        for (int i = 0; i < 4; ++i) { const LAS float* wp = wre + ((j * 4 + i) * 128 + lane) * 4; const f32x4 w0 = *(const LAS f32x4*)wp, w1 = *(const LAS f32x4*)(wp + 256); const float xv = x[4 * j + i];
            el[0] += xv * w0.x; el[1] += xv * w0.y; el[2] += xv * w0.z; el[3] += xv * w0.w; el[4] += xv * w1.x; el[5] += xv * w1.y; el[6] += xv * w1.z; el[7] += xv * w1.w; }
#pragma unroll
    for (int e = 0; e < 8; ++e) el[e] = wave_sum(el[e]) + b_re[gi * 8 + e];
    int i0 = 0; float t0 = el[0];
#pragma unroll
    for (int e = 1; e < 8; ++e) if (el[e] > t0) { t0 = el[e]; i0 = e; }
    int i1 = -1; float t1 = -3.0e38f;
#pragma unroll
    for (int e = 0; e < 8; ++e) if (e != i0 && el[e] > t1) { t1 = el[e]; i1 = e; }
    const float ex = __expf(t1 - t0), p0 = 1.0f / (1.0f + ex), p1 = ex / (1.0f + ex);
    if (lane == 0) {
        Rec rc; rc.e0 = gi * 8 + i0; rc.e1 = gi * 8 + i1; rc.g0 = gw * p0; rc.g1 = gw * p1; rc.pad0 = 0; rc.pad1 = 0;
        rc.s0 = atomicAdd(cnt + rc.e0 * CSTR, 1); rc.s1 = atomicAdd(cnt + rc.e1 * CSTR, 1);
        rec[t] = rc;
    }
}

__device__ __forceinline__ void ph_ln0(Frame& F) { LAUNDER(F);
    const int gw = F.vcu * NWAVES + F.wave, NGW = F.G * NWAVES;
    bf16* hb = (bf16*)(F.ws + WS_HB);
    for (int m = gw; m < T; m += NGW) { f32x4 o[4]; ln_row<0>(F.in[0], F.h, F.h, hb, nullptr, F.in[1], F.in[2], (size_t)m, F.lane, o); }
}
__device__ __forceinline__ void ph_p1(Frame& F, int l, int c) { LAUNDER(F);
    pg8::DenseOrder S; S.init((const bf16*)(F.ws + WS_HB) + (size_t)c * CH * D, D, (const bf16*)(F.ws + WS_WIN) + (size_t)l * NCOL * D, D, CH, NCOL, F.G, (int)blockIdx.x);
    EpiP1 E{(bf16*)(F.ws + WS_QKV), (bf16*)(F.ws + WS_GATES), F.in[5] + (size_t)l * GATEW};
    pg8::gemm_phase<EpiP1, pg8::DenseOrder, false>(F.lds + RING_OFF, S, E, D, D, D);
}
__device__ __forceinline__ void ph_cmb(Frame& F) { LAUNDER(F);
    const bf16* og = (const bf16*)(F.ws + WS_OG); const float* lse = (const float*)(F.ws + WS_LSE); bf16* oabc = (bf16*)(F.ws + WS_OABC);
    for (int idx = F.vcu * NTHREADS + F.tid; idx < CH * 32; idx += F.G * NTHREADS) {
        const int tl = idx >> 5, hc = idx & 31, h = hc >> 3, c = hc & 7;
        const float l0 = lse[((size_t)tl * 3 + 0) * 4 + h], l1 = lse[((size_t)tl * 3 + 1) * 4 + h], l2 = lse[((size_t)tl * 3 + 2) * 4 + h];
        const float mx = fmaxf(l0, fmaxf(l1, l2)); float w0 = __expf(l0 - mx), w1 = __expf(l1 - mx), w2 = __expf(l2 - mx); const float inv = 1.0f / (w0 + w1 + w2); w0 *= inv; w1 *= inv; w2 *= inv;
        const v4u a = *(const v4u*)(og + ((size_t)tl * 3 + 0) * 256 + h * 64 + c * 8), b = *(const v4u*)(og + ((size_t)tl * 3 + 1) * 256 + h * 64 + c * 8), d = *(const v4u*)(og + ((size_t)tl * 3 + 2) * 256 + h * 64 + c * 8);
        v4u ow;
#pragma unroll
        for (int i = 0; i < 4; ++i) {
            const float lo = w0 * __uint_as_float(a[i] << 16) + w1 * __uint_as_float(b[i] << 16) + w2 * __uint_as_float(d[i] << 16);
            const float hi = w0 * __uint_as_float(a[i] & 0xffff0000u) + w1 * __uint_as_float(b[i] & 0xffff0000u) + w2 * __uint_as_float(d[i] & 0xffff0000u);
            ow[i] = pk2(lo, hi);
        }
        *(v4u*)(oabc + (size_t)tl * OW + 512 + h * 64 + c * 8) = ow;
    }
}
__device__ __forceinline__ void ph_p3(Frame& F, int l) { LAUNDER(F);
    const bf16* oabc = (const bf16*)(F.ws + WS_OABC); bf16* merged = (bf16*)(F.ws + WS_MERGED); const bf16* gates = (const bf16*)(F.ws + WS_GATES);
    { pg8::DenseOrder S; S.init(oabc, OW, (const bf16*)(F.ws + WS_WBRA) + (size_t)l * D * 512, 512, CH, D, F.G, (int)blockIdx.x);
      EpiP3<true> E{merged, gates, 0}; pg8::gemm_phase<EpiP3<true>, pg8::DenseOrder, false>(F.lds + RING_OFF, S, E, 512, OW, 512); }
    { pg8::DenseOrder S; S.init(oabc + 512, OW, (const bf16*)(F.ws + WS_WBRB) + (size_t)l * D * 256, 256, CH, D, F.G, (int)blockIdx.x);
      EpiP3<false> E{merged, gates, 1}; pg8::gemm_phase<EpiP3<false>, pg8::DenseOrder, false>(F.lds + RING_OFF, S, E, 256, OW, 256); }
    { pg8::DenseOrder S; S.init(oabc + 768, OW, (const bf16*)(F.ws + WS_WBRC) + (size_t)l * D * 512, 512, CH, D, F.G, (int)blockIdx.x);
      EpiP3<false> E{merged, gates, 2}; pg8::gemm_phase<EpiP3<false>, pg8::DenseOrder, false>(F.lds + RING_OFF, S, E, 512, OW, 512); }
}
__device__ __forceinline__ void ph_p4(Frame& F, int l, int c) { LAUNDER(F);
    pg8::DenseOrder S; S.init((const bf16*)(F.ws + WS_MERGED), D, (const bf16*)(F.ws + WS_WOUT) + (size_t)l * D * D, D, CH, D, F.G, (int)blockIdx.x);
    EpiP4 E{F.h + (size_t)c * CH * D, F.probe ? (float*)(F.ws + WS_OABC) : F.h + (size_t)c * CH * D};
    pg8::gemm_phase<EpiP4, pg8::DenseOrder, false>(F.lds + RING_OFF, S, E, D, D, D);
}
__device__ __forceinline__ void ph_ln1(Frame& F, int l, int c) { LAUNDER(F);
    const int gw = F.vcu * NWAVES + F.wave, NGW = F.G * NWAVES;
    bf16* hb = (bf16*)(F.ws + WS_HB); int* cnt = (int*)(F.ws + WS_CTL) + CW_CNT + l * (32 * CSTR); Rec* rec = (Rec*)(F.ws + WS_REC);
    float* hout = F.h;
    if (F.probe) { hout = (float*)(F.ws + WS_OABC) - (size_t)c * CH * D; hb = (bf16*)(F.ws + WS_QKV) - (size_t)c * CH * D; cnt = (int*)(F.ws + WS_CTL) + 8192 + l * 1024; rec = (Rec*)(F.ws + WS_GATES); }
    LAS float* lrg = (LAS float*)(F.lds + RING_OFF); LAS float* lre = lrg + D * 4;
    { const float* w_rg = F.in[14] + (size_t)l * D * 4; const float* w_re = F.in[16] + (size_t)l * 4 * D * 8;
      for (int u = F.tid; u < D + 4 * D * 2; u += NTHREADS) {
          if (u < D) { const int e = u, ln = (e & 255) >> 2, i = e & 3, j = e >> 8; *(LAS f32x4*)(lrg + ((j * 4 + i) * 64 + ln) * 4) = *(const f32x4*)(w_rg + (size_t)e * 4); }
          else { const int v = u - D, half = v & 1, e = (v >> 1) & 1023, g = v >> 11, ln = (e & 255) >> 2, i = e & 3, j = e >> 8;
                 *(LAS f32x4*)(lre + g * (D * 8) + (((j * 4 + i) * 2 + half) * 64 + ln) * 4) = *(const f32x4*)(w_re + ((size_t)g * D + e) * 8 + half * 4); } }
      __syncthreads(); }
    for (int m = gw; m < CH; m += NGW) {
        const size_t row = (size_t)c * CH + m; f32x4 o[4];
        ln_row<1>(nullptr, F.h, hout, hb, nullptr, F.in[12] + l * D, F.in[13] + l * D, row, F.lane, o);
        float x[16];
#pragma unroll
        for (int j = 0; j < 4; ++j) { x[4 * j] = o[j].x; x[4 * j + 1] = o[j].y; x[4 * j + 2] = o[j].z; x[4 * j + 3] = o[j].w; }
        router_row(x, (int)row, F.lane, lrg, F.in[15] + l * 4, lre, F.in[17] + l * 32, cnt, rec);
    }
    __syncthreads();
}
__device__ __forceinline__ void ph_dsp(Frame& F, int l) { LAUNDER(F);
    LAS int* po = (LAS int*)(F.lds + ROWS_OFF);
    const int* cnt = (const int*)(F.ws + WS_CTL) + CW_CNT + l * (32 * CSTR); const Rec* rec = (const Rec*)(F.ws + WS_REC); int* rowtok = (int*)(F.ws + WS_ROWTOK); float* rowgate = (float*)(F.ws + WS_ROWGATE);
    if (F.tid == 0) { int acc = 0; for (int e = 0; e < NE; ++e) { po[e] = acc; acc += (cnt[e * CSTR] + 255) / 256 * 256; } po[NE] = acc; }
    __syncthreads();
    const int gt = F.vcu * NTHREADS + F.tid, GT = F.G * NTHREADS;
    for (int t = gt; t < T; t += GT) {
        const Rec rc = rec[t];
        const int d0 = po[rc.e0] + rc.s0, d1 = po[rc.e1] + rc.s1;
        rowtok[d0] = 2 * t; rowgate[d0] = rc.g0; rowtok[d1] = 2 * t + 1; rowgate[d1] = rc.g1;
    }
    for (int e = 0; e < NE; ++e) for (int r = po[e] + cnt[e * CSTR] + gt; r < po[e + 1]; r += GT) { rowtok[r] = -1; rowgate[r] = 0.f; }
    __syncthreads();
}
__device__ __forceinline__ int moe_setup(Frame& F, int l, bool gather) { LAUNDER(F);
    LAS int* rows = (LAS int*)(F.lds + ROWS_OFF); LAS int* ulist = rows + 11 * 256; LAS int* po = ulist + 16;
    const int* cnt = (const int*)(F.ws + WS_CTL) + CW_CNT + l * (32 * CSTR); const int* rowtok = (const int*)(F.ws + WS_ROWTOK);
    if (F.tid == 0) { int acc = 0; for (int e = 0; e < NE; ++e) { po[e] = acc; acc += (cnt[e * CSTR] + 255) / 256 * 256; } po[NE] = acc; }
    __syncthreads();
    const int nu_all = (po[NE] / 256) * 4; int nun = (nu_all - F.vcu + F.G - 1) / F.G; nun = nun < 0 ? 0 : (nun > 11 ? 11 : nun);
    if (F.tid < nun) { const int Lx = F.tid * F.G + F.vcu, rt = Lx >> 2, pn = Lx & 3; int e = 0; while (e < NE - 1 && po[e + 1] <= rt * 256) ++e; ulist[F.tid] = (rt << 8) | (e << 2) | pn; }
    if (gather) for (int idx = F.tid; idx < nun * 256; idx += NTHREADS) { const int i = idx >> 8, r = idx & 255, Lx = i * F.G + F.vcu; rows[idx] = rowtok[(Lx >> 2) * 256 + r]; }
    __syncthreads();
    return nun;
}
struct MoeOrder {
    int nun; const LAS int* ulist; const LAS int* rows; const char* A; const char* B; size_t tstepA, estepB, tstepB;
    __device__ __forceinline__ bool next(int i, pg8::Unit& u) const {
        if (i >= nun) return false;
        const int w = __builtin_amdgcn_readfirstlane(ulist[i]); u.pm = w >> 8; u.e = (w >> 2) & 63; u.pn = w & 3; u.ui = i; return true;
    }
    __device__ __forceinline__ const char* a_base(const pg8::Unit& u) const { return A + (size_t)u.pm * tstepA; }
    __device__ __forceinline__ const char* b_base(const pg8::Unit& u) const { return B + (size_t)u.e * estepB + (size_t)u.pn * tstepB; }
    __device__ __forceinline__ int a_row(const pg8::Unit& u, int r) const { const int t = rows[u.ui * 256 + r]; return t < 0 ? 0 : (t >> 1); }
};
__device__ __forceinline__ void ph_p7(Frame& F, int l) { LAUNDER(F);
    const int nun = moe_setup(F, l, true);
    LAS int* rows = (LAS int*)(F.lds + ROWS_OFF);
    MoeOrder S{nun, rows + 11 * 256, rows, (const char*)(F.ws + WS_HB), (const char*)(F.ws + WS_WGU) + (size_t)l * NE * 1024 * 1024 * 2, 0, (size_t)1024 * 1024 * 2, (size_t)256 * 1024 * 2};
    EpiP7 E{(bf16*)(F.ws + WS_HID)};
    pg8::gemm_phase<EpiP7, MoeOrder, true>(F.lds + RING_OFF, S, E, D, D, D);
}
__device__ __forceinline__ void ph_p8(Frame& F, int l) { LAUNDER(F);
    const int nun = moe_setup(F, l, false);
    LAS int* rows = (LAS int*)(F.lds + ROWS_OFF);
    MoeOrder S{nun, rows + 11 * 256, rows, (const char*)(F.ws + WS_HID), (const char*)(F.ws + WS_WD) + (size_t)l * NE * 1024 * 512 * 2, (size_t)256 * DE * 2, (size_t)1024 * 512 * 2, (size_t)256 * 512 * 2};
    EpiP8 E{(bf16*)(F.ws + WS_YB), (const int*)(F.ws + WS_ROWTOK), (const float*)(F.ws + WS_ROWGATE)};
    pg8::gemm_phase<EpiP8, MoeOrder, false>(F.lds + RING_OFF, S, E, DE, DE, DE);
}
__device__ __forceinline__ void ph_ln2(Frame& F, int l) { LAUNDER(F);
    const int gw = F.vcu * NWAVES + F.wave, NGW = F.G * NWAVES;
    bf16* hb = (l == DEPTH - 1) ? nullptr : (bf16*)(F.ws + WS_HB);
    if (F.probe) { for (int m = gw; m < T; m += NGW) { f32x4 o[4]; ln_row<2>(nullptr, F.h, (float*)(F.ws + WS_OABC) - (size_t)(m & ~32767) * D, nullptr, (const bf16*)(F.ws + WS_YB), F.in[21] + l * D, F.in[22] + l * D, (size_t)m, F.lane, o); } return; }
    for (int m = gw; m < T; m += NGW) { f32x4 o[4]; ln_row<2>(nullptr, F.h, F.h, hb, (const bf16*)(F.ws + WS_YB), F.in[21] + l * D, F.in[22] + l * D, (size_t)m, F.lane, o); }
}

typedef short s16x4 __attribute__((ext_vector_type(4)));
constexpr int NT_A = (CH / 32) * 4, NT_B = (CH / L) * 3 * 128 * 4, NT_C = (CH / 64) * 8, NT_ALL = NT_A + NT_B + NT_C;
constexpr float NEGBIG = -1.0e30f, MINIT = -5.0e29f;
#define RC16(reg) (((reg) & 3) + 8 * ((reg) >> 2))

__device__ __forceinline__ void ph_tables(Frame& F) { LAUNDER(F);
    float* TA = (float*)(F.ws + WS_TABA); float* TB = (float*)(F.ws + WS_TABB); float* TC = (float*)(F.ws + WS_TABC);
    const float* rel_bias = F.in[3]; const float* rpb = F.in[7];
    const int gt = F.vcu * NTHREADS + F.tid, GT = F.G * NTHREADS;
    for (int i = gt; i < 8 * 320; i += GT) { const int h = i / 320, rel = i % 320 - 160; TA[i] = (rel >= -128 && rel <= 128) ? rel_bias[BUCK_A[rel + 128] * 20 + h] * LOG2E : NEGBIG; }
    for (int i = gt; i < 12 * 256; i += GT) { const int gh = i >> 8, g = gh >> 2, rel = (i & 255) - 128; TB[i] = (rel >= -64 && rel <= 64) ? rel_bias[BUCK_B[g][rel + 64] * 20 + 8 + gh] * LOG2E : NEGBIG; }
    for (int i = gt; i < DEPTH * 8 * 1024; i += GT) { const int lh = i >> 10, ri = (i >> 6) & 15, ci = (i & 63) - 16; TC[i] = (ri < 15 && ci >= 0 && ci <= 30) ? rpb[((size_t)lh * 15 + ri) * 31 + ci] * LOG2E : NEGBIG; }
}

#define ATT_SOFTMAX(S, m, l, Oa, Ob, TBP, BIDX, XM) do { \
        float tmax_ = NEGBIG; \
        _Pragma("unroll") for (int r_ = 0; r_ < 16; ++r_) { float v_ = S[r_] + (TBP)[(BIDX) + RC16(r_)]; if (TYPE == 2) v_ = ((unsigned)((XM) + RC16(r_)) < 16u) ? v_ : NEGBIG; S[r_] = v_; tmax_ = fmaxf(tmax_, v_); } \
        tmax_ = fmaxf(tmax_, __shfl_xor(tmax_, 32)); \
        const float mn_ = fmaxf(m, tmax_), corr_ = __builtin_amdgcn_exp2f(m - mn_); \
        float rsum_ = 0.f; \
        _Pragma("unroll") for (int r_ = 0; r_ < 16; ++r_) { const float p_ = __builtin_amdgcn_exp2f(S[r_] - mn_); S[r_] = p_; rsum_ += p_; } \
        rsum_ += __shfl_xor(rsum_, 32); \
        l = l * corr_ + rsum_; m = mn_; \
        _Pragma("unroll") for (int i_ = 0; i_ < 16; ++i_) { Oa[i_] *= corr_; Ob[i_] *= corr_; } \
    } while (0)
#define ATT_PACK(Pf, S, s2) do { unsigned pw_[4]; _Pragma("unroll") for (int j_ = 0; j_ < 4; ++j_) pw_[j_] = pg8::cvt_pk_bf16(S[8 * (s2) + 2 * j_], S[8 * (s2) + 2 * j_ + 1]); \
        Pf = __builtin_bit_cast(bf16x8, (v4u){pw_[0], pw_[1], pw_[2], pw_[3]}); } while (0)
#define ATT_STORE(orow, Oa, Ob, l) do { const float inv_ = 1.0f / (l); \
        _Pragma("unroll") for (int g_ = 0; g_ < 4; ++g_) { v2u w0_, w1_; \
            w0_.x = pg8::cvt_pk_bf16(Oa[4 * g_] * inv_, Oa[4 * g_ + 1] * inv_); w0_.y = pg8::cvt_pk_bf16(Oa[4 * g_ + 2] * inv_, Oa[4 * g_ + 3] * inv_); \
            w1_.x = pg8::cvt_pk_bf16(Ob[4 * g_] * inv_, Ob[4 * g_ + 1] * inv_); w1_.y = pg8::cvt_pk_bf16(Ob[4 * g_ + 2] * inv_, Ob[4 * g_ + 3] * inv_); \
            *(v2u*)((orow) + 8 * g_ + 4 * hh) = w0_; *(v2u*)((orow) + 32 + 8 * g_ + 4 * hh) = w1_; } } while (0)

template <int TYPE>
__device__ __forceinline__ void att_task2(LAS unsigned char* wl, const int lane, const bf16* seq  , const float* tab0, const float* tab1,
                                          const int qcol0, const int qcol1, const int kcol, const int vcol, const int TT0, const int TSTEP, const int kstride, const int tlo, const int thi,
                                          const int tq0, const int tq1  , const int toff1  ,
                                          const int gi0, const int gi1, const int gc, const int cbs  ,
                                          const float m_init0, const float m_init1, const float l_init, bf16* orow0, bf16* orow1, float* lse0, float* lse1) {
    const int qi = lane & 31, hh = lane >> 5;
    LAS unsigned char* kt = wl; LAS unsigned char* vt = wl + 4096; LAS float* tb0 = (LAS float*)(wl + 8192); LAS float* tb1 = (TYPE == 0) ? tb0 + 320 : tb0;
    constexpr int TBN = TYPE == 0 ? 320 : (TYPE == 1 ? 256 : 1024);
#pragma unroll
    for (int i = 0; i < TBN / 64; ++i) { tb0[lane + 64 * i] = tab0[lane + 64 * i]; if (TYPE == 0) tb1[lane + 64 * i] = tab1[lane + 64 * i]; }
    bf16x8 Qa[4], Qb[4];
#pragma unroll
    for (int s = 0; s < 4; ++s) { Qa[s] = *(const bf16x8*)(seq + (size_t)tq0 * QKVW + qcol0 + 16 * s + 8 * hh); Qb[s] = *(const bf16x8*)(seq + (size_t)tq1 * QKVW + qcol1 + 16 * s + 8 * hh); }
    f32x16 O0a, O0b, O1a, O1b;
#pragma unroll
    for (int i = 0; i < 16; ++i) { O0a[i] = 0.f; O0b[i] = 0.f; O1a[i] = 0.f; O1b[i] = 0.f; }
    float m0 = m_init0, m1 = m_init1, l0 = l_init, l1 = l_init;
    const int lkey = lane >> 3, lch = lane & 7;
    const bf16* gk = seq + (size_t)(lkey * kstride) * QKVW + 8 * lch;
    const size_t istep = (size_t)8 * kstride * QKVW;
    unsigned kwoff[4], vwoff[4];
#pragma unroll
    for (int i = 0; i < 4; ++i) { const int key = lkey + 8 * i; kwoff[i] = key * 128 + ((lch ^ (key & 7)) << 4); vwoff[i] = key * 128 + (((lch >> 2) ^ ((key >> 1) & 1)) << 6) + ((lch & 3) << 4); }
    unsigned kroff[4];
#pragma unroll
    for (int s = 0; s < 4; ++s) kroff[s] = qi * 128 + (((2 * s + hh) ^ (qi & 7)) << 4);
    const int q4 = (lane & 15) >> 2, p4 = lane & 3, g1 = (lane >> 4) & 1, sw = (q4 >> 1) & 1;
    const unsigned vr0 = (4 * hh + q4) * 128 + 32 * g1 + 8 * p4 + (sw << 6), vr1 = (4 * hh + q4) * 128 + 32 * g1 + 8 * p4 + ((sw ^ 1) << 6);
    const int bidx0 = (TYPE == 2) ? (cbs - gc + 31 + 4 * hh) : ((TYPE == 1 ? 64 : 32) - qi + 4 * hh);
    int cs = gc - 8; cs = cs < 0 ? 0 : (cs > 48 ? 48 : cs);
    const int xm = cbs - cs + 4 * hh;
    int rs0 = gi0 - 4; rs0 = rs0 < 0 ? 0 : (rs0 > 120 ? 120 : rs0);
    int rs1 = gi1 - 4; rs1 = rs1 < 0 ? 0 : (rs1 > 120 ? 120 : rs1);
    v4u kreg[4], vreg[4];
    {
        const bf16* gt0 = gk + (size_t)(TT0 + tlo * TSTEP) * QKVW;
#pragma unroll
        for (int i = 0; i < 4; ++i) { kreg[i] = *(const v4u*)(gt0 + i * istep + kcol); vreg[i] = *(const v4u*)(gt0 + i * istep + vcol); }
    }
    for (int ti = tlo; ti <= thi; ++ti) {
#pragma unroll
        for (int i = 0; i < 4; ++i) { *(LAS v4u*)(kt + kwoff[i]) = kreg[i]; *(LAS v4u*)(vt + vwoff[i]) = vreg[i]; }
        if (ti < thi) {
            const bf16* gt0 = gk + (size_t)(TT0 + (ti + 1) * TSTEP) * QKVW;
#pragma unroll
            for (int i = 0; i < 4; ++i) { kreg[i] = *(const v4u*)(gt0 + i * istep + kcol); vreg[i] = *(const v4u*)(gt0 + i * istep + vcol); }
        }
        f32x16 S0, S1;
#pragma unroll
        for (int i = 0; i < 16; ++i) { S0[i] = 0.f; S1[i] = 0.f; }
#pragma unroll
        for (int s = 0; s < 4; ++s) { const bf16x8 Kf = *(const LAS bf16x8*)(kt + kroff[s]);
            S0 = __builtin_amdgcn_mfma_f32_32x32x16_bf16(Kf, Qa[s], S0, 0, 0, 0); S1 = __builtin_amdgcn_mfma_f32_32x32x16_bf16(Kf, Qb[s], S1, 0, 0, 0); }
        int bi0, bi1;
        if (TYPE == 2) { const bool rv0 = (ti >= rs0) && (ti < rs0 + 8), rv1 = (ti >= rs1) && (ti < rs1 + 8); bi0 = bidx0 + (rv0 ? (ti - gi0 + 7) : 15) * 64; bi1 = bidx0 + (rv1 ? (ti - gi1 + 7) : 15) * 64; }
        else { bi0 = bidx0 + 32 * ti; bi1 = bidx0 + 32 * (ti - toff1); }
        ATT_SOFTMAX(S0, m0, l0, O0a, O0b, tb0, bi0, xm);
        ATT_SOFTMAX(S1, m1, l1, O1a, O1b, tb1, bi1, xm);
#pragma unroll
        for (int s2 = 0; s2 < 2; ++s2) {
            bf16x8 P0, P1; ATT_PACK(P0, S0, s2); ATT_PACK(P1, S1, s2);
            const s16x4 a00 = __builtin_amdgcn_ds_read_tr16_b64_v4i16((LAS s16x4*)(vt + vr0 + (16 * s2) * 128));
            const s16x4 a01 = __builtin_amdgcn_ds_read_tr16_b64_v4i16((LAS s16x4*)(vt + vr0 + (16 * s2 + 8) * 128));
            const s16x4 a10 = __builtin_amdgcn_ds_read_tr16_b64_v4i16((LAS s16x4*)(vt + vr1 + (16 * s2) * 128));
            const s16x4 a11 = __builtin_amdgcn_ds_read_tr16_b64_v4i16((LAS s16x4*)(vt + vr1 + (16 * s2 + 8) * 128));
            const bf16x8 V0 = (bf16x8){a00[0], a00[1], a00[2], a00[3], a01[0], a01[1], a01[2], a01[3]};
            const bf16x8 V1 = (bf16x8){a10[0], a10[1], a10[2], a10[3], a11[0], a11[1], a11[2], a11[3]};
            O0a = __builtin_amdgcn_mfma_f32_32x32x16_bf16(V0, P0, O0a, 0, 0, 0); O0b = __builtin_amdgcn_mfma_f32_32x32x16_bf16(V1, P0, O0b, 0, 0, 0);
            O1a = __builtin_amdgcn_mfma_f32_32x32x16_bf16(V0, P1, O1a, 0, 0, 0); O1b = __builtin_amdgcn_mfma_f32_32x32x16_bf16(V1, P1, O1b, 0, 0, 0);
        }
    }
    ATT_STORE(orow0, O0a, O0b, l0);
    ATT_STORE(orow1, O1a, O1b, l1);
    if (TYPE == 1 && hh == 0) { *lse0 = (m0 + __builtin_amdgcn_logf(l0)) * LN2; *lse1 = (m1 + __builtin_amdgcn_logf(l1)) * LN2; }
}

__device__ __forceinline__ void ph_att(Frame& F, int l) { LAUNDER(F);
    const int lane = F.lane, qi = lane & 31;
    LAS unsigned char* wl = F.lds + RING_OFF + F.wave * 16384;
    const bf16* qkv = (const bf16*)(F.ws + WS_QKV); bf16* oabc = (bf16*)(F.ws + WS_OABC); bf16* og = (bf16*)(F.ws + WS_OG); float* lse = (float*)(F.ws + WS_LSE);
    const float* TA = (const float*)(F.ws + WS_TABA); const float* TB = (const float*)(F.ws + WS_TABB); const float* TC = (const float*)(F.ws + WS_TABC) + (size_t)l * 8 * 1024;
    const float* sink = F.in[6] + l * 8;
    const int gw = F.vcu * NWAVES + F.wave, NGW = F.G * NWAVES;
    for (int task = gw; task < NT_ALL; task += NGW) {
        if (task < NT_A) {
            const int hp = task & 3, qb = (task >> 2) & 255, b = task >> 10, q0 = qb * 32, h0 = hp * 2, h1 = h0 + 1, kvh = hp >> 1;
            int tlo = 0, thi = 8; if (q0 - 128 < 0) tlo = (128 - q0) / 32; if (q0 + 128 + 31 >= L) thi = (L - 1 - (q0 - 128)) / 32;
            const int tq = q0 + qi; bf16* orow = oabc + (size_t)(b * L + tq) * OW;
            att_task2<0>(wl, lane, qkv + (size_t)b * L * QKVW, TA + h0 * 320, TA + h1 * 320, AQ + h0 * 64, AQ + h1 * 64, AK + kvh * 64, AV + kvh * 64, q0 - 128, 32, 1, tlo, thi,
                         tq, tq, 0, 0, 0, 0, 0, sink[h0] * LOG2E, sink[h1] * LOG2E, 1.0f, orow + h0 * 64, orow + h1 * 64, nullptr, nullptr);
        } else if (task < NT_A + NT_B) {
            const int j = task - NT_A, h = j & 3, sbi = (j >> 2) & 127, bg = j >> 9, g = bg % 3, b = bg / 3;
            const int dsh = 2 * g, d = 1 << dsh, nsb = 128 >> dsh, r = sbi / nsb, sb = sbi % nsb, q0 = sb * 64, Ls = L >> dsh;
            int tlo = 0, thi = 5; if (q0 - 64 < 0) tlo = (64 - q0) / 32; if (q0 + 32 + 64 + 31 >= Ls) thi = (Ls - 1 - (q0 - 64)) / 32;
            const int tq0 = (q0 + qi) * d + r, tq1 = (q0 + 32 + qi) * d + r, qc = BQ0 + 768 * g + h * 64;
            att_task2<1>(wl, lane, qkv + (size_t)b * L * QKVW, TB + (g * 4 + h) * 256, nullptr, qc, qc, qc + 256, qc + 512, (q0 - 64) * d + r, 32 * d, d, tlo, thi,
                         tq0, tq1, 1, 0, 0, 0, 0, MINIT, MINIT, 0.0f, og + ((size_t)(b * L + tq0) * 3 + g) * 256 + h * 64, og + ((size_t)(b * L + tq1) * 3 + g) * 256 + h * 64,
                         lse + ((size_t)(b * L + tq0) * 3 + g) * 4 + h, lse + ((size_t)(b * L + tq1) * 3 + g) * 4 + h);
        } else {
            const int j = task - NT_A - NT_B, h = j & 7, cbi = (j >> 3) & 127, b = j >> 10, ip = cbi >> 2, cb = cbi & 3;
            const int gi0 = 4 * ip + (qi >> 4), gi1 = gi0 + 2, gc = 16 * cb + (qi & 15), tq0 = gi0 * 64 + gc, tq1 = gi1 * 64 + gc;
            int cbs = 16 * cb - 8; cbs = cbs < 0 ? 0 : (cbs > 32 ? 32 : cbs);
            int rlo = 4 * ip - 4; rlo = rlo < 0 ? 0 : (rlo > 120 ? 120 : rlo);
            int rhi = 4 * ip + 3 - 4; rhi = rhi < 0 ? 0 : (rhi > 120 ? 120 : rhi); rhi += 7;
            bf16* ob = oabc + (size_t)(b * L) * OW + 768 + h * 64;
            att_task2<2>(wl, lane, qkv + (size_t)b * L * QKVW, TC + h * 1024, nullptr, CQ + h * 64, CQ + h * 64, CK + h * 64, CV + h * 64, cbs, 64, 1, rlo, rhi,
                         tq0, tq1, 0, gi0, gi1, gc, cbs, MINIT, MINIT, 0.0f, ob + (size_t)tq0 * OW, ob + (size_t)tq1 * OW, nullptr, nullptr);
        }
    }
}

constexpr int NSTEPS = 1 + DEPTH * 16;
__global__ void __launch_bounds__(NTHREADS, 2) mk_fwd(Args args) {
    extern __shared__ __attribute__((aligned(16))) unsigned char lds[];
    Frame F;
    F.lds = (LAS unsigned char*)lds; F.tid = threadIdx.x; F.lane = F.tid & 63; F.wave = __builtin_amdgcn_readfirstlane(F.tid >> 6);
    F.G = gridDim.x; { const int bx = blockIdx.x; F.vcu = (F.G % 8 == 0) ? (bx % 8) * (F.G / 8) + bx / 8 : bx; }
    F.in = args.in; F.h = args.out; F.ws = args.ws; F.probe = args.probe;
    volatile LAS unsigned* MISC = (volatile LAS unsigned*)(F.lds + MISC_OFF);
    if (F.tid < 32) MISC[F.tid] = 0u;
    __syncthreads();
    const int lo = args.s_lo, hi = args.s_hi;
    XcdBarrier bar; bar.bar = (unsigned*)(F.ws + WS_CTL) + CW_BAR; bar.x = 0; bar.st = nullptr;
    if (hi - lo > 1) bar = xcd_barrier_post((unsigned*)(F.ws + WS_CTL) + CW_BAR, MISC + 8);
#define RUN(s) (lo <= (s) && (s) < hi)
#define SEAM(s) do { if (RUN(s) && RUN((s) + 1)) xcd_barrier(bar); } while (0)
    if (RUN(0)) { ph_prologue(F); ph_tables(F); ph_ln0(F); }
    SEAM(0);
    for (int l = 0; l < DEPTH; ++l) {
        const int sb = 1 + l * 16;
        for (int c = 0; c < NCHUNK; ++c) {
            const int s = sb + c * 6;
            if (RUN(s)) ph_p1(F, l, c);
            SEAM(s);
            if (RUN(s + 1)) ph_att(F, l);
            SEAM(s + 1);
            if (RUN(s + 2)) ph_cmb(F);
            SEAM(s + 2);
            if (RUN(s + 3)) ph_p3(F, l);
            SEAM(s + 3);
            if (RUN(s + 4)) ph_p4(F, l, c);
            SEAM(s + 4);
            if (RUN(s + 5)) ph_ln1(F, l, c);
            SEAM(s + 5);
        }
        if (RUN(sb + 12)) ph_dsp(F, l);
        SEAM(sb + 12);
        if (RUN(sb + 13)) ph_p7(F, l);
        SEAM(sb + 13);
        if (RUN(sb + 14)) ph_p8(F, l);
        SEAM(sb + 14);
        if (RUN(sb + 15)) ph_ln2(F, l);
        SEAM(sb + 15);
    }
#undef RUN
#undef SEAM
}

#ifndef FAST_MASK
#define FAST_MASK 0x7FF
#endif
#ifndef ONE_LAUNCH
#define ONE_LAUNCH 1
#endif
extern "C" void kernel_launch(void* const* d_in, const int* in_sizes, int n_in, void* d_out, int out_size, void* d_ws, size_t ws_size, hipStream_t stream) {
    static int grid = 0;
    if (grid == 0) {
        if (n_in != 23 || out_size != T * D || ws_size < WS_END) { fprintf(stderr, "kernel_launch: unexpected shapes (n_in %d out %d ws %zu)\n", n_in, out_size, ws_size); grid = -1; return; }
        int dev = 0, cus = 0, per_cu = 0;
        if (hipGetDevice(&dev) != hipSuccess || hipDeviceGetAttribute(&cus, hipDeviceAttributeMultiprocessorCount, dev) != hipSuccess) { grid = -1; return; }
        if (hipFuncSetAttribute((const void*)mk_fwd, hipFuncAttributeMaxDynamicSharedMemorySize, LDS_BYTES) != hipSuccess) { fprintf(stderr, "kernel_launch: hipFuncSetAttribute failed\n"); grid = -1; return; }
        if (hipOccupancyMaxActiveBlocksPerMultiprocessor(&per_cu, (const void*)mk_fwd, NTHREADS, LDS_BYTES) != hipSuccess || per_cu < 1) fprintf(stderr, "kernel_launch: occupancy query reports %d\n", per_cu);
        (void)hipGetLastError();
        grid = cus;
    }
    if (grid < 0) return;
    const float* x = (const float*)d_in[0]; const float* ln0_g = (const float*)d_in[1]; const float* ln0_b = (const float*)d_in[2]; const float* rel_bias = (const float*)d_in[3];
    const float* w_in = (const float*)d_in[4]; const float* b_gate = (const float*)d_in[5]; const float* sink_a = (const float*)d_in[6]; const float* rpb_c = (const float*)d_in[7];
    const float* w_br_a = (const float*)d_in[8]; const float* w_br_b = (const float*)d_in[9]; const float* w_br_c = (const float*)d_in[10]; const float* w_out = (const float*)d_in[11];
    const float* ln1_g = (const float*)d_in[12]; const float* ln1_b = (const float*)d_in[13]; const float* w_rg = (const float*)d_in[14]; const float* b_rg = (const float*)d_in[15];
    const float* w_re = (const float*)d_in[16]; const float* b_re = (const float*)d_in[17]; const float* w_eg = (const float*)d_in[18]; const float* w_eu = (const float*)d_in[19];
    const float* w_ed = (const float*)d_in[20]; const float* ln2_g = (const float*)d_in[21]; const float* ln2_b = (const float*)d_in[22];
    unsigned char* ws = (unsigned char*)d_ws; float* h = (float*)d_out;
    bf16* hb = (bf16*)(ws + WS_HB); bf16* qkv = (bf16*)(ws + WS_QKV); bf16* gates = (bf16*)(ws + WS_GATES); bf16* oabc = (bf16*)(ws + WS_OABC); bf16* og = (bf16*)(ws + WS_OG);
    float* lse = (float*)(ws + WS_LSE); Rec* rec = (Rec*)(ws + WS_REC); int* rowtok = (int*)(ws + WS_ROWTOK); float* rowgate = (float*)(ws + WS_ROWGATE);
    bf16* merged = (bf16*)(ws + WS_MERGED); bf16* hid = (bf16*)(ws + WS_HID); bf16* yb = (bf16*)(ws + WS_YB); int* cnt = (int*)(ws + WS_CTL) + CW_CNT;
    (void)hipMemsetAsync(ws + WS_CTL, 0, CTL_ZERO_BYTES, stream);
    Args a{};
    for (int i = 0; i < 23; ++i) a.in[i] = (const float*)d_in[i];
    a.out = h; a.ws = ws;
    if (ONE_LAUNCH) { a.s_lo = 0; a.s_hi = NSTEPS; hipLaunchKernelGGL(mk_fwd, dim3(grid), dim3(NTHREADS), LDS_BYTES, stream, a); return; }
    const int G = 2048;
    const bool fastp1 = (FAST_MASK >> 1) & 1;
    for (int s = 0; s < NSTEPS; ++s) {
        int kind, l = 0, c = 0;
        if (s == 0) kind = 0; else { const int r = (s - 1) % 16; l = (s - 1) / 16; if (r < 12) { c = r / 6; kind = 1 + r % 6; } else kind = 7 + (r - 12); }
        if ((FAST_MASK >> kind) & 1) { a.s_lo = s; a.s_hi = s + 1;
#ifdef DUP_KIND
            if (kind == DUP_KIND && (kind == 5 || kind == 6 || kind == 10)) { a.probe = 1; hipLaunchKernelGGL(mk_fwd, dim3(grid), dim3(NTHREADS), LDS_BYTES, stream, a); a.probe = 0; }
#endif
            hipLaunchKernelGGL(mk_fwd, dim3(grid), dim3(NTHREADS), LDS_BYTES, stream, a);
#ifdef DUP_KIND
            if (kind == DUP_KIND && !(kind == 5 || kind == 6 || kind == 10)) { hipLaunchKernelGGL(mk_fwd, dim3(grid), dim3(NTHREADS), LDS_BYTES, stream, a); }
#endif
            continue; }
        const size_t r0 = (size_t)c * CH;
        switch (kind) {
        case 0: k_ln<<<G, 256, 0, stream>>>(0, x, h, hb, nullptr, ln0_g, ln0_b, 0, T); break;
        case 1: k_p1<<<G, 256, 0, stream>>>(hb + r0 * D, w_in + (size_t)l * D * NCOL, b_gate + (size_t)l * GATEW, qkv, gates); break;
        case 2: k_attn_naive<<<(28 * CH + 255) / 256, 256, 0, stream>>>(qkv, oabc, og, lse, rel_bias, sink_a + l * 8, rpb_c + (size_t)l * 8 * 15 * 31, fastp1 ? LN2 : 0.125f); break;
        case 3: k_combine<<<(CH * 32 + 255) / 256, 256, 0, stream>>>(og, lse, oabc); break;
        case 4: k_p3<<<G, 256, 0, stream>>>(oabc, gates, w_br_a + (size_t)l * 512 * D, w_br_b + (size_t)l * 256 * D, w_br_c + (size_t)l * 512 * D, merged); break;
        case 5: k_p4<<<G, 256, 0, stream>>>(merged, w_out + (size_t)l * D * D, h + r0 * D); break;
        case 6: k_ln<<<G, 256, 0, stream>>>(1, nullptr, h, hb, nullptr, ln1_g + l * D, ln1_b + l * D, (int)r0, CH);
                if (c == NCHUNK - 1) k_router<<<G, 256, 0, stream>>>(h, w_rg + (size_t)l * D * 4, b_rg + l * 4, w_re + (size_t)l * 4 * D * 8, b_re + l * 32, cnt + l * (32 * CSTR), rec);
                break;
        case 7: (void)hipMemsetAsync(rowtok, 0xFF, (size_t)PROWS * 4, stream); k_dispatch<<<256, 256, 0, stream>>>(cnt + l * (32 * CSTR), rec, rowtok, rowgate); break;
        case 8: k_p7<<<G, 256, 0, stream>>>(hb, cnt + l * (32 * CSTR), rowtok, w_eg + (size_t)l * NE * D * DE, w_eu + (size_t)l * NE * D * DE, hid); break;
        case 9: k_p8<<<G, 256, 0, stream>>>(hid, cnt + l * (32 * CSTR), rowtok, rowgate, w_ed + (size_t)l * NE * DE * D, yb); break;
        case 10: k_ln<<<G, 256, 0, stream>>>(2, nullptr, h, (l == DEPTH - 1) ? nullptr : hb, yb, ln2_g + l * D, ln2_b + l * D, 0, T); break;
        }
    }
}
```

```cpp
#include <hip/hip_runtime.h>
#include <cstdio>
#include <cstdint>
#include <cmath>

typedef unsigned short bf16;
typedef short bf16x8 __attribute__((ext_vector_type(8)));
typedef float f32x16 __attribute__((ext_vector_type(16)));
typedef float f32x4 __attribute__((ext_vector_type(4)));

constexpr int D = 1024, L = 8192, NBATCH = 8, T = NBATCH * L, DEPTH = 2;
constexpr int NCOL = 7680, QKVW = 4608, GATEW = 3072;
constexpr int CH = 32768, NCHUNK = T / CH;
constexpr int OW = 1280;
constexpr int NE = 32, DE = 512;
constexpr int MAXRT = T * 2 / 256 + NE, PROWS = MAXRT * 256;
constexpr float LN_EPS = 1e-5f;
constexpr float ALPHA = 1.41421356237309515f;
constexpr int AQ = 0, AK = 512, AV = 640, BQ0 = 768, CQ = 3072, CK = 3584, CV = 4096;

constexpr size_t MiB = 1u << 20;
constexpr size_t WS_CTL = 0;
constexpr size_t WS_WIN = 1 * MiB, WS_WBRA = 31 * MiB, WS_WBRB = 33 * MiB, WS_WBRC = 34 * MiB, WS_WOUT = 36 * MiB, WS_WGU = 40 * MiB, WS_WD = 168 * MiB;
constexpr size_t WS_HB = 232 * MiB, WS_QKV = 360 * MiB, WS_GATES = 648 * MiB, WS_OABC = 840 * MiB, WS_OG = 920 * MiB, WS_LSE = 968 * MiB,
                 WS_REC = 970 * MiB, WS_ROWTOK = 972 * MiB, WS_ROWGATE = 973 * MiB, WS_TABA = 974 * MiB, WS_TABB = WS_TABA + 16384, WS_TABC = WS_TABA + 32768, WS_WGCNT = WS_TABA + 131072  , WS_END = 975 * MiB;
constexpr size_t WS_MERGED = WS_QKV, WS_HID = WS_QKV, WS_YB = WS_QKV + 136 * MiB;
constexpr int CSTR = 32;

__device__ __constant__ signed char BUCK_A[257] = {12,11,11,11,11,11,11,11,11,11,11,11,11,11,11,11,11,11,11,11,11,11,11,11,11,11,11,11,11,11,11,11,11,11,11,11,11,11,11,11,11,11,11,11,11,11,11,11,11,11,11,11,11,11,11,11,11,11,11,11,11,11,11,11,11,10,10,10,10,10,10,10,10,10,10,10,10,10,10,10,10,10,10,10,10,10,10,10,10,10,10,10,10,10,10,10,10,9,9,9,9,9,9,9,9,9,9,9,9,9,9,9,9,8,8,8,8,8,8,8,8,7,6,5,4,3,2,1,0,17,18,19,20,21,22,23,24,24,24,24,24,24,24,24,25,25,25,25,25,25,25,25,25,25,25,25,25,25,25,25,26,26,26,26,26,26,26,26,26,26,26,26,26,26,26,26,26,26,26,26,26,26,26,26,26,26,26,26,26,26,26,26,27,27,27,27,27,27,27,27,27,27,27,27,27,27,27,27,27,27,27,27,27,27,27,27,27,27,27,27,27,27,27,27,27,27,27,27,27,27,27,27,27,27,27,27,27,27,27,27,27,27,27,27,27,27,27,27,27,27,27,27,27,27,27,27,28};
__device__ __constant__ signed char BUCK_B[3][129] = {
 {11,10,10,10,10,10,10,10,10,10,10,10,10,10,10,10,10,10,10,10,10,10,10,10,10,10,10,10,10,10,10,10,10,9,9,9,9,9,9,9,9,9,9,9,9,9,9,9,9,8,8,8,8,8,8,8,8,7,6,5,4,3,2,1,0,17,18,19,20,21,22,23,24,24,24,24,24,24,24,24,25,25,25,25,25,25,25,25,25,25,25,25,25,25,25,25,26,26,26,26,26,26,26,26,26,26,26,26,26,26,26,26,26,26,26,26,26,26,26,26,26,26,26,26,26,26,26,26,27},
 {13,12,12,12,12,12,12,12,12,12,12,12,12,12,12,12,12,12,12,12,12,12,12,12,12,12,12,12,12,12,12,12,12,11,11,11,11,11,11,11,11,11,11,11,11,11,11,11,11,10,10,10,10,10,10,10,10,9,9,9,9,8,8,4,0,20,24,24,25,25,25,25,26,26,26,26,26,26,26,26,27,27,27,27,27,27,27,27,27,27,27,27,27,27,27,27,28,28,28,28,28,28,28,28,28,28,28,28,28,28,28,28,28,28,28,28,28,28,28,28,28,28,28,28,28,28,28,28,29},
 {15,14,14,14,14,14,14,14,14,14,14,14,14,14,14,14,14,14,14,14,14,14,14,14,14,14,14,14,14,14,14,14,14,13,13,13,13,13,13,13,13,13,13,13,13,13,13,13,13,12,12,12,12,12,12,12,12,11,11,11,11,10,10,9,0,25,26,26,27,27,27,27,28,28,28,28,28,28,28,28,29,29,29,29,29,29,29,29,29,29,29,29,29,29,29,29,30,30,30,30,30,30,30,30,30,30,30,30,30,30,30,30,30,30,30,30,30,30,30,30,30,30,30,30,30,30,30,30,31}};

__device__ __forceinline__ float bf2f(bf16 b) { return __uint_as_float(((unsigned)b) << 16); }
__device__ __forceinline__ bf16 f2bf(float f) { unsigned u = __float_as_uint(f); u += 0x7fffu + ((u >> 16) & 1u); return (bf16)(u >> 16); }
__device__ __forceinline__ float wave_sum(float v) {
#pragma unroll
    for (int o = 1; o < 64; o <<= 1) v += __shfl_xor(v, o);
    return v;
}

__global__ __launch_bounds__(256) void k_ln(int mode, const float* src, float* h, bf16* hb, const bf16* yb, const float* g, const float* bta, int row0, int nrows) {
    const int lane = threadIdx.x & 63, wv = blockIdx.x * 4 + (threadIdx.x >> 6), nw = gridDim.x * 4;
    for (int rr = wv; rr < nrows; rr += nw) {
        const size_t row = (size_t)row0 + rr;
        f32x4 v[4];
#pragma unroll
        for (int j = 0; j < 4; ++j) {
            const int c = lane * 4 + 256 * j;
            v[j] = *(const f32x4*)((mode == 0 ? src : h) + row * D + c);
            if (mode == 2) {
                const uint2 a = *(const uint2*)(yb + (row * 2) * D + c), b = *(const uint2*)(yb + (row * 2 + 1) * D + c);
                v[j].x = ALPHA * v[j].x + bf2f((bf16)(a.x & 0xffff)) + bf2f((bf16)(b.x & 0xffff));
                v[j].y = ALPHA * v[j].y + bf2f((bf16)(a.x >> 16)) + bf2f((bf16)(b.x >> 16));
                v[j].z = ALPHA * v[j].z + bf2f((bf16)(a.y & 0xffff)) + bf2f((bf16)(b.y & 0xffff));
                v[j].w = ALPHA * v[j].w + bf2f((bf16)(a.y >> 16)) + bf2f((bf16)(b.y >> 16));
            }
        }
        float s = 0.f;
#pragma unroll
        for (int j = 0; j < 4; ++j) s += (v[j].x + v[j].y) + (v[j].z + v[j].w);
        const float mean = wave_sum(s) * (1.f / D);
        float q = 0.f;
#pragma unroll
        for (int j = 0; j < 4; ++j) { v[j] = v[j] - mean; q += (v[j].x * v[j].x + v[j].y * v[j].y) + (v[j].z * v[j].z + v[j].w * v[j].w); }
        const float rstd = 1.0f / sqrtf(wave_sum(q) * (1.f / D) + LN_EPS);
#pragma unroll
        for (int j = 0; j < 4; ++j) {
            const int c = lane * 4 + 256 * j;
            const f32x4 gg = *(const f32x4*)(g + c), bb = *(const f32x4*)(bta + c);
            const f32x4 o = v[j] * rstd * gg + bb;
            *(f32x4*)(h + row * D + c) = o;
            if (hb) { uint2 w; w.x = (unsigned)f2bf(o.x) | ((unsigned)f2bf(o.y) << 16); w.y = (unsigned)f2bf(o.z) | ((unsigned)f2bf(o.w) << 16); *(uint2*)(hb + row * D + c) = w; }
        }
    }
}

__device__ __forceinline__ void wave_gemm32(const bf16* arow, const float* wcol, int ldw, int K, f32x16& acc) {
    for (int k0 = 0; k0 < K; k0 += 16) {
        const bf16x8 a = *(const bf16x8*)(arow + k0);
        bf16x8 b;
#pragma unroll
        for (int j = 0; j < 8; ++j) b[j] = (short)f2bf(wcol[(size_t)(k0 + j) * ldw]);
        acc = __builtin_amdgcn_mfma_f32_32x32x16_bf16(a, b, acc, 0, 0, 0);
    }
}
#define ACC_ROW(reg, h) (((reg) & 3) + 8 * ((reg) >> 2) + 4 * (h))

__global__ __launch_bounds__(256) void k_p1(const bf16* hbc, const float* w_in, const float* b_gate, bf16* qkv, bf16* gates) {
    const int lane = threadIdx.x & 63, r = lane & 31, hh = lane >> 5;
    const int wv = blockIdx.x * 4 + (threadIdx.x >> 6), nw = gridDim.x * 4;
    const int ntn = NCOL / 32, total = (CH / 32) * ntn;
    for (int tile = wv; tile < total; tile += nw) {
        const int tm = tile / ntn, tn = tile % ntn;
        f32x16 acc; for (int i = 0; i < 16; ++i) acc[i] = 0.f;
        wave_gemm32(hbc + (size_t)(tm * 32 + r) * D + 8 * hh, w_in + (size_t)(8 * hh) * NCOL + tn * 32 + r, NCOL, D, acc);
        const int col = tn * 32 + r;
#pragma unroll
        for (int i = 0; i < 16; ++i) {
            const int row = tm * 32 + ACC_ROW(i, hh);
            if (col < QKVW) qkv[(size_t)row * QKVW + col] = f2bf(acc[i]);
            else { const float z = acc[i] + b_gate[col - QKVW]; gates[(size_t)row * GATEW + (col - QKVW)] = f2bf(1.0f / (1.0f + __expf(-z))); }
        }
    }
}

__global__ __launch_bounds__(256) void k_attn_naive(const bf16* qkv, bf16* oabc, bf16* og, float* lse, const float* rel_bias, const float* sink_l, const float* rpb_l, float sc) {
    const long idx = (long)blockIdx.x * 256 + threadIdx.x;
    if (idx >= (long)28 * CH) return;
    const int ht = (int)(idx / CH), tl = (int)(idx % CH), b = tl / L, t = tl % L;
    const bf16* base = qkv + (size_t)(b * L) * QKVW;
    int qcol, kcol, vcol;
    if (ht < 8) { qcol = AQ + ht * 64; kcol = AK + (ht >> 2) * 64; vcol = AV + (ht >> 2) * 64; }
    else if (ht < 20) { const int g = (ht - 8) >> 2, h = (ht - 8) & 3; qcol = BQ0 + 768 * g + h * 64; kcol = qcol + 256; vcol = qcol + 512; }
    else { const int h = ht - 20; qcol = CQ + h * 64; kcol = CK + h * 64; vcol = CV + h * 64; }
    float q[64], o[64];
    {
        const uint4* qp = (const uint4*)(base + (size_t)t * QKVW + qcol);
#pragma unroll
        for (int c = 0; c < 8; ++c) { const uint4 u = qp[c]; const unsigned w[4] = {u.x, u.y, u.z, u.w};
#pragma unroll
            for (int i = 0; i < 4; ++i) { q[8 * c + 2 * i] = bf2f((bf16)(w[i] & 0xffff)); q[8 * c + 2 * i + 1] = bf2f((bf16)(w[i] >> 16)); } }
    }
#pragma unroll
    for (int i = 0; i < 64; ++i) o[i] = 0.f;
    float m = -1e30f, l = 0.f;
    if (ht < 8) { m = sink_l[ht]; l = 1.f; }
#define PROC_KEY(KT, BIAS) do { \
        const uint4* kp = (const uint4*)(base + (size_t)(KT) * QKVW + kcol); float s = 0.f; \
        _Pragma("unroll") for (int c = 0; c < 8; ++c) { const uint4 u = kp[c]; const unsigned w[4] = {u.x, u.y, u.z, u.w}; \
            _Pragma("unroll") for (int i = 0; i < 4; ++i) { s += q[8 * c + 2 * i] * bf2f((bf16)(w[i] & 0xffff)); s += q[8 * c + 2 * i + 1] * bf2f((bf16)(w[i] >> 16)); } } \
        s = s * sc + (BIAS); const float mn = fmaxf(m, s), corr = __expf(m - mn), p = __expf(s - mn); l = l * corr + p; m = mn; \
        const uint4* vp = (const uint4*)(base + (size_t)(KT) * QKVW + vcol); \
        _Pragma("unroll") for (int c = 0; c < 8; ++c) { const uint4 u = vp[c]; const unsigned w[4] = {u.x, u.y, u.z, u.w}; \
            _Pragma("unroll") for (int i = 0; i < 4; ++i) { o[8 * c + 2 * i] = o[8 * c + 2 * i] * corr + p * bf2f((bf16)(w[i] & 0xffff)); o[8 * c + 2 * i + 1] = o[8 * c + 2 * i + 1] * corr + p * bf2f((bf16)(w[i] >> 16)); } } \
    } while (0)
    if (ht < 8) {
        for (int rel = -128; rel <= 128; ++rel) { const int kt = t + rel; if (kt < 0 || kt >= L) continue;
            const float bias = rel_bias[BUCK_A[rel + 128] * 20 + ht]; PROC_KEY(kt, bias); }
    } else if (ht < 20) {
        const int g = (ht - 8) >> 2, h = (ht - 8) & 3, dil = (g == 0) ? 1 : (g == 1 ? 4 : 16);
        for (int off = -64; off <= 64; ++off) { const int kt = t + off * dil; if (kt < 0 || kt >= L) continue;
            const float bias = rel_bias[BUCK_B[g][off + 64] * 20 + 8 + 4 * g + h]; PROC_KEY(kt, bias); }
    } else {
        const int h = ht - 20, gi = t >> 6, gc = t & 63;
        int rs = gi - 4; rs = rs < 0 ? 0 : (rs > 120 ? 120 : rs);
        int cs = gc - 8; cs = cs < 0 ? 0 : (cs > 48 ? 48 : cs);
        for (int kr = rs; kr < rs + 8; ++kr)
            for (int kc = cs; kc < cs + 16; ++kc) { const float bias = rpb_l[(h * 15 + (kr - gi + 7)) * 31 + (kc - gc + 15)]; const int kt = kr * 64 + kc; PROC_KEY(kt, bias); }
    }
#undef PROC_KEY
    const float inv = 1.0f / l;
    bf16* dst;
    if (ht < 8) dst = oabc + (size_t)tl * OW + ht * 64;
    else if (ht < 20) { const int g = (ht - 8) >> 2, h = (ht - 8) & 3; dst = og + ((size_t)tl * 3 + g) * 256 + h * 64; lse[((size_t)tl * 3 + g) * 4 + h] = m + __logf(l); }
    else dst = oabc + (size_t)tl * OW + 768 + (ht - 20) * 64;
#pragma unroll
    for (int c = 0; c < 8; ++c) { uint4 u;
        u.x = (unsigned)f2bf(o[8 * c + 0] * inv) | ((unsigned)f2bf(o[8 * c + 1] * inv) << 16); u.y = (unsigned)f2bf(o[8 * c + 2] * inv) | ((unsigned)f2bf(o[8 * c + 3] * inv) << 16);
        u.z = (unsigned)f2bf(o[8 * c + 4] * inv) | ((unsigned)f2bf(o[8 * c + 5] * inv) << 16); u.w = (unsigned)f2bf(o[8 * c + 6] * inv) | ((unsigned)f2bf(o[8 * c + 7] * inv) << 16);
        ((uint4*)dst)[c] = u; }
}

__global__ __launch_bounds__(256) void k_combine(const bf16* og, const float* lse, bf16* oabc) {
    const long idx = (long)blockIdx.x * 256 + threadIdx.x;
    if (idx >= (long)CH * 32) return;
    const int tl = (int)(idx >> 5), hc = (int)(idx & 31), h = hc >> 3, c = hc & 7;
    const float l0 = lse[((size_t)tl * 3 + 0) * 4 + h], l1 = lse[((size_t)tl * 3 + 1) * 4 + h], l2 = lse[((size_t)tl * 3 + 2) * 4 + h];
    const float mx = fmaxf(l0, fmaxf(l1, l2)); float w0 = __expf(l0 - mx), w1 = __expf(l1 - mx), w2 = __expf(l2 - mx); const float inv = 1.0f / (w0 + w1 + w2); w0 *= inv; w1 *= inv; w2 *= inv;
    const uint4 a = *(const uint4*)(og + ((size_t)tl * 3 + 0) * 256 + h * 64 + c * 8), b = *(const uint4*)(og + ((size_t)tl * 3 + 1) * 256 + h * 64 + c * 8), d = *(const uint4*)(og + ((size_t)tl * 3 + 2) * 256 + h * 64 + c * 8);
    const unsigned aw[4] = {a.x, a.y, a.z, a.w}, bw[4] = {b.x, b.y, b.z, b.w}, dw[4] = {d.x, d.y, d.z, d.w}; unsigned ow[4];
#pragma unroll
    for (int i = 0; i < 4; ++i) {
        const float lo = w0 * bf2f((bf16)(aw[i] & 0xffff)) + w1 * bf2f((bf16)(bw[i] & 0xffff)) + w2 * bf2f((bf16)(dw[i] & 0xffff));
        const float hi = w0 * bf2f((bf16)(aw[i] >> 16)) + w1 * bf2f((bf16)(bw[i] >> 16)) + w2 * bf2f((bf16)(dw[i] >> 16));
        ow[i] = (unsigned)f2bf(lo) | ((unsigned)f2bf(hi) << 16);
    }
    *(uint4*)(oabc + (size_t)tl * OW + 512 + h * 64 + c * 8) = make_uint4(ow[0], ow[1], ow[2], ow[3]);
}

__global__ __launch_bounds__(256) void k_p3(const bf16* oabc, const bf16* gates, const float* wa, const float* wb, const float* wc, bf16* merged) {
    const int lane = threadIdx.x & 63, r = lane & 31, hh = lane >> 5;
    const int wv = blockIdx.x * 4 + (threadIdx.x >> 6), nw = gridDim.x * 4;
    const int ntn = D / 32, total = (CH / 32) * ntn;
    for (int tile = wv; tile < total; tile += nw) {
        const int tm = tile / ntn, tn = tile % ntn, col = tn * 32 + r;
        f32x16 mg; for (int i = 0; i < 16; ++i) mg[i] = 0.f;
#pragma unroll 1
        for (int br = 0; br < 3; ++br) {
            f32x16 acc; for (int i = 0; i < 16; ++i) acc[i] = 0.f;
            const int koff = br == 0 ? 0 : (br == 1 ? 512 : 768), K = br == 1 ? 256 : 512;
            const float* w = br == 0 ? wa : (br == 1 ? wb : wc);
            wave_gemm32(oabc + (size_t)(tm * 32 + r) * OW + koff + 8 * hh, w + (size_t)(8 * hh) * D + col, D, K, acc);
#pragma unroll
            for (int i = 0; i < 16; ++i) { const int row = tm * 32 + ACC_ROW(i, hh); mg[i] += bf2f(gates[(size_t)row * GATEW + br * 1024 + col]) * acc[i]; }
        }
#pragma unroll
        for (int i = 0; i < 16; ++i) { const int row = tm * 32 + ACC_ROW(i, hh); merged[(size_t)row * D + col] = f2bf(mg[i]); }
    }
}
__global__ __launch_bounds__(256) void k_p4(const bf16* merged, const float* wo, float* hchunk) {
    const int lane = threadIdx.x & 63, r = lane & 31, hh = lane >> 5;
    const int wv = blockIdx.x * 4 + (threadIdx.x >> 6), nw = gridDim.x * 4;
    const int ntn = D / 32, total = (CH / 32) * ntn;
    for (int tile = wv; tile < total; tile += nw) {
        const int tm = tile / ntn, tn = tile % ntn, col = tn * 32 + r;
        f32x16 acc; for (int i = 0; i < 16; ++i) acc[i] = 0.f;
        wave_gemm32(merged + (size_t)(tm * 32 + r) * D + 8 * hh, wo + (size_t)(8 * hh) * D + col, D, D, acc);
#pragma unroll
        for (int i = 0; i < 16; ++i) { const int row = tm * 32 + ACC_ROW(i, hh); float* p = hchunk + (size_t)row * D + col; *p = ALPHA * *p + acc[i]; }
    }
}

struct Rec { int e0, s0, e1, s1; float g0, g1; int pad0, pad1; };
__global__ __launch_bounds__(256) void k_router(const float* h, const float* w_rg, const float* b_rg, const float* w_re, const float* b_re, int* cnt, Rec* rec) {
    const int lane = threadIdx.x & 63, wv = blockIdx.x * 4 + (threadIdx.x >> 6), nw = gridDim.x * 4;
    for (int t = wv; t < T; t += nw) {
        float x[16];
#pragma unroll
        for (int j = 0; j < 4; ++j) { const f32x4 v = *(const f32x4*)(h + (size_t)t * D + lane * 4 + 256 * j); x[4 * j] = v.x; x[4 * j + 1] = v.y; x[4 * j + 2] = v.z; x[4 * j + 3] = v.w; }
        float gl[4] = {0.f, 0.f, 0.f, 0.f};
#pragma unroll
        for (int j = 0; j < 4; ++j)
#pragma unroll
            for (int i = 0; i < 4; ++i) { const f32x4 w = *(const f32x4*)(w_rg + (size_t)(lane * 4 + 256 * j + i) * 4); const float xv = x[4 * j + i]; gl[0] += xv * w.x; gl[1] += xv * w.y; gl[2] += xv * w.z; gl[3] += xv * w.w; }
#pragma unroll
        for (int g = 0; g < 4; ++g) gl[g] = wave_sum(gl[g]) + b_rg[g];
        int gi = 0; float gm = gl[0];
#pragma unroll
        for (int g = 1; g < 4; ++g) if (gl[g] > gm) { gm = gl[g]; gi = g; }
        float gs = 0.f;
#pragma unroll
        for (int g = 0; g < 4; ++g) gs += __expf(gl[g] - gm);
        const float gw = 1.0f / gs;
        float el[8];
#pragma unroll
        for (int e = 0; e < 8; ++e) el[e] = 0.f;
        const float* wre = w_re + (size_t)gi * D * 8;
#pragma unroll
        for (int j = 0; j < 4; ++j)
#pragma unroll
            for (int i = 0; i < 4; ++i) { const float* wp = wre + (size_t)(lane * 4 + 256 * j + i) * 8; const f32x4 w0 = *(const f32x4*)wp, w1 = *(const f32x4*)(wp + 4); const float xv = x[4 * j + i];
                el[0] += xv * w0.x; el[1] += xv * w0.y; el[2] += xv * w0.z; el[3] += xv * w0.w; el[4] += xv * w1.x; el[5] += xv * w1.y; el[6] += xv * w1.z; el[7] += xv * w1.w; }
#pragma unroll
        for (int e = 0; e < 8; ++e) el[e] = wave_sum(el[e]) + b_re[gi * 8 + e];
        int i0 = 0; float t0 = el[0];
#pragma unroll
        for (int e = 1; e < 8; ++e) if (el[e] > t0) { t0 = el[e]; i0 = e; }
        int i1 = -1; float t1 = -3.0e38f;
#pragma unroll
        for (int e = 0; e < 8; ++e) if (e != i0 && el[e] > t1) { t1 = el[e]; i1 = e; }
        const float ex = __expf(t1 - t0), p0 = 1.0f / (1.0f + ex), p1 = ex / (1.0f + ex);
        if (lane == 0) {
            Rec rc; rc.e0 = gi * 8 + i0; rc.e1 = gi * 8 + i1; rc.g0 = gw * p0; rc.g1 = gw * p1; rc.pad0 = 0; rc.pad1 = 0;
            rc.s0 = atomicAdd(cnt + rc.e0 * CSTR, 1); rc.s1 = atomicAdd(cnt + rc.e1 * CSTR, 1);
            rec[t] = rc;
        }
    }
}
__device__ __forceinline__ void pad_offsets(const int* cnt, int* po) { int acc = 0; for (int e = 0; e < NE; ++e) { po[e] = acc; acc += (cnt[e * CSTR] + 255) / 256 * 256; } po[NE] = acc; }
__global__ __launch_bounds__(256) void k_dispatch(const int* cnt, const Rec* rec, int* rowtok, float* rowgate) {
    __shared__ int po[NE + 1];
    if (threadIdx.x == 0) pad_offsets(cnt, po);
    __syncthreads();
    for (int t = blockIdx.x * 256 + threadIdx.x; t < T; t += gridDim.x * 256) {
        const Rec rc = rec[t];
        const int d0 = po[rc.e0] + rc.s0, d1 = po[rc.e1] + rc.s1;
        rowtok[d0] = 2 * t; rowgate[d0] = rc.g0; rowtok[d1] = 2 * t + 1; rowgate[d1] = rc.g1;
    }
}
__global__ __launch_bounds__(256) void k_p7(const bf16* hb, const int* cnt, const int* rowtok, const float* w_eg, const float* w_eu, bf16* hid) {
    __shared__ int po[NE + 1];
    if (threadIdx.x == 0) pad_offsets(cnt, po);
    __syncthreads();
    const int lane = threadIdx.x & 63, r = lane & 31, hh = lane >> 5;
    const int wv = blockIdx.x * 4 + (threadIdx.x >> 6), nw = gridDim.x * 4;
    const int ntn = DE / 32, total = (po[NE] / 32) * ntn;
    for (int tile = wv; tile < total; tile += nw) {
        const int tm = tile / ntn, tn = tile % ntn, col = tn * 32 + r, row0 = tm * 32;
        int e = 0; while (e < NE - 1 && po[e + 1] <= row0) ++e;
        int tok = rowtok[row0 + r]; tok = tok < 0 ? 0 : (tok >> 1);
        f32x16 ag, au; for (int i = 0; i < 16; ++i) { ag[i] = 0.f; au[i] = 0.f; }
        wave_gemm32(hb + (size_t)tok * D + 8 * hh, w_eg + (size_t)e * D * DE + (size_t)(8 * hh) * DE + col, DE, D, ag);
        wave_gemm32(hb + (size_t)tok * D + 8 * hh, w_eu + (size_t)e * D * DE + (size_t)(8 * hh) * DE + col, DE, D, au);
#pragma unroll
        for (int i = 0; i < 16; ++i) { const int row = row0 + ACC_ROW(i, hh); const float gsl = ag[i] / (1.0f + __expf(-ag[i])); hid[(size_t)row * DE + col] = f2bf(gsl * au[i]); }
    }
}
__global__ __launch_bounds__(256) void k_p8(const bf16* hid, const int* cnt, const int* rowtok, const float* rowgate, const float* w_ed, bf16* yb) {
    __shared__ int po[NE + 1];
    if (threadIdx.x == 0) pad_offsets(cnt, po);
    __syncthreads();
    const int lane = threadIdx.x & 63, r = lane & 31, hh = lane >> 5;
    const int wv = blockIdx.x * 4 + (threadIdx.x >> 6), nw = gridDim.x * 4;
    const int ntn = D / 32, total = (po[NE] / 32) * ntn;
    for (int tile = wv; tile < total; tile += nw) {
        const int tm = tile / ntn, tn = tile % ntn, col = tn * 32 + r, row0 = tm * 32;
        int e = 0; while (e < NE - 1 && po[e + 1] <= row0) ++e;
        f32x16 acc; for (int i = 0; i < 16; ++i) acc[i] = 0.f;
        wave_gemm32(hid + (size_t)(row0 + r) * DE + 8 * hh, w_ed + (size_t)e * DE * D + (size_t)(8 * hh) * D + col, D, DE, acc);
#pragma unroll
        for (int i = 0; i < 16; ++i) { const int row = row0 + ACC_ROW(i, hh); const int rt = rowtok[row]; if (rt >= 0) yb[(size_t)rt * D + col] = f2bf(acc[i] * rowgate[row]); }
    }
}


namespace pg8 {
#define PG8_LAS __attribute__((address_space(3)))
typedef unsigned short bf16_t;
typedef unsigned u32x4 __attribute__((ext_vector_type(4)));
constexpr int BM = 256, BK = 64, HALF = 128, HTB = HALF * BK * 2  , STAGE_BYTES = 8 * HTB, NXCD = 8, WGM = 8;

__host__ __device__ __forceinline__ int lds_byte(int r, int c) { const int st = (r >> 4) * 2 + (c >> 5), rr = r & 15, cc = c & 31, ob = rr * 64 + cc * 2; return st * 1024 + (ob ^ (((ob >> 9) & 1) << 5)); }
__host__ __device__ __forceinline__ void stage_rc(int b, int& R, int& C) { const int st = b / 1024, sb = b % 1024, swz = sb ^ (((sb >> 9) & 1) << 5); R = (st >> 1) * 16 + swz / 64; C = (st & 1) * 32 + (swz % 64) / 2; }
__host__ __device__ __forceinline__ int perm32(int rho) { const int n = rho >> 4, i = rho & 15; return 8 * (i >> 2) + 4 * n + (i & 3); }

struct Unit { int pm, pn, e, ui; };

struct DenseOrder {
    int nM, nN, nwg, G, c; const char* A; const char* B; size_t tstepA, tstepB;
    __device__ void init(const void* A_, int lda, const void* B_, int ldb, int M, int N, int G_, int c_) { nM = M / BM; nN = N / BM; nwg = nM * nN; G = G_; c = c_; A = (const char*)A_; B = (const char*)B_; tstepA = (size_t)BM * lda * 2; tstepB = (size_t)BM * ldb * 2; }
    __device__ bool next(int i, Unit& u) const {
        const long Lx = (long)i * G + c; if (Lx >= nwg) return false;
        int wgid = (int)Lx; { const int q = nwg / NXCD, r = nwg % NXCD, xcd = wgid % NXCD, off = wgid / NXCD; wgid = (xcd < r ? xcd * (q + 1) : r * (q + 1) + (xcd - r) * q) + off; }
        const int nig = WGM * nN, gid = wgid / nig, fm = gid * WGM, gsz = (nM - fm) < WGM ? (nM - fm) : WGM;
        u.pm = fm + ((wgid % nig) % gsz); u.pn = (wgid % nig) / gsz; u.e = 0; u.ui = i; return true;
    }
    __device__ __forceinline__ const char* a_base(const Unit& u) const { return A + (size_t)u.pm * tstepA; }
    __device__ __forceinline__ const char* b_base(const Unit& u) const { return B + (size_t)u.pn * tstepB; }
    __device__ __forceinline__ int a_row(const Unit&, int) const { return 0; }
};

__device__ __forceinline__ unsigned cvt_pk_bf16(float lo, float hi) { unsigned r; asm volatile("v_cvt_pk_bf16_f32 %0, %1, %2" : "=v"(r) : "v"(lo), "v"(hi)); return r; }

template <class Epi, class Sched, bool GATHER>
__device__ __forceinline__ void gemm_phase(PG8_LAS unsigned char* lds, const Sched& S, const Epi& E, const int K, const int lda, const int ldb, const int tid_in) {
    int tid = tid_in; asm volatile("" : "+v"(tid));
    const int wid = __builtin_amdgcn_readfirstlane(tid >> 6), lane = tid & 63, wr = wid >> 2, wc = wid & 3, fr = lane & 15, fq = lane >> 4;
    const int nt = K / BK;
    int RA[2], CA[2]; unsigned voffB[2];
#pragma unroll
    for (int i = 0; i < 2; ++i) { int R, C; stage_rc(tid * 16 + i * 8192, R, C); const int Rb = Epi::PERM ? ((R & ~31) + perm32(R & 31)) : R; RA[i] = R; CA[i] = C; voffB[i] = (unsigned)(Rb * ldb + C) * 2u; }
    const size_t kstep = (size_t)(BK * 2);
    const size_t hstepB = (size_t)HALF * ldb * 2;
    const unsigned ldsw = (unsigned)wid * 1024u;
    const int aoff = lds_byte(wr * 64 + fr, fq * 8), boff = lds_byte(wc * 32 + fr, fq * 8);
#define PG8_SA(b, h) (((b) * 2 + (h)) * HTB)
#define PG8_SB(b, h) ((4 + (b) * 2 + (h)) * HTB)
#define PG8_STAGE2(bufoff, gbase, v0, v1) do { \
        __builtin_amdgcn_global_load_lds((const unsigned*)((const char*)(gbase) + (v0)), (PG8_LAS unsigned*)(lds + (bufoff) + ldsw), 16, 0, 0); \
        __builtin_amdgcn_global_load_lds((const unsigned*)((const char*)(gbase) + (v1)), (PG8_LAS unsigned*)(lds + (bufoff) + ldsw + 8192), 16, 0, 0); } while (0)
#define PG8_STAGEB(bufoff, gbase) PG8_STAGE2(bufoff, gbase, voffB[0], voffB[1])
#define PG8_LDA(dst, b, h) do { _Pragma("unroll") for (int m = 0; m < 4; ++m) _Pragma("unroll") for (int k = 0; k < 2; ++k) dst[m][k] = *(const PG8_LAS bf16x8*)(lds + PG8_SA(b, h) + aoff + m * 2048 + k * 1024); } while (0)
#define PG8_LDB(dst, b, h) do { _Pragma("unroll") for (int n = 0; n < 2; ++n) _Pragma("unroll") for (int k = 0; k < 2; ++k) dst[n][k] = *(const PG8_LAS bf16x8*)(lds + PG8_SB(b, h) + boff + n * 2048 + k * 1024); } while (0)
#define PG8_MMA(ai, bj, At, Bt) do { __builtin_amdgcn_s_setprio(1); _Pragma("unroll") for (int m = 0; m < 4; ++m) _Pragma("unroll") for (int n = 0; n < 2; ++n) _Pragma("unroll") for (int k = 0; k < 2; ++k) \
        acc[ai][bj][m][n] = __builtin_amdgcn_mfma_f32_16x16x32_bf16(Bt[n][k], At[m][k], acc[ai][bj][m][n], 0, 0, 0); __builtin_amdgcn_s_setprio(0); } while (0)
#define PG8_WAIT_V(n) asm volatile("s_waitcnt vmcnt(" #n ")" ::: "memory")
#define PG8_WAIT_L(n) asm volatile("s_waitcnt lgkmcnt(" #n ")" ::: "memory")
#define PG8_BAR __builtin_amdgcn_s_barrier()
#define PG8_SCHED __builtin_amdgcn_sched_barrier(0)
#define PG8_VOFFA(dst, u) do { _Pragma("unroll") for (int h_ = 0; h_ < 2; ++h_) _Pragma("unroll") for (int i_ = 0; i_ < 2; ++i_) { \
        const int row_ = GATHER ? S.a_row(u, h_ * HALF + RA[i_]) : (h_ * HALF + RA[i_]); dst[h_][i_] = (unsigned)(row_ * lda + CA[i_]) * 2u; } } while (0)
    Unit cur, nxt;
    if (!S.next(0, cur)) return;
    f32x4 acc[2][2][4][2];
#pragma unroll
    for (int a = 0; a < 2; ++a)
#pragma unroll
        for (int b = 0; b < 2; ++b)
#pragma unroll
            for (int m = 0; m < 4; ++m)
#pragma unroll
                for (int n = 0; n < 2; ++n) acc[a][b][m][n] = (f32x4){0.f, 0.f, 0.f, 0.f};
    bf16x8 At[4][2], B0[2][2], B1[2][2];
    unsigned vc[2][2], vn[2][2];
    PG8_VOFFA(vc, cur);
    const char* cA = S.a_base(cur); const char* cB = S.b_base(cur);
    PG8_STAGEB(PG8_SB(0, 0), cB); PG8_STAGEB(PG8_SB(0, 1), cB + hstepB); PG8_STAGE2(PG8_SA(0, 0), cA, vc[0][0], vc[0][1]); PG8_STAGE2(PG8_SA(0, 1), cA, vc[1][0], vc[1][1]);
    if (wr == 1) PG8_BAR;
    PG8_WAIT_V(2); PG8_BAR;
    PG8_STAGEB(PG8_SB(1, 0), cB + kstep); PG8_STAGE2(PG8_SA(1, 0), cA + kstep, vc[0][0], vc[0][1]); PG8_STAGEB(PG8_SB(1, 1), cB + hstepB + kstep);
    PG8_WAIT_V(6); PG8_BAR;
    int ui = 0;
    for (;;) {
        const bool has_next = S.next(ui + 1, nxt);
        const char* nA = has_next ? S.a_base(nxt) : cA; const char* nB = has_next ? S.b_base(nxt) : cB;
        if (GATHER) { if (has_next) { PG8_VOFFA(vn, nxt); } else {
#pragma unroll
            for (int h_ = 0; h_ < 2; ++h_) { vn[h_][0] = vc[h_][0]; vn[h_][1] = vc[h_][1]; } } }
        for (int t = 0; t < nt; t += 2) {
            const bool last = (t == nt - 2);
            const char* a1 = cA + (size_t)(t + 1) * kstep;
            const char* a2 = last ? nA : cA + (size_t)(t + 2) * kstep; const char* b2 = last ? nB : cB + (size_t)(t + 2) * kstep;
            const char* a3 = a2 + kstep; const char* b3 = b2 + kstep;
            unsigned w00, w01, w10, w11;
            if (GATHER) { w00 = last ? vn[0][0] : vc[0][0]; w01 = last ? vn[0][1] : vc[0][1]; w10 = last ? vn[1][0] : vc[1][0]; w11 = last ? vn[1][1] : vc[1][1]; }
            else { w00 = vc[0][0]; w01 = vc[0][1]; w10 = vc[1][0]; w11 = vc[1][1]; }
            PG8_LDB(B0, 0, 0); PG8_LDB(B1, 0, 1); PG8_SCHED; PG8_LDA(At, 0, 0); PG8_STAGE2(PG8_SA(1, 1), a1, vc[1][0], vc[1][1]);
            PG8_WAIT_V(8); PG8_WAIT_L(0); PG8_BAR; PG8_MMA(0, 0, At, B0); PG8_MMA(0, 1, At, B1); PG8_BAR; PG8_SCHED;
            PG8_LDA(At, 0, 1); PG8_STAGEB(PG8_SB(0, 0), b2); PG8_STAGEB(PG8_SB(0, 1), b2 + hstepB); PG8_STAGE2(PG8_SA(0, 0), a2, w00, w01);
            PG8_WAIT_V(8); PG8_WAIT_L(0); PG8_BAR; PG8_MMA(1, 0, At, B0); PG8_MMA(1, 1, At, B1); PG8_BAR; PG8_SCHED;
            PG8_LDB(B0, 1, 0); PG8_LDB(B1, 1, 1); PG8_SCHED; PG8_LDA(At, 1, 0); PG8_STAGE2(PG8_SA(0, 1), a2, w10, w11);
            PG8_WAIT_V(8); PG8_WAIT_L(0); PG8_BAR; PG8_MMA(0, 0, At, B0); PG8_MMA(0, 1, At, B1); PG8_BAR; PG8_SCHED;
            PG8_LDA(At, 1, 1); PG8_STAGEB(PG8_SB(1, 0), b3); PG8_STAGEB(PG8_SB(1, 1), b3 + hstepB); PG8_STAGE2(PG8_SA(1, 0), a3, w00, w01);
            PG8_WAIT_V(8); PG8_WAIT_L(0); PG8_BAR; PG8_MMA(1, 0, At, B0); PG8_MMA(1, 1, At, B1); PG8_BAR; PG8_SCHED;
        }
        if (wr == 0) PG8_BAR;
        E(acc, cur, wr, wc, fr, fq);
        if (!has_next) break;
#pragma unroll
        for (int a = 0; a < 2; ++a)
#pragma unroll
            for (int b = 0; b < 2; ++b)
#pragma unroll
                for (int m = 0; m < 4; ++m)
#pragma unroll
                    for (int n = 0; n < 2; ++n) acc[a][b][m][n] = (f32x4){0.f, 0.f, 0.f, 0.f};
        cur = nxt; cA = nA; cB = nB; ++ui;
        if (GATHER) {
#pragma unroll
            for (int h_ = 0; h_ < 2; ++h_) { vc[h_][0] = vn[h_][0]; vc[h_][1] = vn[h_][1]; } }
        if (wr == 1) PG8_BAR;
    }
    PG8_WAIT_V(0);
    PG8_BAR;
#undef PG8_SA
#undef PG8_SB
#undef PG8_STAGE2
#undef PG8_STAGEB
#undef PG8_LDA
#undef PG8_LDB
#undef PG8_MMA
#undef PG8_WAIT_V
#undef PG8_WAIT_L
#undef PG8_BAR
#undef PG8_SCHED
#undef PG8_VOFFA
}
}

constexpr int NWAVES = 8, NTHREADS = 512;
constexpr int RING_OFF = 0, RING_BYTES = 131072, ROWS_OFF = 131072, ROWS_BYTES = 12288, ROUTER_BYTES = 147456  , MISC_OFF = ROUTER_BYTES, LCNT_OFF = MISC_OFF + 128  , LDS_BYTES = 148480;
static_assert(MISC_OFF + 128 <= LDS_BYTES, "LDS map");
constexpr int CW_CNT = 0;
constexpr int CW_BAR = 4096;
constexpr size_t CTL_ZERO_BYTES = 64 * 1024;
constexpr float LOG2E = 1.4426950408889634f, LN2 = 0.6931471805599453f;
constexpr float QSCALE = 0.125f * LOG2E;

#define GAS __attribute__((address_space(1)))
#define LAS __attribute__((address_space(3)))
typedef unsigned v4u __attribute__((ext_vector_type(4)));
typedef unsigned v2u __attribute__((ext_vector_type(2)));
#define LDS_WAIT() asm volatile("s_waitcnt lgkmcnt(0)" ::: "memory")
__device__ __forceinline__ unsigned pk2(float lo, float hi) { return (unsigned)f2bf(lo) | ((unsigned)f2bf(hi) << 16); }

#define XB_TMO      128
#define XB_XCNT(j)  (256  + 64 * (j))
#define XB_XSUB(j)  (1280 + 64 * (j))
#define XB_XGEN(j)  (2304 + 64 * (j))
#define XB_TOP      3328
#define XB_TOPGEN   3392
#define XCD_BAR_WORDS 3456
#define XB_SPIN_CAP (1u << 18)

__device__ __forceinline__ unsigned xb_ld(unsigned* p)              { return __hip_atomic_load(p, __ATOMIC_RELAXED, __HIP_MEMORY_SCOPE_AGENT); }
__device__ __forceinline__ unsigned xb_add(unsigned* p, unsigned v) { return __hip_atomic_fetch_add(p, v, __ATOMIC_RELAXED, __HIP_MEMORY_SCOPE_AGENT); }
__device__ __forceinline__ unsigned xb_xcc_id() { return (unsigned)__builtin_amdgcn_s_getreg((3 << 11) | 20) & 0xFu; }
#define XB_SPIN(cond, bar) do { unsigned _sp = 0; while (cond) { __builtin_amdgcn_s_sleep(1); \
    if ((++_sp & 255u) == 0u) { if (xb_ld(&(bar)[XB_TMO])) break; if (_sp > XB_SPIN_CAP) { atomicAdd(&(bar)[XB_TMO], 1u); break; } } } } while (0)

struct XcdBarrier {
    int wave0;
    unsigned* bar; unsigned x;
    volatile LAS unsigned* st;
};

__device__ __forceinline__ unsigned xb_lane() { unsigned l_; asm volatile("v_mbcnt_lo_u32_b32 %0, -1, 0\n\tv_mbcnt_hi_u32_b32 %0, -1, %0" : "=v"(l_)); return l_; }
__device__ __forceinline__ XcdBarrier xcd_barrier_post(unsigned* bar, volatile LAS unsigned* st, int wave0) {
    XcdBarrier b; b.wave0 = wave0; b.bar = bar; b.x = xb_xcc_id(); b.st = st;
    if (b.wave0 && xb_lane() == 0u) (void)xb_add(&bar[XB_XCNT(b.x)], 1u);
    return b;
}
__device__ __forceinline__ void xcd_barrier_complete(unsigned* bar, unsigned x, unsigned& nloc, unsigned& nx) {
    const unsigned G = gridDim.x * gridDim.y * gridDim.z;
    unsigned sum, cnt, mine, sp = 0u;
    for (;;) {
        sum = 0u; cnt = 0u; mine = 0u;
#pragma unroll
        for (unsigned j = 0; j < 16; ++j) { const unsigned c = xb_ld(&bar[XB_XCNT(j)]); sum += c; cnt += (c > 0u) ? 1u : 0u; mine = (j == x) ? c : mine; }
        if (sum == G) break;
        __builtin_amdgcn_s_sleep(1);
        if ((++sp & 255u) == 0u) { if (xb_ld(&bar[XB_TMO])) break; if (sp > XB_SPIN_CAP) { atomicAdd(&bar[XB_TMO], 1u); break; } }
    }
    nloc = mine > 0u ? mine : 1u; nx = cnt > 0u ? cnt : 1u;
}

__device__ __forceinline__ void xcd_barrier(const XcdBarrier& b) {
    asm volatile("s_waitcnt vmcnt(0)" ::: "memory");
    __syncthreads();
    if (b.wave0 && xb_lane() == 0u) {
        unsigned* bar = b.bar;
        __builtin_amdgcn_s_waitcnt(0);
        unsigned nloc = b.st[0], nx = b.st[1];
        if (nloc == 0u) { xcd_barrier_complete(bar, b.x, nloc, nx); b.st[0] = nloc; b.st[1] = nx; }
        const unsigned old = xb_add(&bar[XB_XSUB(b.x)], 1u);
        const unsigned gen = old / nloc;
        if (old + 1u == (gen + 1u) * nloc) {
            __builtin_amdgcn_fence(__ATOMIC_RELEASE, "agent");
            asm volatile("s_waitcnt vmcnt(0)" ::: "memory");
            const unsigned og = xb_add(&bar[XB_TOP], 1u);
            const unsigned tg = og / nx;
            if (og + 1u == (tg + 1u) * nx) xb_add(&bar[XB_TOPGEN], 1u);
            else XB_SPIN(xb_ld(&bar[XB_TOPGEN]) == tg, bar);
            __builtin_amdgcn_fence(__ATOMIC_ACQUIRE, "agent");
            xb_add(&bar[XB_XGEN(b.x)], 1u);
            asm volatile("s_waitcnt vmcnt(0)" ::: "memory");
        } else {
            XB_SPIN(xb_ld(&bar[XB_XGEN(b.x)]) == gen, bar);
            __builtin_amdgcn_fence(__ATOMIC_ACQUIRE, "agent");
            asm volatile("s_waitcnt vmcnt(0)" ::: "memory");
        }
    }
    __syncthreads();
}


struct Args { const float* in[23]; float* out; unsigned char* ws; int s_lo, s_hi, probe, pad; };

struct Frame {
    LAS unsigned char* lds; int tid, lane, wave, vcu, G;
    const float* const* in; float* h; unsigned char* ws; int probe;
};

__device__ __forceinline__ int hw_lane() { int l_; asm volatile("v_mbcnt_lo_u32_b32 %0, -1, 0\n\tv_mbcnt_hi_u32_b32 %0, -1, %0" : "=v"(l_)); return l_; }
__device__ __forceinline__ float shfl_xor_l(float v, int mask, int lane) { return __builtin_bit_cast(float, __builtin_amdgcn_ds_bpermute((lane ^ mask) << 2, __builtin_bit_cast(int, v))); }
__device__ __forceinline__ float dpp_add(float v, const int ctrl_sel) {
    const int x = __builtin_bit_cast(int, v); int y;
    if (ctrl_sel == 0) y = __builtin_amdgcn_mov_dpp(x, 0xB1, 0xF, 0xF, true);
    else if (ctrl_sel == 1) y = __builtin_amdgcn_mov_dpp(x, 0x4E, 0xF, 0xF, true);
    else if (ctrl_sel == 2) y = __builtin_amdgcn_mov_dpp(x, 0x141, 0xF, 0xF, true);
    else y = __builtin_amdgcn_mov_dpp(x, 0x140, 0xF, 0xF, true);
    return v + __builtin_bit_cast(float, y);
}
__device__ __forceinline__ float wave_sum_l(float v, int lane) {
    (void)lane;
    v = dpp_add(v, 0); v = dpp_add(v, 1); v = dpp_add(v, 2); v = dpp_add(v, 3);
    const int x = __builtin_bit_cast(int, v);
    const float r0 = __builtin_bit_cast(float, __builtin_amdgcn_readlane(x, 0)), r1 = __builtin_bit_cast(float, __builtin_amdgcn_readlane(x, 16)),
                r2 = __builtin_bit_cast(float, __builtin_amdgcn_readlane(x, 32)), r3 = __builtin_bit_cast(float, __builtin_amdgcn_readlane(x, 48));
    return (r0 + r1) + (r2 + r3);
}
#define LAUNDER(F) do { (F).lane = hw_lane(); (F).tid = (F).wave * 64 + (F).lane; asm volatile("" : "+s"((F).G), "+s"((F).vcu), "+s"((F).ws), "+s"((F).h)); } while (0)
__device__ __forceinline__ void p0_item(const float* W, int ldw, int k0, int n0, bf16* WT, int Kd, int drow0, float scale, LAS float* scr, int lane) {
#pragma unroll 8
    for (int i = 0; i < 32; ++i) { const int kk = 2 * i + (lane >> 5); scr[kk * 33 + (lane & 31)] = W[(size_t)(k0 + kk) * ldw + n0 + (lane & 31)] * scale; }
    LDS_WAIT(); asm volatile("" ::: "memory");
    const int c = lane & 7;
#pragma unroll
    for (int j = 0; j < 4; ++j) { const int n = (lane >> 3) + 8 * j; const LAS float* s = scr + (8 * c) * 33 + n;
        v4u o; o.x = pk2(s[0 * 33], s[1 * 33]); o.y = pk2(s[2 * 33], s[3 * 33]); o.z = pk2(s[4 * 33], s[5 * 33]); o.w = pk2(s[6 * 33], s[7 * 33]);
        *(v4u*)(WT + (size_t)(drow0 + n) * Kd + k0 + 8 * c) = o; }
    LDS_WAIT(); asm volatile("" ::: "memory");
}
__device__ __forceinline__ bool is_q_col(int n) { return n < 512 || (n >= 768 && n < 3072 && ((n - 768) % 768) < 256) || (n >= 3072 && n < 3584); }

__device__ __forceinline__ void ph_prologue(Frame& F) { LAUNDER(F);
    LAS float* scr = (LAS float*)(F.lds + RING_OFF + F.wave * 16384);
    const int gw = F.vcu * NWAVES + F.wave, NGW = F.G * NWAVES, lane = F.lane;
    const float* w_in = F.in[4]; const float* w_a = F.in[8]; const float* w_b = F.in[9]; const float* w_c = F.in[10]; const float* w_o = F.in[11];
    const float* w_eg = F.in[18]; const float* w_eu = F.in[19]; const float* w_ed = F.in[20];
    bf16* WIN = (bf16*)(F.ws + WS_WIN); bf16* WBRA = (bf16*)(F.ws + WS_WBRA); bf16* WBRB = (bf16*)(F.ws + WS_WBRB); bf16* WBRC = (bf16*)(F.ws + WS_WBRC); bf16* WOUT = (bf16*)(F.ws + WS_WOUT);
    bf16* WGU = (bf16*)(F.ws + WS_WGU); bf16* WD = (bf16*)(F.ws + WS_WD);
    constexpr int I_IN = 16 * (NCOL / 32), I_A = 8 * 32, I_B = 4 * 32, I_C = 8 * 32, I_O = 16 * 32, I_G = 16 * 16, I_D = 8 * 32;
    constexpr int I_LAYER = I_IN + I_A + I_B + I_C + I_O + NE * (2 * I_G + I_D);
    for (int it = gw; it < DEPTH * I_LAYER; it += NGW) {
        const int l = it / I_LAYER; int r = it % I_LAYER;
        if (r < I_IN) { const int nb = r % (NCOL / 32), kb = r / (NCOL / 32); p0_item(w_in + (size_t)l * D * NCOL, NCOL, 64 * kb, 32 * nb, WIN + (size_t)l * NCOL * D, D, 32 * nb, is_q_col(32 * nb) ? QSCALE : 1.0f, scr, lane); continue; } r -= I_IN;
        if (r < I_A) { const int nb = r % 32, kb = r / 32; p0_item(w_a + (size_t)l * 512 * D, D, 64 * kb, 32 * nb, WBRA + (size_t)l * D * 512, 512, 32 * nb, 1.0f, scr, lane); continue; } r -= I_A;
        if (r < I_B) { const int nb = r % 32, kb = r / 32; p0_item(w_b + (size_t)l * 256 * D, D, 64 * kb, 32 * nb, WBRB + (size_t)l * D * 256, 256, 32 * nb, 1.0f, scr, lane); continue; } r -= I_B;
        if (r < I_C) { const int nb = r % 32, kb = r / 32; p0_item(w_c + (size_t)l * 512 * D, D, 64 * kb, 32 * nb, WBRC + (size_t)l * D * 512, 512, 32 * nb, 1.0f, scr, lane); continue; } r -= I_C;
        if (r < I_O) { const int nb = r % 32, kb = r / 32; p0_item(w_o + (size_t)l * D * D, D, 64 * kb, 32 * nb, WOUT + (size_t)l * D * D, D, 32 * nb, 1.0f, scr, lane); continue; } r -= I_O;
        const int e = r / (2 * I_G + I_D); r %= (2 * I_G + I_D); const size_t le = (size_t)l * NE + e;
        if (r < 2 * I_G) { const int up = r / I_G; r %= I_G; const int nb = r % 16, kb = r / 16;
            p0_item((up ? w_eu : w_eg) + le * D * DE, DE, 64 * kb, 32 * nb, WGU + le * 1024 * 1024, D, (nb >> 2) * 256 + up * 128 + (nb & 3) * 32, 1.0f, scr, lane); continue; }
        r -= 2 * I_G; { const int nb = r % 32, kb = r / 32; p0_item(w_ed + le * DE * D, D, 64 * kb, 32 * nb, WD + le * D * DE, DE, 32 * nb, 1.0f, scr, lane); }
    }
}

struct LnIn { f32x4 v[4]; uint2 a[4], b[4]; };
template <int MODE> __device__ __forceinline__ void ln_load(LnIn& in, const float* src, const bf16* yb, size_t row, int lane) {
#pragma unroll
    for (int j = 0; j < 4; ++j) {
        const int c = lane * 4 + 256 * j;
        in.v[j] = *(const f32x4*)(src + row * D + c);
        if (MODE == 2) { in.a[j] = *(const uint2*)(yb + (row * 2) * D + c); in.b[j] = *(const uint2*)(yb + (row * 2 + 1) * D + c); }
    }
}
template <int MODE> __device__ __forceinline__ void ln_finish(const LnIn& in, float* hout, bf16* hb, const float* g, const float* bta, size_t row, int lane, f32x4 (&o)[4]) {
    f32x4 v[4];
#pragma unroll
    for (int j = 0; j < 4; ++j) {
        v[j] = in.v[j];
        if (MODE == 2) {
            const uint2 a = in.a[j], b = in.b[j];
            v[j].x = ALPHA * v[j].x + bf2f((bf16)(a.x & 0xffff)) + bf2f((bf16)(b.x & 0xffff));
            v[j].y = ALPHA * v[j].y + bf2f((bf16)(a.x >> 16)) + bf2f((bf16)(b.x >> 16));
            v[j].z = ALPHA * v[j].z + bf2f((bf16)(a.y & 0xffff)) + bf2f((bf16)(b.y & 0xffff));
            v[j].w = ALPHA * v[j].w + bf2f((bf16)(a.y >> 16)) + bf2f((bf16)(b.y >> 16));
        }
    }
    float s = 0.f;
#pragma unroll
    for (int j = 0; j < 4; ++j) s += (v[j].x + v[j].y) + (v[j].z + v[j].w);
    const float mean = wave_sum_l(s, lane) * (1.f / D);
    float q = 0.f;
#pragma unroll
    for (int j = 0; j < 4; ++j) { v[j] = v[j] - mean; q += (v[j].x * v[j].x + v[j].y * v[j].y) + (v[j].z * v[j].z + v[j].w * v[j].w); }
    const float rstd = 1.0f / sqrtf(wave_sum_l(q, lane) * (1.f / D) + LN_EPS);
#pragma unroll
    for (int j = 0; j < 4; ++j) {
        const int c = lane * 4 + 256 * j;
        const f32x4 gg = *(const f32x4*)(g + c), bb = *(const f32x4*)(bta + c);
        o[j] = v[j] * rstd * gg + bb;
        *(f32x4*)(hout + row * D + c) = o[j];
        if (hb) { uint2 w; w.x = pk2(o[j].x, o[j].y); w.y = pk2(o[j].z, o[j].w); *(uint2*)(hb + row * D + c) = w; }
    }
}

struct EpiP1 {
    static constexpr bool PERM = true;
    bf16* qkv; bf16* gates; const float* b_gate;
    __device__ __forceinline__ void operator()(const f32x4 (&acc)[2][2][4][2], const pg8::Unit& u, int wr, int wc, int fr, int fq) const {
        const int row0 = u.pm * 256 + wr * 64 + fr; const bool isg = u.pn >= 18;
        bf16* base = isg ? gates : qkv; const int ldc = isg ? GATEW : QKVW; const int col0 = (isg ? (u.pn - 18) : u.pn) * 256 + wc * 32 + 8 * fq;
        f32x4 bv[2][2];
#pragma unroll
        for (int bj = 0; bj < 2; ++bj)
#pragma unroll
            for (int n = 0; n < 2; ++n) bv[bj][n] = isg ? *(const f32x4*)(b_gate + col0 + bj * 128 + 4 * n) : (f32x4){0.f, 0.f, 0.f, 0.f};
#pragma unroll
        for (int ai = 0; ai < 2; ++ai)
#pragma unroll
            for (int m = 0; m < 4; ++m) { bf16* rowp = base + (size_t)(row0 + ai * 128 + m * 16) * ldc + col0;
#pragma unroll
                for (int bj = 0; bj < 2; ++bj) { f32x4 v0 = acc[ai][bj][m][0] + bv[bj][0], v1 = acc[ai][bj][m][1] + bv[bj][1];
                    if (isg) {
#pragma unroll
                        for (int j = 0; j < 4; ++j) { v0[j] = __builtin_amdgcn_rcpf(1.0f + __builtin_amdgcn_exp2f(-LOG2E * v0[j])); v1[j] = __builtin_amdgcn_rcpf(1.0f + __builtin_amdgcn_exp2f(-LOG2E * v1[j])); } }
                    v4u w; w.x = pg8::cvt_pk_bf16(v0[0], v0[1]); w.y = pg8::cvt_pk_bf16(v0[2], v0[3]); w.z = pg8::cvt_pk_bf16(v1[0], v1[1]); w.w = pg8::cvt_pk_bf16(v1[2], v1[3]);
                    *(v4u*)(rowp + bj * 128) = w; } }
    }
};
template <bool FIRST> struct EpiP3 {
    static constexpr bool PERM = true;
    bf16* merged; const bf16* gates; int br;
    __device__ __forceinline__ void operator()(const f32x4 (&acc)[2][2][4][2], const pg8::Unit& u, int wr, int wc, int fr, int fq) const {
        const int row0 = u.pm * 256 + wr * 64 + fr, col0 = u.pn * 256 + wc * 32 + 8 * fq;
#pragma unroll
        for (int ai = 0; ai < 2; ++ai) {
            v4u gw[4][2], ow[4][2];
#pragma unroll
            for (int m = 0; m < 4; ++m)
#pragma unroll
                for (int bj = 0; bj < 2; ++bj) { const size_t row = (size_t)(row0 + ai * 128 + m * 16);
                    gw[m][bj] = *(const v4u*)(gates + row * GATEW + br * 1024 + col0 + bj * 128);
                    ow[m][bj] = FIRST ? (v4u){0u, 0u, 0u, 0u} : *(const v4u*)(merged + row * D + col0 + bj * 128); }
#pragma unroll
            for (int m = 0; m < 4; ++m)
#pragma unroll
                for (int bj = 0; bj < 2; ++bj) { const size_t row = (size_t)(row0 + ai * 128 + m * 16);
                    const f32x4 a0 = acc[ai][bj][m][0], a1 = acc[ai][bj][m][1];
                    float r[8];
#pragma unroll
                    for (int j = 0; j < 4; ++j) { const unsigned g2 = gw[m][bj][j], o2 = ow[m][bj][j]; const float av0 = j < 2 ? a0[2 * j] : a1[2 * j - 4], av1 = j < 2 ? a0[2 * j + 1] : a1[2 * j - 3];
                        r[2 * j] = __uint_as_float(g2 << 16) * av0 + (FIRST ? 0.f : __uint_as_float(o2 << 16)); r[2 * j + 1] = __uint_as_float(g2 & 0xffff0000u) * av1 + (FIRST ? 0.f : __uint_as_float(o2 & 0xffff0000u)); }
                    v4u w; w.x = pg8::cvt_pk_bf16(r[0], r[1]); w.y = pg8::cvt_pk_bf16(r[2], r[3]); w.z = pg8::cvt_pk_bf16(r[4], r[5]); w.w = pg8::cvt_pk_bf16(r[6], r[7]);
                    *(v4u*)(merged + row * D + col0 + bj * 128) = w; }
            asm volatile("" ::: "memory"); }
    }
};
struct EpiP4 {
    static constexpr bool PERM = false;
    const float* hc; float* ho;
    __device__ __forceinline__ void operator()(const f32x4 (&acc)[2][2][4][2], const pg8::Unit& u, int wr, int wc, int fr, int fq) const {
        const int row0 = u.pm * 256 + wr * 64 + fr, col0 = u.pn * 256 + wc * 32 + 4 * fq;
#pragma unroll
        for (int ai = 0; ai < 2; ++ai)
#pragma unroll
            for (int mp = 0; mp < 2; ++mp) { f32x4 hv[2][2][2];
#pragma unroll
                for (int mm = 0; mm < 2; ++mm)
#pragma unroll
                    for (int bj = 0; bj < 2; ++bj)
#pragma unroll
                        for (int n = 0; n < 2; ++n) hv[mm][bj][n] = *(const f32x4*)(hc + (size_t)(row0 + ai * 128 + (2 * mp + mm) * 16) * D + col0 + bj * 128 + n * 16);
#pragma unroll
                for (int mm = 0; mm < 2; ++mm)
#pragma unroll
                    for (int bj = 0; bj < 2; ++bj)
#pragma unroll
                        for (int n = 0; n < 2; ++n) *(f32x4*)(ho + (size_t)(row0 + ai * 128 + (2 * mp + mm) * 16) * D + col0 + bj * 128 + n * 16) = hv[mm][bj][n] * ALPHA + acc[ai][bj][2 * mp + mm][n];
                asm volatile("" ::: "memory"); }
    }
};
struct EpiP7 {
    static constexpr bool PERM = true;
    bf16* hid;
    __device__ __forceinline__ void operator()(const f32x4 (&acc)[2][2][4][2], const pg8::Unit& u, int wr, int wc, int fr, int fq) const {
        const int row0 = u.pm * 256 + wr * 64 + fr, col0 = u.pn * 128 + wc * 32 + 8 * fq;
#pragma unroll
        for (int ai = 0; ai < 2; ++ai)
#pragma unroll
            for (int m = 0; m < 4; ++m) { float r[8];
#pragma unroll
                for (int n = 0; n < 2; ++n)
#pragma unroll
                    for (int j = 0; j < 4; ++j) { const float gv = acc[ai][0][m][n][j], uv = acc[ai][1][m][n][j]; r[4 * n + j] = gv * __builtin_amdgcn_rcpf(1.0f + __builtin_amdgcn_exp2f(-LOG2E * gv)) * uv; }
                v4u w; w.x = pg8::cvt_pk_bf16(r[0], r[1]); w.y = pg8::cvt_pk_bf16(r[2], r[3]); w.z = pg8::cvt_pk_bf16(r[4], r[5]); w.w = pg8::cvt_pk_bf16(r[6], r[7]);
                *(v4u*)(hid + (size_t)(row0 + ai * 128 + m * 16) * DE + col0) = w; }
    }
};
struct EpiP8 {
    static constexpr bool PERM = true;
    bf16* yb; const int* rowtok; const float* rowgate;
    __device__ __forceinline__ void operator()(const f32x4 (&acc)[2][2][4][2], const pg8::Unit& u, int wr, int wc, int fr, int fq) const {
        const int row0 = u.pm * 256 + wr * 64 + fr, col0 = u.pn * 256 + wc * 32 + 8 * fq;
        int rt[2][4]; float gt[2][4];
#pragma unroll
        for (int ai = 0; ai < 2; ++ai)
#pragma unroll
            for (int m = 0; m < 4; ++m) { const int row = row0 + ai * 128 + m * 16; rt[ai][m] = rowtok[row]; gt[ai][m] = rowgate[row]; }
#pragma unroll
        for (int ai = 0; ai < 2; ++ai)
#pragma unroll
            for (int m = 0; m < 4; ++m) {
                if (rt[ai][m] >= 0) {
#pragma unroll
                    for (int bj = 0; bj < 2; ++bj) { const f32x4 v0 = acc[ai][bj][m][0] * gt[ai][m], v1 = acc[ai][bj][m][1] * gt[ai][m];
                        v4u w; w.x = pg8::cvt_pk_bf16(v0[0], v0[1]); w.y = pg8::cvt_pk_bf16(v0[2], v0[3]); w.z = pg8::cvt_pk_bf16(v1[0], v1[1]); w.w = pg8::cvt_pk_bf16(v1[2], v1[3]);
                        *(v4u*)(yb + (size_t)rt[ai][m] * D + col0 + bj * 128) = w; } } }
    }
};

__device__ __forceinline__ void router_row(const float (&x)[16], int t, int lane, const LAS float* w_rg, const float* b_rg, const LAS float* w_re, const float* b_re, LAS int* lcnt, int wslot, Rec* rec) {
    float gl[4] = {0.f, 0.f, 0.f, 0.f};
#pragma unroll
    for (int j = 0; j < 4; ++j)
#pragma unroll
        for (int i = 0; i < 4; ++i) { const f32x4 w = *(const LAS f32x4*)(w_rg + ((j * 4 + i) * 64 + lane) * 4); const float xv = x[4 * j + i]; gl[0] += xv * w.x; gl[1] += xv * w.y; gl[2] += xv * w.z; gl[3] += xv * w.w; }
#pragma unroll
    for (int g = 0; g < 4; ++g) gl[g] = wave_sum_l(gl[g], lane) + b_rg[g];
    int gi = 0; float gm = gl[0];
#pragma unroll
    for (int g = 1; g < 4; ++g) if (gl[g] > gm) { gm = gl[g]; gi = g; }
    float gs = 0.f;
#pragma unroll
    for (int g = 0; g < 4; ++g) gs += __expf(gl[g] - gm);
    const float gw = 1.0f / gs;
    float el[8];
#pragma unroll
    for (int e = 0; e < 8; ++e) el[e] = 0.f;
    const LAS float* wre = w_re + gi * (D * 8);
#pragma unroll
    for (int j = 0; j < 4; ++j)
#pragma unroll
        for (int i = 0; i < 4; ++i) { const LAS float* wp = wre + ((j * 4 + i) * 128 + lane) * 4; const f32x4 w0 = *(const LAS f32x4*)wp, w1 = *(const LAS f32x4*)(wp + 256); const float xv = x[4 * j + i];
            el[0] += xv * w0.x; el[1] += xv * w0.y; el[2] += xv * w0.z; el[3] += xv * w0.w; el[4] += xv * w1.x; el[5] += xv * w1.y; el[6] += xv * w1.z; el[7] += xv * w1.w; }
#pragma unroll
    for (int e = 0; e < 8; ++e) el[e] = wave_sum_l(el[e], lane) + b_re[gi * 8 + e];
    int i0 = 0; float t0 = el[0];
#pragma unroll
    for (int e = 1; e < 8; ++e) if (el[e] > t0) { t0 = el[e]; i0 = e; }
    int i1 = -1; float t1 = -3.0e38f;
#pragma unroll
    for (int e = 0; e < 8; ++e) if (e != i0 && el[e] > t1) { t1 = el[e]; i1 = e; }
    const float ex = __expf(t1 - t0), p0 = 1.0f / (1.0f + ex), p1 = ex / (1.0f + ex);
    if (lane == 0) {
        Rec rc; rc.e0 = gi * 8 + i0; rc.e1 = gi * 8 + i1; rc.g0 = gw * p0; rc.g1 = gw * p1; rc.pad0 = wslot; rc.pad1 = 0;
        rc.s0 = __hip_atomic_fetch_add(lcnt + rc.e0, 1, __ATOMIC_RELAXED, __HIP_MEMORY_SCOPE_WORKGROUP); rc.s1 = __hip_atomic_fetch_add(lcnt + rc.e1, 1, __ATOMIC_RELAXED, __HIP_MEMORY_SCOPE_WORKGROUP);
        rec[t] = rc;
    }
}

__device__ __forceinline__ void ph_ln0(Frame& F) { LAUNDER(F);
    const int gw = F.vcu * NWAVES + F.wave, NGW = F.G * NWAVES;
    bf16* hb = (bf16*)(F.ws + WS_HB);
    LnIn cur, nxt; if (gw < T) ln_load<0>(cur, F.in[0], nullptr, (size_t)gw, F.lane);
    for (int m = gw; m < T; m += NGW) { const bool more = m + NGW < T; if (more) ln_load<0>(nxt, F.in[0], nullptr, (size_t)(m + NGW), F.lane);
        f32x4 o[4]; ln_finish<0>(cur, F.h, hb, F.in[1], F.in[2], (size_t)m, F.lane, o); if (more) cur = nxt; }
}
__device__ __forceinline__ void ph_p1(Frame& F, int l, int c) { LAUNDER(F); asm volatile("" : "+s"(l), "+s"(c));
    pg8::DenseOrder S; S.init((const bf16*)(F.ws + WS_HB) + (size_t)c * CH * D, D, (const bf16*)(F.ws + WS_WIN) + (size_t)l * NCOL * D, D, CH, NCOL, F.G, (int)blockIdx.x);
    EpiP1 E{(bf16*)(F.ws + WS_QKV), (bf16*)(F.ws + WS_GATES), F.in[5] + (size_t)l * GATEW};
    pg8::gemm_phase<EpiP1, pg8::DenseOrder, false>(F.lds + RING_OFF, S, E, D, D, D, F.tid);
}
__device__ __forceinline__ void ph_cmb(Frame& F) { LAUNDER(F);
    const bf16* og = (const bf16*)(F.ws + WS_OG); const float* lse = (const float*)(F.ws + WS_LSE); bf16* oabc = (bf16*)(F.ws + WS_OABC);
    for (int idx = F.vcu * NTHREADS + F.tid; idx < CH * 32; idx += F.G * NTHREADS) {
        const int tl = idx >> 5, hc = idx & 31, h = hc >> 3, c = hc & 7;
        const float l0 = lse[((size_t)tl * 3 + 0) * 4 + h], l1 = lse[((size_t)tl * 3 + 1) * 4 + h], l2 = lse[((size_t)tl * 3 + 2) * 4 + h];
        const float mx = fmaxf(l0, fmaxf(l1, l2)); float w0 = __expf(l0 - mx), w1 = __expf(l1 - mx), w2 = __expf(l2 - mx); const float inv = 1.0f / (w0 + w1 + w2); w0 *= inv; w1 *= inv; w2 *= inv;
        const v4u a = *(const v4u*)(og + ((size_t)tl * 3 + 0) * 256 + h * 64 + c * 8), b = *(const v4u*)(og + ((size_t)tl * 3 + 1) * 256 + h * 64 + c * 8), d = *(const v4u*)(og + ((size_t)tl * 3 + 2) * 256 + h * 64 + c * 8);
        v4u ow;
#pragma unroll
        for (int i = 0; i < 4; ++i) {
            const float lo = w0 * __uint_as_float(a[i] << 16) + w1 * __uint_as_float(b[i] << 16) + w2 * __uint_as_float(d[i] << 16);
            const float hi = w0 * __uint_as_float(a[i] & 0xffff0000u) + w1 * __uint_as_float(b[i] & 0xffff0000u) + w2 * __uint_as_float(d[i] & 0xffff0000u);
            ow[i] = pk2(lo, hi);
        }
        *(v4u*)(oabc + (size_t)tl * OW + 512 + h * 64 + c * 8) = ow;
    }
}
__device__ __forceinline__ void ph_p3(Frame& F, int l) { LAUNDER(F); asm volatile("" : "+s"(l));
    const bf16* oabc = (const bf16*)(F.ws + WS_OABC); bf16* merged = (bf16*)(F.ws + WS_MERGED); const bf16* gates = (const bf16*)(F.ws + WS_GATES);
    { pg8::DenseOrder S; S.init(oabc, OW, (const bf16*)(F.ws + WS_WBRA) + (size_t)l * D * 512, 512, CH, D, F.G, (int)blockIdx.x);
      EpiP3<true> E{merged, gates, 0}; pg8::gemm_phase<EpiP3<true>, pg8::DenseOrder, false>(F.lds + RING_OFF, S, E, 512, OW, 512, F.tid); }
    { pg8::DenseOrder S; S.init(oabc + 512, OW, (const bf16*)(F.ws + WS_WBRB) + (size_t)l * D * 256, 256, CH, D, F.G, (int)blockIdx.x);
      EpiP3<false> E{merged, gates, 1}; pg8::gemm_phase<EpiP3<false>, pg8::DenseOrder, false>(F.lds + RING_OFF, S, E, 256, OW, 256, F.tid); }
    { pg8::DenseOrder S; S.init(oabc + 768, OW, (const bf16*)(F.ws + WS_WBRC) + (size_t)l * D * 512, 512, CH, D, F.G, (int)blockIdx.x);
      EpiP3<false> E{merged, gates, 2}; pg8::gemm_phase<EpiP3<false>, pg8::DenseOrder, false>(F.lds + RING_OFF, S, E, 512, OW, 512, F.tid); }
}
__device__ __forceinline__ void ph_p4(Frame& F, int l, int c) { LAUNDER(F); asm volatile("" : "+s"(l), "+s"(c));
    pg8::DenseOrder S; S.init((const bf16*)(F.ws + WS_MERGED), D, (const bf16*)(F.ws + WS_WOUT) + (size_t)l * D * D, D, CH, D, F.G, (int)blockIdx.x);
    EpiP4 E{F.h + (size_t)c * CH * D, F.probe ? (float*)(F.ws + WS_OABC) : F.h + (size_t)c * CH * D};
    pg8::gemm_phase<EpiP4, pg8::DenseOrder, false>(F.lds + RING_OFF, S, E, D, D, D, F.tid);
}
__device__ __forceinline__ void ph_ln1(Frame& F, int l, int c) { LAUNDER(F); asm volatile("" : "+s"(l), "+s"(c));
    const int gw = F.vcu * NWAVES + F.wave, NGW = F.G * NWAVES;
    bf16* hb = (bf16*)(F.ws + WS_HB); Rec* rec = (Rec*)(F.ws + WS_REC);
    int* wgc = (int*)(F.ws + WS_WGCNT) + ((size_t)(l * NCHUNK + c) * F.G + F.vcu) * 32;
    float* hout = F.h;
    if (F.probe) { hout = (float*)(F.ws + WS_OABC) - (size_t)c * CH * D; hb = (bf16*)(F.ws + WS_QKV) - (size_t)c * CH * D; wgc = (int*)(F.ws + WS_WGCNT) + (size_t)DEPTH * NCHUNK * 256 * 32 + F.vcu * 32; rec = (Rec*)(F.ws + WS_GATES); }
    LAS float* lrg = (LAS float*)(F.lds + RING_OFF); LAS float* lre = lrg + D * 4; LAS int* lcnt = (LAS int*)(F.lds + LCNT_OFF);
    { const float* w_rg = F.in[14] + (size_t)l * D * 4; const float* w_re = F.in[16] + (size_t)l * 4 * D * 8;
      if (F.tid < 32) lcnt[F.tid] = 0;
      for (int u = F.tid; u < D + 4 * D * 2; u += NTHREADS) {
          if (u < D) { const int e = u, ln = (e & 255) >> 2, i = e & 3, j = e >> 8; *(LAS f32x4*)(lrg + ((j * 4 + i) * 64 + ln) * 4) = *(const f32x4*)(w_rg + (size_t)e * 4); }
          else { const int v = u - D, half = v & 1, e = (v >> 1) & 1023, g = v >> 11, ln = (e & 255) >> 2, i = e & 3, j = e >> 8;
                 *(LAS f32x4*)(lre + g * (D * 8) + (((j * 4 + i) * 2 + half) * 64 + ln) * 4) = *(const f32x4*)(w_re + ((size_t)g * D + e) * 8 + half * 4); } }
      __syncthreads(); }
    const size_t rbase = (size_t)c * CH;
    LnIn cur, nxt; if (gw < CH) ln_load<1>(cur, F.h, nullptr, rbase + gw, F.lane);
    for (int m = gw; m < CH; m += NGW) {
        const bool more = m + NGW < CH; if (more) ln_load<1>(nxt, F.h, nullptr, rbase + m + NGW, F.lane);
        const size_t row = rbase + m; f32x4 o[4];
        ln_finish<1>(cur, hout, hb, F.in[12] + l * D, F.in[13] + l * D, row, F.lane, o);
        float x[16];
#pragma unroll
        for (int j = 0; j < 4; ++j) { x[4 * j] = o[j].x; x[4 * j + 1] = o[j].y; x[4 * j + 2] = o[j].z; x[4 * j + 3] = o[j].w; }
        router_row(x, (int)row, F.lane, lrg, F.in[15] + l * 4, lre, F.in[17] + l * 32, lcnt, c * F.G + F.vcu, rec);
        if (more) cur = nxt;
    }
    __syncthreads();
    if (F.tid < 32) wgc[F.tid] = lcnt[F.tid];
}
__device__ __forceinline__ void ph_dsp(Frame& F, int l) { LAUNDER(F); asm volatile("" : "+s"(l));
    LAS int* Tb = (LAS int*)(F.lds + RING_OFF); LAS int* part = Tb + 512 * 32; LAS int* po = part + 32 * 16;
    const int* wg = (const int*)(F.ws + WS_WGCNT) + (size_t)l * NCHUNK * F.G * 32; const int W = NCHUNK * F.G;
    int* cnt = (int*)(F.ws + WS_CTL) + CW_CNT + l * (32 * CSTR); const Rec* rec = (const Rec*)(F.ws + WS_REC); int* rowtok = (int*)(F.ws + WS_ROWTOK); float* rowgate = (float*)(F.ws + WS_ROWGATE);
    for (int i = F.tid; i < W * 32; i += NTHREADS) Tb[i] = wg[i];
    __syncthreads();
    const int e = F.tid >> 4, k = F.tid & 15, per = (W + 15) / 16, w0 = k * per, w1 = (w0 + per) < W ? (w0 + per) : W;
    { int s = 0; for (int w = w0; w < w1; ++w) s += Tb[w * 32 + e]; part[e * 16 + k] = s; }
    __syncthreads();
    { int base = 0; for (int kk = 0; kk < k; ++kk) base += part[e * 16 + kk];
      for (int w = w0; w < w1; ++w) { const int t = Tb[w * 32 + e]; Tb[w * 32 + e] = base; base += t; } }
    __syncthreads();
    if (F.tid == 0) { int acc = 0; for (int ee = 0; ee < NE; ++ee) { int tot = 0; for (int kk = 0; kk < 16; ++kk) tot += part[ee * 16 + kk]; po[ee] = acc; part[ee * 16] = tot; acc += (tot + 255) / 256 * 256; } po[NE] = acc; }
    __syncthreads();
    if (F.vcu == 0 && F.tid < 32) cnt[F.tid * CSTR] = part[F.tid * 16];
    const int gt = F.vcu * NTHREADS + F.tid, GT = F.G * NTHREADS;
    for (int t = gt; t < T; t += GT) {
        const Rec rc = rec[t];
        const int d0 = po[rc.e0] + Tb[rc.pad0 * 32 + rc.e0] + rc.s0, d1 = po[rc.e1] + Tb[rc.pad0 * 32 + rc.e1] + rc.s1;
        rowtok[d0] = 2 * t; rowgate[d0] = rc.g0; rowtok[d1] = 2 * t + 1; rowgate[d1] = rc.g1;
    }
    for (int ee = 0; ee < NE; ++ee) for (int r = po[ee] + part[ee * 16] + gt; r < po[ee + 1]; r += GT) { rowtok[r] = -1; rowgate[r] = 0.f; }
    __syncthreads();
}
__device__ __forceinline__ int moe_setup(Frame& F, int l, bool gather) { LAUNDER(F); asm volatile("" : "+s"(l));
    LAS int* rows = (LAS int*)(F.lds + ROWS_OFF); LAS int* ulist = rows + 11 * 256; LAS int* po = ulist + 16;
    const int* cnt = (const int*)(F.ws + WS_CTL) + CW_CNT + l * (32 * CSTR); const int* rowtok = (const int*)(F.ws + WS_ROWTOK);
    if (F.tid == 0) { int acc = 0; for (int e = 0; e < NE; ++e) { po[e] = acc; acc += (cnt[e * CSTR] + 255) / 256 * 256; } po[NE] = acc; }
    __syncthreads();
    const int nu_all = (po[NE] / 256) * 4; int nun = (nu_all - F.vcu + F.G - 1) / F.G; nun = nun < 0 ? 0 : (nun > 11 ? 11 : nun);
    if (F.tid < nun) { const int Lx = F.tid * F.G + F.vcu, rt = Lx >> 2, pn = Lx & 3; int e = 0; while (e < NE - 1 && po[e + 1] <= rt * 256) ++e; ulist[F.tid] = (rt << 8) | (e << 2) | pn; }
    if (gather) for (int idx = F.tid; idx < nun * 256; idx += NTHREADS) { const int i = idx >> 8, r = idx & 255, Lx = i * F.G + F.vcu; rows[idx] = rowtok[(Lx >> 2) * 256 + r]; }
    __syncthreads();
    return nun;
}
struct MoeOrder {
    int nun; const LAS int* ulist; const LAS int* rows; const char* A; const char* B; size_t tstepA, estepB, tstepB;
    __device__ __forceinline__ bool next(int i, pg8::Unit& u) const {
        if (i >= nun) return false;
        const int w = __builtin_amdgcn_readfirstlane(ulist[i]); u.pm = w >> 8; u.e = (w >> 2) & 63; u.pn = w & 3; u.ui = i; return true;
    }
    __device__ __forceinline__ const char* a_base(const pg8::Unit& u) const { return A + (size_t)u.pm * tstepA; }
    __device__ __forceinline__ const char* b_base(const pg8::Unit& u) const { return B + (size_t)u.e * estepB + (size_t)u.pn * tstepB; }
    __device__ __forceinline__ int a_row(const pg8::Unit& u, int r) const { const int t = rows[u.ui * 256 + r]; return t < 0 ? 0 : (t >> 1); }
};
__device__ __forceinline__ void ph_p7(Frame& F, int l) { LAUNDER(F); asm volatile("" : "+s"(l));
    const int nun = moe_setup(F, l, true);
    LAS int* rows = (LAS int*)(F.lds + ROWS_OFF);
    MoeOrder S{nun, rows + 11 * 256, rows, (const char*)(F.ws + WS_HB), (const char*)(F.ws + WS_WGU) + (size_t)l * NE * 1024 * 1024 * 2, 0, (size_t)1024 * 1024 * 2, (size_t)256 * 1024 * 2};
    EpiP7 E{(bf16*)(F.ws + WS_HID)};
    pg8::gemm_phase<EpiP7, MoeOrder, true>(F.lds + RING_OFF, S, E, D, D, D, F.tid);
}
__device__ __forceinline__ void ph_p8(Frame& F, int l) { LAUNDER(F); asm volatile("" : "+s"(l));
    const int nun = moe_setup(F, l, false);
    LAS int* rows = (LAS int*)(F.lds + ROWS_OFF);
    MoeOrder S{nun, rows + 11 * 256, rows, (const char*)(F.ws + WS_HID), (const char*)(F.ws + WS_WD) + (size_t)l * NE * 1024 * 512 * 2, (size_t)256 * DE * 2, (size_t)1024 * 512 * 2, (size_t)256 * 512 * 2};
    EpiP8 E{(bf16*)(F.ws + WS_YB), (const int*)(F.ws + WS_ROWTOK), (const float*)(F.ws + WS_ROWGATE)};
    pg8::gemm_phase<EpiP8, MoeOrder, false>(F.lds + RING_OFF, S, E, DE, DE, DE, F.tid);
}
__device__ __forceinline__ void ph_ln2(Frame& F, int l) { LAUNDER(F); asm volatile("" : "+s"(l));
    const int gw = F.vcu * NWAVES + F.wave, NGW = F.G * NWAVES;
    bf16* hb = (l == DEPTH - 1) ? nullptr : (bf16*)(F.ws + WS_HB); const bf16* yb = (const bf16*)(F.ws + WS_YB);
    float* hout = F.h; size_t omask = ~(size_t)0;
    if (F.probe) { hout = (float*)(F.ws + WS_OABC); hb = nullptr; omask = 32767; }
    LnIn cur, nxt; if (gw < T) ln_load<2>(cur, F.h, yb, (size_t)gw, F.lane);
    for (int m = gw; m < T; m += NGW) { const bool more = m + NGW < T; if (more) ln_load<2>(nxt, F.h, yb, (size_t)(m + NGW), F.lane);
        f32x4 o[4]; ln_finish<2>(cur, hout - ((size_t)m - ((size_t)m & omask)) * D, hb, F.in[21] + l * D, F.in[22] + l * D, (size_t)m, F.lane, o); if (more) cur = nxt; }
}

typedef short s16x4 __attribute__((ext_vector_type(4)));
constexpr int NT_A = (CH / 32) * 4, NT_B = (CH / L) * 3 * 128 * 4, NT_C = (CH / 64) * 8, NT_ALL = NT_A + NT_B + NT_C;
constexpr float NEGBIG = -1.0e30f, MINIT = -5.0e29f;
#define RC16(reg) (((reg) & 3) + 8 * ((reg) >> 2))

__device__ __forceinline__ void ph_tables(Frame& F) { LAUNDER(F);
    float* TA = (float*)(F.ws + WS_TABA); float* TB = (float*)(F.ws + WS_TABB); float* TC = (float*)(F.ws + WS_TABC);
    const float* rel_bias = F.in[3]; const float* rpb = F.in[7];
    const int gt = F.vcu * NTHREADS + F.tid, GT = F.G * NTHREADS;
    for (int i = gt; i < 8 * 320; i += GT) { const int h = i / 320, rel = i % 320 - 160; TA[i] = (rel >= -128 && rel <= 128) ? rel_bias[BUCK_A[rel + 128] * 20 + h] * LOG2E : NEGBIG; }
    for (int i = gt; i < 12 * 256; i += GT) { const int gh = i >> 8, g = gh >> 2, rel = (i & 255) - 128; TB[i] = (rel >= -64 && rel <= 64) ? rel_bias[BUCK_B[g][rel + 64] * 20 + 8 + gh] * LOG2E : NEGBIG; }
    for (int i = gt; i < DEPTH * 8 * 1024; i += GT) { const int lh = i >> 10, ri = (i >> 6) & 15, ci = (i & 63) - 16; TC[i] = (ri < 15 && ci >= 0 && ci <= 30) ? rpb[((size_t)lh * 15 + ri) * 31 + ci] * LOG2E : NEGBIG; }
}

#define ATT_SOFTMAX(S, m, l, Oa, Ob, TBP, BIDX, XM) do { \
        float tmax_ = NEGBIG; \
        _Pragma("unroll") for (int r_ = 0; r_ < 16; ++r_) { float v_ = S[r_] + (TBP)[(BIDX) + RC16(r_)]; if (TYPE == 2) v_ = ((unsigned)((XM) + RC16(r_)) < 16u) ? v_ : NEGBIG; S[r_] = v_; tmax_ = fmaxf(tmax_, v_); } \
        tmax_ = fmaxf(tmax_, shfl_xor_l(tmax_, 32, lane)); \
        const float mn_ = fmaxf(m, tmax_), corr_ = __builtin_amdgcn_exp2f(m - mn_); \
        float rsum_ = 0.f; \
        _Pragma("unroll") for (int r_ = 0; r_ < 16; ++r_) { const float p_ = __builtin_amdgcn_exp2f(S[r_] - mn_); S[r_] = p_; rsum_ += p_; } \
        rsum_ += shfl_xor_l(rsum_, 32, lane); \
        l = l * corr_ + rsum_; m = mn_; \
        _Pragma("unroll") for (int i_ = 0; i_ < 16; ++i_) { Oa[i_] *= corr_; Ob[i_] *= corr_; } \
    } while (0)
#define ATT_PACK(Pf, S, s2) do { unsigned pw_[4]; _Pragma("unroll") for (int j_ = 0; j_ < 4; ++j_) pw_[j_] = pg8::cvt_pk_bf16(S[8 * (s2) + 2 * j_], S[8 * (s2) + 2 * j_ + 1]); \
        Pf = __builtin_bit_cast(bf16x8, (v4u){pw_[0], pw_[1], pw_[2], pw_[3]}); } while (0)
#define ATT_STORE(orow, Oa, Ob, l) do { const float inv_ = 1.0f / (l); \
        _Pragma("unroll") for (int g_ = 0; g_ < 4; ++g_) { v2u w0_, w1_; \
            w0_.x = pg8::cvt_pk_bf16(Oa[4 * g_] * inv_, Oa[4 * g_ + 1] * inv_); w0_.y = pg8::cvt_pk_bf16(Oa[4 * g_ + 2] * inv_, Oa[4 * g_ + 3] * inv_); \
            w1_.x = pg8::cvt_pk_bf16(Ob[4 * g_] * inv_, Ob[4 * g_ + 1] * inv_); w1_.y = pg8::cvt_pk_bf16(Ob[4 * g_ + 2] * inv_, Ob[4 * g_ + 3] * inv_); \
            *(v2u*)((orow) + 8 * g_ + 4 * hh) = w0_; *(v2u*)((orow) + 32 + 8 * g_ + 4 * hh) = w1_; } } while (0)

template <int TYPE>
__device__ __forceinline__ void att_task2(LAS unsigned char* wl, const int lane, const bf16* seq  , const float* tab0, const float* tab1,
                                          const int qcol0, const int qcol1, const int kcol, const int vcol, const int TT0, const int TSTEP, const int kstride, const int tlo, const int thi,
                                          const int tq0, const int tq1  , const int toff1  ,
                                          const int gi0, const int gi1, const int gc, const int cbs  ,
                                          const float m_init0, const float m_init1, const float l_init, bf16* orow0, bf16* orow1, float* lse0, float* lse1) {
    const int qi = lane & 31, hh = lane >> 5;
    LAS unsigned char* kt = wl; LAS unsigned char* vt = wl + 4096; LAS float* tb0 = (LAS float*)(wl + 8192); LAS float* tb1 = (TYPE == 0) ? tb0 + 320 : tb0;
    constexpr int TBN = TYPE == 0 ? 320 : (TYPE == 1 ? 256 : 1024);
#pragma unroll
    for (int i = 0; i < TBN / 64; ++i) { tb0[lane + 64 * i] = tab0[lane + 64 * i]; if (TYPE == 0) tb1[lane + 64 * i] = tab1[lane + 64 * i]; }
    bf16x8 Qa[4], Qb[4];
#pragma unroll
    for (int s = 0; s < 4; ++s) { Qa[s] = *(const bf16x8*)(seq + (size_t)tq0 * QKVW + qcol0 + 16 * s + 8 * hh); Qb[s] = *(const bf16x8*)(seq + (size_t)tq1 * QKVW + qcol1 + 16 * s + 8 * hh); }
    f32x16 O0a, O0b, O1a, O1b;
#pragma unroll
    for (int i = 0; i < 16; ++i) { O0a[i] = 0.f; O0b[i] = 0.f; O1a[i] = 0.f; O1b[i] = 0.f; }
    float m0 = m_init0, m1 = m_init1, l0 = l_init, l1 = l_init;
    const int lkey = lane >> 3, lch = lane & 7;
    const unsigned goff = (unsigned)(lkey * kstride) * (unsigned)(QKVW * 2) + 16u * (unsigned)lch;
    const size_t istepb = (size_t)8 * kstride * QKVW * 2;
    const char* kbase = (const char*)(seq + kcol); const char* vbase = (const char*)(seq + vcol);
    const unsigned kw0 = lkey * 128 + ((lch ^ (lkey & 7)) << 4), vw0 = lkey * 128 + (((lch >> 2) ^ ((lkey >> 1) & 1)) << 6) + ((lch & 3) << 4);
    const unsigned kr0 = qi * 128 + ((hh ^ (qi & 7)) << 4);
    const int q4 = (lane & 15) >> 2, p4 = lane & 3, g1 = (lane >> 4) & 1, sw = (q4 >> 1) & 1;
    const unsigned vr0 = (4 * hh + q4) * 128 + 32 * g1 + 8 * p4 + (sw << 6), vr1 = (4 * hh + q4) * 128 + 32 * g1 + 8 * p4 + ((sw ^ 1) << 6);
    const int bidx0 = (TYPE == 2) ? (cbs - gc + 31 + 4 * hh) : ((TYPE == 1 ? 64 : 32) - qi + 4 * hh);
    int cs = gc - 8; cs = cs < 0 ? 0 : (cs > 48 ? 48 : cs);
    const int xm = cbs - cs + 4 * hh;
    int rs0 = gi0 - 4; rs0 = rs0 < 0 ? 0 : (rs0 > 120 ? 120 : rs0);
    int rs1 = gi1 - 4; rs1 = rs1 < 0 ? 0 : (rs1 > 120 ? 120 : rs1);
    v4u kreg[4], vreg[4];
    {
        const size_t tb_ = (size_t)(TT0 + tlo * TSTEP) * (QKVW * 2);
#pragma unroll
        for (int i = 0; i < 4; ++i) { kreg[i] = *(const v4u*)(kbase + tb_ + i * istepb + goff); vreg[i] = *(const v4u*)(vbase + tb_ + i * istepb + goff); }
    }
    for (int ti = tlo; ti <= thi; ++ti) {
#pragma unroll
        for (int i = 0; i < 4; ++i) { *(LAS v4u*)(kt + kw0 + 1024 * i) = kreg[i]; *(LAS v4u*)(vt + vw0 + 1024 * i) = vreg[i]; }
        if (ti < thi) {
            const size_t tb_ = (size_t)(TT0 + (ti + 1) * TSTEP) * (QKVW * 2);
#pragma unroll
            for (int i = 0; i < 4; ++i) { kreg[i] = *(const v4u*)(kbase + tb_ + i * istepb + goff); vreg[i] = *(const v4u*)(vbase + tb_ + i * istepb + goff); }
        }
        f32x16 S0, S1;
#pragma unroll
        for (int i = 0; i < 16; ++i) { S0[i] = 0.f; S1[i] = 0.f; }
#pragma unroll
        for (int s = 0; s < 4; ++s) { const bf16x8 Kf = *(const LAS bf16x8*)(kt + (kr0 ^ (unsigned)(s << 5)));
            S0 = __builtin_amdgcn_mfma_f32_32x32x16_bf16(Kf, Qa[s], S0, 0, 0, 0); S1 = __builtin_amdgcn_mfma_f32_32x32x16_bf16(Kf, Qb[s], S1, 0, 0, 0); }
        int bi0, bi1;
        if (TYPE == 2) { const bool rv0 = (ti >= rs0) && (ti < rs0 + 8), rv1 = (ti >= rs1) && (ti < rs1 + 8); bi0 = bidx0 + (rv0 ? (ti - gi0 + 7) : 15) * 64; bi1 = bidx0 + (rv1 ? (ti - gi1 + 7) : 15) * 64; }
        else { bi0 = bidx0 + 32 * ti; bi1 = bidx0 + 32 * (ti - toff1); }
        ATT_SOFTMAX(S0, m0, l0, O0a, O0b, tb0, bi0, xm);
        ATT_SOFTMAX(S1, m1, l1, O1a, O1b, tb1, bi1, xm);
#pragma unroll
        for (int s2 = 0; s2 < 2; ++s2) {
            bf16x8 P0, P1; ATT_PACK(P0, S0, s2); ATT_PACK(P1, S1, s2);
            const s16x4 a00 = __builtin_amdgcn_ds_read_tr16_b64_v4i16((LAS s16x4*)(vt + vr0 + (16 * s2) * 128));
            const s16x4 a01 = __builtin_amdgcn_ds_read_tr16_b64_v4i16((LAS s16x4*)(vt + vr0 + (16 * s2 + 8) * 128));
            const s16x4 a10 = __builtin_amdgcn_ds_read_tr16_b64_v4i16((LAS s16x4*)(vt + vr1 + (16 * s2) * 128));
            const s16x4 a11 = __builtin_amdgcn_ds_read_tr16_b64_v4i16((LAS s16x4*)(vt + vr1 + (16 * s2 + 8) * 128));
            const bf16x8 V0 = (bf16x8){a00[0], a00[1], a00[2], a00[3], a01[0], a01[1], a01[2], a01[3]};
            const bf16x8 V1 = (bf16x8){a10[0], a10[1], a10[2], a10[3], a11[0], a11[1], a11[2], a11[3]};
            O0a = __builtin_amdgcn_mfma_f32_32x32x16_bf16(V0, P0, O0a, 0, 0, 0); O0b = __builtin_amdgcn_mfma_f32_32x32x16_bf16(V1, P0, O0b, 0, 0, 0);
            O1a = __builtin_amdgcn_mfma_f32_32x32x16_bf16(V0, P1, O1a, 0, 0, 0); O1b = __builtin_amdgcn_mfma_f32_32x32x16_bf16(V1, P1, O1b, 0, 0, 0);
        }
    }
    ATT_STORE(orow0, O0a, O0b, l0);
    ATT_STORE(orow1, O1a, O1b, l1);
    if (TYPE == 1 && hh == 0) { *lse0 = (m0 + __builtin_amdgcn_logf(l0)) * LN2; *lse1 = (m1 + __builtin_amdgcn_logf(l1)) * LN2; }
}

__device__ __forceinline__ void ph_att(Frame& F, int l) { LAUNDER(F); asm volatile("" : "+s"(l));
    LAS unsigned char* wl = F.lds + RING_OFF + F.wave * 16384;
    const bf16* qkv = (const bf16*)(F.ws + WS_QKV); bf16* oabc = (bf16*)(F.ws + WS_OABC); bf16* og = (bf16*)(F.ws + WS_OG); float* lse = (float*)(F.ws + WS_LSE);
    const float* TA = (const float*)(F.ws + WS_TABA); const float* TB = (const float*)(F.ws + WS_TABB); const float* TC = (const float*)(F.ws + WS_TABC) + (size_t)l * 8 * 1024;
    const float* sink = F.in[6] + l * 8;
    const int gw = F.vcu * NWAVES + F.wave, NGW = F.G * NWAVES;
    for (int task = gw; task < NT_ALL; task += NGW) {
        int lane = F.lane; asm volatile("" : "+v"(lane)); const int qi = lane & 31;
        if (task < NT_A) {
            const int hp = task & 3, qb = (task >> 2) & 255, b = task >> 10, q0 = qb * 32, h0 = hp * 2, h1 = h0 + 1, kvh = hp >> 1;
            int tlo = 0, thi = 8; if (q0 - 128 < 0) tlo = (128 - q0) / 32; if (q0 + 128 + 31 >= L) thi = (L - 1 - (q0 - 128)) / 32;
            const int tq = q0 + qi; bf16* orow = oabc + (size_t)(b * L + tq) * OW;
            att_task2<0>(wl, lane, qkv + (size_t)b * L * QKVW, TA + h0 * 320, TA + h1 * 320, AQ + h0 * 64, AQ + h1 * 64, AK + kvh * 64, AV + kvh * 64, q0 - 128, 32, 1, tlo, thi,
                         tq, tq, 0, 0, 0, 0, 0, sink[h0] * LOG2E, sink[h1] * LOG2E, 1.0f, orow + h0 * 64, orow + h1 * 64, nullptr, nullptr);
        } else if (task < NT_A + NT_B) {
            const int j = task - NT_A, h = j & 3, sbi = (j >> 2) & 127, bg = j >> 9, g = bg % 3, b = bg / 3;
            const int dsh = 2 * g, d = 1 << dsh, nsb = 128 >> dsh, r = sbi / nsb, sb = sbi % nsb, q0 = sb * 64, Ls = L >> dsh;
            int tlo = 0, thi = 5; if (q0 - 64 < 0) tlo = (64 - q0) / 32; if (q0 + 32 + 64 + 31 >= Ls) thi = (Ls - 1 - (q0 - 64)) / 32;
            const int tq0 = (q0 + qi) * d + r, tq1 = (q0 + 32 + qi) * d + r, qc = BQ0 + 768 * g + h * 64;
            att_task2<1>(wl, lane, qkv + (size_t)b * L * QKVW, TB + (g * 4 + h) * 256, nullptr, qc, qc, qc + 256, qc + 512, (q0 - 64) * d + r, 32 * d, d, tlo, thi,
                         tq0, tq1, 1, 0, 0, 0, 0, MINIT, MINIT, 0.0f, og + ((size_t)(b * L + tq0) * 3 + g) * 256 + h * 64, og + ((size_t)(b * L + tq1) * 3 + g) * 256 + h * 64,
                         lse + ((size_t)(b * L + tq0) * 3 + g) * 4 + h, lse + ((size_t)(b * L + tq1) * 3 + g) * 4 + h);
        } else {
            const int j = task - NT_A - NT_B, h = j & 7, cbi = (j >> 3) & 127, b = j >> 10, ip = cbi >> 2, cb = cbi & 3;
            const int gi0 = 4 * ip + (qi >> 4), gi1 = gi0 + 2, gc = 16 * cb + (qi & 15), tq0 = gi0 * 64 + gc, tq1 = gi1 * 64 + gc;
            int cbs = 16 * cb - 8; cbs = cbs < 0 ? 0 : (cbs > 32 ? 32 : cbs);
            int rlo = 4 * ip - 4; rlo = rlo < 0 ? 0 : (rlo > 120 ? 120 : rlo);
            int rhi = 4 * ip + 3 - 4; rhi = rhi < 0 ? 0 : (rhi > 120 ? 120 : rhi); rhi += 7;
            bf16* ob = oabc + (size_t)(b * L) * OW + 768 + h * 64;
            att_task2<2>(wl, lane, qkv + (size_t)b * L * QKVW, TC + h * 1024, nullptr, CQ + h * 64, CQ + h * 64, CK + h * 64, CV + h * 64, cbs, 64, 1, rlo, rhi,
                         tq0, tq1, 0, gi0, gi1, gc, cbs, MINIT, MINIT, 0.0f, ob + (size_t)tq0 * OW, ob + (size_t)tq1 * OW, nullptr, nullptr);
        }
    }
}

constexpr int NSTEPS = 1 + DEPTH * 16;
__global__ void __launch_bounds__(NTHREADS, 2) mk_fwd(Args args) {
    extern __shared__ __attribute__((aligned(16))) unsigned char lds[];
    Frame F;
    F.lds = (LAS unsigned char*)lds; F.wave = __builtin_amdgcn_readfirstlane((int)threadIdx.x >> 6); F.lane = hw_lane(); F.tid = F.wave * 64 + F.lane;
    F.G = gridDim.x; { const int bx = blockIdx.x; F.vcu = (F.G % 8 == 0) ? (bx % 8) * (F.G / 8) + bx / 8 : bx; }
    F.in = args.in; F.h = args.out; F.ws = args.ws; F.probe = args.probe;
    volatile LAS unsigned* MISC = (volatile LAS unsigned*)(F.lds + MISC_OFF);
    if (F.tid < 32) MISC[F.tid] = 0u;
    __syncthreads();
    const int lo = args.s_lo, hi = args.s_hi;
    XcdBarrier bar; bar.wave0 = (F.wave == 0); bar.bar = (unsigned*)(F.ws + WS_CTL) + CW_BAR; bar.x = 0; bar.st = nullptr;
    if (hi - lo > 1) bar = xcd_barrier_post((unsigned*)(F.ws + WS_CTL) + CW_BAR, MISC + 8, F.wave == 0);
#define RUN(s) (lo <= (s) && (s) < hi)
#define SEAM(s) do { if (RUN(s) && RUN((s) + 1)) xcd_barrier(bar); } while (0)
    if (RUN(0)) { ph_prologue(F); ph_tables(F); ph_ln0(F); }
    SEAM(0);
    for (int l = 0; l < DEPTH; ++l) {
        const int sb = 1 + l * 16;
        for (int c = 0; c < NCHUNK; ++c) {
            const int s = sb + c * 6;
            if (RUN(s)) ph_p1(F, l, c);
            SEAM(s);
            if (RUN(s + 1)) ph_att(F, l);
            SEAM(s + 1);
            if (RUN(s + 2)) ph_cmb(F);
            SEAM(s + 2);
            if (RUN(s + 3)) ph_p3(F, l);
            SEAM(s + 3);
            if (RUN(s + 4)) ph_p4(F, l, c);
            SEAM(s + 4);
            if (RUN(s + 5)) ph_ln1(F, l, c);
            SEAM(s + 5);
        }
        if (RUN(sb + 12)) ph_dsp(F, l);
        SEAM(sb + 12);
        if (RUN(sb + 13)) ph_p7(F, l);
        SEAM(sb + 13);
        if (RUN(sb + 14)) ph_p8(F, l);
        SEAM(sb + 14);
        if (RUN(sb + 15)) ph_ln2(F, l);
        SEAM(sb + 15);
    }
#undef RUN
#undef SEAM
}

#ifndef FAST_MASK
#define FAST_MASK 0x7FF
#endif
#ifndef ONE_LAUNCH
#define ONE_LAUNCH 1
#endif
extern "C" void kernel_launch(void* const* d_in, const int* in_sizes, int n_in, void* d_out, int out_size, void* d_ws, size_t ws_size, hipStream_t stream) {
    static int grid = 0;
    if (grid == 0) {
        if (n_in != 23 || out_size != T * D || ws_size < WS_END) { fprintf(stderr, "kernel_launch: unexpected shapes (n_in %d out %d ws %zu)\n", n_in, out_size, ws_size); grid = -1; return; }
        int dev = 0, cus = 0, per_cu = 0;
        if (hipGetDevice(&dev) != hipSuccess || hipDeviceGetAttribute(&cus, hipDeviceAttributeMultiprocessorCount, dev) != hipSuccess) { grid = -1; return; }
        if (hipFuncSetAttribute((const void*)mk_fwd, hipFuncAttributeMaxDynamicSharedMemorySize, LDS_BYTES) != hipSuccess) { fprintf(stderr, "kernel_launch: hipFuncSetAttribute failed\n"); grid = -1; return; }
        if (hipOccupancyMaxActiveBlocksPerMultiprocessor(&per_cu, (const void*)mk_fwd, NTHREADS, LDS_BYTES) != hipSuccess || per_cu < 1) fprintf(stderr, "kernel_launch: occupancy query reports %d\n", per_cu);
        (void)hipGetLastError();
        grid = cus;
    }
    if (grid < 0) return;
    const float* x = (const float*)d_in[0]; const float* ln0_g = (const float*)d_in[1]; const float* ln0_b = (const float*)d_in[2]; const float* rel_bias = (const float*)d_in[3];
    const float* w_in = (const float*)d_in[4]; const float* b_gate = (const float*)d_in[5]; const float* sink_a = (const float*)d_in[6]; const float* rpb_c = (const float*)d_in[7];
    const float* w_br_a = (const float*)d_in[8]; const float* w_br_b = (const float*)d_in[9]; const float* w_br_c = (const float*)d_in[10]; const float* w_out = (const float*)d_in[11];
    const float* ln1_g = (const float*)d_in[12]; const float* ln1_b = (const float*)d_in[13]; const float* w_rg = (const float*)d_in[14]; const float* b_rg = (const float*)d_in[15];
    const float* w_re = (const float*)d_in[16]; const float* b_re = (const float*)d_in[17]; const float* w_eg = (const float*)d_in[18]; const float* w_eu = (const float*)d_in[19];
    const float* w_ed = (const float*)d_in[20]; const float* ln2_g = (const float*)d_in[21]; const float* ln2_b = (const float*)d_in[22];
    unsigned char* ws = (unsigned char*)d_ws; float* h = (float*)d_out;
    bf16* hb = (bf16*)(ws + WS_HB); bf16* qkv = (bf16*)(ws + WS_QKV); bf16* gates = (bf16*)(ws + WS_GATES); bf16* oabc = (bf16*)(ws + WS_OABC); bf16* og = (bf16*)(ws + WS_OG);
    float* lse = (float*)(ws + WS_LSE); Rec* rec = (Rec*)(ws + WS_REC); int* rowtok = (int*)(ws + WS_ROWTOK); float* rowgate = (float*)(ws + WS_ROWGATE);
    bf16* merged = (bf16*)(ws + WS_MERGED); bf16* hid = (bf16*)(ws + WS_HID); bf16* yb = (bf16*)(ws + WS_YB); int* cnt = (int*)(ws + WS_CTL) + CW_CNT;
    (void)hipMemsetAsync(ws + WS_CTL, 0, CTL_ZERO_BYTES, stream);
    Args a{};
    for (int i = 0; i < 23; ++i) a.in[i] = (const float*)d_in[i];
    a.out = h; a.ws = ws;
    if (ONE_LAUNCH) { a.s_lo = 0; a.s_hi = NSTEPS; hipLaunchKernelGGL(mk_fwd, dim3(grid), dim3(NTHREADS), LDS_BYTES, stream, a); return; }
    const int G = 2048;
    const bool fastp1 = (FAST_MASK >> 1) & 1;
    for (int s = 0; s < NSTEPS; ++s) {
        int kind, l = 0, c = 0;
        if (s == 0) kind = 0; else { const int r = (s - 1) % 16; l = (s - 1) / 16; if (r < 12) { c = r / 6; kind = 1 + r % 6; } else kind = 7 + (r - 12); }
        if ((FAST_MASK >> kind) & 1) { a.s_lo = s; a.s_hi = s + 1;
#ifdef DUP_KIND
            if (kind == DUP_KIND && (kind == 5 || kind == 6 || kind == 10)) { a.probe = 1; hipLaunchKernelGGL(mk_fwd, dim3(grid), dim3(NTHREADS), LDS_BYTES, stream, a); a.probe = 0; }
#endif
            hipLaunchKernelGGL(mk_fwd, dim3(grid), dim3(NTHREADS), LDS_BYTES, stream, a);
#ifdef DUP_KIND
            if (kind == DUP_KIND && !(kind == 5 || kind == 6 || kind == 10)) { hipLaunchKernelGGL(mk_fwd, dim3(grid), dim3(NTHREADS), LDS_BYTES, stream, a); }
#endif
            continue; }
        const size_t r0 = (size_t)c * CH;
        switch (kind) {
        case 0: k_ln<<<G, 256, 0, stream>>>(0, x, h, hb, nullptr, ln0_g, ln0_b, 0, T); break;
        case 1: k_p1<<<G, 256, 0, stream>>>(hb + r0 * D, w_in + (size_t)l * D * NCOL, b_gate + (size_t)l * GATEW, qkv, gates); break;
        case 2: k_attn_naive<<<(28 * CH + 255) / 256, 256, 0, stream>>>(qkv, oabc, og, lse, rel_bias, sink_a + l * 8, rpb_c + (size_t)l * 8 * 15 * 31, fastp1 ? LN2 : 0.125f); break;
        case 3: k_combine<<<(CH * 32 + 255) / 256, 256, 0, stream>>>(og, lse, oabc); break;
        case 4: k_p3<<<G, 256, 0, stream>>>(oabc, gates, w_br_a + (size_t)l * 512 * D, w_br_b + (size_t)l * 256 * D, w_br_c + (size_t)l * 512 * D, merged); break;
        case 5: k_p4<<<G, 256, 0, stream>>>(merged, w_out + (size_t)l * D * D, h + r0 * D); break;
        case 6: k_ln<<<G, 256, 0, stream>>>(1, nullptr, h, hb, nullptr, ln1_g + l * D, ln1_b + l * D, (int)r0, CH);
                if (c == NCHUNK - 1) k_router<<<G, 256, 0, stream>>>(h, w_rg + (size_t)l * D * 4, b_rg + l * 4, w_re + (size_t)l * 4 * D * 8, b_re + l * 32, cnt + l * (32 * CSTR), rec);
                break;
        case 7: (void)hipMemsetAsync(rowtok, 0xFF, (size_t)PROWS * 4, stream); k_dispatch<<<256, 256, 0, stream>>>(cnt + l * (32 * CSTR), rec, rowtok, rowgate); break;
        case 8: k_p7<<<G, 256, 0, stream>>>(hb, cnt + l * (32 * CSTR), rowtok, w_eg + (size_t)l * NE * D * DE, w_eu + (size_t)l * NE * D * DE, hid); break;
        case 9: k_p8<<<G, 256, 0, stream>>>(hid, cnt + l * (32 * CSTR), rowtok, rowgate, w_ed + (size_t)l * NE * DE * D, yb); break;
        case 10: k_ln<<<G, 256, 0, stream>>>(2, nullptr, h, (l == DEPTH - 1) ? nullptr : hb, yb, ln2_g + l * D, ln2_b + l * D, 0, T); break;
        }
    }
}
```

```cpp
#include <hip/hip_runtime.h>
#include <cstdio>
#include <cstdint>
#include <cmath>

typedef unsigned short bf16;
typedef short bf16x8 __attribute__((ext_vector_type(8)));
typedef float f32x16 __attribute__((ext_vector_type(16)));
typedef float f32x4 __attribute__((ext_vector_type(4)));

constexpr int D = 1024, L = 8192, NBATCH = 8, T = NBATCH * L, DEPTH = 2;
constexpr int NCOL = 7680, QKVW = 4608, GATEW = 3072;
constexpr int CH = 32768, NCHUNK = T / CH;
constexpr int OW = 1280;
constexpr int NE = 32, DE = 512;
constexpr int MAXRT = T * 2 / 256 + NE, PROWS = MAXRT * 256;
constexpr float LN_EPS = 1e-5f;
constexpr float ALPHA = 1.41421356237309515f;
constexpr int AQ = 0, AK = 512, AV = 640, BQ0 = 768, CQ = 3072, CK = 3584, CV = 4096;

constexpr size_t MiB = 1u << 20;
constexpr size_t WS_CTL = 0;
constexpr size_t WS_WIN = 1 * MiB, WS_WBRA = 31 * MiB, WS_WBRB = 33 * MiB, WS_WBRC = 34 * MiB, WS_WOUT = 36 * MiB, WS_WGU = 40 * MiB, WS_WD = 168 * MiB;
constexpr size_t WS_HB = 232 * MiB, WS_QKV = 360 * MiB, WS_GATES = 648 * MiB, WS_OABC = 840 * MiB, WS_OG = 920 * MiB, WS_LSE = 968 * MiB,
                 WS_REC = 970 * MiB, WS_ROWTOK = 972 * MiB, WS_ROWGATE = 973 * MiB, WS_TABA = 974 * MiB, WS_TABB = WS_TABA + 16384, WS_TABC = WS_TABA + 32768, WS_WGCNT = WS_TABA + 131072  , WS_END = 975 * MiB;
constexpr size_t WS_MERGED = WS_QKV, WS_HID = WS_QKV, WS_YB = WS_QKV + 136 * MiB;
constexpr int CSTR = 32;

__device__ __constant__ signed char BUCK_A[257] = {12,11,11,11,11,11,11,11,11,11,11,11,11,11,11,11,11,11,11,11,11,11,11,11,11,11,11,11,11,11,11,11,11,11,11,11,11,11,11,11,11,11,11,11,11,11,11,11,11,11,11,11,11,11,11,11,11,11,11,11,11,11,11,11,11,10,10,10,10,10,10,10,10,10,10,10,10,10,10,10,10,10,10,10,10,10,10,10,10,10,10,10,10,10,10,10,10,9,9,9,9,9,9,9,9,9,9,9,9,9,9,9,9,8,8,8,8,8,8,8,8,7,6,5,4,3,2,1,0,17,18,19,20,21,22,23,24,24,24,24,24,24,24,24,25,25,25,25,25,25,25,25,25,25,25,25,25,25,25,25,26,26,26,26,26,26,26,26,26,26,26,26,26,26,26,26,26,26,26,26,26,26,26,26,26,26,26,26,26,26,26,26,27,27,27,27,27,27,27,27,27,27,27,27,27,27,27,27,27,27,27,27,27,27,27,27,27,27,27,27,27,27,27,27,27,27,27,27,27,27,27,27,27,27,27,27,27,27,27,27,27,27,27,27,27,27,27,27,27,27,27,27,27,27,27,27,28};
__device__ __constant__ signed char BUCK_B[3][129] = {
 {11,10,10,10,10,10,10,10,10,10,10,10,10,10,10,10,10,10,10,10,10,10,10,10,10,10,10,10,10,10,10,10,10,9,9,9,9,9,9,9,9,9,9,9,9,9,9,9,9,8,8,8,8,8,8,8,8,7,6,5,4,3,2,1,0,17,18,19,20,21,22,23,24,24,24,24,24,24,24,24,25,25,25,25,25,25,25,25,25,25,25,25,25,25,25,25,26,26,26,26,26,26,26,26,26,26,26,26,26,26,26,26,26,26,26,26,26,26,26,26,26,26,26,26,26,26,26,26,27},
 {13,12,12,12,12,12,12,12,12,12,12,12,12,12,12,12,12,12,12,12,12,12,12,12,12,12,12,12,12,12,12,12,12,11,11,11,11,11,11,11,11,11,11,11,11,11,11,11,11,10,10,10,10,10,10,10,10,9,9,9,9,8,8,4,0,20,24,24,25,25,25,25,26,26,26,26,26,26,26,26,27,27,27,27,27,27,27,27,27,27,27,27,27,27,27,27,28,28,28,28,28,28,28,28,28,28,28,28,28,28,28,28,28,28,28,28,28,28,28,28,28,28,28,28,28,28,28,28,29},
 {15,14,14,14,14,14,14,14,14,14,14,14,14,14,14,14,14,14,14,14,14,14,14,14,14,14,14,14,14,14,14,14,14,13,13,13,13,13,13,13,13,13,13,13,13,13,13,13,13,12,12,12,12,12,12,12,12,11,11,11,11,10,10,9,0,25,26,26,27,27,27,27,28,28,28,28,28,28,28,28,29,29,29,29,29,29,29,29,29,29,29,29,29,29,29,29,30,30,30,30,30,30,30,30,30,30,30,30,30,30,30,30,30,30,30,30,30,30,30,30,30,30,30,30,30,30,30,30,31}};

__device__ __forceinline__ float bf2f(bf16 b) { return __uint_as_float(((unsigned)b) << 16); }
__device__ __forceinline__ bf16 f2bf(float f) { unsigned u = __float_as_uint(f); u += 0x7fffu + ((u >> 16) & 1u); return (bf16)(u >> 16); }
__device__ __forceinline__ float wave_sum(float v) {
#pragma unroll
    for (int o = 1; o < 64; o <<= 1) v += __shfl_xor(v, o);
    return v;
}

__global__ __launch_bounds__(256) void k_ln(int mode, const float* src, float* h, bf16* hb, const bf16* yb, const float* g, const float* bta, int row0, int nrows) {
    const int lane = threadIdx.x & 63, wv = blockIdx.x * 4 + (threadIdx.x >> 6), nw = gridDim.x * 4;
    for (int rr = wv; rr < nrows; rr += nw) {
        const size_t row = (size_t)row0 + rr;
        f32x4 v[4];
#pragma unroll
        for (int j = 0; j < 4; ++j) {
            const int c = lane * 4 + 256 * j;
            v[j] = *(const f32x4*)((mode == 0 ? src : h) + row * D + c);
            if (mode == 2) {
                const uint2 a = *(const uint2*)(yb + (row * 2) * D + c), b = *(const uint2*)(yb + (row * 2 + 1) * D + c);
                v[j].x = ALPHA * v[j].x + bf2f((bf16)(a.x & 0xffff)) + bf2f((bf16)(b.x & 0xffff));
                v[j].y = ALPHA * v[j].y + bf2f((bf16)(a.x >> 16)) + bf2f((bf16)(b.x >> 16));
                v[j].z = ALPHA * v[j].z + bf2f((bf16)(a.y & 0xffff)) + bf2f((bf16)(b.y & 0xffff));
                v[j].w = ALPHA * v[j].w + bf2f((bf16)(a.y >> 16)) + bf2f((bf16)(b.y >> 16));
            }
        }
        float s = 0.f;
#pragma unroll
        for (int j = 0; j < 4; ++j) s += (v[j].x + v[j].y) + (v[j].z + v[j].w);
        const float mean = wave_sum(s) * (1.f / D);
        float q = 0.f;
#pragma unroll
        for (int j = 0; j < 4; ++j) { v[j] = v[j] - mean; q += (v[j].x * v[j].x + v[j].y * v[j].y) + (v[j].z * v[j].z + v[j].w * v[j].w); }
        const float rstd = 1.0f / sqrtf(wave_sum(q) * (1.f / D) + LN_EPS);
#pragma unroll
        for (int j = 0; j < 4; ++j) {
            const int c = lane * 4 + 256 * j;
            const f32x4 gg = *(const f32x4*)(g + c), bb = *(const f32x4*)(bta + c);
            const f32x4 o = v[j] * rstd * gg + bb;
            *(f32x4*)(h + row * D + c) = o;
            if (hb) { uint2 w; w.x = (unsigned)f2bf(o.x) | ((unsigned)f2bf(o.y) << 16); w.y = (unsigned)f2bf(o.z) | ((unsigned)f2bf(o.w) << 16); *(uint2*)(hb + row * D + c) = w; }
        }
    }
}

__device__ __forceinline__ void wave_gemm32(const bf16* arow, const float* wcol, int ldw, int K, f32x16& acc) {
    for (int k0 = 0; k0 < K; k0 += 16) {
        const bf16x8 a = *(const bf16x8*)(arow + k0);
        bf16x8 b;
#pragma unroll
        for (int j = 0; j < 8; ++j) b[j] = (short)f2bf(wcol[(size_t)(k0 + j) * ldw]);
        acc = __builtin_amdgcn_mfma_f32_32x32x16_bf16(a, b, acc, 0, 0, 0);
    }
}
#define ACC_ROW(reg, h) (((reg) & 3) + 8 * ((reg) >> 2) + 4 * (h))

__global__ __launch_bounds__(256) void k_p1(const bf16* hbc, const float* w_in, const float* b_gate, bf16* qkv, bf16* gates) {
    const int lane = threadIdx.x & 63, r = lane & 31, hh = lane >> 5;
    const int wv = blockIdx.x * 4 + (threadIdx.x >> 6), nw = gridDim.x * 4;
    const int ntn = NCOL / 32, total = (CH / 32) * ntn;
    for (int tile = wv; tile < total; tile += nw) {
        const int tm = tile / ntn, tn = tile % ntn;
        f32x16 acc; for (int i = 0; i < 16; ++i) acc[i] = 0.f;
        wave_gemm32(hbc + (size_t)(tm * 32 + r) * D + 8 * hh, w_in + (size_t)(8 * hh) * NCOL + tn * 32 + r, NCOL, D, acc);
        const int col = tn * 32 + r;
#pragma unroll
        for (int i = 0; i < 16; ++i) {
            const int row = tm * 32 + ACC_ROW(i, hh);
            if (col < QKVW) qkv[(size_t)row * QKVW + col] = f2bf(acc[i]);
            else { const float z = acc[i] + b_gate[col - QKVW]; gates[(size_t)row * GATEW + (col - QKVW)] = f2bf(1.0f / (1.0f + __expf(-z))); }
        }
    }
}

__global__ __launch_bounds__(256) void k_attn_naive(const bf16* qkv, bf16* oabc, bf16* og, float* lse, const float* rel_bias, const float* sink_l, const float* rpb_l, float sc) {
    const long idx = (long)blockIdx.x * 256 + threadIdx.x;
    if (idx >= (long)28 * CH) return;
    const int ht = (int)(idx / CH), tl = (int)(idx % CH), b = tl / L, t = tl % L;
    const bf16* base = qkv + (size_t)(b * L) * QKVW;
    int qcol, kcol, vcol;
    if (ht < 8) { qcol = AQ + ht * 64; kcol = AK + (ht >> 2) * 64; vcol = AV + (ht >> 2) * 64; }
    else if (ht < 20) { const int g = (ht - 8) >> 2, h = (ht - 8) & 3; qcol = BQ0 + 768 * g + h * 64; kcol = qcol + 256; vcol = qcol + 512; }
    else { const int h = ht - 20; qcol = CQ + h * 64; kcol = CK + h * 64; vcol = CV + h * 64; }
    float q[64], o[64];
    {
        const uint4* qp = (const uint4*)(base + (size_t)t * QKVW + qcol);
#pragma unroll
        for (int c = 0; c < 8; ++c) { const uint4 u = qp[c]; const unsigned w[4] = {u.x, u.y, u.z, u.w};
#pragma unroll
            for (int i = 0; i < 4; ++i) { q[8 * c + 2 * i] = bf2f((bf16)(w[i] & 0xffff)); q[8 * c + 2 * i + 1] = bf2f((bf16)(w[i] >> 16)); } }
    }
#pragma unroll
    for (int i = 0; i < 64; ++i) o[i] = 0.f;
    float m = -1e30f, l = 0.f;
    if (ht < 8) { m = sink_l[ht]; l = 1.f; }
#define PROC_KEY(KT, BIAS) do { \
        const uint4* kp = (const uint4*)(base + (size_t)(KT) * QKVW + kcol); float s = 0.f; \
        _Pragma("unroll") for (int c = 0; c < 8; ++c) { const uint4 u = kp[c]; const unsigned w[4] = {u.x, u.y, u.z, u.w}; \
            _Pragma("unroll") for (int i = 0; i < 4; ++i) { s += q[8 * c + 2 * i] * bf2f((bf16)(w[i] & 0xffff)); s += q[8 * c + 2 * i + 1] * bf2f((bf16)(w[i] >> 16)); } } \
        s = s * sc + (BIAS); const float mn = fmaxf(m, s), corr = __expf(m - mn), p = __expf(s - mn); l = l * corr + p; m = mn; \
        const uint4* vp = (const uint4*)(base + (size_t)(KT) * QKVW + vcol); \
        _Pragma("unroll") for (int c = 0; c < 8; ++c) { const uint4 u = vp[c]; const unsigned w[4] = {u.x, u.y, u.z, u.w}; \
            _Pragma("unroll") for (int i = 0; i < 4; ++i) { o[8 * c + 2 * i] = o[8 * c + 2 * i] * corr + p * bf2f((bf16)(w[i] & 0xffff)); o[8 * c + 2 * i + 1] = o[8 * c + 2 * i + 1] * corr + p * bf2f((bf16)(w[i] >> 16)); } } \
    } while (0)
    if (ht < 8) {
        for (int rel = -128; rel <= 128; ++rel) { const int kt = t + rel; if (kt < 0 || kt >= L) continue;
            const float bias = rel_bias[BUCK_A[rel + 128] * 20 + ht]; PROC_KEY(kt, bias); }
    } else if (ht < 20) {
        const int g = (ht - 8) >> 2, h = (ht - 8) & 3, dil = (g == 0) ? 1 : (g == 1 ? 4 : 16);
        for (int off = -64; off <= 64; ++off) { const int kt = t + off * dil; if (kt < 0 || kt >= L) continue;
            const float bias = rel_bias[BUCK_B[g][off + 64] * 20 + 8 + 4 * g + h]; PROC_KEY(kt, bias); }
    } else {
        const int h = ht - 20, gi = t >> 6, gc = t & 63;
        int rs = gi - 4; rs = rs < 0 ? 0 : (rs > 120 ? 120 : rs);
        int cs = gc - 8; cs = cs < 0 ? 0 : (cs > 48 ? 48 : cs);
        for (int kr = rs; kr < rs + 8; ++kr)
            for (int kc = cs; kc < cs + 16; ++kc) { const float bias = rpb_l[(h * 15 + (kr - gi + 7)) * 31 + (kc - gc + 15)]; const int kt = kr * 64 + kc; PROC_KEY(kt, bias); }
    }
#undef PROC_KEY
    const float inv = 1.0f / l;
    bf16* dst;
    if (ht < 8) dst = oabc + (size_t)tl * OW + ht * 64;
    else if (ht < 20) { const int g = (ht - 8) >> 2, h = (ht - 8) & 3; dst = og + ((size_t)tl * 3 + g) * 256 + h * 64; lse[((size_t)tl * 3 + g) * 4 + h] = m + __logf(l); }
    else dst = oabc + (size_t)tl * OW + 768 + (ht - 20) * 64;
#pragma unroll
    for (int c = 0; c < 8; ++c) { uint4 u;
        u.x = (unsigned)f2bf(o[8 * c + 0] * inv) | ((unsigned)f2bf(o[8 * c + 1] * inv) << 16); u.y = (unsigned)f2bf(o[8 * c + 2] * inv) | ((unsigned)f2bf(o[8 * c + 3] * inv) << 16);
        u.z = (unsigned)f2bf(o[8 * c + 4] * inv) | ((unsigned)f2bf(o[8 * c + 5] * inv) << 16); u.w = (unsigned)f2bf(o[8 * c + 6] * inv) | ((unsigned)f2bf(o[8 * c + 7] * inv) << 16);
        ((uint4*)dst)[c] = u; }
}

__global__ __launch_bounds__(256) void k_combine(const bf16* og, const float* lse, bf16* oabc) {
    const long idx = (long)blockIdx.x * 256 + threadIdx.x;
    if (idx >= (long)CH * 32) return;
    const int tl = (int)(idx >> 5), hc = (int)(idx & 31), h = hc >> 3, c = hc & 7;
    const float l0 = lse[((size_t)tl * 3 + 0) * 4 + h], l1 = lse[((size_t)tl * 3 + 1) * 4 + h], l2 = lse[((size_t)tl * 3 + 2) * 4 + h];
    const float mx = fmaxf(l0, fmaxf(l1, l2)); float w0 = __expf(l0 - mx), w1 = __expf(l1 - mx), w2 = __expf(l2 - mx); const float inv = 1.0f / (w0 + w1 + w2); w0 *= inv; w1 *= inv; w2 *= inv;
    const uint4 a = *(const uint4*)(og + ((size_t)tl * 3 + 0) * 256 + h * 64 + c * 8), b = *(const uint4*)(og + ((size_t)tl * 3 + 1) * 256 + h * 64 + c * 8), d = *(const uint4*)(og + ((size_t)tl * 3 + 2) * 256 + h * 64 + c * 8);
    const unsigned aw[4] = {a.x, a.y, a.z, a.w}, bw[4] = {b.x, b.y, b.z, b.w}, dw[4] = {d.x, d.y, d.z, d.w}; unsigned ow[4];
#pragma unroll
    for (int i = 0; i < 4; ++i) {
        const float lo = w0 * bf2f((bf16)(aw[i] & 0xffff)) + w1 * bf2f((bf16)(bw[i] & 0xffff)) + w2 * bf2f((bf16)(dw[i] & 0xffff));
        const float hi = w0 * bf2f((bf16)(aw[i] >> 16)) + w1 * bf2f((bf16)(bw[i] >> 16)) + w2 * bf2f((bf16)(dw[i] >> 16));
        ow[i] = (unsigned)f2bf(lo) | ((unsigned)f2bf(hi) << 16);
    }
    *(uint4*)(oabc + (size_t)tl * OW + 512 + h * 64 + c * 8) = make_uint4(ow[0], ow[1], ow[2], ow[3]);
}

__global__ __launch_bounds__(256) void k_p3(const bf16* oabc, const bf16* gates, const float* wa, const float* wb, const float* wc, bf16* merged) {
    const int lane = threadIdx.x & 63, r = lane & 31, hh = lane >> 5;
    const int wv = blockIdx.x * 4 + (threadIdx.x >> 6), nw = gridDim.x * 4;
    const int ntn = D / 32, total = (CH / 32) * ntn;
    for (int tile = wv; tile < total; tile += nw) {
        const int tm = tile / ntn, tn = tile % ntn, col = tn * 32 + r;
        f32x16 mg; for (int i = 0; i < 16; ++i) mg[i] = 0.f;
#pragma unroll 1
        for (int br = 0; br < 3; ++br) {
            f32x16 acc; for (int i = 0; i < 16; ++i) acc[i] = 0.f;
            const int koff = br == 0 ? 0 : (br == 1 ? 512 : 768), K = br == 1 ? 256 : 512;
            const float* w = br == 0 ? wa : (br == 1 ? wb : wc);
            wave_gemm32(oabc + (size_t)(tm * 32 + r) * OW + koff + 8 * hh, w + (size_t)(8 * hh) * D + col, D, K, acc);
#pragma unroll
            for (int i = 0; i < 16; ++i) { const int row = tm * 32 + ACC_ROW(i, hh); mg[i] += bf2f(gates[(size_t)row * GATEW + br * 1024 + col]) * acc[i]; }
        }
#pragma unroll
        for (int i = 0; i < 16; ++i) { const int row = tm * 32 + ACC_ROW(i, hh); merged[(size_t)row * D + col] = f2bf(mg[i]); }
    }
}
__global__ __launch_bounds__(256) void k_p4(const bf16* merged, const float* wo, float* hchunk) {
    const int lane = threadIdx.x & 63, r = lane & 31, hh = lane >> 5;
    const int wv = blockIdx.x * 4 + (threadIdx.x >> 6), nw = gridDim.x * 4;
    const int ntn = D / 32, total = (CH / 32) * ntn;
    for (int tile = wv; tile < total; tile += nw) {
        const int tm = tile / ntn, tn = tile % ntn, col = tn * 32 + r;
        f32x16 acc; for (int i = 0; i < 16; ++i) acc[i] = 0.f;
        wave_gemm32(merged + (size_t)(tm * 32 + r) * D + 8 * hh, wo + (size_t)(8 * hh) * D + col, D, D, acc);
#pragma unroll
        for (int i = 0; i < 16; ++i) { const int row = tm * 32 + ACC_ROW(i, hh); float* p = hchunk + (size_t)row * D + col; *p = ALPHA * *p + acc[i]; }
    }
}

struct Rec { int e0, s0, e1, s1; float g0, g1; int pad0, pad1; };
__global__ __launch_bounds__(256) void k_router(const float* h, const float* w_rg, const float* b_rg, const float* w_re, const float* b_re, int* cnt, Rec* rec) {
    const int lane = threadIdx.x & 63, wv = blockIdx.x * 4 + (threadIdx.x >> 6), nw = gridDim.x * 4;
    for (int t = wv; t < T; t += nw) {
        float x[16];
#pragma unroll
        for (int j = 0; j < 4; ++j) { const f32x4 v = *(const f32x4*)(h + (size_t)t * D + lane * 4 + 256 * j); x[4 * j] = v.x; x[4 * j + 1] = v.y; x[4 * j + 2] = v.z; x[4 * j + 3] = v.w; }
        float gl[4] = {0.f, 0.f, 0.f, 0.f};
#pragma unroll
        for (int j = 0; j < 4; ++j)
#pragma unroll
            for (int i = 0; i < 4; ++i) { const f32x4 w = *(const f32x4*)(w_rg + (size_t)(lane * 4 + 256 * j + i) * 4); const float xv = x[4 * j + i]; gl[0] += xv * w.x; gl[1] += xv * w.y; gl[2] += xv * w.z; gl[3] += xv * w.w; }
#pragma unroll
        for (int g = 0; g < 4; ++g) gl[g] = wave_sum(gl[g]) + b_rg[g];
        int gi = 0; float gm = gl[0];
#pragma unroll
        for (int g = 1; g < 4; ++g) if (gl[g] > gm) { gm = gl[g]; gi = g; }
        float gs = 0.f;
#pragma unroll
        for (int g = 0; g < 4; ++g) gs += __expf(gl[g] - gm);
        const float gw = 1.0f / gs;
        float el[8];
#pragma unroll
        for (int e = 0; e < 8; ++e) el[e] = 0.f;
        const float* wre = w_re + (size_t)gi * D * 8;
#pragma unroll
        for (int j = 0; j < 4; ++j)
#pragma unroll
            for (int i = 0; i < 4; ++i) { const float* wp = wre + (size_t)(lane * 4 + 256 * j + i) * 8; const f32x4 w0 = *(const f32x4*)wp, w1 = *(const f32x4*)(wp + 4); const float xv = x[4 * j + i];
                el[0] += xv * w0.x; el[1] += xv * w0.y; el[2] += xv * w0.z; el[3] += xv * w0.w; el[4] += xv * w1.x; el[5] += xv * w1.y; el[6] += xv * w1.z; el[7] += xv * w1.w; }
#pragma unroll
        for (int e = 0; e < 8; ++e) el[e] = wave_sum(el[e]) + b_re[gi * 8 + e];
        int i0 = 0; float t0 = el[0];
#pragma unroll
        for (int e = 1; e < 8; ++e) if (el[e] > t0) { t0 = el[e]; i0 = e; }
        int i1 = -1; float t1 = -3.0e38f;
#pragma unroll
        for (int e = 0; e < 8; ++e) if (e != i0 && el[e] > t1) { t1 = el[e]; i1 = e; }
        const float ex = __expf(t1 - t0), p0 = 1.0f / (1.0f + ex), p1 = ex / (1.0f + ex);
        if (lane == 0) {
            Rec rc; rc.e0 = gi * 8 + i0; rc.e1 = gi * 8 + i1; rc.g0 = gw * p0; rc.g1 = gw * p1; rc.pad0 = 0; rc.pad1 = 0;
            rc.s0 = atomicAdd(cnt + rc.e0 * CSTR, 1); rc.s1 = atomicAdd(cnt + rc.e1 * CSTR, 1);
            rec[t] = rc;
        }
    }
}
__device__ __forceinline__ void pad_offsets(const int* cnt, int* po) { int acc = 0; for (int e = 0; e < NE; ++e) { po[e] = acc; acc += (cnt[e * CSTR] + 255) / 256 * 256; } po[NE] = acc; }
__global__ __launch_bounds__(256) void k_dispatch(const int* cnt, const Rec* rec, int* rowtok, float* rowgate) {
    __shared__ int po[NE + 1];
    if (threadIdx.x == 0) pad_offsets(cnt, po);
    __syncthreads();
    for (int t = blockIdx.x * 256 + threadIdx.x; t < T; t += gridDim.x * 256) {
        const Rec rc = rec[t];
        const int d0 = po[rc.e0] + rc.s0, d1 = po[rc.e1] + rc.s1;
        rowtok[d0] = 2 * t; rowgate[d0] = rc.g0; rowtok[d1] = 2 * t + 1; rowgate[d1] = rc.g1;
    }
}
__global__ __launch_bounds__(256) void k_p7(const bf16* hb, const int* cnt, const int* rowtok, const float* w_eg, const float* w_eu, bf16* hid) {
    __shared__ int po[NE + 1];
    if (threadIdx.x == 0) pad_offsets(cnt, po);
    __syncthreads();
    const int lane = threadIdx.x & 63, r = lane & 31, hh = lane >> 5;
    const int wv = blockIdx.x * 4 + (threadIdx.x >> 6), nw = gridDim.x * 4;
    const int ntn = DE / 32, total = (po[NE] / 32) * ntn;
    for (int tile = wv; tile < total; tile += nw) {
        const int tm = tile / ntn, tn = tile % ntn, col = tn * 32 + r, row0 = tm * 32;
        int e = 0; while (e < NE - 1 && po[e + 1] <= row0) ++e;
        int tok = rowtok[row0 + r]; tok = tok < 0 ? 0 : (tok >> 1);
        f32x16 ag, au; for (int i = 0; i < 16; ++i) { ag[i] = 0.f; au[i] = 0.f; }
        wave_gemm32(hb + (size_t)tok * D + 8 * hh, w_eg + (size_t)e * D * DE + (size_t)(8 * hh) * DE + col, DE, D, ag);
        wave_gemm32(hb + (size_t)tok * D + 8 * hh, w_eu + (size_t)e * D * DE + (size_t)(8 * hh) * DE + col, DE, D, au);
#pragma unroll
        for (int i = 0; i < 16; ++i) { const int row = row0 + ACC_ROW(i, hh); const float gsl = ag[i] / (1.0f + __expf(-ag[i])); hid[(size_t)row * DE + col] = f2bf(gsl * au[i]); }
    }
}
__global__ __launch_bounds__(256) void k_p8(const bf16* hid, const int* cnt, const int* rowtok, const float* rowgate, const float* w_ed, bf16* yb) {
    __shared__ int po[NE + 1];
    if (threadIdx.x == 0) pad_offsets(cnt, po);
    __syncthreads();
    const int lane = threadIdx.x & 63, r = lane & 31, hh = lane >> 5;
    const int wv = blockIdx.x * 4 + (threadIdx.x >> 6), nw = gridDim.x * 4;
    const int ntn = D / 32, total = (po[NE] / 32) * ntn;
    for (int tile = wv; tile < total; tile += nw) {
        const int tm = tile / ntn, tn = tile % ntn, col = tn * 32 + r, row0 = tm * 32;
        int e = 0; while (e < NE - 1 && po[e + 1] <= row0) ++e;
        f32x16 acc; for (int i = 0; i < 16; ++i) acc[i] = 0.f;
        wave_gemm32(hid + (size_t)(row0 + r) * DE + 8 * hh, w_ed + (size_t)e * DE * D + (size_t)(8 * hh) * D + col, D, DE, acc);
#pragma unroll
        for (int i = 0; i < 16; ++i) { const int row = row0 + ACC_ROW(i, hh); const int rt = rowtok[row]; if (rt >= 0) yb[(size_t)rt * D + col] = f2bf(acc[i] * rowgate[row]); }
    }
}


namespace pg8 {
#define PG8_LAS __attribute__((address_space(3)))
typedef unsigned short bf16_t;
typedef unsigned u32x4 __attribute__((ext_vector_type(4)));
constexpr int BM = 256, BK = 64, HALF = 128, HTB = HALF * BK * 2  , STAGE_BYTES = 8 * HTB, NXCD = 8, WGM = 8;

__host__ __device__ __forceinline__ int lds_byte(int r, int c) { const int st = (r >> 4) * 2 + (c >> 5), rr = r & 15, cc = c & 31, ob = rr * 64 + cc * 2; return st * 1024 + (ob ^ (((ob >> 9) & 1) << 5)); }
__host__ __device__ __forceinline__ void stage_rc(int b, int& R, int& C) { const int st = b / 1024, sb = b % 1024, swz = sb ^ (((sb >> 9) & 1) << 5); R = (st >> 1) * 16 + swz / 64; C = (st & 1) * 32 + (swz % 64) / 2; }
__host__ __device__ __forceinline__ int perm32(int rho) { const int n = rho >> 4, i = rho & 15; return 8 * (i >> 2) + 4 * n + (i & 3); }

struct Unit { int pm, pn, e, ui; };

struct DenseOrder {
    int nM, nN, nwg, G, c; const char* A; const char* B; size_t tstepA, tstepB;
    __device__ void init(const void* A_, int lda, const void* B_, int ldb, int M, int N, int G_, int c_) { nM = M / BM; nN = N / BM; nwg = nM * nN; G = G_; c = c_; A = (const char*)A_; B = (const char*)B_; tstepA = (size_t)BM * lda * 2; tstepB = (size_t)BM * ldb * 2; }
    __device__ bool next(int i, Unit& u) const {
        const long Lx = (long)i * G + c; if (Lx >= nwg) return false;
        int wgid = (int)Lx; { const int q = nwg / NXCD, r = nwg % NXCD, xcd = wgid % NXCD, off = wgid / NXCD; wgid = (xcd < r ? xcd * (q + 1) : r * (q + 1) + (xcd - r) * q) + off; }
        const int nig = WGM * nN, gid = wgid / nig, fm = gid * WGM, gsz = (nM - fm) < WGM ? (nM - fm) : WGM;
        u.pm = fm + ((wgid % nig) % gsz); u.pn = (wgid % nig) / gsz; u.e = 0; u.ui = i; return true;
    }
    __device__ __forceinline__ const char* a_base(const Unit& u) const { return A + (size_t)u.pm * tstepA; }
    __device__ __forceinline__ const char* b_base(const Unit& u) const { return B + (size_t)u.pn * tstepB; }
    __device__ __forceinline__ int a_row(const Unit&, int) const { return 0; }
};

__device__ __forceinline__ unsigned cvt_pk_bf16(float lo, float hi) { unsigned r; asm volatile("v_cvt_pk_bf16_f32 %0, %1, %2" : "=v"(r) : "v"(lo), "v"(hi)); return r; }

template <class Epi, class Sched, bool GATHER>
__device__ __forceinline__ void gemm_phase(PG8_LAS unsigned char* lds, const Sched& S, const Epi& E, const int K, const int lda, const int ldb, const int tid_in) {
    int tid = tid_in; asm volatile("" : "+v"(tid));
    const int wid = __builtin_amdgcn_readfirstlane(tid >> 6), lane = tid & 63, wr = wid >> 2, wc = wid & 3, fr = lane & 15, fq = lane >> 4;
    const int nt = K / BK;
    int RA[2], CA[2]; unsigned voffB[2];
#pragma unroll
    for (int i = 0; i < 2; ++i) { int R, C; stage_rc(tid * 16 + i * 8192, R, C); const int Rb = Epi::PERM ? ((R & ~31) + perm32(R & 31)) : R; RA[i] = R; CA[i] = C; voffB[i] = (unsigned)(Rb * ldb + C) * 2u; }
    const size_t kstep = (size_t)(BK * 2);
    const size_t hstepB = (size_t)HALF * ldb * 2;
    const unsigned ldsw = (unsigned)wid * 1024u;
    const int aoff = lds_byte(wr * 64 + fr, fq * 8), boff = lds_byte(wc * 32 + fr, fq * 8);
#define PG8_SA(b, h) (((b) * 2 + (h)) * HTB)
#define PG8_SB(b, h) ((4 + (b) * 2 + (h)) * HTB)
#define PG8_STAGE2(bufoff, gbase, v0, v1) do { \
        __builtin_amdgcn_global_load_lds((const unsigned*)((const char*)(gbase) + (v0)), (PG8_LAS unsigned*)(lds + (bufoff) + ldsw), 16, 0, 0); \
        __builtin_amdgcn_global_load_lds((const unsigned*)((const char*)(gbase) + (v1)), (PG8_LAS unsigned*)(lds + (bufoff) + ldsw + 8192), 16, 0, 0); } while (0)
#define PG8_STAGEB(bufoff, gbase) PG8_STAGE2(bufoff, gbase, voffB[0], voffB[1])
#define PG8_LDA(dst, b, h) do { _Pragma("unroll") for (int m = 0; m < 4; ++m) _Pragma("unroll") for (int k = 0; k < 2; ++k) dst[m][k] = *(const PG8_LAS bf16x8*)(lds + PG8_SA(b, h) + aoff + m * 2048 + k * 1024); } while (0)
#define PG8_LDB(dst, b, h) do { _Pragma("unroll") for (int n = 0; n < 2; ++n) _Pragma("unroll") for (int k = 0; k < 2; ++k) dst[n][k] = *(const PG8_LAS bf16x8*)(lds + PG8_SB(b, h) + boff + n * 2048 + k * 1024); } while (0)
#define PG8_MMA(ai, bj, At, Bt) do { __builtin_amdgcn_s_setprio(1); _Pragma("unroll") for (int m = 0; m < 4; ++m) _Pragma("unroll") for (int n = 0; n < 2; ++n) _Pragma("unroll") for (int k = 0; k < 2; ++k) \
        acc[ai][bj][m][n] = __builtin_amdgcn_mfma_f32_16x16x32_bf16(Bt[n][k], At[m][k], acc[ai][bj][m][n], 0, 0, 0); __builtin_amdgcn_s_setprio(0); } while (0)
#define PG8_WAIT_V(n) asm volatile("s_waitcnt vmcnt(" #n ")" ::: "memory")
#define PG8_WAIT_L(n) asm volatile("s_waitcnt lgkmcnt(" #n ")" ::: "memory")
#define PG8_BAR __builtin_amdgcn_s_barrier()
#define PG8_SCHED __builtin_amdgcn_sched_barrier(0)
#define PG8_VOFFA(dst, u) do { _Pragma("unroll") for (int h_ = 0; h_ < 2; ++h_) _Pragma("unroll") for (int i_ = 0; i_ < 2; ++i_) { \
        const int row_ = GATHER ? S.a_row(u, h_ * HALF + RA[i_]) : (h_ * HALF + RA[i_]); dst[h_][i_] = (unsigned)(row_ * lda + CA[i_]) * 2u; } } while (0)
    Unit cur, nxt;
    if (!S.next(0, cur)) return;
    f32x4 acc[2][2][4][2];
#pragma unroll
    for (int a = 0; a < 2; ++a)
#pragma unroll
        for (int b = 0; b < 2; ++b)
#pragma unroll
            for (int m = 0; m < 4; ++m)
#pragma unroll
                for (int n = 0; n < 2; ++n) acc[a][b][m][n] = (f32x4){0.f, 0.f, 0.f, 0.f};
    bf16x8 At[4][2], B0[2][2], B1[2][2];
    unsigned vc[2][2], vn[2][2];
    PG8_VOFFA(vc, cur);
    const char* cA = S.a_base(cur); const char* cB = S.b_base(cur);
    PG8_STAGEB(PG8_SB(0, 0), cB); PG8_STAGEB(PG8_SB(0, 1), cB + hstepB); PG8_STAGE2(PG8_SA(0, 0), cA, vc[0][0], vc[0][1]); PG8_STAGE2(PG8_SA(0, 1), cA, vc[1][0], vc[1][1]);
    if (wr == 1) PG8_BAR;
    PG8_WAIT_V(2); PG8_BAR;
    PG8_STAGEB(PG8_SB(1, 0), cB + kstep); PG8_STAGE2(PG8_SA(1, 0), cA + kstep, vc[0][0], vc[0][1]); PG8_STAGEB(PG8_SB(1, 1), cB + hstepB + kstep);
    PG8_WAIT_V(6); PG8_BAR;
    int ui = 0;
    for (;;) {
        const bool has_next = S.next(ui + 1, nxt);
        const char* nA = has_next ? S.a_base(nxt) : cA; const char* nB = has_next ? S.b_base(nxt) : cB;
        if (GATHER) { if (has_next) { PG8_VOFFA(vn, nxt); } else {
#pragma unroll
            for (int h_ = 0; h_ < 2; ++h_) { vn[h_][0] = vc[h_][0]; vn[h_][1] = vc[h_][1]; } } }
        for (int t = 0; t < nt; t += 2) {
            const bool last = (t == nt - 2);
            const char* a1 = cA + (size_t)(t + 1) * kstep;
            const char* a2 = last ? nA : cA + (size_t)(t + 2) * kstep; const char* b2 = last ? nB : cB + (size_t)(t + 2) * kstep;
            const char* a3 = a2 + kstep; const char* b3 = b2 + kstep;
            unsigned w00, w01, w10, w11;
            if (GATHER) { w00 = last ? vn[0][0] : vc[0][0]; w01 = last ? vn[0][1] : vc[0][1]; w10 = last ? vn[1][0] : vc[1][0]; w11 = last ? vn[1][1] : vc[1][1]; }
            else { w00 = vc[0][0]; w01 = vc[0][1]; w10 = vc[1][0]; w11 = vc[1][1]; }
            PG8_LDB(B0, 0, 0); PG8_LDB(B1, 0, 1); PG8_SCHED; PG8_LDA(At, 0, 0); PG8_STAGE2(PG8_SA(1, 1), a1, vc[1][0], vc[1][1]);
            PG8_WAIT_V(8); PG8_WAIT_L(0); PG8_BAR; PG8_MMA(0, 0, At, B0); PG8_MMA(0, 1, At, B1); PG8_BAR; PG8_SCHED;
            PG8_LDA(At, 0, 1); PG8_STAGEB(PG8_SB(0, 0), b2); PG8_STAGEB(PG8_SB(0, 1), b2 + hstepB); PG8_STAGE2(PG8_SA(0, 0), a2, w00, w01);
            PG8_WAIT_V(8); PG8_WAIT_L(0); PG8_BAR; PG8_MMA(1, 0, At, B0); PG8_MMA(1, 1, At, B1); PG8_BAR; PG8_SCHED;
            PG8_LDB(B0, 1, 0); PG8_LDB(B1, 1, 1); PG8_SCHED; PG8_LDA(At, 1, 0); PG8_STAGE2(PG8_SA(0, 1), a2, w10, w11);
            PG8_WAIT_V(8); PG8_WAIT_L(0); PG8_BAR; PG8_MMA(0, 0, At, B0); PG8_MMA(0, 1, At, B1); PG8_BAR; PG8_SCHED;
            PG8_LDA(At, 1, 1); PG8_STAGEB(PG8_SB(1, 0), b3); PG8_STAGEB(PG8_SB(1, 1), b3 + hstepB); PG8_STAGE2(PG8_SA(1, 0), a3, w00, w01);
            PG8_WAIT_V(8); PG8_WAIT_L(0); PG8_BAR; PG8_MMA(1, 0, At, B0); PG8_MMA(1, 1, At, B1); PG8_BAR; PG8_SCHED;
        }
        if (wr == 0) PG8_BAR;
        E(acc, cur, wr, wc, fr, fq);
        if (!has_next) break;
#pragma unroll
        for (int a = 0; a < 2; ++a)
#pragma unroll
            for (int b = 0; b < 2; ++b)
#pragma unroll
                for (int m = 0; m < 4; ++m)
#pragma unroll
                    for (int n = 0; n < 2; ++n) acc[a][b][m][n] = (f32x4){0.f, 0.f, 0.f, 0.f};
        cur = nxt; cA = nA; cB = nB; ++ui;
        if (GATHER) {
#pragma unroll
            for (int h_ = 0; h_ < 2; ++h_) { vc[h_][0] = vn[h_][0]; vc[h_][1] = vn[h_][1]; } }
        if (wr == 1) PG8_BAR;
    }
    PG8_WAIT_V(0);
    PG8_BAR;
#undef PG8_SA
#undef PG8_SB
#undef PG8_STAGE2
#undef PG8_STAGEB
#undef PG8_LDA
#undef PG8_LDB
#undef PG8_MMA
#undef PG8_WAIT_V
#undef PG8_WAIT_L
#undef PG8_BAR
#undef PG8_SCHED
#undef PG8_VOFFA
}
}

constexpr int NWAVES = 8, NTHREADS = 512;
constexpr int RING_OFF = 0, RING_BYTES = 131072, ROWS_OFF = 131072, ROWS_BYTES = 12288, ROUTER_BYTES = 147456  , MISC_OFF = ROUTER_BYTES, LCNT_OFF = MISC_OFF + 128  , LDS_BYTES = 148480;
static_assert(MISC_OFF + 128 <= LDS_BYTES, "LDS map");
constexpr int CW_CNT = 0;
constexpr int CW_BAR = 4096;
constexpr size_t CTL_ZERO_BYTES = 64 * 1024;
constexpr float LOG2E = 1.4426950408889634f, LN2 = 0.6931471805599453f;
constexpr float QSCALE = 0.125f * LOG2E;

#define GAS __attribute__((address_space(1)))
#define LAS __attribute__((address_space(3)))
typedef unsigned v4u __attribute__((ext_vector_type(4)));
typedef unsigned v2u __attribute__((ext_vector_type(2)));
#define LDS_WAIT() asm volatile("s_waitcnt lgkmcnt(0)" ::: "memory")
__device__ __forceinline__ unsigned pk2(float lo, float hi) { return (unsigned)f2bf(lo) | ((unsigned)f2bf(hi) << 16); }

#define XB_TMO      128
#define XB_XCNT(j)  (256  + 64 * (j))
#define XB_XSUB(j)  (1280 + 64 * (j))
#define XB_XGEN(j)  (2304 + 64 * (j))
#define XB_TOP      3328
#define XB_TOPGEN   3392
#define XCD_BAR_WORDS 3456
#define XB_SPIN_CAP (1u << 18)

__device__ __forceinline__ unsigned xb_ld(unsigned* p)              { return __hip_atomic_load(p, __ATOMIC_RELAXED, __HIP_MEMORY_SCOPE_AGENT); }
__device__ __forceinline__ unsigned xb_add(unsigned* p, unsigned v) { return __hip_atomic_fetch_add(p, v, __ATOMIC_RELAXED, __HIP_MEMORY_SCOPE_AGENT); }
__device__ __forceinline__ unsigned xb_xcc_id() { return (unsigned)__builtin_amdgcn_s_getreg((3 << 11) | 20) & 0xFu; }
#define XB_SPIN(cond, bar) do { unsigned _sp = 0; while (cond) { __builtin_amdgcn_s_sleep(1); \
    if ((++_sp & 255u) == 0u) { if (xb_ld(&(bar)[XB_TMO])) break; if (_sp > XB_SPIN_CAP) { atomicAdd(&(bar)[XB_TMO], 1u); break; } } } } while (0)

struct XcdBarrier {
    int wave0;
    unsigned* bar; unsigned x;
    volatile LAS unsigned* st;
};

__device__ __forceinline__ unsigned xb_lane() { unsigned l_; asm volatile("v_mbcnt_lo_u32_b32 %0, -1, 0\n\tv_mbcnt_hi_u32_b32 %0, -1, %0" : "=v"(l_)); return l_; }
__device__ __forceinline__ XcdBarrier xcd_barrier_post(unsigned* bar, volatile LAS unsigned* st, int wave0) {
    XcdBarrier b; b.wave0 = wave0; b.bar = bar; b.x = xb_xcc_id(); b.st = st;
    if (b.wave0 && xb_lane() == 0u) (void)xb_add(&bar[XB_XCNT(b.x)], 1u);
    return b;
}
__device__ __forceinline__ void xcd_barrier_complete(unsigned* bar, unsigned x, unsigned& nloc, unsigned& nx) {
    const unsigned G = gridDim.x * gridDim.y * gridDim.z;
    unsigned sum, cnt, mine, sp = 0u;
    for (;;) {
        sum = 0u; cnt = 0u; mine = 0u;
#pragma unroll
        for (unsigned j = 0; j < 16; ++j) { const unsigned c = xb_ld(&bar[XB_XCNT(j)]); sum += c; cnt += (c > 0u) ? 1u : 0u; mine = (j == x) ? c : mine; }
        if (sum == G) break;
        __builtin_amdgcn_s_sleep(1);
        if ((++sp & 255u) == 0u) { if (xb_ld(&bar[XB_TMO])) break; if (sp > XB_SPIN_CAP) { atomicAdd(&bar[XB_TMO], 1u); break; } }
    }
    nloc = mine > 0u ? mine : 1u; nx = cnt > 0u ? cnt : 1u;
}

__device__ __forceinline__ void xcd_barrier(const XcdBarrier& b) {
    asm volatile("s_waitcnt vmcnt(0)" ::: "memory");
    __syncthreads();
    if (b.wave0 && xb_lane() == 0u) {
        unsigned* bar = b.bar;
        __builtin_amdgcn_s_waitcnt(0);
        unsigned nloc = b.st[0], nx = b.st[1];
        if (nloc == 0u) { xcd_barrier_complete(bar, b.x, nloc, nx); b.st[0] = nloc; b.st[1] = nx; }
        const unsigned old = xb_add(&bar[XB_XSUB(b.x)], 1u);
        const unsigned gen = old / nloc;
        if (old + 1u == (gen + 1u) * nloc) {
            __builtin_amdgcn_fence(__ATOMIC_RELEASE, "agent");
            asm volatile("s_waitcnt vmcnt(0)" ::: "memory");
            const unsigned og = xb_add(&bar[XB_TOP], 1u);
            const unsigned tg = og / nx;
            if (og + 1u == (tg + 1u) * nx) xb_add(&bar[XB_TOPGEN], 1u);
            else XB_SPIN(xb_ld(&bar[XB_TOPGEN]) == tg, bar);
            __builtin_amdgcn_fence(__ATOMIC_ACQUIRE, "agent");
            xb_add(&bar[XB_XGEN(b.x)], 1u);
            asm volatile("s_waitcnt vmcnt(0)" ::: "memory");
        } else {
            XB_SPIN(xb_ld(&bar[XB_XGEN(b.x)]) == gen, bar);
            __builtin_amdgcn_fence(__ATOMIC_ACQUIRE, "agent");
            asm volatile("s_waitcnt vmcnt(0)" ::: "memory");
        }
    }
    __syncthreads();
}


struct Args { const float* in[23]; float* out; unsigned char* ws; int s_lo, s_hi, probe, pad; };

struct Frame {
    LAS unsigned char* lds; int tid, lane, wave, vcu, G;
    const float* const* in; float* h; unsigned char* ws; int probe;
};

__device__ __forceinline__ int hw_lane() { int l_; asm volatile("v_mbcnt_lo_u32_b32 %0, -1, 0\n\tv_mbcnt_hi_u32_b32 %0, -1, %0" : "=v"(l_)); return l_; }
__device__ __forceinline__ float shfl_xor_l(float v, int mask, int lane) { return __builtin_bit_cast(float, __builtin_amdgcn_ds_bpermute((lane ^ mask) << 2, __builtin_bit_cast(int, v))); }
__device__ __forceinline__ float dpp_add(float v, const int ctrl_sel) {
    const int x = __builtin_bit_cast(int, v); int y;
    if (ctrl_sel == 0) y = __builtin_amdgcn_mov_dpp(x, 0xB1, 0xF, 0xF, true);
    else if (ctrl_sel == 1) y = __builtin_amdgcn_mov_dpp(x, 0x4E, 0xF, 0xF, true);
    else if (ctrl_sel == 2) y = __builtin_amdgcn_mov_dpp(x, 0x141, 0xF, 0xF, true);
    else y = __builtin_amdgcn_mov_dpp(x, 0x140, 0xF, 0xF, true);
    return v + __builtin_bit_cast(float, y);
}
__device__ __forceinline__ float wave_sum_l(float v, int lane) {
    (void)lane;
    v = dpp_add(v, 0); v = dpp_add(v, 1); v = dpp_add(v, 2); v = dpp_add(v, 3);
    const int x = __builtin_bit_cast(int, v);
    const float r0 = __builtin_bit_cast(float, __builtin_amdgcn_readlane(x, 0)), r1 = __builtin_bit_cast(float, __builtin_amdgcn_readlane(x, 16)),
                r2 = __builtin_bit_cast(float, __builtin_amdgcn_readlane(x, 32)), r3 = __builtin_bit_cast(float, __builtin_amdgcn_readlane(x, 48));
    return (r0 + r1) + (r2 + r3);
}
#define LAUNDER(F) do { (F).lane = hw_lane(); (F).tid = (F).wave * 64 + (F).lane; asm volatile("" : "+s"((F).G), "+s"((F).vcu), "+s"((F).ws), "+s"((F).h)); } while (0)
__device__ __forceinline__ void p0_item(const float* W, int ldw, int k0, int n0, bf16* WT, int Kd, int drow0, float scale, LAS float* scr, int lane) {
#pragma unroll 8
    for (int i = 0; i < 32; ++i) { const int kk = 2 * i + (lane >> 5); scr[kk * 33 + (lane & 31)] = W[(size_t)(k0 + kk) * ldw + n0 + (lane & 31)] * scale; }
    LDS_WAIT(); asm volatile("" ::: "memory");
    const int c = lane & 7;
#pragma unroll
    for (int j = 0; j < 4; ++j) { const int n = (lane >> 3) + 8 * j; const LAS float* s = scr + (8 * c) * 33 + n;
        v4u o; o.x = pk2(s[0 * 33], s[1 * 33]); o.y = pk2(s[2 * 33], s[3 * 33]); o.z = pk2(s[4 * 33], s[5 * 33]); o.w = pk2(s[6 * 33], s[7 * 33]);
        *(GAS v4u*)(WT + (size_t)(drow0 + n) * Kd + k0 + 8 * c) = o; }
    LDS_WAIT(); asm volatile("" ::: "memory");
}
__device__ __forceinline__ bool is_q_col(int n) { return n < 512 || (n >= 768 && n < 3072 && ((n - 768) % 768) < 256) || (n >= 3072 && n < 3584); }

__device__ __forceinline__ void ph_prologue(Frame& F) { LAUNDER(F);
    LAS float* scr = (LAS float*)(F.lds + RING_OFF + F.wave * 16384);
    const int gw = F.vcu * NWAVES + F.wave, NGW = F.G * NWAVES, lane = F.lane;
    const float* w_in = F.in[4]; const float* w_a = F.in[8]; const float* w_b = F.in[9]; const float* w_c = F.in[10]; const float* w_o = F.in[11];
    const float* w_eg = F.in[18]; const float* w_eu = F.in[19]; const float* w_ed = F.in[20];
    bf16* WIN = (bf16*)(F.ws + WS_WIN); bf16* WBRA = (bf16*)(F.ws + WS_WBRA); bf16* WBRB = (bf16*)(F.ws + WS_WBRB); bf16* WBRC = (bf16*)(F.ws + WS_WBRC); bf16* WOUT = (bf16*)(F.ws + WS_WOUT);
    bf16* WGU = (bf16*)(F.ws + WS_WGU); bf16* WD = (bf16*)(F.ws + WS_WD);
    constexpr int I_IN = 16 * (NCOL / 32), I_A = 8 * 32, I_B = 4 * 32, I_C = 8 * 32, I_O = 16 * 32, I_G = 16 * 16, I_D = 8 * 32;
    constexpr int I_LAYER = I_IN + I_A + I_B + I_C + I_O + NE * (2 * I_G + I_D);
    for (int it = gw; it < DEPTH * I_LAYER; it += NGW) {
        const int l = it / I_LAYER; int r = it % I_LAYER;
        if (r < I_IN) { const int nb = r % (NCOL / 32), kb = r / (NCOL / 32); p0_item(w_in + (size_t)l * D * NCOL, NCOL, 64 * kb, 32 * nb, WIN + (size_t)l * NCOL * D, D, 32 * nb, is_q_col(32 * nb) ? QSCALE : 1.0f, scr, lane); continue; } r -= I_IN;
        if (r < I_A) { const int nb = r % 32, kb = r / 32; p0_item(w_a + (size_t)l * 512 * D, D, 64 * kb, 32 * nb, WBRA + (size_t)l * D * 512, 512, 32 * nb, 1.0f, scr, lane); continue; } r -= I_A;
        if (r < I_B) { const int nb = r % 32, kb = r / 32; p0_item(w_b + (size_t)l * 256 * D, D, 64 * kb, 32 * nb, WBRB + (size_t)l * D * 256, 256, 32 * nb, 1.0f, scr, lane); continue; } r -= I_B;
        if (r < I_C) { const int nb = r % 32, kb = r / 32; p0_item(w_c + (size_t)l * 512 * D, D, 64 * kb, 32 * nb, WBRC + (size_t)l * D * 512, 512, 32 * nb, 1.0f, scr, lane); continue; } r -= I_C;
        if (r < I_O) { const int nb = r % 32, kb = r / 32; p0_item(w_o + (size_t)l * D * D, D, 64 * kb, 32 * nb, WOUT + (size_t)l * D * D, D, 32 * nb, 1.0f, scr, lane); continue; } r -= I_O;
        const int e = r / (2 * I_G + I_D); r %= (2 * I_G + I_D); const size_t le = (size_t)l * NE + e;
        if (r < 2 * I_G) { const int up = r / I_G; r %= I_G; const int nb = r % 16, kb = r / 16;
            p0_item((up ? w_eu : w_eg) + le * D * DE, DE, 64 * kb, 32 * nb, WGU + le * 1024 * 1024, D, (nb >> 2) * 256 + up * 128 + (nb & 3) * 32, 1.0f, scr, lane); continue; }
        r -= 2 * I_G; { const int nb = r % 32, kb = r / 32; p0_item(w_ed + le * DE * D, D, 64 * kb, 32 * nb, WD + le * D * DE, DE, 32 * nb, 1.0f, scr, lane); }
    }
}

struct LnIn { f32x4 v[4]; v2u a[4], b[4]; };
template <int MODE> __device__ __forceinline__ void ln_load(LnIn& in, const float* src, const bf16* yb, size_t row, int lane) {
#pragma unroll
    for (int j = 0; j < 4; ++j) {
        const int c = lane * 4 + 256 * j;
        in.v[j] = *(const GAS f32x4*)(src + row * D + c);
        if (MODE == 2) { in.a[j] = *(const GAS v2u*)(yb + (row * 2) * D + c); in.b[j] = *(const GAS v2u*)(yb + (row * 2 + 1) * D + c); }
    }
}
template <int MODE> __device__ __forceinline__ void ln_finish(const LnIn& in, float* hout, bf16* hb, const float* g, const float* bta, size_t row, int lane, f32x4 (&o)[4]) {
    f32x4 v[4];
#pragma unroll
    for (int j = 0; j < 4; ++j) {
        v[j] = in.v[j];
        if (MODE == 2) {
            const v2u a = in.a[j], b = in.b[j];
            v[j].x = ALPHA * v[j].x + bf2f((bf16)(a.x & 0xffff)) + bf2f((bf16)(b.x & 0xffff));
            v[j].y = ALPHA * v[j].y + bf2f((bf16)(a.x >> 16)) + bf2f((bf16)(b.x >> 16));
            v[j].z = ALPHA * v[j].z + bf2f((bf16)(a.y & 0xffff)) + bf2f((bf16)(b.y & 0xffff));
            v[j].w = ALPHA * v[j].w + bf2f((bf16)(a.y >> 16)) + bf2f((bf16)(b.y >> 16));
        }
    }
    float s = 0.f;
#pragma unroll
    for (int j = 0; j < 4; ++j) s += (v[j].x + v[j].y) + (v[j].z + v[j].w);
    const float mean = wave_sum_l(s, lane) * (1.f / D);
    float q = 0.f;
#pragma unroll
    for (int j = 0; j < 4; ++j) { v[j] = v[j] - mean; q += (v[j].x * v[j].x + v[j].y * v[j].y) + (v[j].z * v[j].z + v[j].w * v[j].w); }
    const float rstd = 1.0f / sqrtf(wave_sum_l(q, lane) * (1.f / D) + LN_EPS);
#pragma unroll
    for (int j = 0; j < 4; ++j) {
        const int c = lane * 4 + 256 * j;
        const f32x4 gg = *(const GAS f32x4*)(g + c), bb = *(const GAS f32x4*)(bta + c);
        o[j] = v[j] * rstd * gg + bb;
        *(GAS f32x4*)(hout + row * D + c) = o[j];
        if (hb) { v2u w; w.x = pk2(o[j].x, o[j].y); w.y = pk2(o[j].z, o[j].w); *(GAS v2u*)(hb + row * D + c) = w; }
    }
}

#ifndef PROBE_EPI
#define PROBE_EPI 0
#endif
struct EpiP1 {
    static constexpr bool PERM = true;
    bf16* qkv; bf16* gates; const float* b_gate; int probe;
    __device__ __forceinline__ void operator()(const f32x4 (&acc)[2][2][4][2], const pg8::Unit& u, int wr, int wc, int fr, int fq) const {
        if (probe == 1 && PROBE_EPI == 0) return;
        const int row0 = (probe == 1 ? (int)(blockIdx.x & 127) : u.pm) * 256 + wr * 64 + fr; const bool isg = u.pn >= 18;
        bf16* base = isg ? gates : qkv; const int ldc = isg ? GATEW : QKVW; const int col0 = (isg ? (u.pn - 18) : u.pn) * 256 + wc * 32 + 8 * fq;
        f32x4 bv[2][2];
#pragma unroll
        for (int bj = 0; bj < 2; ++bj)
#pragma unroll
            for (int n = 0; n < 2; ++n) bv[bj][n] = isg ? *(const GAS f32x4*)(b_gate + col0 + bj * 128 + 4 * n) : (f32x4){0.f, 0.f, 0.f, 0.f};
#pragma unroll
        for (int ai = 0; ai < 2; ++ai)
#pragma unroll
            for (int m = 0; m < 4; ++m) { bf16* rowp = base + (size_t)(row0 + ai * 128 + m * 16) * ldc + col0;
#pragma unroll
                for (int bj = 0; bj < 2; ++bj) { f32x4 v0 = acc[ai][bj][m][0] + bv[bj][0], v1 = acc[ai][bj][m][1] + bv[bj][1];
                    if (isg) {
#pragma unroll
                        for (int j = 0; j < 4; ++j) { v0[j] = __builtin_amdgcn_rcpf(1.0f + __builtin_amdgcn_exp2f(-LOG2E * v0[j])); v1[j] = __builtin_amdgcn_rcpf(1.0f + __builtin_amdgcn_exp2f(-LOG2E * v1[j])); } }
                    v4u w; w.x = pg8::cvt_pk_bf16(v0[0], v0[1]); w.y = pg8::cvt_pk_bf16(v0[2], v0[3]); w.z = pg8::cvt_pk_bf16(v1[0], v1[1]); w.w = pg8::cvt_pk_bf16(v1[2], v1[3]);
                    *(GAS v4u*)(rowp + bj * 128) = w; } }
    }
};
template <bool FIRST> struct EpiP3 {
    static constexpr bool PERM = true;
    bf16* merged; const bf16* gates; int br;
    __device__ __forceinline__ void operator()(const f32x4 (&acc)[2][2][4][2], const pg8::Unit& u, int wr, int wc, int fr, int fq) const {
        const int row0 = u.pm * 256 + wr * 64 + fr, col0 = u.pn * 256 + wc * 32 + 8 * fq;
#pragma unroll
        for (int ai = 0; ai < 2; ++ai) {
            v4u gw[4][2], ow[4][2];
#pragma unroll
            for (int m = 0; m < 4; ++m)
#pragma unroll
                for (int bj = 0; bj < 2; ++bj) { const size_t row = (size_t)(row0 + ai * 128 + m * 16);
                    gw[m][bj] = *(const GAS v4u*)(gates + row * GATEW + br * 1024 + col0 + bj * 128);
                    ow[m][bj] = FIRST ? (v4u){0u, 0u, 0u, 0u} : *(const GAS v4u*)(merged + row * D + col0 + bj * 128); }
#pragma unroll
            for (int m = 0; m < 4; ++m)
#pragma unroll
                for (int bj = 0; bj < 2; ++bj) { const size_t row = (size_t)(row0 + ai * 128 + m * 16);
                    const f32x4 a0 = acc[ai][bj][m][0], a1 = acc[ai][bj][m][1];
                    float r[8];
#pragma unroll
                    for (int j = 0; j < 4; ++j) { const unsigned g2 = gw[m][bj][j], o2 = ow[m][bj][j]; const float av0 = j < 2 ? a0[2 * j] : a1[2 * j - 4], av1 = j < 2 ? a0[2 * j + 1] : a1[2 * j - 3];
                        r[2 * j] = __uint_as_float(g2 << 16) * av0 + (FIRST ? 0.f : __uint_as_float(o2 << 16)); r[2 * j + 1] = __uint_as_float(g2 & 0xffff0000u) * av1 + (FIRST ? 0.f : __uint_as_float(o2 & 0xffff0000u)); }
                    v4u w; w.x = pg8::cvt_pk_bf16(r[0], r[1]); w.y = pg8::cvt_pk_bf16(r[2], r[3]); w.z = pg8::cvt_pk_bf16(r[4], r[5]); w.w = pg8::cvt_pk_bf16(r[6], r[7]);
                    *(GAS v4u*)(merged + row * D + col0 + bj * 128) = w; }
            asm volatile("" ::: "memory"); }
    }
};
struct EpiP4 {
    static constexpr bool PERM = false;
    const float* hc; float* ho;
    __device__ __forceinline__ void operator()(const f32x4 (&acc)[2][2][4][2], const pg8::Unit& u, int wr, int wc, int fr, int fq) const {
        const int row0 = u.pm * 256 + wr * 64 + fr, col0 = u.pn * 256 + wc * 32 + 4 * fq;
#pragma unroll
        for (int ai = 0; ai < 2; ++ai)
#pragma unroll
            for (int mp = 0; mp < 2; ++mp) { f32x4 hv[2][2][2];
#pragma unroll
                for (int mm = 0; mm < 2; ++mm)
#pragma unroll
                    for (int bj = 0; bj < 2; ++bj)
#pragma unroll
                        for (int n = 0; n < 2; ++n) hv[mm][bj][n] = *(const GAS f32x4*)(hc + (size_t)(row0 + ai * 128 + (2 * mp + mm) * 16) * D + col0 + bj * 128 + n * 16);
#pragma unroll
                for (int mm = 0; mm < 2; ++mm)
#pragma unroll
                    for (int bj = 0; bj < 2; ++bj)
#pragma unroll
                        for (int n = 0; n < 2; ++n) *(GAS f32x4*)(ho + (size_t)(row0 + ai * 128 + (2 * mp + mm) * 16) * D + col0 + bj * 128 + n * 16) = hv[mm][bj][n] * ALPHA + acc[ai][bj][2 * mp + mm][n];
                asm volatile("" ::: "memory"); }
    }
};
struct EpiP7 {
    static constexpr bool PERM = true;
    bf16* hid;
    __device__ __forceinline__ void operator()(const f32x4 (&acc)[2][2][4][2], const pg8::Unit& u, int wr, int wc, int fr, int fq) const {
        const int row0 = u.pm * 256 + wr * 64 + fr, col0 = u.pn * 128 + wc * 32 + 8 * fq;
#pragma unroll
        for (int ai = 0; ai < 2; ++ai)
#pragma unroll
            for (int m = 0; m < 4; ++m) { float r[8];
#pragma unroll
                for (int n = 0; n < 2; ++n)
#pragma unroll
                    for (int j = 0; j < 4; ++j) { const float gv = acc[ai][0][m][n][j], uv = acc[ai][1][m][n][j]; r[4 * n + j] = gv * __builtin_amdgcn_rcpf(1.0f + __builtin_amdgcn_exp2f(-LOG2E * gv)) * uv; }
                v4u w; w.x = pg8::cvt_pk_bf16(r[0], r[1]); w.y = pg8::cvt_pk_bf16(r[2], r[3]); w.z = pg8::cvt_pk_bf16(r[4], r[5]); w.w = pg8::cvt_pk_bf16(r[6], r[7]);
                *(GAS v4u*)(hid + (size_t)(row0 + ai * 128 + m * 16) * DE + col0) = w; }
    }
};
struct EpiP8 {
    static constexpr bool PERM = true;
    bf16* yb; const int* rowtok; const float* rowgate;
    __device__ __forceinline__ void operator()(const f32x4 (&acc)[2][2][4][2], const pg8::Unit& u, int wr, int wc, int fr, int fq) const {
        const int row0 = u.pm * 256 + wr * 64 + fr, col0 = u.pn * 256 + wc * 32 + 8 * fq;
        int rt[2][4]; float gt[2][4];
#pragma unroll
        for (int ai = 0; ai < 2; ++ai)
#pragma unroll
            for (int m = 0; m < 4; ++m) { const int row = row0 + ai * 128 + m * 16; rt[ai][m] = *(const GAS int*)(rowtok + row); gt[ai][m] = *(const GAS float*)(rowgate + row); }
#pragma unroll
        for (int ai = 0; ai < 2; ++ai)
#pragma unroll
            for (int m = 0; m < 4; ++m) {
                if (rt[ai][m] >= 0) {
#pragma unroll
                    for (int bj = 0; bj < 2; ++bj) { const f32x4 v0 = acc[ai][bj][m][0] * gt[ai][m], v1 = acc[ai][bj][m][1] * gt[ai][m];
                        v4u w; w.x = pg8::cvt_pk_bf16(v0[0], v0[1]); w.y = pg8::cvt_pk_bf16(v0[2], v0[3]); w.z = pg8::cvt_pk_bf16(v1[0], v1[1]); w.w = pg8::cvt_pk_bf16(v1[2], v1[3]);
                        *(GAS v4u*)(yb + (size_t)rt[ai][m] * D + col0 + bj * 128) = w; } } }
    }
};

__device__ __forceinline__ void router_row(const float (&x)[16], int t, int lane, const LAS float* w_rg, const float* b_rg, const LAS float* w_re, const float* b_re, LAS int* lcnt, int wslot, Rec* rec) {
    float gl[4] = {0.f, 0.f, 0.f, 0.f};
#pragma unroll
    for (int j = 0; j < 4; ++j)
#pragma unroll
        for (int i = 0; i < 4; ++i) { const f32x4 w = *(const LAS f32x4*)(w_rg + ((j * 4 + i) * 64 + lane) * 4); const float xv = x[4 * j + i]; gl[0] += xv * w.x; gl[1] += xv * w.y; gl[2] += xv * w.z; gl[3] += xv * w.w; }
#pragma unroll
    for (int g = 0; g < 4; ++g) gl[g] = wave_sum_l(gl[g], lane) + b_rg[g];
    int gi = 0; float gm = gl[0];
#pragma unroll
    for (int g = 1; g < 4; ++g) if (gl[g] > gm) { gm = gl[g]; gi = g; }
    float gs = 0.f;
#pragma unroll
    for (int g = 0; g < 4; ++g) gs += __expf(gl[g] - gm);
    const float gw = 1.0f / gs;
    float el[8];
#pragma unroll
    for (int e = 0; e < 8; ++e) el[e] = 0.f;
    const LAS float* wre = w_re + gi * (D * 8);
#pragma unroll
    for (int j = 0; j < 4; ++j)
#pragma unroll
        for (int i = 0; i < 4; ++i) { const LAS float* wp = wre + ((j * 4 + i) * 128 + lane) * 4; const f32x4 w0 = *(const LAS f32x4*)wp, w1 = *(const LAS f32x4*)(wp + 256); const float xv = x[4 * j + i];
            el[0] += xv * w0.x; el[1] += xv * w0.y; el[2] += xv * w0.z; el[3] += xv * w0.w; el[4] += xv * w1.x; el[5] += xv * w1.y; el[6] += xv * w1.z; el[7] += xv * w1.w; }
#pragma unroll
    for (int e = 0; e < 8; ++e) el[e] = wave_sum_l(el[e], lane) + b_re[gi * 8 + e];
    int i0 = 0; float t0 = el[0];
#pragma unroll
    for (int e = 1; e < 8; ++e) if (el[e] > t0) { t0 = el[e]; i0 = e; }
    int i1 = -1; float t1 = -3.0e38f;
#pragma unroll
    for (int e = 0; e < 8; ++e) if (e != i0 && el[e] > t1) { t1 = el[e]; i1 = e; }
    const float ex = __expf(t1 - t0), p0 = 1.0f / (1.0f + ex), p1 = ex / (1.0f + ex);
    if (lane == 0) {
        const int e0 = gi * 8 + i0, e1 = gi * 8 + i1;
        const int s0 = __hip_atomic_fetch_add(lcnt + e0, 1, __ATOMIC_RELAXED, __HIP_MEMORY_SCOPE_WORKGROUP), s1 = __hip_atomic_fetch_add(lcnt + e1, 1, __ATOMIC_RELAXED, __HIP_MEMORY_SCOPE_WORKGROUP);
        GAS v4u* rp = (GAS v4u*)(rec + t);
        rp[0] = (v4u){(unsigned)e0, (unsigned)s0, (unsigned)e1, (unsigned)s1};
        rp[1] = (v4u){__float_as_uint(gw * p0), __float_as_uint(gw * p1), (unsigned)wslot, 0u};
    }
}

#ifndef STAG_P1
#define STAG_P1 500
#endif
__device__ __forceinline__ void stagger(int vcu, unsigned q) {
    const unsigned long long t0 = __builtin_amdgcn_s_memrealtime(); const unsigned long long d = (unsigned long long)((vcu & 3) * q);
    while (__builtin_amdgcn_s_memrealtime() - t0 < d) __builtin_amdgcn_s_sleep(8);
}
__device__ __forceinline__ void ph_ln0(Frame& F) { LAUNDER(F);
    const int gw = F.vcu * NWAVES + F.wave, NGW = F.G * NWAVES;
    bf16* hb = (bf16*)(F.ws + WS_HB);
    LnIn cur, nxt; if (gw < T) ln_load<0>(cur, F.in[0], nullptr, (size_t)gw, F.lane);
    for (int m = gw; m < T; m += NGW) { const bool more = m + NGW < T; if (more) ln_load<0>(nxt, F.in[0], nullptr, (size_t)(m + NGW), F.lane);
        f32x4 o[4]; ln_finish<0>(cur, F.h, hb, F.in[1], F.in[2], (size_t)m, F.lane, o); if (more) cur = nxt; }
}
__device__ __forceinline__ void ph_p1(Frame& F, int l, int c) { LAUNDER(F); asm volatile("" : "+s"(l), "+s"(c));
    pg8::DenseOrder S; S.init((const bf16*)(F.ws + WS_HB) + (size_t)c * CH * D, D, (const bf16*)(F.ws + WS_WIN) + (size_t)l * NCOL * D, D, CH, NCOL, F.G, (int)blockIdx.x);
    EpiP1 E{(bf16*)(F.ws + WS_QKV), (bf16*)(F.ws + WS_GATES), F.in[5] + (size_t)l * GATEW, F.probe};
    pg8::gemm_phase<EpiP1, pg8::DenseOrder, false>(F.lds + RING_OFF, S, E, D, D, D, F.tid);
}
__device__ __forceinline__ void ph_cmb(Frame& F) { LAUNDER(F);
    const bf16* og = (const bf16*)(F.ws + WS_OG); const float* lse = (const float*)(F.ws + WS_LSE); bf16* oabc = (bf16*)(F.ws + WS_OABC);
    for (int idx = F.vcu * NTHREADS + F.tid; idx < CH * 32; idx += F.G * NTHREADS) {
        const int tl = idx >> 5, hc = idx & 31, h = hc >> 3, c = hc & 7;
        const GAS float* lg = (const GAS float*)lse + (size_t)tl * 12 + h; const float l0 = lg[0], l1 = lg[4], l2 = lg[8];
        const float mx = fmaxf(l0, fmaxf(l1, l2)); float w0 = __expf(l0 - mx), w1 = __expf(l1 - mx), w2 = __expf(l2 - mx); const float inv = 1.0f / (w0 + w1 + w2); w0 *= inv; w1 *= inv; w2 *= inv;
        const v4u a = *(const GAS v4u*)(og + ((size_t)tl * 3 + 0) * 256 + h * 64 + c * 8), b = *(const GAS v4u*)(og + ((size_t)tl * 3 + 1) * 256 + h * 64 + c * 8), d = *(const GAS v4u*)(og + ((size_t)tl * 3 + 2) * 256 + h * 64 + c * 8);
        v4u ow;
#pragma unroll
        for (int i = 0; i < 4; ++i) {
            const float lo = w0 * __uint_as_float(a[i] << 16) + w1 * __uint_as_float(b[i] << 16) + w2 * __uint_as_float(d[i] << 16);
            const float hi = w0 * __uint_as_float(a[i] & 0xffff0000u) + w1 * __uint_as_float(b[i] & 0xffff0000u) + w2 * __uint_as_float(d[i] & 0xffff0000u);
            ow[i] = pk2(lo, hi);
        }
        *(GAS v4u*)(oabc + (size_t)tl * OW + 512 + h * 64 + c * 8) = ow;
    }
}
__device__ __forceinline__ void ph_p3(Frame& F, int l) { LAUNDER(F); asm volatile("" : "+s"(l));
    const bf16* oabc = (const bf16*)(F.ws + WS_OABC); bf16* merged = (bf16*)(F.ws + WS_MERGED); const bf16* gates = (const bf16*)(F.ws + WS_GATES);
    { pg8::DenseOrder S; S.init(oabc, OW, (const bf16*)(F.ws + WS_WBRA) + (size_t)l * D * 512, 512, CH, D, F.G, (int)blockIdx.x);
      EpiP3<true> E{merged, gates, 0}; pg8::gemm_phase<EpiP3<true>, pg8::DenseOrder, false>(F.lds + RING_OFF, S, E, 512, OW, 512, F.tid); }
    { pg8::DenseOrder S; S.init(oabc + 512, OW, (const bf16*)(F.ws + WS_WBRB) + (size_t)l * D * 256, 256, CH, D, F.G, (int)blockIdx.x);
      EpiP3<false> E{merged, gates, 1}; pg8::gemm_phase<EpiP3<false>, pg8::DenseOrder, false>(F.lds + RING_OFF, S, E, 256, OW, 256, F.tid); }
    { pg8::DenseOrder S; S.init(oabc + 768, OW, (const bf16*)(F.ws + WS_WBRC) + (size_t)l * D * 512, 512, CH, D, F.G, (int)blockIdx.x);
      EpiP3<false> E{merged, gates, 2}; pg8::gemm_phase<EpiP3<false>, pg8::DenseOrder, false>(F.lds + RING_OFF, S, E, 512, OW, 512, F.tid); }
}
__device__ __forceinline__ void ph_p4(Frame& F, int l, int c) { LAUNDER(F); asm volatile("" : "+s"(l), "+s"(c));
    pg8::DenseOrder S; S.init((const bf16*)(F.ws + WS_MERGED), D, (const bf16*)(F.ws + WS_WOUT) + (size_t)l * D * D, D, CH, D, F.G, (int)blockIdx.x);
    EpiP4 E{F.h + (size_t)c * CH * D, F.probe ? (float*)(F.ws + WS_OABC) : F.h + (size_t)c * CH * D};
    pg8::gemm_phase<EpiP4, pg8::DenseOrder, false>(F.lds + RING_OFF, S, E, D, D, D, F.tid);
}
__device__ __forceinline__ void ph_ln1(Frame& F, int l, int c) { LAUNDER(F); asm volatile("" : "+s"(l), "+s"(c));
    const int gw = F.vcu * NWAVES + F.wave, NGW = F.G * NWAVES;
    bf16* hb = (bf16*)(F.ws + WS_HB); Rec* rec = (Rec*)(F.ws + WS_REC);
    int* wgc = (int*)(F.ws + WS_WGCNT) + ((size_t)(l * NCHUNK + c) * F.G + F.vcu) * 32;
    float* hout = F.h;
    if (F.probe) { hout = (float*)(F.ws + WS_OABC) - (size_t)c * CH * D; hb = (bf16*)(F.ws + WS_QKV) - (size_t)c * CH * D; wgc = (int*)(F.ws + WS_WGCNT) + (size_t)DEPTH * NCHUNK * 256 * 32 + F.vcu * 32; rec = (Rec*)(F.ws + WS_GATES); }
    LAS float* lrg = (LAS float*)(F.lds + RING_OFF); LAS float* lre = lrg + D * 4; LAS int* lcnt = (LAS int*)(F.lds + LCNT_OFF);
    { const float* w_rg = F.in[14] + (size_t)l * D * 4; const float* w_re = F.in[16] + (size_t)l * 4 * D * 8;
      if (F.tid < 32) lcnt[F.tid] = 0;
      for (int u = F.tid; u < D + 4 * D * 2; u += NTHREADS) {
          if (u < D) { const int e = u, ln = (e & 255) >> 2, i = e & 3, j = e >> 8; *(LAS f32x4*)(lrg + ((j * 4 + i) * 64 + ln) * 4) = *(const GAS f32x4*)(w_rg + (size_t)e * 4); }
          else { const int v = u - D, half = v & 1, e = (v >> 1) & 1023, g = v >> 11, ln = (e & 255) >> 2, i = e & 3, j = e >> 8;
                 *(LAS f32x4*)(lre + g * (D * 8) + (((j * 4 + i) * 2 + half) * 64 + ln) * 4) = *(const GAS f32x4*)(w_re + ((size_t)g * D + e) * 8 + half * 4); } }
      __syncthreads(); }
    const size_t rbase = (size_t)c * CH;
    LnIn cur, nxt; if (gw < CH) ln_load<1>(cur, F.h, nullptr, rbase + gw, F.lane);
    for (int m = gw; m < CH; m += NGW) {
        const bool more = m + NGW < CH; if (more) ln_load<1>(nxt, F.h, nullptr, rbase + m + NGW, F.lane);
        const size_t row = rbase + m; f32x4 o[4];
        ln_finish<1>(cur, hout, hb, F.in[12] + l * D, F.in[13] + l * D, row, F.lane, o);
        float x[16];
#pragma unroll
        for (int j = 0; j < 4; ++j) { x[4 * j] = o[j].x; x[4 * j + 1] = o[j].y; x[4 * j + 2] = o[j].z; x[4 * j + 3] = o[j].w; }
        router_row(x, (int)row, F.lane, lrg, F.in[15] + l * 4, lre, F.in[17] + l * 32, lcnt, c * F.G + F.vcu, rec);
        if (more) cur = nxt;
    }
    __syncthreads();
    if (F.tid < 32) *(GAS int*)(wgc + F.tid) = lcnt[F.tid];
}
__device__ __forceinline__ void ph_dsp(Frame& F, int l) { LAUNDER(F); asm volatile("" : "+s"(l));
    LAS int* Tb = (LAS int*)(F.lds + RING_OFF); LAS int* part = Tb + 512 * 32; LAS int* po = part + 32 * 16;
    const int* wg = (const int*)(F.ws + WS_WGCNT) + (size_t)l * NCHUNK * F.G * 32; const int W = NCHUNK * F.G;
    int* cnt = (int*)(F.ws + WS_CTL) + CW_CNT + l * (32 * CSTR); const Rec* rec = (const Rec*)(F.ws + WS_REC); int* rowtok = (int*)(F.ws + WS_ROWTOK); float* rowgate = (float*)(F.ws + WS_ROWGATE);
    for (int i = F.tid; i < W * 32; i += NTHREADS) Tb[i] = *(const GAS int*)(wg + i);
    __syncthreads();
    const int e = F.tid >> 4, k = F.tid & 15, per = (W + 15) / 16, w0 = k * per, w1 = (w0 + per) < W ? (w0 + per) : W;
    { int s = 0; for (int w = w0; w < w1; ++w) s += Tb[w * 32 + e]; part[e * 16 + k] = s; }
    __syncthreads();
    { int base = 0; for (int kk = 0; kk < k; ++kk) base += part[e * 16 + kk];
      for (int w = w0; w < w1; ++w) { const int t = Tb[w * 32 + e]; Tb[w * 32 + e] = base; base += t; } }
    __syncthreads();
    if (F.tid == 0) { int acc = 0; for (int ee = 0; ee < NE; ++ee) { int tot = 0; for (int kk = 0; kk < 16; ++kk) tot += part[ee * 16 + kk]; po[ee] = acc; part[ee * 16] = tot; acc += (tot + 255) / 256 * 256; } po[NE] = acc; }
    __syncthreads();
    if (F.vcu == 0 && F.tid < 32) cnt[F.tid * CSTR] = part[F.tid * 16];
    const int gt = F.vcu * NTHREADS + F.tid, GT = F.G * NTHREADS;
    for (int t = gt; t < T; t += GT) {
        const GAS v4u* rp = (const GAS v4u*)(rec + t); const v4u ra = rp[0], rb = rp[1];
        Rec rc; rc.e0 = (int)ra.x; rc.s0 = (int)ra.y; rc.e1 = (int)ra.z; rc.s1 = (int)ra.w; rc.g0 = __uint_as_float(rb.x); rc.g1 = __uint_as_float(rb.y); rc.pad0 = (int)rb.z; rc.pad1 = 0;
        const int d0 = po[rc.e0] + Tb[rc.pad0 * 32 + rc.e0] + rc.s0, d1 = po[rc.e1] + Tb[rc.pad0 * 32 + rc.e1] + rc.s1;
        *(GAS int*)(rowtok + d0) = 2 * t; *(GAS float*)(rowgate + d0) = rc.g0; *(GAS int*)(rowtok + d1) = 2 * t + 1; *(GAS float*)(rowgate + d1) = rc.g1;
    }
    for (int ee = 0; ee < NE; ++ee) for (int r = po[ee] + part[ee * 16] + gt; r < po[ee + 1]; r += GT) { *(GAS int*)(rowtok + r) = -1; *(GAS float*)(rowgate + r) = 0.f; }
    __syncthreads();
}
__device__ __forceinline__ int moe_setup(Frame& F, int l, bool gather) { LAUNDER(F); asm volatile("" : "+s"(l));
    LAS int* rows = (LAS int*)(F.lds + ROWS_OFF); LAS int* ulist = rows + 11 * 256; LAS int* po = ulist + 16;
    const int* cnt = (const int*)(F.ws + WS_CTL) + CW_CNT + l * (32 * CSTR); const int* rowtok = (const int*)(F.ws + WS_ROWTOK);
    if (F.tid == 0) { int acc = 0; for (int e = 0; e < NE; ++e) { po[e] = acc; acc += (cnt[e * CSTR] + 255) / 256 * 256; } po[NE] = acc; }
    __syncthreads();
    const int nu_all = (po[NE] / 256) * 4; int nun = (nu_all - F.vcu + F.G - 1) / F.G; nun = nun < 0 ? 0 : (nun > 11 ? 11 : nun);
    if (F.tid < nun) { const int Lx = F.tid * F.G + F.vcu, rt = Lx >> 2, pn = Lx & 3; int e = 0; while (e < NE - 1 && po[e + 1] <= rt * 256) ++e; ulist[F.tid] = (rt << 8) | (e << 2) | pn; }
    if (gather) for (int idx = F.tid; idx < nun * 256; idx += NTHREADS) { const int i = idx >> 8, r = idx & 255, Lx = i * F.G + F.vcu; rows[idx] = *(const GAS int*)(rowtok + (Lx >> 2) * 256 + r); }
    __syncthreads();
    return nun;
}
struct MoeOrder {
    int nun; const LAS int* ulist; const LAS int* rows; const char* A; const char* B; size_t tstepA, estepB, tstepB;
    __device__ __forceinline__ bool next(int i, pg8::Unit& u) const {
        if (i >= nun) return false;
        const int w = __builtin_amdgcn_readfirstlane(ulist[i]); u.pm = w >> 8; u.e = (w >> 2) & 63; u.pn = w & 3; u.ui = i; return true;
    }
    __device__ __forceinline__ const char* a_base(const pg8::Unit& u) const { return A + (size_t)u.pm * tstepA; }
    __device__ __forceinline__ const char* b_base(const pg8::Unit& u) const { return B + (size_t)u.e * estepB + (size_t)u.pn * tstepB; }
    __device__ __forceinline__ int a_row(const pg8::Unit& u, int r) const { const int t = rows[u.ui * 256 + r]; return t < 0 ? 0 : (t >> 1); }
};
__device__ __forceinline__ void ph_p7(Frame& F, int l) { LAUNDER(F); asm volatile("" : "+s"(l));
    const int nun = moe_setup(F, l, true);
    LAS int* rows = (LAS int*)(F.lds + ROWS_OFF);
    MoeOrder S{nun, rows + 11 * 256, rows, (const char*)(F.ws + WS_HB), (const char*)(F.ws + WS_WGU) + (size_t)l * NE * 1024 * 1024 * 2, 0, (size_t)1024 * 1024 * 2, (size_t)256 * 1024 * 2};
    EpiP7 E{(bf16*)(F.ws + WS_HID)};
    pg8::gemm_phase<EpiP7, MoeOrder, true>(F.lds + RING_OFF, S, E, D, D, D, F.tid);
}
__device__ __forceinline__ void ph_p8(Frame& F, int l) { LAUNDER(F); asm volatile("" : "+s"(l));
    const int nun = moe_setup(F, l, false);
    LAS int* rows = (LAS int*)(F.lds + ROWS_OFF);
    MoeOrder S{nun, rows + 11 * 256, rows, (const char*)(F.ws + WS_HID), (const char*)(F.ws + WS_WD) + (size_t)l * NE * 1024 * 512 * 2, (size_t)256 * DE * 2, (size_t)1024 * 512 * 2, (size_t)256 * 512 * 2};
    EpiP8 E{(bf16*)(F.ws + WS_YB), (const int*)(F.ws + WS_ROWTOK), (const float*)(F.ws + WS_ROWGATE)};
    pg8::gemm_phase<EpiP8, MoeOrder, false>(F.lds + RING_OFF, S, E, DE, DE, DE, F.tid);
}
__device__ __forceinline__ void ph_ln2(Frame& F, int l) { LAUNDER(F); asm volatile("" : "+s"(l));
    const int gw = F.vcu * NWAVES + F.wave, NGW = F.G * NWAVES;
    bf16* hb = (l == DEPTH - 1) ? nullptr : (bf16*)(F.ws + WS_HB); const bf16* yb = (const bf16*)(F.ws + WS_YB);
    float* hout = F.h; size_t omask = ~(size_t)0;
    if (F.probe) { hout = (float*)(F.ws + WS_OABC); hb = nullptr; omask = 32767; }
    LnIn cur, nxt; if (gw < T) ln_load<2>(cur, F.h, yb, (size_t)gw, F.lane);
    for (int m = gw; m < T; m += NGW) { const bool more = m + NGW < T; if (more) ln_load<2>(nxt, F.h, yb, (size_t)(m + NGW), F.lane);
        f32x4 o[4]; ln_finish<2>(cur, hout - ((size_t)m - ((size_t)m & omask)) * D, hb, F.in[21] + l * D, F.in[22] + l * D, (size_t)m, F.lane, o); if (more) cur = nxt; }
}

typedef short s16x4 __attribute__((ext_vector_type(4)));
constexpr int NT_A = (CH / 32) * 4, NT_B = (CH / L) * 3 * 128 * 4, NT_C = (CH / 64) * 8, NT_ALL = NT_A + NT_B + NT_C;
constexpr float NEGBIG = -1.0e30f, MINIT = -5.0e29f;
#define RC16(reg) (((reg) & 3) + 8 * ((reg) >> 2))

__device__ __forceinline__ void ph_tables(Frame& F) { LAUNDER(F);
    float* TA = (float*)(F.ws + WS_TABA); float* TB = (float*)(F.ws + WS_TABB); float* TC = (float*)(F.ws + WS_TABC);
    const float* rel_bias = F.in[3]; const float* rpb = F.in[7];
    const int gt = F.vcu * NTHREADS + F.tid, GT = F.G * NTHREADS;
    for (int i = gt; i < 8 * 320; i += GT) { const int h = i / 320, rel = i % 320 - 160; TA[i] = (rel >= -128 && rel <= 128) ? rel_bias[BUCK_A[rel + 128] * 20 + h] * LOG2E : NEGBIG; }
    for (int i = gt; i < 12 * 256; i += GT) { const int gh = i >> 8, g = gh >> 2, rel = (i & 255) - 128; TB[i] = (rel >= -64 && rel <= 64) ? rel_bias[BUCK_B[g][rel + 64] * 20 + 8 + gh] * LOG2E : NEGBIG; }
    for (int i = gt; i < DEPTH * 8 * 1024; i += GT) { const int lh = i >> 10, ri = (i >> 6) & 15, ci = (i & 63) - 16; TC[i] = (ri < 15 && ci >= 0 && ci <= 30) ? rpb[((size_t)lh * 15 + ri) * 31 + ci] * LOG2E : NEGBIG; }
}

#define ATT_SOFTMAX(S, m, l, Oa, Ob, TBP, BIDX, XM) do { \
        float tmax_ = NEGBIG; \
        _Pragma("unroll") for (int r_ = 0; r_ < 16; ++r_) { float v_ = S[r_] + (TBP)[(BIDX) + RC16(r_)]; if (TYPE == 2) v_ = ((unsigned)((XM) + RC16(r_)) < 16u) ? v_ : NEGBIG; S[r_] = v_; tmax_ = fmaxf(tmax_, v_); } \
        tmax_ = fmaxf(tmax_, shfl_xor_l(tmax_, 32, lane)); \
        const float mn_ = fmaxf(m, tmax_), corr_ = __builtin_amdgcn_exp2f(m - mn_); \
        float rsum_ = 0.f; \
        _Pragma("unroll") for (int r_ = 0; r_ < 16; ++r_) { const float p_ = __builtin_amdgcn_exp2f(S[r_] - mn_); S[r_] = p_; rsum_ += p_; } \
        rsum_ += shfl_xor_l(rsum_, 32, lane); \
        l = l * corr_ + rsum_; m = mn_; \
        _Pragma("unroll") for (int i_ = 0; i_ < 16; ++i_) { Oa[i_] *= corr_; Ob[i_] *= corr_; } \
    } while (0)
#define ATT_PACK(Pf, S, s2) do { unsigned pw_[4]; _Pragma("unroll") for (int j_ = 0; j_ < 4; ++j_) pw_[j_] = pg8::cvt_pk_bf16(S[8 * (s2) + 2 * j_], S[8 * (s2) + 2 * j_ + 1]); \
        Pf = __builtin_bit_cast(bf16x8, (v4u){pw_[0], pw_[1], pw_[2], pw_[3]}); } while (0)
#define ATT_STORE(orow, Oa, Ob, l) do { const float inv_ = 1.0f / (l); \
        _Pragma("unroll") for (int g_ = 0; g_ < 4; ++g_) { v2u w0_, w1_; \
            w0_.x = pg8::cvt_pk_bf16(Oa[4 * g_] * inv_, Oa[4 * g_ + 1] * inv_); w0_.y = pg8::cvt_pk_bf16(Oa[4 * g_ + 2] * inv_, Oa[4 * g_ + 3] * inv_); \
            w1_.x = pg8::cvt_pk_bf16(Ob[4 * g_] * inv_, Ob[4 * g_ + 1] * inv_); w1_.y = pg8::cvt_pk_bf16(Ob[4 * g_ + 2] * inv_, Ob[4 * g_ + 3] * inv_); \
            *(GAS v2u*)((orow) + 8 * g_ + 4 * hh) = w0_; *(GAS v2u*)((orow) + 32 + 8 * g_ + 4 * hh) = w1_; } } while (0)

template <int TYPE>
__device__ __forceinline__ void att_task2(LAS unsigned char* wl, const int lane, const bf16* seq  , const float* tab0, const float* tab1,
                                          const int qcol0, const int qcol1, const int kcol, const int vcol, const int TT0, const int TSTEP, const int kstride, const int tlo, const int thi,
                                          const int tq0, const int tq1  , const int toff1  ,
                                          const int gi0, const int gi1, const int gc, const int cbs  ,
                                          const float m_init0, const float m_init1, const float l_init, bf16* orow0, bf16* orow1, float* lse0, float* lse1) {
    const int qi = lane & 31, hh = lane >> 5;
    LAS unsigned char* kt = wl; LAS unsigned char* vt = wl + 4096; LAS float* tb0 = (LAS float*)(wl + 8192); LAS float* tb1 = (TYPE == 0) ? tb0 + 320 : tb0;
    constexpr int TBN = TYPE == 0 ? 320 : (TYPE == 1 ? 256 : 1024);
#pragma unroll
    for (int i = 0; i < TBN / 64; ++i) { tb0[lane + 64 * i] = *(const GAS float*)(tab0 + lane + 64 * i); if (TYPE == 0) tb1[lane + 64 * i] = *(const GAS float*)(tab1 + lane + 64 * i); }
    bf16x8 Qa[4], Qb[4];
#pragma unroll
    for (int s = 0; s < 4; ++s) { Qa[s] = *(const GAS bf16x8*)(seq + (size_t)tq0 * QKVW + qcol0 + 16 * s + 8 * hh); Qb[s] = *(const GAS bf16x8*)(seq + (size_t)tq1 * QKVW + qcol1 + 16 * s + 8 * hh); }
    f32x16 O0a, O0b, O1a, O1b;
#pragma unroll
    for (int i = 0; i < 16; ++i) { O0a[i] = 0.f; O0b[i] = 0.f; O1a[i] = 0.f; O1b[i] = 0.f; }
    float m0 = m_init0, m1 = m_init1, l0 = l_init, l1 = l_init;
    const int lkey = lane >> 3, lch = lane & 7;
    const unsigned goff = (unsigned)(lkey * kstride) * (unsigned)(QKVW * 2) + 16u * (unsigned)lch;
    const size_t istepb = (size_t)8 * kstride * QKVW * 2;
    const char* kbase = (const char*)(seq + kcol); const char* vbase = (const char*)(seq + vcol);
    const unsigned kw0 = lkey * 128 + ((lch ^ (lkey & 7)) << 4), vw0 = lkey * 128 + (((lch >> 2) ^ ((lkey >> 1) & 1)) << 6) + ((lch & 3) << 4);
    const unsigned kr0 = qi * 128 + ((hh ^ (qi & 7)) << 4);
    const int q4 = (lane & 15) >> 2, p4 = lane & 3, g1 = (lane >> 4) & 1, sw = (q4 >> 1) & 1;
    const unsigned vr0 = (4 * hh + q4) * 128 + 32 * g1 + 8 * p4 + (sw << 6), vr1 = (4 * hh + q4) * 128 + 32 * g1 + 8 * p4 + ((sw ^ 1) << 6);
    const int bidx0 = (TYPE == 2) ? (cbs - gc + 31 + 4 * hh) : ((TYPE == 1 ? 64 : 32) - qi + 4 * hh);
    int cs = gc - 8; cs = cs < 0 ? 0 : (cs > 48 ? 48 : cs);
    const int xm = cbs - cs + 4 * hh;
    int rs0 = gi0 - 4; rs0 = rs0 < 0 ? 0 : (rs0 > 120 ? 120 : rs0);
    int rs1 = gi1 - 4; rs1 = rs1 < 0 ? 0 : (rs1 > 120 ? 120 : rs1);
    v4u kreg[4], vreg[4];
    {
        const size_t tb_ = (size_t)(TT0 + tlo * TSTEP) * (QKVW * 2);
#pragma unroll
        for (int i = 0; i < 4; ++i) { kreg[i] = *(const GAS v4u*)(kbase + tb_ + i * istepb + goff); vreg[i] = *(const GAS v4u*)(vbase + tb_ + i * istepb + goff); }
    }
    for (int ti = tlo; ti <= thi; ++ti) {
#pragma unroll
        for (int i = 0; i < 4; ++i) { *(LAS v4u*)(kt + kw0 + 1024 * i) = kreg[i]; *(LAS v4u*)(vt + vw0 + 1024 * i) = vreg[i]; }
        if (ti < thi) {
            const size_t tb_ = (size_t)(TT0 + (ti + 1) * TSTEP) * (QKVW * 2);
#pragma unroll
            for (int i = 0; i < 4; ++i) { kreg[i] = *(const GAS v4u*)(kbase + tb_ + i * istepb + goff); vreg[i] = *(const GAS v4u*)(vbase + tb_ + i * istepb + goff); }
        }
        f32x16 S0, S1;
#pragma unroll
        for (int i = 0; i < 16; ++i) { S0[i] = 0.f; S1[i] = 0.f; }
#pragma unroll
        for (int s = 0; s < 4; ++s) { const bf16x8 Kf = *(const LAS bf16x8*)(kt + (kr0 ^ (unsigned)(s << 5)));
            S0 = __builtin_amdgcn_mfma_f32_32x32x16_bf16(Kf, Qa[s], S0, 0, 0, 0); S1 = __builtin_amdgcn_mfma_f32_32x32x16_bf16(Kf, Qb[s], S1, 0, 0, 0); }
        int bi0, bi1;
        if (TYPE == 2) { const bool rv0 = (ti >= rs0) && (ti < rs0 + 8), rv1 = (ti >= rs1) && (ti < rs1 + 8); bi0 = bidx0 + (rv0 ? (ti - gi0 + 7) : 15) * 64; bi1 = bidx0 + (rv1 ? (ti - gi1 + 7) : 15) * 64; }
        else { bi0 = bidx0 + 32 * ti; bi1 = bidx0 + 32 * (ti - toff1); }
        ATT_SOFTMAX(S0, m0, l0, O0a, O0b, tb0, bi0, xm);
        ATT_SOFTMAX(S1, m1, l1, O1a, O1b, tb1, bi1, xm);
#pragma unroll
        for (int s2 = 0; s2 < 2; ++s2) {
            bf16x8 P0, P1; ATT_PACK(P0, S0, s2); ATT_PACK(P1, S1, s2);
            const s16x4 a00 = __builtin_amdgcn_ds_read_tr16_b64_v4i16((LAS s16x4*)(vt + vr0 + (16 * s2) * 128));
            const s16x4 a01 = __builtin_amdgcn_ds_read_tr16_b64_v4i16((LAS s16x4*)(vt + vr0 + (16 * s2 + 8) * 128));
            const s16x4 a10 = __builtin_amdgcn_ds_read_tr16_b64_v4i16((LAS s16x4*)(vt + vr1 + (16 * s2) * 128));
            const s16x4 a11 = __builtin_amdgcn_ds_read_tr16_b64_v4i16((LAS s16x4*)(vt + vr1 + (16 * s2 + 8) * 128));
            const bf16x8 V0 = (bf16x8){a00[0], a00[1], a00[2], a00[3], a01[0], a01[1], a01[2], a01[3]};
            const bf16x8 V1 = (bf16x8){a10[0], a10[1], a10[2], a10[3], a11[0], a11[1], a11[2], a11[3]};
            O0a = __builtin_amdgcn_mfma_f32_32x32x16_bf16(V0, P0, O0a, 0, 0, 0); O0b = __builtin_amdgcn_mfma_f32_32x32x16_bf16(V1, P0, O0b, 0, 0, 0);
            O1a = __builtin_amdgcn_mfma_f32_32x32x16_bf16(V0, P1, O1a, 0, 0, 0); O1b = __builtin_amdgcn_mfma_f32_32x32x16_bf16(V1, P1, O1b, 0, 0, 0);
        }
    }
    ATT_STORE(orow0, O0a, O0b, l0);
    ATT_STORE(orow1, O1a, O1b, l1);
    if (TYPE == 1 && hh == 0) { *(GAS float*)lse0 = (m0 + __builtin_amdgcn_logf(l0)) * LN2; *(GAS float*)lse1 = (m1 + __builtin_amdgcn_logf(l1)) * LN2; }
}

__device__ __forceinline__ void ph_att(Frame& F, int l) { LAUNDER(F); asm volatile("" : "+s"(l));
    LAS unsigned char* wl = F.lds + RING_OFF + F.wave * 16384;
    const bf16* qkv = (const bf16*)(F.ws + WS_QKV); bf16* oabc = (bf16*)(F.ws + WS_OABC); bf16* og = (bf16*)(F.ws + WS_OG); float* lse = (float*)(F.ws + WS_LSE);
    const float* TA = (const float*)(F.ws + WS_TABA); const float* TB = (const float*)(F.ws + WS_TABB); const float* TC = (const float*)(F.ws + WS_TABC) + (size_t)l * 8 * 1024;
    const float* sink = F.in[6] + l * 8;
    const int gw = F.vcu * NWAVES + F.wave, NGW = F.G * NWAVES;
    for (int task = gw; task < NT_ALL; task += NGW) {
        int lane = F.lane; asm volatile("" : "+v"(lane)); const int qi = lane & 31;
        if (task < NT_A) {
            const int hp = task & 3, qb = (task >> 2) & 255, b = task >> 10, q0 = qb * 32, h0 = hp * 2, h1 = h0 + 1, kvh = hp >> 1;
            int tlo = 0, thi = 8; if (q0 - 128 < 0) tlo = (128 - q0) / 32; if (q0 + 128 + 31 >= L) thi = (L - 1 - (q0 - 128)) / 32;
            const int tq = q0 + qi; bf16* orow = oabc + (size_t)(b * L + tq) * OW;
            att_task2<0>(wl, lane, qkv + (size_t)b * L * QKVW, TA + h0 * 320, TA + h1 * 320, AQ + h0 * 64, AQ + h1 * 64, AK + kvh * 64, AV + kvh * 64, q0 - 128, 32, 1, tlo, thi,
                         tq, tq, 0, 0, 0, 0, 0, sink[h0] * LOG2E, sink[h1] * LOG2E, 1.0f, orow + h0 * 64, orow + h1 * 64, nullptr, nullptr);
        } else if (task < NT_A + NT_B) {
            const int j = task - NT_A, h = j & 3, sbi = (j >> 2) & 127, bg = j >> 9, g = bg % 3, b = bg / 3;
            const int dsh = 2 * g, d = 1 << dsh, nsb = 128 >> dsh, r = sbi / nsb, sb = sbi % nsb, q0 = sb * 64, Ls = L >> dsh;
            int tlo = 0, thi = 5; if (q0 - 64 < 0) tlo = (64 - q0) / 32; if (q0 + 32 + 64 + 31 >= Ls) thi = (Ls - 1 - (q0 - 64)) / 32;
            const int tq0 = (q0 + qi) * d + r, tq1 = (q0 + 32 + qi) * d + r, qc = BQ0 + 768 * g + h * 64;
            att_task2<1>(wl, lane, qkv + (size_t)b * L * QKVW, TB + (g * 4 + h) * 256, nullptr, qc, qc, qc + 256, qc + 512, (q0 - 64) * d + r, 32 * d, d, tlo, thi,
                         tq0, tq1, 1, 0, 0, 0, 0, MINIT, MINIT, 0.0f, og + ((size_t)(b * L + tq0) * 3 + g) * 256 + h * 64, og + ((size_t)(b * L + tq1) * 3 + g) * 256 + h * 64,
                         lse + ((size_t)(b * L + tq0) * 3 + g) * 4 + h, lse + ((size_t)(b * L + tq1) * 3 + g) * 4 + h);
        } else {
            const int j = task - NT_A - NT_B, h = j & 7, cbi = (j >> 3) & 127, b = j >> 10, ip = cbi >> 2, cb = cbi & 3;
            const int gi0 = 4 * ip + (qi >> 4), gi1 = gi0 + 2, gc = 16 * cb + (qi & 15), tq0 = gi0 * 64 + gc, tq1 = gi1 * 64 + gc;
            int cbs = 16 * cb - 8; cbs = cbs < 0 ? 0 : (cbs > 32 ? 32 : cbs);
            int rlo = 4 * ip - 4; rlo = rlo < 0 ? 0 : (rlo > 120 ? 120 : rlo);
            int rhi = 4 * ip + 3 - 4; rhi = rhi < 0 ? 0 : (rhi > 120 ? 120 : rhi); rhi += 7;
            bf16* ob = oabc + (size_t)(b * L) * OW + 768 + h * 64;
            att_task2<2>(wl, lane, qkv + (size_t)b * L * QKVW, TC + h * 1024, nullptr, CQ + h * 64, CQ + h * 64, CK + h * 64, CV + h * 64, cbs, 64, 1, rlo, rhi,
                         tq0, tq1, 0, gi0, gi1, gc, cbs, MINIT, MINIT, 0.0f, ob + (size_t)tq0 * OW, ob + (size_t)tq1 * OW, nullptr, nullptr);
        }
    }
}

constexpr int NSTEPS = 1 + DEPTH * 16;
__global__ void __launch_bounds__(NTHREADS, 2) mk_fwd(Args args) {
    extern __shared__ __attribute__((aligned(16))) unsigned char lds[];
    Frame F;
    F.lds = (LAS unsigned char*)lds; F.wave = __builtin_amdgcn_readfirstlane((int)threadIdx.x >> 6); F.lane = hw_lane(); F.tid = F.wave * 64 + F.lane;
    F.G = gridDim.x; { const int bx = blockIdx.x; F.vcu = (F.G % 8 == 0) ? (bx % 8) * (F.G / 8) + bx / 8 : bx; }
    F.in = args.in; F.h = args.out; F.ws = args.ws; F.probe = args.probe;
    volatile LAS unsigned* MISC = (volatile LAS unsigned*)(F.lds + MISC_OFF);
    if (F.tid < 32) MISC[F.tid] = 0u;
    __syncthreads();
    const int lo = args.s_lo, hi = args.s_hi;
    XcdBarrier bar; bar.wave0 = (F.wave == 0); bar.bar = (unsigned*)(F.ws + WS_CTL) + CW_BAR; bar.x = 0; bar.st = nullptr;
    if (hi - lo > 1) bar = xcd_barrier_post((unsigned*)(F.ws + WS_CTL) + CW_BAR, MISC + 8, F.wave == 0);
#define RUN(s) (lo <= (s) && (s) < hi)
#define SEAM(s) do { if (RUN(s) && RUN((s) + 1)) xcd_barrier(bar); } while (0)
    if (RUN(0)) { ph_prologue(F); ph_tables(F); ph_ln0(F); }
    SEAM(0);
    for (int l = 0; l < DEPTH; ++l) {
        const int sb = 1 + l * 16;
        for (int c = 0; c < NCHUNK; ++c) {
            const int s = sb + c * 6;
            if (RUN(s)) ph_p1(F, l, c);
            SEAM(s);
            if (RUN(s + 1)) ph_att(F, l);
            SEAM(s + 1);
            if (RUN(s + 2)) ph_cmb(F);
            SEAM(s + 2);
            if (RUN(s + 3)) ph_p3(F, l);
            SEAM(s + 3);
            if (RUN(s + 4)) ph_p4(F, l, c);
            SEAM(s + 4);
            if (RUN(s + 5)) ph_ln1(F, l, c);
            SEAM(s + 5);
        }
        if (RUN(sb + 12)) ph_dsp(F, l);
        SEAM(sb + 12);
        if (RUN(sb + 13)) ph_p7(F, l);
        SEAM(sb + 13);
        if (RUN(sb + 14)) ph_p8(F, l);
        SEAM(sb + 14);
        if (RUN(sb + 15)) ph_ln2(F, l);
        SEAM(sb + 15);
    }
#undef RUN
#undef SEAM
}

#ifndef DUP_NOEPI
#define DUP_NOEPI 0
#endif
#ifndef FAST_MASK
#define FAST_MASK 0x7FF
#endif
#ifndef ONE_LAUNCH
#define ONE_LAUNCH 1
#endif
extern "C" void kernel_launch(void* const* d_in, const int* in_sizes, int n_in, void* d_out, int out_size, void* d_ws, size_t ws_size, hipStream_t stream) {
    static int grid = 0;
    if (grid == 0) {
        if (n_in != 23 || out_size != T * D || ws_size < WS_END) { fprintf(stderr, "kernel_launch: unexpected shapes (n_in %d out %d ws %zu)\n", n_in, out_size, ws_size); grid = -1; return; }
        int dev = 0, cus = 0, per_cu = 0;
        if (hipGetDevice(&dev) != hipSuccess || hipDeviceGetAttribute(&cus, hipDeviceAttributeMultiprocessorCount, dev) != hipSuccess) { grid = -1; return; }
        if (hipFuncSetAttribute((const void*)mk_fwd, hipFuncAttributeMaxDynamicSharedMemorySize, LDS_BYTES) != hipSuccess) { fprintf(stderr, "kernel_launch: hipFuncSetAttribute failed\n"); grid = -1; return; }
        if (hipOccupancyMaxActiveBlocksPerMultiprocessor(&per_cu, (const void*)mk_fwd, NTHREADS, LDS_BYTES) != hipSuccess || per_cu < 1) fprintf(stderr, "kernel_launch: occupancy query reports %d\n", per_cu);
        (void)hipGetLastError();
        grid = cus;
    }
    if (grid < 0) return;
    const float* x = (const float*)d_in[0]; const float* ln0_g = (const float*)d_in[1]; const float* ln0_b = (const float*)d_in[2]; const float* rel_bias = (const float*)d_in[3];
    const float* w_in = (const float*)d_in[4]; const float* b_gate = (const float*)d_in[5]; const float* sink_a = (const float*)d_in[6]; const float* rpb_c = (const float*)d_in[7];
    const float* w_br_a = (const float*)d_in[8]; const float* w_br_b = (const float*)d_in[9]; const float* w_br_c = (const float*)d_in[10]; const float* w_out = (const float*)d_in[11];
    const float* ln1_g = (const float*)d_in[12]; const float* ln1_b = (const float*)d_in[13]; const float* w_rg = (const float*)d_in[14]; const float* b_rg = (const float*)d_in[15];
    const float* w_re = (const float*)d_in[16]; const float* b_re = (const float*)d_in[17]; const float* w_eg = (const float*)d_in[18]; const float* w_eu = (const float*)d_in[19];
    const float* w_ed = (const float*)d_in[20]; const float* ln2_g = (const float*)d_in[21]; const float* ln2_b = (const float*)d_in[22];
    unsigned char* ws = (unsigned char*)d_ws; float* h = (float*)d_out;
    bf16* hb = (bf16*)(ws + WS_HB); bf16* qkv = (bf16*)(ws + WS_QKV); bf16* gates = (bf16*)(ws + WS_GATES); bf16* oabc = (bf16*)(ws + WS_OABC); bf16* og = (bf16*)(ws + WS_OG);
    float* lse = (float*)(ws + WS_LSE); Rec* rec = (Rec*)(ws + WS_REC); int* rowtok = (int*)(ws + WS_ROWTOK); float* rowgate = (float*)(ws + WS_ROWGATE);
    bf16* merged = (bf16*)(ws + WS_MERGED); bf16* hid = (bf16*)(ws + WS_HID); bf16* yb = (bf16*)(ws + WS_YB); int* cnt = (int*)(ws + WS_CTL) + CW_CNT;
    (void)hipMemsetAsync(ws + WS_CTL, 0, CTL_ZERO_BYTES, stream);
    Args a{};
    for (int i = 0; i < 23; ++i) a.in[i] = (const float*)d_in[i];
    a.out = h; a.ws = ws;
    if (ONE_LAUNCH) { a.s_lo = 0; a.s_hi = NSTEPS; hipLaunchKernelGGL(mk_fwd, dim3(grid), dim3(NTHREADS), LDS_BYTES, stream, a); return; }
    const int G = 2048;
    const bool fastp1 = (FAST_MASK >> 1) & 1;
    for (int s = 0; s < NSTEPS; ++s) {
        int kind, l = 0, c = 0;
        if (s == 0) kind = 0; else { const int r = (s - 1) % 16; l = (s - 1) / 16; if (r < 12) { c = r / 6; kind = 1 + r % 6; } else kind = 7 + (r - 12); }
        if ((FAST_MASK >> kind) & 1) { a.s_lo = s; a.s_hi = s + 1;
#ifdef DUP_KIND
            if (kind == DUP_KIND && (kind == 5 || kind == 6 || kind == 10 || (kind == 1 && DUP_NOEPI))) { a.probe = 1; hipLaunchKernelGGL(mk_fwd, dim3(grid), dim3(NTHREADS), LDS_BYTES, stream, a); a.probe = 0; }
#endif
            hipLaunchKernelGGL(mk_fwd, dim3(grid), dim3(NTHREADS), LDS_BYTES, stream, a);
#ifdef DUP_KIND
            if (kind == DUP_KIND && !(kind == 5 || kind == 6 || kind == 10 || (kind == 1 && DUP_NOEPI))) { hipLaunchKernelGGL(mk_fwd, dim3(grid), dim3(NTHREADS), LDS_BYTES, stream, a); }
#endif
            continue; }
        const size_t r0 = (size_t)c * CH;
        switch (kind) {
        case 0: k_ln<<<G, 256, 0, stream>>>(0, x, h, hb, nullptr, ln0_g, ln0_b, 0, T); break;
        case 1: k_p1<<<G, 256, 0, stream>>>(hb + r0 * D, w_in + (size_t)l * D * NCOL, b_gate + (size_t)l * GATEW, qkv, gates); break;
        case 2: k_attn_naive<<<(28 * CH + 255) / 256, 256, 0, stream>>>(qkv, oabc, og, lse, rel_bias, sink_a + l * 8, rpb_c + (size_t)l * 8 * 15 * 31, fastp1 ? LN2 : 0.125f); break;
        case 3: k_combine<<<(CH * 32 + 255) / 256, 256, 0, stream>>>(og, lse, oabc); break;
        case 4: k_p3<<<G, 256, 0, stream>>>(oabc, gates, w_br_a + (size_t)l * 512 * D, w_br_b + (size_t)l * 256 * D, w_br_c + (size_t)l * 512 * D, merged); break;
        case 5: k_p4<<<G, 256, 0, stream>>>(merged, w_out + (size_t)l * D * D, h + r0 * D); break;
        case 6: k_ln<<<G, 256, 0, stream>>>(1, nullptr, h, hb, nullptr, ln1_g + l * D, ln1_b + l * D, (int)r0, CH);
                if (c == NCHUNK - 1) k_router<<<G, 256, 0, stream>>>(h, w_rg + (size_t)l * D * 4, b_rg + l * 4, w_re + (size_t)l * 4 * D * 8, b_re + l * 32, cnt + l * (32 * CSTR), rec);
                break;
        case 7: (void)hipMemsetAsync(rowtok, 0xFF, (size_t)PROWS * 4, stream); k_dispatch<<<256, 256, 0, stream>>>(cnt + l * (32 * CSTR), rec, rowtok, rowgate); break;
        case 8: k_p7<<<G, 256, 0, stream>>>(hb, cnt + l * (32 * CSTR), rowtok, w_eg + (size_t)l * NE * D * DE, w_eu + (size_t)l * NE * D * DE, hid); break;
        case 9: k_p8<<<G, 256, 0, stream>>>(hid, cnt + l * (32 * CSTR), rowtok, rowgate, w_ed + (size_t)l * NE * DE * D, yb); break;
        case 10: k_ln<<<G, 256, 0, stream>>>(2, nullptr, h, (l == DEPTH - 1) ? nullptr : hb, yb, ln2_g + l * D, ln2_b + l * D, 0, T); break;
        }
    }
}
```

```cpp
#include <hip/hip_runtime.h>
#include <cstdio>
#include <cstdint>
#include <cmath>

typedef unsigned short bf16;
typedef short bf16x8 __attribute__((ext_vector_type(8)));
typedef float f32x16 __attribute__((ext_vector_type(16)));
typedef float f32x4 __attribute__((ext_vector_type(4)));

constexpr int D = 1024, L = 8192, NBATCH = 8, T = NBATCH * L, DEPTH = 2;
constexpr int NCOL = 7680, QKVW = 4608, GATEW = 3072;
constexpr int CH = 32768, NCHUNK = T / CH;
constexpr int OW = 1280;
constexpr int NE = 32, DE = 512;
constexpr int MAXRT = T * 2 / 256 + NE, PROWS = MAXRT * 256;
constexpr float LN_EPS = 1e-5f;
constexpr float ALPHA = 1.41421356237309515f;
constexpr int AQ = 0, AK = 512, AV = 640, BQ0 = 768, CQ = 3072, CK = 3584, CV = 4096;

constexpr size_t MiB = 1u << 20;
constexpr size_t WS_CTL = 0;
constexpr size_t WS_WIN = 1 * MiB, WS_WBRA = 31 * MiB, WS_WBRB = 33 * MiB, WS_WBRC = 34 * MiB, WS_WOUT = 36 * MiB, WS_WGU = 40 * MiB, WS_WD = 168 * MiB;
constexpr size_t WS_HB = 232 * MiB, WS_QKV = 360 * MiB, WS_GATES = 648 * MiB, WS_OABC = 840 * MiB, WS_OG = 920 * MiB, WS_LSE = 968 * MiB,
                 WS_REC = 970 * MiB, WS_ROWTOK = 972 * MiB, WS_ROWGATE = 973 * MiB, WS_TABA = 974 * MiB, WS_TABB = WS_TABA + 16384, WS_TABC = WS_TABA + 32768, WS_WGCNT = WS_TABA + 131072  , WS_END = 975 * MiB;
constexpr size_t WS_MERGED = WS_QKV, WS_HID = WS_QKV, WS_YB = WS_QKV + 136 * MiB;
constexpr int CSTR = 32;

__device__ __constant__ signed char BUCK_A[257] = {12,11,11,11,11,11,11,11,11,11,11,11,11,11,11,11,11,11,11,11,11,11,11,11,11,11,11,11,11,11,11,11,11,11,11,11,11,11,11,11,11,11,11,11,11,11,11,11,11,11,11,11,11,11,11,11,11,11,11,11,11,11,11,11,11,10,10,10,10,10,10,10,10,10,10,10,10,10,10,10,10,10,10,10,10,10,10,10,10,10,10,10,10,10,10,10,10,9,9,9,9,9,9,9,9,9,9,9,9,9,9,9,9,8,8,8,8,8,8,8,8,7,6,5,4,3,2,1,0,17,18,19,20,21,22,23,24,24,24,24,24,24,24,24,25,25,25,25,25,25,25,25,25,25,25,25,25,25,25,25,26,26,26,26,26,26,26,26,26,26,26,26,26,26,26,26,26,26,26,26,26,26,26,26,26,26,26,26,26,26,26,26,27,27,27,27,27,27,27,27,27,27,27,27,27,27,27,27,27,27,27,27,27,27,27,27,27,27,27,27,27,27,27,27,27,27,27,27,27,27,27,27,27,27,27,27,27,27,27,27,27,27,27,27,27,27,27,27,27,27,27,27,27,27,27,27,28};
__device__ __constant__ signed char BUCK_B[3][129] = {
 {11,10,10,10,10,10,10,10,10,10,10,10,10,10,10,10,10,10,10,10,10,10,10,10,10,10,10,10,10,10,10,10,10,9,9,9,9,9,9,9,9,9,9,9,9,9,9,9,9,8,8,8,8,8,8,8,8,7,6,5,4,3,2,1,0,17,18,19,20,21,22,23,24,24,24,24,24,24,24,24,25,25,25,25,25,25,25,25,25,25,25,25,25,25,25,25,26,26,26,26,26,26,26,26,26,26,26,26,26,26,26,26,26,26,26,26,26,26,26,26,26,26,26,26,26,26,26,26,27},
 {13,12,12,12,12,12,12,12,12,12,12,12,12,12,12,12,12,12,12,12,12,12,12,12,12,12,12,12,12,12,12,12,12,11,11,11,11,11,11,11,11,11,11,11,11,11,11,11,11,10,10,10,10,10,10,10,10,9,9,9,9,8,8,4,0,20,24,24,25,25,25,25,26,26,26,26,26,26,26,26,27,27,27,27,27,27,27,27,27,27,27,27,27,27,27,27,28,28,28,28,28,28,28,28,28,28,28,28,28,28,28,28,28,28,28,28,28,28,28,28,28,28,28,28,28,28,28,28,29},
 {15,14,14,14,14,14,14,14,14,14,14,14,14,14,14,14,14,14,14,14,14,14,14,14,14,14,14,14,14,14,14,14,14,13,13,13,13,13,13,13,13,13,13,13,13,13,13,13,13,12,12,12,12,12,12,12,12,11,11,11,11,10,10,9,0,25,26,26,27,27,27,27,28,28,28,28,28,28,28,28,29,29,29,29,29,29,29,29,29,29,29,29,29,29,29,29,30,30,30,30,30,30,30,30,30,30,30,30,30,30,30,30,30,30,30,30,30,30,30,30,30,30,30,30,30,30,30,30,31}};

__device__ __forceinline__ float bf2f(bf16 b) { return __uint_as_float(((unsigned)b) << 16); }
__device__ __forceinline__ bf16 f2bf(float f) { unsigned u = __float_as_uint(f); u += 0x7fffu + ((u >> 16) & 1u); return (bf16)(u >> 16); }
__device__ __forceinline__ float wave_sum(float v) {
#pragma unroll
    for (int o = 1; o < 64; o <<= 1) v += __shfl_xor(v, o);
    return v;
}

__global__ __launch_bounds__(256) void k_ln(int mode, const float* src, float* h, bf16* hb, const bf16* yb, const float* g, const float* bta, int row0, int nrows) {
    const int lane = threadIdx.x & 63, wv = blockIdx.x * 4 + (threadIdx.x >> 6), nw = gridDim.x * 4;
    for (int rr = wv; rr < nrows; rr += nw) {
        const size_t row = (size_t)row0 + rr;
        f32x4 v[4];
#pragma unroll
        for (int j = 0; j < 4; ++j) {
            const int c = lane * 4 + 256 * j;
            v[j] = *(const f32x4*)((mode == 0 ? src : h) + row * D + c);
            if (mode == 2) {
                const uint2 a = *(const uint2*)(yb + (row * 2) * D + c), b = *(const uint2*)(yb + (row * 2 + 1) * D + c);
                v[j].x = ALPHA * v[j].x + bf2f((bf16)(a.x & 0xffff)) + bf2f((bf16)(b.x & 0xffff));
                v[j].y = ALPHA * v[j].y + bf2f((bf16)(a.x >> 16)) + bf2f((bf16)(b.x >> 16));
                v[j].z = ALPHA * v[j].z + bf2f((bf16)(a.y & 0xffff)) + bf2f((bf16)(b.y & 0xffff));
                v[j].w = ALPHA * v[j].w + bf2f((bf16)(a.y >> 16)) + bf2f((bf16)(b.y >> 16));
            }
        }
        float s = 0.f;
#pragma unroll
        for (int j = 0; j < 4; ++j) s += (v[j].x + v[j].y) + (v[j].z + v[j].w);
        const float mean = wave_sum(s) * (1.f / D);
        float q = 0.f;
#pragma unroll
        for (int j = 0; j < 4; ++j) { v[j] = v[j] - mean; q += (v[j].x * v[j].x + v[j].y * v[j].y) + (v[j].z * v[j].z + v[j].w * v[j].w); }
        const float rstd = 1.0f / sqrtf(wave_sum(q) * (1.f / D) + LN_EPS);
#pragma unroll
        for (int j = 0; j < 4; ++j) {
            const int c = lane * 4 + 256 * j;
            const f32x4 gg = *(const f32x4*)(g + c), bb = *(const f32x4*)(bta + c);
            const f32x4 o = v[j] * rstd * gg + bb;
            *(f32x4*)(h + row * D + c) = o;
            if (hb) { uint2 w; w.x = (unsigned)f2bf(o.x) | ((unsigned)f2bf(o.y) << 16); w.y = (unsigned)f2bf(o.z) | ((unsigned)f2bf(o.w) << 16); *(uint2*)(hb + row * D + c) = w; }
        }
    }
}

__device__ __forceinline__ void wave_gemm32(const bf16* arow, const float* wcol, int ldw, int K, f32x16& acc) {
    for (int k0 = 0; k0 < K; k0 += 16) {
        const bf16x8 a = *(const bf16x8*)(arow + k0);
        bf16x8 b;
#pragma unroll
        for (int j = 0; j < 8; ++j) b[j] = (short)f2bf(wcol[(size_t)(k0 + j) * ldw]);
        acc = __builtin_amdgcn_mfma_f32_32x32x16_bf16(a, b, acc, 0, 0, 0);
    }
}
#define ACC_ROW(reg, h) (((reg) & 3) + 8 * ((reg) >> 2) + 4 * (h))

__global__ __launch_bounds__(256) void k_p1(const bf16* hbc, const float* w_in, const float* b_gate, bf16* qkv, bf16* gates) {
    const int lane = threadIdx.x & 63, r = lane & 31, hh = lane >> 5;
    const int wv = blockIdx.x * 4 + (threadIdx.x >> 6), nw = gridDim.x * 4;
    const int ntn = NCOL / 32, total = (CH / 32) * ntn;
    for (int tile = wv; tile < total; tile += nw) {
        const int tm = tile / ntn, tn = tile % ntn;
        f32x16 acc; for (int i = 0; i < 16; ++i) acc[i] = 0.f;
        wave_gemm32(hbc + (size_t)(tm * 32 + r) * D + 8 * hh, w_in + (size_t)(8 * hh) * NCOL + tn * 32 + r, NCOL, D, acc);
        const int col = tn * 32 + r;
#pragma unroll
        for (int i = 0; i < 16; ++i) {
            const int row = tm * 32 + ACC_ROW(i, hh);
            if (col < QKVW) qkv[(size_t)row * QKVW + col] = f2bf(acc[i]);
            else { const float z = acc[i] + b_gate[col - QKVW]; gates[(size_t)row * GATEW + (col - QKVW)] = f2bf(1.0f / (1.0f + __expf(-z))); }
        }
    }
}

__global__ __launch_bounds__(256) void k_attn_naive(const bf16* qkv, bf16* oabc, bf16* og, float* lse, const float* rel_bias, const float* sink_l, const float* rpb_l, float sc) {
    const long idx = (long)blockIdx.x * 256 + threadIdx.x;
    if (idx >= (long)28 * CH) return;
    const int ht = (int)(idx / CH), tl = (int)(idx % CH), b = tl / L, t = tl % L;
    const bf16* base = qkv + (size_t)(b * L) * QKVW;
    int qcol, kcol, vcol;
    if (ht < 8) { qcol = AQ + ht * 64; kcol = AK + (ht >> 2) * 64; vcol = AV + (ht >> 2) * 64; }
    else if (ht < 20) { const int g = (ht - 8) >> 2, h = (ht - 8) & 3; qcol = BQ0 + 768 * g + h * 64; kcol = qcol + 256; vcol = qcol + 512; }
    else { const int h = ht - 20; qcol = CQ + h * 64; kcol = CK + h * 64; vcol = CV + h * 64; }
    float q[64], o[64];
    {
        const uint4* qp = (const uint4*)(base + (size_t)t * QKVW + qcol);
#pragma unroll
        for (int c = 0; c < 8; ++c) { const uint4 u = qp[c]; const unsigned w[4] = {u.x, u.y, u.z, u.w};
#pragma unroll
            for (int i = 0; i < 4; ++i) { q[8 * c + 2 * i] = bf2f((bf16)(w[i] & 0xffff)); q[8 * c + 2 * i + 1] = bf2f((bf16)(w[i] >> 16)); } }
    }
#pragma unroll
    for (int i = 0; i < 64; ++i) o[i] = 0.f;
    float m = -1e30f, l = 0.f;
    if (ht < 8) { m = sink_l[ht]; l = 1.f; }
#define PROC_KEY(KT, BIAS) do { \
        const uint4* kp = (const uint4*)(base + (size_t)(KT) * QKVW + kcol); float s = 0.f; \
        _Pragma("unroll") for (int c = 0; c < 8; ++c) { const uint4 u = kp[c]; const unsigned w[4] = {u.x, u.y, u.z, u.w}; \
            _Pragma("unroll") for (int i = 0; i < 4; ++i) { s += q[8 * c + 2 * i] * bf2f((bf16)(w[i] & 0xffff)); s += q[8 * c + 2 * i + 1] * bf2f((bf16)(w[i] >> 16)); } } \
        s = s * sc + (BIAS); const float mn = fmaxf(m, s), corr = __expf(m - mn), p = __expf(s - mn); l = l * corr + p; m = mn; \
        const uint4* vp = (const uint4*)(base + (size_t)(KT) * QKVW + vcol); \
        _Pragma("unroll") for (int c = 0; c < 8; ++c) { const uint4 u = vp[c]; const unsigned w[4] = {u.x, u.y, u.z, u.w}; \
            _Pragma("unroll") for (int i = 0; i < 4; ++i) { o[8 * c + 2 * i] = o[8 * c + 2 * i] * corr + p * bf2f((bf16)(w[i] & 0xffff)); o[8 * c + 2 * i + 1] = o[8 * c + 2 * i + 1] * corr + p * bf2f((bf16)(w[i] >> 16)); } } \
    } while (0)
    if (ht < 8) {
        for (int rel = -128; rel <= 128; ++rel) { const int kt = t + rel; if (kt < 0 || kt >= L) continue;
            const float bias = rel_bias[BUCK_A[rel + 128] * 20 + ht]; PROC_KEY(kt, bias); }
    } else if (ht < 20) {
        const int g = (ht - 8) >> 2, h = (ht - 8) & 3, dil = (g == 0) ? 1 : (g == 1 ? 4 : 16);
        for (int off = -64; off <= 64; ++off) { const int kt = t + off * dil; if (kt < 0 || kt >= L) continue;
            const float bias = rel_bias[BUCK_B[g][off + 64] * 20 + 8 + 4 * g + h]; PROC_KEY(kt, bias); }
    } else {
        const int h = ht - 20, gi = t >> 6, gc = t & 63;
        int rs = gi - 4; rs = rs < 0 ? 0 : (rs > 120 ? 120 : rs);
        int cs = gc - 8; cs = cs < 0 ? 0 : (cs > 48 ? 48 : cs);
        for (int kr = rs; kr < rs + 8; ++kr)
            for (int kc = cs; kc < cs + 16; ++kc) { const float bias = rpb_l[(h * 15 + (kr - gi + 7)) * 31 + (kc - gc + 15)]; const int kt = kr * 64 + kc; PROC_KEY(kt, bias); }
    }
#undef PROC_KEY
    const float inv = 1.0f / l;
    bf16* dst;
    if (ht < 8) dst = oabc + (size_t)tl * OW + ht * 64;
    else if (ht < 20) { const int g = (ht - 8) >> 2, h = (ht - 8) & 3; dst = og + ((size_t)tl * 3 + g) * 256 + h * 64; lse[((size_t)tl * 3 + g) * 4 + h] = m + __logf(l); }
    else dst = oabc + (size_t)tl * OW + 768 + (ht - 20) * 64;
#pragma unroll
    for (int c = 0; c < 8; ++c) { uint4 u;
        u.x = (unsigned)f2bf(o[8 * c + 0] * inv) | ((unsigned)f2bf(o[8 * c + 1] * inv) << 16); u.y = (unsigned)f2bf(o[8 * c + 2] * inv) | ((unsigned)f2bf(o[8 * c + 3] * inv) << 16);
        u.z = (unsigned)f2bf(o[8 * c + 4] * inv) | ((unsigned)f2bf(o[8 * c + 5] * inv) << 16); u.w = (unsigned)f2bf(o[8 * c + 6] * inv) | ((unsigned)f2bf(o[8 * c + 7] * inv) << 16);
        ((uint4*)dst)[c] = u; }
}

__global__ __launch_bounds__(256) void k_combine(const bf16* og, const float* lse, bf16* oabc) {
    const long idx = (long)blockIdx.x * 256 + threadIdx.x;
    if (idx >= (long)CH * 32) return;
    const int tl = (int)(idx >> 5), hc = (int)(idx & 31), h = hc >> 3, c = hc & 7;
    const float l0 = lse[((size_t)tl * 3 + 0) * 4 + h], l1 = lse[((size_t)tl * 3 + 1) * 4 + h], l2 = lse[((size_t)tl * 3 + 2) * 4 + h];
    const float mx = fmaxf(l0, fmaxf(l1, l2)); float w0 = __expf(l0 - mx), w1 = __expf(l1 - mx), w2 = __expf(l2 - mx); const float inv = 1.0f / (w0 + w1 + w2); w0 *= inv; w1 *= inv; w2 *= inv;
    const uint4 a = *(const uint4*)(og + ((size_t)tl * 3 + 0) * 256 + h * 64 + c * 8), b = *(const uint4*)(og + ((size_t)tl * 3 + 1) * 256 + h * 64 + c * 8), d = *(const uint4*)(og + ((size_t)tl * 3 + 2) * 256 + h * 64 + c * 8);
    const unsigned aw[4] = {a.x, a.y, a.z, a.w}, bw[4] = {b.x, b.y, b.z, b.w}, dw[4] = {d.x, d.y, d.z, d.w}; unsigned ow[4];
#pragma unroll
    for (int i = 0; i < 4; ++i) {
        const float lo = w0 * bf2f((bf16)(aw[i] & 0xffff)) + w1 * bf2f((bf16)(bw[i] & 0xffff)) + w2 * bf2f((bf16)(dw[i] & 0xffff));
        const float hi = w0 * bf2f((bf16)(aw[i] >> 16)) + w1 * bf2f((bf16)(bw[i] >> 16)) + w2 * bf2f((bf16)(dw[i] >> 16));
        ow[i] = (unsigned)f2bf(lo) | ((unsigned)f2bf(hi) << 16);
    }
    *(uint4*)(oabc + (size_t)tl * OW + 512 + h * 64 + c * 8) = make_uint4(ow[0], ow[1], ow[2], ow[3]);
}

__global__ __launch_bounds__(256) void k_p3(const bf16* oabc, const bf16* gates, const float* wa, const float* wb, const float* wc, bf16* merged) {
    const int lane = threadIdx.x & 63, r = lane & 31, hh = lane >> 5;
    const int wv = blockIdx.x * 4 + (threadIdx.x >> 6), nw = gridDim.x * 4;
    const int ntn = D / 32, total = (CH / 32) * ntn;
    for (int tile = wv; tile < total; tile += nw) {
        const int tm = tile / ntn, tn = tile % ntn, col = tn * 32 + r;
        f32x16 mg; for (int i = 0; i < 16; ++i) mg[i] = 0.f;
#pragma unroll 1
        for (int br = 0; br < 3; ++br) {
            f32x16 acc; for (int i = 0; i < 16; ++i) acc[i] = 0.f;
            const int koff = br == 0 ? 0 : (br == 1 ? 512 : 768), K = br == 1 ? 256 : 512;
            const float* w = br == 0 ? wa : (br == 1 ? wb : wc);
            wave_gemm32(oabc + (size_t)(tm * 32 + r) * OW + koff + 8 * hh, w + (size_t)(8 * hh) * D + col, D, K, acc);
#pragma unroll
            for (int i = 0; i < 16; ++i) { const int row = tm * 32 + ACC_ROW(i, hh); mg[i] += bf2f(gates[(size_t)row * GATEW + br * 1024 + col]) * acc[i]; }
        }
#pragma unroll
        for (int i = 0; i < 16; ++i) { const int row = tm * 32 + ACC_ROW(i, hh); merged[(size_t)row * D + col] = f2bf(mg[i]); }
    }
}
__global__ __launch_bounds__(256) void k_p4(const bf16* merged, const float* wo, float* hchunk) {
    const int lane = threadIdx.x & 63, r = lane & 31, hh = lane >> 5;
    const int wv = blockIdx.x * 4 + (threadIdx.x >> 6), nw = gridDim.x * 4;
    const int ntn = D / 32, total = (CH / 32) * ntn;
    for (int tile = wv; tile < total; tile += nw) {
        const int tm = tile / ntn, tn = tile % ntn, col = tn * 32 + r;
        f32x16 acc; for (int i = 0; i < 16; ++i) acc[i] = 0.f;
        wave_gemm32(merged + (size_t)(tm * 32 + r) * D + 8 * hh, wo + (size_t)(8 * hh) * D + col, D, D, acc);
#pragma unroll
        for (int i = 0; i < 16; ++i) { const int row = tm * 32 + ACC_ROW(i, hh); float* p = hchunk + (size_t)row * D + col; *p = ALPHA * *p + acc[i]; }
    }
}

struct Rec { int e0, s0, e1, s1; float g0, g1; int pad0, pad1; };
__global__ __launch_bounds__(256) void k_router(const float* h, const float* w_rg, const float* b_rg, const float* w_re, const float* b_re, int* cnt, Rec* rec) {
    const int lane = threadIdx.x & 63, wv = blockIdx.x * 4 + (threadIdx.x >> 6), nw = gridDim.x * 4;
    for (int t = wv; t < T; t += nw) {
        float x[16];
#pragma unroll
        for (int j = 0; j < 4; ++j) { const f32x4 v = *(const f32x4*)(h + (size_t)t * D + lane * 4 + 256 * j); x[4 * j] = v.x; x[4 * j + 1] = v.y; x[4 * j + 2] = v.z; x[4 * j + 3] = v.w; }
        float gl[4] = {0.f, 0.f, 0.f, 0.f};
#pragma unroll
        for (int j = 0; j < 4; ++j)
#pragma unroll
            for (int i = 0; i < 4; ++i) { const f32x4 w = *(const f32x4*)(w_rg + (size_t)(lane * 4 + 256 * j + i) * 4); const float xv = x[4 * j + i]; gl[0] += xv * w.x; gl[1] += xv * w.y; gl[2] += xv * w.z; gl[3] += xv * w.w; }
#pragma unroll
        for (int g = 0; g < 4; ++g) gl[g] = wave_sum(gl[g]) + b_rg[g];
        int gi = 0; float gm = gl[0];
#pragma unroll
        for (int g = 1; g < 4; ++g) if (gl[g] > gm) { gm = gl[g]; gi = g; }
        float gs = 0.f;
#pragma unroll
        for (int g = 0; g < 4; ++g) gs += __expf(gl[g] - gm);
        const float gw = 1.0f / gs;
        float el[8];
#pragma unroll
        for (int e = 0; e < 8; ++e) el[e] = 0.f;
        const float* wre = w_re + (size_t)gi * D * 8;
#pragma unroll
        for (int j = 0; j < 4; ++j)
#pragma unroll
            for (int i = 0; i < 4; ++i) { const float* wp = wre + (size_t)(lane * 4 + 256 * j + i) * 8; const f32x4 w0 = *(const f32x4*)wp, w1 = *(const f32x4*)(wp + 4); const float xv = x[4 * j + i];
                el[0] += xv * w0.x; el[1] += xv * w0.y; el[2] += xv * w0.z; el[3] += xv * w0.w; el[4] += xv * w1.x; el[5] += xv * w1.y; el[6] += xv * w1.z; el[7] += xv * w1.w; }
#pragma unroll
        for (int e = 0; e < 8; ++e) el[e] = wave_sum(el[e]) + b_re[gi * 8 + e];
        int i0 = 0; float t0 = el[0];
#pragma unroll
        for (int e = 1; e < 8; ++e) if (el[e] > t0) { t0 = el[e]; i0 = e; }
        int i1 = -1; float t1 = -3.0e38f;
#pragma unroll
        for (int e = 0; e < 8; ++e) if (e != i0 && el[e] > t1) { t1 = el[e]; i1 = e; }
        const float ex = __expf(t1 - t0), p0 = 1.0f / (1.0f + ex), p1 = ex / (1.0f + ex);
        if (lane == 0) {
            Rec rc; rc.e0 = gi * 8 + i0; rc.e1 = gi * 8 + i1; rc.g0 = gw * p0; rc.g1 = gw * p1; rc.pad0 = 0; rc.pad1 = 0;
            rc.s0 = atomicAdd(cnt + rc.e0 * CSTR, 1); rc.s1 = atomicAdd(cnt + rc.e1 * CSTR, 1);
            rec[t] = rc;
        }
    }
}
__device__ __forceinline__ void pad_offsets(const int* cnt, int* po) { int acc = 0; for (int e = 0; e < NE; ++e) { po[e] = acc; acc += (cnt[e * CSTR] + 255) / 256 * 256; } po[NE] = acc; }
__global__ __launch_bounds__(256) void k_dispatch(const int* cnt, const Rec* rec, int* rowtok, float* rowgate) {
    __shared__ int po[NE + 1];
    if (threadIdx.x == 0) pad_offsets(cnt, po);
    __syncthreads();
    for (int t = blockIdx.x * 256 + threadIdx.x; t < T; t += gridDim.x * 256) {
        const Rec rc = rec[t];
        const int d0 = po[rc.e0] + rc.s0, d1 = po[rc.e1] + rc.s1;
        rowtok[d0] = 2 * t; rowgate[d0] = rc.g0; rowtok[d1] = 2 * t + 1; rowgate[d1] = rc.g1;
    }
}
__global__ __launch_bounds__(256) void k_p7(const bf16* hb, const int* cnt, const int* rowtok, const float* w_eg, const float* w_eu, bf16* hid) {
    __shared__ int po[NE + 1];
    if (threadIdx.x == 0) pad_offsets(cnt, po);
    __syncthreads();
    const int lane = threadIdx.x & 63, r = lane & 31, hh = lane >> 5;
    const int wv = blockIdx.x * 4 + (threadIdx.x >> 6), nw = gridDim.x * 4;
    const int ntn = DE / 32, total = (po[NE] / 32) * ntn;
    for (int tile = wv; tile < total; tile += nw) {
        const int tm = tile / ntn, tn = tile % ntn, col = tn * 32 + r, row0 = tm * 32;
        int e = 0; while (e < NE - 1 && po[e + 1] <= row0) ++e;
        int tok = rowtok[row0 + r]; tok = tok < 0 ? 0 : (tok >> 1);
        f32x16 ag, au; for (int i = 0; i < 16; ++i) { ag[i] = 0.f; au[i] = 0.f; }
        wave_gemm32(hb + (size_t)tok * D + 8 * hh, w_eg + (size_t)e * D * DE + (size_t)(8 * hh) * DE + col, DE, D, ag);
        wave_gemm32(hb + (size_t)tok * D + 8 * hh, w_eu + (size_t)e * D * DE + (size_t)(8 * hh) * DE + col, DE, D, au);
#pragma unroll
        for (int i = 0; i < 16; ++i) { const int row = row0 + ACC_ROW(i, hh); const float gsl = ag[i] / (1.0f + __expf(-ag[i])); hid[(size_t)row * DE + col] = f2bf(gsl * au[i]); }
    }
}
__global__ __launch_bounds__(256) void k_p8(const bf16* hid, const int* cnt, const int* rowtok, const float* rowgate, const float* w_ed, bf16* yb) {
    __shared__ int po[NE + 1];
    if (threadIdx.x == 0) pad_offsets(cnt, po);
    __syncthreads();
    const int lane = threadIdx.x & 63, r = lane & 31, hh = lane >> 5;
    const int wv = blockIdx.x * 4 + (threadIdx.x >> 6), nw = gridDim.x * 4;
    const int ntn = D / 32, total = (po[NE] / 32) * ntn;
    for (int tile = wv; tile < total; tile += nw) {
        const int tm = tile / ntn, tn = tile % ntn, col = tn * 32 + r, row0 = tm * 32;
        int e = 0; while (e < NE - 1 && po[e + 1] <= row0) ++e;
        f32x16 acc; for (int i = 0; i < 16; ++i) acc[i] = 0.f;
        wave_gemm32(hid + (size_t)(row0 + r) * DE + 8 * hh, w_ed + (size_t)e * DE * D + (size_t)(8 * hh) * D + col, D, DE, acc);
#pragma unroll
        for (int i = 0; i < 16; ++i) { const int row = row0 + ACC_ROW(i, hh); const int rt = rowtok[row]; if (rt >= 0) yb[(size_t)rt * D + col] = f2bf(acc[i] * rowgate[row]); }
    }
}


namespace pg8 {
#define PG8_LAS __attribute__((address_space(3)))
typedef unsigned short bf16_t;
typedef unsigned u32x4 __attribute__((ext_vector_type(4)));
constexpr int BM = 256, BK = 64, HALF = 128, HTB = HALF * BK * 2  , STAGE_BYTES = 8 * HTB, NXCD = 8, WGM = 8;

__host__ __device__ __forceinline__ int lds_byte(int r, int c) { const int st = (r >> 4) * 2 + (c >> 5), rr = r & 15, cc = c & 31, ob = rr * 64 + cc * 2; return st * 1024 + (ob ^ (((ob >> 9) & 1) << 5)); }
__host__ __device__ __forceinline__ void stage_rc(int b, int& R, int& C) { const int st = b / 1024, sb = b % 1024, swz = sb ^ (((sb >> 9) & 1) << 5); R = (st >> 1) * 16 + swz / 64; C = (st & 1) * 32 + (swz % 64) / 2; }
__host__ __device__ __forceinline__ int perm32(int rho) { const int n = rho >> 4, i = rho & 15; return 8 * (i >> 2) + 4 * n + (i & 3); }

struct Unit { int pm, pn, e, ui; };

struct DenseOrder {
    int nM, nN, nwg, G, c; const char* A; const char* B; size_t tstepA, tstepB;
    __device__ void init(const void* A_, int lda, const void* B_, int ldb, int M, int N, int G_, int c_) { nM = M / BM; nN = N / BM; nwg = nM * nN; G = G_; c = c_; A = (const char*)A_; B = (const char*)B_; tstepA = (size_t)BM * lda * 2; tstepB = (size_t)BM * ldb * 2; }
    __device__ bool next(int i, Unit& u) const {
        const long Lx = (long)i * G + c; if (Lx >= nwg) return false;
        int wgid = (int)Lx; { const int q = nwg / NXCD, r = nwg % NXCD, xcd = wgid % NXCD, off = wgid / NXCD; wgid = (xcd < r ? xcd * (q + 1) : r * (q + 1) + (xcd - r) * q) + off; }
        const int nig = WGM * nN, gid = wgid / nig, fm = gid * WGM, gsz = (nM - fm) < WGM ? (nM - fm) : WGM;
        u.pm = fm + ((wgid % nig) % gsz); u.pn = (wgid % nig) / gsz; u.e = 0; u.ui = i; return true;
    }
    __device__ __forceinline__ const char* a_base(const Unit& u) const { return A + (size_t)u.pm * tstepA; }
    __device__ __forceinline__ const char* b_base(const Unit& u) const { return B + (size_t)u.pn * tstepB; }
    __device__ __forceinline__ int a_row(const Unit&, int) const { return 0; }
};

__device__ __forceinline__ unsigned cvt_pk_bf16(float lo, float hi) { unsigned r; asm volatile("v_cvt_pk_bf16_f32 %0, %1, %2" : "=v"(r) : "v"(lo), "v"(hi)); return r; }

template <class Epi, class Sched, bool GATHER>
__device__ __forceinline__ void gemm_phase(PG8_LAS unsigned char* lds, const Sched& S, const Epi& E, const int K, const int lda, const int ldb, const int tid_in) {
    int tid = tid_in; asm volatile("" : "+v"(tid));
    const int wid = __builtin_amdgcn_readfirstlane(tid >> 6), lane = tid & 63, wr = wid >> 2, wc = wid & 3, fr = lane & 15, fq = lane >> 4;
    const int nt = K / BK;
    int RA[2], CA[2]; unsigned voffB[2];
#pragma unroll
    for (int i = 0; i < 2; ++i) { int R, C; stage_rc(tid * 16 + i * 8192, R, C); const int Rb = Epi::PERM ? ((R & ~31) + perm32(R & 31)) : R; RA[i] = R; CA[i] = C; voffB[i] = (unsigned)(Rb * ldb + C) * 2u; }
    const size_t kstep = (size_t)(BK * 2);
    const size_t hstepB = (size_t)HALF * ldb * 2;
    const unsigned ldsw = (unsigned)wid * 1024u;
    const int aoff = lds_byte(wr * 64 + fr, fq * 8), boff = lds_byte(wc * 32 + fr, fq * 8);
#define PG8_SA(b, h) (((b) * 2 + (h)) * HTB)
#define PG8_SB(b, h) ((4 + (b) * 2 + (h)) * HTB)
#define PG8_STAGE2(bufoff, gbase, v0, v1) do { \
        __builtin_amdgcn_global_load_lds((const unsigned*)((const char*)(gbase) + (v0)), (PG8_LAS unsigned*)(lds + (bufoff) + ldsw), 16, 0, 0); \
        __builtin_amdgcn_global_load_lds((const unsigned*)((const char*)(gbase) + (v1)), (PG8_LAS unsigned*)(lds + (bufoff) + ldsw + 8192), 16, 0, 0); } while (0)
#define PG8_STAGEB(bufoff, gbase) PG8_STAGE2(bufoff, gbase, voffB[0], voffB[1])
#define PG8_LDA(dst, b, h) do { _Pragma("unroll") for (int m = 0; m < 4; ++m) _Pragma("unroll") for (int k = 0; k < 2; ++k) dst[m][k] = *(const PG8_LAS bf16x8*)(lds + PG8_SA(b, h) + aoff + m * 2048 + k * 1024); } while (0)
#define PG8_LDB(dst, b, h) do { _Pragma("unroll") for (int n = 0; n < 2; ++n) _Pragma("unroll") for (int k = 0; k < 2; ++k) dst[n][k] = *(const PG8_LAS bf16x8*)(lds + PG8_SB(b, h) + boff + n * 2048 + k * 1024); } while (0)
#define PG8_MMA(ai, bj, At, Bt) do { __builtin_amdgcn_s_setprio(1); _Pragma("unroll") for (int m = 0; m < 4; ++m) _Pragma("unroll") for (int n = 0; n < 2; ++n) _Pragma("unroll") for (int k = 0; k < 2; ++k) \
        acc[ai][bj][m][n] = __builtin_amdgcn_mfma_f32_16x16x32_bf16(Bt[n][k], At[m][k], acc[ai][bj][m][n], 0, 0, 0); __builtin_amdgcn_s_setprio(0); } while (0)
#define PG8_WAIT_V(n) asm volatile("s_waitcnt vmcnt(" #n ")" ::: "memory")
#define PG8_WAIT_L(n) asm volatile("s_waitcnt lgkmcnt(" #n ")" ::: "memory")
#define PG8_BAR __builtin_amdgcn_s_barrier()
#define PG8_SCHED __builtin_amdgcn_sched_barrier(0)
#define PG8_VOFFA(dst, u) do { _Pragma("unroll") for (int h_ = 0; h_ < 2; ++h_) _Pragma("unroll") for (int i_ = 0; i_ < 2; ++i_) { \
        const int row_ = GATHER ? S.a_row(u, h_ * HALF + RA[i_]) : (h_ * HALF + RA[i_]); dst[h_][i_] = (unsigned)(row_ * lda + CA[i_]) * 2u; } } while (0)
    Unit cur, nxt;
    if (!S.next(0, cur)) return;
    f32x4 acc[2][2][4][2];
#pragma unroll
    for (int a = 0; a < 2; ++a)
#pragma unroll
        for (int b = 0; b < 2; ++b)
#pragma unroll
            for (int m = 0; m < 4; ++m)
#pragma unroll
                for (int n = 0; n < 2; ++n) acc[a][b][m][n] = (f32x4){0.f, 0.f, 0.f, 0.f};
    bf16x8 At[4][2], B0[2][2], B1[2][2];
    unsigned vc[2][2], vn[2][2];
    PG8_VOFFA(vc, cur);
    const char* cA = S.a_base(cur); const char* cB = S.b_base(cur);
    PG8_STAGEB(PG8_SB(0, 0), cB); PG8_STAGEB(PG8_SB(0, 1), cB + hstepB); PG8_STAGE2(PG8_SA(0, 0), cA, vc[0][0], vc[0][1]); PG8_STAGE2(PG8_SA(0, 1), cA, vc[1][0], vc[1][1]);
    if (wr == 1) PG8_BAR;
    PG8_WAIT_V(2); PG8_BAR;
    PG8_STAGEB(PG8_SB(1, 0), cB + kstep); PG8_STAGE2(PG8_SA(1, 0), cA + kstep, vc[0][0], vc[0][1]); PG8_STAGEB(PG8_SB(1, 1), cB + hstepB + kstep);
    PG8_WAIT_V(6); PG8_BAR;
    int ui = 0;
    for (;;) {
        const bool has_next = S.next(ui + 1, nxt);
        const char* nA = has_next ? S.a_base(nxt) : cA; const char* nB = has_next ? S.b_base(nxt) : cB;
        if (GATHER) { if (has_next) { PG8_VOFFA(vn, nxt); } else {
#pragma unroll
            for (int h_ = 0; h_ < 2; ++h_) { vn[h_][0] = vc[h_][0]; vn[h_][1] = vc[h_][1]; } } }
        for (int t = 0; t < nt; t += 2) {
            const bool last = (t == nt - 2);
            const char* a1 = cA + (size_t)(t + 1) * kstep;
            const char* a2 = last ? nA : cA + (size_t)(t + 2) * kstep; const char* b2 = last ? nB : cB + (size_t)(t + 2) * kstep;
            const char* a3 = a2 + kstep; const char* b3 = b2 + kstep;
            unsigned w00, w01, w10, w11;
            if (GATHER) { w00 = last ? vn[0][0] : vc[0][0]; w01 = last ? vn[0][1] : vc[0][1]; w10 = last ? vn[1][0] : vc[1][0]; w11 = last ? vn[1][1] : vc[1][1]; }
            else { w00 = vc[0][0]; w01 = vc[0][1]; w10 = vc[1][0]; w11 = vc[1][1]; }
            PG8_LDB(B0, 0, 0); PG8_LDB(B1, 0, 1); PG8_SCHED; PG8_LDA(At, 0, 0); PG8_STAGE2(PG8_SA(1, 1), a1, vc[1][0], vc[1][1]);
            PG8_WAIT_V(8); PG8_WAIT_L(0); PG8_BAR; PG8_MMA(0, 0, At, B0); PG8_MMA(0, 1, At, B1); PG8_BAR; PG8_SCHED;
            PG8_LDA(At, 0, 1); PG8_STAGEB(PG8_SB(0, 0), b2); PG8_STAGEB(PG8_SB(0, 1), b2 + hstepB); PG8_STAGE2(PG8_SA(0, 0), a2, w00, w01);
            PG8_WAIT_V(8); PG8_WAIT_L(0); PG8_BAR; PG8_MMA(1, 0, At, B0); PG8_MMA(1, 1, At, B1); PG8_BAR; PG8_SCHED;
            PG8_LDB(B0, 1, 0); PG8_LDB(B1, 1, 1); PG8_SCHED; PG8_LDA(At, 1, 0); PG8_STAGE2(PG8_SA(0, 1), a2, w10, w11);
            PG8_WAIT_V(8); PG8_WAIT_L(0); PG8_BAR; PG8_MMA(0, 0, At, B0); PG8_MMA(0, 1, At, B1); PG8_BAR; PG8_SCHED;
            PG8_LDA(At, 1, 1); PG8_STAGEB(PG8_SB(1, 0), b3); PG8_STAGEB(PG8_SB(1, 1), b3 + hstepB); PG8_STAGE2(PG8_SA(1, 0), a3, w00, w01);
            PG8_WAIT_V(8); PG8_WAIT_L(0); PG8_BAR; PG8_MMA(1, 0, At, B0); PG8_MMA(1, 1, At, B1); PG8_BAR; PG8_SCHED;
        }
        if (wr == 0) PG8_BAR;
        E(acc, cur, wr, wc, fr, fq);
        if (!has_next) break;
#pragma unroll
        for (int a = 0; a < 2; ++a)
#pragma unroll
            for (int b = 0; b < 2; ++b)
#pragma unroll
                for (int m = 0; m < 4; ++m)
#pragma unroll
                    for (int n = 0; n < 2; ++n) acc[a][b][m][n] = (f32x4){0.f, 0.f, 0.f, 0.f};
        cur = nxt; cA = nA; cB = nB; ++ui;
        if (GATHER) {
#pragma unroll
            for (int h_ = 0; h_ < 2; ++h_) { vc[h_][0] = vn[h_][0]; vc[h_][1] = vn[h_][1]; } }
        if (wr == 1) PG8_BAR;
    }
    PG8_WAIT_V(0);
    PG8_BAR;
#undef PG8_SA
#undef PG8_SB
#undef PG8_STAGE2
#undef PG8_STAGEB
#undef PG8_LDA
#undef PG8_LDB
#undef PG8_MMA
#undef PG8_WAIT_V
#undef PG8_WAIT_L
#undef PG8_BAR
#undef PG8_SCHED
#undef PG8_VOFFA
}
template <class Epi, class Sched>
__device__ __forceinline__ void gemm_phase_vk(PG8_LAS unsigned char* lds, const Sched& S, const Epi& E, const int lda, const int tid_in) {
    constexpr bool GATHER = false;
    int tid = tid_in; asm volatile("" : "+v"(tid));
    const int wid = __builtin_amdgcn_readfirstlane(tid >> 6), lane = tid & 63, wr = wid >> 2, wc = wid & 3, fr = lane & 15, fq = lane >> 4;
    int RA[2], CA[2], RB[2];
#pragma unroll
    for (int i = 0; i < 2; ++i) { int R, C; stage_rc(tid * 16 + i * 8192, R, C); const int Rb = Epi::PERM ? ((R & ~31) + perm32(R & 31)) : R; RA[i] = R; CA[i] = C; RB[i] = Rb; }
    const size_t kstep = (size_t)(BK * 2);
    const unsigned ldsw = (unsigned)wid * 1024u;
    const int aoff = lds_byte(wr * 64 + fr, fq * 8), boff = lds_byte(wc * 32 + fr, fq * 8);
#define PG8_SA(b, h) (((b) * 2 + (h)) * HTB)
#define PG8_SB(b, h) ((4 + (b) * 2 + (h)) * HTB)
#define PG8_STAGE2(bufoff, gbase, v0, v1) do { \
        __builtin_amdgcn_global_load_lds((const unsigned*)((const char*)(gbase) + (v0)), (PG8_LAS unsigned*)(lds + (bufoff) + ldsw), 16, 0, 0); \
        __builtin_amdgcn_global_load_lds((const unsigned*)((const char*)(gbase) + (v1)), (PG8_LAS unsigned*)(lds + (bufoff) + ldsw + 8192), 16, 0, 0); } while (0)
#define PG8_VOFFB(dst, hs, u) do { const int ldb_ = S.ldb_of(u); _Pragma("unroll") for (int i_ = 0; i_ < 2; ++i_) { int R_, C_; stage_rc(tid * 16 + i_ * 8192, R_, C_); const int Rb_ = Epi::PERM ? ((R_ & ~31) + perm32(R_ & 31)) : R_; dst[i_] = (unsigned)(Rb_ * ldb_ + C_) * 2u; } hs = (size_t)HALF * ldb_ * 2; } while (0)
#define PG8_LDA(dst, b, h) do { _Pragma("unroll") for (int m = 0; m < 4; ++m) _Pragma("unroll") for (int k = 0; k < 2; ++k) dst[m][k] = *(const PG8_LAS bf16x8*)(lds + PG8_SA(b, h) + aoff + m * 2048 + k * 1024); } while (0)
#define PG8_LDB(dst, b, h) do { _Pragma("unroll") for (int n = 0; n < 2; ++n) _Pragma("unroll") for (int k = 0; k < 2; ++k) dst[n][k] = *(const PG8_LAS bf16x8*)(lds + PG8_SB(b, h) + boff + n * 2048 + k * 1024); } while (0)
#define PG8_MMA(ai, bj, At, Bt) do { __builtin_amdgcn_s_setprio(1); _Pragma("unroll") for (int m = 0; m < 4; ++m) _Pragma("unroll") for (int n = 0; n < 2; ++n) _Pragma("unroll") for (int k = 0; k < 2; ++k) \
        acc[ai][bj][m][n] = __builtin_amdgcn_mfma_f32_16x16x32_bf16(Bt[n][k], At[m][k], acc[ai][bj][m][n], 0, 0, 0); __builtin_amdgcn_s_setprio(0); } while (0)
#define PG8_WAIT_V(n) asm volatile("s_waitcnt vmcnt(" #n ")" ::: "memory")
#define PG8_WAIT_L(n) asm volatile("s_waitcnt lgkmcnt(" #n ")" ::: "memory")
#define PG8_BAR __builtin_amdgcn_s_barrier()
#define PG8_SCHED __builtin_amdgcn_sched_barrier(0)
#define PG8_VOFFA(dst, u) do { _Pragma("unroll") for (int h_ = 0; h_ < 2; ++h_) _Pragma("unroll") for (int i_ = 0; i_ < 2; ++i_) { \
        const int row_ = GATHER ? S.a_row(u, h_ * HALF + RA[i_]) : (h_ * HALF + RA[i_]); dst[h_][i_] = (unsigned)(row_ * lda + CA[i_]) * 2u; } } while (0)
    Unit cur, nxt;
    if (!S.next(0, cur)) return;
    f32x4 acc[2][2][4][2];
#pragma unroll
    for (int a = 0; a < 2; ++a)
#pragma unroll
        for (int b = 0; b < 2; ++b)
#pragma unroll
            for (int m = 0; m < 4; ++m)
#pragma unroll
                for (int n = 0; n < 2; ++n) acc[a][b][m][n] = (f32x4){0.f, 0.f, 0.f, 0.f};
    bf16x8 At[4][2], B0[2][2], B1[2][2];
    unsigned vc[2][2], vn[2][2];
    PG8_VOFFA(vc, cur);
    unsigned vbc[2], vbn[2]; size_t hsc, hsn; PG8_VOFFB(vbc, hsc, cur); int nt = S.K_of(cur) / BK;
    const char* cA = S.a_base(cur); const char* cB = S.b_base(cur);
    PG8_STAGE2(PG8_SB(0, 0), cB, vbc[0], vbc[1]); PG8_STAGE2(PG8_SB(0, 1), cB + hsc, vbc[0], vbc[1]); PG8_STAGE2(PG8_SA(0, 0), cA, vc[0][0], vc[0][1]); PG8_STAGE2(PG8_SA(0, 1), cA, vc[1][0], vc[1][1]);
    if (wr == 1) PG8_BAR;
    PG8_WAIT_V(2); PG8_BAR;
    PG8_STAGE2(PG8_SB(1, 0), cB + kstep, vbc[0], vbc[1]); PG8_STAGE2(PG8_SA(1, 0), cA + kstep, vc[0][0], vc[0][1]); PG8_STAGE2(PG8_SB(1, 1), cB + hsc + kstep, vbc[0], vbc[1]);
    PG8_WAIT_V(6); PG8_BAR;
    int ui = 0;
    for (;;) {
        const bool has_next = S.next(ui + 1, nxt);
        const char* nA = has_next ? S.a_base(nxt) : cA; const char* nB = has_next ? S.b_base(nxt) : cB;
        if (has_next) { PG8_VOFFB(vbn, hsn, nxt); } else { vbn[0] = vbc[0]; vbn[1] = vbc[1]; hsn = hsc; }
        if (GATHER) { if (has_next) { PG8_VOFFA(vn, nxt); } else {
#pragma unroll
            for (int h_ = 0; h_ < 2; ++h_) { vn[h_][0] = vc[h_][0]; vn[h_][1] = vc[h_][1]; } } }
        for (int t = 0; t < nt; t += 2) {
            const bool last = (t == nt - 2);
            const char* a1 = cA + (size_t)(t + 1) * kstep;
            const char* a2 = last ? nA : cA + (size_t)(t + 2) * kstep; const char* b2 = last ? nB : cB + (size_t)(t + 2) * kstep;
            const char* a3 = a2 + kstep; const char* b3 = b2 + kstep;
            unsigned w00, w01, w10, w11;
            if (GATHER) { w00 = last ? vn[0][0] : vc[0][0]; w01 = last ? vn[0][1] : vc[0][1]; w10 = last ? vn[1][0] : vc[1][0]; w11 = last ? vn[1][1] : vc[1][1]; }
            else { w00 = vc[0][0]; w01 = vc[0][1]; w10 = vc[1][0]; w11 = vc[1][1]; }
            const unsigned wb0 = last ? vbn[0] : vbc[0], wb1 = last ? vbn[1] : vbc[1]; const size_t hsb = last ? hsn : hsc;
            PG8_LDB(B0, 0, 0); PG8_LDB(B1, 0, 1); PG8_SCHED; PG8_LDA(At, 0, 0); PG8_STAGE2(PG8_SA(1, 1), a1, vc[1][0], vc[1][1]);
            PG8_WAIT_V(8); PG8_WAIT_L(0); PG8_BAR; PG8_MMA(0, 0, At, B0); PG8_MMA(0, 1, At, B1); PG8_BAR; PG8_SCHED;
            PG8_LDA(At, 0, 1); PG8_STAGE2(PG8_SB(0, 0), b2, wb0, wb1); PG8_STAGE2(PG8_SB(0, 1), b2 + hsb, wb0, wb1); PG8_STAGE2(PG8_SA(0, 0), a2, w00, w01);
            PG8_WAIT_V(8); PG8_WAIT_L(0); PG8_BAR; PG8_MMA(1, 0, At, B0); PG8_MMA(1, 1, At, B1); PG8_BAR; PG8_SCHED;
            PG8_LDB(B0, 1, 0); PG8_LDB(B1, 1, 1); PG8_SCHED; PG8_LDA(At, 1, 0); PG8_STAGE2(PG8_SA(0, 1), a2, w10, w11);
            PG8_WAIT_V(8); PG8_WAIT_L(0); PG8_BAR; PG8_MMA(0, 0, At, B0); PG8_MMA(0, 1, At, B1); PG8_BAR; PG8_SCHED;
            PG8_LDA(At, 1, 1); PG8_STAGE2(PG8_SB(1, 0), b3, wb0, wb1); PG8_STAGE2(PG8_SB(1, 1), b3 + hsb, wb0, wb1); PG8_STAGE2(PG8_SA(1, 0), a3, w00, w01);
            PG8_WAIT_V(8); PG8_WAIT_L(0); PG8_BAR; PG8_MMA(1, 0, At, B0); PG8_MMA(1, 1, At, B1); PG8_BAR; PG8_SCHED;
        }
        if (wr == 0) PG8_BAR;
        E(acc, cur, wr, wc, fr, fq);
        if (!has_next) break;
#pragma unroll
        for (int a = 0; a < 2; ++a)
#pragma unroll
            for (int b = 0; b < 2; ++b)
#pragma unroll
                for (int m = 0; m < 4; ++m)
#pragma unroll
                    for (int n = 0; n < 2; ++n) acc[a][b][m][n] = (f32x4){0.f, 0.f, 0.f, 0.f};
        cur = nxt; cA = nA; cB = nB; ++ui; vbc[0] = vbn[0]; vbc[1] = vbn[1]; hsc = hsn; nt = S.K_of(cur) / BK;
        if (GATHER) {
#pragma unroll
            for (int h_ = 0; h_ < 2; ++h_) { vc[h_][0] = vn[h_][0]; vc[h_][1] = vn[h_][1]; } }
        if (wr == 1) PG8_BAR;
    }
    PG8_WAIT_V(0);
    PG8_BAR;
#undef PG8_SA
#undef PG8_SB
#undef PG8_STAGE2
#undef PG8_VOFFB
#undef PG8_LDA
#undef PG8_LDB
#undef PG8_MMA
#undef PG8_WAIT_V
#undef PG8_WAIT_L
#undef PG8_BAR
#undef PG8_SCHED
#undef PG8_VOFFA
}
}

constexpr int NWAVES = 8, NTHREADS = 512;
constexpr int RING_OFF = 0, RING_BYTES = 131072, ROWS_OFF = 131072, ROWS_BYTES = 12288, ROUTER_BYTES = 147456  , MISC_OFF = ROUTER_BYTES, LCNT_OFF = MISC_OFF + 128  , LDS_BYTES = 148480;
static_assert(MISC_OFF + 128 <= LDS_BYTES, "LDS map");
constexpr int CW_CNT = 0;
constexpr int CW_BAR = 4096;
constexpr size_t CTL_ZERO_BYTES = 64 * 1024;
constexpr float LOG2E = 1.4426950408889634f, LN2 = 0.6931471805599453f;
constexpr float QSCALE = 0.125f * LOG2E;

#define GAS __attribute__((address_space(1)))
#define LAS __attribute__((address_space(3)))
typedef unsigned v4u __attribute__((ext_vector_type(4)));
typedef unsigned v2u __attribute__((ext_vector_type(2)));
#define LDS_WAIT() asm volatile("s_waitcnt lgkmcnt(0)" ::: "memory")
__device__ __forceinline__ unsigned pk2(float lo, float hi) { return (unsigned)f2bf(lo) | ((unsigned)f2bf(hi) << 16); }

#define XB_TMO      128
#define XB_XCNT(j)  (256  + 64 * (j))
#define XB_XSUB(j)  (1280 + 64 * (j))
#define XB_XGEN(j)  (2304 + 64 * (j))
#define XB_TOP      3328
#define XB_TOPGEN   3392
#define XCD_BAR_WORDS 3456
#define XB_SPIN_CAP (1u << 18)

__device__ __forceinline__ unsigned xb_ld(unsigned* p)              { return __hip_atomic_load(p, __ATOMIC_RELAXED, __HIP_MEMORY_SCOPE_AGENT); }
__device__ __forceinline__ unsigned xb_add(unsigned* p, unsigned v) { return __hip_atomic_fetch_add(p, v, __ATOMIC_RELAXED, __HIP_MEMORY_SCOPE_AGENT); }
__device__ __forceinline__ unsigned xb_xcc_id() { return (unsigned)__builtin_amdgcn_s_getreg((3 << 11) | 20) & 0xFu; }
#define XB_SPIN(cond, bar) do { unsigned _sp = 0; while (cond) { __builtin_amdgcn_s_sleep(1); \
    if ((++_sp & 255u) == 0u) { if (xb_ld(&(bar)[XB_TMO])) break; if (_sp > XB_SPIN_CAP) { atomicAdd(&(bar)[XB_TMO], 1u); break; } } } } while (0)

struct XcdBarrier {
    int wave0;
    unsigned* bar; unsigned x;
    volatile LAS unsigned* st;
};

__device__ __forceinline__ unsigned xb_lane() { unsigned l_; asm volatile("v_mbcnt_lo_u32_b32 %0, -1, 0\n\tv_mbcnt_hi_u32_b32 %0, -1, %0" : "=v"(l_)); return l_; }
__device__ __forceinline__ XcdBarrier xcd_barrier_post(unsigned* bar, volatile LAS unsigned* st, int wave0) {
    XcdBarrier b; b.wave0 = wave0; b.bar = bar; b.x = xb_xcc_id(); b.st = st;
    if (b.wave0 && xb_lane() == 0u) (void)xb_add(&bar[XB_XCNT(b.x)], 1u);
    return b;
}
__device__ __forceinline__ void xcd_barrier_complete(unsigned* bar, unsigned x, unsigned& nloc, unsigned& nx) {
    const unsigned G = gridDim.x * gridDim.y * gridDim.z;
    unsigned sum, cnt, mine, sp = 0u;
    for (;;) {
        sum = 0u; cnt = 0u; mine = 0u;
#pragma unroll
        for (unsigned j = 0; j < 16; ++j) { const unsigned c = xb_ld(&bar[XB_XCNT(j)]); sum += c; cnt += (c > 0u) ? 1u : 0u; mine = (j == x) ? c : mine; }
        if (sum == G) break;
        __builtin_amdgcn_s_sleep(1);
        if ((++sp & 255u) == 0u) { if (xb_ld(&bar[XB_TMO])) break; if (sp > XB_SPIN_CAP) { atomicAdd(&bar[XB_TMO], 1u); break; } }
    }
    nloc = mine > 0u ? mine : 1u; nx = cnt > 0u ? cnt : 1u;
}

__device__ __forceinline__ void xcd_barrier(const XcdBarrier& b) {
    asm volatile("s_waitcnt vmcnt(0)" ::: "memory");
    __syncthreads();
    if (b.wave0 && xb_lane() == 0u) {
        unsigned* bar = b.bar;
        __builtin_amdgcn_s_waitcnt(0);
        unsigned nloc = b.st[0], nx = b.st[1];
        if (nloc == 0u) { xcd_barrier_complete(bar, b.x, nloc, nx); b.st[0] = nloc; b.st[1] = nx; }
        const unsigned old = xb_add(&bar[XB_XSUB(b.x)], 1u);
        const unsigned gen = old / nloc;
        if (old + 1u == (gen + 1u) * nloc) {
            __builtin_amdgcn_fence(__ATOMIC_RELEASE, "agent");
            asm volatile("s_waitcnt vmcnt(0)" ::: "memory");
            const unsigned og = xb_add(&bar[XB_TOP], 1u);
            const unsigned tg = og / nx;
            if (og + 1u == (tg + 1u) * nx) xb_add(&bar[XB_TOPGEN], 1u);
            else XB_SPIN(xb_ld(&bar[XB_TOPGEN]) == tg, bar);
            __builtin_amdgcn_fence(__ATOMIC_ACQUIRE, "agent");
            xb_add(&bar[XB_XGEN(b.x)], 1u);
            asm volatile("s_waitcnt vmcnt(0)" ::: "memory");
        } else {
            XB_SPIN(xb_ld(&bar[XB_XGEN(b.x)]) == gen, bar);
            __builtin_amdgcn_fence(__ATOMIC_ACQUIRE, "agent");
            asm volatile("s_waitcnt vmcnt(0)" ::: "memory");
        }
    }
    __syncthreads();
}


struct Args { const float* in[23]; float* out; unsigned char* ws; int s_lo, s_hi, probe, pad; };

struct Frame {
    LAS unsigned char* lds; int tid, lane, wave, vcu, G;
    const float* const* in; float* h; unsigned char* ws; int probe;
};

__device__ __forceinline__ int hw_lane() { int l_; asm volatile("v_mbcnt_lo_u32_b32 %0, -1, 0\n\tv_mbcnt_hi_u32_b32 %0, -1, %0" : "=v"(l_)); return l_; }
__device__ __forceinline__ float shfl_xor_l(float v, int mask, int lane) { return __builtin_bit_cast(float, __builtin_amdgcn_ds_bpermute((lane ^ mask) << 2, __builtin_bit_cast(int, v))); }
__device__ __forceinline__ float dpp_add(float v, const int ctrl_sel) {
    const int x = __builtin_bit_cast(int, v); int y;
    if (ctrl_sel == 0) y = __builtin_amdgcn_mov_dpp(x, 0xB1, 0xF, 0xF, true);
    else if (ctrl_sel == 1) y = __builtin_amdgcn_mov_dpp(x, 0x4E, 0xF, 0xF, true);
    else if (ctrl_sel == 2) y = __builtin_amdgcn_mov_dpp(x, 0x141, 0xF, 0xF, true);
    else y = __builtin_amdgcn_mov_dpp(x, 0x140, 0xF, 0xF, true);
    return v + __builtin_bit_cast(float, y);
}
__device__ __forceinline__ float wave_sum_l(float v, int lane) {
    (void)lane;
    v = dpp_add(v, 0); v = dpp_add(v, 1); v = dpp_add(v, 2); v = dpp_add(v, 3);
    const int x = __builtin_bit_cast(int, v);
    const float r0 = __builtin_bit_cast(float, __builtin_amdgcn_readlane(x, 0)), r1 = __builtin_bit_cast(float, __builtin_amdgcn_readlane(x, 16)),
                r2 = __builtin_bit_cast(float, __builtin_amdgcn_readlane(x, 32)), r3 = __builtin_bit_cast(float, __builtin_amdgcn_readlane(x, 48));
    return (r0 + r1) + (r2 + r3);
}
#define LAUNDER(F) do { (F).lane = hw_lane(); (F).tid = (F).wave * 64 + (F).lane; asm volatile("" : "+s"((F).G), "+s"((F).vcu), "+s"((F).ws), "+s"((F).h)); } while (0)
__device__ __forceinline__ void p0_item(const float* W, int ldw, int k0, int n0, bf16* WT, int Kd, int drow0, float scale, LAS float* scr, int lane) {
#pragma unroll 8
    for (int i = 0; i < 32; ++i) { const int kk = 2 * i + (lane >> 5); scr[kk * 33 + (lane & 31)] = W[(size_t)(k0 + kk) * ldw + n0 + (lane & 31)] * scale; }
    LDS_WAIT(); asm volatile("" ::: "memory");
    const int c = lane & 7;
#pragma unroll
    for (int j = 0; j < 4; ++j) { const int n = (lane >> 3) + 8 * j; const LAS float* s = scr + (8 * c) * 33 + n;
        v4u o; o.x = pk2(s[0 * 33], s[1 * 33]); o.y = pk2(s[2 * 33], s[3 * 33]); o.z = pk2(s[4 * 33], s[5 * 33]); o.w = pk2(s[6 * 33], s[7 * 33]);
        *(GAS v4u*)(WT + (size_t)(drow0 + n) * Kd + k0 + 8 * c) = o; }
    LDS_WAIT(); asm volatile("" ::: "memory");
}
__device__ __forceinline__ bool is_q_col(int n) { return n < 512 || (n >= 768 && n < 3072 && ((n - 768) % 768) < 256) || (n >= 3072 && n < 3584); }

__device__ __forceinline__ void ph_prologue(Frame& F) { LAUNDER(F);
    LAS float* scr = (LAS float*)(F.lds + RING_OFF + F.wave * 16384);
    const int gw = F.vcu * NWAVES + F.wave, NGW = F.G * NWAVES, lane = F.lane;
    const float* w_in = F.in[4]; const float* w_a = F.in[8]; const float* w_b = F.in[9]; const float* w_c = F.in[10]; const float* w_o = F.in[11];
    const float* w_eg = F.in[18]; const float* w_eu = F.in[19]; const float* w_ed = F.in[20];
    bf16* WIN = (bf16*)(F.ws + WS_WIN); bf16* WBRA = (bf16*)(F.ws + WS_WBRA); bf16* WBRB = (bf16*)(F.ws + WS_WBRB); bf16* WBRC = (bf16*)(F.ws + WS_WBRC); bf16* WOUT = (bf16*)(F.ws + WS_WOUT);
    bf16* WGU = (bf16*)(F.ws + WS_WGU); bf16* WD = (bf16*)(F.ws + WS_WD);
    constexpr int I_IN = 16 * (NCOL / 32), I_A = 8 * 32, I_B = 4 * 32, I_C = 8 * 32, I_O = 16 * 32, I_G = 16 * 16, I_D = 8 * 32;
    constexpr int I_LAYER = I_IN + I_A + I_B + I_C + I_O + NE * (2 * I_G + I_D);
    for (int it = gw; it < DEPTH * I_LAYER; it += NGW) {
        const int l = it / I_LAYER; int r = it % I_LAYER;
        if (r < I_IN) { const int nb = r % (NCOL / 32), kb = r / (NCOL / 32); p0_item(w_in + (size_t)l * D * NCOL, NCOL, 64 * kb, 32 * nb, WIN + (size_t)l * NCOL * D, D, 32 * nb, is_q_col(32 * nb) ? QSCALE : 1.0f, scr, lane); continue; } r -= I_IN;
        if (r < I_A) { const int nb = r % 32, kb = r / 32; p0_item(w_a + (size_t)l * 512 * D, D, 64 * kb, 32 * nb, WBRA + (size_t)l * D * 512, 512, 32 * nb, 1.0f, scr, lane); continue; } r -= I_A;
        if (r < I_B) { const int nb = r % 32, kb = r / 32; p0_item(w_b + (size_t)l * 256 * D, D, 64 * kb, 32 * nb, WBRB + (size_t)l * D * 256, 256, 32 * nb, 1.0f, scr, lane); continue; } r -= I_B;
        if (r < I_C) { const int nb = r % 32, kb = r / 32; p0_item(w_c + (size_t)l * 512 * D, D, 64 * kb, 32 * nb, WBRC + (size_t)l * D * 512, 512, 32 * nb, 1.0f, scr, lane); continue; } r -= I_C;
        if (r < I_O) { const int nb = r % 32, kb = r / 32; p0_item(w_o + (size_t)l * D * D, D, 64 * kb, 32 * nb, WOUT + (size_t)l * D * D, D, 32 * nb, 1.0f, scr, lane); continue; } r -= I_O;
        const int e = r / (2 * I_G + I_D); r %= (2 * I_G + I_D); const size_t le = (size_t)l * NE + e;
        if (r < 2 * I_G) { const int up = r / I_G; r %= I_G; const int nb = r % 16, kb = r / 16;
            p0_item((up ? w_eu : w_eg) + le * D * DE, DE, 64 * kb, 32 * nb, WGU + le * 1024 * 1024, D, (nb >> 2) * 256 + up * 128 + (nb & 3) * 32, 1.0f, scr, lane); continue; }
        r -= 2 * I_G; { const int nb = r % 32, kb = r / 32; p0_item(w_ed + le * DE * D, D, 64 * kb, 32 * nb, WD + le * D * DE, DE, 32 * nb, 1.0f, scr, lane); }
    }
}

struct LnIn { f32x4 v[4]; v2u a[4], b[4]; };
template <int MODE> __device__ __forceinline__ void ln_load(LnIn& in, const float* src, const bf16* yb, size_t row, int lane) {
#pragma unroll
    for (int j = 0; j < 4; ++j) {
        const int c = lane * 4 + 256 * j;
        in.v[j] = *(const GAS f32x4*)(src + row * D + c);
        if (MODE == 2) { in.a[j] = *(const GAS v2u*)(yb + (row * 2) * D + c); in.b[j] = *(const GAS v2u*)(yb + (row * 2 + 1) * D + c); }
    }
}
template <int MODE> __device__ __forceinline__ void ln_finish(const LnIn& in, float* hout, bf16* hb, const float* g, const float* bta, size_t row, int lane, f32x4 (&o)[4]) {
    f32x4 v[4];
#pragma unroll
    for (int j = 0; j < 4; ++j) {
        v[j] = in.v[j];
        if (MODE == 2) {
            const v2u a = in.a[j], b = in.b[j];
            v[j].x = ALPHA * v[j].x + bf2f((bf16)(a.x & 0xffff)) + bf2f((bf16)(b.x & 0xffff));
            v[j].y = ALPHA * v[j].y + bf2f((bf16)(a.x >> 16)) + bf2f((bf16)(b.x >> 16));
            v[j].z = ALPHA * v[j].z + bf2f((bf16)(a.y & 0xffff)) + bf2f((bf16)(b.y & 0xffff));
            v[j].w = ALPHA * v[j].w + bf2f((bf16)(a.y >> 16)) + bf2f((bf16)(b.y >> 16));
        }
    }
    float s = 0.f;
#pragma unroll
    for (int j = 0; j < 4; ++j) s += (v[j].x + v[j].y) + (v[j].z + v[j].w);
    const float mean = wave_sum_l(s, lane) * (1.f / D);
    float q = 0.f;
#pragma unroll
    for (int j = 0; j < 4; ++j) { v[j] = v[j] - mean; q += (v[j].x * v[j].x + v[j].y * v[j].y) + (v[j].z * v[j].z + v[j].w * v[j].w); }
    const float rstd = 1.0f / sqrtf(wave_sum_l(q, lane) * (1.f / D) + LN_EPS);
#pragma unroll
    for (int j = 0; j < 4; ++j) {
        const int c = lane * 4 + 256 * j;
        const f32x4 gg = *(const GAS f32x4*)(g + c), bb = *(const GAS f32x4*)(bta + c);
        o[j] = v[j] * rstd * gg + bb;
        *(GAS f32x4*)(hout + row * D + c) = o[j];
        if (hb) { v2u w; w.x = pk2(o[j].x, o[j].y); w.y = pk2(o[j].z, o[j].w); *(GAS v2u*)(hb + row * D + c) = w; }
    }
}

#ifndef PROBE_EPI
#define PROBE_EPI 0
#endif
struct EpiP1 {
    static constexpr bool PERM = true;
    bf16* qkv; bf16* gates; const float* b_gate; int probe;
    __device__ __forceinline__ void operator()(const f32x4 (&acc)[2][2][4][2], const pg8::Unit& u, int wr, int wc, int fr, int fq) const {
        if (probe == 1 && PROBE_EPI == 0) return;
        const int row0 = (probe == 1 ? (int)(blockIdx.x & 127) : u.pm) * 256 + wr * 64 + fr; const bool isg = u.pn >= 18;
        bf16* base = isg ? gates : qkv; const int ldc = isg ? GATEW : QKVW; const int col0 = (isg ? (u.pn - 18) : u.pn) * 256 + wc * 32 + 8 * fq;
        f32x4 bv[2][2];
#pragma unroll
        for (int bj = 0; bj < 2; ++bj)
#pragma unroll
            for (int n = 0; n < 2; ++n) bv[bj][n] = isg ? *(const GAS f32x4*)(b_gate + col0 + bj * 128 + 4 * n) : (f32x4){0.f, 0.f, 0.f, 0.f};
#pragma unroll
        for (int ai = 0; ai < 2; ++ai)
#pragma unroll
            for (int m = 0; m < 4; ++m) { bf16* rowp = base + (size_t)(row0 + ai * 128 + m * 16) * ldc + col0;
#pragma unroll
                for (int bj = 0; bj < 2; ++bj) { f32x4 v0 = acc[ai][bj][m][0] + bv[bj][0], v1 = acc[ai][bj][m][1] + bv[bj][1];
                    if (isg) {
#pragma unroll
                        for (int j = 0; j < 4; ++j) { v0[j] = __builtin_amdgcn_rcpf(1.0f + __builtin_amdgcn_exp2f(-LOG2E * v0[j])); v1[j] = __builtin_amdgcn_rcpf(1.0f + __builtin_amdgcn_exp2f(-LOG2E * v1[j])); } }
                    v4u w; w.x = pg8::cvt_pk_bf16(v0[0], v0[1]); w.y = pg8::cvt_pk_bf16(v0[2], v0[3]); w.z = pg8::cvt_pk_bf16(v1[0], v1[1]); w.w = pg8::cvt_pk_bf16(v1[2], v1[3]);
                    *(GAS v4u*)(rowp + bj * 128) = w; } }
    }
};
template <bool FIRST> struct EpiP3 {
    static constexpr bool PERM = true;
    bf16* merged; const bf16* gates; int br;
    __device__ __forceinline__ void operator()(const f32x4 (&acc)[2][2][4][2], const pg8::Unit& u, int wr, int wc, int fr, int fq) const {
        const int row0 = u.pm * 256 + wr * 64 + fr, col0 = u.pn * 256 + wc * 32 + 8 * fq;
#pragma unroll
        for (int ai = 0; ai < 2; ++ai) {
            v4u gw[4][2], ow[4][2];
#pragma unroll
            for (int m = 0; m < 4; ++m)
#pragma unroll
                for (int bj = 0; bj < 2; ++bj) { const size_t row = (size_t)(row0 + ai * 128 + m * 16);
                    gw[m][bj] = *(const GAS v4u*)(gates + row * GATEW + br * 1024 + col0 + bj * 128);
                    ow[m][bj] = FIRST ? (v4u){0u, 0u, 0u, 0u} : *(const GAS v4u*)(merged + row * D + col0 + bj * 128); }
#pragma unroll
            for (int m = 0; m < 4; ++m)
#pragma unroll
                for (int bj = 0; bj < 2; ++bj) { const size_t row = (size_t)(row0 + ai * 128 + m * 16);
                    const f32x4 a0 = acc[ai][bj][m][0], a1 = acc[ai][bj][m][1];
                    float r[8];
#pragma unroll
                    for (int j = 0; j < 4; ++j) { const unsigned g2 = gw[m][bj][j], o2 = ow[m][bj][j]; const float av0 = j < 2 ? a0[2 * j] : a1[2 * j - 4], av1 = j < 2 ? a0[2 * j + 1] : a1[2 * j - 3];
                        r[2 * j] = __uint_as_float(g2 << 16) * av0 + (FIRST ? 0.f : __uint_as_float(o2 << 16)); r[2 * j + 1] = __uint_as_float(g2 & 0xffff0000u) * av1 + (FIRST ? 0.f : __uint_as_float(o2 & 0xffff0000u)); }
                    v4u w; w.x = pg8::cvt_pk_bf16(r[0], r[1]); w.y = pg8::cvt_pk_bf16(r[2], r[3]); w.z = pg8::cvt_pk_bf16(r[4], r[5]); w.w = pg8::cvt_pk_bf16(r[6], r[7]);
                    *(GAS v4u*)(merged + row * D + col0 + bj * 128) = w; }
            asm volatile("" ::: "memory"); }
    }
};
struct EpiP3V {
    static constexpr bool PERM = true;
    bf16* merged; const bf16* gates;
    __device__ __forceinline__ void operator()(const f32x4 (&acc)[2][2][4][2], const pg8::Unit& u, int wr, int wc, int fr, int fq) const {
        const int row0 = u.pm * 256 + wr * 64 + fr, col0 = u.pn * 256 + wc * 32 + 8 * fq; const int br = u.e; const bool first = (br == 0);
#pragma unroll
        for (int ai = 0; ai < 2; ++ai)
#pragma unroll
        for (int mp = 0; mp < 2; ++mp) {
            v4u gw[2][2], ow[2][2];
#pragma unroll
            for (int mm = 0; mm < 2; ++mm)
#pragma unroll
                for (int bj = 0; bj < 2; ++bj) { const size_t row = (size_t)(row0 + ai * 128 + (2 * mp + mm) * 16);
                    gw[mm][bj] = *(const GAS v4u*)(gates + row * GATEW + br * 1024 + col0 + bj * 128);
                    ow[mm][bj] = (v4u){0u, 0u, 0u, 0u}; if (!first) ow[mm][bj] = *(const GAS v4u*)(merged + row * D + col0 + bj * 128); }
#pragma unroll
            for (int mm = 0; mm < 2; ++mm)
#pragma unroll
                for (int bj = 0; bj < 2; ++bj) { const int m = 2 * mp + mm; const size_t row = (size_t)(row0 + ai * 128 + m * 16);
                    const f32x4 a0 = acc[ai][bj][m][0], a1 = acc[ai][bj][m][1];
                    float r[8];
#pragma unroll
                    for (int j = 0; j < 4; ++j) { const unsigned g2 = gw[mm][bj][j], o2 = ow[mm][bj][j]; const float av0 = j < 2 ? a0[2 * j] : a1[2 * j - 4], av1 = j < 2 ? a0[2 * j + 1] : a1[2 * j - 3];
                        r[2 * j] = __uint_as_float(g2 << 16) * av0 + __uint_as_float(o2 << 16); r[2 * j + 1] = __uint_as_float(g2 & 0xffff0000u) * av1 + __uint_as_float(o2 & 0xffff0000u); }
                    v4u w; w.x = pg8::cvt_pk_bf16(r[0], r[1]); w.y = pg8::cvt_pk_bf16(r[2], r[3]); w.z = pg8::cvt_pk_bf16(r[4], r[5]); w.w = pg8::cvt_pk_bf16(r[6], r[7]);
                    *(GAS v4u*)(merged + row * D + col0 + bj * 128) = w; }
            asm volatile("" ::: "memory"); }
    }
};
struct P3Order {
    pg8::DenseOrder Dn; const char* Abase; const char* wsb; size_t lofs;
    __device__ __forceinline__ bool next(int i, pg8::Unit& u) const { if (!Dn.next(i / 3, u)) return false; u.e = i % 3; u.ui = i; return true; }
    __device__ __forceinline__ const char* a_base(const pg8::Unit& u) const { const size_t ko = (size_t)((u.e + 1) >> 1) * 1024 + (size_t)(u.e >> 1) * 512; return Abase + ko + (size_t)u.pm * Dn.tstepA; }
    __device__ __forceinline__ int K_of(const pg8::Unit& u) const { return 512 - 256 * (u.e & 1); }
    __device__ __forceinline__ int ldb_of(const pg8::Unit& u) const { return 512 - 256 * (u.e & 1); }
    __device__ __forceinline__ const char* b_base(const pg8::Unit& u) const {
        const size_t kb = (size_t)(512 - 256 * (u.e & 1)) * 2;
        const size_t base = WS_WBRA + (size_t)((u.e + 1) >> 1) * (WS_WBRB - WS_WBRA) + (size_t)(u.e >> 1) * (WS_WBRC - WS_WBRB);
        return wsb + base + lofs * (size_t)D * kb + (size_t)u.pn * 256 * kb; }
    __device__ __forceinline__ int a_row(const pg8::Unit&, int) const { return 0; }
};
struct EpiP4 {
    static constexpr bool PERM = false;
    const float* hc; float* ho;
    __device__ __forceinline__ void operator()(const f32x4 (&acc)[2][2][4][2], const pg8::Unit& u, int wr, int wc, int fr, int fq) const {
        const int row0 = u.pm * 256 + wr * 64 + fr, col0 = u.pn * 256 + wc * 32 + 4 * fq;
#pragma unroll
        for (int ai = 0; ai < 2; ++ai)
#pragma unroll
            for (int mp = 0; mp < 2; ++mp) { f32x4 hv[2][2][2];
#pragma unroll
                for (int mm = 0; mm < 2; ++mm)
#pragma unroll
                    for (int bj = 0; bj < 2; ++bj)
#pragma unroll
                        for (int n = 0; n < 2; ++n) hv[mm][bj][n] = *(const GAS f32x4*)(hc + (size_t)(row0 + ai * 128 + (2 * mp + mm) * 16) * D + col0 + bj * 128 + n * 16);
#pragma unroll
                for (int mm = 0; mm < 2; ++mm)
#pragma unroll
                    for (int bj = 0; bj < 2; ++bj)
#pragma unroll
                        for (int n = 0; n < 2; ++n) *(GAS f32x4*)(ho + (size_t)(row0 + ai * 128 + (2 * mp + mm) * 16) * D + col0 + bj * 128 + n * 16) = hv[mm][bj][n] * ALPHA + acc[ai][bj][2 * mp + mm][n];
                asm volatile("" ::: "memory"); }
    }
};
struct EpiP7 {
    static constexpr bool PERM = true;
    bf16* hid;
    __device__ __forceinline__ void operator()(const f32x4 (&acc)[2][2][4][2], const pg8::Unit& u, int wr, int wc, int fr, int fq) const {
        const int row0 = u.pm * 256 + wr * 64 + fr, col0 = u.pn * 128 + wc * 32 + 8 * fq;
#pragma unroll
        for (int ai = 0; ai < 2; ++ai)
#pragma unroll
            for (int m = 0; m < 4; ++m) { float r[8];
#pragma unroll
                for (int n = 0; n < 2; ++n)
#pragma unroll
                    for (int j = 0; j < 4; ++j) { const float gv = acc[ai][0][m][n][j], uv = acc[ai][1][m][n][j]; r[4 * n + j] = gv * __builtin_amdgcn_rcpf(1.0f + __builtin_amdgcn_exp2f(-LOG2E * gv)) * uv; }
                v4u w; w.x = pg8::cvt_pk_bf16(r[0], r[1]); w.y = pg8::cvt_pk_bf16(r[2], r[3]); w.z = pg8::cvt_pk_bf16(r[4], r[5]); w.w = pg8::cvt_pk_bf16(r[6], r[7]);
                *(GAS v4u*)(hid + (size_t)(row0 + ai * 128 + m * 16) * DE + col0) = w; }
    }
};
struct EpiP8 {
    static constexpr bool PERM = true;
    bf16* yb; const int* rowtok; const float* rowgate;
    __device__ __forceinline__ void operator()(const f32x4 (&acc)[2][2][4][2], const pg8::Unit& u, int wr, int wc, int fr, int fq) const {
        const int row0 = u.pm * 256 + wr * 64 + fr, col0 = u.pn * 256 + wc * 32 + 8 * fq;
        int rt[2][4]; float gt[2][4];
#pragma unroll
        for (int ai = 0; ai < 2; ++ai)
#pragma unroll
            for (int m = 0; m < 4; ++m) { const int row = row0 + ai * 128 + m * 16; rt[ai][m] = *(const GAS int*)(rowtok + row); gt[ai][m] = *(const GAS float*)(rowgate + row); }
#pragma unroll
        for (int ai = 0; ai < 2; ++ai)
#pragma unroll
            for (int m = 0; m < 4; ++m) {
                if (rt[ai][m] >= 0) {
#pragma unroll
                    for (int bj = 0; bj < 2; ++bj) { const f32x4 v0 = acc[ai][bj][m][0] * gt[ai][m], v1 = acc[ai][bj][m][1] * gt[ai][m];
                        v4u w; w.x = pg8::cvt_pk_bf16(v0[0], v0[1]); w.y = pg8::cvt_pk_bf16(v0[2], v0[3]); w.z = pg8::cvt_pk_bf16(v1[0], v1[1]); w.w = pg8::cvt_pk_bf16(v1[2], v1[3]);
                        *(GAS v4u*)(yb + (size_t)rt[ai][m] * D + col0 + bj * 128) = w; } } }
    }
};

__device__ __forceinline__ void router_row(const float (&x)[16], int t, int lane, const LAS float* w_rg, const float* b_rg, const LAS float* w_re, const float* b_re, LAS int* lcnt, int wslot, Rec* rec) {
    float gl[4] = {0.f, 0.f, 0.f, 0.f};
#pragma unroll
    for (int j = 0; j < 4; ++j)
#pragma unroll
        for (int i = 0; i < 4; ++i) { const f32x4 w = *(const LAS f32x4*)(w_rg + ((j * 4 + i) * 64 + lane) * 4); const float xv = x[4 * j + i]; gl[0] += xv * w.x; gl[1] += xv * w.y; gl[2] += xv * w.z; gl[3] += xv * w.w; }
#pragma unroll
    for (int g = 0; g < 4; ++g) gl[g] = wave_sum_l(gl[g], lane) + b_rg[g];
    int gi = 0; float gm = gl[0];
#pragma unroll
    for (int g = 1; g < 4; ++g) if (gl[g] > gm) { gm = gl[g]; gi = g; }
    float gs = 0.f;
#pragma unroll
    for (int g = 0; g < 4; ++g) gs += __expf(gl[g] - gm);
    const float gw = 1.0f / gs;
    float el[8];
#pragma unroll
    for (int e = 0; e < 8; ++e) el[e] = 0.f;
    const LAS float* wre = w_re + gi * (D * 8);
#pragma unroll
    for (int j = 0; j < 4; ++j)
#pragma unroll
        for (int i = 0; i < 4; ++i) { const LAS float* wp = wre + ((j * 4 + i) * 128 + lane) * 4; const f32x4 w0 = *(const LAS f32x4*)wp, w1 = *(const LAS f32x4*)(wp + 256); const float xv = x[4 * j + i];
            el[0] += xv * w0.x; el[1] += xv * w0.y; el[2] += xv * w0.z; el[3] += xv * w0.w; el[4] += xv * w1.x; el[5] += xv * w1.y; el[6] += xv * w1.z; el[7] += xv * w1.w; }
#pragma unroll
    for (int e = 0; e < 8; ++e) el[e] = wave_sum_l(el[e], lane) + b_re[gi * 8 + e];
    int i0 = 0; float t0 = el[0];
#pragma unroll
    for (int e = 1; e < 8; ++e) if (el[e] > t0) { t0 = el[e]; i0 = e; }
    int i1 = -1; float t1 = -3.0e38f;
#pragma unroll
    for (int e = 0; e < 8; ++e) if (e != i0 && el[e] > t1) { t1 = el[e]; i1 = e; }
    const float ex = __expf(t1 - t0), p0 = 1.0f / (1.0f + ex), p1 = ex / (1.0f + ex);
    if (lane == 0) {
        const int e0 = gi * 8 + i0, e1 = gi * 8 + i1;
        const int s0 = __hip_atomic_fetch_add(lcnt + e0, 1, __ATOMIC_RELAXED, __HIP_MEMORY_SCOPE_WORKGROUP), s1 = __hip_atomic_fetch_add(lcnt + e1, 1, __ATOMIC_RELAXED, __HIP_MEMORY_SCOPE_WORKGROUP);
        GAS v4u* rp = (GAS v4u*)(rec + t);
        rp[0] = (v4u){(unsigned)e0, (unsigned)s0, (unsigned)e1, (unsigned)s1};
        rp[1] = (v4u){__float_as_uint(gw * p0), __float_as_uint(gw * p1), (unsigned)wslot, 0u};
    }
}

#ifndef STAG_P1
#define STAG_P1 500
#endif
__device__ __forceinline__ void stagger(int vcu, unsigned q) {
    const unsigned long long t0 = __builtin_amdgcn_s_memrealtime(); const unsigned long long d = (unsigned long long)((vcu & 3) * q);
    while (__builtin_amdgcn_s_memrealtime() - t0 < d) __builtin_amdgcn_s_sleep(8);
}
__device__ __forceinline__ void ph_ln0(Frame& F) { LAUNDER(F);
    const int gw = F.vcu * NWAVES + F.wave, NGW = F.G * NWAVES;
    bf16* hb = (bf16*)(F.ws + WS_HB);
    LnIn cur, nxt; if (gw < T) ln_load<0>(cur, F.in[0], nullptr, (size_t)gw, F.lane);
    for (int m = gw; m < T; m += NGW) { const bool more = m + NGW < T; if (more) ln_load<0>(nxt, F.in[0], nullptr, (size_t)(m + NGW), F.lane);
        f32x4 o[4]; ln_finish<0>(cur, F.h, hb, F.in[1], F.in[2], (size_t)m, F.lane, o); if (more) cur = nxt; }
}
__device__ __forceinline__ void ph_p1(Frame& F, int l, int c) { LAUNDER(F); asm volatile("" : "+s"(l), "+s"(c));
    pg8::DenseOrder S; S.init((const bf16*)(F.ws + WS_HB) + (size_t)c * CH * D, D, (const bf16*)(F.ws + WS_WIN) + (size_t)l * NCOL * D, D, CH, NCOL, F.G, (int)blockIdx.x);
    EpiP1 E{(bf16*)(F.ws + WS_QKV), (bf16*)(F.ws + WS_GATES), F.in[5] + (size_t)l * GATEW, F.probe};
    pg8::gemm_phase<EpiP1, pg8::DenseOrder, false>(F.lds + RING_OFF, S, E, D, D, D, F.tid);
}
__device__ __forceinline__ void ph_cmb(Frame& F) { LAUNDER(F);
    const bf16* og = (const bf16*)(F.ws + WS_OG); const float* lse = (const float*)(F.ws + WS_LSE); bf16* oabc = (bf16*)(F.ws + WS_OABC);
    for (int idx = F.vcu * NTHREADS + F.tid; idx < CH * 32; idx += F.G * NTHREADS) {
        const int tl = idx >> 5, hc = idx & 31, h = hc >> 3, c = hc & 7;
        const GAS float* lg = (const GAS float*)lse + (size_t)tl * 12 + h; const float l0 = lg[0], l1 = lg[4], l2 = lg[8];
        const float mx = fmaxf(l0, fmaxf(l1, l2)); float w0 = __expf(l0 - mx), w1 = __expf(l1 - mx), w2 = __expf(l2 - mx); const float inv = 1.0f / (w0 + w1 + w2); w0 *= inv; w1 *= inv; w2 *= inv;
        const v4u a = *(const GAS v4u*)(og + ((size_t)tl * 3 + 0) * 256 + h * 64 + c * 8), b = *(const GAS v4u*)(og + ((size_t)tl * 3 + 1) * 256 + h * 64 + c * 8), d = *(const GAS v4u*)(og + ((size_t)tl * 3 + 2) * 256 + h * 64 + c * 8);
        v4u ow;
#pragma unroll
        for (int i = 0; i < 4; ++i) {
            const float lo = w0 * __uint_as_float(a[i] << 16) + w1 * __uint_as_float(b[i] << 16) + w2 * __uint_as_float(d[i] << 16);
            const float hi = w0 * __uint_as_float(a[i] & 0xffff0000u) + w1 * __uint_as_float(b[i] & 0xffff0000u) + w2 * __uint_as_float(d[i] & 0xffff0000u);
            ow[i] = pk2(lo, hi);
        }
        *(GAS v4u*)(oabc + (size_t)tl * OW + 512 + h * 64 + c * 8) = ow;
    }
}
__device__ __forceinline__ void ph_p3(Frame& F, int l) { LAUNDER(F); asm volatile("" : "+s"(l));
    const bf16* oabc = (const bf16*)(F.ws + WS_OABC); bf16* merged = (bf16*)(F.ws + WS_MERGED); const bf16* gates = (const bf16*)(F.ws + WS_GATES);
    P3Order S; S.Dn.init(oabc, OW, nullptr, 0, CH, D, F.G, (int)blockIdx.x);
    S.Abase = (const char*)oabc; S.wsb = (const char*)F.ws; S.lofs = (size_t)l;
    EpiP3V E{merged, gates};
    pg8::gemm_phase_vk<EpiP3V, P3Order>(F.lds + RING_OFF, S, E, OW, F.tid);
}
__device__ __forceinline__ void ph_p4(Frame& F, int l, int c) { LAUNDER(F); asm volatile("" : "+s"(l), "+s"(c));
    pg8::DenseOrder S; S.init((const bf16*)(F.ws + WS_MERGED), D, (const bf16*)(F.ws + WS_WOUT) + (size_t)l * D * D, D, CH, D, F.G, (int)blockIdx.x);
    EpiP4 E{F.h + (size_t)c * CH * D, F.probe ? (float*)(F.ws + WS_OABC) : F.h + (size_t)c * CH * D};
    pg8::gemm_phase<EpiP4, pg8::DenseOrder, false>(F.lds + RING_OFF, S, E, D, D, D, F.tid);
}
__device__ __forceinline__ void ph_ln1(Frame& F, int l, int c) { LAUNDER(F); asm volatile("" : "+s"(l), "+s"(c));
    const int gw = F.vcu * NWAVES + F.wave, NGW = F.G * NWAVES;
    bf16* hb = (bf16*)(F.ws + WS_HB); Rec* rec = (Rec*)(F.ws + WS_REC);
    int* wgc = (int*)(F.ws + WS_WGCNT) + ((size_t)(l * NCHUNK + c) * F.G + F.vcu) * 32;
    float* hout = F.h;
    if (F.probe) { hout = (float*)(F.ws + WS_OABC) - (size_t)c * CH * D; hb = (bf16*)(F.ws + WS_QKV) - (size_t)c * CH * D; wgc = (int*)(F.ws + WS_WGCNT) + (size_t)DEPTH * NCHUNK * 256 * 32 + F.vcu * 32; rec = (Rec*)(F.ws + WS_GATES); }
    LAS float* lrg = (LAS float*)(F.lds + RING_OFF); LAS float* lre = lrg + D * 4; LAS int* lcnt = (LAS int*)(F.lds + LCNT_OFF);
    { const float* w_rg = F.in[14] + (size_t)l * D * 4; const float* w_re = F.in[16] + (size_t)l * 4 * D * 8;
      if (F.tid < 32) lcnt[F.tid] = 0;
      for (int u = F.tid; u < D + 4 * D * 2; u += NTHREADS) {
          if (u < D) { const int e = u, ln = (e & 255) >> 2, i = e & 3, j = e >> 8; *(LAS f32x4*)(lrg + ((j * 4 + i) * 64 + ln) * 4) = *(const GAS f32x4*)(w_rg + (size_t)e * 4); }
          else { const int v = u - D, half = v & 1, e = (v >> 1) & 1023, g = v >> 11, ln = (e & 255) >> 2, i = e & 3, j = e >> 8;
                 *(LAS f32x4*)(lre + g * (D * 8) + (((j * 4 + i) * 2 + half) * 64 + ln) * 4) = *(const GAS f32x4*)(w_re + ((size_t)g * D + e) * 8 + half * 4); } }
      __syncthreads(); }
    const size_t rbase = (size_t)c * CH;
    LnIn cur, nxt; if (gw < CH) ln_load<1>(cur, F.h, nullptr, rbase + gw, F.lane);
    for (int m = gw; m < CH; m += NGW) {
        const bool more = m + NGW < CH; if (more) ln_load<1>(nxt, F.h, nullptr, rbase + m + NGW, F.lane);
        const size_t row = rbase + m; f32x4 o[4];
        ln_finish<1>(cur, hout, hb, F.in[12] + l * D, F.in[13] + l * D, row, F.lane, o);
        float x[16];
#pragma unroll
        for (int j = 0; j < 4; ++j) { x[4 * j] = o[j].x; x[4 * j + 1] = o[j].y; x[4 * j + 2] = o[j].z; x[4 * j + 3] = o[j].w; }
        router_row(x, (int)row, F.lane, lrg, F.in[15] + l * 4, lre, F.in[17] + l * 32, lcnt, c * F.G + F.vcu, rec);
        if (more) cur = nxt;
    }
    __syncthreads();
    if (F.tid < 32) *(GAS int*)(wgc + F.tid) = lcnt[F.tid];
}
__device__ __forceinline__ void ph_dsp(Frame& F, int l) { LAUNDER(F); asm volatile("" : "+s"(l));
    LAS int* Tb = (LAS int*)(F.lds + RING_OFF); LAS int* part = Tb + 512 * 32; LAS int* po = part + 32 * 16;
    const int* wg = (const int*)(F.ws + WS_WGCNT) + (size_t)l * NCHUNK * F.G * 32; const int W = NCHUNK * F.G;
    int* cnt = (int*)(F.ws + WS_CTL) + CW_CNT + l * (32 * CSTR); const Rec* rec = (const Rec*)(F.ws + WS_REC); int* rowtok = (int*)(F.ws + WS_ROWTOK); float* rowgate = (float*)(F.ws + WS_ROWGATE);
    for (int i = F.tid; i < W * 32; i += NTHREADS) Tb[i] = *(const GAS int*)(wg + i);
    __syncthreads();
    const int e = F.tid >> 4, k = F.tid & 15, per = (W + 15) / 16, w0 = k * per, w1 = (w0 + per) < W ? (w0 + per) : W;
    { int s = 0; for (int w = w0; w < w1; ++w) s += Tb[w * 32 + e]; part[e * 16 + k] = s; }
    __syncthreads();
    { int base = 0; for (int kk = 0; kk < k; ++kk) base += part[e * 16 + kk];
      for (int w = w0; w < w1; ++w) { const int t = Tb[w * 32 + e]; Tb[w * 32 + e] = base; base += t; } }
    __syncthreads();
    if (F.tid == 0) { int acc = 0; for (int ee = 0; ee < NE; ++ee) { int tot = 0; for (int kk = 0; kk < 16; ++kk) tot += part[ee * 16 + kk]; po[ee] = acc; part[ee * 16] = tot; acc += (tot + 255) / 256 * 256; } po[NE] = acc; }
    __syncthreads();
    if (F.vcu == 0 && F.tid < 32) cnt[F.tid * CSTR] = part[F.tid * 16];
    const int gt = F.vcu * NTHREADS + F.tid, GT = F.G * NTHREADS;
    for (int t = gt; t < T; t += GT) {
        const GAS v4u* rp = (const GAS v4u*)(rec + t); const v4u ra = rp[0], rb = rp[1];
        Rec rc; rc.e0 = (int)ra.x; rc.s0 = (int)ra.y; rc.e1 = (int)ra.z; rc.s1 = (int)ra.w; rc.g0 = __uint_as_float(rb.x); rc.g1 = __uint_as_float(rb.y); rc.pad0 = (int)rb.z; rc.pad1 = 0;
        const int d0 = po[rc.e0] + Tb[rc.pad0 * 32 + rc.e0] + rc.s0, d1 = po[rc.e1] + Tb[rc.pad0 * 32 + rc.e1] + rc.s1;
        *(GAS int*)(rowtok + d0) = 2 * t; *(GAS float*)(rowgate + d0) = rc.g0; *(GAS int*)(rowtok + d1) = 2 * t + 1; *(GAS float*)(rowgate + d1) = rc.g1;
    }
    for (int ee = 0; ee < NE; ++ee) for (int r = po[ee] + part[ee * 16] + gt; r < po[ee + 1]; r += GT) { *(GAS int*)(rowtok + r) = -1; *(GAS float*)(rowgate + r) = 0.f; }
    __syncthreads();
}
__device__ __forceinline__ int moe_setup(Frame& F, int l, bool gather) { LAUNDER(F); asm volatile("" : "+s"(l));
    LAS int* rows = (LAS int*)(F.lds + ROWS_OFF); LAS int* ulist = rows + 11 * 256; LAS int* po = ulist + 16;
    const int* cnt = (const int*)(F.ws + WS_CTL) + CW_CNT + l * (32 * CSTR); const int* rowtok = (const int*)(F.ws + WS_ROWTOK);
    if (F.tid == 0) { int acc = 0; for (int e = 0; e < NE; ++e) { po[e] = acc; acc += (cnt[e * CSTR] + 255) / 256 * 256; } po[NE] = acc; }
    __syncthreads();
    const int nu_all = (po[NE] / 256) * 4; int nun = (nu_all - F.vcu + F.G - 1) / F.G; nun = nun < 0 ? 0 : (nun > 11 ? 11 : nun);
    if (F.tid < nun) { const int Lx = F.tid * F.G + F.vcu, rt = Lx >> 2, pn = Lx & 3; int e = 0; while (e < NE - 1 && po[e + 1] <= rt * 256) ++e; ulist[F.tid] = (rt << 8) | (e << 2) | pn; }
    if (gather) for (int idx = F.tid; idx < nun * 256; idx += NTHREADS) { const int i = idx >> 8, r = idx & 255, Lx = i * F.G + F.vcu; rows[idx] = *(const GAS int*)(rowtok + (Lx >> 2) * 256 + r); }
    __syncthreads();
    return nun;
}
struct MoeOrder {
    int nun; const LAS int* ulist; const LAS int* rows; const char* A; const char* B; size_t tstepA, estepB, tstepB;
    __device__ __forceinline__ bool next(int i, pg8::Unit& u) const {
        if (i >= nun) return false;
        const int w = __builtin_amdgcn_readfirstlane(ulist[i]); u.pm = w >> 8; u.e = (w >> 2) & 63; u.pn = w & 3; u.ui = i; return true;
    }
    __device__ __forceinline__ const char* a_base(const pg8::Unit& u) const { return A + (size_t)u.pm * tstepA; }
    __device__ __forceinline__ const char* b_base(const pg8::Unit& u) const { return B + (size_t)u.e * estepB + (size_t)u.pn * tstepB; }
    __device__ __forceinline__ int a_row(const pg8::Unit& u, int r) const { const int t = rows[u.ui * 256 + r]; return t < 0 ? 0 : (t >> 1); }
};
__device__ __forceinline__ void ph_p7(Frame& F, int l) { LAUNDER(F); asm volatile("" : "+s"(l));
    const int nun = moe_setup(F, l, true);
    LAS int* rows = (LAS int*)(F.lds + ROWS_OFF);
    MoeOrder S{nun, rows + 11 * 256, rows, (const char*)(F.ws + WS_HB), (const char*)(F.ws + WS_WGU) + (size_t)l * NE * 1024 * 1024 * 2, 0, (size_t)1024 * 1024 * 2, (size_t)256 * 1024 * 2};
    EpiP7 E{(bf16*)(F.ws + WS_HID)};
    pg8::gemm_phase<EpiP7, MoeOrder, true>(F.lds + RING_OFF, S, E, D, D, D, F.tid);
}
__device__ __forceinline__ void ph_p8(Frame& F, int l) { LAUNDER(F); asm volatile("" : "+s"(l));
    const int nun = moe_setup(F, l, false);
    LAS int* rows = (LAS int*)(F.lds + ROWS_OFF);
    MoeOrder S{nun, rows + 11 * 256, rows, (const char*)(F.ws + WS_HID), (const char*)(F.ws + WS_WD) + (size_t)l * NE * 1024 * 512 * 2, (size_t)256 * DE * 2, (size_t)1024 * 512 * 2, (size_t)256 * 512 * 2};
    EpiP8 E{(bf16*)(F.ws + WS_YB), (const int*)(F.ws + WS_ROWTOK), (const float*)(F.ws + WS_ROWGATE)};
    pg8::gemm_phase<EpiP8, MoeOrder, false>(F.lds + RING_OFF, S, E, DE, DE, DE, F.tid);
}
__device__ __forceinline__ void ph_ln2(Frame& F, int l) { LAUNDER(F); asm volatile("" : "+s"(l));
    const int gw = F.vcu * NWAVES + F.wave, NGW = F.G * NWAVES;
    bf16* hb = (l == DEPTH - 1) ? nullptr : (bf16*)(F.ws + WS_HB); const bf16* yb = (const bf16*)(F.ws + WS_YB);
    float* hout = F.h; size_t omask = ~(size_t)0;
    if (F.probe) { hout = (float*)(F.ws + WS_OABC); hb = nullptr; omask = 32767; }
    LnIn cur, nxt; if (gw < T) ln_load<2>(cur, F.h, yb, (size_t)gw, F.lane);
    for (int m = gw; m < T; m += NGW) { const bool more = m + NGW < T; if (more) ln_load<2>(nxt, F.h, yb, (size_t)(m + NGW), F.lane);
        f32x4 o[4]; ln_finish<2>(cur, hout - ((size_t)m - ((size_t)m & omask)) * D, hb, F.in[21] + l * D, F.in[22] + l * D, (size_t)m, F.lane, o); if (more) cur = nxt; }
}

typedef short s16x4 __attribute__((ext_vector_type(4)));
constexpr int NT_A = (CH / 32) * 4, NT_B = (CH / L) * 3 * 128 * 4, NT_C = (CH / 64) * 8, NT_ALL = NT_A + NT_B + NT_C;
constexpr float NEGBIG = -1.0e30f, MINIT = -5.0e29f;
#define RC16(reg) (((reg) & 3) + 8 * ((reg) >> 2))

__device__ __forceinline__ void ph_tables(Frame& F) { LAUNDER(F);
    float* TA = (float*)(F.ws + WS_TABA); float* TB = (float*)(F.ws + WS_TABB); float* TC = (float*)(F.ws + WS_TABC);
    const float* rel_bias = F.in[3]; const float* rpb = F.in[7];
    const int gt = F.vcu * NTHREADS + F.tid, GT = F.G * NTHREADS;
    for (int i = gt; i < 8 * 320; i += GT) { const int h = i / 320, rel = i % 320 - 160; TA[i] = (rel >= -128 && rel <= 128) ? rel_bias[BUCK_A[rel + 128] * 20 + h] * LOG2E : NEGBIG; }
    for (int i = gt; i < 12 * 256; i += GT) { const int gh = i >> 8, g = gh >> 2, rel = (i & 255) - 128; TB[i] = (rel >= -64 && rel <= 64) ? rel_bias[BUCK_B[g][rel + 64] * 20 + 8 + gh] * LOG2E : NEGBIG; }
    for (int i = gt; i < DEPTH * 8 * 1024; i += GT) { const int lh = i >> 10, ri = (i >> 6) & 15, ci = (i & 63) - 16; TC[i] = (ri < 15 && ci >= 0 && ci <= 30) ? rpb[((size_t)lh * 15 + ri) * 31 + ci] * LOG2E : NEGBIG; }
}

#define ATT_INIT(S, TBP, BIDX, XM) do { \
        _Pragma("unroll") for (int r_ = 0; r_ < 16; ++r_) { float v_ = (TBP)[(BIDX) + RC16(r_)]; if (TYPE == 2) v_ = ((unsigned)((XM) + RC16(r_)) < 16u) ? v_ : NEGBIG; S[r_] = v_; } } while (0)
#define ATT_TMAX(S, t) do { t = NEGBIG; _Pragma("unroll") for (int r_ = 0; r_ < 16; ++r_) t = fmaxf(t, S[r_]); } while (0)
#define ATT_RESCALE(need, t, m, l, Oa, Ob) do { const float mn_ = (need) ? (t) : m, corr_ = __builtin_amdgcn_exp2f(m - mn_); m = mn_; l *= corr_; \
        _Pragma("unroll") for (int i_ = 0; i_ < 16; ++i_) { Oa[i_] *= corr_; Ob[i_] *= corr_; } } while (0)
#define ATT_EXP(S, m, rs) do { rs = 0.f; _Pragma("unroll") for (int r_ = 0; r_ < 16; ++r_) { const float p_ = __builtin_amdgcn_exp2f(S[r_] - m); S[r_] = p_; rs += p_; } } while (0)
#define ATT_PACK(Pf, S, s2) do { unsigned pw_[4]; _Pragma("unroll") for (int j_ = 0; j_ < 4; ++j_) pw_[j_] = pg8::cvt_pk_bf16(S[8 * (s2) + 2 * j_], S[8 * (s2) + 2 * j_ + 1]); \
        Pf = __builtin_bit_cast(bf16x8, (v4u){pw_[0], pw_[1], pw_[2], pw_[3]}); } while (0)
#define ATT_STORE(orow, Oa, Ob, l) do { const float inv_ = 1.0f / (l); \
        _Pragma("unroll") for (int g_ = 0; g_ < 4; ++g_) { v2u w0_, w1_; \
            w0_.x = pg8::cvt_pk_bf16(Oa[4 * g_] * inv_, Oa[4 * g_ + 1] * inv_); w0_.y = pg8::cvt_pk_bf16(Oa[4 * g_ + 2] * inv_, Oa[4 * g_ + 3] * inv_); \
            w1_.x = pg8::cvt_pk_bf16(Ob[4 * g_] * inv_, Ob[4 * g_ + 1] * inv_); w1_.y = pg8::cvt_pk_bf16(Ob[4 * g_ + 2] * inv_, Ob[4 * g_ + 3] * inv_); \
            *(GAS v2u*)((orow) + 8 * g_ + 4 * hh) = w0_; *(GAS v2u*)((orow) + 32 + 8 * g_ + 4 * hh) = w1_; } } while (0)

template <int TYPE>
__device__ __forceinline__ void att_task2(LAS unsigned char* wl, const int lane, const bf16* seq  , const float* tab0, const float* tab1,
                                          const int qcol0, const int qcol1, const int kcol, const int vcol, const int TT0, const int TSTEP, const int kstride, const int tlo, const int thi,
                                          const int tq0, const int tq1  , const int toff1  ,
                                          const int gi0, const int gi1, const int gc, const int cbs  ,
                                          const float m_init0, const float m_init1, const float l_init, bf16* orow0, bf16* orow1, float* lse0, float* lse1) {
    const int qi = lane & 31, hh = lane >> 5;
    LAS unsigned char* kt = wl; LAS unsigned char* vt = wl + 4096; LAS float* tb0 = (LAS float*)(wl + 8192); LAS float* tb1 = (TYPE == 0) ? tb0 + 320 : tb0;
    constexpr int TBN = TYPE == 0 ? 320 : (TYPE == 1 ? 256 : 1024);
#pragma unroll
    for (int i = 0; i < TBN / 64; ++i) { tb0[lane + 64 * i] = *(const GAS float*)(tab0 + lane + 64 * i); if (TYPE == 0) tb1[lane + 64 * i] = *(const GAS float*)(tab1 + lane + 64 * i); }
    bf16x8 Qa[4], Qb[4];
#pragma unroll
    for (int s = 0; s < 4; ++s) { Qa[s] = *(const GAS bf16x8*)(seq + (size_t)tq0 * QKVW + qcol0 + 16 * s + 8 * hh); Qb[s] = *(const GAS bf16x8*)(seq + (size_t)tq1 * QKVW + qcol1 + 16 * s + 8 * hh); }
    f32x16 O0a, O0b, O1a, O1b;
#pragma unroll
    for (int i = 0; i < 16; ++i) { O0a[i] = 0.f; O0b[i] = 0.f; O1a[i] = 0.f; O1b[i] = 0.f; }
    float m0 = m_init0, m1 = m_init1, l0 = l_init, l1 = l_init;
    const int lkey = lane >> 3, lch = lane & 7;
    const unsigned goff = (unsigned)(lkey * kstride) * (unsigned)(QKVW * 2) + 16u * (unsigned)lch;
    const size_t istepb = (size_t)8 * kstride * QKVW * 2;
    const char* kbase = (const char*)(seq + kcol); const char* vbase = (const char*)(seq + vcol);
    const unsigned kw0 = lkey * 128 + ((lch ^ (lkey & 7)) << 4), vw0 = lkey * 128 + (((lch >> 2) ^ ((lkey >> 1) & 1)) << 6) + ((lch & 3) << 4);
    const unsigned kr0 = qi * 128 + ((hh ^ (qi & 7)) << 4);
    const int q4 = (lane & 15) >> 2, p4 = lane & 3, g1 = (lane >> 4) & 1, sw = (q4 >> 1) & 1;
    const unsigned vr0 = (4 * hh + q4) * 128 + 32 * g1 + 8 * p4 + (sw << 6), vr1 = (4 * hh + q4) * 128 + 32 * g1 + 8 * p4 + ((sw ^ 1) << 6);
    const int bidx0 = (TYPE == 2) ? (cbs - gc + 31 + 4 * hh) : ((TYPE == 1 ? 64 : 32) - qi + 4 * hh);
    int cs = gc - 8; cs = cs < 0 ? 0 : (cs > 48 ? 48 : cs);
    const int xm = cbs - cs + 4 * hh;
    int rs0 = gi0 - 4; rs0 = rs0 < 0 ? 0 : (rs0 > 120 ? 120 : rs0);
    int rs1 = gi1 - 4; rs1 = rs1 < 0 ? 0 : (rs1 > 120 ? 120 : rs1);
    v4u kreg[4], vreg[4];
    {
        const size_t tb_ = (size_t)(TT0 + tlo * TSTEP) * (QKVW * 2);
#pragma unroll
        for (int i = 0; i < 4; ++i) { kreg[i] = *(const GAS v4u*)(kbase + tb_ + i * istepb + goff); vreg[i] = *(const GAS v4u*)(vbase + tb_ + i * istepb + goff); }
    }
    for (int ti = tlo; ti <= thi; ++ti) {
#pragma unroll
        for (int i = 0; i < 4; ++i) { *(LAS v4u*)(kt + kw0 + 1024 * i) = kreg[i]; *(LAS v4u*)(vt + vw0 + 1024 * i) = vreg[i]; }
        if (ti < thi) {
            const size_t tb_ = (size_t)(TT0 + (ti + 1) * TSTEP) * (QKVW * 2);
#pragma unroll
            for (int i = 0; i < 4; ++i) { kreg[i] = *(const GAS v4u*)(kbase + tb_ + i * istepb + goff); vreg[i] = *(const GAS v4u*)(vbase + tb_ + i * istepb + goff); }
        }
        int bi0, bi1;
        if (TYPE == 2) { const bool rv0 = (ti >= rs0) && (ti < rs0 + 8), rv1 = (ti >= rs1) && (ti < rs1 + 8); bi0 = bidx0 + (rv0 ? (ti - gi0 + 7) : 15) * 64; bi1 = bidx0 + (rv1 ? (ti - gi1 + 7) : 15) * 64; }
        else { bi0 = bidx0 + 32 * ti; bi1 = bidx0 + 32 * (ti - toff1); }
        f32x16 S0, S1;
        ATT_INIT(S0, tb0, bi0, xm); ATT_INIT(S1, tb1, bi1, xm);
#pragma unroll
        for (int s = 0; s < 4; ++s) { const bf16x8 Kf = *(const LAS bf16x8*)(kt + (kr0 ^ (unsigned)(s << 5)));
            S0 = __builtin_amdgcn_mfma_f32_32x32x16_bf16(Kf, Qa[s], S0, 0, 0, 0); S1 = __builtin_amdgcn_mfma_f32_32x32x16_bf16(Kf, Qb[s], S1, 0, 0, 0); }
        float t0, t1; ATT_TMAX(S0, t0); ATT_TMAX(S1, t1);
        t0 = fmaxf(t0, shfl_xor_l(t0, 32, lane)); t1 = fmaxf(t1, shfl_xor_l(t1, 32, lane));
        const bool need0 = t0 > m0 + 8.0f, need1 = t1 > m1 + 8.0f;
        if (__builtin_amdgcn_ballot_w64(need0 || need1) != 0ull) { ATT_RESCALE(need0, t0, m0, l0, O0a, O0b); ATT_RESCALE(need1, t1, m1, l1, O1a, O1b); }
        float rs0, rs1; ATT_EXP(S0, m0, rs0); ATT_EXP(S1, m1, rs1);
        rs0 += shfl_xor_l(rs0, 32, lane); rs1 += shfl_xor_l(rs1, 32, lane);
        l0 += rs0; l1 += rs1;
#pragma unroll
        for (int s2 = 0; s2 < 2; ++s2) {
            bf16x8 P0, P1; ATT_PACK(P0, S0, s2); ATT_PACK(P1, S1, s2);
            const s16x4 a00 = __builtin_amdgcn_ds_read_tr16_b64_v4i16((LAS s16x4*)(vt + vr0 + (16 * s2) * 128));
            const s16x4 a01 = __builtin_amdgcn_ds_read_tr16_b64_v4i16((LAS s16x4*)(vt + vr0 + (16 * s2 + 8) * 128));
            const s16x4 a10 = __builtin_amdgcn_ds_read_tr16_b64_v4i16((LAS s16x4*)(vt + vr1 + (16 * s2) * 128));
            const s16x4 a11 = __builtin_amdgcn_ds_read_tr16_b64_v4i16((LAS s16x4*)(vt + vr1 + (16 * s2 + 8) * 128));
            const bf16x8 V0 = (bf16x8){a00[0], a00[1], a00[2], a00[3], a01[0], a01[1], a01[2], a01[3]};
            const bf16x8 V1 = (bf16x8){a10[0], a10[1], a10[2], a10[3], a11[0], a11[1], a11[2], a11[3]};
            O0a = __builtin_amdgcn_mfma_f32_32x32x16_bf16(V0, P0, O0a, 0, 0, 0); O0b = __builtin_amdgcn_mfma_f32_32x32x16_bf16(V1, P0, O0b, 0, 0, 0);
            O1a = __builtin_amdgcn_mfma_f32_32x32x16_bf16(V0, P1, O1a, 0, 0, 0); O1b = __builtin_amdgcn_mfma_f32_32x32x16_bf16(V1, P1, O1b, 0, 0, 0);
        }
    }
    ATT_STORE(orow0, O0a, O0b, l0);
    ATT_STORE(orow1, O1a, O1b, l1);
    if (TYPE == 1 && hh == 0) { *(GAS float*)lse0 = (m0 + __builtin_amdgcn_logf(l0)) * LN2; *(GAS float*)lse1 = (m1 + __builtin_amdgcn_logf(l1)) * LN2; }
}

__device__ __forceinline__ void ph_att(Frame& F, int l) { LAUNDER(F); asm volatile("" : "+s"(l));
    LAS unsigned char* wl = F.lds + RING_OFF + F.wave * 16384;
    const bf16* qkv = (const bf16*)(F.ws + WS_QKV); bf16* oabc = (bf16*)(F.ws + WS_OABC); bf16* og = (bf16*)(F.ws + WS_OG); float* lse = (float*)(F.ws + WS_LSE);
    const float* TA = (const float*)(F.ws + WS_TABA); const float* TB = (const float*)(F.ws + WS_TABB); const float* TC = (const float*)(F.ws + WS_TABC) + (size_t)l * 8 * 1024;
    const float* sink = F.in[6] + l * 8;
    const int gw = F.vcu * NWAVES + F.wave, NGW = F.G * NWAVES;
    for (int task = gw; task < NT_ALL; task += NGW) {
        int lane = F.lane; asm volatile("" : "+v"(lane)); const int qi = lane & 31;
        if (task < NT_A) {
            const int hp = task & 3, qb = (task >> 2) & 255, b = task >> 10, q0 = qb * 32, h0 = hp * 2, h1 = h0 + 1, kvh = hp >> 1;
            int tlo = 0, thi = 8; if (q0 - 128 < 0) tlo = (128 - q0) / 32; if (q0 + 128 + 31 >= L) thi = (L - 1 - (q0 - 128)) / 32;
            const int tq = q0 + qi; bf16* orow = oabc + (size_t)(b * L + tq) * OW;
            att_task2<0>(wl, lane, qkv + (size_t)b * L * QKVW, TA + h0 * 320, TA + h1 * 320, AQ + h0 * 64, AQ + h1 * 64, AK + kvh * 64, AV + kvh * 64, q0 - 128, 32, 1, tlo, thi,
                         tq, tq, 0, 0, 0, 0, 0, sink[h0] * LOG2E, sink[h1] * LOG2E, 1.0f, orow + h0 * 64, orow + h1 * 64, nullptr, nullptr);
        } else if (task < NT_A + NT_B) {
            const int j = task - NT_A, h = j & 3, sbi = (j >> 2) & 127, bg = j >> 9, g = bg % 3, b = bg / 3;
            const int dsh = 2 * g, d = 1 << dsh, nsb = 128 >> dsh, r = sbi / nsb, sb = sbi % nsb, q0 = sb * 64, Ls = L >> dsh;
            int tlo = 0, thi = 5; if (q0 - 64 < 0) tlo = (64 - q0) / 32; if (q0 + 32 + 64 + 31 >= Ls) thi = (Ls - 1 - (q0 - 64)) / 32;
            const int tq0 = (q0 + qi) * d + r, tq1 = (q0 + 32 + qi) * d + r, qc = BQ0 + 768 * g + h * 64;
            att_task2<1>(wl, lane, qkv + (size_t)b * L * QKVW, TB + (g * 4 + h) * 256, nullptr, qc, qc, qc + 256, qc + 512, (q0 - 64) * d + r, 32 * d, d, tlo, thi,
                         tq0, tq1, 1, 0, 0, 0, 0, MINIT, MINIT, 0.0f, og + ((size_t)(b * L + tq0) * 3 + g) * 256 + h * 64, og + ((size_t)(b * L + tq1) * 3 + g) * 256 + h * 64,
                         lse + ((size_t)(b * L + tq0) * 3 + g) * 4 + h, lse + ((size_t)(b * L + tq1) * 3 + g) * 4 + h);
        } else {
            const int j = task - NT_A - NT_B, h = j & 7, cbi = (j >> 3) & 127, b = j >> 10, ip = cbi >> 2, cb = cbi & 3;
            const int gi0 = 4 * ip + (qi >> 4), gi1 = gi0 + 2, gc = 16 * cb + (qi & 15), tq0 = gi0 * 64 + gc, tq1 = gi1 * 64 + gc;
            int cbs = 16 * cb - 8; cbs = cbs < 0 ? 0 : (cbs > 32 ? 32 : cbs);
            int rlo = 4 * ip - 4; rlo = rlo < 0 ? 0 : (rlo > 120 ? 120 : rlo);
            int rhi = 4 * ip + 3 - 4; rhi = rhi < 0 ? 0 : (rhi > 120 ? 120 : rhi); rhi += 7;
            bf16* ob = oabc + (size_t)(b * L) * OW + 768 + h * 64;
            att_task2<2>(wl, lane, qkv + (size_t)b * L * QKVW, TC + h * 1024, nullptr, CQ + h * 64, CQ + h * 64, CK + h * 64, CV + h * 64, cbs, 64, 1, rlo, rhi,
                         tq0, tq1, 0, gi0, gi1, gc, cbs, MINIT, MINIT, 0.0f, ob + (size_t)tq0 * OW, ob + (size_t)tq1 * OW, nullptr, nullptr);
        }
    }
}

constexpr int NSTEPS = 1 + DEPTH * 16;
__global__ void __launch_bounds__(NTHREADS, 2) mk_fwd(Args args) {
    extern __shared__ __attribute__((aligned(16))) unsigned char lds[];
    Frame F;
    F.lds = (LAS unsigned char*)lds; F.wave = __builtin_amdgcn_readfirstlane((int)threadIdx.x >> 6); F.lane = hw_lane(); F.tid = F.wave * 64 + F.lane;
    F.G = gridDim.x; { const int bx = blockIdx.x; F.vcu = (F.G % 8 == 0) ? (bx % 8) * (F.G / 8) + bx / 8 : bx; }
    F.in = args.in; F.h = args.out; F.ws = args.ws; F.probe = args.probe;
    volatile LAS unsigned* MISC = (volatile LAS unsigned*)(F.lds + MISC_OFF);
    if (F.tid < 32) MISC[F.tid] = 0u;
    __syncthreads();
    const int lo = args.s_lo, hi = args.s_hi;
    XcdBarrier bar; bar.wave0 = (F.wave == 0); bar.bar = (unsigned*)(F.ws + WS_CTL) + CW_BAR; bar.x = 0; bar.st = nullptr;
    if (hi - lo > 1) bar = xcd_barrier_post((unsigned*)(F.ws + WS_CTL) + CW_BAR, MISC + 8, F.wave == 0);
#define RUN(s) (lo <= (s) && (s) < hi)
#define SEAM(s) do { if (RUN(s) && RUN((s) + 1)) xcd_barrier(bar); } while (0)
    if (RUN(0)) { ph_prologue(F); ph_tables(F); ph_ln0(F); }
    SEAM(0);
    for (int l = 0; l < DEPTH; ++l) {
        const int sb = 1 + l * 16;
        for (int c = 0; c < NCHUNK; ++c) {
            const int s = sb + c * 6;
            if (RUN(s)) ph_p1(F, l, c);
            SEAM(s);
            if (RUN(s + 1)) ph_att(F, l);
            SEAM(s + 1);
            if (RUN(s + 2)) ph_cmb(F);
            SEAM(s + 2);
            if (RUN(s + 3)) ph_p3(F, l);
            SEAM(s + 3);
            if (RUN(s + 4)) ph_p4(F, l, c);
            SEAM(s + 4);
            if (RUN(s + 5)) ph_ln1(F, l, c);
            SEAM(s + 5);
        }
        if (RUN(sb + 12)) ph_dsp(F, l);
        SEAM(sb + 12);
        if (RUN(sb + 13)) ph_p7(F, l);
        SEAM(sb + 13);
        if (RUN(sb + 14)) ph_p8(F, l);
        SEAM(sb + 14);
        if (RUN(sb + 15)) ph_ln2(F, l);
        SEAM(sb + 15);
    }
#undef RUN
#undef SEAM
}

#ifndef DUP_NOEPI
#define DUP_NOEPI 0
#endif
#ifndef FAST_MASK
#define FAST_MASK 0x7FF
#endif
#ifndef ONE_LAUNCH
#define ONE_LAUNCH 1
#endif
extern "C" void kernel_launch(void* const* d_in, const int* in_sizes, int n_in, void* d_out, int out_size, void* d_ws, size_t ws_size, hipStream_t stream) {
    static int grid = 0;
    if (grid == 0) {
        if (n_in != 23 || out_size != T * D || ws_size < WS_END) { fprintf(stderr, "kernel_launch: unexpected shapes (n_in %d out %d ws %zu)\n", n_in, out_size, ws_size); grid = -1; return; }
        int dev = 0, cus = 0, per_cu = 0;
        if (hipGetDevice(&dev) != hipSuccess || hipDeviceGetAttribute(&cus, hipDeviceAttributeMultiprocessorCount, dev) != hipSuccess) { grid = -1; return; }
        if (hipFuncSetAttribute((const void*)mk_fwd, hipFuncAttributeMaxDynamicSharedMemorySize, LDS_BYTES) != hipSuccess) { fprintf(stderr, "kernel_launch: hipFuncSetAttribute failed\n"); grid = -1; return; }
        if (hipOccupancyMaxActiveBlocksPerMultiprocessor(&per_cu, (const void*)mk_fwd, NTHREADS, LDS_BYTES) != hipSuccess || per_cu < 1) fprintf(stderr, "kernel_launch: occupancy query reports %d\n", per_cu);
        (void)hipGetLastError();
        grid = cus;
    }
    if (grid < 0) return;
    const float* x = (const float*)d_in[0]; const float* ln0_g = (const float*)d_in[1]; const float* ln0_b = (const float*)d_in[2]; const float* rel_bias = (const float*)d_in[3];
    const float* w_in = (const float*)d_in[4]; const float* b_gate = (const float*)d_in[5]; const float* sink_a = (const float*)d_in[6]; const float* rpb_c = (const float*)d_in[7];
    const float* w_br_a = (const float*)d_in[8]; const float* w_br_b = (const float*)d_in[9]; const float* w_br_c = (const float*)d_in[10]; const float* w_out = (const float*)d_in[11];
    const float* ln1_g = (const float*)d_in[12]; const float* ln1_b = (const float*)d_in[13]; const float* w_rg = (const float*)d_in[14]; const float* b_rg = (const float*)d_in[15];
    const float* w_re = (const float*)d_in[16]; const float* b_re = (const float*)d_in[17]; const float* w_eg = (const float*)d_in[18]; const float* w_eu = (const float*)d_in[19];
    const float* w_ed = (const float*)d_in[20]; const float* ln2_g = (const float*)d_in[21]; const float* ln2_b = (const float*)d_in[22];
    unsigned char* ws = (unsigned char*)d_ws; float* h = (float*)d_out;
    bf16* hb = (bf16*)(ws + WS_HB); bf16* qkv = (bf16*)(ws + WS_QKV); bf16* gates = (bf16*)(ws + WS_GATES); bf16* oabc = (bf16*)(ws + WS_OABC); bf16* og = (bf16*)(ws + WS_OG);
    float* lse = (float*)(ws + WS_LSE); Rec* rec = (Rec*)(ws + WS_REC); int* rowtok = (int*)(ws + WS_ROWTOK); float* rowgate = (float*)(ws + WS_ROWGATE);
    bf16* merged = (bf16*)(ws + WS_MERGED); bf16* hid = (bf16*)(ws + WS_HID); bf16* yb = (bf16*)(ws + WS_YB); int* cnt = (int*)(ws + WS_CTL) + CW_CNT;
    (void)hipMemsetAsync(ws + WS_CTL, 0, CTL_ZERO_BYTES, stream);
    Args a{};
    for (int i = 0; i < 23; ++i) a.in[i] = (const float*)d_in[i];
    a.out = h; a.ws = ws;
    if (ONE_LAUNCH) { a.s_lo = 0; a.s_hi = NSTEPS; hipLaunchKernelGGL(mk_fwd, dim3(grid), dim3(NTHREADS), LDS_BYTES, stream, a); return; }
    const int G = 2048;
    const bool fastp1 = (FAST_MASK >> 1) & 1;
    for (int s = 0; s < NSTEPS; ++s) {
        int kind, l = 0, c = 0;
        if (s == 0) kind = 0; else { const int r = (s - 1) % 16; l = (s - 1) / 16; if (r < 12) { c = r / 6; kind = 1 + r % 6; } else kind = 7 + (r - 12); }
        if ((FAST_MASK >> kind) & 1) { a.s_lo = s; a.s_hi = s + 1;
#ifdef DUP_KIND
            if (kind == DUP_KIND && (kind == 5 || kind == 6 || kind == 10 || (kind == 1 && DUP_NOEPI))) { a.probe = 1; hipLaunchKernelGGL(mk_fwd, dim3(grid), dim3(NTHREADS), LDS_BYTES, stream, a); a.probe = 0; }
#endif
            hipLaunchKernelGGL(mk_fwd, dim3(grid), dim3(NTHREADS), LDS_BYTES, stream, a);
#ifdef DUP_KIND
            if (kind == DUP_KIND && !(kind == 5 || kind == 6 || kind == 10 || (kind == 1 && DUP_NOEPI))) { hipLaunchKernelGGL(mk_fwd, dim3(grid), dim3(NTHREADS), LDS_BYTES, stream, a); }
#endif
            continue; }
        const size_t r0 = (size_t)c * CH;
        switch (kind) {
        case 0: k_ln<<<G, 256, 0, stream>>>(0, x, h, hb, nullptr, ln0_g, ln0_b, 0, T); break;
        case 1: k_p1<<<G, 256, 0, stream>>>(hb + r0 * D, w_in + (size_t)l * D * NCOL, b_gate + (size_t)l * GATEW, qkv, gates); break;
        case 2: k_attn_naive<<<(28 * CH + 255) / 256, 256, 0, stream>>>(qkv, oabc, og, lse, rel_bias, sink_a + l * 8, rpb_c + (size_t)l * 8 * 15 * 31, fastp1 ? LN2 : 0.125f); break;
        case 3: k_combine<<<(CH * 32 + 255) / 256, 256, 0, stream>>>(og, lse, oabc); break;
        case 4: k_p3<<<G, 256, 0, stream>>>(oabc, gates, w_br_a + (size_t)l * 512 * D, w_br_b + (size_t)l * 256 * D, w_br_c + (size_t)l * 512 * D, merged); break;
        case 5: k_p4<<<G, 256, 0, stream>>>(merged, w_out + (size_t)l * D * D, h + r0 * D); break;
        case 6: k_ln<<<G, 256, 0, stream>>>(1, nullptr, h, hb, nullptr, ln1_g + l * D, ln1_b + l * D, (int)r0, CH);
                if (c == NCHUNK - 1) k_router<<<G, 256, 0, stream>>>(h, w_rg + (size_t)l * D * 4, b_rg + l * 4, w_re + (size_t)l * 4 * D * 8, b_re + l * 32, cnt + l * (32 * CSTR), rec);
                break;
        case 7: (void)hipMemsetAsync(rowtok, 0xFF, (size_t)PROWS * 4, stream); k_dispatch<<<256, 256, 0, stream>>>(cnt + l * (32 * CSTR), rec, rowtok, rowgate); break;
        case 8: k_p7<<<G, 256, 0, stream>>>(hb, cnt + l * (32 * CSTR), rowtok, w_eg + (size_t)l * NE * D * DE, w_eu + (size_t)l * NE * D * DE, hid); break;
        case 9: k_p8<<<G, 256, 0, stream>>>(hid, cnt + l * (32 * CSTR), rowtok, rowgate, w_ed + (size_t)l * NE * DE * D, yb); break;
        case 10: k_ln<<<G, 256, 0, stream>>>(2, nullptr, h, (l == DEPTH - 1) ? nullptr : hb, yb, ln2_g + l * D, ln2_b + l * D, 0, T); break;
        }
    }
}
```

```cpp
#include <hip/hip_runtime.h>
#include <cstdio>
#include <cstdint>
#include <cmath>

typedef unsigned short bf16;
typedef short bf16x8 __attribute__((ext_vector_type(8)));
typedef float f32x16 __attribute__((ext_vector_type(16)));
typedef float f32x4 __attribute__((ext_vector_type(4)));

constexpr int D = 1024, L = 8192, NBATCH = 8, T = NBATCH * L, DEPTH = 2;
constexpr int NCOL = 7680, QKVW = 4608, GATEW = 3072;
constexpr int CH = 32768, NCHUNK = T / CH;
constexpr int OW = 1280;
constexpr int NE = 32, DE = 512;
constexpr int MAXRT = T * 2 / 256 + NE, PROWS = MAXRT * 256;
constexpr float LN_EPS = 1e-5f;
constexpr float ALPHA = 1.41421356237309515f;
constexpr int AQ = 0, AK = 512, AV = 640, BQ0 = 768, CQ = 3072, CK = 3584, CV = 4096;

constexpr size_t MiB = 1u << 20;
constexpr size_t WS_CTL = 0;
constexpr size_t WS_WIN = 1 * MiB, WS_WBRA = 31 * MiB, WS_WBRB = 33 * MiB, WS_WBRC = 34 * MiB, WS_WOUT = 36 * MiB, WS_WGU = 40 * MiB, WS_WD = 168 * MiB;
constexpr size_t WS_HB = 232 * MiB, WS_QKV = 360 * MiB, WS_GATES = 648 * MiB, WS_OABC = 840 * MiB, WS_OG = 920 * MiB, WS_LSE = 968 * MiB,
                 WS_REC = 970 * MiB, WS_ROWTOK = 972 * MiB, WS_ROWGATE = 973 * MiB, WS_TABA = 974 * MiB, WS_TABB = WS_TABA + 16384, WS_TABC = WS_TABA + 32768, WS_WGCNT = WS_TABA + 131072  , WS_END = 975 * MiB;
constexpr size_t WS_MERGED = WS_QKV, WS_HID = WS_QKV, WS_YB = WS_QKV + 136 * MiB;
constexpr int CSTR = 32;

__device__ __constant__ signed char BUCK_A[257] = {12,11,11,11,11,11,11,11,11,11,11,11,11,11,11,11,11,11,11,11,11,11,11,11,11,11,11,11,11,11,11,11,11,11,11,11,11,11,11,11,11,11,11,11,11,11,11,11,11,11,11,11,11,11,11,11,11,11,11,11,11,11,11,11,11,10,10,10,10,10,10,10,10,10,10,10,10,10,10,10,10,10,10,10,10,10,10,10,10,10,10,10,10,10,10,10,10,9,9,9,9,9,9,9,9,9,9,9,9,9,9,9,9,8,8,8,8,8,8,8,8,7,6,5,4,3,2,1,0,17,18,19,20,21,22,23,24,24,24,24,24,24,24,24,25,25,25,25,25,25,25,25,25,25,25,25,25,25,25,25,26,26,26,26,26,26,26,26,26,26,26,26,26,26,26,26,26,26,26,26,26,26,26,26,26,26,26,26,26,26,26,26,27,27,27,27,27,27,27,27,27,27,27,27,27,27,27,27,27,27,27,27,27,27,27,27,27,27,27,27,27,27,27,27,27,27,27,27,27,27,27,27,27,27,27,27,27,27,27,27,27,27,27,27,27,27,27,27,27,27,27,27,27,27,27,27,28};
__device__ __constant__ signed char BUCK_B[3][129] = {
 {11,10,10,10,10,10,10,10,10,10,10,10,10,10,10,10,10,10,10,10,10,10,10,10,10,10,10,10,10,10,10,10,10,9,9,9,9,9,9,9,9,9,9,9,9,9,9,9,9,8,8,8,8,8,8,8,8,7,6,5,4,3,2,1,0,17,18,19,20,21,22,23,24,24,24,24,24,24,24,24,25,25,25,25,25,25,25,25,25,25,25,25,25,25,25,25,26,26,26,26,26,26,26,26,26,26,26,26,26,26,26,26,26,26,26,26,26,26,26,26,26,26,26,26,26,26,26,26,27},
 {13,12,12,12,12,12,12,12,12,12,12,12,12,12,12,12,12,12,12,12,12,12,12,12,12,12,12,12,12,12,12,12,12,11,11,11,11,11,11,11,11,11,11,11,11,11,11,11,11,10,10,10,10,10,10,10,10,9,9,9,9,8,8,4,0,20,24,24,25,25,25,25,26,26,26,26,26,26,26,26,27,27,27,27,27,27,27,27,27,27,27,27,27,27,27,27,28,28,28,28,28,28,28,28,28,28,28,28,28,28,28,28,28,28,28,28,28,28,28,28,28,28,28,28,28,28,28,28,29},
 {15,14,14,14,14,14,14,14,14,14,14,14,14,14,14,14,14,14,14,14,14,14,14,14,14,14,14,14,14,14,14,14,14,13,13,13,13,13,13,13,13,13,13,13,13,13,13,13,13,12,12,12,12,12,12,12,12,11,11,11,11,10,10,9,0,25,26,26,27,27,27,27,28,28,28,28,28,28,28,28,29,29,29,29,29,29,29,29,29,29,29,29,29,29,29,29,30,30,30,30,30,30,30,30,30,30,30,30,30,30,30,30,30,30,30,30,30,30,30,30,30,30,30,30,30,30,30,30,31}};

__device__ __forceinline__ float bf2f(bf16 b) { return __uint_as_float(((unsigned)b) << 16); }
__device__ __forceinline__ bf16 f2bf(float f) { unsigned u = __float_as_uint(f); u += 0x7fffu + ((u >> 16) & 1u); return (bf16)(u >> 16); }
__device__ __forceinline__ float wave_sum(float v) {
#pragma unroll
    for (int o = 1; o < 64; o <<= 1) v += __shfl_xor(v, o);
    return v;
}

__global__ __launch_bounds__(256) void k_ln(int mode, const float* src, float* h, bf16* hb, const bf16* yb, const float* g, const float* bta, int row0, int nrows) {
    const int lane = threadIdx.x & 63, wv = blockIdx.x * 4 + (threadIdx.x >> 6), nw = gridDim.x * 4;
    for (int rr = wv; rr < nrows; rr += nw) {
        const size_t row = (size_t)row0 + rr;
        f32x4 v[4];
#pragma unroll
        for (int j = 0; j < 4; ++j) {
            const int c = lane * 4 + 256 * j;
            v[j] = *(const f32x4*)((mode == 0 ? src : h) + row * D + c);
            if (mode == 2) {
                const uint2 a = *(const uint2*)(yb + (row * 2) * D + c), b = *(const uint2*)(yb + (row * 2 + 1) * D + c);
                v[j].x = ALPHA * v[j].x + bf2f((bf16)(a.x & 0xffff)) + bf2f((bf16)(b.x & 0xffff));
                v[j].y = ALPHA * v[j].y + bf2f((bf16)(a.x >> 16)) + bf2f((bf16)(b.x >> 16));
                v[j].z = ALPHA * v[j].z + bf2f((bf16)(a.y & 0xffff)) + bf2f((bf16)(b.y & 0xffff));
                v[j].w = ALPHA * v[j].w + bf2f((bf16)(a.y >> 16)) + bf2f((bf16)(b.y >> 16));
            }
        }
        float s = 0.f;
#pragma unroll
        for (int j = 0; j < 4; ++j) s += (v[j].x + v[j].y) + (v[j].z + v[j].w);
        const float mean = wave_sum(s) * (1.f / D);
        float q = 0.f;
#pragma unroll
        for (int j = 0; j < 4; ++j) { v[j] = v[j] - mean; q += (v[j].x * v[j].x + v[j].y * v[j].y) + (v[j].z * v[j].z + v[j].w * v[j].w); }
        const float rstd = 1.0f / sqrtf(wave_sum(q) * (1.f / D) + LN_EPS);
#pragma unroll
        for (int j = 0; j < 4; ++j) {
            const int c = lane * 4 + 256 * j;
            const f32x4 gg = *(const f32x4*)(g + c), bb = *(const f32x4*)(bta + c);
            const f32x4 o = v[j] * rstd * gg + bb;
            *(f32x4*)(h + row * D + c) = o;
            if (hb) { uint2 w; w.x = (unsigned)f2bf(o.x) | ((unsigned)f2bf(o.y) << 16); w.y = (unsigned)f2bf(o.z) | ((unsigned)f2bf(o.w) << 16); *(uint2*)(hb + row * D + c) = w; }
        }
    }
}

__device__ __forceinline__ void wave_gemm32(const bf16* arow, const float* wcol, int ldw, int K, f32x16& acc) {
    for (int k0 = 0; k0 < K; k0 += 16) {
        const bf16x8 a = *(const bf16x8*)(arow + k0);
        bf16x8 b;
#pragma unroll
        for (int j = 0; j < 8; ++j) b[j] = (short)f2bf(wcol[(size_t)(k0 + j) * ldw]);
        acc = __builtin_amdgcn_mfma_f32_32x32x16_bf16(a, b, acc, 0, 0, 0);
    }
}
#define ACC_ROW(reg, h) (((reg) & 3) + 8 * ((reg) >> 2) + 4 * (h))

__global__ __launch_bounds__(256) void k_p1(const bf16* hbc, const float* w_in, const float* b_gate, bf16* qkv, bf16* gates) {
    const int lane = threadIdx.x & 63, r = lane & 31, hh = lane >> 5;
    const int wv = blockIdx.x * 4 + (threadIdx.x >> 6), nw = gridDim.x * 4;
    const int ntn = NCOL / 32, total = (CH / 32) * ntn;
    for (int tile = wv; tile < total; tile += nw) {
        const int tm = tile / ntn, tn = tile % ntn;
        f32x16 acc; for (int i = 0; i < 16; ++i) acc[i] = 0.f;
        wave_gemm32(hbc + (size_t)(tm * 32 + r) * D + 8 * hh, w_in + (size_t)(8 * hh) * NCOL + tn * 32 + r, NCOL, D, acc);
        const int col = tn * 32 + r;
#pragma unroll
        for (int i = 0; i < 16; ++i) {
            const int row = tm * 32 + ACC_ROW(i, hh);
            if (col < QKVW) qkv[(size_t)row * QKVW + col] = f2bf(acc[i]);
            else { const float z = acc[i] + b_gate[col - QKVW]; gates[(size_t)row * GATEW + (col - QKVW)] = f2bf(1.0f / (1.0f + __expf(-z))); }
        }
    }
}

__global__ __launch_bounds__(256) void k_attn_naive(const bf16* qkv, bf16* oabc, bf16* og, float* lse, const float* rel_bias, const float* sink_l, const float* rpb_l, float sc) {
    const long idx = (long)blockIdx.x * 256 + threadIdx.x;
    if (idx >= (long)28 * CH) return;
    const int ht = (int)(idx / CH), tl = (int)(idx % CH), b = tl / L, t = tl % L;
    const bf16* base = qkv + (size_t)(b * L) * QKVW;
    int qcol, kcol, vcol;
    if (ht < 8) { qcol = AQ + ht * 64; kcol = AK + (ht >> 2) * 64; vcol = AV + (ht >> 2) * 64; }
    else if (ht < 20) { const int g = (ht - 8) >> 2, h = (ht - 8) & 3; qcol = BQ0 + 768 * g + h * 64; kcol = qcol + 256; vcol = qcol + 512; }
    else { const int h = ht - 20; qcol = CQ + h * 64; kcol = CK + h * 64; vcol = CV + h * 64; }
    float q[64], o[64];
    {
        const uint4* qp = (const uint4*)(base + (size_t)t * QKVW + qcol);
#pragma unroll
        for (int c = 0; c < 8; ++c) { const uint4 u = qp[c]; const unsigned w[4] = {u.x, u.y, u.z, u.w};
#pragma unroll
            for (int i = 0; i < 4; ++i) { q[8 * c + 2 * i] = bf2f((bf16)(w[i] & 0xffff)); q[8 * c + 2 * i + 1] = bf2f((bf16)(w[i] >> 16)); } }
    }
#pragma unroll
    for (int i = 0; i < 64; ++i) o[i] = 0.f;
    float m = -1e30f, l = 0.f;
    if (ht < 8) { m = sink_l[ht]; l = 1.f; }
#define PROC_KEY(KT, BIAS) do { \
        const uint4* kp = (const uint4*)(base + (size_t)(KT) * QKVW + kcol); float s = 0.f; \
        _Pragma("unroll") for (int c = 0; c < 8; ++c) { const uint4 u = kp[c]; const unsigned w[4] = {u.x, u.y, u.z, u.w}; \
            _Pragma("unroll") for (int i = 0; i < 4; ++i) { s += q[8 * c + 2 * i] * bf2f((bf16)(w[i] & 0xffff)); s += q[8 * c + 2 * i + 1] * bf2f((bf16)(w[i] >> 16)); } } \
        s = s * sc + (BIAS); const float mn = fmaxf(m, s), corr = __expf(m - mn), p = __expf(s - mn); l = l * corr + p; m = mn; \
        const uint4* vp = (const uint4*)(base + (size_t)(KT) * QKVW + vcol); \
        _Pragma("unroll") for (int c = 0; c < 8; ++c) { const uint4 u = vp[c]; const unsigned w[4] = {u.x, u.y, u.z, u.w}; \
            _Pragma("unroll") for (int i = 0; i < 4; ++i) { o[8 * c + 2 * i] = o[8 * c + 2 * i] * corr + p * bf2f((bf16)(w[i] & 0xffff)); o[8 * c + 2 * i + 1] = o[8 * c + 2 * i + 1] * corr + p * bf2f((bf16)(w[i] >> 16)); } } \
    } while (0)
    if (ht < 8) {
        for (int rel = -128; rel <= 128; ++rel) { const int kt = t + rel; if (kt < 0 || kt >= L) continue;
            const float bias = rel_bias[BUCK_A[rel + 128] * 20 + ht]; PROC_KEY(kt, bias); }
    } else if (ht < 20) {
        const int g = (ht - 8) >> 2, h = (ht - 8) & 3, dil = (g == 0) ? 1 : (g == 1 ? 4 : 16);
        for (int off = -64; off <= 64; ++off) { const int kt = t + off * dil; if (kt < 0 || kt >= L) continue;
            const float bias = rel_bias[BUCK_B[g][off + 64] * 20 + 8 + 4 * g + h]; PROC_KEY(kt, bias); }
    } else {
        const int h = ht - 20, gi = t >> 6, gc = t & 63;
        int rs = gi - 4; rs = rs < 0 ? 0 : (rs > 120 ? 120 : rs);
        int cs = gc - 8; cs = cs < 0 ? 0 : (cs > 48 ? 48 : cs);
        for (int kr = rs; kr < rs + 8; ++kr)
            for (int kc = cs; kc < cs + 16; ++kc) { const float bias = rpb_l[(h * 15 + (kr - gi + 7)) * 31 + (kc - gc + 15)]; const int kt = kr * 64 + kc; PROC_KEY(kt, bias); }
    }
#undef PROC_KEY
    const float inv = 1.0f / l;
    bf16* dst;
    if (ht < 8) dst = oabc + (size_t)tl * OW + ht * 64;
    else if (ht < 20) { const int g = (ht - 8) >> 2, h = (ht - 8) & 3; dst = og + ((size_t)tl * 3 + g) * 256 + h * 64; lse[((size_t)tl * 3 + g) * 4 + h] = m + __logf(l); }
    else dst = oabc + (size_t)tl * OW + 768 + (ht - 20) * 64;
#pragma unroll
    for (int c = 0; c < 8; ++c) { uint4 u;
        u.x = (unsigned)f2bf(o[8 * c + 0] * inv) | ((unsigned)f2bf(o[8 * c + 1] * inv) << 16); u.y = (unsigned)f2bf(o[8 * c + 2] * inv) | ((unsigned)f2bf(o[8 * c + 3] * inv) << 16);
        u.z = (unsigned)f2bf(o[8 * c + 4] * inv) | ((unsigned)f2bf(o[8 * c + 5] * inv) << 16); u.w = (unsigned)f2bf(o[8 * c + 6] * inv) | ((unsigned)f2bf(o[8 * c + 7] * inv) << 16);
        ((uint4*)dst)[c] = u; }
}

__global__ __launch_bounds__(256) void k_combine(const bf16* og, const float* lse, bf16* oabc) {
    const long idx = (long)blockIdx.x * 256 + threadIdx.x;
    if (idx >= (long)CH * 32) return;
    const int tl = (int)(idx >> 5), hc = (int)(idx & 31), h = hc >> 3, c = hc & 7;
    const float l0 = lse[((size_t)tl * 3 + 0) * 4 + h], l1 = lse[((size_t)tl * 3 + 1) * 4 + h], l2 = lse[((size_t)tl * 3 + 2) * 4 + h];
    const float mx = fmaxf(l0, fmaxf(l1, l2)); float w0 = __expf(l0 - mx), w1 = __expf(l1 - mx), w2 = __expf(l2 - mx); const float inv = 1.0f / (w0 + w1 + w2); w0 *= inv; w1 *= inv; w2 *= inv;
    const uint4 a = *(const uint4*)(og + ((size_t)tl * 3 + 0) * 256 + h * 64 + c * 8), b = *(const uint4*)(og + ((size_t)tl * 3 + 1) * 256 + h * 64 + c * 8), d = *(const uint4*)(og + ((size_t)tl * 3 + 2) * 256 + h * 64 + c * 8);
    const unsigned aw[4] = {a.x, a.y, a.z, a.w}, bw[4] = {b.x, b.y, b.z, b.w}, dw[4] = {d.x, d.y, d.z, d.w}; unsigned ow[4];
#pragma unroll
    for (int i = 0; i < 4; ++i) {
        const float lo = w0 * bf2f((bf16)(aw[i] & 0xffff)) + w1 * bf2f((bf16)(bw[i] & 0xffff)) + w2 * bf2f((bf16)(dw[i] & 0xffff));
        const float hi = w0 * bf2f((bf16)(aw[i] >> 16)) + w1 * bf2f((bf16)(bw[i] >> 16)) + w2 * bf2f((bf16)(dw[i] >> 16));
        ow[i] = (unsigned)f2bf(lo) | ((unsigned)f2bf(hi) << 16);
    }
    *(uint4*)(oabc + (size_t)tl * OW + 512 + h * 64 + c * 8) = make_uint4(ow[0], ow[1], ow[2], ow[3]);
}

__global__ __launch_bounds__(256) void k_p3(const bf16* oabc, const bf16* gates, const float* wa, const float* wb, const float* wc, bf16* merged) {
    const int lane = threadIdx.x & 63, r = lane & 31, hh = lane >> 5;
    const int wv = blockIdx.x * 4 + (threadIdx.x >> 6), nw = gridDim.x * 4;
    const int ntn = D / 32, total = (CH / 32) * ntn;
    for (int tile = wv; tile < total; tile += nw) {
        const int tm = tile / ntn, tn = tile % ntn, col = tn * 32 + r;
        f32x16 mg; for (int i = 0; i < 16; ++i) mg[i] = 0.f;
#pragma unroll 1
        for (int br = 0; br < 3; ++br) {
            f32x16 acc; for (int i = 0; i < 16; ++i) acc[i] = 0.f;
            const int koff = br == 0 ? 0 : (br == 1 ? 512 : 768), K = br == 1 ? 256 : 512;
            const float* w = br == 0 ? wa : (br == 1 ? wb : wc);
            wave_gemm32(oabc + (size_t)(tm * 32 + r) * OW + koff + 8 * hh, w + (size_t)(8 * hh) * D + col, D, K, acc);
#pragma unroll
            for (int i = 0; i < 16; ++i) { const int row = tm * 32 + ACC_ROW(i, hh); mg[i] += bf2f(gates[(size_t)row * GATEW + br * 1024 + col]) * acc[i]; }
        }
#pragma unroll
        for (int i = 0; i < 16; ++i) { const int row = tm * 32 + ACC_ROW(i, hh); merged[(size_t)row * D + col] = f2bf(mg[i]); }
    }
}
__global__ __launch_bounds__(256) void k_p4(const bf16* merged, const float* wo, float* hchunk) {
    const int lane = threadIdx.x & 63, r = lane & 31, hh = lane >> 5;
    const int wv = blockIdx.x * 4 + (threadIdx.x >> 6), nw = gridDim.x * 4;
    const int ntn = D / 32, total = (CH / 32) * ntn;
    for (int tile = wv; tile < total; tile += nw) {
        const int tm = tile / ntn, tn = tile % ntn, col = tn * 32 + r;
        f32x16 acc; for (int i = 0; i < 16; ++i) acc[i] = 0.f;
        wave_gemm32(merged + (size_t)(tm * 32 + r) * D + 8 * hh, wo + (size_t)(8 * hh) * D + col, D, D, acc);
#pragma unroll
        for (int i = 0; i < 16; ++i) { const int row = tm * 32 + ACC_ROW(i, hh); float* p = hchunk + (size_t)row * D + col; *p = ALPHA * *p + acc[i]; }
    }
}

struct Rec { int e0, s0, e1, s1; float g0, g1; int pad0, pad1; };
__global__ __launch_bounds__(256) void k_router(const float* h, const float* w_rg, const float* b_rg, const float* w_re, const float* b_re, int* cnt, Rec* rec) {
    const int lane = threadIdx.x & 63, wv = blockIdx.x * 4 + (threadIdx.x >> 6), nw = gridDim.x * 4;
    for (int t = wv; t < T; t += nw) {
        float x[16];
#pragma unroll
        for (int j = 0; j < 4; ++j) { const f32x4 v = *(const f32x4*)(h + (size_t)t * D + lane * 4 + 256 * j); x[4 * j] = v.x; x[4 * j + 1] = v.y; x[4 * j + 2] = v.z; x[4 * j + 3] = v.w; }
        float gl[4] = {0.f, 0.f, 0.f, 0.f};
#pragma unroll
        for (int j = 0; j < 4; ++j)
#pragma unroll
            for (int i = 0; i < 4; ++i) { const f32x4 w = *(const f32x4*)(w_rg + (size_t)(lane * 4 + 256 * j + i) * 4); const float xv = x[4 * j + i]; gl[0] += xv * w.x; gl[1] += xv * w.y; gl[2] += xv * w.z; gl[3] += xv * w.w; }
#pragma unroll
        for (int g = 0; g < 4; ++g) gl[g] = wave_sum(gl[g]) + b_rg[g];
        int gi = 0; float gm = gl[0];
#pragma unroll
        for (int g = 1; g < 4; ++g) if (gl[g] > gm) { gm = gl[g]; gi = g; }
        float gs = 0.f;
#pragma unroll
        for (int g = 0; g < 4; ++g) gs += __expf(gl[g] - gm);
        const float gw = 1.0f / gs;
        float el[8];
#pragma unroll
        for (int e = 0; e < 8; ++e) el[e] = 0.f;
        const float* wre = w_re + (size_t)gi * D * 8;
#pragma unroll
        for (int j = 0; j < 4; ++j)
#pragma unroll
            for (int i = 0; i < 4; ++i) { const float* wp = wre + (size_t)(lane * 4 + 256 * j + i) * 8; const f32x4 w0 = *(const f32x4*)wp, w1 = *(const f32x4*)(wp + 4); const float xv = x[4 * j + i];
                el[0] += xv * w0.x; el[1] += xv * w0.y; el[2] += xv * w0.z; el[3] += xv * w0.w; el[4] += xv * w1.x; el[5] += xv * w1.y; el[6] += xv * w1.z; el[7] += xv * w1.w; }
#pragma unroll
        for (int e = 0; e < 8; ++e) el[e] = wave_sum(el[e]) + b_re[gi * 8 + e];
        int i0 = 0; float t0 = el[0];
#pragma unroll
        for (int e = 1; e < 8; ++e) if (el[e] > t0) { t0 = el[e]; i0 = e; }
        int i1 = -1; float t1 = -3.0e38f;
#pragma unroll
        for (int e = 0; e < 8; ++e) if (e != i0 && el[e] > t1) { t1 = el[e]; i1 = e; }
        const float ex = __expf(t1 - t0), p0 = 1.0f / (1.0f + ex), p1 = ex / (1.0f + ex);
        if (lane == 0) {
            Rec rc; rc.e0 = gi * 8 + i0; rc.e1 = gi * 8 + i1; rc.g0 = gw * p0; rc.g1 = gw * p1; rc.pad0 = 0; rc.pad1 = 0;
            rc.s0 = atomicAdd(cnt + rc.e0 * CSTR, 1); rc.s1 = atomicAdd(cnt + rc.e1 * CSTR, 1);
            rec[t] = rc;
        }
    }
}
__device__ __forceinline__ void pad_offsets(const int* cnt, int* po) { int acc = 0; for (int e = 0; e < NE; ++e) { po[e] = acc; acc += (cnt[e * CSTR] + 255) / 256 * 256; } po[NE] = acc; }
__global__ __launch_bounds__(256) void k_dispatch(const int* cnt, const Rec* rec, int* rowtok, float* rowgate) {
    __shared__ int po[NE + 1];
    if (threadIdx.x == 0) pad_offsets(cnt, po);
    __syncthreads();
    for (int t = blockIdx.x * 256 + threadIdx.x; t < T; t += gridDim.x * 256) {
        const Rec rc = rec[t];
        const int d0 = po[rc.e0] + rc.s0, d1 = po[rc.e1] + rc.s1;
        rowtok[d0] = 2 * t; rowgate[d0] = rc.g0; rowtok[d1] = 2 * t + 1; rowgate[d1] = rc.g1;
    }
}
__global__ __launch_bounds__(256) void k_p7(const bf16* hb, const int* cnt, const int* rowtok, const float* w_eg, const float* w_eu, bf16* hid) {
    __shared__ int po[NE + 1];
    if (threadIdx.x == 0) pad_offsets(cnt, po);
    __syncthreads();
    const int lane = threadIdx.x & 63, r = lane & 31, hh = lane >> 5;
    const int wv = blockIdx.x * 4 + (threadIdx.x >> 6), nw = gridDim.x * 4;
    const int ntn = DE / 32, total = (po[NE] / 32) * ntn;
    for (int tile = wv; tile < total; tile += nw) {
        const int tm = tile / ntn, tn = tile % ntn, col = tn * 32 + r, row0 = tm * 32;
        int e = 0; while (e < NE - 1 && po[e + 1] <= row0) ++e;
        int tok = rowtok[row0 + r]; tok = tok < 0 ? 0 : (tok >> 1);
        f32x16 ag, au; for (int i = 0; i < 16; ++i) { ag[i] = 0.f; au[i] = 0.f; }
        wave_gemm32(hb + (size_t)tok * D + 8 * hh, w_eg + (size_t)e * D * DE + (size_t)(8 * hh) * DE + col, DE, D, ag);
        wave_gemm32(hb + (size_t)tok * D + 8 * hh, w_eu + (size_t)e * D * DE + (size_t)(8 * hh) * DE + col, DE, D, au);
#pragma unroll
        for (int i = 0; i < 16; ++i) { const int row = row0 + ACC_ROW(i, hh); const float gsl = ag[i] / (1.0f + __expf(-ag[i])); hid[(size_t)row * DE + col] = f2bf(gsl * au[i]); }
    }
}
__global__ __launch_bounds__(256) void k_p8(const bf16* hid, const int* cnt, const int* rowtok, const float* rowgate, const float* w_ed, bf16* yb) {
    __shared__ int po[NE + 1];
    if (threadIdx.x == 0) pad_offsets(cnt, po);
    __syncthreads();
    const int lane = threadIdx.x & 63, r = lane & 31, hh = lane >> 5;
    const int wv = blockIdx.x * 4 + (threadIdx.x >> 6), nw = gridDim.x * 4;
    const int ntn = D / 32, total = (po[NE] / 32) * ntn;
    for (int tile = wv; tile < total; tile += nw) {
        const int tm = tile / ntn, tn = tile % ntn, col = tn * 32 + r, row0 = tm * 32;
        int e = 0; while (e < NE - 1 && po[e + 1] <= row0) ++e;
        f32x16 acc; for (int i = 0; i < 16; ++i) acc[i] = 0.f;
        wave_gemm32(hid + (size_t)(row0 + r) * DE + 8 * hh, w_ed + (size_t)e * DE * D + (size_t)(8 * hh) * D + col, D, DE, acc);
#pragma unroll
        for (int i = 0; i < 16; ++i) { const int row = row0 + ACC_ROW(i, hh); const int rt = rowtok[row]; if (rt >= 0) yb[(size_t)rt * D + col] = f2bf(acc[i] * rowgate[row]); }
    }
}


namespace pg8 {
#define PG8_LAS __attribute__((address_space(3)))
typedef unsigned short bf16_t;
typedef unsigned u32x4 __attribute__((ext_vector_type(4)));
constexpr int BM = 256, BK = 64, HALF = 128, HTB = HALF * BK * 2  , STAGE_BYTES = 8 * HTB, NXCD = 8, WGM = 8;

__host__ __device__ __forceinline__ int lds_byte(int r, int c) { const int st = (r >> 4) * 2 + (c >> 5), rr = r & 15, cc = c & 31, ob = rr * 64 + cc * 2; return st * 1024 + (ob ^ (((ob >> 9) & 1) << 5)); }
__host__ __device__ __forceinline__ void stage_rc(int b, int& R, int& C) { const int st = b / 1024, sb = b % 1024, swz = sb ^ (((sb >> 9) & 1) << 5); R = (st >> 1) * 16 + swz / 64; C = (st & 1) * 32 + (swz % 64) / 2; }
__host__ __device__ __forceinline__ int perm32(int rho) { const int n = rho >> 4, i = rho & 15; return 8 * (i >> 2) + 4 * n + (i & 3); }

struct Unit { int pm, pn, e, ui; };

struct DenseOrder {
    int nM, nN, nwg, G, c; const char* A; const char* B; size_t tstepA, tstepB;
    __device__ void init(const void* A_, int lda, const void* B_, int ldb, int M, int N, int G_, int c_) { nM = M / BM; nN = N / BM; nwg = nM * nN; G = G_; c = c_; A = (const char*)A_; B = (const char*)B_; tstepA = (size_t)BM * lda * 2; tstepB = (size_t)BM * ldb * 2; }
    __device__ bool next(int i, Unit& u) const {
        const long Lx = (long)i * G + c; if (Lx >= nwg) return false;
        int wgid = (int)Lx; { const int q = nwg / NXCD, r = nwg % NXCD, xcd = wgid % NXCD, off = wgid / NXCD; wgid = (xcd < r ? xcd * (q + 1) : r * (q + 1) + (xcd - r) * q) + off; }
        const int nig = WGM * nN, gid = wgid / nig, fm = gid * WGM, gsz = (nM - fm) < WGM ? (nM - fm) : WGM;
        u.pm = fm + ((wgid % nig) % gsz); u.pn = (wgid % nig) / gsz; u.e = 0; u.ui = i; return true;
    }
    __device__ __forceinline__ const char* a_base(const Unit& u) const { return A + (size_t)u.pm * tstepA; }
    __device__ __forceinline__ const char* b_base(const Unit& u) const { return B + (size_t)u.pn * tstepB; }
    __device__ __forceinline__ int a_row(const Unit&, int) const { return 0; }
};

__device__ __forceinline__ unsigned cvt_pk_bf16(float lo, float hi) { unsigned r; asm volatile("v_cvt_pk_bf16_f32 %0, %1, %2" : "=v"(r) : "v"(lo), "v"(hi)); return r; }

template <class Epi, class Sched, bool GATHER>
__device__ __forceinline__ void gemm_phase(PG8_LAS unsigned char* lds, const Sched& S, const Epi& E, const int K, const int lda, const int ldb, const int tid_in) {
    int tid = tid_in; asm volatile("" : "+v"(tid));
    const int wid = __builtin_amdgcn_readfirstlane(tid >> 6), lane = tid & 63, wr = wid >> 2, wc = wid & 3, fr = lane & 15, fq = lane >> 4;
    const int nt = K / BK;
    int RA[2], CA[2]; unsigned voffB[2];
#pragma unroll
    for (int i = 0; i < 2; ++i) { int R, C; stage_rc(tid * 16 + i * 8192, R, C); const int Rb = Epi::PERM ? ((R & ~31) + perm32(R & 31)) : R; RA[i] = R; CA[i] = C; voffB[i] = (unsigned)(Rb * ldb + C) * 2u; }
    const size_t kstep = (size_t)(BK * 2);
    const size_t hstepB = (size_t)HALF * ldb * 2;
    const unsigned ldsw = (unsigned)wid * 1024u;
    const int aoff = lds_byte(wr * 64 + fr, fq * 8), boff = lds_byte(wc * 32 + fr, fq * 8);
#define PG8_SA(b, h) (((b) * 2 + (h)) * HTB)
#define PG8_SB(b, h) ((4 + (b) * 2 + (h)) * HTB)
#define PG8_STAGE2(bufoff, gbase, v0, v1) do { \
        __builtin_amdgcn_global_load_lds((const unsigned*)((const char*)(gbase) + (v0)), (PG8_LAS unsigned*)(lds + (bufoff) + ldsw), 16, 0, 0); \
        __builtin_amdgcn_global_load_lds((const unsigned*)((const char*)(gbase) + (v1)), (PG8_LAS unsigned*)(lds + (bufoff) + ldsw + 8192), 16, 0, 0); } while (0)
#define PG8_STAGEB(bufoff, gbase) PG8_STAGE2(bufoff, gbase, voffB[0], voffB[1])
#define PG8_LDA(dst, b, h) do { _Pragma("unroll") for (int m = 0; m < 4; ++m) _Pragma("unroll") for (int k = 0; k < 2; ++k) dst[m][k] = *(const PG8_LAS bf16x8*)(lds + PG8_SA(b, h) + aoff + m * 2048 + k * 1024); } while (0)
#define PG8_LDB(dst, b, h) do { _Pragma("unroll") for (int n = 0; n < 2; ++n) _Pragma("unroll") for (int k = 0; k < 2; ++k) dst[n][k] = *(const PG8_LAS bf16x8*)(lds + PG8_SB(b, h) + boff + n * 2048 + k * 1024); } while (0)
#define PG8_MMA(ai, bj, At, Bt) do { __builtin_amdgcn_s_setprio(1); _Pragma("unroll") for (int m = 0; m < 4; ++m) _Pragma("unroll") for (int n = 0; n < 2; ++n) _Pragma("unroll") for (int k = 0; k < 2; ++k) \
        acc[ai][bj][m][n] = __builtin_amdgcn_mfma_f32_16x16x32_bf16(Bt[n][k], At[m][k], acc[ai][bj][m][n], 0, 0, 0); __builtin_amdgcn_s_setprio(0); } while (0)
#define PG8_WAIT_V(n) asm volatile("s_waitcnt vmcnt(" #n ")" ::: "memory")
#define PG8_WAIT_L(n) asm volatile("s_waitcnt lgkmcnt(" #n ")" ::: "memory")
#define PG8_BAR __builtin_amdgcn_s_barrier()
#define PG8_SCHED __builtin_amdgcn_sched_barrier(0)
#define PG8_VOFFA(dst, u) do { _Pragma("unroll") for (int h_ = 0; h_ < 2; ++h_) _Pragma("unroll") for (int i_ = 0; i_ < 2; ++i_) { \
        const int row_ = GATHER ? S.a_row(u, h_ * HALF + RA[i_]) : (h_ * HALF + RA[i_]); dst[h_][i_] = (unsigned)(row_ * lda + CA[i_]) * 2u; } } while (0)
    Unit cur, nxt;
    if (!S.next(0, cur)) return;
    f32x4 acc[2][2][4][2];
#pragma unroll
    for (int a = 0; a < 2; ++a)
#pragma unroll
        for (int b = 0; b < 2; ++b)
#pragma unroll
            for (int m = 0; m < 4; ++m)
#pragma unroll
                for (int n = 0; n < 2; ++n) acc[a][b][m][n] = (f32x4){0.f, 0.f, 0.f, 0.f};
    bf16x8 At[4][2], B0[2][2], B1[2][2];
    unsigned vc[2][2], vn[2][2];
    PG8_VOFFA(vc, cur);
    const char* cA = S.a_base(cur); const char* cB = S.b_base(cur);
    PG8_STAGEB(PG8_SB(0, 0), cB); PG8_STAGEB(PG8_SB(0, 1), cB + hstepB); PG8_STAGE2(PG8_SA(0, 0), cA, vc[0][0], vc[0][1]); PG8_STAGE2(PG8_SA(0, 1), cA, vc[1][0], vc[1][1]);
    if (wr == 1) PG8_BAR;
    PG8_WAIT_V(2); PG8_BAR;
    PG8_STAGEB(PG8_SB(1, 0), cB + kstep); PG8_STAGE2(PG8_SA(1, 0), cA + kstep, vc[0][0], vc[0][1]); PG8_STAGEB(PG8_SB(1, 1), cB + hstepB + kstep);
    PG8_WAIT_V(6); PG8_BAR;
    int ui = 0;
    for (;;) {
        const bool has_next = S.next(ui + 1, nxt);
        const char* nA = has_next ? S.a_base(nxt) : cA; const char* nB = has_next ? S.b_base(nxt) : cB;
        if (GATHER) { if (has_next) { PG8_VOFFA(vn, nxt); } else {
#pragma unroll
            for (int h_ = 0; h_ < 2; ++h_) { vn[h_][0] = vc[h_][0]; vn[h_][1] = vc[h_][1]; } } }
        for (int t = 0; t < nt; t += 2) {
            const bool last = (t == nt - 2);
            const char* a1 = cA + (size_t)(t + 1) * kstep;
            const char* a2 = last ? nA : cA + (size_t)(t + 2) * kstep; const char* b2 = last ? nB : cB + (size_t)(t + 2) * kstep;
            const char* a3 = a2 + kstep; const char* b3 = b2 + kstep;
            unsigned w00, w01, w10, w11;
            if (GATHER) { w00 = last ? vn[0][0] : vc[0][0]; w01 = last ? vn[0][1] : vc[0][1]; w10 = last ? vn[1][0] : vc[1][0]; w11 = last ? vn[1][1] : vc[1][1]; }
            else { w00 = vc[0][0]; w01 = vc[0][1]; w10 = vc[1][0]; w11 = vc[1][1]; }
            PG8_LDB(B0, 0, 0); PG8_LDB(B1, 0, 1); PG8_SCHED; PG8_LDA(At, 0, 0); PG8_STAGE2(PG8_SA(1, 1), a1, vc[1][0], vc[1][1]);
            PG8_WAIT_V(8); PG8_WAIT_L(0); PG8_BAR; PG8_MMA(0, 0, At, B0); PG8_MMA(0, 1, At, B1); PG8_BAR; PG8_SCHED;
            PG8_LDA(At, 0, 1); PG8_STAGEB(PG8_SB(0, 0), b2); PG8_STAGEB(PG8_SB(0, 1), b2 + hstepB); PG8_STAGE2(PG8_SA(0, 0), a2, w00, w01);
            PG8_WAIT_V(8); PG8_WAIT_L(0); PG8_BAR; PG8_MMA(1, 0, At, B0); PG8_MMA(1, 1, At, B1); PG8_BAR; PG8_SCHED;
            PG8_LDB(B0, 1, 0); PG8_LDB(B1, 1, 1); PG8_SCHED; PG8_LDA(At, 1, 0); PG8_STAGE2(PG8_SA(0, 1), a2, w10, w11);
            PG8_WAIT_V(8); PG8_WAIT_L(0); PG8_BAR; PG8_MMA(0, 0, At, B0); PG8_MMA(0, 1, At, B1); PG8_BAR; PG8_SCHED;
            PG8_LDA(At, 1, 1); PG8_STAGEB(PG8_SB(1, 0), b3); PG8_STAGEB(PG8_SB(1, 1), b3 + hstepB); PG8_STAGE2(PG8_SA(1, 0), a3, w00, w01);
            PG8_WAIT_V(8); PG8_WAIT_L(0); PG8_BAR; PG8_MMA(1, 0, At, B0); PG8_MMA(1, 1, At, B1); PG8_BAR; PG8_SCHED;
        }
        if (wr == 0) PG8_BAR;
        E(acc, cur, wr, wc, fr, fq);
        if (!has_next) break;
#pragma unroll
        for (int a = 0; a < 2; ++a)
#pragma unroll
            for (int b = 0; b < 2; ++b)
#pragma unroll
                for (int m = 0; m < 4; ++m)
#pragma unroll
                    for (int n = 0; n < 2; ++n) acc[a][b][m][n] = (f32x4){0.f, 0.f, 0.f, 0.f};
        cur = nxt; cA = nA; cB = nB; ++ui;
        if (GATHER) {
#pragma unroll
            for (int h_ = 0; h_ < 2; ++h_) { vc[h_][0] = vn[h_][0]; vc[h_][1] = vn[h_][1]; } }
        if (wr == 1) PG8_BAR;
    }
    PG8_WAIT_V(0);
    PG8_BAR;
#undef PG8_SA
#undef PG8_SB
#undef PG8_STAGE2
#undef PG8_STAGEB
#undef PG8_LDA
#undef PG8_LDB
#undef PG8_MMA
#undef PG8_WAIT_V
#undef PG8_WAIT_L
#undef PG8_BAR
#undef PG8_SCHED
#undef PG8_VOFFA
}
template <class Epi, class Sched>
__device__ __forceinline__ void gemm_phase_vk(PG8_LAS unsigned char* lds, const Sched& S, const Epi& E, const int lda, const int tid_in) {
    constexpr bool GATHER = false;
    int tid = tid_in; asm volatile("" : "+v"(tid));
    const int wid = __builtin_amdgcn_readfirstlane(tid >> 6), lane = tid & 63, wr = wid >> 2, wc = wid & 3, fr = lane & 15, fq = lane >> 4;
    int RA[2], CA[2], RB[2];
#pragma unroll
    for (int i = 0; i < 2; ++i) { int R, C; stage_rc(tid * 16 + i * 8192, R, C); const int Rb = Epi::PERM ? ((R & ~31) + perm32(R & 31)) : R; RA[i] = R; CA[i] = C; RB[i] = Rb; }
    const size_t kstep = (size_t)(BK * 2);
    const unsigned ldsw = (unsigned)wid * 1024u;
    const int aoff = lds_byte(wr * 64 + fr, fq * 8), boff = lds_byte(wc * 32 + fr, fq * 8);
#define PG8_SA(b, h) (((b) * 2 + (h)) * HTB)
#define PG8_SB(b, h) ((4 + (b) * 2 + (h)) * HTB)
#define PG8_STAGE2(bufoff, gbase, v0, v1) do { \
        __builtin_amdgcn_global_load_lds((const unsigned*)((const char*)(gbase) + (v0)), (PG8_LAS unsigned*)(lds + (bufoff) + ldsw), 16, 0, 0); \
        __builtin_amdgcn_global_load_lds((const unsigned*)((const char*)(gbase) + (v1)), (PG8_LAS unsigned*)(lds + (bufoff) + ldsw + 8192), 16, 0, 0); } while (0)
#define PG8_VOFFB(dst, hs, u) do { const int ldb_ = S.ldb_of(u); _Pragma("unroll") for (int i_ = 0; i_ < 2; ++i_) { int R_, C_; stage_rc(tid * 16 + i_ * 8192, R_, C_); const int Rb_ = Epi::PERM ? ((R_ & ~31) + perm32(R_ & 31)) : R_; dst[i_] = (unsigned)(Rb_ * ldb_ + C_) * 2u; } hs = (size_t)HALF * ldb_ * 2; } while (0)
#define PG8_LDA(dst, b, h) do { _Pragma("unroll") for (int m = 0; m < 4; ++m) _Pragma("unroll") for (int k = 0; k < 2; ++k) dst[m][k] = *(const PG8_LAS bf16x8*)(lds + PG8_SA(b, h) + aoff + m * 2048 + k * 1024); } while (0)
#define PG8_LDB(dst, b, h) do { _Pragma("unroll") for (int n = 0; n < 2; ++n) _Pragma("unroll") for (int k = 0; k < 2; ++k) dst[n][k] = *(const PG8_LAS bf16x8*)(lds + PG8_SB(b, h) + boff + n * 2048 + k * 1024); } while (0)
#define PG8_MMA(ai, bj, At, Bt) do { __builtin_amdgcn_s_setprio(1); _Pragma("unroll") for (int m = 0; m < 4; ++m) _Pragma("unroll") for (int n = 0; n < 2; ++n) _Pragma("unroll") for (int k = 0; k < 2; ++k) \
        acc[ai][bj][m][n] = __builtin_amdgcn_mfma_f32_16x16x32_bf16(Bt[n][k], At[m][k], acc[ai][bj][m][n], 0, 0, 0); __builtin_amdgcn_s_setprio(0); } while (0)
#define PG8_WAIT_V(n) asm volatile("s_waitcnt vmcnt(" #n ")" ::: "memory")
#define PG8_WAIT_L(n) asm volatile("s_waitcnt lgkmcnt(" #n ")" ::: "memory")
#define PG8_BAR __builtin_amdgcn_s_barrier()
#define PG8_SCHED __builtin_amdgcn_sched_barrier(0)
#define PG8_VOFFA(dst, u) do { _Pragma("unroll") for (int h_ = 0; h_ < 2; ++h_) _Pragma("unroll") for (int i_ = 0; i_ < 2; ++i_) { \
        const int row_ = GATHER ? S.a_row(u, h_ * HALF + RA[i_]) : (h_ * HALF + RA[i_]); dst[h_][i_] = (unsigned)(row_ * lda + CA[i_]) * 2u; } } while (0)
    Unit cur, nxt;
    if (!S.next(0, cur)) return;
    f32x4 acc[2][2][4][2];
#pragma unroll
    for (int a = 0; a < 2; ++a)
#pragma unroll
        for (int b = 0; b < 2; ++b)
#pragma unroll
            for (int m = 0; m < 4; ++m)
#pragma unroll
                for (int n = 0; n < 2; ++n) acc[a][b][m][n] = (f32x4){0.f, 0.f, 0.f, 0.f};
    bf16x8 At[4][2], B0[2][2], B1[2][2];
    unsigned vc[2][2], vn[2][2];
    PG8_VOFFA(vc, cur);
    unsigned vbc[2], vbn[2]; size_t hsc, hsn; PG8_VOFFB(vbc, hsc, cur); int nt = S.K_of(cur) / BK;
    const char* cA = S.a_base(cur); const char* cB = S.b_base(cur);
    PG8_STAGE2(PG8_SB(0, 0), cB, vbc[0], vbc[1]); PG8_STAGE2(PG8_SB(0, 1), cB + hsc, vbc[0], vbc[1]); PG8_STAGE2(PG8_SA(0, 0), cA, vc[0][0], vc[0][1]); PG8_STAGE2(PG8_SA(0, 1), cA, vc[1][0], vc[1][1]);
    if (wr == 1) PG8_BAR;
    PG8_WAIT_V(2); PG8_BAR;
    PG8_STAGE2(PG8_SB(1, 0), cB + kstep, vbc[0], vbc[1]); PG8_STAGE2(PG8_SA(1, 0), cA + kstep, vc[0][0], vc[0][1]); PG8_STAGE2(PG8_SB(1, 1), cB + hsc + kstep, vbc[0], vbc[1]);
    PG8_WAIT_V(6); PG8_BAR;
    int ui = 0;
    for (;;) {
        const bool has_next = S.next(ui + 1, nxt);
        const char* nA = has_next ? S.a_base(nxt) : cA; const char* nB = has_next ? S.b_base(nxt) : cB;
        if (has_next) { PG8_VOFFB(vbn, hsn, nxt); } else { vbn[0] = vbc[0]; vbn[1] = vbc[1]; hsn = hsc; }
        if (GATHER) { if (has_next) { PG8_VOFFA(vn, nxt); } else {
#pragma unroll
            for (int h_ = 0; h_ < 2; ++h_) { vn[h_][0] = vc[h_][0]; vn[h_][1] = vc[h_][1]; } } }
        for (int t = 0; t < nt; t += 2) {
            const bool last = (t == nt - 2);
            const char* a1 = cA + (size_t)(t + 1) * kstep;
            const char* a2 = last ? nA : cA + (size_t)(t + 2) * kstep; const char* b2 = last ? nB : cB + (size_t)(t + 2) * kstep;
            const char* a3 = a2 + kstep; const char* b3 = b2 + kstep;
            unsigned w00, w01, w10, w11;
            if (GATHER) { w00 = last ? vn[0][0] : vc[0][0]; w01 = last ? vn[0][1] : vc[0][1]; w10 = last ? vn[1][0] : vc[1][0]; w11 = last ? vn[1][1] : vc[1][1]; }
            else { w00 = vc[0][0]; w01 = vc[0][1]; w10 = vc[1][0]; w11 = vc[1][1]; }
            const unsigned wb0 = last ? vbn[0] : vbc[0], wb1 = last ? vbn[1] : vbc[1]; const size_t hsb = last ? hsn : hsc;
            PG8_LDB(B0, 0, 0); PG8_LDB(B1, 0, 1); PG8_SCHED; PG8_LDA(At, 0, 0); PG8_STAGE2(PG8_SA(1, 1), a1, vc[1][0], vc[1][1]);
            PG8_WAIT_V(8); PG8_WAIT_L(0); PG8_BAR; PG8_MMA(0, 0, At, B0); PG8_MMA(0, 1, At, B1); PG8_BAR; PG8_SCHED;
            PG8_LDA(At, 0, 1); PG8_STAGE2(PG8_SB(0, 0), b2, wb0, wb1); PG8_STAGE2(PG8_SB(0, 1), b2 + hsb, wb0, wb1); PG8_STAGE2(PG8_SA(0, 0), a2, w00, w01);
            PG8_WAIT_V(8); PG8_WAIT_L(0); PG8_BAR; PG8_MMA(1, 0, At, B0); PG8_MMA(1, 1, At, B1); PG8_BAR; PG8_SCHED;
            PG8_LDB(B0, 1, 0); PG8_LDB(B1, 1, 1); PG8_SCHED; PG8_LDA(At, 1, 0); PG8_STAGE2(PG8_SA(0, 1), a2, w10, w11);
            PG8_WAIT_V(8); PG8_WAIT_L(0); PG8_BAR; PG8_MMA(0, 0, At, B0); PG8_MMA(0, 1, At, B1); PG8_BAR; PG8_SCHED;
            PG8_LDA(At, 1, 1); PG8_STAGE2(PG8_SB(1, 0), b3, wb0, wb1); PG8_STAGE2(PG8_SB(1, 1), b3 + hsb, wb0, wb1); PG8_STAGE2(PG8_SA(1, 0), a3, w00, w01);
            PG8_WAIT_V(8); PG8_WAIT_L(0); PG8_BAR; PG8_MMA(1, 0, At, B0); PG8_MMA(1, 1, At, B1); PG8_BAR; PG8_SCHED;
        }
        if (wr == 0) PG8_BAR;
        E(acc, cur, wr, wc, fr, fq);
        if (!has_next) break;
#pragma unroll
        for (int a = 0; a < 2; ++a)
#pragma unroll
            for (int b = 0; b < 2; ++b)
#pragma unroll
                for (int m = 0; m < 4; ++m)
#pragma unroll
                    for (int n = 0; n < 2; ++n) acc[a][b][m][n] = (f32x4){0.f, 0.f, 0.f, 0.f};
        cur = nxt; cA = nA; cB = nB; ++ui; vbc[0] = vbn[0]; vbc[1] = vbn[1]; hsc = hsn; nt = S.K_of(cur) / BK;
        if (GATHER) {
#pragma unroll
            for (int h_ = 0; h_ < 2; ++h_) { vc[h_][0] = vn[h_][0]; vc[h_][1] = vn[h_][1]; } }
        if (wr == 1) PG8_BAR;
    }
    PG8_WAIT_V(0);
    PG8_BAR;
#undef PG8_SA
#undef PG8_SB
#undef PG8_STAGE2
#undef PG8_VOFFB
#undef PG8_LDA
#undef PG8_LDB
#undef PG8_MMA
#undef PG8_WAIT_V
#undef PG8_WAIT_L
#undef PG8_BAR
#undef PG8_SCHED
#undef PG8_VOFFA
}
}

constexpr int NWAVES = 8, NTHREADS = 512;
constexpr int RING_OFF = 0, RING_BYTES = 131072, ROWS_OFF = 131072, ROWS_BYTES = 12288, ROUTER_BYTES = 147456  , MISC_OFF = ROUTER_BYTES, LCNT_OFF = MISC_OFF + 128  , LDS_BYTES = 148480;
static_assert(MISC_OFF + 128 <= LDS_BYTES, "LDS map");
constexpr int CW_CNT = 0;
constexpr int CW_BAR = 4096;
constexpr size_t CTL_ZERO_BYTES = 64 * 1024;
constexpr float LOG2E = 1.4426950408889634f, LN2 = 0.6931471805599453f;
constexpr float QSCALE = 0.125f * LOG2E;

#define GAS __attribute__((address_space(1)))
#define LAS __attribute__((address_space(3)))
typedef unsigned v4u __attribute__((ext_vector_type(4)));
typedef unsigned v2u __attribute__((ext_vector_type(2)));
#define LDS_WAIT() asm volatile("s_waitcnt lgkmcnt(0)" ::: "memory")
__device__ __forceinline__ unsigned pk2(float lo, float hi) { return (unsigned)f2bf(lo) | ((unsigned)f2bf(hi) << 16); }

#define XB_TMO      128
#define XB_XCNT(j)  (256  + 64 * (j))
#define XB_XSUB(j)  (1280 + 64 * (j))
#define XB_XGEN(j)  (2304 + 64 * (j))
#define XB_TOP      3328
#define XB_TOPGEN   3392
#define XCD_BAR_WORDS 3456
#define XB_SPIN_CAP (1u << 18)

__device__ __forceinline__ unsigned xb_ld(unsigned* p)              { return __hip_atomic_load(p, __ATOMIC_RELAXED, __HIP_MEMORY_SCOPE_AGENT); }
__device__ __forceinline__ unsigned xb_add(unsigned* p, unsigned v) { return __hip_atomic_fetch_add(p, v, __ATOMIC_RELAXED, __HIP_MEMORY_SCOPE_AGENT); }
__device__ __forceinline__ unsigned xb_xcc_id() { return (unsigned)__builtin_amdgcn_s_getreg((3 << 11) | 20) & 0xFu; }
#define XB_SPIN(cond, bar) do { unsigned _sp = 0; while (cond) { __builtin_amdgcn_s_sleep(1); \
    if ((++_sp & 255u) == 0u) { if (xb_ld(&(bar)[XB_TMO])) break; if (_sp > XB_SPIN_CAP) { atomicAdd(&(bar)[XB_TMO], 1u); break; } } } } while (0)

struct XcdBarrier {
    int wave0;
    unsigned* bar; unsigned x;
    volatile LAS unsigned* st;
};

__device__ __forceinline__ unsigned xb_lane() { unsigned l_; asm volatile("v_mbcnt_lo_u32_b32 %0, -1, 0\n\tv_mbcnt_hi_u32_b32 %0, -1, %0" : "=v"(l_)); return l_; }
__device__ __forceinline__ XcdBarrier xcd_barrier_post(unsigned* bar, volatile LAS unsigned* st, int wave0) {
    XcdBarrier b; b.wave0 = wave0; b.bar = bar; b.x = xb_xcc_id(); b.st = st;
    if (b.wave0 && xb_lane() == 0u) (void)xb_add(&bar[XB_XCNT(b.x)], 1u);
    return b;
}
__device__ __forceinline__ void xcd_barrier_complete(unsigned* bar, unsigned x, unsigned& nloc, unsigned& nx) {
    const unsigned G = gridDim.x * gridDim.y * gridDim.z;
    unsigned sum, cnt, mine, sp = 0u;
    for (;;) {
        sum = 0u; cnt = 0u; mine = 0u;
#pragma unroll
        for (unsigned j = 0; j < 16; ++j) { const unsigned c = xb_ld(&bar[XB_XCNT(j)]); sum += c; cnt += (c > 0u) ? 1u : 0u; mine = (j == x) ? c : mine; }
        if (sum == G) break;
        __builtin_amdgcn_s_sleep(1);
        if ((++sp & 255u) == 0u) { if (xb_ld(&bar[XB_TMO])) break; if (sp > XB_SPIN_CAP) { atomicAdd(&bar[XB_TMO], 1u); break; } }
    }
    nloc = mine > 0u ? mine : 1u; nx = cnt > 0u ? cnt : 1u;
}

__device__ __forceinline__ void xcd_barrier(const XcdBarrier& b) {
    asm volatile("s_waitcnt vmcnt(0)" ::: "memory");
    __syncthreads();
    if (b.wave0 && xb_lane() == 0u) {
        unsigned* bar = b.bar;
        __builtin_amdgcn_s_waitcnt(0);
        unsigned nloc = b.st[0], nx = b.st[1];
        if (nloc == 0u) { xcd_barrier_complete(bar, b.x, nloc, nx); b.st[0] = nloc; b.st[1] = nx; }
        const unsigned old = xb_add(&bar[XB_XSUB(b.x)], 1u);
        const unsigned gen = old / nloc;
        if (old + 1u == (gen + 1u) * nloc) {
            __builtin_amdgcn_fence(__ATOMIC_RELEASE, "agent");
            asm volatile("s_waitcnt vmcnt(0)" ::: "memory");
            const unsigned og = xb_add(&bar[XB_TOP], 1u);
            const unsigned tg = og / nx;
            if (og + 1u == (tg + 1u) * nx) xb_add(&bar[XB_TOPGEN], 1u);
            else XB_SPIN(xb_ld(&bar[XB_TOPGEN]) == tg, bar);
            __builtin_amdgcn_fence(__ATOMIC_ACQUIRE, "agent");
            xb_add(&bar[XB_XGEN(b.x)], 1u);
            asm volatile("s_waitcnt vmcnt(0)" ::: "memory");
        } else {
            XB_SPIN(xb_ld(&bar[XB_XGEN(b.x)]) == gen, bar);
            __builtin_amdgcn_fence(__ATOMIC_ACQUIRE, "agent");
            asm volatile("s_waitcnt vmcnt(0)" ::: "memory");
        }
    }
    __syncthreads();
}


struct Args { const float* in[23]; float* out; unsigned char* ws; int s_lo, s_hi, probe, pad; };

struct Frame {
    LAS unsigned char* lds; int tid, lane, wave, vcu, G;
    const float* const* in; float* h; unsigned char* ws; int probe;
};

__device__ __forceinline__ int hw_lane() { int l_; asm volatile("v_mbcnt_lo_u32_b32 %0, -1, 0\n\tv_mbcnt_hi_u32_b32 %0, -1, %0" : "=v"(l_)); return l_; }
__device__ __forceinline__ float shfl_xor_l(float v, int mask, int lane) { return __builtin_bit_cast(float, __builtin_amdgcn_ds_bpermute((lane ^ mask) << 2, __builtin_bit_cast(int, v))); }
__device__ __forceinline__ float dpp_add(float v, const int ctrl_sel) {
    const int x = __builtin_bit_cast(int, v); int y;
    if (ctrl_sel == 0) y = __builtin_amdgcn_mov_dpp(x, 0xB1, 0xF, 0xF, true);
    else if (ctrl_sel == 1) y = __builtin_amdgcn_mov_dpp(x, 0x4E, 0xF, 0xF, true);
    else if (ctrl_sel == 2) y = __builtin_amdgcn_mov_dpp(x, 0x141, 0xF, 0xF, true);
    else y = __builtin_amdgcn_mov_dpp(x, 0x140, 0xF, 0xF, true);
    return v + __builtin_bit_cast(float, y);
}
__device__ __forceinline__ float wave_sum_l(float v, int lane) {
    (void)lane;
    v = dpp_add(v, 0); v = dpp_add(v, 1); v = dpp_add(v, 2); v = dpp_add(v, 3);
    const int x = __builtin_bit_cast(int, v);
    const float r0 = __builtin_bit_cast(float, __builtin_amdgcn_readlane(x, 0)), r1 = __builtin_bit_cast(float, __builtin_amdgcn_readlane(x, 16)),
                r2 = __builtin_bit_cast(float, __builtin_amdgcn_readlane(x, 32)), r3 = __builtin_bit_cast(float, __builtin_amdgcn_readlane(x, 48));
    return (r0 + r1) + (r2 + r3);
}
#define LAUNDER(F) do { (F).lane = hw_lane(); (F).tid = (F).wave * 64 + (F).lane; asm volatile("" : "+s"((F).G), "+s"((F).vcu), "+s"((F).ws), "+s"((F).h)); } while (0)
__device__ __forceinline__ void p0_item(const float* W, int ldw, int k0, int n0, bf16* WT, int Kd, int drow0, float scale, LAS float* scr, int lane) {
#pragma unroll 8
    for (int i = 0; i < 32; ++i) { const int kk = 2 * i + (lane >> 5); scr[kk * 33 + (lane & 31)] = W[(size_t)(k0 + kk) * ldw + n0 + (lane & 31)] * scale; }
    LDS_WAIT(); asm volatile("" ::: "memory");
    const int c = lane & 7;
#pragma unroll
    for (int j = 0; j < 4; ++j) { const int n = (lane >> 3) + 8 * j; const LAS float* s = scr + (8 * c) * 33 + n;
        v4u o; o.x = pk2(s[0 * 33], s[1 * 33]); o.y = pk2(s[2 * 33], s[3 * 33]); o.z = pk2(s[4 * 33], s[5 * 33]); o.w = pk2(s[6 * 33], s[7 * 33]);
        *(GAS v4u*)(WT + (size_t)(drow0 + n) * Kd + k0 + 8 * c) = o; }
    LDS_WAIT(); asm volatile("" ::: "memory");
}
__device__ __forceinline__ bool is_q_col(int n) { return n < 512 || (n >= 768 && n < 3072 && ((n - 768) % 768) < 256) || (n >= 3072 && n < 3584); }

__device__ __forceinline__ void ph_prologue(Frame& F) { LAUNDER(F);
    LAS float* scr = (LAS float*)(F.lds + RING_OFF + F.wave * 16384);
    const int gw = F.vcu * NWAVES + F.wave, NGW = F.G * NWAVES, lane = F.lane;
    const float* w_in = F.in[4]; const float* w_a = F.in[8]; const float* w_b = F.in[9]; const float* w_c = F.in[10]; const float* w_o = F.in[11];
    const float* w_eg = F.in[18]; const float* w_eu = F.in[19]; const float* w_ed = F.in[20];
    bf16* WIN = (bf16*)(F.ws + WS_WIN); bf16* WBRA = (bf16*)(F.ws + WS_WBRA); bf16* WBRB = (bf16*)(F.ws + WS_WBRB); bf16* WBRC = (bf16*)(F.ws + WS_WBRC); bf16* WOUT = (bf16*)(F.ws + WS_WOUT);
    bf16* WGU = (bf16*)(F.ws + WS_WGU); bf16* WD = (bf16*)(F.ws + WS_WD);
    constexpr int I_IN = 16 * (NCOL / 32), I_A = 8 * 32, I_B = 4 * 32, I_C = 8 * 32, I_O = 16 * 32, I_G = 16 * 16, I_D = 8 * 32;
    constexpr int I_LAYER = I_IN + I_A + I_B + I_C + I_O + NE * (2 * I_G + I_D);
    for (int it = gw; it < DEPTH * I_LAYER; it += NGW) {
        const int l = it / I_LAYER; int r = it % I_LAYER;
        if (r < I_IN) { const int nb = r % (NCOL / 32), kb = r / (NCOL / 32); p0_item(w_in + (size_t)l * D * NCOL, NCOL, 64 * kb, 32 * nb, WIN + (size_t)l * NCOL * D, D, 32 * nb, is_q_col(32 * nb) ? QSCALE : 1.0f, scr, lane); continue; } r -= I_IN;
        if (r < I_A) { const int nb = r % 32, kb = r / 32; p0_item(w_a + (size_t)l * 512 * D, D, 64 * kb, 32 * nb, WBRA + (size_t)l * D * 512, 512, 32 * nb, 1.0f, scr, lane); continue; } r -= I_A;
        if (r < I_B) { const int nb = r % 32, kb = r / 32; p0_item(w_b + (size_t)l * 256 * D, D, 64 * kb, 32 * nb, WBRB + (size_t)l * D * 256, 256, 32 * nb, 1.0f, scr, lane); continue; } r -= I_B;
        if (r < I_C) { const int nb = r % 32, kb = r / 32; p0_item(w_c + (size_t)l * 512 * D, D, 64 * kb, 32 * nb, WBRC + (size_t)l * D * 512, 512, 32 * nb, 1.0f, scr, lane); continue; } r -= I_C;
        if (r < I_O) { const int nb = r % 32, kb = r / 32; p0_item(w_o + (size_t)l * D * D, D, 64 * kb, 32 * nb, WOUT + (size_t)l * D * D, D, 32 * nb, 1.0f, scr, lane); continue; } r -= I_O;
        const int e = r / (2 * I_G + I_D); r %= (2 * I_G + I_D); const size_t le = (size_t)l * NE + e;
        if (r < 2 * I_G) { const int up = r / I_G; r %= I_G; const int nb = r % 16, kb = r / 16;
            p0_item((up ? w_eu : w_eg) + le * D * DE, DE, 64 * kb, 32 * nb, WGU + le * 1024 * 1024, D, (nb >> 2) * 256 + up * 128 + (nb & 3) * 32, 1.0f, scr, lane); continue; }
        r -= 2 * I_G; { const int nb = r % 32, kb = r / 32; p0_item(w_ed + le * DE * D, D, 64 * kb, 32 * nb, WD + le * D * DE, DE, 32 * nb, 1.0f, scr, lane); }
    }
}

struct LnIn { f32x4 v[4]; v2u a[4], b[4], hw[4]; };
template <int MODE> __device__ __forceinline__ void ln_load(LnIn& in, const float* src, const bf16* hsb, const bf16* yb, size_t row, int lane) {
#pragma unroll
    for (int j = 0; j < 4; ++j) {
        const int c = lane * 4 + 256 * j;
        if (MODE != 2) in.v[j] = *(const GAS f32x4*)(src + row * D + c);
        if (MODE == 2) { in.hw[j] = *(const GAS v2u*)(hsb + row * D + c); in.a[j] = *(const GAS v2u*)(yb + (row * 2) * D + c); in.b[j] = *(const GAS v2u*)(yb + (row * 2 + 1) * D + c); }
    }
}
template <int MODE> __device__ __forceinline__ void ln_finish(const LnIn& in, float* hout, bf16* hb, const float* g, const float* bta, size_t row, int lane, f32x4 (&o)[4]) {
    f32x4 v[4];
#pragma unroll
    for (int j = 0; j < 4; ++j) {
        if (MODE != 2) v[j] = in.v[j];
        if (MODE == 2) {
            const v2u a = in.a[j], b = in.b[j], hw = in.hw[j];
            v[j].x = ALPHA * __uint_as_float(hw.x << 16) + __uint_as_float(a.x << 16) + __uint_as_float(b.x << 16);
            v[j].y = ALPHA * __uint_as_float(hw.x & 0xffff0000u) + __uint_as_float(a.x & 0xffff0000u) + __uint_as_float(b.x & 0xffff0000u);
            v[j].z = ALPHA * __uint_as_float(hw.y << 16) + __uint_as_float(a.y << 16) + __uint_as_float(b.y << 16);
            v[j].w = ALPHA * __uint_as_float(hw.y & 0xffff0000u) + __uint_as_float(a.y & 0xffff0000u) + __uint_as_float(b.y & 0xffff0000u);
        }
    }
    float s = 0.f;
#pragma unroll
    for (int j = 0; j < 4; ++j) s += (v[j].x + v[j].y) + (v[j].z + v[j].w);
    const float mean = wave_sum_l(s, lane) * (1.f / D);
    float q = 0.f;
#pragma unroll
    for (int j = 0; j < 4; ++j) { v[j] = v[j] - mean; q += (v[j].x * v[j].x + v[j].y * v[j].y) + (v[j].z * v[j].z + v[j].w * v[j].w); }
    const float rstd = 1.0f / sqrtf(wave_sum_l(q, lane) * (1.f / D) + LN_EPS);
#pragma unroll
    for (int j = 0; j < 4; ++j) {
        const int c = lane * 4 + 256 * j;
        const f32x4 gg = *(const GAS f32x4*)(g + c), bb = *(const GAS f32x4*)(bta + c);
        o[j] = v[j] * rstd * gg + bb;
        if (hout) *(GAS f32x4*)(hout + row * D + c) = o[j];
        if (hb) { v2u w; w.x = pk2(o[j].x, o[j].y); w.y = pk2(o[j].z, o[j].w); *(GAS v2u*)(hb + row * D + c) = w; }
    }
}

#ifndef PROBE_EPI
#define PROBE_EPI 0
#endif
struct EpiP1 {
    static constexpr bool PERM = true;
    bf16* qkv; bf16* gates; const float* b_gate; int probe;
    __device__ __forceinline__ void operator()(const f32x4 (&acc)[2][2][4][2], const pg8::Unit& u, int wr, int wc, int fr, int fq) const {
        if (probe == 1 && PROBE_EPI == 0) return;
        const int row0 = (probe == 1 ? (int)(blockIdx.x & 127) : u.pm) * 256 + wr * 64 + fr; const bool isg = u.pn >= 18;
        bf16* base = isg ? gates : qkv; const int ldc = isg ? GATEW : QKVW; const int col0 = (isg ? (u.pn - 18) : u.pn) * 256 + wc * 32 + 8 * fq;
        f32x4 bv[2][2];
#pragma unroll
        for (int bj = 0; bj < 2; ++bj)
#pragma unroll
            for (int n = 0; n < 2; ++n) bv[bj][n] = isg ? *(const GAS f32x4*)(b_gate + col0 + bj * 128 + 4 * n) : (f32x4){0.f, 0.f, 0.f, 0.f};
#pragma unroll
        for (int ai = 0; ai < 2; ++ai)
#pragma unroll
            for (int m = 0; m < 4; ++m) { bf16* rowp = base + (size_t)(row0 + ai * 128 + m * 16) * ldc + col0;
#pragma unroll
                for (int bj = 0; bj < 2; ++bj) { f32x4 v0 = acc[ai][bj][m][0] + bv[bj][0], v1 = acc[ai][bj][m][1] + bv[bj][1];
                    if (isg) {
#pragma unroll
                        for (int j = 0; j < 4; ++j) { v0[j] = __builtin_amdgcn_rcpf(1.0f + __builtin_amdgcn_exp2f(-LOG2E * v0[j])); v1[j] = __builtin_amdgcn_rcpf(1.0f + __builtin_amdgcn_exp2f(-LOG2E * v1[j])); } }
                    v4u w; w.x = pg8::cvt_pk_bf16(v0[0], v0[1]); w.y = pg8::cvt_pk_bf16(v0[2], v0[3]); w.z = pg8::cvt_pk_bf16(v1[0], v1[1]); w.w = pg8::cvt_pk_bf16(v1[2], v1[3]);
                    *(GAS v4u*)(rowp + bj * 128) = w; } }
    }
};
template <bool FIRST> struct EpiP3 {
    static constexpr bool PERM = true;
    bf16* merged; const bf16* gates; int br;
    __device__ __forceinline__ void operator()(const f32x4 (&acc)[2][2][4][2], const pg8::Unit& u, int wr, int wc, int fr, int fq) const {
        const int row0 = u.pm * 256 + wr * 64 + fr, col0 = u.pn * 256 + wc * 32 + 8 * fq;
#pragma unroll
        for (int ai = 0; ai < 2; ++ai) {
            v4u gw[4][2], ow[4][2];
#pragma unroll
            for (int m = 0; m < 4; ++m)
#pragma unroll
                for (int bj = 0; bj < 2; ++bj) { const size_t row = (size_t)(row0 + ai * 128 + m * 16);
                    gw[m][bj] = *(const GAS v4u*)(gates + row * GATEW + br * 1024 + col0 + bj * 128);
                    ow[m][bj] = FIRST ? (v4u){0u, 0u, 0u, 0u} : *(const GAS v4u*)(merged + row * D + col0 + bj * 128); }
#pragma unroll
            for (int m = 0; m < 4; ++m)
#pragma unroll
                for (int bj = 0; bj < 2; ++bj) { const size_t row = (size_t)(row0 + ai * 128 + m * 16);
                    const f32x4 a0 = acc[ai][bj][m][0], a1 = acc[ai][bj][m][1];
                    float r[8];
#pragma unroll
                    for (int j = 0; j < 4; ++j) { const unsigned g2 = gw[m][bj][j], o2 = ow[m][bj][j]; const float av0 = j < 2 ? a0[2 * j] : a1[2 * j - 4], av1 = j < 2 ? a0[2 * j + 1] : a1[2 * j - 3];
                        r[2 * j] = __uint_as_float(g2 << 16) * av0 + (FIRST ? 0.f : __uint_as_float(o2 << 16)); r[2 * j + 1] = __uint_as_float(g2 & 0xffff0000u) * av1 + (FIRST ? 0.f : __uint_as_float(o2 & 0xffff0000u)); }
                    v4u w; w.x = pg8::cvt_pk_bf16(r[0], r[1]); w.y = pg8::cvt_pk_bf16(r[2], r[3]); w.z = pg8::cvt_pk_bf16(r[4], r[5]); w.w = pg8::cvt_pk_bf16(r[6], r[7]);
                    *(GAS v4u*)(merged + row * D + col0 + bj * 128) = w; }
            asm volatile("" ::: "memory"); }
    }
};
struct EpiP3V {
    static constexpr bool PERM = true;
    bf16* merged; const bf16* gates;
    __device__ __forceinline__ void operator()(const f32x4 (&acc)[2][2][4][2], const pg8::Unit& u, int wr, int wc, int fr, int fq) const {
        const int row0 = u.pm * 256 + wr * 64 + fr, col0 = u.pn * 256 + wc * 32 + 8 * fq; const int br = u.e; const bool first = (br == 0);
#pragma unroll
        for (int ai = 0; ai < 2; ++ai)
#pragma unroll
        for (int mp = 0; mp < 2; ++mp) {
            v4u gw[2][2], ow[2][2];
#pragma unroll
            for (int mm = 0; mm < 2; ++mm)
#pragma unroll
                for (int bj = 0; bj < 2; ++bj) { const size_t row = (size_t)(row0 + ai * 128 + (2 * mp + mm) * 16);
                    gw[mm][bj] = *(const GAS v4u*)(gates + row * GATEW + br * 1024 + col0 + bj * 128);
                    ow[mm][bj] = (v4u){0u, 0u, 0u, 0u}; if (!first) ow[mm][bj] = *(const GAS v4u*)(merged + row * D + col0 + bj * 128); }
#pragma unroll
            for (int mm = 0; mm < 2; ++mm)
#pragma unroll
                for (int bj = 0; bj < 2; ++bj) { const int m = 2 * mp + mm; const size_t row = (size_t)(row0 + ai * 128 + m * 16);
                    const f32x4 a0 = acc[ai][bj][m][0], a1 = acc[ai][bj][m][1];
                    float r[8];
#pragma unroll
                    for (int j = 0; j < 4; ++j) { const unsigned g2 = gw[mm][bj][j], o2 = ow[mm][bj][j]; const float av0 = j < 2 ? a0[2 * j] : a1[2 * j - 4], av1 = j < 2 ? a0[2 * j + 1] : a1[2 * j - 3];
                        r[2 * j] = __uint_as_float(g2 << 16) * av0 + __uint_as_float(o2 << 16); r[2 * j + 1] = __uint_as_float(g2 & 0xffff0000u) * av1 + __uint_as_float(o2 & 0xffff0000u); }
                    v4u w; w.x = pg8::cvt_pk_bf16(r[0], r[1]); w.y = pg8::cvt_pk_bf16(r[2], r[3]); w.z = pg8::cvt_pk_bf16(r[4], r[5]); w.w = pg8::cvt_pk_bf16(r[6], r[7]);
                    *(GAS v4u*)(merged + row * D + col0 + bj * 128) = w; }
            asm volatile("" ::: "memory"); }
    }
};
struct P3Order {
    pg8::DenseOrder Dn; const char* Abase; const char* wsb; size_t lofs;
    __device__ __forceinline__ bool next(int i, pg8::Unit& u) const { if (!Dn.next(i / 3, u)) return false; u.e = i % 3; u.ui = i; return true; }
    __device__ __forceinline__ const char* a_base(const pg8::Unit& u) const { const size_t ko = (size_t)((u.e + 1) >> 1) * 1024 + (size_t)(u.e >> 1) * 512; return Abase + ko + (size_t)u.pm * Dn.tstepA; }
    __device__ __forceinline__ int K_of(const pg8::Unit& u) const { return 512 - 256 * (u.e & 1); }
    __device__ __forceinline__ int ldb_of(const pg8::Unit& u) const { return 512 - 256 * (u.e & 1); }
    __device__ __forceinline__ const char* b_base(const pg8::Unit& u) const {
        const size_t kb = (size_t)(512 - 256 * (u.e & 1)) * 2;
        const size_t base = WS_WBRA + (size_t)((u.e + 1) >> 1) * (WS_WBRB - WS_WBRA) + (size_t)(u.e >> 1) * (WS_WBRC - WS_WBRB);
        return wsb + base + lofs * (size_t)D * kb + (size_t)u.pn * 256 * kb; }
    __device__ __forceinline__ int a_row(const pg8::Unit&, int) const { return 0; }
};
struct EpiP4 {
    static constexpr bool PERM = false;
    const bf16* hbc; float* ho;
    __device__ __forceinline__ void operator()(const f32x4 (&acc)[2][2][4][2], const pg8::Unit& u, int wr, int wc, int fr, int fq) const {
        const int row0 = u.pm * 256 + wr * 64 + fr, col0 = u.pn * 256 + wc * 32 + 4 * fq;
#pragma unroll
        for (int ai = 0; ai < 2; ++ai) { v2u hv[4][2][2];
#pragma unroll
            for (int m = 0; m < 4; ++m)
#pragma unroll
                for (int bj = 0; bj < 2; ++bj)
#pragma unroll
                    for (int n = 0; n < 2; ++n) hv[m][bj][n] = *(const GAS v2u*)(hbc + (size_t)(row0 + ai * 128 + m * 16) * D + col0 + bj * 128 + n * 16);
#pragma unroll
            for (int m = 0; m < 4; ++m)
#pragma unroll
                for (int bj = 0; bj < 2; ++bj)
#pragma unroll
                    for (int n = 0; n < 2; ++n) { const v2u w = hv[m][bj][n]; const f32x4 hf = (f32x4){__uint_as_float(w.x << 16), __uint_as_float(w.x & 0xffff0000u), __uint_as_float(w.y << 16), __uint_as_float(w.y & 0xffff0000u)};
                        *(GAS f32x4*)(ho + (size_t)(row0 + ai * 128 + m * 16) * D + col0 + bj * 128 + n * 16) = hf * ALPHA + acc[ai][bj][m][n]; }
            asm volatile("" ::: "memory"); }
    }
};
struct EpiP7 {
    static constexpr bool PERM = true;
    bf16* hid;
    __device__ __forceinline__ void operator()(const f32x4 (&acc)[2][2][4][2], const pg8::Unit& u, int wr, int wc, int fr, int fq) const {
        const int row0 = u.pm * 256 + wr * 64 + fr, col0 = u.pn * 128 + wc * 32 + 8 * fq;
#pragma unroll
        for (int ai = 0; ai < 2; ++ai)
#pragma unroll
            for (int m = 0; m < 4; ++m) { float r[8];
#pragma unroll
                for (int n = 0; n < 2; ++n)
#pragma unroll
                    for (int j = 0; j < 4; ++j) { const float gv = acc[ai][0][m][n][j], uv = acc[ai][1][m][n][j]; r[4 * n + j] = gv * __builtin_amdgcn_rcpf(1.0f + __builtin_amdgcn_exp2f(-LOG2E * gv)) * uv; }
                v4u w; w.x = pg8::cvt_pk_bf16(r[0], r[1]); w.y = pg8::cvt_pk_bf16(r[2], r[3]); w.z = pg8::cvt_pk_bf16(r[4], r[5]); w.w = pg8::cvt_pk_bf16(r[6], r[7]);
                *(GAS v4u*)(hid + (size_t)(row0 + ai * 128 + m * 16) * DE + col0) = w; }
    }
};
struct EpiP8 {
    static constexpr bool PERM = true;
    bf16* yb; const int* rowtok; const float* rowgate;
    __device__ __forceinline__ void operator()(const f32x4 (&acc)[2][2][4][2], const pg8::Unit& u, int wr, int wc, int fr, int fq) const {
        const int row0 = u.pm * 256 + wr * 64 + fr, col0 = u.pn * 256 + wc * 32 + 8 * fq;
        int rt[2][4]; float gt[2][4];
#pragma unroll
        for (int ai = 0; ai < 2; ++ai)
#pragma unroll
            for (int m = 0; m < 4; ++m) { const int row = row0 + ai * 128 + m * 16; rt[ai][m] = *(const GAS int*)(rowtok + row); gt[ai][m] = *(const GAS float*)(rowgate + row); }
#pragma unroll
        for (int ai = 0; ai < 2; ++ai)
#pragma unroll
            for (int m = 0; m < 4; ++m) {
                if (rt[ai][m] >= 0) {
#pragma unroll
                    for (int bj = 0; bj < 2; ++bj) { const f32x4 v0 = acc[ai][bj][m][0] * gt[ai][m], v1 = acc[ai][bj][m][1] * gt[ai][m];
                        v4u w; w.x = pg8::cvt_pk_bf16(v0[0], v0[1]); w.y = pg8::cvt_pk_bf16(v0[2], v0[3]); w.z = pg8::cvt_pk_bf16(v1[0], v1[1]); w.w = pg8::cvt_pk_bf16(v1[2], v1[3]);
                        *(GAS v4u*)(yb + (size_t)rt[ai][m] * D + col0 + bj * 128) = w; } } }
    }
};

__device__ __forceinline__ void router_row(const float (&x)[16], int t, int lane, const LAS float* w_rg, const float* b_rg, const LAS float* w_re, const float* b_re, LAS int* lcnt, int wslot, Rec* rec) {
    float gl[4] = {0.f, 0.f, 0.f, 0.f};
#pragma unroll
    for (int j = 0; j < 4; ++j)
#pragma unroll
        for (int i = 0; i < 4; ++i) { const f32x4 w = *(const LAS f32x4*)(w_rg + ((j * 4 + i) * 64 + lane) * 4); const float xv = x[4 * j + i]; gl[0] += xv * w.x; gl[1] += xv * w.y; gl[2] += xv * w.z; gl[3] += xv * w.w; }
#pragma unroll
    for (int g = 0; g < 4; ++g) gl[g] = wave_sum_l(gl[g], lane) + b_rg[g];
    int gi = 0; float gm = gl[0];
#pragma unroll
    for (int g = 1; g < 4; ++g) if (gl[g] > gm) { gm = gl[g]; gi = g; }
    float gs = 0.f;
#pragma unroll
    for (int g = 0; g < 4; ++g) gs += __expf(gl[g] - gm);
    const float gw = 1.0f / gs;
    float el[8];
#pragma unroll
    for (int e = 0; e < 8; ++e) el[e] = 0.f;
    const LAS float* wre = w_re + gi * (D * 8);
#pragma unroll
    for (int j = 0; j < 4; ++j)
#pragma unroll
        for (int i = 0; i < 4; ++i) { const LAS float* wp = wre + ((j * 4 + i) * 128 + lane) * 4; const f32x4 w0 = *(const LAS f32x4*)wp, w1 = *(const LAS f32x4*)(wp + 256); const float xv = x[4 * j + i];
            el[0] += xv * w0.x; el[1] += xv * w0.y; el[2] += xv * w0.z; el[3] += xv * w0.w; el[4] += xv * w1.x; el[5] += xv * w1.y; el[6] += xv * w1.z; el[7] += xv * w1.w; }
#pragma unroll
    for (int e = 0; e < 8; ++e) el[e] = wave_sum_l(el[e], lane) + b_re[gi * 8 + e];
    int i0 = 0; float t0 = el[0];
#pragma unroll
    for (int e = 1; e < 8; ++e) if (el[e] > t0) { t0 = el[e]; i0 = e; }
    int i1 = -1; float t1 = -3.0e38f;
#pragma unroll
    for (int e = 0; e < 8; ++e) if (e != i0 && el[e] > t1) { t1 = el[e]; i1 = e; }
    const float ex = __expf(t1 - t0), p0 = 1.0f / (1.0f + ex), p1 = ex / (1.0f + ex);
    if (lane == 0) {
        const int e0 = gi * 8 + i0, e1 = gi * 8 + i1;
        const int s0 = __hip_atomic_fetch_add(lcnt + e0, 1, __ATOMIC_RELAXED, __HIP_MEMORY_SCOPE_WORKGROUP), s1 = __hip_atomic_fetch_add(lcnt + e1, 1, __ATOMIC_RELAXED, __HIP_MEMORY_SCOPE_WORKGROUP);
        GAS v4u* rp = (GAS v4u*)(rec + t);
        rp[0] = (v4u){(unsigned)e0, (unsigned)s0, (unsigned)e1, (unsigned)s1};
        rp[1] = (v4u){__float_as_uint(gw * p0), __float_as_uint(gw * p1), (unsigned)wslot, 0u};
    }
}

#ifndef STAG_P1
#define STAG_P1 500
#endif
__device__ __forceinline__ void stagger(int vcu, unsigned q) {
    const unsigned long long t0 = __builtin_amdgcn_s_memrealtime(); const unsigned long long d = (unsigned long long)((vcu & 3) * q);
    while (__builtin_amdgcn_s_memrealtime() - t0 < d) __builtin_amdgcn_s_sleep(8);
}
__device__ __forceinline__ void ph_ln0(Frame& F) { LAUNDER(F);
    const int gw = F.vcu * NWAVES + F.wave, NGW = F.G * NWAVES;
    bf16* hb = (bf16*)(F.ws + WS_HB);
    LnIn cur, nxt; if (gw < T) ln_load<0>(cur, F.in[0], nullptr, nullptr, (size_t)gw, F.lane);
    for (int m = gw; m < T; m += NGW) { const bool more = m + NGW < T; if (more) ln_load<0>(nxt, F.in[0], nullptr, nullptr, (size_t)(m + NGW), F.lane);
        f32x4 o[4]; ln_finish<0>(cur, nullptr, hb, F.in[1], F.in[2], (size_t)m, F.lane, o); if (more) cur = nxt; }
}
__device__ __forceinline__ void ph_p1(Frame& F, int l, int c) { LAUNDER(F); asm volatile("" : "+s"(l), "+s"(c));
    pg8::DenseOrder S; S.init((const bf16*)(F.ws + WS_HB) + (size_t)c * CH * D, D, (const bf16*)(F.ws + WS_WIN) + (size_t)l * NCOL * D, D, CH, NCOL, F.G, (int)blockIdx.x);
    EpiP1 E{(bf16*)(F.ws + WS_QKV), (bf16*)(F.ws + WS_GATES), F.in[5] + (size_t)l * GATEW, F.probe};
    pg8::gemm_phase<EpiP1, pg8::DenseOrder, false>(F.lds + RING_OFF, S, E, D, D, D, F.tid);
}
__device__ __forceinline__ void ph_cmb(Frame& F) { LAUNDER(F);
    const bf16* og = (const bf16*)(F.ws + WS_OG); const float* lse = (const float*)(F.ws + WS_LSE); bf16* oabc = (bf16*)(F.ws + WS_OABC);
    for (int idx = F.vcu * NTHREADS + F.tid; idx < CH * 32; idx += F.G * NTHREADS) {
        const int tl = idx >> 5, hc = idx & 31, h = hc >> 3, c = hc & 7;
        const GAS float* lg = (const GAS float*)lse + (size_t)tl * 12 + h; const float l0 = lg[0], l1 = lg[4], l2 = lg[8];
        const float mx = fmaxf(l0, fmaxf(l1, l2)); float w0 = __expf(l0 - mx), w1 = __expf(l1 - mx), w2 = __expf(l2 - mx); const float inv = 1.0f / (w0 + w1 + w2); w0 *= inv; w1 *= inv; w2 *= inv;
        const v4u a = *(const GAS v4u*)(og + ((size_t)tl * 3 + 0) * 256 + h * 64 + c * 8), b = *(const GAS v4u*)(og + ((size_t)tl * 3 + 1) * 256 + h * 64 + c * 8), d = *(const GAS v4u*)(og + ((size_t)tl * 3 + 2) * 256 + h * 64 + c * 8);
        v4u ow;
#pragma unroll
        for (int i = 0; i < 4; ++i) {
            const float lo = w0 * __uint_as_float(a[i] << 16) + w1 * __uint_as_float(b[i] << 16) + w2 * __uint_as_float(d[i] << 16);
            const float hi = w0 * __uint_as_float(a[i] & 0xffff0000u) + w1 * __uint_as_float(b[i] & 0xffff0000u) + w2 * __uint_as_float(d[i] & 0xffff0000u);
            ow[i] = pk2(lo, hi);
        }
        *(GAS v4u*)(oabc + (size_t)tl * OW + 512 + h * 64 + c * 8) = ow;
    }
}
__device__ __forceinline__ void ph_p3(Frame& F, int l) { LAUNDER(F); asm volatile("" : "+s"(l));
    const bf16* oabc = (const bf16*)(F.ws + WS_OABC); bf16* merged = (bf16*)(F.ws + WS_MERGED); const bf16* gates = (const bf16*)(F.ws + WS_GATES);
    P3Order S; S.Dn.init(oabc, OW, nullptr, 0, CH, D, F.G, (int)blockIdx.x);
    S.Abase = (const char*)oabc; S.wsb = (const char*)F.ws; S.lofs = (size_t)l;
    EpiP3V E{merged, gates};
    pg8::gemm_phase_vk<EpiP3V, P3Order>(F.lds + RING_OFF, S, E, OW, F.tid);
}
__device__ __forceinline__ void ph_p4(Frame& F, int l, int c) { LAUNDER(F); asm volatile("" : "+s"(l), "+s"(c));
    pg8::DenseOrder S; S.init((const bf16*)(F.ws + WS_MERGED), D, (const bf16*)(F.ws + WS_WOUT) + (size_t)l * D * D, D, CH, D, F.G, (int)blockIdx.x);
    EpiP4 E{(const bf16*)(F.ws + WS_HB) + (size_t)c * CH * D, F.probe ? (float*)(F.ws + WS_OABC) : F.h + (size_t)c * CH * D};
    pg8::gemm_phase<EpiP4, pg8::DenseOrder, false>(F.lds + RING_OFF, S, E, D, D, D, F.tid);
}
__device__ __forceinline__ void ph_ln1(Frame& F, int l, int c) { LAUNDER(F); asm volatile("" : "+s"(l), "+s"(c));
    const int gw = F.vcu * NWAVES + F.wave, NGW = F.G * NWAVES;
    bf16* hb = (bf16*)(F.ws + WS_HB); Rec* rec = (Rec*)(F.ws + WS_REC);
    int* wgc = (int*)(F.ws + WS_WGCNT) + ((size_t)(l * NCHUNK + c) * F.G + F.vcu) * 32;
    if (F.probe) { hb = (bf16*)(F.ws + WS_QKV) - (size_t)c * CH * D; wgc = (int*)(F.ws + WS_WGCNT) + (size_t)DEPTH * NCHUNK * 256 * 32 + F.vcu * 32; rec = (Rec*)(F.ws + WS_GATES); }
    LAS float* lrg = (LAS float*)(F.lds + RING_OFF); LAS float* lre = lrg + D * 4; LAS int* lcnt = (LAS int*)(F.lds + LCNT_OFF);
    { const float* w_rg = F.in[14] + (size_t)l * D * 4; const float* w_re = F.in[16] + (size_t)l * 4 * D * 8;
      if (F.tid < 32) lcnt[F.tid] = 0;
      for (int u = F.tid; u < D + 4 * D * 2; u += NTHREADS) {
          if (u < D) { const int e = u, ln = (e & 255) >> 2, i = e & 3, j = e >> 8; *(LAS f32x4*)(lrg + ((j * 4 + i) * 64 + ln) * 4) = *(const GAS f32x4*)(w_rg + (size_t)e * 4); }
          else { const int v = u - D, half = v & 1, e = (v >> 1) & 1023, g = v >> 11, ln = (e & 255) >> 2, i = e & 3, j = e >> 8;
                 *(LAS f32x4*)(lre + g * (D * 8) + (((j * 4 + i) * 2 + half) * 64 + ln) * 4) = *(const GAS f32x4*)(w_re + ((size_t)g * D + e) * 8 + half * 4); } }
      __syncthreads(); }
    const size_t rbase = (size_t)c * CH;
    LnIn cur, nxt; if (gw < CH) ln_load<1>(cur, F.h, nullptr, nullptr, rbase + gw, F.lane);
    for (int m = gw; m < CH; m += NGW) {
        const bool more = m + NGW < CH; if (more) ln_load<1>(nxt, F.h, nullptr, nullptr, rbase + m + NGW, F.lane);
        const size_t row = rbase + m; f32x4 o[4];
        ln_finish<1>(cur, nullptr, hb, F.in[12] + l * D, F.in[13] + l * D, row, F.lane, o);
        float x[16];
#pragma unroll
        for (int j = 0; j < 4; ++j) { x[4 * j] = o[j].x; x[4 * j + 1] = o[j].y; x[4 * j + 2] = o[j].z; x[4 * j + 3] = o[j].w; }
        router_row(x, (int)row, F.lane, lrg, F.in[15] + l * 4, lre, F.in[17] + l * 32, lcnt, c * F.G + F.vcu, rec);
        if (more) cur = nxt;
    }
    __syncthreads();
    if (F.tid < 32) *(GAS int*)(wgc + F.tid) = lcnt[F.tid];
}
__device__ __forceinline__ void ph_dsp(Frame& F, int l) { LAUNDER(F); asm volatile("" : "+s"(l));
    LAS int* Tb = (LAS int*)(F.lds + RING_OFF); LAS int* part = Tb + 512 * 32; LAS int* po = part + 32 * 16;
    const int* wg = (const int*)(F.ws + WS_WGCNT) + (size_t)l * NCHUNK * F.G * 32; const int W = NCHUNK * F.G;
    int* cnt = (int*)(F.ws + WS_CTL) + CW_CNT + l * (32 * CSTR); const Rec* rec = (const Rec*)(F.ws + WS_REC); int* rowtok = (int*)(F.ws + WS_ROWTOK); float* rowgate = (float*)(F.ws + WS_ROWGATE);
    for (int i = F.tid; i < W * 32; i += NTHREADS) Tb[i] = *(const GAS int*)(wg + i);
    __syncthreads();
    const int e = F.tid >> 4, k = F.tid & 15, per = (W + 15) / 16, w0 = k * per, w1 = (w0 + per) < W ? (w0 + per) : W;
    { int s = 0; for (int w = w0; w < w1; ++w) s += Tb[w * 32 + e]; part[e * 16 + k] = s; }
    __syncthreads();
    { int base = 0; for (int kk = 0; kk < k; ++kk) base += part[e * 16 + kk];
      for (int w = w0; w < w1; ++w) { const int t = Tb[w * 32 + e]; Tb[w * 32 + e] = base; base += t; } }
    __syncthreads();
    if (F.tid == 0) { int acc = 0; for (int ee = 0; ee < NE; ++ee) { int tot = 0; for (int kk = 0; kk < 16; ++kk) tot += part[ee * 16 + kk]; po[ee] = acc; part[ee * 16] = tot; acc += (tot + 255) / 256 * 256; } po[NE] = acc; }
    __syncthreads();
    if (F.vcu == 0 && F.tid < 32) cnt[F.tid * CSTR] = part[F.tid * 16];
    const int gt = F.vcu * NTHREADS + F.tid, GT = F.G * NTHREADS;
    for (int t = gt; t < T; t += GT) {
        const GAS v4u* rp = (const GAS v4u*)(rec + t); const v4u ra = rp[0], rb = rp[1];
        Rec rc; rc.e0 = (int)ra.x; rc.s0 = (int)ra.y; rc.e1 = (int)ra.z; rc.s1 = (int)ra.w; rc.g0 = __uint_as_float(rb.x); rc.g1 = __uint_as_float(rb.y); rc.pad0 = (int)rb.z; rc.pad1 = 0;
        const int d0 = po[rc.e0] + Tb[rc.pad0 * 32 + rc.e0] + rc.s0, d1 = po[rc.e1] + Tb[rc.pad0 * 32 + rc.e1] + rc.s1;
        *(GAS int*)(rowtok + d0) = 2 * t; *(GAS float*)(rowgate + d0) = rc.g0; *(GAS int*)(rowtok + d1) = 2 * t + 1; *(GAS float*)(rowgate + d1) = rc.g1;
    }
    for (int ee = 0; ee < NE; ++ee) for (int r = po[ee] + part[ee * 16] + gt; r < po[ee + 1]; r += GT) { *(GAS int*)(rowtok + r) = -1; *(GAS float*)(rowgate + r) = 0.f; }
    __syncthreads();
}
__device__ __forceinline__ int moe_setup(Frame& F, int l, bool gather) { LAUNDER(F); asm volatile("" : "+s"(l));
    LAS int* rows = (LAS int*)(F.lds + ROWS_OFF); LAS int* ulist = rows + 11 * 256; LAS int* po = ulist + 16;
    const int* cnt = (const int*)(F.ws + WS_CTL) + CW_CNT + l * (32 * CSTR); const int* rowtok = (const int*)(F.ws + WS_ROWTOK);
    if (F.tid == 0) { int acc = 0; for (int e = 0; e < NE; ++e) { po[e] = acc; acc += (cnt[e * CSTR] + 255) / 256 * 256; } po[NE] = acc; }
    __syncthreads();
    const int nu_all = (po[NE] / 256) * 4; int nun = (nu_all - F.vcu + F.G - 1) / F.G; nun = nun < 0 ? 0 : (nun > 11 ? 11 : nun);
    if (F.tid < nun) { const int Lx = F.tid * F.G + F.vcu, rt = Lx >> 2, pn = Lx & 3; int e = 0; while (e < NE - 1 && po[e + 1] <= rt * 256) ++e; ulist[F.tid] = (rt << 8) | (e << 2) | pn; }
    if (gather) for (int idx = F.tid; idx < nun * 256; idx += NTHREADS) { const int i = idx >> 8, r = idx & 255, Lx = i * F.G + F.vcu; rows[idx] = *(const GAS int*)(rowtok + (Lx >> 2) * 256 + r); }
    __syncthreads();
    return nun;
}
struct MoeOrder {
    int nun; const LAS int* ulist; const LAS int* rows; const char* A; const char* B; size_t tstepA, estepB, tstepB;
    __device__ __forceinline__ bool next(int i, pg8::Unit& u) const {
        if (i >= nun) return false;
        const int w = __builtin_amdgcn_readfirstlane(ulist[i]); u.pm = w >> 8; u.e = (w >> 2) & 63; u.pn = w & 3; u.ui = i; return true;
    }
    __device__ __forceinline__ const char* a_base(const pg8::Unit& u) const { return A + (size_t)u.pm * tstepA; }
    __device__ __forceinline__ const char* b_base(const pg8::Unit& u) const { return B + (size_t)u.e * estepB + (size_t)u.pn * tstepB; }
    __device__ __forceinline__ int a_row(const pg8::Unit& u, int r) const { const int t = rows[u.ui * 256 + r]; return t < 0 ? 0 : (t >> 1); }
};
__device__ __forceinline__ void ph_p7(Frame& F, int l) { LAUNDER(F); asm volatile("" : "+s"(l));
    const int nun = moe_setup(F, l, true);
    LAS int* rows = (LAS int*)(F.lds + ROWS_OFF);
    MoeOrder S{nun, rows + 11 * 256, rows, (const char*)(F.ws + WS_HB), (const char*)(F.ws + WS_WGU) + (size_t)l * NE * 1024 * 1024 * 2, 0, (size_t)1024 * 1024 * 2, (size_t)256 * 1024 * 2};
    EpiP7 E{(bf16*)(F.ws + WS_HID)};
    pg8::gemm_phase<EpiP7, MoeOrder, true>(F.lds + RING_OFF, S, E, D, D, D, F.tid);
}
__device__ __forceinline__ void ph_p8(Frame& F, int l) { LAUNDER(F); asm volatile("" : "+s"(l));
    const int nun = moe_setup(F, l, false);
    LAS int* rows = (LAS int*)(F.lds + ROWS_OFF);
    MoeOrder S{nun, rows + 11 * 256, rows, (const char*)(F.ws + WS_HID), (const char*)(F.ws + WS_WD) + (size_t)l * NE * 1024 * 512 * 2, (size_t)256 * DE * 2, (size_t)1024 * 512 * 2, (size_t)256 * 512 * 2};
    EpiP8 E{(bf16*)(F.ws + WS_YB), (const int*)(F.ws + WS_ROWTOK), (const float*)(F.ws + WS_ROWGATE)};
    pg8::gemm_phase<EpiP8, MoeOrder, false>(F.lds + RING_OFF, S, E, DE, DE, DE, F.tid);
}
__device__ __forceinline__ void ph_ln2(Frame& F, int l) { LAUNDER(F); asm volatile("" : "+s"(l));
    const int gw = F.vcu * NWAVES + F.wave, NGW = F.G * NWAVES;
    const bool lastl = (l == DEPTH - 1);
    const bf16* hsb = (const bf16*)(F.ws + WS_HB); const bf16* yb = (const bf16*)(F.ws + WS_YB);
    bf16* hb = lastl ? nullptr : (bf16*)(F.ws + WS_HB); float* hout = lastl ? F.h : nullptr; size_t omask = ~(size_t)0;
    if (F.probe) { hout = lastl ? (float*)(F.ws + WS_OABC) : nullptr; hb = lastl ? nullptr : (bf16*)(F.ws + WS_OABC); omask = 32767; }
    LnIn cur, nxt; if (gw < T) ln_load<2>(cur, nullptr, hsb, yb, (size_t)gw, F.lane);
    for (int m = gw; m < T; m += NGW) { const bool more = m + NGW < T; if (more) ln_load<2>(nxt, nullptr, hsb, yb, (size_t)(m + NGW), F.lane);
        const size_t back = ((size_t)m - ((size_t)m & omask)) * D;
        f32x4 o[4]; ln_finish<2>(cur, hout ? hout - back : nullptr, hb ? hb - back : nullptr, F.in[21] + l * D, F.in[22] + l * D, (size_t)m, F.lane, o); if (more) cur = nxt; }
}

typedef short s16x4 __attribute__((ext_vector_type(4)));
constexpr int NT_A = (CH / 32) * 4, NT_B = (CH / L) * 3 * 128 * 4, NT_C = (CH / 64) * 8, NT_ALL = NT_A + NT_B + NT_C;
constexpr float NEGBIG = -1.0e30f, MINIT = -5.0e29f;
#define RC16(reg) (((reg) & 3) + 8 * ((reg) >> 2))

__device__ __forceinline__ void ph_tables(Frame& F) { LAUNDER(F);
    float* TA = (float*)(F.ws + WS_TABA); float* TB = (float*)(F.ws + WS_TABB); float* TC = (float*)(F.ws + WS_TABC);
    const float* rel_bias = F.in[3]; const float* rpb = F.in[7];
    const int gt = F.vcu * NTHREADS + F.tid, GT = F.G * NTHREADS;
    for (int i = gt; i < 8 * 320; i += GT) { const int h = i / 320, rel = i % 320 - 160; TA[i] = (rel >= -128 && rel <= 128) ? rel_bias[BUCK_A[rel + 128] * 20 + h] * LOG2E : NEGBIG; }
    for (int i = gt; i < 12 * 256; i += GT) { const int gh = i >> 8, g = gh >> 2, rel = (i & 255) - 128; TB[i] = (rel >= -64 && rel <= 64) ? rel_bias[BUCK_B[g][rel + 64] * 20 + 8 + gh] * LOG2E : NEGBIG; }
    for (int i = gt; i < DEPTH * 8 * 1024; i += GT) { const int lh = i >> 10, ri = (i >> 6) & 15, ci = (i & 63) - 16; TC[i] = (ri < 15 && ci >= 0 && ci <= 30) ? rpb[((size_t)lh * 15 + ri) * 31 + ci] * LOG2E : NEGBIG; }
}

#define ATT_INIT(S, TBP, BIDX, XM) do { \
        _Pragma("unroll") for (int r_ = 0; r_ < 16; ++r_) { float v_ = (TBP)[(BIDX) + RC16(r_)]; if (TYPE == 2) v_ = ((unsigned)((XM) + RC16(r_)) < 16u) ? v_ : NEGBIG; S[r_] = v_; } } while (0)
#define ATT_TMAX(S, t) do { t = NEGBIG; _Pragma("unroll") for (int r_ = 0; r_ < 16; ++r_) t = fmaxf(t, S[r_]); } while (0)
#define ATT_RESCALE(need, t, m, l, Oa, Ob) do { const float mn_ = (need) ? (t) : m, corr_ = __builtin_amdgcn_exp2f(m - mn_); m = mn_; l *= corr_; \
        _Pragma("unroll") for (int i_ = 0; i_ < 16; ++i_) { Oa[i_] *= corr_; Ob[i_] *= corr_; } } while (0)
#define ATT_EXP(S, m, rs) do { rs = 0.f; _Pragma("unroll") for (int r_ = 0; r_ < 16; ++r_) { const float p_ = __builtin_amdgcn_exp2f(S[r_] - m); S[r_] = p_; rs += p_; } } while (0)
#define ATT_PACK(Pf, S, s2) do { unsigned pw_[4]; _Pragma("unroll") for (int j_ = 0; j_ < 4; ++j_) pw_[j_] = pg8::cvt_pk_bf16(S[8 * (s2) + 2 * j_], S[8 * (s2) + 2 * j_ + 1]); \
        Pf = __builtin_bit_cast(bf16x8, (v4u){pw_[0], pw_[1], pw_[2], pw_[3]}); } while (0)
#define ATT_STORE(orow, Oa, Ob, l) do { const float inv_ = 1.0f / (l); \
        _Pragma("unroll") for (int g_ = 0; g_ < 4; ++g_) { v2u w0_, w1_; \
            w0_.x = pg8::cvt_pk_bf16(Oa[4 * g_] * inv_, Oa[4 * g_ + 1] * inv_); w0_.y = pg8::cvt_pk_bf16(Oa[4 * g_ + 2] * inv_, Oa[4 * g_ + 3] * inv_); \
            w1_.x = pg8::cvt_pk_bf16(Ob[4 * g_] * inv_, Ob[4 * g_ + 1] * inv_); w1_.y = pg8::cvt_pk_bf16(Ob[4 * g_ + 2] * inv_, Ob[4 * g_ + 3] * inv_); \
            *(GAS v2u*)((orow) + 8 * g_ + 4 * hh) = w0_; *(GAS v2u*)((orow) + 32 + 8 * g_ + 4 * hh) = w1_; } } while (0)

template <int TYPE>
__device__ __forceinline__ void att_task2(LAS unsigned char* wl, const int lane, const bf16* seq  , const float* tab0, const float* tab1,
                                          const int qcol0, const int qcol1, const int kcol, const int vcol, const int TT0, const int TSTEP, const int kstride, const int tlo, const int thi,
                                          const int tq0, const int tq1  , const int toff1  ,
                                          const int gi0, const int gi1, const int gc, const int cbs  ,
                                          const float m_init0, const float m_init1, const float l_init, bf16* orow0, bf16* orow1, float* lse0, float* lse1) {
    const int qi = lane & 31, hh = lane >> 5;
    LAS unsigned char* kt = wl; LAS unsigned char* vt = wl + 4096; LAS float* tb0 = (LAS float*)(wl + 8192); LAS float* tb1 = (TYPE == 0) ? tb0 + 320 : tb0;
    constexpr int TBN = TYPE == 0 ? 320 : (TYPE == 1 ? 256 : 1024);
#pragma unroll
    for (int i = 0; i < TBN / 64; ++i) { tb0[lane + 64 * i] = *(const GAS float*)(tab0 + lane + 64 * i); if (TYPE == 0) tb1[lane + 64 * i] = *(const GAS float*)(tab1 + lane + 64 * i); }
    bf16x8 Qa[4], Qb[4];
#pragma unroll
    for (int s = 0; s < 4; ++s) { Qa[s] = *(const GAS bf16x8*)(seq + (size_t)tq0 * QKVW + qcol0 + 16 * s + 8 * hh); Qb[s] = *(const GAS bf16x8*)(seq + (size_t)tq1 * QKVW + qcol1 + 16 * s + 8 * hh); }
    f32x16 O0a, O0b, O1a, O1b;
#pragma unroll
    for (int i = 0; i < 16; ++i) { O0a[i] = 0.f; O0b[i] = 0.f; O1a[i] = 0.f; O1b[i] = 0.f; }
    float m0 = m_init0, m1 = m_init1, l0 = l_init, l1 = l_init;
    const int lkey = lane >> 3, lch = lane & 7;
    const unsigned goff = (unsigned)(lkey * kstride) * (unsigned)(QKVW * 2) + 16u * (unsigned)lch;
    const size_t istepb = (size_t)8 * kstride * QKVW * 2;
    const char* kbase = (const char*)(seq + kcol); const char* vbase = (const char*)(seq + vcol);
    const unsigned kw0 = lkey * 128 + ((lch ^ (lkey & 7)) << 4), vw0 = lkey * 128 + (((lch >> 2) ^ ((lkey >> 1) & 1)) << 6) + ((lch & 3) << 4);
    const unsigned kr0 = qi * 128 + ((hh ^ (qi & 7)) << 4);
    const int q4 = (lane & 15) >> 2, p4 = lane & 3, g1 = (lane >> 4) & 1, sw = (q4 >> 1) & 1;
    const unsigned vr0 = (4 * hh + q4) * 128 + 32 * g1 + 8 * p4 + (sw << 6), vr1 = (4 * hh + q4) * 128 + 32 * g1 + 8 * p4 + ((sw ^ 1) << 6);
    const int bidx0 = (TYPE == 2) ? (cbs - gc + 31 + 4 * hh) : ((TYPE == 1 ? 64 : 32) - qi + 4 * hh);
    int cs = gc - 8; cs = cs < 0 ? 0 : (cs > 48 ? 48 : cs);
    const int xm = cbs - cs + 4 * hh;
    int rs0 = gi0 - 4; rs0 = rs0 < 0 ? 0 : (rs0 > 120 ? 120 : rs0);
    int rs1 = gi1 - 4; rs1 = rs1 < 0 ? 0 : (rs1 > 120 ? 120 : rs1);
    v4u kreg[4], vreg[4];
    {
        const size_t tb_ = (size_t)(TT0 + tlo * TSTEP) * (QKVW * 2);
#pragma unroll
        for (int i = 0; i < 4; ++i) { kreg[i] = *(const GAS v4u*)(kbase + tb_ + i * istepb + goff); vreg[i] = *(const GAS v4u*)(vbase + tb_ + i * istepb + goff); }
    }
    for (int ti = tlo; ti <= thi; ++ti) {
#pragma unroll
        for (int i = 0; i < 4; ++i) { *(LAS v4u*)(kt + kw0 + 1024 * i) = kreg[i]; *(LAS v4u*)(vt + vw0 + 1024 * i) = vreg[i]; }
        if (ti < thi) {
            const size_t tb_ = (size_t)(TT0 + (ti + 1) * TSTEP) * (QKVW * 2);
#pragma unroll
            for (int i = 0; i < 4; ++i) { kreg[i] = *(const GAS v4u*)(kbase + tb_ + i * istepb + goff); vreg[i] = *(const GAS v4u*)(vbase + tb_ + i * istepb + goff); }
        }
        int bi0, bi1;
        if (TYPE == 2) { const bool rv0 = (ti >= rs0) && (ti < rs0 + 8), rv1 = (ti >= rs1) && (ti < rs1 + 8); bi0 = bidx0 + (rv0 ? (ti - gi0 + 7) : 15) * 64; bi1 = bidx0 + (rv1 ? (ti - gi1 + 7) : 15) * 64; }
        else { bi0 = bidx0 + 32 * ti; bi1 = bidx0 + 32 * (ti - toff1); }
        f32x16 S0, S1;
        ATT_INIT(S0, tb0, bi0, xm); ATT_INIT(S1, tb1, bi1, xm);
#pragma unroll
        for (int s = 0; s < 4; ++s) { const bf16x8 Kf = *(const LAS bf16x8*)(kt + (kr0 ^ (unsigned)(s << 5)));
            S0 = __builtin_amdgcn_mfma_f32_32x32x16_bf16(Kf, Qa[s], S0, 0, 0, 0); S1 = __builtin_amdgcn_mfma_f32_32x32x16_bf16(Kf, Qb[s], S1, 0, 0, 0); }
        float t0, t1; ATT_TMAX(S0, t0); ATT_TMAX(S1, t1);
        t0 = fmaxf(t0, shfl_xor_l(t0, 32, lane)); t1 = fmaxf(t1, shfl_xor_l(t1, 32, lane));
        const bool need0 = t0 > m0 + 8.0f, need1 = t1 > m1 + 8.0f;
        if (__builtin_amdgcn_ballot_w64(need0 || need1) != 0ull) { ATT_RESCALE(need0, t0, m0, l0, O0a, O0b); ATT_RESCALE(need1, t1, m1, l1, O1a, O1b); }
        float rs0, rs1; ATT_EXP(S0, m0, rs0); ATT_EXP(S1, m1, rs1);
        rs0 += shfl_xor_l(rs0, 32, lane); rs1 += shfl_xor_l(rs1, 32, lane);
        l0 += rs0; l1 += rs1;
#pragma unroll
        for (int s2 = 0; s2 < 2; ++s2) {
            bf16x8 P0, P1; ATT_PACK(P0, S0, s2); ATT_PACK(P1, S1, s2);
            const s16x4 a00 = __builtin_amdgcn_ds_read_tr16_b64_v4i16((LAS s16x4*)(vt + vr0 + (16 * s2) * 128));
            const s16x4 a01 = __builtin_amdgcn_ds_read_tr16_b64_v4i16((LAS s16x4*)(vt + vr0 + (16 * s2 + 8) * 128));
            const s16x4 a10 = __builtin_amdgcn_ds_read_tr16_b64_v4i16((LAS s16x4*)(vt + vr1 + (16 * s2) * 128));
            const s16x4 a11 = __builtin_amdgcn_ds_read_tr16_b64_v4i16((LAS s16x4*)(vt + vr1 + (16 * s2 + 8) * 128));
            const bf16x8 V0 = (bf16x8){a00[0], a00[1], a00[2], a00[3], a01[0], a01[1], a01[2], a01[3]};
            const bf16x8 V1 = (bf16x8){a10[0], a10[1], a10[2], a10[3], a11[0], a11[1], a11[2], a11[3]};
            O0a = __builtin_amdgcn_mfma_f32_32x32x16_bf16(V0, P0, O0a, 0, 0, 0); O0b = __builtin_amdgcn_mfma_f32_32x32x16_bf16(V1, P0, O0b, 0, 0, 0);
            O1a = __builtin_amdgcn_mfma_f32_32x32x16_bf16(V0, P1, O1a, 0, 0, 0); O1b = __builtin_amdgcn_mfma_f32_32x32x16_bf16(V1, P1, O1b, 0, 0, 0);
        }
    }
    ATT_STORE(orow0, O0a, O0b, l0);
    ATT_STORE(orow1, O1a, O1b, l1);
    if (TYPE == 1 && hh == 0) { *(GAS float*)lse0 = (m0 + __builtin_amdgcn_logf(l0)) * LN2; *(GAS float*)lse1 = (m1 + __builtin_amdgcn_logf(l1)) * LN2; }
}

__device__ __forceinline__ void ph_att(Frame& F, int l) { LAUNDER(F); asm volatile("" : "+s"(l));
    LAS unsigned char* wl = F.lds + RING_OFF + F.wave * 16384;
    const bf16* qkv = (const bf16*)(F.ws + WS_QKV); bf16* oabc = (bf16*)(F.ws + WS_OABC); bf16* og = (bf16*)(F.ws + WS_OG); float* lse = (float*)(F.ws + WS_LSE);
    const float* TA = (const float*)(F.ws + WS_TABA); const float* TB = (const float*)(F.ws + WS_TABB); const float* TC = (const float*)(F.ws + WS_TABC) + (size_t)l * 8 * 1024;
    const float* sink = F.in[6] + l * 8;
    const int gw = F.vcu * NWAVES + F.wave, NGW = F.G * NWAVES;
    for (int task = gw; task < NT_ALL; task += NGW) {
        int lane = F.lane; asm volatile("" : "+v"(lane)); const int qi = lane & 31;
        if (task < NT_A) {
            const int hp = task & 3, qb = (task >> 2) & 255, b = task >> 10, q0 = qb * 32, h0 = hp * 2, h1 = h0 + 1, kvh = hp >> 1;
            int tlo = 0, thi = 8; if (q0 - 128 < 0) tlo = (128 - q0) / 32; if (q0 + 128 + 31 >= L) thi = (L - 1 - (q0 - 128)) / 32;
            const int tq = q0 + qi; bf16* orow = oabc + (size_t)(b * L + tq) * OW;
            att_task2<0>(wl, lane, qkv + (size_t)b * L * QKVW, TA + h0 * 320, TA + h1 * 320, AQ + h0 * 64, AQ + h1 * 64, AK + kvh * 64, AV + kvh * 64, q0 - 128, 32, 1, tlo, thi,
                         tq, tq, 0, 0, 0, 0, 0, sink[h0] * LOG2E, sink[h1] * LOG2E, 1.0f, orow + h0 * 64, orow + h1 * 64, nullptr, nullptr);
        } else if (task < NT_A + NT_B) {
            const int j = task - NT_A, h = j & 3, sbi = (j >> 2) & 127, bg = j >> 9, g = bg % 3, b = bg / 3;
            const int dsh = 2 * g, d = 1 << dsh, nsb = 128 >> dsh, r = sbi / nsb, sb = sbi % nsb, q0 = sb * 64, Ls = L >> dsh;
            int tlo = 0, thi = 5; if (q0 - 64 < 0) tlo = (64 - q0) / 32; if (q0 + 32 + 64 + 31 >= Ls) thi = (Ls - 1 - (q0 - 64)) / 32;
            const int tq0 = (q0 + qi) * d + r, tq1 = (q0 + 32 + qi) * d + r, qc = BQ0 + 768 * g + h * 64;
            att_task2<1>(wl, lane, qkv + (size_t)b * L * QKVW, TB + (g * 4 + h) * 256, nullptr, qc, qc, qc + 256, qc + 512, (q0 - 64) * d + r, 32 * d, d, tlo, thi,
                         tq0, tq1, 1, 0, 0, 0, 0, MINIT, MINIT, 0.0f, og + ((size_t)(b * L + tq0) * 3 + g) * 256 + h * 64, og + ((size_t)(b * L + tq1) * 3 + g) * 256 + h * 64,
                         lse + ((size_t)(b * L + tq0) * 3 + g) * 4 + h, lse + ((size_t)(b * L + tq1) * 3 + g) * 4 + h);
        } else {
            const int j = task - NT_A - NT_B, h = j & 7, cbi = (j >> 3) & 127, b = j >> 10, ip = cbi >> 2, cb = cbi & 3;
            const int gi0 = 4 * ip + (qi >> 4), gi1 = gi0 + 2, gc = 16 * cb + (qi & 15), tq0 = gi0 * 64 + gc, tq1 = gi1 * 64 + gc;
            int cbs = 16 * cb - 8; cbs = cbs < 0 ? 0 : (cbs > 32 ? 32 : cbs);
            int rlo = 4 * ip - 4; rlo = rlo < 0 ? 0 : (rlo > 120 ? 120 : rlo);
            int rhi = 4 * ip + 3 - 4; rhi = rhi < 0 ? 0 : (rhi > 120 ? 120 : rhi); rhi += 7;
            bf16* ob = oabc + (size_t)(b * L) * OW + 768 + h * 64;
            att_task2<2>(wl, lane, qkv + (size_t)b * L * QKVW, TC + h * 1024, nullptr, CQ + h * 64, CQ + h * 64, CK + h * 64, CV + h * 64, cbs, 64, 1, rlo, rhi,
                         tq0, tq1, 0, gi0, gi1, gc, cbs, MINIT, MINIT, 0.0f, ob + (size_t)tq0 * OW, ob + (size_t)tq1 * OW, nullptr, nullptr);
        }
    }
}

constexpr int NSTEPS = 1 + DEPTH * 16;
__global__ void __launch_bounds__(NTHREADS, 2) mk_fwd(Args args) {
    extern __shared__ __attribute__((aligned(16))) unsigned char lds[];
    Frame F;
    F.lds = (LAS unsigned char*)lds; F.wave = __builtin_amdgcn_readfirstlane((int)threadIdx.x >> 6); F.lane = hw_lane(); F.tid = F.wave * 64 + F.lane;
    F.G = gridDim.x; { const int bx = blockIdx.x; F.vcu = (F.G % 8 == 0) ? (bx % 8) * (F.G / 8) + bx / 8 : bx; }
    F.in = args.in; F.h = args.out; F.ws = args.ws; F.probe = args.probe;
    volatile LAS unsigned* MISC = (volatile LAS unsigned*)(F.lds + MISC_OFF);
    if (F.tid < 32) MISC[F.tid] = 0u;
    __syncthreads();
    const int lo = args.s_lo, hi = args.s_hi;
    XcdBarrier bar; bar.wave0 = (F.wave == 0); bar.bar = (unsigned*)(F.ws + WS_CTL) + CW_BAR; bar.x = 0; bar.st = nullptr;
    if (hi - lo > 1) bar = xcd_barrier_post((unsigned*)(F.ws + WS_CTL) + CW_BAR, MISC + 8, F.wave == 0);
#define RUN(s) (lo <= (s) && (s) < hi)
#define SEAM(s) do { if (RUN(s) && RUN((s) + 1)) xcd_barrier(bar); } while (0)
    if (RUN(0)) { ph_prologue(F); ph_tables(F); ph_ln0(F); }
    SEAM(0);
    for (int l = 0; l < DEPTH; ++l) {
        const int sb = 1 + l * 16;
        for (int c = 0; c < NCHUNK; ++c) {
            const int s = sb + c * 6;
            if (RUN(s)) ph_p1(F, l, c);
            SEAM(s);
            if (RUN(s + 1)) ph_att(F, l);
            SEAM(s + 1);
            if (RUN(s + 2)) ph_cmb(F);
            SEAM(s + 2);
            if (RUN(s + 3)) ph_p3(F, l);
            SEAM(s + 3);
            if (RUN(s + 4)) ph_p4(F, l, c);
            SEAM(s + 4);
            if (RUN(s + 5)) ph_ln1(F, l, c);
            SEAM(s + 5);
        }
        if (RUN(sb + 12)) ph_dsp(F, l);
        SEAM(sb + 12);
        if (RUN(sb + 13)) ph_p7(F, l);
        SEAM(sb + 13);
        if (RUN(sb + 14)) ph_p8(F, l);
        SEAM(sb + 14);
        if (RUN(sb + 15)) ph_ln2(F, l);
        SEAM(sb + 15);
    }
#undef RUN
#undef SEAM
}

#ifndef DUP_NOEPI
#define DUP_NOEPI 0
#endif
#ifndef FAST_MASK
#define FAST_MASK 0x7FF
#endif
#ifndef ONE_LAUNCH
#define ONE_LAUNCH 1
#endif
extern "C" void kernel_launch(void* const* d_in, const int* in_sizes, int n_in, void* d_out, int out_size, void* d_ws, size_t ws_size, hipStream_t stream) {
    static int grid = 0;
    if (grid == 0) {
        if (n_in != 23 || out_size != T * D || ws_size < WS_END) { fprintf(stderr, "kernel_launch: unexpected shapes (n_in %d out %d ws %zu)\n", n_in, out_size, ws_size); grid = -1; return; }
        int dev = 0, cus = 0, per_cu = 0;
        if (hipGetDevice(&dev) != hipSuccess || hipDeviceGetAttribute(&cus, hipDeviceAttributeMultiprocessorCount, dev) != hipSuccess) { grid = -1; return; }
        if (hipFuncSetAttribute((const void*)mk_fwd, hipFuncAttributeMaxDynamicSharedMemorySize, LDS_BYTES) != hipSuccess) { fprintf(stderr, "kernel_launch: hipFuncSetAttribute failed\n"); grid = -1; return; }
        if (hipOccupancyMaxActiveBlocksPerMultiprocessor(&per_cu, (const void*)mk_fwd, NTHREADS, LDS_BYTES) != hipSuccess || per_cu < 1) fprintf(stderr, "kernel_launch: occupancy query reports %d\n", per_cu);
        (void)hipGetLastError();
        grid = cus;
    }
    if (grid < 0) return;
    const float* x = (const float*)d_in[0]; const float* ln0_g = (const float*)d_in[1]; const float* ln0_b = (const float*)d_in[2]; const float* rel_bias = (const float*)d_in[3];
    const float* w_in = (const float*)d_in[4]; const float* b_gate = (const float*)d_in[5]; const float* sink_a = (const float*)d_in[6]; const float* rpb_c = (const float*)d_in[7];
    const float* w_br_a = (const float*)d_in[8]; const float* w_br_b = (const float*)d_in[9]; const float* w_br_c = (const float*)d_in[10]; const float* w_out = (const float*)d_in[11];
    const float* ln1_g = (const float*)d_in[12]; const float* ln1_b = (const float*)d_in[13]; const float* w_rg = (const float*)d_in[14]; const float* b_rg = (const float*)d_in[15];
    const float* w_re = (const float*)d_in[16]; const float* b_re = (const float*)d_in[17]; const float* w_eg = (const float*)d_in[18]; const float* w_eu = (const float*)d_in[19];
    const float* w_ed = (const float*)d_in[20]; const float* ln2_g = (const float*)d_in[21]; const float* ln2_b = (const float*)d_in[22];
    unsigned char* ws = (unsigned char*)d_ws; float* h = (float*)d_out;
    bf16* hb = (bf16*)(ws + WS_HB); bf16* qkv = (bf16*)(ws + WS_QKV); bf16* gates = (bf16*)(ws + WS_GATES); bf16* oabc = (bf16*)(ws + WS_OABC); bf16* og = (bf16*)(ws + WS_OG);
    float* lse = (float*)(ws + WS_LSE); Rec* rec = (Rec*)(ws + WS_REC); int* rowtok = (int*)(ws + WS_ROWTOK); float* rowgate = (float*)(ws + WS_ROWGATE);
    bf16* merged = (bf16*)(ws + WS_MERGED); bf16* hid = (bf16*)(ws + WS_HID); bf16* yb = (bf16*)(ws + WS_YB); int* cnt = (int*)(ws + WS_CTL) + CW_CNT;
    (void)hipMemsetAsync(ws + WS_CTL, 0, CTL_ZERO_BYTES, stream);
    Args a{};
    for (int i = 0; i < 23; ++i) a.in[i] = (const float*)d_in[i];
    a.out = h; a.ws = ws;
    if (ONE_LAUNCH) { a.s_lo = 0; a.s_hi = NSTEPS; hipLaunchKernelGGL(mk_fwd, dim3(grid), dim3(NTHREADS), LDS_BYTES, stream, a); return; }
    const int G = 2048;
    const bool fastp1 = (FAST_MASK >> 1) & 1;
    for (int s = 0; s < NSTEPS; ++s) {
        int kind, l = 0, c = 0;
        if (s == 0) kind = 0; else { const int r = (s - 1) % 16; l = (s - 1) / 16; if (r < 12) { c = r / 6; kind = 1 + r % 6; } else kind = 7 + (r - 12); }
        if ((FAST_MASK >> kind) & 1) { a.s_lo = s; a.s_hi = s + 1;
#ifdef DUP_KIND
            if (kind == DUP_KIND && (kind == 5 || kind == 6 || kind == 10 || (kind == 1 && DUP_NOEPI))) { a.probe = 1; hipLaunchKernelGGL(mk_fwd, dim3(grid), dim3(NTHREADS), LDS_BYTES, stream, a); a.probe = 0; }
#endif
            hipLaunchKernelGGL(mk_fwd, dim3(grid), dim3(NTHREADS), LDS_BYTES, stream, a);
#ifdef DUP_KIND
            if (kind == DUP_KIND && !(kind == 5 || kind == 6 || kind == 10 || (kind == 1 && DUP_NOEPI))) { hipLaunchKernelGGL(mk_fwd, dim3(grid), dim3(NTHREADS), LDS_BYTES, stream, a); }
#endif
            continue; }
        const size_t r0 = (size_t)c * CH;
        switch (kind) {
        case 0: k_ln<<<G, 256, 0, stream>>>(0, x, h, hb, nullptr, ln0_g, ln0_b, 0, T); break;
        case 1: k_p1<<<G, 256, 0, stream>>>(hb + r0 * D, w_in + (size_t)l * D * NCOL, b_gate + (size_t)l * GATEW, qkv, gates); break;
        case 2: k_attn_naive<<<(28 * CH + 255) / 256, 256, 0, stream>>>(qkv, oabc, og, lse, rel_bias, sink_a + l * 8, rpb_c + (size_t)l * 8 * 15 * 31, fastp1 ? LN2 : 0.125f); break;
        case 3: k_combine<<<(CH * 32 + 255) / 256, 256, 0, stream>>>(og, lse, oabc); break;
        case 4: k_p3<<<G, 256, 0, stream>>>(oabc, gates, w_br_a + (size_t)l * 512 * D, w_br_b + (size_t)l * 256 * D, w_br_c + (size_t)l * 512 * D, merged); break;
        case 5: k_p4<<<G, 256, 0, stream>>>(merged, w_out + (size_t)l * D * D, h + r0 * D); break;
        case 6: k_ln<<<G, 256, 0, stream>>>(1, nullptr, h, hb, nullptr, ln1_g + l * D, ln1_b + l * D, (int)r0, CH);
                if (c == NCHUNK - 1) k_router<<<G, 256, 0, stream>>>(h, w_rg + (size_t)l * D * 4, b_rg + l * 4, w_re + (size_t)l * 4 * D * 8, b_re + l * 32, cnt + l * (32 * CSTR), rec);
                break;
        case 7: (void)hipMemsetAsync(rowtok, 0xFF, (size_t)PROWS * 4, stream); k_dispatch<<<256, 256, 0, stream>>>(cnt + l * (32 * CSTR), rec, rowtok, rowgate); break;
        case 8: k_p7<<<G, 256, 0, stream>>>(hb, cnt + l * (32 * CSTR), rowtok, w_eg + (size_t)l * NE * D * DE, w_eu + (size_t)l * NE * D * DE, hid); break;
        case 9: k_p8<<<G, 256, 0, stream>>>(hid, cnt + l * (32 * CSTR), rowtok, rowgate, w_ed + (size_t)l * NE * DE * D, yb); break;
        case 10: k_ln<<<G, 256, 0, stream>>>(2, nullptr, h, (l == DEPTH - 1) ? nullptr : hb, yb, ln2_g + l * D, ln2_b + l * D, 0, T); break;
        }
    }
}
```

```cpp
#include <hip/hip_runtime.h>
#include <cstdio>
#include <cstdint>
#include <cmath>

typedef unsigned short bf16;
typedef short bf16x8 __attribute__((ext_vector_type(8)));
typedef float f32x16 __attribute__((ext_vector_type(16)));
typedef float f32x4 __attribute__((ext_vector_type(4)));

constexpr int D = 1024, L = 8192, NBATCH = 8, T = NBATCH * L, DEPTH = 2;
constexpr int NCOL = 7680, QKVW = 4608, GATEW = 3072;
constexpr int CH = 32768, NCHUNK = T / CH;
constexpr int OW = 1280;
constexpr int NE = 32, DE = 512;
constexpr int MAXRT = T * 2 / 256 + NE, PROWS = MAXRT * 256;
constexpr float LN_EPS = 1e-5f;
constexpr float ALPHA = 1.41421356237309515f;
constexpr int AQ = 0, AK = 512, AV = 640, BQ0 = 768, CQ = 3072, CK = 3584, CV = 4096;

constexpr size_t MiB = 1u << 20;
constexpr size_t WS_CTL = 0;
constexpr size_t WS_WIN = 1 * MiB, WS_WBRA = 31 * MiB, WS_WBRB = 33 * MiB, WS_WBRC = 34 * MiB, WS_WOUT = 36 * MiB, WS_WGU = 40 * MiB, WS_WD = 168 * MiB;
constexpr size_t WS_HB = 232 * MiB, WS_QKV = 360 * MiB, WS_GATES = 648 * MiB, WS_OABC = 840 * MiB, WS_OG = 920 * MiB, WS_LSE = 968 * MiB,
                 WS_REC = 970 * MiB, WS_ROWTOK = 972 * MiB, WS_ROWGATE = 973 * MiB, WS_TABA = 974 * MiB, WS_TABB = WS_TABA + 16384, WS_TABC = WS_TABA + 32768, WS_WGCNT = WS_TABA + 131072  , WS_END = 975 * MiB;
constexpr size_t WS_MERGED = WS_QKV, WS_HID = WS_QKV, WS_YB = WS_QKV + 136 * MiB;
constexpr int CSTR = 32;

__device__ __constant__ signed char BUCK_A[257] = {12,11,11,11,11,11,11,11,11,11,11,11,11,11,11,11,11,11,11,11,11,11,11,11,11,11,11,11,11,11,11,11,11,11,11,11,11,11,11,11,11,11,11,11,11,11,11,11,11,11,11,11,11,11,11,11,11,11,11,11,11,11,11,11,11,10,10,10,10,10,10,10,10,10,10,10,10,10,10,10,10,10,10,10,10,10,10,10,10,10,10,10,10,10,10,10,10,9,9,9,9,9,9,9,9,9,9,9,9,9,9,9,9,8,8,8,8,8,8,8,8,7,6,5,4,3,2,1,0,17,18,19,20,21,22,23,24,24,24,24,24,24,24,24,25,25,25,25,25,25,25,25,25,25,25,25,25,25,25,25,26,26,26,26,26,26,26,26,26,26,26,26,26,26,26,26,26,26,26,26,26,26,26,26,26,26,26,26,26,26,26,26,27,27,27,27,27,27,27,27,27,27,27,27,27,27,27,27,27,27,27,27,27,27,27,27,27,27,27,27,27,27,27,27,27,27,27,27,27,27,27,27,27,27,27,27,27,27,27,27,27,27,27,27,27,27,27,27,27,27,27,27,27,27,27,27,28};
__device__ __constant__ signed char BUCK_B[3][129] = {
 {11,10,10,10,10,10,10,10,10,10,10,10,10,10,10,10,10,10,10,10,10,10,10,10,10,10,10,10,10,10,10,10,10,9,9,9,9,9,9,9,9,9,9,9,9,9,9,9,9,8,8,8,8,8,8,8,8,7,6,5,4,3,2,1,0,17,18,19,20,21,22,23,24,24,24,24,24,24,24,24,25,25,25,25,25,25,25,25,25,25,25,25,25,25,25,25,26,26,26,26,26,26,26,26,26,26,26,26,26,26,26,26,26,26,26,26,26,26,26,26,26,26,26,26,26,26,26,26,27},
 {13,12,12,12,12,12,12,12,12,12,12,12,12,12,12,12,12,12,12,12,12,12,12,12,12,12,12,12,12,12,12,12,12,11,11,11,11,11,11,11,11,11,11,11,11,11,11,11,11,10,10,10,10,10,10,10,10,9,9,9,9,8,8,4,0,20,24,24,25,25,25,25,26,26,26,26,26,26,26,26,27,27,27,27,27,27,27,27,27,27,27,27,27,27,27,27,28,28,28,28,28,28,28,28,28,28,28,28,28,28,28,28,28,28,28,28,28,28,28,28,28,28,28,28,28,28,28,28,29},
 {15,14,14,14,14,14,14,14,14,14,14,14,14,14,14,14,14,14,14,14,14,14,14,14,14,14,14,14,14,14,14,14,14,13,13,13,13,13,13,13,13,13,13,13,13,13,13,13,13,12,12,12,12,12,12,12,12,11,11,11,11,10,10,9,0,25,26,26,27,27,27,27,28,28,28,28,28,28,28,28,29,29,29,29,29,29,29,29,29,29,29,29,29,29,29,29,30,30,30,30,30,30,30,30,30,30,30,30,30,30,30,30,30,30,30,30,30,30,30,30,30,30,30,30,30,30,30,30,31}};

__device__ __forceinline__ float bf2f(bf16 b) { return __uint_as_float(((unsigned)b) << 16); }
__device__ __forceinline__ bf16 f2bf(float f) { unsigned u = __float_as_uint(f); u += 0x7fffu + ((u >> 16) & 1u); return (bf16)(u >> 16); }
__device__ __forceinline__ float wave_sum(float v) {
#pragma unroll
    for (int o = 1; o < 64; o <<= 1) v += __shfl_xor(v, o);
    return v;
}

__global__ __launch_bounds__(256) void k_ln(int mode, const float* src, float* h, bf16* hb, const bf16* yb, const float* g, const float* bta, int row0, int nrows) {
    const int lane = threadIdx.x & 63, wv = blockIdx.x * 4 + (threadIdx.x >> 6), nw = gridDim.x * 4;
    for (int rr = wv; rr < nrows; rr += nw) {
        const size_t row = (size_t)row0 + rr;
        f32x4 v[4];
#pragma unroll
        for (int j = 0; j < 4; ++j) {
            const int c = lane * 4 + 256 * j;
            v[j] = *(const f32x4*)((mode == 0 ? src : h) + row * D + c);
            if (mode == 2) {
                const uint2 a = *(const uint2*)(yb + (row * 2) * D + c), b = *(const uint2*)(yb + (row * 2 + 1) * D + c);
                v[j].x = ALPHA * v[j].x + bf2f((bf16)(a.x & 0xffff)) + bf2f((bf16)(b.x & 0xffff));
                v[j].y = ALPHA * v[j].y + bf2f((bf16)(a.x >> 16)) + bf2f((bf16)(b.x >> 16));
                v[j].z = ALPHA * v[j].z + bf2f((bf16)(a.y & 0xffff)) + bf2f((bf16)(b.y & 0xffff));
                v[j].w = ALPHA * v[j].w + bf2f((bf16)(a.y >> 16)) + bf2f((bf16)(b.y >> 16));
            }
        }
        float s = 0.f;
#pragma unroll
        for (int j = 0; j < 4; ++j) s += (v[j].x + v[j].y) + (v[j].z + v[j].w);
        const float mean = wave_sum(s) * (1.f / D);
        float q = 0.f;
#pragma unroll
        for (int j = 0; j < 4; ++j) { v[j] = v[j] - mean; q += (v[j].x * v[j].x + v[j].y * v[j].y) + (v[j].z * v[j].z + v[j].w * v[j].w); }
        const float rstd = 1.0f / sqrtf(wave_sum(q) * (1.f / D) + LN_EPS);
#pragma unroll
        for (int j = 0; j < 4; ++j) {
            const int c = lane * 4 + 256 * j;
            const f32x4 gg = *(const f32x4*)(g + c), bb = *(const f32x4*)(bta + c);
            const f32x4 o = v[j] * rstd * gg + bb;
            *(f32x4*)(h + row * D + c) = o;
            if (hb) { uint2 w; w.x = (unsigned)f2bf(o.x) | ((unsigned)f2bf(o.y) << 16); w.y = (unsigned)f2bf(o.z) | ((unsigned)f2bf(o.w) << 16); *(uint2*)(hb + row * D + c) = w; }
        }
    }
}

__device__ __forceinline__ void wave_gemm32(const bf16* arow, const float* wcol, int ldw, int K, f32x16& acc) {
    for (int k0 = 0; k0 < K; k0 += 16) {
        const bf16x8 a = *(const bf16x8*)(arow + k0);
        bf16x8 b;
#pragma unroll
        for (int j = 0; j < 8; ++j) b[j] = (short)f2bf(wcol[(size_t)(k0 + j) * ldw]);
        acc = __builtin_amdgcn_mfma_f32_32x32x16_bf16(a, b, acc, 0, 0, 0);
    }
}
#define ACC_ROW(reg, h) (((reg) & 3) + 8 * ((reg) >> 2) + 4 * (h))

__global__ __launch_bounds__(256) void k_p1(const bf16* hbc, const float* w_in, const float* b_gate, bf16* qkv, bf16* gates) {
    const int lane = threadIdx.x & 63, r = lane & 31, hh = lane >> 5;
    const int wv = blockIdx.x * 4 + (threadIdx.x >> 6), nw = gridDim.x * 4;
    const int ntn = NCOL / 32, total = (CH / 32) * ntn;
    for (int tile = wv; tile < total; tile += nw) {
        const int tm = tile / ntn, tn = tile % ntn;
        f32x16 acc; for (int i = 0; i < 16; ++i) acc[i] = 0.f;
        wave_gemm32(hbc + (size_t)(tm * 32 + r) * D + 8 * hh, w_in + (size_t)(8 * hh) * NCOL + tn * 32 + r, NCOL, D, acc);
        const int col = tn * 32 + r;
#pragma unroll
        for (int i = 0; i < 16; ++i) {
            const int row = tm * 32 + ACC_ROW(i, hh);
            if (col < QKVW) qkv[(size_t)row * QKVW + col] = f2bf(acc[i]);
            else { const float z = acc[i] + b_gate[col - QKVW]; gates[(size_t)row * GATEW + (col - QKVW)] = f2bf(1.0f / (1.0f + __expf(-z))); }
        }
    }
}

__global__ __launch_bounds__(256) void k_attn_naive(const bf16* qkv, bf16* oabc, bf16* og, float* lse, const float* rel_bias, const float* sink_l, const float* rpb_l, float sc) {
    const long idx = (long)blockIdx.x * 256 + threadIdx.x;
    if (idx >= (long)28 * CH) return;
    const int ht = (int)(idx / CH), tl = (int)(idx % CH), b = tl / L, t = tl % L;
    const bf16* base = qkv + (size_t)(b * L) * QKVW;
    int qcol, kcol, vcol;
    if (ht < 8) { qcol = AQ + ht * 64; kcol = AK + (ht >> 2) * 64; vcol = AV + (ht >> 2) * 64; }
    else if (ht < 20) { const int g = (ht - 8) >> 2, h = (ht - 8) & 3; qcol = BQ0 + 768 * g + h * 64; kcol = qcol + 256; vcol = qcol + 512; }
    else { const int h = ht - 20; qcol = CQ + h * 64; kcol = CK + h * 64; vcol = CV + h * 64; }
    float q[64], o[64];
    {
        const uint4* qp = (const uint4*)(base + (size_t)t * QKVW + qcol);
#pragma unroll
        for (int c = 0; c < 8; ++c) { const uint4 u = qp[c]; const unsigned w[4] = {u.x, u.y, u.z, u.w};
#pragma unroll
            for (int i = 0; i < 4; ++i) { q[8 * c + 2 * i] = bf2f((bf16)(w[i] & 0xffff)); q[8 * c + 2 * i + 1] = bf2f((bf16)(w[i] >> 16)); } }
    }
#pragma unroll
    for (int i = 0; i < 64; ++i) o[i] = 0.f;
    float m = -1e30f, l = 0.f;
    if (ht < 8) { m = sink_l[ht]; l = 1.f; }
#define PROC_KEY(KT, BIAS) do { \
        const uint4* kp = (const uint4*)(base + (size_t)(KT) * QKVW + kcol); float s = 0.f; \
        _Pragma("unroll") for (int c = 0; c < 8; ++c) { const uint4 u = kp[c]; const unsigned w[4] = {u.x, u.y, u.z, u.w}; \
            _Pragma("unroll") for (int i = 0; i < 4; ++i) { s += q[8 * c + 2 * i] * bf2f((bf16)(w[i] & 0xffff)); s += q[8 * c + 2 * i + 1] * bf2f((bf16)(w[i] >> 16)); } } \
        s = s * sc + (BIAS); const float mn = fmaxf(m, s), corr = __expf(m - mn), p = __expf(s - mn); l = l * corr + p; m = mn; \
        const uint4* vp = (const uint4*)(base + (size_t)(KT) * QKVW + vcol); \
        _Pragma("unroll") for (int c = 0; c < 8; ++c) { const uint4 u = vp[c]; const unsigned w[4] = {u.x, u.y, u.z, u.w}; \
            _Pragma("unroll") for (int i = 0; i < 4; ++i) { o[8 * c + 2 * i] = o[8 * c + 2 * i] * corr + p * bf2f((bf16)(w[i] & 0xffff)); o[8 * c + 2 * i + 1] = o[8 * c + 2 * i + 1] * corr + p * bf2f((bf16)(w[i] >> 16)); } } \
    } while (0)
    if (ht < 8) {
        for (int rel = -128; rel <= 128; ++rel) { const int kt = t + rel; if (kt < 0 || kt >= L) continue;
            const float bias = rel_bias[BUCK_A[rel + 128] * 20 + ht]; PROC_KEY(kt, bias); }
    } else if (ht < 20) {
        const int g = (ht - 8) >> 2, h = (ht - 8) & 3, dil = (g == 0) ? 1 : (g == 1 ? 4 : 16);
        for (int off = -64; off <= 64; ++off) { const int kt = t + off * dil; if (kt < 0 || kt >= L) continue;
            const float bias = rel_bias[BUCK_B[g][off + 64] * 20 + 8 + 4 * g + h]; PROC_KEY(kt, bias); }
    } else {
        const int h = ht - 20, gi = t >> 6, gc = t & 63;
        int rs = gi - 4; rs = rs < 0 ? 0 : (rs > 120 ? 120 : rs);
        int cs = gc - 8; cs = cs < 0 ? 0 : (cs > 48 ? 48 : cs);
        for (int kr = rs; kr < rs + 8; ++kr)
            for (int kc = cs; kc < cs + 16; ++kc) { const float bias = rpb_l[(h * 15 + (kr - gi + 7)) * 31 + (kc - gc + 15)]; const int kt = kr * 64 + kc; PROC_KEY(kt, bias); }
    }
#undef PROC_KEY
    const float inv = 1.0f / l;
    bf16* dst;
    if (ht < 8) dst = oabc + (size_t)tl * OW + ht * 64;
    else if (ht < 20) { const int g = (ht - 8) >> 2, h = (ht - 8) & 3; dst = og + ((size_t)tl * 3 + g) * 256 + h * 64; lse[((size_t)tl * 3 + g) * 4 + h] = m + __logf(l); }
    else dst = oabc + (size_t)tl * OW + 768 + (ht - 20) * 64;
#pragma unroll
    for (int c = 0; c < 8; ++c) { uint4 u;
        u.x = (unsigned)f2bf(o[8 * c + 0] * inv) | ((unsigned)f2bf(o[8 * c + 1] * inv) << 16); u.y = (unsigned)f2bf(o[8 * c + 2] * inv) | ((unsigned)f2bf(o[8 * c + 3] * inv) << 16);
        u.z = (unsigned)f2bf(o[8 * c + 4] * inv) | ((unsigned)f2bf(o[8 * c + 5] * inv) << 16); u.w = (unsigned)f2bf(o[8 * c + 6] * inv) | ((unsigned)f2bf(o[8 * c + 7] * inv) << 16);
        ((uint4*)dst)[c] = u; }
}

__global__ __launch_bounds__(256) void k_combine(const bf16* og, const float* lse, bf16* oabc) {
    const long idx = (long)blockIdx.x * 256 + threadIdx.x;
    if (idx >= (long)CH * 32) return;
    const int tl = (int)(idx >> 5), hc = (int)(idx & 31), h = hc >> 3, c = hc & 7;
    const float l0 = lse[((size_t)tl * 3 + 0) * 4 + h], l1 = lse[((size_t)tl * 3 + 1) * 4 + h], l2 = lse[((size_t)tl * 3 + 2) * 4 + h];
    const float mx = fmaxf(l0, fmaxf(l1, l2)); float w0 = __expf(l0 - mx), w1 = __expf(l1 - mx), w2 = __expf(l2 - mx); const float inv = 1.0f / (w0 + w1 + w2); w0 *= inv; w1 *= inv; w2 *= inv;
    const uint4 a = *(const uint4*)(og + ((size_t)tl * 3 + 0) * 256 + h * 64 + c * 8), b = *(const uint4*)(og + ((size_t)tl * 3 + 1) * 256 + h * 64 + c * 8), d = *(const uint4*)(og + ((size_t)tl * 3 + 2) * 256 + h * 64 + c * 8);
    const unsigned aw[4] = {a.x, a.y, a.z, a.w}, bw[4] = {b.x, b.y, b.z, b.w}, dw[4] = {d.x, d.y, d.z, d.w}; unsigned ow[4];
#pragma unroll
    for (int i = 0; i < 4; ++i) {
        const float lo = w0 * bf2f((bf16)(aw[i] & 0xffff)) + w1 * bf2f((bf16)(bw[i] & 0xffff)) + w2 * bf2f((bf16)(dw[i] & 0xffff));
        const float hi = w0 * bf2f((bf16)(aw[i] >> 16)) + w1 * bf2f((bf16)(bw[i] >> 16)) + w2 * bf2f((bf16)(dw[i] >> 16));
        ow[i] = (unsigned)f2bf(lo) | ((unsigned)f2bf(hi) << 16);
    }
    *(uint4*)(oabc + (size_t)tl * OW + 512 + h * 64 + c * 8) = make_uint4(ow[0], ow[1], ow[2], ow[3]);
}

__global__ __launch_bounds__(256) void k_p3(const bf16* oabc, const bf16* gates, const float* wa, const float* wb, const float* wc, bf16* merged) {
    const int lane = threadIdx.x & 63, r = lane & 31, hh = lane >> 5;
    const int wv = blockIdx.x * 4 + (threadIdx.x >> 6), nw = gridDim.x * 4;
    const int ntn = D / 32, total = (CH / 32) * ntn;
    for (int tile = wv; tile < total; tile += nw) {
        const int tm = tile / ntn, tn = tile % ntn, col = tn * 32 + r;
        f32x16 mg; for (int i = 0; i < 16; ++i) mg[i] = 0.f;
#pragma unroll 1
        for (int br = 0; br < 3; ++br) {
            f32x16 acc; for (int i = 0; i < 16; ++i) acc[i] = 0.f;
            const int koff = br == 0 ? 0 : (br == 1 ? 512 : 768), K = br == 1 ? 256 : 512;
            const float* w = br == 0 ? wa : (br == 1 ? wb : wc);
            wave_gemm32(oabc + (size_t)(tm * 32 + r) * OW + koff + 8 * hh, w + (size_t)(8 * hh) * D + col, D, K, acc);
#pragma unroll
            for (int i = 0; i < 16; ++i) { const int row = tm * 32 + ACC_ROW(i, hh); mg[i] += bf2f(gates[(size_t)row * GATEW + br * 1024 + col]) * acc[i]; }
        }
#pragma unroll
        for (int i = 0; i < 16; ++i) { const int row = tm * 32 + ACC_ROW(i, hh); merged[(size_t)row * D + col] = f2bf(mg[i]); }
    }
}
__global__ __launch_bounds__(256) void k_p4(const bf16* merged, const float* wo, float* hchunk) {
    const int lane = threadIdx.x & 63, r = lane & 31, hh = lane >> 5;
    const int wv = blockIdx.x * 4 + (threadIdx.x >> 6), nw = gridDim.x * 4;
    const int ntn = D / 32, total = (CH / 32) * ntn;
    for (int tile = wv; tile < total; tile += nw) {
        const int tm = tile / ntn, tn = tile % ntn, col = tn * 32 + r;
        f32x16 acc; for (int i = 0; i < 16; ++i) acc[i] = 0.f;
        wave_gemm32(merged + (size_t)(tm * 32 + r) * D + 8 * hh, wo + (size_t)(8 * hh) * D + col, D, D, acc);
#pragma unroll
        for (int i = 0; i < 16; ++i) { const int row = tm * 32 + ACC_ROW(i, hh); float* p = hchunk + (size_t)row * D + col; *p = ALPHA * *p + acc[i]; }
    }
}

struct Rec { int e0, s0, e1, s1; float g0, g1; int pad0, pad1; };
__global__ __launch_bounds__(256) void k_router(const float* h, const float* w_rg, const float* b_rg, const float* w_re, const float* b_re, int* cnt, Rec* rec) {
    const int lane = threadIdx.x & 63, wv = blockIdx.x * 4 + (threadIdx.x >> 6), nw = gridDim.x * 4;
    for (int t = wv; t < T; t += nw) {
        float x[16];
#pragma unroll
        for (int j = 0; j < 4; ++j) { const f32x4 v = *(const f32x4*)(h + (size_t)t * D + lane * 4 + 256 * j); x[4 * j] = v.x; x[4 * j + 1] = v.y; x[4 * j + 2] = v.z; x[4 * j + 3] = v.w; }
        float gl[4] = {0.f, 0.f, 0.f, 0.f};
#pragma unroll
        for (int j = 0; j < 4; ++j)
#pragma unroll
            for (int i = 0; i < 4; ++i) { const f32x4 w = *(const f32x4*)(w_rg + (size_t)(lane * 4 + 256 * j + i) * 4); const float xv = x[4 * j + i]; gl[0] += xv * w.x; gl[1] += xv * w.y; gl[2] += xv * w.z; gl[3] += xv * w.w; }
#pragma unroll
        for (int g = 0; g < 4; ++g) gl[g] = wave_sum(gl[g]) + b_rg[g];
        int gi = 0; float gm = gl[0];
#pragma unroll
        for (int g = 1; g < 4; ++g) if (gl[g] > gm) { gm = gl[g]; gi = g; }
        float gs = 0.f;
#pragma unroll
        for (int g = 0; g < 4; ++g) gs += __expf(gl[g] - gm);
        const float gw = 1.0f / gs;
        float el[8];
#pragma unroll
        for (int e = 0; e < 8; ++e) el[e] = 0.f;
        const float* wre = w_re + (size_t)gi * D * 8;
#pragma unroll
        for (int j = 0; j < 4; ++j)
#pragma unroll
            for (int i = 0; i < 4; ++i) { const float* wp = wre + (size_t)(lane * 4 + 256 * j + i) * 8; const f32x4 w0 = *(const f32x4*)wp, w1 = *(const f32x4*)(wp + 4); const float xv = x[4 * j + i];
                el[0] += xv * w0.x; el[1] += xv * w0.y; el[2] += xv * w0.z; el[3] += xv * w0.w; el[4] += xv * w1.x; el[5] += xv * w1.y; el[6] += xv * w1.z; el[7] += xv * w1.w; }
#pragma unroll
        for (int e = 0; e < 8; ++e) el[e] = wave_sum(el[e]) + b_re[gi * 8 + e];
        int i0 = 0; float t0 = el[0];
#pragma unroll
        for (int e = 1; e < 8; ++e) if (el[e] > t0) { t0 = el[e]; i0 = e; }
        int i1 = -1; float t1 = -3.0e38f;
#pragma unroll
        for (int e = 0; e < 8; ++e) if (e != i0 && el[e] > t1) { t1 = el[e]; i1 = e; }
        const float ex = __expf(t1 - t0), p0 = 1.0f / (1.0f + ex), p1 = ex / (1.0f + ex);
        if (lane == 0) {
            Rec rc; rc.e0 = gi * 8 + i0; rc.e1 = gi * 8 + i1; rc.g0 = gw * p0; rc.g1 = gw * p1; rc.pad0 = 0; rc.pad1 = 0;
            rc.s0 = atomicAdd(cnt + rc.e0 * CSTR, 1); rc.s1 = atomicAdd(cnt + rc.e1 * CSTR, 1);
            rec[t] = rc;
        }
    }
}
__device__ __forceinline__ void pad_offsets(const int* cnt, int* po) { int acc = 0; for (int e = 0; e < NE; ++e) { po[e] = acc; acc += (cnt[e * CSTR] + 255) / 256 * 256; } po[NE] = acc; }
__global__ __launch_bounds__(256) void k_dispatch(const int* cnt, const Rec* rec, int* rowtok, float* rowgate) {
    __shared__ int po[NE + 1];
    if (threadIdx.x == 0) pad_offsets(cnt, po);
    __syncthreads();
    for (int t = blockIdx.x * 256 + threadIdx.x; t < T; t += gridDim.x * 256) {
        const Rec rc = rec[t];
        const int d0 = po[rc.e0] + rc.s0, d1 = po[rc.e1] + rc.s1;
        rowtok[d0] = 2 * t; rowgate[d0] = rc.g0; rowtok[d1] = 2 * t + 1; rowgate[d1] = rc.g1;
    }
}
__global__ __launch_bounds__(256) void k_p7(const bf16* hb, const int* cnt, const int* rowtok, const float* w_eg, const float* w_eu, bf16* hid) {
    __shared__ int po[NE + 1];
    if (threadIdx.x == 0) pad_offsets(cnt, po);
    __syncthreads();
    const int lane = threadIdx.x & 63, r = lane & 31, hh = lane >> 5;
    const int wv = blockIdx.x * 4 + (threadIdx.x >> 6), nw = gridDim.x * 4;
    const int ntn = DE / 32, total = (po[NE] / 32) * ntn;
    for (int tile = wv; tile < total; tile += nw) {
        const int tm = tile / ntn, tn = tile % ntn, col = tn * 32 + r, row0 = tm * 32;
        int e = 0; while (e < NE - 1 && po[e + 1] <= row0) ++e;
        int tok = rowtok[row0 + r]; tok = tok < 0 ? 0 : (tok >> 1);
        f32x16 ag, au; for (int i = 0; i < 16; ++i) { ag[i] = 0.f; au[i] = 0.f; }
        wave_gemm32(hb + (size_t)tok * D + 8 * hh, w_eg + (size_t)e * D * DE + (size_t)(8 * hh) * DE + col, DE, D, ag);
        wave_gemm32(hb + (size_t)tok * D + 8 * hh, w_eu + (size_t)e * D * DE + (size_t)(8 * hh) * DE + col, DE, D, au);
#pragma unroll
        for (int i = 0; i < 16; ++i) { const int row = row0 + ACC_ROW(i, hh); const float gsl = ag[i] / (1.0f + __expf(-ag[i])); hid[(size_t)row * DE + col] = f2bf(gsl * au[i]); }
    }
}
__global__ __launch_bounds__(256) void k_p8(const bf16* hid, const int* cnt, const int* rowtok, const float* rowgate, const float* w_ed, bf16* yb) {
    __shared__ int po[NE + 1];
    if (threadIdx.x == 0) pad_offsets(cnt, po);
    __syncthreads();
    const int lane = threadIdx.x & 63, r = lane & 31, hh = lane >> 5;
    const int wv = blockIdx.x * 4 + (threadIdx.x >> 6), nw = gridDim.x * 4;
    const int ntn = D / 32, total = (po[NE] / 32) * ntn;
    for (int tile = wv; tile < total; tile += nw) {
        const int tm = tile / ntn, tn = tile % ntn, col = tn * 32 + r, row0 = tm * 32;
        int e = 0; while (e < NE - 1 && po[e + 1] <= row0) ++e;
        f32x16 acc; for (int i = 0; i < 16; ++i) acc[i] = 0.f;
        wave_gemm32(hid + (size_t)(row0 + r) * DE + 8 * hh, w_ed + (size_t)e * DE * D + (size_t)(8 * hh) * D + col, D, DE, acc);
#pragma unroll
        for (int i = 0; i < 16; ++i) { const int row = row0 + ACC_ROW(i, hh); const int rt = rowtok[row]; if (rt >= 0) yb[(size_t)rt * D + col] = f2bf(acc[i] * rowgate[row]); }
    }
}


namespace pg8 {
#define PG8_LAS __attribute__((address_space(3)))
typedef unsigned short bf16_t;
typedef unsigned u32x4 __attribute__((ext_vector_type(4)));
constexpr int BM = 256, BK = 64, HALF = 128, HTB = HALF * BK * 2  , STAGE_BYTES = 8 * HTB, NXCD = 8, WGM = 8;

__host__ __device__ __forceinline__ int lds_byte(int r, int c) { const int st = (r >> 4) * 2 + (c >> 5), rr = r & 15, cc = c & 31, ob = rr * 64 + cc * 2; return st * 1024 + (ob ^ (((ob >> 9) & 1) << 5)); }
__host__ __device__ __forceinline__ void stage_rc(int b, int& R, int& C) { const int st = b / 1024, sb = b % 1024, swz = sb ^ (((sb >> 9) & 1) << 5); R = (st >> 1) * 16 + swz / 64; C = (st & 1) * 32 + (swz % 64) / 2; }
__host__ __device__ __forceinline__ int perm32(int rho) { const int n = rho >> 4, i = rho & 15; return 8 * (i >> 2) + 4 * n + (i & 3); }

struct Unit { int pm, pn, e, ui; };

struct DenseOrder {
    int nM, nN, nwg, G, c; const char* A; const char* B; size_t tstepA, tstepB;
    __device__ void init(const void* A_, int lda, const void* B_, int ldb, int M, int N, int G_, int c_) { nM = M / BM; nN = N / BM; nwg = nM * nN; G = G_; c = c_; A = (const char*)A_; B = (const char*)B_; tstepA = (size_t)BM * lda * 2; tstepB = (size_t)BM * ldb * 2; }
    __device__ bool next(int i, Unit& u) const {
        const long Lx = (long)i * G + c; if (Lx >= nwg) return false;
        int wgid = (int)Lx; { const int q = nwg / NXCD, r = nwg % NXCD, xcd = wgid % NXCD, off = wgid / NXCD; wgid = (xcd < r ? xcd * (q + 1) : r * (q + 1) + (xcd - r) * q) + off; }
        const int nig = WGM * nN, gid = wgid / nig, fm = gid * WGM, gsz = (nM - fm) < WGM ? (nM - fm) : WGM;
        u.pm = fm + ((wgid % nig) % gsz); u.pn = (wgid % nig) / gsz; u.e = 0; u.ui = i; return true;
    }
    __device__ __forceinline__ const char* a_base(const Unit& u) const { return A + (size_t)u.pm * tstepA; }
    __device__ __forceinline__ const char* b_base(const Unit& u) const { return B + (size_t)u.pn * tstepB; }
    __device__ __forceinline__ int a_row(const Unit&, int) const { return 0; }
};

__device__ __forceinline__ unsigned cvt_pk_bf16(float lo, float hi) { unsigned r; asm volatile("v_cvt_pk_bf16_f32 %0, %1, %2" : "=v"(r) : "v"(lo), "v"(hi)); return r; }

template <class Epi, class Sched, bool GATHER>
__device__ __forceinline__ void gemm_phase(PG8_LAS unsigned char* lds, const Sched& S, const Epi& E, const int K, const int lda, const int ldb, const int tid_in) {
    int tid = tid_in; asm volatile("" : "+v"(tid));
    const int wid = __builtin_amdgcn_readfirstlane(tid >> 6), lane = tid & 63, wr = wid >> 2, wc = wid & 3, fr = lane & 15, fq = lane >> 4;
    const int nt = K / BK;
    int RA[2], CA[2]; unsigned voffB[2];
#pragma unroll
    for (int i = 0; i < 2; ++i) { int R, C; stage_rc(tid * 16 + i * 8192, R, C); const int Rb = Epi::PERM ? ((R & ~31) + perm32(R & 31)) : R; RA[i] = R; CA[i] = C; voffB[i] = (unsigned)(Rb * ldb + C) * 2u; }
    const size_t kstep = (size_t)(BK * 2);
    const size_t hstepB = (size_t)HALF * ldb * 2;
    const unsigned ldsw = (unsigned)wid * 1024u;
    const int aoff = lds_byte(wr * 64 + fr, fq * 8), boff = lds_byte(wc * 32 + fr, fq * 8);
#define PG8_SA(b, h) (((b) * 2 + (h)) * HTB)
#define PG8_SB(b, h) ((4 + (b) * 2 + (h)) * HTB)
#define PG8_STAGE2(bufoff, gbase, v0, v1) do { \
        __builtin_amdgcn_global_load_lds((const unsigned*)((const char*)(gbase) + (v0)), (PG8_LAS unsigned*)(lds + (bufoff) + ldsw), 16, 0, 0); \
        __builtin_amdgcn_global_load_lds((const unsigned*)((const char*)(gbase) + (v1)), (PG8_LAS unsigned*)(lds + (bufoff) + ldsw + 8192), 16, 0, 0); } while (0)
#define PG8_STAGEB(bufoff, gbase) PG8_STAGE2(bufoff, gbase, voffB[0], voffB[1])
#define PG8_LDA(dst, b, h) do { _Pragma("unroll") for (int m = 0; m < 4; ++m) _Pragma("unroll") for (int k = 0; k < 2; ++k) dst[m][k] = *(const PG8_LAS bf16x8*)(lds + PG8_SA(b, h) + aoff + m * 2048 + k * 1024); } while (0)
#define PG8_LDB(dst, b, h) do { _Pragma("unroll") for (int n = 0; n < 2; ++n) _Pragma("unroll") for (int k = 0; k < 2; ++k) dst[n][k] = *(const PG8_LAS bf16x8*)(lds + PG8_SB(b, h) + boff + n * 2048 + k * 1024); } while (0)
#define PG8_MMA(ai, bj, At, Bt) do { __builtin_amdgcn_s_setprio(1); _Pragma("unroll") for (int m = 0; m < 4; ++m) _Pragma("unroll") for (int n = 0; n < 2; ++n) _Pragma("unroll") for (int k = 0; k < 2; ++k) \
        acc[ai][bj][m][n] = __builtin_amdgcn_mfma_f32_16x16x32_bf16(Bt[n][k], At[m][k], acc[ai][bj][m][n], 0, 0, 0); __builtin_amdgcn_s_setprio(0); } while (0)
#define PG8_WAIT_V(n) asm volatile("s_waitcnt vmcnt(" #n ")" ::: "memory")
#define PG8_WAIT_L(n) asm volatile("s_waitcnt lgkmcnt(" #n ")" ::: "memory")
#define PG8_BAR __builtin_amdgcn_s_barrier()
#define PG8_SCHED __builtin_amdgcn_sched_barrier(0)
#define PG8_VOFFA(dst, u) do { _Pragma("unroll") for (int h_ = 0; h_ < 2; ++h_) _Pragma("unroll") for (int i_ = 0; i_ < 2; ++i_) { \
        const int row_ = GATHER ? S.a_row(u, h_ * HALF + RA[i_]) : (h_ * HALF + RA[i_]); dst[h_][i_] = (unsigned)(row_ * lda + CA[i_]) * 2u; } } while (0)
    Unit cur, nxt;
    if (!S.next(0, cur)) return;
    f32x4 acc[2][2][4][2];
#pragma unroll
    for (int a = 0; a < 2; ++a)
#pragma unroll
        for (int b = 0; b < 2; ++b)
#pragma unroll
            for (int m = 0; m < 4; ++m)
#pragma unroll
                for (int n = 0; n < 2; ++n) acc[a][b][m][n] = (f32x4){0.f, 0.f, 0.f, 0.f};
    bf16x8 At[4][2], B0[2][2], B1[2][2];
    unsigned vc[2][2], vn[2][2];
    PG8_VOFFA(vc, cur);
    const char* cA = S.a_base(cur); const char* cB = S.b_base(cur);
    PG8_STAGEB(PG8_SB(0, 0), cB); PG8_STAGEB(PG8_SB(0, 1), cB + hstepB); PG8_STAGE2(PG8_SA(0, 0), cA, vc[0][0], vc[0][1]); PG8_STAGE2(PG8_SA(0, 1), cA, vc[1][0], vc[1][1]);
    if (wr == 1) PG8_BAR;
    PG8_WAIT_V(2); PG8_BAR;
    PG8_STAGEB(PG8_SB(1, 0), cB + kstep); PG8_STAGE2(PG8_SA(1, 0), cA + kstep, vc[0][0], vc[0][1]); PG8_STAGEB(PG8_SB(1, 1), cB + hstepB + kstep);
    PG8_WAIT_V(6); PG8_BAR;
    int ui = 0;
    for (;;) {
        const bool has_next = S.next(ui + 1, nxt);
        const char* nA = has_next ? S.a_base(nxt) : cA; const char* nB = has_next ? S.b_base(nxt) : cB;
        if (GATHER) { if (has_next) { PG8_VOFFA(vn, nxt); } else {
#pragma unroll
            for (int h_ = 0; h_ < 2; ++h_) { vn[h_][0] = vc[h_][0]; vn[h_][1] = vc[h_][1]; } } }
        for (int t = 0; t < nt; t += 2) {
            const bool last = (t == nt - 2);
            const char* a1 = cA + (size_t)(t + 1) * kstep;
            const char* a2 = last ? nA : cA + (size_t)(t + 2) * kstep; const char* b2 = last ? nB : cB + (size_t)(t + 2) * kstep;
            const char* a3 = a2 + kstep; const char* b3 = b2 + kstep;
            unsigned w00, w01, w10, w11;
            if (GATHER) { w00 = last ? vn[0][0] : vc[0][0]; w01 = last ? vn[0][1] : vc[0][1]; w10 = last ? vn[1][0] : vc[1][0]; w11 = last ? vn[1][1] : vc[1][1]; }
            else { w00 = vc[0][0]; w01 = vc[0][1]; w10 = vc[1][0]; w11 = vc[1][1]; }
            PG8_LDB(B0, 0, 0); PG8_LDB(B1, 0, 1); PG8_SCHED; PG8_LDA(At, 0, 0); PG8_STAGE2(PG8_SA(1, 1), a1, vc[1][0], vc[1][1]);
            PG8_WAIT_V(8); PG8_WAIT_L(0); PG8_BAR; PG8_MMA(0, 0, At, B0); PG8_MMA(0, 1, At, B1); PG8_BAR; PG8_SCHED;
            PG8_LDA(At, 0, 1); PG8_STAGEB(PG8_SB(0, 0), b2); PG8_STAGEB(PG8_SB(0, 1), b2 + hstepB); PG8_STAGE2(PG8_SA(0, 0), a2, w00, w01);
            PG8_WAIT_V(8); PG8_WAIT_L(0); PG8_BAR; PG8_MMA(1, 0, At, B0); PG8_MMA(1, 1, At, B1); PG8_BAR; PG8_SCHED;
            PG8_LDB(B0, 1, 0); PG8_LDB(B1, 1, 1); PG8_SCHED; PG8_LDA(At, 1, 0); PG8_STAGE2(PG8_SA(0, 1), a2, w10, w11);
            PG8_WAIT_V(8); PG8_WAIT_L(0); PG8_BAR; PG8_MMA(0, 0, At, B0); PG8_MMA(0, 1, At, B1); PG8_BAR; PG8_SCHED;
            PG8_LDA(At, 1, 1); PG8_STAGEB(PG8_SB(1, 0), b3); PG8_STAGEB(PG8_SB(1, 1), b3 + hstepB); PG8_STAGE2(PG8_SA(1, 0), a3, w00, w01);
            PG8_WAIT_V(8); PG8_WAIT_L(0); PG8_BAR; PG8_MMA(1, 0, At, B0); PG8_MMA(1, 1, At, B1); PG8_BAR; PG8_SCHED;
        }
        if (wr == 0) PG8_BAR;
        E(acc, cur, wr, wc, fr, fq);
        if (!has_next) break;
#pragma unroll
        for (int a = 0; a < 2; ++a)
#pragma unroll
            for (int b = 0; b < 2; ++b)
#pragma unroll
                for (int m = 0; m < 4; ++m)
#pragma unroll
                    for (int n = 0; n < 2; ++n) acc[a][b][m][n] = (f32x4){0.f, 0.f, 0.f, 0.f};
        cur = nxt; cA = nA; cB = nB; ++ui;
        if (GATHER) {
#pragma unroll
            for (int h_ = 0; h_ < 2; ++h_) { vc[h_][0] = vn[h_][0]; vc[h_][1] = vn[h_][1]; } }
        if (wr == 1) PG8_BAR;
    }
    PG8_WAIT_V(0);
    PG8_BAR;
#undef PG8_SA
#undef PG8_SB
#undef PG8_STAGE2
#undef PG8_STAGEB
#undef PG8_LDA
#undef PG8_LDB
#undef PG8_MMA
#undef PG8_WAIT_V
#undef PG8_WAIT_L
#undef PG8_BAR
#undef PG8_SCHED
#undef PG8_VOFFA
}
template <class Epi, class Sched>
__device__ __forceinline__ void gemm_phase_vk(PG8_LAS unsigned char* lds, const Sched& S, const Epi& E, const int lda, const int tid_in) {
    constexpr bool GATHER = false;
    int tid = tid_in; asm volatile("" : "+v"(tid));
    const int wid = __builtin_amdgcn_readfirstlane(tid >> 6), lane = tid & 63, wr = wid >> 2, wc = wid & 3, fr = lane & 15, fq = lane >> 4;
    int RA[2], CA[2], RB[2];
#pragma unroll
    for (int i = 0; i < 2; ++i) { int R, C; stage_rc(tid * 16 + i * 8192, R, C); const int Rb = Epi::PERM ? ((R & ~31) + perm32(R & 31)) : R; RA[i] = R; CA[i] = C; RB[i] = Rb; }
    const size_t kstep = (size_t)(BK * 2);
    const unsigned ldsw = (unsigned)wid * 1024u;
    const int aoff = lds_byte(wr * 64 + fr, fq * 8), boff = lds_byte(wc * 32 + fr, fq * 8);
#define PG8_SA(b, h) (((b) * 2 + (h)) * HTB)
#define PG8_SB(b, h) ((4 + (b) * 2 + (h)) * HTB)
#define PG8_STAGE2(bufoff, gbase, v0, v1) do { \
        __builtin_amdgcn_global_load_lds((const unsigned*)((const char*)(gbase) + (v0)), (PG8_LAS unsigned*)(lds + (bufoff) + ldsw), 16, 0, 0); \
        __builtin_amdgcn_global_load_lds((const unsigned*)((const char*)(gbase) + (v1)), (PG8_LAS unsigned*)(lds + (bufoff) + ldsw + 8192), 16, 0, 0); } while (0)
#define PG8_VOFFB(dst, hs, u) do { const int ldb_ = S.ldb_of(u); _Pragma("unroll") for (int i_ = 0; i_ < 2; ++i_) { int R_, C_; stage_rc(tid * 16 + i_ * 8192, R_, C_); const int Rb_ = Epi::PERM ? ((R_ & ~31) + perm32(R_ & 31)) : R_; dst[i_] = (unsigned)(Rb_ * ldb_ + C_) * 2u; } hs = (size_t)HALF * ldb_ * 2; } while (0)
#define PG8_LDA(dst, b, h) do { _Pragma("unroll") for (int m = 0; m < 4; ++m) _Pragma("unroll") for (int k = 0; k < 2; ++k) dst[m][k] = *(const PG8_LAS bf16x8*)(lds + PG8_SA(b, h) + aoff + m * 2048 + k * 1024); } while (0)
#define PG8_LDB(dst, b, h) do { _Pragma("unroll") for (int n = 0; n < 2; ++n) _Pragma("unroll") for (int k = 0; k < 2; ++k) dst[n][k] = *(const PG8_LAS bf16x8*)(lds + PG8_SB(b, h) + boff + n * 2048 + k * 1024); } while (0)
#define PG8_MMA(ai, bj, At, Bt) do { __builtin_amdgcn_s_setprio(1); _Pragma("unroll") for (int m = 0; m < 4; ++m) _Pragma("unroll") for (int n = 0; n < 2; ++n) _Pragma("unroll") for (int k = 0; k < 2; ++k) \
        acc[ai][bj][m][n] = __builtin_amdgcn_mfma_f32_16x16x32_bf16(Bt[n][k], At[m][k], acc[ai][bj][m][n], 0, 0, 0); __builtin_amdgcn_s_setprio(0); } while (0)
#define PG8_WAIT_V(n) asm volatile("s_waitcnt vmcnt(" #n ")" ::: "memory")
#define PG8_WAIT_L(n) asm volatile("s_waitcnt lgkmcnt(" #n ")" ::: "memory")
#define PG8_BAR __builtin_amdgcn_s_barrier()
#define PG8_SCHED __builtin_amdgcn_sched_barrier(0)
#define PG8_VOFFA(dst, u) do { _Pragma("unroll") for (int h_ = 0; h_ < 2; ++h_) _Pragma("unroll") for (int i_ = 0; i_ < 2; ++i_) { \
        const int row_ = GATHER ? S.a_row(u, h_ * HALF + RA[i_]) : (h_ * HALF + RA[i_]); dst[h_][i_] = (unsigned)(row_ * lda + CA[i_]) * 2u; } } while (0)
    Unit cur, nxt;
    if (!S.next(0, cur)) return;
    f32x4 acc[2][2][4][2];
#pragma unroll
    for (int a = 0; a < 2; ++a)
#pragma unroll
        for (int b = 0; b < 2; ++b)
#pragma unroll
            for (int m = 0; m < 4; ++m)
#pragma unroll
                for (int n = 0; n < 2; ++n) acc[a][b][m][n] = (f32x4){0.f, 0.f, 0.f, 0.f};
    bf16x8 At[4][2], B0[2][2], B1[2][2];
    unsigned vc[2][2], vn[2][2];
    PG8_VOFFA(vc, cur);
    unsigned vbc[2], vbn[2]; size_t hsc, hsn; PG8_VOFFB(vbc, hsc, cur); int nt = S.K_of(cur) / BK;
    const char* cA = S.a_base(cur); const char* cB = S.b_base(cur);
    PG8_STAGE2(PG8_SB(0, 0), cB, vbc[0], vbc[1]); PG8_STAGE2(PG8_SB(0, 1), cB + hsc, vbc[0], vbc[1]); PG8_STAGE2(PG8_SA(0, 0), cA, vc[0][0], vc[0][1]); PG8_STAGE2(PG8_SA(0, 1), cA, vc[1][0], vc[1][1]);
    if (wr == 1) PG8_BAR;
    PG8_WAIT_V(2); PG8_BAR;
    PG8_STAGE2(PG8_SB(1, 0), cB + kstep, vbc[0], vbc[1]); PG8_STAGE2(PG8_SA(1, 0), cA + kstep, vc[0][0], vc[0][1]); PG8_STAGE2(PG8_SB(1, 1), cB + hsc + kstep, vbc[0], vbc[1]);
    PG8_WAIT_V(6); PG8_BAR;
    int ui = 0;
    for (;;) {
        const bool has_next = S.next(ui + 1, nxt);
        const char* nA = has_next ? S.a_base(nxt) : cA; const char* nB = has_next ? S.b_base(nxt) : cB;
        if (has_next) { PG8_VOFFB(vbn, hsn, nxt); } else { vbn[0] = vbc[0]; vbn[1] = vbc[1]; hsn = hsc; }
        if (GATHER) { if (has_next) { PG8_VOFFA(vn, nxt); } else {
#pragma unroll
            for (int h_ = 0; h_ < 2; ++h_) { vn[h_][0] = vc[h_][0]; vn[h_][1] = vc[h_][1]; } } }
        for (int t = 0; t < nt; t += 2) {
            const bool last = (t == nt - 2);
            const char* a1 = cA + (size_t)(t + 1) * kstep;
            const char* a2 = last ? nA : cA + (size_t)(t + 2) * kstep; const char* b2 = last ? nB : cB + (size_t)(t + 2) * kstep;
            const char* a3 = a2 + kstep; const char* b3 = b2 + kstep;
            unsigned w00, w01, w10, w11;
            if (GATHER) { w00 = last ? vn[0][0] : vc[0][0]; w01 = last ? vn[0][1] : vc[0][1]; w10 = last ? vn[1][0] : vc[1][0]; w11 = last ? vn[1][1] : vc[1][1]; }
            else { w00 = vc[0][0]; w01 = vc[0][1]; w10 = vc[1][0]; w11 = vc[1][1]; }
            const unsigned wb0 = last ? vbn[0] : vbc[0], wb1 = last ? vbn[1] : vbc[1]; const size_t hsb = last ? hsn : hsc;
            PG8_LDB(B0, 0, 0); PG8_LDB(B1, 0, 1); PG8_SCHED; PG8_LDA(At, 0, 0); PG8_STAGE2(PG8_SA(1, 1), a1, vc[1][0], vc[1][1]);
            PG8_WAIT_V(8); PG8_WAIT_L(0); PG8_BAR; PG8_MMA(0, 0, At, B0); PG8_MMA(0, 1, At, B1); PG8_BAR; PG8_SCHED;
            PG8_LDA(At, 0, 1); PG8_STAGE2(PG8_SB(0, 0), b2, wb0, wb1); PG8_STAGE2(PG8_SB(0, 1), b2 + hsb, wb0, wb1); PG8_STAGE2(PG8_SA(0, 0), a2, w00, w01);
            PG8_WAIT_V(8); PG8_WAIT_L(0); PG8_BAR; PG8_MMA(1, 0, At, B0); PG8_MMA(1, 1, At, B1); PG8_BAR; PG8_SCHED;
            PG8_LDB(B0, 1, 0); PG8_LDB(B1, 1, 1); PG8_SCHED; PG8_LDA(At, 1, 0); PG8_STAGE2(PG8_SA(0, 1), a2, w10, w11);
            PG8_WAIT_V(8); PG8_WAIT_L(0); PG8_BAR; PG8_MMA(0, 0, At, B0); PG8_MMA(0, 1, At, B1); PG8_BAR; PG8_SCHED;
            PG8_LDA(At, 1, 1); PG8_STAGE2(PG8_SB(1, 0), b3, wb0, wb1); PG8_STAGE2(PG8_SB(1, 1), b3 + hsb, wb0, wb1); PG8_STAGE2(PG8_SA(1, 0), a3, w00, w01);
            PG8_WAIT_V(8); PG8_WAIT_L(0); PG8_BAR; PG8_MMA(1, 0, At, B0); PG8_MMA(1, 1, At, B1); PG8_BAR; PG8_SCHED;
        }
        if (wr == 0) PG8_BAR;
        E(acc, cur, wr, wc, fr, fq);
        if (!has_next) break;
#pragma unroll
        for (int a = 0; a < 2; ++a)
#pragma unroll
            for (int b = 0; b < 2; ++b)
#pragma unroll
                for (int m = 0; m < 4; ++m)
#pragma unroll
                    for (int n = 0; n < 2; ++n) acc[a][b][m][n] = (f32x4){0.f, 0.f, 0.f, 0.f};
        cur = nxt; cA = nA; cB = nB; ++ui; vbc[0] = vbn[0]; vbc[1] = vbn[1]; hsc = hsn; nt = S.K_of(cur) / BK;
        if (GATHER) {
#pragma unroll
            for (int h_ = 0; h_ < 2; ++h_) { vc[h_][0] = vn[h_][0]; vc[h_][1] = vn[h_][1]; } }
        if (wr == 1) PG8_BAR;
    }
    PG8_WAIT_V(0);
    PG8_BAR;
#undef PG8_SA
#undef PG8_SB
#undef PG8_STAGE2
#undef PG8_VOFFB
#undef PG8_LDA
#undef PG8_LDB
#undef PG8_MMA
#undef PG8_WAIT_V
#undef PG8_WAIT_L
#undef PG8_BAR
#undef PG8_SCHED
#undef PG8_VOFFA
}
}

constexpr int NWAVES = 8, NTHREADS = 512;
constexpr int RING_OFF = 0, RING_BYTES = 131072, ROWS_OFF = 131072, ROWS_BYTES = 12288, ROUTER_BYTES = 147456  , MISC_OFF = ROUTER_BYTES, LCNT_OFF = MISC_OFF + 128  , LDS_BYTES = 148480;
static_assert(MISC_OFF + 128 <= LDS_BYTES, "LDS map");
constexpr int CW_CNT = 0;
constexpr int CW_BAR = 4096;
constexpr size_t CTL_ZERO_BYTES = 64 * 1024;
constexpr float LOG2E = 1.4426950408889634f, LN2 = 0.6931471805599453f;
constexpr float QSCALE = 0.125f * LOG2E;

#define GAS __attribute__((address_space(1)))
#define LAS __attribute__((address_space(3)))
typedef unsigned v4u __attribute__((ext_vector_type(4)));
typedef unsigned v2u __attribute__((ext_vector_type(2)));
#define LDS_WAIT() asm volatile("s_waitcnt lgkmcnt(0)" ::: "memory")
__device__ __forceinline__ unsigned pk2(float lo, float hi) { return (unsigned)f2bf(lo) | ((unsigned)f2bf(hi) << 16); }

#define XB_TMO      128
#define XB_XCNT(j)  (256  + 64 * (j))
#define XB_XSUB(j)  (1280 + 64 * (j))
#define XB_XGEN(j)  (2304 + 64 * (j))
#define XB_TOP      3328
#define XB_TOPGEN   3392
#define XCD_BAR_WORDS 3456
#define XB_SPIN_CAP (1u << 18)

__device__ __forceinline__ unsigned xb_ld(unsigned* p)              { return __hip_atomic_load(p, __ATOMIC_RELAXED, __HIP_MEMORY_SCOPE_AGENT); }
__device__ __forceinline__ unsigned xb_add(unsigned* p, unsigned v) { return __hip_atomic_fetch_add(p, v, __ATOMIC_RELAXED, __HIP_MEMORY_SCOPE_AGENT); }
__device__ __forceinline__ unsigned xb_xcc_id() { return (unsigned)__builtin_amdgcn_s_getreg((3 << 11) | 20) & 0xFu; }
#define XB_SPIN(cond, bar) do { unsigned _sp = 0; while (cond) { __builtin_amdgcn_s_sleep(1); \
    if ((++_sp & 255u) == 0u) { if (xb_ld(&(bar)[XB_TMO])) break; if (_sp > XB_SPIN_CAP) { atomicAdd(&(bar)[XB_TMO], 1u); break; } } } } while (0)

struct XcdBarrier {
    int wave0;
    unsigned* bar; unsigned x;
    volatile LAS unsigned* st;
};

__device__ __forceinline__ unsigned xb_lane() { unsigned l_; asm volatile("v_mbcnt_lo_u32_b32 %0, -1, 0\n\tv_mbcnt_hi_u32_b32 %0, -1, %0" : "=v"(l_)); return l_; }
__device__ __forceinline__ XcdBarrier xcd_barrier_post(unsigned* bar, volatile LAS unsigned* st, int wave0) {
    XcdBarrier b; b.wave0 = wave0; b.bar = bar; b.x = xb_xcc_id(); b.st = st;
    if (b.wave0 && xb_lane() == 0u) (void)xb_add(&bar[XB_XCNT(b.x)], 1u);
    return b;
}
__device__ __forceinline__ void xcd_barrier_complete(unsigned* bar, unsigned x, unsigned& nloc, unsigned& nx) {
    const unsigned G = gridDim.x * gridDim.y * gridDim.z;
    unsigned sum, cnt, mine, sp = 0u;
    for (;;) {
        sum = 0u; cnt = 0u; mine = 0u;
#pragma unroll
        for (unsigned j = 0; j < 16; ++j) { const unsigned c = xb_ld(&bar[XB_XCNT(j)]); sum += c; cnt += (c > 0u) ? 1u : 0u; mine = (j == x) ? c : mine; }
        if (sum == G) break;
        __builtin_amdgcn_s_sleep(1);
        if ((++sp & 255u) == 0u) { if (xb_ld(&bar[XB_TMO])) break; if (sp > XB_SPIN_CAP) { atomicAdd(&bar[XB_TMO], 1u); break; } }
    }
    nloc = mine > 0u ? mine : 1u; nx = cnt > 0u ? cnt : 1u;
}

__device__ __forceinline__ void xcd_barrier(const XcdBarrier& b) {
    asm volatile("s_waitcnt vmcnt(0)" ::: "memory");
    __syncthreads();
    if (b.wave0 && xb_lane() == 0u) {
        unsigned* bar = b.bar;
        __builtin_amdgcn_s_waitcnt(0);
        unsigned nloc = b.st[0], nx = b.st[1];
        if (nloc == 0u) { xcd_barrier_complete(bar, b.x, nloc, nx); b.st[0] = nloc; b.st[1] = nx; }
        const unsigned old = xb_add(&bar[XB_XSUB(b.x)], 1u);
        const unsigned gen = old / nloc;
        if (old + 1u == (gen + 1u) * nloc) {
            __builtin_amdgcn_fence(__ATOMIC_RELEASE, "agent");
            asm volatile("s_waitcnt vmcnt(0)" ::: "memory");
            const unsigned og = xb_add(&bar[XB_TOP], 1u);
            const unsigned tg = og / nx;
            if (og + 1u == (tg + 1u) * nx) xb_add(&bar[XB_TOPGEN], 1u);
            else XB_SPIN(xb_ld(&bar[XB_TOPGEN]) == tg, bar);
            __builtin_amdgcn_fence(__ATOMIC_ACQUIRE, "agent");
            xb_add(&bar[XB_XGEN(b.x)], 1u);
            asm volatile("s_waitcnt vmcnt(0)" ::: "memory");
        } else {
            XB_SPIN(xb_ld(&bar[XB_XGEN(b.x)]) == gen, bar);
            __builtin_amdgcn_fence(__ATOMIC_ACQUIRE, "agent");
            asm volatile("s_waitcnt vmcnt(0)" ::: "memory");
        }
    }
    __syncthreads();
}


struct Args { const float* in[23]; float* out; unsigned char* ws; int s_lo, s_hi, probe, pad; };

struct Frame {
    LAS unsigned char* lds; int tid, lane, wave, vcu, G;
    const float* const* in; float* h; unsigned char* ws; int probe;
};

__device__ __forceinline__ int hw_lane() { int l_; asm volatile("v_mbcnt_lo_u32_b32 %0, -1, 0\n\tv_mbcnt_hi_u32_b32 %0, -1, %0" : "=v"(l_)); return l_; }
__device__ __forceinline__ float shfl_xor_l(float v, int mask, int lane) { return __builtin_bit_cast(float, __builtin_amdgcn_ds_bpermute((lane ^ mask) << 2, __builtin_bit_cast(int, v))); }
__device__ __forceinline__ float dpp_add(float v, const int ctrl_sel) {
    const int x = __builtin_bit_cast(int, v); int y;
    if (ctrl_sel == 0) y = __builtin_amdgcn_mov_dpp(x, 0xB1, 0xF, 0xF, true);
    else if (ctrl_sel == 1) y = __builtin_amdgcn_mov_dpp(x, 0x4E, 0xF, 0xF, true);
    else if (ctrl_sel == 2) y = __builtin_amdgcn_mov_dpp(x, 0x141, 0xF, 0xF, true);
    else y = __builtin_amdgcn_mov_dpp(x, 0x140, 0xF, 0xF, true);
    return v + __builtin_bit_cast(float, y);
}
__device__ __forceinline__ float wave_sum_l(float v, int lane) {
    (void)lane;
    v = dpp_add(v, 0); v = dpp_add(v, 1); v = dpp_add(v, 2); v = dpp_add(v, 3);
    const int x = __builtin_bit_cast(int, v);
    const float r0 = __builtin_bit_cast(float, __builtin_amdgcn_readlane(x, 0)), r1 = __builtin_bit_cast(float, __builtin_amdgcn_readlane(x, 16)),
                r2 = __builtin_bit_cast(float, __builtin_amdgcn_readlane(x, 32)), r3 = __builtin_bit_cast(float, __builtin_amdgcn_readlane(x, 48));
    return (r0 + r1) + (r2 + r3);
}
#define LAUNDER(F) do { (F).lane = hw_lane(); (F).tid = (F).wave * 64 + (F).lane; asm volatile("" : "+s"((F).G), "+s"((F).vcu), "+s"((F).ws), "+s"((F).h)); } while (0)
__device__ __forceinline__ void p0_item(const float* W, int ldw, int k0, int n0, bf16* WT, int Kd, int drow0, float scale, LAS float* scr, int lane) {
#pragma unroll 8
    for (int i = 0; i < 32; ++i) { const int kk = 2 * i + (lane >> 5); scr[kk * 33 + (lane & 31)] = W[(size_t)(k0 + kk) * ldw + n0 + (lane & 31)] * scale; }
    LDS_WAIT(); asm volatile("" ::: "memory");
    const int c = lane & 7;
#pragma unroll
    for (int j = 0; j < 4; ++j) { const int n = (lane >> 3) + 8 * j; const LAS float* s = scr + (8 * c) * 33 + n;
        v4u o; o.x = pk2(s[0 * 33], s[1 * 33]); o.y = pk2(s[2 * 33], s[3 * 33]); o.z = pk2(s[4 * 33], s[5 * 33]); o.w = pk2(s[6 * 33], s[7 * 33]);
        *(GAS v4u*)(WT + (size_t)(drow0 + n) * Kd + k0 + 8 * c) = o; }
    LDS_WAIT(); asm volatile("" ::: "memory");
}
__device__ __forceinline__ bool is_q_col(int n) { return n < 512 || (n >= 768 && n < 3072 && ((n - 768) % 768) < 256) || (n >= 3072 && n < 3584); }

__device__ __forceinline__ void ph_prologue(Frame& F) { LAUNDER(F);
    LAS float* scr = (LAS float*)(F.lds + RING_OFF + F.wave * 16384);
    const int gw = F.vcu * NWAVES + F.wave, NGW = F.G * NWAVES, lane = F.lane;
    const float* w_in = F.in[4]; const float* w_a = F.in[8]; const float* w_b = F.in[9]; const float* w_c = F.in[10]; const float* w_o = F.in[11];
    const float* w_eg = F.in[18]; const float* w_eu = F.in[19]; const float* w_ed = F.in[20];
    bf16* WIN = (bf16*)(F.ws + WS_WIN); bf16* WBRA = (bf16*)(F.ws + WS_WBRA); bf16* WBRB = (bf16*)(F.ws + WS_WBRB); bf16* WBRC = (bf16*)(F.ws + WS_WBRC); bf16* WOUT = (bf16*)(F.ws + WS_WOUT);
    bf16* WGU = (bf16*)(F.ws + WS_WGU); bf16* WD = (bf16*)(F.ws + WS_WD);
    constexpr int I_IN = 16 * (NCOL / 32), I_A = 8 * 32, I_B = 4 * 32, I_C = 8 * 32, I_O = 16 * 32, I_G = 16 * 16, I_D = 8 * 32;
    constexpr int I_LAYER = I_IN + I_A + I_B + I_C + I_O + NE * (2 * I_G + I_D);
    for (int it = gw; it < DEPTH * I_LAYER; it += NGW) {
        const int l = it / I_LAYER; int r = it % I_LAYER;
        if (r < I_IN) { const int nb = r % (NCOL / 32), kb = r / (NCOL / 32); p0_item(w_in + (size_t)l * D * NCOL, NCOL, 64 * kb, 32 * nb, WIN + (size_t)l * NCOL * D, D, 32 * nb, is_q_col(32 * nb) ? QSCALE : 1.0f, scr, lane); continue; } r -= I_IN;
        if (r < I_A) { const int nb = r % 32, kb = r / 32; p0_item(w_a + (size_t)l * 512 * D, D, 64 * kb, 32 * nb, WBRA + (size_t)l * D * 512, 512, 32 * nb, 1.0f, scr, lane); continue; } r -= I_A;
        if (r < I_B) { const int nb = r % 32, kb = r / 32; p0_item(w_b + (size_t)l * 256 * D, D, 64 * kb, 32 * nb, WBRB + (size_t)l * D * 256, 256, 32 * nb, 1.0f, scr, lane); continue; } r -= I_B;
        if (r < I_C) { const int nb = r % 32, kb = r / 32; p0_item(w_c + (size_t)l * 512 * D, D, 64 * kb, 32 * nb, WBRC + (size_t)l * D * 512, 512, 32 * nb, 1.0f, scr, lane); continue; } r -= I_C;
        if (r < I_O) { const int nb = r % 32, kb = r / 32; p0_item(w_o + (size_t)l * D * D, D, 64 * kb, 32 * nb, WOUT + (size_t)l * D * D, D, 32 * nb, 1.0f, scr, lane); continue; } r -= I_O;
        const int e = r / (2 * I_G + I_D); r %= (2 * I_G + I_D); const size_t le = (size_t)l * NE + e;
        if (r < 2 * I_G) { const int up = r / I_G; r %= I_G; const int nb = r % 16, kb = r / 16;
            p0_item((up ? w_eu : w_eg) + le * D * DE, DE, 64 * kb, 32 * nb, WGU + le * 1024 * 1024, D, (nb >> 2) * 256 + up * 128 + (nb & 3) * 32, 1.0f, scr, lane); continue; }
        r -= 2 * I_G; { const int nb = r % 32, kb = r / 32; p0_item(w_ed + le * DE * D, D, 64 * kb, 32 * nb, WD + le * D * DE, DE, 32 * nb, 1.0f, scr, lane); }
    }
}

struct LnIn { f32x4 v[4]; v2u a[4], b[4], hw[4]; };
template <int MODE> __device__ __forceinline__ void ln_load(LnIn& in, const float* src, const bf16* hsb, const bf16* yb, size_t row, int lane) {
#pragma unroll
    for (int j = 0; j < 4; ++j) {
        const int c = lane * 4 + 256 * j;
        if (MODE != 2) in.v[j] = *(const GAS f32x4*)(src + row * D + c);
        if (MODE == 2) { in.hw[j] = *(const GAS v2u*)(hsb + row * D + c); in.a[j] = *(const GAS v2u*)(yb + (row * 2) * D + c); in.b[j] = *(const GAS v2u*)(yb + (row * 2 + 1) * D + c); }
    }
}
template <int MODE> __device__ __forceinline__ void ln_finish(const LnIn& in, float* hout, bf16* hb, const float* g, const float* bta, size_t row, int lane, f32x4 (&o)[4]) {
    f32x4 v[4];
#pragma unroll
    for (int j = 0; j < 4; ++j) {
        if (MODE != 2) v[j] = in.v[j];
        if (MODE == 2) {
            const v2u a = in.a[j], b = in.b[j], hw = in.hw[j];
            v[j].x = ALPHA * __uint_as_float(hw.x << 16) + __uint_as_float(a.x << 16) + __uint_as_float(b.x << 16);
            v[j].y = ALPHA * __uint_as_float(hw.x & 0xffff0000u) + __uint_as_float(a.x & 0xffff0000u) + __uint_as_float(b.x & 0xffff0000u);
            v[j].z = ALPHA * __uint_as_float(hw.y << 16) + __uint_as_float(a.y << 16) + __uint_as_float(b.y << 16);
            v[j].w = ALPHA * __uint_as_float(hw.y & 0xffff0000u) + __uint_as_float(a.y & 0xffff0000u) + __uint_as_float(b.y & 0xffff0000u);
        }
    }
    float s = 0.f;
#pragma unroll
    for (int j = 0; j < 4; ++j) s += (v[j].x + v[j].y) + (v[j].z + v[j].w);
    const float mean = wave_sum_l(s, lane) * (1.f / D);
    float q = 0.f;
#pragma unroll
    for (int j = 0; j < 4; ++j) { v[j] = v[j] - mean; q += (v[j].x * v[j].x + v[j].y * v[j].y) + (v[j].z * v[j].z + v[j].w * v[j].w); }
    const float rstd = 1.0f / sqrtf(wave_sum_l(q, lane) * (1.f / D) + LN_EPS);
#pragma unroll
    for (int j = 0; j < 4; ++j) {
        const int c = lane * 4 + 256 * j;
        const f32x4 gg = *(const GAS f32x4*)(g + c), bb = *(const GAS f32x4*)(bta + c);
        o[j] = v[j] * rstd * gg + bb;
        if (hout) *(GAS f32x4*)(hout + row * D + c) = o[j];
        if (hb) { v2u w; w.x = pk2(o[j].x, o[j].y); w.y = pk2(o[j].z, o[j].w); *(GAS v2u*)(hb + row * D + c) = w; }
    }
}

#ifndef PROBE_EPI
#define PROBE_EPI 0
#endif
struct EpiP1 {
    static constexpr bool PERM = true;
    bf16* qkv; bf16* gates; const float* b_gate; int probe;
    __device__ __forceinline__ void operator()(const f32x4 (&acc)[2][2][4][2], const pg8::Unit& u, int wr, int wc, int fr, int fq) const {
        if (probe == 1 && PROBE_EPI == 0) return;
        const int row0 = (probe == 1 ? (int)(blockIdx.x & 127) : u.pm) * 256 + wr * 64 + fr; const bool isg = u.pn >= 18;
        bf16* base = isg ? gates : qkv; const int ldc = isg ? GATEW : QKVW; const int col0 = (isg ? (u.pn - 18) : u.pn) * 256 + wc * 32 + 8 * fq;
        f32x4 bv[2][2];
#pragma unroll
        for (int bj = 0; bj < 2; ++bj)
#pragma unroll
            for (int n = 0; n < 2; ++n) bv[bj][n] = isg ? *(const GAS f32x4*)(b_gate + col0 + bj * 128 + 4 * n) : (f32x4){0.f, 0.f, 0.f, 0.f};
#pragma unroll
        for (int ai = 0; ai < 2; ++ai)
#pragma unroll
            for (int m = 0; m < 4; ++m) { bf16* rowp = base + (size_t)(row0 + ai * 128 + m * 16) * ldc + col0;
#pragma unroll
                for (int bj = 0; bj < 2; ++bj) { f32x4 v0 = acc[ai][bj][m][0] + bv[bj][0], v1 = acc[ai][bj][m][1] + bv[bj][1];
                    if (isg) {
#pragma unroll
                        for (int j = 0; j < 4; ++j) { v0[j] = __builtin_amdgcn_rcpf(1.0f + __builtin_amdgcn_exp2f(-LOG2E * v0[j])); v1[j] = __builtin_amdgcn_rcpf(1.0f + __builtin_amdgcn_exp2f(-LOG2E * v1[j])); } }
                    v4u w; w.x = pg8::cvt_pk_bf16(v0[0], v0[1]); w.y = pg8::cvt_pk_bf16(v0[2], v0[3]); w.z = pg8::cvt_pk_bf16(v1[0], v1[1]); w.w = pg8::cvt_pk_bf16(v1[2], v1[3]);
                    *(GAS v4u*)(rowp + bj * 128) = w; } }
    }
};
template <bool FIRST> struct EpiP3 {
    static constexpr bool PERM = true;
    bf16* merged; const bf16* gates; int br;
    __device__ __forceinline__ void operator()(const f32x4 (&acc)[2][2][4][2], const pg8::Unit& u, int wr, int wc, int fr, int fq) const {
        const int row0 = u.pm * 256 + wr * 64 + fr, col0 = u.pn * 256 + wc * 32 + 8 * fq;
#pragma unroll
        for (int ai = 0; ai < 2; ++ai) {
            v4u gw[4][2], ow[4][2];
#pragma unroll
            for (int m = 0; m < 4; ++m)
#pragma unroll
                for (int bj = 0; bj < 2; ++bj) { const size_t row = (size_t)(row0 + ai * 128 + m * 16);
                    gw[m][bj] = *(const GAS v4u*)(gates + row * GATEW + br * 1024 + col0 + bj * 128);
                    ow[m][bj] = FIRST ? (v4u){0u, 0u, 0u, 0u} : *(const GAS v4u*)(merged + row * D + col0 + bj * 128); }
#pragma unroll
            for (int m = 0; m < 4; ++m)
#pragma unroll
                for (int bj = 0; bj < 2; ++bj) { const size_t row = (size_t)(row0 + ai * 128 + m * 16);
                    const f32x4 a0 = acc[ai][bj][m][0], a1 = acc[ai][bj][m][1];
                    float r[8];
#pragma unroll
                    for (int j = 0; j < 4; ++j) { const unsigned g2 = gw[m][bj][j], o2 = ow[m][bj][j]; const float av0 = j < 2 ? a0[2 * j] : a1[2 * j - 4], av1 = j < 2 ? a0[2 * j + 1] : a1[2 * j - 3];
                        r[2 * j] = __uint_as_float(g2 << 16) * av0 + (FIRST ? 0.f : __uint_as_float(o2 << 16)); r[2 * j + 1] = __uint_as_float(g2 & 0xffff0000u) * av1 + (FIRST ? 0.f : __uint_as_float(o2 & 0xffff0000u)); }
                    v4u w; w.x = pg8::cvt_pk_bf16(r[0], r[1]); w.y = pg8::cvt_pk_bf16(r[2], r[3]); w.z = pg8::cvt_pk_bf16(r[4], r[5]); w.w = pg8::cvt_pk_bf16(r[6], r[7]);
                    *(GAS v4u*)(merged + row * D + col0 + bj * 128) = w; }
            asm volatile("" ::: "memory"); }
    }
};
struct EpiP3V {
    static constexpr bool PERM = true;
    bf16* merged; const bf16* gates;
    __device__ __forceinline__ void operator()(const f32x4 (&acc)[2][2][4][2], const pg8::Unit& u, int wr, int wc, int fr, int fq) const {
        const int row0 = u.pm * 256 + wr * 64 + fr, col0 = u.pn * 256 + wc * 32 + 8 * fq; const int br = u.e; const bool first = (br == 0);
#pragma unroll
        for (int ai = 0; ai < 2; ++ai)
#pragma unroll
        for (int mp = 0; mp < 2; ++mp) {
            v4u gw[2][2], ow[2][2];
#pragma unroll
            for (int mm = 0; mm < 2; ++mm)
#pragma unroll
                for (int bj = 0; bj < 2; ++bj) { const size_t row = (size_t)(row0 + ai * 128 + (2 * mp + mm) * 16);
                    gw[mm][bj] = *(const GAS v4u*)(gates + row * GATEW + br * 1024 + col0 + bj * 128);
                    ow[mm][bj] = (v4u){0u, 0u, 0u, 0u}; if (!first) ow[mm][bj] = *(const GAS v4u*)(merged + row * D + col0 + bj * 128); }
#pragma unroll
            for (int mm = 0; mm < 2; ++mm)
#pragma unroll
                for (int bj = 0; bj < 2; ++bj) { const int m = 2 * mp + mm; const size_t row = (size_t)(row0 + ai * 128 + m * 16);
                    const f32x4 a0 = acc[ai][bj][m][0], a1 = acc[ai][bj][m][1];
                    float r[8];
#pragma unroll
                    for (int j = 0; j < 4; ++j) { const unsigned g2 = gw[mm][bj][j], o2 = ow[mm][bj][j]; const float av0 = j < 2 ? a0[2 * j] : a1[2 * j - 4], av1 = j < 2 ? a0[2 * j + 1] : a1[2 * j - 3];
                        r[2 * j] = __uint_as_float(g2 << 16) * av0 + __uint_as_float(o2 << 16); r[2 * j + 1] = __uint_as_float(g2 & 0xffff0000u) * av1 + __uint_as_float(o2 & 0xffff0000u); }
                    v4u w; w.x = pg8::cvt_pk_bf16(r[0], r[1]); w.y = pg8::cvt_pk_bf16(r[2], r[3]); w.z = pg8::cvt_pk_bf16(r[4], r[5]); w.w = pg8::cvt_pk_bf16(r[6], r[7]);
                    *(GAS v4u*)(merged + row * D + col0 + bj * 128) = w; }
            asm volatile("" ::: "memory"); }
    }
};
struct P3Order {
    pg8::DenseOrder Dn; const char* Abase; const char* wsb; size_t lofs;
    __device__ __forceinline__ bool next(int i, pg8::Unit& u) const { if (!Dn.next(i / 3, u)) return false; u.e = i % 3; u.ui = i; return true; }
    __device__ __forceinline__ const char* a_base(const pg8::Unit& u) const { const size_t ko = (size_t)((u.e + 1) >> 1) * 1024 + (size_t)(u.e >> 1) * 512; return Abase + ko + (size_t)u.pm * Dn.tstepA; }
    __device__ __forceinline__ int K_of(const pg8::Unit& u) const { return 512 - 256 * (u.e & 1); }
    __device__ __forceinline__ int ldb_of(const pg8::Unit& u) const { return 512 - 256 * (u.e & 1); }
    __device__ __forceinline__ const char* b_base(const pg8::Unit& u) const {
        const size_t kb = (size_t)(512 - 256 * (u.e & 1)) * 2;
        const size_t base = WS_WBRA + (size_t)((u.e + 1) >> 1) * (WS_WBRB - WS_WBRA) + (size_t)(u.e >> 1) * (WS_WBRC - WS_WBRB);
        return wsb + base + lofs * (size_t)D * kb + (size_t)u.pn * 256 * kb; }
    __device__ __forceinline__ int a_row(const pg8::Unit&, int) const { return 0; }
};
struct EpiP4 {
    static constexpr bool PERM = false;
    const bf16* hbc; float* ho;
    __device__ __forceinline__ void operator()(const f32x4 (&acc)[2][2][4][2], const pg8::Unit& u, int wr, int wc, int fr, int fq) const {
        const int row0 = u.pm * 256 + wr * 64 + fr, col0 = u.pn * 256 + wc * 32 + 4 * fq;
#pragma unroll
        for (int ai = 0; ai < 2; ++ai) { v2u hv[4][2][2];
#pragma unroll
            for (int m = 0; m < 4; ++m)
#pragma unroll
                for (int bj = 0; bj < 2; ++bj)
#pragma unroll
                    for (int n = 0; n < 2; ++n) hv[m][bj][n] = *(const GAS v2u*)(hbc + (size_t)(row0 + ai * 128 + m * 16) * D + col0 + bj * 128 + n * 16);
#pragma unroll
            for (int m = 0; m < 4; ++m)
#pragma unroll
                for (int bj = 0; bj < 2; ++bj)
#pragma unroll
                    for (int n = 0; n < 2; ++n) { const v2u w = hv[m][bj][n]; const f32x4 hf = (f32x4){__uint_as_float(w.x << 16), __uint_as_float(w.x & 0xffff0000u), __uint_as_float(w.y << 16), __uint_as_float(w.y & 0xffff0000u)};
                        *(GAS f32x4*)(ho + (size_t)(row0 + ai * 128 + m * 16) * D + col0 + bj * 128 + n * 16) = hf * ALPHA + acc[ai][bj][m][n]; }
            asm volatile("" ::: "memory"); }
    }
};
struct EpiP7 {
    static constexpr bool PERM = true;
    bf16* hid;
    __device__ __forceinline__ void operator()(const f32x4 (&acc)[2][2][4][2], const pg8::Unit& u, int wr, int wc, int fr, int fq) const {
        const int row0 = u.pm * 256 + wr * 64 + fr, col0 = u.pn * 128 + wc * 32 + 8 * fq;
#pragma unroll
        for (int ai = 0; ai < 2; ++ai)
#pragma unroll
            for (int m = 0; m < 4; ++m) { float r[8];
#pragma unroll
                for (int n = 0; n < 2; ++n)
#pragma unroll
                    for (int j = 0; j < 4; ++j) { const float gv = acc[ai][0][m][n][j], uv = acc[ai][1][m][n][j]; r[4 * n + j] = gv * __builtin_amdgcn_rcpf(1.0f + __builtin_amdgcn_exp2f(-LOG2E * gv)) * uv; }
                v4u w; w.x = pg8::cvt_pk_bf16(r[0], r[1]); w.y = pg8::cvt_pk_bf16(r[2], r[3]); w.z = pg8::cvt_pk_bf16(r[4], r[5]); w.w = pg8::cvt_pk_bf16(r[6], r[7]);
                *(GAS v4u*)(hid + (size_t)(row0 + ai * 128 + m * 16) * DE + col0) = w; }
    }
};
struct EpiP8 {
    static constexpr bool PERM = true;
    bf16* yb; const int* rowtok; const float* rowgate;
    __device__ __forceinline__ void operator()(const f32x4 (&acc)[2][2][4][2], const pg8::Unit& u, int wr, int wc, int fr, int fq) const {
        const int row0 = u.pm * 256 + wr * 64 + fr, col0 = u.pn * 256 + wc * 32 + 8 * fq;
        int rt[2][4]; float gt[2][4];
#pragma unroll
        for (int ai = 0; ai < 2; ++ai)
#pragma unroll
            for (int m = 0; m < 4; ++m) { const int row = row0 + ai * 128 + m * 16; rt[ai][m] = *(const GAS int*)(rowtok + row); gt[ai][m] = *(const GAS float*)(rowgate + row); }
#pragma unroll
        for (int ai = 0; ai < 2; ++ai)
#pragma unroll
            for (int m = 0; m < 4; ++m) {
                if (rt[ai][m] >= 0) {
#pragma unroll
                    for (int bj = 0; bj < 2; ++bj) { const f32x4 v0 = acc[ai][bj][m][0] * gt[ai][m], v1 = acc[ai][bj][m][1] * gt[ai][m];
                        v4u w; w.x = pg8::cvt_pk_bf16(v0[0], v0[1]); w.y = pg8::cvt_pk_bf16(v0[2], v0[3]); w.z = pg8::cvt_pk_bf16(v1[0], v1[1]); w.w = pg8::cvt_pk_bf16(v1[2], v1[3]);
                        *(GAS v4u*)(yb + (size_t)rt[ai][m] * D + col0 + bj * 128) = w; } } }
    }
};

__device__ __forceinline__ void router_row(const float (&x)[16], int t, int lane, const f32x4 (&wg)[16], const float* b_rg, const LAS float* w_re, const float* b_re, LAS int* lcnt, int wslot, Rec* rec) {
    float gl[4] = {0.f, 0.f, 0.f, 0.f};
#pragma unroll
    for (int j = 0; j < 4; ++j)
#pragma unroll
        for (int i = 0; i < 4; ++i) { const f32x4 w = wg[4 * j + i]; const float xv = x[4 * j + i]; gl[0] += xv * w.x; gl[1] += xv * w.y; gl[2] += xv * w.z; gl[3] += xv * w.w; }
#pragma unroll
    for (int g = 0; g < 4; ++g) gl[g] = wave_sum_l(gl[g], lane) + b_rg[g];
    int gi = 0; float gm = gl[0];
#pragma unroll
    for (int g = 1; g < 4; ++g) if (gl[g] > gm) { gm = gl[g]; gi = g; }
    float gs = 0.f;
#pragma unroll
    for (int g = 0; g < 4; ++g) gs += __expf(gl[g] - gm);
    const float gw = 1.0f / gs;
    float el[8];
#pragma unroll
    for (int e = 0; e < 8; ++e) el[e] = 0.f;
    const LAS float* wre = w_re + gi * (D * 8);
#pragma unroll
    for (int j = 0; j < 4; ++j)
#pragma unroll
        for (int i = 0; i < 4; ++i) { const LAS float* wp = wre + ((j * 4 + i) * 128 + lane) * 4; const f32x4 w0 = *(const LAS f32x4*)wp, w1 = *(const LAS f32x4*)(wp + 256); const float xv = x[4 * j + i];
            el[0] += xv * w0.x; el[1] += xv * w0.y; el[2] += xv * w0.z; el[3] += xv * w0.w; el[4] += xv * w1.x; el[5] += xv * w1.y; el[6] += xv * w1.z; el[7] += xv * w1.w; }
#pragma unroll
    for (int e = 0; e < 8; ++e) el[e] = wave_sum_l(el[e], lane) + b_re[gi * 8 + e];
    int i0 = 0; float t0 = el[0];
#pragma unroll
    for (int e = 1; e < 8; ++e) if (el[e] > t0) { t0 = el[e]; i0 = e; }
    int i1 = -1; float t1 = -3.0e38f;
#pragma unroll
    for (int e = 0; e < 8; ++e) if (e != i0 && el[e] > t1) { t1 = el[e]; i1 = e; }
    const float ex = __expf(t1 - t0), p0 = 1.0f / (1.0f + ex), p1 = ex / (1.0f + ex);
    if (lane == 0) {
        const int e0 = gi * 8 + i0, e1 = gi * 8 + i1;
        const int s0 = __hip_atomic_fetch_add(lcnt + e0, 1, __ATOMIC_RELAXED, __HIP_MEMORY_SCOPE_WORKGROUP), s1 = __hip_atomic_fetch_add(lcnt + e1, 1, __ATOMIC_RELAXED, __HIP_MEMORY_SCOPE_WORKGROUP);
        GAS v4u* rp = (GAS v4u*)(rec + t);
        rp[0] = (v4u){(unsigned)e0, (unsigned)s0, (unsigned)e1, (unsigned)s1};
        rp[1] = (v4u){__float_as_uint(gw * p0), __float_as_uint(gw * p1), (unsigned)wslot, 0u};
    }
}

#ifndef STAG_P1
#define STAG_P1 500
#endif
__device__ __forceinline__ void stagger(int vcu, unsigned q) {
    const unsigned long long t0 = __builtin_amdgcn_s_memrealtime(); const unsigned long long d = (unsigned long long)((vcu & 3) * q);
    while (__builtin_amdgcn_s_memrealtime() - t0 < d) __builtin_amdgcn_s_sleep(8);
}
__device__ __forceinline__ void ph_ln0(Frame& F) { LAUNDER(F);
    const int gw = F.vcu * NWAVES + F.wave, NGW = F.G * NWAVES;
    bf16* hb = (bf16*)(F.ws + WS_HB);
    LnIn cur, nxt; if (gw < T) ln_load<0>(cur, F.in[0], nullptr, nullptr, (size_t)gw, F.lane);
    for (int m = gw; m < T; m += NGW) { const bool more = m + NGW < T; if (more) ln_load<0>(nxt, F.in[0], nullptr, nullptr, (size_t)(m + NGW), F.lane);
        f32x4 o[4]; ln_finish<0>(cur, nullptr, hb, F.in[1], F.in[2], (size_t)m, F.lane, o); if (more) cur = nxt; }
}
__device__ __forceinline__ void ph_p1(Frame& F, int l, int c) { LAUNDER(F); asm volatile("" : "+s"(l), "+s"(c));
    pg8::DenseOrder S; S.init((const bf16*)(F.ws + WS_HB) + (size_t)c * CH * D, D, (const bf16*)(F.ws + WS_WIN) + (size_t)l * NCOL * D, D, CH, NCOL, F.G, (int)blockIdx.x);
    EpiP1 E{(bf16*)(F.ws + WS_QKV), (bf16*)(F.ws + WS_GATES), F.in[5] + (size_t)l * GATEW, F.probe};
    pg8::gemm_phase<EpiP1, pg8::DenseOrder, false>(F.lds + RING_OFF, S, E, D, D, D, F.tid);
}
__device__ __forceinline__ void ph_cmb(Frame& F) { LAUNDER(F);
    const bf16* og = (const bf16*)(F.ws + WS_OG); const float* lse = (const float*)(F.ws + WS_LSE); bf16* oabc = (bf16*)(F.ws + WS_OABC);
    for (int idx = F.vcu * NTHREADS + F.tid; idx < CH * 32; idx += F.G * NTHREADS) {
        const int tl = idx >> 5, hc = idx & 31, h = hc >> 3, c = hc & 7;
        const GAS float* lg = (const GAS float*)lse + (size_t)tl * 12 + h; const float l0 = lg[0], l1 = lg[4], l2 = lg[8];
        const float mx = fmaxf(l0, fmaxf(l1, l2)); float w0 = __expf(l0 - mx), w1 = __expf(l1 - mx), w2 = __expf(l2 - mx); const float inv = 1.0f / (w0 + w1 + w2); w0 *= inv; w1 *= inv; w2 *= inv;
        const v4u a = *(const GAS v4u*)(og + ((size_t)tl * 3 + 0) * 256 + h * 64 + c * 8), b = *(const GAS v4u*)(og + ((size_t)tl * 3 + 1) * 256 + h * 64 + c * 8), d = *(const GAS v4u*)(og + ((size_t)tl * 3 + 2) * 256 + h * 64 + c * 8);
        v4u ow;
#pragma unroll
        for (int i = 0; i < 4; ++i) {
            const float lo = w0 * __uint_as_float(a[i] << 16) + w1 * __uint_as_float(b[i] << 16) + w2 * __uint_as_float(d[i] << 16);
            const float hi = w0 * __uint_as_float(a[i] & 0xffff0000u) + w1 * __uint_as_float(b[i] & 0xffff0000u) + w2 * __uint_as_float(d[i] & 0xffff0000u);
            ow[i] = pk2(lo, hi);
        }
        *(GAS v4u*)(oabc + (size_t)tl * OW + 512 + h * 64 + c * 8) = ow;
    }
}
__device__ __forceinline__ void ph_p3(Frame& F, int l) { LAUNDER(F); asm volatile("" : "+s"(l));
    const bf16* oabc = (const bf16*)(F.ws + WS_OABC); bf16* merged = (bf16*)(F.ws + WS_MERGED); const bf16* gates = (const bf16*)(F.ws + WS_GATES);
    P3Order S; S.Dn.init(oabc, OW, nullptr, 0, CH, D, F.G, (int)blockIdx.x);
    S.Abase = (const char*)oabc; S.wsb = (const char*)F.ws; S.lofs = (size_t)l;
    EpiP3V E{merged, gates};
    pg8::gemm_phase_vk<EpiP3V, P3Order>(F.lds + RING_OFF, S, E, OW, F.tid);
}
__device__ __forceinline__ void ph_p4(Frame& F, int l, int c) { LAUNDER(F); asm volatile("" : "+s"(l), "+s"(c));
    pg8::DenseOrder S; S.init((const bf16*)(F.ws + WS_MERGED), D, (const bf16*)(F.ws + WS_WOUT) + (size_t)l * D * D, D, CH, D, F.G, (int)blockIdx.x);
    EpiP4 E{(const bf16*)(F.ws + WS_HB) + (size_t)c * CH * D, F.probe ? (float*)(F.ws + WS_OABC) : F.h + (size_t)c * CH * D};
    pg8::gemm_phase<EpiP4, pg8::DenseOrder, false>(F.lds + RING_OFF, S, E, D, D, D, F.tid);
}
__device__ __forceinline__ void ph_ln1(Frame& F, int l, int c) { LAUNDER(F); asm volatile("" : "+s"(l), "+s"(c));
    const int gw = F.vcu * NWAVES + F.wave, NGW = F.G * NWAVES;
    bf16* hb = (bf16*)(F.ws + WS_HB); Rec* rec = (Rec*)(F.ws + WS_REC);
    int* wgc = (int*)(F.ws + WS_WGCNT) + ((size_t)(l * NCHUNK + c) * F.G + F.vcu) * 32;
    if (F.probe) { hb = (bf16*)(F.ws + WS_QKV) - (size_t)c * CH * D; wgc = (int*)(F.ws + WS_WGCNT) + (size_t)DEPTH * NCHUNK * 256 * 32 + F.vcu * 32; rec = (Rec*)(F.ws + WS_GATES); }
    LAS float* lrg = (LAS float*)(F.lds + RING_OFF); LAS float* lre = lrg + D * 4; LAS int* lcnt = (LAS int*)(F.lds + LCNT_OFF);
    { const float* w_rg = F.in[14] + (size_t)l * D * 4; const float* w_re = F.in[16] + (size_t)l * 4 * D * 8;
      if (F.tid < 32) lcnt[F.tid] = 0;
      for (int u = F.tid; u < D + 4 * D * 2; u += NTHREADS) {
          if (u < D) { const int e = u, ln = (e & 255) >> 2, i = e & 3, j = e >> 8; *(LAS f32x4*)(lrg + ((j * 4 + i) * 64 + ln) * 4) = *(const GAS f32x4*)(w_rg + (size_t)e * 4); }
          else { const int v = u - D, half = v & 1, e = (v >> 1) & 1023, g = v >> 11, ln = (e & 255) >> 2, i = e & 3, j = e >> 8;
                 *(LAS f32x4*)(lre + g * (D * 8) + (((j * 4 + i) * 2 + half) * 64 + ln) * 4) = *(const GAS f32x4*)(w_re + ((size_t)g * D + e) * 8 + half * 4); } }
      __syncthreads(); }
    f32x4 wg[16];
#pragma unroll
    for (int j = 0; j < 4; ++j)
#pragma unroll
        for (int i = 0; i < 4; ++i) wg[4 * j + i] = *(const LAS f32x4*)(lrg + ((j * 4 + i) * 64 + F.lane) * 4);
    const size_t rbase = (size_t)c * CH;
    LnIn cur, nxt; if (gw < CH) ln_load<1>(cur, F.h, nullptr, nullptr, rbase + gw, F.lane);
    for (int m = gw; m < CH; m += NGW) {
        const bool more = m + NGW < CH; if (more) ln_load<1>(nxt, F.h, nullptr, nullptr, rbase + m + NGW, F.lane);
        const size_t row = rbase + m; f32x4 o[4];
        ln_finish<1>(cur, nullptr, hb, F.in[12] + l * D, F.in[13] + l * D, row, F.lane, o);
        float x[16];
#pragma unroll
        for (int j = 0; j < 4; ++j) { x[4 * j] = o[j].x; x[4 * j + 1] = o[j].y; x[4 * j + 2] = o[j].z; x[4 * j + 3] = o[j].w; }
        router_row(x, (int)row, F.lane, wg, F.in[15] + l * 4, lre, F.in[17] + l * 32, lcnt, c * F.G + F.vcu, rec);
        if (more) cur = nxt;
    }
    __syncthreads();
    if (F.tid < 32) *(GAS int*)(wgc + F.tid) = lcnt[F.tid];
}
__device__ __forceinline__ void ph_dsp(Frame& F, int l) { LAUNDER(F); asm volatile("" : "+s"(l));
    LAS int* Tb = (LAS int*)(F.lds + RING_OFF); LAS int* part = Tb + 512 * 32; LAS int* po = part + 32 * 16;
    const int* wg = (const int*)(F.ws + WS_WGCNT) + (size_t)l * NCHUNK * F.G * 32; const int W = NCHUNK * F.G;
    int* cnt = (int*)(F.ws + WS_CTL) + CW_CNT + l * (32 * CSTR); const Rec* rec = (const Rec*)(F.ws + WS_REC); int* rowtok = (int*)(F.ws + WS_ROWTOK); float* rowgate = (float*)(F.ws + WS_ROWGATE);
    for (int i = F.tid; i < W * 32; i += NTHREADS) Tb[i] = *(const GAS int*)(wg + i);
    __syncthreads();
    const int e = F.tid >> 4, k = F.tid & 15, per = (W + 15) / 16, w0 = k * per, w1 = (w0 + per) < W ? (w0 + per) : W;
    { int s = 0; for (int w = w0; w < w1; ++w) s += Tb[w * 32 + e]; part[e * 16 + k] = s; }
    __syncthreads();
    { int base = 0; for (int kk = 0; kk < k; ++kk) base += part[e * 16 + kk];
      for (int w = w0; w < w1; ++w) { const int t = Tb[w * 32 + e]; Tb[w * 32 + e] = base; base += t; } }
    __syncthreads();
    if (F.tid == 0) { int acc = 0; for (int ee = 0; ee < NE; ++ee) { int tot = 0; for (int kk = 0; kk < 16; ++kk) tot += part[ee * 16 + kk]; po[ee] = acc; part[ee * 16] = tot; acc += (tot + 255) / 256 * 256; } po[NE] = acc; }
    __syncthreads();
    if (F.vcu == 0 && F.tid < 32) cnt[F.tid * CSTR] = part[F.tid * 16];
    const int gt = F.vcu * NTHREADS + F.tid, GT = F.G * NTHREADS;
    for (int t = gt; t < T; t += GT) {
        const GAS v4u* rp = (const GAS v4u*)(rec + t); const v4u ra = rp[0], rb = rp[1];
        Rec rc; rc.e0 = (int)ra.x; rc.s0 = (int)ra.y; rc.e1 = (int)ra.z; rc.s1 = (int)ra.w; rc.g0 = __uint_as_float(rb.x); rc.g1 = __uint_as_float(rb.y); rc.pad0 = (int)rb.z; rc.pad1 = 0;
        const int d0 = po[rc.e0] + Tb[rc.pad0 * 32 + rc.e0] + rc.s0, d1 = po[rc.e1] + Tb[rc.pad0 * 32 + rc.e1] + rc.s1;
        *(GAS int*)(rowtok + d0) = 2 * t; *(GAS float*)(rowgate + d0) = rc.g0; *(GAS int*)(rowtok + d1) = 2 * t + 1; *(GAS float*)(rowgate + d1) = rc.g1;
    }
    for (int ee = 0; ee < NE; ++ee) for (int r = po[ee] + part[ee * 16] + gt; r < po[ee + 1]; r += GT) { *(GAS int*)(rowtok + r) = -1; *(GAS float*)(rowgate + r) = 0.f; }
    __syncthreads();
}
__device__ __forceinline__ int moe_setup(Frame& F, int l, bool gather) { LAUNDER(F); asm volatile("" : "+s"(l));
    LAS int* rows = (LAS int*)(F.lds + ROWS_OFF); LAS int* ulist = rows + 11 * 256; LAS int* po = ulist + 16;
    const int* cnt = (const int*)(F.ws + WS_CTL) + CW_CNT + l * (32 * CSTR); const int* rowtok = (const int*)(F.ws + WS_ROWTOK);
    if (F.tid == 0) { int acc = 0; for (int e = 0; e < NE; ++e) { po[e] = acc; acc += (cnt[e * CSTR] + 255) / 256 * 256; } po[NE] = acc; }
    __syncthreads();
    const int nu_all = (po[NE] / 256) * 4; int nun = (nu_all - F.vcu + F.G - 1) / F.G; nun = nun < 0 ? 0 : (nun > 11 ? 11 : nun);
    if (F.tid < nun) { const int Lx = F.tid * F.G + F.vcu, rt = Lx >> 2, pn = Lx & 3; int e = 0; while (e < NE - 1 && po[e + 1] <= rt * 256) ++e; ulist[F.tid] = (rt << 8) | (e << 2) | pn; }
    if (gather) for (int idx = F.tid; idx < nun * 256; idx += NTHREADS) { const int i = idx >> 8, r = idx & 255, Lx = i * F.G + F.vcu; rows[idx] = *(const GAS int*)(rowtok + (Lx >> 2) * 256 + r); }
    __syncthreads();
    return nun;
}
struct MoeOrder {
    int nun; const LAS int* ulist; const LAS int* rows; const char* A; const char* B; size_t tstepA, estepB, tstepB;
    __device__ __forceinline__ bool next(int i, pg8::Unit& u) const {
        if (i >= nun) return false;
        const int w = __builtin_amdgcn_readfirstlane(ulist[i]); u.pm = w >> 8; u.e = (w >> 2) & 63; u.pn = w & 3; u.ui = i; return true;
    }
    __device__ __forceinline__ const char* a_base(const pg8::Unit& u) const { return A + (size_t)u.pm * tstepA; }
    __device__ __forceinline__ const char* b_base(const pg8::Unit& u) const { return B + (size_t)u.e * estepB + (size_t)u.pn * tstepB; }
    __device__ __forceinline__ int a_row(const pg8::Unit& u, int r) const { const int t = rows[u.ui * 256 + r]; return t < 0 ? 0 : (t >> 1); }
};
__device__ __forceinline__ void ph_p7(Frame& F, int l) { LAUNDER(F); asm volatile("" : "+s"(l));
    const int nun = moe_setup(F, l, true);
    LAS int* rows = (LAS int*)(F.lds + ROWS_OFF);
    MoeOrder S{nun, rows + 11 * 256, rows, (const char*)(F.ws + WS_HB), (const char*)(F.ws + WS_WGU) + (size_t)l * NE * 1024 * 1024 * 2, 0, (size_t)1024 * 1024 * 2, (size_t)256 * 1024 * 2};
    EpiP7 E{(bf16*)(F.ws + WS_HID)};
    pg8::gemm_phase<EpiP7, MoeOrder, true>(F.lds + RING_OFF, S, E, D, D, D, F.tid);
}
__device__ __forceinline__ void ph_p8(Frame& F, int l) { LAUNDER(F); asm volatile("" : "+s"(l));
    const int nun = moe_setup(F, l, false);
    LAS int* rows = (LAS int*)(F.lds + ROWS_OFF);
    MoeOrder S{nun, rows + 11 * 256, rows, (const char*)(F.ws + WS_HID), (const char*)(F.ws + WS_WD) + (size_t)l * NE * 1024 * 512 * 2, (size_t)256 * DE * 2, (size_t)1024 * 512 * 2, (size_t)256 * 512 * 2};
    EpiP8 E{(bf16*)(F.ws + WS_YB), (const int*)(F.ws + WS_ROWTOK), (const float*)(F.ws + WS_ROWGATE)};
    pg8::gemm_phase<EpiP8, MoeOrder, false>(F.lds + RING_OFF, S, E, DE, DE, DE, F.tid);
}
__device__ __forceinline__ void ph_ln2(Frame& F, int l) { LAUNDER(F); asm volatile("" : "+s"(l));
    const int gw = F.vcu * NWAVES + F.wave, NGW = F.G * NWAVES;
    const bool lastl = (l == DEPTH - 1);
    const bf16* hsb = (const bf16*)(F.ws + WS_HB); const bf16* yb = (const bf16*)(F.ws + WS_YB);
    bf16* hb = lastl ? nullptr : (bf16*)(F.ws + WS_HB); float* hout = lastl ? F.h : nullptr; size_t omask = ~(size_t)0;
    if (F.probe) { hout = lastl ? (float*)(F.ws + WS_OABC) : nullptr; hb = lastl ? nullptr : (bf16*)(F.ws + WS_OABC); omask = 32767; }
    LnIn cur, nxt; if (gw < T) ln_load<2>(cur, nullptr, hsb, yb, (size_t)gw, F.lane);
    for (int m = gw; m < T; m += NGW) { const bool more = m + NGW < T; if (more) ln_load<2>(nxt, nullptr, hsb, yb, (size_t)(m + NGW), F.lane);
        const size_t back = ((size_t)m - ((size_t)m & omask)) * D;
        f32x4 o[4]; ln_finish<2>(cur, hout ? hout - back : nullptr, hb ? hb - back : nullptr, F.in[21] + l * D, F.in[22] + l * D, (size_t)m, F.lane, o); if (more) cur = nxt; }
}

typedef short s16x4 __attribute__((ext_vector_type(4)));
constexpr int NT_A = (CH / 32) * 4, NT_B = (CH / L) * 3 * 128 * 4, NT_C = (CH / 64) * 8, NT_ALL = NT_A + NT_B + NT_C;
constexpr float NEGBIG = -1.0e30f, MINIT = -5.0e29f;
#define RC16(reg) (((reg) & 3) + 8 * ((reg) >> 2))

__device__ __forceinline__ void ph_tables(Frame& F) { LAUNDER(F);
    float* TA = (float*)(F.ws + WS_TABA); float* TB = (float*)(F.ws + WS_TABB); float* TC = (float*)(F.ws + WS_TABC);
    const float* rel_bias = F.in[3]; const float* rpb = F.in[7];
    const int gt = F.vcu * NTHREADS + F.tid, GT = F.G * NTHREADS;
    for (int i = gt; i < 8 * 320; i += GT) { const int h = i / 320, rel = i % 320 - 160; TA[i] = (rel >= -128 && rel <= 128) ? rel_bias[BUCK_A[rel + 128] * 20 + h] * LOG2E : NEGBIG; }
    for (int i = gt; i < 12 * 256; i += GT) { const int gh = i >> 8, g = gh >> 2, rel = (i & 255) - 128; TB[i] = (rel >= -64 && rel <= 64) ? rel_bias[BUCK_B[g][rel + 64] * 20 + 8 + gh] * LOG2E : NEGBIG; }
    for (int i = gt; i < DEPTH * 8 * 1024; i += GT) { const int lh = i >> 10, ri = (i >> 6) & 15, ci = (i & 63) - 16; TC[i] = (ri < 15 && ci >= 0 && ci <= 30) ? rpb[((size_t)lh * 15 + ri) * 31 + ci] * LOG2E : NEGBIG; }
}

#define ATT_INIT(S, TBP, BIDX, XM) do { \
        _Pragma("unroll") for (int r_ = 0; r_ < 16; ++r_) { float v_ = (TBP)[(BIDX) + RC16(r_)]; if (TYPE == 2) v_ = ((unsigned)((XM) + RC16(r_)) < 16u) ? v_ : NEGBIG; S[r_] = v_; } } while (0)
__device__ __forceinline__ float xhalf_max(float t) { float a_ = t, b_ = t; asm volatile("s_nop 1\n\tv_permlane32_swap_b32 %0, %1" : "+v"(a_), "+v"(b_)); return fmaxf(a_, b_); }
__device__ __forceinline__ float xhalf_sum(float t) { float a_ = t, b_ = t; asm volatile("s_nop 1\n\tv_permlane32_swap_b32 %0, %1" : "+v"(a_), "+v"(b_)); return a_ + b_; }
#define ATT_TMAX(S, t) do { t = NEGBIG; _Pragma("unroll") for (int r_ = 0; r_ < 16; ++r_) t = fmaxf(t, S[r_]); } while (0)
#define ATT_RESCALE(need, t, m, l, Oa, Ob) do { const float mn_ = (need) ? (t) : m, corr_ = __builtin_amdgcn_exp2f(m - mn_); m = mn_; l *= corr_; \
        _Pragma("unroll") for (int i_ = 0; i_ < 16; ++i_) { Oa[i_] *= corr_; Ob[i_] *= corr_; } } while (0)
#define ATT_EXP(S, m, rs) do { rs = 0.f; _Pragma("unroll") for (int r_ = 0; r_ < 16; ++r_) { const float p_ = __builtin_amdgcn_exp2f(S[r_] - m); S[r_] = p_; rs += p_; } } while (0)
#define ATT_PACK(Pf, S, s2) do { unsigned pw_[4]; _Pragma("unroll") for (int j_ = 0; j_ < 4; ++j_) pw_[j_] = pg8::cvt_pk_bf16(S[8 * (s2) + 2 * j_], S[8 * (s2) + 2 * j_ + 1]); \
        Pf = __builtin_bit_cast(bf16x8, (v4u){pw_[0], pw_[1], pw_[2], pw_[3]}); } while (0)
#define ATT_STORE(orow, Oa, Ob, l) do { const float inv_ = 1.0f / (l); \
        _Pragma("unroll") for (int g_ = 0; g_ < 4; ++g_) { v2u w0_, w1_; \
            w0_.x = pg8::cvt_pk_bf16(Oa[4 * g_] * inv_, Oa[4 * g_ + 1] * inv_); w0_.y = pg8::cvt_pk_bf16(Oa[4 * g_ + 2] * inv_, Oa[4 * g_ + 3] * inv_); \
            w1_.x = pg8::cvt_pk_bf16(Ob[4 * g_] * inv_, Ob[4 * g_ + 1] * inv_); w1_.y = pg8::cvt_pk_bf16(Ob[4 * g_ + 2] * inv_, Ob[4 * g_ + 3] * inv_); \
            *(GAS v2u*)((orow) + 8 * g_ + 4 * hh) = w0_; *(GAS v2u*)((orow) + 32 + 8 * g_ + 4 * hh) = w1_; } } while (0)

template <int TYPE>
__device__ __forceinline__ void att_task2(LAS unsigned char* wl, const int lane, const bf16* seq  , const float* tab0, const float* tab1,
                                          const int qcol0, const int qcol1, const int kcol, const int vcol, const int TT0, const int TSTEP, const int kstride, const int tlo, const int thi,
                                          const int tq0, const int tq1  , const int toff1  ,
                                          const int gi0, const int gi1, const int gc, const int cbs  ,
                                          const float m_init0, const float m_init1, const float l_init, bf16* orow0, bf16* orow1, float* lse0, float* lse1) {
    const int qi = lane & 31, hh = lane >> 5;
    LAS unsigned char* kt = wl; LAS unsigned char* vt = wl + 4096; LAS float* tb0 = (LAS float*)(wl + 8192); LAS float* tb1 = (TYPE == 0) ? tb0 + 320 : tb0;
    constexpr int TBN = TYPE == 0 ? 320 : (TYPE == 1 ? 256 : 1024);
#pragma unroll
    for (int i = 0; i < TBN / 64; ++i) { tb0[lane + 64 * i] = *(const GAS float*)(tab0 + lane + 64 * i); if (TYPE == 0) tb1[lane + 64 * i] = *(const GAS float*)(tab1 + lane + 64 * i); }
    bf16x8 Qa[4], Qb[4];
#pragma unroll
    for (int s = 0; s < 4; ++s) { Qa[s] = *(const GAS bf16x8*)(seq + (size_t)tq0 * QKVW + qcol0 + 16 * s + 8 * hh); Qb[s] = *(const GAS bf16x8*)(seq + (size_t)tq1 * QKVW + qcol1 + 16 * s + 8 * hh); }
    f32x16 O0a, O0b, O1a, O1b;
#pragma unroll
    for (int i = 0; i < 16; ++i) { O0a[i] = 0.f; O0b[i] = 0.f; O1a[i] = 0.f; O1b[i] = 0.f; }
    float m0 = m_init0, m1 = m_init1, l0 = l_init, l1 = l_init;
    const int lkey = lane >> 3, lch = lane & 7;
    const unsigned goff = (unsigned)(lkey * kstride) * (unsigned)(QKVW * 2) + 16u * (unsigned)lch;
    const size_t istepb = (size_t)8 * kstride * QKVW * 2;
    const char* kbase = (const char*)(seq + kcol); const char* vbase = (const char*)(seq + vcol);
    const unsigned kw0 = lkey * 128 + ((lch ^ (lkey & 7)) << 4), vw0 = lkey * 128 + (((lch >> 2) ^ ((lkey >> 1) & 1)) << 6) + ((lch & 3) << 4);
    const unsigned kr0 = qi * 128 + ((hh ^ (qi & 7)) << 4);
    const int q4 = (lane & 15) >> 2, p4 = lane & 3, g1 = (lane >> 4) & 1, sw = (q4 >> 1) & 1;
    const unsigned vr0 = (4 * hh + q4) * 128 + 32 * g1 + 8 * p4 + (sw << 6), vr1 = (4 * hh + q4) * 128 + 32 * g1 + 8 * p4 + ((sw ^ 1) << 6);
    const int bidx0 = (TYPE == 2) ? (cbs - gc + 31 + 4 * hh) : ((TYPE == 1 ? 64 : 32) - qi + 4 * hh);
    int cs = gc - 8; cs = cs < 0 ? 0 : (cs > 48 ? 48 : cs);
    const int xm = cbs - cs + 4 * hh;
    int rs0 = gi0 - 4; rs0 = rs0 < 0 ? 0 : (rs0 > 120 ? 120 : rs0);
    int rs1 = gi1 - 4; rs1 = rs1 < 0 ? 0 : (rs1 > 120 ? 120 : rs1);
    v4u kreg[4], vreg[4];
    {
        const size_t tb_ = (size_t)(TT0 + tlo * TSTEP) * (QKVW * 2);
#pragma unroll
        for (int i = 0; i < 4; ++i) { kreg[i] = *(const GAS v4u*)(kbase + tb_ + i * istepb + goff); vreg[i] = *(const GAS v4u*)(vbase + tb_ + i * istepb + goff); }
    }
    for (int ti = tlo; ti <= thi; ++ti) {
#pragma unroll
        for (int i = 0; i < 4; ++i) { *(LAS v4u*)(kt + kw0 + 1024 * i) = kreg[i]; *(LAS v4u*)(vt + vw0 + 1024 * i) = vreg[i]; }
        if (ti < thi) {
            const size_t tb_ = (size_t)(TT0 + (ti + 1) * TSTEP) * (QKVW * 2);
#pragma unroll
            for (int i = 0; i < 4; ++i) { kreg[i] = *(const GAS v4u*)(kbase + tb_ + i * istepb + goff); vreg[i] = *(const GAS v4u*)(vbase + tb_ + i * istepb + goff); }
        }
        int bi0, bi1;
        if (TYPE == 2) { const bool rv0 = (ti >= rs0) && (ti < rs0 + 8), rv1 = (ti >= rs1) && (ti < rs1 + 8); bi0 = bidx0 + (rv0 ? (ti - gi0 + 7) : 15) * 64; bi1 = bidx0 + (rv1 ? (ti - gi1 + 7) : 15) * 64; }
        else { bi0 = bidx0 + 32 * ti; bi1 = bidx0 + 32 * (ti - toff1); }
        f32x16 S0, S1;
        ATT_INIT(S0, tb0, bi0, xm); ATT_INIT(S1, tb1, bi1, xm);
#pragma unroll
        for (int s = 0; s < 4; ++s) { const bf16x8 Kf = *(const LAS bf16x8*)(kt + (kr0 ^ (unsigned)(s << 5)));
            S0 = __builtin_amdgcn_mfma_f32_32x32x16_bf16(Kf, Qa[s], S0, 0, 0, 0); S1 = __builtin_amdgcn_mfma_f32_32x32x16_bf16(Kf, Qb[s], S1, 0, 0, 0); }
        float t0, t1; ATT_TMAX(S0, t0); ATT_TMAX(S1, t1);
        t0 = xhalf_max(t0); t1 = xhalf_max(t1);
        const bool need0 = t0 > m0 + 8.0f, need1 = t1 > m1 + 8.0f;
        if (__builtin_amdgcn_ballot_w64(need0 || need1) != 0ull) { ATT_RESCALE(need0, t0, m0, l0, O0a, O0b); ATT_RESCALE(need1, t1, m1, l1, O1a, O1b); }
        float rs0, rs1; ATT_EXP(S0, m0, rs0); ATT_EXP(S1, m1, rs1);
        rs0 = xhalf_sum(rs0); rs1 = xhalf_sum(rs1);
        l0 += rs0; l1 += rs1;
#pragma unroll
        for (int s2 = 0; s2 < 2; ++s2) {
            bf16x8 P0, P1; ATT_PACK(P0, S0, s2); ATT_PACK(P1, S1, s2);
            const s16x4 a00 = __builtin_amdgcn_ds_read_tr16_b64_v4i16((LAS s16x4*)(vt + vr0 + (16 * s2) * 128));
            const s16x4 a01 = __builtin_amdgcn_ds_read_tr16_b64_v4i16((LAS s16x4*)(vt + vr0 + (16 * s2 + 8) * 128));
            const s16x4 a10 = __builtin_amdgcn_ds_read_tr16_b64_v4i16((LAS s16x4*)(vt + vr1 + (16 * s2) * 128));
            const s16x4 a11 = __builtin_amdgcn_ds_read_tr16_b64_v4i16((LAS s16x4*)(vt + vr1 + (16 * s2 + 8) * 128));
            const bf16x8 V0 = (bf16x8){a00[0], a00[1], a00[2], a00[3], a01[0], a01[1], a01[2], a01[3]};
            const bf16x8 V1 = (bf16x8){a10[0], a10[1], a10[2], a10[3], a11[0], a11[1], a11[2], a11[3]};
            O0a = __builtin_amdgcn_mfma_f32_32x32x16_bf16(V0, P0, O0a, 0, 0, 0); O0b = __builtin_amdgcn_mfma_f32_32x32x16_bf16(V1, P0, O0b, 0, 0, 0);
            O1a = __builtin_amdgcn_mfma_f32_32x32x16_bf16(V0, P1, O1a, 0, 0, 0); O1b = __builtin_amdgcn_mfma_f32_32x32x16_bf16(V1, P1, O1b, 0, 0, 0);
        }
    }
    ATT_STORE(orow0, O0a, O0b, l0);
    ATT_STORE(orow1, O1a, O1b, l1);
    if (TYPE == 1 && hh == 0) { *(GAS float*)lse0 = (m0 + __builtin_amdgcn_logf(l0)) * LN2; *(GAS float*)lse1 = (m1 + __builtin_amdgcn_logf(l1)) * LN2; }
}

__device__ __forceinline__ void ph_att(Frame& F, int l) { LAUNDER(F); asm volatile("" : "+s"(l));
    LAS unsigned char* wl = F.lds + RING_OFF + F.wave * 16384;
    const bf16* qkv = (const bf16*)(F.ws + WS_QKV); bf16* oabc = (bf16*)(F.ws + WS_OABC); bf16* og = (bf16*)(F.ws + WS_OG); float* lse = (float*)(F.ws + WS_LSE);
    const float* TA = (const float*)(F.ws + WS_TABA); const float* TB = (const float*)(F.ws + WS_TABB); const float* TC = (const float*)(F.ws + WS_TABC) + (size_t)l * 8 * 1024;
    const float* sink = F.in[6] + l * 8;
    const int gw = F.vcu * NWAVES + F.wave, NGW = F.G * NWAVES;
    for (int task = gw; task < NT_ALL; task += NGW) {
        int lane = F.lane; asm volatile("" : "+v"(lane)); const int qi = lane & 31;
        if (task < NT_A) {
            const int hp = task & 3, qb = (task >> 2) & 255, b = task >> 10, q0 = qb * 32, h0 = hp * 2, h1 = h0 + 1, kvh = hp >> 1;
            int tlo = 0, thi = 8; if (q0 - 128 < 0) tlo = (128 - q0) / 32; if (q0 + 128 + 31 >= L) thi = (L - 1 - (q0 - 128)) / 32;
            const int tq = q0 + qi; bf16* orow = oabc + (size_t)(b * L + tq) * OW;
            att_task2<0>(wl, lane, qkv + (size_t)b * L * QKVW, TA + h0 * 320, TA + h1 * 320, AQ + h0 * 64, AQ + h1 * 64, AK + kvh * 64, AV + kvh * 64, q0 - 128, 32, 1, tlo, thi,
                         tq, tq, 0, 0, 0, 0, 0, sink[h0] * LOG2E, sink[h1] * LOG2E, 1.0f, orow + h0 * 64, orow + h1 * 64, nullptr, nullptr);
        } else if (task < NT_A + NT_B) {
            const int j = task - NT_A, h = j & 3, sbi = (j >> 2) & 127, bg = j >> 9, g = bg % 3, b = bg / 3;
            const int dsh = 2 * g, d = 1 << dsh, nsb = 128 >> dsh, r = sbi / nsb, sb = sbi % nsb, q0 = sb * 64, Ls = L >> dsh;
            int tlo = 0, thi = 5; if (q0 - 64 < 0) tlo = (64 - q0) / 32; if (q0 + 32 + 64 + 31 >= Ls) thi = (Ls - 1 - (q0 - 64)) / 32;
            const int tq0 = (q0 + qi) * d + r, tq1 = (q0 + 32 + qi) * d + r, qc = BQ0 + 768 * g + h * 64;
            att_task2<1>(wl, lane, qkv + (size_t)b * L * QKVW, TB + (g * 4 + h) * 256, nullptr, qc, qc, qc + 256, qc + 512, (q0 - 64) * d + r, 32 * d, d, tlo, thi,
                         tq0, tq1, 1, 0, 0, 0, 0, MINIT, MINIT, 0.0f, og + ((size_t)(b * L + tq0) * 3 + g) * 256 + h * 64, og + ((size_t)(b * L + tq1) * 3 + g) * 256 + h * 64,
                         lse + ((size_t)(b * L + tq0) * 3 + g) * 4 + h, lse + ((size_t)(b * L + tq1) * 3 + g) * 4 + h);
        } else {
            const int j = task - NT_A - NT_B, h = j & 7, cbi = (j >> 3) & 127, b = j >> 10, ip = cbi >> 2, cb = cbi & 3;
            const int gi0 = 4 * ip + (qi >> 4), gi1 = gi0 + 2, gc = 16 * cb + (qi & 15), tq0 = gi0 * 64 + gc, tq1 = gi1 * 64 + gc;
            int cbs = 16 * cb - 8; cbs = cbs < 0 ? 0 : (cbs > 32 ? 32 : cbs);
            int rlo = 4 * ip - 4; rlo = rlo < 0 ? 0 : (rlo > 120 ? 120 : rlo);
            int rhi = 4 * ip + 3 - 4; rhi = rhi < 0 ? 0 : (rhi > 120 ? 120 : rhi); rhi += 7;
            bf16* ob = oabc + (size_t)(b * L) * OW + 768 + h * 64;
            att_task2<2>(wl, lane, qkv + (size_t)b * L * QKVW, TC + h * 1024, nullptr, CQ + h * 64, CQ + h * 64, CK + h * 64, CV + h * 64, cbs, 64, 1, rlo, rhi,
                         tq0, tq1, 0, gi0, gi1, gc, cbs, MINIT, MINIT, 0.0f, ob + (size_t)tq0 * OW, ob + (size_t)tq1 * OW, nullptr, nullptr);
        }
    }
}

constexpr int NSTEPS = 1 + DEPTH * 16;
__global__ void __launch_bounds__(NTHREADS, 2) mk_fwd(Args args) {
    extern __shared__ __attribute__((aligned(16))) unsigned char lds[];
    Frame F;
    F.lds = (LAS unsigned char*)lds; F.wave = __builtin_amdgcn_readfirstlane((int)threadIdx.x >> 6); F.lane = hw_lane(); F.tid = F.wave * 64 + F.lane;
    F.G = gridDim.x; { const int bx = blockIdx.x; F.vcu = (F.G % 8 == 0) ? (bx % 8) * (F.G / 8) + bx / 8 : bx; }
    F.in = args.in; F.h = args.out; F.ws = args.ws; F.probe = args.probe;
    volatile LAS unsigned* MISC = (volatile LAS unsigned*)(F.lds + MISC_OFF);
    if (F.tid < 32) MISC[F.tid] = 0u;
    __syncthreads();
    const int lo = args.s_lo, hi = args.s_hi;
    XcdBarrier bar; bar.wave0 = (F.wave == 0); bar.bar = (unsigned*)(F.ws + WS_CTL) + CW_BAR; bar.x = 0; bar.st = nullptr;
    if (hi - lo > 1) bar = xcd_barrier_post((unsigned*)(F.ws + WS_CTL) + CW_BAR, MISC + 8, F.wave == 0);
#define RUN(s) (lo <= (s) && (s) < hi)
#define SEAM(s) do { if (RUN(s) && RUN((s) + 1)) xcd_barrier(bar); } while (0)
    if (RUN(0)) { ph_prologue(F); ph_tables(F); ph_ln0(F); }
    SEAM(0);
    for (int l = 0; l < DEPTH; ++l) {
        const int sb = 1 + l * 16;
        for (int c = 0; c < NCHUNK; ++c) {
            const int s = sb + c * 6;
            if (RUN(s)) ph_p1(F, l, c);
            SEAM(s);
            if (RUN(s + 1)) ph_att(F, l);
            SEAM(s + 1);
            if (RUN(s + 2)) ph_cmb(F);
            SEAM(s + 2);
            if (RUN(s + 3)) ph_p3(F, l);
            SEAM(s + 3);
            if (RUN(s + 4)) ph_p4(F, l, c);
            SEAM(s + 4);
            if (RUN(s + 5)) ph_ln1(F, l, c);
            if (c == NCHUNK - 1) SEAM(s + 5);
        }
        if (RUN(sb + 12)) ph_dsp(F, l);
        SEAM(sb + 12);
        if (RUN(sb + 13)) ph_p7(F, l);
        SEAM(sb + 13);
        if (RUN(sb + 14)) ph_p8(F, l);
        SEAM(sb + 14);
        if (RUN(sb + 15)) ph_ln2(F, l);
        SEAM(sb + 15);
    }
#undef RUN
#undef SEAM
}

#ifndef DUP_NOEPI
#define DUP_NOEPI 0
#endif
#ifndef FAST_MASK
#define FAST_MASK 0x7FF
#endif
#ifndef ONE_LAUNCH
#define ONE_LAUNCH 1
#endif
extern "C" void kernel_launch(void* const* d_in, const int* in_sizes, int n_in, void* d_out, int out_size, void* d_ws, size_t ws_size, hipStream_t stream) {
    static int grid = 0;
    if (grid == 0) {
        if (n_in != 23 || out_size != T * D || ws_size < WS_END) { fprintf(stderr, "kernel_launch: unexpected shapes (n_in %d out %d ws %zu)\n", n_in, out_size, ws_size); grid = -1; return; }
        int dev = 0, cus = 0, per_cu = 0;
        if (hipGetDevice(&dev) != hipSuccess || hipDeviceGetAttribute(&cus, hipDeviceAttributeMultiprocessorCount, dev) != hipSuccess) { grid = -1; return; }
        if (hipFuncSetAttribute((const void*)mk_fwd, hipFuncAttributeMaxDynamicSharedMemorySize, LDS_BYTES) != hipSuccess) { fprintf(stderr, "kernel_launch: hipFuncSetAttribute failed\n"); grid = -1; return; }
        if (hipOccupancyMaxActiveBlocksPerMultiprocessor(&per_cu, (const void*)mk_fwd, NTHREADS, LDS_BYTES) != hipSuccess || per_cu < 1) fprintf(stderr, "kernel_launch: occupancy query reports %d\n", per_cu);
        (void)hipGetLastError();
        grid = cus;
    }
    if (grid < 0) return;
    const float* x = (const float*)d_in[0]; const float* ln0_g = (const float*)d_in[1]; const float* ln0_b = (const float*)d_in[2]; const float* rel_bias = (const float*)d_in[3];
    const float* w_in = (const float*)d_in[4]; const float* b_gate = (const float*)d_in[5]; const float* sink_a = (const float*)d_in[6]; const float* rpb_c = (const float*)d_in[7];
    const float* w_br_a = (const float*)d_in[8]; const float* w_br_b = (const float*)d_in[9]; const float* w_br_c = (const float*)d_in[10]; const float* w_out = (const float*)d_in[11];
    const float* ln1_g = (const float*)d_in[12]; const float* ln1_b = (const float*)d_in[13]; const float* w_rg = (const float*)d_in[14]; const float* b_rg = (const float*)d_in[15];
    const float* w_re = (const float*)d_in[16]; const float* b_re = (const float*)d_in[17]; const float* w_eg = (const float*)d_in[18]; const float* w_eu = (const float*)d_in[19];
    const float* w_ed = (const float*)d_in[20]; const float* ln2_g = (const float*)d_in[21]; const float* ln2_b = (const float*)d_in[22];
    unsigned char* ws = (unsigned char*)d_ws; float* h = (float*)d_out;
    bf16* hb = (bf16*)(ws + WS_HB); bf16* qkv = (bf16*)(ws + WS_QKV); bf16* gates = (bf16*)(ws + WS_GATES); bf16* oabc = (bf16*)(ws + WS_OABC); bf16* og = (bf16*)(ws + WS_OG);
    float* lse = (float*)(ws + WS_LSE); Rec* rec = (Rec*)(ws + WS_REC); int* rowtok = (int*)(ws + WS_ROWTOK); float* rowgate = (float*)(ws + WS_ROWGATE);
    bf16* merged = (bf16*)(ws + WS_MERGED); bf16* hid = (bf16*)(ws + WS_HID); bf16* yb = (bf16*)(ws + WS_YB); int* cnt = (int*)(ws + WS_CTL) + CW_CNT;
    (void)hipMemsetAsync(ws + WS_CTL, 0, CTL_ZERO_BYTES, stream);
    Args a{};
    for (int i = 0; i < 23; ++i) a.in[i] = (const float*)d_in[i];
    a.out = h; a.ws = ws;
    if (ONE_LAUNCH) { a.s_lo = 0; a.s_hi = NSTEPS; hipLaunchKernelGGL(mk_fwd, dim3(grid), dim3(NTHREADS), LDS_BYTES, stream, a); return; }
    const int G = 2048;
    const bool fastp1 = (FAST_MASK >> 1) & 1;
    for (int s = 0; s < NSTEPS; ++s) {
        int kind, l = 0, c = 0;
        if (s == 0) kind = 0; else { const int r = (s - 1) % 16; l = (s - 1) / 16; if (r < 12) { c = r / 6; kind = 1 + r % 6; } else kind = 7 + (r - 12); }
        if ((FAST_MASK >> kind) & 1) { a.s_lo = s; a.s_hi = s + 1;
#ifdef DUP_KIND
            if (kind == DUP_KIND && (kind == 5 || kind == 6 || kind == 10 || (kind == 1 && DUP_NOEPI))) { a.probe = 1; hipLaunchKernelGGL(mk_fwd, dim3(grid), dim3(NTHREADS), LDS_BYTES, stream, a); a.probe = 0; }
#endif
            hipLaunchKernelGGL(mk_fwd, dim3(grid), dim3(NTHREADS), LDS_BYTES, stream, a);
#ifdef DUP_KIND
            if (kind == DUP_KIND && !(kind == 5 || kind == 6 || kind == 10 || (kind == 1 && DUP_NOEPI))) { hipLaunchKernelGGL(mk_fwd, dim3(grid), dim3(NTHREADS), LDS_BYTES, stream, a); }
#endif
            continue; }
        const size_t r0 = (size_t)c * CH;
        switch (kind) {
        case 0: k_ln<<<G, 256, 0, stream>>>(0, x, h, hb, nullptr, ln0_g, ln0_b, 0, T); break;
        case 1: k_p1<<<G, 256, 0, stream>>>(hb + r0 * D, w_in + (size_t)l * D * NCOL, b_gate + (size_t)l * GATEW, qkv, gates); break;
        case 2: k_attn_naive<<<(28 * CH + 255) / 256, 256, 0, stream>>>(qkv, oabc, og, lse, rel_bias, sink_a + l * 8, rpb_c + (size_t)l * 8 * 15 * 31, fastp1 ? LN2 : 0.125f); break;
        case 3: k_combine<<<(CH * 32 + 255) / 256, 256, 0, stream>>>(og, lse, oabc); break;
        case 4: k_p3<<<G, 256, 0, stream>>>(oabc, gates, w_br_a + (size_t)l * 512 * D, w_br_b + (size_t)l * 256 * D, w_br_c + (size_t)l * 512 * D, merged); break;
        case 5: k_p4<<<G, 256, 0, stream>>>(merged, w_out + (size_t)l * D * D, h + r0 * D); break;
        case 6: k_ln<<<G, 256, 0, stream>>>(1, nullptr, h, hb, nullptr, ln1_g + l * D, ln1_b + l * D, (int)r0, CH);
                if (c == NCHUNK - 1) k_router<<<G, 256, 0, stream>>>(h, w_rg + (size_t)l * D * 4, b_rg + l * 4, w_re + (size_t)l * 4 * D * 8, b_re + l * 32, cnt + l * (32 * CSTR), rec);
                break;
        case 7: (void)hipMemsetAsync(rowtok, 0xFF, (size_t)PROWS * 4, stream); k_dispatch<<<256, 256, 0, stream>>>(cnt + l * (32 * CSTR), rec, rowtok, rowgate); break;
        case 8: k_p7<<<G, 256, 0, stream>>>(hb, cnt + l * (32 * CSTR), rowtok, w_eg + (size_t)l * NE * D * DE, w_eu + (size_t)l * NE * D * DE, hid); break;
        case 9: k_p8<<<G, 256, 0, stream>>>(hid, cnt + l * (32 * CSTR), rowtok, rowgate, w_ed + (size_t)l * NE * DE * D, yb); break;
        case 10: k_ln<<<G, 256, 0, stream>>>(2, nullptr, h, (l == DEPTH - 1) ? nullptr : hb, yb, ln2_g + l * D, ln2_b + l * D, 0, T); break;
        }
    }
}
```

```cpp
#include <hip/hip_runtime.h>
#include <cstdio>
#include <cstdint>
#include <cmath>

typedef unsigned short bf16;
typedef short bf16x8 __attribute__((ext_vector_type(8)));
typedef float f32x16 __attribute__((ext_vector_type(16)));
typedef float f32x4 __attribute__((ext_vector_type(4)));

constexpr int D = 1024, L = 8192, NBATCH = 8, T = NBATCH * L, DEPTH = 2;
constexpr int NCOL = 7680, QKVW = 4608, GATEW = 3072;
constexpr int CH = 32768, NCHUNK = T / CH;
constexpr int OW = 1280;
constexpr int NE = 32, DE = 512;
constexpr int MAXRT = T * 2 / 256 + NE, PROWS = MAXRT * 256;
constexpr float LN_EPS = 1e-5f;
constexpr float ALPHA = 1.41421356237309515f;
constexpr int AQ = 0, AK = 512, AV = 640, BQ0 = 768, CQ = 3072, CK = 3584, CV = 4096;

constexpr size_t MiB = 1u << 20;
constexpr size_t WS_CTL = 0;
constexpr size_t WS_WIN = 1 * MiB, WS_WBRA = 31 * MiB, WS_WBRB = 33 * MiB, WS_WBRC = 34 * MiB, WS_WOUT = 36 * MiB, WS_WGU = 40 * MiB, WS_WD = 168 * MiB;
constexpr size_t WS_HB = 232 * MiB, WS_QKV = 360 * MiB, WS_GATES = 648 * MiB, WS_OABC = 840 * MiB, WS_OG = 920 * MiB, WS_LSE = 968 * MiB,
                 WS_REC = 970 * MiB, WS_ROWTOK = 972 * MiB, WS_ROWGATE = 973 * MiB, WS_TABA = 974 * MiB, WS_TABB = WS_TABA + 16384, WS_TABC = WS_TABA + 32768, WS_WGCNT = WS_TABA + 131072  , WS_END = 975 * MiB;
constexpr size_t WS_MERGED = WS_QKV, WS_HID = WS_QKV, WS_YB = WS_QKV + 136 * MiB;
constexpr int CSTR = 32;

__device__ __constant__ signed char BUCK_A[257] = {12,11,11,11,11,11,11,11,11,11,11,11,11,11,11,11,11,11,11,11,11,11,11,11,11,11,11,11,11,11,11,11,11,11,11,11,11,11,11,11,11,11,11,11,11,11,11,11,11,11,11,11,11,11,11,11,11,11,11,11,11,11,11,11,11,10,10,10,10,10,10,10,10,10,10,10,10,10,10,10,10,10,10,10,10,10,10,10,10,10,10,10,10,10,10,10,10,9,9,9,9,9,9,9,9,9,9,9,9,9,9,9,9,8,8,8,8,8,8,8,8,7,6,5,4,3,2,1,0,17,18,19,20,21,22,23,24,24,24,24,24,24,24,24,25,25,25,25,25,25,25,25,25,25,25,25,25,25,25,25,26,26,26,26,26,26,26,26,26,26,26,26,26,26,26,26,26,26,26,26,26,26,26,26,26,26,26,26,26,26,26,26,27,27,27,27,27,27,27,27,27,27,27,27,27,27,27,27,27,27,27,27,27,27,27,27,27,27,27,27,27,27,27,27,27,27,27,27,27,27,27,27,27,27,27,27,27,27,27,27,27,27,27,27,27,27,27,27,27,27,27,27,27,27,27,27,28};
__device__ __constant__ signed char BUCK_B[3][129] = {
 {11,10,10,10,10,10,10,10,10,10,10,10,10,10,10,10,10,10,10,10,10,10,10,10,10,10,10,10,10,10,10,10,10,9,9,9,9,9,9,9,9,9,9,9,9,9,9,9,9,8,8,8,8,8,8,8,8,7,6,5,4,3,2,1,0,17,18,19,20,21,22,23,24,24,24,24,24,24,24,24,25,25,25,25,25,25,25,25,25,25,25,25,25,25,25,25,26,26,26,26,26,26,26,26,26,26,26,26,26,26,26,26,26,26,26,26,26,26,26,26,26,26,26,26,26,26,26,26,27},
 {13,12,12,12,12,12,12,12,12,12,12,12,12,12,12,12,12,12,12,12,12,12,12,12,12,12,12,12,12,12,12,12,12,11,11,11,11,11,11,11,11,11,11,11,11,11,11,11,11,10,10,10,10,10,10,10,10,9,9,9,9,8,8,4,0,20,24,24,25,25,25,25,26,26,26,26,26,26,26,26,27,27,27,27,27,27,27,27,27,27,27,27,27,27,27,27,28,28,28,28,28,28,28,28,28,28,28,28,28,28,28,28,28,28,28,28,28,28,28,28,28,28,28,28,28,28,28,28,29},
 {15,14,14,14,14,14,14,14,14,14,14,14,14,14,14,14,14,14,14,14,14,14,14,14,14,14,14,14,14,14,14,14,14,13,13,13,13,13,13,13,13,13,13,13,13,13,13,13,13,12,12,12,12,12,12,12,12,11,11,11,11,10,10,9,0,25,26,26,27,27,27,27,28,28,28,28,28,28,28,28,29,29,29,29,29,29,29,29,29,29,29,29,29,29,29,29,30,30,30,30,30,30,30,30,30,30,30,30,30,30,30,30,30,30,30,30,30,30,30,30,30,30,30,30,30,30,30,30,31}};

__device__ __forceinline__ float bf2f(bf16 b) { return __uint_as_float(((unsigned)b) << 16); }
__device__ __forceinline__ bf16 f2bf(float f) { unsigned u = __float_as_uint(f); u += 0x7fffu + ((u >> 16) & 1u); return (bf16)(u >> 16); }
__device__ __forceinline__ float wave_sum(float v) {
#pragma unroll
    for (int o = 1; o < 64; o <<= 1) v += __shfl_xor(v, o);
    return v;
}

__global__ __launch_bounds__(256) void k_ln(int mode, const float* src, float* h, bf16* hb, const bf16* yb, const float* g, const float* bta, int row0, int nrows) {
    const int lane = threadIdx.x & 63, wv = blockIdx.x * 4 + (threadIdx.x >> 6), nw = gridDim.x * 4;
    for (int rr = wv; rr < nrows; rr += nw) {
        const size_t row = (size_t)row0 + rr;
        f32x4 v[4];
#pragma unroll
        for (int j = 0; j < 4; ++j) {
            const int c = lane * 4 + 256 * j;
            v[j] = *(const f32x4*)((mode == 0 ? src : h) + row * D + c);
            if (mode == 2) {
                const uint2 a = *(const uint2*)(yb + (row * 2) * D + c), b = *(const uint2*)(yb + (row * 2 + 1) * D + c);
                v[j].x = ALPHA * v[j].x + bf2f((bf16)(a.x & 0xffff)) + bf2f((bf16)(b.x & 0xffff));
                v[j].y = ALPHA * v[j].y + bf2f((bf16)(a.x >> 16)) + bf2f((bf16)(b.x >> 16));
                v[j].z = ALPHA * v[j].z + bf2f((bf16)(a.y & 0xffff)) + bf2f((bf16)(b.y & 0xffff));
                v[j].w = ALPHA * v[j].w + bf2f((bf16)(a.y >> 16)) + bf2f((bf16)(b.y >> 16));
            }
        }
        float s = 0.f;
#pragma unroll
        for (int j = 0; j < 4; ++j) s += (v[j].x + v[j].y) + (v[j].z + v[j].w);
        const float mean = wave_sum(s) * (1.f / D);
        float q = 0.f;
#pragma unroll
        for (int j = 0; j < 4; ++j) { v[j] = v[j] - mean; q += (v[j].x * v[j].x + v[j].y * v[j].y) + (v[j].z * v[j].z + v[j].w * v[j].w); }
        const float rstd = 1.0f / sqrtf(wave_sum(q) * (1.f / D) + LN_EPS);
#pragma unroll
        for (int j = 0; j < 4; ++j) {
            const int c = lane * 4 + 256 * j;
            const f32x4 gg = *(const f32x4*)(g + c), bb = *(const f32x4*)(bta + c);
            const f32x4 o = v[j] * rstd * gg + bb;
            *(f32x4*)(h + row * D + c) = o;
            if (hb) { uint2 w; w.x = (unsigned)f2bf(o.x) | ((unsigned)f2bf(o.y) << 16); w.y = (unsigned)f2bf(o.z) | ((unsigned)f2bf(o.w) << 16); *(uint2*)(hb + row * D + c) = w; }
        }
    }
}

__device__ __forceinline__ void wave_gemm32(const bf16* arow, const float* wcol, int ldw, int K, f32x16& acc) {
    for (int k0 = 0; k0 < K; k0 += 16) {
        const bf16x8 a = *(const bf16x8*)(arow + k0);
        bf16x8 b;
#pragma unroll
        for (int j = 0; j < 8; ++j) b[j] = (short)f2bf(wcol[(size_t)(k0 + j) * ldw]);
        acc = __builtin_amdgcn_mfma_f32_32x32x16_bf16(a, b, acc, 0, 0, 0);
    }
}
#define ACC_ROW(reg, h) (((reg) & 3) + 8 * ((reg) >> 2) + 4 * (h))

__global__ __launch_bounds__(256) void k_p1(const bf16* hbc, const float* w_in, const float* b_gate, bf16* qkv, bf16* gates) {
    const int lane = threadIdx.x & 63, r = lane & 31, hh = lane >> 5;
    const int wv = blockIdx.x * 4 + (threadIdx.x >> 6), nw = gridDim.x * 4;
    const int ntn = NCOL / 32, total = (CH / 32) * ntn;
    for (int tile = wv; tile < total; tile += nw) {
        const int tm = tile / ntn, tn = tile % ntn;
        f32x16 acc; for (int i = 0; i < 16; ++i) acc[i] = 0.f;
        wave_gemm32(hbc + (size_t)(tm * 32 + r) * D + 8 * hh, w_in + (size_t)(8 * hh) * NCOL + tn * 32 + r, NCOL, D, acc);
        const int col = tn * 32 + r;
#pragma unroll
        for (int i = 0; i < 16; ++i) {
            const int row = tm * 32 + ACC_ROW(i, hh);
            if (col < QKVW) qkv[(size_t)row * QKVW + col] = f2bf(acc[i]);
            else { const float z = acc[i] + b_gate[col - QKVW]; gates[(size_t)row * GATEW + (col - QKVW)] = f2bf(1.0f / (1.0f + __expf(-z))); }
        }
    }
}

__global__ __launch_bounds__(256) void k_attn_naive(const bf16* qkv, bf16* oabc, bf16* og, float* lse, const float* rel_bias, const float* sink_l, const float* rpb_l, float sc) {
    const long idx = (long)blockIdx.x * 256 + threadIdx.x;
    if (idx >= (long)28 * CH) return;
    const int ht = (int)(idx / CH), tl = (int)(idx % CH), b = tl / L, t = tl % L;
    const bf16* base = qkv + (size_t)(b * L) * QKVW;
    int qcol, kcol, vcol;
    if (ht < 8) { qcol = AQ + ht * 64; kcol = AK + (ht >> 2) * 64; vcol = AV + (ht >> 2) * 64; }
    else if (ht < 20) { const int g = (ht - 8) >> 2, h = (ht - 8) & 3; qcol = BQ0 + 768 * g + h * 64; kcol = qcol + 256; vcol = qcol + 512; }
    else { const int h = ht - 20; qcol = CQ + h * 64; kcol = CK + h * 64; vcol = CV + h * 64; }
    float q[64], o[64];
    {
        const uint4* qp = (const uint4*)(base + (size_t)t * QKVW + qcol);
#pragma unroll
        for (int c = 0; c < 8; ++c) { const uint4 u = qp[c]; const unsigned w[4] = {u.x, u.y, u.z, u.w};
#pragma unroll
            for (int i = 0; i < 4; ++i) { q[8 * c + 2 * i] = bf2f((bf16)(w[i] & 0xffff)); q[8 * c + 2 * i + 1] = bf2f((bf16)(w[i] >> 16)); } }
    }
#pragma unroll
    for (int i = 0; i < 64; ++i) o[i] = 0.f;
    float m = -1e30f, l = 0.f;
    if (ht < 8) { m = sink_l[ht]; l = 1.f; }
#define PROC_KEY(KT, BIAS) do { \
        const uint4* kp = (const uint4*)(base + (size_t)(KT) * QKVW + kcol); float s = 0.f; \
        _Pragma("unroll") for (int c = 0; c < 8; ++c) { const uint4 u = kp[c]; const unsigned w[4] = {u.x, u.y, u.z, u.w}; \
            _Pragma("unroll") for (int i = 0; i < 4; ++i) { s += q[8 * c + 2 * i] * bf2f((bf16)(w[i] & 0xffff)); s += q[8 * c + 2 * i + 1] * bf2f((bf16)(w[i] >> 16)); } } \
        s = s * sc + (BIAS); const float mn = fmaxf(m, s), corr = __expf(m - mn), p = __expf(s - mn); l = l * corr + p; m = mn; \
        const uint4* vp = (const uint4*)(base + (size_t)(KT) * QKVW + vcol); \
        _Pragma("unroll") for (int c = 0; c < 8; ++c) { const uint4 u = vp[c]; const unsigned w[4] = {u.x, u.y, u.z, u.w}; \
            _Pragma("unroll") for (int i = 0; i < 4; ++i) { o[8 * c + 2 * i] = o[8 * c + 2 * i] * corr + p * bf2f((bf16)(w[i] & 0xffff)); o[8 * c + 2 * i + 1] = o[8 * c + 2 * i + 1] * corr + p * bf2f((bf16)(w[i] >> 16)); } } \
    } while (0)
    if (ht < 8) {
        for (int rel = -128; rel <= 128; ++rel) { const int kt = t + rel; if (kt < 0 || kt >= L) continue;
            const float bias = rel_bias[BUCK_A[rel + 128] * 20 + ht]; PROC_KEY(kt, bias); }
    } else if (ht < 20) {
        const int g = (ht - 8) >> 2, h = (ht - 8) & 3, dil = (g == 0) ? 1 : (g == 1 ? 4 : 16);
        for (int off = -64; off <= 64; ++off) { const int kt = t + off * dil; if (kt < 0 || kt >= L) continue;
            const float bias = rel_bias[BUCK_B[g][off + 64] * 20 + 8 + 4 * g + h]; PROC_KEY(kt, bias); }
    } else {
        const int h = ht - 20, gi = t >> 6, gc = t & 63;
        int rs = gi - 4; rs = rs < 0 ? 0 : (rs > 120 ? 120 : rs);
        int cs = gc - 8; cs = cs < 0 ? 0 : (cs > 48 ? 48 : cs);
        for (int kr = rs; kr < rs + 8; ++kr)
            for (int kc = cs; kc < cs + 16; ++kc) { const float bias = rpb_l[(h * 15 + (kr - gi + 7)) * 31 + (kc - gc + 15)]; const int kt = kr * 64 + kc; PROC_KEY(kt, bias); }
    }
#undef PROC_KEY
    const float inv = 1.0f / l;
    bf16* dst;
    if (ht < 8) dst = oabc + (size_t)tl * OW + ht * 64;
    else if (ht < 20) { const int g = (ht - 8) >> 2, h = (ht - 8) & 3; dst = og + ((size_t)tl * 3 + g) * 256 + h * 64; lse[((size_t)tl * 3 + g) * 4 + h] = m + __logf(l); }
    else dst = oabc + (size_t)tl * OW + 768 + (ht - 20) * 64;
#pragma unroll
    for (int c = 0; c < 8; ++c) { uint4 u;
        u.x = (unsigned)f2bf(o[8 * c + 0] * inv) | ((unsigned)f2bf(o[8 * c + 1] * inv) << 16); u.y = (unsigned)f2bf(o[8 * c + 2] * inv) | ((unsigned)f2bf(o[8 * c + 3] * inv) << 16);
        u.z = (unsigned)f2bf(o[8 * c + 4] * inv) | ((unsigned)f2bf(o[8 * c + 5] * inv) << 16); u.w = (unsigned)f2bf(o[8 * c + 6] * inv) | ((unsigned)f2bf(o[8 * c + 7] * inv) << 16);
        ((uint4*)dst)[c] = u; }
}

__global__ __launch_bounds__(256) void k_combine(const bf16* og, const float* lse, bf16* oabc) {
    const long idx = (long)blockIdx.x * 256 + threadIdx.x;
    if (idx >= (long)CH * 32) return;
    const int tl = (int)(idx >> 5), hc = (int)(idx & 31), h = hc >> 3, c = hc & 7;
    const float l0 = lse[((size_t)tl * 3 + 0) * 4 + h], l1 = lse[((size_t)tl * 3 + 1) * 4 + h], l2 = lse[((size_t)tl * 3 + 2) * 4 + h];
    const float mx = fmaxf(l0, fmaxf(l1, l2)); float w0 = __expf(l0 - mx), w1 = __expf(l1 - mx), w2 = __expf(l2 - mx); const float inv = 1.0f / (w0 + w1 + w2); w0 *= inv; w1 *= inv; w2 *= inv;
    const uint4 a = *(const uint4*)(og + ((size_t)tl * 3 + 0) * 256 + h * 64 + c * 8), b = *(const uint4*)(og + ((size_t)tl * 3 + 1) * 256 + h * 64 + c * 8), d = *(const uint4*)(og + ((size_t)tl * 3 + 2) * 256 + h * 64 + c * 8);
    const unsigned aw[4] = {a.x, a.y, a.z, a.w}, bw[4] = {b.x, b.y, b.z, b.w}, dw[4] = {d.x, d.y, d.z, d.w}; unsigned ow[4];
#pragma unroll
    for (int i = 0; i < 4; ++i) {
        const float lo = w0 * bf2f((bf16)(aw[i] & 0xffff)) + w1 * bf2f((bf16)(bw[i] & 0xffff)) + w2 * bf2f((bf16)(dw[i] & 0xffff));
        const float hi = w0 * bf2f((bf16)(aw[i] >> 16)) + w1 * bf2f((bf16)(bw[i] >> 16)) + w2 * bf2f((bf16)(dw[i] >> 16));
        ow[i] = (unsigned)f2bf(lo) | ((unsigned)f2bf(hi) << 16);
    }
    *(uint4*)(oabc + (size_t)tl * OW + 512 + h * 64 + c * 8) = make_uint4(ow[0], ow[1], ow[2], ow[3]);
}

__global__ __launch_bounds__(256) void k_p3(const bf16* oabc, const bf16* gates, const float* wa, const float* wb, const float* wc, bf16* merged) {
    const int lane = threadIdx.x & 63, r = lane & 31, hh = lane >> 5;
    const int wv = blockIdx.x * 4 + (threadIdx.x >> 6), nw = gridDim.x * 4;
    const int ntn = D / 32, total = (CH / 32) * ntn;
    for (int tile = wv; tile < total; tile += nw) {
        const int tm = tile / ntn, tn = tile % ntn, col = tn * 32 + r;
        f32x16 mg; for (int i = 0; i < 16; ++i) mg[i] = 0.f;
#pragma unroll 1
        for (int br = 0; br < 3; ++br) {
            f32x16 acc; for (int i = 0; i < 16; ++i) acc[i] = 0.f;
            const int koff = br == 0 ? 0 : (br == 1 ? 512 : 768), K = br == 1 ? 256 : 512;
            const float* w = br == 0 ? wa : (br == 1 ? wb : wc);
            wave_gemm32(oabc + (size_t)(tm * 32 + r) * OW + koff + 8 * hh, w + (size_t)(8 * hh) * D + col, D, K, acc);
#pragma unroll
            for (int i = 0; i < 16; ++i) { const int row = tm * 32 + ACC_ROW(i, hh); mg[i] += bf2f(gates[(size_t)row * GATEW + br * 1024 + col]) * acc[i]; }
        }
#pragma unroll
        for (int i = 0; i < 16; ++i) { const int row = tm * 32 + ACC_ROW(i, hh); merged[(size_t)row * D + col] = f2bf(mg[i]); }
    }
}
__global__ __launch_bounds__(256) void k_p4(const bf16* merged, const float* wo, float* hchunk) {
    const int lane = threadIdx.x & 63, r = lane & 31, hh = lane >> 5;
    const int wv = blockIdx.x * 4 + (threadIdx.x >> 6), nw = gridDim.x * 4;
    const int ntn = D / 32, total = (CH / 32) * ntn;
    for (int tile = wv; tile < total; tile += nw) {
        const int tm = tile / ntn, tn = tile % ntn, col = tn * 32 + r;
        f32x16 acc; for (int i = 0; i < 16; ++i) acc[i] = 0.f;
        wave_gemm32(merged + (size_t)(tm * 32 + r) * D + 8 * hh, wo + (size_t)(8 * hh) * D + col, D, D, acc);
#pragma unroll
        for (int i = 0; i < 16; ++i) { const int row = tm * 32 + ACC_ROW(i, hh); float* p = hchunk + (size_t)row * D + col; *p = ALPHA * *p + acc[i]; }
    }
}

struct Rec { int e0, s0, e1, s1; float g0, g1; int pad0, pad1; };
__global__ __launch_bounds__(256) void k_router(const float* h, const float* w_rg, const float* b_rg, const float* w_re, const float* b_re, int* cnt, Rec* rec) {
    const int lane = threadIdx.x & 63, wv = blockIdx.x * 4 + (threadIdx.x >> 6), nw = gridDim.x * 4;
    for (int t = wv; t < T; t += nw) {
        float x[16];
#pragma unroll
        for (int j = 0; j < 4; ++j) { const f32x4 v = *(const f32x4*)(h + (size_t)t * D + lane * 4 + 256 * j); x[4 * j] = v.x; x[4 * j + 1] = v.y; x[4 * j + 2] = v.z; x[4 * j + 3] = v.w; }
        float gl[4] = {0.f, 0.f, 0.f, 0.f};
#pragma unroll
        for (int j = 0; j < 4; ++j)
#pragma unroll
            for (int i = 0; i < 4; ++i) { const f32x4 w = *(const f32x4*)(w_rg + (size_t)(lane * 4 + 256 * j + i) * 4); const float xv = x[4 * j + i]; gl[0] += xv * w.x; gl[1] += xv * w.y; gl[2] += xv * w.z; gl[3] += xv * w.w; }
#pragma unroll
        for (int g = 0; g < 4; ++g) gl[g] = wave_sum(gl[g]) + b_rg[g];
        int gi = 0; float gm = gl[0];
#pragma unroll
        for (int g = 1; g < 4; ++g) if (gl[g] > gm) { gm = gl[g]; gi = g; }
        float gs = 0.f;
#pragma unroll
        for (int g = 0; g < 4; ++g) gs += __expf(gl[g] - gm);
        const float gw = 1.0f / gs;
        float el[8];
#pragma unroll
        for (int e = 0; e < 8; ++e) el[e] = 0.f;
        const float* wre = w_re + (size_t)gi * D * 8;
#pragma unroll
        for (int j = 0; j < 4; ++j)
#pragma unroll
            for (int i = 0; i < 4; ++i) { const float* wp = wre + (size_t)(lane * 4 + 256 * j + i) * 8; const f32x4 w0 = *(const f32x4*)wp, w1 = *(const f32x4*)(wp + 4); const float xv = x[4 * j + i];
                el[0] += xv * w0.x; el[1] += xv * w0.y; el[2] += xv * w0.z; el[3] += xv * w0.w; el[4] += xv * w1.x; el[5] += xv * w1.y; el[6] += xv * w1.z; el[7] += xv * w1.w; }
#pragma unroll
        for (int e = 0; e < 8; ++e) el[e] = wave_sum(el[e]) + b_re[gi * 8 + e];
        int i0 = 0; float t0 = el[0];
#pragma unroll
        for (int e = 1; e < 8; ++e) if (el[e] > t0) { t0 = el[e]; i0 = e; }
        int i1 = -1; float t1 = -3.0e38f;
#pragma unroll
        for (int e = 0; e < 8; ++e) if (e != i0 && el[e] > t1) { t1 = el[e]; i1 = e; }
        const float ex = __expf(t1 - t0), p0 = 1.0f / (1.0f + ex), p1 = ex / (1.0f + ex);
        if (lane == 0) {
            Rec rc; rc.e0 = gi * 8 + i0; rc.e1 = gi * 8 + i1; rc.g0 = gw * p0; rc.g1 = gw * p1; rc.pad0 = 0; rc.pad1 = 0;
            rc.s0 = atomicAdd(cnt + rc.e0 * CSTR, 1); rc.s1 = atomicAdd(cnt + rc.e1 * CSTR, 1);
            rec[t] = rc;
        }
    }
}
__device__ __forceinline__ void pad_offsets(const int* cnt, int* po) { int acc = 0; for (int e = 0; e < NE; ++e) { po[e] = acc; acc += (cnt[e * CSTR] + 255) / 256 * 256; } po[NE] = acc; }
__global__ __launch_bounds__(256) void k_dispatch(const int* cnt, const Rec* rec, int* rowtok, float* rowgate) {
    __shared__ int po[NE + 1];
    if (threadIdx.x == 0) pad_offsets(cnt, po);
    __syncthreads();
    for (int t = blockIdx.x * 256 + threadIdx.x; t < T; t += gridDim.x * 256) {
        const Rec rc = rec[t];
        const int d0 = po[rc.e0] + rc.s0, d1 = po[rc.e1] + rc.s1;
        rowtok[d0] = 2 * t; rowgate[d0] = rc.g0; rowtok[d1] = 2 * t + 1; rowgate[d1] = rc.g1;
    }
}
__global__ __launch_bounds__(256) void k_p7(const bf16* hb, const int* cnt, const int* rowtok, const float* w_eg, const float* w_eu, bf16* hid) {
    __shared__ int po[NE + 1];
    if (threadIdx.x == 0) pad_offsets(cnt, po);
    __syncthreads();
    const int lane = threadIdx.x & 63, r = lane & 31, hh = lane >> 5;
    const int wv = blockIdx.x * 4 + (threadIdx.x >> 6), nw = gridDim.x * 4;
    const int ntn = DE / 32, total = (po[NE] / 32) * ntn;
    for (int tile = wv; tile < total; tile += nw) {
        const int tm = tile / ntn, tn = tile % ntn, col = tn * 32 + r, row0 = tm * 32;
        int e = 0; while (e < NE - 1 && po[e + 1] <= row0) ++e;
        int tok = rowtok[row0 + r]; tok = tok < 0 ? 0 : (tok >> 1);
        f32x16 ag, au; for (int i = 0; i < 16; ++i) { ag[i] = 0.f; au[i] = 0.f; }
        wave_gemm32(hb + (size_t)tok * D + 8 * hh, w_eg + (size_t)e * D * DE + (size_t)(8 * hh) * DE + col, DE, D, ag);
        wave_gemm32(hb + (size_t)tok * D + 8 * hh, w_eu + (size_t)e * D * DE + (size_t)(8 * hh) * DE + col, DE, D, au);
#pragma unroll
        for (int i = 0; i < 16; ++i) { const int row = row0 + ACC_ROW(i, hh); const float gsl = ag[i] / (1.0f + __expf(-ag[i])); hid[(size_t)row * DE + col] = f2bf(gsl * au[i]); }
    }
}
__global__ __launch_bounds__(256) void k_p8(const bf16* hid, const int* cnt, const int* rowtok, const float* rowgate, const float* w_ed, bf16* yb) {
    __shared__ int po[NE + 1];
    if (threadIdx.x == 0) pad_offsets(cnt, po);
    __syncthreads();
    const int lane = threadIdx.x & 63, r = lane & 31, hh = lane >> 5;
    const int wv = blockIdx.x * 4 + (threadIdx.x >> 6), nw = gridDim.x * 4;
    const int ntn = D / 32, total = (po[NE] / 32) * ntn;
    for (int tile = wv; tile < total; tile += nw) {
        const int tm = tile / ntn, tn = tile % ntn, col = tn * 32 + r, row0 = tm * 32;
        int e = 0; while (e < NE - 1 && po[e + 1] <= row0) ++e;
        f32x16 acc; for (int i = 0; i < 16; ++i) acc[i] = 0.f;
        wave_gemm32(hid + (size_t)(row0 + r) * DE + 8 * hh, w_ed + (size_t)e * DE * D + (size_t)(8 * hh) * D + col, D, DE, acc);
#pragma unroll
        for (int i = 0; i < 16; ++i) { const int row = row0 + ACC_ROW(i, hh); const int rt = rowtok[row]; if (rt >= 0) yb[(size_t)rt * D + col] = f2bf(acc[i] * rowgate[row]); }
    }
}


#ifndef PG8_ALIGN
#define PG8_ALIGN 1
#endif
namespace pg8 {
#define PG8_LAS __attribute__((address_space(3)))
typedef unsigned short bf16_t;
typedef unsigned u32x4 __attribute__((ext_vector_type(4)));
constexpr int BM = 256, BK = 64, HALF = 128, HTB = HALF * BK * 2  , STAGE_BYTES = 8 * HTB, NXCD = 8, WGM = 4;

__host__ __device__ __forceinline__ int lds_byte(int r, int c) { const int st = (r >> 4) * 2 + (c >> 5), rr = r & 15, cc = c & 31, ob = rr * 64 + cc * 2; return st * 1024 + (ob ^ (((ob >> 9) & 1) << 5)); }
__host__ __device__ __forceinline__ void stage_rc(int b, int& R, int& C) { const int st = b / 1024, sb = b % 1024, swz = sb ^ (((sb >> 9) & 1) << 5); R = (st >> 1) * 16 + swz / 64; C = (st & 1) * 32 + (swz % 64) / 2; }
__host__ __device__ __forceinline__ int perm32(int rho) { const int n = rho >> 4, i = rho & 15; return 8 * (i >> 2) + 4 * n + (i & 3); }

struct Unit { int pm, pn, e, ui; };

struct DenseOrder {
    int nM, nN, nwg, G, c; const char* A; const char* B; size_t tstepA, tstepB;
    __device__ void init(const void* A_, int lda, const void* B_, int ldb, int M, int N, int G_, int c_) { nM = M / BM; nN = N / BM; nwg = nM * nN; G = G_; c = c_; A = (const char*)A_; B = (const char*)B_; tstepA = (size_t)BM * lda * 2; tstepB = (size_t)BM * ldb * 2; }
    __device__ bool next(int i, Unit& u) const {
        const long Lx = (long)i * G + c; if (Lx >= nwg) return false;
        int wgid = (int)Lx; { const int q = nwg / NXCD, r = nwg % NXCD, xcd = wgid % NXCD, off = wgid / NXCD; wgid = (xcd < r ? xcd * (q + 1) : r * (q + 1) + (xcd - r) * q) + off; }
        const int nig = WGM * nN, gid = wgid / nig, fm = gid * WGM, gsz = (nM - fm) < WGM ? (nM - fm) : WGM;
        u.pm = fm + ((wgid % nig) % gsz); u.pn = (wgid % nig) / gsz; u.e = 0; u.ui = i; return true;
    }
    __device__ __forceinline__ const char* a_base(const Unit& u) const { return A + (size_t)u.pm * tstepA; }
    __device__ __forceinline__ const char* b_base(const Unit& u) const { return B + (size_t)u.pn * tstepB; }
    __device__ __forceinline__ int a_row(const Unit&, int) const { return 0; }
};

__device__ __forceinline__ unsigned cvt_pk_bf16(float lo, float hi) { unsigned r; asm volatile("v_cvt_pk_bf16_f32 %0, %1, %2" : "=v"(r) : "v"(lo), "v"(hi)); return r; }

template <class Epi, class Sched, bool GATHER>
__device__ __forceinline__ void gemm_phase(PG8_LAS unsigned char* lds, const Sched& S, const Epi& E, const int K, const int lda, const int ldb, const int tid_in) {
    int tid = tid_in; asm volatile("" : "+v"(tid));
    const int wid = __builtin_amdgcn_readfirstlane(tid >> 6), lane = tid & 63, wr = wid >> 2, wc = wid & 3, fr = lane & 15, fq = lane >> 4;
    const int nt = K / BK;
    int RA[2], CA[2]; unsigned voffB[2];
#pragma unroll
    for (int i = 0; i < 2; ++i) { int R, C; stage_rc(tid * 16 + i * 8192, R, C); const int Rb = Epi::PERM ? ((R & ~31) + perm32(R & 31)) : R; RA[i] = R; CA[i] = C; voffB[i] = (unsigned)(Rb * ldb + C) * 2u; }
    const size_t kstep = (size_t)(BK * 2);
    const size_t hstepB = (size_t)HALF * ldb * 2;
    const unsigned ldsw = (unsigned)wid * 1024u;
    const int aoff = lds_byte(wr * 64 + fr, fq * 8), boff = lds_byte(wc * 32 + fr, fq * 8);
#define PG8_SA(b, h) (((b) * 2 + (h)) * HTB)
#define PG8_SB(b, h) ((4 + (b) * 2 + (h)) * HTB)
#define PG8_STAGE2(bufoff, gbase, v0, v1) do { \
        __builtin_amdgcn_global_load_lds((const unsigned*)((const char*)(gbase) + (v0)), (PG8_LAS unsigned*)(lds + (bufoff) + ldsw), 16, 0, 0); \
        __builtin_amdgcn_global_load_lds((const unsigned*)((const char*)(gbase) + (v1)), (PG8_LAS unsigned*)(lds + (bufoff) + ldsw + 8192), 16, 0, 0); } while (0)
#define PG8_STAGEB(bufoff, gbase) PG8_STAGE2(bufoff, gbase, voffB[0], voffB[1])
#define PG8_LDA(dst, b, h) do { _Pragma("unroll") for (int m = 0; m < 4; ++m) _Pragma("unroll") for (int k = 0; k < 2; ++k) dst[m][k] = *(const PG8_LAS bf16x8*)(lds + PG8_SA(b, h) + aoff + m * 2048 + k * 1024); } while (0)
#define PG8_LDB(dst, b, h) do { _Pragma("unroll") for (int n = 0; n < 2; ++n) _Pragma("unroll") for (int k = 0; k < 2; ++k) dst[n][k] = *(const PG8_LAS bf16x8*)(lds + PG8_SB(b, h) + boff + n * 2048 + k * 1024); } while (0)
#define PG8_MMA(ai, bj, At, Bt) do { __builtin_amdgcn_s_setprio(1); _Pragma("unroll") for (int m = 0; m < 4; ++m) _Pragma("unroll") for (int n = 0; n < 2; ++n) _Pragma("unroll") for (int k = 0; k < 2; ++k) \
        acc[ai][bj][m][n] = __builtin_amdgcn_mfma_f32_16x16x32_bf16(Bt[n][k], At[m][k], acc[ai][bj][m][n], 0, 0, 0); __builtin_amdgcn_s_setprio(0); } while (0)
#define PG8_WAIT_V(n) asm volatile("s_waitcnt vmcnt(" #n ")" ::: "memory")
#define PG8_WAIT_L(n) asm volatile("s_waitcnt lgkmcnt(" #n ")" ::: "memory")
#define PG8_BAR __builtin_amdgcn_s_barrier()
#define PG8_SCHED __builtin_amdgcn_sched_barrier(0)
#define PG8_VOFFA(dst, u) do { _Pragma("unroll") for (int h_ = 0; h_ < 2; ++h_) _Pragma("unroll") for (int i_ = 0; i_ < 2; ++i_) { \
        const int row_ = GATHER ? S.a_row(u, h_ * HALF + RA[i_]) : (h_ * HALF + RA[i_]); dst[h_][i_] = (unsigned)(row_ * lda + CA[i_]) * 2u; } } while (0)
    Unit cur, nxt;
    if (!S.next(0, cur)) return;
    f32x4 acc[2][2][4][2];
#pragma unroll
    for (int a = 0; a < 2; ++a)
#pragma unroll
        for (int b = 0; b < 2; ++b)
#pragma unroll
            for (int m = 0; m < 4; ++m)
#pragma unroll
                for (int n = 0; n < 2; ++n) acc[a][b][m][n] = (f32x4){0.f, 0.f, 0.f, 0.f};
    bf16x8 At[4][2], B0[2][2], B1[2][2];
    unsigned vc[2][2], vn[2][2];
    PG8_VOFFA(vc, cur);
    const char* cA = S.a_base(cur); const char* cB = S.b_base(cur);
    PG8_STAGEB(PG8_SB(0, 0), cB); PG8_STAGEB(PG8_SB(0, 1), cB + hstepB); PG8_STAGE2(PG8_SA(0, 0), cA, vc[0][0], vc[0][1]); PG8_STAGE2(PG8_SA(0, 1), cA, vc[1][0], vc[1][1]);
    if (wr == 1) PG8_BAR;
    PG8_WAIT_V(2); PG8_BAR;
    PG8_STAGEB(PG8_SB(1, 0), cB + kstep); PG8_STAGE2(PG8_SA(1, 0), cA + kstep, vc[0][0], vc[0][1]); PG8_STAGEB(PG8_SB(1, 1), cB + hstepB + kstep);
    PG8_WAIT_V(6); PG8_BAR;
    int ui = 0;
    for (;;) {
        const bool has_next = S.next(ui + 1, nxt);
        const char* nA = has_next ? S.a_base(nxt) : cA; const char* nB = has_next ? S.b_base(nxt) : cB;
        if (GATHER) { if (has_next) { PG8_VOFFA(vn, nxt); } else {
#pragma unroll
            for (int h_ = 0; h_ < 2; ++h_) { vn[h_][0] = vc[h_][0]; vn[h_][1] = vc[h_][1]; } } }
        for (int t = 0; t < nt; t += 2) {
            const bool last = (t == nt - 2);
            const char* a1 = cA + (size_t)(t + 1) * kstep;
            const char* a2 = last ? nA : cA + (size_t)(t + 2) * kstep; const char* b2 = last ? nB : cB + (size_t)(t + 2) * kstep;
            const char* a3 = a2 + kstep; const char* b3 = b2 + kstep;
            unsigned w00, w01, w10, w11;
            if (GATHER) { w00 = last ? vn[0][0] : vc[0][0]; w01 = last ? vn[0][1] : vc[0][1]; w10 = last ? vn[1][0] : vc[1][0]; w11 = last ? vn[1][1] : vc[1][1]; }
            else { w00 = vc[0][0]; w01 = vc[0][1]; w10 = vc[1][0]; w11 = vc[1][1]; }
            PG8_LDB(B0, 0, 0); PG8_LDB(B1, 0, 1); PG8_SCHED; PG8_LDA(At, 0, 0); PG8_STAGE2(PG8_SA(1, 1), a1, vc[1][0], vc[1][1]);
            PG8_WAIT_V(8); PG8_WAIT_L(0); PG8_BAR; PG8_MMA(0, 0, At, B0); PG8_MMA(0, 1, At, B1); PG8_BAR; PG8_SCHED;
            PG8_LDA(At, 0, 1); PG8_STAGEB(PG8_SB(0, 0), b2); PG8_STAGEB(PG8_SB(0, 1), b2 + hstepB); PG8_STAGE2(PG8_SA(0, 0), a2, w00, w01);
            PG8_WAIT_V(8); PG8_WAIT_L(0); PG8_BAR; PG8_MMA(1, 0, At, B0); PG8_MMA(1, 1, At, B1); PG8_BAR; PG8_SCHED;
            PG8_LDB(B0, 1, 0); PG8_LDB(B1, 1, 1); PG8_SCHED; PG8_LDA(At, 1, 0); PG8_STAGE2(PG8_SA(0, 1), a2, w10, w11);
            PG8_WAIT_V(8); PG8_WAIT_L(0); PG8_BAR; PG8_MMA(0, 0, At, B0); PG8_MMA(0, 1, At, B1); PG8_BAR; PG8_SCHED;
            PG8_LDA(At, 1, 1); PG8_STAGEB(PG8_SB(1, 0), b3); PG8_STAGEB(PG8_SB(1, 1), b3 + hstepB); PG8_STAGE2(PG8_SA(1, 0), a3, w00, w01);
            PG8_WAIT_V(8); PG8_WAIT_L(0); PG8_BAR; PG8_MMA(1, 0, At, B0); PG8_MMA(1, 1, At, B1); PG8_BAR; PG8_SCHED;
        }
        if (PG8_ALIGN && wr == 0) PG8_BAR;
        E(acc, cur, wr, wc, fr, fq);
        if (!has_next) break;
#pragma unroll
        for (int a = 0; a < 2; ++a)
#pragma unroll
            for (int b = 0; b < 2; ++b)
#pragma unroll
                for (int m = 0; m < 4; ++m)
#pragma unroll
                    for (int n = 0; n < 2; ++n) acc[a][b][m][n] = (f32x4){0.f, 0.f, 0.f, 0.f};
        cur = nxt; cA = nA; cB = nB; ++ui;
        if (GATHER) {
#pragma unroll
            for (int h_ = 0; h_ < 2; ++h_) { vc[h_][0] = vn[h_][0]; vc[h_][1] = vn[h_][1]; } }
        if (PG8_ALIGN && wr == 1) PG8_BAR;
    }
    PG8_WAIT_V(0);
    if (!PG8_ALIGN && wr == 0) PG8_BAR;
    PG8_BAR;
#undef PG8_SA
#undef PG8_SB
#undef PG8_STAGE2
#undef PG8_STAGEB
#undef PG8_LDA
#undef PG8_LDB
#undef PG8_MMA
#undef PG8_WAIT_V
#undef PG8_WAIT_L
#undef PG8_BAR
#undef PG8_SCHED
#undef PG8_VOFFA
}
template <class Epi, class Sched>
__device__ __forceinline__ void gemm_phase_vk(PG8_LAS unsigned char* lds, const Sched& S, const Epi& E, const int lda, const int tid_in) {
    constexpr bool GATHER = false;
    int tid = tid_in; asm volatile("" : "+v"(tid));
    const int wid = __builtin_amdgcn_readfirstlane(tid >> 6), lane = tid & 63, wr = wid >> 2, wc = wid & 3, fr = lane & 15, fq = lane >> 4;
    int RA[2], CA[2], RB[2];
#pragma unroll
    for (int i = 0; i < 2; ++i) { int R, C; stage_rc(tid * 16 + i * 8192, R, C); const int Rb = Epi::PERM ? ((R & ~31) + perm32(R & 31)) : R; RA[i] = R; CA[i] = C; RB[i] = Rb; }
    const size_t kstep = (size_t)(BK * 2);
    const unsigned ldsw = (unsigned)wid * 1024u;
    const int aoff = lds_byte(wr * 64 + fr, fq * 8), boff = lds_byte(wc * 32 + fr, fq * 8);
#define PG8_SA(b, h) (((b) * 2 + (h)) * HTB)
#define PG8_SB(b, h) ((4 + (b) * 2 + (h)) * HTB)
#define PG8_STAGE2(bufoff, gbase, v0, v1) do { \
        __builtin_amdgcn_global_load_lds((const unsigned*)((const char*)(gbase) + (v0)), (PG8_LAS unsigned*)(lds + (bufoff) + ldsw), 16, 0, 0); \
        __builtin_amdgcn_global_load_lds((const unsigned*)((const char*)(gbase) + (v1)), (PG8_LAS unsigned*)(lds + (bufoff) + ldsw + 8192), 16, 0, 0); } while (0)
#define PG8_VOFFB(dst, hs, u) do { const int ldb_ = S.ldb_of(u); _Pragma("unroll") for (int i_ = 0; i_ < 2; ++i_) { int R_, C_; stage_rc(tid * 16 + i_ * 8192, R_, C_); const int Rb_ = Epi::PERM ? ((R_ & ~31) + perm32(R_ & 31)) : R_; dst[i_] = (unsigned)(Rb_ * ldb_ + C_) * 2u; } hs = (size_t)HALF * ldb_ * 2; } while (0)
#define PG8_LDA(dst, b, h) do { _Pragma("unroll") for (int m = 0; m < 4; ++m) _Pragma("unroll") for (int k = 0; k < 2; ++k) dst[m][k] = *(const PG8_LAS bf16x8*)(lds + PG8_SA(b, h) + aoff + m * 2048 + k * 1024); } while (0)
#define PG8_LDB(dst, b, h) do { _Pragma("unroll") for (int n = 0; n < 2; ++n) _Pragma("unroll") for (int k = 0; k < 2; ++k) dst[n][k] = *(const PG8_LAS bf16x8*)(lds + PG8_SB(b, h) + boff + n * 2048 + k * 1024); } while (0)
#define PG8_MMA(ai, bj, At, Bt) do { __builtin_amdgcn_s_setprio(1); _Pragma("unroll") for (int m = 0; m < 4; ++m) _Pragma("unroll") for (int n = 0; n < 2; ++n) _Pragma("unroll") for (int k = 0; k < 2; ++k) \
        acc[ai][bj][m][n] = __builtin_amdgcn_mfma_f32_16x16x32_bf16(Bt[n][k], At[m][k], acc[ai][bj][m][n], 0, 0, 0); __builtin_amdgcn_s_setprio(0); } while (0)
#define PG8_WAIT_V(n) asm volatile("s_waitcnt vmcnt(" #n ")" ::: "memory")
#define PG8_WAIT_L(n) asm volatile("s_waitcnt lgkmcnt(" #n ")" ::: "memory")
#define PG8_BAR __builtin_amdgcn_s_barrier()
#define PG8_SCHED __builtin_amdgcn_sched_barrier(0)
#define PG8_VOFFA(dst, u) do { _Pragma("unroll") for (int h_ = 0; h_ < 2; ++h_) _Pragma("unroll") for (int i_ = 0; i_ < 2; ++i_) { \
        const int row_ = GATHER ? S.a_row(u, h_ * HALF + RA[i_]) : (h_ * HALF + RA[i_]); dst[h_][i_] = (unsigned)(row_ * lda + CA[i_]) * 2u; } } while (0)
    Unit cur, nxt;
    if (!S.next(0, cur)) return;
    f32x4 acc[2][2][4][2];
#pragma unroll
    for (int a = 0; a < 2; ++a)
#pragma unroll
        for (int b = 0; b < 2; ++b)
#pragma unroll
            for (int m = 0; m < 4; ++m)
#pragma unroll
                for (int n = 0; n < 2; ++n) acc[a][b][m][n] = (f32x4){0.f, 0.f, 0.f, 0.f};
    bf16x8 At[4][2], B0[2][2], B1[2][2];
    unsigned vc[2][2], vn[2][2];
    PG8_VOFFA(vc, cur);
    unsigned vbc[2], vbn[2]; size_t hsc, hsn; PG8_VOFFB(vbc, hsc, cur); int nt = S.K_of(cur) / BK;
    const char* cA = S.a_base(cur); const char* cB = S.b_base(cur);
    PG8_STAGE2(PG8_SB(0, 0), cB, vbc[0], vbc[1]); PG8_STAGE2(PG8_SB(0, 1), cB + hsc, vbc[0], vbc[1]); PG8_STAGE2(PG8_SA(0, 0), cA, vc[0][0], vc[0][1]); PG8_STAGE2(PG8_SA(0, 1), cA, vc[1][0], vc[1][1]);
    if (wr == 1) PG8_BAR;
    PG8_WAIT_V(2); PG8_BAR;
    PG8_STAGE2(PG8_SB(1, 0), cB + kstep, vbc[0], vbc[1]); PG8_STAGE2(PG8_SA(1, 0), cA + kstep, vc[0][0], vc[0][1]); PG8_STAGE2(PG8_SB(1, 1), cB + hsc + kstep, vbc[0], vbc[1]);
    PG8_WAIT_V(6); PG8_BAR;
    int ui = 0;
    for (;;) {
        const bool has_next = S.next(ui + 1, nxt);
        const char* nA = has_next ? S.a_base(nxt) : cA; const char* nB = has_next ? S.b_base(nxt) : cB;
        if (has_next) { PG8_VOFFB(vbn, hsn, nxt); } else { vbn[0] = vbc[0]; vbn[1] = vbc[1]; hsn = hsc; }
        if (GATHER) { if (has_next) { PG8_VOFFA(vn, nxt); } else {
#pragma unroll
            for (int h_ = 0; h_ < 2; ++h_) { vn[h_][0] = vc[h_][0]; vn[h_][1] = vc[h_][1]; } } }
        for (int t = 0; t < nt; t += 2) {
            const bool last = (t == nt - 2);
            const char* a1 = cA + (size_t)(t + 1) * kstep;
            const char* a2 = last ? nA : cA + (size_t)(t + 2) * kstep; const char* b2 = last ? nB : cB + (size_t)(t + 2) * kstep;
            const char* a3 = a2 + kstep; const char* b3 = b2 + kstep;
            unsigned w00, w01, w10, w11;
            if (GATHER) { w00 = last ? vn[0][0] : vc[0][0]; w01 = last ? vn[0][1] : vc[0][1]; w10 = last ? vn[1][0] : vc[1][0]; w11 = last ? vn[1][1] : vc[1][1]; }
            else { w00 = vc[0][0]; w01 = vc[0][1]; w10 = vc[1][0]; w11 = vc[1][1]; }
            const unsigned wb0 = last ? vbn[0] : vbc[0], wb1 = last ? vbn[1] : vbc[1]; const size_t hsb = last ? hsn : hsc;
            PG8_LDB(B0, 0, 0); PG8_LDB(B1, 0, 1); PG8_SCHED; PG8_LDA(At, 0, 0); PG8_STAGE2(PG8_SA(1, 1), a1, vc[1][0], vc[1][1]);
            PG8_WAIT_V(8); PG8_WAIT_L(0); PG8_BAR; PG8_MMA(0, 0, At, B0); PG8_MMA(0, 1, At, B1); PG8_BAR; PG8_SCHED;
            PG8_LDA(At, 0, 1); PG8_STAGE2(PG8_SB(0, 0), b2, wb0, wb1); PG8_STAGE2(PG8_SB(0, 1), b2 + hsb, wb0, wb1); PG8_STAGE2(PG8_SA(0, 0), a2, w00, w01);
            PG8_WAIT_V(8); PG8_WAIT_L(0); PG8_BAR; PG8_MMA(1, 0, At, B0); PG8_MMA(1, 1, At, B1); PG8_BAR; PG8_SCHED;
            PG8_LDB(B0, 1, 0); PG8_LDB(B1, 1, 1); PG8_SCHED; PG8_LDA(At, 1, 0); PG8_STAGE2(PG8_SA(0, 1), a2, w10, w11);
            PG8_WAIT_V(8); PG8_WAIT_L(0); PG8_BAR; PG8_MMA(0, 0, At, B0); PG8_MMA(0, 1, At, B1); PG8_BAR; PG8_SCHED;
            PG8_LDA(At, 1, 1); PG8_STAGE2(PG8_SB(1, 0), b3, wb0, wb1); PG8_STAGE2(PG8_SB(1, 1), b3 + hsb, wb0, wb1); PG8_STAGE2(PG8_SA(1, 0), a3, w00, w01);
            PG8_WAIT_V(8); PG8_WAIT_L(0); PG8_BAR; PG8_MMA(1, 0, At, B0); PG8_MMA(1, 1, At, B1); PG8_BAR; PG8_SCHED;
        }
        if (PG8_ALIGN && wr == 0) PG8_BAR;
        E(acc, cur, wr, wc, fr, fq);
        if (!has_next) break;
#pragma unroll
        for (int a = 0; a < 2; ++a)
#pragma unroll
            for (int b = 0; b < 2; ++b)
#pragma unroll
                for (int m = 0; m < 4; ++m)
#pragma unroll
                    for (int n = 0; n < 2; ++n) acc[a][b][m][n] = (f32x4){0.f, 0.f, 0.f, 0.f};
        cur = nxt; cA = nA; cB = nB; ++ui; vbc[0] = vbn[0]; vbc[1] = vbn[1]; hsc = hsn; nt = S.K_of(cur) / BK;
        if (GATHER) {
#pragma unroll
            for (int h_ = 0; h_ < 2; ++h_) { vc[h_][0] = vn[h_][0]; vc[h_][1] = vn[h_][1]; } }
        if (PG8_ALIGN && wr == 1) PG8_BAR;
    }
    PG8_WAIT_V(0);
    if (!PG8_ALIGN && wr == 0) PG8_BAR;
    PG8_BAR;
#undef PG8_SA
#undef PG8_SB
#undef PG8_STAGE2
#undef PG8_VOFFB
#undef PG8_LDA
#undef PG8_LDB
#undef PG8_MMA
#undef PG8_WAIT_V
#undef PG8_WAIT_L
#undef PG8_BAR
#undef PG8_SCHED
#undef PG8_VOFFA
}
}

constexpr int NWAVES = 8, NTHREADS = 512;
constexpr int RING_OFF = 0, RING_BYTES = 131072, ROWS_OFF = 131072, ROWS_BYTES = 12288, ROUTER_BYTES = 147456  , MISC_OFF = ROUTER_BYTES, LCNT_OFF = MISC_OFF + 128  , LDS_BYTES = 148480;
static_assert(MISC_OFF + 128 <= LDS_BYTES, "LDS map");
constexpr int CW_CNT = 0;
constexpr int CW_BAR = 4096;
constexpr size_t CTL_ZERO_BYTES = 64 * 1024;
constexpr float LOG2E = 1.4426950408889634f, LN2 = 0.6931471805599453f;
constexpr float QSCALE = 0.125f * LOG2E;

#define GAS __attribute__((address_space(1)))
#define LAS __attribute__((address_space(3)))
typedef unsigned v4u __attribute__((ext_vector_type(4)));
typedef unsigned v2u __attribute__((ext_vector_type(2)));
#define LDS_WAIT() asm volatile("s_waitcnt lgkmcnt(0)" ::: "memory")
__device__ __forceinline__ unsigned pk2(float lo, float hi) { return (unsigned)f2bf(lo) | ((unsigned)f2bf(hi) << 16); }

#define XB_TMO      128
#define XB_XCNT(j)  (256  + 64 * (j))
#define XB_XSUB(j)  (1280 + 64 * (j))
#define XB_XGEN(j)  (2304 + 64 * (j))
#define XB_TOP      3328
#define XB_TOPGEN   3392
#define XCD_BAR_WORDS 3456
#define XB_SPIN_CAP (1u << 18)

__device__ __forceinline__ unsigned xb_ld(unsigned* p)              { return __hip_atomic_load(p, __ATOMIC_RELAXED, __HIP_MEMORY_SCOPE_AGENT); }
__device__ __forceinline__ unsigned xb_add(unsigned* p, unsigned v) { return __hip_atomic_fetch_add(p, v, __ATOMIC_RELAXED, __HIP_MEMORY_SCOPE_AGENT); }
__device__ __forceinline__ unsigned xb_xcc_id() { return (unsigned)__builtin_amdgcn_s_getreg((3 << 11) | 20) & 0xFu; }
#define XB_SPIN(cond, bar) do { unsigned _sp = 0; while (cond) { __builtin_amdgcn_s_sleep(1); \
    if ((++_sp & 255u) == 0u) { if (xb_ld(&(bar)[XB_TMO])) break; if (_sp > XB_SPIN_CAP) { atomicAdd(&(bar)[XB_TMO], 1u); break; } } } } while (0)

struct XcdBarrier {
    int wave0;
    unsigned* bar; unsigned x;
    volatile LAS unsigned* st;
};

__device__ __forceinline__ unsigned xb_lane() { unsigned l_; asm volatile("v_mbcnt_lo_u32_b32 %0, -1, 0\n\tv_mbcnt_hi_u32_b32 %0, -1, %0" : "=v"(l_)); return l_; }
__device__ __forceinline__ XcdBarrier xcd_barrier_post(unsigned* bar, volatile LAS unsigned* st, int wave0) {
    XcdBarrier b; b.wave0 = wave0; b.bar = bar; b.x = xb_xcc_id(); b.st = st;
    if (b.wave0 && xb_lane() == 0u) (void)xb_add(&bar[XB_XCNT(b.x)], 1u);
    return b;
}
__device__ __forceinline__ void xcd_barrier_complete(unsigned* bar, unsigned x, unsigned& nloc, unsigned& nx) {
    const unsigned G = gridDim.x * gridDim.y * gridDim.z;
    unsigned sum, cnt, mine, sp = 0u;
    for (;;) {
        sum = 0u; cnt = 0u; mine = 0u;
#pragma unroll
        for (unsigned j = 0; j < 16; ++j) { const unsigned c = xb_ld(&bar[XB_XCNT(j)]); sum += c; cnt += (c > 0u) ? 1u : 0u; mine = (j == x) ? c : mine; }
        if (sum == G) break;
        __builtin_amdgcn_s_sleep(1);
        if ((++sp & 255u) == 0u) { if (xb_ld(&bar[XB_TMO])) break; if (sp > XB_SPIN_CAP) { atomicAdd(&bar[XB_TMO], 1u); break; } }
    }
    nloc = mine > 0u ? mine : 1u; nx = cnt > 0u ? cnt : 1u;
}

__device__ __forceinline__ void xcd_barrier(const XcdBarrier& b) {
    asm volatile("s_waitcnt vmcnt(0)" ::: "memory");
    __syncthreads();
    if (b.wave0 && xb_lane() == 0u) {
        unsigned* bar = b.bar;
        __builtin_amdgcn_s_waitcnt(0);
        unsigned nloc = b.st[0], nx = b.st[1];
        if (nloc == 0u) { xcd_barrier_complete(bar, b.x, nloc, nx); b.st[0] = nloc; b.st[1] = nx; }
        const unsigned old = xb_add(&bar[XB_XSUB(b.x)], 1u);
        const unsigned gen = old / nloc;
        if (old + 1u == (gen + 1u) * nloc) {
            __builtin_amdgcn_fence(__ATOMIC_RELEASE, "agent");
            asm volatile("s_waitcnt vmcnt(0)" ::: "memory");
            const unsigned og = xb_add(&bar[XB_TOP], 1u);
            const unsigned tg = og / nx;
            if (og + 1u == (tg + 1u) * nx) xb_add(&bar[XB_TOPGEN], 1u);
            else XB_SPIN(xb_ld(&bar[XB_TOPGEN]) == tg, bar);
            __builtin_amdgcn_fence(__ATOMIC_ACQUIRE, "agent");
            xb_add(&bar[XB_XGEN(b.x)], 1u);
            asm volatile("s_waitcnt vmcnt(0)" ::: "memory");
        } else {
            XB_SPIN(xb_ld(&bar[XB_XGEN(b.x)]) == gen, bar);
            __builtin_amdgcn_fence(__ATOMIC_ACQUIRE, "agent");
            asm volatile("s_waitcnt vmcnt(0)" ::: "memory");
        }
    }
    __syncthreads();
}


struct Args { const float* in[23]; float* out; unsigned char* ws; int s_lo, s_hi, probe, pad; };

struct Frame {
    LAS unsigned char* lds; int tid, lane, wave, vcu, G;
    const float* const* in; float* h; unsigned char* ws; int probe;
};

__device__ __forceinline__ int hw_lane() { int l_; asm volatile("v_mbcnt_lo_u32_b32 %0, -1, 0\n\tv_mbcnt_hi_u32_b32 %0, -1, %0" : "=v"(l_)); return l_; }
__device__ __forceinline__ float shfl_xor_l(float v, int mask, int lane) { return __builtin_bit_cast(float, __builtin_amdgcn_ds_bpermute((lane ^ mask) << 2, __builtin_bit_cast(int, v))); }
__device__ __forceinline__ float dpp_add(float v, const int ctrl_sel) {
    const int x = __builtin_bit_cast(int, v); int y;
    if (ctrl_sel == 0) y = __builtin_amdgcn_mov_dpp(x, 0xB1, 0xF, 0xF, true);
    else if (ctrl_sel == 1) y = __builtin_amdgcn_mov_dpp(x, 0x4E, 0xF, 0xF, true);
    else if (ctrl_sel == 2) y = __builtin_amdgcn_mov_dpp(x, 0x141, 0xF, 0xF, true);
    else y = __builtin_amdgcn_mov_dpp(x, 0x140, 0xF, 0xF, true);
    return v + __builtin_bit_cast(float, y);
}
__device__ __forceinline__ float wave_sum_l(float v, int lane) {
    (void)lane;
    v = dpp_add(v, 0); v = dpp_add(v, 1); v = dpp_add(v, 2); v = dpp_add(v, 3);
    const int x = __builtin_bit_cast(int, v);
    const float r0 = __builtin_bit_cast(float, __builtin_amdgcn_readlane(x, 0)), r1 = __builtin_bit_cast(float, __builtin_amdgcn_readlane(x, 16)),
                r2 = __builtin_bit_cast(float, __builtin_amdgcn_readlane(x, 32)), r3 = __builtin_bit_cast(float, __builtin_amdgcn_readlane(x, 48));
    return (r0 + r1) + (r2 + r3);
}
#define LAUNDER(F) do { (F).lane = hw_lane(); (F).tid = (F).wave * 64 + (F).lane; asm volatile("" : "+s"((F).G), "+s"((F).vcu), "+s"((F).ws), "+s"((F).h)); } while (0)
__device__ __forceinline__ void p0_item(const float* W, int ldw, int k0, int n0, bf16* WT, int Kd, int drow0, float scale, LAS float* scr, int lane) {
#pragma unroll 8
    for (int i = 0; i < 32; ++i) { const int kk = 2 * i + (lane >> 5); scr[kk * 33 + (lane & 31)] = W[(size_t)(k0 + kk) * ldw + n0 + (lane & 31)] * scale; }
    LDS_WAIT(); asm volatile("" ::: "memory");
    const int c = lane & 7;
#pragma unroll
    for (int j = 0; j < 4; ++j) { const int n = (lane >> 3) + 8 * j; const LAS float* s = scr + (8 * c) * 33 + n;
        v4u o; o.x = pk2(s[0 * 33], s[1 * 33]); o.y = pk2(s[2 * 33], s[3 * 33]); o.z = pk2(s[4 * 33], s[5 * 33]); o.w = pk2(s[6 * 33], s[7 * 33]);
        *(GAS v4u*)(WT + (size_t)(drow0 + n) * Kd + k0 + 8 * c) = o; }
    LDS_WAIT(); asm volatile("" ::: "memory");
}
__device__ __forceinline__ bool is_q_col(int n) { return n < 512 || (n >= 768 && n < 3072 && ((n - 768) % 768) < 256) || (n >= 3072 && n < 3584); }

__device__ __forceinline__ void ph_prologue(Frame& F) { LAUNDER(F);
    LAS float* scr = (LAS float*)(F.lds + RING_OFF + F.wave * 16384);
    const int gw = F.vcu * NWAVES + F.wave, NGW = F.G * NWAVES, lane = F.lane;
    const float* w_in = F.in[4]; const float* w_a = F.in[8]; const float* w_b = F.in[9]; const float* w_c = F.in[10]; const float* w_o = F.in[11];
    const float* w_eg = F.in[18]; const float* w_eu = F.in[19]; const float* w_ed = F.in[20];
    bf16* WIN = (bf16*)(F.ws + WS_WIN); bf16* WBRA = (bf16*)(F.ws + WS_WBRA); bf16* WBRB = (bf16*)(F.ws + WS_WBRB); bf16* WBRC = (bf16*)(F.ws + WS_WBRC); bf16* WOUT = (bf16*)(F.ws + WS_WOUT);
    bf16* WGU = (bf16*)(F.ws + WS_WGU); bf16* WD = (bf16*)(F.ws + WS_WD);
    constexpr int I_IN = 16 * (NCOL / 32), I_A = 8 * 32, I_B = 4 * 32, I_C = 8 * 32, I_O = 16 * 32, I_G = 16 * 16, I_D = 8 * 32;
    constexpr int I_LAYER = I_IN + I_A + I_B + I_C + I_O + NE * (2 * I_G + I_D);
    for (int it = gw; it < DEPTH * I_LAYER; it += NGW) {
        const int l = it / I_LAYER; int r = it % I_LAYER;
        if (r < I_IN) { const int nb = r % (NCOL / 32), kb = r / (NCOL / 32); p0_item(w_in + (size_t)l * D * NCOL, NCOL, 64 * kb, 32 * nb, WIN + (size_t)l * NCOL * D, D, 32 * nb, is_q_col(32 * nb) ? QSCALE : 1.0f, scr, lane); continue; } r -= I_IN;
        if (r < I_A) { const int nb = r % 32, kb = r / 32; p0_item(w_a + (size_t)l * 512 * D, D, 64 * kb, 32 * nb, WBRA + (size_t)l * D * 512, 512, 32 * nb, 1.0f, scr, lane); continue; } r -= I_A;
        if (r < I_B) { const int nb = r % 32, kb = r / 32; p0_item(w_b + (size_t)l * 256 * D, D, 64 * kb, 32 * nb, WBRB + (size_t)l * D * 256, 256, 32 * nb, 1.0f, scr, lane); continue; } r -= I_B;
        if (r < I_C) { const int nb = r % 32, kb = r / 32; p0_item(w_c + (size_t)l * 512 * D, D, 64 * kb, 32 * nb, WBRC + (size_t)l * D * 512, 512, 32 * nb, 1.0f, scr, lane); continue; } r -= I_C;
        if (r < I_O) { const int nb = r % 32, kb = r / 32; p0_item(w_o + (size_t)l * D * D, D, 64 * kb, 32 * nb, WOUT + (size_t)l * D * D, D, 32 * nb, 1.0f, scr, lane); continue; } r -= I_O;
        const int e = r / (2 * I_G + I_D); r %= (2 * I_G + I_D); const size_t le = (size_t)l * NE + e;
        if (r < 2 * I_G) { const int up = r / I_G; r %= I_G; const int nb = r % 16, kb = r / 16;
            p0_item((up ? w_eu : w_eg) + le * D * DE, DE, 64 * kb, 32 * nb, WGU + le * 1024 * 1024, D, (nb >> 2) * 256 + up * 128 + (nb & 3) * 32, 1.0f, scr, lane); continue; }
        r -= 2 * I_G; { const int nb = r % 32, kb = r / 32; p0_item(w_ed + le * DE * D, D, 64 * kb, 32 * nb, WD + le * D * DE, DE, 32 * nb, 1.0f, scr, lane); }
    }
}

struct LnIn { f32x4 v[4]; v2u a[4], b[4], hw[4]; };
template <int MODE> __device__ __forceinline__ void ln_load(LnIn& in, const float* src, const bf16* hsb, const bf16* yb, size_t row, int lane) {
#pragma unroll
    for (int j = 0; j < 4; ++j) {
        const int c = lane * 4 + 256 * j;
        if (MODE != 2) in.v[j] = *(const GAS f32x4*)(src + row * D + c);
        if (MODE == 2) { in.hw[j] = *(const GAS v2u*)(hsb + row * D + c); in.a[j] = *(const GAS v2u*)(yb + (row * 2) * D + c); in.b[j] = *(const GAS v2u*)(yb + (row * 2 + 1) * D + c); }
    }
}
template <int MODE> __device__ __forceinline__ void ln_finish(const LnIn& in, float* hout, bf16* hb, const float* g, const float* bta, size_t row, int lane, f32x4 (&o)[4]) {
    f32x4 v[4];
#pragma unroll
    for (int j = 0; j < 4; ++j) {
        if (MODE != 2) v[j] = in.v[j];
        if (MODE == 2) {
            const v2u a = in.a[j], b = in.b[j], hw = in.hw[j];
            v[j].x = ALPHA * __uint_as_float(hw.x << 16) + __uint_as_float(a.x << 16) + __uint_as_float(b.x << 16);
            v[j].y = ALPHA * __uint_as_float(hw.x & 0xffff0000u) + __uint_as_float(a.x & 0xffff0000u) + __uint_as_float(b.x & 0xffff0000u);
            v[j].z = ALPHA * __uint_as_float(hw.y << 16) + __uint_as_float(a.y << 16) + __uint_as_float(b.y << 16);
            v[j].w = ALPHA * __uint_as_float(hw.y & 0xffff0000u) + __uint_as_float(a.y & 0xffff0000u) + __uint_as_float(b.y & 0xffff0000u);
        }
    }
    float s = 0.f;
#pragma unroll
    for (int j = 0; j < 4; ++j) s += (v[j].x + v[j].y) + (v[j].z + v[j].w);
    const float mean = wave_sum_l(s, lane) * (1.f / D);
    float q = 0.f;
#pragma unroll
    for (int j = 0; j < 4; ++j) { v[j] = v[j] - mean; q += (v[j].x * v[j].x + v[j].y * v[j].y) + (v[j].z * v[j].z + v[j].w * v[j].w); }
    const float rstd = 1.0f / sqrtf(wave_sum_l(q, lane) * (1.f / D) + LN_EPS);
#pragma unroll
    for (int j = 0; j < 4; ++j) {
        const int c = lane * 4 + 256 * j;
        const f32x4 gg = *(const GAS f32x4*)(g + c), bb = *(const GAS f32x4*)(bta + c);
        o[j] = v[j] * rstd * gg + bb;
        if (hout) *(GAS f32x4*)(hout + row * D + c) = o[j];
        if (hb) { v2u w; w.x = pk2(o[j].x, o[j].y); w.y = pk2(o[j].z, o[j].w); *(GAS v2u*)(hb + row * D + c) = w; }
    }
}

#ifndef PROBE_EPI
#define PROBE_EPI 0
#endif
struct EpiP1 {
    static constexpr bool PERM = true;
    bf16* qkv; bf16* gates; const float* b_gate; int probe;
    __device__ __forceinline__ void operator()(const f32x4 (&acc)[2][2][4][2], const pg8::Unit& u, int wr, int wc, int fr, int fq) const {
        if (probe == 1 && PROBE_EPI == 0) return;
        const int row0 = (probe == 1 ? (int)(blockIdx.x & 127) : u.pm) * 256 + wr * 64 + fr; const bool isg = u.pn >= 18;
        bf16* base = isg ? gates : qkv; const int ldc = isg ? GATEW : QKVW; const int col0 = (isg ? (u.pn - 18) : u.pn) * 256 + wc * 32 + 8 * fq;
        f32x4 bv[2][2];
#pragma unroll
        for (int bj = 0; bj < 2; ++bj)
#pragma unroll
            for (int n = 0; n < 2; ++n) bv[bj][n] = isg ? *(const GAS f32x4*)(b_gate + col0 + bj * 128 + 4 * n) : (f32x4){0.f, 0.f, 0.f, 0.f};
#pragma unroll
        for (int ai = 0; ai < 2; ++ai)
#pragma unroll
            for (int m = 0; m < 4; ++m) { bf16* rowp = base + (size_t)(row0 + ai * 128 + m * 16) * ldc + col0;
#pragma unroll
                for (int bj = 0; bj < 2; ++bj) { f32x4 v0 = acc[ai][bj][m][0] + bv[bj][0], v1 = acc[ai][bj][m][1] + bv[bj][1];
                    if (isg) {
#pragma unroll
                        for (int j = 0; j < 4; ++j) { v0[j] = __builtin_amdgcn_rcpf(1.0f + __builtin_amdgcn_exp2f(-LOG2E * v0[j])); v1[j] = __builtin_amdgcn_rcpf(1.0f + __builtin_amdgcn_exp2f(-LOG2E * v1[j])); } }
                    v4u w; w.x = pg8::cvt_pk_bf16(v0[0], v0[1]); w.y = pg8::cvt_pk_bf16(v0[2], v0[3]); w.z = pg8::cvt_pk_bf16(v1[0], v1[1]); w.w = pg8::cvt_pk_bf16(v1[2], v1[3]);
                    *(GAS v4u*)(rowp + bj * 128) = w; } }
    }
};
template <bool FIRST> struct EpiP3 {
    static constexpr bool PERM = true;
    bf16* merged; const bf16* gates; int br;
    __device__ __forceinline__ void operator()(const f32x4 (&acc)[2][2][4][2], const pg8::Unit& u, int wr, int wc, int fr, int fq) const {
        const int row0 = u.pm * 256 + wr * 64 + fr, col0 = u.pn * 256 + wc * 32 + 8 * fq;
#pragma unroll
        for (int ai = 0; ai < 2; ++ai) {
            v4u gw[4][2], ow[4][2];
#pragma unroll
            for (int m = 0; m < 4; ++m)
#pragma unroll
                for (int bj = 0; bj < 2; ++bj) { const size_t row = (size_t)(row0 + ai * 128 + m * 16);
                    gw[m][bj] = *(const GAS v4u*)(gates + row * GATEW + br * 1024 + col0 + bj * 128);
                    ow[m][bj] = FIRST ? (v4u){0u, 0u, 0u, 0u} : *(const GAS v4u*)(merged + row * D + col0 + bj * 128); }
#pragma unroll
            for (int m = 0; m < 4; ++m)
#pragma unroll
                for (int bj = 0; bj < 2; ++bj) { const size_t row = (size_t)(row0 + ai * 128 + m * 16);
                    const f32x4 a0 = acc[ai][bj][m][0], a1 = acc[ai][bj][m][1];
                    float r[8];
#pragma unroll
                    for (int j = 0; j < 4; ++j) { const unsigned g2 = gw[m][bj][j], o2 = ow[m][bj][j]; const float av0 = j < 2 ? a0[2 * j] : a1[2 * j - 4], av1 = j < 2 ? a0[2 * j + 1] : a1[2 * j - 3];
                        r[2 * j] = __uint_as_float(g2 << 16) * av0 + (FIRST ? 0.f : __uint_as_float(o2 << 16)); r[2 * j + 1] = __uint_as_float(g2 & 0xffff0000u) * av1 + (FIRST ? 0.f : __uint_as_float(o2 & 0xffff0000u)); }
                    v4u w; w.x = pg8::cvt_pk_bf16(r[0], r[1]); w.y = pg8::cvt_pk_bf16(r[2], r[3]); w.z = pg8::cvt_pk_bf16(r[4], r[5]); w.w = pg8::cvt_pk_bf16(r[6], r[7]);
                    *(GAS v4u*)(merged + row * D + col0 + bj * 128) = w; }
            asm volatile("" ::: "memory"); }
    }
};
struct EpiP3V {
    static constexpr bool PERM = true;
    bf16* merged; const bf16* gates;
    __device__ __forceinline__ void operator()(const f32x4 (&acc)[2][2][4][2], const pg8::Unit& u, int wr, int wc, int fr, int fq) const {
        const int row0 = u.pm * 256 + wr * 64 + fr, col0 = u.pn * 256 + wc * 32 + 8 * fq; const int br = u.e; const bool first = (br == 0);
#pragma unroll
        for (int ai = 0; ai < 2; ++ai)
#pragma unroll
        for (int mp = 0; mp < 2; ++mp) {
            v4u gw[2][2], ow[2][2];
#pragma unroll
            for (int mm = 0; mm < 2; ++mm)
#pragma unroll
                for (int bj = 0; bj < 2; ++bj) { const size_t row = (size_t)(row0 + ai * 128 + (2 * mp + mm) * 16);
                    gw[mm][bj] = *(const GAS v4u*)(gates + row * GATEW + br * 1024 + col0 + bj * 128);
                    ow[mm][bj] = (v4u){0u, 0u, 0u, 0u}; if (!first) ow[mm][bj] = *(const GAS v4u*)(merged + row * D + col0 + bj * 128); }
#pragma unroll
            for (int mm = 0; mm < 2; ++mm)
#pragma unroll
                for (int bj = 0; bj < 2; ++bj) { const int m = 2 * mp + mm; const size_t row = (size_t)(row0 + ai * 128 + m * 16);
                    const f32x4 a0 = acc[ai][bj][m][0], a1 = acc[ai][bj][m][1];
                    float r[8];
#pragma unroll
                    for (int j = 0; j < 4; ++j) { const unsigned g2 = gw[mm][bj][j], o2 = ow[mm][bj][j]; const float av0 = j < 2 ? a0[2 * j] : a1[2 * j - 4], av1 = j < 2 ? a0[2 * j + 1] : a1[2 * j - 3];
                        r[2 * j] = __uint_as_float(g2 << 16) * av0 + __uint_as_float(o2 << 16); r[2 * j + 1] = __uint_as_float(g2 & 0xffff0000u) * av1 + __uint_as_float(o2 & 0xffff0000u); }
                    v4u w; w.x = pg8::cvt_pk_bf16(r[0], r[1]); w.y = pg8::cvt_pk_bf16(r[2], r[3]); w.z = pg8::cvt_pk_bf16(r[4], r[5]); w.w = pg8::cvt_pk_bf16(r[6], r[7]);
                    *(GAS v4u*)(merged + row * D + col0 + bj * 128) = w; }
            asm volatile("" ::: "memory"); }
    }
};
struct P3Order {
    pg8::DenseOrder Dn; const char* Abase; const char* wsb; size_t lofs;
    __device__ __forceinline__ bool next(int i, pg8::Unit& u) const { if (!Dn.next(i / 3, u)) return false; u.e = i % 3; u.ui = i; return true; }
    __device__ __forceinline__ const char* a_base(const pg8::Unit& u) const { const size_t ko = (size_t)((u.e + 1) >> 1) * 1024 + (size_t)(u.e >> 1) * 512; return Abase + ko + (size_t)u.pm * Dn.tstepA; }
    __device__ __forceinline__ int K_of(const pg8::Unit& u) const { return 512 - 256 * (u.e & 1); }
    __device__ __forceinline__ int ldb_of(const pg8::Unit& u) const { return 512 - 256 * (u.e & 1); }
    __device__ __forceinline__ const char* b_base(const pg8::Unit& u) const {
        const size_t kb = (size_t)(512 - 256 * (u.e & 1)) * 2;
        const size_t base = WS_WBRA + (size_t)((u.e + 1) >> 1) * (WS_WBRB - WS_WBRA) + (size_t)(u.e >> 1) * (WS_WBRC - WS_WBRB);
        return wsb + base + lofs * (size_t)D * kb + (size_t)u.pn * 256 * kb; }
    __device__ __forceinline__ int a_row(const pg8::Unit&, int) const { return 0; }
};
struct EpiP4 {
    static constexpr bool PERM = false;
    const bf16* hbc; float* ho;
    __device__ __forceinline__ void operator()(const f32x4 (&acc)[2][2][4][2], const pg8::Unit& u, int wr, int wc, int fr, int fq) const {
        const int row0 = u.pm * 256 + wr * 64 + fr, col0 = u.pn * 256 + wc * 32 + 4 * fq;
#pragma unroll
        for (int ai = 0; ai < 2; ++ai) { v2u hv[4][2][2];
#pragma unroll
            for (int m = 0; m < 4; ++m)
#pragma unroll
                for (int bj = 0; bj < 2; ++bj)
#pragma unroll
                    for (int n = 0; n < 2; ++n) hv[m][bj][n] = *(const GAS v2u*)(hbc + (size_t)(row0 + ai * 128 + m * 16) * D + col0 + bj * 128 + n * 16);
#pragma unroll
            for (int m = 0; m < 4; ++m)
#pragma unroll
                for (int bj = 0; bj < 2; ++bj)
#pragma unroll
                    for (int n = 0; n < 2; ++n) { const v2u w = hv[m][bj][n]; const f32x4 hf = (f32x4){__uint_as_float(w.x << 16), __uint_as_float(w.x & 0xffff0000u), __uint_as_float(w.y << 16), __uint_as_float(w.y & 0xffff0000u)};
                        *(GAS f32x4*)(ho + (size_t)(row0 + ai * 128 + m * 16) * D + col0 + bj * 128 + n * 16) = hf * ALPHA + acc[ai][bj][m][n]; }
            asm volatile("" ::: "memory"); }
    }
};
struct EpiP7 {
    static constexpr bool PERM = true;
    bf16* hid;
    __device__ __forceinline__ void operator()(const f32x4 (&acc)[2][2][4][2], const pg8::Unit& u, int wr, int wc, int fr, int fq) const {
        const int row0 = u.pm * 256 + wr * 64 + fr, col0 = u.pn * 128 + wc * 32 + 8 * fq;
#pragma unroll
        for (int ai = 0; ai < 2; ++ai)
#pragma unroll
            for (int m = 0; m < 4; ++m) { float r[8];
#pragma unroll
                for (int n = 0; n < 2; ++n)
#pragma unroll
                    for (int j = 0; j < 4; ++j) { const float gv = acc[ai][0][m][n][j], uv = acc[ai][1][m][n][j]; r[4 * n + j] = gv * __builtin_amdgcn_rcpf(1.0f + __builtin_amdgcn_exp2f(-LOG2E * gv)) * uv; }
                v4u w; w.x = pg8::cvt_pk_bf16(r[0], r[1]); w.y = pg8::cvt_pk_bf16(r[2], r[3]); w.z = pg8::cvt_pk_bf16(r[4], r[5]); w.w = pg8::cvt_pk_bf16(r[6], r[7]);
                *(GAS v4u*)(hid + (size_t)(row0 + ai * 128 + m * 16) * DE + col0) = w; }
    }
};
struct EpiP8 {
    static constexpr bool PERM = true;
    bf16* yb; const int* rowtok; const float* rowgate;
    __device__ __forceinline__ void operator()(const f32x4 (&acc)[2][2][4][2], const pg8::Unit& u, int wr, int wc, int fr, int fq) const {
        const int row0 = u.pm * 256 + wr * 64 + fr, col0 = u.pn * 256 + wc * 32 + 8 * fq;
        int rt[2][4]; float gt[2][4];
#pragma unroll
        for (int ai = 0; ai < 2; ++ai)
#pragma unroll
            for (int m = 0; m < 4; ++m) { const int row = row0 + ai * 128 + m * 16; rt[ai][m] = *(const GAS int*)(rowtok + row); gt[ai][m] = *(const GAS float*)(rowgate + row); }
#pragma unroll
        for (int ai = 0; ai < 2; ++ai)
#pragma unroll
            for (int m = 0; m < 4; ++m) {
                if (rt[ai][m] >= 0) {
#pragma unroll
                    for (int bj = 0; bj < 2; ++bj) { const f32x4 v0 = acc[ai][bj][m][0] * gt[ai][m], v1 = acc[ai][bj][m][1] * gt[ai][m];
                        v4u w; w.x = pg8::cvt_pk_bf16(v0[0], v0[1]); w.y = pg8::cvt_pk_bf16(v0[2], v0[3]); w.z = pg8::cvt_pk_bf16(v1[0], v1[1]); w.w = pg8::cvt_pk_bf16(v1[2], v1[3]);
                        *(GAS v4u*)(yb + (size_t)rt[ai][m] * D + col0 + bj * 128) = w; } } }
    }
};

typedef float f32x2 __attribute__((ext_vector_type(2)));
template <int N> __device__ __forceinline__ void wave_sum_n(float (&v)[N]) {
#pragma unroll
    for (int s = 0; s < 4; ++s)
#pragma unroll
        for (int n = 0; n < N; ++n) v[n] = dpp_add(v[n], s);
#pragma unroll
    for (int n = 0; n < N; ++n) { const int x = __builtin_bit_cast(int, v[n]);
        const float r0 = __builtin_bit_cast(float, __builtin_amdgcn_readlane(x, 0)), r1 = __builtin_bit_cast(float, __builtin_amdgcn_readlane(x, 16)),
                    r2 = __builtin_bit_cast(float, __builtin_amdgcn_readlane(x, 32)), r3 = __builtin_bit_cast(float, __builtin_amdgcn_readlane(x, 48));
        v[n] = (r0 + r1) + (r2 + r3); }
}
__device__ __forceinline__ void router_row(const float (&x)[16], int t, int lane, const f32x4 (&wg)[16], const float* b_rg, const LAS float* w_re, const float* b_re, LAS int* lcnt, int wslot, Rec* rec) {
    f32x2 g01 = (f32x2){0.f, 0.f}, g23 = (f32x2){0.f, 0.f};
#pragma unroll
    for (int k = 0; k < 16; ++k) { const f32x4 w = wg[k]; const f32x2 xv = (f32x2){x[k], x[k]}; g01 = xv * (f32x2){w.x, w.y} + g01; g23 = xv * (f32x2){w.z, w.w} + g23; }
    float gl[4] = {g01.x, g01.y, g23.x, g23.y};
    wave_sum_n<4>(gl);
#pragma unroll
    for (int g = 0; g < 4; ++g) gl[g] += b_rg[g];
    int gi = 0; float gm = gl[0];
#pragma unroll
    for (int g = 1; g < 4; ++g) if (gl[g] > gm) { gm = gl[g]; gi = g; }
    float gs = 0.f;
#pragma unroll
    for (int g = 0; g < 4; ++g) gs += __expf(gl[g] - gm);
    const float gw = 1.0f / gs;
    f32x2 e01 = (f32x2){0.f, 0.f}, e23 = e01, e45 = e01, e67 = e01;
    const LAS float* wre = w_re + gi * (D * 8);
#pragma unroll
    for (int j = 0; j < 4; ++j)
#pragma unroll
        for (int i = 0; i < 4; ++i) { const LAS float* wp = wre + ((j * 4 + i) * 128 + lane) * 4; const f32x4 w0 = *(const LAS f32x4*)wp, w1 = *(const LAS f32x4*)(wp + 256); const f32x2 xv = (f32x2){x[4 * j + i], x[4 * j + i]};
            e01 = xv * (f32x2){w0.x, w0.y} + e01; e23 = xv * (f32x2){w0.z, w0.w} + e23; e45 = xv * (f32x2){w1.x, w1.y} + e45; e67 = xv * (f32x2){w1.z, w1.w} + e67; }
    float el[8] = {e01.x, e01.y, e23.x, e23.y, e45.x, e45.y, e67.x, e67.y};
    wave_sum_n<8>(el);
#pragma unroll
    for (int e = 0; e < 8; ++e) el[e] += b_re[gi * 8 + e];
    int i0 = 0; float t0 = el[0];
#pragma unroll
    for (int e = 1; e < 8; ++e) if (el[e] > t0) { t0 = el[e]; i0 = e; }
    int i1 = -1; float t1 = -3.0e38f;
#pragma unroll
    for (int e = 0; e < 8; ++e) if (e != i0 && el[e] > t1) { t1 = el[e]; i1 = e; }
    const float ex = __expf(t1 - t0), p0 = 1.0f / (1.0f + ex), p1 = ex / (1.0f + ex);
    if (lane == 0) {
        const int e0 = gi * 8 + i0, e1 = gi * 8 + i1;
        const int s0 = __hip_atomic_fetch_add(lcnt + e0, 1, __ATOMIC_RELAXED, __HIP_MEMORY_SCOPE_WORKGROUP), s1 = __hip_atomic_fetch_add(lcnt + e1, 1, __ATOMIC_RELAXED, __HIP_MEMORY_SCOPE_WORKGROUP);
        GAS v4u* rp = (GAS v4u*)(rec + t);
        rp[0] = (v4u){(unsigned)e0, (unsigned)s0, (unsigned)e1, (unsigned)s1};
        rp[1] = (v4u){__float_as_uint(gw * p0), __float_as_uint(gw * p1), (unsigned)wslot, 0u};
    }
}

#ifndef STAG_P1
#define STAG_P1 500
#endif
__device__ __forceinline__ void stagger(int vcu, unsigned q) {
    const unsigned long long t0 = __builtin_amdgcn_s_memrealtime(); const unsigned long long d = (unsigned long long)((vcu & 3) * q);
    while (__builtin_amdgcn_s_memrealtime() - t0 < d) __builtin_amdgcn_s_sleep(8);
}
__device__ __forceinline__ void ph_ln0(Frame& F) { LAUNDER(F);
    const int gw = F.vcu * NWAVES + F.wave, NGW = F.G * NWAVES;
    bf16* hb = (bf16*)(F.ws + WS_HB);
    LnIn cur, nxt; if (gw < T) ln_load<0>(cur, F.in[0], nullptr, nullptr, (size_t)gw, F.lane);
    for (int m = gw; m < T; m += NGW) { const bool more = m + NGW < T; if (more) ln_load<0>(nxt, F.in[0], nullptr, nullptr, (size_t)(m + NGW), F.lane);
        f32x4 o[4]; ln_finish<0>(cur, nullptr, hb, F.in[1], F.in[2], (size_t)m, F.lane, o); if (more) cur = nxt; }
}
__device__ __forceinline__ void ph_p1(Frame& F, int l, int c) { LAUNDER(F); asm volatile("" : "+s"(l), "+s"(c));
    pg8::DenseOrder S; S.init((const bf16*)(F.ws + WS_HB) + (size_t)c * CH * D, D, (const bf16*)(F.ws + WS_WIN) + (size_t)l * NCOL * D, D, CH, NCOL, F.G, (int)blockIdx.x);
    EpiP1 E{(bf16*)(F.ws + WS_QKV), (bf16*)(F.ws + WS_GATES), F.in[5] + (size_t)l * GATEW, F.probe};
    pg8::gemm_phase<EpiP1, pg8::DenseOrder, false>(F.lds + RING_OFF, S, E, D, D, D, F.tid);
}
__device__ __forceinline__ void ph_cmb(Frame& F) { LAUNDER(F);
    const bf16* og = (const bf16*)(F.ws + WS_OG); const float* lse = (const float*)(F.ws + WS_LSE); bf16* oabc = (bf16*)(F.ws + WS_OABC);
    for (int idx = F.vcu * NTHREADS + F.tid; idx < CH * 32; idx += F.G * NTHREADS) {
        const int tl = idx >> 5, hc = idx & 31, h = hc >> 3, c = hc & 7;
        const GAS float* lg = (const GAS float*)lse + (size_t)tl * 12 + h; const float l0 = lg[0], l1 = lg[4], l2 = lg[8];
        const float mx = fmaxf(l0, fmaxf(l1, l2)); float w0 = __expf(l0 - mx), w1 = __expf(l1 - mx), w2 = __expf(l2 - mx); const float inv = 1.0f / (w0 + w1 + w2); w0 *= inv; w1 *= inv; w2 *= inv;
        const v4u a = *(const GAS v4u*)(og + ((size_t)tl * 3 + 0) * 256 + h * 64 + c * 8), b = *(const GAS v4u*)(og + ((size_t)tl * 3 + 1) * 256 + h * 64 + c * 8), d = *(const GAS v4u*)(og + ((size_t)tl * 3 + 2) * 256 + h * 64 + c * 8);
        v4u ow;
#pragma unroll
        for (int i = 0; i < 4; ++i) {
            const float lo = w0 * __uint_as_float(a[i] << 16) + w1 * __uint_as_float(b[i] << 16) + w2 * __uint_as_float(d[i] << 16);
            const float hi = w0 * __uint_as_float(a[i] & 0xffff0000u) + w1 * __uint_as_float(b[i] & 0xffff0000u) + w2 * __uint_as_float(d[i] & 0xffff0000u);
            ow[i] = pk2(lo, hi);
        }
        *(GAS v4u*)(oabc + (size_t)tl * OW + 512 + h * 64 + c * 8) = ow;
    }
}
__device__ __forceinline__ void ph_p3(Frame& F, int l) { LAUNDER(F); asm volatile("" : "+s"(l));
    const bf16* oabc = (const bf16*)(F.ws + WS_OABC); bf16* merged = (bf16*)(F.ws + WS_MERGED); const bf16* gates = (const bf16*)(F.ws + WS_GATES);
    P3Order S; S.Dn.init(oabc, OW, nullptr, 0, CH, D, F.G, (int)blockIdx.x);
    S.Abase = (const char*)oabc; S.wsb = (const char*)F.ws; S.lofs = (size_t)l;
    EpiP3V E{merged, gates};
    pg8::gemm_phase_vk<EpiP3V, P3Order>(F.lds + RING_OFF, S, E, OW, F.tid);
}
__device__ __forceinline__ void ph_p4(Frame& F, int l, int c) { LAUNDER(F); asm volatile("" : "+s"(l), "+s"(c));
    pg8::DenseOrder S; S.init((const bf16*)(F.ws + WS_MERGED), D, (const bf16*)(F.ws + WS_WOUT) + (size_t)l * D * D, D, CH, D, F.G, (int)blockIdx.x);
    EpiP4 E{(const bf16*)(F.ws + WS_HB) + (size_t)c * CH * D, F.probe ? (float*)(F.ws + WS_OABC) : F.h + (size_t)c * CH * D};
    pg8::gemm_phase<EpiP4, pg8::DenseOrder, false>(F.lds + RING_OFF, S, E, D, D, D, F.tid);
}
__device__ __forceinline__ void ph_ln1(Frame& F, int l, int c) { LAUNDER(F); asm volatile("" : "+s"(l), "+s"(c));
    const int gw = F.vcu * NWAVES + F.wave, NGW = F.G * NWAVES;
    bf16* hb = (bf16*)(F.ws + WS_HB); Rec* rec = (Rec*)(F.ws + WS_REC);
    int* wgc = (int*)(F.ws + WS_WGCNT) + ((size_t)(l * NCHUNK + c) * F.G + F.vcu) * 32;
    if (F.probe) { hb = (bf16*)(F.ws + WS_QKV) - (size_t)c * CH * D; wgc = (int*)(F.ws + WS_WGCNT) + (size_t)DEPTH * NCHUNK * 256 * 32 + F.vcu * 32; rec = (Rec*)(F.ws + WS_GATES); }
    LAS float* lrg = (LAS float*)(F.lds + RING_OFF); LAS float* lre = lrg + D * 4; LAS int* lcnt = (LAS int*)(F.lds + LCNT_OFF);
    { const float* w_rg = F.in[14] + (size_t)l * D * 4; const float* w_re = F.in[16] + (size_t)l * 4 * D * 8;
      if (F.tid < 32) lcnt[F.tid] = 0;
      for (int u = F.tid; u < D + 4 * D * 2; u += NTHREADS) {
          if (u < D) { const int e = u, ln = (e & 255) >> 2, i = e & 3, j = e >> 8; *(LAS f32x4*)(lrg + ((j * 4 + i) * 64 + ln) * 4) = *(const GAS f32x4*)(w_rg + (size_t)e * 4); }
          else { const int v = u - D, half = v & 1, e = (v >> 1) & 1023, g = v >> 11, ln = (e & 255) >> 2, i = e & 3, j = e >> 8;
                 *(LAS f32x4*)(lre + g * (D * 8) + (((j * 4 + i) * 2 + half) * 64 + ln) * 4) = *(const GAS f32x4*)(w_re + ((size_t)g * D + e) * 8 + half * 4); } }
      __syncthreads(); }
    f32x4 wg[16];
#pragma unroll
    for (int j = 0; j < 4; ++j)
#pragma unroll
        for (int i = 0; i < 4; ++i) wg[4 * j + i] = *(const LAS f32x4*)(lrg + ((j * 4 + i) * 64 + F.lane) * 4);
    const size_t rbase = (size_t)c * CH;
    LnIn cur, nxt; if (gw < CH) ln_load<1>(cur, F.h, nullptr, nullptr, rbase + gw, F.lane);
    for (int m = gw; m < CH; m += NGW) {
        const bool more = m + NGW < CH; if (more) ln_load<1>(nxt, F.h, nullptr, nullptr, rbase + m + NGW, F.lane);
        const size_t row = rbase + m; f32x4 o[4];
        ln_finish<1>(cur, nullptr, hb, F.in[12] + l * D, F.in[13] + l * D, row, F.lane, o);
        float x[16];
#pragma unroll
        for (int j = 0; j < 4; ++j) { x[4 * j] = o[j].x; x[4 * j + 1] = o[j].y; x[4 * j + 2] = o[j].z; x[4 * j + 3] = o[j].w; }
        router_row(x, (int)row, F.lane, wg, F.in[15] + l * 4, lre, F.in[17] + l * 32, lcnt, c * F.G + F.vcu, rec);
        if (more) cur = nxt;
    }
    __syncthreads();
    if (F.tid < 32) *(GAS int*)(wgc + F.tid) = lcnt[F.tid];
}
__device__ __forceinline__ void ph_dsp(Frame& F, int l) { LAUNDER(F); asm volatile("" : "+s"(l));
    LAS int* Tb = (LAS int*)(F.lds + RING_OFF); LAS int* part = Tb + 512 * 32; LAS int* po = part + 32 * 16;
    const int* wg = (const int*)(F.ws + WS_WGCNT) + (size_t)l * NCHUNK * F.G * 32; const int W = NCHUNK * F.G;
    int* cnt = (int*)(F.ws + WS_CTL) + CW_CNT + l * (32 * CSTR); const Rec* rec = (const Rec*)(F.ws + WS_REC); int* rowtok = (int*)(F.ws + WS_ROWTOK); float* rowgate = (float*)(F.ws + WS_ROWGATE);
    for (int i = F.tid; i < W * 32; i += NTHREADS) Tb[i] = *(const GAS int*)(wg + i);
    __syncthreads();
    const int e = F.tid >> 4, k = F.tid & 15, per = (W + 15) / 16, w0 = k * per, w1 = (w0 + per) < W ? (w0 + per) : W;
    { int s = 0; for (int w = w0; w < w1; ++w) s += Tb[w * 32 + e]; part[e * 16 + k] = s; }
    __syncthreads();
    { int base = 0; for (int kk = 0; kk < k; ++kk) base += part[e * 16 + kk];
      for (int w = w0; w < w1; ++w) { const int t = Tb[w * 32 + e]; Tb[w * 32 + e] = base; base += t; } }
    __syncthreads();
    if (F.tid == 0) { int acc = 0; for (int ee = 0; ee < NE; ++ee) { int tot = 0; for (int kk = 0; kk < 16; ++kk) tot += part[ee * 16 + kk]; po[ee] = acc; part[ee * 16] = tot; acc += (tot + 255) / 256 * 256; } po[NE] = acc; }
    __syncthreads();
    if (F.vcu == 0 && F.tid < 32) cnt[F.tid * CSTR] = part[F.tid * 16];
    const int gt = F.vcu * NTHREADS + F.tid, GT = F.G * NTHREADS;
    for (int t = gt; t < T; t += GT) {
        const GAS v4u* rp = (const GAS v4u*)(rec + t); const v4u ra = rp[0], rb = rp[1];
        Rec rc; rc.e0 = (int)ra.x; rc.s0 = (int)ra.y; rc.e1 = (int)ra.z; rc.s1 = (int)ra.w; rc.g0 = __uint_as_float(rb.x); rc.g1 = __uint_as_float(rb.y); rc.pad0 = (int)rb.z; rc.pad1 = 0;
        const int d0 = po[rc.e0] + Tb[rc.pad0 * 32 + rc.e0] + rc.s0, d1 = po[rc.e1] + Tb[rc.pad0 * 32 + rc.e1] + rc.s1;
        *(GAS int*)(rowtok + d0) = 2 * t; *(GAS float*)(rowgate + d0) = rc.g0; *(GAS int*)(rowtok + d1) = 2 * t + 1; *(GAS float*)(rowgate + d1) = rc.g1;
    }
    for (int ee = 0; ee < NE; ++ee) for (int r = po[ee] + part[ee * 16] + gt; r < po[ee + 1]; r += GT) { *(GAS int*)(rowtok + r) = -1; *(GAS float*)(rowgate + r) = 0.f; }
    __syncthreads();
}
__device__ __forceinline__ int moe_setup(Frame& F, int l, bool gather) { LAUNDER(F); asm volatile("" : "+s"(l));
    LAS int* rows = (LAS int*)(F.lds + ROWS_OFF); LAS int* ulist = rows + 11 * 256; LAS int* po = ulist + 16;
    const int* cnt = (const int*)(F.ws + WS_CTL) + CW_CNT + l * (32 * CSTR); const int* rowtok = (const int*)(F.ws + WS_ROWTOK);
    if (F.tid == 0) { int acc = 0; for (int e = 0; e < NE; ++e) { po[e] = acc; acc += (cnt[e * CSTR] + 255) / 256 * 256; } po[NE] = acc; }
    __syncthreads();
    const int nu_all = (po[NE] / 256) * 4; int nun = (nu_all - F.vcu + F.G - 1) / F.G; nun = nun < 0 ? 0 : (nun > 11 ? 11 : nun);
    if (F.tid < nun) { const int Lx = F.tid * F.G + F.vcu, rt = Lx >> 2, pn = Lx & 3; int e = 0; while (e < NE - 1 && po[e + 1] <= rt * 256) ++e; ulist[F.tid] = (rt << 8) | (e << 2) | pn; }
    if (gather) for (int idx = F.tid; idx < nun * 256; idx += NTHREADS) { const int i = idx >> 8, r = idx & 255, Lx = i * F.G + F.vcu; rows[idx] = *(const GAS int*)(rowtok + (Lx >> 2) * 256 + r); }
    __syncthreads();
    return nun;
}
struct MoeOrder {
    int nun; const LAS int* ulist; const LAS int* rows; const char* A; const char* B; size_t tstepA, estepB, tstepB;
    __device__ __forceinline__ bool next(int i, pg8::Unit& u) const {
        if (i >= nun) return false;
        const int w = __builtin_amdgcn_readfirstlane(ulist[i]); u.pm = w >> 8; u.e = (w >> 2) & 63; u.pn = w & 3; u.ui = i; return true;
    }
    __device__ __forceinline__ const char* a_base(const pg8::Unit& u) const { return A + (size_t)u.pm * tstepA; }
    __device__ __forceinline__ const char* b_base(const pg8::Unit& u) const { return B + (size_t)u.e * estepB + (size_t)u.pn * tstepB; }
    __device__ __forceinline__ int a_row(const pg8::Unit& u, int r) const { const int t = rows[u.ui * 256 + r]; return t < 0 ? 0 : (t >> 1); }
};
__device__ __forceinline__ void ph_p7(Frame& F, int l) { LAUNDER(F); asm volatile("" : "+s"(l));
    const int nun = moe_setup(F, l, true);
    LAS int* rows = (LAS int*)(F.lds + ROWS_OFF);
    MoeOrder S{nun, rows + 11 * 256, rows, (const char*)(F.ws + WS_HB), (const char*)(F.ws + WS_WGU) + (size_t)l * NE * 1024 * 1024 * 2, 0, (size_t)1024 * 1024 * 2, (size_t)256 * 1024 * 2};
    EpiP7 E{(bf16*)(F.ws + WS_HID)};
    pg8::gemm_phase<EpiP7, MoeOrder, true>(F.lds + RING_OFF, S, E, D, D, D, F.tid);
}
__device__ __forceinline__ void ph_p8(Frame& F, int l) { LAUNDER(F); asm volatile("" : "+s"(l));
    const int nun = moe_setup(F, l, false);
    LAS int* rows = (LAS int*)(F.lds + ROWS_OFF);
    MoeOrder S{nun, rows + 11 * 256, rows, (const char*)(F.ws + WS_HID), (const char*)(F.ws + WS_WD) + (size_t)l * NE * 1024 * 512 * 2, (size_t)256 * DE * 2, (size_t)1024 * 512 * 2, (size_t)256 * 512 * 2};
    EpiP8 E{(bf16*)(F.ws + WS_YB), (const int*)(F.ws + WS_ROWTOK), (const float*)(F.ws + WS_ROWGATE)};
    pg8::gemm_phase<EpiP8, MoeOrder, false>(F.lds + RING_OFF, S, E, DE, DE, DE, F.tid);
}
__device__ __forceinline__ void ph_ln2(Frame& F, int l) { LAUNDER(F); asm volatile("" : "+s"(l));
    const int gw = F.vcu * NWAVES + F.wave, NGW = F.G * NWAVES;
    const bool lastl = (l == DEPTH - 1);
    const bf16* hsb = (const bf16*)(F.ws + WS_HB); const bf16* yb = (const bf16*)(F.ws + WS_YB);
    bf16* hb = lastl ? nullptr : (bf16*)(F.ws + WS_HB); float* hout = lastl ? F.h : nullptr; size_t omask = ~(size_t)0;
    if (F.probe) { hout = lastl ? (float*)(F.ws + WS_OABC) : nullptr; hb = lastl ? nullptr : (bf16*)(F.ws + WS_OABC); omask = 32767; }
    LnIn cur, nxt; if (gw < T) ln_load<2>(cur, nullptr, hsb, yb, (size_t)gw, F.lane);
    for (int m = gw; m < T; m += NGW) { const bool more = m + NGW < T; if (more) ln_load<2>(nxt, nullptr, hsb, yb, (size_t)(m + NGW), F.lane);
        const size_t back = ((size_t)m - ((size_t)m & omask)) * D;
        f32x4 o[4]; ln_finish<2>(cur, hout ? hout - back : nullptr, hb ? hb - back : nullptr, F.in[21] + l * D, F.in[22] + l * D, (size_t)m, F.lane, o); if (more) cur = nxt; }
}

typedef short s16x4 __attribute__((ext_vector_type(4)));
constexpr int NT_A = (CH / 32) * 4, NT_B = (CH / L) * 3 * 128 * 4, NT_C = (CH / 64) * 8, NT_ALL = NT_A + NT_B + NT_C;
constexpr float NEGBIG = -1.0e30f, MINIT = -5.0e29f;
#define RC16(reg) (((reg) & 3) + 8 * ((reg) >> 2))

__device__ __forceinline__ void ph_tables(Frame& F) { LAUNDER(F);
    float* TA = (float*)(F.ws + WS_TABA); float* TB = (float*)(F.ws + WS_TABB); float* TC = (float*)(F.ws + WS_TABC);
    const float* rel_bias = F.in[3]; const float* rpb = F.in[7];
    const int gt = F.vcu * NTHREADS + F.tid, GT = F.G * NTHREADS;
    for (int i = gt; i < 8 * 320; i += GT) { const int h = i / 320, rel = i % 320 - 160; TA[i] = (rel >= -128 && rel <= 128) ? rel_bias[BUCK_A[rel + 128] * 20 + h] * LOG2E : NEGBIG; }
    for (int i = gt; i < 12 * 256; i += GT) { const int gh = i >> 8, g = gh >> 2, rel = (i & 255) - 128; TB[i] = (rel >= -64 && rel <= 64) ? rel_bias[BUCK_B[g][rel + 64] * 20 + 8 + gh] * LOG2E : NEGBIG; }
    for (int i = gt; i < DEPTH * 8 * 1024; i += GT) { const int lh = i >> 10, ri = (i >> 6) & 15, ci = (i & 63) - 16; TC[i] = (ri < 15 && ci >= 0 && ci <= 30) ? rpb[((size_t)lh * 15 + ri) * 31 + ci] * LOG2E : NEGBIG; }
}

#define ATT_INIT(S, TBP, BIDX, XM) do { \
        _Pragma("unroll") for (int r_ = 0; r_ < 16; ++r_) { float v_ = (TBP)[(BIDX) + RC16(r_)]; if (TYPE == 2) v_ = ((unsigned)((XM) + RC16(r_)) < 16u) ? v_ : NEGBIG; S[r_] = v_; } } while (0)
__device__ __forceinline__ float xhalf_max(float t) { float a_ = t, b_ = t; asm volatile("s_nop 1\n\tv_permlane32_swap_b32 %0, %1" : "+v"(a_), "+v"(b_)); return fmaxf(a_, b_); }
__device__ __forceinline__ float xhalf_sum(float t) { float a_ = t, b_ = t; asm volatile("s_nop 1\n\tv_permlane32_swap_b32 %0, %1" : "+v"(a_), "+v"(b_)); return a_ + b_; }
#define ATT_TMAX(S, t) do { t = NEGBIG; _Pragma("unroll") for (int r_ = 0; r_ < 16; ++r_) t = fmaxf(t, S[r_]); } while (0)
#define ATT_RESCALE(need, t, m, l, Oa, Ob) do { const float mn_ = (need) ? (t) : m, corr_ = __builtin_amdgcn_exp2f(m - mn_); m = mn_; l *= corr_; \
        _Pragma("unroll") for (int i_ = 0; i_ < 16; ++i_) { Oa[i_] *= corr_; Ob[i_] *= corr_; } } while (0)
#define ATT_EXP(S, m, rs) do { rs = 0.f; _Pragma("unroll") for (int r_ = 0; r_ < 16; ++r_) { const float p_ = __builtin_amdgcn_exp2f(S[r_] - m); S[r_] = p_; rs += p_; } } while (0)
#define ATT_PACK(Pf, S, s2) do { unsigned pw_[4]; _Pragma("unroll") for (int j_ = 0; j_ < 4; ++j_) pw_[j_] = pg8::cvt_pk_bf16(S[8 * (s2) + 2 * j_], S[8 * (s2) + 2 * j_ + 1]); \
        Pf = __builtin_bit_cast(bf16x8, (v4u){pw_[0], pw_[1], pw_[2], pw_[3]}); } while (0)
#define ATT_STORE(orow, Oa, Ob, l) do { const float inv_ = 1.0f / (l); \
        _Pragma("unroll") for (int g_ = 0; g_ < 4; ++g_) { v2u w0_, w1_; \
            w0_.x = pg8::cvt_pk_bf16(Oa[4 * g_] * inv_, Oa[4 * g_ + 1] * inv_); w0_.y = pg8::cvt_pk_bf16(Oa[4 * g_ + 2] * inv_, Oa[4 * g_ + 3] * inv_); \
            w1_.x = pg8::cvt_pk_bf16(Ob[4 * g_] * inv_, Ob[4 * g_ + 1] * inv_); w1_.y = pg8::cvt_pk_bf16(Ob[4 * g_ + 2] * inv_, Ob[4 * g_ + 3] * inv_); \
            *(GAS v2u*)((orow) + 8 * g_ + 4 * hh) = w0_; *(GAS v2u*)((orow) + 32 + 8 * g_ + 4 * hh) = w1_; } } while (0)

template <int TYPE>
__device__ __forceinline__ void att_task2(LAS unsigned char* wl, const int lane, const bf16* seq  , const float* tab0, const float* tab1,
                                          const int qcol0, const int qcol1, const int kcol, const int vcol, const int TT0, const int TSTEP, const int kstride, const int tlo, const int thi,
                                          const int tq0, const int tq1  , const int toff1  ,
                                          const int gi0, const int gi1, const int gc, const int cbs  ,
                                          const float m_init0, const float m_init1, const float l_init, bf16* orow0, bf16* orow1, float* lse0, float* lse1) {
    const int qi = lane & 31, hh = lane >> 5;
    LAS unsigned char* kt = wl; LAS unsigned char* vt = wl + 4096; LAS float* tb0 = (LAS float*)(wl + 8192); LAS float* tb1 = (TYPE == 0) ? tb0 + 320 : tb0;
    constexpr int TBN = TYPE == 0 ? 320 : (TYPE == 1 ? 256 : 1024);
#pragma unroll
    for (int i = 0; i < TBN / 64; ++i) { tb0[lane + 64 * i] = *(const GAS float*)(tab0 + lane + 64 * i); if (TYPE == 0) tb1[lane + 64 * i] = *(const GAS float*)(tab1 + lane + 64 * i); }
    bf16x8 Qa[4], Qb[4];
#pragma unroll
    for (int s = 0; s < 4; ++s) { Qa[s] = *(const GAS bf16x8*)(seq + (size_t)tq0 * QKVW + qcol0 + 16 * s + 8 * hh); Qb[s] = *(const GAS bf16x8*)(seq + (size_t)tq1 * QKVW + qcol1 + 16 * s + 8 * hh); }
    f32x16 O0a, O0b, O1a, O1b;
#pragma unroll
    for (int i = 0; i < 16; ++i) { O0a[i] = 0.f; O0b[i] = 0.f; O1a[i] = 0.f; O1b[i] = 0.f; }
    float m0 = m_init0, m1 = m_init1, l0 = l_init, l1 = l_init;
    const int lkey = lane >> 3, lch = lane & 7;
    const unsigned goff = (unsigned)(lkey * kstride) * (unsigned)(QKVW * 2) + 16u * (unsigned)lch;
    const size_t istepb = (size_t)8 * kstride * QKVW * 2;
    const char* kbase = (const char*)(seq + kcol); const char* vbase = (const char*)(seq + vcol);
    const unsigned kw0 = lkey * 128 + ((lch ^ (lkey & 7)) << 4), vw0 = lkey * 128 + (((lch >> 2) ^ ((lkey >> 1) & 1)) << 6) + ((lch & 3) << 4);
    const unsigned kr0 = qi * 128 + ((hh ^ (qi & 7)) << 4);
    const int q4 = (lane & 15) >> 2, p4 = lane & 3, g1 = (lane >> 4) & 1, sw = (q4 >> 1) & 1;
    const unsigned vr0 = (4 * hh + q4) * 128 + 32 * g1 + 8 * p4 + (sw << 6), vr1 = (4 * hh + q4) * 128 + 32 * g1 + 8 * p4 + ((sw ^ 1) << 6);
    const int bidx0 = (TYPE == 2) ? (cbs - gc + 31 + 4 * hh) : ((TYPE == 1 ? 64 : 32) - qi + 4 * hh);
    int cs = gc - 8; cs = cs < 0 ? 0 : (cs > 48 ? 48 : cs);
    const int xm = cbs - cs + 4 * hh;
    int rs0 = gi0 - 4; rs0 = rs0 < 0 ? 0 : (rs0 > 120 ? 120 : rs0);
    int rs1 = gi1 - 4; rs1 = rs1 < 0 ? 0 : (rs1 > 120 ? 120 : rs1);
    v4u kreg[4], vreg[4];
    {
        const size_t tb_ = (size_t)(TT0 + tlo * TSTEP) * (QKVW * 2);
#pragma unroll
        for (int i = 0; i < 4; ++i) { kreg[i] = *(const GAS v4u*)(kbase + tb_ + i * istepb + goff); vreg[i] = *(const GAS v4u*)(vbase + tb_ + i * istepb + goff); }
    }
    for (int ti = tlo; ti <= thi; ++ti) {
#pragma unroll
        for (int i = 0; i < 4; ++i) { *(LAS v4u*)(kt + kw0 + 1024 * i) = kreg[i]; *(LAS v4u*)(vt + vw0 + 1024 * i) = vreg[i]; }
        if (ti < thi) {
            const size_t tb_ = (size_t)(TT0 + (ti + 1) * TSTEP) * (QKVW * 2);
#pragma unroll
            for (int i = 0; i < 4; ++i) { kreg[i] = *(const GAS v4u*)(kbase + tb_ + i * istepb + goff); vreg[i] = *(const GAS v4u*)(vbase + tb_ + i * istepb + goff); }
        }
        int bi0, bi1;
        if (TYPE == 2) { const bool rv0 = (ti >= rs0) && (ti < rs0 + 8), rv1 = (ti >= rs1) && (ti < rs1 + 8); bi0 = bidx0 + (rv0 ? (ti - gi0 + 7) : 15) * 64; bi1 = bidx0 + (rv1 ? (ti - gi1 + 7) : 15) * 64; }
        else { bi0 = bidx0 + 32 * ti; bi1 = bidx0 + 32 * (ti - toff1); }
        f32x16 S0, S1;
        ATT_INIT(S0, tb0, bi0, xm); ATT_INIT(S1, tb1, bi1, xm);
#pragma unroll
        for (int s = 0; s < 4; ++s) { const bf16x8 Kf = *(const LAS bf16x8*)(kt + (kr0 ^ (unsigned)(s << 5)));
            S0 = __builtin_amdgcn_mfma_f32_32x32x16_bf16(Kf, Qa[s], S0, 0, 0, 0); S1 = __builtin_amdgcn_mfma_f32_32x32x16_bf16(Kf, Qb[s], S1, 0, 0, 0); }
        float t0, t1; ATT_TMAX(S0, t0); ATT_TMAX(S1, t1);
        t0 = xhalf_max(t0); t1 = xhalf_max(t1);
        const bool need0 = t0 > m0 + 8.0f, need1 = t1 > m1 + 8.0f;
        if (__builtin_amdgcn_ballot_w64(need0 || need1) != 0ull) { ATT_RESCALE(need0, t0, m0, l0, O0a, O0b); ATT_RESCALE(need1, t1, m1, l1, O1a, O1b); }
        float rs0, rs1; ATT_EXP(S0, m0, rs0); ATT_EXP(S1, m1, rs1);
        rs0 = xhalf_sum(rs0); rs1 = xhalf_sum(rs1);
        l0 += rs0; l1 += rs1;
#pragma unroll
        for (int s2 = 0; s2 < 2; ++s2) {
            bf16x8 P0, P1; ATT_PACK(P0, S0, s2); ATT_PACK(P1, S1, s2);
            const s16x4 a00 = __builtin_amdgcn_ds_read_tr16_b64_v4i16((LAS s16x4*)(vt + vr0 + (16 * s2) * 128));
            const s16x4 a01 = __builtin_amdgcn_ds_read_tr16_b64_v4i16((LAS s16x4*)(vt + vr0 + (16 * s2 + 8) * 128));
            const s16x4 a10 = __builtin_amdgcn_ds_read_tr16_b64_v4i16((LAS s16x4*)(vt + vr1 + (16 * s2) * 128));
            const s16x4 a11 = __builtin_amdgcn_ds_read_tr16_b64_v4i16((LAS s16x4*)(vt + vr1 + (16 * s2 + 8) * 128));
            const bf16x8 V0 = (bf16x8){a00[0], a00[1], a00[2], a00[3], a01[0], a01[1], a01[2], a01[3]};
            const bf16x8 V1 = (bf16x8){a10[0], a10[1], a10[2], a10[3], a11[0], a11[1], a11[2], a11[3]};
            O0a = __builtin_amdgcn_mfma_f32_32x32x16_bf16(V0, P0, O0a, 0, 0, 0); O0b = __builtin_amdgcn_mfma_f32_32x32x16_bf16(V1, P0, O0b, 0, 0, 0);
            O1a = __builtin_amdgcn_mfma_f32_32x32x16_bf16(V0, P1, O1a, 0, 0, 0); O1b = __builtin_amdgcn_mfma_f32_32x32x16_bf16(V1, P1, O1b, 0, 0, 0);
        }
    }
    ATT_STORE(orow0, O0a, O0b, l0);
    ATT_STORE(orow1, O1a, O1b, l1);
    if (TYPE == 1 && hh == 0) { *(GAS float*)lse0 = (m0 + __builtin_amdgcn_logf(l0)) * LN2; *(GAS float*)lse1 = (m1 + __builtin_amdgcn_logf(l1)) * LN2; }
}

__device__ __forceinline__ void ph_att(Frame& F, int l) { LAUNDER(F); asm volatile("" : "+s"(l));
    LAS unsigned char* wl = F.lds + RING_OFF + F.wave * 16384;
    const bf16* qkv = (const bf16*)(F.ws + WS_QKV); bf16* oabc = (bf16*)(F.ws + WS_OABC); bf16* og = (bf16*)(F.ws + WS_OG); float* lse = (float*)(F.ws + WS_LSE);
    const float* TA = (const float*)(F.ws + WS_TABA); const float* TB = (const float*)(F.ws + WS_TABB); const float* TC = (const float*)(F.ws + WS_TABC) + (size_t)l * 8 * 1024;
    const float* sink = F.in[6] + l * 8;
    const int gw = F.vcu * NWAVES + F.wave, NGW = F.G * NWAVES;
    for (int task = gw; task < NT_ALL; task += NGW) {
        int lane = F.lane; asm volatile("" : "+v"(lane)); const int qi = lane & 31;
        if (task < NT_A) {
            const int hp = task & 3, qb = (task >> 2) & 255, b = task >> 10, q0 = qb * 32, h0 = hp * 2, h1 = h0 + 1, kvh = hp >> 1;
            int tlo = 0, thi = 8; if (q0 - 128 < 0) tlo = (128 - q0) / 32; if (q0 + 128 + 31 >= L) thi = (L - 1 - (q0 - 128)) / 32;
            const int tq = q0 + qi; bf16* orow = oabc + (size_t)(b * L + tq) * OW;
            att_task2<0>(wl, lane, qkv + (size_t)b * L * QKVW, TA + h0 * 320, TA + h1 * 320, AQ + h0 * 64, AQ + h1 * 64, AK + kvh * 64, AV + kvh * 64, q0 - 128, 32, 1, tlo, thi,
                         tq, tq, 0, 0, 0, 0, 0, sink[h0] * LOG2E, sink[h1] * LOG2E, 1.0f, orow + h0 * 64, orow + h1 * 64, nullptr, nullptr);
        } else if (task < NT_A + NT_B) {
            const int j = task - NT_A, h = j & 3, sbi = (j >> 2) & 127, bg = j >> 9, g = bg % 3, b = bg / 3;
            const int dsh = 2 * g, d = 1 << dsh, nsb = 128 >> dsh, r = sbi / nsb, sb = sbi % nsb, q0 = sb * 64, Ls = L >> dsh;
            int tlo = 0, thi = 5; if (q0 - 64 < 0) tlo = (64 - q0) / 32; if (q0 + 32 + 64 + 31 >= Ls) thi = (Ls - 1 - (q0 - 64)) / 32;
            const int tq0 = (q0 + qi) * d + r, tq1 = (q0 + 32 + qi) * d + r, qc = BQ0 + 768 * g + h * 64;
            att_task2<1>(wl, lane, qkv + (size_t)b * L * QKVW, TB + (g * 4 + h) * 256, nullptr, qc, qc, qc + 256, qc + 512, (q0 - 64) * d + r, 32 * d, d, tlo, thi,
                         tq0, tq1, 1, 0, 0, 0, 0, MINIT, MINIT, 0.0f, og + ((size_t)(b * L + tq0) * 3 + g) * 256 + h * 64, og + ((size_t)(b * L + tq1) * 3 + g) * 256 + h * 64,
                         lse + ((size_t)(b * L + tq0) * 3 + g) * 4 + h, lse + ((size_t)(b * L + tq1) * 3 + g) * 4 + h);
        } else {
            const int j = task - NT_A - NT_B, h = j & 7, cbi = (j >> 3) & 127, b = j >> 10, ip = cbi >> 2, cb = cbi & 3;
            const int gi0 = 4 * ip + (qi >> 4), gi1 = gi0 + 2, gc = 16 * cb + (qi & 15), tq0 = gi0 * 64 + gc, tq1 = gi1 * 64 + gc;
            int cbs = 16 * cb - 8; cbs = cbs < 0 ? 0 : (cbs > 32 ? 32 : cbs);
            int rlo = 4 * ip - 4; rlo = rlo < 0 ? 0 : (rlo > 120 ? 120 : rlo);
            int rhi = 4 * ip + 3 - 4; rhi = rhi < 0 ? 0 : (rhi > 120 ? 120 : rhi); rhi += 7;
            bf16* ob = oabc + (size_t)(b * L) * OW + 768 + h * 64;
            att_task2<2>(wl, lane, qkv + (size_t)b * L * QKVW, TC + h * 1024, nullptr, CQ + h * 64, CQ + h * 64, CK + h * 64, CV + h * 64, cbs, 64, 1, rlo, rhi,
                         tq0, tq1, 0, gi0, gi1, gc, cbs, MINIT, MINIT, 0.0f, ob + (size_t)tq0 * OW, ob + (size_t)tq1 * OW, nullptr, nullptr);
        }
    }
}

constexpr int NSTEPS = 1 + DEPTH * 16;
__global__ void __launch_bounds__(NTHREADS, 2) mk_fwd(Args args) {
    extern __shared__ __attribute__((aligned(16))) unsigned char lds[];
    Frame F;
    F.lds = (LAS unsigned char*)lds; F.wave = __builtin_amdgcn_readfirstlane((int)threadIdx.x >> 6); F.lane = hw_lane(); F.tid = F.wave * 64 + F.lane;
    F.G = gridDim.x; { const int bx = blockIdx.x; F.vcu = (F.G % 8 == 0) ? (bx % 8) * (F.G / 8) + bx / 8 : bx; }
    F.in = args.in; F.h = args.out; F.ws = args.ws; F.probe = args.probe;
    volatile LAS unsigned* MISC = (volatile LAS unsigned*)(F.lds + MISC_OFF);
    if (F.tid < 32) MISC[F.tid] = 0u;
    __syncthreads();
    const int lo = args.s_lo, hi = args.s_hi;
    XcdBarrier bar; bar.wave0 = (F.wave == 0); bar.bar = (unsigned*)(F.ws + WS_CTL) + CW_BAR; bar.x = 0; bar.st = nullptr;
    if (hi - lo > 1) bar = xcd_barrier_post((unsigned*)(F.ws + WS_CTL) + CW_BAR, MISC + 8, F.wave == 0);
#define RUN(s) (lo <= (s) && (s) < hi)
#define SEAM(s) do { if (RUN(s) && RUN((s) + 1)) xcd_barrier(bar); } while (0)
    if (RUN(0)) { ph_prologue(F); ph_tables(F); ph_ln0(F); }
    SEAM(0);
    for (int l = 0; l < DEPTH; ++l) {
        const int sb = 1 + l * 16;
        for (int c = 0; c < NCHUNK; ++c) {
            const int s = sb + c * 6;
            if (RUN(s)) ph_p1(F, l, c);
            SEAM(s);
            if (RUN(s + 1)) ph_att(F, l);
            SEAM(s + 1);
            if (RUN(s + 2)) ph_cmb(F);
            SEAM(s + 2);
            if (RUN(s + 3)) ph_p3(F, l);
            SEAM(s + 3);
            if (RUN(s + 4)) ph_p4(F, l, c);
            SEAM(s + 4);
            if (RUN(s + 5)) ph_ln1(F, l, c);
            if (c == NCHUNK - 1) SEAM(s + 5);
        }
        if (RUN(sb + 12)) ph_dsp(F, l);
        SEAM(sb + 12);
        if (RUN(sb + 13)) ph_p7(F, l);
        SEAM(sb + 13);
        if (RUN(sb + 14)) ph_p8(F, l);
        SEAM(sb + 14);
        if (RUN(sb + 15)) ph_ln2(F, l);
        SEAM(sb + 15);
    }
#undef RUN
#undef SEAM
}

#ifndef DUP_NOEPI
#define DUP_NOEPI 0
#endif
#ifndef FAST_MASK
#define FAST_MASK 0x7FF
#endif
#ifndef ONE_LAUNCH
#define ONE_LAUNCH 1
#endif
extern "C" void kernel_launch(void* const* d_in, const int* in_sizes, int n_in, void* d_out, int out_size, void* d_ws, size_t ws_size, hipStream_t stream) {
    static int grid = 0;
    if (grid == 0) {
        if (n_in != 23 || out_size != T * D || ws_size < WS_END) { fprintf(stderr, "kernel_launch: unexpected shapes (n_in %d out %d ws %zu)\n", n_in, out_size, ws_size); grid = -1; return; }
        int dev = 0, cus = 0, per_cu = 0;
        if (hipGetDevice(&dev) != hipSuccess || hipDeviceGetAttribute(&cus, hipDeviceAttributeMultiprocessorCount, dev) != hipSuccess) { grid = -1; return; }
        if (hipFuncSetAttribute((const void*)mk_fwd, hipFuncAttributeMaxDynamicSharedMemorySize, LDS_BYTES) != hipSuccess) { fprintf(stderr, "kernel_launch: hipFuncSetAttribute failed\n"); grid = -1; return; }
        if (hipOccupancyMaxActiveBlocksPerMultiprocessor(&per_cu, (const void*)mk_fwd, NTHREADS, LDS_BYTES) != hipSuccess || per_cu < 1) fprintf(stderr, "kernel_launch: occupancy query reports %d\n", per_cu);
        (void)hipGetLastError();
        grid = cus;
    }
    if (grid < 0) return;
    const float* x = (const float*)d_in[0]; const float* ln0_g = (const float*)d_in[1]; const float* ln0_b = (const float*)d_in[2]; const float* rel_bias = (const float*)d_in[3];
    const float* w_in = (const float*)d_in[4]; const float* b_gate = (const float*)d_in[5]; const float* sink_a = (const float*)d_in[6]; const float* rpb_c = (const float*)d_in[7];
    const float* w_br_a = (const float*)d_in[8]; const float* w_br_b = (const float*)d_in[9]; const float* w_br_c = (const float*)d_in[10]; const float* w_out = (const float*)d_in[11];
    const float* ln1_g = (const float*)d_in[12]; const float* ln1_b = (const float*)d_in[13]; const float* w_rg = (const float*)d_in[14]; const float* b_rg = (const float*)d_in[15];
    const float* w_re = (const float*)d_in[16]; const float* b_re = (const float*)d_in[17]; const float* w_eg = (const float*)d_in[18]; const float* w_eu = (const float*)d_in[19];
    const float* w_ed = (const float*)d_in[20]; const float* ln2_g = (const float*)d_in[21]; const float* ln2_b = (const float*)d_in[22];
    unsigned char* ws = (unsigned char*)d_ws; float* h = (float*)d_out;
    bf16* hb = (bf16*)(ws + WS_HB); bf16* qkv = (bf16*)(ws + WS_QKV); bf16* gates = (bf16*)(ws + WS_GATES); bf16* oabc = (bf16*)(ws + WS_OABC); bf16* og = (bf16*)(ws + WS_OG);
    float* lse = (float*)(ws + WS_LSE); Rec* rec = (Rec*)(ws + WS_REC); int* rowtok = (int*)(ws + WS_ROWTOK); float* rowgate = (float*)(ws + WS_ROWGATE);
    bf16* merged = (bf16*)(ws + WS_MERGED); bf16* hid = (bf16*)(ws + WS_HID); bf16* yb = (bf16*)(ws + WS_YB); int* cnt = (int*)(ws + WS_CTL) + CW_CNT;
    (void)hipMemsetAsync(ws + WS_CTL, 0, CTL_ZERO_BYTES, stream);
    Args a{};
    for (int i = 0; i < 23; ++i) a.in[i] = (const float*)d_in[i];
    a.out = h; a.ws = ws;
    if (ONE_LAUNCH) { a.s_lo = 0; a.s_hi = NSTEPS; hipLaunchKernelGGL(mk_fwd, dim3(grid), dim3(NTHREADS), LDS_BYTES, stream, a); return; }
    const int G = 2048;
    const bool fastp1 = (FAST_MASK >> 1) & 1;
    for (int s = 0; s < NSTEPS; ++s) {
        int kind, l = 0, c = 0;
        if (s == 0) kind = 0; else { const int r = (s - 1) % 16; l = (s - 1) / 16; if (r < 12) { c = r / 6; kind = 1 + r % 6; } else kind = 7 + (r - 12); }
        if ((FAST_MASK >> kind) & 1) { a.s_lo = s; a.s_hi = s + 1;
#ifdef DUP_KIND
            if (kind == DUP_KIND && (kind == 5 || kind == 6 || kind == 10 || (kind == 1 && DUP_NOEPI))) { a.probe = 1; hipLaunchKernelGGL(mk_fwd, dim3(grid), dim3(NTHREADS), LDS_BYTES, stream, a); a.probe = 0; }
#endif
            hipLaunchKernelGGL(mk_fwd, dim3(grid), dim3(NTHREADS), LDS_BYTES, stream, a);
#ifdef DUP_KIND
            if (kind == DUP_KIND && !(kind == 5 || kind == 6 || kind == 10 || (kind == 1 && DUP_NOEPI))) { hipLaunchKernelGGL(mk_fwd, dim3(grid), dim3(NTHREADS), LDS_BYTES, stream, a); }
#endif
            continue; }
        const size_t r0 = (size_t)c * CH;
        switch (kind) {
        case 0: k_ln<<<G, 256, 0, stream>>>(0, x, h, hb, nullptr, ln0_g, ln0_b, 0, T); break;
        case 1: k_p1<<<G, 256, 0, stream>>>(hb + r0 * D, w_in + (size_t)l * D * NCOL, b_gate + (size_t)l * GATEW, qkv, gates); break;
        case 2: k_attn_naive<<<(28 * CH + 255) / 256, 256, 0, stream>>>(qkv, oabc, og, lse, rel_bias, sink_a + l * 8, rpb_c + (size_t)l * 8 * 15 * 31, fastp1 ? LN2 : 0.125f); break;
        case 3: k_combine<<<(CH * 32 + 255) / 256, 256, 0, stream>>>(og, lse, oabc); break;
        case 4: k_p3<<<G, 256, 0, stream>>>(oabc, gates, w_br_a + (size_t)l * 512 * D, w_br_b + (size_t)l * 256 * D, w_br_c + (size_t)l * 512 * D, merged); break;
        case 5: k_p4<<<G, 256, 0, stream>>>(merged, w_out + (size_t)l * D * D, h + r0 * D); break;
        case 6: k_ln<<<G, 256, 0, stream>>>(1, nullptr, h, hb, nullptr, ln1_g + l * D, ln1_b + l * D, (int)r0, CH);
                if (c == NCHUNK - 1) k_router<<<G, 256, 0, stream>>>(h, w_rg + (size_t)l * D * 4, b_rg + l * 4, w_re + (size_t)l * 4 * D * 8, b_re + l * 32, cnt + l * (32 * CSTR), rec);
                break;
        case 7: (void)hipMemsetAsync(rowtok, 0xFF, (size_t)PROWS * 4, stream); k_dispatch<<<256, 256, 0, stream>>>(cnt + l * (32 * CSTR), rec, rowtok, rowgate); break;
        case 8: k_p7<<<G, 256, 0, stream>>>(hb, cnt + l * (32 * CSTR), rowtok, w_eg + (size_t)l * NE * D * DE, w_eu + (size_t)l * NE * D * DE, hid); break;
        case 9: k_p8<<<G, 256, 0, stream>>>(hid, cnt + l * (32 * CSTR), rowtok, rowgate, w_ed + (size_t)l * NE * DE * D, yb); break;
        case 10: k_ln<<<G, 256, 0, stream>>>(2, nullptr, h, (l == DEPTH - 1) ? nullptr : hb, yb, ln2_g + l * D, ln2_b + l * D, 0, T); break;
        }
    }
}
```

```cpp
#include <hip/hip_runtime.h>
#include <cstdio>
#include <cstdint>
#include <cmath>

typedef unsigned short bf16;
typedef short bf16x8 __attribute__((ext_vector_type(8)));
typedef float f32x16 __attribute__((ext_vector_type(16)));
typedef float f32x4 __attribute__((ext_vector_type(4)));

constexpr int D = 1024, L = 8192, NBATCH = 8, T = NBATCH * L, DEPTH = 2;
constexpr int NCOL = 7680, QKVW = 4608, GATEW = 3072;
constexpr int CH = 32768, NCHUNK = T / CH;
constexpr int OW = 1280;
constexpr int NE = 32, DE = 512;
constexpr int MAXRT = T * 2 / 256 + NE, PROWS = MAXRT * 256;
constexpr float LN_EPS = 1e-5f;
constexpr float ALPHA = 1.41421356237309515f;
constexpr int AQ = 0, AK = 512, AV = 640, BQ0 = 768, CQ = 3072, CK = 3584, CV = 4096;

constexpr size_t MiB = 1u << 20;
constexpr size_t WS_CTL = 0;
constexpr size_t WS_WIN = 1 * MiB, WS_WBRA = 31 * MiB, WS_WBRB = 33 * MiB, WS_WBRC = 34 * MiB, WS_WOUT = 36 * MiB, WS_WGU = 40 * MiB, WS_WD = 168 * MiB;
constexpr size_t WS_HB = 232 * MiB, WS_QKV = 360 * MiB, WS_GATES = 648 * MiB, WS_OABC = 840 * MiB, WS_OG = 920 * MiB, WS_LSE = 968 * MiB,
                 WS_REC = 970 * MiB, WS_ROWTOK = 972 * MiB, WS_ROWGATE = 973 * MiB, WS_TABA = 974 * MiB, WS_TABB = WS_TABA + 16384, WS_TABC = WS_TABA + 32768, WS_WGCNT = WS_TABA + 131072  , WS_END = 975 * MiB;
constexpr size_t WS_MERGED = WS_QKV, WS_HID = WS_QKV, WS_YB = WS_QKV + 136 * MiB;
constexpr int CSTR = 32;

__device__ __constant__ signed char BUCK_A[257] = {12,11,11,11,11,11,11,11,11,11,11,11,11,11,11,11,11,11,11,11,11,11,11,11,11,11,11,11,11,11,11,11,11,11,11,11,11,11,11,11,11,11,11,11,11,11,11,11,11,11,11,11,11,11,11,11,11,11,11,11,11,11,11,11,11,10,10,10,10,10,10,10,10,10,10,10,10,10,10,10,10,10,10,10,10,10,10,10,10,10,10,10,10,10,10,10,10,9,9,9,9,9,9,9,9,9,9,9,9,9,9,9,9,8,8,8,8,8,8,8,8,7,6,5,4,3,2,1,0,17,18,19,20,21,22,23,24,24,24,24,24,24,24,24,25,25,25,25,25,25,25,25,25,25,25,25,25,25,25,25,26,26,26,26,26,26,26,26,26,26,26,26,26,26,26,26,26,26,26,26,26,26,26,26,26,26,26,26,26,26,26,26,27,27,27,27,27,27,27,27,27,27,27,27,27,27,27,27,27,27,27,27,27,27,27,27,27,27,27,27,27,27,27,27,27,27,27,27,27,27,27,27,27,27,27,27,27,27,27,27,27,27,27,27,27,27,27,27,27,27,27,27,27,27,27,27,28};
__device__ __constant__ signed char BUCK_B[3][129] = {
 {11,10,10,10,10,10,10,10,10,10,10,10,10,10,10,10,10,10,10,10,10,10,10,10,10,10,10,10,10,10,10,10,10,9,9,9,9,9,9,9,9,9,9,9,9,9,9,9,9,8,8,8,8,8,8,8,8,7,6,5,4,3,2,1,0,17,18,19,20,21,22,23,24,24,24,24,24,24,24,24,25,25,25,25,25,25,25,25,25,25,25,25,25,25,25,25,26,26,26,26,26,26,26,26,26,26,26,26,26,26,26,26,26,26,26,26,26,26,26,26,26,26,26,26,26,26,26,26,27},
 {13,12,12,12,12,12,12,12,12,12,12,12,12,12,12,12,12,12,12,12,12,12,12,12,12,12,12,12,12,12,12,12,12,11,11,11,11,11,11,11,11,11,11,11,11,11,11,11,11,10,10,10,10,10,10,10,10,9,9,9,9,8,8,4,0,20,24,24,25,25,25,25,26,26,26,26,26,26,26,26,27,27,27,27,27,27,27,27,27,27,27,27,27,27,27,27,28,28,28,28,28,28,28,28,28,28,28,28,28,28,28,28,28,28,28,28,28,28,28,28,28,28,28,28,28,28,28,28,29},
 {15,14,14,14,14,14,14,14,14,14,14,14,14,14,14,14,14,14,14,14,14,14,14,14,14,14,14,14,14,14,14,14,14,13,13,13,13,13,13,13,13,13,13,13,13,13,13,13,13,12,12,12,12,12,12,12,12,11,11,11,11,10,10,9,0,25,26,26,27,27,27,27,28,28,28,28,28,28,28,28,29,29,29,29,29,29,29,29,29,29,29,29,29,29,29,29,30,30,30,30,30,30,30,30,30,30,30,30,30,30,30,30,30,30,30,30,30,30,30,30,30,30,30,30,30,30,30,30,31}};

__device__ __forceinline__ float bf2f(bf16 b) { return __uint_as_float(((unsigned)b) << 16); }
__device__ __forceinline__ bf16 f2bf(float f) { unsigned u = __float_as_uint(f); u += 0x7fffu + ((u >> 16) & 1u); return (bf16)(u >> 16); }
__device__ __forceinline__ float wave_sum(float v) {
#pragma unroll
    for (int o = 1; o < 64; o <<= 1) v += __shfl_xor(v, o);
    return v;
}

struct Rec { int e0, s0, e1, s1; float g0, g1; int pad0, pad1; };

#ifndef PG8_ALIGN
#define PG8_ALIGN 1
#endif
namespace pg8 {
#define PG8_LAS __attribute__((address_space(3)))
typedef unsigned short bf16_t;
typedef unsigned u32x4 __attribute__((ext_vector_type(4)));
constexpr int BM = 256, BK = 64, HALF = 128, HTB = HALF * BK * 2  , STAGE_BYTES = 8 * HTB, NXCD = 8, WGM = 4;

__host__ __device__ __forceinline__ int lds_byte(int r, int c) { const int st = (r >> 4) * 2 + (c >> 5), rr = r & 15, cc = c & 31, ob = rr * 64 + cc * 2; return st * 1024 + (ob ^ (((ob >> 9) & 1) << 5)); }
__host__ __device__ __forceinline__ void stage_rc(int b, int& R, int& C) { const int st = b / 1024, sb = b % 1024, swz = sb ^ (((sb >> 9) & 1) << 5); R = (st >> 1) * 16 + swz / 64; C = (st & 1) * 32 + (swz % 64) / 2; }
__host__ __device__ __forceinline__ int perm32(int rho) { const int n = rho >> 4, i = rho & 15; return 8 * (i >> 2) + 4 * n + (i & 3); }

struct Unit { int pm, pn, e, ui; };

struct DenseOrder {
    int nM, nN, nwg, G, c; const char* A; const char* B; size_t tstepA, tstepB;
    __device__ void init(const void* A_, int lda, const void* B_, int ldb, int M, int N, int G_, int c_) { nM = M / BM; nN = N / BM; nwg = nM * nN; G = G_; c = c_; A = (const char*)A_; B = (const char*)B_; tstepA = (size_t)BM * lda * 2; tstepB = (size_t)BM * ldb * 2; }
    __device__ bool next(int i, Unit& u) const {
        const long Lx = (long)i * G + c; if (Lx >= nwg) return false;
        int wgid = (int)Lx; { const int q = nwg / NXCD, r = nwg % NXCD, xcd = wgid % NXCD, off = wgid / NXCD; wgid = (xcd < r ? xcd * (q + 1) : r * (q + 1) + (xcd - r) * q) + off; }
        const int nig = WGM * nN, gid = wgid / nig, fm = gid * WGM, gsz = (nM - fm) < WGM ? (nM - fm) : WGM;
        u.pm = fm + ((wgid % nig) % gsz); u.pn = (wgid % nig) / gsz; u.e = 0; u.ui = i; return true;
    }
    __device__ __forceinline__ const char* a_base(const Unit& u) const { return A + (size_t)u.pm * tstepA; }
    __device__ __forceinline__ const char* b_base(const Unit& u) const { return B + (size_t)u.pn * tstepB; }
    __device__ __forceinline__ int a_row(const Unit&, int) const { return 0; }
};

__device__ __forceinline__ unsigned cvt_pk_bf16(float lo, float hi) { unsigned r; asm volatile("v_cvt_pk_bf16_f32 %0, %1, %2" : "=v"(r) : "v"(lo), "v"(hi)); return r; }

template <class Epi, class Sched, bool GATHER>
__device__ __forceinline__ void gemm_phase(PG8_LAS unsigned char* lds, const Sched& S, const Epi& E, const int K, const int lda, const int ldb, const int tid_in) {
    int tid = tid_in; asm volatile("" : "+v"(tid));
    const int wid = __builtin_amdgcn_readfirstlane(tid >> 6), lane = tid & 63, wr = wid >> 2, wc = wid & 3, fr = lane & 15, fq = lane >> 4;
    const int nt = K / BK;
    int RA[2], CA[2]; unsigned voffB[2];
#pragma unroll
    for (int i = 0; i < 2; ++i) { int R, C; stage_rc(tid * 16 + i * 8192, R, C); const int Rb = Epi::PERM ? ((R & ~31) + perm32(R & 31)) : R; RA[i] = R; CA[i] = C; voffB[i] = (unsigned)(Rb * ldb + C) * 2u; }
    const size_t kstep = (size_t)(BK * 2);
    const size_t hstepB = (size_t)HALF * ldb * 2;
    const unsigned ldsw = (unsigned)wid * 1024u;
    const int aoff = lds_byte(wr * 64 + fr, fq * 8), boff = lds_byte(wc * 32 + fr, fq * 8);
#define PG8_SA(b, h) (((b) * 2 + (h)) * HTB)
#define PG8_SB(b, h) ((4 + (b) * 2 + (h)) * HTB)
#define PG8_STAGE2(bufoff, gbase, v0, v1) do { \
        __builtin_amdgcn_global_load_lds((const unsigned*)((const char*)(gbase) + (v0)), (PG8_LAS unsigned*)(lds + (bufoff) + ldsw), 16, 0, 0); \
        __builtin_amdgcn_global_load_lds((const unsigned*)((const char*)(gbase) + (v1)), (PG8_LAS unsigned*)(lds + (bufoff) + ldsw + 8192), 16, 0, 0); } while (0)
#define PG8_STAGEB(bufoff, gbase) PG8_STAGE2(bufoff, gbase, voffB[0], voffB[1])
#define PG8_LDA(dst, b, h) do { _Pragma("unroll") for (int m = 0; m < 4; ++m) _Pragma("unroll") for (int k = 0; k < 2; ++k) dst[m][k] = *(const PG8_LAS bf16x8*)(lds + PG8_SA(b, h) + aoff + m * 2048 + k * 1024); } while (0)
#define PG8_LDB(dst, b, h) do { _Pragma("unroll") for (int n = 0; n < 2; ++n) _Pragma("unroll") for (int k = 0; k < 2; ++k) dst[n][k] = *(const PG8_LAS bf16x8*)(lds + PG8_SB(b, h) + boff + n * 2048 + k * 1024); } while (0)
#define PG8_MMA(ai, bj, At, Bt) do { __builtin_amdgcn_s_setprio(1); _Pragma("unroll") for (int m = 0; m < 4; ++m) _Pragma("unroll") for (int n = 0; n < 2; ++n) _Pragma("unroll") for (int k = 0; k < 2; ++k) \
        acc[ai][bj][m][n] = __builtin_amdgcn_mfma_f32_16x16x32_bf16(Bt[n][k], At[m][k], acc[ai][bj][m][n], 0, 0, 0); __builtin_amdgcn_s_setprio(0); } while (0)
#define PG8_WAIT_V(n) asm volatile("s_waitcnt vmcnt(" #n ")" ::: "memory")
#define PG8_WAIT_L(n) asm volatile("s_waitcnt lgkmcnt(" #n ")" ::: "memory")
#define PG8_BAR __builtin_amdgcn_s_barrier()
#define PG8_SCHED __builtin_amdgcn_sched_barrier(0)
#define PG8_VOFFA(dst, u) do { _Pragma("unroll") for (int h_ = 0; h_ < 2; ++h_) _Pragma("unroll") for (int i_ = 0; i_ < 2; ++i_) { \
        const int row_ = GATHER ? S.a_row(u, h_ * HALF + RA[i_]) : (h_ * HALF + RA[i_]); dst[h_][i_] = (unsigned)(row_ * lda + CA[i_]) * 2u; } } while (0)
    Unit cur, nxt;
    if (!S.next(0, cur)) return;
    f32x4 acc[2][2][4][2];
#pragma unroll
    for (int a = 0; a < 2; ++a)
#pragma unroll
        for (int b = 0; b < 2; ++b)
#pragma unroll
            for (int m = 0; m < 4; ++m)
#pragma unroll
                for (int n = 0; n < 2; ++n) acc[a][b][m][n] = (f32x4){0.f, 0.f, 0.f, 0.f};
    bf16x8 At[4][2], B0[2][2], B1[2][2];
    unsigned vc[2][2], vn[2][2];
    PG8_VOFFA(vc, cur);
    const char* cA = S.a_base(cur); const char* cB = S.b_base(cur);
    PG8_STAGEB(PG8_SB(0, 0), cB); PG8_STAGEB(PG8_SB(0, 1), cB + hstepB); PG8_STAGE2(PG8_SA(0, 0), cA, vc[0][0], vc[0][1]); PG8_STAGE2(PG8_SA(0, 1), cA, vc[1][0], vc[1][1]);
    if (wr == 1) PG8_BAR;
    PG8_WAIT_V(2); PG8_BAR;
    PG8_STAGEB(PG8_SB(1, 0), cB + kstep); PG8_STAGE2(PG8_SA(1, 0), cA + kstep, vc[0][0], vc[0][1]); PG8_STAGEB(PG8_SB(1, 1), cB + hstepB + kstep);
    PG8_WAIT_V(6); PG8_BAR;
    int ui = 0;
    for (;;) {
        const bool has_next = S.next(ui + 1, nxt);
        const char* nA = has_next ? S.a_base(nxt) : cA; const char* nB = has_next ? S.b_base(nxt) : cB;
        if (GATHER) { if (has_next) { PG8_VOFFA(vn, nxt); } else {
#pragma unroll
            for (int h_ = 0; h_ < 2; ++h_) { vn[h_][0] = vc[h_][0]; vn[h_][1] = vc[h_][1]; } } }
        for (int t = 0; t < nt; t += 2) {
            const bool last = (t == nt - 2);
            const char* a1 = cA + (size_t)(t + 1) * kstep;
            const char* a2 = last ? nA : cA + (size_t)(t + 2) * kstep; const char* b2 = last ? nB : cB + (size_t)(t + 2) * kstep;
            const char* a3 = a2 + kstep; const char* b3 = b2 + kstep;
            unsigned w00, w01, w10, w11;
            if (GATHER) { w00 = last ? vn[0][0] : vc[0][0]; w01 = last ? vn[0][1] : vc[0][1]; w10 = last ? vn[1][0] : vc[1][0]; w11 = last ? vn[1][1] : vc[1][1]; }
            else { w00 = vc[0][0]; w01 = vc[0][1]; w10 = vc[1][0]; w11 = vc[1][1]; }
            PG8_LDB(B0, 0, 0); PG8_LDB(B1, 0, 1); PG8_SCHED; PG8_LDA(At, 0, 0); PG8_STAGE2(PG8_SA(1, 1), a1, vc[1][0], vc[1][1]);
            PG8_WAIT_V(8); PG8_WAIT_L(0); PG8_BAR; PG8_MMA(0, 0, At, B0); PG8_MMA(0, 1, At, B1); PG8_BAR; PG8_SCHED;
            PG8_LDA(At, 0, 1); PG8_STAGEB(PG8_SB(0, 0), b2); PG8_STAGEB(PG8_SB(0, 1), b2 + hstepB); PG8_STAGE2(PG8_SA(0, 0), a2, w00, w01);
            PG8_WAIT_V(8); PG8_WAIT_L(0); PG8_BAR; PG8_MMA(1, 0, At, B0); PG8_MMA(1, 1, At, B1); PG8_BAR; PG8_SCHED;
            PG8_LDB(B0, 1, 0); PG8_LDB(B1, 1, 1); PG8_SCHED; PG8_LDA(At, 1, 0); PG8_STAGE2(PG8_SA(0, 1), a2, w10, w11);
            PG8_WAIT_V(8); PG8_WAIT_L(0); PG8_BAR; PG8_MMA(0, 0, At, B0); PG8_MMA(0, 1, At, B1); PG8_BAR; PG8_SCHED;
            PG8_LDA(At, 1, 1); PG8_STAGEB(PG8_SB(1, 0), b3); PG8_STAGEB(PG8_SB(1, 1), b3 + hstepB); PG8_STAGE2(PG8_SA(1, 0), a3, w00, w01);
            PG8_WAIT_V(8); PG8_WAIT_L(0); PG8_BAR; PG8_MMA(1, 0, At, B0); PG8_MMA(1, 1, At, B1); PG8_BAR; PG8_SCHED;
        }
        if (PG8_ALIGN && wr == 0) PG8_BAR;
        E(acc, cur, wr, wc, fr, fq);
        if (!has_next) break;
#pragma unroll
        for (int a = 0; a < 2; ++a)
#pragma unroll
            for (int b = 0; b < 2; ++b)
#pragma unroll
                for (int m = 0; m < 4; ++m)
#pragma unroll
                    for (int n = 0; n < 2; ++n) acc[a][b][m][n] = (f32x4){0.f, 0.f, 0.f, 0.f};
        cur = nxt; cA = nA; cB = nB; ++ui;
        if (GATHER) {
#pragma unroll
            for (int h_ = 0; h_ < 2; ++h_) { vc[h_][0] = vn[h_][0]; vc[h_][1] = vn[h_][1]; } }
        if (PG8_ALIGN && wr == 1) PG8_BAR;
    }
    PG8_WAIT_V(0);
    if (!PG8_ALIGN && wr == 0) PG8_BAR;
    PG8_BAR;
#undef PG8_SA
#undef PG8_SB
#undef PG8_STAGE2
#undef PG8_STAGEB
#undef PG8_LDA
#undef PG8_LDB
#undef PG8_MMA
#undef PG8_WAIT_V
#undef PG8_WAIT_L
#undef PG8_BAR
#undef PG8_SCHED
#undef PG8_VOFFA
}
template <class Epi, class Sched>
__device__ __forceinline__ void gemm_phase_vk(PG8_LAS unsigned char* lds, const Sched& S, const Epi& E, const int lda, const int tid_in) {
    constexpr bool GATHER = false;
    int tid = tid_in; asm volatile("" : "+v"(tid));
    const int wid = __builtin_amdgcn_readfirstlane(tid >> 6), lane = tid & 63, wr = wid >> 2, wc = wid & 3, fr = lane & 15, fq = lane >> 4;
    int RA[2], CA[2], RB[2];
#pragma unroll
    for (int i = 0; i < 2; ++i) { int R, C; stage_rc(tid * 16 + i * 8192, R, C); const int Rb = Epi::PERM ? ((R & ~31) + perm32(R & 31)) : R; RA[i] = R; CA[i] = C; RB[i] = Rb; }
    const size_t kstep = (size_t)(BK * 2);
    const unsigned ldsw = (unsigned)wid * 1024u;
    const int aoff = lds_byte(wr * 64 + fr, fq * 8), boff = lds_byte(wc * 32 + fr, fq * 8);
#define PG8_SA(b, h) (((b) * 2 + (h)) * HTB)
#define PG8_SB(b, h) ((4 + (b) * 2 + (h)) * HTB)
#define PG8_STAGE2(bufoff, gbase, v0, v1) do { \
        __builtin_amdgcn_global_load_lds((const unsigned*)((const char*)(gbase) + (v0)), (PG8_LAS unsigned*)(lds + (bufoff) + ldsw), 16, 0, 0); \
        __builtin_amdgcn_global_load_lds((const unsigned*)((const char*)(gbase) + (v1)), (PG8_LAS unsigned*)(lds + (bufoff) + ldsw + 8192), 16, 0, 0); } while (0)
#define PG8_VOFFB(dst, hs, u) do { const int ldb_ = S.ldb_of(u); _Pragma("unroll") for (int i_ = 0; i_ < 2; ++i_) { int R_, C_; stage_rc(tid * 16 + i_ * 8192, R_, C_); const int Rb_ = Epi::PERM ? ((R_ & ~31) + perm32(R_ & 31)) : R_; dst[i_] = (unsigned)(Rb_ * ldb_ + C_) * 2u; } hs = (size_t)HALF * ldb_ * 2; } while (0)
#define PG8_LDA(dst, b, h) do { _Pragma("unroll") for (int m = 0; m < 4; ++m) _Pragma("unroll") for (int k = 0; k < 2; ++k) dst[m][k] = *(const PG8_LAS bf16x8*)(lds + PG8_SA(b, h) + aoff + m * 2048 + k * 1024); } while (0)
#define PG8_LDB(dst, b, h) do { _Pragma("unroll") for (int n = 0; n < 2; ++n) _Pragma("unroll") for (int k = 0; k < 2; ++k) dst[n][k] = *(const PG8_LAS bf16x8*)(lds + PG8_SB(b, h) + boff + n * 2048 + k * 1024); } while (0)
#define PG8_MMA(ai, bj, At, Bt) do { __builtin_amdgcn_s_setprio(1); _Pragma("unroll") for (int m = 0; m < 4; ++m) _Pragma("unroll") for (int n = 0; n < 2; ++n) _Pragma("unroll") for (int k = 0; k < 2; ++k) \
        acc[ai][bj][m][n] = __builtin_amdgcn_mfma_f32_16x16x32_bf16(Bt[n][k], At[m][k], acc[ai][bj][m][n], 0, 0, 0); __builtin_amdgcn_s_setprio(0); } while (0)
#define PG8_WAIT_V(n) asm volatile("s_waitcnt vmcnt(" #n ")" ::: "memory")
#define PG8_WAIT_L(n) asm volatile("s_waitcnt lgkmcnt(" #n ")" ::: "memory")
#define PG8_BAR __builtin_amdgcn_s_barrier()
#define PG8_SCHED __builtin_amdgcn_sched_barrier(0)
#define PG8_VOFFA(dst, u) do { _Pragma("unroll") for (int h_ = 0; h_ < 2; ++h_) _Pragma("unroll") for (int i_ = 0; i_ < 2; ++i_) { \
        const int row_ = GATHER ? S.a_row(u, h_ * HALF + RA[i_]) : (h_ * HALF + RA[i_]); dst[h_][i_] = (unsigned)(row_ * lda + CA[i_]) * 2u; } } while (0)
    Unit cur, nxt;
    if (!S.next(0, cur)) return;
    f32x4 acc[2][2][4][2];
#pragma unroll
    for (int a = 0; a < 2; ++a)
#pragma unroll
        for (int b = 0; b < 2; ++b)
#pragma unroll
            for (int m = 0; m < 4; ++m)
#pragma unroll
                for (int n = 0; n < 2; ++n) acc[a][b][m][n] = (f32x4){0.f, 0.f, 0.f, 0.f};
    bf16x8 At[4][2], B0[2][2], B1[2][2];
    unsigned vc[2][2], vn[2][2];
    PG8_VOFFA(vc, cur);
    unsigned vbc[2], vbn[2]; size_t hsc, hsn; PG8_VOFFB(vbc, hsc, cur); int nt = S.K_of(cur) / BK;
    const char* cA = S.a_base(cur); const char* cB = S.b_base(cur);
    PG8_STAGE2(PG8_SB(0, 0), cB, vbc[0], vbc[1]); PG8_STAGE2(PG8_SB(0, 1), cB + hsc, vbc[0], vbc[1]); PG8_STAGE2(PG8_SA(0, 0), cA, vc[0][0], vc[0][1]); PG8_STAGE2(PG8_SA(0, 1), cA, vc[1][0], vc[1][1]);
    if (wr == 1) PG8_BAR;
    PG8_WAIT_V(2); PG8_BAR;
    PG8_STAGE2(PG8_SB(1, 0), cB + kstep, vbc[0], vbc[1]); PG8_STAGE2(PG8_SA(1, 0), cA + kstep, vc[0][0], vc[0][1]); PG8_STAGE2(PG8_SB(1, 1), cB + hsc + kstep, vbc[0], vbc[1]);
    PG8_WAIT_V(6); PG8_BAR;
    int ui = 0;
    for (;;) {
        const bool has_next = S.next(ui + 1, nxt);
        const char* nA = has_next ? S.a_base(nxt) : cA; const char* nB = has_next ? S.b_base(nxt) : cB;
        if (has_next) { PG8_VOFFB(vbn, hsn, nxt); } else { vbn[0] = vbc[0]; vbn[1] = vbc[1]; hsn = hsc; }
        if (GATHER) { if (has_next) { PG8_VOFFA(vn, nxt); } else {
#pragma unroll
            for (int h_ = 0; h_ < 2; ++h_) { vn[h_][0] = vc[h_][0]; vn[h_][1] = vc[h_][1]; } } }
        for (int t = 0; t < nt; t += 2) {
            const bool last = (t == nt - 2);
            const char* a1 = cA + (size_t)(t + 1) * kstep;
            const char* a2 = last ? nA : cA + (size_t)(t + 2) * kstep; const char* b2 = last ? nB : cB + (size_t)(t + 2) * kstep;
            const char* a3 = a2 + kstep; const char* b3 = b2 + kstep;
            unsigned w00, w01, w10, w11;
            if (GATHER) { w00 = last ? vn[0][0] : vc[0][0]; w01 = last ? vn[0][1] : vc[0][1]; w10 = last ? vn[1][0] : vc[1][0]; w11 = last ? vn[1][1] : vc[1][1]; }
            else { w00 = vc[0][0]; w01 = vc[0][1]; w10 = vc[1][0]; w11 = vc[1][1]; }
            const unsigned wb0 = last ? vbn[0] : vbc[0], wb1 = last ? vbn[1] : vbc[1]; const size_t hsb = last ? hsn : hsc;
            PG8_LDB(B0, 0, 0); PG8_LDB(B1, 0, 1); PG8_SCHED; PG8_LDA(At, 0, 0); PG8_STAGE2(PG8_SA(1, 1), a1, vc[1][0], vc[1][1]);
            PG8_WAIT_V(8); PG8_WAIT_L(0); PG8_BAR; PG8_MMA(0, 0, At, B0); PG8_MMA(0, 1, At, B1); PG8_BAR; PG8_SCHED;
            PG8_LDA(At, 0, 1); PG8_STAGE2(PG8_SB(0, 0), b2, wb0, wb1); PG8_STAGE2(PG8_SB(0, 1), b2 + hsb, wb0, wb1); PG8_STAGE2(PG8_SA(0, 0), a2, w00, w01);
            PG8_WAIT_V(8); PG8_WAIT_L(0); PG8_BAR; PG8_MMA(1, 0, At, B0); PG8_MMA(1, 1, At, B1); PG8_BAR; PG8_SCHED;
            PG8_LDB(B0, 1, 0); PG8_LDB(B1, 1, 1); PG8_SCHED; PG8_LDA(At, 1, 0); PG8_STAGE2(PG8_SA(0, 1), a2, w10, w11);
            PG8_WAIT_V(8); PG8_WAIT_L(0); PG8_BAR; PG8_MMA(0, 0, At, B0); PG8_MMA(0, 1, At, B1); PG8_BAR; PG8_SCHED;
            PG8_LDA(At, 1, 1); PG8_STAGE2(PG8_SB(1, 0), b3, wb0, wb1); PG8_STAGE2(PG8_SB(1, 1), b3 + hsb, wb0, wb1); PG8_STAGE2(PG8_SA(1, 0), a3, w00, w01);
            PG8_WAIT_V(8); PG8_WAIT_L(0); PG8_BAR; PG8_MMA(1, 0, At, B0); PG8_MMA(1, 1, At, B1); PG8_BAR; PG8_SCHED;
        }
        if (PG8_ALIGN && wr == 0) PG8_BAR;
        E(acc, cur, wr, wc, fr, fq);
        if (!has_next) break;
#pragma unroll
        for (int a = 0; a < 2; ++a)
#pragma unroll
            for (int b = 0; b < 2; ++b)
#pragma unroll
                for (int m = 0; m < 4; ++m)
#pragma unroll
                    for (int n = 0; n < 2; ++n) acc[a][b][m][n] = (f32x4){0.f, 0.f, 0.f, 0.f};
        cur = nxt; cA = nA; cB = nB; ++ui; vbc[0] = vbn[0]; vbc[1] = vbn[1]; hsc = hsn; nt = S.K_of(cur) / BK;
        if (GATHER) {
#pragma unroll
            for (int h_ = 0; h_ < 2; ++h_) { vc[h_][0] = vn[h_][0]; vc[h_][1] = vn[h_][1]; } }
        if (PG8_ALIGN && wr == 1) PG8_BAR;
    }
    PG8_WAIT_V(0);
    if (!PG8_ALIGN && wr == 0) PG8_BAR;
    PG8_BAR;
#undef PG8_SA
#undef PG8_SB
#undef PG8_STAGE2
#undef PG8_VOFFB
#undef PG8_LDA
#undef PG8_LDB
#undef PG8_MMA
#undef PG8_WAIT_V
#undef PG8_WAIT_L
#undef PG8_BAR
#undef PG8_SCHED
#undef PG8_VOFFA
}
}

constexpr int NWAVES = 8, NTHREADS = 512;
constexpr int RING_OFF = 0, RING_BYTES = 131072, ROWS_OFF = 131072, ROWS_BYTES = 12288, ROUTER_BYTES = 147456  , MISC_OFF = ROUTER_BYTES, LCNT_OFF = MISC_OFF + 128  , LDS_BYTES = 148480;
static_assert(MISC_OFF + 128 <= LDS_BYTES, "LDS map");
constexpr int CW_CNT = 0;
constexpr int CW_BAR = 4096;
constexpr size_t CTL_ZERO_BYTES = 64 * 1024;
constexpr float LOG2E = 1.4426950408889634f, LN2 = 0.6931471805599453f;
constexpr float QSCALE = 0.125f * LOG2E;

#define GAS __attribute__((address_space(1)))
#define LAS __attribute__((address_space(3)))
typedef unsigned v4u __attribute__((ext_vector_type(4)));
typedef unsigned v2u __attribute__((ext_vector_type(2)));
#define LDS_WAIT() asm volatile("s_waitcnt lgkmcnt(0)" ::: "memory")
__device__ __forceinline__ unsigned pk2(float lo, float hi) { return (unsigned)f2bf(lo) | ((unsigned)f2bf(hi) << 16); }

#define XB_TMO      128
#define XB_XCNT(j)  (256  + 64 * (j))
#define XB_XSUB(j)  (1280 + 64 * (j))
#define XB_XGEN(j)  (2304 + 64 * (j))
#define XB_TOP      3328
#define XB_TOPGEN   3392
#define XCD_BAR_WORDS 3456
#define XB_SPIN_CAP (1u << 18)

__device__ __forceinline__ unsigned xb_ld(unsigned* p)              { return __hip_atomic_load(p, __ATOMIC_RELAXED, __HIP_MEMORY_SCOPE_AGENT); }
__device__ __forceinline__ unsigned xb_add(unsigned* p, unsigned v) { return __hip_atomic_fetch_add(p, v, __ATOMIC_RELAXED, __HIP_MEMORY_SCOPE_AGENT); }
__device__ __forceinline__ unsigned xb_xcc_id() { return (unsigned)__builtin_amdgcn_s_getreg((3 << 11) | 20) & 0xFu; }
#define XB_SPIN(cond, bar) do { unsigned _sp = 0; while (cond) { __builtin_amdgcn_s_sleep(1); \
    if ((++_sp & 255u) == 0u) { if (xb_ld(&(bar)[XB_TMO])) break; if (_sp > XB_SPIN_CAP) { atomicAdd(&(bar)[XB_TMO], 1u); break; } } } } while (0)

struct XcdBarrier {
    int wave0;
    unsigned* bar; unsigned x;
    volatile LAS unsigned* st;
};

__device__ __forceinline__ unsigned xb_lane() { unsigned l_; asm volatile("v_mbcnt_lo_u32_b32 %0, -1, 0\n\tv_mbcnt_hi_u32_b32 %0, -1, %0" : "=v"(l_)); return l_; }
__device__ __forceinline__ XcdBarrier xcd_barrier_post(unsigned* bar, volatile LAS unsigned* st, int wave0) {
    XcdBarrier b; b.wave0 = wave0; b.bar = bar; b.x = xb_xcc_id(); b.st = st;
    if (b.wave0 && xb_lane() == 0u) (void)xb_add(&bar[XB_XCNT(b.x)], 1u);
    return b;
}
__device__ __forceinline__ void xcd_barrier_complete(unsigned* bar, unsigned x, unsigned& nloc, unsigned& nx) {
    const unsigned G = gridDim.x * gridDim.y * gridDim.z;
    unsigned sum, cnt, mine, sp = 0u;
    for (;;) {
        sum = 0u; cnt = 0u; mine = 0u;
#pragma unroll
        for (unsigned j = 0; j < 16; ++j) { const unsigned c = xb_ld(&bar[XB_XCNT(j)]); sum += c; cnt += (c > 0u) ? 1u : 0u; mine = (j == x) ? c : mine; }
        if (sum == G) break;
        __builtin_amdgcn_s_sleep(1);
        if ((++sp & 255u) == 0u) { if (xb_ld(&bar[XB_TMO])) break; if (sp > XB_SPIN_CAP) { atomicAdd(&bar[XB_TMO], 1u); break; } }
    }
    nloc = mine > 0u ? mine : 1u; nx = cnt > 0u ? cnt : 1u;
}

__device__ __forceinline__ void xcd_barrier(const XcdBarrier& b) {
    asm volatile("s_waitcnt vmcnt(0)" ::: "memory");
    __syncthreads();
    if (b.wave0 && xb_lane() == 0u) {
        unsigned* bar = b.bar;
        __builtin_amdgcn_s_waitcnt(0);
        unsigned nloc = b.st[0], nx = b.st[1];
        if (nloc == 0u) { xcd_barrier_complete(bar, b.x, nloc, nx); b.st[0] = nloc; b.st[1] = nx; }
        const unsigned old = xb_add(&bar[XB_XSUB(b.x)], 1u);
        const unsigned gen = old / nloc;
        if (old + 1u == (gen + 1u) * nloc) {
            __builtin_amdgcn_fence(__ATOMIC_RELEASE, "agent");
            asm volatile("s_waitcnt vmcnt(0)" ::: "memory");
            const unsigned og = xb_add(&bar[XB_TOP], 1u);
            const unsigned tg = og / nx;
            if (og + 1u == (tg + 1u) * nx) xb_add(&bar[XB_TOPGEN], 1u);
            else XB_SPIN(xb_ld(&bar[XB_TOPGEN]) == tg, bar);
            __builtin_amdgcn_fence(__ATOMIC_ACQUIRE, "agent");
            xb_add(&bar[XB_XGEN(b.x)], 1u);
            asm volatile("s_waitcnt vmcnt(0)" ::: "memory");
        } else {
            XB_SPIN(xb_ld(&bar[XB_XGEN(b.x)]) == gen, bar);
            __builtin_amdgcn_fence(__ATOMIC_ACQUIRE, "agent");
            asm volatile("s_waitcnt vmcnt(0)" ::: "memory");
        }
    }
    __syncthreads();
}


struct Args { const float* in[23]; float* out; unsigned char* ws; int s_lo, s_hi, probe, pad; };

struct Frame {
    LAS unsigned char* lds; int tid, lane, wave, vcu, G;
    const float* const* in; float* h; unsigned char* ws; int probe;
};

__device__ __forceinline__ int hw_lane() { int l_; asm volatile("v_mbcnt_lo_u32_b32 %0, -1, 0\n\tv_mbcnt_hi_u32_b32 %0, -1, %0" : "=v"(l_)); return l_; }
__device__ __forceinline__ float shfl_xor_l(float v, int mask, int lane) { return __builtin_bit_cast(float, __builtin_amdgcn_ds_bpermute((lane ^ mask) << 2, __builtin_bit_cast(int, v))); }
__device__ __forceinline__ float dpp_add(float v, const int ctrl_sel) {
    const int x = __builtin_bit_cast(int, v); int y;
    if (ctrl_sel == 0) y = __builtin_amdgcn_mov_dpp(x, 0xB1, 0xF, 0xF, true);
    else if (ctrl_sel == 1) y = __builtin_amdgcn_mov_dpp(x, 0x4E, 0xF, 0xF, true);
    else if (ctrl_sel == 2) y = __builtin_amdgcn_mov_dpp(x, 0x141, 0xF, 0xF, true);
    else y = __builtin_amdgcn_mov_dpp(x, 0x140, 0xF, 0xF, true);
    return v + __builtin_bit_cast(float, y);
}
__device__ __forceinline__ float wave_sum_l(float v, int lane) {
    (void)lane;
    v = dpp_add(v, 0); v = dpp_add(v, 1); v = dpp_add(v, 2); v = dpp_add(v, 3);
    const int x = __builtin_bit_cast(int, v);
    const float r0 = __builtin_bit_cast(float, __builtin_amdgcn_readlane(x, 0)), r1 = __builtin_bit_cast(float, __builtin_amdgcn_readlane(x, 16)),
                r2 = __builtin_bit_cast(float, __builtin_amdgcn_readlane(x, 32)), r3 = __builtin_bit_cast(float, __builtin_amdgcn_readlane(x, 48));
    return (r0 + r1) + (r2 + r3);
}
#define LAUNDER(F) do { (F).lane = hw_lane(); (F).tid = (F).wave * 64 + (F).lane; asm volatile("" : "+s"((F).G), "+s"((F).vcu), "+s"((F).ws), "+s"((F).h)); } while (0)
__device__ __forceinline__ void p0_item(const float* W, int ldw, int k0, int n0, bf16* WT, int Kd, int drow0, float scale, LAS float* scr, int lane) {
#pragma unroll 8
    for (int i = 0; i < 32; ++i) { const int kk = 2 * i + (lane >> 5); scr[kk * 33 + (lane & 31)] = W[(size_t)(k0 + kk) * ldw + n0 + (lane & 31)] * scale; }
    LDS_WAIT(); asm volatile("" ::: "memory");
    const int c = lane & 7;
#pragma unroll
    for (int j = 0; j < 4; ++j) { const int n = (lane >> 3) + 8 * j; const LAS float* s = scr + (8 * c) * 33 + n;
        v4u o; o.x = pk2(s[0 * 33], s[1 * 33]); o.y = pk2(s[2 * 33], s[3 * 33]); o.z = pk2(s[4 * 33], s[5 * 33]); o.w = pk2(s[6 * 33], s[7 * 33]);
        *(GAS v4u*)(WT + (size_t)(drow0 + n) * Kd + k0 + 8 * c) = o; }
    LDS_WAIT(); asm volatile("" ::: "memory");
}
__device__ __forceinline__ bool is_q_col(int n) { return n < 512 || (n >= 768 && n < 3072 && ((n - 768) % 768) < 256) || (n >= 3072 && n < 3584); }

__device__ __forceinline__ void ph_prologue(Frame& F) { LAUNDER(F);
    LAS float* scr = (LAS float*)(F.lds + RING_OFF + F.wave * 16384);
    const int gw = F.vcu * NWAVES + F.wave, NGW = F.G * NWAVES, lane = F.lane;
    const float* w_in = F.in[4]; const float* w_a = F.in[8]; const float* w_b = F.in[9]; const float* w_c = F.in[10]; const float* w_o = F.in[11];
    const float* w_eg = F.in[18]; const float* w_eu = F.in[19]; const float* w_ed = F.in[20];
    bf16* WIN = (bf16*)(F.ws + WS_WIN); bf16* WBRA = (bf16*)(F.ws + WS_WBRA); bf16* WBRB = (bf16*)(F.ws + WS_WBRB); bf16* WBRC = (bf16*)(F.ws + WS_WBRC); bf16* WOUT = (bf16*)(F.ws + WS_WOUT);
    bf16* WGU = (bf16*)(F.ws + WS_WGU); bf16* WD = (bf16*)(F.ws + WS_WD);
    constexpr int I_IN = 16 * (NCOL / 32), I_A = 8 * 32, I_B = 4 * 32, I_C = 8 * 32, I_O = 16 * 32, I_G = 16 * 16, I_D = 8 * 32;
    constexpr int I_LAYER = I_IN + I_A + I_B + I_C + I_O + NE * (2 * I_G + I_D);
    for (int it = gw; it < DEPTH * I_LAYER; it += NGW) {
        const int l = it / I_LAYER; int r = it % I_LAYER;
        if (r < I_IN) { const int nb = r % (NCOL / 32), kb = r / (NCOL / 32); p0_item(w_in + (size_t)l * D * NCOL, NCOL, 64 * kb, 32 * nb, WIN + (size_t)l * NCOL * D, D, 32 * nb, is_q_col(32 * nb) ? QSCALE : 1.0f, scr, lane); continue; } r -= I_IN;
        if (r < I_A) { const int nb = r % 32, kb = r / 32; p0_item(w_a + (size_t)l * 512 * D, D, 64 * kb, 32 * nb, WBRA + (size_t)l * D * 512, 512, 32 * nb, 1.0f, scr, lane); continue; } r -= I_A;
        if (r < I_B) { const int nb = r % 32, kb = r / 32; p0_item(w_b + (size_t)l * 256 * D, D, 64 * kb, 32 * nb, WBRB + (size_t)l * D * 256, 256, 32 * nb, 1.0f, scr, lane); continue; } r -= I_B;
        if (r < I_C) { const int nb = r % 32, kb = r / 32; p0_item(w_c + (size_t)l * 512 * D, D, 64 * kb, 32 * nb, WBRC + (size_t)l * D * 512, 512, 32 * nb, 1.0f, scr, lane); continue; } r -= I_C;
        if (r < I_O) { const int nb = r % 32, kb = r / 32; p0_item(w_o + (size_t)l * D * D, D, 64 * kb, 32 * nb, WOUT + (size_t)l * D * D, D, 32 * nb, 1.0f, scr, lane); continue; } r -= I_O;
        const int e = r / (2 * I_G + I_D); r %= (2 * I_G + I_D); const size_t le = (size_t)l * NE + e;
        if (r < 2 * I_G) { const int up = r / I_G; r %= I_G; const int nb = r % 16, kb = r / 16;
            p0_item((up ? w_eu : w_eg) + le * D * DE, DE, 64 * kb, 32 * nb, WGU + le * 1024 * 1024, D, (nb >> 2) * 256 + up * 128 + (nb & 3) * 32, 1.0f, scr, lane); continue; }
        r -= 2 * I_G; { const int nb = r % 32, kb = r / 32; p0_item(w_ed + le * DE * D, D, 64 * kb, 32 * nb, WD + le * D * DE, DE, 32 * nb, 1.0f, scr, lane); }
    }
}

struct LnIn { f32x4 v[4]; v2u a[4], b[4], hw[4]; };
template <int MODE> __device__ __forceinline__ void ln_load(LnIn& in, const float* src, const bf16* hsb, const bf16* yb, size_t row, int lane) {
#pragma unroll
    for (int j = 0; j < 4; ++j) {
        const int c = lane * 4 + 256 * j;
        if (MODE != 2) in.v[j] = *(const GAS f32x4*)(src + row * D + c);
        if (MODE == 2) { in.hw[j] = *(const GAS v2u*)(hsb + row * D + c); in.a[j] = *(const GAS v2u*)(yb + (row * 2) * D + c); in.b[j] = *(const GAS v2u*)(yb + (row * 2 + 1) * D + c); }
    }
}
template <int MODE> __device__ __forceinline__ void ln_finish(const LnIn& in, float* hout, bf16* hb, const float* g, const float* bta, size_t row, int lane, f32x4 (&o)[4]) {
    f32x4 v[4];
#pragma unroll
    for (int j = 0; j < 4; ++j) {
        if (MODE != 2) v[j] = in.v[j];
        if (MODE == 2) {
            const v2u a = in.a[j], b = in.b[j], hw = in.hw[j];
            v[j].x = ALPHA * __uint_as_float(hw.x << 16) + __uint_as_float(a.x << 16) + __uint_as_float(b.x << 16);
            v[j].y = ALPHA * __uint_as_float(hw.x & 0xffff0000u) + __uint_as_float(a.x & 0xffff0000u) + __uint_as_float(b.x & 0xffff0000u);
            v[j].z = ALPHA * __uint_as_float(hw.y << 16) + __uint_as_float(a.y << 16) + __uint_as_float(b.y << 16);
            v[j].w = ALPHA * __uint_as_float(hw.y & 0xffff0000u) + __uint_as_float(a.y & 0xffff0000u) + __uint_as_float(b.y & 0xffff0000u);
        }
    }
    float s = 0.f;
#pragma unroll
    for (int j = 0; j < 4; ++j) s += (v[j].x + v[j].y) + (v[j].z + v[j].w);
    const float mean = wave_sum_l(s, lane) * (1.f / D);
    float q = 0.f;
#pragma unroll
    for (int j = 0; j < 4; ++j) { v[j] = v[j] - mean; q += (v[j].x * v[j].x + v[j].y * v[j].y) + (v[j].z * v[j].z + v[j].w * v[j].w); }
    const float rstd = 1.0f / sqrtf(wave_sum_l(q, lane) * (1.f / D) + LN_EPS);
#pragma unroll
    for (int j = 0; j < 4; ++j) {
        const int c = lane * 4 + 256 * j;
        const f32x4 gg = *(const GAS f32x4*)(g + c), bb = *(const GAS f32x4*)(bta + c);
        o[j] = v[j] * rstd * gg + bb;
        if (hout) *(GAS f32x4*)(hout + row * D + c) = o[j];
        if (hb) { v2u w; w.x = pk2(o[j].x, o[j].y); w.y = pk2(o[j].z, o[j].w); *(GAS v2u*)(hb + row * D + c) = w; }
    }
}

#ifndef PROBE_EPI
#define PROBE_EPI 0
#endif
struct EpiP1 {
    static constexpr bool PERM = true;
    bf16* qkv; bf16* gates; const float* b_gate; int probe;
    __device__ __forceinline__ void operator()(const f32x4 (&acc)[2][2][4][2], const pg8::Unit& u, int wr, int wc, int fr, int fq) const {
        if (probe == 1 && PROBE_EPI == 0) return;
        const int row0 = (probe == 1 ? (int)(blockIdx.x & 127) : u.pm) * 256 + wr * 64 + fr; const bool isg = u.pn >= 18;
        bf16* base = isg ? gates : qkv; const int ldc = isg ? GATEW : QKVW; const int col0 = (isg ? (u.pn - 18) : u.pn) * 256 + wc * 32 + 8 * fq;
        f32x4 bv[2][2];
#pragma unroll
        for (int bj = 0; bj < 2; ++bj)
#pragma unroll
            for (int n = 0; n < 2; ++n) bv[bj][n] = isg ? *(const GAS f32x4*)(b_gate + col0 + bj * 128 + 4 * n) : (f32x4){0.f, 0.f, 0.f, 0.f};
#pragma unroll
        for (int ai = 0; ai < 2; ++ai)
#pragma unroll
            for (int m = 0; m < 4; ++m) { bf16* rowp = base + (size_t)(row0 + ai * 128 + m * 16) * ldc + col0;
#pragma unroll
                for (int bj = 0; bj < 2; ++bj) { f32x4 v0 = acc[ai][bj][m][0] + bv[bj][0], v1 = acc[ai][bj][m][1] + bv[bj][1];
                    if (isg) {
#pragma unroll
                        for (int j = 0; j < 4; ++j) { v0[j] = __builtin_amdgcn_rcpf(1.0f + __builtin_amdgcn_exp2f(-LOG2E * v0[j])); v1[j] = __builtin_amdgcn_rcpf(1.0f + __builtin_amdgcn_exp2f(-LOG2E * v1[j])); } }
                    v4u w; w.x = pg8::cvt_pk_bf16(v0[0], v0[1]); w.y = pg8::cvt_pk_bf16(v0[2], v0[3]); w.z = pg8::cvt_pk_bf16(v1[0], v1[1]); w.w = pg8::cvt_pk_bf16(v1[2], v1[3]);
                    *(GAS v4u*)(rowp + bj * 128) = w; } }
    }
};
template <bool FIRST> struct EpiP3 {
    static constexpr bool PERM = true;
    bf16* merged; const bf16* gates; int br;
    __device__ __forceinline__ void operator()(const f32x4 (&acc)[2][2][4][2], const pg8::Unit& u, int wr, int wc, int fr, int fq) const {
        const int row0 = u.pm * 256 + wr * 64 + fr, col0 = u.pn * 256 + wc * 32 + 8 * fq;
#pragma unroll
        for (int ai = 0; ai < 2; ++ai) {
            v4u gw[4][2], ow[4][2];
#pragma unroll
            for (int m = 0; m < 4; ++m)
#pragma unroll
                for (int bj = 0; bj < 2; ++bj) { const size_t row = (size_t)(row0 + ai * 128 + m * 16);
                    gw[m][bj] = *(const GAS v4u*)(gates + row * GATEW + br * 1024 + col0 + bj * 128);
                    ow[m][bj] = FIRST ? (v4u){0u, 0u, 0u, 0u} : *(const GAS v4u*)(merged + row * D + col0 + bj * 128); }
#pragma unroll
            for (int m = 0; m < 4; ++m)
#pragma unroll
                for (int bj = 0; bj < 2; ++bj) { const size_t row = (size_t)(row0 + ai * 128 + m * 16);
                    const f32x4 a0 = acc[ai][bj][m][0], a1 = acc[ai][bj][m][1];
                    float r[8];
#pragma unroll
                    for (int j = 0; j < 4; ++j) { const unsigned g2 = gw[m][bj][j], o2 = ow[m][bj][j]; const float av0 = j < 2 ? a0[2 * j] : a1[2 * j - 4], av1 = j < 2 ? a0[2 * j + 1] : a1[2 * j - 3];
                        r[2 * j] = __uint_as_float(g2 << 16) * av0 + (FIRST ? 0.f : __uint_as_float(o2 << 16)); r[2 * j + 1] = __uint_as_float(g2 & 0xffff0000u) * av1 + (FIRST ? 0.f : __uint_as_float(o2 & 0xffff0000u)); }
                    v4u w; w.x = pg8::cvt_pk_bf16(r[0], r[1]); w.y = pg8::cvt_pk_bf16(r[2], r[3]); w.z = pg8::cvt_pk_bf16(r[4], r[5]); w.w = pg8::cvt_pk_bf16(r[6], r[7]);
                    *(GAS v4u*)(merged + row * D + col0 + bj * 128) = w; }
            asm volatile("" ::: "memory"); }
    }
};
struct EpiP3V {
    static constexpr bool PERM = true;
    bf16* merged; const bf16* gates;
    __device__ __forceinline__ void operator()(const f32x4 (&acc)[2][2][4][2], const pg8::Unit& u, int wr, int wc, int fr, int fq) const {
        const int row0 = u.pm * 256 + wr * 64 + fr, col0 = u.pn * 256 + wc * 32 + 8 * fq; const int br = u.e; const bool first = (br == 0);
#pragma unroll
        for (int ai = 0; ai < 2; ++ai)
#pragma unroll
        for (int mp = 0; mp < 2; ++mp) {
            v4u gw[2][2], ow[2][2];
#pragma unroll
            for (int mm = 0; mm < 2; ++mm)
#pragma unroll
                for (int bj = 0; bj < 2; ++bj) { const size_t row = (size_t)(row0 + ai * 128 + (2 * mp + mm) * 16);
                    gw[mm][bj] = *(const GAS v4u*)(gates + row * GATEW + br * 1024 + col0 + bj * 128);
                    ow[mm][bj] = (v4u){0u, 0u, 0u, 0u}; if (!first) ow[mm][bj] = *(const GAS v4u*)(merged + row * D + col0 + bj * 128); }
#pragma unroll
            for (int mm = 0; mm < 2; ++mm)
#pragma unroll
                for (int bj = 0; bj < 2; ++bj) { const int m = 2 * mp + mm; const size_t row = (size_t)(row0 + ai * 128 + m * 16);
                    const f32x4 a0 = acc[ai][bj][m][0], a1 = acc[ai][bj][m][1];
                    float r[8];
#pragma unroll
                    for (int j = 0; j < 4; ++j) { const unsigned g2 = gw[mm][bj][j], o2 = ow[mm][bj][j]; const float av0 = j < 2 ? a0[2 * j] : a1[2 * j - 4], av1 = j < 2 ? a0[2 * j + 1] : a1[2 * j - 3];
                        r[2 * j] = __uint_as_float(g2 << 16) * av0 + __uint_as_float(o2 << 16); r[2 * j + 1] = __uint_as_float(g2 & 0xffff0000u) * av1 + __uint_as_float(o2 & 0xffff0000u); }
                    v4u w; w.x = pg8::cvt_pk_bf16(r[0], r[1]); w.y = pg8::cvt_pk_bf16(r[2], r[3]); w.z = pg8::cvt_pk_bf16(r[4], r[5]); w.w = pg8::cvt_pk_bf16(r[6], r[7]);
                    *(GAS v4u*)(merged + row * D + col0 + bj * 128) = w; }
            asm volatile("" ::: "memory"); }
    }
};
struct P3Order {
    pg8::DenseOrder Dn; const char* Abase; const char* wsb; size_t lofs;
    __device__ __forceinline__ bool next(int i, pg8::Unit& u) const { if (!Dn.next(i / 3, u)) return false; u.e = i % 3; u.ui = i; return true; }
    __device__ __forceinline__ const char* a_base(const pg8::Unit& u) const { const size_t ko = (size_t)((u.e + 1) >> 1) * 1024 + (size_t)(u.e >> 1) * 512; return Abase + ko + (size_t)u.pm * Dn.tstepA; }
    __device__ __forceinline__ int K_of(const pg8::Unit& u) const { return 512 - 256 * (u.e & 1); }
    __device__ __forceinline__ int ldb_of(const pg8::Unit& u) const { return 512 - 256 * (u.e & 1); }
    __device__ __forceinline__ const char* b_base(const pg8::Unit& u) const {
        const size_t kb = (size_t)(512 - 256 * (u.e & 1)) * 2;
        const size_t base = WS_WBRA + (size_t)((u.e + 1) >> 1) * (WS_WBRB - WS_WBRA) + (size_t)(u.e >> 1) * (WS_WBRC - WS_WBRB);
        return wsb + base + lofs * (size_t)D * kb + (size_t)u.pn * 256 * kb; }
    __device__ __forceinline__ int a_row(const pg8::Unit&, int) const { return 0; }
};
struct EpiP4 {
    static constexpr bool PERM = false;
    const bf16* hbc; float* ho;
    __device__ __forceinline__ void operator()(const f32x4 (&acc)[2][2][4][2], const pg8::Unit& u, int wr, int wc, int fr, int fq) const {
        const int row0 = u.pm * 256 + wr * 64 + fr, col0 = u.pn * 256 + wc * 32 + 4 * fq;
#pragma unroll
        for (int ai = 0; ai < 2; ++ai) { v2u hv[4][2][2];
#pragma unroll
            for (int m = 0; m < 4; ++m)
#pragma unroll
                for (int bj = 0; bj < 2; ++bj)
#pragma unroll
                    for (int n = 0; n < 2; ++n) hv[m][bj][n] = *(const GAS v2u*)(hbc + (size_t)(row0 + ai * 128 + m * 16) * D + col0 + bj * 128 + n * 16);
#pragma unroll
            for (int m = 0; m < 4; ++m)
#pragma unroll
                for (int bj = 0; bj < 2; ++bj)
#pragma unroll
                    for (int n = 0; n < 2; ++n) { const v2u w = hv[m][bj][n]; const f32x4 hf = (f32x4){__uint_as_float(w.x << 16), __uint_as_float(w.x & 0xffff0000u), __uint_as_float(w.y << 16), __uint_as_float(w.y & 0xffff0000u)};
                        *(GAS f32x4*)(ho + (size_t)(row0 + ai * 128 + m * 16) * D + col0 + bj * 128 + n * 16) = hf * ALPHA + acc[ai][bj][m][n]; }
            asm volatile("" ::: "memory"); }
    }
};
struct EpiP7 {
    static constexpr bool PERM = true;
    bf16* hid;
    __device__ __forceinline__ void operator()(const f32x4 (&acc)[2][2][4][2], const pg8::Unit& u, int wr, int wc, int fr, int fq) const {
        const int row0 = u.pm * 256 + wr * 64 + fr, col0 = u.pn * 128 + wc * 32 + 8 * fq;
#pragma unroll
        for (int ai = 0; ai < 2; ++ai)
#pragma unroll
            for (int m = 0; m < 4; ++m) { float r[8];
#pragma unroll
                for (int n = 0; n < 2; ++n)
#pragma unroll
                    for (int j = 0; j < 4; ++j) { const float gv = acc[ai][0][m][n][j], uv = acc[ai][1][m][n][j]; r[4 * n + j] = gv * __builtin_amdgcn_rcpf(1.0f + __builtin_amdgcn_exp2f(-LOG2E * gv)) * uv; }
                v4u w; w.x = pg8::cvt_pk_bf16(r[0], r[1]); w.y = pg8::cvt_pk_bf16(r[2], r[3]); w.z = pg8::cvt_pk_bf16(r[4], r[5]); w.w = pg8::cvt_pk_bf16(r[6], r[7]);
                *(GAS v4u*)(hid + (size_t)(row0 + ai * 128 + m * 16) * DE + col0) = w; }
    }
};
struct EpiP8 {
    static constexpr bool PERM = true;
    bf16* yb; const int* rowtok; const float* rowgate;
    __device__ __forceinline__ void operator()(const f32x4 (&acc)[2][2][4][2], const pg8::Unit& u, int wr, int wc, int fr, int fq) const {
        const int row0 = u.pm * 256 + wr * 64 + fr, col0 = u.pn * 256 + wc * 32 + 8 * fq;
        int rt[2][4]; float gt[2][4];
#pragma unroll
        for (int ai = 0; ai < 2; ++ai)
#pragma unroll
            for (int m = 0; m < 4; ++m) { const int row = row0 + ai * 128 + m * 16; rt[ai][m] = *(const GAS int*)(rowtok + row); gt[ai][m] = *(const GAS float*)(rowgate + row); }
#pragma unroll
        for (int ai = 0; ai < 2; ++ai)
#pragma unroll
            for (int m = 0; m < 4; ++m) {
                if (rt[ai][m] >= 0) {
#pragma unroll
                    for (int bj = 0; bj < 2; ++bj) { const f32x4 v0 = acc[ai][bj][m][0] * gt[ai][m], v1 = acc[ai][bj][m][1] * gt[ai][m];
                        v4u w; w.x = pg8::cvt_pk_bf16(v0[0], v0[1]); w.y = pg8::cvt_pk_bf16(v0[2], v0[3]); w.z = pg8::cvt_pk_bf16(v1[0], v1[1]); w.w = pg8::cvt_pk_bf16(v1[2], v1[3]);
                        *(GAS v4u*)(yb + (size_t)rt[ai][m] * D + col0 + bj * 128) = w; } } }
    }
};

typedef float f32x2 __attribute__((ext_vector_type(2)));
template <int N> __device__ __forceinline__ void wave_sum_n(float (&v)[N]) {
#pragma unroll
    for (int s = 0; s < 4; ++s)
#pragma unroll
        for (int n = 0; n < N; ++n) v[n] = dpp_add(v[n], s);
#pragma unroll
    for (int n = 0; n < N; ++n) { const int x = __builtin_bit_cast(int, v[n]);
        const float r0 = __builtin_bit_cast(float, __builtin_amdgcn_readlane(x, 0)), r1 = __builtin_bit_cast(float, __builtin_amdgcn_readlane(x, 16)),
                    r2 = __builtin_bit_cast(float, __builtin_amdgcn_readlane(x, 32)), r3 = __builtin_bit_cast(float, __builtin_amdgcn_readlane(x, 48));
        v[n] = (r0 + r1) + (r2 + r3); }
}
__device__ __forceinline__ void router_row(const float (&x)[16], int t, int lane, const f32x4 (&wg)[16], const float* b_rg, const LAS float* w_re, const float* b_re, LAS int* lcnt, int wslot, Rec* rec) {
    f32x2 g01 = (f32x2){0.f, 0.f}, g23 = (f32x2){0.f, 0.f};
#pragma unroll
    for (int k = 0; k < 16; ++k) { const f32x4 w = wg[k]; const f32x2 xv = (f32x2){x[k], x[k]}; g01 = xv * (f32x2){w.x, w.y} + g01; g23 = xv * (f32x2){w.z, w.w} + g23; }
    float gl[4] = {g01.x, g01.y, g23.x, g23.y};
    wave_sum_n<4>(gl);
#pragma unroll
    for (int g = 0; g < 4; ++g) gl[g] += b_rg[g];
    int gi = 0; float gm = gl[0];
#pragma unroll
    for (int g = 1; g < 4; ++g) if (gl[g] > gm) { gm = gl[g]; gi = g; }
    float gs = 0.f;
#pragma unroll
    for (int g = 0; g < 4; ++g) gs += __expf(gl[g] - gm);
    const float gw = 1.0f / gs;
    f32x2 e01 = (f32x2){0.f, 0.f}, e23 = e01, e45 = e01, e67 = e01;
    const LAS float* wre = w_re + gi * (D * 8);
#pragma unroll
    for (int j = 0; j < 4; ++j)
#pragma unroll
        for (int i = 0; i < 4; ++i) { const LAS float* wp = wre + ((j * 4 + i) * 128 + lane) * 4; const f32x4 w0 = *(const LAS f32x4*)wp, w1 = *(const LAS f32x4*)(wp + 256); const f32x2 xv = (f32x2){x[4 * j + i], x[4 * j + i]};
            e01 = xv * (f32x2){w0.x, w0.y} + e01; e23 = xv * (f32x2){w0.z, w0.w} + e23; e45 = xv * (f32x2){w1.x, w1.y} + e45; e67 = xv * (f32x2){w1.z, w1.w} + e67; }
    float el[8] = {e01.x, e01.y, e23.x, e23.y, e45.x, e45.y, e67.x, e67.y};
    wave_sum_n<8>(el);
#pragma unroll
    for (int e = 0; e < 8; ++e) el[e] += b_re[gi * 8 + e];
    int i0 = 0; float t0 = el[0];
#pragma unroll
    for (int e = 1; e < 8; ++e) if (el[e] > t0) { t0 = el[e]; i0 = e; }
    int i1 = -1; float t1 = -3.0e38f;
#pragma unroll
    for (int e = 0; e < 8; ++e) if (e != i0 && el[e] > t1) { t1 = el[e]; i1 = e; }
    const float ex = __expf(t1 - t0), p0 = 1.0f / (1.0f + ex), p1 = ex / (1.0f + ex);
    if (lane == 0) {
        const int e0 = gi * 8 + i0, e1 = gi * 8 + i1;
        const int s0 = __hip_atomic_fetch_add(lcnt + e0, 1, __ATOMIC_RELAXED, __HIP_MEMORY_SCOPE_WORKGROUP), s1 = __hip_atomic_fetch_add(lcnt + e1, 1, __ATOMIC_RELAXED, __HIP_MEMORY_SCOPE_WORKGROUP);
        GAS v4u* rp = (GAS v4u*)(rec + t);
        rp[0] = (v4u){(unsigned)e0, (unsigned)s0, (unsigned)e1, (unsigned)s1};
        rp[1] = (v4u){__float_as_uint(gw * p0), __float_as_uint(gw * p1), (unsigned)wslot, 0u};
    }
}

#ifndef STAG_P1
#define STAG_P1 500
#endif
__device__ __forceinline__ void stagger(int vcu, unsigned q) {
    const unsigned long long t0 = __builtin_amdgcn_s_memrealtime(); const unsigned long long d = (unsigned long long)((vcu & 3) * q);
    while (__builtin_amdgcn_s_memrealtime() - t0 < d) __builtin_amdgcn_s_sleep(8);
}
__device__ __forceinline__ void ph_ln0(Frame& F) { LAUNDER(F);
    const int gw = F.vcu * NWAVES + F.wave, NGW = F.G * NWAVES;
    bf16* hb = (bf16*)(F.ws + WS_HB);
    LnIn cur, nxt; if (gw < T) ln_load<0>(cur, F.in[0], nullptr, nullptr, (size_t)gw, F.lane);
    for (int m = gw; m < T; m += NGW) { const bool more = m + NGW < T; if (more) ln_load<0>(nxt, F.in[0], nullptr, nullptr, (size_t)(m + NGW), F.lane);
        f32x4 o[4]; ln_finish<0>(cur, nullptr, hb, F.in[1], F.in[2], (size_t)m, F.lane, o); if (more) cur = nxt; }
}
__device__ __forceinline__ void ph_p1(Frame& F, int l, int c) { LAUNDER(F); asm volatile("" : "+s"(l), "+s"(c));
    pg8::DenseOrder S; S.init((const bf16*)(F.ws + WS_HB) + (size_t)c * CH * D, D, (const bf16*)(F.ws + WS_WIN) + (size_t)l * NCOL * D, D, CH, NCOL, F.G, (int)blockIdx.x);
    EpiP1 E{(bf16*)(F.ws + WS_QKV), (bf16*)(F.ws + WS_GATES), F.in[5] + (size_t)l * GATEW, F.probe};
    pg8::gemm_phase<EpiP1, pg8::DenseOrder, false>(F.lds + RING_OFF, S, E, D, D, D, F.tid);
}
__device__ __forceinline__ void ph_cmb(Frame& F) { LAUNDER(F);
    const bf16* og = (const bf16*)(F.ws + WS_OG); const float* lse = (const float*)(F.ws + WS_LSE); bf16* oabc = (bf16*)(F.ws + WS_OABC);
    for (int idx = F.vcu * NTHREADS + F.tid; idx < CH * 32; idx += F.G * NTHREADS) {
        const int tl = idx >> 5, hc = idx & 31, h = hc >> 3, c = hc & 7;
        const GAS float* lg = (const GAS float*)lse + (size_t)tl * 12 + h; const float l0 = lg[0], l1 = lg[4], l2 = lg[8];
        const float mx = fmaxf(l0, fmaxf(l1, l2)); float w0 = __expf(l0 - mx), w1 = __expf(l1 - mx), w2 = __expf(l2 - mx); const float inv = 1.0f / (w0 + w1 + w2); w0 *= inv; w1 *= inv; w2 *= inv;
        const v4u a = *(const GAS v4u*)(og + ((size_t)tl * 3 + 0) * 256 + h * 64 + c * 8), b = *(const GAS v4u*)(og + ((size_t)tl * 3 + 1) * 256 + h * 64 + c * 8), d = *(const GAS v4u*)(og + ((size_t)tl * 3 + 2) * 256 + h * 64 + c * 8);
        v4u ow;
#pragma unroll
        for (int i = 0; i < 4; ++i) {
            const float lo = w0 * __uint_as_float(a[i] << 16) + w1 * __uint_as_float(b[i] << 16) + w2 * __uint_as_float(d[i] << 16);
            const float hi = w0 * __uint_as_float(a[i] & 0xffff0000u) + w1 * __uint_as_float(b[i] & 0xffff0000u) + w2 * __uint_as_float(d[i] & 0xffff0000u);
            ow[i] = pk2(lo, hi);
        }
        *(GAS v4u*)(oabc + (size_t)tl * OW + 512 + h * 64 + c * 8) = ow;
    }
}
__device__ __forceinline__ void ph_p3(Frame& F, int l) { LAUNDER(F); asm volatile("" : "+s"(l));
    const bf16* oabc = (const bf16*)(F.ws + WS_OABC); bf16* merged = (bf16*)(F.ws + WS_MERGED); const bf16* gates = (const bf16*)(F.ws + WS_GATES);
    P3Order S; S.Dn.init(oabc, OW, nullptr, 0, CH, D, F.G, (int)blockIdx.x);
    S.Abase = (const char*)oabc; S.wsb = (const char*)F.ws; S.lofs = (size_t)l;
    EpiP3V E{merged, gates};
    pg8::gemm_phase_vk<EpiP3V, P3Order>(F.lds + RING_OFF, S, E, OW, F.tid);
}
__device__ __forceinline__ void ph_p4(Frame& F, int l, int c) { LAUNDER(F); asm volatile("" : "+s"(l), "+s"(c));
    pg8::DenseOrder S; S.init((const bf16*)(F.ws + WS_MERGED), D, (const bf16*)(F.ws + WS_WOUT) + (size_t)l * D * D, D, CH, D, F.G, (int)blockIdx.x);
    EpiP4 E{(const bf16*)(F.ws + WS_HB) + (size_t)c * CH * D, F.probe ? (float*)(F.ws + WS_OABC) : F.h + (size_t)c * CH * D};
    pg8::gemm_phase<EpiP4, pg8::DenseOrder, false>(F.lds + RING_OFF, S, E, D, D, D, F.tid);
}
__device__ __forceinline__ void ph_ln1(Frame& F, int l, int c) { LAUNDER(F); asm volatile("" : "+s"(l), "+s"(c));
    const int gw = F.vcu * NWAVES + F.wave, NGW = F.G * NWAVES;
    bf16* hb = (bf16*)(F.ws + WS_HB); Rec* rec = (Rec*)(F.ws + WS_REC);
    int* wgc = (int*)(F.ws + WS_WGCNT) + ((size_t)(l * NCHUNK + c) * F.G + F.vcu) * 32;
    if (F.probe) { hb = (bf16*)(F.ws + WS_QKV) - (size_t)c * CH * D; wgc = (int*)(F.ws + WS_WGCNT) + (size_t)DEPTH * NCHUNK * 256 * 32 + F.vcu * 32; rec = (Rec*)(F.ws + WS_GATES); }
    LAS float* lrg = (LAS float*)(F.lds + RING_OFF); LAS float* lre = lrg + D * 4; LAS int* lcnt = (LAS int*)(F.lds + LCNT_OFF);
    { const float* w_rg = F.in[14] + (size_t)l * D * 4; const float* w_re = F.in[16] + (size_t)l * 4 * D * 8;
      if (F.tid < 32) lcnt[F.tid] = 0;
      for (int u = F.tid; u < D + 4 * D * 2; u += NTHREADS) {
          if (u < D) { const int e = u, ln = (e & 255) >> 2, i = e & 3, j = e >> 8; *(LAS f32x4*)(lrg + ((j * 4 + i) * 64 + ln) * 4) = *(const GAS f32x4*)(w_rg + (size_t)e * 4); }
          else { const int v = u - D, half = v & 1, e = (v >> 1) & 1023, g = v >> 11, ln = (e & 255) >> 2, i = e & 3, j = e >> 8;
                 *(LAS f32x4*)(lre + g * (D * 8) + (((j * 4 + i) * 2 + half) * 64 + ln) * 4) = *(const GAS f32x4*)(w_re + ((size_t)g * D + e) * 8 + half * 4); } }
      __syncthreads(); }
    f32x4 wg[16];
#pragma unroll
    for (int j = 0; j < 4; ++j)
#pragma unroll
        for (int i = 0; i < 4; ++i) wg[4 * j + i] = *(const LAS f32x4*)(lrg + ((j * 4 + i) * 64 + F.lane) * 4);
    const size_t rbase = (size_t)c * CH;
    LnIn cur, nxt; if (gw < CH) ln_load<1>(cur, F.h, nullptr, nullptr, rbase + gw, F.lane);
    for (int m = gw; m < CH; m += NGW) {
        const bool more = m + NGW < CH; if (more) ln_load<1>(nxt, F.h, nullptr, nullptr, rbase + m + NGW, F.lane);
        const size_t row = rbase + m; f32x4 o[4];
        ln_finish<1>(cur, nullptr, hb, F.in[12] + l * D, F.in[13] + l * D, row, F.lane, o);
        float x[16];
#pragma unroll
        for (int j = 0; j < 4; ++j) { x[4 * j] = o[j].x; x[4 * j + 1] = o[j].y; x[4 * j + 2] = o[j].z; x[4 * j + 3] = o[j].w; }
        router_row(x, (int)row, F.lane, wg, F.in[15] + l * 4, lre, F.in[17] + l * 32, lcnt, c * F.G + F.vcu, rec);
        if (more) cur = nxt;
    }
    __syncthreads();
    if (F.tid < 32) *(GAS int*)(wgc + F.tid) = lcnt[F.tid];
}
__device__ __forceinline__ void ph_dsp(Frame& F, int l) { LAUNDER(F); asm volatile("" : "+s"(l));
    LAS int* Tb = (LAS int*)(F.lds + RING_OFF); LAS int* part = Tb + 512 * 32; LAS int* po = part + 32 * 16;
    const int* wg = (const int*)(F.ws + WS_WGCNT) + (size_t)l * NCHUNK * F.G * 32; const int W = NCHUNK * F.G;
    int* cnt = (int*)(F.ws + WS_CTL) + CW_CNT + l * (32 * CSTR); const Rec* rec = (const Rec*)(F.ws + WS_REC); int* rowtok = (int*)(F.ws + WS_ROWTOK); float* rowgate = (float*)(F.ws + WS_ROWGATE);
    for (int i = F.tid; i < W * 32; i += NTHREADS) Tb[i] = *(const GAS int*)(wg + i);
    __syncthreads();
    const int e = F.tid >> 4, k = F.tid & 15, per = (W + 15) / 16, w0 = k * per, w1 = (w0 + per) < W ? (w0 + per) : W;
    { int s = 0; for (int w = w0; w < w1; ++w) s += Tb[w * 32 + e]; part[e * 16 + k] = s; }
    __syncthreads();
    { int base = 0; for (int kk = 0; kk < k; ++kk) base += part[e * 16 + kk];
      for (int w = w0; w < w1; ++w) { const int t = Tb[w * 32 + e]; Tb[w * 32 + e] = base; base += t; } }
    __syncthreads();
    if (F.tid == 0) { int acc = 0; for (int ee = 0; ee < NE; ++ee) { int tot = 0; for (int kk = 0; kk < 16; ++kk) tot += part[ee * 16 + kk]; po[ee] = acc; part[ee * 16] = tot; acc += (tot + 255) / 256 * 256; } po[NE] = acc; }
    __syncthreads();
    if (F.vcu == 0 && F.tid < 32) cnt[F.tid * CSTR] = part[F.tid * 16];
    const int gt = F.vcu * NTHREADS + F.tid, GT = F.G * NTHREADS;
    for (int t = gt; t < T; t += GT) {
        const GAS v4u* rp = (const GAS v4u*)(rec + t); const v4u ra = rp[0], rb = rp[1];
        Rec rc; rc.e0 = (int)ra.x; rc.s0 = (int)ra.y; rc.e1 = (int)ra.z; rc.s1 = (int)ra.w; rc.g0 = __uint_as_float(rb.x); rc.g1 = __uint_as_float(rb.y); rc.pad0 = (int)rb.z; rc.pad1 = 0;
        const int d0 = po[rc.e0] + Tb[rc.pad0 * 32 + rc.e0] + rc.s0, d1 = po[rc.e1] + Tb[rc.pad0 * 32 + rc.e1] + rc.s1;
        *(GAS int*)(rowtok + d0) = 2 * t; *(GAS float*)(rowgate + d0) = rc.g0; *(GAS int*)(rowtok + d1) = 2 * t + 1; *(GAS float*)(rowgate + d1) = rc.g1;
    }
    for (int ee = 0; ee < NE; ++ee) for (int r = po[ee] + part[ee * 16] + gt; r < po[ee + 1]; r += GT) { *(GAS int*)(rowtok + r) = -1; *(GAS float*)(rowgate + r) = 0.f; }
    __syncthreads();
}
__device__ __forceinline__ int moe_setup(Frame& F, int l, bool gather) { LAUNDER(F); asm volatile("" : "+s"(l));
    LAS int* rows = (LAS int*)(F.lds + ROWS_OFF); LAS int* ulist = rows + 11 * 256; LAS int* po = ulist + 16;
    const int* cnt = (const int*)(F.ws + WS_CTL) + CW_CNT + l * (32 * CSTR); const int* rowtok = (const int*)(F.ws + WS_ROWTOK);
    if (F.tid == 0) { int acc = 0; for (int e = 0; e < NE; ++e) { po[e] = acc; acc += (cnt[e * CSTR] + 255) / 256 * 256; } po[NE] = acc; }
    __syncthreads();
    const int nu_all = (po[NE] / 256) * 4; int nun = (nu_all - F.vcu + F.G - 1) / F.G; nun = nun < 0 ? 0 : (nun > 11 ? 11 : nun);
    if (F.tid < nun) { const int Lx = F.tid * F.G + F.vcu, rt = Lx >> 2, pn = Lx & 3; int e = 0; while (e < NE - 1 && po[e + 1] <= rt * 256) ++e; ulist[F.tid] = (rt << 8) | (e << 2) | pn; }
    if (gather) for (int idx = F.tid; idx < nun * 256; idx += NTHREADS) { const int i = idx >> 8, r = idx & 255, Lx = i * F.G + F.vcu; rows[idx] = *(const GAS int*)(rowtok + (Lx >> 2) * 256 + r); }
    __syncthreads();
    return nun;
}
struct MoeOrder {
    int nun; const LAS int* ulist; const LAS int* rows; const char* A; const char* B; size_t tstepA, estepB, tstepB;
    __device__ __forceinline__ bool next(int i, pg8::Unit& u) const {
        if (i >= nun) return false;
        const int w = __builtin_amdgcn_readfirstlane(ulist[i]); u.pm = w >> 8; u.e = (w >> 2) & 63; u.pn = w & 3; u.ui = i; return true;
    }
    __device__ __forceinline__ const char* a_base(const pg8::Unit& u) const { return A + (size_t)u.pm * tstepA; }
    __device__ __forceinline__ const char* b_base(const pg8::Unit& u) const { return B + (size_t)u.e * estepB + (size_t)u.pn * tstepB; }
    __device__ __forceinline__ int a_row(const pg8::Unit& u, int r) const { const int t = rows[u.ui * 256 + r]; return t < 0 ? 0 : (t >> 1); }
};
__device__ __forceinline__ void ph_p7(Frame& F, int l) { LAUNDER(F); asm volatile("" : "+s"(l));
    const int nun = moe_setup(F, l, true);
    LAS int* rows = (LAS int*)(F.lds + ROWS_OFF);
    MoeOrder S{nun, rows + 11 * 256, rows, (const char*)(F.ws + WS_HB), (const char*)(F.ws + WS_WGU) + (size_t)l * NE * 1024 * 1024 * 2, 0, (size_t)1024 * 1024 * 2, (size_t)256 * 1024 * 2};
    EpiP7 E{(bf16*)(F.ws + WS_HID)};
    pg8::gemm_phase<EpiP7, MoeOrder, true>(F.lds + RING_OFF, S, E, D, D, D, F.tid);
}
__device__ __forceinline__ void ph_p8(Frame& F, int l) { LAUNDER(F); asm volatile("" : "+s"(l));
    const int nun = moe_setup(F, l, false);
    LAS int* rows = (LAS int*)(F.lds + ROWS_OFF);
    MoeOrder S{nun, rows + 11 * 256, rows, (const char*)(F.ws + WS_HID), (const char*)(F.ws + WS_WD) + (size_t)l * NE * 1024 * 512 * 2, (size_t)256 * DE * 2, (size_t)1024 * 512 * 2, (size_t)256 * 512 * 2};
    EpiP8 E{(bf16*)(F.ws + WS_YB), (const int*)(F.ws + WS_ROWTOK), (const float*)(F.ws + WS_ROWGATE)};
    pg8::gemm_phase<EpiP8, MoeOrder, false>(F.lds + RING_OFF, S, E, DE, DE, DE, F.tid);
}
__device__ __forceinline__ void ph_ln2(Frame& F, int l) { LAUNDER(F); asm volatile("" : "+s"(l));
    const int gw = F.vcu * NWAVES + F.wave, NGW = F.G * NWAVES;
    const bool lastl = (l == DEPTH - 1);
    const bf16* hsb = (const bf16*)(F.ws + WS_HB); const bf16* yb = (const bf16*)(F.ws + WS_YB);
    bf16* hb = lastl ? nullptr : (bf16*)(F.ws + WS_HB); float* hout = lastl ? F.h : nullptr; size_t omask = ~(size_t)0;
    if (F.probe) { hout = lastl ? (float*)(F.ws + WS_OABC) : nullptr; hb = lastl ? nullptr : (bf16*)(F.ws + WS_OABC); omask = 32767; }
    LnIn cur, nxt; if (gw < T) ln_load<2>(cur, nullptr, hsb, yb, (size_t)gw, F.lane);
    for (int m = gw; m < T; m += NGW) { const bool more = m + NGW < T; if (more) ln_load<2>(nxt, nullptr, hsb, yb, (size_t)(m + NGW), F.lane);
        const size_t back = ((size_t)m - ((size_t)m & omask)) * D;
        f32x4 o[4]; ln_finish<2>(cur, hout ? hout - back : nullptr, hb ? hb - back : nullptr, F.in[21] + l * D, F.in[22] + l * D, (size_t)m, F.lane, o); if (more) cur = nxt; }
}

typedef short s16x4 __attribute__((ext_vector_type(4)));
constexpr int NT_A = (CH / 32) * 4, NT_B = (CH / L) * 3 * 128 * 4, NT_C = (CH / 64) * 8, NT_ALL = NT_A + NT_B + NT_C;
constexpr float NEGBIG = -1.0e30f, MINIT = -5.0e29f;
#define RC16(reg) (((reg) & 3) + 8 * ((reg) >> 2))

__device__ __forceinline__ void ph_tables(Frame& F) { LAUNDER(F);
    float* TA = (float*)(F.ws + WS_TABA); float* TB = (float*)(F.ws + WS_TABB); float* TC = (float*)(F.ws + WS_TABC);
    const float* rel_bias = F.in[3]; const float* rpb = F.in[7];
    const int gt = F.vcu * NTHREADS + F.tid, GT = F.G * NTHREADS;
    for (int i = gt; i < 8 * 320; i += GT) { const int h = i / 320, rel = i % 320 - 160; TA[i] = (rel >= -128 && rel <= 128) ? rel_bias[BUCK_A[rel + 128] * 20 + h] * LOG2E : NEGBIG; }
    for (int i = gt; i < 12 * 256; i += GT) { const int gh = i >> 8, g = gh >> 2, rel = (i & 255) - 128; TB[i] = (rel >= -64 && rel <= 64) ? rel_bias[BUCK_B[g][rel + 64] * 20 + 8 + gh] * LOG2E : NEGBIG; }
    for (int i = gt; i < DEPTH * 8 * 1024; i += GT) { const int lh = i >> 10, ri = (i >> 6) & 15, ci = (i & 63) - 16; TC[i] = (ri < 15 && ci >= 0 && ci <= 30) ? rpb[((size_t)lh * 15 + ri) * 31 + ci] * LOG2E : NEGBIG; }
}

#define ATT_INIT(S, TBP, BIDX, XM) do { \
        _Pragma("unroll") for (int r_ = 0; r_ < 16; ++r_) { float v_ = (TBP)[(BIDX) + RC16(r_)]; if (TYPE == 2) v_ = ((unsigned)((XM) + RC16(r_)) < 16u) ? v_ : NEGBIG; S[r_] = v_; } } while (0)
__device__ __forceinline__ float xhalf_max(float t) { float a_ = t, b_ = t; asm volatile("s_nop 1\n\tv_permlane32_swap_b32 %0, %1" : "+v"(a_), "+v"(b_)); return fmaxf(a_, b_); }
__device__ __forceinline__ float xhalf_sum(float t) { float a_ = t, b_ = t; asm volatile("s_nop 1\n\tv_permlane32_swap_b32 %0, %1" : "+v"(a_), "+v"(b_)); return a_ + b_; }
#define ATT_TMAX(S, t) do { t = NEGBIG; _Pragma("unroll") for (int r_ = 0; r_ < 16; ++r_) t = fmaxf(t, S[r_]); } while (0)
#define ATT_RESCALE(need, t, m, l, Oa, Ob) do { const float mn_ = (need) ? (t) : m, corr_ = __builtin_amdgcn_exp2f(m - mn_); m = mn_; l *= corr_; \
        _Pragma("unroll") for (int i_ = 0; i_ < 16; ++i_) { Oa[i_] *= corr_; Ob[i_] *= corr_; } } while (0)
#define ATT_EXP(S, m, rs) do { rs = 0.f; _Pragma("unroll") for (int r_ = 0; r_ < 16; ++r_) { const float p_ = __builtin_amdgcn_exp2f(S[r_] - m); S[r_] = p_; rs += p_; } } while (0)
#define ATT_PACK(Pf, S, s2) do { unsigned pw_[4]; _Pragma("unroll") for (int j_ = 0; j_ < 4; ++j_) pw_[j_] = pg8::cvt_pk_bf16(S[8 * (s2) + 2 * j_], S[8 * (s2) + 2 * j_ + 1]); \
        Pf = __builtin_bit_cast(bf16x8, (v4u){pw_[0], pw_[1], pw_[2], pw_[3]}); } while (0)
#define ATT_STORE(orow, Oa, Ob, l) do { const float inv_ = 1.0f / (l); \
        _Pragma("unroll") for (int g_ = 0; g_ < 4; ++g_) { v2u w0_, w1_; \
            w0_.x = pg8::cvt_pk_bf16(Oa[4 * g_] * inv_, Oa[4 * g_ + 1] * inv_); w0_.y = pg8::cvt_pk_bf16(Oa[4 * g_ + 2] * inv_, Oa[4 * g_ + 3] * inv_); \
            w1_.x = pg8::cvt_pk_bf16(Ob[4 * g_] * inv_, Ob[4 * g_ + 1] * inv_); w1_.y = pg8::cvt_pk_bf16(Ob[4 * g_ + 2] * inv_, Ob[4 * g_ + 3] * inv_); \
            *(GAS v2u*)((orow) + 8 * g_ + 4 * hh) = w0_; *(GAS v2u*)((orow) + 32 + 8 * g_ + 4 * hh) = w1_; } } while (0)

template <int TYPE>
__device__ __forceinline__ void att_task2(LAS unsigned char* wl, const int lane, const bf16* seq  , const float* tab0, const float* tab1,
                                          const int qcol0, const int qcol1, const int kcol, const int vcol, const int TT0, const int TSTEP, const int kstride, const int tlo, const int thi,
                                          const int tq0, const int tq1  , const int toff1  ,
                                          const int gi0, const int gi1, const int gc, const int cbs  ,
                                          const float m_init0, const float m_init1, const float l_init, bf16* orow0, bf16* orow1, float* lse0, float* lse1) {
    const int qi = lane & 31, hh = lane >> 5;
    LAS unsigned char* kt = wl; LAS unsigned char* vt = wl + 4096; LAS float* tb0 = (LAS float*)(wl + 8192); LAS float* tb1 = (TYPE == 0) ? tb0 + 320 : tb0;
    constexpr int TBN = TYPE == 0 ? 320 : (TYPE == 1 ? 256 : 1024);
#pragma unroll
    for (int i = 0; i < TBN / 64; ++i) { tb0[lane + 64 * i] = *(const GAS float*)(tab0 + lane + 64 * i); if (TYPE == 0) tb1[lane + 64 * i] = *(const GAS float*)(tab1 + lane + 64 * i); }
    bf16x8 Qa[4], Qb[4];
#pragma unroll
    for (int s = 0; s < 4; ++s) { Qa[s] = *(const GAS bf16x8*)(seq + (size_t)tq0 * QKVW + qcol0 + 16 * s + 8 * hh); Qb[s] = *(const GAS bf16x8*)(seq + (size_t)tq1 * QKVW + qcol1 + 16 * s + 8 * hh); }
    f32x16 O0a, O0b, O1a, O1b;
#pragma unroll
    for (int i = 0; i < 16; ++i) { O0a[i] = 0.f; O0b[i] = 0.f; O1a[i] = 0.f; O1b[i] = 0.f; }
    float m0 = m_init0, m1 = m_init1, l0 = l_init, l1 = l_init;
    const int lkey = lane >> 3, lch = lane & 7;
    const unsigned goff = (unsigned)(lkey * kstride) * (unsigned)(QKVW * 2) + 16u * (unsigned)lch;
    const size_t istepb = (size_t)8 * kstride * QKVW * 2;
    const char* kbase = (const char*)(seq + kcol); const char* vbase = (const char*)(seq + vcol);
    const unsigned kw0 = lkey * 128 + ((lch ^ (lkey & 7)) << 4), vw0 = lkey * 128 + (((lch >> 2) ^ ((lkey >> 1) & 1)) << 6) + ((lch & 3) << 4);
    const unsigned kr0 = qi * 128 + ((hh ^ (qi & 7)) << 4);
    const int q4 = (lane & 15) >> 2, p4 = lane & 3, g1 = (lane >> 4) & 1, sw = (q4 >> 1) & 1;
    const unsigned vr0 = (4 * hh + q4) * 128 + 32 * g1 + 8 * p4 + (sw << 6), vr1 = (4 * hh + q4) * 128 + 32 * g1 + 8 * p4 + ((sw ^ 1) << 6);
    const int bidx0 = (TYPE == 2) ? (cbs - gc + 31 + 4 * hh) : ((TYPE == 1 ? 64 : 32) - qi + 4 * hh);
    int cs = gc - 8; cs = cs < 0 ? 0 : (cs > 48 ? 48 : cs);
    const int xm = cbs - cs + 4 * hh;
    int rs0 = gi0 - 4; rs0 = rs0 < 0 ? 0 : (rs0 > 120 ? 120 : rs0);
    int rs1 = gi1 - 4; rs1 = rs1 < 0 ? 0 : (rs1 > 120 ? 120 : rs1);
    v4u kreg[4], vreg[4];
    {
        const size_t tb_ = (size_t)(TT0 + tlo * TSTEP) * (QKVW * 2);
#pragma unroll
        for (int i = 0; i < 4; ++i) { kreg[i] = *(const GAS v4u*)(kbase + tb_ + i * istepb + goff); vreg[i] = *(const GAS v4u*)(vbase + tb_ + i * istepb + goff); }
    }
    for (int ti = tlo; ti <= thi; ++ti) {
#pragma unroll
        for (int i = 0; i < 4; ++i) { *(LAS v4u*)(kt + kw0 + 1024 * i) = kreg[i]; *(LAS v4u*)(vt + vw0 + 1024 * i) = vreg[i]; }
        if (ti < thi) {
            const size_t tb_ = (size_t)(TT0 + (ti + 1) * TSTEP) * (QKVW * 2);
#pragma unroll
            for (int i = 0; i < 4; ++i) { kreg[i] = *(const GAS v4u*)(kbase + tb_ + i * istepb + goff); vreg[i] = *(const GAS v4u*)(vbase + tb_ + i * istepb + goff); }
        }
        int bi0, bi1;
        if (TYPE == 2) { const bool rv0 = (ti >= rs0) && (ti < rs0 + 8), rv1 = (ti >= rs1) && (ti < rs1 + 8); bi0 = bidx0 + (rv0 ? (ti - gi0 + 7) : 15) * 64; bi1 = bidx0 + (rv1 ? (ti - gi1 + 7) : 15) * 64; }
        else { bi0 = bidx0 + 32 * ti; bi1 = bidx0 + 32 * (ti - toff1); }
        f32x16 S0, S1;
        ATT_INIT(S0, tb0, bi0, xm); ATT_INIT(S1, tb1, bi1, xm);
#pragma unroll
        for (int s = 0; s < 4; ++s) { const bf16x8 Kf = *(const LAS bf16x8*)(kt + (kr0 ^ (unsigned)(s << 5)));
            S0 = __builtin_amdgcn_mfma_f32_32x32x16_bf16(Kf, Qa[s], S0, 0, 0, 0); S1 = __builtin_amdgcn_mfma_f32_32x32x16_bf16(Kf, Qb[s], S1, 0, 0, 0); }
        float t0, t1; ATT_TMAX(S0, t0); ATT_TMAX(S1, t1);
        t0 = xhalf_max(t0); t1 = xhalf_max(t1);
        const bool need0 = t0 > m0 + 8.0f, need1 = t1 > m1 + 8.0f;
        if (__builtin_amdgcn_ballot_w64(need0 || need1) != 0ull) { ATT_RESCALE(need0, t0, m0, l0, O0a, O0b); ATT_RESCALE(need1, t1, m1, l1, O1a, O1b); }
        float rs0, rs1; ATT_EXP(S0, m0, rs0); ATT_EXP(S1, m1, rs1);
        rs0 = xhalf_sum(rs0); rs1 = xhalf_sum(rs1);
        l0 += rs0; l1 += rs1;
#pragma unroll
        for (int s2 = 0; s2 < 2; ++s2) {
            bf16x8 P0, P1; ATT_PACK(P0, S0, s2); ATT_PACK(P1, S1, s2);
            const s16x4 a00 = __builtin_amdgcn_ds_read_tr16_b64_v4i16((LAS s16x4*)(vt + vr0 + (16 * s2) * 128));
            const s16x4 a01 = __builtin_amdgcn_ds_read_tr16_b64_v4i16((LAS s16x4*)(vt + vr0 + (16 * s2 + 8) * 128));
            const s16x4 a10 = __builtin_amdgcn_ds_read_tr16_b64_v4i16((LAS s16x4*)(vt + vr1 + (16 * s2) * 128));
            const s16x4 a11 = __builtin_amdgcn_ds_read_tr16_b64_v4i16((LAS s16x4*)(vt + vr1 + (16 * s2 + 8) * 128));
            const bf16x8 V0 = (bf16x8){a00[0], a00[1], a00[2], a00[3], a01[0], a01[1], a01[2], a01[3]};
            const bf16x8 V1 = (bf16x8){a10[0], a10[1], a10[2], a10[3], a11[0], a11[1], a11[2], a11[3]};
            O0a = __builtin_amdgcn_mfma_f32_32x32x16_bf16(V0, P0, O0a, 0, 0, 0); O0b = __builtin_amdgcn_mfma_f32_32x32x16_bf16(V1, P0, O0b, 0, 0, 0);
            O1a = __builtin_amdgcn_mfma_f32_32x32x16_bf16(V0, P1, O1a, 0, 0, 0); O1b = __builtin_amdgcn_mfma_f32_32x32x16_bf16(V1, P1, O1b, 0, 0, 0);
        }
    }
    ATT_STORE(orow0, O0a, O0b, l0);
    ATT_STORE(orow1, O1a, O1b, l1);
    if (TYPE == 1 && hh == 0) { *(GAS float*)lse0 = (m0 + __builtin_amdgcn_logf(l0)) * LN2; *(GAS float*)lse1 = (m1 + __builtin_amdgcn_logf(l1)) * LN2; }
}

__device__ __forceinline__ void ph_att(Frame& F, int l) { LAUNDER(F); asm volatile("" : "+s"(l));
    LAS unsigned char* wl = F.lds + RING_OFF + F.wave * 16384;
    const bf16* qkv = (const bf16*)(F.ws + WS_QKV); bf16* oabc = (bf16*)(F.ws + WS_OABC); bf16* og = (bf16*)(F.ws + WS_OG); float* lse = (float*)(F.ws + WS_LSE);
    const float* TA = (const float*)(F.ws + WS_TABA); const float* TB = (const float*)(F.ws + WS_TABB); const float* TC = (const float*)(F.ws + WS_TABC) + (size_t)l * 8 * 1024;
    const float* sink = F.in[6] + l * 8;
    const int gw = F.vcu * NWAVES + F.wave, NGW = F.G * NWAVES;
    for (int task = gw; task < NT_ALL; task += NGW) {
        int lane = F.lane; asm volatile("" : "+v"(lane)); const int qi = lane & 31;
        if (task < NT_A) {
            const int hp = task & 3, qb = (task >> 2) & 255, b = task >> 10, q0 = qb * 32, h0 = hp * 2, h1 = h0 + 1, kvh = hp >> 1;
            int tlo = 0, thi = 8; if (q0 - 128 < 0) tlo = (128 - q0) / 32; if (q0 + 128 + 31 >= L) thi = (L - 1 - (q0 - 128)) / 32;
            const int tq = q0 + qi; bf16* orow = oabc + (size_t)(b * L + tq) * OW;
            att_task2<0>(wl, lane, qkv + (size_t)b * L * QKVW, TA + h0 * 320, TA + h1 * 320, AQ + h0 * 64, AQ + h1 * 64, AK + kvh * 64, AV + kvh * 64, q0 - 128, 32, 1, tlo, thi,
                         tq, tq, 0, 0, 0, 0, 0, sink[h0] * LOG2E, sink[h1] * LOG2E, 1.0f, orow + h0 * 64, orow + h1 * 64, nullptr, nullptr);
        } else if (task < NT_A + NT_B) {
            const int j = task - NT_A, h = j & 3, sbi = (j >> 2) & 127, bg = j >> 9, g = bg % 3, b = bg / 3;
            const int dsh = 2 * g, d = 1 << dsh, nsb = 128 >> dsh, r = sbi / nsb, sb = sbi % nsb, q0 = sb * 64, Ls = L >> dsh;
            int tlo = 0, thi = 5; if (q0 - 64 < 0) tlo = (64 - q0) / 32; if (q0 + 32 + 64 + 31 >= Ls) thi = (Ls - 1 - (q0 - 64)) / 32;
            const int tq0 = (q0 + qi) * d + r, tq1 = (q0 + 32 + qi) * d + r, qc = BQ0 + 768 * g + h * 64;
            att_task2<1>(wl, lane, qkv + (size_t)b * L * QKVW, TB + (g * 4 + h) * 256, nullptr, qc, qc, qc + 256, qc + 512, (q0 - 64) * d + r, 32 * d, d, tlo, thi,
                         tq0, tq1, 1, 0, 0, 0, 0, MINIT, MINIT, 0.0f, og + ((size_t)(b * L + tq0) * 3 + g) * 256 + h * 64, og + ((size_t)(b * L + tq1) * 3 + g) * 256 + h * 64,
                         lse + ((size_t)(b * L + tq0) * 3 + g) * 4 + h, lse + ((size_t)(b * L + tq1) * 3 + g) * 4 + h);
        } else {
            const int j = task - NT_A - NT_B, h = j & 7, cbi = (j >> 3) & 127, b = j >> 10, ip = cbi >> 2, cb = cbi & 3;
            const int gi0 = 4 * ip + (qi >> 4), gi1 = gi0 + 2, gc = 16 * cb + (qi & 15), tq0 = gi0 * 64 + gc, tq1 = gi1 * 64 + gc;
            int cbs = 16 * cb - 8; cbs = cbs < 0 ? 0 : (cbs > 32 ? 32 : cbs);
            int rlo = 4 * ip - 4; rlo = rlo < 0 ? 0 : (rlo > 120 ? 120 : rlo);
            int rhi = 4 * ip + 3 - 4; rhi = rhi < 0 ? 0 : (rhi > 120 ? 120 : rhi); rhi += 7;
            bf16* ob = oabc + (size_t)(b * L) * OW + 768 + h * 64;
            att_task2<2>(wl, lane, qkv + (size_t)b * L * QKVW, TC + h * 1024, nullptr, CQ + h * 64, CQ + h * 64, CK + h * 64, CV + h * 64, cbs, 64, 1, rlo, rhi,
                         tq0, tq1, 0, gi0, gi1, gc, cbs, MINIT, MINIT, 0.0f, ob + (size_t)tq0 * OW, ob + (size_t)tq1 * OW, nullptr, nullptr);
        }
    }
}

constexpr int NSTEPS = 1 + DEPTH * 16;
__global__ void __launch_bounds__(NTHREADS, 2) mk_fwd(Args args) {
    extern __shared__ __attribute__((aligned(16))) unsigned char lds[];
    Frame F;
    F.lds = (LAS unsigned char*)lds; F.wave = __builtin_amdgcn_readfirstlane((int)threadIdx.x >> 6); F.lane = hw_lane(); F.tid = F.wave * 64 + F.lane;
    F.G = gridDim.x; { const int bx = blockIdx.x; F.vcu = (F.G % 8 == 0) ? (bx % 8) * (F.G / 8) + bx / 8 : bx; }
    F.in = args.in; F.h = args.out; F.ws = args.ws; F.probe = args.probe;
    volatile LAS unsigned* MISC = (volatile LAS unsigned*)(F.lds + MISC_OFF);
    if (F.tid < 32) MISC[F.tid] = 0u;
    __syncthreads();
    const int lo = args.s_lo, hi = args.s_hi;
    XcdBarrier bar; bar.wave0 = (F.wave == 0); bar.bar = (unsigned*)(F.ws + WS_CTL) + CW_BAR; bar.x = 0; bar.st = nullptr;
    if (hi - lo > 1) bar = xcd_barrier_post((unsigned*)(F.ws + WS_CTL) + CW_BAR, MISC + 8, F.wave == 0);
#define RUN(s) (lo <= (s) && (s) < hi)
#define SEAM(s) do { if (RUN(s) && RUN((s) + 1)) xcd_barrier(bar); } while (0)
    if (RUN(0)) { ph_prologue(F); ph_tables(F); ph_ln0(F); }
    SEAM(0);
    for (int l = 0; l < DEPTH; ++l) {
        const int sb = 1 + l * 16;
        for (int c = 0; c < NCHUNK; ++c) {
            const int s = sb + c * 6;
            if (RUN(s)) ph_p1(F, l, c);
            SEAM(s);
            if (RUN(s + 1)) ph_att(F, l);
            SEAM(s + 1);
            if (RUN(s + 2)) ph_cmb(F);
            SEAM(s + 2);
            if (RUN(s + 3)) ph_p3(F, l);
            SEAM(s + 3);
            if (RUN(s + 4)) ph_p4(F, l, c);
            SEAM(s + 4);
            if (RUN(s + 5)) ph_ln1(F, l, c);
            if (c == NCHUNK - 1) SEAM(s + 5);
        }
        if (RUN(sb + 12)) ph_dsp(F, l);
        SEAM(sb + 12);
        if (RUN(sb + 13)) ph_p7(F, l);
        SEAM(sb + 13);
        if (RUN(sb + 14)) ph_p8(F, l);
        SEAM(sb + 14);
        if (RUN(sb + 15)) ph_ln2(F, l);
        SEAM(sb + 15);
    }
#undef RUN
#undef SEAM
}

extern "C" void kernel_launch(void* const* d_in, const int* in_sizes, int n_in, void* d_out, int out_size, void* d_ws, size_t ws_size, hipStream_t stream) {
    static int grid = 0;
    if (grid == 0) {
        if (n_in != 23 || out_size != T * D || ws_size < WS_END) { fprintf(stderr, "kernel_launch: unexpected shapes (n_in %d out %d ws %zu)\n", n_in, out_size, ws_size); grid = -1; return; }
        int dev = 0, cus = 0, per_cu = 0;
        if (hipGetDevice(&dev) != hipSuccess || hipDeviceGetAttribute(&cus, hipDeviceAttributeMultiprocessorCount, dev) != hipSuccess) { grid = -1; return; }
        if (hipFuncSetAttribute((const void*)mk_fwd, hipFuncAttributeMaxDynamicSharedMemorySize, LDS_BYTES) != hipSuccess) { fprintf(stderr, "kernel_launch: hipFuncSetAttribute failed\n"); grid = -1; return; }
        if (hipOccupancyMaxActiveBlocksPerMultiprocessor(&per_cu, (const void*)mk_fwd, NTHREADS, LDS_BYTES) != hipSuccess || per_cu < 1) fprintf(stderr, "kernel_launch: occupancy query reports %d\n", per_cu);
        (void)hipGetLastError();
        grid = cus > 256 ? 256 : cus;
    }
    if (grid < 0) return;
    (void)hipMemsetAsync((unsigned char*)d_ws + WS_CTL, 0, CTL_ZERO_BYTES, stream);
    Args a{};
    for (int i = 0; i < 23; ++i) a.in[i] = (const float*)d_in[i];
    a.out = (float*)d_out; a.ws = (unsigned char*)d_ws; a.s_lo = 0; a.s_hi = NSTEPS; a.probe = 0; a.pad = 0;
    hipLaunchKernelGGL(mk_fwd, dim3(grid), dim3(NTHREADS), LDS_BYTES, stream, a);
}
```

```cpp
#include <hip/hip_runtime.h>
#include <cstdio>
#include <cstdint>
#include <cmath>

typedef unsigned short bf16;
typedef short bf16x8 __attribute__((ext_vector_type(8)));
typedef float f32x16 __attribute__((ext_vector_type(16)));
typedef float f32x4 __attribute__((ext_vector_type(4)));

constexpr int D = 1024, L = 8192, NBATCH = 8, T = NBATCH * L, DEPTH = 2;
constexpr int NCOL = 7680, QKVW = 4608, GATEW = 3072;
constexpr int CH = 32768, NCHUNK = T / CH;
constexpr int OW = 1280;
constexpr int NE = 32, DE = 512;
constexpr int MAXRT = T * 2 / 256 + NE, PROWS = MAXRT * 256;
constexpr float LN_EPS = 1e-5f;
constexpr float ALPHA = 1.41421356237309515f;
constexpr int AQ = 0, AK = 512, AV = 640, BQ0 = 768, CQ = 3072, CK = 3584, CV = 4096;

constexpr size_t MiB = 1u << 20;
constexpr size_t WS_CTL = 0;
constexpr size_t WS_WIN = 1 * MiB, WS_WBRA = 31 * MiB, WS_WBRB = 33 * MiB, WS_WBRC = 34 * MiB, WS_WOUT = 36 * MiB, WS_WGU = 40 * MiB, WS_WD = 168 * MiB;
constexpr size_t WS_HB = 232 * MiB, WS_QKV = 360 * MiB, WS_GATES = 648 * MiB, WS_OABC = 840 * MiB, WS_OG = 920 * MiB, WS_LSE = 968 * MiB,
                 WS_REC = 970 * MiB, WS_ROWTOK = 972 * MiB, WS_ROWGATE = 973 * MiB, WS_TABA = 974 * MiB, WS_TABB = WS_TABA + 16384, WS_TABC = WS_TABA + 32768, WS_WGCNT = WS_TABA + 131072  , WS_END = 975 * MiB;
constexpr size_t WS_MERGED = WS_QKV, WS_HID = WS_QKV, WS_YB = WS_QKV + 136 * MiB;
constexpr int CSTR = 32;

__device__ __constant__ signed char BUCK_A[257] = {12,11,11,11,11,11,11,11,11,11,11,11,11,11,11,11,11,11,11,11,11,11,11,11,11,11,11,11,11,11,11,11,11,11,11,11,11,11,11,11,11,11,11,11,11,11,11,11,11,11,11,11,11,11,11,11,11,11,11,11,11,11,11,11,11,10,10,10,10,10,10,10,10,10,10,10,10,10,10,10,10,10,10,10,10,10,10,10,10,10,10,10,10,10,10,10,10,9,9,9,9,9,9,9,9,9,9,9,9,9,9,9,9,8,8,8,8,8,8,8,8,7,6,5,4,3,2,1,0,17,18,19,20,21,22,23,24,24,24,24,24,24,24,24,25,25,25,25,25,25,25,25,25,25,25,25,25,25,25,25,26,26,26,26,26,26,26,26,26,26,26,26,26,26,26,26,26,26,26,26,26,26,26,26,26,26,26,26,26,26,26,26,27,27,27,27,27,27,27,27,27,27,27,27,27,27,27,27,27,27,27,27,27,27,27,27,27,27,27,27,27,27,27,27,27,27,27,27,27,27,27,27,27,27,27,27,27,27,27,27,27,27,27,27,27,27,27,27,27,27,27,27,27,27,27,27,28};
__device__ __constant__ signed char BUCK_B[3][129] = {
 {11,10,10,10,10,10,10,10,10,10,10,10,10,10,10,10,10,10,10,10,10,10,10,10,10,10,10,10,10,10,10,10,10,9,9,9,9,9,9,9,9,9,9,9,9,9,9,9,9,8,8,8,8,8,8,8,8,7,6,5,4,3,2,1,0,17,18,19,20,21,22,23,24,24,24,24,24,24,24,24,25,25,25,25,25,25,25,25,25,25,25,25,25,25,25,25,26,26,26,26,26,26,26,26,26,26,26,26,26,26,26,26,26,26,26,26,26,26,26,26,26,26,26,26,26,26,26,26,27},
 {13,12,12,12,12,12,12,12,12,12,12,12,12,12,12,12,12,12,12,12,12,12,12,12,12,12,12,12,12,12,12,12,12,11,11,11,11,11,11,11,11,11,11,11,11,11,11,11,11,10,10,10,10,10,10,10,10,9,9,9,9,8,8,4,0,20,24,24,25,25,25,25,26,26,26,26,26,26,26,26,27,27,27,27,27,27,27,27,27,27,27,27,27,27,27,27,28,28,28,28,28,28,28,28,28,28,28,28,28,28,28,28,28,28,28,28,28,28,28,28,28,28,28,28,28,28,28,28,29},
 {15,14,14,14,14,14,14,14,14,14,14,14,14,14,14,14,14,14,14,14,14,14,14,14,14,14,14,14,14,14,14,14,14,13,13,13,13,13,13,13,13,13,13,13,13,13,13,13,13,12,12,12,12,12,12,12,12,11,11,11,11,10,10,9,0,25,26,26,27,27,27,27,28,28,28,28,28,28,28,28,29,29,29,29,29,29,29,29,29,29,29,29,29,29,29,29,30,30,30,30,30,30,30,30,30,30,30,30,30,30,30,30,30,30,30,30,30,30,30,30,30,30,30,30,30,30,30,30,31}};

__device__ __forceinline__ float bf2f(bf16 b) { return __uint_as_float(((unsigned)b) << 16); }
__device__ __forceinline__ bf16 f2bf(float f) { unsigned u = __float_as_uint(f); u += 0x7fffu + ((u >> 16) & 1u); return (bf16)(u >> 16); }
__device__ __forceinline__ float wave_sum(float v) {
#pragma unroll
    for (int o = 1; o < 64; o <<= 1) v += __shfl_xor(v, o);
    return v;
}

struct Rec { int e0, s0, e1, s1; float g0, g1; int pad0, pad1; };

#ifndef PG8_ALIGN
#define PG8_ALIGN 1
#endif
namespace pg8 {
#define PG8_LAS __attribute__((address_space(3)))
typedef unsigned short bf16_t;
typedef unsigned u32x4 __attribute__((ext_vector_type(4)));
constexpr int BM = 256, BK = 64, HALF = 128, HTB = HALF * BK * 2  , STAGE_BYTES = 8 * HTB, NXCD = 8, WGM = 4;

__host__ __device__ __forceinline__ int lds_byte(int r, int c) { const int st = (r >> 4) * 2 + (c >> 5), rr = r & 15, cc = c & 31, ob = rr * 64 + cc * 2; return st * 1024 + (ob ^ (((ob >> 9) & 1) << 5)); }
__host__ __device__ __forceinline__ void stage_rc(int b, int& R, int& C) { const int st = b / 1024, sb = b % 1024, swz = sb ^ (((sb >> 9) & 1) << 5); R = (st >> 1) * 16 + swz / 64; C = (st & 1) * 32 + (swz % 64) / 2; }
__host__ __device__ __forceinline__ int perm32(int rho) { const int n = rho >> 4, i = rho & 15; return 8 * (i >> 2) + 4 * n + (i & 3); }

struct Unit { int pm, pn, e, ui; };

struct DenseOrder {
    int nM, nN, nwg, G, c; const char* A; const char* B; size_t tstepA, tstepB;
    __device__ void init(const void* A_, int lda, const void* B_, int ldb, int M, int N, int G_, int c_) { nM = M / BM; nN = N / BM; nwg = nM * nN; G = G_; c = c_; A = (const char*)A_; B = (const char*)B_; tstepA = (size_t)BM * lda * 2; tstepB = (size_t)BM * ldb * 2; }
    __device__ bool next(int i, Unit& u) const {
        const long Lx = (long)i * G + c; if (Lx >= nwg) return false;
        int wgid = (int)Lx; { const int q = nwg / NXCD, r = nwg % NXCD, xcd = wgid % NXCD, off = wgid / NXCD; wgid = (xcd < r ? xcd * (q + 1) : r * (q + 1) + (xcd - r) * q) + off; }
        const int nig = WGM * nN, gid = wgid / nig, fm = gid * WGM, gsz = (nM - fm) < WGM ? (nM - fm) : WGM;
        u.pm = fm + ((wgid % nig) % gsz); u.pn = (wgid % nig) / gsz; u.e = 0; u.ui = i; return true;
    }
    __device__ __forceinline__ const char* a_base(const Unit& u) const { return A + (size_t)u.pm * tstepA; }
    __device__ __forceinline__ const char* b_base(const Unit& u) const { return B + (size_t)u.pn * tstepB; }
    __device__ __forceinline__ int a_row(const Unit&, int) const { return 0; }
};

__device__ __forceinline__ unsigned cvt_pk_bf16(float lo, float hi) { unsigned r; asm volatile("v_cvt_pk_bf16_f32 %0, %1, %2" : "=v"(r) : "v"(lo), "v"(hi)); return r; }

template <class Epi, class Sched, bool GATHER>
__device__ __forceinline__ void gemm_phase(PG8_LAS unsigned char* lds, const Sched& S, const Epi& E, const int K, const int lda, const int ldb, const int tid_in) {
    int tid = tid_in; asm volatile("" : "+v"(tid));
    const int wid = __builtin_amdgcn_readfirstlane(tid >> 6), lane = tid & 63, wr = wid >> 2, wc = wid & 3, fr = lane & 15, fq = lane >> 4;
    const int nt = K / BK;
    int RA[2], CA[2]; unsigned voffB[2];
#pragma unroll
    for (int i = 0; i < 2; ++i) { int R, C; stage_rc(tid * 16 + i * 8192, R, C); const int Rb = Epi::PERM ? ((R & ~31) + perm32(R & 31)) : R; RA[i] = R; CA[i] = C; voffB[i] = (unsigned)(Rb * ldb + C) * 2u; }
    const size_t kstep = (size_t)(BK * 2);
    const size_t hstepB = (size_t)HALF * ldb * 2;
    const unsigned ldsw = (unsigned)wid * 1024u;
    const int aoff = lds_byte(wr * 64 + fr, fq * 8), boff = lds_byte(wc * 32 + fr, fq * 8);
#define PG8_SA(b, h) (((b) * 2 + (h)) * HTB)
#define PG8_SB(b, h) ((4 + (b) * 2 + (h)) * HTB)
#define PG8_STAGE2(bufoff, gbase, v0, v1) do { \
        __builtin_amdgcn_global_load_lds((const unsigned*)((const char*)(gbase) + (v0)), (PG8_LAS unsigned*)(lds + (bufoff) + ldsw), 16, 0, 0); \
        __builtin_amdgcn_global_load_lds((const unsigned*)((const char*)(gbase) + (v1)), (PG8_LAS unsigned*)(lds + (bufoff) + ldsw + 8192), 16, 0, 0); } while (0)
#define PG8_STAGEB(bufoff, gbase) PG8_STAGE2(bufoff, gbase, voffB[0], voffB[1])
#define PG8_LDA(dst, b, h) do { _Pragma("unroll") for (int m = 0; m < 4; ++m) _Pragma("unroll") for (int k = 0; k < 2; ++k) dst[m][k] = *(const PG8_LAS bf16x8*)(lds + PG8_SA(b, h) + aoff + m * 2048 + k * 1024); } while (0)
#define PG8_LDB(dst, b, h) do { _Pragma("unroll") for (int n = 0; n < 2; ++n) _Pragma("unroll") for (int k = 0; k < 2; ++k) dst[n][k] = *(const PG8_LAS bf16x8*)(lds + PG8_SB(b, h) + boff + n * 2048 + k * 1024); } while (0)
#define PG8_MMA(ai, bj, At, Bt) do { __builtin_amdgcn_s_setprio(1); _Pragma("unroll") for (int m = 0; m < 4; ++m) _Pragma("unroll") for (int n = 0; n < 2; ++n) _Pragma("unroll") for (int k = 0; k < 2; ++k) \
        acc[ai][bj][m][n] = __builtin_amdgcn_mfma_f32_16x16x32_bf16(Bt[n][k], At[m][k], acc[ai][bj][m][n], 0, 0, 0); __builtin_amdgcn_s_setprio(0); } while (0)
#define PG8_WAIT_V(n) asm volatile("s_waitcnt vmcnt(" #n ")" ::: "memory")
#define PG8_WAIT_L(n) asm volatile("s_waitcnt lgkmcnt(" #n ")" ::: "memory")
#define PG8_BAR __builtin_amdgcn_s_barrier()
#define PG8_SCHED __builtin_amdgcn_sched_barrier(0)
#define PG8_VOFFA(dst, u) do { _Pragma("unroll") for (int h_ = 0; h_ < 2; ++h_) _Pragma("unroll") for (int i_ = 0; i_ < 2; ++i_) { \
        const int row_ = GATHER ? S.a_row(u, h_ * HALF + RA[i_]) : (h_ * HALF + RA[i_]); dst[h_][i_] = (unsigned)(row_ * lda + CA[i_]) * 2u; } } while (0)
    Unit cur, nxt;
    if (!S.next(0, cur)) return;
    f32x4 acc[2][2][4][2];
#pragma unroll
    for (int a = 0; a < 2; ++a)
#pragma unroll
        for (int b = 0; b < 2; ++b)
#pragma unroll
            for (int m = 0; m < 4; ++m)
#pragma unroll
                for (int n = 0; n < 2; ++n) acc[a][b][m][n] = (f32x4){0.f, 0.f, 0.f, 0.f};
    bf16x8 At[4][2], B0[2][2], B1[2][2];
    unsigned vc[2][2], vn[2][2];
    PG8_VOFFA(vc, cur);
    const char* cA = S.a_base(cur); const char* cB = S.b_base(cur);
    PG8_STAGEB(PG8_SB(0, 0), cB); PG8_STAGEB(PG8_SB(0, 1), cB + hstepB); PG8_STAGE2(PG8_SA(0, 0), cA, vc[0][0], vc[0][1]); PG8_STAGE2(PG8_SA(0, 1), cA, vc[1][0], vc[1][1]);
    if (wr == 1) PG8_BAR;
    PG8_WAIT_V(2); PG8_BAR;
    PG8_STAGEB(PG8_SB(1, 0), cB + kstep); PG8_STAGE2(PG8_SA(1, 0), cA + kstep, vc[0][0], vc[0][1]); PG8_STAGEB(PG8_SB(1, 1), cB + hstepB + kstep);
    PG8_WAIT_V(6); PG8_BAR;
    int ui = 0;
    for (;;) {
        const bool has_next = S.next(ui + 1, nxt);
        const char* nA = has_next ? S.a_base(nxt) : cA; const char* nB = has_next ? S.b_base(nxt) : cB;
        if (GATHER) { if (has_next) { PG8_VOFFA(vn, nxt); } else {
#pragma unroll
            for (int h_ = 0; h_ < 2; ++h_) { vn[h_][0] = vc[h_][0]; vn[h_][1] = vc[h_][1]; } } }
        for (int t = 0; t < nt; t += 2) {
            const bool last = (t == nt - 2);
            const char* a1 = cA + (size_t)(t + 1) * kstep;
            const char* a2 = last ? nA : cA + (size_t)(t + 2) * kstep; const char* b2 = last ? nB : cB + (size_t)(t + 2) * kstep;
            const char* a3 = a2 + kstep; const char* b3 = b2 + kstep;
            unsigned w00, w01, w10, w11;
            if (GATHER) { w00 = last ? vn[0][0] : vc[0][0]; w01 = last ? vn[0][1] : vc[0][1]; w10 = last ? vn[1][0] : vc[1][0]; w11 = last ? vn[1][1] : vc[1][1]; }
            else { w00 = vc[0][0]; w01 = vc[0][1]; w10 = vc[1][0]; w11 = vc[1][1]; }
            PG8_LDB(B0, 0, 0); PG8_LDB(B1, 0, 1); PG8_SCHED; PG8_LDA(At, 0, 0); PG8_STAGE2(PG8_SA(1, 1), a1, vc[1][0], vc[1][1]);
            PG8_WAIT_V(8); PG8_WAIT_L(0); PG8_BAR; PG8_MMA(0, 0, At, B0); PG8_MMA(0, 1, At, B1); PG8_BAR; PG8_SCHED;
            PG8_LDA(At, 0, 1); PG8_STAGEB(PG8_SB(0, 0), b2); PG8_STAGEB(PG8_SB(0, 1), b2 + hstepB); PG8_STAGE2(PG8_SA(0, 0), a2, w00, w01);
            PG8_WAIT_V(8); PG8_WAIT_L(0); PG8_BAR; PG8_MMA(1, 0, At, B0); PG8_MMA(1, 1, At, B1); PG8_BAR; PG8_SCHED;
            PG8_LDB(B0, 1, 0); PG8_LDB(B1, 1, 1); PG8_SCHED; PG8_LDA(At, 1, 0); PG8_STAGE2(PG8_SA(0, 1), a2, w10, w11);
            PG8_WAIT_V(8); PG8_WAIT_L(0); PG8_BAR; PG8_MMA(0, 0, At, B0); PG8_MMA(0, 1, At, B1); PG8_BAR; PG8_SCHED;
            PG8_LDA(At, 1, 1); PG8_STAGEB(PG8_SB(1, 0), b3); PG8_STAGEB(PG8_SB(1, 1), b3 + hstepB); PG8_STAGE2(PG8_SA(1, 0), a3, w00, w01);
            PG8_WAIT_V(8); PG8_WAIT_L(0); PG8_BAR; PG8_MMA(1, 0, At, B0); PG8_MMA(1, 1, At, B1); PG8_BAR; PG8_SCHED;
        }
        if (PG8_ALIGN && wr == 0) PG8_BAR;
        E(acc, cur, wr, wc, fr, fq);
        if (!has_next) break;
#pragma unroll
        for (int a = 0; a < 2; ++a)
#pragma unroll
            for (int b = 0; b < 2; ++b)
#pragma unroll
                for (int m = 0; m < 4; ++m)
#pragma unroll
                    for (int n = 0; n < 2; ++n) acc[a][b][m][n] = (f32x4){0.f, 0.f, 0.f, 0.f};
        cur = nxt; cA = nA; cB = nB; ++ui;
        if (GATHER) {
#pragma unroll
            for (int h_ = 0; h_ < 2; ++h_) { vc[h_][0] = vn[h_][0]; vc[h_][1] = vn[h_][1]; } }
        if (PG8_ALIGN && wr == 1) PG8_BAR;
    }
    PG8_WAIT_V(0);
    if (!PG8_ALIGN && wr == 0) PG8_BAR;
    PG8_BAR;
#undef PG8_SA
#undef PG8_SB
#undef PG8_STAGE2
#undef PG8_STAGEB
#undef PG8_LDA
#undef PG8_LDB
#undef PG8_MMA
#undef PG8_WAIT_V
#undef PG8_WAIT_L
#undef PG8_BAR
#undef PG8_SCHED
#undef PG8_VOFFA
}
template <class Epi, class Sched>
__device__ __forceinline__ void gemm_phase_vk(PG8_LAS unsigned char* lds, const Sched& S, const Epi& E, const int lda, const int tid_in) {
    constexpr bool GATHER = false;
    int tid = tid_in; asm volatile("" : "+v"(tid));
    const int wid = __builtin_amdgcn_readfirstlane(tid >> 6), lane = tid & 63, wr = wid >> 2, wc = wid & 3, fr = lane & 15, fq = lane >> 4;
    int RA[2], CA[2], RB[2];
#pragma unroll
    for (int i = 0; i < 2; ++i) { int R, C; stage_rc(tid * 16 + i * 8192, R, C); const int Rb = Epi::PERM ? ((R & ~31) + perm32(R & 31)) : R; RA[i] = R; CA[i] = C; RB[i] = Rb; }
    const size_t kstep = (size_t)(BK * 2);
    const unsigned ldsw = (unsigned)wid * 1024u;
    const int aoff = lds_byte(wr * 64 + fr, fq * 8), boff = lds_byte(wc * 32 + fr, fq * 8);
#define PG8_SA(b, h) (((b) * 2 + (h)) * HTB)
#define PG8_SB(b, h) ((4 + (b) * 2 + (h)) * HTB)
#define PG8_STAGE2(bufoff, gbase, v0, v1) do { \
        __builtin_amdgcn_global_load_lds((const unsigned*)((const char*)(gbase) + (v0)), (PG8_LAS unsigned*)(lds + (bufoff) + ldsw), 16, 0, 0); \
        __builtin_amdgcn_global_load_lds((const unsigned*)((const char*)(gbase) + (v1)), (PG8_LAS unsigned*)(lds + (bufoff) + ldsw + 8192), 16, 0, 0); } while (0)
#define PG8_VOFFB(dst, hs, u) do { const int ldb_ = S.ldb_of(u); _Pragma("unroll") for (int i_ = 0; i_ < 2; ++i_) { int R_, C_; stage_rc(tid * 16 + i_ * 8192, R_, C_); const int Rb_ = Epi::PERM ? ((R_ & ~31) + perm32(R_ & 31)) : R_; dst[i_] = (unsigned)(Rb_ * ldb_ + C_) * 2u; } hs = (size_t)HALF * ldb_ * 2; } while (0)
#define PG8_LDA(dst, b, h) do { _Pragma("unroll") for (int m = 0; m < 4; ++m) _Pragma("unroll") for (int k = 0; k < 2; ++k) dst[m][k] = *(const PG8_LAS bf16x8*)(lds + PG8_SA(b, h) + aoff + m * 2048 + k * 1024); } while (0)
#define PG8_LDB(dst, b, h) do { _Pragma("unroll") for (int n = 0; n < 2; ++n) _Pragma("unroll") for (int k = 0; k < 2; ++k) dst[n][k] = *(const PG8_LAS bf16x8*)(lds + PG8_SB(b, h) + boff + n * 2048 + k * 1024); } while (0)
#define PG8_MMA(ai, bj, At, Bt) do { __builtin_amdgcn_s_setprio(1); _Pragma("unroll") for (int m = 0; m < 4; ++m) _Pragma("unroll") for (int n = 0; n < 2; ++n) _Pragma("unroll") for (int k = 0; k < 2; ++k) \
        acc[ai][bj][m][n] = __builtin_amdgcn_mfma_f32_16x16x32_bf16(Bt[n][k], At[m][k], acc[ai][bj][m][n], 0, 0, 0); __builtin_amdgcn_s_setprio(0); } while (0)
#define PG8_WAIT_V(n) asm volatile("s_waitcnt vmcnt(" #n ")" ::: "memory")
#define PG8_WAIT_L(n) asm volatile("s_waitcnt lgkmcnt(" #n ")" ::: "memory")
#define PG8_BAR __builtin_amdgcn_s_barrier()
#define PG8_SCHED __builtin_amdgcn_sched_barrier(0)
#define PG8_VOFFA(dst, u) do { _Pragma("unroll") for (int h_ = 0; h_ < 2; ++h_) _Pragma("unroll") for (int i_ = 0; i_ < 2; ++i_) { \
        const int row_ = GATHER ? S.a_row(u, h_ * HALF + RA[i_]) : (h_ * HALF + RA[i_]); dst[h_][i_] = (unsigned)(row_ * lda + CA[i_]) * 2u; } } while (0)
    Unit cur, nxt;
    if (!S.next(0, cur)) return;
    f32x4 acc[2][2][4][2];
#pragma unroll
    for (int a = 0; a < 2; ++a)
#pragma unroll
        for (int b = 0; b < 2; ++b)
#pragma unroll
            for (int m = 0; m < 4; ++m)
#pragma unroll
                for (int n = 0; n < 2; ++n) acc[a][b][m][n] = (f32x4){0.f, 0.f, 0.f, 0.f};
    bf16x8 At[4][2], B0[2][2], B1[2][2];
    unsigned vc[2][2], vn[2][2];
    PG8_VOFFA(vc, cur);
    unsigned vbc[2], vbn[2]; size_t hsc, hsn; PG8_VOFFB(vbc, hsc, cur); int nt = S.K_of(cur) / BK;
    const char* cA = S.a_base(cur); const char* cB = S.b_base(cur);
    PG8_STAGE2(PG8_SB(0, 0), cB, vbc[0], vbc[1]); PG8_STAGE2(PG8_SB(0, 1), cB + hsc, vbc[0], vbc[1]); PG8_STAGE2(PG8_SA(0, 0), cA, vc[0][0], vc[0][1]); PG8_STAGE2(PG8_SA(0, 1), cA, vc[1][0], vc[1][1]);
    if (wr == 1) PG8_BAR;
    PG8_WAIT_V(2); PG8_BAR;
    PG8_STAGE2(PG8_SB(1, 0), cB + kstep, vbc[0], vbc[1]); PG8_STAGE2(PG8_SA(1, 0), cA + kstep, vc[0][0], vc[0][1]); PG8_STAGE2(PG8_SB(1, 1), cB + hsc + kstep, vbc[0], vbc[1]);
    PG8_WAIT_V(6); PG8_BAR;
    int ui = 0;
    for (;;) {
        const bool has_next = S.next(ui + 1, nxt);
        const char* nA = has_next ? S.a_base(nxt) : cA; const char* nB = has_next ? S.b_base(nxt) : cB;
        if (has_next) { PG8_VOFFB(vbn, hsn, nxt); } else { vbn[0] = vbc[0]; vbn[1] = vbc[1]; hsn = hsc; }
        if (GATHER) { if (has_next) { PG8_VOFFA(vn, nxt); } else {
#pragma unroll
            for (int h_ = 0; h_ < 2; ++h_) { vn[h_][0] = vc[h_][0]; vn[h_][1] = vc[h_][1]; } } }
        for (int t = 0; t < nt; t += 2) {
            const bool last = (t == nt - 2);
            const char* a1 = cA + (size_t)(t + 1) * kstep;
            const char* a2 = last ? nA : cA + (size_t)(t + 2) * kstep; const char* b2 = last ? nB : cB + (size_t)(t + 2) * kstep;
            const char* a3 = a2 + kstep; const char* b3 = b2 + kstep;
            unsigned w00, w01, w10, w11;
            if (GATHER) { w00 = last ? vn[0][0] : vc[0][0]; w01 = last ? vn[0][1] : vc[0][1]; w10 = last ? vn[1][0] : vc[1][0]; w11 = last ? vn[1][1] : vc[1][1]; }
            else { w00 = vc[0][0]; w01 = vc[0][1]; w10 = vc[1][0]; w11 = vc[1][1]; }
            const unsigned wb0 = last ? vbn[0] : vbc[0], wb1 = last ? vbn[1] : vbc[1]; const size_t hsb = last ? hsn : hsc;
            PG8_LDB(B0, 0, 0); PG8_LDB(B1, 0, 1); PG8_SCHED; PG8_LDA(At, 0, 0); PG8_STAGE2(PG8_SA(1, 1), a1, vc[1][0], vc[1][1]);
            PG8_WAIT_V(8); PG8_WAIT_L(0); PG8_BAR; PG8_MMA(0, 0, At, B0); PG8_MMA(0, 1, At, B1); PG8_BAR; PG8_SCHED;
            PG8_LDA(At, 0, 1); PG8_STAGE2(PG8_SB(0, 0), b2, wb0, wb1); PG8_STAGE2(PG8_SB(0, 1), b2 + hsb, wb0, wb1); PG8_STAGE2(PG8_SA(0, 0), a2, w00, w01);
            PG8_WAIT_V(8); PG8_WAIT_L(0); PG8_BAR; PG8_MMA(1, 0, At, B0); PG8_MMA(1, 1, At, B1); PG8_BAR; PG8_SCHED;
            PG8_LDB(B0, 1, 0); PG8_LDB(B1, 1, 1); PG8_SCHED; PG8_LDA(At, 1, 0); PG8_STAGE2(PG8_SA(0, 1), a2, w10, w11);
            PG8_WAIT_V(8); PG8_WAIT_L(0); PG8_BAR; PG8_MMA(0, 0, At, B0); PG8_MMA(0, 1, At, B1); PG8_BAR; PG8_SCHED;
            PG8_LDA(At, 1, 1); PG8_STAGE2(PG8_SB(1, 0), b3, wb0, wb1); PG8_STAGE2(PG8_SB(1, 1), b3 + hsb, wb0, wb1); PG8_STAGE2(PG8_SA(1, 0), a3, w00, w01);
            PG8_WAIT_V(8); PG8_WAIT_L(0); PG8_BAR; PG8_MMA(1, 0, At, B0); PG8_MMA(1, 1, At, B1); PG8_BAR; PG8_SCHED;
        }
        if (PG8_ALIGN && wr == 0) PG8_BAR;
        E(acc, cur, wr, wc, fr, fq);
        if (!has_next) break;
#pragma unroll
        for (int a = 0; a < 2; ++a)
#pragma unroll
            for (int b = 0; b < 2; ++b)
#pragma unroll
                for (int m = 0; m < 4; ++m)
#pragma unroll
                    for (int n = 0; n < 2; ++n) acc[a][b][m][n] = (f32x4){0.f, 0.f, 0.f, 0.f};
        cur = nxt; cA = nA; cB = nB; ++ui; vbc[0] = vbn[0]; vbc[1] = vbn[1]; hsc = hsn; nt = S.K_of(cur) / BK;
        if (GATHER) {
#pragma unroll
            for (int h_ = 0; h_ < 2; ++h_) { vc[h_][0] = vn[h_][0]; vc[h_][1] = vn[h_][1]; } }
        if (PG8_ALIGN && wr == 1) PG8_BAR;
    }
    PG8_WAIT_V(0);
    if (!PG8_ALIGN && wr == 0) PG8_BAR;
    PG8_BAR;
#undef PG8_SA
#undef PG8_SB
#undef PG8_STAGE2
#undef PG8_VOFFB
#undef PG8_LDA
#undef PG8_LDB
#undef PG8_MMA
#undef PG8_WAIT_V
#undef PG8_WAIT_L
#undef PG8_BAR
#undef PG8_SCHED
#undef PG8_VOFFA
}
}

constexpr int NWAVES = 8, NTHREADS = 512;
constexpr int RING_OFF = 0, RING_BYTES = 131072, ROWS_OFF = 131072, ROWS_BYTES = 12288, ROUTER_BYTES = 147456  , MISC_OFF = ROUTER_BYTES, LCNT_OFF = MISC_OFF + 128  , LDS_BYTES = 148480;
static_assert(MISC_OFF + 128 <= LDS_BYTES, "LDS map");
constexpr int CW_CNT = 0;
constexpr int CW_BAR = 4096;
constexpr size_t CTL_ZERO_BYTES = 64 * 1024;
constexpr float LOG2E = 1.4426950408889634f, LN2 = 0.6931471805599453f;
constexpr float QSCALE = 0.125f * LOG2E;

#define GAS __attribute__((address_space(1)))
#define LAS __attribute__((address_space(3)))
typedef unsigned v4u __attribute__((ext_vector_type(4)));
typedef unsigned v2u __attribute__((ext_vector_type(2)));
#define LDS_WAIT() asm volatile("s_waitcnt lgkmcnt(0)" ::: "memory")
__device__ __forceinline__ unsigned pk2(float lo, float hi) { return (unsigned)f2bf(lo) | ((unsigned)f2bf(hi) << 16); }

#define XB_TMO      128
#define XB_XCNT(j)  (256  + 64 * (j))
#define XB_XSUB(j)  (1280 + 64 * (j))
#define XB_XGEN(j)  (2304 + 64 * (j))
#define XB_TOP      3328
#define XB_TOPGEN   3392
#define XCD_BAR_WORDS 3456
#define XB_SPIN_CAP (1u << 18)

__device__ __forceinline__ unsigned xb_ld(unsigned* p)              { return __hip_atomic_load(p, __ATOMIC_RELAXED, __HIP_MEMORY_SCOPE_AGENT); }
__device__ __forceinline__ unsigned xb_add(unsigned* p, unsigned v) { return __hip_atomic_fetch_add(p, v, __ATOMIC_RELAXED, __HIP_MEMORY_SCOPE_AGENT); }
__device__ __forceinline__ unsigned xb_xcc_id() { return (unsigned)__builtin_amdgcn_s_getreg((3 << 11) | 20) & 0xFu; }
#define XB_SPIN(cond, bar) do { unsigned _sp = 0; while (cond) { __builtin_amdgcn_s_sleep(1); \
    if ((++_sp & 255u) == 0u) { if (xb_ld(&(bar)[XB_TMO])) break; if (_sp > XB_SPIN_CAP) { atomicAdd(&(bar)[XB_TMO], 1u); break; } } } } while (0)

struct XcdBarrier {
    int wave0;
    unsigned* bar; unsigned x;
    volatile LAS unsigned* st;
};

__device__ __forceinline__ unsigned xb_lane() { unsigned l_; asm volatile("v_mbcnt_lo_u32_b32 %0, -1, 0\n\tv_mbcnt_hi_u32_b32 %0, -1, %0" : "=v"(l_)); return l_; }
__device__ __forceinline__ XcdBarrier xcd_barrier_post(unsigned* bar, volatile LAS unsigned* st, int wave0) {
    XcdBarrier b; b.wave0 = wave0; b.bar = bar; b.x = xb_xcc_id(); b.st = st;
    if (b.wave0 && xb_lane() == 0u) (void)xb_add(&bar[XB_XCNT(b.x)], 1u);
    return b;
}
__device__ __forceinline__ void xcd_barrier_complete(unsigned* bar, unsigned x, unsigned& nloc, unsigned& nx) {
    const unsigned G = gridDim.x * gridDim.y * gridDim.z;
    unsigned sum, cnt, mine, sp = 0u;
    for (;;) {
        sum = 0u; cnt = 0u; mine = 0u;
#pragma unroll
        for (unsigned j = 0; j < 16; ++j) { const unsigned c = xb_ld(&bar[XB_XCNT(j)]); sum += c; cnt += (c > 0u) ? 1u : 0u; mine = (j == x) ? c : mine; }
        if (sum == G) break;
        __builtin_amdgcn_s_sleep(1);
        if ((++sp & 255u) == 0u) { if (xb_ld(&bar[XB_TMO])) break; if (sp > XB_SPIN_CAP) { atomicAdd(&bar[XB_TMO], 1u); break; } }
    }
    nloc = mine > 0u ? mine : 1u; nx = cnt > 0u ? cnt : 1u;
}

__device__ __forceinline__ void xcd_barrier(const XcdBarrier& b) {
    asm volatile("s_waitcnt vmcnt(0)" ::: "memory");
    __syncthreads();
    if (b.wave0 && xb_lane() == 0u) {
        unsigned* bar = b.bar;
        __builtin_amdgcn_s_waitcnt(0);
        unsigned nloc = b.st[0], nx = b.st[1];
        if (nloc == 0u) { xcd_barrier_complete(bar, b.x, nloc, nx); b.st[0] = nloc; b.st[1] = nx; }
        const unsigned old = xb_add(&bar[XB_XSUB(b.x)], 1u);
        const unsigned gen = old / nloc;
        if (old + 1u == (gen + 1u) * nloc) {
            __builtin_amdgcn_fence(__ATOMIC_RELEASE, "agent");
            asm volatile("s_waitcnt vmcnt(0)" ::: "memory");
            const unsigned og = xb_add(&bar[XB_TOP], 1u);
            const unsigned tg = og / nx;
            if (og + 1u == (tg + 1u) * nx) xb_add(&bar[XB_TOPGEN], 1u);
            else XB_SPIN(xb_ld(&bar[XB_TOPGEN]) == tg, bar);
            __builtin_amdgcn_fence(__ATOMIC_ACQUIRE, "agent");
            xb_add(&bar[XB_XGEN(b.x)], 1u);
            asm volatile("s_waitcnt vmcnt(0)" ::: "memory");
        } else {
            XB_SPIN(xb_ld(&bar[XB_XGEN(b.x)]) == gen, bar);
            __builtin_amdgcn_fence(__ATOMIC_ACQUIRE, "agent");
            asm volatile("s_waitcnt vmcnt(0)" ::: "memory");
        }
    }
    __syncthreads();
}


struct Args { const float* in[23]; float* out; unsigned char* ws; int s_lo, s_hi, probe, pad; };

struct Frame {
    LAS unsigned char* lds; int tid, lane, wave, vcu, G;
    const float* const* in; float* h; unsigned char* ws; int probe;
};

__device__ __forceinline__ int hw_lane() { int l_; asm volatile("v_mbcnt_lo_u32_b32 %0, -1, 0\n\tv_mbcnt_hi_u32_b32 %0, -1, %0" : "=v"(l_)); return l_; }
__device__ __forceinline__ float shfl_xor_l(float v, int mask, int lane) { return __builtin_bit_cast(float, __builtin_amdgcn_ds_bpermute((lane ^ mask) << 2, __builtin_bit_cast(int, v))); }
__device__ __forceinline__ float dpp_add(float v, const int ctrl_sel) {
    const int x = __builtin_bit_cast(int, v); int y;
    if (ctrl_sel == 0) y = __builtin_amdgcn_mov_dpp(x, 0xB1, 0xF, 0xF, true);
    else if (ctrl_sel == 1) y = __builtin_amdgcn_mov_dpp(x, 0x4E, 0xF, 0xF, true);
    else if (ctrl_sel == 2) y = __builtin_amdgcn_mov_dpp(x, 0x141, 0xF, 0xF, true);
    else y = __builtin_amdgcn_mov_dpp(x, 0x140, 0xF, 0xF, true);
    return v + __builtin_bit_cast(float, y);
}
__device__ __forceinline__ float wave_sum_l(float v, int lane) {
    (void)lane;
    v = dpp_add(v, 0); v = dpp_add(v, 1); v = dpp_add(v, 2); v = dpp_add(v, 3);
    const int x = __builtin_bit_cast(int, v);
    const float r0 = __builtin_bit_cast(float, __builtin_amdgcn_readlane(x, 0)), r1 = __builtin_bit_cast(float, __builtin_amdgcn_readlane(x, 16)),
                r2 = __builtin_bit_cast(float, __builtin_amdgcn_readlane(x, 32)), r3 = __builtin_bit_cast(float, __builtin_amdgcn_readlane(x, 48));
    return (r0 + r1) + (r2 + r3);
}
#define LAUNDER(F) do { (F).lane = hw_lane(); (F).tid = (F).wave * 64 + (F).lane; asm volatile("" : "+s"((F).G), "+s"((F).vcu), "+s"((F).ws), "+s"((F).h)); } while (0)
__device__ __forceinline__ void p0_item(const float* W, int ldw, int k0, int n0, bf16* WT, int Kd, int drow0, float scale, LAS float* scr, int lane) {
#pragma unroll 8
    for (int i = 0; i < 32; ++i) { const int kk = 2 * i + (lane >> 5); scr[kk * 33 + (lane & 31)] = W[(size_t)(k0 + kk) * ldw + n0 + (lane & 31)] * scale; }
    LDS_WAIT(); asm volatile("" ::: "memory");
    const int c = lane & 7;
#pragma unroll
    for (int j = 0; j < 4; ++j) { const int n = (lane >> 3) + 8 * j; const LAS float* s = scr + (8 * c) * 33 + n;
        v4u o; o.x = pk2(s[0 * 33], s[1 * 33]); o.y = pk2(s[2 * 33], s[3 * 33]); o.z = pk2(s[4 * 33], s[5 * 33]); o.w = pk2(s[6 * 33], s[7 * 33]);
        *(GAS v4u*)(WT + (size_t)(drow0 + n) * Kd + k0 + 8 * c) = o; }
    LDS_WAIT(); asm volatile("" ::: "memory");
}
__device__ __forceinline__ bool is_q_col(int n) { return n < 512 || (n >= 768 && n < 3072 && ((n - 768) % 768) < 256) || (n >= 3072 && n < 3584); }

__device__ __forceinline__ void ph_prologue(Frame& F) { LAUNDER(F);
    LAS float* scr = (LAS float*)(F.lds + RING_OFF + F.wave * 16384);
    const int gw = F.vcu * NWAVES + F.wave, NGW = F.G * NWAVES, lane = F.lane;
    const float* w_in = F.in[4]; const float* w_a = F.in[8]; const float* w_b = F.in[9]; const float* w_c = F.in[10]; const float* w_o = F.in[11];
    const float* w_eg = F.in[18]; const float* w_eu = F.in[19]; const float* w_ed = F.in[20];
    bf16* WIN = (bf16*)(F.ws + WS_WIN); bf16* WBRA = (bf16*)(F.ws + WS_WBRA); bf16* WBRB = (bf16*)(F.ws + WS_WBRB); bf16* WBRC = (bf16*)(F.ws + WS_WBRC); bf16* WOUT = (bf16*)(F.ws + WS_WOUT);
    bf16* WGU = (bf16*)(F.ws + WS_WGU); bf16* WD = (bf16*)(F.ws + WS_WD);
    constexpr int I_IN = 16 * (NCOL / 32), I_A = 8 * 32, I_B = 4 * 32, I_C = 8 * 32, I_O = 16 * 32, I_G = 16 * 16, I_D = 8 * 32;
    constexpr int I_LAYER = I_IN + I_A + I_B + I_C + I_O + NE * (2 * I_G + I_D);
    for (int it = gw; it < DEPTH * I_LAYER; it += NGW) {
        const int l = it / I_LAYER; int r = it % I_LAYER;
        if (r < I_IN) { const int nb = r % (NCOL / 32), kb = r / (NCOL / 32); p0_item(w_in + (size_t)l * D * NCOL, NCOL, 64 * kb, 32 * nb, WIN + (size_t)l * NCOL * D, D, 32 * nb, is_q_col(32 * nb) ? QSCALE : 1.0f, scr, lane); continue; } r -= I_IN;
        if (r < I_A) { const int nb = r % 32, kb = r / 32; p0_item(w_a + (size_t)l * 512 * D, D, 64 * kb, 32 * nb, WBRA + (size_t)l * D * 512, 512, 32 * nb, 1.0f, scr, lane); continue; } r -= I_A;
        if (r < I_B) { const int nb = r % 32, kb = r / 32; p0_item(w_b + (size_t)l * 256 * D, D, 64 * kb, 32 * nb, WBRB + (size_t)l * D * 256, 256, 32 * nb, 1.0f, scr, lane); continue; } r -= I_B;
        if (r < I_C) { const int nb = r % 32, kb = r / 32; p0_item(w_c + (size_t)l * 512 * D, D, 64 * kb, 32 * nb, WBRC + (size_t)l * D * 512, 512, 32 * nb, 1.0f, scr, lane); continue; } r -= I_C;
        if (r < I_O) { const int nb = r % 32, kb = r / 32; p0_item(w_o + (size_t)l * D * D, D, 64 * kb, 32 * nb, WOUT + (size_t)l * D * D, D, 32 * nb, 1.0f, scr, lane); continue; } r -= I_O;
        const int e = r / (2 * I_G + I_D); r %= (2 * I_G + I_D); const size_t le = (size_t)l * NE + e;
        if (r < 2 * I_G) { const int up = r / I_G; r %= I_G; const int nb = r % 16, kb = r / 16;
            p0_item((up ? w_eu : w_eg) + le * D * DE, DE, 64 * kb, 32 * nb, WGU + le * 1024 * 1024, D, (nb >> 2) * 256 + up * 128 + (nb & 3) * 32, 1.0f, scr, lane); continue; }
        r -= 2 * I_G; { const int nb = r % 32, kb = r / 32; p0_item(w_ed + le * DE * D, D, 64 * kb, 32 * nb, WD + le * D * DE, DE, 32 * nb, 1.0f, scr, lane); }
    }
}

struct LnIn { f32x4 v[4]; v2u a[4], b[4], hw[4]; };
template <int MODE> __device__ __forceinline__ void ln_load(LnIn& in, const float* src, const bf16* hsb, const bf16* yb, size_t row, int lane) {
#pragma unroll
    for (int j = 0; j < 4; ++j) {
        const int c = lane * 4 + 256 * j;
        if (MODE != 2) in.v[j] = *(const GAS f32x4*)(src + row * D + c);
        if (MODE == 2) { in.hw[j] = *(const GAS v2u*)(hsb + row * D + c); in.a[j] = *(const GAS v2u*)(yb + (row * 2) * D + c); in.b[j] = *(const GAS v2u*)(yb + (row * 2 + 1) * D + c); }
    }
}
template <int MODE> __device__ __forceinline__ void ln_finish(const LnIn& in, float* hout, bf16* hb, const float* g, const float* bta, size_t row, int lane, f32x4 (&o)[4]) {
    f32x4 v[4];
#pragma unroll
    for (int j = 0; j < 4; ++j) {
        if (MODE != 2) v[j] = in.v[j];
        if (MODE == 2) {
            const v2u a = in.a[j], b = in.b[j], hw = in.hw[j];
            v[j].x = ALPHA * __uint_as_float(hw.x << 16) + __uint_as_float(a.x << 16) + __uint_as_float(b.x << 16);
            v[j].y = ALPHA * __uint_as_float(hw.x & 0xffff0000u) + __uint_as_float(a.x & 0xffff0000u) + __uint_as_float(b.x & 0xffff0000u);
            v[j].z = ALPHA * __uint_as_float(hw.y << 16) + __uint_as_float(a.y << 16) + __uint_as_float(b.y << 16);
            v[j].w = ALPHA * __uint_as_float(hw.y & 0xffff0000u) + __uint_as_float(a.y & 0xffff0000u) + __uint_as_float(b.y & 0xffff0000u);
        }
    }
    float s = 0.f;
#pragma unroll
    for (int j = 0; j < 4; ++j) s += (v[j].x + v[j].y) + (v[j].z + v[j].w);
    const float mean = wave_sum_l(s, lane) * (1.f / D);
    float q = 0.f;
#pragma unroll
    for (int j = 0; j < 4; ++j) { v[j] = v[j] - mean; q += (v[j].x * v[j].x + v[j].y * v[j].y) + (v[j].z * v[j].z + v[j].w * v[j].w); }
    const float rstd = 1.0f / sqrtf(wave_sum_l(q, lane) * (1.f / D) + LN_EPS);
#pragma unroll
    for (int j = 0; j < 4; ++j) {
        const int c = lane * 4 + 256 * j;
        const f32x4 gg = *(const GAS f32x4*)(g + c), bb = *(const GAS f32x4*)(bta + c);
        o[j] = v[j] * rstd * gg + bb;
        if (hout) *(GAS f32x4*)(hout + row * D + c) = o[j];
        if (hb) { v2u w; w.x = pk2(o[j].x, o[j].y); w.y = pk2(o[j].z, o[j].w); *(GAS v2u*)(hb + row * D + c) = w; }
    }
}

#ifndef PROBE_EPI
#define PROBE_EPI 0
#endif
struct EpiP1 {
    static constexpr bool PERM = true;
    bf16* qkv; bf16* gates; const float* b_gate; int probe;
    __device__ __forceinline__ void operator()(const f32x4 (&acc)[2][2][4][2], const pg8::Unit& u, int wr, int wc, int fr, int fq) const {
        if (probe == 1 && PROBE_EPI == 0) return;
        const int row0 = (probe == 1 ? (int)(blockIdx.x & 127) : u.pm) * 256 + wr * 64 + fr; const bool isg = u.pn >= 18;
        bf16* base = isg ? gates : qkv; const int ldc = isg ? GATEW : QKVW; const int col0 = (isg ? (u.pn - 18) : u.pn) * 256 + wc * 32 + 8 * fq;
        f32x4 bv[2][2];
#pragma unroll
        for (int bj = 0; bj < 2; ++bj)
#pragma unroll
            for (int n = 0; n < 2; ++n) bv[bj][n] = isg ? *(const GAS f32x4*)(b_gate + col0 + bj * 128 + 4 * n) : (f32x4){0.f, 0.f, 0.f, 0.f};
#pragma unroll
        for (int ai = 0; ai < 2; ++ai)
#pragma unroll
            for (int m = 0; m < 4; ++m) { bf16* rowp = base + (size_t)(row0 + ai * 128 + m * 16) * ldc + col0;
#pragma unroll
                for (int bj = 0; bj < 2; ++bj) { f32x4 v0 = acc[ai][bj][m][0] + bv[bj][0], v1 = acc[ai][bj][m][1] + bv[bj][1];
                    if (isg) {
#pragma unroll
                        for (int j = 0; j < 4; ++j) { v0[j] = __builtin_amdgcn_rcpf(1.0f + __builtin_amdgcn_exp2f(-LOG2E * v0[j])); v1[j] = __builtin_amdgcn_rcpf(1.0f + __builtin_amdgcn_exp2f(-LOG2E * v1[j])); } }
                    v4u w; w.x = pg8::cvt_pk_bf16(v0[0], v0[1]); w.y = pg8::cvt_pk_bf16(v0[2], v0[3]); w.z = pg8::cvt_pk_bf16(v1[0], v1[1]); w.w = pg8::cvt_pk_bf16(v1[2], v1[3]);
                    *(GAS v4u*)(rowp + bj * 128) = w; } }
    }
};
template <bool FIRST> struct EpiP3 {
    static constexpr bool PERM = true;
    bf16* merged; const bf16* gates; int br;
    __device__ __forceinline__ void operator()(const f32x4 (&acc)[2][2][4][2], const pg8::Unit& u, int wr, int wc, int fr, int fq) const {
        const int row0 = u.pm * 256 + wr * 64 + fr, col0 = u.pn * 256 + wc * 32 + 8 * fq;
#pragma unroll
        for (int ai = 0; ai < 2; ++ai) {
            v4u gw[4][2], ow[4][2];
#pragma unroll
            for (int m = 0; m < 4; ++m)
#pragma unroll
                for (int bj = 0; bj < 2; ++bj) { const size_t row = (size_t)(row0 + ai * 128 + m * 16);
                    gw[m][bj] = *(const GAS v4u*)(gates + row * GATEW + br * 1024 + col0 + bj * 128);
                    ow[m][bj] = FIRST ? (v4u){0u, 0u, 0u, 0u} : *(const GAS v4u*)(merged + row * D + col0 + bj * 128); }
#pragma unroll
            for (int m = 0; m < 4; ++m)
#pragma unroll
                for (int bj = 0; bj < 2; ++bj) { const size_t row = (size_t)(row0 + ai * 128 + m * 16);
                    const f32x4 a0 = acc[ai][bj][m][0], a1 = acc[ai][bj][m][1];
                    float r[8];
#pragma unroll
                    for (int j = 0; j < 4; ++j) { const unsigned g2 = gw[m][bj][j], o2 = ow[m][bj][j]; const float av0 = j < 2 ? a0[2 * j] : a1[2 * j - 4], av1 = j < 2 ? a0[2 * j + 1] : a1[2 * j - 3];
                        r[2 * j] = __uint_as_float(g2 << 16) * av0 + (FIRST ? 0.f : __uint_as_float(o2 << 16)); r[2 * j + 1] = __uint_as_float(g2 & 0xffff0000u) * av1 + (FIRST ? 0.f : __uint_as_float(o2 & 0xffff0000u)); }
                    v4u w; w.x = pg8::cvt_pk_bf16(r[0], r[1]); w.y = pg8::cvt_pk_bf16(r[2], r[3]); w.z = pg8::cvt_pk_bf16(r[4], r[5]); w.w = pg8::cvt_pk_bf16(r[6], r[7]);
                    *(GAS v4u*)(merged + row * D + col0 + bj * 128) = w; }
            asm volatile("" ::: "memory"); }
    }
};
struct EpiP3V {
    static constexpr bool PERM = true;
    bf16* merged; const bf16* gates;
    __device__ __forceinline__ void operator()(const f32x4 (&acc)[2][2][4][2], const pg8::Unit& u, int wr, int wc, int fr, int fq) const {
        const int row0 = u.pm * 256 + wr * 64 + fr, col0 = u.pn * 256 + wc * 32 + 8 * fq; const int br = u.e; const bool first = (br == 0);
#pragma unroll
        for (int ai = 0; ai < 2; ++ai)
#pragma unroll
        for (int mp = 0; mp < 2; ++mp) {
            v4u gw[2][2], ow[2][2];
#pragma unroll
            for (int mm = 0; mm < 2; ++mm)
#pragma unroll
                for (int bj = 0; bj < 2; ++bj) { const size_t row = (size_t)(row0 + ai * 128 + (2 * mp + mm) * 16);
                    gw[mm][bj] = *(const GAS v4u*)(gates + row * GATEW + br * 1024 + col0 + bj * 128);
                    ow[mm][bj] = (v4u){0u, 0u, 0u, 0u}; if (!first) ow[mm][bj] = *(const GAS v4u*)(merged + row * D + col0 + bj * 128); }
#pragma unroll
            for (int mm = 0; mm < 2; ++mm)
#pragma unroll
                for (int bj = 0; bj < 2; ++bj) { const int m = 2 * mp + mm; const size_t row = (size_t)(row0 + ai * 128 + m * 16);
                    const f32x4 a0 = acc[ai][bj][m][0], a1 = acc[ai][bj][m][1];
                    float r[8];
#pragma unroll
                    for (int j = 0; j < 4; ++j) { const unsigned g2 = gw[mm][bj][j], o2 = ow[mm][bj][j]; const float av0 = j < 2 ? a0[2 * j] : a1[2 * j - 4], av1 = j < 2 ? a0[2 * j + 1] : a1[2 * j - 3];
                        r[2 * j] = __uint_as_float(g2 << 16) * av0 + __uint_as_float(o2 << 16); r[2 * j + 1] = __uint_as_float(g2 & 0xffff0000u) * av1 + __uint_as_float(o2 & 0xffff0000u); }
                    v4u w; w.x = pg8::cvt_pk_bf16(r[0], r[1]); w.y = pg8::cvt_pk_bf16(r[2], r[3]); w.z = pg8::cvt_pk_bf16(r[4], r[5]); w.w = pg8::cvt_pk_bf16(r[6], r[7]);
                    *(GAS v4u*)(merged + row * D + col0 + bj * 128) = w; }
            asm volatile("" ::: "memory"); }
    }
};
struct P3Order {
    pg8::DenseOrder Dn; const char* Abase; const char* wsb; size_t lofs;
    __device__ __forceinline__ bool next(int i, pg8::Unit& u) const { if (!Dn.next(i / 3, u)) return false; u.e = i % 3; u.ui = i; return true; }
    __device__ __forceinline__ const char* a_base(const pg8::Unit& u) const { const size_t ko = (size_t)((u.e + 1) >> 1) * 1024 + (size_t)(u.e >> 1) * 512; return Abase + ko + (size_t)u.pm * Dn.tstepA; }
    __device__ __forceinline__ int K_of(const pg8::Unit& u) const { return 512 - 256 * (u.e & 1); }
    __device__ __forceinline__ int ldb_of(const pg8::Unit& u) const { return 512 - 256 * (u.e & 1); }
    __device__ __forceinline__ const char* b_base(const pg8::Unit& u) const {
        const size_t kb = (size_t)(512 - 256 * (u.e & 1)) * 2;
        const size_t base = WS_WBRA + (size_t)((u.e + 1) >> 1) * (WS_WBRB - WS_WBRA) + (size_t)(u.e >> 1) * (WS_WBRC - WS_WBRB);
        return wsb + base + lofs * (size_t)D * kb + (size_t)u.pn * 256 * kb; }
    __device__ __forceinline__ int a_row(const pg8::Unit&, int) const { return 0; }
};
struct EpiP4 {
    static constexpr bool PERM = false;
    const bf16* hbc; float* ho;
    __device__ __forceinline__ void operator()(const f32x4 (&acc)[2][2][4][2], const pg8::Unit& u, int wr, int wc, int fr, int fq) const {
        const int row0 = u.pm * 256 + wr * 64 + fr, col0 = u.pn * 256 + wc * 32 + 4 * fq;
#pragma unroll
        for (int ai = 0; ai < 2; ++ai) { v2u hv[4][2][2];
#pragma unroll
            for (int m = 0; m < 4; ++m)
#pragma unroll
                for (int bj = 0; bj < 2; ++bj)
#pragma unroll
                    for (int n = 0; n < 2; ++n) hv[m][bj][n] = *(const GAS v2u*)(hbc + (size_t)(row0 + ai * 128 + m * 16) * D + col0 + bj * 128 + n * 16);
#pragma unroll
            for (int m = 0; m < 4; ++m)
#pragma unroll
                for (int bj = 0; bj < 2; ++bj)
#pragma unroll
                    for (int n = 0; n < 2; ++n) { const v2u w = hv[m][bj][n]; const f32x4 hf = (f32x4){__uint_as_float(w.x << 16), __uint_as_float(w.x & 0xffff0000u), __uint_as_float(w.y << 16), __uint_as_float(w.y & 0xffff0000u)};
                        *(GAS f32x4*)(ho + (size_t)(row0 + ai * 128 + m * 16) * D + col0 + bj * 128 + n * 16) = hf * ALPHA + acc[ai][bj][m][n]; }
            asm volatile("" ::: "memory"); }
    }
};
struct EpiP7 {
    static constexpr bool PERM = true;
    bf16* hid;
    __device__ __forceinline__ void operator()(const f32x4 (&acc)[2][2][4][2], const pg8::Unit& u, int wr, int wc, int fr, int fq) const {
        const int row0 = u.pm * 256 + wr * 64 + fr, col0 = u.pn * 128 + wc * 32 + 8 * fq;
#pragma unroll
        for (int ai = 0; ai < 2; ++ai)
#pragma unroll
            for (int m = 0; m < 4; ++m) { float r[8];
#pragma unroll
                for (int n = 0; n < 2; ++n)
#pragma unroll
                    for (int j = 0; j < 4; ++j) { const float gv = acc[ai][0][m][n][j], uv = acc[ai][1][m][n][j]; r[4 * n + j] = gv * __builtin_amdgcn_rcpf(1.0f + __builtin_amdgcn_exp2f(-LOG2E * gv)) * uv; }
                v4u w; w.x = pg8::cvt_pk_bf16(r[0], r[1]); w.y = pg8::cvt_pk_bf16(r[2], r[3]); w.z = pg8::cvt_pk_bf16(r[4], r[5]); w.w = pg8::cvt_pk_bf16(r[6], r[7]);
                *(GAS v4u*)(hid + (size_t)(row0 + ai * 128 + m * 16) * DE + col0) = w; }
    }
};
struct EpiP8 {
    static constexpr bool PERM = true;
    bf16* yb; const int* rowtok; const float* rowgate;
    __device__ __forceinline__ void operator()(const f32x4 (&acc)[2][2][4][2], const pg8::Unit& u, int wr, int wc, int fr, int fq) const {
        const int row0 = u.pm * 256 + wr * 64 + fr, col0 = u.pn * 256 + wc * 32 + 8 * fq;
        int rt[2][4]; float gt[2][4];
#pragma unroll
        for (int ai = 0; ai < 2; ++ai)
#pragma unroll
            for (int m = 0; m < 4; ++m) { const int row = row0 + ai * 128 + m * 16; rt[ai][m] = *(const GAS int*)(rowtok + row); gt[ai][m] = *(const GAS float*)(rowgate + row); }
#pragma unroll
        for (int ai = 0; ai < 2; ++ai)
#pragma unroll
            for (int m = 0; m < 4; ++m) {
                if (rt[ai][m] >= 0) {
#pragma unroll
                    for (int bj = 0; bj < 2; ++bj) { const f32x4 v0 = acc[ai][bj][m][0] * gt[ai][m], v1 = acc[ai][bj][m][1] * gt[ai][m];
                        v4u w; w.x = pg8::cvt_pk_bf16(v0[0], v0[1]); w.y = pg8::cvt_pk_bf16(v0[2], v0[3]); w.z = pg8::cvt_pk_bf16(v1[0], v1[1]); w.w = pg8::cvt_pk_bf16(v1[2], v1[3]);
                        *(GAS v4u*)(yb + (size_t)rt[ai][m] * D + col0 + bj * 128) = w; } } }
    }
};

typedef float f32x2 __attribute__((ext_vector_type(2)));
template <int N> __device__ __forceinline__ void wave_sum_n(float (&v)[N]) {
#pragma unroll
    for (int s = 0; s < 4; ++s)
#pragma unroll
        for (int n = 0; n < N; ++n) v[n] = dpp_add(v[n], s);
#pragma unroll
    for (int n = 0; n < N; ++n) { const int x = __builtin_bit_cast(int, v[n]);
        const float r0 = __builtin_bit_cast(float, __builtin_amdgcn_readlane(x, 0)), r1 = __builtin_bit_cast(float, __builtin_amdgcn_readlane(x, 16)),
                    r2 = __builtin_bit_cast(float, __builtin_amdgcn_readlane(x, 32)), r3 = __builtin_bit_cast(float, __builtin_amdgcn_readlane(x, 48));
        v[n] = (r0 + r1) + (r2 + r3); }
}
__device__ __forceinline__ void router_row(const float (&x)[16], int t, int lane, const f32x4 (&wg)[16], const float* b_rg, const LAS float* w_re, const float* b_re, LAS int* lcnt, int wslot, Rec* rec) {
    f32x2 g01 = (f32x2){0.f, 0.f}, g23 = (f32x2){0.f, 0.f};
#pragma unroll
    for (int k = 0; k < 16; ++k) { const f32x4 w = wg[k]; const f32x2 xv = (f32x2){x[k], x[k]}; g01 = xv * (f32x2){w.x, w.y} + g01; g23 = xv * (f32x2){w.z, w.w} + g23; }
    float gl[4] = {g01.x, g01.y, g23.x, g23.y};
    wave_sum_n<4>(gl);
#pragma unroll
    for (int g = 0; g < 4; ++g) gl[g] += b_rg[g];
    int gi = 0; float gm = gl[0];
#pragma unroll
    for (int g = 1; g < 4; ++g) if (gl[g] > gm) { gm = gl[g]; gi = g; }
    float gs = 0.f;
#pragma unroll
    for (int g = 0; g < 4; ++g) gs += __expf(gl[g] - gm);
    const float gw = 1.0f / gs;
    f32x2 e01 = (f32x2){0.f, 0.f}, e23 = e01, e45 = e01, e67 = e01;
    const LAS float* wre = w_re + gi * (D * 8);
#pragma unroll
    for (int j = 0; j < 4; ++j)
#pragma unroll
        for (int i = 0; i < 4; ++i) { const LAS float* wp = wre + ((j * 4 + i) * 128 + lane) * 4; const f32x4 w0 = *(const LAS f32x4*)wp, w1 = *(const LAS f32x4*)(wp + 256); const f32x2 xv = (f32x2){x[4 * j + i], x[4 * j + i]};
            e01 = xv * (f32x2){w0.x, w0.y} + e01; e23 = xv * (f32x2){w0.z, w0.w} + e23; e45 = xv * (f32x2){w1.x, w1.y} + e45; e67 = xv * (f32x2){w1.z, w1.w} + e67; }
    float el[8] = {e01.x, e01.y, e23.x, e23.y, e45.x, e45.y, e67.x, e67.y};
    wave_sum_n<8>(el);
#pragma unroll
    for (int e = 0; e < 8; ++e) el[e] += b_re[gi * 8 + e];
    int i0 = 0; float t0 = el[0];
#pragma unroll
    for (int e = 1; e < 8; ++e) if (el[e] > t0) { t0 = el[e]; i0 = e; }
    int i1 = -1; float t1 = -3.0e38f;
#pragma unroll
    for (int e = 0; e < 8; ++e) if (e != i0 && el[e] > t1) { t1 = el[e]; i1 = e; }
    const float ex = __expf(t1 - t0), p0 = 1.0f / (1.0f + ex), p1 = ex / (1.0f + ex);
    if (lane == 0) {
        const int e0 = gi * 8 + i0, e1 = gi * 8 + i1;
        const int s0 = __hip_atomic_fetch_add(lcnt + e0, 1, __ATOMIC_RELAXED, __HIP_MEMORY_SCOPE_WORKGROUP), s1 = __hip_atomic_fetch_add(lcnt + e1, 1, __ATOMIC_RELAXED, __HIP_MEMORY_SCOPE_WORKGROUP);
        GAS v4u* rp = (GAS v4u*)(rec + t);
        rp[0] = (v4u){(unsigned)e0, (unsigned)s0, (unsigned)e1, (unsigned)s1};
        rp[1] = (v4u){__float_as_uint(gw * p0), __float_as_uint(gw * p1), (unsigned)wslot, 0u};
    }
}

#ifndef STAG_P1
#define STAG_P1 500
#endif
__device__ __forceinline__ void stagger(int vcu, unsigned q) {
    const unsigned long long t0 = __builtin_amdgcn_s_memrealtime(); const unsigned long long d = (unsigned long long)((vcu & 3) * q);
    while (__builtin_amdgcn_s_memrealtime() - t0 < d) __builtin_amdgcn_s_sleep(8);
}
__device__ __forceinline__ void ph_ln0(Frame& F) { LAUNDER(F);
    const int gw = F.vcu * NWAVES + F.wave, NGW = F.G * NWAVES;
    bf16* hb = (bf16*)(F.ws + WS_HB);
    LnIn cur, nxt, nx2; if (gw < T) ln_load<0>(cur, F.in[0], nullptr, nullptr, (size_t)gw, F.lane);
    if (gw + NGW < T) ln_load<0>(nxt, F.in[0], nullptr, nullptr, (size_t)(gw + NGW), F.lane);
    for (int m = gw; m < T; m += NGW) { const bool more = m + NGW < T, more2 = m + 2 * NGW < T; if (more2) ln_load<0>(nx2, F.in[0], nullptr, nullptr, (size_t)(m + 2 * NGW), F.lane);
        f32x4 o[4]; ln_finish<0>(cur, nullptr, hb, F.in[1], F.in[2], (size_t)m, F.lane, o); if (more) { cur = nxt; nxt = nx2; } }
}
__device__ __forceinline__ void ph_p1(Frame& F, int l, int c) { LAUNDER(F); asm volatile("" : "+s"(l), "+s"(c));
    pg8::DenseOrder S; S.init((const bf16*)(F.ws + WS_HB) + (size_t)c * CH * D, D, (const bf16*)(F.ws + WS_WIN) + (size_t)l * NCOL * D, D, CH, NCOL, F.G, (int)blockIdx.x);
    EpiP1 E{(bf16*)(F.ws + WS_QKV), (bf16*)(F.ws + WS_GATES), F.in[5] + (size_t)l * GATEW, F.probe};
    pg8::gemm_phase<EpiP1, pg8::DenseOrder, false>(F.lds + RING_OFF, S, E, D, D, D, F.tid);
}
__device__ __forceinline__ void ph_cmb(Frame& F) { LAUNDER(F);
    const bf16* og = (const bf16*)(F.ws + WS_OG); const float* lse = (const float*)(F.ws + WS_LSE); bf16* oabc = (bf16*)(F.ws + WS_OABC);
    for (int idx = F.vcu * NTHREADS + F.tid; idx < CH * 32; idx += F.G * NTHREADS) {
        const int tl = idx >> 5, hc = idx & 31, h = hc >> 3, c = hc & 7;
        const GAS float* lg = (const GAS float*)lse + (size_t)tl * 12 + h; const float l0 = lg[0], l1 = lg[4], l2 = lg[8];
        const float mx = fmaxf(l0, fmaxf(l1, l2)); float w0 = __expf(l0 - mx), w1 = __expf(l1 - mx), w2 = __expf(l2 - mx); const float inv = 1.0f / (w0 + w1 + w2); w0 *= inv; w1 *= inv; w2 *= inv;
        const v4u a = *(const GAS v4u*)(og + ((size_t)tl * 3 + 0) * 256 + h * 64 + c * 8), b = *(const GAS v4u*)(og + ((size_t)tl * 3 + 1) * 256 + h * 64 + c * 8), d = *(const GAS v4u*)(og + ((size_t)tl * 3 + 2) * 256 + h * 64 + c * 8);
        v4u ow;
#pragma unroll
        for (int i = 0; i < 4; ++i) {
            const float lo = w0 * __uint_as_float(a[i] << 16) + w1 * __uint_as_float(b[i] << 16) + w2 * __uint_as_float(d[i] << 16);
            const float hi = w0 * __uint_as_float(a[i] & 0xffff0000u) + w1 * __uint_as_float(b[i] & 0xffff0000u) + w2 * __uint_as_float(d[i] & 0xffff0000u);
            ow[i] = pk2(lo, hi);
        }
        *(GAS v4u*)(oabc + (size_t)tl * OW + 512 + h * 64 + c * 8) = ow;
    }
}
__device__ __forceinline__ void ph_p3(Frame& F, int l) { LAUNDER(F); asm volatile("" : "+s"(l));
    const bf16* oabc = (const bf16*)(F.ws + WS_OABC); bf16* merged = (bf16*)(F.ws + WS_MERGED); const bf16* gates = (const bf16*)(F.ws + WS_GATES);
    P3Order S; S.Dn.init(oabc, OW, nullptr, 0, CH, D, F.G, (int)blockIdx.x);
    S.Abase = (const char*)oabc; S.wsb = (const char*)F.ws; S.lofs = (size_t)l;
    EpiP3V E{merged, gates};
    pg8::gemm_phase_vk<EpiP3V, P3Order>(F.lds + RING_OFF, S, E, OW, F.tid);
}
__device__ __forceinline__ void ph_p4(Frame& F, int l, int c) { LAUNDER(F); asm volatile("" : "+s"(l), "+s"(c));
    pg8::DenseOrder S; S.init((const bf16*)(F.ws + WS_MERGED), D, (const bf16*)(F.ws + WS_WOUT) + (size_t)l * D * D, D, CH, D, F.G, (int)blockIdx.x);
    EpiP4 E{(const bf16*)(F.ws + WS_HB) + (size_t)c * CH * D, F.probe ? (float*)(F.ws + WS_OABC) : F.h + (size_t)c * CH * D};
    pg8::gemm_phase<EpiP4, pg8::DenseOrder, false>(F.lds + RING_OFF, S, E, D, D, D, F.tid);
}
__device__ __forceinline__ void ph_ln1(Frame& F, int l, int c) { LAUNDER(F); asm volatile("" : "+s"(l), "+s"(c));
    const int gw = F.vcu * NWAVES + F.wave, NGW = F.G * NWAVES;
    bf16* hb = (bf16*)(F.ws + WS_HB); Rec* rec = (Rec*)(F.ws + WS_REC);
    int* wgc = (int*)(F.ws + WS_WGCNT) + ((size_t)(l * NCHUNK + c) * F.G + F.vcu) * 32;
    if (F.probe) { hb = (bf16*)(F.ws + WS_QKV) - (size_t)c * CH * D; wgc = (int*)(F.ws + WS_WGCNT) + (size_t)DEPTH * NCHUNK * 256 * 32 + F.vcu * 32; rec = (Rec*)(F.ws + WS_GATES); }
    LAS float* lrg = (LAS float*)(F.lds + RING_OFF); LAS float* lre = lrg + D * 4; LAS int* lcnt = (LAS int*)(F.lds + LCNT_OFF);
    { const float* w_rg = F.in[14] + (size_t)l * D * 4; const float* w_re = F.in[16] + (size_t)l * 4 * D * 8;
      if (F.tid < 32) lcnt[F.tid] = 0;
      for (int u = F.tid; u < D + 4 * D * 2; u += NTHREADS) {
          if (u < D) { const int e = u, ln = (e & 255) >> 2, i = e & 3, j = e >> 8; *(LAS f32x4*)(lrg + ((j * 4 + i) * 64 + ln) * 4) = *(const GAS f32x4*)(w_rg + (size_t)e * 4); }
          else { const int v = u - D, half = v & 1, e = (v >> 1) & 1023, g = v >> 11, ln = (e & 255) >> 2, i = e & 3, j = e >> 8;
                 *(LAS f32x4*)(lre + g * (D * 8) + (((j * 4 + i) * 2 + half) * 64 + ln) * 4) = *(const GAS f32x4*)(w_re + ((size_t)g * D + e) * 8 + half * 4); } }
      __syncthreads(); }
    f32x4 wg[16];
#pragma unroll
    for (int j = 0; j < 4; ++j)
#pragma unroll
        for (int i = 0; i < 4; ++i) wg[4 * j + i] = *(const LAS f32x4*)(lrg + ((j * 4 + i) * 64 + F.lane) * 4);
    const size_t rbase = (size_t)c * CH;
    LnIn cur, nxt, nx2; if (gw < CH) ln_load<1>(cur, F.h, nullptr, nullptr, rbase + gw, F.lane);
    if (gw + NGW < CH) ln_load<1>(nxt, F.h, nullptr, nullptr, rbase + gw + NGW, F.lane);
    for (int m = gw; m < CH; m += NGW) {
        const bool more = m + NGW < CH, more2 = m + 2 * NGW < CH; if (more2) ln_load<1>(nx2, F.h, nullptr, nullptr, rbase + m + 2 * NGW, F.lane);
        const size_t row = rbase + m; f32x4 o[4];
        ln_finish<1>(cur, nullptr, hb, F.in[12] + l * D, F.in[13] + l * D, row, F.lane, o);
        float x[16];
#pragma unroll
        for (int j = 0; j < 4; ++j) { x[4 * j] = o[j].x; x[4 * j + 1] = o[j].y; x[4 * j + 2] = o[j].z; x[4 * j + 3] = o[j].w; }
        router_row(x, (int)row, F.lane, wg, F.in[15] + l * 4, lre, F.in[17] + l * 32, lcnt, c * F.G + F.vcu, rec);
        if (more) { cur = nxt; nxt = nx2; }
    }
    __syncthreads();
    if (F.tid < 32) *(GAS int*)(wgc + F.tid) = lcnt[F.tid];
}
__device__ __forceinline__ void ph_dsp(Frame& F, int l) { LAUNDER(F); asm volatile("" : "+s"(l));
    LAS int* Tb = (LAS int*)(F.lds + RING_OFF); LAS int* part = Tb + 512 * 32; LAS int* po = part + 32 * 16;
    const int* wg = (const int*)(F.ws + WS_WGCNT) + (size_t)l * NCHUNK * F.G * 32; const int W = NCHUNK * F.G;
    int* cnt = (int*)(F.ws + WS_CTL) + CW_CNT + l * (32 * CSTR); const Rec* rec = (const Rec*)(F.ws + WS_REC); int* rowtok = (int*)(F.ws + WS_ROWTOK); float* rowgate = (float*)(F.ws + WS_ROWGATE);
    for (int i = F.tid; i < W * 32; i += NTHREADS) Tb[i] = *(const GAS int*)(wg + i);
    __syncthreads();
    const int e = F.tid >> 4, k = F.tid & 15, per = (W + 15) / 16, w0 = k * per, w1 = (w0 + per) < W ? (w0 + per) : W;
    { int s = 0; for (int w = w0; w < w1; ++w) s += Tb[w * 32 + e]; part[e * 16 + k] = s; }
    __syncthreads();
    { int base = 0; for (int kk = 0; kk < k; ++kk) base += part[e * 16 + kk];
      for (int w = w0; w < w1; ++w) { const int t = Tb[w * 32 + e]; Tb[w * 32 + e] = base; base += t; } }
    __syncthreads();
    if (F.tid == 0) { int acc = 0; for (int ee = 0; ee < NE; ++ee) { int tot = 0; for (int kk = 0; kk < 16; ++kk) tot += part[ee * 16 + kk]; po[ee] = acc; part[ee * 16] = tot; acc += (tot + 255) / 256 * 256; } po[NE] = acc; }
    __syncthreads();
    if (F.vcu == 0 && F.tid < 32) cnt[F.tid * CSTR] = part[F.tid * 16];
    const int gt = F.vcu * NTHREADS + F.tid, GT = F.G * NTHREADS;
    for (int t = gt; t < T; t += GT) {
        const GAS v4u* rp = (const GAS v4u*)(rec + t); const v4u ra = rp[0], rb = rp[1];
        Rec rc; rc.e0 = (int)ra.x; rc.s0 = (int)ra.y; rc.e1 = (int)ra.z; rc.s1 = (int)ra.w; rc.g0 = __uint_as_float(rb.x); rc.g1 = __uint_as_float(rb.y); rc.pad0 = (int)rb.z; rc.pad1 = 0;
        const int d0 = po[rc.e0] + Tb[rc.pad0 * 32 + rc.e0] + rc.s0, d1 = po[rc.e1] + Tb[rc.pad0 * 32 + rc.e1] + rc.s1;
        *(GAS int*)(rowtok + d0) = 2 * t; *(GAS float*)(rowgate + d0) = rc.g0; *(GAS int*)(rowtok + d1) = 2 * t + 1; *(GAS float*)(rowgate + d1) = rc.g1;
    }
    for (int ee = 0; ee < NE; ++ee) for (int r = po[ee] + part[ee * 16] + gt; r < po[ee + 1]; r += GT) { *(GAS int*)(rowtok + r) = -1; *(GAS float*)(rowgate + r) = 0.f; }
    __syncthreads();
}
__device__ __forceinline__ int moe_setup(Frame& F, int l, bool gather) { LAUNDER(F); asm volatile("" : "+s"(l));
    LAS int* rows = (LAS int*)(F.lds + ROWS_OFF); LAS int* ulist = rows + 11 * 256; LAS int* po = ulist + 16;
    const int* cnt = (const int*)(F.ws + WS_CTL) + CW_CNT + l * (32 * CSTR); const int* rowtok = (const int*)(F.ws + WS_ROWTOK);
    if (F.tid == 0) { int acc = 0; for (int e = 0; e < NE; ++e) { po[e] = acc; acc += (cnt[e * CSTR] + 255) / 256 * 256; } po[NE] = acc; }
    __syncthreads();
    const int nu_all = (po[NE] / 256) * 4; int nun = (nu_all - F.vcu + F.G - 1) / F.G; nun = nun < 0 ? 0 : (nun > 11 ? 11 : nun);
    if (F.tid < nun) { const int Lx = F.tid * F.G + F.vcu, rt = Lx >> 2, pn = Lx & 3; int e = 0; while (e < NE - 1 && po[e + 1] <= rt * 256) ++e; ulist[F.tid] = (rt << 8) | (e << 2) | pn; }
    if (gather) for (int idx = F.tid; idx < nun * 256; idx += NTHREADS) { const int i = idx >> 8, r = idx & 255, Lx = i * F.G + F.vcu; rows[idx] = *(const GAS int*)(rowtok + (Lx >> 2) * 256 + r); }
    __syncthreads();
    return nun;
}
struct MoeOrder {
    int nun; const LAS int* ulist; const LAS int* rows; const char* A; const char* B; size_t tstepA, estepB, tstepB;
    __device__ __forceinline__ bool next(int i, pg8::Unit& u) const {
        if (i >= nun) return false;
        const int w = __builtin_amdgcn_readfirstlane(ulist[i]); u.pm = w >> 8; u.e = (w >> 2) & 63; u.pn = w & 3; u.ui = i; return true;
    }
    __device__ __forceinline__ const char* a_base(const pg8::Unit& u) const { return A + (size_t)u.pm * tstepA; }
    __device__ __forceinline__ const char* b_base(const pg8::Unit& u) const { return B + (size_t)u.e * estepB + (size_t)u.pn * tstepB; }
    __device__ __forceinline__ int a_row(const pg8::Unit& u, int r) const { const int t = rows[u.ui * 256 + r]; return t < 0 ? 0 : (t >> 1); }
};
__device__ __forceinline__ void ph_p7(Frame& F, int l) { LAUNDER(F); asm volatile("" : "+s"(l));
    const int nun = moe_setup(F, l, true);
    LAS int* rows = (LAS int*)(F.lds + ROWS_OFF);
    MoeOrder S{nun, rows + 11 * 256, rows, (const char*)(F.ws + WS_HB), (const char*)(F.ws + WS_WGU) + (size_t)l * NE * 1024 * 1024 * 2, 0, (size_t)1024 * 1024 * 2, (size_t)256 * 1024 * 2};
    EpiP7 E{(bf16*)(F.ws + WS_HID)};
    pg8::gemm_phase<EpiP7, MoeOrder, true>(F.lds + RING_OFF, S, E, D, D, D, F.tid);
}
__device__ __forceinline__ void ph_p8(Frame& F, int l) { LAUNDER(F); asm volatile("" : "+s"(l));
    const int nun = moe_setup(F, l, false);
    LAS int* rows = (LAS int*)(F.lds + ROWS_OFF);
    MoeOrder S{nun, rows + 11 * 256, rows, (const char*)(F.ws + WS_HID), (const char*)(F.ws + WS_WD) + (size_t)l * NE * 1024 * 512 * 2, (size_t)256 * DE * 2, (size_t)1024 * 512 * 2, (size_t)256 * 512 * 2};
    EpiP8 E{(bf16*)(F.ws + WS_YB), (const int*)(F.ws + WS_ROWTOK), (const float*)(F.ws + WS_ROWGATE)};
    pg8::gemm_phase<EpiP8, MoeOrder, false>(F.lds + RING_OFF, S, E, DE, DE, DE, F.tid);
}
__device__ __forceinline__ void ph_ln2(Frame& F, int l) { LAUNDER(F); asm volatile("" : "+s"(l));
    const int gw = F.vcu * NWAVES + F.wave, NGW = F.G * NWAVES;
    const bool lastl = (l == DEPTH - 1);
    const bf16* hsb = (const bf16*)(F.ws + WS_HB); const bf16* yb = (const bf16*)(F.ws + WS_YB);
    bf16* hb = lastl ? nullptr : (bf16*)(F.ws + WS_HB); float* hout = lastl ? F.h : nullptr; size_t omask = ~(size_t)0;
    if (F.probe) { hout = lastl ? (float*)(F.ws + WS_OABC) : nullptr; hb = lastl ? nullptr : (bf16*)(F.ws + WS_OABC); omask = 32767; }
    LnIn cur, nxt, nx2; if (gw < T) ln_load<2>(cur, nullptr, hsb, yb, (size_t)gw, F.lane);
    if (gw + NGW < T) ln_load<2>(nxt, nullptr, hsb, yb, (size_t)(gw + NGW), F.lane);
    for (int m = gw; m < T; m += NGW) { const bool more = m + NGW < T, more2 = m + 2 * NGW < T; if (more2) ln_load<2>(nx2, nullptr, hsb, yb, (size_t)(m + 2 * NGW), F.lane);
        const size_t back = ((size_t)m - ((size_t)m & omask)) * D;
        f32x4 o[4]; ln_finish<2>(cur, hout ? hout - back : nullptr, hb ? hb - back : nullptr, F.in[21] + l * D, F.in[22] + l * D, (size_t)m, F.lane, o); if (more) { cur = nxt; nxt = nx2; } }
}

typedef short s16x4 __attribute__((ext_vector_type(4)));
constexpr int NT_A = (CH / 32) * 4, NT_B = (CH / L) * 3 * 128 * 4, NT_C = (CH / 64) * 8, NT_ALL = NT_A + NT_B + NT_C;
constexpr float NEGBIG = -1.0e30f, MINIT = -5.0e29f;
#define RC16(reg) (((reg) & 3) + 8 * ((reg) >> 2))

__device__ __forceinline__ void ph_tables(Frame& F) { LAUNDER(F);
    float* TA = (float*)(F.ws + WS_TABA); float* TB = (float*)(F.ws + WS_TABB); float* TC = (float*)(F.ws + WS_TABC);
    const float* rel_bias = F.in[3]; const float* rpb = F.in[7];
    const int gt = F.vcu * NTHREADS + F.tid, GT = F.G * NTHREADS;
    for (int i = gt; i < 8 * 320; i += GT) { const int h = i / 320, rel = i % 320 - 160; TA[i] = (rel >= -128 && rel <= 128) ? rel_bias[BUCK_A[rel + 128] * 20 + h] * LOG2E : NEGBIG; }
    for (int i = gt; i < 12 * 256; i += GT) { const int gh = i >> 8, g = gh >> 2, rel = (i & 255) - 128; TB[i] = (rel >= -64 && rel <= 64) ? rel_bias[BUCK_B[g][rel + 64] * 20 + 8 + gh] * LOG2E : NEGBIG; }
    for (int i = gt; i < DEPTH * 8 * 1024; i += GT) { const int lh = i >> 10, ri = (i >> 6) & 15, ci = (i & 63) - 16; TC[i] = (ri < 15 && ci >= 0 && ci <= 30) ? rpb[((size_t)lh * 15 + ri) * 31 + ci] * LOG2E : NEGBIG; }
}

#define ATT_INIT(S, TBP, BIDX, XM) do { \
        _Pragma("unroll") for (int r_ = 0; r_ < 16; ++r_) { float v_ = (TBP)[(BIDX) + RC16(r_)]; if (TYPE == 2) v_ = ((unsigned)((XM) + RC16(r_)) < 16u) ? v_ : NEGBIG; S[r_] = v_; } } while (0)
__device__ __forceinline__ float xhalf_max(float t) { float a_ = t, b_ = t; asm volatile("s_nop 1\n\tv_permlane32_swap_b32 %0, %1" : "+v"(a_), "+v"(b_)); return fmaxf(a_, b_); }
__device__ __forceinline__ float xhalf_sum(float t) { float a_ = t, b_ = t; asm volatile("s_nop 1\n\tv_permlane32_swap_b32 %0, %1" : "+v"(a_), "+v"(b_)); return a_ + b_; }
#define ATT_TMAX(S, t) do { t = NEGBIG; _Pragma("unroll") for (int r_ = 0; r_ < 16; ++r_) t = fmaxf(t, S[r_]); } while (0)
#define ATT_RESCALE(need, t, m, l, Oa, Ob) do { const float mn_ = (need) ? (t) : m, corr_ = __builtin_amdgcn_exp2f(m - mn_); m = mn_; l *= corr_; \
        _Pragma("unroll") for (int i_ = 0; i_ < 16; ++i_) { Oa[i_] *= corr_; Ob[i_] *= corr_; } } while (0)
#define ATT_EXP(S, m, rs) do { rs = 0.f; _Pragma("unroll") for (int r_ = 0; r_ < 16; ++r_) { const float p_ = __builtin_amdgcn_exp2f(S[r_] - m); S[r_] = p_; rs += p_; } } while (0)
#define ATT_PACK(Pf, S, s2) do { unsigned pw_[4]; _Pragma("unroll") for (int j_ = 0; j_ < 4; ++j_) pw_[j_] = pg8::cvt_pk_bf16(S[8 * (s2) + 2 * j_], S[8 * (s2) + 2 * j_ + 1]); \
        Pf = __builtin_bit_cast(bf16x8, (v4u){pw_[0], pw_[1], pw_[2], pw_[3]}); } while (0)
#define ATT_STORE(orow, Oa, Ob, l) do { const float inv_ = 1.0f / (l); \
        _Pragma("unroll") for (int g_ = 0; g_ < 4; ++g_) { v2u w0_, w1_; \
            w0_.x = pg8::cvt_pk_bf16(Oa[4 * g_] * inv_, Oa[4 * g_ + 1] * inv_); w0_.y = pg8::cvt_pk_bf16(Oa[4 * g_ + 2] * inv_, Oa[4 * g_ + 3] * inv_); \
            w1_.x = pg8::cvt_pk_bf16(Ob[4 * g_] * inv_, Ob[4 * g_ + 1] * inv_); w1_.y = pg8::cvt_pk_bf16(Ob[4 * g_ + 2] * inv_, Ob[4 * g_ + 3] * inv_); \
            *(GAS v2u*)((orow) + 8 * g_ + 4 * hh) = w0_; *(GAS v2u*)((orow) + 32 + 8 * g_ + 4 * hh) = w1_; } } while (0)

template <int TYPE>
__device__ __forceinline__ void att_task2(LAS unsigned char* wl, const int lane, const bf16* seq  , const float* tab0, const float* tab1,
                                          const int qcol0, const int qcol1, const int kcol, const int vcol, const int TT0, const int TSTEP, const int kstride, const int tlo, const int thi,
                                          const int tq0, const int tq1  , const int toff1  ,
                                          const int gi0, const int gi1, const int gc, const int cbs  ,
                                          const float m_init0, const float m_init1, const float l_init, bf16* orow0, bf16* orow1, float* lse0, float* lse1) {
    const int qi = lane & 31, hh = lane >> 5;
    LAS unsigned char* kt = wl; LAS unsigned char* vt = wl + 4096; LAS float* tb0 = (LAS float*)(wl + 8192); LAS float* tb1 = (TYPE == 0) ? tb0 + 320 : tb0;
    constexpr int TBN = TYPE == 0 ? 320 : (TYPE == 1 ? 256 : 1024);
#pragma unroll
    for (int i = 0; i < TBN / 64; ++i) { tb0[lane + 64 * i] = *(const GAS float*)(tab0 + lane + 64 * i); if (TYPE == 0) tb1[lane + 64 * i] = *(const GAS float*)(tab1 + lane + 64 * i); }
    bf16x8 Qa[4], Qb[4];
#pragma unroll
    for (int s = 0; s < 4; ++s) { Qa[s] = *(const GAS bf16x8*)(seq + (size_t)tq0 * QKVW + qcol0 + 16 * s + 8 * hh); Qb[s] = *(const GAS bf16x8*)(seq + (size_t)tq1 * QKVW + qcol1 + 16 * s + 8 * hh); }
    f32x16 O0a, O0b, O1a, O1b;
#pragma unroll
    for (int i = 0; i < 16; ++i) { O0a[i] = 0.f; O0b[i] = 0.f; O1a[i] = 0.f; O1b[i] = 0.f; }
    float m0 = m_init0, m1 = m_init1, l0 = l_init, l1 = l_init;
    const int lkey = lane >> 3, lch = lane & 7;
    const unsigned goff = (unsigned)(lkey * kstride) * (unsigned)(QKVW * 2) + 16u * (unsigned)lch;
    const size_t istepb = (size_t)8 * kstride * QKVW * 2;
    const char* kbase = (const char*)(seq + kcol); const char* vbase = (const char*)(seq + vcol);
    const unsigned kw0 = lkey * 128 + ((lch ^ (lkey & 7)) << 4), vw0 = lkey * 128 + (((lch >> 2) ^ ((lkey >> 1) & 1)) << 6) + ((lch & 3) << 4);
    const unsigned kr0 = qi * 128 + ((hh ^ (qi & 7)) << 4);
    const int q4 = (lane & 15) >> 2, p4 = lane & 3, g1 = (lane >> 4) & 1, sw = (q4 >> 1) & 1;
    const unsigned vr0 = (4 * hh + q4) * 128 + 32 * g1 + 8 * p4 + (sw << 6), vr1 = (4 * hh + q4) * 128 + 32 * g1 + 8 * p4 + ((sw ^ 1) << 6);
    const int bidx0 = (TYPE == 2) ? (cbs - gc + 31 + 4 * hh) : ((TYPE == 1 ? 64 : 32) - qi + 4 * hh);
    int cs = gc - 8; cs = cs < 0 ? 0 : (cs > 48 ? 48 : cs);
    const int xm = cbs - cs + 4 * hh;
    int rs0 = gi0 - 4; rs0 = rs0 < 0 ? 0 : (rs0 > 120 ? 120 : rs0);
    int rs1 = gi1 - 4; rs1 = rs1 < 0 ? 0 : (rs1 > 120 ? 120 : rs1);
    v4u kreg[4], vreg[4];
    {
        const size_t tb_ = (size_t)(TT0 + tlo * TSTEP) * (QKVW * 2);
#pragma unroll
        for (int i = 0; i < 4; ++i) { kreg[i] = *(const GAS v4u*)(kbase + tb_ + i * istepb + goff); vreg[i] = *(const GAS v4u*)(vbase + tb_ + i * istepb + goff); }
    }
    for (int ti = tlo; ti <= thi; ++ti) {
#pragma unroll
        for (int i = 0; i < 4; ++i) { *(LAS v4u*)(kt + kw0 + 1024 * i) = kreg[i]; *(LAS v4u*)(vt + vw0 + 1024 * i) = vreg[i]; }
        if (ti < thi) {
            const size_t tb_ = (size_t)(TT0 + (ti + 1) * TSTEP) * (QKVW * 2);
#pragma unroll
            for (int i = 0; i < 4; ++i) { kreg[i] = *(const GAS v4u*)(kbase + tb_ + i * istepb + goff); vreg[i] = *(const GAS v4u*)(vbase + tb_ + i * istepb + goff); }
        }
        int bi0, bi1;
        if (TYPE == 2) { const bool rv0 = (ti >= rs0) && (ti < rs0 + 8), rv1 = (ti >= rs1) && (ti < rs1 + 8); bi0 = bidx0 + (rv0 ? (ti - gi0 + 7) : 15) * 64; bi1 = bidx0 + (rv1 ? (ti - gi1 + 7) : 15) * 64; }
        else { bi0 = bidx0 + 32 * ti; bi1 = bidx0 + 32 * (ti - toff1); }
        f32x16 S0, S1;
        ATT_INIT(S0, tb0, bi0, xm); ATT_INIT(S1, tb1, bi1, xm);
#pragma unroll
        for (int s = 0; s < 4; ++s) { const bf16x8 Kf = *(const LAS bf16x8*)(kt + (kr0 ^ (unsigned)(s << 5)));
            S0 = __builtin_amdgcn_mfma_f32_32x32x16_bf16(Kf, Qa[s], S0, 0, 0, 0); S1 = __builtin_amdgcn_mfma_f32_32x32x16_bf16(Kf, Qb[s], S1, 0, 0, 0); }
        float t0, t1; ATT_TMAX(S0, t0); ATT_TMAX(S1, t1);
        t0 = xhalf_max(t0); t1 = xhalf_max(t1);
        const bool need0 = t0 > m0 + 8.0f, need1 = t1 > m1 + 8.0f;
        if (__builtin_amdgcn_ballot_w64(need0 || need1) != 0ull) { ATT_RESCALE(need0, t0, m0, l0, O0a, O0b); ATT_RESCALE(need1, t1, m1, l1, O1a, O1b); }
        float rs0, rs1; ATT_EXP(S0, m0, rs0); ATT_EXP(S1, m1, rs1);
        rs0 = xhalf_sum(rs0); rs1 = xhalf_sum(rs1);
        l0 += rs0; l1 += rs1;
#pragma unroll
        for (int s2 = 0; s2 < 2; ++s2) {
            bf16x8 P0, P1; ATT_PACK(P0, S0, s2); ATT_PACK(P1, S1, s2);
            const s16x4 a00 = __builtin_amdgcn_ds_read_tr16_b64_v4i16((LAS s16x4*)(vt + vr0 + (16 * s2) * 128));
            const s16x4 a01 = __builtin_amdgcn_ds_read_tr16_b64_v4i16((LAS s16x4*)(vt + vr0 + (16 * s2 + 8) * 128));
            const s16x4 a10 = __builtin_amdgcn_ds_read_tr16_b64_v4i16((LAS s16x4*)(vt + vr1 + (16 * s2) * 128));
            const s16x4 a11 = __builtin_amdgcn_ds_read_tr16_b64_v4i16((LAS s16x4*)(vt + vr1 + (16 * s2 + 8) * 128));
            const bf16x8 V0 = (bf16x8){a00[0], a00[1], a00[2], a00[3], a01[0], a01[1], a01[2], a01[3]};
            const bf16x8 V1 = (bf16x8){a10[0], a10[1], a10[2], a10[3], a11[0], a11[1], a11[2], a11[3]};
            O0a = __builtin_amdgcn_mfma_f32_32x32x16_bf16(V0, P0, O0a, 0, 0, 0); O0b = __builtin_amdgcn_mfma_f32_32x32x16_bf16(V1, P0, O0b, 0, 0, 0);
            O1a = __builtin_amdgcn_mfma_f32_32x32x16_bf16(V0, P1, O1a, 0, 0, 0); O1b = __builtin_amdgcn_mfma_f32_32x32x16_bf16(V1, P1, O1b, 0, 0, 0);
        }
    }
    ATT_STORE(orow0, O0a, O0b, l0);
    ATT_STORE(orow1, O1a, O1b, l1);
    if (TYPE == 1 && hh == 0) { *(GAS float*)lse0 = (m0 + __builtin_amdgcn_logf(l0)) * LN2; *(GAS float*)lse1 = (m1 + __builtin_amdgcn_logf(l1)) * LN2; }
}

__device__ __forceinline__ void ph_att(Frame& F, int l) { LAUNDER(F); asm volatile("" : "+s"(l));
    LAS unsigned char* wl = F.lds + RING_OFF + F.wave * 16384;
    const bf16* qkv = (const bf16*)(F.ws + WS_QKV); bf16* oabc = (bf16*)(F.ws + WS_OABC); bf16* og = (bf16*)(F.ws + WS_OG); float* lse = (float*)(F.ws + WS_LSE);
    const float* TA = (const float*)(F.ws + WS_TABA); const float* TB = (const float*)(F.ws + WS_TABB); const float* TC = (const float*)(F.ws + WS_TABC) + (size_t)l * 8 * 1024;
    const float* sink = F.in[6] + l * 8;
    const int gw = F.vcu * NWAVES + F.wave, NGW = F.G * NWAVES;
    for (int task = gw; task < NT_ALL; task += NGW) {
        int lane = F.lane; asm volatile("" : "+v"(lane)); const int qi = lane & 31;
        if (task < NT_A) {
            const int hp = task & 3, qb = (task >> 2) & 255, b = task >> 10, q0 = qb * 32, h0 = hp * 2, h1 = h0 + 1, kvh = hp >> 1;
            int tlo = 0, thi = 8; if (q0 - 128 < 0) tlo = (128 - q0) / 32; if (q0 + 128 + 31 >= L) thi = (L - 1 - (q0 - 128)) / 32;
            const int tq = q0 + qi; bf16* orow = oabc + (size_t)(b * L + tq) * OW;
            att_task2<0>(wl, lane, qkv + (size_t)b * L * QKVW, TA + h0 * 320, TA + h1 * 320, AQ + h0 * 64, AQ + h1 * 64, AK + kvh * 64, AV + kvh * 64, q0 - 128, 32, 1, tlo, thi,
                         tq, tq, 0, 0, 0, 0, 0, sink[h0] * LOG2E, sink[h1] * LOG2E, 1.0f, orow + h0 * 64, orow + h1 * 64, nullptr, nullptr);
        } else if (task < NT_A + NT_B) {
            const int j = task - NT_A, h = j & 3, sbi = (j >> 2) & 127, bg = j >> 9, g = bg % 3, b = bg / 3;
            const int dsh = 2 * g, d = 1 << dsh, nsb = 128 >> dsh, r = sbi / nsb, sb = sbi % nsb, q0 = sb * 64, Ls = L >> dsh;
            int tlo = 0, thi = 5; if (q0 - 64 < 0) tlo = (64 - q0) / 32; if (q0 + 32 + 64 + 31 >= Ls) thi = (Ls - 1 - (q0 - 64)) / 32;
            const int tq0 = (q0 + qi) * d + r, tq1 = (q0 + 32 + qi) * d + r, qc = BQ0 + 768 * g + h * 64;
            att_task2<1>(wl, lane, qkv + (size_t)b * L * QKVW, TB + (g * 4 + h) * 256, nullptr, qc, qc, qc + 256, qc + 512, (q0 - 64) * d + r, 32 * d, d, tlo, thi,
                         tq0, tq1, 1, 0, 0, 0, 0, MINIT, MINIT, 0.0f, og + ((size_t)(b * L + tq0) * 3 + g) * 256 + h * 64, og + ((size_t)(b * L + tq1) * 3 + g) * 256 + h * 64,
                         lse + ((size_t)(b * L + tq0) * 3 + g) * 4 + h, lse + ((size_t)(b * L + tq1) * 3 + g) * 4 + h);
        } else {
            const int j = task - NT_A - NT_B, h = j & 7, cbi = (j >> 3) & 127, b = j >> 10, ip = cbi >> 2, cb = cbi & 3;
            const int gi0 = 4 * ip + (qi >> 4), gi1 = gi0 + 2, gc = 16 * cb + (qi & 15), tq0 = gi0 * 64 + gc, tq1 = gi1 * 64 + gc;
            int cbs = 16 * cb - 8; cbs = cbs < 0 ? 0 : (cbs > 32 ? 32 : cbs);
            int rlo = 4 * ip - 4; rlo = rlo < 0 ? 0 : (rlo > 120 ? 120 : rlo);
            int rhi = 4 * ip + 3 - 4; rhi = rhi < 0 ? 0 : (rhi > 120 ? 120 : rhi); rhi += 7;
            bf16* ob = oabc + (size_t)(b * L) * OW + 768 + h * 64;
            att_task2<2>(wl, lane, qkv + (size_t)b * L * QKVW, TC + h * 1024, nullptr, CQ + h * 64, CQ + h * 64, CK + h * 64, CV + h * 64, cbs, 64, 1, rlo, rhi,
                         tq0, tq1, 0, gi0, gi1, gc, cbs, MINIT, MINIT, 0.0f, ob + (size_t)tq0 * OW, ob + (size_t)tq1 * OW, nullptr, nullptr);
        }
    }
}

constexpr int NSTEPS = 1 + DEPTH * 16;
__global__ void __launch_bounds__(NTHREADS, 2) mk_fwd(Args args) {
    extern __shared__ __attribute__((aligned(16))) unsigned char lds[];
    Frame F;
    F.lds = (LAS unsigned char*)lds; F.wave = __builtin_amdgcn_readfirstlane((int)threadIdx.x >> 6); F.lane = hw_lane(); F.tid = F.wave * 64 + F.lane;
    F.G = gridDim.x; { const int bx = blockIdx.x; F.vcu = (F.G % 8 == 0) ? (bx % 8) * (F.G / 8) + bx / 8 : bx; }
    F.in = args.in; F.h = args.out; F.ws = args.ws; F.probe = args.probe;
    volatile LAS unsigned* MISC = (volatile LAS unsigned*)(F.lds + MISC_OFF);
    if (F.tid < 32) MISC[F.tid] = 0u;
    __syncthreads();
    const int lo = args.s_lo, hi = args.s_hi;
    XcdBarrier bar; bar.wave0 = (F.wave == 0); bar.bar = (unsigned*)(F.ws + WS_CTL) + CW_BAR; bar.x = 0; bar.st = nullptr;
    if (hi - lo > 1) bar = xcd_barrier_post((unsigned*)(F.ws + WS_CTL) + CW_BAR, MISC + 8, F.wave == 0);
#define RUN(s) (lo <= (s) && (s) < hi)
#define SEAM(s) do { if (RUN(s) && RUN((s) + 1)) xcd_barrier(bar); } while (0)
    if (RUN(0)) { ph_prologue(F); ph_tables(F); ph_ln0(F); }
    SEAM(0);
    for (int l = 0; l < DEPTH; ++l) {
        const int sb = 1 + l * 16;
        for (int c = 0; c < NCHUNK; ++c) {
            const int s = sb + c * 6;
            if (RUN(s)) ph_p1(F, l, c);
            SEAM(s);
            if (RUN(s + 1)) ph_att(F, l);
            SEAM(s + 1);
            if (RUN(s + 2)) ph_cmb(F);
            SEAM(s + 2);
            if (RUN(s + 3)) ph_p3(F, l);
            SEAM(s + 3);
            if (RUN(s + 4)) ph_p4(F, l, c);
            SEAM(s + 4);
            if (RUN(s + 5)) ph_ln1(F, l, c);
            if (c == NCHUNK - 1) SEAM(s + 5);
        }
        if (RUN(sb + 12)) ph_dsp(F, l);
        SEAM(sb + 12);
        if (RUN(sb + 13)) ph_p7(F, l);
        SEAM(sb + 13);
        if (RUN(sb + 14)) ph_p8(F, l);
        SEAM(sb + 14);
        if (RUN(sb + 15)) ph_ln2(F, l);
        SEAM(sb + 15);
    }
#undef RUN
#undef SEAM
}

extern "C" void kernel_launch(void* const* d_in, const int* in_sizes, int n_in, void* d_out, int out_size, void* d_ws, size_t ws_size, hipStream_t stream) {
    static int grid = 0;
    if (grid == 0) {
        if (n_in != 23 || out_size != T * D || ws_size < WS_END) { fprintf(stderr, "kernel_launch: unexpected shapes (n_in %d out %d ws %zu)\n", n_in, out_size, ws_size); grid = -1; return; }
        int dev = 0, cus = 0, per_cu = 0;
        if (hipGetDevice(&dev) != hipSuccess || hipDeviceGetAttribute(&cus, hipDeviceAttributeMultiprocessorCount, dev) != hipSuccess) { grid = -1; return; }
        if (hipFuncSetAttribute((const void*)mk_fwd, hipFuncAttributeMaxDynamicSharedMemorySize, LDS_BYTES) != hipSuccess) { fprintf(stderr, "kernel_launch: hipFuncSetAttribute failed\n"); grid = -1; return; }
        if (hipOccupancyMaxActiveBlocksPerMultiprocessor(&per_cu, (const void*)mk_fwd, NTHREADS, LDS_BYTES) != hipSuccess || per_cu < 1) fprintf(stderr, "kernel_launch: occupancy query reports %d\n", per_cu);
        (void)hipGetLastError();
        grid = cus > 256 ? 256 : cus;
    }
    if (grid < 0) return;
    (void)hipMemsetAsync((unsigned char*)d_ws + WS_CTL, 0, CTL_ZERO_BYTES, stream);
    Args a{};
    for (int i = 0; i < 23; ++i) a.in[i] = (const float*)d_in[i];
    a.out = (float*)d_out; a.ws = (unsigned char*)d_ws; a.s_lo = 0; a.s_hi = NSTEPS; a.probe = 0; a.pad = 0;
    hipLaunchKernelGGL(mk_fwd, dim3(grid), dim3(NTHREADS), LDS_BYTES, stream, a);
}
```

```cpp
#include <hip/hip_runtime.h>
#include <cstdio>
#include <cstdint>
#include <cmath>

typedef unsigned short bf16;
typedef short bf16x8 __attribute__((ext_vector_type(8)));
typedef float f32x16 __attribute__((ext_vector_type(16)));
typedef float f32x4 __attribute__((ext_vector_type(4)));

constexpr int D = 1024, L = 8192, NBATCH = 8, T = NBATCH * L, DEPTH = 2;
constexpr int NCOL = 7680, QKVW = 4608, GATEW = 3072;
constexpr int CH = 32768, NCHUNK = T / CH;
constexpr int OW = 1280;
constexpr int NE = 32, DE = 512;
constexpr int MAXRT = T * 2 / 256 + NE, PROWS = MAXRT * 256;
constexpr float LN_EPS = 1e-5f;
constexpr float ALPHA = 1.41421356237309515f;
constexpr int AQ = 0, AK = 512, AV = 640, BQ0 = 768, CQ = 3072, CK = 3584, CV = 4096;

constexpr size_t MiB = 1u << 20;
constexpr size_t WS_CTL = 0;
constexpr size_t WS_WIN = 1 * MiB, WS_WBRA = 31 * MiB, WS_WBRB = 33 * MiB, WS_WBRC = 34 * MiB, WS_WOUT = 36 * MiB, WS_WGU = 40 * MiB, WS_WD = 168 * MiB;
constexpr size_t WS_HB = 232 * MiB, WS_QKV = 360 * MiB, WS_GATES = 648 * MiB, WS_OABC = 840 * MiB, WS_OG = 920 * MiB, WS_LSE = 968 * MiB,
                 WS_REC = 970 * MiB, WS_ROWTOK = 972 * MiB, WS_ROWGATE = 973 * MiB, WS_TABA = 974 * MiB, WS_TABB = WS_TABA + 16384, WS_TABC = WS_TABA + 32768, WS_WGCNT = WS_TABA + 131072  , WS_END = 975 * MiB;
constexpr size_t WS_MERGED = WS_QKV, WS_HID = WS_QKV, WS_YB = WS_QKV + 136 * MiB;
constexpr int CSTR = 32;

__device__ __constant__ signed char BUCK_A[257] = {12,11,11,11,11,11,11,11,11,11,11,11,11,11,11,11,11,11,11,11,11,11,11,11,11,11,11,11,11,11,11,11,11,11,11,11,11,11,11,11,11,11,11,11,11,11,11,11,11,11,11,11,11,11,11,11,11,11,11,11,11,11,11,11,11,10,10,10,10,10,10,10,10,10,10,10,10,10,10,10,10,10,10,10,10,10,10,10,10,10,10,10,10,10,10,10,10,9,9,9,9,9,9,9,9,9,9,9,9,9,9,9,9,8,8,8,8,8,8,8,8,7,6,5,4,3,2,1,0,17,18,19,20,21,22,23,24,24,24,24,24,24,24,24,25,25,25,25,25,25,25,25,25,25,25,25,25,25,25,25,26,26,26,26,26,26,26,26,26,26,26,26,26,26,26,26,26,26,26,26,26,26,26,26,26,26,26,26,26,26,26,26,27,27,27,27,27,27,27,27,27,27,27,27,27,27,27,27,27,27,27,27,27,27,27,27,27,27,27,27,27,27,27,27,27,27,27,27,27,27,27,27,27,27,27,27,27,27,27,27,27,27,27,27,27,27,27,27,27,27,27,27,27,27,27,27,28};
__device__ __constant__ signed char BUCK_B[3][129] = {
 {11,10,10,10,10,10,10,10,10,10,10,10,10,10,10,10,10,10,10,10,10,10,10,10,10,10,10,10,10,10,10,10,10,9,9,9,9,9,9,9,9,9,9,9,9,9,9,9,9,8,8,8,8,8,8,8,8,7,6,5,4,3,2,1,0,17,18,19,20,21,22,23,24,24,24,24,24,24,24,24,25,25,25,25,25,25,25,25,25,25,25,25,25,25,25,25,26,26,26,26,26,26,26,26,26,26,26,26,26,26,26,26,26,26,26,26,26,26,26,26,26,26,26,26,26,26,26,26,27},
 {13,12,12,12,12,12,12,12,12,12,12,12,12,12,12,12,12,12,12,12,12,12,12,12,12,12,12,12,12,12,12,12,12,11,11,11,11,11,11,11,11,11,11,11,11,11,11,11,11,10,10,10,10,10,10,10,10,9,9,9,9,8,8,4,0,20,24,24,25,25,25,25,26,26,26,26,26,26,26,26,27,27,27,27,27,27,27,27,27,27,27,27,27,27,27,27,28,28,28,28,28,28,28,28,28,28,28,28,28,28,28,28,28,28,28,28,28,28,28,28,28,28,28,28,28,28,28,28,29},
 {15,14,14,14,14,14,14,14,14,14,14,14,14,14,14,14,14,14,14,14,14,14,14,14,14,14,14,14,14,14,14,14,14,13,13,13,13,13,13,13,13,13,13,13,13,13,13,13,13,12,12,12,12,12,12,12,12,11,11,11,11,10,10,9,0,25,26,26,27,27,27,27,28,28,28,28,28,28,28,28,29,29,29,29,29,29,29,29,29,29,29,29,29,29,29,29,30,30,30,30,30,30,30,30,30,30,30,30,30,30,30,30,30,30,30,30,30,30,30,30,30,30,30,30,30,30,30,30,31}};

__device__ __forceinline__ float bf2f(bf16 b) { return __uint_as_float(((unsigned)b) << 16); }
__device__ __forceinline__ bf16 f2bf(float f) { unsigned u = __float_as_uint(f); u += 0x7fffu + ((u >> 16) & 1u); return (bf16)(u >> 16); }
__device__ __forceinline__ float wave_sum(float v) {
#pragma unroll
    for (int o = 1; o < 64; o <<= 1) v += __shfl_xor(v, o);
    return v;
}

struct Rec { int e0, s0, e1, s1; float g0, g1; int pad0, pad1; };

#ifndef PG8_ALIGN
#define PG8_ALIGN 1
#endif
namespace pg8 {
#define PG8_LAS __attribute__((address_space(3)))
typedef unsigned short bf16_t;
typedef unsigned u32x4 __attribute__((ext_vector_type(4)));
constexpr int BM = 256, BK = 64, HALF = 128, HTB = HALF * BK * 2  , STAGE_BYTES = 8 * HTB, NXCD = 8, WGM = 4;

__host__ __device__ __forceinline__ int lds_byte(int r, int c) { const int st = (r >> 4) * 2 + (c >> 5), rr = r & 15, cc = c & 31, ob = rr * 64 + cc * 2; return st * 1024 + (ob ^ (((ob >> 9) & 1) << 5)); }
__host__ __device__ __forceinline__ void stage_rc(int b, int& R, int& C) { const int st = b / 1024, sb = b % 1024, swz = sb ^ (((sb >> 9) & 1) << 5); R = (st >> 1) * 16 + swz / 64; C = (st & 1) * 32 + (swz % 64) / 2; }
__host__ __device__ __forceinline__ int perm32(int rho) { const int n = rho >> 4, i = rho & 15; return 8 * (i >> 2) + 4 * n + (i & 3); }

struct Unit { int pm, pn, e, ui; };

struct DenseOrder {
    int nM, nN, nwg, G, c; const char* A; const char* B; size_t tstepA, tstepB;
    __device__ void init(const void* A_, int lda, const void* B_, int ldb, int M, int N, int G_, int c_) { nM = M / BM; nN = N / BM; nwg = nM * nN; G = G_; c = c_; A = (const char*)A_; B = (const char*)B_; tstepA = (size_t)BM * lda * 2; tstepB = (size_t)BM * ldb * 2; }
    __device__ bool next(int i, Unit& u) const {
        const long Lx = (long)i * G + c; if (Lx >= nwg) return false;
        int wgid = (int)Lx; { const int q = nwg / NXCD, r = nwg % NXCD, xcd = wgid % NXCD, off = wgid / NXCD; wgid = (xcd < r ? xcd * (q + 1) : r * (q + 1) + (xcd - r) * q) + off; }
        const int nig = WGM * nN, gid = wgid / nig, fm = gid * WGM, gsz = (nM - fm) < WGM ? (nM - fm) : WGM;
        u.pm = fm + ((wgid % nig) % gsz); u.pn = (wgid % nig) / gsz; u.e = 0; u.ui = i; return true;
    }
    __device__ __forceinline__ const char* a_base(const Unit& u) const { return A + (size_t)u.pm * tstepA; }
    __device__ __forceinline__ const char* b_base(const Unit& u) const { return B + (size_t)u.pn * tstepB; }
    __device__ __forceinline__ int a_row(const Unit&, int) const { return 0; }
};

__device__ __forceinline__ unsigned cvt_pk_bf16(float lo, float hi) { unsigned r; asm volatile("v_cvt_pk_bf16_f32 %0, %1, %2" : "=v"(r) : "v"(lo), "v"(hi)); return r; }

template <class Epi, class Sched, bool GATHER>
__device__ __forceinline__ void gemm_phase(PG8_LAS unsigned char* lds, const Sched& S, const Epi& E, const int K, const int lda, const int ldb, const int tid_in) {
    int tid = tid_in; asm volatile("" : "+v"(tid));
    const int wid = __builtin_amdgcn_readfirstlane(tid >> 6), lane = tid & 63, wr = wid >> 2, wc = wid & 3, fr = lane & 15, fq = lane >> 4;
    const int nt = K / BK;
    int RA[2], CA[2]; unsigned voffB[2];
#pragma unroll
    for (int i = 0; i < 2; ++i) { int R, C; stage_rc(tid * 16 + i * 8192, R, C); const int Rb = Epi::PERM ? ((R & ~31) + perm32(R & 31)) : R; RA[i] = R; CA[i] = C; voffB[i] = (unsigned)(Rb * ldb + C) * 2u; }
    const size_t kstep = (size_t)(BK * 2);
    const size_t hstepB = (size_t)HALF * ldb * 2;
    const unsigned ldsw = (unsigned)wid * 1024u;
    const int aoff = lds_byte(wr * 64 + fr, fq * 8), boff = lds_byte(wc * 32 + fr, fq * 8);
#define PG8_SA(b, h) (((b) * 2 + (h)) * HTB)
#define PG8_SB(b, h) ((4 + (b) * 2 + (h)) * HTB)
#define PG8_STAGE2(bufoff, gbase, v0, v1) do { \
        __builtin_amdgcn_global_load_lds((const unsigned*)((const char*)(gbase) + (v0)), (PG8_LAS unsigned*)(lds + (bufoff) + ldsw), 16, 0, 0); \
        __builtin_amdgcn_global_load_lds((const unsigned*)((const char*)(gbase) + (v1)), (PG8_LAS unsigned*)(lds + (bufoff) + ldsw + 8192), 16, 0, 0); } while (0)
#define PG8_STAGEB(bufoff, gbase) PG8_STAGE2(bufoff, gbase, voffB[0], voffB[1])
#define PG8_LDA(dst, b, h) do { _Pragma("unroll") for (int m = 0; m < 4; ++m) _Pragma("unroll") for (int k = 0; k < 2; ++k) dst[m][k] = *(const PG8_LAS bf16x8*)(lds + PG8_SA(b, h) + aoff + m * 2048 + k * 1024); } while (0)
#define PG8_LDB(dst, b, h) do { _Pragma("unroll") for (int n = 0; n < 2; ++n) _Pragma("unroll") for (int k = 0; k < 2; ++k) dst[n][k] = *(const PG8_LAS bf16x8*)(lds + PG8_SB(b, h) + boff + n * 2048 + k * 1024); } while (0)
#define PG8_MMA(ai, bj, At, Bt) do { __builtin_amdgcn_s_setprio(1); _Pragma("unroll") for (int m = 0; m < 4; ++m) _Pragma("unroll") for (int n = 0; n < 2; ++n) _Pragma("unroll") for (int k = 0; k < 2; ++k) \
        acc[ai][bj][m][n] = __builtin_amdgcn_mfma_f32_16x16x32_bf16(Bt[n][k], At[m][k], acc[ai][bj][m][n], 0, 0, 0); __builtin_amdgcn_s_setprio(0); } while (0)
#define PG8_WAIT_V(n) asm volatile("s_waitcnt vmcnt(" #n ")" ::: "memory")
#define PG8_WAIT_L(n) asm volatile("s_waitcnt lgkmcnt(" #n ")" ::: "memory")
#define PG8_BAR __builtin_amdgcn_s_barrier()
#define PG8_SCHED __builtin_amdgcn_sched_barrier(0)
#define PG8_VOFFA(dst, u) do { _Pragma("unroll") for (int h_ = 0; h_ < 2; ++h_) _Pragma("unroll") for (int i_ = 0; i_ < 2; ++i_) { \
        const int row_ = GATHER ? S.a_row(u, h_ * HALF + RA[i_]) : (h_ * HALF + RA[i_]); dst[h_][i_] = (unsigned)(row_ * lda + CA[i_]) * 2u; } } while (0)
    Unit cur, nxt;
    if (!S.next(0, cur)) return;
    f32x4 acc[2][2][4][2];
#pragma unroll
    for (int a = 0; a < 2; ++a)
#pragma unroll
        for (int b = 0; b < 2; ++b)
#pragma unroll
            for (int m = 0; m < 4; ++m)
#pragma unroll
                for (int n = 0; n < 2; ++n) acc[a][b][m][n] = (f32x4){0.f, 0.f, 0.f, 0.f};
    bf16x8 At[4][2], B0[2][2], B1[2][2];
    unsigned vc[2][2], vn[2][2];
    PG8_VOFFA(vc, cur);
    const char* cA = S.a_base(cur); const char* cB = S.b_base(cur);
    PG8_STAGEB(PG8_SB(0, 0), cB); PG8_STAGEB(PG8_SB(0, 1), cB + hstepB); PG8_STAGE2(PG8_SA(0, 0), cA, vc[0][0], vc[0][1]); PG8_STAGE2(PG8_SA(0, 1), cA, vc[1][0], vc[1][1]);
    if (wr == 1) PG8_BAR;
    PG8_WAIT_V(2); PG8_BAR;
    PG8_STAGEB(PG8_SB(1, 0), cB + kstep); PG8_STAGE2(PG8_SA(1, 0), cA + kstep, vc[0][0], vc[0][1]); PG8_STAGEB(PG8_SB(1, 1), cB + hstepB + kstep);
    PG8_WAIT_V(6); PG8_BAR;
    int ui = 0;
    for (;;) {
        const bool has_next = S.next(ui + 1, nxt);
        const char* nA = has_next ? S.a_base(nxt) : cA; const char* nB = has_next ? S.b_base(nxt) : cB;
        if (GATHER) { if (has_next) { PG8_VOFFA(vn, nxt); } else {
#pragma unroll
            for (int h_ = 0; h_ < 2; ++h_) { vn[h_][0] = vc[h_][0]; vn[h_][1] = vc[h_][1]; } } }
        for (int t = 0; t < nt; t += 2) {
            const bool last = (t == nt - 2);
            const char* a1 = cA + (size_t)(t + 1) * kstep;
            const char* a2 = last ? nA : cA + (size_t)(t + 2) * kstep; const char* b2 = last ? nB : cB + (size_t)(t + 2) * kstep;
            const char* a3 = a2 + kstep; const char* b3 = b2 + kstep;
            unsigned w00, w01, w10, w11;
            if (GATHER) { w00 = last ? vn[0][0] : vc[0][0]; w01 = last ? vn[0][1] : vc[0][1]; w10 = last ? vn[1][0] : vc[1][0]; w11 = last ? vn[1][1] : vc[1][1]; }
            else { w00 = vc[0][0]; w01 = vc[0][1]; w10 = vc[1][0]; w11 = vc[1][1]; }
            PG8_LDB(B0, 0, 0); PG8_LDB(B1, 0, 1); PG8_SCHED; PG8_LDA(At, 0, 0); PG8_STAGE2(PG8_SA(1, 1), a1, vc[1][0], vc[1][1]);
            PG8_WAIT_V(8); PG8_WAIT_L(0); PG8_BAR; PG8_MMA(0, 0, At, B0); PG8_MMA(0, 1, At, B1); PG8_BAR; PG8_SCHED;
            PG8_LDA(At, 0, 1); PG8_STAGEB(PG8_SB(0, 0), b2); PG8_STAGEB(PG8_SB(0, 1), b2 + hstepB); PG8_STAGE2(PG8_SA(0, 0), a2, w00, w01);
            PG8_WAIT_V(8); PG8_WAIT_L(0); PG8_BAR; PG8_MMA(1, 0, At, B0); PG8_MMA(1, 1, At, B1); PG8_BAR; PG8_SCHED;
            PG8_LDB(B0, 1, 0); PG8_LDB(B1, 1, 1); PG8_SCHED; PG8_LDA(At, 1, 0); PG8_STAGE2(PG8_SA(0, 1), a2, w10, w11);
            PG8_WAIT_V(8); PG8_WAIT_L(0); PG8_BAR; PG8_MMA(0, 0, At, B0); PG8_MMA(0, 1, At, B1); PG8_BAR; PG8_SCHED;
            PG8_LDA(At, 1, 1); PG8_STAGEB(PG8_SB(1, 0), b3); PG8_STAGEB(PG8_SB(1, 1), b3 + hstepB); PG8_STAGE2(PG8_SA(1, 0), a3, w00, w01);
            PG8_WAIT_V(8); PG8_WAIT_L(0); PG8_BAR; PG8_MMA(1, 0, At, B0); PG8_MMA(1, 1, At, B1); PG8_BAR; PG8_SCHED;
        }
        if (PG8_ALIGN && wr == 0) PG8_BAR;
        E(acc, cur, wr, wc, fr, fq);
        if (!has_next) break;
#pragma unroll
        for (int a = 0; a < 2; ++a)
#pragma unroll
            for (int b = 0; b < 2; ++b)
#pragma unroll
                for (int m = 0; m < 4; ++m)
#pragma unroll
                    for (int n = 0; n < 2; ++n) acc[a][b][m][n] = (f32x4){0.f, 0.f, 0.f, 0.f};
        cur = nxt; cA = nA; cB = nB; ++ui;
        if (GATHER) {
#pragma unroll
            for (int h_ = 0; h_ < 2; ++h_) { vc[h_][0] = vn[h_][0]; vc[h_][1] = vn[h_][1]; } }
        if (PG8_ALIGN && wr == 1) PG8_BAR;
    }
    PG8_WAIT_V(0);
    if (!PG8_ALIGN && wr == 0) PG8_BAR;
    PG8_BAR;
#undef PG8_SA
#undef PG8_SB
#undef PG8_STAGE2
#undef PG8_STAGEB
#undef PG8_LDA
#undef PG8_LDB
#undef PG8_MMA
#undef PG8_WAIT_V
#undef PG8_WAIT_L
#undef PG8_BAR
#undef PG8_SCHED
#undef PG8_VOFFA
}
template <class Epi, class Sched>
__device__ __forceinline__ void gemm_phase_vk(PG8_LAS unsigned char* lds, const Sched& S, const Epi& E, const int lda, const int tid_in) {
    constexpr bool GATHER = false;
    int tid = tid_in; asm volatile("" : "+v"(tid));
    const int wid = __builtin_amdgcn_readfirstlane(tid >> 6), lane = tid & 63, wr = wid >> 2, wc = wid & 3, fr = lane & 15, fq = lane >> 4;
    int RA[2], CA[2], RB[2];
#pragma unroll
    for (int i = 0; i < 2; ++i) { int R, C; stage_rc(tid * 16 + i * 8192, R, C); const int Rb = Epi::PERM ? ((R & ~31) + perm32(R & 31)) : R; RA[i] = R; CA[i] = C; RB[i] = Rb; }
    const size_t kstep = (size_t)(BK * 2);
    const unsigned ldsw = (unsigned)wid * 1024u;
    const int aoff = lds_byte(wr * 64 + fr, fq * 8), boff = lds_byte(wc * 32 + fr, fq * 8);
#define PG8_SA(b, h) (((b) * 2 + (h)) * HTB)
#define PG8_SB(b, h) ((4 + (b) * 2 + (h)) * HTB)
#define PG8_STAGE2(bufoff, gbase, v0, v1) do { \
        __builtin_amdgcn_global_load_lds((const unsigned*)((const char*)(gbase) + (v0)), (PG8_LAS unsigned*)(lds + (bufoff) + ldsw), 16, 0, 0); \
        __builtin_amdgcn_global_load_lds((const unsigned*)((const char*)(gbase) + (v1)), (PG8_LAS unsigned*)(lds + (bufoff) + ldsw + 8192), 16, 0, 0); } while (0)
#define PG8_VOFFB(dst, hs, u) do { const int ldb_ = S.ldb_of(u); _Pragma("unroll") for (int i_ = 0; i_ < 2; ++i_) { int R_, C_; stage_rc(tid * 16 + i_ * 8192, R_, C_); const int Rb_ = Epi::PERM ? ((R_ & ~31) + perm32(R_ & 31)) : R_; dst[i_] = (unsigned)(Rb_ * ldb_ + C_) * 2u; } hs = (size_t)HALF * ldb_ * 2; } while (0)
#define PG8_LDA(dst, b, h) do { _Pragma("unroll") for (int m = 0; m < 4; ++m) _Pragma("unroll") for (int k = 0; k < 2; ++k) dst[m][k] = *(const PG8_LAS bf16x8*)(lds + PG8_SA(b, h) + aoff + m * 2048 + k * 1024); } while (0)
#define PG8_LDB(dst, b, h) do { _Pragma("unroll") for (int n = 0; n < 2; ++n) _Pragma("unroll") for (int k = 0; k < 2; ++k) dst[n][k] = *(const PG8_LAS bf16x8*)(lds + PG8_SB(b, h) + boff + n * 2048 + k * 1024); } while (0)
#define PG8_MMA(ai, bj, At, Bt) do { __builtin_amdgcn_s_setprio(1); _Pragma("unroll") for (int m = 0; m < 4; ++m) _Pragma("unroll") for (int n = 0; n < 2; ++n) _Pragma("unroll") for (int k = 0; k < 2; ++k) \
        acc[ai][bj][m][n] = __builtin_amdgcn_mfma_f32_16x16x32_bf16(Bt[n][k], At[m][k], acc[ai][bj][m][n], 0, 0, 0); __builtin_amdgcn_s_setprio(0); } while (0)
#define PG8_WAIT_V(n) asm volatile("s_waitcnt vmcnt(" #n ")" ::: "memory")
#define PG8_WAIT_L(n) asm volatile("s_waitcnt lgkmcnt(" #n ")" ::: "memory")
#define PG8_BAR __builtin_amdgcn_s_barrier()
#define PG8_SCHED __builtin_amdgcn_sched_barrier(0)
#define PG8_VOFFA(dst, u) do { _Pragma("unroll") for (int h_ = 0; h_ < 2; ++h_) _Pragma("unroll") for (int i_ = 0; i_ < 2; ++i_) { \
        const int row_ = GATHER ? S.a_row(u, h_ * HALF + RA[i_]) : (h_ * HALF + RA[i_]); dst[h_][i_] = (unsigned)(row_ * lda + CA[i_]) * 2u; } } while (0)
    Unit cur, nxt;
    if (!S.next(0, cur)) return;
    f32x4 acc[2][2][4][2];
#pragma unroll
    for (int a = 0; a < 2; ++a)
#pragma unroll
        for (int b = 0; b < 2; ++b)
#pragma unroll
            for (int m = 0; m < 4; ++m)
#pragma unroll
                for (int n = 0; n < 2; ++n) acc[a][b][m][n] = (f32x4){0.f, 0.f, 0.f, 0.f};
    bf16x8 At[4][2], B0[2][2], B1[2][2];
    unsigned vc[2][2], vn[2][2];
    PG8_VOFFA(vc, cur);
    unsigned vbc[2], vbn[2]; size_t hsc, hsn; PG8_VOFFB(vbc, hsc, cur); int nt = S.K_of(cur) / BK;
    const char* cA = S.a_base(cur); const char* cB = S.b_base(cur);
    PG8_STAGE2(PG8_SB(0, 0), cB, vbc[0], vbc[1]); PG8_STAGE2(PG8_SB(0, 1), cB + hsc, vbc[0], vbc[1]); PG8_STAGE2(PG8_SA(0, 0), cA, vc[0][0], vc[0][1]); PG8_STAGE2(PG8_SA(0, 1), cA, vc[1][0], vc[1][1]);
    if (wr == 1) PG8_BAR;
    PG8_WAIT_V(2); PG8_BAR;
    PG8_STAGE2(PG8_SB(1, 0), cB + kstep, vbc[0], vbc[1]); PG8_STAGE2(PG8_SA(1, 0), cA + kstep, vc[0][0], vc[0][1]); PG8_STAGE2(PG8_SB(1, 1), cB + hsc + kstep, vbc[0], vbc[1]);
    PG8_WAIT_V(6); PG8_BAR;
    int ui = 0;
    for (;;) {
        const bool has_next = S.next(ui + 1, nxt);
        const char* nA = has_next ? S.a_base(nxt) : cA; const char* nB = has_next ? S.b_base(nxt) : cB;
        if (has_next) { PG8_VOFFB(vbn, hsn, nxt); } else { vbn[0] = vbc[0]; vbn[1] = vbc[1]; hsn = hsc; }
        if (GATHER) { if (has_next) { PG8_VOFFA(vn, nxt); } else {
#pragma unroll
            for (int h_ = 0; h_ < 2; ++h_) { vn[h_][0] = vc[h_][0]; vn[h_][1] = vc[h_][1]; } } }
        for (int t = 0; t < nt; t += 2) {
            const bool last = (t == nt - 2);
            const char* a1 = cA + (size_t)(t + 1) * kstep;
            const char* a2 = last ? nA : cA + (size_t)(t + 2) * kstep; const char* b2 = last ? nB : cB + (size_t)(t + 2) * kstep;
            const char* a3 = a2 + kstep; const char* b3 = b2 + kstep;
            unsigned w00, w01, w10, w11;
            if (GATHER) { w00 = last ? vn[0][0] : vc[0][0]; w01 = last ? vn[0][1] : vc[0][1]; w10 = last ? vn[1][0] : vc[1][0]; w11 = last ? vn[1][1] : vc[1][1]; }
            else { w00 = vc[0][0]; w01 = vc[0][1]; w10 = vc[1][0]; w11 = vc[1][1]; }
            const unsigned wb0 = last ? vbn[0] : vbc[0], wb1 = last ? vbn[1] : vbc[1]; const size_t hsb = last ? hsn : hsc;
            PG8_LDB(B0, 0, 0); PG8_LDB(B1, 0, 1); PG8_SCHED; PG8_LDA(At, 0, 0); PG8_STAGE2(PG8_SA(1, 1), a1, vc[1][0], vc[1][1]);
            PG8_WAIT_V(8); PG8_WAIT_L(0); PG8_BAR; PG8_MMA(0, 0, At, B0); PG8_MMA(0, 1, At, B1); PG8_BAR; PG8_SCHED;
            PG8_LDA(At, 0, 1); PG8_STAGE2(PG8_SB(0, 0), b2, wb0, wb1); PG8_STAGE2(PG8_SB(0, 1), b2 + hsb, wb0, wb1); PG8_STAGE2(PG8_SA(0, 0), a2, w00, w01);
            PG8_WAIT_V(8); PG8_WAIT_L(0); PG8_BAR; PG8_MMA(1, 0, At, B0); PG8_MMA(1, 1, At, B1); PG8_BAR; PG8_SCHED;
            PG8_LDB(B0, 1, 0); PG8_LDB(B1, 1, 1); PG8_SCHED; PG8_LDA(At, 1, 0); PG8_STAGE2(PG8_SA(0, 1), a2, w10, w11);
            PG8_WAIT_V(8); PG8_WAIT_L(0); PG8_BAR; PG8_MMA(0, 0, At, B0); PG8_MMA(0, 1, At, B1); PG8_BAR; PG8_SCHED;
            PG8_LDA(At, 1, 1); PG8_STAGE2(PG8_SB(1, 0), b3, wb0, wb1); PG8_STAGE2(PG8_SB(1, 1), b3 + hsb, wb0, wb1); PG8_STAGE2(PG8_SA(1, 0), a3, w00, w01);
            PG8_WAIT_V(8); PG8_WAIT_L(0); PG8_BAR; PG8_MMA(1, 0, At, B0); PG8_MMA(1, 1, At, B1); PG8_BAR; PG8_SCHED;
        }
        if (PG8_ALIGN && wr == 0) PG8_BAR;
        E(acc, cur, wr, wc, fr, fq);
        if (!has_next) break;
#pragma unroll
        for (int a = 0; a < 2; ++a)
#pragma unroll
            for (int b = 0; b < 2; ++b)
#pragma unroll
                for (int m = 0; m < 4; ++m)
#pragma unroll
                    for (int n = 0; n < 2; ++n) acc[a][b][m][n] = (f32x4){0.f, 0.f, 0.f, 0.f};
        cur = nxt; cA = nA; cB = nB; ++ui; vbc[0] = vbn[0]; vbc[1] = vbn[1]; hsc = hsn; nt = S.K_of(cur) / BK;
        if (GATHER) {
#pragma unroll
            for (int h_ = 0; h_ < 2; ++h_) { vc[h_][0] = vn[h_][0]; vc[h_][1] = vn[h_][1]; } }
        if (PG8_ALIGN && wr == 1) PG8_BAR;
    }
    PG8_WAIT_V(0);
    if (!PG8_ALIGN && wr == 0) PG8_BAR;
    PG8_BAR;
#undef PG8_SA
#undef PG8_SB
#undef PG8_STAGE2
#undef PG8_VOFFB
#undef PG8_LDA
#undef PG8_LDB
#undef PG8_MMA
#undef PG8_WAIT_V
#undef PG8_WAIT_L
#undef PG8_BAR
#undef PG8_SCHED
#undef PG8_VOFFA
}
}

constexpr int NWAVES = 8, NTHREADS = 512;
constexpr int RING_OFF = 0, RING_BYTES = 131072, ROWS_OFF = 131072, ROWS_BYTES = 12288, ROUTER_BYTES = 147456  , MISC_OFF = ROUTER_BYTES, LCNT_OFF = MISC_OFF + 128  , LDS_BYTES = 148480;
static_assert(MISC_OFF + 128 <= LDS_BYTES, "LDS map");
constexpr int CW_CNT = 0;
constexpr int CW_BAR = 4096;
constexpr size_t CTL_ZERO_BYTES = 64 * 1024;
constexpr float LOG2E = 1.4426950408889634f, LN2 = 0.6931471805599453f;
constexpr float QSCALE = 0.125f * LOG2E;

#define GAS __attribute__((address_space(1)))
#define LAS __attribute__((address_space(3)))
typedef unsigned v4u __attribute__((ext_vector_type(4)));
typedef unsigned v2u __attribute__((ext_vector_type(2)));
#define LDS_WAIT() asm volatile("s_waitcnt lgkmcnt(0)" ::: "memory")
__device__ __forceinline__ unsigned pk2(float lo, float hi) { return (unsigned)f2bf(lo) | ((unsigned)f2bf(hi) << 16); }

#define XB_TMO      128
#define XB_XCNT(j)  (256  + 64 * (j))
#define XB_XSUB(j)  (1280 + 64 * (j))
#define XB_XGEN(j)  (2304 + 64 * (j))
#define XB_TOP      3328
#define XB_TOPGEN   3392
#define XCD_BAR_WORDS 3456
#define XB_SPIN_CAP (1u << 18)

__device__ __forceinline__ unsigned xb_ld(unsigned* p)              { return __hip_atomic_load(p, __ATOMIC_RELAXED, __HIP_MEMORY_SCOPE_AGENT); }
__device__ __forceinline__ unsigned xb_add(unsigned* p, unsigned v) { return __hip_atomic_fetch_add(p, v, __ATOMIC_RELAXED, __HIP_MEMORY_SCOPE_AGENT); }
__device__ __forceinline__ unsigned xb_xcc_id() { return (unsigned)__builtin_amdgcn_s_getreg((3 << 11) | 20) & 0xFu; }
#define XB_SPIN(cond, bar) do { unsigned _sp = 0; while (cond) { __builtin_amdgcn_s_sleep(1); \
    if ((++_sp & 255u) == 0u) { if (xb_ld(&(bar)[XB_TMO])) break; if (_sp > XB_SPIN_CAP) { atomicAdd(&(bar)[XB_TMO], 1u); break; } } } } while (0)

struct XcdBarrier {
    int wave0;
    unsigned* bar; unsigned x;
    volatile LAS unsigned* st;
};

__device__ __forceinline__ unsigned xb_lane() { unsigned l_; asm volatile("v_mbcnt_lo_u32_b32 %0, -1, 0\n\tv_mbcnt_hi_u32_b32 %0, -1, %0" : "=v"(l_)); return l_; }
__device__ __forceinline__ XcdBarrier xcd_barrier_post(unsigned* bar, volatile LAS unsigned* st, int wave0) {
    XcdBarrier b; b.wave0 = wave0; b.bar = bar; b.x = xb_xcc_id(); b.st = st;
    if (b.wave0 && xb_lane() == 0u) (void)xb_add(&bar[XB_XCNT(b.x)], 1u);
    return b;
}
__device__ __forceinline__ void xcd_barrier_complete(unsigned* bar, unsigned x, unsigned& nloc, unsigned& nx) {
    const unsigned G = gridDim.x * gridDim.y * gridDim.z;
    unsigned sum, cnt, mine, sp = 0u;
    for (;;) {
        sum = 0u; cnt = 0u; mine = 0u;
#pragma unroll
        for (unsigned j = 0; j < 16; ++j) { const unsigned c = xb_ld(&bar[XB_XCNT(j)]); sum += c; cnt += (c > 0u) ? 1u : 0u; mine = (j == x) ? c : mine; }
        if (sum == G) break;
        __builtin_amdgcn_s_sleep(1);
        if ((++sp & 255u) == 0u) { if (xb_ld(&bar[XB_TMO])) break; if (sp > XB_SPIN_CAP) { atomicAdd(&bar[XB_TMO], 1u); break; } }
    }
    nloc = mine > 0u ? mine : 1u; nx = cnt > 0u ? cnt : 1u;
}

__device__ __forceinline__ void xcd_barrier(const XcdBarrier& b) {
    asm volatile("s_waitcnt vmcnt(0)" ::: "memory");
    __syncthreads();
    if (b.wave0 && xb_lane() == 0u) {
        unsigned* bar = b.bar;
        __builtin_amdgcn_s_waitcnt(0);
        unsigned nloc = b.st[0], nx = b.st[1];
        if (nloc == 0u) { xcd_barrier_complete(bar, b.x, nloc, nx); b.st[0] = nloc; b.st[1] = nx; }
        const unsigned old = xb_add(&bar[XB_XSUB(b.x)], 1u);
        const unsigned gen = old / nloc;
        if (old + 1u == (gen + 1u) * nloc) {
            __builtin_amdgcn_fence(__ATOMIC_RELEASE, "agent");
            asm volatile("s_waitcnt vmcnt(0)" ::: "memory");
            const unsigned og = xb_add(&bar[XB_TOP], 1u);
            const unsigned tg = og / nx;
            if (og + 1u == (tg + 1u) * nx) xb_add(&bar[XB_TOPGEN], 1u);
            else XB_SPIN(xb_ld(&bar[XB_TOPGEN]) == tg, bar);
            __builtin_amdgcn_fence(__ATOMIC_ACQUIRE, "agent");
            xb_add(&bar[XB_XGEN(b.x)], 1u);
            asm volatile("s_waitcnt vmcnt(0)" ::: "memory");
        } else {
            XB_SPIN(xb_ld(&bar[XB_XGEN(b.x)]) == gen, bar);
            __builtin_amdgcn_fence(__ATOMIC_ACQUIRE, "agent");
            asm volatile("s_waitcnt vmcnt(0)" ::: "memory");
        }
    }
    __syncthreads();
}


struct Args { const float* in[23]; float* out; unsigned char* ws; int s_lo, s_hi, probe, pad; };

struct Frame {
    LAS unsigned char* lds; int tid, lane, wave, vcu, G;
    const float* const* in; float* h; unsigned char* ws; int probe;
};

__device__ __forceinline__ int hw_lane() { int l_; asm volatile("v_mbcnt_lo_u32_b32 %0, -1, 0\n\tv_mbcnt_hi_u32_b32 %0, -1, %0" : "=v"(l_)); return l_; }
__device__ __forceinline__ float shfl_xor_l(float v, int mask, int lane) { return __builtin_bit_cast(float, __builtin_amdgcn_ds_bpermute((lane ^ mask) << 2, __builtin_bit_cast(int, v))); }
__device__ __forceinline__ float dpp_add(float v, const int ctrl_sel) {
    const int x = __builtin_bit_cast(int, v); int y;
    if (ctrl_sel == 0) y = __builtin_amdgcn_mov_dpp(x, 0xB1, 0xF, 0xF, true);
    else if (ctrl_sel == 1) y = __builtin_amdgcn_mov_dpp(x, 0x4E, 0xF, 0xF, true);
    else if (ctrl_sel == 2) y = __builtin_amdgcn_mov_dpp(x, 0x141, 0xF, 0xF, true);
    else y = __builtin_amdgcn_mov_dpp(x, 0x140, 0xF, 0xF, true);
    return v + __builtin_bit_cast(float, y);
}
__device__ __forceinline__ float wave_sum_l(float v, int lane) {
    (void)lane;
    v = dpp_add(v, 0); v = dpp_add(v, 1); v = dpp_add(v, 2); v = dpp_add(v, 3);
    const int x = __builtin_bit_cast(int, v);
    const float r0 = __builtin_bit_cast(float, __builtin_amdgcn_readlane(x, 0)), r1 = __builtin_bit_cast(float, __builtin_amdgcn_readlane(x, 16)),
                r2 = __builtin_bit_cast(float, __builtin_amdgcn_readlane(x, 32)), r3 = __builtin_bit_cast(float, __builtin_amdgcn_readlane(x, 48));
    return (r0 + r1) + (r2 + r3);
}
#define LAUNDER(F) do { (F).lane = hw_lane(); (F).tid = (F).wave * 64 + (F).lane; asm volatile("" : "+s"((F).G), "+s"((F).vcu), "+s"((F).ws), "+s"((F).h)); } while (0)
__device__ __forceinline__ void p0_item(const float* W, int ldw, int k0, int n0, bf16* WT, int Kd, int drow0, float scale, LAS float* scr, int lane) {
#pragma unroll 8
    for (int i = 0; i < 32; ++i) { const int kk = 2 * i + (lane >> 5); scr[kk * 33 + (lane & 31)] = W[(size_t)(k0 + kk) * ldw + n0 + (lane & 31)] * scale; }
    LDS_WAIT(); asm volatile("" ::: "memory");
    const int c = lane & 7;
#pragma unroll
    for (int j = 0; j < 4; ++j) { const int n = (lane >> 3) + 8 * j; const LAS float* s = scr + (8 * c) * 33 + n;
        v4u o; o.x = pk2(s[0 * 33], s[1 * 33]); o.y = pk2(s[2 * 33], s[3 * 33]); o.z = pk2(s[4 * 33], s[5 * 33]); o.w = pk2(s[6 * 33], s[7 * 33]);
        *(GAS v4u*)(WT + (size_t)(drow0 + n) * Kd + k0 + 8 * c) = o; }
    LDS_WAIT(); asm volatile("" ::: "memory");
}
__device__ __forceinline__ bool is_q_col(int n) { return n < 512 || (n >= 768 && n < 3072 && ((n - 768) % 768) < 256) || (n >= 3072 && n < 3584); }

__device__ __forceinline__ void ph_prologue(Frame& F) { LAUNDER(F);
    LAS float* scr = (LAS float*)(F.lds + RING_OFF + F.wave * 16384);
    const int gw = F.vcu * NWAVES + F.wave, NGW = F.G * NWAVES, lane = F.lane;
    const float* w_in = F.in[4]; const float* w_a = F.in[8]; const float* w_b = F.in[9]; const float* w_c = F.in[10]; const float* w_o = F.in[11];
    const float* w_eg = F.in[18]; const float* w_eu = F.in[19]; const float* w_ed = F.in[20];
    bf16* WIN = (bf16*)(F.ws + WS_WIN); bf16* WBRA = (bf16*)(F.ws + WS_WBRA); bf16* WBRB = (bf16*)(F.ws + WS_WBRB); bf16* WBRC = (bf16*)(F.ws + WS_WBRC); bf16* WOUT = (bf16*)(F.ws + WS_WOUT);
    bf16* WGU = (bf16*)(F.ws + WS_WGU); bf16* WD = (bf16*)(F.ws + WS_WD);
    constexpr int I_IN = 16 * (NCOL / 32), I_A = 8 * 32, I_B = 4 * 32, I_C = 8 * 32, I_O = 16 * 32, I_G = 16 * 16, I_D = 8 * 32;
    constexpr int I_LAYER = I_IN + I_A + I_B + I_C + I_O + NE * (2 * I_G + I_D);
    for (int it = gw; it < DEPTH * I_LAYER; it += NGW) {
        const int l = it / I_LAYER; int r = it % I_LAYER;
        if (r < I_IN) { const int nb = r % (NCOL / 32), kb = r / (NCOL / 32); p0_item(w_in + (size_t)l * D * NCOL, NCOL, 64 * kb, 32 * nb, WIN + (size_t)l * NCOL * D, D, 32 * nb, is_q_col(32 * nb) ? QSCALE : 1.0f, scr, lane); continue; } r -= I_IN;
        if (r < I_A) { const int nb = r % 32, kb = r / 32; p0_item(w_a + (size_t)l * 512 * D, D, 64 * kb, 32 * nb, WBRA + (size_t)l * D * 512, 512, 32 * nb, 1.0f, scr, lane); continue; } r -= I_A;
        if (r < I_B) { const int nb = r % 32, kb = r / 32; p0_item(w_b + (size_t)l * 256 * D, D, 64 * kb, 32 * nb, WBRB + (size_t)l * D * 256, 256, 32 * nb, 1.0f, scr, lane); continue; } r -= I_B;
        if (r < I_C) { const int nb = r % 32, kb = r / 32; p0_item(w_c + (size_t)l * 512 * D, D, 64 * kb, 32 * nb, WBRC + (size_t)l * D * 512, 512, 32 * nb, 1.0f, scr, lane); continue; } r -= I_C;
        if (r < I_O) { const int nb = r % 32, kb = r / 32; p0_item(w_o + (size_t)l * D * D, D, 64 * kb, 32 * nb, WOUT + (size_t)l * D * D, D, 32 * nb, 1.0f, scr, lane); continue; } r -= I_O;
        const int e = r / (2 * I_G + I_D); r %= (2 * I_G + I_D); const size_t le = (size_t)l * NE + e;
        if (r < 2 * I_G) { const int up = r / I_G; r %= I_G; const int nb = r % 16, kb = r / 16;
            p0_item((up ? w_eu : w_eg) + le * D * DE, DE, 64 * kb, 32 * nb, WGU + le * 1024 * 1024, D, (nb >> 2) * 256 + up * 128 + (nb & 3) * 32, 1.0f, scr, lane); continue; }
        r -= 2 * I_G; { const int nb = r % 32, kb = r / 32; p0_item(w_ed + le * DE * D, D, 64 * kb, 32 * nb, WD + le * D * DE, DE, 32 * nb, 1.0f, scr, lane); }
    }
}

struct LnIn { f32x4 v[4]; v2u a[4], b[4], hw[4]; };
template <int MODE> __device__ __forceinline__ void ln_load(LnIn& in, const float* src, const bf16* hsb, const bf16* yb, size_t row, int lane) {
#pragma unroll
    for (int j = 0; j < 4; ++j) {
        const int c = lane * 4 + 256 * j;
        if (MODE != 2) in.v[j] = *(const GAS f32x4*)(src + row * D + c);
        if (MODE == 2) { in.hw[j] = *(const GAS v2u*)(hsb + row * D + c); in.a[j] = *(const GAS v2u*)(yb + (row * 2) * D + c); in.b[j] = *(const GAS v2u*)(yb + (row * 2 + 1) * D + c); }
    }
}
template <int MODE> __device__ __forceinline__ void ln_finish(const LnIn& in, float* hout, bf16* hb, const float* g, const float* bta, size_t row, int lane, f32x4 (&o)[4]) {
    f32x4 v[4];
#pragma unroll
    for (int j = 0; j < 4; ++j) {
        if (MODE != 2) v[j] = in.v[j];
        if (MODE == 2) {
            const v2u a = in.a[j], b = in.b[j], hw = in.hw[j];
            v[j].x = ALPHA * __uint_as_float(hw.x << 16) + __uint_as_float(a.x << 16) + __uint_as_float(b.x << 16);
            v[j].y = ALPHA * __uint_as_float(hw.x & 0xffff0000u) + __uint_as_float(a.x & 0xffff0000u) + __uint_as_float(b.x & 0xffff0000u);
            v[j].z = ALPHA * __uint_as_float(hw.y << 16) + __uint_as_float(a.y << 16) + __uint_as_float(b.y << 16);
            v[j].w = ALPHA * __uint_as_float(hw.y & 0xffff0000u) + __uint_as_float(a.y & 0xffff0000u) + __uint_as_float(b.y & 0xffff0000u);
        }
    }
    float s = 0.f;
#pragma unroll
    for (int j = 0; j < 4; ++j) s += (v[j].x + v[j].y) + (v[j].z + v[j].w);
    const float mean = wave_sum_l(s, lane) * (1.f / D);
    float q = 0.f;
#pragma unroll
    for (int j = 0; j < 4; ++j) { v[j] = v[j] - mean; q += (v[j].x * v[j].x + v[j].y * v[j].y) + (v[j].z * v[j].z + v[j].w * v[j].w); }
    const float rstd = 1.0f / sqrtf(wave_sum_l(q, lane) * (1.f / D) + LN_EPS);
#pragma unroll
    for (int j = 0; j < 4; ++j) {
        const int c = lane * 4 + 256 * j;
        const f32x4 gg = *(const GAS f32x4*)(g + c), bb = *(const GAS f32x4*)(bta + c);
        o[j] = v[j] * rstd * gg + bb;
        if (hout) *(GAS f32x4*)(hout + row * D + c) = o[j];
        if (hb) { v2u w; w.x = pk2(o[j].x, o[j].y); w.y = pk2(o[j].z, o[j].w); *(GAS v2u*)(hb + row * D + c) = w; }
    }
}

#ifndef PROBE_EPI
#define PROBE_EPI 0
#endif
struct EpiP1 {
    static constexpr bool PERM = true;
    bf16* qkv; bf16* gates; const float* b_gate; int probe;
    __device__ __forceinline__ void operator()(const f32x4 (&acc)[2][2][4][2], const pg8::Unit& u, int wr, int wc, int fr, int fq) const {
        if (probe == 1 && PROBE_EPI == 0) return;
        const int row0 = (probe == 1 ? (int)(blockIdx.x & 127) : u.pm) * 256 + wr * 64 + fr; const bool isg = u.pn >= 18;
        bf16* base = isg ? gates : qkv; const int ldc = isg ? GATEW : QKVW; const int col0 = (isg ? (u.pn - 18) : u.pn) * 256 + wc * 32 + 8 * fq;
        f32x4 bv[2][2];
#pragma unroll
        for (int bj = 0; bj < 2; ++bj)
#pragma unroll
            for (int n = 0; n < 2; ++n) bv[bj][n] = isg ? *(const GAS f32x4*)(b_gate + col0 + bj * 128 + 4 * n) : (f32x4){0.f, 0.f, 0.f, 0.f};
#pragma unroll
        for (int ai = 0; ai < 2; ++ai)
#pragma unroll
            for (int m = 0; m < 4; ++m) { bf16* rowp = base + (size_t)(row0 + ai * 128 + m * 16) * ldc + col0;
#pragma unroll
                for (int bj = 0; bj < 2; ++bj) { f32x4 v0 = acc[ai][bj][m][0] + bv[bj][0], v1 = acc[ai][bj][m][1] + bv[bj][1];
                    if (isg && !(probe == 1 && PROBE_EPI == 2)) {
#pragma unroll
                        for (int j = 0; j < 4; ++j) { v0[j] = __builtin_amdgcn_rcpf(1.0f + __builtin_amdgcn_exp2f(-LOG2E * v0[j])); v1[j] = __builtin_amdgcn_rcpf(1.0f + __builtin_amdgcn_exp2f(-LOG2E * v1[j])); } }
                    v4u w; w.x = pg8::cvt_pk_bf16(v0[0], v0[1]); w.y = pg8::cvt_pk_bf16(v0[2], v0[3]); w.z = pg8::cvt_pk_bf16(v1[0], v1[1]); w.w = pg8::cvt_pk_bf16(v1[2], v1[3]);
                    *(GAS v4u*)(rowp + bj * 128) = w; } }
    }
};
template <bool FIRST> struct EpiP3 {
    static constexpr bool PERM = true;
    bf16* merged; const bf16* gates; int br;
    __device__ __forceinline__ void operator()(const f32x4 (&acc)[2][2][4][2], const pg8::Unit& u, int wr, int wc, int fr, int fq) const {
        const int row0 = u.pm * 256 + wr * 64 + fr, col0 = u.pn * 256 + wc * 32 + 8 * fq;
#pragma unroll
        for (int ai = 0; ai < 2; ++ai) {
            v4u gw[4][2], ow[4][2];
#pragma unroll
            for (int m = 0; m < 4; ++m)
#pragma unroll
                for (int bj = 0; bj < 2; ++bj) { const size_t row = (size_t)(row0 + ai * 128 + m * 16);
                    gw[m][bj] = *(const GAS v4u*)(gates + row * GATEW + br * 1024 + col0 + bj * 128);
                    ow[m][bj] = FIRST ? (v4u){0u, 0u, 0u, 0u} : *(const GAS v4u*)(merged + row * D + col0 + bj * 128); }
#pragma unroll
            for (int m = 0; m < 4; ++m)
#pragma unroll
                for (int bj = 0; bj < 2; ++bj) { const size_t row = (size_t)(row0 + ai * 128 + m * 16);
                    const f32x4 a0 = acc[ai][bj][m][0], a1 = acc[ai][bj][m][1];
                    float r[8];
#pragma unroll
                    for (int j = 0; j < 4; ++j) { const unsigned g2 = gw[m][bj][j], o2 = ow[m][bj][j]; const float av0 = j < 2 ? a0[2 * j] : a1[2 * j - 4], av1 = j < 2 ? a0[2 * j + 1] : a1[2 * j - 3];
                        r[2 * j] = __uint_as_float(g2 << 16) * av0 + (FIRST ? 0.f : __uint_as_float(o2 << 16)); r[2 * j + 1] = __uint_as_float(g2 & 0xffff0000u) * av1 + (FIRST ? 0.f : __uint_as_float(o2 & 0xffff0000u)); }
                    v4u w; w.x = pg8::cvt_pk_bf16(r[0], r[1]); w.y = pg8::cvt_pk_bf16(r[2], r[3]); w.z = pg8::cvt_pk_bf16(r[4], r[5]); w.w = pg8::cvt_pk_bf16(r[6], r[7]);
                    *(GAS v4u*)(merged + row * D + col0 + bj * 128) = w; }
            asm volatile("" ::: "memory"); }
    }
};
struct EpiP3V {
    static constexpr bool PERM = true;
    bf16* merged; const bf16* gates;
    __device__ __forceinline__ void operator()(const f32x4 (&acc)[2][2][4][2], const pg8::Unit& u, int wr, int wc, int fr, int fq) const {
        const int row0 = u.pm * 256 + wr * 64 + fr, col0 = u.pn * 256 + wc * 32 + 8 * fq; const int br = u.e; const bool first = (br == 0);
#pragma unroll
        for (int ai = 0; ai < 2; ++ai)
#pragma unroll
        for (int mp = 0; mp < 2; ++mp) {
            v4u gw[2][2], ow[2][2];
#pragma unroll
            for (int mm = 0; mm < 2; ++mm)
#pragma unroll
                for (int bj = 0; bj < 2; ++bj) { const size_t row = (size_t)(row0 + ai * 128 + (2 * mp + mm) * 16);
                    gw[mm][bj] = *(const GAS v4u*)(gates + row * GATEW + br * 1024 + col0 + bj * 128);
                    ow[mm][bj] = (v4u){0u, 0u, 0u, 0u}; if (!first) ow[mm][bj] = *(const GAS v4u*)(merged + row * D + col0 + bj * 128); }
#pragma unroll
            for (int mm = 0; mm < 2; ++mm)
#pragma unroll
                for (int bj = 0; bj < 2; ++bj) { const int m = 2 * mp + mm; const size_t row = (size_t)(row0 + ai * 128 + m * 16);
                    const f32x4 a0 = acc[ai][bj][m][0], a1 = acc[ai][bj][m][1];
                    float r[8];
#pragma unroll
                    for (int j = 0; j < 4; ++j) { const unsigned g2 = gw[mm][bj][j], o2 = ow[mm][bj][j]; const float av0 = j < 2 ? a0[2 * j] : a1[2 * j - 4], av1 = j < 2 ? a0[2 * j + 1] : a1[2 * j - 3];
                        r[2 * j] = __uint_as_float(g2 << 16) * av0 + __uint_as_float(o2 << 16); r[2 * j + 1] = __uint_as_float(g2 & 0xffff0000u) * av1 + __uint_as_float(o2 & 0xffff0000u); }
                    v4u w; w.x = pg8::cvt_pk_bf16(r[0], r[1]); w.y = pg8::cvt_pk_bf16(r[2], r[3]); w.z = pg8::cvt_pk_bf16(r[4], r[5]); w.w = pg8::cvt_pk_bf16(r[6], r[7]);
                    *(GAS v4u*)(merged + row * D + col0 + bj * 128) = w; }
            asm volatile("" ::: "memory"); }
    }
};
struct P3Order {
    pg8::DenseOrder Dn; const char* Abase; const char* wsb; size_t lofs;
    __device__ __forceinline__ bool next(int i, pg8::Unit& u) const { if (!Dn.next(i / 3, u)) return false; u.e = i % 3; u.ui = i; return true; }
    __device__ __forceinline__ const char* a_base(const pg8::Unit& u) const { const size_t ko = (size_t)((u.e + 1) >> 1) * 1024 + (size_t)(u.e >> 1) * 512; return Abase + ko + (size_t)u.pm * Dn.tstepA; }
    __device__ __forceinline__ int K_of(const pg8::Unit& u) const { return 512 - 256 * (u.e & 1); }
    __device__ __forceinline__ int ldb_of(const pg8::Unit& u) const { return 512 - 256 * (u.e & 1); }
    __device__ __forceinline__ const char* b_base(const pg8::Unit& u) const {
        const size_t kb = (size_t)(512 - 256 * (u.e & 1)) * 2;
        const size_t base = WS_WBRA + (size_t)((u.e + 1) >> 1) * (WS_WBRB - WS_WBRA) + (size_t)(u.e >> 1) * (WS_WBRC - WS_WBRB);
        return wsb + base + lofs * (size_t)D * kb + (size_t)u.pn * 256 * kb; }
    __device__ __forceinline__ int a_row(const pg8::Unit&, int) const { return 0; }
};
struct EpiP4 {
    static constexpr bool PERM = false;
    const bf16* hbc; float* ho;
    __device__ __forceinline__ void operator()(const f32x4 (&acc)[2][2][4][2], const pg8::Unit& u, int wr, int wc, int fr, int fq) const {
        const int row0 = u.pm * 256 + wr * 64 + fr, col0 = u.pn * 256 + wc * 32 + 4 * fq;
#pragma unroll
        for (int ai = 0; ai < 2; ++ai) { v2u hv[4][2][2];
#pragma unroll
            for (int m = 0; m < 4; ++m)
#pragma unroll
                for (int bj = 0; bj < 2; ++bj)
#pragma unroll
                    for (int n = 0; n < 2; ++n) hv[m][bj][n] = *(const GAS v2u*)(hbc + (size_t)(row0 + ai * 128 + m * 16) * D + col0 + bj * 128 + n * 16);
#pragma unroll
            for (int m = 0; m < 4; ++m)
#pragma unroll
                for (int bj = 0; bj < 2; ++bj)
#pragma unroll
                    for (int n = 0; n < 2; ++n) { const v2u w = hv[m][bj][n]; const f32x4 hf = (f32x4){__uint_as_float(w.x << 16), __uint_as_float(w.x & 0xffff0000u), __uint_as_float(w.y << 16), __uint_as_float(w.y & 0xffff0000u)};
                        *(GAS f32x4*)(ho + (size_t)(row0 + ai * 128 + m * 16) * D + col0 + bj * 128 + n * 16) = hf * ALPHA + acc[ai][bj][m][n]; }
            asm volatile("" ::: "memory"); }
    }
};
struct EpiP7 {
    static constexpr bool PERM = true;
    bf16* hid;
    __device__ __forceinline__ void operator()(const f32x4 (&acc)[2][2][4][2], const pg8::Unit& u, int wr, int wc, int fr, int fq) const {
        const int row0 = u.pm * 256 + wr * 64 + fr, col0 = u.pn * 128 + wc * 32 + 8 * fq;
#pragma unroll
        for (int ai = 0; ai < 2; ++ai)
#pragma unroll
            for (int m = 0; m < 4; ++m) { float r[8];
#pragma unroll
                for (int n = 0; n < 2; ++n)
#pragma unroll
                    for (int j = 0; j < 4; ++j) { const float gv = acc[ai][0][m][n][j], uv = acc[ai][1][m][n][j]; r[4 * n + j] = gv * __builtin_amdgcn_rcpf(1.0f + __builtin_amdgcn_exp2f(-LOG2E * gv)) * uv; }
                v4u w; w.x = pg8::cvt_pk_bf16(r[0], r[1]); w.y = pg8::cvt_pk_bf16(r[2], r[3]); w.z = pg8::cvt_pk_bf16(r[4], r[5]); w.w = pg8::cvt_pk_bf16(r[6], r[7]);
                *(GAS v4u*)(hid + (size_t)(row0 + ai * 128 + m * 16) * DE + col0) = w; }
    }
};
struct EpiP8 {
    static constexpr bool PERM = true;
    bf16* yb; const int* rowtok; const float* rowgate;
    __device__ __forceinline__ void operator()(const f32x4 (&acc)[2][2][4][2], const pg8::Unit& u, int wr, int wc, int fr, int fq) const {
        const int row0 = u.pm * 256 + wr * 64 + fr, col0 = u.pn * 256 + wc * 32 + 8 * fq;
        int rt[2][4]; float gt[2][4];
#pragma unroll
        for (int ai = 0; ai < 2; ++ai)
#pragma unroll
            for (int m = 0; m < 4; ++m) { const int row = row0 + ai * 128 + m * 16; rt[ai][m] = *(const GAS int*)(rowtok + row); gt[ai][m] = *(const GAS float*)(rowgate + row); }
#pragma unroll
        for (int ai = 0; ai < 2; ++ai)
#pragma unroll
            for (int m = 0; m < 4; ++m) {
                if (rt[ai][m] >= 0) {
#pragma unroll
                    for (int bj = 0; bj < 2; ++bj) { const f32x4 v0 = acc[ai][bj][m][0] * gt[ai][m], v1 = acc[ai][bj][m][1] * gt[ai][m];
                        v4u w; w.x = pg8::cvt_pk_bf16(v0[0], v0[1]); w.y = pg8::cvt_pk_bf16(v0[2], v0[3]); w.z = pg8::cvt_pk_bf16(v1[0], v1[1]); w.w = pg8::cvt_pk_bf16(v1[2], v1[3]);
                        *(GAS v4u*)(yb + (size_t)rt[ai][m] * D + col0 + bj * 128) = w; } } }
    }
};

typedef float f32x2 __attribute__((ext_vector_type(2)));
template <int N> __device__ __forceinline__ void wave_sum_n(float (&v)[N]) {
#pragma unroll
    for (int s = 0; s < 4; ++s)
#pragma unroll
        for (int n = 0; n < N; ++n) v[n] = dpp_add(v[n], s);
#pragma unroll
    for (int n = 0; n < N; ++n) { const int x = __builtin_bit_cast(int, v[n]);
        const float r0 = __builtin_bit_cast(float, __builtin_amdgcn_readlane(x, 0)), r1 = __builtin_bit_cast(float, __builtin_amdgcn_readlane(x, 16)),
                    r2 = __builtin_bit_cast(float, __builtin_amdgcn_readlane(x, 32)), r3 = __builtin_bit_cast(float, __builtin_amdgcn_readlane(x, 48));
        v[n] = (r0 + r1) + (r2 + r3); }
}
__device__ __forceinline__ void router_row(const float (&x)[16], int t, int lane, const f32x4 (&wg)[16], const float* b_rg, const LAS float* w_re, const float* b_re, LAS int* lcnt, int wslot, Rec* rec) {
    f32x2 g01 = (f32x2){0.f, 0.f}, g23 = (f32x2){0.f, 0.f};
#pragma unroll
    for (int k = 0; k < 16; ++k) { const f32x4 w = wg[k]; const f32x2 xv = (f32x2){x[k], x[k]}; g01 = xv * (f32x2){w.x, w.y} + g01; g23 = xv * (f32x2){w.z, w.w} + g23; }
    float gl[4] = {g01.x, g01.y, g23.x, g23.y};
    wave_sum_n<4>(gl);
#pragma unroll
    for (int g = 0; g < 4; ++g) gl[g] += b_rg[g];
    int gi = 0; float gm = gl[0];
#pragma unroll
    for (int g = 1; g < 4; ++g) if (gl[g] > gm) { gm = gl[g]; gi = g; }
    float gs = 0.f;
#pragma unroll
    for (int g = 0; g < 4; ++g) gs += __expf(gl[g] - gm);
    const float gw = 1.0f / gs;
    f32x2 e01 = (f32x2){0.f, 0.f}, e23 = e01, e45 = e01, e67 = e01;
    const LAS float* wre = w_re + gi * (D * 8);
#pragma unroll
    for (int j = 0; j < 4; ++j)
#pragma unroll
        for (int i = 0; i < 4; ++i) { const LAS float* wp = wre + ((j * 4 + i) * 128 + lane) * 4; const f32x4 w0 = *(const LAS f32x4*)wp, w1 = *(const LAS f32x4*)(wp + 256); const f32x2 xv = (f32x2){x[4 * j + i], x[4 * j + i]};
            e01 = xv * (f32x2){w0.x, w0.y} + e01; e23 = xv * (f32x2){w0.z, w0.w} + e23; e45 = xv * (f32x2){w1.x, w1.y} + e45; e67 = xv * (f32x2){w1.z, w1.w} + e67; }
    float el[8] = {e01.x, e01.y, e23.x, e23.y, e45.x, e45.y, e67.x, e67.y};
    wave_sum_n<8>(el);
#pragma unroll
    for (int e = 0; e < 8; ++e) el[e] += b_re[gi * 8 + e];
    int i0 = 0; float t0 = el[0];
#pragma unroll
    for (int e = 1; e < 8; ++e) if (el[e] > t0) { t0 = el[e]; i0 = e; }
    int i1 = -1; float t1 = -3.0e38f;
#pragma unroll
    for (int e = 0; e < 8; ++e) if (e != i0 && el[e] > t1) { t1 = el[e]; i1 = e; }
    const float ex = __expf(t1 - t0), p0 = 1.0f / (1.0f + ex), p1 = ex / (1.0f + ex);
    if (lane == 0) {
        const int e0 = gi * 8 + i0, e1 = gi * 8 + i1;
        const int s0 = __hip_atomic_fetch_add(lcnt + e0, 1, __ATOMIC_RELAXED, __HIP_MEMORY_SCOPE_WORKGROUP), s1 = __hip_atomic_fetch_add(lcnt + e1, 1, __ATOMIC_RELAXED, __HIP_MEMORY_SCOPE_WORKGROUP);
        GAS v4u* rp = (GAS v4u*)(rec + t);
        rp[0] = (v4u){(unsigned)e0, (unsigned)s0, (unsigned)e1, (unsigned)s1};
        rp[1] = (v4u){__float_as_uint(gw * p0), __float_as_uint(gw * p1), (unsigned)wslot, 0u};
    }
}

#ifndef STAG_P1
#define STAG_P1 500
#endif
__device__ __forceinline__ void stagger(int vcu, unsigned q) {
    const unsigned long long t0 = __builtin_amdgcn_s_memrealtime(); const unsigned long long d = (unsigned long long)((vcu & 3) * q);
    while (__builtin_amdgcn_s_memrealtime() - t0 < d) __builtin_amdgcn_s_sleep(8);
}
__device__ __forceinline__ void ph_ln0(Frame& F) { LAUNDER(F);
    const int gw = F.vcu * NWAVES + F.wave, NGW = F.G * NWAVES;
    bf16* hb = (bf16*)(F.ws + WS_HB);
    LnIn cur, nxt, nx2; if (gw < T) ln_load<0>(cur, F.in[0], nullptr, nullptr, (size_t)gw, F.lane);
    if (gw + NGW < T) ln_load<0>(nxt, F.in[0], nullptr, nullptr, (size_t)(gw + NGW), F.lane);
    for (int m = gw; m < T; m += NGW) { const bool more = m + NGW < T, more2 = m + 2 * NGW < T; if (more2) ln_load<0>(nx2, F.in[0], nullptr, nullptr, (size_t)(m + 2 * NGW), F.lane);
        f32x4 o[4]; ln_finish<0>(cur, nullptr, hb, F.in[1], F.in[2], (size_t)m, F.lane, o); if (more) { cur = nxt; nxt = nx2; } }
}
__device__ __forceinline__ void ph_p1(Frame& F, int l, int c) { LAUNDER(F); asm volatile("" : "+s"(l), "+s"(c));
    pg8::DenseOrder S; S.init((const bf16*)(F.ws + WS_HB) + (size_t)c * CH * D, D, (const bf16*)(F.ws + WS_WIN) + (size_t)l * NCOL * D, D, CH, NCOL, F.G, (int)blockIdx.x);
    EpiP1 E{(bf16*)(F.ws + WS_QKV), (bf16*)(F.ws + WS_GATES), F.in[5] + (size_t)l * GATEW, F.probe};
    pg8::gemm_phase<EpiP1, pg8::DenseOrder, false>(F.lds + RING_OFF, S, E, D, D, D, F.tid);
}
__device__ __forceinline__ void ph_cmb(Frame& F) { LAUNDER(F);
    const bf16* og = (const bf16*)(F.ws + WS_OG); const float* lse = (const float*)(F.ws + WS_LSE); bf16* oabc = (bf16*)(F.ws + WS_OABC);
    for (int idx = F.vcu * NTHREADS + F.tid; idx < CH * 32; idx += F.G * NTHREADS) {
        const int tl = idx >> 5, hc = idx & 31, h = hc >> 3, c = hc & 7;
        const GAS float* lg = (const GAS float*)lse + (size_t)tl * 12 + h; const float l0 = lg[0], l1 = lg[4], l2 = lg[8];
        const float mx = fmaxf(l0, fmaxf(l1, l2)); float w0 = __expf(l0 - mx), w1 = __expf(l1 - mx), w2 = __expf(l2 - mx); const float inv = 1.0f / (w0 + w1 + w2); w0 *= inv; w1 *= inv; w2 *= inv;
        const v4u a = *(const GAS v4u*)(og + ((size_t)tl * 3 + 0) * 256 + h * 64 + c * 8), b = *(const GAS v4u*)(og + ((size_t)tl * 3 + 1) * 256 + h * 64 + c * 8), d = *(const GAS v4u*)(og + ((size_t)tl * 3 + 2) * 256 + h * 64 + c * 8);
        v4u ow;
#pragma unroll
        for (int i = 0; i < 4; ++i) {
            const float lo = w0 * __uint_as_float(a[i] << 16) + w1 * __uint_as_float(b[i] << 16) + w2 * __uint_as_float(d[i] << 16);
            const float hi = w0 * __uint_as_float(a[i] & 0xffff0000u) + w1 * __uint_as_float(b[i] & 0xffff0000u) + w2 * __uint_as_float(d[i] & 0xffff0000u);
            ow[i] = pk2(lo, hi);
        }
        *(GAS v4u*)(oabc + (size_t)tl * OW + 512 + h * 64 + c * 8) = ow;
    }
}
__device__ __forceinline__ void ph_p3(Frame& F, int l) { LAUNDER(F); asm volatile("" : "+s"(l));
    const bf16* oabc = (const bf16*)(F.ws + WS_OABC); bf16* merged = (bf16*)(F.ws + WS_MERGED); const bf16* gates = (const bf16*)(F.ws + WS_GATES);
    P3Order S; S.Dn.init(oabc, OW, nullptr, 0, CH, D, F.G, (int)blockIdx.x);
    S.Abase = (const char*)oabc; S.wsb = (const char*)F.ws; S.lofs = (size_t)l;
    EpiP3V E{merged, gates};
    pg8::gemm_phase_vk<EpiP3V, P3Order>(F.lds + RING_OFF, S, E, OW, F.tid);
}
__device__ __forceinline__ void ph_p4(Frame& F, int l, int c) { LAUNDER(F); asm volatile("" : "+s"(l), "+s"(c));
    pg8::DenseOrder S; S.init((const bf16*)(F.ws + WS_MERGED), D, (const bf16*)(F.ws + WS_WOUT) + (size_t)l * D * D, D, CH, D, F.G, (int)blockIdx.x);
    EpiP4 E{(const bf16*)(F.ws + WS_HB) + (size_t)c * CH * D, F.probe ? (float*)(F.ws + WS_OABC) : F.h + (size_t)c * CH * D};
    pg8::gemm_phase<EpiP4, pg8::DenseOrder, false>(F.lds + RING_OFF, S, E, D, D, D, F.tid);
}
__device__ __forceinline__ void ph_ln1(Frame& F, int l, int c) { LAUNDER(F); asm volatile("" : "+s"(l), "+s"(c));
    const int gw = F.vcu * NWAVES + F.wave, NGW = F.G * NWAVES;
    bf16* hb = (bf16*)(F.ws + WS_HB); Rec* rec = (Rec*)(F.ws + WS_REC);
    int* wgc = (int*)(F.ws + WS_WGCNT) + ((size_t)(l * NCHUNK + c) * F.G + F.vcu) * 32;
    if (F.probe) { hb = (bf16*)(F.ws + WS_QKV) - (size_t)c * CH * D; wgc = (int*)(F.ws + WS_WGCNT) + (size_t)DEPTH * NCHUNK * 256 * 32 + F.vcu * 32; rec = (Rec*)(F.ws + WS_GATES); }
    LAS float* lrg = (LAS float*)(F.lds + RING_OFF); LAS float* lre = lrg + D * 4; LAS int* lcnt = (LAS int*)(F.lds + LCNT_OFF);
    { const float* w_rg = F.in[14] + (size_t)l * D * 4; const float* w_re = F.in[16] + (size_t)l * 4 * D * 8;
      if (F.tid < 32) lcnt[F.tid] = 0;
      for (int u = F.tid; u < D + 4 * D * 2; u += NTHREADS) {
          if (u < D) { const int e = u, ln = (e & 255) >> 2, i = e & 3, j = e >> 8; *(LAS f32x4*)(lrg + ((j * 4 + i) * 64 + ln) * 4) = *(const GAS f32x4*)(w_rg + (size_t)e * 4); }
          else { const int v = u - D, half = v & 1, e = (v >> 1) & 1023, g = v >> 11, ln = (e & 255) >> 2, i = e & 3, j = e >> 8;
                 *(LAS f32x4*)(lre + g * (D * 8) + (((j * 4 + i) * 2 + half) * 64 + ln) * 4) = *(const GAS f32x4*)(w_re + ((size_t)g * D + e) * 8 + half * 4); } }
      __syncthreads(); }
    f32x4 wg[16];
#pragma unroll
    for (int j = 0; j < 4; ++j)
#pragma unroll
        for (int i = 0; i < 4; ++i) wg[4 * j + i] = *(const LAS f32x4*)(lrg + ((j * 4 + i) * 64 + F.lane) * 4);
    const size_t rbase = (size_t)c * CH;
    LnIn cur, nxt, nx2; if (gw < CH) ln_load<1>(cur, F.h, nullptr, nullptr, rbase + gw, F.lane);
    if (gw + NGW < CH) ln_load<1>(nxt, F.h, nullptr, nullptr, rbase + gw + NGW, F.lane);
    for (int m = gw; m < CH; m += NGW) {
        const bool more = m + NGW < CH, more2 = m + 2 * NGW < CH; if (more2) ln_load<1>(nx2, F.h, nullptr, nullptr, rbase + m + 2 * NGW, F.lane);
        const size_t row = rbase + m; f32x4 o[4];
        ln_finish<1>(cur, nullptr, hb, F.in[12] + l * D, F.in[13] + l * D, row, F.lane, o);
        float x[16];
#pragma unroll
        for (int j = 0; j < 4; ++j) { x[4 * j] = o[j].x; x[4 * j + 1] = o[j].y; x[4 * j + 2] = o[j].z; x[4 * j + 3] = o[j].w; }
        router_row(x, (int)row, F.lane, wg, F.in[15] + l * 4, lre, F.in[17] + l * 32, lcnt, c * F.G + F.vcu, rec);
        if (more) { cur = nxt; nxt = nx2; }
    }
    __syncthreads();
    if (F.tid < 32) *(GAS int*)(wgc + F.tid) = lcnt[F.tid];
}
__device__ __forceinline__ void ph_dsp(Frame& F, int l) { LAUNDER(F); asm volatile("" : "+s"(l));
    LAS int* Tb = (LAS int*)(F.lds + RING_OFF); LAS int* part = Tb + 512 * 32; LAS int* po = part + 32 * 16;
    const int* wg = (const int*)(F.ws + WS_WGCNT) + (size_t)l * NCHUNK * F.G * 32; const int W = NCHUNK * F.G;
    int* cnt = (int*)(F.ws + WS_CTL) + CW_CNT + l * (32 * CSTR); const Rec* rec = (const Rec*)(F.ws + WS_REC); int* rowtok = (int*)(F.ws + WS_ROWTOK); float* rowgate = (float*)(F.ws + WS_ROWGATE);
    for (int i = F.tid; i < W * 32; i += NTHREADS) Tb[i] = *(const GAS int*)(wg + i);
    __syncthreads();
    const int e = F.tid >> 4, k = F.tid & 15, per = (W + 15) / 16, w0 = k * per, w1 = (w0 + per) < W ? (w0 + per) : W;
    { int s = 0; for (int w = w0; w < w1; ++w) s += Tb[w * 32 + e]; part[e * 16 + k] = s; }
    __syncthreads();
    { int base = 0; for (int kk = 0; kk < k; ++kk) base += part[e * 16 + kk];
      for (int w = w0; w < w1; ++w) { const int t = Tb[w * 32 + e]; Tb[w * 32 + e] = base; base += t; } }
    __syncthreads();
    if (F.tid == 0) { int acc = 0; for (int ee = 0; ee < NE; ++ee) { int tot = 0; for (int kk = 0; kk < 16; ++kk) tot += part[ee * 16 + kk]; po[ee] = acc; part[ee * 16] = tot; acc += (tot + 255) / 256 * 256; } po[NE] = acc; }
    __syncthreads();
    if (F.vcu == 0 && F.tid < 32) cnt[F.tid * CSTR] = part[F.tid * 16];
    const int gt = F.vcu * NTHREADS + F.tid, GT = F.G * NTHREADS;
    for (int t = gt; t < T; t += GT) {
        const GAS v4u* rp = (const GAS v4u*)(rec + t); const v4u ra = rp[0], rb = rp[1];
        Rec rc; rc.e0 = (int)ra.x; rc.s0 = (int)ra.y; rc.e1 = (int)ra.z; rc.s1 = (int)ra.w; rc.g0 = __uint_as_float(rb.x); rc.g1 = __uint_as_float(rb.y); rc.pad0 = (int)rb.z; rc.pad1 = 0;
        const int d0 = po[rc.e0] + Tb[rc.pad0 * 32 + rc.e0] + rc.s0, d1 = po[rc.e1] + Tb[rc.pad0 * 32 + rc.e1] + rc.s1;
        *(GAS int*)(rowtok + d0) = 2 * t; *(GAS float*)(rowgate + d0) = rc.g0; *(GAS int*)(rowtok + d1) = 2 * t + 1; *(GAS float*)(rowgate + d1) = rc.g1;
    }
    for (int ee = 0; ee < NE; ++ee) for (int r = po[ee] + part[ee * 16] + gt; r < po[ee + 1]; r += GT) { *(GAS int*)(rowtok + r) = -1; *(GAS float*)(rowgate + r) = 0.f; }
    __syncthreads();
}
__device__ __forceinline__ int moe_setup(Frame& F, int l, bool gather) { LAUNDER(F); asm volatile("" : "+s"(l));
    LAS int* rows = (LAS int*)(F.lds + ROWS_OFF); LAS int* ulist = rows + 11 * 256; LAS int* po = ulist + 16;
    const int* cnt = (const int*)(F.ws + WS_CTL) + CW_CNT + l * (32 * CSTR); const int* rowtok = (const int*)(F.ws + WS_ROWTOK);
    if (F.tid == 0) { int acc = 0; for (int e = 0; e < NE; ++e) { po[e] = acc; acc += (cnt[e * CSTR] + 255) / 256 * 256; } po[NE] = acc; }
    __syncthreads();
    const int nu_all = (po[NE] / 256) * 4; int nun = (nu_all - F.vcu + F.G - 1) / F.G; nun = nun < 0 ? 0 : (nun > 11 ? 11 : nun);
    if (F.tid < nun) { const int Lx = F.tid * F.G + F.vcu, rt = Lx >> 2, pn = Lx & 3; int e = 0; while (e < NE - 1 && po[e + 1] <= rt * 256) ++e; ulist[F.tid] = (rt << 8) | (e << 2) | pn; }
    if (gather) for (int idx = F.tid; idx < nun * 256; idx += NTHREADS) { const int i = idx >> 8, r = idx & 255, Lx = i * F.G + F.vcu; rows[idx] = *(const GAS int*)(rowtok + (Lx >> 2) * 256 + r); }
    __syncthreads();
    return nun;
}
struct MoeOrder {
    int nun; const LAS int* ulist; const LAS int* rows; const char* A; const char* B; size_t tstepA, estepB, tstepB;
    __device__ __forceinline__ bool next(int i, pg8::Unit& u) const {
        if (i >= nun) return false;
        const int w = __builtin_amdgcn_readfirstlane(ulist[i]); u.pm = w >> 8; u.e = (w >> 2) & 63; u.pn = w & 3; u.ui = i; return true;
    }
    __device__ __forceinline__ const char* a_base(const pg8::Unit& u) const { return A + (size_t)u.pm * tstepA; }
    __device__ __forceinline__ const char* b_base(const pg8::Unit& u) const { return B + (size_t)u.e * estepB + (size_t)u.pn * tstepB; }
    __device__ __forceinline__ int a_row(const pg8::Unit& u, int r) const { const int t = rows[u.ui * 256 + r]; return t < 0 ? 0 : (t >> 1); }
};
__device__ __forceinline__ void ph_p7(Frame& F, int l) { LAUNDER(F); asm volatile("" : "+s"(l));
    const int nun = moe_setup(F, l, true);
    LAS int* rows = (LAS int*)(F.lds + ROWS_OFF);
    MoeOrder S{nun, rows + 11 * 256, rows, (const char*)(F.ws + WS_HB), (const char*)(F.ws + WS_WGU) + (size_t)l * NE * 1024 * 1024 * 2, 0, (size_t)1024 * 1024 * 2, (size_t)256 * 1024 * 2};
    EpiP7 E{(bf16*)(F.ws + WS_HID)};
    pg8::gemm_phase<EpiP7, MoeOrder, true>(F.lds + RING_OFF, S, E, D, D, D, F.tid);
}
__device__ __forceinline__ void ph_p8(Frame& F, int l) { LAUNDER(F); asm volatile("" : "+s"(l));
    const int nun = moe_setup(F, l, false);
    LAS int* rows = (LAS int*)(F.lds + ROWS_OFF);
    MoeOrder S{nun, rows + 11 * 256, rows, (const char*)(F.ws + WS_HID), (const char*)(F.ws + WS_WD) + (size_t)l * NE * 1024 * 512 * 2, (size_t)256 * DE * 2, (size_t)1024 * 512 * 2, (size_t)256 * 512 * 2};
    EpiP8 E{(bf16*)(F.ws + WS_YB), (const int*)(F.ws + WS_ROWTOK), (const float*)(F.ws + WS_ROWGATE)};
    pg8::gemm_phase<EpiP8, MoeOrder, false>(F.lds + RING_OFF, S, E, DE, DE, DE, F.tid);
}
__device__ __forceinline__ void ph_ln2(Frame& F, int l) { LAUNDER(F); asm volatile("" : "+s"(l));
    const int gw = F.vcu * NWAVES + F.wave, NGW = F.G * NWAVES;
    const bool lastl = (l == DEPTH - 1);
    const bf16* hsb = (const bf16*)(F.ws + WS_HB); const bf16* yb = (const bf16*)(F.ws + WS_YB);
    bf16* hb = lastl ? nullptr : (bf16*)(F.ws + WS_HB); float* hout = lastl ? F.h : nullptr; size_t omask = ~(size_t)0;
    if (F.probe) { hout = lastl ? (float*)(F.ws + WS_OABC) : nullptr; hb = lastl ? nullptr : (bf16*)(F.ws + WS_OABC); omask = 32767; }
    LnIn cur, nxt, nx2; if (gw < T) ln_load<2>(cur, nullptr, hsb, yb, (size_t)gw, F.lane);
    if (gw + NGW < T) ln_load<2>(nxt, nullptr, hsb, yb, (size_t)(gw + NGW), F.lane);
    for (int m = gw; m < T; m += NGW) { const bool more = m + NGW < T, more2 = m + 2 * NGW < T; if (more2) ln_load<2>(nx2, nullptr, hsb, yb, (size_t)(m + 2 * NGW), F.lane);
        const size_t back = ((size_t)m - ((size_t)m & omask)) * D;
        f32x4 o[4]; ln_finish<2>(cur, hout ? hout - back : nullptr, hb ? hb - back : nullptr, F.in[21] + l * D, F.in[22] + l * D, (size_t)m, F.lane, o); if (more) { cur = nxt; nxt = nx2; } }
}

typedef short s16x4 __attribute__((ext_vector_type(4)));
constexpr int NT_A = (CH / 32) * 4, NT_B = (CH / L) * 3 * 128 * 4, NT_C = (CH / 64) * 8, NT_ALL = NT_A + NT_B + NT_C;
constexpr float NEGBIG = -1.0e30f, MINIT = -5.0e29f;
#define RC16(reg) (((reg) & 3) + 8 * ((reg) >> 2))

__device__ __forceinline__ void ph_tables(Frame& F) { LAUNDER(F);
    float* TA = (float*)(F.ws + WS_TABA); float* TB = (float*)(F.ws + WS_TABB); float* TC = (float*)(F.ws + WS_TABC);
    const float* rel_bias = F.in[3]; const float* rpb = F.in[7];
    const int gt = F.vcu * NTHREADS + F.tid, GT = F.G * NTHREADS;
    for (int i = gt; i < 8 * 320; i += GT) { const int h = i / 320, rel = i % 320 - 160; TA[i] = (rel >= -128 && rel <= 128) ? rel_bias[BUCK_A[rel + 128] * 20 + h] * LOG2E : NEGBIG; }
    for (int i = gt; i < 12 * 256; i += GT) { const int gh = i >> 8, g = gh >> 2, rel = (i & 255) - 128; TB[i] = (rel >= -64 && rel <= 64) ? rel_bias[BUCK_B[g][rel + 64] * 20 + 8 + gh] * LOG2E : NEGBIG; }
    for (int i = gt; i < DEPTH * 8 * 1024; i += GT) { const int lh = i >> 10, ri = (i >> 6) & 15, ci = (i & 63) - 16; TC[i] = (ri < 15 && ci >= 0 && ci <= 30) ? rpb[((size_t)lh * 15 + ri) * 31 + ci] * LOG2E : NEGBIG; }
}

#define ATT_INIT(S, TBP, BIDX, XM) do { \
        _Pragma("unroll") for (int r_ = 0; r_ < 16; ++r_) { float v_ = (TBP)[(BIDX) + RC16(r_)]; if (TYPE == 2) v_ = ((unsigned)((XM) + RC16(r_)) < 16u) ? v_ : NEGBIG; S[r_] = v_; } } while (0)
__device__ __forceinline__ float xhalf_max(float t) { float a_ = t, b_ = t; asm volatile("s_nop 1\n\tv_permlane32_swap_b32 %0, %1" : "+v"(a_), "+v"(b_)); return fmaxf(a_, b_); }
__device__ __forceinline__ float xhalf_sum(float t) { float a_ = t, b_ = t; asm volatile("s_nop 1\n\tv_permlane32_swap_b32 %0, %1" : "+v"(a_), "+v"(b_)); return a_ + b_; }
#define ATT_TMAX(S, t) do { t = NEGBIG; _Pragma("unroll") for (int r_ = 0; r_ < 16; ++r_) t = fmaxf(t, S[r_]); } while (0)
#define ATT_RESCALE(need, t, m, l, Oa, Ob) do { const float mn_ = (need) ? (t) : m, corr_ = __builtin_amdgcn_exp2f(m - mn_); m = mn_; l *= corr_; \
        _Pragma("unroll") for (int i_ = 0; i_ < 16; ++i_) { Oa[i_] *= corr_; Ob[i_] *= corr_; } } while (0)
#define ATT_EXP(S, m, rs) do { rs = 0.f; _Pragma("unroll") for (int r_ = 0; r_ < 16; ++r_) { const float p_ = __builtin_amdgcn_exp2f(S[r_] - m); S[r_] = p_; rs += p_; } } while (0)
#define ATT_PACK(Pf, S, s2) do { unsigned pw_[4]; _Pragma("unroll") for (int j_ = 0; j_ < 4; ++j_) pw_[j_] = pg8::cvt_pk_bf16(S[8 * (s2) + 2 * j_], S[8 * (s2) + 2 * j_ + 1]); \
        Pf = __builtin_bit_cast(bf16x8, (v4u){pw_[0], pw_[1], pw_[2], pw_[3]}); } while (0)
#define ATT_STORE(orow, Oa, Ob, l) do { const float inv_ = 1.0f / (l); \
        _Pragma("unroll") for (int g_ = 0; g_ < 4; ++g_) { v2u w0_, w1_; \
            w0_.x = pg8::cvt_pk_bf16(Oa[4 * g_] * inv_, Oa[4 * g_ + 1] * inv_); w0_.y = pg8::cvt_pk_bf16(Oa[4 * g_ + 2] * inv_, Oa[4 * g_ + 3] * inv_); \
            w1_.x = pg8::cvt_pk_bf16(Ob[4 * g_] * inv_, Ob[4 * g_ + 1] * inv_); w1_.y = pg8::cvt_pk_bf16(Ob[4 * g_ + 2] * inv_, Ob[4 * g_ + 3] * inv_); \
            *(GAS v2u*)((orow) + 8 * g_ + 4 * hh) = w0_; *(GAS v2u*)((orow) + 32 + 8 * g_ + 4 * hh) = w1_; } } while (0)

template <int TYPE>
__device__ __forceinline__ void att_task2(LAS unsigned char* wl, const int lane, const bf16* seq  , const float* tab0, const float* tab1,
                                          const int qcol0, const int qcol1, const int kcol, const int vcol, const int TT0, const int TSTEP, const int kstride, const int tlo, const int thi,
                                          const int tq0, const int tq1  , const int toff1  ,
                                          const int gi0, const int gi1, const int gc, const int cbs  ,
                                          const float m_init0, const float m_init1, const float l_init, bf16* orow0, bf16* orow1, float* lse0, float* lse1) {
    const int qi = lane & 31, hh = lane >> 5;
    LAS unsigned char* kt = wl; LAS unsigned char* vt = wl + 4096; LAS float* tb0 = (LAS float*)(wl + 8192); LAS float* tb1 = (TYPE == 0) ? tb0 + 320 : tb0;
    constexpr int TBN = TYPE == 0 ? 320 : (TYPE == 1 ? 256 : 1024);
#pragma unroll
    for (int i = 0; i < TBN / 64; ++i) { tb0[lane + 64 * i] = *(const GAS float*)(tab0 + lane + 64 * i); if (TYPE == 0) tb1[lane + 64 * i] = *(const GAS float*)(tab1 + lane + 64 * i); }
    bf16x8 Qa[4], Qb[4];
#pragma unroll
    for (int s = 0; s < 4; ++s) { Qa[s] = *(const GAS bf16x8*)(seq + (size_t)tq0 * QKVW + qcol0 + 16 * s + 8 * hh); Qb[s] = *(const GAS bf16x8*)(seq + (size_t)tq1 * QKVW + qcol1 + 16 * s + 8 * hh); }
    f32x16 O0a, O0b, O1a, O1b;
#pragma unroll
    for (int i = 0; i < 16; ++i) { O0a[i] = 0.f; O0b[i] = 0.f; O1a[i] = 0.f; O1b[i] = 0.f; }
    float m0 = m_init0, m1 = m_init1, l0 = l_init, l1 = l_init;
    const int lkey = lane >> 3, lch = lane & 7;
    const unsigned goff = (unsigned)(lkey * kstride) * (unsigned)(QKVW * 2) + 16u * (unsigned)lch;
    const size_t istepb = (size_t)8 * kstride * QKVW * 2;
    const char* kbase = (const char*)(seq + kcol); const char* vbase = (const char*)(seq + vcol);
    const unsigned kw0 = lkey * 128 + ((lch ^ (lkey & 7)) << 4), vw0 = lkey * 128 + (((lch >> 2) ^ ((lkey >> 1) & 1)) << 6) + ((lch & 3) << 4);
    const unsigned kr0 = qi * 128 + ((hh ^ (qi & 7)) << 4);
    const int q4 = (lane & 15) >> 2, p4 = lane & 3, g1 = (lane >> 4) & 1, sw = (q4 >> 1) & 1;
    const unsigned vr0 = (4 * hh + q4) * 128 + 32 * g1 + 8 * p4 + (sw << 6), vr1 = (4 * hh + q4) * 128 + 32 * g1 + 8 * p4 + ((sw ^ 1) << 6);
    const int bidx0 = (TYPE == 2) ? (cbs - gc + 31 + 4 * hh) : ((TYPE == 1 ? 64 : 32) - qi + 4 * hh);
    int cs = gc - 8; cs = cs < 0 ? 0 : (cs > 48 ? 48 : cs);
    const int xm = cbs - cs + 4 * hh;
    int rs0 = gi0 - 4; rs0 = rs0 < 0 ? 0 : (rs0 > 120 ? 120 : rs0);
    int rs1 = gi1 - 4; rs1 = rs1 < 0 ? 0 : (rs1 > 120 ? 120 : rs1);
    v4u kreg[4], vreg[4];
    {
        const size_t tb_ = (size_t)(TT0 + tlo * TSTEP) * (QKVW * 2);
#pragma unroll
        for (int i = 0; i < 4; ++i) { kreg[i] = *(const GAS v4u*)(kbase + tb_ + i * istepb + goff); vreg[i] = *(const GAS v4u*)(vbase + tb_ + i * istepb + goff); }
    }
    for (int ti = tlo; ti <= thi; ++ti) {
#pragma unroll
        for (int i = 0; i < 4; ++i) { *(LAS v4u*)(kt + kw0 + 1024 * i) = kreg[i]; *(LAS v4u*)(vt + vw0 + 1024 * i) = vreg[i]; }
        if (ti < thi) {
            const size_t tb_ = (size_t)(TT0 + (ti + 1) * TSTEP) * (QKVW * 2);
#pragma unroll
            for (int i = 0; i < 4; ++i) { kreg[i] = *(const GAS v4u*)(kbase + tb_ + i * istepb + goff); vreg[i] = *(const GAS v4u*)(vbase + tb_ + i * istepb + goff); }
        }
        int bi0, bi1;
        if (TYPE == 2) { const bool rv0 = (ti >= rs0) && (ti < rs0 + 8), rv1 = (ti >= rs1) && (ti < rs1 + 8); bi0 = bidx0 + (rv0 ? (ti - gi0 + 7) : 15) * 64; bi1 = bidx0 + (rv1 ? (ti - gi1 + 7) : 15) * 64; }
        else { bi0 = bidx0 + 32 * ti; bi1 = bidx0 + 32 * (ti - toff1); }
        f32x16 S0, S1;
        ATT_INIT(S0, tb0, bi0, xm); ATT_INIT(S1, tb1, bi1, xm);
#pragma unroll
        for (int s = 0; s < 4; ++s) { const bf16x8 Kf = *(const LAS bf16x8*)(kt + (kr0 ^ (unsigned)(s << 5)));
            S0 = __builtin_amdgcn_mfma_f32_32x32x16_bf16(Kf, Qa[s], S0, 0, 0, 0); S1 = __builtin_amdgcn_mfma_f32_32x32x16_bf16(Kf, Qb[s], S1, 0, 0, 0); }
        float t0, t1; ATT_TMAX(S0, t0); ATT_TMAX(S1, t1);
        t0 = xhalf_max(t0); t1 = xhalf_max(t1);
        const bool need0 = t0 > m0 + 8.0f, need1 = t1 > m1 + 8.0f;
        if (__builtin_amdgcn_ballot_w64(need0 || need1) != 0ull) { ATT_RESCALE(need0, t0, m0, l0, O0a, O0b); ATT_RESCALE(need1, t1, m1, l1, O1a, O1b); }
        float rs0, rs1; ATT_EXP(S0, m0, rs0); ATT_EXP(S1, m1, rs1);
        rs0 = xhalf_sum(rs0); rs1 = xhalf_sum(rs1);
        l0 += rs0; l1 += rs1;
#pragma unroll
        for (int s2 = 0; s2 < 2; ++s2) {
            bf16x8 P0, P1; ATT_PACK(P0, S0, s2); ATT_PACK(P1, S1, s2);
            const s16x4 a00 = __builtin_amdgcn_ds_read_tr16_b64_v4i16((LAS s16x4*)(vt + vr0 + (16 * s2) * 128));
            const s16x4 a01 = __builtin_amdgcn_ds_read_tr16_b64_v4i16((LAS s16x4*)(vt + vr0 + (16 * s2 + 8) * 128));
            const s16x4 a10 = __builtin_amdgcn_ds_read_tr16_b64_v4i16((LAS s16x4*)(vt + vr1 + (16 * s2) * 128));
            const s16x4 a11 = __builtin_amdgcn_ds_read_tr16_b64_v4i16((LAS s16x4*)(vt + vr1 + (16 * s2 + 8) * 128));
            const bf16x8 V0 = (bf16x8){a00[0], a00[1], a00[2], a00[3], a01[0], a01[1], a01[2], a01[3]};
            const bf16x8 V1 = (bf16x8){a10[0], a10[1], a10[2], a10[3], a11[0], a11[1], a11[2], a11[3]};
            O0a = __builtin_amdgcn_mfma_f32_32x32x16_bf16(V0, P0, O0a, 0, 0, 0); O0b = __builtin_amdgcn_mfma_f32_32x32x16_bf16(V1, P0, O0b, 0, 0, 0);
            O1a = __builtin_amdgcn_mfma_f32_32x32x16_bf16(V0, P1, O1a, 0, 0, 0); O1b = __builtin_amdgcn_mfma_f32_32x32x16_bf16(V1, P1, O1b, 0, 0, 0);
        }
    }
    ATT_STORE(orow0, O0a, O0b, l0);
    ATT_STORE(orow1, O1a, O1b, l1);
    if (TYPE == 1 && hh == 0) { *(GAS float*)lse0 = (m0 + __builtin_amdgcn_logf(l0)) * LN2; *(GAS float*)lse1 = (m1 + __builtin_amdgcn_logf(l1)) * LN2; }
}

__device__ __forceinline__ void att_tasks(Frame& F, int l, const int t_lo, const int t_hi) {
    LAS unsigned char* wl = F.lds + RING_OFF + F.wave * 16384;
    const bf16* qkv = (const bf16*)(F.ws + WS_QKV); bf16* oabc = (bf16*)(F.ws + WS_OABC); bf16* og = (bf16*)(F.ws + WS_OG); float* lse = (float*)(F.ws + WS_LSE);
    const float* TA = (const float*)(F.ws + WS_TABA); const float* TB = (const float*)(F.ws + WS_TABB); const float* TC = (const float*)(F.ws + WS_TABC) + (size_t)l * 8 * 1024;
    const float* sink = F.in[6] + l * 8;
    const int gw = F.vcu * NWAVES + F.wave, NGW = F.G * NWAVES;
    for (int task = t_lo + gw; task < t_hi; task += NGW) {
        int lane = F.lane; asm volatile("" : "+v"(lane)); const int qi = lane & 31;
        if (task < NT_A) {
            const int hp = task & 3, qb = (task >> 2) & 255, b = task >> 10, q0 = qb * 32, h0 = hp * 2, h1 = h0 + 1, kvh = hp >> 1;
            int tlo = 0, thi = 8; if (q0 - 128 < 0) tlo = (128 - q0) / 32; if (q0 + 128 + 31 >= L) thi = (L - 1 - (q0 - 128)) / 32;
            const int tq = q0 + qi; bf16* orow = oabc + (size_t)(b * L + tq) * OW;
            att_task2<0>(wl, lane, qkv + (size_t)b * L * QKVW, TA + h0 * 320, TA + h1 * 320, AQ + h0 * 64, AQ + h1 * 64, AK + kvh * 64, AV + kvh * 64, q0 - 128, 32, 1, tlo, thi,
                         tq, tq, 0, 0, 0, 0, 0, sink[h0] * LOG2E, sink[h1] * LOG2E, 1.0f, orow + h0 * 64, orow + h1 * 64, nullptr, nullptr);
        } else if (task < NT_A + NT_B) {
            const int j = task - NT_A, h = j & 3, sbi = (j >> 2) & 127, bg = j >> 9, g = bg % 3, b = bg / 3;
            const int dsh = 2 * g, d = 1 << dsh, nsb = 128 >> dsh, r = sbi / nsb, sb = sbi % nsb, q0 = sb * 64, Ls = L >> dsh;
            int tlo = 0, thi = 5; if (q0 - 64 < 0) tlo = (64 - q0) / 32; if (q0 + 32 + 64 + 31 >= Ls) thi = (Ls - 1 - (q0 - 64)) / 32;
            const int tq0 = (q0 + qi) * d + r, tq1 = (q0 + 32 + qi) * d + r, qc = BQ0 + 768 * g + h * 64;
            att_task2<1>(wl, lane, qkv + (size_t)b * L * QKVW, TB + (g * 4 + h) * 256, nullptr, qc, qc, qc + 256, qc + 512, (q0 - 64) * d + r, 32 * d, d, tlo, thi,
                         tq0, tq1, 1, 0, 0, 0, 0, MINIT, MINIT, 0.0f, og + ((size_t)(b * L + tq0) * 3 + g) * 256 + h * 64, og + ((size_t)(b * L + tq1) * 3 + g) * 256 + h * 64,
                         lse + ((size_t)(b * L + tq0) * 3 + g) * 4 + h, lse + ((size_t)(b * L + tq1) * 3 + g) * 4 + h);
        } else {
            const int j = task - NT_A - NT_B, h = j & 7, cbi = (j >> 3) & 127, b = j >> 10, ip = cbi >> 2, cb = cbi & 3;
            const int gi0 = 4 * ip + (qi >> 4), gi1 = gi0 + 2, gc = 16 * cb + (qi & 15), tq0 = gi0 * 64 + gc, tq1 = gi1 * 64 + gc;
            int cbs = 16 * cb - 8; cbs = cbs < 0 ? 0 : (cbs > 32 ? 32 : cbs);
            int rlo = 4 * ip - 4; rlo = rlo < 0 ? 0 : (rlo > 120 ? 120 : rlo);
            int rhi = 4 * ip + 3 - 4; rhi = rhi < 0 ? 0 : (rhi > 120 ? 120 : rhi); rhi += 7;
            bf16* ob = oabc + (size_t)(b * L) * OW + 768 + h * 64;
            att_task2<2>(wl, lane, qkv + (size_t)b * L * QKVW, TC + h * 1024, nullptr, CQ + h * 64, CQ + h * 64, CK + h * 64, CV + h * 64, cbs, 64, 1, rlo, rhi,
                         tq0, tq1, 0, gi0, gi1, gc, cbs, MINIT, MINIT, 0.0f, ob + (size_t)tq0 * OW, ob + (size_t)tq1 * OW, nullptr, nullptr);
        }
    }
}
template <class Bar> __device__ __forceinline__ void ph_att(Frame& F, int l, const Bar& bar, const bool fused) { LAUNDER(F); asm volatile("" : "+s"(l));
    att_tasks(F, l, NT_A, NT_A + NT_B);
    if (fused) { xcd_barrier(bar); ph_cmb(F); }
    att_tasks(F, l, 0, NT_A);
    att_tasks(F, l, NT_A + NT_B, NT_ALL);
}

constexpr int NSTEPS = 1 + DEPTH * 16;
__global__ void __launch_bounds__(NTHREADS, 2) mk_fwd(Args args) {
    extern __shared__ __attribute__((aligned(16))) unsigned char lds[];
    Frame F;
    F.lds = (LAS unsigned char*)lds; F.wave = __builtin_amdgcn_readfirstlane((int)threadIdx.x >> 6); F.lane = hw_lane(); F.tid = F.wave * 64 + F.lane;
    F.G = gridDim.x; { const int bx = blockIdx.x; F.vcu = (F.G % 8 == 0) ? (bx % 8) * (F.G / 8) + bx / 8 : bx; }
    F.in = args.in; F.h = args.out; F.ws = args.ws; F.probe = args.probe;
    volatile LAS unsigned* MISC = (volatile LAS unsigned*)(F.lds + MISC_OFF);
    if (F.tid < 32) MISC[F.tid] = 0u;
    __syncthreads();
    const int lo = args.s_lo, hi = args.s_hi;
    XcdBarrier bar; bar.wave0 = (F.wave == 0); bar.bar = (unsigned*)(F.ws + WS_CTL) + CW_BAR; bar.x = 0; bar.st = nullptr;
    if (hi - lo > 1) bar = xcd_barrier_post((unsigned*)(F.ws + WS_CTL) + CW_BAR, MISC + 8, F.wave == 0);
#define RUN(s) (lo <= (s) && (s) < hi)
#define SEAM(s) do { if (RUN(s) && RUN((s) + 1)) xcd_barrier(bar); } while (0)
    if (RUN(0)) { ph_prologue(F); ph_tables(F); ph_ln0(F); }
    SEAM(0);
    for (int l = 0; l < DEPTH; ++l) {
        const int sb = 1 + l * 16;
        for (int c = 0; c < NCHUNK; ++c) {
            const int s = sb + c * 6;
            if (RUN(s)) ph_p1(F, l, c);
            SEAM(s);
            const bool att_fused = RUN(s + 1) && RUN(s + 2);
            if (RUN(s + 1)) ph_att(F, l, bar, att_fused);
            if (!att_fused) { SEAM(s + 1); if (RUN(s + 2)) ph_cmb(F); }
            SEAM(s + 2);
            if (RUN(s + 3)) ph_p3(F, l);
            SEAM(s + 3);
            if (RUN(s + 4)) ph_p4(F, l, c);
            SEAM(s + 4);
            if (RUN(s + 5)) ph_ln1(F, l, c);
            if (c == NCHUNK - 1) SEAM(s + 5);
        }
        if (RUN(sb + 12)) ph_dsp(F, l);
        SEAM(sb + 12);
        if (RUN(sb + 13)) ph_p7(F, l);
        SEAM(sb + 13);
        if (RUN(sb + 14)) ph_p8(F, l);
        SEAM(sb + 14);
        if (RUN(sb + 15)) ph_ln2(F, l);
        SEAM(sb + 15);
    }
#undef RUN
#undef SEAM
}

extern "C" void kernel_launch(void* const* d_in, const int* in_sizes, int n_in, void* d_out, int out_size, void* d_ws, size_t ws_size, hipStream_t stream) {
    static int grid = 0;
    if (grid == 0) {
        if (n_in != 23 || out_size != T * D || ws_size < WS_END) { fprintf(stderr, "kernel_launch: unexpected shapes (n_in %d out %d ws %zu)\n", n_in, out_size, ws_size); grid = -1; return; }
        int dev = 0, cus = 0, per_cu = 0;
        if (hipGetDevice(&dev) != hipSuccess || hipDeviceGetAttribute(&cus, hipDeviceAttributeMultiprocessorCount, dev) != hipSuccess) { grid = -1; return; }
        if (hipFuncSetAttribute((const void*)mk_fwd, hipFuncAttributeMaxDynamicSharedMemorySize, LDS_BYTES) != hipSuccess) { fprintf(stderr, "kernel_launch: hipFuncSetAttribute failed\n"); grid = -1; return; }
        if (hipOccupancyMaxActiveBlocksPerMultiprocessor(&per_cu, (const void*)mk_fwd, NTHREADS, LDS_BYTES) != hipSuccess || per_cu < 1) fprintf(stderr, "kernel_launch: occupancy query reports %d\n", per_cu);
        (void)hipGetLastError();
        grid = cus > 256 ? 256 : cus;
    }
    if (grid < 0) return;
    (void)hipMemsetAsync((unsigned char*)d_ws + WS_CTL, 0, CTL_ZERO_BYTES, stream);
    Args a{};
    for (int i = 0; i < 23; ++i) a.in[i] = (const float*)d_in[i];
    a.out = (float*)d_out; a.ws = (unsigned char*)d_ws; a.s_lo = 0; a.s_hi = NSTEPS; a.probe = 0; a.pad = 0;
    hipLaunchKernelGGL(mk_fwd, dim3(grid), dim3(NTHREADS), LDS_BYTES, stream, a);
}
```

```cpp
#include <hip/hip_runtime.h>
#include <cstdio>
#include <cstdint>
#include <cmath>

typedef unsigned short bf16;
typedef short bf16x8 __attribute__((ext_vector_type(8)));
typedef float f32x16 __attribute__((ext_vector_type(16)));
typedef float f32x4 __attribute__((ext_vector_type(4)));

constexpr int D = 1024, L = 8192, NBATCH = 8, T = NBATCH * L, DEPTH = 2;
constexpr int NCOL = 7680, QKVW = 4608, GATEW = 3072;
constexpr int CH = 32768, NCHUNK = T / CH;
constexpr int OW = 1280;
constexpr int NE = 32, DE = 512;
constexpr int MAXRT = T * 2 / 256 + NE, PROWS = MAXRT * 256;
constexpr float LN_EPS = 1e-5f;
constexpr float ALPHA = 1.41421356237309515f;
constexpr int AQ = 0, AK = 512, AV = 640, BQ0 = 768, CQ = 3072, CK = 3584, CV = 4096;

constexpr size_t MiB = 1u << 20;
constexpr size_t WS_CTL = 0;
constexpr size_t WS_WIN = 1 * MiB, WS_WBRA = 31 * MiB, WS_WBRB = 33 * MiB, WS_WBRC = 34 * MiB, WS_WOUT = 36 * MiB, WS_WGU = 40 * MiB, WS_WD = 168 * MiB;
constexpr size_t WS_HB = 232 * MiB, WS_QKV = 360 * MiB, WS_GATES = 648 * MiB, WS_OABC = 840 * MiB, WS_OG = 920 * MiB, WS_LSE = 968 * MiB,
                 WS_REC = 970 * MiB, WS_ROWTOK = 972 * MiB, WS_ROWGATE = 973 * MiB, WS_TABA = 974 * MiB, WS_TABB = WS_TABA + 16384, WS_TABC = WS_TABA + 32768, WS_WGCNT = WS_TABA + 131072  , WS_END = 975 * MiB;
constexpr size_t WS_MERGED = WS_QKV, WS_HID = WS_QKV, WS_YB = WS_QKV + 136 * MiB;
constexpr int CSTR = 32;

__device__ __constant__ signed char BUCK_A[257] = {12,11,11,11,11,11,11,11,11,11,11,11,11,11,11,11,11,11,11,11,11,11,11,11,11,11,11,11,11,11,11,11,11,11,11,11,11,11,11,11,11,11,11,11,11,11,11,11,11,11,11,11,11,11,11,11,11,11,11,11,11,11,11,11,11,10,10,10,10,10,10,10,10,10,10,10,10,10,10,10,10,10,10,10,10,10,10,10,10,10,10,10,10,10,10,10,10,9,9,9,9,9,9,9,9,9,9,9,9,9,9,9,9,8,8,8,8,8,8,8,8,7,6,5,4,3,2,1,0,17,18,19,20,21,22,23,24,24,24,24,24,24,24,24,25,25,25,25,25,25,25,25,25,25,25,25,25,25,25,25,26,26,26,26,26,26,26,26,26,26,26,26,26,26,26,26,26,26,26,26,26,26,26,26,26,26,26,26,26,26,26,26,27,27,27,27,27,27,27,27,27,27,27,27,27,27,27,27,27,27,27,27,27,27,27,27,27,27,27,27,27,27,27,27,27,27,27,27,27,27,27,27,27,27,27,27,27,27,27,27,27,27,27,27,27,27,27,27,27,27,27,27,27,27,27,27,28};
__device__ __constant__ signed char BUCK_B[3][129] = {
 {11,10,10,10,10,10,10,10,10,10,10,10,10,10,10,10,10,10,10,10,10,10,10,10,10,10,10,10,10,10,10,10,10,9,9,9,9,9,9,9,9,9,9,9,9,9,9,9,9,8,8,8,8,8,8,8,8,7,6,5,4,3,2,1,0,17,18,19,20,21,22,23,24,24,24,24,24,24,24,24,25,25,25,25,25,25,25,25,25,25,25,25,25,25,25,25,26,26,26,26,26,26,26,26,26,26,26,26,26,26,26,26,26,26,26,26,26,26,26,26,26,26,26,26,26,26,26,26,27},
 {13,12,12,12,12,12,12,12,12,12,12,12,12,12,12,12,12,12,12,12,12,12,12,12,12,12,12,12,12,12,12,12,12,11,11,11,11,11,11,11,11,11,11,11,11,11,11,11,11,10,10,10,10,10,10,10,10,9,9,9,9,8,8,4,0,20,24,24,25,25,25,25,26,26,26,26,26,26,26,26,27,27,27,27,27,27,27,27,27,27,27,27,27,27,27,27,28,28,28,28,28,28,28,28,28,28,28,28,28,28,28,28,28,28,28,28,28,28,28,28,28,28,28,28,28,28,28,28,29},
 {15,14,14,14,14,14,14,14,14,14,14,14,14,14,14,14,14,14,14,14,14,14,14,14,14,14,14,14,14,14,14,14,14,13,13,13,13,13,13,13,13,13,13,13,13,13,13,13,13,12,12,12,12,12,12,12,12,11,11,11,11,10,10,9,0,25,26,26,27,27,27,27,28,28,28,28,28,28,28,28,29,29,29,29,29,29,29,29,29,29,29,29,29,29,29,29,30,30,30,30,30,30,30,30,30,30,30,30,30,30,30,30,30,30,30,30,30,30,30,30,30,30,30,30,30,30,30,30,31}};

__device__ __forceinline__ float bf2f(bf16 b) { return __uint_as_float(((unsigned)b) << 16); }
__device__ __forceinline__ bf16 f2bf(float f) { unsigned u = __float_as_uint(f); u += 0x7fffu + ((u >> 16) & 1u); return (bf16)(u >> 16); }
__device__ __forceinline__ float wave_sum(float v) {
#pragma unroll
    for (int o = 1; o < 64; o <<= 1) v += __shfl_xor(v, o);
    return v;
}

struct Rec { int e0, s0, e1, s1; float g0, g1; int pad0, pad1; };

#ifndef PG8_ALIGN
#define PG8_ALIGN 1
#endif
namespace pg8 {
#define PG8_LAS __attribute__((address_space(3)))
typedef unsigned short bf16_t;
typedef unsigned u32x4 __attribute__((ext_vector_type(4)));
constexpr int BM = 256, BK = 64, HALF = 128, HTB = HALF * BK * 2  , STAGE_BYTES = 8 * HTB, NXCD = 8, WGM = 4;

__host__ __device__ __forceinline__ int lds_byte(int r, int c) { const int st = (r >> 4) * 2 + (c >> 5), rr = r & 15, cc = c & 31, ob = rr * 64 + cc * 2; return st * 1024 + (ob ^ (((ob >> 9) & 1) << 5)); }
__host__ __device__ __forceinline__ void stage_rc(int b, int& R, int& C) { const int st = b / 1024, sb = b % 1024, swz = sb ^ (((sb >> 9) & 1) << 5); R = (st >> 1) * 16 + swz / 64; C = (st & 1) * 32 + (swz % 64) / 2; }
__host__ __device__ __forceinline__ int perm_adj(int r) { return 16 * ((r >> 2) & 3) + 4 * (r >> 4) + (r & 3); }
__host__ __device__ __forceinline__ int perm32(int rho) { const int n = rho >> 4, i = rho & 15; return 8 * (i >> 2) + 4 * n + (i & 3); }

struct Unit { int pm, pn, e, ui; };

struct DenseOrder {
    int nM, nN, nwg, G, c; const char* A; const char* B; size_t tstepA, tstepB;
    __device__ void init(const void* A_, int lda, const void* B_, int ldb, int M, int N, int G_, int c_) { nM = M / BM; nN = N / BM; nwg = nM * nN; G = G_; c = c_; A = (const char*)A_; B = (const char*)B_; tstepA = (size_t)BM * lda * 2; tstepB = (size_t)BM * ldb * 2; }
    __device__ bool next(int i, Unit& u) const {
        const long Lx = (long)i * G + c; if (Lx >= nwg) return false;
        int wgid = (int)Lx; { const int q = nwg / NXCD, r = nwg % NXCD, xcd = wgid % NXCD, off = wgid / NXCD; wgid = (xcd < r ? xcd * (q + 1) : r * (q + 1) + (xcd - r) * q) + off; }
        const int nig = WGM * nN, gid = wgid / nig, fm = gid * WGM, gsz = (nM - fm) < WGM ? (nM - fm) : WGM;
        u.pm = fm + ((wgid % nig) % gsz); u.pn = (wgid % nig) / gsz; u.e = 0; u.ui = i; return true;
    }
    __device__ __forceinline__ const char* a_base(const Unit& u) const { return A + (size_t)u.pm * tstepA; }
    __device__ __forceinline__ const char* b_base(const Unit& u) const { return B + (size_t)u.pn * tstepB; }
    __device__ __forceinline__ int a_row(const Unit&, int) const { return 0; }
};

__device__ __forceinline__ unsigned cvt_pk_bf16(float lo, float hi) { unsigned r; asm volatile("v_cvt_pk_bf16_f32 %0, %1, %2" : "=v"(r) : "v"(lo), "v"(hi)); return r; }

template <class Epi, class Sched, bool GATHER>
__device__ __forceinline__ void gemm_phase(PG8_LAS unsigned char* lds, const Sched& S, const Epi& E, const int K, const int lda, const int ldb, const int tid_in) {
    int tid = tid_in; asm volatile("" : "+v"(tid));
    const int wid = __builtin_amdgcn_readfirstlane(tid >> 6), lane = tid & 63, wr = wid >> 2, wc = wid & 3, fr = lane & 15, fq = lane >> 4;
    const int nt = K / BK;
    int RA[2], CA[2]; unsigned voffB[2];
#pragma unroll
    for (int i = 0; i < 2; ++i) { int R, C; stage_rc(tid * 16 + i * 8192, R, C); const int Rb = Epi::ADJ ? (64 * (R >> 5) + perm_adj(R & 31)) : (Epi::PERM ? ((R & ~31) + perm32(R & 31)) : R); RA[i] = R; CA[i] = C; voffB[i] = (unsigned)(Rb * ldb + C) * 2u; }
    const size_t kstep = (size_t)(BK * 2);
    const size_t hstepB = (size_t)(Epi::ADJ ? 8 : HALF) * ldb * 2;
    const unsigned ldsw = (unsigned)wid * 1024u;
    const int aoff = lds_byte(wr * 64 + fr, fq * 8), boff = lds_byte(wc * 32 + fr, fq * 8);
#define PG8_SA(b, h) (((b) * 2 + (h)) * HTB)
#define PG8_SB(b, h) ((4 + (b) * 2 + (h)) * HTB)
#define PG8_STAGE2(bufoff, gbase, v0, v1) do { \
        __builtin_amdgcn_global_load_lds((const unsigned*)((const char*)(gbase) + (v0)), (PG8_LAS unsigned*)(lds + (bufoff) + ldsw), 16, 0, 0); \
        __builtin_amdgcn_global_load_lds((const unsigned*)((const char*)(gbase) + (v1)), (PG8_LAS unsigned*)(lds + (bufoff) + ldsw + 8192), 16, 0, 0); } while (0)
#define PG8_STAGEB(bufoff, gbase) PG8_STAGE2(bufoff, gbase, voffB[0], voffB[1])
#define PG8_LDA(dst, b, h) do { _Pragma("unroll") for (int m = 0; m < 4; ++m) _Pragma("unroll") for (int k = 0; k < 2; ++k) dst[m][k] = *(const PG8_LAS bf16x8*)(lds + PG8_SA(b, h) + aoff + m * 2048 + k * 1024); } while (0)
#define PG8_LDB(dst, b, h) do { _Pragma("unroll") for (int n = 0; n < 2; ++n) _Pragma("unroll") for (int k = 0; k < 2; ++k) dst[n][k] = *(const PG8_LAS bf16x8*)(lds + PG8_SB(b, h) + boff + n * 2048 + k * 1024); } while (0)
#define PG8_MMA(ai, bj, At, Bt) do { __builtin_amdgcn_s_setprio(1); _Pragma("unroll") for (int m = 0; m < 4; ++m) _Pragma("unroll") for (int n = 0; n < 2; ++n) _Pragma("unroll") for (int k = 0; k < 2; ++k) \
        acc[ai][bj][m][n] = __builtin_amdgcn_mfma_f32_16x16x32_bf16(Bt[n][k], At[m][k], acc[ai][bj][m][n], 0, 0, 0); __builtin_amdgcn_s_setprio(0); } while (0)
#define PG8_WAIT_V(n) asm volatile("s_waitcnt vmcnt(" #n ")" ::: "memory")
#define PG8_WAIT_L(n) asm volatile("s_waitcnt lgkmcnt(" #n ")" ::: "memory")
#define PG8_WAIT_VR(rl) do { if (Epi::EXACT && (rl)) { if (Epi::NSTORE_LO > 0) asm volatile("s_cmp_eq_u32 %0, 2\n\ts_cbranch_scc1 3f\n\ts_waitcnt vmcnt(%2)\n\ts_branch 5f\n3:\ts_waitcnt vmcnt(%1)\n5:" :: "s"(rl), "n"(8 + Epi::NSTORE), "n"(8 + Epi::NSTORE_LO) : "memory", "scc"); else asm volatile("s_waitcnt vmcnt(%0)" :: "n"(8 + Epi::NSTORE) : "memory"); } else asm volatile("s_waitcnt vmcnt(8)" ::: "memory"); } while (0)
#define PG8_BAR __builtin_amdgcn_s_barrier()
#define PG8_SCHED __builtin_amdgcn_sched_barrier(0)
#define PG8_VOFFA(dst, u) do { _Pragma("unroll") for (int h_ = 0; h_ < 2; ++h_) _Pragma("unroll") for (int i_ = 0; i_ < 2; ++i_) { \
        const int row_ = GATHER ? S.a_row(u, h_ * HALF + RA[i_]) : (h_ * HALF + RA[i_]); dst[h_][i_] = (unsigned)(row_ * lda + CA[i_]) * 2u; } } while (0)
    Unit cur, nxt;
    if (!S.next(0, cur)) return;
    f32x4 acc[2][2][4][2];
#pragma unroll
    for (int a = 0; a < 2; ++a)
#pragma unroll
        for (int b = 0; b < 2; ++b)
#pragma unroll
            for (int m = 0; m < 4; ++m)
#pragma unroll
                for (int n = 0; n < 2; ++n) acc[a][b][m][n] = (f32x4){0.f, 0.f, 0.f, 0.f};
    bf16x8 At[4][2], B0[2][2], B1[2][2];
    unsigned vc[2][2], vn[2][2];
    PG8_VOFFA(vc, cur);
    const char* cA = S.a_base(cur); const char* cB = S.b_base(cur);
    PG8_STAGEB(PG8_SB(0, 0), cB); PG8_STAGEB(PG8_SB(0, 1), cB + hstepB); PG8_STAGE2(PG8_SA(0, 0), cA, vc[0][0], vc[0][1]); PG8_STAGE2(PG8_SA(0, 1), cA, vc[1][0], vc[1][1]);
    if (wr == 1) PG8_BAR;
    PG8_WAIT_V(2); PG8_BAR;
    PG8_STAGEB(PG8_SB(1, 0), cB + kstep); PG8_STAGE2(PG8_SA(1, 0), cA + kstep, vc[0][0], vc[0][1]); PG8_STAGEB(PG8_SB(1, 1), cB + hstepB + kstep);
    PG8_WAIT_V(6); PG8_BAR;
    int ui = 0; bool fresh = false; int pst = 0;
    for (;;) {
        const bool has_next = S.next(ui + 1, nxt);
        const char* nA = has_next ? S.a_base(nxt) : cA; const char* nB = has_next ? S.b_base(nxt) : cB;
        if (GATHER) { if (has_next) { PG8_VOFFA(vn, nxt); } else {
#pragma unroll
            for (int h_ = 0; h_ < 2; ++h_) { vn[h_][0] = vc[h_][0]; vn[h_][1] = vc[h_][1]; } } }
        for (int t = 0; t < nt; t += 2) {
            const bool last = (t == nt - 2); int tz = t; asm volatile("" : "+s"(tz)); const int rl = __builtin_amdgcn_readfirstlane((fresh && tz == 0) ? (Epi::NSTORE_LO > 0 ? pst : 1) : 0);
            const char* a1 = cA + (size_t)(t + 1) * kstep;
            const char* a2 = last ? nA : cA + (size_t)(t + 2) * kstep; const char* b2 = last ? nB : cB + (size_t)(t + 2) * kstep;
            const char* a3 = a2 + kstep; const char* b3 = b2 + kstep;
            unsigned w00, w01, w10, w11;
            if (GATHER) { w00 = last ? vn[0][0] : vc[0][0]; w01 = last ? vn[0][1] : vc[0][1]; w10 = last ? vn[1][0] : vc[1][0]; w11 = last ? vn[1][1] : vc[1][1]; }
            else { w00 = vc[0][0]; w01 = vc[0][1]; w10 = vc[1][0]; w11 = vc[1][1]; }
            PG8_LDB(B0, 0, 0); PG8_LDB(B1, 0, 1); PG8_SCHED; PG8_LDA(At, 0, 0); PG8_STAGE2(PG8_SA(1, 1), a1, vc[1][0], vc[1][1]);
            PG8_WAIT_VR(rl); PG8_WAIT_L(0); PG8_BAR; PG8_MMA(0, 0, At, B0); PG8_MMA(0, 1, At, B1); PG8_BAR; PG8_SCHED;
            PG8_LDA(At, 0, 1); PG8_STAGEB(PG8_SB(0, 0), b2); PG8_STAGEB(PG8_SB(0, 1), b2 + hstepB); PG8_STAGE2(PG8_SA(0, 0), a2, w00, w01);
            PG8_WAIT_VR(rl); PG8_WAIT_L(0); PG8_BAR; PG8_MMA(1, 0, At, B0); PG8_MMA(1, 1, At, B1); PG8_BAR; PG8_SCHED;
            PG8_LDB(B0, 1, 0); PG8_LDB(B1, 1, 1); PG8_SCHED; PG8_LDA(At, 1, 0); PG8_STAGE2(PG8_SA(0, 1), a2, w10, w11);
            PG8_WAIT_V(8); PG8_WAIT_L(0); PG8_BAR; PG8_MMA(0, 0, At, B0); PG8_MMA(0, 1, At, B1); PG8_BAR; PG8_SCHED;
            PG8_LDA(At, 1, 1); PG8_STAGEB(PG8_SB(1, 0), b3); PG8_STAGEB(PG8_SB(1, 1), b3 + hstepB); PG8_STAGE2(PG8_SA(1, 0), a3, w00, w01);
            PG8_WAIT_V(8); PG8_WAIT_L(0); PG8_BAR; PG8_MMA(1, 0, At, B0); PG8_MMA(1, 1, At, B1); PG8_BAR; PG8_SCHED;
        }
        if (PG8_ALIGN && wr == 0) PG8_BAR;
        E(acc, cur, wr, wc, fr, fq);
        if (!has_next) break;
        if (Epi::NSTORE_LO > 0) pst = Epi::nst(cur);
#pragma unroll
        for (int a = 0; a < 2; ++a)
#pragma unroll
            for (int b = 0; b < 2; ++b)
#pragma unroll
                for (int m = 0; m < 4; ++m)
#pragma unroll
                    for (int n = 0; n < 2; ++n) acc[a][b][m][n] = (f32x4){0.f, 0.f, 0.f, 0.f};
        cur = nxt; cA = nA; cB = nB; ++ui;
        if (GATHER) {
#pragma unroll
            for (int h_ = 0; h_ < 2; ++h_) { vc[h_][0] = vn[h_][0]; vc[h_][1] = vn[h_][1]; } }
        if (PG8_ALIGN && wr == 1) PG8_BAR;
        fresh = true;
    }
    PG8_WAIT_V(0);
    if (!PG8_ALIGN && wr == 0) PG8_BAR;
    PG8_BAR;
#undef PG8_SA
#undef PG8_SB
#undef PG8_STAGE2
#undef PG8_STAGEB
#undef PG8_LDA
#undef PG8_LDB
#undef PG8_MMA
#undef PG8_WAIT_V
#undef PG8_WAIT_L
#undef PG8_WAIT_VR
#undef PG8_BAR
#undef PG8_SCHED
#undef PG8_VOFFA
}
template <class Epi, class Sched>
__device__ __forceinline__ void gemm_phase_vk(PG8_LAS unsigned char* lds, const Sched& S, const Epi& E, const int lda, const int tid_in) {
    constexpr bool GATHER = false;
    int tid = tid_in; asm volatile("" : "+v"(tid));
    const int wid = __builtin_amdgcn_readfirstlane(tid >> 6), lane = tid & 63, wr = wid >> 2, wc = wid & 3, fr = lane & 15, fq = lane >> 4;
    int RA[2], CA[2], RB[2];
#pragma unroll
    for (int i = 0; i < 2; ++i) { int R, C; stage_rc(tid * 16 + i * 8192, R, C); const int Rb = Epi::PERM ? ((R & ~31) + perm32(R & 31)) : R; RA[i] = R; CA[i] = C; RB[i] = Rb; }
    const size_t kstep = (size_t)(BK * 2);
    const unsigned ldsw = (unsigned)wid * 1024u;
    const int aoff = lds_byte(wr * 64 + fr, fq * 8), boff = lds_byte(wc * 32 + fr, fq * 8);
#define PG8_SA(b, h) (((b) * 2 + (h)) * HTB)
#define PG8_SB(b, h) ((4 + (b) * 2 + (h)) * HTB)
#define PG8_STAGE2(bufoff, gbase, v0, v1) do { \
        __builtin_amdgcn_global_load_lds((const unsigned*)((const char*)(gbase) + (v0)), (PG8_LAS unsigned*)(lds + (bufoff) + ldsw), 16, 0, 0); \
        __builtin_amdgcn_global_load_lds((const unsigned*)((const char*)(gbase) + (v1)), (PG8_LAS unsigned*)(lds + (bufoff) + ldsw + 8192), 16, 0, 0); } while (0)
#define PG8_VOFFB(dst, hs, u) do { const int ldb_ = S.ldb_of(u); _Pragma("unroll") for (int i_ = 0; i_ < 2; ++i_) { int R_, C_; stage_rc(tid * 16 + i_ * 8192, R_, C_); const int Rb_ = Epi::ADJ ? (64 * (R_ >> 5) + perm_adj(R_ & 31)) : (Epi::PERM ? ((R_ & ~31) + perm32(R_ & 31)) : R_); dst[i_] = (unsigned)(Rb_ * ldb_ + C_) * 2u; } hs = (size_t)(Epi::ADJ ? 8 : HALF) * ldb_ * 2; } while (0)
#define PG8_LDA(dst, b, h) do { _Pragma("unroll") for (int m = 0; m < 4; ++m) _Pragma("unroll") for (int k = 0; k < 2; ++k) dst[m][k] = *(const PG8_LAS bf16x8*)(lds + PG8_SA(b, h) + aoff + m * 2048 + k * 1024); } while (0)
#define PG8_LDB(dst, b, h) do { _Pragma("unroll") for (int n = 0; n < 2; ++n) _Pragma("unroll") for (int k = 0; k < 2; ++k) dst[n][k] = *(const PG8_LAS bf16x8*)(lds + PG8_SB(b, h) + boff + n * 2048 + k * 1024); } while (0)
#define PG8_MMA(ai, bj, At, Bt) do { __builtin_amdgcn_s_setprio(1); _Pragma("unroll") for (int m = 0; m < 4; ++m) _Pragma("unroll") for (int n = 0; n < 2; ++n) _Pragma("unroll") for (int k = 0; k < 2; ++k) \
        acc[ai][bj][m][n] = __builtin_amdgcn_mfma_f32_16x16x32_bf16(Bt[n][k], At[m][k], acc[ai][bj][m][n], 0, 0, 0); __builtin_amdgcn_s_setprio(0); } while (0)
#define PG8_WAIT_V(n) asm volatile("s_waitcnt vmcnt(" #n ")" ::: "memory")
#define PG8_WAIT_L(n) asm volatile("s_waitcnt lgkmcnt(" #n ")" ::: "memory")
#define PG8_WAIT_VR(rl) do { if (Epi::EXACT && (rl)) { if (Epi::NSTORE_LO > 0) asm volatile("s_cmp_eq_u32 %0, 2\n\ts_cbranch_scc1 3f\n\ts_waitcnt vmcnt(%2)\n\ts_branch 5f\n3:\ts_waitcnt vmcnt(%1)\n5:" :: "s"(rl), "n"(8 + Epi::NSTORE), "n"(8 + Epi::NSTORE_LO) : "memory", "scc"); else asm volatile("s_waitcnt vmcnt(%0)" :: "n"(8 + Epi::NSTORE) : "memory"); } else asm volatile("s_waitcnt vmcnt(8)" ::: "memory"); } while (0)
#define PG8_BAR __builtin_amdgcn_s_barrier()
#define PG8_SCHED __builtin_amdgcn_sched_barrier(0)
#define PG8_VOFFA(dst, u) do { _Pragma("unroll") for (int h_ = 0; h_ < 2; ++h_) _Pragma("unroll") for (int i_ = 0; i_ < 2; ++i_) { \
        const int row_ = GATHER ? S.a_row(u, h_ * HALF + RA[i_]) : (h_ * HALF + RA[i_]); dst[h_][i_] = (unsigned)(row_ * lda + CA[i_]) * 2u; } } while (0)
    Unit cur, nxt;
    if (!S.next(0, cur)) return;
    f32x4 acc[2][2][4][2];
#pragma unroll
    for (int a = 0; a < 2; ++a)
#pragma unroll
        for (int b = 0; b < 2; ++b)
#pragma unroll
            for (int m = 0; m < 4; ++m)
#pragma unroll
                for (int n = 0; n < 2; ++n) acc[a][b][m][n] = (f32x4){0.f, 0.f, 0.f, 0.f};
    bf16x8 At[4][2], B0[2][2], B1[2][2];
    unsigned vc[2][2], vn[2][2];
    PG8_VOFFA(vc, cur);
    unsigned vbc[2], vbn[2]; size_t hsc, hsn; PG8_VOFFB(vbc, hsc, cur); int nt = S.K_of(cur) / BK;
    const char* cA = S.a_base(cur); const char* cB = S.b_base(cur);
    PG8_STAGE2(PG8_SB(0, 0), cB, vbc[0], vbc[1]); PG8_STAGE2(PG8_SB(0, 1), cB + hsc, vbc[0], vbc[1]); PG8_STAGE2(PG8_SA(0, 0), cA, vc[0][0], vc[0][1]); PG8_STAGE2(PG8_SA(0, 1), cA, vc[1][0], vc[1][1]);
    if (wr == 1) PG8_BAR;
    PG8_WAIT_V(2); PG8_BAR;
    PG8_STAGE2(PG8_SB(1, 0), cB + kstep, vbc[0], vbc[1]); PG8_STAGE2(PG8_SA(1, 0), cA + kstep, vc[0][0], vc[0][1]); PG8_STAGE2(PG8_SB(1, 1), cB + hsc + kstep, vbc[0], vbc[1]);
    PG8_WAIT_V(6); PG8_BAR;
    int ui = 0; bool fresh = false; int pst = 0;
    for (;;) {
        const bool has_next = S.next(ui + 1, nxt);
        const char* nA = has_next ? S.a_base(nxt) : cA; const char* nB = has_next ? S.b_base(nxt) : cB;
        if (has_next) { PG8_VOFFB(vbn, hsn, nxt); } else { vbn[0] = vbc[0]; vbn[1] = vbc[1]; hsn = hsc; }
        if (GATHER) { if (has_next) { PG8_VOFFA(vn, nxt); } else {
#pragma unroll
            for (int h_ = 0; h_ < 2; ++h_) { vn[h_][0] = vc[h_][0]; vn[h_][1] = vc[h_][1]; } } }
        for (int t = 0; t < nt; t += 2) {
            const bool last = (t == nt - 2); int tz = t; asm volatile("" : "+s"(tz)); const int rl = __builtin_amdgcn_readfirstlane((fresh && tz == 0) ? (Epi::NSTORE_LO > 0 ? pst : 1) : 0);
            const char* a1 = cA + (size_t)(t + 1) * kstep;
            const char* a2 = last ? nA : cA + (size_t)(t + 2) * kstep; const char* b2 = last ? nB : cB + (size_t)(t + 2) * kstep;
            const char* a3 = a2 + kstep; const char* b3 = b2 + kstep;
            unsigned w00, w01, w10, w11;
            if (GATHER) { w00 = last ? vn[0][0] : vc[0][0]; w01 = last ? vn[0][1] : vc[0][1]; w10 = last ? vn[1][0] : vc[1][0]; w11 = last ? vn[1][1] : vc[1][1]; }
            else { w00 = vc[0][0]; w01 = vc[0][1]; w10 = vc[1][0]; w11 = vc[1][1]; }
            const unsigned wb0 = last ? vbn[0] : vbc[0], wb1 = last ? vbn[1] : vbc[1]; const size_t hsb = last ? hsn : hsc;
            PG8_LDB(B0, 0, 0); PG8_LDB(B1, 0, 1); PG8_SCHED; PG8_LDA(At, 0, 0); PG8_STAGE2(PG8_SA(1, 1), a1, vc[1][0], vc[1][1]);
            PG8_WAIT_VR(rl); PG8_WAIT_L(0); PG8_BAR; PG8_MMA(0, 0, At, B0); PG8_MMA(0, 1, At, B1); PG8_BAR; PG8_SCHED;
            PG8_LDA(At, 0, 1); PG8_STAGE2(PG8_SB(0, 0), b2, wb0, wb1); PG8_STAGE2(PG8_SB(0, 1), b2 + hsb, wb0, wb1); PG8_STAGE2(PG8_SA(0, 0), a2, w00, w01);
            PG8_WAIT_VR(rl); PG8_WAIT_L(0); PG8_BAR; PG8_MMA(1, 0, At, B0); PG8_MMA(1, 1, At, B1); PG8_BAR; PG8_SCHED;
            PG8_LDB(B0, 1, 0); PG8_LDB(B1, 1, 1); PG8_SCHED; PG8_LDA(At, 1, 0); PG8_STAGE2(PG8_SA(0, 1), a2, w10, w11);
            PG8_WAIT_V(8); PG8_WAIT_L(0); PG8_BAR; PG8_MMA(0, 0, At, B0); PG8_MMA(0, 1, At, B1); PG8_BAR; PG8_SCHED;
            PG8_LDA(At, 1, 1); PG8_STAGE2(PG8_SB(1, 0), b3, wb0, wb1); PG8_STAGE2(PG8_SB(1, 1), b3 + hsb, wb0, wb1); PG8_STAGE2(PG8_SA(1, 0), a3, w00, w01);
            PG8_WAIT_V(8); PG8_WAIT_L(0); PG8_BAR; PG8_MMA(1, 0, At, B0); PG8_MMA(1, 1, At, B1); PG8_BAR; PG8_SCHED;
        }
        if (PG8_ALIGN && wr == 0) PG8_BAR;
        E(acc, cur, wr, wc, fr, fq);
        if (!has_next) break;
        if (Epi::NSTORE_LO > 0) pst = Epi::nst(cur);
        if (!S.keep_acc(cur)) {
#pragma unroll
        for (int a = 0; a < 2; ++a)
#pragma unroll
            for (int b = 0; b < 2; ++b)
#pragma unroll
                for (int m = 0; m < 4; ++m)
#pragma unroll
                    for (int n = 0; n < 2; ++n) acc[a][b][m][n] = (f32x4){0.f, 0.f, 0.f, 0.f}; }
        cur = nxt; cA = nA; cB = nB; ++ui; vbc[0] = vbn[0]; vbc[1] = vbn[1]; hsc = hsn; nt = S.K_of(cur) / BK;
        if (GATHER) {
#pragma unroll
            for (int h_ = 0; h_ < 2; ++h_) { vc[h_][0] = vn[h_][0]; vc[h_][1] = vn[h_][1]; } }
        if (PG8_ALIGN && wr == 1) PG8_BAR;
        fresh = true;
    }
    PG8_WAIT_V(0);
    if (!PG8_ALIGN && wr == 0) PG8_BAR;
    PG8_BAR;
#undef PG8_SA
#undef PG8_SB
#undef PG8_STAGE2
#undef PG8_VOFFB
#undef PG8_LDA
#undef PG8_LDB
#undef PG8_MMA
#undef PG8_WAIT_V
#undef PG8_WAIT_L
#undef PG8_WAIT_VR
#undef PG8_BAR
#undef PG8_SCHED
#undef PG8_VOFFA
}
}

constexpr int NWAVES = 8, NTHREADS = 512;
constexpr int RING_OFF = 0, RING_BYTES = 131072, ROWS_OFF = 131072, ROWS_BYTES = 12288, ROUTER_BYTES = 147456  , MISC_OFF = ROUTER_BYTES, LCNT_OFF = MISC_OFF + 128  , LDS_BYTES = 148480;
static_assert(MISC_OFF + 128 <= LDS_BYTES, "LDS map");
constexpr int CW_CNT = 0;
constexpr int CW_BAR = 4096;
constexpr size_t CTL_ZERO_BYTES = 64 * 1024;
constexpr float LOG2E = 1.4426950408889634f, LN2 = 0.6931471805599453f;
constexpr float QSCALE = 0.125f * LOG2E;

#define GAS __attribute__((address_space(1)))
#define LAS __attribute__((address_space(3)))
typedef unsigned v4u __attribute__((ext_vector_type(4)));
typedef unsigned v2u __attribute__((ext_vector_type(2)));
#define LDS_WAIT() asm volatile("s_waitcnt lgkmcnt(0)" ::: "memory")
__device__ __forceinline__ unsigned pk2(float lo, float hi) { return (unsigned)f2bf(lo) | ((unsigned)f2bf(hi) << 16); }

#define XB_TMO      128
#define XB_XCNT(j)  (256  + 64 * (j))
#define XB_XSUB(j)  (1280 + 64 * (j))
#define XB_XGEN(j)  (2304 + 64 * (j))
#define XB_TOP      3328
#define XB_TOPGEN   3392
#define XCD_BAR_WORDS 3456
#define XB_SPIN_CAP (1u << 18)

__device__ __forceinline__ unsigned xb_ld(unsigned* p)              { return __hip_atomic_load(p, __ATOMIC_RELAXED, __HIP_MEMORY_SCOPE_AGENT); }
__device__ __forceinline__ unsigned xb_add(unsigned* p, unsigned v) { return __hip_atomic_fetch_add(p, v, __ATOMIC_RELAXED, __HIP_MEMORY_SCOPE_AGENT); }
__device__ __forceinline__ unsigned xb_xcc_id() { return (unsigned)__builtin_amdgcn_s_getreg((3 << 11) | 20) & 0xFu; }
#define XB_SPIN(cond, bar) do { unsigned _sp = 0; while (cond) { __builtin_amdgcn_s_sleep(1); \
    if ((++_sp & 255u) == 0u) { if (xb_ld(&(bar)[XB_TMO])) break; if (_sp > XB_SPIN_CAP) { atomicAdd(&(bar)[XB_TMO], 1u); break; } } } } while (0)

struct XcdBarrier {
    int wave0;
    unsigned* bar; unsigned x;
    volatile LAS unsigned* st;
};

__device__ __forceinline__ unsigned xb_lane() { unsigned l_; asm volatile("v_mbcnt_lo_u32_b32 %0, -1, 0\n\tv_mbcnt_hi_u32_b32 %0, -1, %0" : "=v"(l_)); return l_; }
__device__ __forceinline__ XcdBarrier xcd_barrier_post(unsigned* bar, volatile LAS unsigned* st, int wave0) {
    XcdBarrier b; b.wave0 = wave0; b.bar = bar; b.x = xb_xcc_id(); b.st = st;
    if (b.wave0 && xb_lane() == 0u) (void)xb_add(&bar[XB_XCNT(b.x)], 1u);
    return b;
}
__device__ __forceinline__ void xcd_barrier_complete(unsigned* bar, unsigned x, unsigned& nloc, unsigned& nx) {
    const unsigned G = gridDim.x * gridDim.y * gridDim.z;
    unsigned sum, cnt, mine, sp = 0u;
    for (;;) {
        sum = 0u; cnt = 0u; mine = 0u;
#pragma unroll
        for (unsigned j = 0; j < 16; ++j) { const unsigned c = xb_ld(&bar[XB_XCNT(j)]); sum += c; cnt += (c > 0u) ? 1u : 0u; mine = (j == x) ? c : mine; }
        if (sum == G) break;
        __builtin_amdgcn_s_sleep(1);
        if ((++sp & 255u) == 0u) { if (xb_ld(&bar[XB_TMO])) break; if (sp > XB_SPIN_CAP) { atomicAdd(&bar[XB_TMO], 1u); break; } }
    }
    nloc = mine > 0u ? mine : 1u; nx = cnt > 0u ? cnt : 1u;
}

__device__ __forceinline__ void xcd_barrier(const XcdBarrier& b) {
    asm volatile("s_waitcnt vmcnt(0)" ::: "memory");
    __syncthreads();
    if (b.wave0 && xb_lane() == 0u) {
        unsigned* bar = b.bar;
        __builtin_amdgcn_s_waitcnt(0);
        unsigned nloc = b.st[0], nx = b.st[1];
        if (nloc == 0u) { xcd_barrier_complete(bar, b.x, nloc, nx); b.st[0] = nloc; b.st[1] = nx; }
        const unsigned old = xb_add(&bar[XB_XSUB(b.x)], 1u);
        const unsigned gen = old / nloc;
        if (old + 1u == (gen + 1u) * nloc) {
            __builtin_amdgcn_fence(__ATOMIC_RELEASE, "agent");
            asm volatile("s_waitcnt vmcnt(0)" ::: "memory");
            const unsigned og = xb_add(&bar[XB_TOP], 1u);
            const unsigned tg = og / nx;
            if (og + 1u == (tg + 1u) * nx) xb_add(&bar[XB_TOPGEN], 1u);
            else XB_SPIN(xb_ld(&bar[XB_TOPGEN]) == tg, bar);
            __builtin_amdgcn_fence(__ATOMIC_ACQUIRE, "agent");
            xb_add(&bar[XB_XGEN(b.x)], 1u);
            asm volatile("s_waitcnt vmcnt(0)" ::: "memory");
        } else {
            XB_SPIN(xb_ld(&bar[XB_XGEN(b.x)]) == gen, bar);
            __builtin_amdgcn_fence(__ATOMIC_ACQUIRE, "agent");
            asm volatile("s_waitcnt vmcnt(0)" ::: "memory");
        }
    }
    __syncthreads();
}


struct Args { const float* in[23]; float* out; unsigned char* ws; int s_lo, s_hi, probe, pad; };

struct Frame {
    LAS unsigned char* lds; int tid, lane, wave, vcu, G;
    const float* const* in; float* h; unsigned char* ws; int probe;
};

__device__ __forceinline__ int hw_lane() { int l_; asm volatile("v_mbcnt_lo_u32_b32 %0, -1, 0\n\tv_mbcnt_hi_u32_b32 %0, -1, %0" : "=v"(l_)); return l_; }
__device__ __forceinline__ float shfl_xor_l(float v, int mask, int lane) { return __builtin_bit_cast(float, __builtin_amdgcn_ds_bpermute((lane ^ mask) << 2, __builtin_bit_cast(int, v))); }
__device__ __forceinline__ float dpp_add(float v, const int ctrl_sel) {
    const int x = __builtin_bit_cast(int, v); int y;
    if (ctrl_sel == 0) y = __builtin_amdgcn_mov_dpp(x, 0xB1, 0xF, 0xF, true);
    else if (ctrl_sel == 1) y = __builtin_amdgcn_mov_dpp(x, 0x4E, 0xF, 0xF, true);
    else if (ctrl_sel == 2) y = __builtin_amdgcn_mov_dpp(x, 0x141, 0xF, 0xF, true);
    else y = __builtin_amdgcn_mov_dpp(x, 0x140, 0xF, 0xF, true);
    return v + __builtin_bit_cast(float, y);
}
__device__ __forceinline__ float wave_sum_l(float v, int lane) {
    (void)lane;
    v = dpp_add(v, 0); v = dpp_add(v, 1); v = dpp_add(v, 2); v = dpp_add(v, 3);
    const int x = __builtin_bit_cast(int, v);
    const float r0 = __builtin_bit_cast(float, __builtin_amdgcn_readlane(x, 0)), r1 = __builtin_bit_cast(float, __builtin_amdgcn_readlane(x, 16)),
                r2 = __builtin_bit_cast(float, __builtin_amdgcn_readlane(x, 32)), r3 = __builtin_bit_cast(float, __builtin_amdgcn_readlane(x, 48));
    return (r0 + r1) + (r2 + r3);
}
#define LAUNDER(F) do { (F).lane = hw_lane(); (F).tid = (F).wave * 64 + (F).lane; asm volatile("" : "+s"((F).G), "+s"((F).vcu), "+s"((F).ws), "+s"((F).h)); } while (0)
__device__ __forceinline__ void p0_item(const float* W, int ldw, int k0, int n0, bf16* WT, int Kd, int drow0, float scale, LAS float* scr, int lane) {
#pragma unroll 8
    for (int i = 0; i < 32; ++i) { const int kk = 2 * i + (lane >> 5); scr[kk * 33 + (lane & 31)] = *(const GAS float*)(W + (size_t)(k0 + kk) * ldw + n0 + (lane & 31)) * scale; }
    LDS_WAIT(); asm volatile("" ::: "memory");
    const int c = lane & 7;
#pragma unroll
    for (int j = 0; j < 4; ++j) { const int n = (lane >> 3) + 8 * j; const LAS float* s = scr + (8 * c) * 33 + n;
        v4u o; o.x = pk2(s[0 * 33], s[1 * 33]); o.y = pk2(s[2 * 33], s[3 * 33]); o.z = pk2(s[4 * 33], s[5 * 33]); o.w = pk2(s[6 * 33], s[7 * 33]);
        *(GAS v4u*)(WT + (size_t)(drow0 + n) * Kd + k0 + 8 * c) = o; }
    LDS_WAIT(); asm volatile("" ::: "memory");
}
__device__ __forceinline__ bool is_q_col(int n) { return n < 512 || (n >= 768 && n < 3072 && ((n - 768) % 768) < 256) || (n >= 3072 && n < 3584); }

__device__ __forceinline__ void ph_prologue(Frame& F) { LAUNDER(F);
    LAS float* scr = (LAS float*)(F.lds + RING_OFF + F.wave * 16384);
    const int gw = F.vcu * NWAVES + F.wave, NGW = F.G * NWAVES, lane = F.lane;
    const float* w_in = F.in[4]; const float* w_a = F.in[8]; const float* w_b = F.in[9]; const float* w_c = F.in[10]; const float* w_o = F.in[11];
    const float* w_eg = F.in[18]; const float* w_eu = F.in[19]; const float* w_ed = F.in[20];
    bf16* WIN = (bf16*)(F.ws + WS_WIN); bf16* WBRA = (bf16*)(F.ws + WS_WBRA); bf16* WBRB = (bf16*)(F.ws + WS_WBRB); bf16* WBRC = (bf16*)(F.ws + WS_WBRC); bf16* WOUT = (bf16*)(F.ws + WS_WOUT);
    bf16* WGU = (bf16*)(F.ws + WS_WGU); bf16* WD = (bf16*)(F.ws + WS_WD);
    constexpr int I_IN = 16 * (NCOL / 32), I_A = 8 * 32, I_B = 4 * 32, I_C = 8 * 32, I_O = 16 * 32, I_G = 16 * 16, I_D = 8 * 32;
    constexpr int I_LAYER = I_IN + I_A + I_B + I_C + I_O + NE * (2 * I_G + I_D);
    for (int it = gw; it < DEPTH * I_LAYER; it += NGW) {
        const int l = it / I_LAYER; int r = it % I_LAYER;
        if (r < I_IN) { const int nb = r % (NCOL / 32), kb = r / (NCOL / 32); p0_item(w_in + (size_t)l * D * NCOL, NCOL, 64 * kb, 32 * nb, WIN + (size_t)l * NCOL * D, D, 32 * nb, is_q_col(32 * nb) ? QSCALE : 1.0f, scr, lane); continue; } r -= I_IN;
        if (r < I_A) { const int nb = r % 32, kb = r / 32; p0_item(w_a + (size_t)l * 512 * D, D, 64 * kb, 32 * nb, WBRA + (size_t)l * D * 512, 512, 32 * nb, 1.0f, scr, lane); continue; } r -= I_A;
        if (r < I_B) { const int nb = r % 32, kb = r / 32; p0_item(w_b + (size_t)l * 256 * D, D, 64 * kb, 32 * nb, WBRB + (size_t)l * D * 256, 256, 32 * nb, 1.0f, scr, lane); continue; } r -= I_B;
        if (r < I_C) { const int nb = r % 32, kb = r / 32; p0_item(w_c + (size_t)l * 512 * D, D, 64 * kb, 32 * nb, WBRC + (size_t)l * D * 512, 512, 32 * nb, 1.0f, scr, lane); continue; } r -= I_C;
        if (r < I_O) { const int nb = r % 32, kb = r / 32; p0_item(w_o + (size_t)l * D * D, D, 64 * kb, 32 * nb, WOUT + (size_t)l * D * D, D, 32 * nb, 1.0f, scr, lane); continue; } r -= I_O;
        const int e = r / (2 * I_G + I_D); r %= (2 * I_G + I_D); const size_t le = (size_t)l * NE + e;
        if (r < 2 * I_G) { const int up = r / I_G; r %= I_G; const int nb = r % 16, kb = r / 16;
            p0_item((up ? w_eu : w_eg) + le * D * DE, DE, 64 * kb, 32 * nb, WGU + le * 1024 * 1024, D, (nb >> 2) * 256 + up * 128 + (nb & 3) * 32, 1.0f, scr, lane); continue; }
        r -= 2 * I_G; { const int nb = r % 32, kb = r / 32; p0_item(w_ed + le * DE * D, D, 64 * kb, 32 * nb, WD + le * D * DE, DE, 32 * nb, 1.0f, scr, lane); }
    }
}

struct LnIn { f32x4 v[4]; v4u hw[2], a[2], b[2]; };
template <int MODE> __device__ __forceinline__ void ln_load(LnIn& in, const float* src, const bf16* hsb, const bf16* yb, size_t row, int lane) {
#pragma unroll
    for (int j = 0; j < 2; ++j) {
        const int c = lane * 8 + 512 * j;
        if (MODE == 0) { in.v[2 * j] = *(const GAS f32x4*)(src + row * D + c); in.v[2 * j + 1] = *(const GAS f32x4*)(src + row * D + c + 4); }
        if (MODE != 0) in.hw[j] = *(const GAS v4u*)(hsb + row * D + c);
        if (MODE == 2) { in.a[j] = *(const GAS v4u*)(yb + (row * 2) * D + c); in.b[j] = *(const GAS v4u*)(yb + (row * 2 + 1) * D + c); }
    }
}
__device__ __forceinline__ void ln_params(f32x4 (&gg)[4], f32x4 (&bb)[4], const float* g, const float* bta, int lane) {
#pragma unroll
    for (int j = 0; j < 2; ++j)
#pragma unroll
        for (int q = 0; q < 2; ++q) { gg[2 * j + q] = *(const GAS f32x4*)(g + lane * 8 + 512 * j + 4 * q); bb[2 * j + q] = *(const GAS f32x4*)(bta + lane * 8 + 512 * j + 4 * q); }
}
template <int MODE> __device__ __forceinline__ void ln_finish(const LnIn& in, float* hout, bf16* hb, const f32x4 (&gg)[4], const f32x4 (&bb)[4], size_t row, int lane, f32x4 (&o)[4]) {
    f32x4 v[4];
#pragma unroll
    for (int j = 0; j < 2; ++j) {
        if (MODE == 0) { v[2 * j] = in.v[2 * j]; v[2 * j + 1] = in.v[2 * j + 1]; }
        else {
            const v4u hw = in.hw[j];
#pragma unroll
            for (int q = 0; q < 2; ++q) {
                const unsigned w0 = hw[2 * q], w1 = hw[2 * q + 1];
                f32x4 t = (f32x4){__uint_as_float(w0 << 16), __uint_as_float(w0 & 0xffff0000u), __uint_as_float(w1 << 16), __uint_as_float(w1 & 0xffff0000u)};
                if (MODE == 2) { const unsigned a0 = in.a[j][2 * q], a1 = in.a[j][2 * q + 1], b0 = in.b[j][2 * q], b1 = in.b[j][2 * q + 1];
                    t = t * ALPHA + (f32x4){__uint_as_float(a0 << 16), __uint_as_float(a0 & 0xffff0000u), __uint_as_float(a1 << 16), __uint_as_float(a1 & 0xffff0000u)}
                                  + (f32x4){__uint_as_float(b0 << 16), __uint_as_float(b0 & 0xffff0000u), __uint_as_float(b1 << 16), __uint_as_float(b1 & 0xffff0000u)}; }
                v[2 * j + q] = t; }
        }
    }
    float s = 0.f;
#pragma unroll
    for (int j = 0; j < 4; ++j) s += (v[j].x + v[j].y) + (v[j].z + v[j].w);
    const float mean = wave_sum_l(s, lane) * (1.f / D);
    float q2 = 0.f;
#pragma unroll
    for (int j = 0; j < 4; ++j) { v[j] = v[j] - mean; q2 += (v[j].x * v[j].x + v[j].y * v[j].y) + (v[j].z * v[j].z + v[j].w * v[j].w); }
    const float rstd = 1.0f / sqrtf(wave_sum_l(q2, lane) * (1.f / D) + LN_EPS);
#pragma unroll
    for (int j = 0; j < 4; ++j) o[j] = v[j] * rstd * gg[j] + bb[j];
#pragma unroll
    for (int j = 0; j < 2; ++j) {
        const int c = lane * 8 + 512 * j;
        if (hout) { *(GAS f32x4*)(hout + row * D + c) = o[2 * j]; *(GAS f32x4*)(hout + row * D + c + 4) = o[2 * j + 1]; }
        if (hb) { v4u w; w.x = pk2(o[2 * j].x, o[2 * j].y); w.y = pk2(o[2 * j].z, o[2 * j].w); w.z = pk2(o[2 * j + 1].x, o[2 * j + 1].y); w.w = pk2(o[2 * j + 1].z, o[2 * j + 1].w); *(GAS v4u*)(hb + row * D + c) = w; }
    }
}

__device__ __forceinline__ unsigned xor8_u(unsigned x) { return (unsigned)__builtin_amdgcn_mov_dpp((int)x, 0x128, 0xF, 0xF, true); }
__device__ __forceinline__ v4u xor8_v4u(v4u x) { return (v4u){xor8_u(x.x), xor8_u(x.y), xor8_u(x.z), xor8_u(x.w)}; }
__device__ __forceinline__ f32x4 xor8_f4(f32x4 x) { return (f32x4){__uint_as_float(xor8_u(__float_as_uint(x.x))), __uint_as_float(xor8_u(__float_as_uint(x.y))), __uint_as_float(xor8_u(__float_as_uint(x.z))), __uint_as_float(xor8_u(__float_as_uint(x.w)))}; }
__device__ __forceinline__ unsigned sel_u(bool c, unsigned a, unsigned b) { return c ? a : b; }
__device__ __forceinline__ void xchg8_v4u(const v4u pa, const v4u pb, const bool hi, v4u& first, v4u& second) {
    v4u send, recv;
#pragma unroll
    for (int j = 0; j < 4; ++j) { send[j] = sel_u(hi, pa[j], pb[j]); recv[j] = xor8_u(send[j]); first[j] = sel_u(hi, recv[j], pa[j]); second[j] = sel_u(hi, pb[j], recv[j]); }
}
__device__ __forceinline__ void xchg8_f4(const f32x4 pa, const f32x4 pb, const bool hi, f32x4& first, f32x4& second) {
#pragma unroll
    for (int j = 0; j < 4; ++j) { const unsigned a = __float_as_uint(pa[j]), b = __float_as_uint(pb[j]); const unsigned send = sel_u(hi, a, b), recv = xor8_u(send);
        first[j] = __uint_as_float(sel_u(hi, recv, a)); second[j] = __uint_as_float(sel_u(hi, b, recv)); }
}
#define XCHG8(T, XF, pa, pb, hi, first, second) XCHG8_##T(pa, pb, hi, first, second)
#define XCHG8_v4u(pa, pb, hi, first, second) xchg8_v4u(pa, pb, (hi) != 0, first, second)
#define XCHG8_f32x4(pa, pb, hi, first, second) xchg8_f4(pa, pb, (hi) != 0, first, second)
#ifndef GATE_RND
#define GATE_RND
#endif
struct EpiP1 {
    static constexpr bool PERM = true, ADJ = true; static constexpr bool EXACT = true; static constexpr int NSTORE = 16, NSTORE_LO = 8;
    static __device__ __forceinline__ int nst(const pg8::Unit& u) { return u.pn >= 18 ? 1 : 2; }
    bf16* qkv; unsigned char* gates; const float* b_gate; int probe;
    __device__ __forceinline__ void operator()(const f32x4 (&acc)[2][2][4][2], const pg8::Unit& u, int wr, int wc, int fr, int fq) const {
        asm volatile("" : "+v"(fr), "+v"(fq));
        if (u.pn >= 18) {
            const int tcol = (u.pn - 18) * 256 + wc * 64 + 16 * fq;
            f32x4 bv[4];
#pragma unroll
            for (int q = 0; q < 4; ++q) { bv[q] = *(const GAS f32x4*)(b_gate + tcol + 4 * q); bv[q] *= -LOG2E; }
            const float c255 = 1.0f / 255.0f;
#pragma unroll
            for (int ai = 0; ai < 2; ++ai)
#pragma unroll
                for (int m = 0; m < 4; ++m) { v4u w;
#pragma unroll
                    for (int bj = 0; bj < 2; ++bj)
#pragma unroll
                        for (int n = 0; n < 2; ++n) { const f32x4 v = acc[ai][bj][m][n]; const f32x4 b4 = bv[2 * bj + n]; unsigned p = 0u;
#pragma unroll
                            for (int j = 0; j < 4; ++j) { const float ex = __builtin_amdgcn_exp2f(__builtin_fmaf(v[j], -LOG2E, b4[j])); float dn;
                                asm("v_fma_f32 %0, %1, %2, %2 clamp" : "=v"(dn) : "v"(ex), "s"(c255));
                                p = __builtin_amdgcn_cvt_pk_u8_f32(__builtin_amdgcn_rcpf(dn) GATE_RND, j, p); }
                            w[2 * bj + n] = p; }
                    *(GAS v4u*)(gates + (size_t)(u.pm * 256 + ai * 128 + wr * 64 + m * 16 + fr) * GATEW + tcol) = w; }
            return;
        }
        const int hi = fr >> 3, r7 = fr & 7, tcol = u.pn * 256 + wc * 64 + 16 * fq;
#pragma unroll
        for (int ai = 0; ai < 2; ++ai)
#pragma unroll
            for (int m = 0; m < 4; ++m) { v4u w[2];
#pragma unroll
                for (int bj = 0; bj < 2; ++bj) { const f32x4 v0 = acc[ai][bj][m][0], v1 = acc[ai][bj][m][1];
                    w[bj].x = pg8::cvt_pk_bf16(v0[0], v0[1]); w[bj].y = pg8::cvt_pk_bf16(v0[2], v0[3]); w[bj].z = pg8::cvt_pk_bf16(v1[0], v1[1]); w[bj].w = pg8::cvt_pk_bf16(v1[2], v1[3]); }
                v4u s0, s1; XCHG8(v4u, xor8_v4u, w[0], w[1], hi, s0, s1);
                bf16* rowp = qkv + ((size_t)(u.pn * 4 + wc) * CH + (size_t)(u.pm * 256 + ai * 128 + wr * 64 + m * 16 + r7)) * 64 + 16 * fq + 8 * hi;
                *(GAS v4u*)rowp = s0; *(GAS v4u*)(rowp + 8 * 64) = s1; }
    }
};
struct EpiP3V {
    static constexpr bool PERM = true, ADJ = true; static constexpr bool EXACT = true; static constexpr int NSTORE = 16, NSTORE_LO = 0;
    static __device__ __forceinline__ int nst(const pg8::Unit&) { return 2; }
    bf16* merged; const unsigned char* gates;
    __device__ __forceinline__ void operator()(f32x4 (&acc)[2][2][4][2], const pg8::Unit& u, int wr, int wc, int fr, int fq) const {
        const int br = u.e; const int col = u.pn * 256 + wc * 64 + 16 * fq;
        if (br < 2) {
#pragma unroll
            for (int ai = 0; ai < 2; ++ai) {
                v4u gn[4], gd[4];
#pragma unroll
                for (int m = 0; m < 4; ++m) { const unsigned char* gp = gates + (size_t)(u.pm * 256 + ai * 128 + wr * 64 + m * 16 + fr) * GATEW + br * 1024 + col;
                    gn[m] = *(const GAS v4u*)gp; gd[m] = *(const GAS v4u*)(gp + 1024); }
#pragma unroll
                for (int m = 0; m < 4; ++m)
#pragma unroll
                    for (int bj = 0; bj < 2; ++bj)
#pragma unroll
                        for (int n = 0; n < 2; ++n) { const unsigned a4 = gn[m][2 * bj + n], b4 = gd[m][2 * bj + n];
#pragma unroll
                            for (int j = 0; j < 4; ++j) acc[ai][bj][m][n][j] *= (float)((a4 >> (8 * j)) & 255u) * __builtin_amdgcn_rcpf((float)((b4 >> (8 * j)) & 255u)); }
                asm volatile("" ::: "memory"); }
            return;
        }
        const int hi = fr >> 3, r7 = fr & 7;
#pragma unroll
        for (int ai = 0; ai < 2; ++ai) {
            v4u gw[4];
#pragma unroll
            for (int m = 0; m < 4; ++m) gw[m] = *(const GAS v4u*)(gates + (size_t)(u.pm * 256 + ai * 128 + wr * 64 + m * 16 + fr) * GATEW + 2 * 1024 + col);
#pragma unroll
            for (int m = 0; m < 4; ++m) { v4u w[2];
#pragma unroll
                for (int bj = 0; bj < 2; ++bj) { float r[8];
#pragma unroll
                    for (int n = 0; n < 2; ++n) { const unsigned g4 = gw[m][2 * bj + n];
#pragma unroll
                        for (int j = 0; j < 4; ++j) r[4 * n + j] = acc[ai][bj][m][n][j] * ((float)((g4 >> (8 * j)) & 255u) * (1.0f / 255.0f)); }
                    w[bj].x = pg8::cvt_pk_bf16(r[0], r[1]); w[bj].y = pg8::cvt_pk_bf16(r[2], r[3]); w[bj].z = pg8::cvt_pk_bf16(r[4], r[5]); w[bj].w = pg8::cvt_pk_bf16(r[6], r[7]); }
                v4u s0, s1; XCHG8(v4u, xor8_v4u, w[0], w[1], hi, s0, s1);
                bf16* rowp = merged + (size_t)(u.pm * 256 + ai * 128 + wr * 64 + m * 16 + r7) * D + col + 8 * hi;
                *(GAS v4u*)rowp = s0; *(GAS v4u*)(rowp + (size_t)8 * D) = s1; }
            asm volatile("" ::: "memory"); }
    }
};
struct P3Order {
    pg8::DenseOrder Dn; const char* Abase; const char* wsb; size_t lofs;
    __device__ __forceinline__ bool next(int i, pg8::Unit& u) const { if (!Dn.next(i / 3, u)) return false; u.e = i % 3; u.ui = i; return true; }
    __device__ __forceinline__ const char* a_base(const pg8::Unit& u) const { const size_t ko = (size_t)((u.e + 1) >> 1) * 1024 + (size_t)(u.e >> 1) * 512; return Abase + ko + (size_t)u.pm * Dn.tstepA; }
    __device__ __forceinline__ int K_of(const pg8::Unit& u) const { return 512 - 256 * (u.e & 1); }
    __device__ __forceinline__ int ldb_of(const pg8::Unit& u) const { return 512 - 256 * (u.e & 1); }
    __device__ __forceinline__ const char* b_base(const pg8::Unit& u) const {
        const size_t kb = (size_t)(512 - 256 * (u.e & 1)) * 2;
        const size_t base = WS_WBRA + (size_t)((u.e + 1) >> 1) * (WS_WBRB - WS_WBRA) + (size_t)(u.e >> 1) * (WS_WBRC - WS_WBRB);
        return wsb + base + lofs * (size_t)D * kb + (size_t)u.pn * 256 * kb; }
    __device__ __forceinline__ int a_row(const pg8::Unit&, int) const { return 0; }
    __device__ __forceinline__ bool keep_acc(const pg8::Unit& u) const { return u.e != 2; }
};
struct EpiP4 {
    static constexpr bool PERM = true, ADJ = true; static constexpr bool EXACT = true; static constexpr int NSTORE = 16, NSTORE_LO = 0;
    static __device__ __forceinline__ int nst(const pg8::Unit&) { return 2; }
    const bf16* hbc; bf16* vb;
    __device__ __forceinline__ void operator()(const f32x4 (&acc)[2][2][4][2], const pg8::Unit& u, int wr, int wc, int fr, int fq) const {
        const int hi = fr >> 3, r7 = fr & 7, col = u.pn * 256 + wc * 64 + 16 * fq + 8 * hi;
#pragma unroll
        for (int ai = 0; ai < 2; ++ai) { v4u hv[4][2];
#pragma unroll
            for (int m = 0; m < 4; ++m)
#pragma unroll
                for (int k = 0; k < 2; ++k) hv[m][k] = *(const GAS v4u*)(hbc + (size_t)(u.pm * 256 + ai * 128 + wr * 64 + m * 16 + 8 * k + r7) * D + col);
#pragma unroll
            for (int m = 0; m < 4; ++m) { f32x4 x0[2], x1[2];
                XCHG8(f32x4, xor8_f4, acc[ai][0][m][0], acc[ai][1][m][0], hi, x0[0], x0[1]);
                XCHG8(f32x4, xor8_f4, acc[ai][0][m][1], acc[ai][1][m][1], hi, x1[0], x1[1]);
#pragma unroll
                for (int k = 0; k < 2; ++k) { const v4u h4 = hv[m][k]; const f32x4 a0 = x0[k], a1 = x1[k]; float r[8];
#pragma unroll
                    for (int j = 0; j < 4; ++j) { const unsigned hw = h4[j]; const float av0 = j < 2 ? a0[2 * j] : a1[2 * j - 4], av1 = j < 2 ? a0[2 * j + 1] : a1[2 * j - 3];
                        r[2 * j] = ALPHA * __uint_as_float(hw << 16) + av0; r[2 * j + 1] = ALPHA * __uint_as_float(hw & 0xffff0000u) + av1; }
                    v4u w; w.x = pg8::cvt_pk_bf16(r[0], r[1]); w.y = pg8::cvt_pk_bf16(r[2], r[3]); w.z = pg8::cvt_pk_bf16(r[4], r[5]); w.w = pg8::cvt_pk_bf16(r[6], r[7]);
                    *(GAS v4u*)(vb + (size_t)(u.pm * 256 + ai * 128 + wr * 64 + m * 16 + 8 * k + r7) * D + col) = w; } }
            asm volatile("" ::: "memory"); }
    }
};
struct EpiP7 {
    static constexpr bool PERM = true, ADJ = false; static constexpr bool EXACT = true; static constexpr int NSTORE = 8, NSTORE_LO = 0;
    static __device__ __forceinline__ int nst(const pg8::Unit&) { return 2; }
    bf16* hid;
    __device__ __forceinline__ void operator()(const f32x4 (&acc)[2][2][4][2], const pg8::Unit& u, int wr, int wc, int fr, int fq) const {
        const int row0 = u.pm * 256 + wr * 64 + fr, col0 = u.pn * 128 + wc * 32 + 8 * fq;
#pragma unroll
        for (int ai = 0; ai < 2; ++ai)
#pragma unroll
            for (int m = 0; m < 4; ++m) { float r[8];
#pragma unroll
                for (int n = 0; n < 2; ++n)
#pragma unroll
                    for (int j = 0; j < 4; ++j) { const float gv = acc[ai][0][m][n][j], uv = acc[ai][1][m][n][j]; r[4 * n + j] = gv * __builtin_amdgcn_rcpf(1.0f + __builtin_amdgcn_exp2f(-LOG2E * gv)) * uv; }
                v4u w; w.x = pg8::cvt_pk_bf16(r[0], r[1]); w.y = pg8::cvt_pk_bf16(r[2], r[3]); w.z = pg8::cvt_pk_bf16(r[4], r[5]); w.w = pg8::cvt_pk_bf16(r[6], r[7]);
                *(GAS v4u*)(hid + (size_t)(row0 + ai * 128 + m * 16) * DE + col0) = w; }
    }
};
constexpr size_t P8_DUMMY = (WS_GATES + 100 * MiB - WS_YB) / 2;
struct EpiP8 {
    static constexpr bool PERM = true, ADJ = true; static constexpr int NSTORE = 16;
    static constexpr bool EXACT = false; static constexpr int NSTORE_LO = 0;
    static __device__ __forceinline__ int nst(const pg8::Unit&) { return 2; }
    bf16* yb; const LAS int* rows;
    __device__ __forceinline__ void operator()(const f32x4 (&acc)[2][2][4][2], const pg8::Unit& u, int wr, int wc, int fr, int fq) const {
        const int hi = fr >> 3, r7 = fr & 7, col = u.pn * 256 + wc * 64 + 16 * fq + 8 * hi;
        const LAS int* rw = rows + u.ui * 256 + wr * 64;
#pragma unroll
        for (int ai = 0; ai < 2; ++ai)
#pragma unroll
            for (int m = 0; m < 4; ++m) { const int rl = ai * 128 + m * 16;
                const unsigned wown = (unsigned)rw[rl + fr], w0 = (unsigned)rw[rl + r7], w1 = (unsigned)rw[rl + 8 + r7];
                const float gt = __uint_as_float((wown & 0x7fffu) << 16);
                v4u w[2];
#pragma unroll
                for (int bj = 0; bj < 2; ++bj) { const f32x4 v0 = acc[ai][bj][m][0] * gt, v1 = acc[ai][bj][m][1] * gt;
                    w[bj].x = pg8::cvt_pk_bf16(v0[0], v0[1]); w[bj].y = pg8::cvt_pk_bf16(v0[2], v0[3]); w[bj].z = pg8::cvt_pk_bf16(v1[0], v1[1]); w[bj].w = pg8::cvt_pk_bf16(v1[2], v1[3]); }
                v4u s0, s1; XCHG8(v4u, xor8_v4u, w[0], w[1], hi, s0, s1);
                if (w0 != 0xFFFFFFFFu) *(GAS v4u*)(yb + (size_t)(w0 >> 15) * D + col) = s0;
                if (w1 != 0xFFFFFFFFu) *(GAS v4u*)(yb + (size_t)(w1 >> 15) * D + col) = s1; }
    }
};

typedef float f32x2 __attribute__((ext_vector_type(2)));
template <int N> __device__ __forceinline__ void wave_sum_n(float (&v)[N]) {
#pragma unroll
    for (int s = 0; s < 4; ++s)
#pragma unroll
        for (int n = 0; n < N; ++n) v[n] = dpp_add(v[n], s);
#pragma unroll
    for (int n = 0; n < N; ++n) { const int x = __builtin_bit_cast(int, v[n]);
        const float r0 = __builtin_bit_cast(float, __builtin_amdgcn_readlane(x, 0)), r1 = __builtin_bit_cast(float, __builtin_amdgcn_readlane(x, 16)),
                    r2 = __builtin_bit_cast(float, __builtin_amdgcn_readlane(x, 32)), r3 = __builtin_bit_cast(float, __builtin_amdgcn_readlane(x, 48));
        v[n] = (r0 + r1) + (r2 + r3); }
}
__device__ __forceinline__ void router_row(const float (&x)[16], int t, int lane, const f32x4 (&wg)[16], const float* b_rg, const LAS float* w_re, const float* b_re, LAS int* lcnt, int wslot, Rec* rec) {
    f32x2 g01 = (f32x2){0.f, 0.f}, g23 = (f32x2){0.f, 0.f};
#pragma unroll
    for (int k = 0; k < 16; ++k) { const f32x4 w = wg[k]; const f32x2 xv = (f32x2){x[k], x[k]}; g01 = xv * (f32x2){w.x, w.y} + g01; g23 = xv * (f32x2){w.z, w.w} + g23; }
    float gl[4] = {g01.x, g01.y, g23.x, g23.y};
    wave_sum_n<4>(gl);
#pragma unroll
    for (int g = 0; g < 4; ++g) gl[g] += b_rg[g];
    int gi = 0; float gm = gl[0];
#pragma unroll
    for (int g = 1; g < 4; ++g) if (gl[g] > gm) { gm = gl[g]; gi = g; }
    float gs = 0.f;
#pragma unroll
    for (int g = 0; g < 4; ++g) gs += __expf(gl[g] - gm);
    const float gw = 1.0f / gs;
    f32x2 e01 = (f32x2){0.f, 0.f}, e23 = e01, e45 = e01, e67 = e01;
    const LAS float* wre = w_re + gi * (D * 8);
#pragma unroll
    for (int j = 0; j < 4; ++j)
#pragma unroll
        for (int i = 0; i < 4; ++i) { const LAS float* wp = wre + ((j * 4 + i) * 128 + lane) * 4; const f32x4 w0 = *(const LAS f32x4*)wp, w1 = *(const LAS f32x4*)(wp + 256); const f32x2 xv = (f32x2){x[4 * j + i], x[4 * j + i]};
            e01 = xv * (f32x2){w0.x, w0.y} + e01; e23 = xv * (f32x2){w0.z, w0.w} + e23; e45 = xv * (f32x2){w1.x, w1.y} + e45; e67 = xv * (f32x2){w1.z, w1.w} + e67; }
    float el[8] = {e01.x, e01.y, e23.x, e23.y, e45.x, e45.y, e67.x, e67.y};
    wave_sum_n<8>(el);
#pragma unroll
    for (int e = 0; e < 8; ++e) el[e] += b_re[gi * 8 + e];
    int i0 = 0; float t0 = el[0];
#pragma unroll
    for (int e = 1; e < 8; ++e) if (el[e] > t0) { t0 = el[e]; i0 = e; }
    int i1 = -1; float t1 = -3.0e38f;
#pragma unroll
    for (int e = 0; e < 8; ++e) if (e != i0 && el[e] > t1) { t1 = el[e]; i1 = e; }
    const float ex = __expf(t1 - t0), p0 = 1.0f / (1.0f + ex), p1 = ex / (1.0f + ex);
    if (lane == 0) {
        const int e0 = gi * 8 + i0, e1 = gi * 8 + i1;
        const int s0 = __hip_atomic_fetch_add(lcnt + e0, 1, __ATOMIC_RELAXED, __HIP_MEMORY_SCOPE_WORKGROUP), s1 = __hip_atomic_fetch_add(lcnt + e1, 1, __ATOMIC_RELAXED, __HIP_MEMORY_SCOPE_WORKGROUP);
        *((GAS v4u*)rec + t) = (v4u){__float_as_uint(gw * p0), __float_as_uint(gw * p1), (unsigned)e0 | ((unsigned)e1 << 8) | ((unsigned)wslot << 16), (unsigned)s0 | ((unsigned)s1 << 16)};
    }
}

#ifndef STAG_P1
#define STAG_P1 500
#endif
__device__ __forceinline__ void stagger(int vcu, unsigned q) {
    const unsigned long long t0 = __builtin_amdgcn_s_memrealtime(); const unsigned long long d = (unsigned long long)((vcu & 3) * q);
    while (__builtin_amdgcn_s_memrealtime() - t0 < d) __builtin_amdgcn_s_sleep(8);
}
__device__ __forceinline__ void ph_ln0(Frame& F) { LAUNDER(F);
    const int gw = F.vcu * NWAVES + F.wave, NGW = F.G * NWAVES;
    bf16* hb = (bf16*)(F.ws + WS_HB);
    f32x4 gg[4], bb[4]; ln_params(gg, bb, F.in[1], F.in[2], F.lane);
    LnIn cur, nxt, nx2; if (gw < T) ln_load<0>(cur, F.in[0], nullptr, nullptr, (size_t)gw, F.lane);
    if (gw + NGW < T) ln_load<0>(nxt, F.in[0], nullptr, nullptr, (size_t)(gw + NGW), F.lane);
    for (int m = gw; m < T; m += NGW) { const bool more = m + NGW < T, more2 = m + 2 * NGW < T; if (more2) ln_load<0>(nx2, F.in[0], nullptr, nullptr, (size_t)(m + 2 * NGW), F.lane);
        f32x4 o[4]; ln_finish<0>(cur, nullptr, hb, gg, bb, (size_t)m, F.lane, o); if (more) { cur = nxt; nxt = nx2; } }
}
__device__ __forceinline__ void ph_p1(Frame& F, int l, int c) { LAUNDER(F); asm volatile("" : "+s"(l), "+s"(c));
    pg8::DenseOrder S; S.init((const bf16*)(F.ws + WS_HB) + (size_t)c * CH * D, D, (const bf16*)(F.ws + WS_WIN) + (size_t)l * NCOL * D, D, CH, NCOL, F.G, (int)blockIdx.x);
    EpiP1 E{(bf16*)(F.ws + WS_QKV), (unsigned char*)(F.ws + WS_GATES), F.in[5] + (size_t)l * GATEW, F.probe};
    pg8::gemm_phase<EpiP1, pg8::DenseOrder, false>(F.lds + RING_OFF, S, E, D, D, D, F.tid);
}
__device__ __forceinline__ void ph_cmb(Frame& F) { LAUNDER(F);
    const bf16* og = (const bf16*)(F.ws + WS_OG); const float* lse = (const float*)(F.ws + WS_LSE); bf16* oabc = (bf16*)(F.ws + WS_OABC);
    for (int idx = F.vcu * NTHREADS + F.tid; idx < CH * 32; idx += F.G * NTHREADS) {
        const int tl = idx >> 5, hc = idx & 31, h = hc >> 3, c = hc & 7;
        const GAS float* lg = (const GAS float*)lse + (size_t)tl * 12 + h; const float l0 = lg[0], l1 = lg[4], l2 = lg[8];
        const float mx = fmaxf(l0, fmaxf(l1, l2)); float w0 = __expf(l0 - mx), w1 = __expf(l1 - mx), w2 = __expf(l2 - mx); const float inv = 1.0f / (w0 + w1 + w2); w0 *= inv; w1 *= inv; w2 *= inv;
        const v4u a = *(const GAS v4u*)(og + ((size_t)tl * 3 + 0) * 256 + h * 64 + c * 8), b = *(const GAS v4u*)(og + ((size_t)tl * 3 + 1) * 256 + h * 64 + c * 8), d = *(const GAS v4u*)(og + ((size_t)tl * 3 + 2) * 256 + h * 64 + c * 8);
        v4u ow;
#pragma unroll
        for (int i = 0; i < 4; ++i) {
            const float lo = w0 * __uint_as_float(a[i] << 16) + w1 * __uint_as_float(b[i] << 16) + w2 * __uint_as_float(d[i] << 16);
            const float hi = w0 * __uint_as_float(a[i] & 0xffff0000u) + w1 * __uint_as_float(b[i] & 0xffff0000u) + w2 * __uint_as_float(d[i] & 0xffff0000u);
            ow[i] = pk2(lo, hi);
        }
        *(GAS v4u*)(oabc + (size_t)tl * OW + 512 + h * 64 + c * 8) = ow;
    }
}
__device__ __forceinline__ void ph_p3(Frame& F, int l) { LAUNDER(F); asm volatile("" : "+s"(l));
    const bf16* oabc = (const bf16*)(F.ws + WS_OABC); bf16* merged = (bf16*)(F.ws + WS_MERGED); const unsigned char* gates = (const unsigned char*)(F.ws + WS_GATES);
    P3Order S; S.Dn.init(oabc, OW, nullptr, 0, CH, D, F.G, (int)blockIdx.x);
    S.Abase = (const char*)oabc; S.wsb = (const char*)F.ws; S.lofs = (size_t)l;
    EpiP3V E{merged, gates};
    pg8::gemm_phase_vk<EpiP3V, P3Order>(F.lds + RING_OFF, S, E, OW, F.tid);
}
__device__ __forceinline__ void ph_p4(Frame& F, int l, int c) { LAUNDER(F); asm volatile("" : "+s"(l), "+s"(c));
    pg8::DenseOrder S; S.init((const bf16*)(F.ws + WS_MERGED), D, (const bf16*)(F.ws + WS_WOUT) + (size_t)l * D * D, D, CH, D, F.G, (int)blockIdx.x);
    EpiP4 E{(const bf16*)(F.ws + WS_HB) + (size_t)c * CH * D, F.probe ? (bf16*)(F.ws + WS_OABC) : (bf16*)F.h + (size_t)c * CH * D};
    pg8::gemm_phase<EpiP4, pg8::DenseOrder, false>(F.lds + RING_OFF, S, E, D, D, D, F.tid);
}
__device__ __forceinline__ void ph_ln1(Frame& F, int l, int c) { LAUNDER(F); asm volatile("" : "+s"(l), "+s"(c));
    const int gw = F.vcu * NWAVES + F.wave, NGW = F.G * NWAVES;
    bf16* hb = (bf16*)(F.ws + WS_HB); Rec* rec = (Rec*)(F.ws + WS_REC);
    int* wgc = (int*)(F.ws + WS_WGCNT) + ((size_t)(l * NCHUNK + c) * F.G + F.vcu) * 32;
    if (F.probe) { hb = (bf16*)(F.ws + WS_QKV) - (size_t)c * CH * D; wgc = (int*)(F.ws + WS_WGCNT) + (size_t)DEPTH * NCHUNK * 256 * 32 + F.vcu * 32; rec = (Rec*)(F.ws + WS_GATES); }
    LAS float* lrg = (LAS float*)(F.lds + RING_OFF); LAS float* lre = lrg + D * 4; LAS int* lcnt = (LAS int*)(F.lds + LCNT_OFF);
    { const float* w_rg = F.in[14] + (size_t)l * D * 4; const float* w_re = F.in[16] + (size_t)l * 4 * D * 8;
      if (F.tid < 32) lcnt[F.tid] = 0;
      for (int u = F.tid; u < D + 4 * D * 2; u += NTHREADS) {
          if (u < D) { const int e = u, ln = (e & 511) >> 3, k = (e >> 9) * 8 + (e & 7); *(LAS f32x4*)(lrg + (k * 64 + ln) * 4) = *(const GAS f32x4*)(w_rg + (size_t)e * 4); }
          else { const int v = u - D, half = v & 1, e = (v >> 1) & 1023, g = v >> 11, ln = (e & 511) >> 3, k = (e >> 9) * 8 + (e & 7);
                 *(LAS f32x4*)(lre + g * (D * 8) + ((k * 2 + half) * 64 + ln) * 4) = *(const GAS f32x4*)(w_re + ((size_t)g * D + e) * 8 + half * 4); } }
      __syncthreads(); }
    f32x4 wg[16];
#pragma unroll
    for (int j = 0; j < 4; ++j)
#pragma unroll
        for (int i = 0; i < 4; ++i) wg[4 * j + i] = *(const LAS f32x4*)(lrg + ((j * 4 + i) * 64 + F.lane) * 4);
    const size_t rbase = (size_t)c * CH;
    const bf16* vsrc = (const bf16*)F.h;
    f32x4 gg[4], bb[4]; ln_params(gg, bb, F.in[12] + l * D, F.in[13] + l * D, F.lane);
    LnIn cur, nxt, nx2; if (gw < CH) ln_load<1>(cur, nullptr, vsrc, nullptr, rbase + gw, F.lane);
    if (gw + NGW < CH) ln_load<1>(nxt, nullptr, vsrc, nullptr, rbase + gw + NGW, F.lane);
    for (int m = gw; m < CH; m += NGW) {
        const bool more = m + NGW < CH, more2 = m + 2 * NGW < CH; if (more2) ln_load<1>(nx2, nullptr, vsrc, nullptr, rbase + m + 2 * NGW, F.lane);
        const size_t row = rbase + m; f32x4 o[4];
        ln_finish<1>(cur, nullptr, hb, gg, bb, row, F.lane, o);
        float x[16];
#pragma unroll
        for (int j = 0; j < 4; ++j) { x[4 * j] = o[j].x; x[4 * j + 1] = o[j].y; x[4 * j + 2] = o[j].z; x[4 * j + 3] = o[j].w; }
        router_row(x, (int)row, F.lane, wg, F.in[15] + l * 4, lre, F.in[17] + l * 32, lcnt, c * F.G + F.vcu, rec);
        if (more) { cur = nxt; nxt = nx2; }
    }
    __syncthreads();
    if (F.tid < 32) *(GAS int*)(wgc + F.tid) = lcnt[F.tid];
}
__device__ __forceinline__ void ph_dsp(Frame& F, int l) { LAUNDER(F); asm volatile("" : "+s"(l));
    LAS int* Tb = (LAS int*)(F.lds + RING_OFF); LAS int* part = Tb + 512 * 32; LAS int* po = part + 32 * 16;
    const int* wg = (const int*)(F.ws + WS_WGCNT) + (size_t)l * NCHUNK * F.G * 32; const int W = NCHUNK * F.G;
    int* cnt = (int*)(F.ws + WS_CTL) + CW_CNT + l * (32 * CSTR); const Rec* rec = (const Rec*)(F.ws + WS_REC); int* rowtok = (int*)(F.ws + WS_ROWTOK); float* rowgate = (float*)(F.ws + WS_ROWGATE);
    for (int i = F.tid; i < W * 32; i += NTHREADS) Tb[i] = *(const GAS int*)(wg + i);
    __syncthreads();
    const int e = F.tid >> 4, k = F.tid & 15, per = (W + 15) / 16, w0 = k * per, w1 = (w0 + per) < W ? (w0 + per) : W;
    { int s = 0; for (int w = w0; w < w1; ++w) s += Tb[w * 32 + e]; part[e * 16 + k] = s; }
    __syncthreads();
    { int base = 0; for (int kk = 0; kk < k; ++kk) base += part[e * 16 + kk];
      for (int w = w0; w < w1; ++w) { const int t = Tb[w * 32 + e]; Tb[w * 32 + e] = base; base += t; } }
    __syncthreads();
    LAS int* tot = po + 40;
    if (F.tid < NE) { int t_ = 0; for (int kk = 0; kk < 16; ++kk) t_ += part[F.tid * 16 + kk]; tot[F.tid] = t_; }
    __syncthreads();
    if (F.tid < NE) part[F.tid * 16] = tot[F.tid];
    if (F.tid == 0) { int acc = 0; for (int ee = 0; ee < NE; ++ee) { po[ee] = acc; acc += (tot[ee] + 255) / 256 * 256; } po[NE] = acc; }
    __syncthreads();
    if (F.vcu == 0 && F.tid < 32) cnt[F.tid * CSTR] = part[F.tid * 16];
    const int gt = F.vcu * NTHREADS + F.tid, GT = F.G * NTHREADS;
    for (int t = gt; t < T; t += GT) {
        const v4u ra = *((const GAS v4u*)rec + t);
        Rec rc; rc.g0 = __uint_as_float(ra.x); rc.g1 = __uint_as_float(ra.y); rc.e0 = (int)(ra.z & 255u); rc.e1 = (int)((ra.z >> 8) & 255u); rc.pad0 = (int)(ra.z >> 16); rc.s0 = (int)(ra.w & 0xffffu); rc.s1 = (int)(ra.w >> 16); rc.pad1 = 0;
        const int d0 = po[rc.e0] + Tb[rc.pad0 * 32 + rc.e0] + rc.s0, d1 = po[rc.e1] + Tb[rc.pad0 * 32 + rc.e1] + rc.s1;
        *(GAS unsigned*)(rowtok + d0) = ((unsigned)(2 * t) << 15) | ((unsigned)f2bf(rc.g0) & 0x7fffu); *(GAS unsigned*)(rowtok + d1) = ((unsigned)(2 * t + 1) << 15) | ((unsigned)f2bf(rc.g1) & 0x7fffu);
    }
    for (int ee = 0; ee < NE; ++ee) for (int r = po[ee] + part[ee * 16] + gt; r < po[ee + 1]; r += GT) { *(GAS int*)(rowtok + r) = -1; }
    __syncthreads();
}
__device__ __forceinline__ int moe_setup(Frame& F, int l, bool gather) { LAUNDER(F); asm volatile("" : "+s"(l));
    LAS int* rows = (LAS int*)(F.lds + ROWS_OFF); LAS int* ulist = rows + 11 * 256; LAS int* po = ulist + 16;
    const int* cnt = (const int*)(F.ws + WS_CTL) + CW_CNT + l * (32 * CSTR); const int* rowtok = (const int*)(F.ws + WS_ROWTOK);
    LAS int* tot = po + 40;
    if (F.tid < NE) tot[F.tid] = *(const GAS int*)(cnt + F.tid * CSTR);
    __syncthreads();
    if (F.tid == 0) { int acc = 0; for (int e = 0; e < NE; ++e) { po[e] = acc; acc += (tot[e] + 255) / 256 * 256; } po[NE] = acc; }
    __syncthreads();
    const int nu_all = (po[NE] / 256) * 4; int nun = (nu_all - F.vcu + F.G - 1) / F.G; nun = nun < 0 ? 0 : (nun > 11 ? 11 : nun);
    if (F.tid < nun) { const int Lx = F.tid * F.G + F.vcu, rt = Lx >> 2, pn = Lx & 3; int e = 0; while (e < NE - 1 && po[e + 1] <= rt * 256) ++e; ulist[F.tid] = (rt << 8) | (e << 2) | pn; }
    for (int idx = F.tid; idx < nun * 256; idx += NTHREADS) { const int i = idx >> 8, r = idx & 255, Lx = i * F.G + F.vcu; rows[idx] = *(const GAS int*)(rowtok + (Lx >> 2) * 256 + r); }
    __syncthreads();
    return nun;
}
struct MoeOrder {
    int nun; const LAS int* ulist; const LAS int* rows; const char* A; const char* B; size_t tstepA, estepB, tstepB;
    __device__ __forceinline__ bool next(int i, pg8::Unit& u) const {
        if (i >= nun) return false;
        const int w = __builtin_amdgcn_readfirstlane(ulist[i]); u.pm = w >> 8; u.e = (w >> 2) & 63; u.pn = w & 3; u.ui = i; return true;
    }
    __device__ __forceinline__ const char* a_base(const pg8::Unit& u) const { return A + (size_t)u.pm * tstepA; }
    __device__ __forceinline__ const char* b_base(const pg8::Unit& u) const { return B + (size_t)u.e * estepB + (size_t)u.pn * tstepB; }
    __device__ __forceinline__ int a_row(const pg8::Unit& u, int r) const { const int t = rows[u.ui * 256 + r]; return t == -1 ? 0 : (int)((unsigned)t >> 16); }
};
__device__ __forceinline__ void ph_p7(Frame& F, int l) { LAUNDER(F); asm volatile("" : "+s"(l));
    const int nun = moe_setup(F, l, true);
    LAS int* rows = (LAS int*)(F.lds + ROWS_OFF);
    MoeOrder S{nun, rows + 11 * 256, rows, (const char*)(F.ws + WS_HB), (const char*)(F.ws + WS_WGU) + (size_t)l * NE * 1024 * 1024 * 2, 0, (size_t)1024 * 1024 * 2, (size_t)256 * 1024 * 2};
    EpiP7 E{(bf16*)(F.ws + WS_HID)};
    pg8::gemm_phase<EpiP7, MoeOrder, true>(F.lds + RING_OFF, S, E, D, D, D, F.tid);
}
__device__ __forceinline__ void ph_p8(Frame& F, int l) { LAUNDER(F); asm volatile("" : "+s"(l));
    const int nun = moe_setup(F, l, false);
    LAS int* rows = (LAS int*)(F.lds + ROWS_OFF);
    MoeOrder S{nun, rows + 11 * 256, rows, (const char*)(F.ws + WS_HID), (const char*)(F.ws + WS_WD) + (size_t)l * NE * 1024 * 512 * 2, (size_t)256 * DE * 2, (size_t)1024 * 512 * 2, (size_t)256 * 512 * 2};
    EpiP8 E{(bf16*)(F.ws + WS_YB), rows};
    pg8::gemm_phase<EpiP8, MoeOrder, false>(F.lds + RING_OFF, S, E, DE, DE, DE, F.tid);
}
__device__ __forceinline__ void ph_ln2(Frame& F, int l) { LAUNDER(F); asm volatile("" : "+s"(l));
    const int gw = F.vcu * NWAVES + F.wave, NGW = F.G * NWAVES;
    const bool lastl = (l == DEPTH - 1);
    const bf16* hsb = (const bf16*)(F.ws + WS_HB); const bf16* yb = (const bf16*)(F.ws + WS_YB);
    bf16* hb = lastl ? nullptr : (bf16*)(F.ws + WS_HB); float* hout = lastl ? F.h : nullptr; size_t omask = ~(size_t)0;
    if (F.probe) { hout = lastl ? (float*)(F.ws + WS_OABC) : nullptr; hb = lastl ? nullptr : (bf16*)(F.ws + WS_OABC); omask = 32767; }
    f32x4 gg[4], bb[4]; ln_params(gg, bb, F.in[21] + l * D, F.in[22] + l * D, F.lane);
    LnIn cur, nxt, nx2; if (gw < T) ln_load<2>(cur, nullptr, hsb, yb, (size_t)gw, F.lane);
    if (gw + NGW < T) ln_load<2>(nxt, nullptr, hsb, yb, (size_t)(gw + NGW), F.lane);
    for (int m = gw; m < T; m += NGW) { const bool more = m + NGW < T, more2 = m + 2 * NGW < T; if (more2) ln_load<2>(nx2, nullptr, hsb, yb, (size_t)(m + 2 * NGW), F.lane);
        const size_t back = ((size_t)m - ((size_t)m & omask)) * D;
        f32x4 o[4]; ln_finish<2>(cur, hout ? hout - back : nullptr, hb ? hb - back : nullptr, gg, bb, (size_t)m, F.lane, o); if (more) { cur = nxt; nxt = nx2; } }
}

typedef short s16x4 __attribute__((ext_vector_type(4)));
constexpr int NT_A = (CH / 32) * 4, NT_B = (CH / L) * 3 * 128 * 4, NT_C = (CH / 64) * 8, NT_ALL = NT_A + NT_B + NT_C;
constexpr float NEGBIG = -1.0e30f, MINIT = -5.0e29f;
#define RC16(reg) (((reg) & 3) + 8 * ((reg) >> 2))
#define QPLANE(col) ((size_t)((col) >> 6) * ((size_t)CH * 64))

__device__ __forceinline__ void ph_tables(Frame& F) { LAUNDER(F);
    float* TA = (float*)(F.ws + WS_TABA); float* TB = (float*)(F.ws + WS_TABB); float* TC = (float*)(F.ws + WS_TABC);
    const float* rel_bias = F.in[3]; const float* rpb = F.in[7];
    const int gt = F.vcu * NTHREADS + F.tid, GT = F.G * NTHREADS;
    for (int i = gt; i < 8 * 320; i += GT) { const int h = i / 320, rel = i % 320 - 160; *(GAS float*)(TA + i) = (rel >= -128 && rel <= 128) ? rel_bias[BUCK_A[rel + 128] * 20 + h] * LOG2E : NEGBIG; }
    for (int i = gt; i < 12 * 256; i += GT) { const int gh = i >> 8, g = gh >> 2, rel = (i & 255) - 128; *(GAS float*)(TB + i) = (rel >= -64 && rel <= 64) ? rel_bias[BUCK_B[g][rel + 64] * 20 + 8 + gh] * LOG2E : NEGBIG; }
    for (int i = gt; i < DEPTH * 8 * 1024; i += GT) { const int lh = i >> 10, ri = (i >> 6) & 15, ci = (i & 63) - 16; *(GAS float*)(TC + i) = (ri < 15 && ci >= 0 && ci <= 30) ? rpb[((size_t)lh * 15 + ri) * 31 + ci] * LOG2E : NEGBIG; }
}

#define ATT_INIT(S, TBP, BIDX, XM) do { \
        _Pragma("unroll") for (int r_ = 0; r_ < 16; ++r_) { float v_ = (TBP)[(BIDX) + RC16(r_)]; if (TYPE == 2) v_ = ((unsigned)((XM) + RC16(r_)) < 16u) ? v_ : NEGBIG; S[r_] = v_; } } while (0)
__device__ __forceinline__ float xhalf_max(float t) { float a_ = t, b_ = t; asm volatile("s_nop 1\n\tv_permlane32_swap_b32 %0, %1" : "+v"(a_), "+v"(b_)); return fmaxf(a_, b_); }
__device__ __forceinline__ float xhalf_sum(float t) { float a_ = t, b_ = t; asm volatile("s_nop 1\n\tv_permlane32_swap_b32 %0, %1" : "+v"(a_), "+v"(b_)); return a_ + b_; }
#define ATT_TMAX(S, t) do { t = NEGBIG; _Pragma("unroll") for (int r_ = 0; r_ < 16; ++r_) t = fmaxf(t, S[r_]); } while (0)
#define ATT_RESCALE(need, t, m, l, Oa, Ob) do { const float mn_ = (need) ? (t) : m, corr_ = __builtin_amdgcn_exp2f(m - mn_); m = mn_; l *= corr_; \
        _Pragma("unroll") for (int i_ = 0; i_ < 16; ++i_) { Oa[i_] *= corr_; Ob[i_] *= corr_; } } while (0)
#define ATT_EXP(S, m, rs) do { rs = 0.f; _Pragma("unroll") for (int r_ = 0; r_ < 16; ++r_) { const float p_ = __builtin_amdgcn_exp2f(S[r_] - m); S[r_] = p_; rs += p_; } } while (0)
#define ATT_PACK(Pf, S, s2) do { unsigned pw_[4]; _Pragma("unroll") for (int j_ = 0; j_ < 4; ++j_) pw_[j_] = pg8::cvt_pk_bf16(S[8 * (s2) + 2 * j_], S[8 * (s2) + 2 * j_ + 1]); \
        Pf = __builtin_bit_cast(bf16x8, (v4u){pw_[0], pw_[1], pw_[2], pw_[3]}); } while (0)
__device__ __forceinline__ void swap32(unsigned& a, unsigned& b) { asm volatile("s_nop 1\n\tv_permlane32_swap_b32 %0, %1" : "+v"(a), "+v"(b)); }
#define ATT_STAGE(st, Oa, Ob, l) do { const float inv_ = 1.0f / (l); const unsigned sb_ = (unsigned)(qi * 128); \
        _Pragma("unroll") for (int gp_ = 0; gp_ < 2; ++gp_) { \
            unsigned a0_ = pg8::cvt_pk_bf16(Oa[8 * gp_] * inv_, Oa[8 * gp_ + 1] * inv_), a1_ = pg8::cvt_pk_bf16(Oa[8 * gp_ + 2] * inv_, Oa[8 * gp_ + 3] * inv_); \
            unsigned b0_ = pg8::cvt_pk_bf16(Oa[8 * gp_ + 4] * inv_, Oa[8 * gp_ + 5] * inv_), b1_ = pg8::cvt_pk_bf16(Oa[8 * gp_ + 6] * inv_, Oa[8 * gp_ + 7] * inv_); \
            swap32(a0_, b0_); swap32(a1_, b1_); \
            *(LAS v4u*)((st) + sb_ + ((unsigned)((2 * gp_ + hh) ^ (qi & 7)) << 4)) = (v4u){a0_, a1_, b0_, b1_}; \
            unsigned c0_ = pg8::cvt_pk_bf16(Ob[8 * gp_] * inv_, Ob[8 * gp_ + 1] * inv_), c1_ = pg8::cvt_pk_bf16(Ob[8 * gp_ + 2] * inv_, Ob[8 * gp_ + 3] * inv_); \
            unsigned d0_ = pg8::cvt_pk_bf16(Ob[8 * gp_ + 4] * inv_, Ob[8 * gp_ + 5] * inv_), d1_ = pg8::cvt_pk_bf16(Ob[8 * gp_ + 6] * inv_, Ob[8 * gp_ + 7] * inv_); \
            swap32(c0_, d0_); swap32(c1_, d1_); \
            *(LAS v4u*)((st) + sb_ + ((unsigned)((4 + 2 * gp_ + hh) ^ (qi & 7)) << 4)) = (v4u){c0_, c1_, d0_, d1_}; } } while (0)
#define ATT_FLUSH(st, ob, tqs) do { \
        _Pragma("unroll") for (int i_ = 0; i_ < 4; ++i_) { const int r_ = (lane >> 3) + 8 * i_, c_ = lane & 7; \
            const v4u v_ = *(const LAS v4u*)((st) + (unsigned)(r_ * 128) + ((unsigned)(c_ ^ (r_ & 7)) << 4)); \
            *(GAS v4u*)((ob) + (size_t)((tqs) + ATT_LTOK(r_)) * ostr + c_ * 8) = v_; } } while (0)

template <int TYPE>
__device__ __forceinline__ void att_task2(LAS unsigned char* wl, const int lane, const bf16* seq  , const float* tab0, const float* tab1,
                                          const int qcol0, const int qcol1, const int kcol, const int vcol, const int TT0, const int TSTEP, const int kstride, const int tlo, const int thi,
                                          const int tqs0, const int tqs1  , const int toff1  ,
                                          const int gi0, const int gi1, const int gc, const int cbs  ,
                                          const float m_init0, const float m_init1, const float l_init, bf16* ob0, bf16* ob1, const int ostr, float* lb  , const int grp  , const bool load_tab) {
    const int qi = lane & 31, hh = lane >> 5;
#define ATT_LTOK(q_) (TYPE == 2 ? (((q_) >> 4) * 64 + ((q_) & 15)) : (q_) * (TYPE == 1 ? kstride : 1))
    const int tq0 = tqs0 + ATT_LTOK(qi), tq1 = tqs1 + ATT_LTOK(qi);
    LAS unsigned char* kt = wl; LAS unsigned char* vt = wl + 4096; LAS float* tbl = (LAS float*)(wl + 8192); LAS float* tb0 = (TYPE == 1) ? tbl + grp * 256 : tbl; LAS float* tb1 = (TYPE == 0) ? tb0 + 320 : tb0;
    constexpr int TBN = TYPE == 0 ? 320 : (TYPE == 1 ? 256 : 1024);
    if (load_tab) {
#pragma unroll
        for (int i = 0; i < TBN / 64; ++i) { tbl[lane + 64 * i] = *(const GAS float*)(tab0 + lane + 64 * i); if (TYPE == 0) tb1[lane + 64 * i] = *(const GAS float*)(tab1 + lane + 64 * i);
            if (TYPE == 1) { tbl[256 + lane + 64 * i] = *(const GAS float*)(tab0 + 1024 + lane + 64 * i); tbl[512 + lane + 64 * i] = *(const GAS float*)(tab0 + 2048 + lane + 64 * i); } } }
    bf16x8 Qa[4], Qb[4];
#pragma unroll
    for (int s = 0; s < 4; ++s) { Qa[s] = *(const GAS bf16x8*)(seq + QPLANE(qcol0) + (size_t)tq0 * 64 + 16 * s + 8 * hh); Qb[s] = *(const GAS bf16x8*)(seq + QPLANE(qcol1) + (size_t)tq1 * 64 + 16 * s + 8 * hh); }
    f32x16 O0a, O0b, O1a, O1b;
#pragma unroll
    for (int i = 0; i < 16; ++i) { O0a[i] = 0.f; O0b[i] = 0.f; O1a[i] = 0.f; O1b[i] = 0.f; }
    float m0 = m_init0, m1 = m_init1, l0 = l_init, l1 = l_init;
    const int lkey = lane >> 3, lch = lane & 7;
    const unsigned goff = (unsigned)(lkey * kstride) * 128u + 16u * (unsigned)lch;
    const size_t istepb = (size_t)8 * kstride * 128;
    const char* kbase = (const char*)(seq + QPLANE(kcol)); const char* vbase = (const char*)(seq + QPLANE(vcol));
    const unsigned kw0 = lkey * 128 + ((lch ^ (lkey & 7)) << 4), vw0 = lkey * 128 + (((lch >> 2) ^ ((lkey >> 1) & 1)) << 6) + ((lch & 3) << 4);
    const unsigned kr0 = qi * 128 + ((hh ^ (qi & 7)) << 4);
    const int q4 = (lane & 15) >> 2, p4 = lane & 3, g1 = (lane >> 4) & 1, sw = (q4 >> 1) & 1;
    const unsigned vr0 = (4 * hh + q4) * 128 + 32 * g1 + 8 * p4 + (sw << 6), vr1 = (4 * hh + q4) * 128 + 32 * g1 + 8 * p4 + ((sw ^ 1) << 6);
    const int bidx0 = (TYPE == 2) ? (cbs - gc + 31 + 4 * hh) : ((TYPE == 1 ? 64 : 32) - qi + 4 * hh);
    int cs = gc - 8; cs = cs < 0 ? 0 : (cs > 48 ? 48 : cs);
    const int xm = cbs - cs + 4 * hh;
    int rs0 = gi0 - 4; rs0 = rs0 < 0 ? 0 : (rs0 > 120 ? 120 : rs0);
    int rs1 = gi1 - 4; rs1 = rs1 < 0 ? 0 : (rs1 > 120 ? 120 : rs1);
    v4u kreg[4], vreg[4];
    {
        const size_t tb_ = (size_t)(TT0 + tlo * TSTEP) * 128;
#pragma unroll
        for (int i = 0; i < 4; ++i) { kreg[i] = *(const GAS v4u*)(kbase + tb_ + i * istepb + goff); vreg[i] = *(const GAS v4u*)(vbase + tb_ + i * istepb + goff); }
    }
    for (int ti = tlo; ti <= thi; ++ti) {
#pragma unroll
        for (int i = 0; i < 4; ++i) { *(LAS v4u*)(kt + kw0 + 1024 * i) = kreg[i]; *(LAS v4u*)(vt + vw0 + 1024 * i) = vreg[i]; }
        if (ti < thi) {
            const size_t tb_ = (size_t)(TT0 + (ti + 1) * TSTEP) * 128;
#pragma unroll
            for (int i = 0; i < 4; ++i) { kreg[i] = *(const GAS v4u*)(kbase + tb_ + i * istepb + goff); vreg[i] = *(const GAS v4u*)(vbase + tb_ + i * istepb + goff); }
        }
        int bi0, bi1;
        if (TYPE == 2) { const bool rv0 = (ti >= rs0) && (ti < rs0 + 8), rv1 = (ti >= rs1) && (ti < rs1 + 8); bi0 = bidx0 + (rv0 ? (ti - gi0 + 7) : 15) * 64; bi1 = bidx0 + (rv1 ? (ti - gi1 + 7) : 15) * 64; }
        else { bi0 = bidx0 + 32 * ti; bi1 = bidx0 + 32 * (ti - toff1); }
        f32x16 S0, S1;
        ATT_INIT(S0, tb0, bi0, xm); ATT_INIT(S1, tb1, bi1, xm);
#pragma unroll
        for (int s = 0; s < 4; ++s) { const bf16x8 Kf = *(const LAS bf16x8*)(kt + (kr0 ^ (unsigned)(s << 5)));
            S0 = __builtin_amdgcn_mfma_f32_32x32x16_bf16(Kf, Qa[s], S0, 0, 0, 0); S1 = __builtin_amdgcn_mfma_f32_32x32x16_bf16(Kf, Qb[s], S1, 0, 0, 0); }
        float t0, t1; ATT_TMAX(S0, t0); ATT_TMAX(S1, t1);
        t0 = xhalf_max(t0); t1 = xhalf_max(t1);
        const bool need0 = t0 > m0 + 8.0f, need1 = t1 > m1 + 8.0f;
        if (__builtin_amdgcn_ballot_w64(need0 || need1) != 0ull) { ATT_RESCALE(need0, t0, m0, l0, O0a, O0b); ATT_RESCALE(need1, t1, m1, l1, O1a, O1b); }
        float rs0, rs1; ATT_EXP(S0, m0, rs0); ATT_EXP(S1, m1, rs1);
        rs0 = xhalf_sum(rs0); rs1 = xhalf_sum(rs1);
        l0 += rs0; l1 += rs1;
#pragma unroll
        for (int s2 = 0; s2 < 2; ++s2) {
            bf16x8 P0, P1; ATT_PACK(P0, S0, s2); ATT_PACK(P1, S1, s2);
            const s16x4 a00 = __builtin_amdgcn_ds_read_tr16_b64_v4i16((LAS s16x4*)(vt + vr0 + (16 * s2) * 128));
            const s16x4 a01 = __builtin_amdgcn_ds_read_tr16_b64_v4i16((LAS s16x4*)(vt + vr0 + (16 * s2 + 8) * 128));
            const s16x4 a10 = __builtin_amdgcn_ds_read_tr16_b64_v4i16((LAS s16x4*)(vt + vr1 + (16 * s2) * 128));
            const s16x4 a11 = __builtin_amdgcn_ds_read_tr16_b64_v4i16((LAS s16x4*)(vt + vr1 + (16 * s2 + 8) * 128));
            const bf16x8 V0 = (bf16x8){a00[0], a00[1], a00[2], a00[3], a01[0], a01[1], a01[2], a01[3]};
            const bf16x8 V1 = (bf16x8){a10[0], a10[1], a10[2], a10[3], a11[0], a11[1], a11[2], a11[3]};
            O0a = __builtin_amdgcn_mfma_f32_32x32x16_bf16(V0, P0, O0a, 0, 0, 0); O0b = __builtin_amdgcn_mfma_f32_32x32x16_bf16(V1, P0, O0b, 0, 0, 0);
            O1a = __builtin_amdgcn_mfma_f32_32x32x16_bf16(V0, P1, O1a, 0, 0, 0); O1b = __builtin_amdgcn_mfma_f32_32x32x16_bf16(V1, P1, O1b, 0, 0, 0);
        }
    }
    ATT_STAGE(kt, O0a, O0b, l0); ATT_STAGE(vt, O1a, O1b, l1);
    ATT_FLUSH(kt, ob0, tqs0); ATT_FLUSH(vt, ob1, tqs1);
    if (TYPE == 1 && hh == 0) { *(GAS float*)(lb + (size_t)tq0 * 12) = (m0 + __builtin_amdgcn_logf(l0)) * LN2; *(GAS float*)(lb + (size_t)tq1 * 12) = (m1 + __builtin_amdgcn_logf(l1)) * LN2; }
#undef ATT_LTOK
}

__device__ __forceinline__ void att_tasks(Frame& F, int l, const int t_lo, const int t_hi) {
    LAS unsigned char* wl = F.lds + RING_OFF + F.wave * 16384;
    const bf16* qkv = (const bf16*)(F.ws + WS_QKV); bf16* oabc = (bf16*)(F.ws + WS_OABC); bf16* og = (bf16*)(F.ws + WS_OG); float* lse = (float*)(F.ws + WS_LSE);
    const float* TA = (const float*)(F.ws + WS_TABA); const float* TB = (const float*)(F.ws + WS_TABB); const float* TC = (const float*)(F.ws + WS_TABC) + (size_t)l * 8 * 1024;
    const float* sink = F.in[6] + l * 8;
    const int gw = F.vcu * NWAVES + F.wave, NGW = F.G * NWAVES;
    const float* last_tab = nullptr;
    for (int task = t_lo + gw; task < t_hi; task += NGW) {
        int lane = F.lane; asm volatile("" : "+v"(lane)); const int qi = lane & 31;
        if (task < NT_A) {
            const int hp = task & 3, qb = (task >> 2) & 255, b = task >> 10, q0 = qb * 32, h0 = hp * 2, h1 = h0 + 1, kvh = hp >> 1;
            int tlo = 0, thi = 8; if (q0 - 128 < 0) tlo = (128 - q0) / 32; if (q0 + 128 + 31 >= L) thi = (L - 1 - (q0 - 128)) / 32;
            bf16* orow = oabc + (size_t)(b * L) * OW;
            att_task2<0>(wl, lane, qkv + (size_t)b * L * 64, TA + h0 * 320, TA + h1 * 320, AQ + h0 * 64, AQ + h1 * 64, AK + kvh * 64, AV + kvh * 64, q0 - 128, 32, 1, tlo, thi,
                         q0, q0, 0, 0, 0, 0, 0, sink[h0] * LOG2E, sink[h1] * LOG2E, 1.0f, orow + h0 * 64, orow + h1 * 64, OW, nullptr, 0, last_tab != TA + h0 * 320); last_tab = TA + h0 * 320;
        } else if (task < NT_A + NT_B) {
            const int j = task - NT_A, h = j & 3, sbi = (j >> 2) & 127, bg = j >> 9, b = (bg * 11) >> 5  , g = bg - 3 * b;
            const int dsh = 2 * g, d = 1 << dsh, nsb = 128 >> dsh, r = sbi >> (7 - dsh), sb = sbi & (nsb - 1), q0 = sb * 64, Ls = L >> dsh;
            int tlo = 0, thi = 5; if (q0 - 64 < 0) tlo = (64 - q0) / 32; if (q0 + 32 + 64 + 31 >= Ls) thi = (Ls - 1 - (q0 - 64)) / 32;
            const int qc = BQ0 + 768 * g + h * 64; bf16* ogb = og + ((size_t)(b * L) * 3 + g) * 256 + h * 64;
            att_task2<1>(wl, lane, qkv + (size_t)b * L * 64, TB + h * 256, nullptr, qc, qc, qc + 256, qc + 512, (q0 - 64) * d + r, 32 * d, d, tlo, thi,
                         q0 * d + r, (q0 + 32) * d + r, 1, 0, 0, 0, 0, MINIT, MINIT, 0.0f, ogb, ogb, 768,
                         lse + ((size_t)(b * L) * 3 + g) * 4 + h, g, last_tab != TB + h * 256); last_tab = TB + h * 256;
        } else {
            const int j = task - NT_A - NT_B, h = j & 7, cbi = (j >> 3) & 127, b = j >> 10, ip = cbi >> 2, cb = cbi & 3;
            const int gi0 = 4 * ip + (qi >> 4), gi1 = gi0 + 2, gc = 16 * cb + (qi & 15), tqs = 4 * ip * 64 + 16 * cb;
            int cbs = 16 * cb - 8; cbs = cbs < 0 ? 0 : (cbs > 32 ? 32 : cbs);
            int rlo = 4 * ip - 4; rlo = rlo < 0 ? 0 : (rlo > 120 ? 120 : rlo);
            int rhi = 4 * ip + 3 - 4; rhi = rhi < 0 ? 0 : (rhi > 120 ? 120 : rhi); rhi += 7;
            bf16* ob = oabc + (size_t)(b * L) * OW + 768 + h * 64;
            att_task2<2>(wl, lane, qkv + (size_t)b * L * 64, TC + h * 1024, nullptr, CQ + h * 64, CQ + h * 64, CK + h * 64, CV + h * 64, cbs, 64, 1, rlo, rhi,
                         tqs, tqs + 128, 0, gi0, gi1, gc, cbs, MINIT, MINIT, 0.0f, ob, ob, OW, nullptr, 0, last_tab != TC + h * 1024); last_tab = TC + h * 1024;
        }
    }
}
template <class Bar> __device__ __forceinline__ void ph_att(Frame& F, int l, const Bar& bar, const bool fused) { LAUNDER(F); asm volatile("" : "+s"(l));
    att_tasks(F, l, NT_A, NT_A + NT_B);
    if (fused) { xcd_barrier(bar); ph_cmb(F); }
    att_tasks(F, l, 0, NT_A);
    att_tasks(F, l, NT_A + NT_B, NT_ALL);
}

constexpr int NSTEPS = 1 + DEPTH * 16;
__global__ void __launch_bounds__(NTHREADS, 2) mk_fwd(Args args) {
    extern __shared__ __attribute__((aligned(16))) unsigned char lds[];
    Frame F;
    F.lds = (LAS unsigned char*)lds; F.wave = __builtin_amdgcn_readfirstlane((int)threadIdx.x >> 6); F.lane = hw_lane(); F.tid = F.wave * 64 + F.lane;
    F.G = gridDim.x; { const int bx = blockIdx.x; F.vcu = (F.G % 8 == 0) ? (bx % 8) * (F.G / 8) + bx / 8 : bx; }
    F.in = args.in; F.h = args.out; F.ws = args.ws; F.probe = args.probe;
    volatile LAS unsigned* MISC = (volatile LAS unsigned*)(F.lds + MISC_OFF);
    if (F.tid < 32) MISC[F.tid] = 0u;
    __syncthreads();
    const int lo = args.s_lo, hi = args.s_hi;
    XcdBarrier bar; bar.wave0 = (F.wave == 0); bar.bar = (unsigned*)(F.ws + WS_CTL) + CW_BAR; bar.x = 0; bar.st = nullptr;
    if (hi - lo > 1) bar = xcd_barrier_post((unsigned*)(F.ws + WS_CTL) + CW_BAR, MISC + 8, F.wave == 0);
#define RUN(s) (lo <= (s) && (s) < hi)
#define SEAM(s) do { if (RUN(s) && RUN((s) + 1)) xcd_barrier(bar); } while (0)
    if (RUN(0)) { ph_prologue(F); ph_tables(F); ph_ln0(F); }
    SEAM(0);
    for (int l = 0; l < DEPTH; ++l) {
        const int sb = 1 + l * 16;
        for (int c = 0; c < NCHUNK; ++c) {
            const int s = sb + c * 6;
            if (RUN(s)) ph_p1(F, l, c);
            SEAM(s);
            const bool att_fused = RUN(s + 1) && RUN(s + 2);
            if (RUN(s + 1)) ph_att(F, l, bar, att_fused);
            if (!att_fused) { SEAM(s + 1); if (RUN(s + 2)) ph_cmb(F); }
            SEAM(s + 2);
            if (RUN(s + 3)) ph_p3(F, l);
            SEAM(s + 3);
            if (RUN(s + 4)) ph_p4(F, l, c);
            SEAM(s + 4);
            if (RUN(s + 5)) ph_ln1(F, l, c);
            if (c == NCHUNK - 1) SEAM(s + 5);
        }
        if (RUN(sb + 12)) ph_dsp(F, l);
        SEAM(sb + 12);
        if (RUN(sb + 13)) ph_p7(F, l);
        SEAM(sb + 13);
        if (RUN(sb + 14)) ph_p8(F, l);
        SEAM(sb + 14);
        if (RUN(sb + 15)) ph_ln2(F, l);
        SEAM(sb + 15);
    }
#undef RUN
#undef SEAM
}

extern "C" void kernel_launch(void* const* d_in, const int* in_sizes, int n_in, void* d_out, int out_size, void* d_ws, size_t ws_size, hipStream_t stream) {
    static int grid = 0;
    if (grid == 0) {
        if (n_in != 23 || out_size != T * D || ws_size < WS_END) { fprintf(stderr, "kernel_launch: unexpected shapes (n_in %d out %d ws %zu)\n", n_in, out_size, ws_size); grid = -1; return; }
        int dev = 0, cus = 0, per_cu = 0;
        if (hipGetDevice(&dev) != hipSuccess || hipDeviceGetAttribute(&cus, hipDeviceAttributeMultiprocessorCount, dev) != hipSuccess) { grid = -1; return; }
        if (hipFuncSetAttribute((const void*)mk_fwd, hipFuncAttributeMaxDynamicSharedMemorySize, LDS_BYTES) != hipSuccess) { fprintf(stderr, "kernel_launch: hipFuncSetAttribute failed\n"); grid = -1; return; }
        if (hipOccupancyMaxActiveBlocksPerMultiprocessor(&per_cu, (const void*)mk_fwd, NTHREADS, LDS_BYTES) != hipSuccess || per_cu < 1) fprintf(stderr, "kernel_launch: occupancy query reports %d\n", per_cu);
        (void)hipGetLastError();
        grid = cus > 256 ? 256 : cus;
    }
    if (grid < 0) return;
    (void)hipMemsetAsync((unsigned char*)d_ws + WS_CTL, 0, CTL_ZERO_BYTES, stream);
    Args a{};
    for (int i = 0; i < 23; ++i) a.in[i] = (const float*)d_in[i];
    a.out = (float*)d_out; a.ws = (unsigned char*)d_ws; a.s_lo = 0; a.s_hi = NSTEPS; a.probe = 0; a.pad = 0;
    hipLaunchKernelGGL(mk_fwd, dim3(grid), dim3(NTHREADS), LDS_BYTES, stream, a);
}
```

```cpp
#include <hip/hip_runtime.h>
#include <cstdio>
#include <cstdint>
#include <cmath>

typedef unsigned short bf16;
typedef short bf16x8 __attribute__((ext_vector_type(8)));
typedef float f32x16 __attribute__((ext_vector_type(16)));
typedef float f32x4 __attribute__((ext_vector_type(4)));

constexpr int D = 1024, L = 8192, NBATCH = 8, T = NBATCH * L, DEPTH = 2;
constexpr int NCOL = 7680, QKVW = 4608, GATEW = 3072;
constexpr int CH = 32768, NCHUNK = T / CH;
constexpr int OW = 1280;
constexpr int NE = 32, DE = 512;
constexpr int MAXRT = T * 2 / 256 + NE, PROWS = MAXRT * 256;
constexpr float LN_EPS = 1e-5f;
constexpr float ALPHA = 1.41421356237309515f;
constexpr int AQ = 0, AK = 512, AV = 640, BQ0 = 768, CQ = 3072, CK = 3584, CV = 4096;

constexpr size_t MiB = 1u << 20;
constexpr size_t WS_CTL = 0;
constexpr size_t WS_WIN = 1 * MiB, WS_WBRA = 31 * MiB, WS_WBRB = 33 * MiB, WS_WBRC = 34 * MiB, WS_WOUT = 36 * MiB, WS_WGU = 40 * MiB, WS_WD = 168 * MiB;
constexpr size_t WS_HB = 232 * MiB, WS_QKV = 360 * MiB, WS_GATES = 648 * MiB, WS_OABC = 840 * MiB, WS_OG = 920 * MiB, WS_LSE = 968 * MiB,
                 WS_REC = 970 * MiB, WS_ROWTOK = 972 * MiB, WS_ROWGATE = 973 * MiB, WS_TABA = 974 * MiB, WS_TABB = WS_TABA + 16384, WS_TABC = WS_TABA + 32768, WS_WGCNT = WS_TABA + 131072  , WS_END = 975 * MiB;
constexpr size_t WS_MERGED = WS_QKV, WS_HID = WS_QKV, WS_YB = WS_QKV + 136 * MiB;
constexpr int CSTR = 32;

__device__ __constant__ signed char BUCK_A[257] = {12,11,11,11,11,11,11,11,11,11,11,11,11,11,11,11,11,11,11,11,11,11,11,11,11,11,11,11,11,11,11,11,11,11,11,11,11,11,11,11,11,11,11,11,11,11,11,11,11,11,11,11,11,11,11,11,11,11,11,11,11,11,11,11,11,10,10,10,10,10,10,10,10,10,10,10,10,10,10,10,10,10,10,10,10,10,10,10,10,10,10,10,10,10,10,10,10,9,9,9,9,9,9,9,9,9,9,9,9,9,9,9,9,8,8,8,8,8,8,8,8,7,6,5,4,3,2,1,0,17,18,19,20,21,22,23,24,24,24,24,24,24,24,24,25,25,25,25,25,25,25,25,25,25,25,25,25,25,25,25,26,26,26,26,26,26,26,26,26,26,26,26,26,26,26,26,26,26,26,26,26,26,26,26,26,26,26,26,26,26,26,26,27,27,27,27,27,27,27,27,27,27,27,27,27,27,27,27,27,27,27,27,27,27,27,27,27,27,27,27,27,27,27,27,27,27,27,27,27,27,27,27,27,27,27,27,27,27,27,27,27,27,27,27,27,27,27,27,27,27,27,27,27,27,27,27,28};
__device__ __constant__ signed char BUCK_B[3][129] = {
 {11,10,10,10,10,10,10,10,10,10,10,10,10,10,10,10,10,10,10,10,10,10,10,10,10,10,10,10,10,10,10,10,10,9,9,9,9,9,9,9,9,9,9,9,9,9,9,9,9,8,8,8,8,8,8,8,8,7,6,5,4,3,2,1,0,17,18,19,20,21,22,23,24,24,24,24,24,24,24,24,25,25,25,25,25,25,25,25,25,25,25,25,25,25,25,25,26,26,26,26,26,26,26,26,26,26,26,26,26,26,26,26,26,26,26,26,26,26,26,26,26,26,26,26,26,26,26,26,27},
 {13,12,12,12,12,12,12,12,12,12,12,12,12,12,12,12,12,12,12,12,12,12,12,12,12,12,12,12,12,12,12,12,12,11,11,11,11,11,11,11,11,11,11,11,11,11,11,11,11,10,10,10,10,10,10,10,10,9,9,9,9,8,8,4,0,20,24,24,25,25,25,25,26,26,26,26,26,26,26,26,27,27,27,27,27,27,27,27,27,27,27,27,27,27,27,27,28,28,28,28,28,28,28,28,28,28,28,28,28,28,28,28,28,28,28,28,28,28,28,28,28,28,28,28,28,28,28,28,29},
 {15,14,14,14,14,14,14,14,14,14,14,14,14,14,14,14,14,14,14,14,14,14,14,14,14,14,14,14,14,14,14,14,14,13,13,13,13,13,13,13,13,13,13,13,13,13,13,13,13,12,12,12,12,12,12,12,12,11,11,11,11,10,10,9,0,25,26,26,27,27,27,27,28,28,28,28,28,28,28,28,29,29,29,29,29,29,29,29,29,29,29,29,29,29,29,29,30,30,30,30,30,30,30,30,30,30,30,30,30,30,30,30,30,30,30,30,30,30,30,30,30,30,30,30,30,30,30,30,31}};

__device__ __forceinline__ float bf2f(bf16 b) { return __uint_as_float(((unsigned)b) << 16); }
__device__ __forceinline__ bf16 f2bf(float f) { unsigned u = __float_as_uint(f); u += 0x7fffu + ((u >> 16) & 1u); return (bf16)(u >> 16); }
__device__ __forceinline__ float wave_sum(float v) {
#pragma unroll
    for (int o = 1; o < 64; o <<= 1) v += __shfl_xor(v, o);
    return v;
}

struct Rec { int e0, s0, e1, s1; float g0, g1; int pad0, pad1; };

#ifndef PG8_ALIGN
#define PG8_ALIGN 1
#endif
namespace pg8 {
#define PG8_LAS __attribute__((address_space(3)))
typedef unsigned short bf16_t;
typedef unsigned u32x4 __attribute__((ext_vector_type(4)));
constexpr int BM = 256, BK = 64, HALF = 128, HTB = HALF * BK * 2  , STAGE_BYTES = 8 * HTB, NXCD = 8, WGM = 4;

__host__ __device__ __forceinline__ int lds_byte(int r, int c) { const int st = (r >> 4) * 2 + (c >> 5), rr = r & 15, cc = c & 31, ob = rr * 64 + cc * 2; return st * 1024 + (ob ^ (((ob >> 9) & 1) << 5)); }
__host__ __device__ __forceinline__ void stage_rc(int b, int& R, int& C) { const int st = b / 1024, sb = b % 1024, swz = sb ^ (((sb >> 9) & 1) << 5); R = (st >> 1) * 16 + swz / 64; C = (st & 1) * 32 + (swz % 64) / 2; }
__host__ __device__ __forceinline__ int perm_adj(int r) { return 16 * ((r >> 2) & 3) + 4 * (r >> 4) + (r & 3); }
__host__ __device__ __forceinline__ int perm32(int rho) { const int n = rho >> 4, i = rho & 15; return 8 * (i >> 2) + 4 * n + (i & 3); }

struct Unit { int pm, pn, e, ui; };

struct DenseOrder {
    int nM, nN, nwg, G, c; const char* A; const char* B; size_t tstepA, tstepB;
    __device__ void init(const void* A_, int lda, const void* B_, int ldb, int M, int N, int G_, int c_) { nM = M / BM; nN = N / BM; nwg = nM * nN; G = G_; c = c_; A = (const char*)A_; B = (const char*)B_; tstepA = (size_t)BM * lda * 2; tstepB = (size_t)BM * ldb * 2; }
    __device__ bool next(int i, Unit& u) const {
        const long Lx = (long)i * G + c; if (Lx >= nwg) return false;
        int wgid = (int)Lx; { const int q = nwg / NXCD, r = nwg % NXCD, xcd = wgid % NXCD, off = wgid / NXCD; wgid = (xcd < r ? xcd * (q + 1) : r * (q + 1) + (xcd - r) * q) + off; }
        const int nig = WGM * nN, gid = wgid / nig, fm = gid * WGM, gsz = (nM - fm) < WGM ? (nM - fm) : WGM;
        u.pm = fm + ((wgid % nig) % gsz); u.pn = (wgid % nig) / gsz; u.e = 0; u.ui = i; return true;
    }
    __device__ __forceinline__ const char* a_base(const Unit& u) const { return A + (size_t)u.pm * tstepA; }
    __device__ __forceinline__ const char* b_base(const Unit& u) const { return B + (size_t)u.pn * tstepB; }
    __device__ __forceinline__ int a_row(const Unit&, int) const { return 0; }
};

__device__ __forceinline__ unsigned cvt_pk_bf16(float lo, float hi) { unsigned r; asm volatile("v_cvt_pk_bf16_f32 %0, %1, %2" : "=v"(r) : "v"(lo), "v"(hi)); return r; }

template <class Epi, class Sched, bool GATHER>
__device__ __forceinline__ void gemm_phase(PG8_LAS unsigned char* lds, const Sched& S, const Epi& E, const int K, const int lda, const int ldb, const int tid_in) {
    int tid = tid_in; asm volatile("" : "+v"(tid));
    const int wid = __builtin_amdgcn_readfirstlane(tid >> 6), lane = tid & 63, wr = wid >> 2, wc = wid & 3, fr = lane & 15, fq = lane >> 4;
    const int nt = K / BK;
    int RA[2], CA[2]; unsigned voffB[2];
#pragma unroll
    for (int i = 0; i < 2; ++i) { int R, C; stage_rc(tid * 16 + i * 8192, R, C); const int Rb = Epi::ADJ ? (64 * (R >> 5) + perm_adj(R & 31)) : (Epi::PERM ? ((R & ~31) + perm32(R & 31)) : R); RA[i] = R; CA[i] = C; voffB[i] = (unsigned)(Rb * ldb + C) * 2u; }
    const size_t kstep = (size_t)(BK * 2);
    const size_t hstepB = (size_t)(Epi::ADJ ? 8 : HALF) * ldb * 2;
    const unsigned ldsw = (unsigned)wid * 1024u;
    const int aoff = lds_byte(wr * 64 + fr, fq * 8), boff = lds_byte(wc * 32 + fr, fq * 8);
#define PG8_SA(b, h) (((b) * 2 + (h)) * HTB)
#define PG8_SB(b, h) ((4 + (b) * 2 + (h)) * HTB)
#define PG8_STAGE2(bufoff, gbase, v0, v1) do { \
        __builtin_amdgcn_global_load_lds((const unsigned*)((const char*)(gbase) + (v0)), (PG8_LAS unsigned*)(lds + (bufoff) + ldsw), 16, 0, 0); \
        __builtin_amdgcn_global_load_lds((const unsigned*)((const char*)(gbase) + (v1)), (PG8_LAS unsigned*)(lds + (bufoff) + ldsw + 8192), 16, 0, 0); } while (0)
#define PG8_STAGEB(bufoff, gbase) PG8_STAGE2(bufoff, gbase, voffB[0], voffB[1])
#define PG8_LDA(dst, b, h) do { _Pragma("unroll") for (int m = 0; m < 4; ++m) _Pragma("unroll") for (int k = 0; k < 2; ++k) dst[m][k] = *(const PG8_LAS bf16x8*)(lds + PG8_SA(b, h) + aoff + m * 2048 + k * 1024); } while (0)
#define PG8_LDB(dst, b, h) do { _Pragma("unroll") for (int n = 0; n < 2; ++n) _Pragma("unroll") for (int k = 0; k < 2; ++k) dst[n][k] = *(const PG8_LAS bf16x8*)(lds + PG8_SB(b, h) + boff + n * 2048 + k * 1024); } while (0)
#define PG8_MMA(ai, bj, At, Bt) do { __builtin_amdgcn_s_setprio(1); _Pragma("unroll") for (int m = 0; m < 4; ++m) _Pragma("unroll") for (int n = 0; n < 2; ++n) _Pragma("unroll") for (int k = 0; k < 2; ++k) \
        acc[ai][bj][m][n] = __builtin_amdgcn_mfma_f32_16x16x32_bf16(Bt[n][k], At[m][k], acc[ai][bj][m][n], 0, 0, 0); __builtin_amdgcn_s_setprio(0); } while (0)
#define PG8_WAIT_V(n) asm volatile("s_waitcnt vmcnt(" #n ")" ::: "memory")
#define PG8_WAIT_L(n) asm volatile("s_waitcnt lgkmcnt(" #n ")" ::: "memory")
#define PG8_WAIT_VR(rl) do { if (Epi::EXACT && (rl)) { if (Epi::NSTORE_LO > 0) asm volatile("s_cmp_eq_u32 %0, 2\n\ts_cbranch_scc1 3f\n\ts_waitcnt vmcnt(%2)\n\ts_branch 5f\n3:\ts_waitcnt vmcnt(%1)\n5:" :: "s"(rl), "n"(8 + Epi::NSTORE), "n"(8 + Epi::NSTORE_LO) : "memory", "scc"); else asm volatile("s_waitcnt vmcnt(%0)" :: "n"(8 + Epi::NSTORE) : "memory"); } else asm volatile("s_waitcnt vmcnt(8)" ::: "memory"); } while (0)
#define PG8_BAR __builtin_amdgcn_s_barrier()
#define PG8_SCHED __builtin_amdgcn_sched_barrier(0)
#define PG8_VOFFA(dst, u) do { _Pragma("unroll") for (int h_ = 0; h_ < 2; ++h_) _Pragma("unroll") for (int i_ = 0; i_ < 2; ++i_) { \
        const int row_ = GATHER ? S.a_row(u, h_ * HALF + RA[i_]) : (h_ * HALF + RA[i_]); dst[h_][i_] = (unsigned)(row_ * lda + CA[i_]) * 2u; } } while (0)
    Unit cur, nxt;
    if (!S.next(0, cur)) return;
    f32x4 acc[2][2][4][2];
#pragma unroll
    for (int a = 0; a < 2; ++a)
#pragma unroll
        for (int b = 0; b < 2; ++b)
#pragma unroll
            for (int m = 0; m < 4; ++m)
#pragma unroll
                for (int n = 0; n < 2; ++n) acc[a][b][m][n] = (f32x4){0.f, 0.f, 0.f, 0.f};
    bf16x8 At[4][2], B0[2][2], B1[2][2];
    unsigned vc[2][2], vn[2][2];
    PG8_VOFFA(vc, cur);
    const char* cA = S.a_base(cur); const char* cB = S.b_base(cur);
    PG8_STAGEB(PG8_SB(0, 0), cB); PG8_STAGEB(PG8_SB(0, 1), cB + hstepB); PG8_STAGE2(PG8_SA(0, 0), cA, vc[0][0], vc[0][1]); PG8_STAGE2(PG8_SA(0, 1), cA, vc[1][0], vc[1][1]);
    if (wr == 1) PG8_BAR;
    PG8_WAIT_V(2); PG8_BAR;
    PG8_STAGEB(PG8_SB(1, 0), cB + kstep); PG8_STAGE2(PG8_SA(1, 0), cA + kstep, vc[0][0], vc[0][1]); PG8_STAGEB(PG8_SB(1, 1), cB + hstepB + kstep);
    PG8_WAIT_V(6); PG8_BAR;
    int ui = 0; bool fresh = false; int pst = 0;
    for (;;) {
        const bool has_next = S.next(ui + 1, nxt);
        const char* nA = has_next ? S.a_base(nxt) : cA; const char* nB = has_next ? S.b_base(nxt) : cB;
        if (GATHER) { if (has_next) { PG8_VOFFA(vn, nxt); } else {
#pragma unroll
            for (int h_ = 0; h_ < 2; ++h_) { vn[h_][0] = vc[h_][0]; vn[h_][1] = vc[h_][1]; } } }
        for (int t = 0; t < nt; t += 2) {
            const bool last = (t == nt - 2); int tz = t; asm volatile("" : "+s"(tz)); const int rl = __builtin_amdgcn_readfirstlane((fresh && tz == 0) ? (Epi::NSTORE_LO > 0 ? pst : 1) : 0);
            const char* a1 = cA + (size_t)(t + 1) * kstep;
            const char* a2 = last ? nA : cA + (size_t)(t + 2) * kstep; const char* b2 = last ? nB : cB + (size_t)(t + 2) * kstep;
            const char* a3 = a2 + kstep; const char* b3 = b2 + kstep;
            unsigned w00, w01, w10, w11;
            if (GATHER) { w00 = last ? vn[0][0] : vc[0][0]; w01 = last ? vn[0][1] : vc[0][1]; w10 = last ? vn[1][0] : vc[1][0]; w11 = last ? vn[1][1] : vc[1][1]; }
            else { w00 = vc[0][0]; w01 = vc[0][1]; w10 = vc[1][0]; w11 = vc[1][1]; }
            PG8_LDB(B0, 0, 0); PG8_LDB(B1, 0, 1); PG8_SCHED; PG8_LDA(At, 0, 0); PG8_STAGE2(PG8_SA(1, 1), a1, vc[1][0], vc[1][1]);
            PG8_WAIT_VR(rl); PG8_WAIT_L(0); PG8_BAR; PG8_MMA(0, 0, At, B0); PG8_MMA(0, 1, At, B1); PG8_BAR; PG8_SCHED;
            PG8_LDA(At, 0, 1); PG8_STAGEB(PG8_SB(0, 0), b2); PG8_STAGEB(PG8_SB(0, 1), b2 + hstepB); PG8_STAGE2(PG8_SA(0, 0), a2, w00, w01);
            PG8_WAIT_VR(rl); PG8_WAIT_L(0); PG8_BAR; PG8_MMA(1, 0, At, B0); PG8_MMA(1, 1, At, B1); PG8_BAR; PG8_SCHED;
            PG8_LDB(B0, 1, 0); PG8_LDB(B1, 1, 1); PG8_SCHED; PG8_LDA(At, 1, 0); PG8_STAGE2(PG8_SA(0, 1), a2, w10, w11);
            PG8_WAIT_V(8); PG8_WAIT_L(0); PG8_BAR; PG8_MMA(0, 0, At, B0); PG8_MMA(0, 1, At, B1); PG8_BAR; PG8_SCHED;
            PG8_LDA(At, 1, 1); PG8_STAGEB(PG8_SB(1, 0), b3); PG8_STAGEB(PG8_SB(1, 1), b3 + hstepB); PG8_STAGE2(PG8_SA(1, 0), a3, w00, w01);
            PG8_WAIT_V(8); PG8_WAIT_L(0); PG8_BAR; PG8_MMA(1, 0, At, B0); PG8_MMA(1, 1, At, B1); PG8_BAR; PG8_SCHED;
        }
        if (PG8_ALIGN && wr == 0) PG8_BAR;
        E(acc, cur, wr, wc, fr, fq);
        if (!has_next) break;
        if (Epi::NSTORE_LO > 0) pst = Epi::nst(cur);
#pragma unroll
        for (int a = 0; a < 2; ++a)
#pragma unroll
            for (int b = 0; b < 2; ++b)
#pragma unroll
                for (int m = 0; m < 4; ++m)
#pragma unroll
                    for (int n = 0; n < 2; ++n) acc[a][b][m][n] = (f32x4){0.f, 0.f, 0.f, 0.f};
        cur = nxt; cA = nA; cB = nB; ++ui;
        if (GATHER) {
#pragma unroll
            for (int h_ = 0; h_ < 2; ++h_) { vc[h_][0] = vn[h_][0]; vc[h_][1] = vn[h_][1]; } }
        if (PG8_ALIGN && wr == 1) PG8_BAR;
        fresh = true;
    }
    PG8_WAIT_V(0);
    if (!PG8_ALIGN && wr == 0) PG8_BAR;
    PG8_BAR;
#undef PG8_SA
#undef PG8_SB
#undef PG8_STAGE2
#undef PG8_STAGEB
#undef PG8_LDA
#undef PG8_LDB
#undef PG8_MMA
#undef PG8_WAIT_V
#undef PG8_WAIT_L
#undef PG8_WAIT_VR
#undef PG8_BAR
#undef PG8_SCHED
#undef PG8_VOFFA
}
template <class Epi, class Sched>
__device__ __forceinline__ void gemm_phase_vk(PG8_LAS unsigned char* lds, const Sched& S, const Epi& E, const int lda, const int tid_in) {
    constexpr bool GATHER = false;
    int tid = tid_in; asm volatile("" : "+v"(tid));
    const int wid = __builtin_amdgcn_readfirstlane(tid >> 6), lane = tid & 63, wr = wid >> 2, wc = wid & 3, fr = lane & 15, fq = lane >> 4;
    int RA[2], CA[2], RB[2];
#pragma unroll
    for (int i = 0; i < 2; ++i) { int R, C; stage_rc(tid * 16 + i * 8192, R, C); const int Rb = Epi::PERM ? ((R & ~31) + perm32(R & 31)) : R; RA[i] = R; CA[i] = C; RB[i] = Rb; }
    const size_t kstep = (size_t)(BK * 2);
    const unsigned ldsw = (unsigned)wid * 1024u;
    const int aoff = lds_byte(wr * 64 + fr, fq * 8), boff = lds_byte(wc * 32 + fr, fq * 8);
#define PG8_SA(b, h) (((b) * 2 + (h)) * HTB)
#define PG8_SB(b, h) ((4 + (b) * 2 + (h)) * HTB)
#define PG8_STAGE2(bufoff, gbase, v0, v1) do { \
        __builtin_amdgcn_global_load_lds((const unsigned*)((const char*)(gbase) + (v0)), (PG8_LAS unsigned*)(lds + (bufoff) + ldsw), 16, 0, 0); \
        __builtin_amdgcn_global_load_lds((const unsigned*)((const char*)(gbase) + (v1)), (PG8_LAS unsigned*)(lds + (bufoff) + ldsw + 8192), 16, 0, 0); } while (0)
#define PG8_VOFFB(dst, hs, u) do { const int ldb_ = S.ldb_of(u); _Pragma("unroll") for (int i_ = 0; i_ < 2; ++i_) { int R_, C_; stage_rc(tid * 16 + i_ * 8192, R_, C_); const int Rb_ = Epi::ADJ ? (64 * (R_ >> 5) + perm_adj(R_ & 31)) : (Epi::PERM ? ((R_ & ~31) + perm32(R_ & 31)) : R_); dst[i_] = (unsigned)(Rb_ * ldb_ + C_) * 2u; } hs = (size_t)(Epi::ADJ ? 8 : HALF) * ldb_ * 2; } while (0)
#define PG8_LDA(dst, b, h) do { _Pragma("unroll") for (int m = 0; m < 4; ++m) _Pragma("unroll") for (int k = 0; k < 2; ++k) dst[m][k] = *(const PG8_LAS bf16x8*)(lds + PG8_SA(b, h) + aoff + m * 2048 + k * 1024); } while (0)
#define PG8_LDB(dst, b, h) do { _Pragma("unroll") for (int n = 0; n < 2; ++n) _Pragma("unroll") for (int k = 0; k < 2; ++k) dst[n][k] = *(const PG8_LAS bf16x8*)(lds + PG8_SB(b, h) + boff + n * 2048 + k * 1024); } while (0)
#define PG8_MMA(ai, bj, At, Bt) do { __builtin_amdgcn_s_setprio(1); _Pragma("unroll") for (int m = 0; m < 4; ++m) _Pragma("unroll") for (int n = 0; n < 2; ++n) _Pragma("unroll") for (int k = 0; k < 2; ++k) \
        acc[ai][bj][m][n] = __builtin_amdgcn_mfma_f32_16x16x32_bf16(Bt[n][k], At[m][k], acc[ai][bj][m][n], 0, 0, 0); __builtin_amdgcn_s_setprio(0); } while (0)
#define PG8_WAIT_V(n) asm volatile("s_waitcnt vmcnt(" #n ")" ::: "memory")
#define PG8_WAIT_L(n) asm volatile("s_waitcnt lgkmcnt(" #n ")" ::: "memory")
#define PG8_WAIT_VR(rl) do { if (Epi::EXACT && (rl)) { if (Epi::NSTORE_LO > 0) asm volatile("s_cmp_eq_u32 %0, 2\n\ts_cbranch_scc1 3f\n\ts_waitcnt vmcnt(%2)\n\ts_branch 5f\n3:\ts_waitcnt vmcnt(%1)\n5:" :: "s"(rl), "n"(8 + Epi::NSTORE), "n"(8 + Epi::NSTORE_LO) : "memory", "scc"); else asm volatile("s_waitcnt vmcnt(%0)" :: "n"(8 + Epi::NSTORE) : "memory"); } else asm volatile("s_waitcnt vmcnt(8)" ::: "memory"); } while (0)
#define PG8_BAR __builtin_amdgcn_s_barrier()
#define PG8_SCHED __builtin_amdgcn_sched_barrier(0)
#define PG8_VOFFA(dst, u) do { _Pragma("unroll") for (int h_ = 0; h_ < 2; ++h_) _Pragma("unroll") for (int i_ = 0; i_ < 2; ++i_) { \
        const int row_ = GATHER ? S.a_row(u, h_ * HALF + RA[i_]) : (h_ * HALF + RA[i_]); dst[h_][i_] = (unsigned)(row_ * lda + CA[i_]) * 2u; } } while (0)
    Unit cur, nxt;
    if (!S.next(0, cur)) return;
    f32x4 acc[2][2][4][2];
#pragma unroll
    for (int a = 0; a < 2; ++a)
#pragma unroll
        for (int b = 0; b < 2; ++b)
#pragma unroll
            for (int m = 0; m < 4; ++m)
#pragma unroll
                for (int n = 0; n < 2; ++n) acc[a][b][m][n] = (f32x4){0.f, 0.f, 0.f, 0.f};
    bf16x8 At[4][2], B0[2][2], B1[2][2];
    unsigned vc[2][2], vn[2][2];
    PG8_VOFFA(vc, cur);
    unsigned vbc[2], vbn[2]; size_t hsc, hsn; PG8_VOFFB(vbc, hsc, cur); int nt = S.K_of(cur) / BK;
    const char* cA = S.a_base(cur); const char* cB = S.b_base(cur);
    PG8_STAGE2(PG8_SB(0, 0), cB, vbc[0], vbc[1]); PG8_STAGE2(PG8_SB(0, 1), cB + hsc, vbc[0], vbc[1]); PG8_STAGE2(PG8_SA(0, 0), cA, vc[0][0], vc[0][1]); PG8_STAGE2(PG8_SA(0, 1), cA, vc[1][0], vc[1][1]);
    if (wr == 1) PG8_BAR;
    PG8_WAIT_V(2); PG8_BAR;
    PG8_STAGE2(PG8_SB(1, 0), cB + kstep, vbc[0], vbc[1]); PG8_STAGE2(PG8_SA(1, 0), cA + kstep, vc[0][0], vc[0][1]); PG8_STAGE2(PG8_SB(1, 1), cB + hsc + kstep, vbc[0], vbc[1]);
    PG8_WAIT_V(6); PG8_BAR;
    int ui = 0; bool fresh = false; int pst = 0;
    for (;;) {
        const bool has_next = S.next(ui + 1, nxt);
        const char* nA = has_next ? S.a_base(nxt) : cA; const char* nB = has_next ? S.b_base(nxt) : cB;
        if (has_next) { PG8_VOFFB(vbn, hsn, nxt); } else { vbn[0] = vbc[0]; vbn[1] = vbc[1]; hsn = hsc; }
        if (GATHER) { if (has_next) { PG8_VOFFA(vn, nxt); } else {
#pragma unroll
            for (int h_ = 0; h_ < 2; ++h_) { vn[h_][0] = vc[h_][0]; vn[h_][1] = vc[h_][1]; } } }
        for (int t = 0; t < nt; t += 2) {
            const bool last = (t == nt - 2); int tz = t; asm volatile("" : "+s"(tz)); const int rl = __builtin_amdgcn_readfirstlane((fresh && tz == 0) ? (Epi::NSTORE_LO > 0 ? pst : 1) : 0);
            const char* a1 = cA + (size_t)(t + 1) * kstep;
            const char* a2 = last ? nA : cA + (size_t)(t + 2) * kstep; const char* b2 = last ? nB : cB + (size_t)(t + 2) * kstep;
            const char* a3 = a2 + kstep; const char* b3 = b2 + kstep;
            unsigned w00, w01, w10, w11;
            if (GATHER) { w00 = last ? vn[0][0] : vc[0][0]; w01 = last ? vn[0][1] : vc[0][1]; w10 = last ? vn[1][0] : vc[1][0]; w11 = last ? vn[1][1] : vc[1][1]; }
            else { w00 = vc[0][0]; w01 = vc[0][1]; w10 = vc[1][0]; w11 = vc[1][1]; }
            const unsigned wb0 = last ? vbn[0] : vbc[0], wb1 = last ? vbn[1] : vbc[1]; const size_t hsb = last ? hsn : hsc;
            PG8_LDB(B0, 0, 0); PG8_LDB(B1, 0, 1); PG8_SCHED; PG8_LDA(At, 0, 0); PG8_STAGE2(PG8_SA(1, 1), a1, vc[1][0], vc[1][1]);
            PG8_WAIT_VR(rl); PG8_WAIT_L(0); PG8_BAR; PG8_MMA(0, 0, At, B0); PG8_MMA(0, 1, At, B1); PG8_BAR; PG8_SCHED;
            PG8_LDA(At, 0, 1); PG8_STAGE2(PG8_SB(0, 0), b2, wb0, wb1); PG8_STAGE2(PG8_SB(0, 1), b2 + hsb, wb0, wb1); PG8_STAGE2(PG8_SA(0, 0), a2, w00, w01);
            PG8_WAIT_VR(rl); PG8_WAIT_L(0); PG8_BAR; PG8_MMA(1, 0, At, B0); PG8_MMA(1, 1, At, B1); PG8_BAR; PG8_SCHED;
            PG8_LDB(B0, 1, 0); PG8_LDB(B1, 1, 1); PG8_SCHED; PG8_LDA(At, 1, 0); PG8_STAGE2(PG8_SA(0, 1), a2, w10, w11);
            PG8_WAIT_V(8); PG8_WAIT_L(0); PG8_BAR; PG8_MMA(0, 0, At, B0); PG8_MMA(0, 1, At, B1); PG8_BAR; PG8_SCHED;
            PG8_LDA(At, 1, 1); PG8_STAGE2(PG8_SB(1, 0), b3, wb0, wb1); PG8_STAGE2(PG8_SB(1, 1), b3 + hsb, wb0, wb1); PG8_STAGE2(PG8_SA(1, 0), a3, w00, w01);
            PG8_WAIT_V(8); PG8_WAIT_L(0); PG8_BAR; PG8_MMA(1, 0, At, B0); PG8_MMA(1, 1, At, B1); PG8_BAR; PG8_SCHED;
        }
        if (PG8_ALIGN && wr == 0) PG8_BAR;
        E(acc, cur, wr, wc, fr, fq);
        if (!has_next) break;
        if (Epi::NSTORE_LO > 0) pst = Epi::nst(cur);
        if (!S.keep_acc(cur)) {
#pragma unroll
        for (int a = 0; a < 2; ++a)
#pragma unroll
            for (int b = 0; b < 2; ++b)
#pragma unroll
                for (int m = 0; m < 4; ++m)
#pragma unroll
                    for (int n = 0; n < 2; ++n) acc[a][b][m][n] = (f32x4){0.f, 0.f, 0.f, 0.f}; }
        cur = nxt; cA = nA; cB = nB; ++ui; vbc[0] = vbn[0]; vbc[1] = vbn[1]; hsc = hsn; nt = S.K_of(cur) / BK;
        if (GATHER) {
#pragma unroll
            for (int h_ = 0; h_ < 2; ++h_) { vc[h_][0] = vn[h_][0]; vc[h_][1] = vn[h_][1]; } }
        if (PG8_ALIGN && wr == 1) PG8_BAR;
        fresh = true;
    }
    PG8_WAIT_V(0);
    if (!PG8_ALIGN && wr == 0) PG8_BAR;
    PG8_BAR;
#undef PG8_SA
#undef PG8_SB
#undef PG8_STAGE2
#undef PG8_VOFFB
#undef PG8_LDA
#undef PG8_LDB
#undef PG8_MMA
#undef PG8_WAIT_V
#undef PG8_WAIT_L
#undef PG8_WAIT_VR
#undef PG8_BAR
#undef PG8_SCHED
#undef PG8_VOFFA
}
}

constexpr int NWAVES = 8, NTHREADS = 512;
constexpr int RING_OFF = 0, RING_BYTES = 131072, ROWS_OFF = 131072, ROWS_BYTES = 12288, ROUTER_BYTES = 147456  , MISC_OFF = ROUTER_BYTES, LCNT_OFF = MISC_OFF + 128  , LDS_BYTES = 148480;
static_assert(MISC_OFF + 128 <= LDS_BYTES, "LDS map");
constexpr int CW_CNT = 0;
constexpr int CW_BAR = 4096;
constexpr size_t CTL_ZERO_BYTES = 64 * 1024;
constexpr float LOG2E = 1.4426950408889634f, LN2 = 0.6931471805599453f;
constexpr float QSCALE = 0.125f * LOG2E;

#define GAS __attribute__((address_space(1)))
#define LAS __attribute__((address_space(3)))
typedef unsigned v4u __attribute__((ext_vector_type(4)));
typedef unsigned v2u __attribute__((ext_vector_type(2)));
#define LDS_WAIT() asm volatile("s_waitcnt lgkmcnt(0)" ::: "memory")
__device__ __forceinline__ unsigned pk2(float lo, float hi) { return (unsigned)f2bf(lo) | ((unsigned)f2bf(hi) << 16); }

#define XB_TMO      128
#define XB_XCNT(j)  (256  + 64 * (j))
#define XB_XSUB(j)  (1280 + 64 * (j))
#define XB_XGEN(j)  (2304 + 64 * (j))
#define XB_TOP      3328
#define XB_TOPGEN   3392
#define XCD_BAR_WORDS 3456
#define XB_SPIN_CAP (1u << 18)

__device__ __forceinline__ unsigned xb_ld(unsigned* p)              { return __hip_atomic_load(p, __ATOMIC_RELAXED, __HIP_MEMORY_SCOPE_AGENT); }
__device__ __forceinline__ unsigned xb_add(unsigned* p, unsigned v) { return __hip_atomic_fetch_add(p, v, __ATOMIC_RELAXED, __HIP_MEMORY_SCOPE_AGENT); }
__device__ __forceinline__ unsigned xb_xcc_id() { return (unsigned)__builtin_amdgcn_s_getreg((3 << 11) | 20) & 0xFu; }
#define XB_SPIN(cond, bar) do { unsigned _sp = 0; while (cond) { __builtin_amdgcn_s_sleep(1); \
    if ((++_sp & 255u) == 0u) { if (xb_ld(&(bar)[XB_TMO])) break; if (_sp > XB_SPIN_CAP) { atomicAdd(&(bar)[XB_TMO], 1u); break; } } } } while (0)

struct XcdBarrier {
    int wave0;
    unsigned* bar; unsigned x;
    volatile LAS unsigned* st;
};

__device__ __forceinline__ unsigned xb_lane() { unsigned l_; asm volatile("v_mbcnt_lo_u32_b32 %0, -1, 0\n\tv_mbcnt_hi_u32_b32 %0, -1, %0" : "=v"(l_)); return l_; }
__device__ __forceinline__ XcdBarrier xcd_barrier_post(unsigned* bar, volatile LAS unsigned* st, int wave0) {
    XcdBarrier b; b.wave0 = wave0; b.bar = bar; b.x = xb_xcc_id(); b.st = st;
    if (b.wave0 && xb_lane() == 0u) (void)xb_add(&bar[XB_XCNT(b.x)], 1u);
    return b;
}
__device__ __forceinline__ void xcd_barrier_complete(unsigned* bar, unsigned x, unsigned& nloc, unsigned& nx) {
    const unsigned G = gridDim.x * gridDim.y * gridDim.z;
    unsigned sum, cnt, mine, sp = 0u;
    for (;;) {
        sum = 0u; cnt = 0u; mine = 0u;
#pragma unroll
        for (unsigned j = 0; j < 16; ++j) { const unsigned c = xb_ld(&bar[XB_XCNT(j)]); sum += c; cnt += (c > 0u) ? 1u : 0u; mine = (j == x) ? c : mine; }
        if (sum == G) break;
        __builtin_amdgcn_s_sleep(1);
        if ((++sp & 255u) == 0u) { if (xb_ld(&bar[XB_TMO])) break; if (sp > XB_SPIN_CAP) { atomicAdd(&bar[XB_TMO], 1u); break; } }
    }
    nloc = mine > 0u ? mine : 1u; nx = cnt > 0u ? cnt : 1u;
}

__device__ __forceinline__ void xcd_barrier(const XcdBarrier& b) {
    asm volatile("s_waitcnt vmcnt(0)" ::: "memory");
    __syncthreads();
    if (b.wave0 && xb_lane() == 0u) {
        unsigned* bar = b.bar;
        __builtin_amdgcn_s_waitcnt(0);
        unsigned nloc = b.st[0], nx = b.st[1];
        if (nloc == 0u) { xcd_barrier_complete(bar, b.x, nloc, nx); b.st[0] = nloc; b.st[1] = nx; }
        const unsigned old = xb_add(&bar[XB_XSUB(b.x)], 1u);
        const unsigned gen = old / nloc;
        if (old + 1u == (gen + 1u) * nloc) {
            __builtin_amdgcn_fence(__ATOMIC_RELEASE, "agent");
            asm volatile("s_waitcnt vmcnt(0)" ::: "memory");
            const unsigned og = xb_add(&bar[XB_TOP], 1u);
            const unsigned tg = og / nx;
            if (og + 1u == (tg + 1u) * nx) xb_add(&bar[XB_TOPGEN], 1u);
            else XB_SPIN(xb_ld(&bar[XB_TOPGEN]) == tg, bar);
            __builtin_amdgcn_fence(__ATOMIC_ACQUIRE, "agent");
            xb_add(&bar[XB_XGEN(b.x)], 1u);
            asm volatile("s_waitcnt vmcnt(0)" ::: "memory");
        } else {
            XB_SPIN(xb_ld(&bar[XB_XGEN(b.x)]) == gen, bar);
            __builtin_amdgcn_fence(__ATOMIC_ACQUIRE, "agent");
            asm volatile("s_waitcnt vmcnt(0)" ::: "memory");
        }
    }
    __syncthreads();
}


struct Args { const float* in[23]; float* out; unsigned char* ws; int s_lo, s_hi, probe, pad; };

struct Frame {
    LAS unsigned char* lds; int tid, lane, wave, vcu, G;
    const float* const* in; float* h; unsigned char* ws; int probe;
};

__device__ __forceinline__ int hw_lane() { int l_; asm volatile("v_mbcnt_lo_u32_b32 %0, -1, 0\n\tv_mbcnt_hi_u32_b32 %0, -1, %0" : "=v"(l_)); return l_; }
__device__ __forceinline__ float shfl_xor_l(float v, int mask, int lane) { return __builtin_bit_cast(float, __builtin_amdgcn_ds_bpermute((lane ^ mask) << 2, __builtin_bit_cast(int, v))); }
__device__ __forceinline__ float dpp_add(float v, const int ctrl_sel) {
    const int x = __builtin_bit_cast(int, v); int y;
    if (ctrl_sel == 0) y = __builtin_amdgcn_mov_dpp(x, 0xB1, 0xF, 0xF, true);
    else if (ctrl_sel == 1) y = __builtin_amdgcn_mov_dpp(x, 0x4E, 0xF, 0xF, true);
    else if (ctrl_sel == 2) y = __builtin_amdgcn_mov_dpp(x, 0x141, 0xF, 0xF, true);
    else y = __builtin_amdgcn_mov_dpp(x, 0x140, 0xF, 0xF, true);
    return v + __builtin_bit_cast(float, y);
}
__device__ __forceinline__ float wave_sum_l(float v, int lane) {
    (void)lane;
    v = dpp_add(v, 0); v = dpp_add(v, 1); v = dpp_add(v, 2); v = dpp_add(v, 3);
    const int x = __builtin_bit_cast(int, v);
    const float r0 = __builtin_bit_cast(float, __builtin_amdgcn_readlane(x, 0)), r1 = __builtin_bit_cast(float, __builtin_amdgcn_readlane(x, 16)),
                r2 = __builtin_bit_cast(float, __builtin_amdgcn_readlane(x, 32)), r3 = __builtin_bit_cast(float, __builtin_amdgcn_readlane(x, 48));
    return (r0 + r1) + (r2 + r3);
}
#define LAUNDER(F) do { (F).lane = hw_lane(); (F).tid = (F).wave * 64 + (F).lane; asm volatile("" : "+s"((F).G), "+s"((F).vcu), "+s"((F).ws), "+s"((F).h)); } while (0)
__device__ __forceinline__ void p0_item(const float* W, int ldw, int k0, int n0, bf16* WT, int Kd, int drow0, float scale, LAS float* scr, int lane) {
#pragma unroll 8
    for (int i = 0; i < 32; ++i) { const int kk = 2 * i + (lane >> 5); scr[kk * 33 + (lane & 31)] = *(const GAS float*)(W + (size_t)(k0 + kk) * ldw + n0 + (lane & 31)) * scale; }
    LDS_WAIT(); asm volatile("" ::: "memory");
    const int c = lane & 7;
#pragma unroll
    for (int j = 0; j < 4; ++j) { const int n = (lane >> 3) + 8 * j; const LAS float* s = scr + (8 * c) * 33 + n;
        v4u o; o.x = pk2(s[0 * 33], s[1 * 33]); o.y = pk2(s[2 * 33], s[3 * 33]); o.z = pk2(s[4 * 33], s[5 * 33]); o.w = pk2(s[6 * 33], s[7 * 33]);
        *(GAS v4u*)(WT + (size_t)(drow0 + n) * Kd + k0 + 8 * c) = o; }
    LDS_WAIT(); asm volatile("" ::: "memory");
}
__device__ __forceinline__ bool is_q_col(int n) { return n < 512 || (n >= 768 && n < 3072 && ((n - 768) % 768) < 256) || (n >= 3072 && n < 3584); }

__device__ __forceinline__ void ph_prologue(Frame& F) { LAUNDER(F);
    LAS float* scr = (LAS float*)(F.lds + RING_OFF + F.wave * 16384);
    const int gw = F.vcu * NWAVES + F.wave, NGW = F.G * NWAVES, lane = F.lane;
    const float* w_in = F.in[4]; const float* w_a = F.in[8]; const float* w_b = F.in[9]; const float* w_c = F.in[10]; const float* w_o = F.in[11];
    const float* w_eg = F.in[18]; const float* w_eu = F.in[19]; const float* w_ed = F.in[20];
    bf16* WIN = (bf16*)(F.ws + WS_WIN); bf16* WBRA = (bf16*)(F.ws + WS_WBRA); bf16* WBRB = (bf16*)(F.ws + WS_WBRB); bf16* WBRC = (bf16*)(F.ws + WS_WBRC); bf16* WOUT = (bf16*)(F.ws + WS_WOUT);
    bf16* WGU = (bf16*)(F.ws + WS_WGU); bf16* WD = (bf16*)(F.ws + WS_WD);
    constexpr int I_IN = 16 * (NCOL / 32), I_A = 8 * 32, I_B = 4 * 32, I_C = 8 * 32, I_O = 16 * 32, I_G = 16 * 16, I_D = 8 * 32;
    constexpr int I_LAYER = I_IN + I_A + I_B + I_C + I_O + NE * (2 * I_G + I_D);
    for (int it = gw; it < DEPTH * I_LAYER; it += NGW) {
        const int l = it / I_LAYER; int r = it % I_LAYER;
        if (r < I_IN) { const int nb = r % (NCOL / 32), kb = r / (NCOL / 32); p0_item(w_in + (size_t)l * D * NCOL, NCOL, 64 * kb, 32 * nb, WIN + (size_t)l * NCOL * D, D, 32 * nb, is_q_col(32 * nb) ? QSCALE : 1.0f, scr, lane); continue; } r -= I_IN;
        if (r < I_A) { const int nb = r % 32, kb = r / 32; p0_item(w_a + (size_t)l * 512 * D, D, 64 * kb, 32 * nb, WBRA + (size_t)l * D * 512, 512, 32 * nb, 1.0f, scr, lane); continue; } r -= I_A;
        if (r < I_B) { const int nb = r % 32, kb = r / 32; p0_item(w_b + (size_t)l * 256 * D, D, 64 * kb, 32 * nb, WBRB + (size_t)l * D * 256, 256, 32 * nb, 1.0f, scr, lane); continue; } r -= I_B;
        if (r < I_C) { const int nb = r % 32, kb = r / 32; p0_item(w_c + (size_t)l * 512 * D, D, 64 * kb, 32 * nb, WBRC + (size_t)l * D * 512, 512, 32 * nb, 1.0f, scr, lane); continue; } r -= I_C;
        if (r < I_O) { const int nb = r % 32, kb = r / 32; p0_item(w_o + (size_t)l * D * D, D, 64 * kb, 32 * nb, WOUT + (size_t)l * D * D, D, 32 * nb, 1.0f, scr, lane); continue; } r -= I_O;
        const int e = r / (2 * I_G + I_D); r %= (2 * I_G + I_D); const size_t le = (size_t)l * NE + e;
        if (r < 2 * I_G) { const int up = r / I_G; r %= I_G; const int nb = r % 16, kb = r / 16;
            p0_item((up ? w_eu : w_eg) + le * D * DE, DE, 64 * kb, 32 * nb, WGU + le * 1024 * 1024, D, (nb >> 2) * 256 + up * 128 + (nb & 3) * 32, 1.0f, scr, lane); continue; }
        r -= 2 * I_G; { const int nb = r % 32, kb = r / 32; p0_item(w_ed + le * DE * D, D, 64 * kb, 32 * nb, WD + le * D * DE, DE, 32 * nb, 1.0f, scr, lane); }
    }
}

struct LnIn { f32x4 v[4]; v4u hw[2], a[2], b[2]; };
template <int MODE> __device__ __forceinline__ void ln_load(LnIn& in, const float* src, const bf16* hsb, const bf16* yb, size_t row, int lane) {
#pragma unroll
    for (int j = 0; j < 2; ++j) {
        const int c = lane * 8 + 512 * j;
        if (MODE == 0) { in.v[2 * j] = *(const GAS f32x4*)(src + row * D + c); in.v[2 * j + 1] = *(const GAS f32x4*)(src + row * D + c + 4); }
        if (MODE != 0) in.hw[j] = *(const GAS v4u*)(hsb + row * D + c);
        if (MODE == 2) { in.a[j] = *(const GAS v4u*)(yb + (row * 2) * D + c); in.b[j] = *(const GAS v4u*)(yb + (row * 2 + 1) * D + c); }
    }
}
__device__ __forceinline__ void ln_params(f32x4 (&gg)[4], f32x4 (&bb)[4], const float* g, const float* bta, int lane) {
#pragma unroll
    for (int j = 0; j < 2; ++j)
#pragma unroll
        for (int q = 0; q < 2; ++q) { gg[2 * j + q] = *(const GAS f32x4*)(g + lane * 8 + 512 * j + 4 * q); bb[2 * j + q] = *(const GAS f32x4*)(bta + lane * 8 + 512 * j + 4 * q); }
}
template <int MODE> __device__ __forceinline__ void ln_finish(const LnIn& in, float* hout, bf16* hb, const f32x4 (&gg)[4], const f32x4 (&bb)[4], size_t row, int lane, f32x4 (&o)[4]) {
    f32x4 v[4];
#pragma unroll
    for (int j = 0; j < 2; ++j) {
        if (MODE == 0) { v[2 * j] = in.v[2 * j]; v[2 * j + 1] = in.v[2 * j + 1]; }
        else {
            const v4u hw = in.hw[j];
#pragma unroll
            for (int q = 0; q < 2; ++q) {
                const unsigned w0 = hw[2 * q], w1 = hw[2 * q + 1];
                f32x4 t = (f32x4){__uint_as_float(w0 << 16), __uint_as_float(w0 & 0xffff0000u), __uint_as_float(w1 << 16), __uint_as_float(w1 & 0xffff0000u)};
                if (MODE == 2) { const unsigned a0 = in.a[j][2 * q], a1 = in.a[j][2 * q + 1], b0 = in.b[j][2 * q], b1 = in.b[j][2 * q + 1];
                    t = t * ALPHA + (f32x4){__uint_as_float(a0 << 16), __uint_as_float(a0 & 0xffff0000u), __uint_as_float(a1 << 16), __uint_as_float(a1 & 0xffff0000u)}
                                  + (f32x4){__uint_as_float(b0 << 16), __uint_as_float(b0 & 0xffff0000u), __uint_as_float(b1 << 16), __uint_as_float(b1 & 0xffff0000u)}; }
                v[2 * j + q] = t; }
        }
    }
    float s = 0.f;
#pragma unroll
    for (int j = 0; j < 4; ++j) s += (v[j].x + v[j].y) + (v[j].z + v[j].w);
    const float mean = wave_sum_l(s, lane) * (1.f / D);
    float q2 = 0.f;
#pragma unroll
    for (int j = 0; j < 4; ++j) { v[j] = v[j] - mean; q2 += (v[j].x * v[j].x + v[j].y * v[j].y) + (v[j].z * v[j].z + v[j].w * v[j].w); }
    const float rstd = 1.0f / sqrtf(wave_sum_l(q2, lane) * (1.f / D) + LN_EPS);
#pragma unroll
    for (int j = 0; j < 4; ++j) o[j] = v[j] * rstd * gg[j] + bb[j];
#pragma unroll
    for (int j = 0; j < 2; ++j) {
        const int c = lane * 8 + 512 * j;
        if (hout) { *(GAS f32x4*)(hout + row * D + c) = o[2 * j]; *(GAS f32x4*)(hout + row * D + c + 4) = o[2 * j + 1]; }
        if (hb) { v4u w; w.x = pk2(o[2 * j].x, o[2 * j].y); w.y = pk2(o[2 * j].z, o[2 * j].w); w.z = pk2(o[2 * j + 1].x, o[2 * j + 1].y); w.w = pk2(o[2 * j + 1].z, o[2 * j + 1].w); *(GAS v4u*)(hb + row * D + c) = w; }
    }
}

__device__ __forceinline__ unsigned xor8_u(unsigned x) { return (unsigned)__builtin_amdgcn_mov_dpp((int)x, 0x128, 0xF, 0xF, true); }
__device__ __forceinline__ v4u xor8_v4u(v4u x) { return (v4u){xor8_u(x.x), xor8_u(x.y), xor8_u(x.z), xor8_u(x.w)}; }
__device__ __forceinline__ f32x4 xor8_f4(f32x4 x) { return (f32x4){__uint_as_float(xor8_u(__float_as_uint(x.x))), __uint_as_float(xor8_u(__float_as_uint(x.y))), __uint_as_float(xor8_u(__float_as_uint(x.z))), __uint_as_float(xor8_u(__float_as_uint(x.w)))}; }
__device__ __forceinline__ unsigned sel_u(bool c, unsigned a, unsigned b) { return c ? a : b; }
__device__ __forceinline__ void xchg8_v4u(const v4u pa, const v4u pb, const bool hi, v4u& first, v4u& second) {
    v4u send, recv;
#pragma unroll
    for (int j = 0; j < 4; ++j) { send[j] = sel_u(hi, pa[j], pb[j]); recv[j] = xor8_u(send[j]); first[j] = sel_u(hi, recv[j], pa[j]); second[j] = sel_u(hi, pb[j], recv[j]); }
}
__device__ __forceinline__ void xchg8_f4(const f32x4 pa, const f32x4 pb, const bool hi, f32x4& first, f32x4& second) {
#pragma unroll
    for (int j = 0; j < 4; ++j) { const unsigned a = __float_as_uint(pa[j]), b = __float_as_uint(pb[j]); const unsigned send = sel_u(hi, a, b), recv = xor8_u(send);
        first[j] = __uint_as_float(sel_u(hi, recv, a)); second[j] = __uint_as_float(sel_u(hi, b, recv)); }
}
#define XCHG8(T, XF, pa, pb, hi, first, second) XCHG8_##T(pa, pb, hi, first, second)
#define XCHG8_v4u(pa, pb, hi, first, second) xchg8_v4u(pa, pb, (hi) != 0, first, second)
#define XCHG8_f32x4(pa, pb, hi, first, second) xchg8_f4(pa, pb, (hi) != 0, first, second)
#ifndef GATE_RND
#define GATE_RND
#endif
struct EpiP1 {
    static constexpr bool PERM = true, ADJ = true; static constexpr bool EXACT = true; static constexpr int NSTORE = 16, NSTORE_LO = 8;
    static __device__ __forceinline__ int nst(const pg8::Unit& u) { return u.pn >= 18 ? 1 : 2; }
    bf16* qkv; unsigned char* gates; const float* b_gate; int probe;
    __device__ __forceinline__ void operator()(const f32x4 (&acc)[2][2][4][2], const pg8::Unit& u, int wr, int wc, int fr, int fq) const {
        asm volatile("" : "+v"(fr), "+v"(fq));
        if (u.pn >= 18) {
            const int tcol = (u.pn - 18) * 256 + wc * 64 + 16 * fq;
            f32x4 bv[4];
#pragma unroll
            for (int q = 0; q < 4; ++q) { bv[q] = *(const GAS f32x4*)(b_gate + tcol + 4 * q); bv[q] *= -LOG2E; }
            const float c255 = 1.0f / 255.0f;
#pragma unroll
            for (int ai = 0; ai < 2; ++ai)
#pragma unroll
                for (int m = 0; m < 4; ++m) { v4u w;
#pragma unroll
                    for (int bj = 0; bj < 2; ++bj)
#pragma unroll
                        for (int n = 0; n < 2; ++n) { const f32x4 v = acc[ai][bj][m][n]; const f32x4 b4 = bv[2 * bj + n]; unsigned p = 0u;
#pragma unroll
                            for (int j = 0; j < 4; ++j) { const float ex = __builtin_amdgcn_exp2f(__builtin_fmaf(v[j], -LOG2E, b4[j])); float dn;
                                asm("v_fma_f32 %0, %1, %2, %2 clamp" : "=v"(dn) : "v"(ex), "s"(c255));
                                p = __builtin_amdgcn_cvt_pk_u8_f32(__builtin_amdgcn_rcpf(dn) GATE_RND, j, p); }
                            w[2 * bj + n] = p; }
                    *(GAS v4u*)(gates + (size_t)(u.pm * 256 + ai * 128 + wr * 64 + m * 16 + fr) * GATEW + tcol) = w; }
            return;
        }
        const int hi = fr >> 3, r7 = fr & 7, tcol = u.pn * 256 + wc * 64 + 16 * fq;
#pragma unroll
        for (int ai = 0; ai < 2; ++ai)
#pragma unroll
            for (int m = 0; m < 4; ++m) { v4u w[2];
#pragma unroll
                for (int bj = 0; bj < 2; ++bj) { const f32x4 v0 = acc[ai][bj][m][0], v1 = acc[ai][bj][m][1];
                    w[bj].x = pg8::cvt_pk_bf16(v0[0], v0[1]); w[bj].y = pg8::cvt_pk_bf16(v0[2], v0[3]); w[bj].z = pg8::cvt_pk_bf16(v1[0], v1[1]); w[bj].w = pg8::cvt_pk_bf16(v1[2], v1[3]); }
                v4u s0, s1; XCHG8(v4u, xor8_v4u, w[0], w[1], hi, s0, s1);
                bf16* rowp = qkv + ((size_t)(u.pn * 4 + wc) * CH + (size_t)(u.pm * 256 + ai * 128 + wr * 64 + m * 16 + r7)) * 64 + 16 * fq + 8 * hi;
                *(GAS v4u*)rowp = s0; *(GAS v4u*)(rowp + 8 * 64) = s1; }
    }
};
struct EpiP3V {
    static constexpr bool PERM = true, ADJ = true; static constexpr bool EXACT = true; static constexpr int NSTORE = 16, NSTORE_LO = 0;
    static __device__ __forceinline__ int nst(const pg8::Unit&) { return 2; }
    bf16* merged; const unsigned char* gates;
    __device__ __forceinline__ void operator()(f32x4 (&acc)[2][2][4][2], const pg8::Unit& u, int wr, int wc, int fr, int fq) const {
        const int br = u.e; const int col = u.pn * 256 + wc * 64 + 16 * fq;
        if (br < 2) {
#pragma unroll
            for (int ai = 0; ai < 2; ++ai) {
                v4u gn[4], gd[4];
#pragma unroll
                for (int m = 0; m < 4; ++m) { const unsigned char* gp = gates + (size_t)(u.pm * 256 + ai * 128 + wr * 64 + m * 16 + fr) * GATEW + br * 1024 + col;
                    gn[m] = *(const GAS v4u*)gp; gd[m] = *(const GAS v4u*)(gp + 1024); }
#pragma unroll
                for (int m = 0; m < 4; ++m)
#pragma unroll
                    for (int bj = 0; bj < 2; ++bj)
#pragma unroll
                        for (int n = 0; n < 2; ++n) { const unsigned a4 = gn[m][2 * bj + n], b4 = gd[m][2 * bj + n];
#pragma unroll
                            for (int j = 0; j < 4; ++j) acc[ai][bj][m][n][j] *= (float)((a4 >> (8 * j)) & 255u) * __builtin_amdgcn_rcpf((float)((b4 >> (8 * j)) & 255u)); }
                asm volatile("" ::: "memory"); }
            return;
        }
        const int hi = fr >> 3, r7 = fr & 7;
#pragma unroll
        for (int ai = 0; ai < 2; ++ai) {
            v4u gw[4];
#pragma unroll
            for (int m = 0; m < 4; ++m) gw[m] = *(const GAS v4u*)(gates + (size_t)(u.pm * 256 + ai * 128 + wr * 64 + m * 16 + fr) * GATEW + 2 * 1024 + col);
#pragma unroll
            for (int m = 0; m < 4; ++m) { v4u w[2];
#pragma unroll
                for (int bj = 0; bj < 2; ++bj) { float r[8];
#pragma unroll
                    for (int n = 0; n < 2; ++n) { const unsigned g4 = gw[m][2 * bj + n];
#pragma unroll
                        for (int j = 0; j < 4; ++j) r[4 * n + j] = acc[ai][bj][m][n][j] * ((float)((g4 >> (8 * j)) & 255u) * (1.0f / 255.0f)); }
                    w[bj].x = pg8::cvt_pk_bf16(r[0], r[1]); w[bj].y = pg8::cvt_pk_bf16(r[2], r[3]); w[bj].z = pg8::cvt_pk_bf16(r[4], r[5]); w[bj].w = pg8::cvt_pk_bf16(r[6], r[7]); }
                v4u s0, s1; XCHG8(v4u, xor8_v4u, w[0], w[1], hi, s0, s1);
                bf16* rowp = merged + (size_t)(u.pm * 256 + ai * 128 + wr * 64 + m * 16 + r7) * D + col + 8 * hi;
                *(GAS v4u*)rowp = s0; *(GAS v4u*)(rowp + (size_t)8 * D) = s1; }
            asm volatile("" ::: "memory"); }
    }
};
struct P3Order {
    pg8::DenseOrder Dn; const char* Abase; const char* wsb; size_t lofs;
    __device__ __forceinline__ bool next(int i, pg8::Unit& u) const { if (!Dn.next(i / 3, u)) return false; u.e = i % 3; u.ui = i; return true; }
    __device__ __forceinline__ const char* a_base(const pg8::Unit& u) const { const size_t ko = (size_t)((u.e + 1) >> 1) * 1024 + (size_t)(u.e >> 1) * 512; return Abase + ko + (size_t)u.pm * Dn.tstepA; }
    __device__ __forceinline__ int K_of(const pg8::Unit& u) const { return 512 - 256 * (u.e & 1); }
    __device__ __forceinline__ int ldb_of(const pg8::Unit& u) const { return 512 - 256 * (u.e & 1); }
    __device__ __forceinline__ const char* b_base(const pg8::Unit& u) const {
        const size_t kb = (size_t)(512 - 256 * (u.e & 1)) * 2;
        const size_t base = WS_WBRA + (size_t)((u.e + 1) >> 1) * (WS_WBRB - WS_WBRA) + (size_t)(u.e >> 1) * (WS_WBRC - WS_WBRB);
        return wsb + base + lofs * (size_t)D * kb + (size_t)u.pn * 256 * kb; }
    __device__ __forceinline__ int a_row(const pg8::Unit&, int) const { return 0; }
    __device__ __forceinline__ bool keep_acc(const pg8::Unit& u) const { return u.e != 2; }
};
struct EpiP4 {
    static constexpr bool PERM = true, ADJ = true; static constexpr bool EXACT = true; static constexpr int NSTORE = 16, NSTORE_LO = 0;
    static __device__ __forceinline__ int nst(const pg8::Unit&) { return 2; }
    const bf16* hbc; bf16* vb;
    __device__ __forceinline__ void operator()(const f32x4 (&acc)[2][2][4][2], const pg8::Unit& u, int wr, int wc, int fr, int fq) const {
        const int hi = fr >> 3, r7 = fr & 7, col = u.pn * 256 + wc * 64 + 16 * fq + 8 * hi;
#pragma unroll
        for (int ai = 0; ai < 2; ++ai) { v4u hv[4][2];
#pragma unroll
            for (int m = 0; m < 4; ++m)
#pragma unroll
                for (int k = 0; k < 2; ++k) hv[m][k] = *(const GAS v4u*)(hbc + (size_t)(u.pm * 256 + ai * 128 + wr * 64 + m * 16 + 8 * k + r7) * D + col);
#pragma unroll
            for (int m = 0; m < 4; ++m) { f32x4 x0[2], x1[2];
                XCHG8(f32x4, xor8_f4, acc[ai][0][m][0], acc[ai][1][m][0], hi, x0[0], x0[1]);
                XCHG8(f32x4, xor8_f4, acc[ai][0][m][1], acc[ai][1][m][1], hi, x1[0], x1[1]);
#pragma unroll
                for (int k = 0; k < 2; ++k) { const v4u h4 = hv[m][k]; const f32x4 a0 = x0[k], a1 = x1[k]; float r[8];
#pragma unroll
                    for (int j = 0; j < 4; ++j) { const unsigned hw = h4[j]; const float av0 = j < 2 ? a0[2 * j] : a1[2 * j - 4], av1 = j < 2 ? a0[2 * j + 1] : a1[2 * j - 3];
                        r[2 * j] = ALPHA * __uint_as_float(hw << 16) + av0; r[2 * j + 1] = ALPHA * __uint_as_float(hw & 0xffff0000u) + av1; }
                    v4u w; w.x = pg8::cvt_pk_bf16(r[0], r[1]); w.y = pg8::cvt_pk_bf16(r[2], r[3]); w.z = pg8::cvt_pk_bf16(r[4], r[5]); w.w = pg8::cvt_pk_bf16(r[6], r[7]);
                    *(GAS v4u*)(vb + (size_t)(u.pm * 256 + ai * 128 + wr * 64 + m * 16 + 8 * k + r7) * D + col) = w; } }
            asm volatile("" ::: "memory"); }
    }
};
struct EpiP7 {
    static constexpr bool PERM = true, ADJ = false; static constexpr bool EXACT = true; static constexpr int NSTORE = 8, NSTORE_LO = 0;
    static __device__ __forceinline__ int nst(const pg8::Unit&) { return 2; }
    bf16* hid;
    __device__ __forceinline__ void operator()(const f32x4 (&acc)[2][2][4][2], const pg8::Unit& u, int wr, int wc, int fr, int fq) const {
        const int row0 = u.pm * 256 + wr * 64 + fr, col0 = u.pn * 128 + wc * 32 + 8 * fq;
#pragma unroll
        for (int ai = 0; ai < 2; ++ai)
#pragma unroll
            for (int m = 0; m < 4; ++m) { float r[8];
#pragma unroll
                for (int n = 0; n < 2; ++n)
#pragma unroll
                    for (int j = 0; j < 4; ++j) { const float gv = acc[ai][0][m][n][j], uv = acc[ai][1][m][n][j]; r[4 * n + j] = gv * __builtin_amdgcn_rcpf(1.0f + __builtin_amdgcn_exp2f(-LOG2E * gv)) * uv; }
                v4u w; w.x = pg8::cvt_pk_bf16(r[0], r[1]); w.y = pg8::cvt_pk_bf16(r[2], r[3]); w.z = pg8::cvt_pk_bf16(r[4], r[5]); w.w = pg8::cvt_pk_bf16(r[6], r[7]);
                *(GAS v4u*)(hid + (size_t)(row0 + ai * 128 + m * 16) * DE + col0) = w; }
    }
};
constexpr size_t P8_DUMMY = (WS_GATES + 100 * MiB - WS_YB) / 2;
struct EpiP8 {
    static constexpr bool PERM = true, ADJ = true; static constexpr int NSTORE = 16;
    static constexpr bool EXACT = false; static constexpr int NSTORE_LO = 0;
    static __device__ __forceinline__ int nst(const pg8::Unit&) { return 2; }
    bf16* yb; const LAS int* rows;
    __device__ __forceinline__ void operator()(const f32x4 (&acc)[2][2][4][2], const pg8::Unit& u, int wr, int wc, int fr, int fq) const {
        const int hi = fr >> 3, r7 = fr & 7, col = u.pn * 256 + wc * 64 + 16 * fq + 8 * hi;
        const LAS int* rw = rows + u.ui * 256 + wr * 64;
#pragma unroll
        for (int ai = 0; ai < 2; ++ai)
#pragma unroll
            for (int m = 0; m < 4; ++m) { const int rl = ai * 128 + m * 16;
                const unsigned wown = (unsigned)rw[rl + fr], w0 = (unsigned)rw[rl + r7], w1 = (unsigned)rw[rl + 8 + r7];
                const float gt = __uint_as_float((wown & 0x7fffu) << 16);
                v4u w[2];
#pragma unroll
                for (int bj = 0; bj < 2; ++bj) { const f32x4 v0 = acc[ai][bj][m][0] * gt, v1 = acc[ai][bj][m][1] * gt;
                    w[bj].x = pg8::cvt_pk_bf16(v0[0], v0[1]); w[bj].y = pg8::cvt_pk_bf16(v0[2], v0[3]); w[bj].z = pg8::cvt_pk_bf16(v1[0], v1[1]); w[bj].w = pg8::cvt_pk_bf16(v1[2], v1[3]); }
                v4u s0, s1; XCHG8(v4u, xor8_v4u, w[0], w[1], hi, s0, s1);
                if (w0 != 0xFFFFFFFFu) *(GAS v4u*)(yb + (size_t)(w0 >> 15) * D + col) = s0;
                if (w1 != 0xFFFFFFFFu) *(GAS v4u*)(yb + (size_t)(w1 >> 15) * D + col) = s1; }
    }
};

typedef float f32x2 __attribute__((ext_vector_type(2)));
template <int N> __device__ __forceinline__ void wave_sum_n(float (&v)[N]) {
#pragma unroll
    for (int s = 0; s < 4; ++s)
#pragma unroll
        for (int n = 0; n < N; ++n) v[n] = dpp_add(v[n], s);
#pragma unroll
    for (int n = 0; n < N; ++n) { const int x = __builtin_bit_cast(int, v[n]);
        const float r0 = __builtin_bit_cast(float, __builtin_amdgcn_readlane(x, 0)), r1 = __builtin_bit_cast(float, __builtin_amdgcn_readlane(x, 16)),
                    r2 = __builtin_bit_cast(float, __builtin_amdgcn_readlane(x, 32)), r3 = __builtin_bit_cast(float, __builtin_amdgcn_readlane(x, 48));
        v[n] = (r0 + r1) + (r2 + r3); }
}
__device__ __forceinline__ void router_row(const float (&x)[16], int t, int lane, const f32x4 (&wg)[16], const float* b_rg, const LAS float* w_re, const float* b_re, LAS int* lcnt, int wslot, Rec* rec) {
    f32x2 g01 = (f32x2){0.f, 0.f}, g23 = (f32x2){0.f, 0.f};
#pragma unroll
    for (int k = 0; k < 16; ++k) { const f32x4 w = wg[k]; const f32x2 xv = (f32x2){x[k], x[k]}; g01 = xv * (f32x2){w.x, w.y} + g01; g23 = xv * (f32x2){w.z, w.w} + g23; }
    float gl[4] = {g01.x, g01.y, g23.x, g23.y};
    wave_sum_n<4>(gl);
#pragma unroll
    for (int g = 0; g < 4; ++g) gl[g] += b_rg[g];
    int gi = 0; float gm = gl[0];
#pragma unroll
    for (int g = 1; g < 4; ++g) if (gl[g] > gm) { gm = gl[g]; gi = g; }
    float gs = 0.f;
#pragma unroll
    for (int g = 0; g < 4; ++g) gs += __expf(gl[g] - gm);
    const float gw = 1.0f / gs;
    f32x2 e01 = (f32x2){0.f, 0.f}, e23 = e01, e45 = e01, e67 = e01;
    const LAS float* wre = w_re + gi * (D * 8);
#pragma unroll
    for (int j = 0; j < 4; ++j)
#pragma unroll
        for (int i = 0; i < 4; ++i) { const LAS float* wp = wre + ((j * 4 + i) * 128 + lane) * 4; const f32x4 w0 = *(const LAS f32x4*)wp, w1 = *(const LAS f32x4*)(wp + 256); const f32x2 xv = (f32x2){x[4 * j + i], x[4 * j + i]};
            e01 = xv * (f32x2){w0.x, w0.y} + e01; e23 = xv * (f32x2){w0.z, w0.w} + e23; e45 = xv * (f32x2){w1.x, w1.y} + e45; e67 = xv * (f32x2){w1.z, w1.w} + e67; }
    float el[8] = {e01.x, e01.y, e23.x, e23.y, e45.x, e45.y, e67.x, e67.y};
    wave_sum_n<8>(el);
#pragma unroll
    for (int e = 0; e < 8; ++e) el[e] += b_re[gi * 8 + e];
    int i0 = 0; float t0 = el[0];
#pragma unroll
    for (int e = 1; e < 8; ++e) if (el[e] > t0) { t0 = el[e]; i0 = e; }
    int i1 = -1; float t1 = -3.0e38f;
#pragma unroll
    for (int e = 0; e < 8; ++e) if (e != i0 && el[e] > t1) { t1 = el[e]; i1 = e; }
    const float ex = __expf(t1 - t0), p0 = 1.0f / (1.0f + ex), p1 = ex / (1.0f + ex);
    if (lane == 0) {
        const int e0 = gi * 8 + i0, e1 = gi * 8 + i1;
        const int s0 = __hip_atomic_fetch_add(lcnt + e0, 1, __ATOMIC_RELAXED, __HIP_MEMORY_SCOPE_WORKGROUP), s1 = __hip_atomic_fetch_add(lcnt + e1, 1, __ATOMIC_RELAXED, __HIP_MEMORY_SCOPE_WORKGROUP);
        *((GAS v4u*)rec + t) = (v4u){__float_as_uint(gw * p0), __float_as_uint(gw * p1), (unsigned)e0 | ((unsigned)e1 << 8) | ((unsigned)wslot << 16), (unsigned)s0 | ((unsigned)s1 << 16)};
    }
}

#ifndef STAG_P1
#define STAG_P1 500
#endif
__device__ __forceinline__ void stagger(int vcu, unsigned q) {
    const unsigned long long t0 = __builtin_amdgcn_s_memrealtime(); const unsigned long long d = (unsigned long long)((vcu & 3) * q);
    while (__builtin_amdgcn_s_memrealtime() - t0 < d) __builtin_amdgcn_s_sleep(8);
}
__device__ __forceinline__ void ph_ln0(Frame& F) { LAUNDER(F);
    const int gw = F.vcu * NWAVES + F.wave, NGW = F.G * NWAVES;
    bf16* hb = (bf16*)(F.ws + WS_HB);
    f32x4 gg[4], bb[4]; ln_params(gg, bb, F.in[1], F.in[2], F.lane);
    LnIn cur, nxt, nx2; if (gw < T) ln_load<0>(cur, F.in[0], nullptr, nullptr, (size_t)gw, F.lane);
    if (gw + NGW < T) ln_load<0>(nxt, F.in[0], nullptr, nullptr, (size_t)(gw + NGW), F.lane);
    for (int m = gw; m < T; m += NGW) { const bool more = m + NGW < T, more2 = m + 2 * NGW < T; if (more2) ln_load<0>(nx2, F.in[0], nullptr, nullptr, (size_t)(m + 2 * NGW), F.lane);
        f32x4 o[4]; ln_finish<0>(cur, nullptr, hb, gg, bb, (size_t)m, F.lane, o); if (more) { cur = nxt; nxt = nx2; } }
}
__device__ __forceinline__ void ph_p1(Frame& F, int l, int c) { LAUNDER(F); asm volatile("" : "+s"(l), "+s"(c));
    pg8::DenseOrder S; S.init((const bf16*)(F.ws + WS_HB) + (size_t)c * CH * D, D, (const bf16*)(F.ws + WS_WIN) + (size_t)l * NCOL * D, D, CH, NCOL, F.G, (int)blockIdx.x);
    EpiP1 E{(bf16*)(F.ws + WS_QKV), (unsigned char*)(F.ws + WS_GATES), F.in[5] + (size_t)l * GATEW, F.probe};
    pg8::gemm_phase<EpiP1, pg8::DenseOrder, false>(F.lds + RING_OFF, S, E, D, D, D, F.tid);
}
__device__ __forceinline__ void ph_cmb(Frame& F) { LAUNDER(F);
    const bf16* og = (const bf16*)(F.ws + WS_OG); const float* lse = (const float*)(F.ws + WS_LSE); bf16* oabc = (bf16*)(F.ws + WS_OABC);
    for (int idx = F.vcu * NTHREADS + F.tid; idx < CH * 32; idx += F.G * NTHREADS) {
        const int tl = idx >> 5, hc = idx & 31, h = hc >> 3, c = hc & 7;
        const GAS float* lg = (const GAS float*)lse + (size_t)tl * 12 + h; const float l0 = lg[0], l1 = lg[4], l2 = lg[8];
        const float mx = fmaxf(l0, fmaxf(l1, l2)); float w0 = __expf(l0 - mx), w1 = __expf(l1 - mx), w2 = __expf(l2 - mx); const float inv = 1.0f / (w0 + w1 + w2); w0 *= inv; w1 *= inv; w2 *= inv;
        const v4u a = *(const GAS v4u*)(og + ((size_t)tl * 3 + 0) * 256 + h * 64 + c * 8), b = *(const GAS v4u*)(og + ((size_t)tl * 3 + 1) * 256 + h * 64 + c * 8), d = *(const GAS v4u*)(og + ((size_t)tl * 3 + 2) * 256 + h * 64 + c * 8);
        v4u ow;
#pragma unroll
        for (int i = 0; i < 4; ++i) {
            const float lo = w0 * __uint_as_float(a[i] << 16) + w1 * __uint_as_float(b[i] << 16) + w2 * __uint_as_float(d[i] << 16);
            const float hi = w0 * __uint_as_float(a[i] & 0xffff0000u) + w1 * __uint_as_float(b[i] & 0xffff0000u) + w2 * __uint_as_float(d[i] & 0xffff0000u);
            ow[i] = pk2(lo, hi);
        }
        *(GAS v4u*)(oabc + (size_t)tl * OW + 512 + h * 64 + c * 8) = ow;
    }
}
__device__ __forceinline__ void ph_p3(Frame& F, int l) { LAUNDER(F); asm volatile("" : "+s"(l));
    const bf16* oabc = (const bf16*)(F.ws + WS_OABC); bf16* merged = (bf16*)(F.ws + WS_MERGED); const unsigned char* gates = (const unsigned char*)(F.ws + WS_GATES);
    P3Order S; S.Dn.init(oabc, OW, nullptr, 0, CH, D, F.G, (int)blockIdx.x);
    S.Abase = (const char*)oabc; S.wsb = (const char*)F.ws; S.lofs = (size_t)l;
    EpiP3V E{merged, gates};
    pg8::gemm_phase_vk<EpiP3V, P3Order>(F.lds + RING_OFF, S, E, OW, F.tid);
}
__device__ __forceinline__ void ph_p4(Frame& F, int l, int c) { LAUNDER(F); asm volatile("" : "+s"(l), "+s"(c));
    pg8::DenseOrder S; S.init((const bf16*)(F.ws + WS_MERGED), D, (const bf16*)(F.ws + WS_WOUT) + (size_t)l * D * D, D, CH, D, F.G, (int)blockIdx.x);
    EpiP4 E{(const bf16*)(F.ws + WS_HB) + (size_t)c * CH * D, F.probe ? (bf16*)(F.ws + WS_OABC) : (bf16*)F.h + (size_t)c * CH * D};
    pg8::gemm_phase<EpiP4, pg8::DenseOrder, false>(F.lds + RING_OFF, S, E, D, D, D, F.tid);
}
__device__ __forceinline__ void ph_ln1(Frame& F, int l, int c) { LAUNDER(F); asm volatile("" : "+s"(l), "+s"(c));
    const int gw = F.vcu * NWAVES + F.wave, NGW = F.G * NWAVES;
    bf16* hb = (bf16*)(F.ws + WS_HB); Rec* rec = (Rec*)(F.ws + WS_REC);
    int* wgc = (int*)(F.ws + WS_WGCNT) + ((size_t)(l * NCHUNK + c) * F.G + F.vcu) * 32;
    if (F.probe) { hb = (bf16*)(F.ws + WS_QKV) - (size_t)c * CH * D; wgc = (int*)(F.ws + WS_WGCNT) + (size_t)DEPTH * NCHUNK * 256 * 32 + F.vcu * 32; rec = (Rec*)(F.ws + WS_GATES); }
    LAS float* lrg = (LAS float*)(F.lds + RING_OFF); LAS float* lre = lrg + D * 4; LAS int* lcnt = (LAS int*)(F.lds + LCNT_OFF);
    { const float* w_rg = F.in[14] + (size_t)l * D * 4; const float* w_re = F.in[16] + (size_t)l * 4 * D * 8;
      if (F.tid < 32) lcnt[F.tid] = 0;
      for (int u = F.tid; u < D + 4 * D * 2; u += NTHREADS) {
          if (u < D) { const int e = u, ln = (e & 511) >> 3, k = (e >> 9) * 8 + (e & 7); *(LAS f32x4*)(lrg + (k * 64 + ln) * 4) = *(const GAS f32x4*)(w_rg + (size_t)e * 4); }
          else { const int v = u - D, half = v & 1, e = (v >> 1) & 1023, g = v >> 11, ln = (e & 511) >> 3, k = (e >> 9) * 8 + (e & 7);
                 *(LAS f32x4*)(lre + g * (D * 8) + ((k * 2 + half) * 64 + ln) * 4) = *(const GAS f32x4*)(w_re + ((size_t)g * D + e) * 8 + half * 4); } }
      __syncthreads(); }
    f32x4 wg[16];
#pragma unroll
    for (int j = 0; j < 4; ++j)
#pragma unroll
        for (int i = 0; i < 4; ++i) wg[4 * j + i] = *(const LAS f32x4*)(lrg + ((j * 4 + i) * 64 + F.lane) * 4);
    const size_t rbase = (size_t)c * CH;
    const bf16* vsrc = (const bf16*)F.h;
    f32x4 gg[4], bb[4]; ln_params(gg, bb, F.in[12] + l * D, F.in[13] + l * D, F.lane);
    LnIn cur, nxt, nx2; if (gw < CH) ln_load<1>(cur, nullptr, vsrc, nullptr, rbase + gw, F.lane);
    if (gw + NGW < CH) ln_load<1>(nxt, nullptr, vsrc, nullptr, rbase + gw + NGW, F.lane);
    for (int m = gw; m < CH; m += NGW) {
        const bool more = m + NGW < CH, more2 = m + 2 * NGW < CH; if (more2) ln_load<1>(nx2, nullptr, vsrc, nullptr, rbase + m + 2 * NGW, F.lane);
        const size_t row = rbase + m; f32x4 o[4];
        ln_finish<1>(cur, nullptr, hb, gg, bb, row, F.lane, o);
        float x[16];
#pragma unroll
        for (int j = 0; j < 4; ++j) { x[4 * j] = o[j].x; x[4 * j + 1] = o[j].y; x[4 * j + 2] = o[j].z; x[4 * j + 3] = o[j].w; }
        router_row(x, (int)row, F.lane, wg, F.in[15] + l * 4, lre, F.in[17] + l * 32, lcnt, c * F.G + F.vcu, rec);
        if (more) { cur = nxt; nxt = nx2; }
    }
    __syncthreads();
    if (F.tid < 32) *(GAS int*)(wgc + F.tid) = lcnt[F.tid];
}
__device__ __forceinline__ void ph_dsp(Frame& F, int l) { LAUNDER(F); asm volatile("" : "+s"(l));
    LAS int* Tb = (LAS int*)(F.lds + RING_OFF); LAS int* part = Tb + 512 * 32; LAS int* po = part + 32 * 16;
    const int* wg = (const int*)(F.ws + WS_WGCNT) + (size_t)l * NCHUNK * F.G * 32; const int W = NCHUNK * F.G;
    int* cnt = (int*)(F.ws + WS_CTL) + CW_CNT + l * (32 * CSTR); const Rec* rec = (const Rec*)(F.ws + WS_REC); int* rowtok = (int*)(F.ws + WS_ROWTOK); float* rowgate = (float*)(F.ws + WS_ROWGATE);
    for (int i = F.tid; i < W * 32; i += NTHREADS) Tb[i] = *(const GAS int*)(wg + i);
    __syncthreads();
    const int e = F.tid >> 4, k = F.tid & 15, per = (W + 15) / 16, w0 = k * per, w1 = (w0 + per) < W ? (w0 + per) : W;
    { int s = 0; for (int w = w0; w < w1; ++w) s += Tb[w * 32 + e]; part[e * 16 + k] = s; }
    __syncthreads();
    { int base = 0; for (int kk = 0; kk < k; ++kk) base += part[e * 16 + kk];
      for (int w = w0; w < w1; ++w) { const int t = Tb[w * 32 + e]; Tb[w * 32 + e] = base; base += t; } }
    __syncthreads();
    LAS int* tot = po + 40;
    if (F.tid < NE) { int t_ = 0; for (int kk = 0; kk < 16; ++kk) t_ += part[F.tid * 16 + kk]; tot[F.tid] = t_; }
    __syncthreads();
    if (F.tid < NE) part[F.tid * 16] = tot[F.tid];
    if (F.tid == 0) { int acc = 0; for (int ee = 0; ee < NE; ++ee) { po[ee] = acc; acc += (tot[ee] + 255) / 256 * 256; } po[NE] = acc; }
    __syncthreads();
    if (F.vcu == 0 && F.tid < 32) cnt[F.tid * CSTR] = part[F.tid * 16];
    const int gt = F.vcu * NTHREADS + F.tid, GT = F.G * NTHREADS;
    for (int t = gt; t < T; t += GT) {
        const v4u ra = *((const GAS v4u*)rec + t);
        Rec rc; rc.g0 = __uint_as_float(ra.x); rc.g1 = __uint_as_float(ra.y); rc.e0 = (int)(ra.z & 255u); rc.e1 = (int)((ra.z >> 8) & 255u); rc.pad0 = (int)(ra.z >> 16); rc.s0 = (int)(ra.w & 0xffffu); rc.s1 = (int)(ra.w >> 16); rc.pad1 = 0;
        const int d0 = po[rc.e0] + Tb[rc.pad0 * 32 + rc.e0] + rc.s0, d1 = po[rc.e1] + Tb[rc.pad0 * 32 + rc.e1] + rc.s1;
        *(GAS unsigned*)(rowtok + d0) = ((unsigned)(2 * t) << 15) | ((unsigned)f2bf(rc.g0) & 0x7fffu); *(GAS unsigned*)(rowtok + d1) = ((unsigned)(2 * t + 1) << 15) | ((unsigned)f2bf(rc.g1) & 0x7fffu);
    }
    for (int ee = 0; ee < NE; ++ee) for (int r = po[ee] + part[ee * 16] + gt; r < po[ee + 1]; r += GT) { *(GAS int*)(rowtok + r) = -1; }
    __syncthreads();
}
#define CW_MOE 3000
__device__ __forceinline__ int moe_setup(Frame& F, int l, int part, int shifted, int& Rout) { LAUNDER(F); asm volatile("" : "+s"(l));
    LAS int* rows = (LAS int*)(F.lds + ROWS_OFF); LAS int* ulist = rows + 11 * 256; LAS int* po = ulist + 16;
    const int* cnt = (const int*)(F.ws + WS_CTL) + CW_CNT + l * (32 * CSTR); const int* rowtok = (const int*)(F.ws + WS_ROWTOK);
    LAS int* tot = po + 40;
    if (F.tid < NE) tot[F.tid] = *(const GAS int*)(cnt + F.tid * CSTR);
    __syncthreads();
    if (F.tid == 0) { int acc = 0; for (int e = 0; e < NE; ++e) { po[e] = acc; acc += (tot[e] + 255) / 256 * 256; } po[NE] = acc; }
    __syncthreads();
    const int nu_all = (po[NE] / 256) * 4, W = nu_all / F.G, R = nu_all - W * F.G; Rout = R;
    int nun, base, stride;
    if (part == 0) { nun = W > 11 ? 11 : W; base = F.vcu; stride = F.G; }
    else { int j = F.vcu - (shifted ? R : 0); if (j < 0) j += F.G; nun = (j < R) ? 1 : 0; base = W * F.G + j; stride = 0; }
    if (F.tid < nun) { const int Lx = base + F.tid * stride, rt = Lx >> 2, pn = Lx & 3; int e = 0; while (e < NE - 1 && po[e + 1] <= rt * 256) ++e; ulist[F.tid] = (rt << 8) | (e << 2) | pn; }
    for (int idx = F.tid; idx < nun * 256; idx += NTHREADS) { const int i = idx >> 8, r = idx & 255, Lx = base + i * stride; rows[idx] = *(const GAS int*)(rowtok + (Lx >> 2) * 256 + r); }
    __syncthreads();
    return nun;
}
__device__ __forceinline__ void moe_signal(Frame& F, int l, bool did) {
    asm volatile("s_waitcnt vmcnt(0)" ::: "memory"); __syncthreads();
    if (did && F.wave == 0 && xb_lane() == 0u) { __builtin_amdgcn_fence(__ATOMIC_RELEASE, "agent"); asm volatile("s_waitcnt vmcnt(0)" ::: "memory"); (void)xb_add((unsigned*)(F.ws + WS_CTL) + CW_MOE + l * 64, 1u); }
}
__device__ __forceinline__ void moe_wait(Frame& F, int l, int R) {
    if (F.wave == 0 && xb_lane() == 0u) { unsigned* c2 = (unsigned*)(F.ws + WS_CTL) + CW_MOE + l * 64; unsigned* bar = (unsigned*)(F.ws + WS_CTL) + CW_BAR;
        XB_SPIN(xb_ld(c2) < (unsigned)R, bar);
        __builtin_amdgcn_fence(__ATOMIC_ACQUIRE, "agent"); asm volatile("s_waitcnt vmcnt(0)" ::: "memory"); }
    __syncthreads();
}
struct MoeOrder {
    int nun; const LAS int* ulist; const LAS int* rows; const char* A; const char* B; size_t tstepA, estepB, tstepB;
    __device__ __forceinline__ bool next(int i, pg8::Unit& u) const {
        if (i >= nun) return false;
        const int w = __builtin_amdgcn_readfirstlane(ulist[i]); u.pm = w >> 8; u.e = (w >> 2) & 63; u.pn = w & 3; u.ui = i; return true;
    }
    __device__ __forceinline__ const char* a_base(const pg8::Unit& u) const { return A + (size_t)u.pm * tstepA; }
    __device__ __forceinline__ const char* b_base(const pg8::Unit& u) const { return B + (size_t)u.e * estepB + (size_t)u.pn * tstepB; }
    __device__ __forceinline__ int a_row(const pg8::Unit& u, int r) const { const int t = rows[u.ui * 256 + r]; return t == -1 ? 0 : (int)((unsigned)t >> 16); }
};
__device__ __forceinline__ void ph_p7(Frame& F, int l, const int part) { LAUNDER(F); asm volatile("" : "+s"(l));
    int R; const int nun = moe_setup(F, l, part, 0, R);
    LAS int* rows = (LAS int*)(F.lds + ROWS_OFF);
    MoeOrder S{nun, rows + 11 * 256, rows, (const char*)(F.ws + WS_HB), (const char*)(F.ws + WS_WGU) + (size_t)l * NE * 1024 * 1024 * 2, 0, (size_t)1024 * 1024 * 2, (size_t)256 * 1024 * 2};
    EpiP7 E{(bf16*)(F.ws + WS_HID)};
    pg8::gemm_phase<EpiP7, MoeOrder, true>(F.lds + RING_OFF, S, E, D, D, D, F.tid);
    if (part == 1) moe_signal(F, l, nun > 0);
}
__device__ __forceinline__ void ph_p8(Frame& F, int l, const int part) { LAUNDER(F); asm volatile("" : "+s"(l));
    int R; const int nun = moe_setup(F, l, part, 1, R);
    if (part == 1) { if (nun == 0) return; moe_wait(F, l, R); }
    LAS int* rows = (LAS int*)(F.lds + ROWS_OFF);
    MoeOrder S{nun, rows + 11 * 256, rows, (const char*)(F.ws + WS_HID), (const char*)(F.ws + WS_WD) + (size_t)l * NE * 1024 * 512 * 2, (size_t)256 * DE * 2, (size_t)1024 * 512 * 2, (size_t)256 * 512 * 2};
    EpiP8 E{(bf16*)(F.ws + WS_YB), rows};
    pg8::gemm_phase<EpiP8, MoeOrder, false>(F.lds + RING_OFF, S, E, DE, DE, DE, F.tid);
}
__device__ __forceinline__ void ph_ln2(Frame& F, int l) { LAUNDER(F); asm volatile("" : "+s"(l));
    const int gw = F.vcu * NWAVES + F.wave, NGW = F.G * NWAVES;
    const bool lastl = (l == DEPTH - 1);
    const bf16* hsb = (const bf16*)(F.ws + WS_HB); const bf16* yb = (const bf16*)(F.ws + WS_YB);
    bf16* hb = lastl ? nullptr : (bf16*)(F.ws + WS_HB); float* hout = lastl ? F.h : nullptr; size_t omask = ~(size_t)0;
    if (F.probe) { hout = lastl ? (float*)(F.ws + WS_OABC) : nullptr; hb = lastl ? nullptr : (bf16*)(F.ws + WS_OABC); omask = 32767; }
    f32x4 gg[4], bb[4]; ln_params(gg, bb, F.in[21] + l * D, F.in[22] + l * D, F.lane);
    LnIn cur, nxt, nx2; if (gw < T) ln_load<2>(cur, nullptr, hsb, yb, (size_t)gw, F.lane);
    if (gw + NGW < T) ln_load<2>(nxt, nullptr, hsb, yb, (size_t)(gw + NGW), F.lane);
    for (int m = gw; m < T; m += NGW) { const bool more = m + NGW < T, more2 = m + 2 * NGW < T; if (more2) ln_load<2>(nx2, nullptr, hsb, yb, (size_t)(m + 2 * NGW), F.lane);
        const size_t back = ((size_t)m - ((size_t)m & omask)) * D;
        f32x4 o[4]; ln_finish<2>(cur, hout ? hout - back : nullptr, hb ? hb - back : nullptr, gg, bb, (size_t)m, F.lane, o); if (more) { cur = nxt; nxt = nx2; } }
}

typedef short s16x4 __attribute__((ext_vector_type(4)));
constexpr int NT_A = (CH / 32) * 4, NT_B = (CH / L) * 3 * 128 * 4, NT_C = (CH / 64) * 8, NT_ALL = NT_A + NT_B + NT_C;
constexpr float NEGBIG = -1.0e30f, MINIT = -5.0e29f;
#define RC16(reg) (((reg) & 3) + 8 * ((reg) >> 2))
#define QPLANE(col) ((size_t)((col) >> 6) * ((size_t)CH * 64))

__device__ __forceinline__ void ph_tables(Frame& F) { LAUNDER(F);
    float* TA = (float*)(F.ws + WS_TABA); float* TB = (float*)(F.ws + WS_TABB); float* TC = (float*)(F.ws + WS_TABC);
    const float* rel_bias = F.in[3]; const float* rpb = F.in[7];
    const int gt = F.vcu * NTHREADS + F.tid, GT = F.G * NTHREADS;
    for (int i = gt; i < 8 * 320; i += GT) { const int h = i / 320, rel = i % 320 - 160; *(GAS float*)(TA + i) = (rel >= -128 && rel <= 128) ? rel_bias[BUCK_A[rel + 128] * 20 + h] * LOG2E : NEGBIG; }
    for (int i = gt; i < 12 * 256; i += GT) { const int gh = i >> 8, g = gh >> 2, rel = (i & 255) - 128; *(GAS float*)(TB + i) = (rel >= -64 && rel <= 64) ? rel_bias[BUCK_B[g][rel + 64] * 20 + 8 + gh] * LOG2E : NEGBIG; }
    for (int i = gt; i < DEPTH * 8 * 1024; i += GT) { const int lh = i >> 10, ri = (i >> 6) & 15, ci = (i & 63) - 16; *(GAS float*)(TC + i) = (ri < 15 && ci >= 0 && ci <= 30) ? rpb[((size_t)lh * 15 + ri) * 31 + ci] * LOG2E : NEGBIG; }
}

#define ATT_INIT(S, TBP, BIDX, XM) do { \
        _Pragma("unroll") for (int r_ = 0; r_ < 16; ++r_) { float v_ = (TBP)[(BIDX) + RC16(r_)]; if (TYPE == 2) v_ = ((unsigned)((XM) + RC16(r_)) < 16u) ? v_ : NEGBIG; S[r_] = v_; } } while (0)
__device__ __forceinline__ float xhalf_max(float t) { float a_ = t, b_ = t; asm volatile("s_nop 1\n\tv_permlane32_swap_b32 %0, %1" : "+v"(a_), "+v"(b_)); return fmaxf(a_, b_); }
__device__ __forceinline__ float xhalf_sum(float t) { float a_ = t, b_ = t; asm volatile("s_nop 1\n\tv_permlane32_swap_b32 %0, %1" : "+v"(a_), "+v"(b_)); return a_ + b_; }
#define ATT_TMAX(S, t) do { t = NEGBIG; _Pragma("unroll") for (int r_ = 0; r_ < 16; ++r_) t = fmaxf(t, S[r_]); } while (0)
#define ATT_RESCALE(need, t, m, l, Oa, Ob) do { const float mn_ = (need) ? (t) : m, corr_ = __builtin_amdgcn_exp2f(m - mn_); m = mn_; l *= corr_; \
        _Pragma("unroll") for (int i_ = 0; i_ < 16; ++i_) { Oa[i_] *= corr_; Ob[i_] *= corr_; } } while (0)
#define ATT_EXP(S, m, rs) do { rs = 0.f; _Pragma("unroll") for (int r_ = 0; r_ < 16; ++r_) { const float p_ = __builtin_amdgcn_exp2f(S[r_] - m); S[r_] = p_; rs += p_; } } while (0)
#define ATT_PACK(Pf, S, s2) do { unsigned pw_[4]; _Pragma("unroll") for (int j_ = 0; j_ < 4; ++j_) pw_[j_] = pg8::cvt_pk_bf16(S[8 * (s2) + 2 * j_], S[8 * (s2) + 2 * j_ + 1]); \
        Pf = __builtin_bit_cast(bf16x8, (v4u){pw_[0], pw_[1], pw_[2], pw_[3]}); } while (0)
__device__ __forceinline__ void swap32(unsigned& a, unsigned& b) { asm volatile("s_nop 1\n\tv_permlane32_swap_b32 %0, %1" : "+v"(a), "+v"(b)); }
#define ATT_STAGE(st, Oa, Ob, l) do { const float inv_ = 1.0f / (l); const unsigned sb_ = (unsigned)(qi * 128); \
        _Pragma("unroll") for (int gp_ = 0; gp_ < 2; ++gp_) { \
            unsigned a0_ = pg8::cvt_pk_bf16(Oa[8 * gp_] * inv_, Oa[8 * gp_ + 1] * inv_), a1_ = pg8::cvt_pk_bf16(Oa[8 * gp_ + 2] * inv_, Oa[8 * gp_ + 3] * inv_); \
            unsigned b0_ = pg8::cvt_pk_bf16(Oa[8 * gp_ + 4] * inv_, Oa[8 * gp_ + 5] * inv_), b1_ = pg8::cvt_pk_bf16(Oa[8 * gp_ + 6] * inv_, Oa[8 * gp_ + 7] * inv_); \
            swap32(a0_, b0_); swap32(a1_, b1_); \
            *(LAS v4u*)((st) + sb_ + ((unsigned)((2 * gp_ + hh) ^ (qi & 7)) << 4)) = (v4u){a0_, a1_, b0_, b1_}; \
            unsigned c0_ = pg8::cvt_pk_bf16(Ob[8 * gp_] * inv_, Ob[8 * gp_ + 1] * inv_), c1_ = pg8::cvt_pk_bf16(Ob[8 * gp_ + 2] * inv_, Ob[8 * gp_ + 3] * inv_); \
            unsigned d0_ = pg8::cvt_pk_bf16(Ob[8 * gp_ + 4] * inv_, Ob[8 * gp_ + 5] * inv_), d1_ = pg8::cvt_pk_bf16(Ob[8 * gp_ + 6] * inv_, Ob[8 * gp_ + 7] * inv_); \
            swap32(c0_, d0_); swap32(c1_, d1_); \
            *(LAS v4u*)((st) + sb_ + ((unsigned)((4 + 2 * gp_ + hh) ^ (qi & 7)) << 4)) = (v4u){c0_, c1_, d0_, d1_}; } } while (0)
#define ATT_FLUSH(st, ob, tqs) do { \
        _Pragma("unroll") for (int i_ = 0; i_ < 4; ++i_) { const int r_ = (lane >> 3) + 8 * i_, c_ = lane & 7; \
            const v4u v_ = *(const LAS v4u*)((st) + (unsigned)(r_ * 128) + ((unsigned)(c_ ^ (r_ & 7)) << 4)); \
            *(GAS v4u*)((ob) + (size_t)((tqs) + ATT_LTOK(r_)) * ostr + c_ * 8) = v_; } } while (0)

template <int TYPE>
__device__ __forceinline__ void att_task2(LAS unsigned char* wl, const int lane, const bf16* seq  , const float* tab0, const float* tab1,
                                          const int qcol0, const int qcol1, const int kcol, const int vcol, const int TT0, const int TSTEP, const int kstride, const int tlo, const int thi,
                                          const int tqs0, const int tqs1  , const int toff1  ,
                                          const int gi0, const int gi1, const int gc, const int cbs  ,
                                          const float m_init0, const float m_init1, const float l_init, bf16* ob0, bf16* ob1, const int ostr, float* lb  , const int grp  , const bool load_tab) {
    const int qi = lane & 31, hh = lane >> 5;
#define ATT_LTOK(q_) (TYPE == 2 ? (((q_) >> 4) * 64 + ((q_) & 15)) : (q_) * (TYPE == 1 ? kstride : 1))
    const int tq0 = tqs0 + ATT_LTOK(qi), tq1 = tqs1 + ATT_LTOK(qi);
    LAS unsigned char* kt = wl; LAS unsigned char* vt = wl + 4096; LAS float* tbl = (LAS float*)(wl + 8192); LAS float* tb0 = (TYPE == 1) ? tbl + grp * 256 : tbl; LAS float* tb1 = (TYPE == 0) ? tb0 + 320 : tb0;
    constexpr int TBN = TYPE == 0 ? 320 : (TYPE == 1 ? 256 : 1024);
    if (load_tab) {
#pragma unroll
        for (int i = 0; i < TBN / 64; ++i) { tbl[lane + 64 * i] = *(const GAS float*)(tab0 + lane + 64 * i); if (TYPE == 0) tb1[lane + 64 * i] = *(const GAS float*)(tab1 + lane + 64 * i);
            if (TYPE == 1) { tbl[256 + lane + 64 * i] = *(const GAS float*)(tab0 + 1024 + lane + 64 * i); tbl[512 + lane + 64 * i] = *(const GAS float*)(tab0 + 2048 + lane + 64 * i); } } }
    bf16x8 Qa[4], Qb[4];
#pragma unroll
    for (int s = 0; s < 4; ++s) { Qa[s] = *(const GAS bf16x8*)(seq + QPLANE(qcol0) + (size_t)tq0 * 64 + 16 * s + 8 * hh); Qb[s] = *(const GAS bf16x8*)(seq + QPLANE(qcol1) + (size_t)tq1 * 64 + 16 * s + 8 * hh); }
    f32x16 O0a, O0b, O1a, O1b;
#pragma unroll
    for (int i = 0; i < 16; ++i) { O0a[i] = 0.f; O0b[i] = 0.f; O1a[i] = 0.f; O1b[i] = 0.f; }
    float m0 = m_init0, m1 = m_init1, l0 = l_init, l1 = l_init;
    const int lkey = lane >> 3, lch = lane & 7;
    const unsigned goff = (unsigned)(lkey * kstride) * 128u + 16u * (unsigned)lch;
    const size_t istepb = (size_t)8 * kstride * 128;
    const char* kbase = (const char*)(seq + QPLANE(kcol)); const char* vbase = (const char*)(seq + QPLANE(vcol));
    const unsigned kw0 = lkey * 128 + ((lch ^ (lkey & 7)) << 4), vw0 = lkey * 128 + (((lch >> 2) ^ ((lkey >> 1) & 1)) << 6) + ((lch & 3) << 4);
    const unsigned kr0 = qi * 128 + ((hh ^ (qi & 7)) << 4);
    const int q4 = (lane & 15) >> 2, p4 = lane & 3, g1 = (lane >> 4) & 1, sw = (q4 >> 1) & 1;
    const unsigned vr0 = (4 * hh + q4) * 128 + 32 * g1 + 8 * p4 + (sw << 6), vr1 = (4 * hh + q4) * 128 + 32 * g1 + 8 * p4 + ((sw ^ 1) << 6);
    const int bidx0 = (TYPE == 2) ? (cbs - gc + 31 + 4 * hh) : ((TYPE == 1 ? 64 : 32) - qi + 4 * hh);
    int cs = gc - 8; cs = cs < 0 ? 0 : (cs > 48 ? 48 : cs);
    const int xm = cbs - cs + 4 * hh;
    int rs0 = gi0 - 4; rs0 = rs0 < 0 ? 0 : (rs0 > 120 ? 120 : rs0);
    int rs1 = gi1 - 4; rs1 = rs1 < 0 ? 0 : (rs1 > 120 ? 120 : rs1);
    v4u kreg[4], vreg[4];
    {
        const size_t tb_ = (size_t)(TT0 + tlo * TSTEP) * 128;
#pragma unroll
        for (int i = 0; i < 4; ++i) { kreg[i] = *(const GAS v4u*)(kbase + tb_ + i * istepb + goff); vreg[i] = *(const GAS v4u*)(vbase + tb_ + i * istepb + goff); }
    }
    for (int ti = tlo; ti <= thi; ++ti) {
#pragma unroll
        for (int i = 0; i < 4; ++i) { *(LAS v4u*)(kt + kw0 + 1024 * i) = kreg[i]; *(LAS v4u*)(vt + vw0 + 1024 * i) = vreg[i]; }
        if (ti < thi) {
            const size_t tb_ = (size_t)(TT0 + (ti + 1) * TSTEP) * 128;
#pragma unroll
            for (int i = 0; i < 4; ++i) { kreg[i] = *(const GAS v4u*)(kbase + tb_ + i * istepb + goff); vreg[i] = *(const GAS v4u*)(vbase + tb_ + i * istepb + goff); }
        }
        int bi0, bi1;
        if (TYPE == 2) { const bool rv0 = (ti >= rs0) && (ti < rs0 + 8), rv1 = (ti >= rs1) && (ti < rs1 + 8); bi0 = bidx0 + (rv0 ? (ti - gi0 + 7) : 15) * 64; bi1 = bidx0 + (rv1 ? (ti - gi1 + 7) : 15) * 64; }
        else { bi0 = bidx0 + 32 * ti; bi1 = bidx0 + 32 * (ti - toff1); }
        f32x16 S0, S1;
        ATT_INIT(S0, tb0, bi0, xm); ATT_INIT(S1, tb1, bi1, xm);
#pragma unroll
        for (int s = 0; s < 4; ++s) { const bf16x8 Kf = *(const LAS bf16x8*)(kt + (kr0 ^ (unsigned)(s << 5)));
            S0 = __builtin_amdgcn_mfma_f32_32x32x16_bf16(Kf, Qa[s], S0, 0, 0, 0); S1 = __builtin_amdgcn_mfma_f32_32x32x16_bf16(Kf, Qb[s], S1, 0, 0, 0); }
        float t0, t1; ATT_TMAX(S0, t0); ATT_TMAX(S1, t1);
        t0 = xhalf_max(t0); t1 = xhalf_max(t1);
        const bool need0 = t0 > m0 + 8.0f, need1 = t1 > m1 + 8.0f;
        if (__builtin_amdgcn_ballot_w64(need0 || need1) != 0ull) { ATT_RESCALE(need0, t0, m0, l0, O0a, O0b); ATT_RESCALE(need1, t1, m1, l1, O1a, O1b); }
        float rs0, rs1; ATT_EXP(S0, m0, rs0); ATT_EXP(S1, m1, rs1);
        rs0 = xhalf_sum(rs0); rs1 = xhalf_sum(rs1);
        l0 += rs0; l1 += rs1;
#pragma unroll
        for (int s2 = 0; s2 < 2; ++s2) {
            bf16x8 P0, P1; ATT_PACK(P0, S0, s2); ATT_PACK(P1, S1, s2);
            const s16x4 a00 = __builtin_amdgcn_ds_read_tr16_b64_v4i16((LAS s16x4*)(vt + vr0 + (16 * s2) * 128));
            const s16x4 a01 = __builtin_amdgcn_ds_read_tr16_b64_v4i16((LAS s16x4*)(vt + vr0 + (16 * s2 + 8) * 128));
            const s16x4 a10 = __builtin_amdgcn_ds_read_tr16_b64_v4i16((LAS s16x4*)(vt + vr1 + (16 * s2) * 128));
            const s16x4 a11 = __builtin_amdgcn_ds_read_tr16_b64_v4i16((LAS s16x4*)(vt + vr1 + (16 * s2 + 8) * 128));
            const bf16x8 V0 = (bf16x8){a00[0], a00[1], a00[2], a00[3], a01[0], a01[1], a01[2], a01[3]};
            const bf16x8 V1 = (bf16x8){a10[0], a10[1], a10[2], a10[3], a11[0], a11[1], a11[2], a11[3]};
            O0a = __builtin_amdgcn_mfma_f32_32x32x16_bf16(V0, P0, O0a, 0, 0, 0); O0b = __builtin_amdgcn_mfma_f32_32x32x16_bf16(V1, P0, O0b, 0, 0, 0);
            O1a = __builtin_amdgcn_mfma_f32_32x32x16_bf16(V0, P1, O1a, 0, 0, 0); O1b = __builtin_amdgcn_mfma_f32_32x32x16_bf16(V1, P1, O1b, 0, 0, 0);
        }
    }
    ATT_STAGE(kt, O0a, O0b, l0); ATT_STAGE(vt, O1a, O1b, l1);
    ATT_FLUSH(kt, ob0, tqs0); ATT_FLUSH(vt, ob1, tqs1);
    if (TYPE == 1 && hh == 0) { *(GAS float*)(lb + (size_t)tq0 * 12) = (m0 + __builtin_amdgcn_logf(l0)) * LN2; *(GAS float*)(lb + (size_t)tq1 * 12) = (m1 + __builtin_amdgcn_logf(l1)) * LN2; }
#undef ATT_LTOK
}

__device__ __forceinline__ void att_tasks(Frame& F, int l, const int t_lo, const int t_hi) {
    LAS unsigned char* wl = F.lds + RING_OFF + F.wave * 16384;
    const bf16* qkv = (const bf16*)(F.ws + WS_QKV); bf16* oabc = (bf16*)(F.ws + WS_OABC); bf16* og = (bf16*)(F.ws + WS_OG); float* lse = (float*)(F.ws + WS_LSE);
    const float* TA = (const float*)(F.ws + WS_TABA); const float* TB = (const float*)(F.ws + WS_TABB); const float* TC = (const float*)(F.ws + WS_TABC) + (size_t)l * 8 * 1024;
    const float* sink = F.in[6] + l * 8;
    const int gw = F.vcu * NWAVES + F.wave, NGW = F.G * NWAVES;
    const float* last_tab = nullptr;
    for (int task = t_lo + gw; task < t_hi; task += NGW) {
        int lane = F.lane; asm volatile("" : "+v"(lane)); const int qi = lane & 31;
        if (task < NT_A) {
            const int hp = task & 3, qb = (task >> 2) & 255, b = task >> 10, q0 = qb * 32, h0 = hp * 2, h1 = h0 + 1, kvh = hp >> 1;
            int tlo = 0, thi = 8; if (q0 - 128 < 0) tlo = (128 - q0) / 32; if (q0 + 128 + 31 >= L) thi = (L - 1 - (q0 - 128)) / 32;
            bf16* orow = oabc + (size_t)(b * L) * OW;
            att_task2<0>(wl, lane, qkv + (size_t)b * L * 64, TA + h0 * 320, TA + h1 * 320, AQ + h0 * 64, AQ + h1 * 64, AK + kvh * 64, AV + kvh * 64, q0 - 128, 32, 1, tlo, thi,
                         q0, q0, 0, 0, 0, 0, 0, sink[h0] * LOG2E, sink[h1] * LOG2E, 1.0f, orow + h0 * 64, orow + h1 * 64, OW, nullptr, 0, last_tab != TA + h0 * 320); last_tab = TA + h0 * 320;
        } else if (task < NT_A + NT_B) {
            const int j = task - NT_A, h = j & 3, sbi = (j >> 2) & 127, bg = j >> 9, b = (bg * 11) >> 5  , g = bg - 3 * b;
            const int dsh = 2 * g, d = 1 << dsh, nsb = 128 >> dsh, r = sbi >> (7 - dsh), sb = sbi & (nsb - 1), q0 = sb * 64, Ls = L >> dsh;
            int tlo = 0, thi = 5; if (q0 - 64 < 0) tlo = (64 - q0) / 32; if (q0 + 32 + 64 + 31 >= Ls) thi = (Ls - 1 - (q0 - 64)) / 32;
            const int qc = BQ0 + 768 * g + h * 64; bf16* ogb = og + ((size_t)(b * L) * 3 + g) * 256 + h * 64;
            att_task2<1>(wl, lane, qkv + (size_t)b * L * 64, TB + h * 256, nullptr, qc, qc, qc + 256, qc + 512, (q0 - 64) * d + r, 32 * d, d, tlo, thi,
                         q0 * d + r, (q0 + 32) * d + r, 1, 0, 0, 0, 0, MINIT, MINIT, 0.0f, ogb, ogb, 768,
                         lse + ((size_t)(b * L) * 3 + g) * 4 + h, g, last_tab != TB + h * 256); last_tab = TB + h * 256;
        } else {
            const int j = task - NT_A - NT_B, h = j & 7, cbi = (j >> 3) & 127, b = j >> 10, ip = cbi >> 2, cb = cbi & 3;
            const int gi0 = 4 * ip + (qi >> 4), gi1 = gi0 + 2, gc = 16 * cb + (qi & 15), tqs = 4 * ip * 64 + 16 * cb;
            int cbs = 16 * cb - 8; cbs = cbs < 0 ? 0 : (cbs > 32 ? 32 : cbs);
            int rlo = 4 * ip - 4; rlo = rlo < 0 ? 0 : (rlo > 120 ? 120 : rlo);
            int rhi = 4 * ip + 3 - 4; rhi = rhi < 0 ? 0 : (rhi > 120 ? 120 : rhi); rhi += 7;
            bf16* ob = oabc + (size_t)(b * L) * OW + 768 + h * 64;
            att_task2<2>(wl, lane, qkv + (size_t)b * L * 64, TC + h * 1024, nullptr, CQ + h * 64, CQ + h * 64, CK + h * 64, CV + h * 64, cbs, 64, 1, rlo, rhi,
                         tqs, tqs + 128, 0, gi0, gi1, gc, cbs, MINIT, MINIT, 0.0f, ob, ob, OW, nullptr, 0, last_tab != TC + h * 1024); last_tab = TC + h * 1024;
        }
    }
}
template <class Bar> __device__ __forceinline__ void ph_att(Frame& F, int l, const Bar& bar, const bool fused) { LAUNDER(F); asm volatile("" : "+s"(l));
    att_tasks(F, l, NT_A, NT_A + NT_B);
    if (fused) { xcd_barrier(bar); ph_cmb(F); }
    att_tasks(F, l, 0, NT_A);
    att_tasks(F, l, NT_A + NT_B, NT_ALL);
}

constexpr int NSTEPS = 1 + DEPTH * 16;
__global__ void __launch_bounds__(NTHREADS, 2) mk_fwd(Args args) {
    extern __shared__ __attribute__((aligned(16))) unsigned char lds[];
    Frame F;
    F.lds = (LAS unsigned char*)lds; F.wave = __builtin_amdgcn_readfirstlane((int)threadIdx.x >> 6); F.lane = hw_lane(); F.tid = F.wave * 64 + F.lane;
    F.G = gridDim.x; { const int bx = blockIdx.x; F.vcu = (F.G % 8 == 0) ? (bx % 8) * (F.G / 8) + bx / 8 : bx; }
    F.in = args.in; F.h = args.out; F.ws = args.ws; F.probe = args.probe;
    volatile LAS unsigned* MISC = (volatile LAS unsigned*)(F.lds + MISC_OFF);
    if (F.tid < 32) MISC[F.tid] = 0u;
    __syncthreads();
    const int lo = args.s_lo, hi = args.s_hi;
    XcdBarrier bar; bar.wave0 = (F.wave == 0); bar.bar = (unsigned*)(F.ws + WS_CTL) + CW_BAR; bar.x = 0; bar.st = nullptr;
    if (hi - lo > 1) bar = xcd_barrier_post((unsigned*)(F.ws + WS_CTL) + CW_BAR, MISC + 8, F.wave == 0);
#define RUN(s) (lo <= (s) && (s) < hi)
#define SEAM(s) do { if (RUN(s) && RUN((s) + 1)) xcd_barrier(bar); } while (0)
    if (RUN(0)) { ph_prologue(F); ph_tables(F); ph_ln0(F); }
    SEAM(0);
    for (int l = 0; l < DEPTH; ++l) {
        const int sb = 1 + l * 16;
        for (int c = 0; c < NCHUNK; ++c) {
            const int s = sb + c * 6;
            if (RUN(s)) ph_p1(F, l, c);
            SEAM(s);
            const bool att_fused = RUN(s + 1) && RUN(s + 2);
            if (RUN(s + 1)) ph_att(F, l, bar, att_fused);
            if (!att_fused) { SEAM(s + 1); if (RUN(s + 2)) ph_cmb(F); }
            SEAM(s + 2);
            if (RUN(s + 3)) ph_p3(F, l);
            SEAM(s + 3);
            if (RUN(s + 4)) ph_p4(F, l, c);
            SEAM(s + 4);
            if (RUN(s + 5)) ph_ln1(F, l, c);
            if (c == NCHUNK - 1) SEAM(s + 5);
        }
        if (RUN(sb + 12)) ph_dsp(F, l);
        SEAM(sb + 12);
        if (RUN(sb + 13)) ph_p7(F, l, 0);
        SEAM(sb + 13);
        if (RUN(sb + 14)) { ph_p7(F, l, 1); ph_p8(F, l, 0); ph_p8(F, l, 1); }
        SEAM(sb + 14);
        if (RUN(sb + 15)) ph_ln2(F, l);
        SEAM(sb + 15);
    }
#undef RUN
#undef SEAM
}

extern "C" void kernel_launch(void* const* d_in, const int* in_sizes, int n_in, void* d_out, int out_size, void* d_ws, size_t ws_size, hipStream_t stream) {
    static int grid = 0;
    if (grid == 0) {
        if (n_in != 23 || out_size != T * D || ws_size < WS_END) { fprintf(stderr, "kernel_launch: unexpected shapes (n_in %d out %d ws %zu)\n", n_in, out_size, ws_size); grid = -1; return; }
        int dev = 0, cus = 0, per_cu = 0;
        if (hipGetDevice(&dev) != hipSuccess || hipDeviceGetAttribute(&cus, hipDeviceAttributeMultiprocessorCount, dev) != hipSuccess) { grid = -1; return; }
        if (hipFuncSetAttribute((const void*)mk_fwd, hipFuncAttributeMaxDynamicSharedMemorySize, LDS_BYTES) != hipSuccess) { fprintf(stderr, "kernel_launch: hipFuncSetAttribute failed\n"); grid = -1; return; }
        if (hipOccupancyMaxActiveBlocksPerMultiprocessor(&per_cu, (const void*)mk_fwd, NTHREADS, LDS_BYTES) != hipSuccess || per_cu < 1) fprintf(stderr, "kernel_launch: occupancy query reports %d\n", per_cu);
        (void)hipGetLastError();
        grid = cus > 256 ? 256 : cus;
    }
    if (grid < 0) return;
    (void)hipMemsetAsync((unsigned char*)d_ws + WS_CTL, 0, CTL_ZERO_BYTES, stream);
    Args a{};
    for (int i = 0; i < 23; ++i) a.in[i] = (const float*)d_in[i];
    a.out = (float*)d_out; a.ws = (unsigned char*)d_ws; a.s_lo = 0; a.s_hi = NSTEPS; a.probe = 0; a.pad = 0;
    hipLaunchKernelGGL(mk_fwd, dim3(grid), dim3(NTHREADS), LDS_BYTES, stream, a);
}
```
